# Optimizing an MI355X kernel written in HIP

```python
import math
import jax, jax.numpy as jnp
from jax import lax
import numpy as np

D_MODEL = 1024
BATCH = 32
SEQ = 256
DEPTH = 4
DEC_BATCH = 2
DEC_SEQ = 1024
PAST_LEN = 512

GRID_W = 64
N_MIXERS = 3
N_A = (DEPTH + 2) // 3
N_B = (DEPTH + 1) // 3
N_C = DEPTH // 3
N_MOD = 6
EPS = 1e-6
D_RNN = 1280
LRU_BLOCKS = 10
LRU_BLOCK = D_RNN // LRU_BLOCKS
LRU_CONV_W = 4
LRU_CONV_LEFT = 2
LRU_C = 8.0
LRU_A_MIN = 0.9
LRU_A_MAX = 0.999
D_B = 2 * D_MODEL
CHUNK = 128
G_B = 8
N_HEADS_C = 8
HEAD_DIM_C = D_MODEL // (2 * N_HEADS_C)
N_FREQ_AXIS = HEAD_DIM_C // 4
ROPE_BASE = 10000.0
Q_BLOCK = 128
D_FF = 2816
FFN_CONV_W = 3
FFN_CONV_LEFT = 1

kernel_name = 'hybrid_diffusion_rglru_chunkmlp_diffattn_step'


def rms_norm(x, g):
    xf = x.astype(jnp.float32)
    y = xf * lax.rsqrt(jnp.mean(xf * xf, axis=-1, keepdims=True) + EPS)
    return (y * g.astype(jnp.float32)).astype(x.dtype)


def adaln(cond, w, b):
    m = jax.nn.silu(cond) @ w + b
    return jnp.split(m[:, None, :], N_MOD, axis=-1)


def modulate(x, g, shift, scale):
    return rms_norm(x, g) * (1 + scale) + shift


def dw_conv(x, w, b, left):
    K = w.shape[0]
    T = x.shape[1]
    xp = jnp.pad(x, ((0, 0), (left, K - 1 - left), (0, 0)))
    y = b
    for k in range(K):
        y = y + xp[:, k:k + T] * w[k]
    return y


def linear_scan(a, b, h0):
    b = b.at[:, 0].add(a[:, 0] * h0)
    def combine(l, r):
        al, bl = l
        ar, br = r
        return al * ar, ar * bl + br
    _, h = lax.associative_scan(combine, (a, b), axis=1)
    return h


def rglru_mixer(h, h0, w_in, conv_w, conv_b, w_gate, b_gate, lam, w_out):
    gate_br, rec = jnp.split(h @ w_in, 2, axis=-1)
    xc = dw_conv(rec, conv_w, conv_b, LRU_CONV_LEFT)
    B, T, _ = xc.shape
    xb = xc.reshape(B, T, LRU_BLOCKS, LRU_BLOCK)
    gates = jax.nn.sigmoid(jnp.einsum('btnk,dgnkj->dgbtnj', xb, w_gate) + b_gate[:, :, None, None])
    gates = gates.astype(jnp.float32).reshape(2, 2, B, T, D_RNN)
    r, i = gates[:, 0], gates[:, 1]
    log_a = -LRU_C * r * jax.nn.softplus(-lam.astype(jnp.float32))[:, None, None, :]
    a = jnp.exp(log_a)
    bx = jnp.sqrt(-jnp.expm1(2.0 * log_a)) * (i * xc.astype(jnp.float32)[None])
    h0f = h0.astype(jnp.float32)
    hf = linear_scan(a[0], bx[0], h0f[:, 0])
    hb = jnp.flip(linear_scan(jnp.flip(a[1], 1), jnp.flip(bx[1], 1), h0f[:, 1]), 1)
    y = (jax.nn.gelu(gate_br) * (hf + hb).astype(h.dtype)) @ w_out
    final = jnp.stack([hf[:, -1], hb[:, 0]], axis=1).astype(h.dtype)
    return y, final


def chunk_mlp_mixer(h, w_in, b_in, norm_g, w_s, b_s, w_out):
    u, v = jnp.split(jax.nn.gelu(h @ w_in + b_in), 2, axis=-1)
    v = rms_norm(v, norm_g)
    B, T, _ = v.shape
    vr = v.reshape(B, T // CHUNK, CHUNK, G_B, D_B // G_B)
    sv = jnp.einsum('gpq,bcqgk->bcpgk', w_s, vr) + b_s.T[:, :, None]
    return (u * sv.reshape(B, T, D_B)) @ w_out


def axial_rope(T):
    rows = T // GRID_W
    row = jnp.repeat(jnp.arange(rows), GRID_W)
    col = jnp.tile(jnp.arange(GRID_W), rows)
    inv = ROPE_BASE ** (-jnp.arange(N_FREQ_AXIS, dtype=jnp.float32) / N_FREQ_AXIS)
    ang = jnp.concatenate([row[:, None] * inv, col[:, None] * inv], axis=-1)
    return jnp.cos(ang), jnp.sin(ang)


def apply_rope(x, cos, sin):
    half = HEAD_DIM_C // 2
    x1, x2 = x[..., :half], x[..., half:]
    cs = cos[None, :, None, None, :].astype(x.dtype)
    sn = sin[None, :, None, None, :].astype(x.dtype)
    return jnp.concatenate([x1 * cs - x2 * sn, x2 * cs + x1 * sn], axis=-1)


def diff_qkv(h, w_qkv, qk_g, rope):
    B, T, _ = h.shape
    q, k, v = jnp.split(h @ w_qkv, 3, axis=-1)
    q = rms_norm(q.reshape(B, T, N_HEADS_C, 2, HEAD_DIM_C), qk_g[0])
    k = rms_norm(k.reshape(B, T, N_HEADS_C, 2, HEAD_DIM_C), qk_g[1])
    v = v.reshape(B, T, N_HEADS_C, 2 * HEAD_DIM_C)
    if rope is not None:
        q = apply_rope(q, rope[0], rope[1])
        k = apply_rope(k, rope[0], rope[1])
    return q, k, v


def diff_lambda(lam_vec, lam_init):
    lv = lam_vec.astype(jnp.float32)
    return jnp.exp(jnp.sum(lv[0] * lv[1])) - jnp.exp(jnp.sum(lv[2] * lv[3])) + lam_init


def diff_attention(q, k, v, lam, lam_init, subln_g):
    B, Tq = q.shape[0], q.shape[1]
    nb = Tq // Q_BLOCK
    qb = q.reshape(B, nb, Q_BLOCK, N_HEADS_C, 2, HEAD_DIM_C).transpose(1, 0, 2, 3, 4, 5)
    scale = HEAD_DIM_C ** -0.5
    def one_block(qblk):
        s = jnp.einsum('bqhcd,bkhcd->bchqk', qblk, k).astype(jnp.float32) * scale
        p = jax.nn.softmax(s, axis=-1)
        w = p[:, 0] - lam * p[:, 1]
        return jnp.einsum('bhqk,bkhe->bqhe', w.astype(v.dtype), v)
    o = lax.map(one_block, qb)
    o = o.transpose(1, 0, 2, 3, 4).reshape(B, Tq, N_HEADS_C, 2 * HEAD_DIM_C)
    o = rms_norm(o, subln_g) * (1.0 - lam_init)
    return o.reshape(B, Tq, N_HEADS_C * 2 * HEAD_DIM_C)


def conv_ffn(h, w_up, conv_w, conv_b, w_down):
    z = dw_conv(h @ w_up, conv_w, conv_b, FFN_CONV_LEFT)
    g, u = jnp.split(z, 2, axis=-1)
    return (jax.nn.silu(g) * u) @ w_down


def setup_inputs(seed: int = 0) -> dict:
    key = jax.random.key(seed)
    ks = iter(jax.random.split(key, 40))
    f32 = jnp.float32
    def nrm(shape, scale):
        return jax.random.normal(next(ks), shape, f32) * scale
    def gain(shape):
        return 1.0 + nrm(shape, 0.02)
    a0 = jax.random.uniform(next(ks), (N_A, 2, D_RNN), f32, minval=LRU_A_MIN, maxval=LRU_A_MAX)
    a_root = a0 ** (1.0 / LRU_C)
    lru_lambda = jnp.log(a_root) - jnp.log1p(-a_root)
    return {
        'x_prompt': nrm((BATCH, SEQ, D_MODEL), 1.0),
        'x_sample': nrm((DEC_BATCH, DEC_SEQ, D_MODEL), 1.0),
        'state_lru': nrm((DEC_BATCH, N_A, 2, D_RNN), 0.5),
        'cache_k': nrm((DEC_BATCH, N_C, PAST_LEN, N_HEADS_C, 2, HEAD_DIM_C), 1.0),
        'cache_v': nrm((DEC_BATCH, N_C, PAST_LEN, N_HEADS_C, 2 * HEAD_DIM_C), 1.0),
        'c': nrm((DEC_BATCH, D_MODEL), 1.0),
        'c_ctx': nrm((D_MODEL,), 1.0),
        'w_mod': nrm((DEPTH, D_MODEL, N_MOD * D_MODEL), 0.5 * D_MODEL ** -0.5),
        'b_mod': nrm((DEPTH, N_MOD * D_MODEL), 0.02),
        'norm_g': gain((DEPTH, 2, D_MODEL)),
        'lru_w_in': nrm((N_A, D_MODEL, 2 * D_RNN), D_MODEL ** -0.5),
        'lru_conv_w': nrm((N_A, LRU_CONV_W, D_RNN), LRU_CONV_W ** -0.5),
        'lru_conv_b': nrm((N_A, D_RNN), 0.02),
        'lru_w_gate': nrm((N_A, 2, 2, LRU_BLOCKS, LRU_BLOCK, LRU_BLOCK), LRU_BLOCK ** -0.5),
        'lru_b_gate': nrm((N_A, 2, 2, LRU_BLOCKS, LRU_BLOCK), 0.02),
        'lru_lambda': lru_lambda,
        'lru_w_out': nrm((N_A, D_RNN, D_MODEL), D_RNN ** -0.5),
        'cmlp_w_in': nrm((N_B, D_MODEL, 2 * D_B), D_MODEL ** -0.5),
        'cmlp_b_in': nrm((N_B, 2 * D_B), 0.02),
        'cmlp_norm_g': gain((N_B, D_B)),
        'cmlp_w_s': nrm((N_B, G_B, CHUNK, CHUNK), CHUNK ** -0.5),
        'cmlp_b_s': nrm((N_B, G_B, CHUNK), 0.02),
        'cmlp_w_out': nrm((N_B, D_B, D_MODEL), D_B ** -0.5),
        'attn_w_qkv': nrm((N_C, D_MODEL, 3 * N_HEADS_C * 2 * HEAD_DIM_C), D_MODEL ** -0.5),
        'attn_qk_g': gain((N_C, 2, HEAD_DIM_C)),
        'attn_lambda': nrm((N_C, 4, HEAD_DIM_C), 0.1),
        'attn_subln_g': gain((N_C, 2 * HEAD_DIM_C)),
        'attn_w_out': nrm((N_C, N_HEADS_C * 2 * HEAD_DIM_C, D_MODEL), (N_HEADS_C * 2 * HEAD_DIM_C) ** -0.5),
        'ffn_w_up': nrm((DEPTH, D_MODEL, 2 * D_FF), D_MODEL ** -0.5),
        'ffn_conv_w': nrm((DEPTH, FFN_CONV_W, 2 * D_FF), FFN_CONV_W ** -0.5),
        'ffn_conv_b': nrm((DEPTH, 2 * D_FF), 0.02),
        'ffn_w_down': nrm((DEPTH, D_FF, D_MODEL), D_FF ** -0.5),
    }


def reference(x_prompt, x_sample, state_lru, cache_k, cache_v, c, c_ctx, w_mod, b_mod, norm_g,
              lru_w_in, lru_conv_w, lru_conv_b, lru_w_gate, lru_b_gate, lru_lambda, lru_w_out,
              cmlp_w_in, cmlp_b_in, cmlp_norm_g, cmlp_w_s, cmlp_b_s, cmlp_w_out,
              attn_w_qkv, attn_qk_g, attn_lambda, attn_subln_g, attn_w_out,
              ffn_w_up, ffn_conv_w, ffn_conv_b, ffn_w_down):
    xp, xs = x_prompt, x_sample
    rope = axial_rope(xs.shape[1])
    cond_ctx = c_ctx[None, :]
    new_lru, new_k, new_v = [], [], []
    for l in range(DEPTH):
        kind = l % N_MIXERS
        j = l // N_MIXERS
        sh1p, sc1p, g1p, sh2p, sc2p, g2p = adaln(cond_ctx, w_mod[l], b_mod[l])
        sh1s, sc1s, g1s, sh2s, sc2s, g2s = adaln(c, w_mod[l], b_mod[l])
        hp = modulate(xp, norm_g[l, 0], sh1p, sc1p)
        hs = modulate(xs, norm_g[l, 0], sh1s, sc1s)
        if kind == 0:
            lru_args = (lru_w_in[j], lru_conv_w[j], lru_conv_b[j], lru_w_gate[j], lru_b_gate[j],
                        lru_lambda[j], lru_w_out[j])
            h0 = jnp.zeros((xp.shape[0], 2, D_RNN), xp.dtype)
            yp, st = rglru_mixer(hp, h0, *lru_args)
            ys, _ = rglru_mixer(hs, state_lru[:, j], *lru_args)
            new_lru.append(st)
        elif kind == 1:
            cm_args = (cmlp_w_in[j], cmlp_b_in[j], cmlp_norm_g[j], cmlp_w_s[j], cmlp_b_s[j], cmlp_w_out[j])
            yp = chunk_mlp_mixer(hp, *cm_args)
            ys = chunk_mlp_mixer(hs, *cm_args)
        else:
            lam_init = 0.8 - 0.6 * math.exp(-0.3 * l)
            lam = diff_lambda(attn_lambda[j], lam_init)
            qp, kp, vp = diff_qkv(hp, attn_w_qkv[j], attn_qk_g[j], None)
            qs, ks_lat, vs_lat = diff_qkv(hs, attn_w_qkv[j], attn_qk_g[j], rope)
            yp = diff_attention(qp, kp, vp, lam, lam_init, attn_subln_g[j]) @ attn_w_out[j]
            k_all = jnp.concatenate([cache_k[:, j], ks_lat], axis=1)
            v_all = jnp.concatenate([cache_v[:, j], vs_lat], axis=1)
            ys = diff_attention(qs, k_all, v_all, lam, lam_init, attn_subln_g[j]) @ attn_w_out[j]
            new_k.append(kp)
            new_v.append(vp)
        xp = xp + g1p * yp
        xs = xs + g1s * ys
        hp = modulate(xp, norm_g[l, 1], sh2p, sc2p)
        hs = modulate(xs, norm_g[l, 1], sh2s, sc2s)
        xp = xp + g2p * conv_ffn(hp, ffn_w_up[l], ffn_conv_w[l], ffn_conv_b[l], ffn_w_down[l])
        xs = xs + g2s * conv_ffn(hs, ffn_w_up[l], ffn_conv_w[l], ffn_conv_b[l], ffn_w_down[l])
    new_state_lru = jnp.stack(new_lru, axis=1)
    new_cache_k = jnp.stack(new_k, axis=1)
    new_cache_v = jnp.stack(new_v, axis=1)
    return (xp, xs, new_state_lru, new_cache_k, new_cache_v)
```

```cpp
#include <hip/hip_runtime.h>
#include <cstdio>
#include <cstdint>

#define GAS __attribute__((address_space(1)))
#define LAS __attribute__((address_space(3)))
typedef unsigned short bf16;
typedef float f32x4 __attribute__((ext_vector_type(4)));
typedef unsigned u32x2 __attribute__((ext_vector_type(2)));
typedef unsigned u32x4 __attribute__((ext_vector_type(4)));

constexpr int D = 1024, NPROMPT = 32 * 256, NSAMPLE = 2 * 1024, M = NPROMPT + NSAMPLE;
constexpr int DEPTH = 4, DRNN = 1280, DB = 2048, DFF = 2816, PAST = 512, TKS = PAST + 1024;
constexpr float EPS = 1e-6f;
constexpr int NWAVES = 8, NT = NWAVES * 64;

enum { I_XP = 0, I_XS, I_STATE, I_CK, I_CV, I_C, I_CCTX, I_WMOD, I_BMOD, I_NORMG, I_LRU_WIN, I_LRU_CW, I_LRU_CB, I_LRU_WG, I_LRU_BG, I_LRU_LAM, I_LRU_WOUT,
       I_CM_WIN, I_CM_BIN, I_CM_NG, I_CM_WS, I_CM_BS, I_CM_WOUT, I_AT_WQKV, I_AT_QKG, I_AT_LAM, I_AT_SUBG, I_AT_WOUT, I_FF_WUP, I_FF_CW, I_FF_CB, I_FF_WDN, N_IN };
constexpr size_t O_YP = 0, O_YS = (size_t)NPROMPT * D, O_STATE = (size_t)M * D, O_CK = O_STATE + 32 * 2 * 2 * DRNN, O_CV = O_CK + (size_t)NPROMPT * D;

constexpr size_t MiB = 1u << 20;
constexpr size_t WS_CTL = 0, CTL_ZERO_BYTES = 64 * 1024;
constexpr size_t WS_MOD = 1 * MiB;
constexpr size_t WS_RSTD = WS_MOD + 512 * 1024;
constexpr size_t WS_ROPE = WS_RSTD + 256 * 1024;
constexpr size_t WS_H = 2 * MiB;
constexpr size_t WS_T1 = 22 * MiB;
constexpr size_t WS_T2 = 132 * MiB;
constexpr size_t WS_T3 = 187 * MiB;
constexpr size_t WS_KS = 237 * MiB, WS_VS = 243 * MiB;
constexpr size_t WS_END = 249 * MiB;
constexpr int CW_BAR = 1024;

__device__ __forceinline__ unsigned f2bf(float f) { unsigned u = __builtin_bit_cast(unsigned, f); return (u + 0x7fffu + ((u >> 16) & 1u)) >> 16; }
__device__ __forceinline__ float bf2f(unsigned b) { return __builtin_bit_cast(float, (b & 0xffffu) << 16); }
__device__ __forceinline__ float wave_sum(float v) {
#pragma unroll
    for (int o = 1; o < 64; o <<= 1) v += __shfl_xor(v, o);
    return v;
}
__device__ __forceinline__ float wave_max(float v) {
#pragma unroll
    for (int o = 1; o < 64; o <<= 1) v = fmaxf(v, __shfl_xor(v, o));
    return v;
}
__device__ __forceinline__ float gelu_tanh(float x) { const float y = 0.7978845608028654f * (x + 0.044715f * x * x * x); const float t = 1.f - 2.f / (__expf(2.f * y) + 1.f); return 0.5f * x * (1.f + t); }
__device__ __forceinline__ float sigmoidf_(float x) { return 1.f / (1.f + __expf(-x)); }
__device__ __forceinline__ float siluf_(float x) { return x / (1.f + __expf(-x)); }
__device__ __forceinline__ float softplusf_(float x) { return fmaxf(x, 0.f) + log1pf(expf(-fabsf(x))); }

#define XB_TMO      128
#define XB_XCNT(j)  (256  + 64 * (j))
#define XB_XSUB(j)  (1280 + 64 * (j))
#define XB_XGEN(j)  (2304 + 64 * (j))
#define XB_TOP      3328
#define XB_TOPGEN   3392
#define XCD_BAR_WORDS 3456
#define XB_SPIN_CAP (1u << 22)
__device__ __forceinline__ unsigned xb_ld(unsigned* p)              { return __hip_atomic_load(p, __ATOMIC_RELAXED, __HIP_MEMORY_SCOPE_AGENT); }
__device__ __forceinline__ unsigned xb_add(unsigned* p, unsigned v) { return __hip_atomic_fetch_add(p, v, __ATOMIC_RELAXED, __HIP_MEMORY_SCOPE_AGENT); }
__device__ __forceinline__ unsigned xb_xcc_id() { return (unsigned)__builtin_amdgcn_s_getreg((3 << 11) | 20) & 0xFu; }
#define XB_SPIN(cond, bar) do { unsigned _sp = 0; while (cond) { __builtin_amdgcn_s_sleep(1); \
    if ((++_sp & 255u) == 0u) { if (xb_ld(&(bar)[XB_TMO])) break; if (_sp > XB_SPIN_CAP) { atomicAdd(&(bar)[XB_TMO], 1u); break; } } } } while (0)
struct XcdBarrier { unsigned* bar; unsigned x; volatile LAS unsigned* st; };
__device__ __forceinline__ XcdBarrier xcd_barrier_post(unsigned* bar, volatile LAS unsigned* st) {
    XcdBarrier b; b.bar = bar; b.x = xb_xcc_id(); b.st = st;
    if (threadIdx.x == 0) (void)xb_add(&bar[XB_XCNT(b.x)], 1u);
    return b;
}
__device__ __forceinline__ void xcd_barrier_complete(unsigned* bar, unsigned x, unsigned& nloc, unsigned& nx) {
    const unsigned G = gridDim.x * gridDim.y * gridDim.z;
    unsigned sum, cnt, mine, sp = 0u;
    for (;;) {
        sum = 0u; cnt = 0u; mine = 0u;
#pragma unroll
        for (unsigned j = 0; j < 16; ++j) { const unsigned c = xb_ld(&bar[XB_XCNT(j)]); sum += c; cnt += (c > 0u) ? 1u : 0u; mine = (j == x) ? c : mine; }
        if (sum == G) break;
        __builtin_amdgcn_s_sleep(1);
        if ((++sp & 255u) == 0u) { if (xb_ld(&bar[XB_TMO])) break; if (sp > XB_SPIN_CAP) { atomicAdd(&bar[XB_TMO], 1u); break; } }
    }
    nloc = mine > 0u ? mine : 1u; nx = cnt > 0u ? cnt : 1u;
}
__device__ __forceinline__ void xcd_barrier(const XcdBarrier& b) {
    asm volatile("s_waitcnt vmcnt(0)" ::: "memory");
    __syncthreads();
    if (threadIdx.x == 0) {
        unsigned* bar = b.bar;
        __builtin_amdgcn_s_waitcnt(0);
        unsigned nloc = b.st[0], nx = b.st[1];
        if (nloc == 0u) { xcd_barrier_complete(bar, b.x, nloc, nx); b.st[0] = nloc; b.st[1] = nx; }
        const unsigned old = xb_add(&bar[XB_XSUB(b.x)], 1u);
        const unsigned gen = old / nloc;
        if (old + 1u == (gen + 1u) * nloc) {
            __builtin_amdgcn_fence(__ATOMIC_RELEASE, "agent");
            asm volatile("s_waitcnt vmcnt(0)" ::: "memory");
            const unsigned og = xb_add(&bar[XB_TOP], 1u);
            const unsigned tg = og / nx;
            if (og + 1u == (tg + 1u) * nx) xb_add(&bar[XB_TOPGEN], 1u);
            else XB_SPIN(xb_ld(&bar[XB_TOPGEN]) == tg, bar);
            __builtin_amdgcn_fence(__ATOMIC_ACQUIRE, "agent");
            xb_add(&bar[XB_XGEN(b.x)], 1u);
            asm volatile("s_waitcnt vmcnt(0)" ::: "memory");
        } else {
            XB_SPIN(xb_ld(&bar[XB_XGEN(b.x)]) == gen, bar);
            __builtin_amdgcn_fence(__ATOMIC_ACQUIRE, "agent");
            asm volatile("s_waitcnt vmcnt(0)" ::: "memory");
        }
    }
    __syncthreads();
}

struct Params { const float* in[N_IN]; float* out; unsigned char* ws; };
struct Frame {
    LAS unsigned char* lds; int tid, lane, wave, bid, G;
    const float* in[N_IN]; float* out; unsigned char* ws;
    float* mod; float* rstd; float* rope; bf16 *H, *T1, *T2, *T3, *KS, *VS;
};
__device__ __forceinline__ const float* xin_row(const Frame& F, int row) { return row < NPROMPT ? F.in[I_XP] + (size_t)row * D : F.in[I_XS] + (size_t)(row - NPROMPT) * D; }
__device__ __forceinline__ int cidx_of(int row) { return row < NPROMPT ? 0 : 1 + ((row - NPROMPT) >> 10); }
__device__ __forceinline__ const float* modp(const Frame& F, int l, int row, int which) { return F.mod + (size_t)((l * 3 + cidx_of(row)) * 6 + which) * D; }

__device__ __forceinline__ void phase_prologue(Frame& F) {
    LAS float* sc = (LAS float*)F.lds;
    const float* c = F.in[I_C]; const float* cctx = F.in[I_CCTX];
    for (int i = F.tid; i < 3 * D; i += NT) { const int ci = i >> 10, k = i & 1023; const float v = ci == 0 ? cctx[k] : c[(ci - 1) * D + k]; sc[i] = siluf_(v); }
    __syncthreads();
    LAS float* part = sc + 3 * D;
    const int kp = F.tid >> 6, cl = F.tid & 63;
    for (int item = F.bid; item < DEPTH * 6 * D / 64; item += F.G) {
        const int col = item * 64 + cl, l = col / (6 * D), cc = col % (6 * D);
        const float* w = F.in[I_WMOD] + (size_t)l * D * 6 * D + cc;
        float s0 = 0.f, s1 = 0.f, s2 = 0.f;
        for (int k = kp * 128; k < kp * 128 + 128; ++k) { const float wv = w[(size_t)k * 6 * D]; s0 += sc[k] * wv; s1 += sc[D + k] * wv; s2 += sc[2 * D + k] * wv; }
        part[(kp * 3 + 0) * 64 + cl] = s0; part[(kp * 3 + 1) * 64 + cl] = s1; part[(kp * 3 + 2) * 64 + cl] = s2;
        __syncthreads();
        if (F.tid < 192) { const int ci = F.tid >> 6; float s = F.in[I_BMOD][l * 6 * D + cc];
            for (int q = 0; q < 8; ++q) s += part[(q * 3 + ci) * 64 + cl];
            F.mod[(size_t)((l * 3 + ci) * 6) * D + cc] = s; }
        __syncthreads();
    }
    const int gt = F.bid * NT + F.tid, GT = F.G * NT;
    for (int i = gt; i < 1024 * 32; i += GT) { const int t = i >> 5, j = i & 31; const float inv = powf(10000.f, -(float)(j & 15) / 16.f); const float pos = (float)(j < 16 ? (t >> 6) : (t & 63));
        const float ang = pos * inv; F.rope[i] = cosf(ang); F.rope[32768 + i] = sinf(ang); }
    for (int i = gt; i < 2 * PAST * D; i += GT) { const int b = i / (PAST * D), r = i % (PAST * D);
        F.KS[(size_t)b * TKS * D + r] = (bf16)f2bf(F.in[I_CK][i]); F.VS[(size_t)b * TKS * D + r] = (bf16)f2bf(F.in[I_CV][i]); }
}

__device__ __forceinline__ void phase_modulate(Frame& F, int l, int sub) {
    const int gw = F.bid * NWAVES + F.wave, NGW = F.G * NWAVES;
    const float* g = F.in[I_NORMG] + (size_t)(l * 2 + sub) * D;
    for (int row = gw; row < M; row += NGW) {
        const float* xr = (l == 0 && sub == 0) ? xin_row(F, row) : F.out + (size_t)row * D;
        const float* sh = modp(F, l, row, sub * 3 + 0); const float* scl = modp(F, l, row, sub * 3 + 1);
        f32x4 v[4]; float s = 0.f;
#pragma unroll
        for (int j = 0; j < 4; ++j) { v[j] = *(const f32x4*)(xr + 4 * F.lane + 256 * j); s += v[j].x * v[j].x + v[j].y * v[j].y + v[j].z * v[j].z + v[j].w * v[j].w; }
        const float rstd = rsqrtf(wave_sum(s) * (1.f / D) + EPS);
#pragma unroll
        for (int j = 0; j < 4; ++j) { const int c0 = 4 * F.lane + 256 * j; const f32x4 gg = *(const f32x4*)(g + c0), s4 = *(const f32x4*)(sh + c0), c4 = *(const f32x4*)(scl + c0);
            const f32x4 o = v[j] * rstd * gg * (1.f + c4) + s4; u32x2 w; w.x = f2bf(o.x) | (f2bf(o.y) << 16); w.y = f2bf(o.z) | (f2bf(o.w) << 16);
            *(u32x2*)(F.H + (size_t)row * D + c0) = w; }
    }
}

template <class P>
__device__ __forceinline__ void gemm_naive(Frame& F, const P& p, int nbatch, int Mr, int N, int K) {
    LAS float* As = (LAS float*)F.lds;
    LAS float* Bs = As + 16 * 132;
    const int tid = F.tid, tx = tid & 31, ty = tid >> 5;
    const int tm = Mr / 128, tn = N / 128, per = tm * tn, total = per * nbatch;
    for (int t = F.bid; t < total; t += F.G) {
        const int b = t / per, r = t % per, pn = r / tm, pm = r % tm;
        const bf16* A; int lda; const float* W; int ldw; p.get(b, A, lda, W, ldw);
        float acc[8][4];
#pragma unroll
        for (int i = 0; i < 8; ++i)
#pragma unroll
            for (int j = 0; j < 4; ++j) acc[i][j] = 0.f;
        for (int k0 = 0; k0 < K; k0 += 16) {
            { const int row = tid >> 2, kq = (tid & 3) * 4;
              const u32x2 v = *(const u32x2*)(A + (size_t)(pm * 128 + row) * lda + k0 + kq);
              As[(kq + 0) * 132 + row] = bf2f(v.x); As[(kq + 1) * 132 + row] = bf2f(v.x >> 16); As[(kq + 2) * 132 + row] = bf2f(v.y); As[(kq + 3) * 132 + row] = bf2f(v.y >> 16); }
            { const int k = tid >> 5, n4 = (tid & 31) * 4;
              *(LAS f32x4*)(Bs + k * 128 + n4) = *(const f32x4*)(W + (size_t)(k0 + k) * ldw + pn * 128 + n4); }
            __syncthreads();
#pragma unroll 2
            for (int k = 0; k < 16; ++k) {
                const f32x4 a0 = *(const LAS f32x4*)(As + k * 132 + ty * 8), a1 = *(const LAS f32x4*)(As + k * 132 + ty * 8 + 4), bv = *(const LAS f32x4*)(Bs + k * 128 + tx * 4);
                const float a[8] = {a0.x, a0.y, a0.z, a0.w, a1.x, a1.y, a1.z, a1.w}; const float bb[4] = {bv.x, bv.y, bv.z, bv.w};
#pragma unroll
                for (int i = 0; i < 8; ++i)
#pragma unroll
                    for (int j = 0; j < 4; ++j) acc[i][j] += a[i] * bb[j];
            }
            __syncthreads();
        }
#pragma unroll
        for (int i = 0; i < 8; ++i)
#pragma unroll
            for (int j = 0; j < 4; ++j) p.epi(b, pm * 128 + ty * 8 + i, pn * 128 + tx * 4 + j, acc[i][j]);
    }
}

struct PStoreBf16 {
    const bf16* A; int lda; const float* W; int ldw; bf16* O; int ldo; const float* bias; int act; int split;
    __device__ __forceinline__ void get(int, const bf16*& a, int& la, const float*& w, int& lw) const { a = A; la = lda; w = W; lw = ldw; }
    __device__ __forceinline__ void epi(int, int row, int col, float v) const {
        if (bias) v += bias[col];
        if (act == 1 || (act == 2 && col < split)) v = gelu_tanh(v);
        O[(size_t)row * ldo + col] = (bf16)f2bf(v); }
};
struct PResid {
    const bf16* A; int lda; const float* W; int ldw; float* out; const float* xp; const float* xs; const float* modl; int which; bool from_input;
    __device__ __forceinline__ void get(int, const bf16*& a, int& la, const float*& w, int& lw) const { a = A; la = lda; w = W; lw = ldw; }
    __device__ __forceinline__ void epi(int, int row, int col, float v) const {
        const float base = from_input ? (row < NPROMPT ? xp[(size_t)row * D + col] : xs[(size_t)(row - NPROMPT) * D + col]) : out[(size_t)row * D + col];
        out[(size_t)row * D + col] = base + modl[(size_t)(cidx_of(row) * 6 + which) * D + col] * v; }
};
struct PLruIn {
    const bf16* A; const float* W; bf16* GBp; bf16* RECp;
    __device__ __forceinline__ void get(int, const bf16*& a, int& la, const float*& w, int& lw) const { a = A; la = D; w = W; lw = 2 * DRNN; }
    __device__ __forceinline__ void epi(int, int row, int col, float v) const {
        if (col < DRNN) GBp[(size_t)row * DRNN + col] = (bf16)f2bf(gelu_tanh(v)); else RECp[(size_t)row * DRNN + col - DRNN] = (bf16)f2bf(v); }
};
struct PGates {
    const bf16* XC; const float* WG; const float* BG; bf16* O;
    __device__ __forceinline__ void get(int b, const bf16*& a, int& la, const float*& w, int& lw) const { a = XC + (b % 10) * 128; la = DRNN; w = WG + (size_t)b * 128 * 128; lw = 128; }
    __device__ __forceinline__ void epi(int b, int row, int col, float v) const { const int dg = b / 10, n = b % 10;
        O[((size_t)dg * M + row) * DRNN + n * 128 + col] = (bf16)f2bf(sigmoidf_(v + BG[dg * DRNN + n * 128 + col])); }
};

__device__ __forceinline__ void phase_lru_conv(Frame& F, int j, const bf16* REC, bf16* XC) {
    const float* cw = F.in[I_LRU_CW] + (size_t)j * 4 * DRNN; const float* cb = F.in[I_LRU_CB] + (size_t)j * DRNN;
    const int gt = F.bid * NT + F.tid, GT = F.G * NT;
    for (int i = gt; i < M * DRNN; i += GT) { const int row = i / DRNN, ch = i % DRNN;
        int t, T; if (row < NPROMPT) { t = row & 255; T = 256; } else { t = (row - NPROMPT) & 1023; T = 1024; }
        float s = cb[ch];
#pragma unroll
        for (int k = 0; k < 4; ++k) { const int tt = t + k - 2; if (tt >= 0 && tt < T) s += cw[k * DRNN + ch] * bf2f(REC[(size_t)(row + k - 2) * DRNN + ch]); }
        XC[i] = (bf16)f2bf(s); }
}
__device__ __forceinline__ void phase_lru_scan(Frame& F, int j, const bf16* GATES, const bf16* XC, const bf16* GB, bf16* HS) {
    const int gt = F.bid * NT + F.tid, GT = F.G * NT;
    const int NL = (2 + 32) * DRNN;
    for (int line = gt; line < NL; line += GT) {
        const int s = line / DRNN, ch = line % DRNN;
        int base, T; float h0f = 0.f, h0b = 0.f;
        if (s < 2) { base = NPROMPT + s * 1024; T = 1024; h0f = F.in[I_STATE][((size_t)(s * 2 + j) * 2 + 0) * DRNN + ch]; h0b = F.in[I_STATE][((size_t)(s * 2 + j) * 2 + 1) * DRNN + ch]; }
        else { base = (s - 2) * 256; T = 256; }
        const float spf = softplusf_(-F.in[I_LRU_LAM][(size_t)(j * 2 + 0) * DRNN + ch]), spb = softplusf_(-F.in[I_LRU_LAM][(size_t)(j * 2 + 1) * DRNN + ch]);
        float h = h0f;
        for (int t = 0; t < T; ++t) { const size_t o = (size_t)(base + t) * DRNN + ch;
            const float r = bf2f(GATES[o]), ig = bf2f(GATES[(size_t)M * DRNN + o]), xc = bf2f(XC[o]);
            const float la = -8.f * r * spf, a = expf(la), bx = sqrtf(-expm1f(2.f * la)) * (ig * xc);
            h = a * h + bx; HS[o] = (bf16)f2bf(h); }
        const float ff = h;
        h = h0b;
        for (int t = T - 1; t >= 0; --t) { const size_t o = (size_t)(base + t) * DRNN + ch;
            const float r = bf2f(GATES[(size_t)2 * M * DRNN + o]), ig = bf2f(GATES[(size_t)3 * M * DRNN + o]), xc = bf2f(XC[o]);
            const float la = -8.f * r * spb, a = expf(la), bx = sqrtf(-expm1f(2.f * la)) * (ig * xc);
            h = a * h + bx; HS[o] = (bf16)f2bf(bf2f(GB[o]) * (bf2f(HS[o]) + h)); }
        if (s >= 2) { float* st = F.out + O_STATE + ((size_t)((s - 2) * 2 + j) * 2) * DRNN; st[ch] = ff; st[DRNN + ch] = h; }
    }
}

__device__ __forceinline__ void phase_cmlp_rstd(Frame& F, const bf16* UV) {
    const int gw = F.bid * NWAVES + F.wave, NGW = F.G * NWAVES;
    for (int row = gw; row < M; row += NGW) { float s = 0.f;
        for (int c = F.lane; c < DB; c += 64) { const float v = bf2f(UV[(size_t)row * 2 * DB + DB + c]); s += v * v; }
        s = wave_sum(s); if (F.lane == 0) F.rstd[row] = rsqrtf(s * (1.f / DB) + EPS); }
}
__device__ __forceinline__ void phase_cmlp_spatial(Frame& F, const bf16* UV, bf16* ACT) {
    const float* ws = F.in[I_CM_WS]; const float* bs = F.in[I_CM_BS]; const float* ng = F.in[I_CM_NG];
    const int gt = F.bid * NT + F.tid, GT = F.G * NT;
    for (int i = gt; i < M * DB; i += GT) { const int row = i / DB, ch = i % DB, g = ch >> 8, p = row & 127, r0 = row & ~127;
        float s = 0.f;
        for (int q = 0; q < 128; ++q) s += ws[(size_t)(g * 128 + p) * 128 + q] * F.rstd[r0 + q] * bf2f(UV[(size_t)(r0 + q) * 2 * DB + DB + ch]);
        const float sv = s * ng[ch] + bs[g * 128 + p];
        ACT[i] = (bf16)f2bf(bf2f(UV[(size_t)row * 2 * DB + ch]) * sv); }
}

__device__ __forceinline__ void phase_qkv_post(Frame& F, const bf16* QKV, bf16* Q, bf16* KP, bf16* VP) {
    const int gw = F.bid * NWAVES + F.wave, NGW = F.G * NWAVES;
    const float* qkg = F.in[I_AT_QKG];
    for (int row = gw; row < M; row += NGW) {
        const bool smp = row >= NPROMPT; const int sb = smp ? (row - NPROMPT) >> 10 : 0, t = smp ? (row - NPROMPT) & 1023 : 0;
        const float cs = smp ? F.rope[t * 32 + (F.lane & 31)] : 1.f, sn = smp ? F.rope[32768 + t * 32 + (F.lane & 31)] : 0.f;
        for (int grp = 0; grp < 32; ++grp) {
            const float v = bf2f(QKV[(size_t)row * 3072 + grp * 64 + F.lane]);
            const float ms = wave_sum(v * v) * (1.f / 64.f);
            float n = v * rsqrtf(ms + EPS) * qkg[(grp >> 4) * 64 + F.lane];
            const float keep = n;
            if (smp) { const float pr = __shfl_xor(n, 32); n = F.lane < 32 ? n * cs - pr * sn : n * cs + pr * sn; }
            if (grp < 16) Q[(size_t)row * D + grp * 64 + F.lane] = (bf16)f2bf(n);
            else { const int c = (grp - 16) * 64 + F.lane;
                if (smp) F.KS[((size_t)sb * TKS + PAST + t) * D + c] = (bf16)f2bf(n);
                else { KP[(size_t)row * D + c] = (bf16)f2bf(keep); F.out[O_CK + (size_t)row * D + c] = keep; } }
        }
        for (int c = F.lane; c < D; c += 64) { const bf16 vb = QKV[(size_t)row * 3072 + 2048 + c];
            if (smp) F.VS[((size_t)sb * TKS + PAST + t) * D + c] = vb; else { VP[(size_t)row * D + c] = vb; F.out[O_CV + (size_t)row * D + c] = bf2f(vb); } }
    }
}
__device__ __forceinline__ void phase_attn_naive(Frame& F, int l, const bf16* Q, const bf16* KP, const bf16* VP, bf16* O) {
    const int gw = F.bid * NWAVES + F.wave, NGW = F.G * NWAVES;
    LAS float* s1 = (LAS float*)F.lds + F.wave * 3328; LAS float* s2 = s1 + 1536; LAS float* qs = s2 + 1536;
    const float* al = F.in[I_AT_LAM];
    const float lam_init = 0.8f - 0.6f * expf(-0.3f * (float)l);
    const float lam = expf(wave_sum(al[F.lane] * al[64 + F.lane])) - expf(wave_sum(al[128 + F.lane] * al[192 + F.lane])) + lam_init;
    const float* sg = F.in[I_AT_SUBG];
    for (int item = gw; item < M * 8; item += NGW) {
        const int row = item >> 3, h = item & 7;
        const bf16 *Kb, *Vb; int Tk;
        if (row < NPROMPT) { Kb = KP + (size_t)(row & ~255) * D; Vb = VP + (size_t)(row & ~255) * D; Tk = 256; }
        else { const int sb = (row - NPROMPT) >> 10; Kb = F.KS + (size_t)sb * TKS * D; Vb = F.VS + (size_t)sb * TKS * D; Tk = TKS; }
        qs[F.lane] = bf2f(Q[(size_t)row * D + h * 128 + F.lane]); qs[64 + F.lane] = bf2f(Q[(size_t)row * D + h * 128 + 64 + F.lane]);
        asm volatile("s_waitcnt lgkmcnt(0)" ::: "memory");
        float m1 = -1e30f, m2 = -1e30f;
        for (int k = F.lane; k < Tk; k += 64) { const bf16* kr = Kb + (size_t)k * D + h * 128; float d1 = 0.f, d2 = 0.f;
#pragma unroll 4
            for (int d = 0; d < 64; d += 2) { const unsigned a = *(const unsigned*)(kr + d), b = *(const unsigned*)(kr + 64 + d);
                d1 += qs[d] * bf2f(a) + qs[d + 1] * bf2f(a >> 16); d2 += qs[64 + d] * bf2f(b) + qs[64 + d + 1] * bf2f(b >> 16); }
            d1 *= 0.125f; d2 *= 0.125f; s1[k] = d1; s2[k] = d2; m1 = fmaxf(m1, d1); m2 = fmaxf(m2, d2); }
        m1 = wave_max(m1); m2 = wave_max(m2);
        float l1 = 0.f, l2 = 0.f;
        for (int k = F.lane; k < Tk; k += 64) { const float e1 = expf(s1[k] - m1), e2 = expf(s2[k] - m2); s1[k] = e1; s2[k] = e2; l1 += e1; l2 += e2; }
        l1 = wave_sum(l1); l2 = wave_sum(l2);
        const float i1 = 1.f / l1, i2 = lam / l2;
        for (int k = F.lane; k < Tk; k += 64) s1[k] = bf2f(f2bf(s1[k] * i1 - s2[k] * i2));
        asm volatile("s_waitcnt lgkmcnt(0)" ::: "memory");
        float o0 = 0.f, o1 = 0.f;
        for (int k = 0; k < Tk; ++k) { const unsigned vv = *(const unsigned*)(Vb + (size_t)k * D + h * 128 + 2 * F.lane); const float w = s1[k]; o0 += w * bf2f(vv); o1 += w * bf2f(vv >> 16); }
        const float ms = wave_sum(o0 * o0 + o1 * o1) * (1.f / 128.f), rs = rsqrtf(ms + EPS) * (1.f - lam_init);
        o0 = o0 * rs * sg[2 * F.lane]; o1 = o1 * rs * sg[2 * F.lane + 1];
        *(unsigned*)(O + (size_t)row * D + h * 128 + 2 * F.lane) = f2bf(o0) | (f2bf(o1) << 16);
        asm volatile("s_waitcnt lgkmcnt(0)" ::: "memory");
    }
}

__device__ __forceinline__ void phase_ffn_convgate(Frame& F, int l, const bf16* Z, bf16* ACT) {
    const float* cw = F.in[I_FF_CW] + (size_t)l * 3 * 2 * DFF; const float* cb = F.in[I_FF_CB] + (size_t)l * 2 * DFF;
    const int gt = F.bid * NT + F.tid, GT = F.G * NT;
    for (int i = gt; i < M * DFF; i += GT) { const int row = i / DFF, j = i % DFF;
        int t, T; if (row < NPROMPT) { t = row & 255; T = 256; } else { t = (row - NPROMPT) & 1023; T = 1024; }
        float g = cb[j], u = cb[DFF + j];
#pragma unroll
        for (int k = 0; k < 3; ++k) { const int tt = t + k - 1; if (tt >= 0 && tt < T) { const bf16* zr = Z + (size_t)(row + k - 1) * 2 * DFF; g += cw[k * 2 * DFF + j] * bf2f(zr[j]); u += cw[k * 2 * DFF + DFF + j] * bf2f(zr[DFF + j]); } }
        ACT[i] = (bf16)f2bf(siluf_(g) * u); }
}

constexpr int LDS_BYTES = 147456;
constexpr int MISC_OFF = 131072 + 320;
__global__ void __launch_bounds__(NT, 2) mk_fwd(Params prm) {
    extern __shared__ __attribute__((aligned(16))) unsigned char lds_raw[];
    Frame F;
    F.lds = (LAS unsigned char*)lds_raw; F.tid = threadIdx.x; F.lane = F.tid & 63; F.wave = __builtin_amdgcn_readfirstlane(F.tid >> 6); F.bid = blockIdx.x; F.G = gridDim.x;
#pragma unroll
    for (int i = 0; i < N_IN; ++i) F.in[i] = prm.in[i];
    F.out = prm.out; F.ws = prm.ws;
    F.mod = (float*)(prm.ws + WS_MOD); F.rstd = (float*)(prm.ws + WS_RSTD); F.rope = (float*)(prm.ws + WS_ROPE);
    F.H = (bf16*)(prm.ws + WS_H); F.T1 = (bf16*)(prm.ws + WS_T1); F.T2 = (bf16*)(prm.ws + WS_T2); F.T3 = (bf16*)(prm.ws + WS_T3); F.KS = (bf16*)(prm.ws + WS_KS); F.VS = (bf16*)(prm.ws + WS_VS);
    volatile LAS unsigned* MISC = (volatile LAS unsigned*)(F.lds + MISC_OFF);
    if (F.tid < 32) MISC[F.tid] = 0u;
    __syncthreads();
    XcdBarrier bar = xcd_barrier_post((unsigned*)(prm.ws + WS_CTL) + CW_BAR, MISC + 8);
#define GRID_BAR() xcd_barrier(bar)

    phase_prologue(F);
    GRID_BAR();
#pragma unroll 1
    for (int l = 0; l < DEPTH; ++l) {
        const int kind = l % 3, j = l / 3;
        phase_modulate(F, l, 0);
        GRID_BAR();
        if (kind == 0) {
            bf16 *GB = F.T2, *REC = F.T2 + (size_t)M * DRNN, *XC = F.T3, *GATES = F.T1, *HS = REC;
            { PLruIn pin{F.H, F.in[I_LRU_WIN] + (size_t)j * D * 2 * DRNN, GB, REC};
              gemm_naive(F, pin, 1, M, 2 * DRNN, D); }
            GRID_BAR();
            phase_lru_conv(F, j, REC, XC);
            GRID_BAR();
            { PGates pg{XC, F.in[I_LRU_WG] + (size_t)j * 40 * 128 * 128, F.in[I_LRU_BG] + (size_t)j * 4 * DRNN, GATES};
              gemm_naive(F, pg, 40, M, 128, 128); }
            GRID_BAR();
            phase_lru_scan(F, j, GATES, XC, GB, HS);
            GRID_BAR();
            { PResid pr{HS, DRNN, F.in[I_LRU_WOUT] + (size_t)j * DRNN * D, D, F.out, F.in[I_XP], F.in[I_XS], F.mod + (size_t)l * 18 * D, 2, l == 0};
              gemm_naive(F, pr, 1, M, D, DRNN); }
        } else if (kind == 1) {
            bf16 *UV = F.T1, *ACT = F.T2;
            { PStoreBf16 p{F.H, D, F.in[I_CM_WIN], 2 * DB, UV, 2 * DB, F.in[I_CM_BIN], 1, 0};
              gemm_naive(F, p, 1, M, 2 * DB, D); }
            GRID_BAR();
            phase_cmlp_rstd(F, UV);
            GRID_BAR();
            phase_cmlp_spatial(F, UV, ACT);
            GRID_BAR();
            { PResid pr{ACT, DB, F.in[I_CM_WOUT], D, F.out, F.in[I_XP], F.in[I_XS], F.mod + (size_t)l * 18 * D, 2, false};
              gemm_naive(F, pr, 1, M, D, DB); }
        } else {
            bf16 *QKV = F.T1, *Q = F.T2, *KP = F.T2 + (size_t)M * D, *VP = KP + (size_t)NPROMPT * D, *O = F.T3;
            { PStoreBf16 p{F.H, D, F.in[I_AT_WQKV], 3 * D, QKV, 3 * D, nullptr, 0, 0};
              gemm_naive(F, p, 1, M, 3 * D, D); }
            GRID_BAR();
            phase_qkv_post(F, QKV, Q, KP, VP);
            GRID_BAR();
            phase_attn_naive(F, l, Q, KP, VP, O);
            GRID_BAR();
            { PResid pr{O, D, F.in[I_AT_WOUT], D, F.out, F.in[I_XP], F.in[I_XS], F.mod + (size_t)l * 18 * D, 2, false};
              gemm_naive(F, pr, 1, M, D, D); }
        }
        GRID_BAR();
        phase_modulate(F, l, 1);
        GRID_BAR();
        { PStoreBf16 p{F.H, D, F.in[I_FF_WUP] + (size_t)l * D * 2 * DFF, 2 * DFF, F.T1, 2 * DFF, nullptr, 0, 0};
          gemm_naive(F, p, 1, M, 2 * DFF, D); }
        GRID_BAR();
        phase_ffn_convgate(F, l, F.T1, F.T2);
        GRID_BAR();
        { PResid pr{F.T2, DFF, F.in[I_FF_WDN] + (size_t)l * DFF * D, D, F.out, F.in[I_XP], F.in[I_XS], F.mod + (size_t)l * 18 * D, 5, false};
          gemm_naive(F, pr, 1, M, D, DFF); }
        GRID_BAR();
    }
}

extern "C" void kernel_launch(void* const* d_in, const int* in_sizes, int n_in, void* d_out, int out_size, void* d_ws, size_t ws_size, hipStream_t stream) {
    static int grid = 0;
    if (grid == 0) {
        if (n_in != N_IN || ws_size < WS_END) { fprintf(stderr, "kernel_launch: unexpected n_in %d or ws_size %zu\n", n_in, ws_size); grid = -1; return; }
        int dev = 0, cus = 0, per_cu = 0;
        hipGetDevice(&dev); hipDeviceGetAttribute(&cus, hipDeviceAttributeMultiprocessorCount, dev);
        hipFuncSetAttribute((const void*)mk_fwd, hipFuncAttributeMaxDynamicSharedMemorySize, LDS_BYTES);
        hipOccupancyMaxActiveBlocksPerMultiprocessor(&per_cu, (const void*)mk_fwd, NT, LDS_BYTES);
        (void)hipGetLastError();
        if (per_cu < 1) { fprintf(stderr, "kernel_launch: occupancy query says %d blocks per CU\n", per_cu); per_cu = 1; }
        grid = cus;
    }
    if (grid < 0) return;
    hipMemsetAsync((char*)d_ws + WS_CTL, 0, CTL_ZERO_BYTES, stream);
    Params p{};
    for (int i = 0; i < N_IN; ++i) p.in[i] = (const float*)d_in[i];
    p.out = (float*)d_out; p.ws = (unsigned char*)d_ws;
    void* args[] = {&p};
    hipError_t e = hipLaunchCooperativeKernel((const void*)mk_fwd, dim3(grid), dim3(NT), args, LDS_BYTES, stream);
    if (e != hipSuccess) fprintf(stderr, "kernel_launch: cooperative launch failed: %s (grid %d)\n", hipGetErrorString(e), grid);
}
```

```cpp
#include <hip/hip_runtime.h>
#include <cstdio>
#include <cstdint>

#define GAS __attribute__((address_space(1)))
#define LAS __attribute__((address_space(3)))
typedef unsigned short bf16;
typedef float f32x4 __attribute__((ext_vector_type(4)));
typedef unsigned u32x2 __attribute__((ext_vector_type(2)));
typedef unsigned u32x4 __attribute__((ext_vector_type(4)));

constexpr int D = 1024, NPROMPT = 32 * 256, NSAMPLE = 2 * 1024, M = NPROMPT + NSAMPLE;
constexpr int DEPTH = 4, DRNN = 1280, DB = 2048, DFF = 2816, PAST = 512, TKS = PAST + 1024;
constexpr float EPS = 1e-6f;
constexpr int NWAVES = 8, NT = NWAVES * 64;

enum { I_XP = 0, I_XS, I_STATE, I_CK, I_CV, I_C, I_CCTX, I_WMOD, I_BMOD, I_NORMG, I_LRU_WIN, I_LRU_CW, I_LRU_CB, I_LRU_WG, I_LRU_BG, I_LRU_LAM, I_LRU_WOUT,
       I_CM_WIN, I_CM_BIN, I_CM_NG, I_CM_WS, I_CM_BS, I_CM_WOUT, I_AT_WQKV, I_AT_QKG, I_AT_LAM, I_AT_SUBG, I_AT_WOUT, I_FF_WUP, I_FF_CW, I_FF_CB, I_FF_WDN, N_IN };
constexpr size_t O_YP = 0, O_YS = (size_t)NPROMPT * D, O_STATE = (size_t)M * D, O_CK = O_STATE + 32 * 2 * 2 * DRNN, O_CV = O_CK + (size_t)NPROMPT * D;

constexpr size_t MiB = 1u << 20;
constexpr size_t WS_CTL = 0, CTL_ZERO_BYTES = 64 * 1024;
constexpr size_t WS_MOD = 1 * MiB;
constexpr size_t WS_RSTD = WS_MOD + 512 * 1024;
constexpr size_t WS_ROPE = WS_RSTD + 256 * 1024;
constexpr size_t WS_H = 2 * MiB;
constexpr size_t WS_T1 = 22 * MiB;
constexpr size_t WS_T2 = 132 * MiB;
constexpr size_t WS_T3 = 187 * MiB;
constexpr size_t WS_KS = 237 * MiB, WS_VS = 243 * MiB;
constexpr size_t WS_W = 249 * MiB;
constexpr size_t WE_LRU_IN = 0, WE_LRU_OUT = WE_LRU_IN + (size_t)2 * 2560 * 1024, WE_CM_IN = WE_LRU_OUT + (size_t)2 * 1024 * 1280, WE_CM_OUT = WE_CM_IN + (size_t)4096 * 1024,
                 WE_QKV = WE_CM_OUT + (size_t)1024 * 2048, WE_AT_OUT = WE_QKV + (size_t)3072 * 1024, WE_UP = WE_AT_OUT + (size_t)1024 * 1024, WE_DN = WE_UP + (size_t)4 * 5632 * 1024,
                 WE_END = WE_DN + (size_t)4 * 1024 * 2816;
constexpr size_t WS_END = WS_W + 102 * MiB;
static_assert(WE_END * 2 <= 102 * MiB, "weight copies fit");
constexpr int CW_BAR = 1024;

__device__ __forceinline__ unsigned f2bf(float f) { unsigned u = __builtin_bit_cast(unsigned, f); return (u + 0x7fffu + ((u >> 16) & 1u)) >> 16; }
__device__ __forceinline__ float bf2f(unsigned b) { return __builtin_bit_cast(float, (b & 0xffffu) << 16); }
__device__ __forceinline__ float wave_sum(float v) {
#pragma unroll
    for (int o = 1; o < 64; o <<= 1) v += __shfl_xor(v, o);
    return v;
}
__device__ __forceinline__ float wave_max(float v) {
#pragma unroll
    for (int o = 1; o < 64; o <<= 1) v = fmaxf(v, __shfl_xor(v, o));
    return v;
}
__device__ __forceinline__ float gelu_tanh(float x) { const float y = 0.7978845608028654f * (x + 0.044715f * x * x * x); const float t = 1.f - 2.f / (__expf(2.f * y) + 1.f); return 0.5f * x * (1.f + t); }
__device__ __forceinline__ float sigmoidf_(float x) { return 1.f / (1.f + __expf(-x)); }
__device__ __forceinline__ float siluf_(float x) { return x / (1.f + __expf(-x)); }
__device__ __forceinline__ float softplusf_(float x) { return fmaxf(x, 0.f) + log1pf(expf(-fabsf(x))); }

#define XB_TMO      128
#define XB_XCNT(j)  (256  + 64 * (j))
#define XB_XSUB(j)  (1280 + 64 * (j))
#define XB_XGEN(j)  (2304 + 64 * (j))
#define XB_TOP      3328
#define XB_TOPGEN   3392
#define XCD_BAR_WORDS 3456
#define XB_SPIN_CAP (1u << 22)
__device__ __forceinline__ unsigned xb_ld(unsigned* p)              { return __hip_atomic_load(p, __ATOMIC_RELAXED, __HIP_MEMORY_SCOPE_AGENT); }
__device__ __forceinline__ unsigned xb_add(unsigned* p, unsigned v) { return __hip_atomic_fetch_add(p, v, __ATOMIC_RELAXED, __HIP_MEMORY_SCOPE_AGENT); }
__device__ __forceinline__ unsigned xb_xcc_id() { return (unsigned)__builtin_amdgcn_s_getreg((3 << 11) | 20) & 0xFu; }
#define XB_SPIN(cond, bar) do { unsigned _sp = 0; while (cond) { __builtin_amdgcn_s_sleep(1); \
    if ((++_sp & 255u) == 0u) { if (xb_ld(&(bar)[XB_TMO])) break; if (_sp > XB_SPIN_CAP) { atomicAdd(&(bar)[XB_TMO], 1u); break; } } } } while (0)
struct XcdBarrier { unsigned* bar; unsigned x; volatile LAS unsigned* st; };
__device__ __forceinline__ XcdBarrier xcd_barrier_post(unsigned* bar, volatile LAS unsigned* st) {
    XcdBarrier b; b.bar = bar; b.x = xb_xcc_id(); b.st = st;
    if (threadIdx.x == 0) (void)xb_add(&bar[XB_XCNT(b.x)], 1u);
    return b;
}
__device__ __forceinline__ void xcd_barrier_complete(unsigned* bar, unsigned x, unsigned& nloc, unsigned& nx) {
    const unsigned G = gridDim.x * gridDim.y * gridDim.z;
    unsigned sum, cnt, mine, sp = 0u;
    for (;;) {
        sum = 0u; cnt = 0u; mine = 0u;
#pragma unroll
        for (unsigned j = 0; j < 16; ++j) { const unsigned c = xb_ld(&bar[XB_XCNT(j)]); sum += c; cnt += (c > 0u) ? 1u : 0u; mine = (j == x) ? c : mine; }
        if (sum == G) break;
        __builtin_amdgcn_s_sleep(1);
        if ((++sp & 255u) == 0u) { if (xb_ld(&bar[XB_TMO])) break; if (sp > XB_SPIN_CAP) { atomicAdd(&bar[XB_TMO], 1u); break; } }
    }
    nloc = mine > 0u ? mine : 1u; nx = cnt > 0u ? cnt : 1u;
}
__device__ __forceinline__ void xcd_barrier(const XcdBarrier& b) {
    asm volatile("s_waitcnt vmcnt(0)" ::: "memory");
    __syncthreads();
    if (threadIdx.x == 0) {
        unsigned* bar = b.bar;
        __builtin_amdgcn_s_waitcnt(0);
        unsigned nloc = b.st[0], nx = b.st[1];
        if (nloc == 0u) { xcd_barrier_complete(bar, b.x, nloc, nx); b.st[0] = nloc; b.st[1] = nx; }
        const unsigned old = xb_add(&bar[XB_XSUB(b.x)], 1u);
        const unsigned gen = old / nloc;
        if (old + 1u == (gen + 1u) * nloc) {
            __builtin_amdgcn_fence(__ATOMIC_RELEASE, "agent");
            asm volatile("s_waitcnt vmcnt(0)" ::: "memory");
            const unsigned og = xb_add(&bar[XB_TOP], 1u);
            const unsigned tg = og / nx;
            if (og + 1u == (tg + 1u) * nx) xb_add(&bar[XB_TOPGEN], 1u);
            else XB_SPIN(xb_ld(&bar[XB_TOPGEN]) == tg, bar);
            __builtin_amdgcn_fence(__ATOMIC_ACQUIRE, "agent");
            xb_add(&bar[XB_XGEN(b.x)], 1u);
            asm volatile("s_waitcnt vmcnt(0)" ::: "memory");
        } else {
            XB_SPIN(xb_ld(&bar[XB_XGEN(b.x)]) == gen, bar);
            __builtin_amdgcn_fence(__ATOMIC_ACQUIRE, "agent");
            asm volatile("s_waitcnt vmcnt(0)" ::: "memory");
        }
    }
    __syncthreads();
}

namespace pg8 {
#define PG8_LAS __attribute__((address_space(3)))
typedef unsigned short bf16_t;
typedef short bf16x8 __attribute__((ext_vector_type(8)));
typedef float f32x4 __attribute__((ext_vector_type(4)));
typedef unsigned u32x4 __attribute__((ext_vector_type(4)));
constexpr int BM = 256, BK = 64, HALF = 128, HTB = HALF * BK * 2  , STAGE_BYTES = 8 * HTB, NXCD = 8, WGM = 8;

__host__ __device__ __forceinline__ int lds_byte(int r, int c) { const int st = (r >> 4) * 2 + (c >> 5), rr = r & 15, cc = c & 31, ob = rr * 64 + cc * 2; return st * 1024 + (ob ^ (((ob >> 9) & 1) << 5)); }
__host__ __device__ __forceinline__ void stage_rc(int b, int& R, int& C) { const int st = b / 1024, sb = b % 1024, swz = sb ^ (((sb >> 9) & 1) << 5); R = (st >> 1) * 16 + swz / 64; C = (st & 1) * 32 + (swz % 64) / 2; }
__host__ __device__ __forceinline__ int perm32(int rho) { const int n = rho >> 4, i = rho & 15; return 8 * (i >> 2) + 4 * n + (i & 3); }

struct Unit { int pm, pn; };
struct Gemm { const bf16_t* A; const bf16_t* Bt; int M, N, K; };

struct StaticOrder {
    int nM, nN, nwg, G, c;
    __host__ __device__ void init(int M, int N, int G_, int c_) { nM = M / BM; nN = N / BM; nwg = nM * nN; G = G_; c = c_; }
    __host__ __device__ bool next(int i, Unit& u) const {
        const long L = (long)i * G + c; if (L >= nwg) return false;
        int wgid = (int)L; { const int q = nwg / NXCD, r = nwg % NXCD, xcd = wgid % NXCD, off = wgid / NXCD; wgid = (xcd < r ? xcd * (q + 1) : r * (q + 1) + (xcd - r) * q) + off; }
        const int nig = WGM * nN, gid = wgid / nig, fm = gid * WGM, gsz = (nM - fm) < WGM ? (nM - fm) : WGM;
        u.pm = fm + ((wgid % nig) % gsz); u.pn = (wgid % nig) / gsz; return true;
    }
    __device__ __forceinline__ void a_ready(const Unit&) const {}
    __device__ __forceinline__ void done(const Unit&) const {}
};

template <class Epi, class Sched, bool ALIGN_EPI = false, bool SP2 = false>
__device__ __forceinline__ void gemm_phase(PG8_LAS unsigned char* lds, const Gemm g, const Sched& S, const Epi& E) {
    int tid_ = threadIdx.x; asm volatile("" : "+v"(tid_));
    const int tid = tid_, wid = __builtin_amdgcn_readfirstlane(tid >> 6), lane = tid & 63, wr = wid >> 2, wc = wid & 3, fr = lane & 15, fq = lane >> 4;
    const int K = g.K, nt = K / BK;
    unsigned voffA[2], voffB[2];
#pragma unroll
    for (int i = 0; i < 2; ++i) { int R, C; stage_rc(tid * 16 + i * 8192, R, C); const int Rb = Epi::PERM ? ((R & ~31) + perm32(R & 31)) : R;
        voffA[i] = (unsigned)(R * K + C) * 2u; voffB[i] = (unsigned)(Rb * K + C) * 2u; }
    const size_t kstep = (size_t)(BK * 2);
    const size_t hstep = (size_t)HALF * K * 2;
    const size_t tstep = 2 * hstep;
    const unsigned ldsw = (unsigned)wid * 1024u;
    const int aoff = lds_byte(wr * 64 + fr, fq * 8), boff = lds_byte(wc * 32 + fr, fq * 8);
#define PG8_SA(b, h) (((b) * 2 + (h)) * HTB)
#define PG8_SB(b, h) ((4 + (b) * 2 + (h)) * HTB)
#define PG8_STAGE(bufoff, gbase, voff) do { _Pragma("unroll") for (int _i = 0; _i < 2; ++_i) \
        __builtin_amdgcn_global_load_lds((const unsigned*)((const char*)(gbase) + (voff)[_i]), (PG8_LAS unsigned*)(lds + (bufoff) + ldsw + _i * 8192), 16, 0, 0); } while (0)
#define PG8_LDA(dst, b, h) do { _Pragma("unroll") for (int m = 0; m < 4; ++m) _Pragma("unroll") for (int k = 0; k < 2; ++k) dst[m][k] = *(const PG8_LAS bf16x8*)(lds + PG8_SA(b, h) + aoff + m * 2048 + k * 1024); } while (0)
#define PG8_LDB(dst, b, h) do { _Pragma("unroll") for (int n = 0; n < 2; ++n) _Pragma("unroll") for (int k = 0; k < 2; ++k) dst[n][k] = *(const PG8_LAS bf16x8*)(lds + PG8_SB(b, h) + boff + n * 2048 + k * 1024); } while (0)
#define PG8_MMA(ai, bj, At, Bt) do { __builtin_amdgcn_s_setprio(1); _Pragma("unroll") for (int m = 0; m < 4; ++m) _Pragma("unroll") for (int n = 0; n < 2; ++n) _Pragma("unroll") for (int k = 0; k < 2; ++k) \
        acc[ai][bj][m][n] = __builtin_amdgcn_mfma_f32_16x16x32_bf16(Bt[n][k], At[m][k], acc[ai][bj][m][n], 0, 0, 0); __builtin_amdgcn_s_setprio(0); } while (0)
#define PG8_WAIT_V(n) asm volatile("s_waitcnt vmcnt(" #n ")" ::: "memory")
#define PG8_WAIT_L(n) asm volatile("s_waitcnt lgkmcnt(" #n ")" ::: "memory")
#define PG8_BAR __builtin_amdgcn_s_barrier()
#define PG8_SCHED __builtin_amdgcn_sched_barrier(0)
    Unit cur, nxt; int ui = 0;
    if (!S.next(0, cur)) return;
    f32x4 acc[2][2][4][2];
#pragma unroll
    for (int a = 0; a < 2; ++a)
#pragma unroll
        for (int b = 0; b < 2; ++b)
#pragma unroll
            for (int m = 0; m < 4; ++m)
#pragma unroll
                for (int n = 0; n < 2; ++n) acc[a][b][m][n] = (f32x4){0.f, 0.f, 0.f, 0.f};
    bf16x8 At[4][2], B0[2][2], B1[2][2];
    const char* cA = (const char*)g.A + (size_t)cur.pm * tstep; const char* cB = (const char*)g.Bt + (size_t)cur.pn * tstep;
    S.a_ready(cur);
    if constexpr (SP2) {
        PG8_STAGE(PG8_SB(0, 0), cB, voffB); PG8_STAGE(PG8_SB(0, 1), cB + hstep, voffB); PG8_STAGE(PG8_SA(0, 0), cA, voffA); PG8_STAGE(PG8_SA(0, 1), cA + hstep, voffA);
        if (wr == 1) PG8_BAR;
        PG8_WAIT_V(2); PG8_BAR;
        PG8_STAGE(PG8_SB(1, 0), cB + kstep, voffB); PG8_STAGE(PG8_SA(1, 0), cA + kstep, voffA); PG8_STAGE(PG8_SB(1, 1), cB + hstep + kstep, voffB);
        PG8_WAIT_V(6); PG8_BAR;
    } else {
        PG8_STAGE(PG8_SB(0, 0), cB, voffB); PG8_STAGE(PG8_SA(0, 0), cA, voffA); PG8_STAGE(PG8_SB(0, 1), cB + hstep, voffB); PG8_STAGE(PG8_SA(0, 1), cA + hstep, voffA);
        if (wr == 1) PG8_BAR;
        PG8_WAIT_V(4); PG8_BAR;
        PG8_STAGE(PG8_SB(1, 0), cB + kstep, voffB); PG8_STAGE(PG8_SA(1, 0), cA + kstep, voffA); PG8_STAGE(PG8_SB(1, 1), cB + hstep + kstep, voffB);
        PG8_WAIT_V(6); PG8_BAR;
    }
    for (;;) {
        const bool has_next = S.next(ui + 1, nxt);
        const char* nA = has_next ? (const char*)g.A + (size_t)nxt.pm * tstep : cA; const char* nB = has_next ? (const char*)g.Bt + (size_t)nxt.pn * tstep : cB;
        for (int t = 0; t < nt; t += 2) {
            const bool last = (t == nt - 2);
            const char* a1 = cA + (size_t)(t + 1) * kstep;
            const char* a2 = last ? nA : cA + (size_t)(t + 2) * kstep; const char* b2 = last ? nB : cB + (size_t)(t + 2) * kstep;
            const char* a3 = a2 + kstep; const char* b3 = b2 + kstep;
            if (last && has_next) S.a_ready(nxt);
            if constexpr (SP2) {
            PG8_LDB(B0, 0, 0); PG8_LDB(B1, 0, 1); PG8_SCHED; PG8_LDA(At, 0, 0); PG8_STAGE(PG8_SA(1, 1), a1 + hstep, voffA);
            PG8_WAIT_V(8); PG8_WAIT_L(0); PG8_BAR; PG8_MMA(0, 0, At, B0); PG8_MMA(0, 1, At, B1); PG8_BAR; PG8_SCHED;
            PG8_LDA(At, 0, 1); PG8_STAGE(PG8_SB(0, 0), b2, voffB); PG8_STAGE(PG8_SB(0, 1), b2 + hstep, voffB); PG8_STAGE(PG8_SA(0, 0), a2, voffA);
            PG8_WAIT_V(8); PG8_WAIT_L(0); PG8_BAR; PG8_MMA(1, 0, At, B0); PG8_MMA(1, 1, At, B1); PG8_BAR; PG8_SCHED;
            PG8_LDB(B0, 1, 0); PG8_LDB(B1, 1, 1); PG8_SCHED; PG8_LDA(At, 1, 0); PG8_STAGE(PG8_SA(0, 1), a2 + hstep, voffA);
            PG8_WAIT_V(8); PG8_WAIT_L(0); PG8_BAR; PG8_MMA(0, 0, At, B0); PG8_MMA(0, 1, At, B1); PG8_BAR; PG8_SCHED;
            PG8_LDA(At, 1, 1); PG8_STAGE(PG8_SB(1, 0), b3, voffB); PG8_STAGE(PG8_SB(1, 1), b3 + hstep, voffB); PG8_STAGE(PG8_SA(1, 0), a3, voffA);
            PG8_WAIT_V(8); PG8_WAIT_L(0); PG8_BAR; PG8_MMA(1, 0, At, B0); PG8_MMA(1, 1, At, B1); PG8_BAR; PG8_SCHED;
            } else {
            PG8_LDB(B0, 0, 0); PG8_SCHED; PG8_LDA(At, 0, 0); PG8_STAGE(PG8_SA(1, 1), a1 + hstep, voffA);
            PG8_WAIT_L(8); PG8_BAR; PG8_WAIT_L(0); PG8_MMA(0, 0, At, B0); PG8_BAR; PG8_SCHED;
            PG8_LDB(B1, 0, 1); PG8_STAGE(PG8_SB(0, 0), b2, voffB);
            PG8_BAR; PG8_WAIT_L(0); PG8_MMA(0, 1, At, B1); PG8_BAR;
            PG8_LDA(At, 0, 1); PG8_STAGE(PG8_SA(0, 0), a2, voffA);
            PG8_BAR; PG8_WAIT_L(0); PG8_MMA(1, 0, At, B0); PG8_BAR; PG8_SCHED;
            PG8_STAGE(PG8_SB(0, 1), b2 + hstep, voffB);
            PG8_WAIT_V(6); PG8_BAR; PG8_MMA(1, 1, At, B1); PG8_BAR;
            PG8_LDB(B0, 1, 0); PG8_SCHED; PG8_LDA(At, 1, 0); PG8_STAGE(PG8_SA(0, 1), a2 + hstep, voffA);
            PG8_WAIT_L(8); PG8_BAR; PG8_WAIT_L(0); PG8_MMA(0, 0, At, B0); PG8_BAR; PG8_SCHED;
            PG8_LDB(B1, 1, 1); PG8_STAGE(PG8_SB(1, 0), b3, voffB);
            PG8_BAR; PG8_WAIT_L(0); PG8_MMA(0, 1, At, B1); PG8_BAR;
            PG8_LDA(At, 1, 1); PG8_STAGE(PG8_SA(1, 0), a3, voffA);
            PG8_BAR; PG8_WAIT_L(0); PG8_MMA(1, 0, At, B0); PG8_BAR; PG8_SCHED;
            PG8_STAGE(PG8_SB(1, 1), b3 + hstep, voffB);
            PG8_WAIT_V(6); PG8_BAR; PG8_MMA(1, 1, At, B1); PG8_BAR;
            }
        }
        if constexpr (ALIGN_EPI) { if (wr == 0) PG8_BAR; }
        if constexpr (!Epi::AFTER_DRAIN) { E(acc, cur, wr, wc, fr, fq); S.done(cur); }
        if (!has_next) break;
#pragma unroll
        for (int a = 0; a < 2; ++a)
#pragma unroll
            for (int b = 0; b < 2; ++b)
#pragma unroll
                for (int m = 0; m < 4; ++m)
#pragma unroll
                    for (int n = 0; n < 2; ++n) acc[a][b][m][n] = (f32x4){0.f, 0.f, 0.f, 0.f};
        cur = nxt; cA = nA; cB = nB; ++ui;
        if constexpr (ALIGN_EPI) { if (wr == 1) PG8_BAR; }
    }
    PG8_WAIT_V(0);
    if constexpr (!ALIGN_EPI) { if (wr == 0) PG8_BAR; }
    PG8_BAR;
    if constexpr (Epi::AFTER_DRAIN) { E.fused(acc, cur, wr, wc, fr, fq, lds, wid, lane); S.done(cur); }
#undef PG8_SA
#undef PG8_SB
#undef PG8_STAGE
#undef PG8_LDA
#undef PG8_LDB
#undef PG8_MMA
#undef PG8_WAIT_V
#undef PG8_WAIT_L
#undef PG8_BAR
#undef PG8_SCHED
}
}

namespace pg8 {
__device__ __forceinline__ unsigned cvt_pk_bf16(float lo, float hi) { unsigned r; asm volatile("v_cvt_pk_bf16_f32 %0, %1, %2" : "=v"(r) : "v"(lo), "v"(hi)); return r; }
__device__ __forceinline__ f32x4 gelu4(f32x4 v) { f32x4 o; o.x = gelu_tanh(v.x); o.y = gelu_tanh(v.y); o.z = gelu_tanh(v.z); o.w = gelu_tanh(v.w); return o; }
template <int ACT> struct EpiBf16 {
    static constexpr bool PERM = true, AFTER_DRAIN = false;
    bf16_t* O; int ldc; const float* bias; int split_cols; size_t split_stride;
    __device__ __forceinline__ void operator()(const f32x4 (&acc)[2][2][4][2], const Unit& u, int wr, int wc, int fr, int fq) const {
        const int row0 = u.pm * BM + wr * 64 + fr; int colt = u.pn * BM; bf16_t* base = O; int t = 0;
        if (split_cols) { t = colt / split_cols; base += (size_t)t * split_stride; colt -= t * split_cols; }
        const bool act = (ACT == 1) || (ACT == 2 && t == 0);
        const int col0 = colt + wc * 32 + 8 * fq, bcol0 = u.pn * BM + wc * 32 + 8 * fq;
        f32x4 bv[2][2];
#pragma unroll
        for (int bj = 0; bj < 2; ++bj)
#pragma unroll
            for (int n = 0; n < 2; ++n) bv[bj][n] = bias ? *(const GAS f32x4*)(bias + bcol0 + bj * HALF + 4 * n) : (f32x4){0.f, 0.f, 0.f, 0.f};
#pragma unroll
        for (int ai = 0; ai < 2; ++ai)
#pragma unroll
            for (int m = 0; m < 4; ++m) { bf16_t* rowp = base + (size_t)(row0 + ai * HALF + m * 16) * ldc + col0;
#pragma unroll
                for (int bj = 0; bj < 2; ++bj) { f32x4 v0 = acc[ai][bj][m][0] + bv[bj][0], v1 = acc[ai][bj][m][1] + bv[bj][1];
                    if (ACT != 0) { if (act) { v0 = gelu4(v0); v1 = gelu4(v1); } }
                    u32x4 w; w.x = cvt_pk_bf16(v0[0], v0[1]); w.y = cvt_pk_bf16(v0[2], v0[3]); w.z = cvt_pk_bf16(v1[0], v1[1]); w.w = cvt_pk_bf16(v1[2], v1[3]);
                    *(GAS u32x4*)(rowp + bj * HALF) = w; } }
    }
};
struct EpiResid {
    static constexpr bool PERM = false, AFTER_DRAIN = false;
    float* out; const float* xp; const float* xs; const float* modl; int which; bool from_input;
    __device__ __forceinline__ void operator()(const f32x4 (&acc)[2][2][4][2], const Unit& u, int wr, int wc, int fr, int fq) const {
        const int trow = u.pm * BM, row0 = wr * 64 + fr, col0 = u.pn * BM + wc * 32 + 4 * fq;
        const int ci = trow < NPROMPT ? 0 : 1 + ((trow - NPROMPT) >> 10);
        const float* gp = modl + (size_t)(ci * 6 + which) * D + col0;
        const float* bp = from_input ? (trow < NPROMPT ? xp + (size_t)trow * D : xs + (size_t)(trow - NPROMPT) * D) : out + (size_t)trow * D;
        GAS float* op = (GAS float*)(out + (size_t)trow * D); const GAS float* bpg = (const GAS float*)bp; const GAS float* gpg = (const GAS float*)gp;
        f32x4 gv[2][2];
#pragma unroll
        for (int bj = 0; bj < 2; ++bj)
#pragma unroll
            for (int n = 0; n < 2; ++n) gv[bj][n] = *(const GAS f32x4*)(gpg + bj * HALF + n * 16);
#pragma unroll
        for (int ai = 0; ai < 2; ++ai)
#pragma unroll
            for (int m = 0; m < 4; ++m) { const size_t off = (size_t)(row0 + ai * HALF + m * 16) * D + col0;
                f32x4 bs[2][2];
#pragma unroll
                for (int bj = 0; bj < 2; ++bj)
#pragma unroll
                    for (int n = 0; n < 2; ++n) bs[bj][n] = *(const GAS f32x4*)(bpg + off + bj * HALF + n * 16);
#pragma unroll
                for (int bj = 0; bj < 2; ++bj)
#pragma unroll
                    for (int n = 0; n < 2; ++n) *(GAS f32x4*)(op + off + bj * HALF + n * 16) = bs[bj][n] + gv[bj][n] * acc[ai][bj][m][n];
                asm volatile("" ::: "memory"); }
    }
};
}

struct Params { const float* in[N_IN]; float* out; unsigned char* ws; };
struct Frame {
    LAS unsigned char* lds; int tid, lane, wave, bid, G;
    const float* const* in; float* out; unsigned char* ws; float* out0; unsigned char* ws0;
    float* mod; float* rstd; float* rope; bf16 *H, *T1, *T2, *T3, *KS, *VS, *WT;
    __device__ __forceinline__ void fresh() {
        int t = threadIdx.x; asm volatile("" : "+v"(t)); tid = t; lane = t & 63; wave = __builtin_amdgcn_readfirstlane(t >> 6);
        int b = blockIdx.x; asm volatile("" : "+s"(b)); bid = b;
        unsigned char* w = ws0; asm volatile("" : "+s"(w)); ws = w; float* o = out0; asm volatile("" : "+s"(o)); out = o;
        mod = (float*)(w + WS_MOD); rstd = (float*)(w + WS_RSTD); rope = (float*)(w + WS_ROPE);
        H = (bf16*)(w + WS_H); T1 = (bf16*)(w + WS_T1); T2 = (bf16*)(w + WS_T2); T3 = (bf16*)(w + WS_T3); KS = (bf16*)(w + WS_KS); VS = (bf16*)(w + WS_VS); WT = (bf16*)(w + WS_W);
    }
};
__device__ __forceinline__ const float* xin_row(const Frame& F, int row) { return row < NPROMPT ? F.in[I_XP] + (size_t)row * D : F.in[I_XS] + (size_t)(row - NPROMPT) * D; }
__device__ __forceinline__ int cidx_of(int row) { return row < NPROMPT ? 0 : 1 + ((row - NPROMPT) >> 10); }
__device__ __forceinline__ const float* modp(const Frame& F, int l, int row, int which) { return F.mod + (size_t)((l * 3 + cidx_of(row)) * 6 + which) * D; }


__device__ __forceinline__ void transpose_item(const float* W, int K, int N, bf16* WT, LAS float* scr, int item, int lane) {
    const int nblk = N / 32, kb = item / nblk, nb = item % nblk, k0 = 64 * kb, n0 = 32 * nb;
#pragma unroll 8
    for (int i = 0; i < 32; ++i) { const int kk = 2 * i + (lane >> 5); scr[kk * 33 + (lane & 31)] = W[(size_t)(k0 + kk) * N + n0 + (lane & 31)]; }
    asm volatile("s_waitcnt lgkmcnt(0)" ::: "memory");
    const int c = lane & 7;
#pragma unroll
    for (int j = 0; j < 4; ++j) { const int n = (lane >> 3) + 8 * j; const LAS float* sp = scr + (8 * c) * 33 + n;
        u32x4 o; o.x = f2bf(sp[0 * 33]) | (f2bf(sp[1 * 33]) << 16); o.y = f2bf(sp[2 * 33]) | (f2bf(sp[3 * 33]) << 16); o.z = f2bf(sp[4 * 33]) | (f2bf(sp[5 * 33]) << 16); o.w = f2bf(sp[6 * 33]) | (f2bf(sp[7 * 33]) << 16);
        *(u32x4*)(WT + (size_t)(n0 + n) * K + k0 + 8 * c) = o; }
    asm volatile("s_waitcnt lgkmcnt(0)" ::: "memory");
}
__device__ __forceinline__ bool transpose_group(int& r, const float* W, int nmat, int K, int N, bf16* WT, LAS float* scr, int lane) {
    const int per = (K / 64) * (N / 32), tot = nmat * per;
    if (r >= tot) { r -= tot; return false; }
    const int mi = r / per; transpose_item(W + (size_t)mi * K * N, K, N, WT + (size_t)mi * K * N, scr, r % per, lane); return true;
}
__device__ __forceinline__ void phase_prologue(Frame& F) {
    F.fresh();
    LAS float* sc = (LAS float*)F.lds;
    const float* c = F.in[I_C]; const float* cctx = F.in[I_CCTX];
    for (int i = F.tid; i < 3 * D; i += NT) { const int ci = i >> 10, k = i & 1023; const float v = ci == 0 ? cctx[k] : c[(ci - 1) * D + k]; sc[i] = siluf_(v); }
    __syncthreads();
    LAS float* part = sc + 3 * D;
    const int kp = F.tid >> 6, cl = F.tid & 63;
    for (int item = F.bid; item < DEPTH * 6 * D / 64; item += F.G) {
        const int col = item * 64 + cl, l = col / (6 * D), cc = col % (6 * D);
        const float* w = F.in[I_WMOD] + (size_t)l * D * 6 * D + cc;
        float s0 = 0.f, s1 = 0.f, s2 = 0.f;
        for (int k = kp * 128; k < kp * 128 + 128; ++k) { const float wv = w[(size_t)k * 6 * D]; s0 += sc[k] * wv; s1 += sc[D + k] * wv; s2 += sc[2 * D + k] * wv; }
        part[(kp * 3 + 0) * 64 + cl] = s0; part[(kp * 3 + 1) * 64 + cl] = s1; part[(kp * 3 + 2) * 64 + cl] = s2;
        __syncthreads();
        if (F.tid < 192) { const int ci = F.tid >> 6; float s = F.in[I_BMOD][l * 6 * D + cc];
            for (int q = 0; q < 8; ++q) s += part[(q * 3 + ci) * 64 + cl];
            F.mod[(size_t)((l * 3 + ci) * 6) * D + cc] = s; }
        __syncthreads();
    }
    { __syncthreads();
      LAS float* scr = (LAS float*)(F.lds + F.wave * 16384);
      const int gw = F.bid * NWAVES + F.wave, NGW = F.G * NWAVES;
      constexpr int NITEMS = (int)(WE_END / 2048);
      for (int it = gw; it < NITEMS; it += NGW) { int r = it;
          if (transpose_group(r, F.in[I_FF_WUP], 4, D, 2 * DFF, F.WT + WE_UP, scr, F.lane)) continue;
          if (transpose_group(r, F.in[I_FF_WDN], 4, DFF, D, F.WT + WE_DN, scr, F.lane)) continue;
          if (transpose_group(r, F.in[I_LRU_WIN], 2, D, 2 * DRNN, F.WT + WE_LRU_IN, scr, F.lane)) continue;
          if (transpose_group(r, F.in[I_LRU_WOUT], 2, DRNN, D, F.WT + WE_LRU_OUT, scr, F.lane)) continue;
          if (transpose_group(r, F.in[I_CM_WIN], 1, D, 2 * DB, F.WT + WE_CM_IN, scr, F.lane)) continue;
          if (transpose_group(r, F.in[I_CM_WOUT], 1, DB, D, F.WT + WE_CM_OUT, scr, F.lane)) continue;
          if (transpose_group(r, F.in[I_AT_WQKV], 1, D, 3 * D, F.WT + WE_QKV, scr, F.lane)) continue;
          transpose_group(r, F.in[I_AT_WOUT], 1, D, D, F.WT + WE_AT_OUT, scr, F.lane); } }
    const int gt = F.bid * NT + F.tid, GT = F.G * NT;
    for (int i = gt; i < 1024 * 32; i += GT) { const int t = i >> 5, j = i & 31; const float inv = powf(10000.f, -(float)(j & 15) / 16.f); const float pos = (float)(j < 16 ? (t >> 6) : (t & 63));
        const float ang = pos * inv; F.rope[i] = cosf(ang); F.rope[32768 + i] = sinf(ang); }
    for (int i = gt; i < 2 * PAST * D; i += GT) { const int b = i / (PAST * D), r = i % (PAST * D);
        F.KS[(size_t)b * TKS * D + r] = (bf16)f2bf(F.in[I_CK][i]); F.VS[(size_t)b * TKS * D + r] = (bf16)f2bf(F.in[I_CV][i]); }
}

__device__ __forceinline__ void phase_modulate(Frame& F, int l, int sub) {
    F.fresh();
    const int gw = F.bid * NWAVES + F.wave, NGW = F.G * NWAVES;
    const float* g = F.in[I_NORMG] + (size_t)(l * 2 + sub) * D;
    for (int row = gw; row < M; row += NGW) {
        const float* xr = (l == 0 && sub == 0) ? xin_row(F, row) : F.out + (size_t)row * D;
        const float* sh = modp(F, l, row, sub * 3 + 0); const float* scl = modp(F, l, row, sub * 3 + 1);
        f32x4 v[4]; float s = 0.f;
#pragma unroll
        for (int j = 0; j < 4; ++j) { v[j] = *(const f32x4*)(xr + 4 * F.lane + 256 * j); s += v[j].x * v[j].x + v[j].y * v[j].y + v[j].z * v[j].z + v[j].w * v[j].w; }
        const float rstd = rsqrtf(wave_sum(s) * (1.f / D) + EPS);
#pragma unroll
        for (int j = 0; j < 4; ++j) { const int c0 = 4 * F.lane + 256 * j; const f32x4 gg = *(const f32x4*)(g + c0), s4 = *(const f32x4*)(sh + c0), c4 = *(const f32x4*)(scl + c0);
            const f32x4 o = v[j] * rstd * gg * (1.f + c4) + s4; u32x2 w; w.x = f2bf(o.x) | (f2bf(o.y) << 16); w.y = f2bf(o.z) | (f2bf(o.w) << 16);
            *(u32x2*)(F.H + (size_t)row * D + c0) = w; }
    }
}

template <class P>
__device__ __forceinline__ void gemm_naive(Frame& F, const P& p, int nbatch, int Mr, int N, int K) {
    F.fresh();
    LAS float* As = (LAS float*)F.lds;
    LAS float* Bs = As + 16 * 132;
    const int tid = F.tid, tx = tid & 31, ty = tid >> 5;
    const int tm = Mr / 128, tn = N / 128, per = tm * tn, total = per * nbatch;
    for (int t = F.bid; t < total; t += F.G) {
        const int b = t / per, r = t % per, pn = r / tm, pm = r % tm;
        const bf16* A; int lda; const float* W; int ldw; p.get(b, A, lda, W, ldw);
        float acc[8][4];
#pragma unroll
        for (int i = 0; i < 8; ++i)
#pragma unroll
            for (int j = 0; j < 4; ++j) acc[i][j] = 0.f;
        for (int k0 = 0; k0 < K; k0 += 16) {
            { const int row = tid >> 2, kq = (tid & 3) * 4;
              const u32x2 v = *(const u32x2*)(A + (size_t)(pm * 128 + row) * lda + k0 + kq);
              As[(kq + 0) * 132 + row] = bf2f(v.x); As[(kq + 1) * 132 + row] = bf2f(v.x >> 16); As[(kq + 2) * 132 + row] = bf2f(v.y); As[(kq + 3) * 132 + row] = bf2f(v.y >> 16); }
            { const int k = tid >> 5, n4 = (tid & 31) * 4;
              *(LAS f32x4*)(Bs + k * 128 + n4) = *(const f32x4*)(W + (size_t)(k0 + k) * ldw + pn * 128 + n4); }
            __syncthreads();
#pragma unroll 2
            for (int k = 0; k < 16; ++k) {
                const f32x4 a0 = *(const LAS f32x4*)(As + k * 132 + ty * 8), a1 = *(const LAS f32x4*)(As + k * 132 + ty * 8 + 4), bv = *(const LAS f32x4*)(Bs + k * 128 + tx * 4);
                const float a[8] = {a0.x, a0.y, a0.z, a0.w, a1.x, a1.y, a1.z, a1.w}; const float bb[4] = {bv.x, bv.y, bv.z, bv.w};
#pragma unroll
                for (int i = 0; i < 8; ++i)
#pragma unroll
                    for (int j = 0; j < 4; ++j) acc[i][j] += a[i] * bb[j];
            }
            __syncthreads();
        }
#pragma unroll
        for (int i = 0; i < 8; ++i)
#pragma unroll
            for (int j = 0; j < 4; ++j) p.epi(b, pm * 128 + ty * 8 + i, pn * 128 + tx * 4 + j, acc[i][j]);
    }
}

struct PStoreBf16 {
    const bf16* A; int lda; const float* W; int ldw; bf16* O; int ldo; const float* bias; int act; int split;
    __device__ __forceinline__ void get(int, const bf16*& a, int& la, const float*& w, int& lw) const { a = A; la = lda; w = W; lw = ldw; }
    __device__ __forceinline__ void epi(int, int row, int col, float v) const {
        if (bias) v += bias[col];
        if (act == 1 || (act == 2 && col < split)) v = gelu_tanh(v);
        O[(size_t)row * ldo + col] = (bf16)f2bf(v); }
};
struct PResid {
    const bf16* A; int lda; const float* W; int ldw; float* out; const float* xp; const float* xs; const float* modl; int which; bool from_input;
    __device__ __forceinline__ void get(int, const bf16*& a, int& la, const float*& w, int& lw) const { a = A; la = lda; w = W; lw = ldw; }
    __device__ __forceinline__ void epi(int, int row, int col, float v) const {
        const float base = from_input ? (row < NPROMPT ? xp[(size_t)row * D + col] : xs[(size_t)(row - NPROMPT) * D + col]) : out[(size_t)row * D + col];
        out[(size_t)row * D + col] = base + modl[(size_t)(cidx_of(row) * 6 + which) * D + col] * v; }
};
struct PLruIn {
    const bf16* A; const float* W; bf16* GBp; bf16* RECp;
    __device__ __forceinline__ void get(int, const bf16*& a, int& la, const float*& w, int& lw) const { a = A; la = D; w = W; lw = 2 * DRNN; }
    __device__ __forceinline__ void epi(int, int row, int col, float v) const {
        if (col < DRNN) GBp[(size_t)row * DRNN + col] = (bf16)f2bf(gelu_tanh(v)); else RECp[(size_t)row * DRNN + col - DRNN] = (bf16)f2bf(v); }
};
struct PGates {
    const bf16* XC; const float* WG; const float* BG; bf16* O;
    __device__ __forceinline__ void get(int b, const bf16*& a, int& la, const float*& w, int& lw) const { a = XC + (b % 10) * 128; la = DRNN; w = WG + (size_t)b * 128 * 128; lw = 128; }
    __device__ __forceinline__ void epi(int b, int row, int col, float v) const { const int dg = b / 10, n = b % 10;
        O[((size_t)dg * M + row) * DRNN + n * 128 + col] = (bf16)f2bf(sigmoidf_(v + BG[dg * DRNN + n * 128 + col])); }
};

__device__ __forceinline__ void phase_lru_conv(Frame& F, int j, const bf16* REC, bf16* XC) {
    F.fresh();
    const float* cw = F.in[I_LRU_CW] + (size_t)j * 4 * DRNN; const float* cb = F.in[I_LRU_CB] + (size_t)j * DRNN;
    const int gt = F.bid * NT + F.tid, GT = F.G * NT;
    for (int i = gt; i < M * DRNN; i += GT) { const int row = i / DRNN, ch = i % DRNN;
        int t, T; if (row < NPROMPT) { t = row & 255; T = 256; } else { t = (row - NPROMPT) & 1023; T = 1024; }
        float s = cb[ch];
#pragma unroll
        for (int k = 0; k < 4; ++k) { const int tt = t + k - 2; if (tt >= 0 && tt < T) s += cw[k * DRNN + ch] * bf2f(REC[(size_t)(row + k - 2) * DRNN + ch]); }
        XC[i] = (bf16)f2bf(s); }
}
__device__ __forceinline__ void phase_lru_scan(Frame& F, int j, const bf16* GATES, const bf16* XC, const bf16* GB, bf16* HS) {
    F.fresh();
    const int gt = F.bid * NT + F.tid, GT = F.G * NT;
    const int NL = (2 + 32) * DRNN;
    for (int line = gt; line < NL; line += GT) {
        const int s = line / DRNN, ch = line % DRNN;
        int base, T; float h0f = 0.f, h0b = 0.f;
        if (s < 2) { base = NPROMPT + s * 1024; T = 1024; h0f = F.in[I_STATE][((size_t)(s * 2 + j) * 2 + 0) * DRNN + ch]; h0b = F.in[I_STATE][((size_t)(s * 2 + j) * 2 + 1) * DRNN + ch]; }
        else { base = (s - 2) * 256; T = 256; }
        const float spf = softplusf_(-F.in[I_LRU_LAM][(size_t)(j * 2 + 0) * DRNN + ch]), spb = softplusf_(-F.in[I_LRU_LAM][(size_t)(j * 2 + 1) * DRNN + ch]);
        float h = h0f;
        for (int t = 0; t < T; ++t) { const size_t o = (size_t)(base + t) * DRNN + ch;
            const float r = bf2f(GATES[o]), ig = bf2f(GATES[(size_t)M * DRNN + o]), xc = bf2f(XC[o]);
            const float la = -8.f * r * spf, a = expf(la), bx = sqrtf(-expm1f(2.f * la)) * (ig * xc);
            h = a * h + bx; HS[o] = (bf16)f2bf(h); }
        const float ff = h;
        h = h0b;
        for (int t = T - 1; t >= 0; --t) { const size_t o = (size_t)(base + t) * DRNN + ch;
            const float r = bf2f(GATES[(size_t)2 * M * DRNN + o]), ig = bf2f(GATES[(size_t)3 * M * DRNN + o]), xc = bf2f(XC[o]);
            const float la = -8.f * r * spb, a = expf(la), bx = sqrtf(-expm1f(2.f * la)) * (ig * xc);
            h = a * h + bx; HS[o] = (bf16)f2bf(bf2f(GB[o]) * (bf2f(HS[o]) + h)); }
        if (s >= 2) { float* st = F.out + O_STATE + ((size_t)((s - 2) * 2 + j) * 2) * DRNN; st[ch] = ff; st[DRNN + ch] = h; }
    }
}

__device__ __forceinline__ void phase_cmlp_rstd(Frame& F, const bf16* UV) {
    F.fresh();
    const int gw = F.bid * NWAVES + F.wave, NGW = F.G * NWAVES;
    for (int row = gw; row < M; row += NGW) { float s = 0.f;
        for (int c = F.lane; c < DB; c += 64) { const float v = bf2f(UV[(size_t)row * 2 * DB + DB + c]); s += v * v; }
        s = wave_sum(s); if (F.lane == 0) F.rstd[row] = rsqrtf(s * (1.f / DB) + EPS); }
}
__device__ __forceinline__ void phase_cmlp_spatial(Frame& F, const bf16* UV, bf16* ACT) {
    F.fresh();
    const float* ws = F.in[I_CM_WS]; const float* bs = F.in[I_CM_BS]; const float* ng = F.in[I_CM_NG];
    const int gt = F.bid * NT + F.tid, GT = F.G * NT;
    for (int i = gt; i < M * DB; i += GT) { const int row = i / DB, ch = i % DB, g = ch >> 8, p = row & 127, r0 = row & ~127;
        float s = 0.f;
        for (int q = 0; q < 128; ++q) s += ws[(size_t)(g * 128 + p) * 128 + q] * F.rstd[r0 + q] * bf2f(UV[(size_t)(r0 + q) * 2 * DB + DB + ch]);
        const float sv = s * ng[ch] + bs[g * 128 + p];
        ACT[i] = (bf16)f2bf(bf2f(UV[(size_t)row * 2 * DB + ch]) * sv); }
}

__device__ __forceinline__ void phase_qkv_post(Frame& F, const bf16* QKV, bf16* Q, bf16* KP, bf16* VP) {
    F.fresh();
    const int gw = F.bid * NWAVES + F.wave, NGW = F.G * NWAVES;
    const float* qkg = F.in[I_AT_QKG];
    for (int row = gw; row < M; row += NGW) {
        const bool smp = row >= NPROMPT; const int sb = smp ? (row - NPROMPT) >> 10 : 0, t = smp ? (row - NPROMPT) & 1023 : 0;
        const float cs = smp ? F.rope[t * 32 + (F.lane & 31)] : 1.f, sn = smp ? F.rope[32768 + t * 32 + (F.lane & 31)] : 0.f;
        for (int grp = 0; grp < 32; ++grp) {
            const float v = bf2f(QKV[(size_t)row * 3072 + grp * 64 + F.lane]);
            const float ms = wave_sum(v * v) * (1.f / 64.f);
            float n = v * rsqrtf(ms + EPS) * qkg[(grp >> 4) * 64 + F.lane];
            const float keep = n;
            if (smp) { const float pr = __shfl_xor(n, 32); n = F.lane < 32 ? n * cs - pr * sn : n * cs + pr * sn; }
            if (grp < 16) Q[(size_t)row * D + grp * 64 + F.lane] = (bf16)f2bf(n);
            else { const int c = (grp - 16) * 64 + F.lane;
                if (smp) F.KS[((size_t)sb * TKS + PAST + t) * D + c] = (bf16)f2bf(n);
                else { KP[(size_t)row * D + c] = (bf16)f2bf(keep); F.out[O_CK + (size_t)row * D + c] = keep; } }
        }
        for (int c = F.lane; c < D; c += 64) { const bf16 vb = QKV[(size_t)row * 3072 + 2048 + c];
            if (smp) F.VS[((size_t)sb * TKS + PAST + t) * D + c] = vb; else { VP[(size_t)row * D + c] = vb; F.out[O_CV + (size_t)row * D + c] = bf2f(vb); } }
    }
}
__device__ __forceinline__ void phase_attn_naive(Frame& F, int l, const bf16* Q, const bf16* KP, const bf16* VP, bf16* O) {
    F.fresh();
    const int gw = F.bid * NWAVES + F.wave, NGW = F.G * NWAVES;
    LAS float* s1 = (LAS float*)F.lds + F.wave * 3328; LAS float* s2 = s1 + 1536; LAS float* qs = s2 + 1536;
    const float* al = F.in[I_AT_LAM];
    const float lam_init = 0.8f - 0.6f * expf(-0.3f * (float)l);
    const float lam = expf(wave_sum(al[F.lane] * al[64 + F.lane])) - expf(wave_sum(al[128 + F.lane] * al[192 + F.lane])) + lam_init;
    const float* sg = F.in[I_AT_SUBG];
    for (int item = gw; item < M * 8; item += NGW) {
        const int row = item >> 3, h = item & 7;
        const bf16 *Kb, *Vb; int Tk;
        if (row < NPROMPT) { Kb = KP + (size_t)(row & ~255) * D; Vb = VP + (size_t)(row & ~255) * D; Tk = 256; }
        else { const int sb = (row - NPROMPT) >> 10; Kb = F.KS + (size_t)sb * TKS * D; Vb = F.VS + (size_t)sb * TKS * D; Tk = TKS; }
        qs[F.lane] = bf2f(Q[(size_t)row * D + h * 128 + F.lane]); qs[64 + F.lane] = bf2f(Q[(size_t)row * D + h * 128 + 64 + F.lane]);
        asm volatile("s_waitcnt lgkmcnt(0)" ::: "memory");
        float m1 = -1e30f, m2 = -1e30f;
        for (int k = F.lane; k < Tk; k += 64) { const bf16* kr = Kb + (size_t)k * D + h * 128; float d1 = 0.f, d2 = 0.f;
#pragma unroll 4
            for (int d = 0; d < 64; d += 2) { const unsigned a = *(const unsigned*)(kr + d), b = *(const unsigned*)(kr + 64 + d);
                d1 += qs[d] * bf2f(a) + qs[d + 1] * bf2f(a >> 16); d2 += qs[64 + d] * bf2f(b) + qs[64 + d + 1] * bf2f(b >> 16); }
            d1 *= 0.125f; d2 *= 0.125f; s1[k] = d1; s2[k] = d2; m1 = fmaxf(m1, d1); m2 = fmaxf(m2, d2); }
        m1 = wave_max(m1); m2 = wave_max(m2);
        float l1 = 0.f, l2 = 0.f;
        for (int k = F.lane; k < Tk; k += 64) { const float e1 = expf(s1[k] - m1), e2 = expf(s2[k] - m2); s1[k] = e1; s2[k] = e2; l1 += e1; l2 += e2; }
        l1 = wave_sum(l1); l2 = wave_sum(l2);
        const float i1 = 1.f / l1, i2 = lam / l2;
        for (int k = F.lane; k < Tk; k += 64) s1[k] = bf2f(f2bf(s1[k] * i1 - s2[k] * i2));
        asm volatile("s_waitcnt lgkmcnt(0)" ::: "memory");
        float o0 = 0.f, o1 = 0.f;
        for (int k = 0; k < Tk; ++k) { const unsigned vv = *(const unsigned*)(Vb + (size_t)k * D + h * 128 + 2 * F.lane); const float w = s1[k]; o0 += w * bf2f(vv); o1 += w * bf2f(vv >> 16); }
        const float ms = wave_sum(o0 * o0 + o1 * o1) * (1.f / 128.f), rs = rsqrtf(ms + EPS) * (1.f - lam_init);
        o0 = o0 * rs * sg[2 * F.lane]; o1 = o1 * rs * sg[2 * F.lane + 1];
        *(unsigned*)(O + (size_t)row * D + h * 128 + 2 * F.lane) = f2bf(o0) | (f2bf(o1) << 16);
        asm volatile("s_waitcnt lgkmcnt(0)" ::: "memory");
    }
}

__device__ __forceinline__ void phase_ffn_convgate(Frame& F, int l, const bf16* Z, bf16* ACT) {
    F.fresh();
    const float* cw = F.in[I_FF_CW] + (size_t)l * 3 * 2 * DFF; const float* cb = F.in[I_FF_CB] + (size_t)l * 2 * DFF;
    const int gt = F.bid * NT + F.tid, GT = F.G * NT;
    for (int i = gt; i < M * DFF; i += GT) { const int row = i / DFF, j = i % DFF;
        int t, T; if (row < NPROMPT) { t = row & 255; T = 256; } else { t = (row - NPROMPT) & 1023; T = 1024; }
        float g = cb[j], u = cb[DFF + j];
#pragma unroll
        for (int k = 0; k < 3; ++k) { const int tt = t + k - 1; if (tt >= 0 && tt < T) { const bf16* zr = Z + (size_t)(row + k - 1) * 2 * DFF; g += cw[k * 2 * DFF + j] * bf2f(zr[j]); u += cw[k * 2 * DFF + DFF + j] * bf2f(zr[DFF + j]); } }
        ACT[i] = (bf16)f2bf(siluf_(g) * u); }
}

constexpr int LDS_BYTES = 147456;
constexpr int MISC_OFF = 131072 + 320;
__global__ void __launch_bounds__(NT, 2) mk_fwd(Params prm) {
    extern __shared__ __attribute__((aligned(16))) unsigned char lds_raw[];
    Frame F;
    F.lds = (LAS unsigned char*)lds_raw; F.G = gridDim.x; F.in = prm.in; F.out0 = prm.out; F.ws0 = prm.ws;
    F.fresh();
    volatile LAS unsigned* MISC = (volatile LAS unsigned*)(F.lds + MISC_OFF);
    if (F.tid < 32) MISC[F.tid] = 0u;
    __syncthreads();
    XcdBarrier bar = xcd_barrier_post((unsigned*)(prm.ws + WS_CTL) + CW_BAR, MISC + 8);
#define GRID_BAR() xcd_barrier(bar)

#define GEMM_BF16(ACT, A_, Bt_, N_, K_, O_, ldc_, bias_, splitc_, splits_) do { pg8::Gemm g{A_, Bt_, M, N_, K_}; pg8::StaticOrder S; S.init(M, N_, F.G, F.bid); \
        pg8::EpiBf16<ACT> E{O_, ldc_, bias_, splitc_, splits_}; pg8::gemm_phase<pg8::EpiBf16<ACT>, pg8::StaticOrder, true, true>(F.lds, g, S, E); } while (0)
#define GEMM_RESID(A_, Bt_, K_, which_, fromin_) do { pg8::Gemm g{A_, Bt_, M, D, K_}; pg8::StaticOrder S; S.init(M, D, F.G, F.bid); \
        pg8::EpiResid E{F.out, F.in[I_XP], F.in[I_XS], F.mod + (size_t)l * 18 * D, which_, fromin_}; pg8::gemm_phase<pg8::EpiResid, pg8::StaticOrder, true, true>(F.lds, g, S, E); } while (0)

    phase_prologue(F);
    GRID_BAR();
#pragma unroll 1
    for (int l = 0; l < DEPTH; ++l) {
        const int kind = l % 3, j = l / 3;
        phase_modulate(F, l, 0);
        F.fresh();
        GRID_BAR();
        if (kind == 0) {
            bf16 *GB = F.T2, *REC = F.T2 + (size_t)M * DRNN, *XC = F.T3, *GATES = F.T1, *HS = REC;
            GEMM_BF16(2, F.H, F.WT + WE_LRU_IN + (size_t)j * 2 * DRNN * D, 2 * DRNN, D, GB, DRNN, nullptr, DRNN, (size_t)M * DRNN);
            GRID_BAR();
            phase_lru_conv(F, j, REC, XC);
            GRID_BAR();
            { PGates pg{XC, F.in[I_LRU_WG] + (size_t)j * 40 * 128 * 128, F.in[I_LRU_BG] + (size_t)j * 4 * DRNN, GATES};
              gemm_naive(F, pg, 40, M, 128, 128); }
            GRID_BAR();
            phase_lru_scan(F, j, GATES, XC, GB, HS);
            GRID_BAR();
            GEMM_RESID(HS, F.WT + WE_LRU_OUT + (size_t)j * D * DRNN, DRNN, 2, l == 0);
        } else if (kind == 1) {
            bf16 *UV = F.T1, *ACT = F.T2;
            GEMM_BF16(1, F.H, F.WT + WE_CM_IN, 2 * DB, D, UV, 2 * DB, F.in[I_CM_BIN], 0, 0);
            GRID_BAR();
            phase_cmlp_rstd(F, UV);
            GRID_BAR();
            phase_cmlp_spatial(F, UV, ACT);
            GRID_BAR();
            GEMM_RESID(ACT, F.WT + WE_CM_OUT, DB, 2, false);
        } else {
            bf16 *QKV = F.T1, *Q = F.T2, *KP = F.T2 + (size_t)M * D, *VP = KP + (size_t)NPROMPT * D, *O = F.T3;
            GEMM_BF16(0, F.H, F.WT + WE_QKV, 3 * D, D, QKV, 3 * D, nullptr, 0, 0);
            GRID_BAR();
            phase_qkv_post(F, QKV, Q, KP, VP);
            GRID_BAR();
            phase_attn_naive(F, l, Q, KP, VP, O);
            GRID_BAR();
            GEMM_RESID(O, F.WT + WE_AT_OUT, D, 2, false);
        }
        GRID_BAR();
        phase_modulate(F, l, 1);
        GRID_BAR();
        GEMM_BF16(0, F.H, F.WT + WE_UP + (size_t)l * 2 * DFF * D, 2 * DFF, D, F.T1, 2 * DFF, nullptr, 0, 0);
        GRID_BAR();
        phase_ffn_convgate(F, l, F.T1, F.T2);
        GRID_BAR();
        GEMM_RESID(F.T2, F.WT + WE_DN + (size_t)l * D * DFF, DFF, 5, false);
        GRID_BAR();
    }
}

extern "C" void kernel_launch(void* const* d_in, const int* in_sizes, int n_in, void* d_out, int out_size, void* d_ws, size_t ws_size, hipStream_t stream) {
    static int grid = 0;
    if (grid == 0) {
        if (n_in != N_IN || ws_size < WS_END) { fprintf(stderr, "kernel_launch: unexpected n_in %d or ws_size %zu\n", n_in, ws_size); grid = -1; return; }
        int dev = 0, cus = 0, per_cu = 0;
        hipGetDevice(&dev); hipDeviceGetAttribute(&cus, hipDeviceAttributeMultiprocessorCount, dev);
        hipFuncSetAttribute((const void*)mk_fwd, hipFuncAttributeMaxDynamicSharedMemorySize, LDS_BYTES);
        hipOccupancyMaxActiveBlocksPerMultiprocessor(&per_cu, (const void*)mk_fwd, NT, LDS_BYTES);
        (void)hipGetLastError();
        if (per_cu < 1) { fprintf(stderr, "kernel_launch: occupancy query says %d blocks per CU\n", per_cu); per_cu = 1; }
        grid = cus;
    }
    if (grid < 0) return;
    hipMemsetAsync((char*)d_ws + WS_CTL, 0, CTL_ZERO_BYTES, stream);
    Params p{};
    for (int i = 0; i < N_IN; ++i) p.in[i] = (const float*)d_in[i];
    p.out = (float*)d_out; p.ws = (unsigned char*)d_ws;
    void* args[] = {&p};
    hipError_t e = hipLaunchCooperativeKernel((const void*)mk_fwd, dim3(grid), dim3(NT), args, LDS_BYTES, stream);
    if (e != hipSuccess) fprintf(stderr, "kernel_launch: cooperative launch failed: %s (grid %d)\n", hipGetErrorString(e), grid);
}
```

```cpp
#include <hip/hip_runtime.h>
#include <cstdio>
#include <cstdint>

#define GAS __attribute__((address_space(1)))
#define LAS __attribute__((address_space(3)))
typedef unsigned short bf16;
typedef float f32x4 __attribute__((ext_vector_type(4)));
typedef unsigned u32x2 __attribute__((ext_vector_type(2)));
typedef unsigned u32x4 __attribute__((ext_vector_type(4)));

constexpr int D = 1024, NPROMPT = 32 * 256, NSAMPLE = 2 * 1024, M = NPROMPT + NSAMPLE;
constexpr int DEPTH = 4, DRNN = 1280, DB = 2048, DFF = 2816, PAST = 512, TKS = PAST + 1024;
constexpr float EPS = 1e-6f;
constexpr int NWAVES = 8, NT = NWAVES * 64;

enum { I_XP = 0, I_XS, I_STATE, I_CK, I_CV, I_C, I_CCTX, I_WMOD, I_BMOD, I_NORMG, I_LRU_WIN, I_LRU_CW, I_LRU_CB, I_LRU_WG, I_LRU_BG, I_LRU_LAM, I_LRU_WOUT,
       I_CM_WIN, I_CM_BIN, I_CM_NG, I_CM_WS, I_CM_BS, I_CM_WOUT, I_AT_WQKV, I_AT_QKG, I_AT_LAM, I_AT_SUBG, I_AT_WOUT, I_FF_WUP, I_FF_CW, I_FF_CB, I_FF_WDN, N_IN };
constexpr size_t O_YP = 0, O_YS = (size_t)NPROMPT * D, O_STATE = (size_t)M * D, O_CK = O_STATE + 32 * 2 * 2 * DRNN, O_CV = O_CK + (size_t)NPROMPT * D;

constexpr size_t MiB = 1u << 20;
constexpr size_t WS_CTL = 0, CTL_ZERO_BYTES = 64 * 1024;
constexpr size_t WS_MOD = 1 * MiB;
constexpr size_t WS_RSTD = WS_MOD + 512 * 1024;
constexpr size_t WS_ROPE = WS_RSTD + 256 * 1024;
constexpr size_t WS_H = 2 * MiB;
constexpr size_t WS_T1 = 22 * MiB;
constexpr size_t WS_T2 = 132 * MiB;
constexpr size_t WS_T3 = 187 * MiB;
constexpr size_t WS_KS = 237 * MiB, WS_VS = 243 * MiB;
constexpr size_t WS_W = 249 * MiB;
constexpr size_t WE_LRU_IN = 0, WE_LRU_OUT = WE_LRU_IN + (size_t)2 * 2560 * 1024, WE_CM_IN = WE_LRU_OUT + (size_t)2 * 1024 * 1280, WE_CM_OUT = WE_CM_IN + (size_t)4096 * 1024,
                 WE_QKV = WE_CM_OUT + (size_t)1024 * 2048, WE_AT_OUT = WE_QKV + (size_t)3072 * 1024, WE_UP = WE_AT_OUT + (size_t)1024 * 1024, WE_DN = WE_UP + (size_t)4 * 5632 * 1024,
                 WE_WG = WE_DN + (size_t)4 * 1024 * 2816, WE_END = WE_WG + (size_t)80 * 128 * 128;
constexpr size_t WS_END = WS_W + 106 * MiB;
static_assert(WE_END * 2 <= 106 * MiB, "weight copies fit");
constexpr int CW_BAR = 1024;

__device__ __forceinline__ unsigned f2bf(float f) { unsigned u = __builtin_bit_cast(unsigned, f); return (u + 0x7fffu + ((u >> 16) & 1u)) >> 16; }
__device__ __forceinline__ float bf2f(unsigned b) { return __builtin_bit_cast(float, (b & 0xffffu) << 16); }
__device__ __forceinline__ float wave_sum(float v) {
#pragma unroll
    for (int o = 1; o < 64; o <<= 1) v += __shfl_xor(v, o);
    return v;
}
__device__ __forceinline__ float wave_max(float v) {
#pragma unroll
    for (int o = 1; o < 64; o <<= 1) v = fmaxf(v, __shfl_xor(v, o));
    return v;
}
__device__ __forceinline__ float gelu_tanh(float x) { const float y = 0.7978845608028654f * (x + 0.044715f * x * x * x); const float t = 1.f - 2.f / (__expf(2.f * y) + 1.f); return 0.5f * x * (1.f + t); }
__device__ __forceinline__ float sigmoidf_(float x) { return 1.f / (1.f + __expf(-x)); }
__device__ __forceinline__ float siluf_(float x) { return x / (1.f + __expf(-x)); }
__device__ __forceinline__ float softplusf_(float x) { return fmaxf(x, 0.f) + log1pf(expf(-fabsf(x))); }

#define XB_TMO      128
#define XB_XCNT(j)  (256  + 64 * (j))
#define XB_XSUB(j)  (1280 + 64 * (j))
#define XB_XGEN(j)  (2304 + 64 * (j))
#define XB_TOP      3328
#define XB_TOPGEN   3392
#define XCD_BAR_WORDS 3456
#define XB_SPIN_CAP (1u << 22)
__device__ __forceinline__ unsigned xb_ld(unsigned* p)              { return __hip_atomic_load(p, __ATOMIC_RELAXED, __HIP_MEMORY_SCOPE_AGENT); }
__device__ __forceinline__ unsigned xb_add(unsigned* p, unsigned v) { return __hip_atomic_fetch_add(p, v, __ATOMIC_RELAXED, __HIP_MEMORY_SCOPE_AGENT); }
__device__ __forceinline__ unsigned xb_xcc_id() { return (unsigned)__builtin_amdgcn_s_getreg((3 << 11) | 20) & 0xFu; }
#define XB_SPIN(cond, bar) do { unsigned _sp = 0; while (cond) { __builtin_amdgcn_s_sleep(1); \
    if ((++_sp & 255u) == 0u) { if (xb_ld(&(bar)[XB_TMO])) break; if (_sp > XB_SPIN_CAP) { atomicAdd(&(bar)[XB_TMO], 1u); break; } } } } while (0)
struct XcdBarrier { unsigned* bar; unsigned x; volatile LAS unsigned* st; };
__device__ __forceinline__ XcdBarrier xcd_barrier_post(unsigned* bar, volatile LAS unsigned* st) {
    XcdBarrier b; b.bar = bar; b.x = xb_xcc_id(); b.st = st;
    if (threadIdx.x == 0) (void)xb_add(&bar[XB_XCNT(b.x)], 1u);
    return b;
}
__device__ __forceinline__ void xcd_barrier_complete(unsigned* bar, unsigned x, unsigned& nloc, unsigned& nx) {
    const unsigned G = gridDim.x * gridDim.y * gridDim.z;
    unsigned sum, cnt, mine, sp = 0u;
    for (;;) {
        sum = 0u; cnt = 0u; mine = 0u;
#pragma unroll
        for (unsigned j = 0; j < 16; ++j) { const unsigned c = xb_ld(&bar[XB_XCNT(j)]); sum += c; cnt += (c > 0u) ? 1u : 0u; mine = (j == x) ? c : mine; }
        if (sum == G) break;
        __builtin_amdgcn_s_sleep(1);
        if ((++sp & 255u) == 0u) { if (xb_ld(&bar[XB_TMO])) break; if (sp > XB_SPIN_CAP) { atomicAdd(&bar[XB_TMO], 1u); break; } }
    }
    nloc = mine > 0u ? mine : 1u; nx = cnt > 0u ? cnt : 1u;
}
__device__ __forceinline__ void xcd_barrier(const XcdBarrier& b) {
    asm volatile("s_waitcnt vmcnt(0)" ::: "memory");
    __syncthreads();
    if (threadIdx.x == 0) {
        unsigned* bar = b.bar;
        __builtin_amdgcn_s_waitcnt(0);
        unsigned nloc = b.st[0], nx = b.st[1];
        if (nloc == 0u) { xcd_barrier_complete(bar, b.x, nloc, nx); b.st[0] = nloc; b.st[1] = nx; }
        const unsigned old = xb_add(&bar[XB_XSUB(b.x)], 1u);
        const unsigned gen = old / nloc;
        if (old + 1u == (gen + 1u) * nloc) {
            __builtin_amdgcn_fence(__ATOMIC_RELEASE, "agent");
            asm volatile("s_waitcnt vmcnt(0)" ::: "memory");
            const unsigned og = xb_add(&bar[XB_TOP], 1u);
            const unsigned tg = og / nx;
            if (og + 1u == (tg + 1u) * nx) xb_add(&bar[XB_TOPGEN], 1u);
            else XB_SPIN(xb_ld(&bar[XB_TOPGEN]) == tg, bar);
            __builtin_amdgcn_fence(__ATOMIC_ACQUIRE, "agent");
            xb_add(&bar[XB_XGEN(b.x)], 1u);
            asm volatile("s_waitcnt vmcnt(0)" ::: "memory");
        } else {
            XB_SPIN(xb_ld(&bar[XB_XGEN(b.x)]) == gen, bar);
            __builtin_amdgcn_fence(__ATOMIC_ACQUIRE, "agent");
            asm volatile("s_waitcnt vmcnt(0)" ::: "memory");
        }
    }
    __syncthreads();
}

namespace pg8 {
#define PG8_LAS __attribute__((address_space(3)))
typedef unsigned short bf16_t;
typedef short bf16x8 __attribute__((ext_vector_type(8)));
typedef float f32x4 __attribute__((ext_vector_type(4)));
typedef unsigned u32x4 __attribute__((ext_vector_type(4)));
constexpr int BM = 256, BK = 64, HALF = 128, HTB = HALF * BK * 2  , STAGE_BYTES = 8 * HTB, NXCD = 8, WGM = 8;

__host__ __device__ __forceinline__ int lds_byte(int r, int c) { const int st = (r >> 4) * 2 + (c >> 5), rr = r & 15, cc = c & 31, ob = rr * 64 + cc * 2; return st * 1024 + (ob ^ (((ob >> 9) & 1) << 5)); }
__host__ __device__ __forceinline__ void stage_rc(int b, int& R, int& C) { const int st = b / 1024, sb = b % 1024, swz = sb ^ (((sb >> 9) & 1) << 5); R = (st >> 1) * 16 + swz / 64; C = (st & 1) * 32 + (swz % 64) / 2; }
__host__ __device__ __forceinline__ int perm32(int rho) { const int n = rho >> 4, i = rho & 15; return 8 * (i >> 2) + 4 * n + (i & 3); }

struct Unit { int pm, pn; };
struct Gemm { const bf16_t* A; const bf16_t* Bt; int M, N, K; };

struct StaticOrder {
    int nM, nN, nwg, G, c;
    __host__ __device__ void init(int M, int N, int G_, int c_) { nM = M / BM; nN = N / BM; nwg = nM * nN; G = G_; c = c_; }
    __host__ __device__ bool next(int i, Unit& u) const {
        const long L = (long)i * G + c; if (L >= nwg) return false;
        int wgid = (int)L; { const int q = nwg / NXCD, r = nwg % NXCD, xcd = wgid % NXCD, off = wgid / NXCD; wgid = (xcd < r ? xcd * (q + 1) : r * (q + 1) + (xcd - r) * q) + off; }
        const int nig = WGM * nN, gid = wgid / nig, fm = gid * WGM, gsz = (nM - fm) < WGM ? (nM - fm) : WGM;
        u.pm = fm + ((wgid % nig) % gsz); u.pn = (wgid % nig) / gsz; return true;
    }
    __device__ __forceinline__ void a_ready(const Unit&) const {}
    __device__ __forceinline__ void done(const Unit&) const {}
};

template <class Epi, class Sched, bool ALIGN_EPI = false, bool SP2 = false>
__device__ __forceinline__ void gemm_phase(PG8_LAS unsigned char* lds, const Gemm g, const Sched& S, const Epi& E) {
    int tid_ = threadIdx.x; asm volatile("" : "+v"(tid_));
    const int tid = tid_, wid = __builtin_amdgcn_readfirstlane(tid >> 6), lane = tid & 63, wr = wid >> 2, wc = wid & 3, fr = lane & 15, fq = lane >> 4;
    const int K = g.K, nt = K / BK;
    unsigned voffA[2], voffB[2];
#pragma unroll
    for (int i = 0; i < 2; ++i) { int R, C; stage_rc(tid * 16 + i * 8192, R, C); const int Rb = Epi::PERM ? ((R & ~31) + perm32(R & 31)) : R;
        voffA[i] = (unsigned)(R * K + C) * 2u; voffB[i] = (unsigned)(Rb * K + C) * 2u; }
    const size_t kstep = (size_t)(BK * 2);
    const size_t hstep = (size_t)HALF * K * 2;
    const size_t tstep = 2 * hstep;
    const unsigned ldsw = (unsigned)wid * 1024u;
    const int aoff = lds_byte(wr * 64 + fr, fq * 8), boff = lds_byte(wc * 32 + fr, fq * 8);
#define PG8_SA(b, h) (((b) * 2 + (h)) * HTB)
#define PG8_SB(b, h) ((4 + (b) * 2 + (h)) * HTB)
#define PG8_STAGE(bufoff, gbase, voff) do { _Pragma("unroll") for (int _i = 0; _i < 2; ++_i) \
        __builtin_amdgcn_global_load_lds((const unsigned*)((const char*)(gbase) + (voff)[_i]), (PG8_LAS unsigned*)(lds + (bufoff) + ldsw + _i * 8192), 16, 0, 0); } while (0)
#define PG8_LDA(dst, b, h) do { _Pragma("unroll") for (int m = 0; m < 4; ++m) _Pragma("unroll") for (int k = 0; k < 2; ++k) dst[m][k] = *(const PG8_LAS bf16x8*)(lds + PG8_SA(b, h) + aoff + m * 2048 + k * 1024); } while (0)
#define PG8_LDB(dst, b, h) do { _Pragma("unroll") for (int n = 0; n < 2; ++n) _Pragma("unroll") for (int k = 0; k < 2; ++k) dst[n][k] = *(const PG8_LAS bf16x8*)(lds + PG8_SB(b, h) + boff + n * 2048 + k * 1024); } while (0)
#define PG8_MMA(ai, bj, At, Bt) do { __builtin_amdgcn_s_setprio(1); _Pragma("unroll") for (int m = 0; m < 4; ++m) _Pragma("unroll") for (int n = 0; n < 2; ++n) _Pragma("unroll") for (int k = 0; k < 2; ++k) \
        acc[ai][bj][m][n] = __builtin_amdgcn_mfma_f32_16x16x32_bf16(Bt[n][k], At[m][k], acc[ai][bj][m][n], 0, 0, 0); __builtin_amdgcn_s_setprio(0); } while (0)
#define PG8_WAIT_V(n) asm volatile("s_waitcnt vmcnt(" #n ")" ::: "memory")
#define PG8_WAIT_L(n) asm volatile("s_waitcnt lgkmcnt(" #n ")" ::: "memory")
#define PG8_BAR __builtin_amdgcn_s_barrier()
#define PG8_SCHED __builtin_amdgcn_sched_barrier(0)
    Unit cur, nxt; int ui = 0;
    if (!S.next(0, cur)) return;
    f32x4 acc[2][2][4][2];
#pragma unroll
    for (int a = 0; a < 2; ++a)
#pragma unroll
        for (int b = 0; b < 2; ++b)
#pragma unroll
            for (int m = 0; m < 4; ++m)
#pragma unroll
                for (int n = 0; n < 2; ++n) acc[a][b][m][n] = (f32x4){0.f, 0.f, 0.f, 0.f};
    bf16x8 At[4][2], B0[2][2], B1[2][2];
    const char* cA = (const char*)g.A + (size_t)cur.pm * tstep; const char* cB = (const char*)g.Bt + (size_t)cur.pn * tstep;
    S.a_ready(cur);
    if constexpr (SP2) {
        PG8_STAGE(PG8_SB(0, 0), cB, voffB); PG8_STAGE(PG8_SB(0, 1), cB + hstep, voffB); PG8_STAGE(PG8_SA(0, 0), cA, voffA); PG8_STAGE(PG8_SA(0, 1), cA + hstep, voffA);
        if (wr == 1) PG8_BAR;
        PG8_WAIT_V(2); PG8_BAR;
        PG8_STAGE(PG8_SB(1, 0), cB + kstep, voffB); PG8_STAGE(PG8_SA(1, 0), cA + kstep, voffA); PG8_STAGE(PG8_SB(1, 1), cB + hstep + kstep, voffB);
        PG8_WAIT_V(6); PG8_BAR;
    } else {
        PG8_STAGE(PG8_SB(0, 0), cB, voffB); PG8_STAGE(PG8_SA(0, 0), cA, voffA); PG8_STAGE(PG8_SB(0, 1), cB + hstep, voffB); PG8_STAGE(PG8_SA(0, 1), cA + hstep, voffA);
        if (wr == 1) PG8_BAR;
        PG8_WAIT_V(4); PG8_BAR;
        PG8_STAGE(PG8_SB(1, 0), cB + kstep, voffB); PG8_STAGE(PG8_SA(1, 0), cA + kstep, voffA); PG8_STAGE(PG8_SB(1, 1), cB + hstep + kstep, voffB);
        PG8_WAIT_V(6); PG8_BAR;
    }
    for (;;) {
        const bool has_next = S.next(ui + 1, nxt);
        const char* nA = has_next ? (const char*)g.A + (size_t)nxt.pm * tstep : cA; const char* nB = has_next ? (const char*)g.Bt + (size_t)nxt.pn * tstep : cB;
        for (int t = 0; t < nt; t += 2) {
            const bool last = (t == nt - 2);
            const char* a1 = cA + (size_t)(t + 1) * kstep;
            const char* a2 = last ? nA : cA + (size_t)(t + 2) * kstep; const char* b2 = last ? nB : cB + (size_t)(t + 2) * kstep;
            const char* a3 = a2 + kstep; const char* b3 = b2 + kstep;
            if (last && has_next) S.a_ready(nxt);
            if constexpr (SP2) {
            PG8_LDB(B0, 0, 0); PG8_LDB(B1, 0, 1); PG8_SCHED; PG8_LDA(At, 0, 0); PG8_STAGE(PG8_SA(1, 1), a1 + hstep, voffA);
            PG8_WAIT_V(8); PG8_WAIT_L(0); PG8_BAR; PG8_MMA(0, 0, At, B0); PG8_MMA(0, 1, At, B1); PG8_BAR; PG8_SCHED;
            PG8_LDA(At, 0, 1); PG8_STAGE(PG8_SB(0, 0), b2, voffB); PG8_STAGE(PG8_SB(0, 1), b2 + hstep, voffB); PG8_STAGE(PG8_SA(0, 0), a2, voffA);
            PG8_WAIT_V(8); PG8_WAIT_L(0); PG8_BAR; PG8_MMA(1, 0, At, B0); PG8_MMA(1, 1, At, B1); PG8_BAR; PG8_SCHED;
            PG8_LDB(B0, 1, 0); PG8_LDB(B1, 1, 1); PG8_SCHED; PG8_LDA(At, 1, 0); PG8_STAGE(PG8_SA(0, 1), a2 + hstep, voffA);
            PG8_WAIT_V(8); PG8_WAIT_L(0); PG8_BAR; PG8_MMA(0, 0, At, B0); PG8_MMA(0, 1, At, B1); PG8_BAR; PG8_SCHED;
            PG8_LDA(At, 1, 1); PG8_STAGE(PG8_SB(1, 0), b3, voffB); PG8_STAGE(PG8_SB(1, 1), b3 + hstep, voffB); PG8_STAGE(PG8_SA(1, 0), a3, voffA);
            PG8_WAIT_V(8); PG8_WAIT_L(0); PG8_BAR; PG8_MMA(1, 0, At, B0); PG8_MMA(1, 1, At, B1); PG8_BAR; PG8_SCHED;
            } else {
            PG8_LDB(B0, 0, 0); PG8_SCHED; PG8_LDA(At, 0, 0); PG8_STAGE(PG8_SA(1, 1), a1 + hstep, voffA);
            PG8_WAIT_L(8); PG8_BAR; PG8_WAIT_L(0); PG8_MMA(0, 0, At, B0); PG8_BAR; PG8_SCHED;
            PG8_LDB(B1, 0, 1); PG8_STAGE(PG8_SB(0, 0), b2, voffB);
            PG8_BAR; PG8_WAIT_L(0); PG8_MMA(0, 1, At, B1); PG8_BAR;
            PG8_LDA(At, 0, 1); PG8_STAGE(PG8_SA(0, 0), a2, voffA);
            PG8_BAR; PG8_WAIT_L(0); PG8_MMA(1, 0, At, B0); PG8_BAR; PG8_SCHED;
            PG8_STAGE(PG8_SB(0, 1), b2 + hstep, voffB);
            PG8_WAIT_V(6); PG8_BAR; PG8_MMA(1, 1, At, B1); PG8_BAR;
            PG8_LDB(B0, 1, 0); PG8_SCHED; PG8_LDA(At, 1, 0); PG8_STAGE(PG8_SA(0, 1), a2 + hstep, voffA);
            PG8_WAIT_L(8); PG8_BAR; PG8_WAIT_L(0); PG8_MMA(0, 0, At, B0); PG8_BAR; PG8_SCHED;
            PG8_LDB(B1, 1, 1); PG8_STAGE(PG8_SB(1, 0), b3, voffB);
            PG8_BAR; PG8_WAIT_L(0); PG8_MMA(0, 1, At, B1); PG8_BAR;
            PG8_LDA(At, 1, 1); PG8_STAGE(PG8_SA(1, 0), a3, voffA);
            PG8_BAR; PG8_WAIT_L(0); PG8_MMA(1, 0, At, B0); PG8_BAR; PG8_SCHED;
            PG8_STAGE(PG8_SB(1, 1), b3 + hstep, voffB);
            PG8_WAIT_V(6); PG8_BAR; PG8_MMA(1, 1, At, B1); PG8_BAR;
            }
        }
        if constexpr (ALIGN_EPI) { if (wr == 0) PG8_BAR; }
        if constexpr (!Epi::AFTER_DRAIN) { E(acc, cur, wr, wc, fr, fq); S.done(cur); }
        if (!has_next) break;
#pragma unroll
        for (int a = 0; a < 2; ++a)
#pragma unroll
            for (int b = 0; b < 2; ++b)
#pragma unroll
                for (int m = 0; m < 4; ++m)
#pragma unroll
                    for (int n = 0; n < 2; ++n) acc[a][b][m][n] = (f32x4){0.f, 0.f, 0.f, 0.f};
        cur = nxt; cA = nA; cB = nB; ++ui;
        if constexpr (ALIGN_EPI) { if (wr == 1) PG8_BAR; }
    }
    PG8_WAIT_V(0);
    if constexpr (!ALIGN_EPI) { if (wr == 0) PG8_BAR; }
    PG8_BAR;
    if constexpr (Epi::AFTER_DRAIN) { E.fused(acc, cur, wr, wc, fr, fq, lds, wid, lane); S.done(cur); }
#undef PG8_SA
#undef PG8_SB
#undef PG8_STAGE
#undef PG8_LDA
#undef PG8_LDB
#undef PG8_MMA
#undef PG8_WAIT_V
#undef PG8_WAIT_L
#undef PG8_BAR
#undef PG8_SCHED
}
}

namespace pg8 {
__device__ __forceinline__ unsigned cvt_pk_bf16(float lo, float hi) { unsigned r; asm volatile("v_cvt_pk_bf16_f32 %0, %1, %2" : "=v"(r) : "v"(lo), "v"(hi)); return r; }
__device__ __forceinline__ f32x4 gelu4(f32x4 v) { f32x4 o; o.x = gelu_tanh(v.x); o.y = gelu_tanh(v.y); o.z = gelu_tanh(v.z); o.w = gelu_tanh(v.w); return o; }
template <int ACT> struct EpiBf16 {
    static constexpr bool PERM = true, AFTER_DRAIN = false;
    bf16_t* O; int ldc; const float* bias; int split_cols; size_t split_stride;
    __device__ __forceinline__ void operator()(const f32x4 (&acc)[2][2][4][2], const Unit& u, int wr, int wc, int fr, int fq) const {
        const int row0 = u.pm * BM + wr * 64 + fr; int colt = u.pn * BM; bf16_t* base = O; int t = 0;
        if (split_cols) { t = colt / split_cols; base += (size_t)t * split_stride; colt -= t * split_cols; }
        const bool act = (ACT == 1) || (ACT == 2 && t == 0);
        const int col0 = colt + wc * 32 + 8 * fq, bcol0 = u.pn * BM + wc * 32 + 8 * fq;
        f32x4 bv[2][2];
#pragma unroll
        for (int bj = 0; bj < 2; ++bj)
#pragma unroll
            for (int n = 0; n < 2; ++n) bv[bj][n] = bias ? *(const GAS f32x4*)(bias + bcol0 + bj * HALF + 4 * n) : (f32x4){0.f, 0.f, 0.f, 0.f};
#pragma unroll
        for (int ai = 0; ai < 2; ++ai)
#pragma unroll
            for (int m = 0; m < 4; ++m) { bf16_t* rowp = base + (size_t)(row0 + ai * HALF + m * 16) * ldc + col0;
#pragma unroll
                for (int bj = 0; bj < 2; ++bj) { f32x4 v0 = acc[ai][bj][m][0] + bv[bj][0], v1 = acc[ai][bj][m][1] + bv[bj][1];
                    if (ACT != 0) { if (act) { v0 = gelu4(v0); v1 = gelu4(v1); } }
                    u32x4 w; w.x = cvt_pk_bf16(v0[0], v0[1]); w.y = cvt_pk_bf16(v0[2], v0[3]); w.z = cvt_pk_bf16(v1[0], v1[1]); w.w = cvt_pk_bf16(v1[2], v1[3]);
                    *(GAS u32x4*)(rowp + bj * HALF) = w; } }
    }
};
struct EpiResid {
    static constexpr bool PERM = false, AFTER_DRAIN = false;
    float* out; const float* xp; const float* xs; const float* modl; int which; bool from_input;
    __device__ __forceinline__ void operator()(const f32x4 (&acc)[2][2][4][2], const Unit& u, int wr, int wc, int fr, int fq) const {
        const int trow = u.pm * BM, row0 = wr * 64 + fr, col0 = u.pn * BM + wc * 32 + 4 * fq;
        const int ci = trow < NPROMPT ? 0 : 1 + ((trow - NPROMPT) >> 10);
        const float* gp = modl + (size_t)(ci * 6 + which) * D + col0;
        const float* bp = from_input ? (trow < NPROMPT ? xp + (size_t)trow * D : xs + (size_t)(trow - NPROMPT) * D) : out + (size_t)trow * D;
        GAS float* op = (GAS float*)(out + (size_t)trow * D); const GAS float* bpg = (const GAS float*)bp; const GAS float* gpg = (const GAS float*)gp;
        f32x4 gv[2][2];
#pragma unroll
        for (int bj = 0; bj < 2; ++bj)
#pragma unroll
            for (int n = 0; n < 2; ++n) gv[bj][n] = *(const GAS f32x4*)(gpg + bj * HALF + n * 16);
#pragma unroll
        for (int ai = 0; ai < 2; ++ai)
#pragma unroll
            for (int m = 0; m < 4; ++m) { const size_t off = (size_t)(row0 + ai * HALF + m * 16) * D + col0;
                f32x4 bs[2][2];
#pragma unroll
                for (int bj = 0; bj < 2; ++bj)
#pragma unroll
                    for (int n = 0; n < 2; ++n) bs[bj][n] = *(const GAS f32x4*)(bpg + off + bj * HALF + n * 16);
#pragma unroll
                for (int bj = 0; bj < 2; ++bj)
#pragma unroll
                    for (int n = 0; n < 2; ++n) *(GAS f32x4*)(op + off + bj * HALF + n * 16) = bs[bj][n] + gv[bj][n] * acc[ai][bj][m][n];
                asm volatile("" ::: "memory"); }
    }
};
}

struct Params { const float* in[N_IN]; float* out; unsigned char* ws; };
struct Frame {
    LAS unsigned char* lds; int tid, lane, wave, bid, G;
    const float* const* in; float* out; unsigned char* ws; float* out0; unsigned char* ws0;
    float* mod; float* rstd; float* rope; bf16 *H, *T1, *T2, *T3, *KS, *VS, *WT;
    __device__ __forceinline__ void fresh() {
        int t = threadIdx.x; asm volatile("" : "+v"(t)); tid = t; lane = t & 63; wave = __builtin_amdgcn_readfirstlane(t >> 6);
        int b = blockIdx.x; asm volatile("" : "+s"(b)); bid = b;
        unsigned char* w = ws0; asm volatile("" : "+s"(w)); ws = w; float* o = out0; asm volatile("" : "+s"(o)); out = o;
        mod = (float*)(w + WS_MOD); rstd = (float*)(w + WS_RSTD); rope = (float*)(w + WS_ROPE);
        H = (bf16*)(w + WS_H); T1 = (bf16*)(w + WS_T1); T2 = (bf16*)(w + WS_T2); T3 = (bf16*)(w + WS_T3); KS = (bf16*)(w + WS_KS); VS = (bf16*)(w + WS_VS); WT = (bf16*)(w + WS_W);
    }
};
__device__ __forceinline__ const float* xin_row(const Frame& F, int row) { return row < NPROMPT ? F.in[I_XP] + (size_t)row * D : F.in[I_XS] + (size_t)(row - NPROMPT) * D; }
__device__ __forceinline__ int cidx_of(int row) { return row < NPROMPT ? 0 : 1 + ((row - NPROMPT) >> 10); }
__device__ __forceinline__ const float* modp(const Frame& F, int l, int row, int which) { return F.mod + (size_t)((l * 3 + cidx_of(row)) * 6 + which) * D; }


__device__ __forceinline__ void transpose_item(const float* W, int K, int N, bf16* WT, LAS float* scr, int item, int lane) {
    const int nblk = N / 32, kb = item / nblk, nb = item % nblk, k0 = 64 * kb, n0 = 32 * nb;
#pragma unroll 8
    for (int i = 0; i < 32; ++i) { const int kk = 2 * i + (lane >> 5); scr[kk * 33 + (lane & 31)] = W[(size_t)(k0 + kk) * N + n0 + (lane & 31)]; }
    asm volatile("s_waitcnt lgkmcnt(0)" ::: "memory");
    const int c = lane & 7;
#pragma unroll
    for (int j = 0; j < 4; ++j) { const int n = (lane >> 3) + 8 * j; const LAS float* sp = scr + (8 * c) * 33 + n;
        u32x4 o; o.x = f2bf(sp[0 * 33]) | (f2bf(sp[1 * 33]) << 16); o.y = f2bf(sp[2 * 33]) | (f2bf(sp[3 * 33]) << 16); o.z = f2bf(sp[4 * 33]) | (f2bf(sp[5 * 33]) << 16); o.w = f2bf(sp[6 * 33]) | (f2bf(sp[7 * 33]) << 16);
        *(u32x4*)(WT + (size_t)(n0 + n) * K + k0 + 8 * c) = o; }
    asm volatile("s_waitcnt lgkmcnt(0)" ::: "memory");
}
__device__ __forceinline__ bool transpose_group(int& r, const float* W, int nmat, int K, int N, bf16* WT, LAS float* scr, int lane) {
    const int per = (K / 64) * (N / 32), tot = nmat * per;
    if (r >= tot) { r -= tot; return false; }
    const int mi = r / per; transpose_item(W + (size_t)mi * K * N, K, N, WT + (size_t)mi * K * N, scr, r % per, lane); return true;
}
__device__ __forceinline__ void phase_prologue(Frame& F) {
    F.fresh();
    LAS float* sc = (LAS float*)F.lds;
    const float* c = F.in[I_C]; const float* cctx = F.in[I_CCTX];
    for (int i = F.tid; i < 3 * D; i += NT) { const int ci = i >> 10, k = i & 1023; const float v = ci == 0 ? cctx[k] : c[(ci - 1) * D + k]; sc[i] = siluf_(v); }
    __syncthreads();
    LAS float* part = sc + 3 * D;
    const int kp = F.tid >> 6, cl = F.tid & 63;
    for (int item = F.bid; item < DEPTH * 6 * D / 64; item += F.G) {
        const int col = item * 64 + cl, l = col / (6 * D), cc = col % (6 * D);
        const float* w = F.in[I_WMOD] + (size_t)l * D * 6 * D + cc;
        float s0 = 0.f, s1 = 0.f, s2 = 0.f;
        for (int k = kp * 128; k < kp * 128 + 128; ++k) { const float wv = w[(size_t)k * 6 * D]; s0 += sc[k] * wv; s1 += sc[D + k] * wv; s2 += sc[2 * D + k] * wv; }
        part[(kp * 3 + 0) * 64 + cl] = s0; part[(kp * 3 + 1) * 64 + cl] = s1; part[(kp * 3 + 2) * 64 + cl] = s2;
        __syncthreads();
        if (F.tid < 192) { const int ci = F.tid >> 6; float s = F.in[I_BMOD][l * 6 * D + cc];
            for (int q = 0; q < 8; ++q) s += part[(q * 3 + ci) * 64 + cl];
            F.mod[(size_t)((l * 3 + ci) * 6) * D + cc] = s; }
        __syncthreads();
    }
    { __syncthreads();
      LAS float* scr = (LAS float*)(F.lds + F.wave * 16384);
      const int gw = F.bid * NWAVES + F.wave, NGW = F.G * NWAVES;
      constexpr int NITEMS = (int)(WE_END / 2048);
      for (int it = gw; it < NITEMS; it += NGW) { int r = it;
          if (transpose_group(r, F.in[I_FF_WUP], 4, D, 2 * DFF, F.WT + WE_UP, scr, F.lane)) continue;
          if (transpose_group(r, F.in[I_FF_WDN], 4, DFF, D, F.WT + WE_DN, scr, F.lane)) continue;
          if (transpose_group(r, F.in[I_LRU_WIN], 2, D, 2 * DRNN, F.WT + WE_LRU_IN, scr, F.lane)) continue;
          if (transpose_group(r, F.in[I_LRU_WOUT], 2, DRNN, D, F.WT + WE_LRU_OUT, scr, F.lane)) continue;
          if (transpose_group(r, F.in[I_CM_WIN], 1, D, 2 * DB, F.WT + WE_CM_IN, scr, F.lane)) continue;
          if (transpose_group(r, F.in[I_CM_WOUT], 1, DB, D, F.WT + WE_CM_OUT, scr, F.lane)) continue;
          if (transpose_group(r, F.in[I_AT_WQKV], 1, D, 3 * D, F.WT + WE_QKV, scr, F.lane)) continue;
          if (transpose_group(r, F.in[I_AT_WOUT], 1, D, D, F.WT + WE_AT_OUT, scr, F.lane)) continue;
          transpose_group(r, F.in[I_LRU_WG], 80, 128, 128, F.WT + WE_WG, scr, F.lane); } }
    const int gt = F.bid * NT + F.tid, GT = F.G * NT;
    for (int i = gt; i < 1024 * 32; i += GT) { const int t = i >> 5, j = i & 31; const float inv = powf(10000.f, -(float)(j & 15) / 16.f); const float pos = (float)(j < 16 ? (t >> 6) : (t & 63));
        const float ang = pos * inv; F.rope[i] = cosf(ang); F.rope[32768 + i] = sinf(ang); }
    for (int i = gt; i < 2 * PAST * D; i += GT) { const int b = i / (PAST * D), r = i % (PAST * D);
        F.KS[(size_t)b * TKS * D + r] = (bf16)f2bf(F.in[I_CK][i]); F.VS[(size_t)b * TKS * D + r] = (bf16)f2bf(F.in[I_CV][i]); }
}

__device__ __forceinline__ void phase_modulate(Frame& F, int l, int sub) {
    F.fresh();
    const int gw = F.bid * NWAVES + F.wave, NGW = F.G * NWAVES;
    const float* g = F.in[I_NORMG] + (size_t)(l * 2 + sub) * D;
    for (int row = gw; row < M; row += NGW) {
        const float* xr = (l == 0 && sub == 0) ? xin_row(F, row) : F.out + (size_t)row * D;
        const float* sh = modp(F, l, row, sub * 3 + 0); const float* scl = modp(F, l, row, sub * 3 + 1);
        f32x4 v[4]; float s = 0.f;
#pragma unroll
        for (int j = 0; j < 4; ++j) { v[j] = *(const f32x4*)(xr + 4 * F.lane + 256 * j); s += v[j].x * v[j].x + v[j].y * v[j].y + v[j].z * v[j].z + v[j].w * v[j].w; }
        const float rstd = rsqrtf(wave_sum(s) * (1.f / D) + EPS);
#pragma unroll
        for (int j = 0; j < 4; ++j) { const int c0 = 4 * F.lane + 256 * j; const f32x4 gg = *(const f32x4*)(g + c0), s4 = *(const f32x4*)(sh + c0), c4 = *(const f32x4*)(scl + c0);
            const f32x4 o = v[j] * rstd * gg * (1.f + c4) + s4; u32x2 w; w.x = f2bf(o.x) | (f2bf(o.y) << 16); w.y = f2bf(o.z) | (f2bf(o.w) << 16);
            *(u32x2*)(F.H + (size_t)row * D + c0) = w; }
    }
}

template <class P>
__device__ __forceinline__ void gemm_naive(Frame& F, const P& p, int nbatch, int Mr, int N, int K) {
    F.fresh();
    LAS float* As = (LAS float*)F.lds;
    LAS float* Bs = As + 16 * 132;
    const int tid = F.tid, tx = tid & 31, ty = tid >> 5;
    const int tm = Mr / 128, tn = N / 128, per = tm * tn, total = per * nbatch;
    for (int t = F.bid; t < total; t += F.G) {
        const int b = t / per, r = t % per, pn = r / tm, pm = r % tm;
        const bf16* A; int lda; const float* W; int ldw; p.get(b, A, lda, W, ldw);
        float acc[8][4];
#pragma unroll
        for (int i = 0; i < 8; ++i)
#pragma unroll
            for (int j = 0; j < 4; ++j) acc[i][j] = 0.f;
        for (int k0 = 0; k0 < K; k0 += 16) {
            { const int row = tid >> 2, kq = (tid & 3) * 4;
              const u32x2 v = *(const u32x2*)(A + (size_t)(pm * 128 + row) * lda + k0 + kq);
              As[(kq + 0) * 132 + row] = bf2f(v.x); As[(kq + 1) * 132 + row] = bf2f(v.x >> 16); As[(kq + 2) * 132 + row] = bf2f(v.y); As[(kq + 3) * 132 + row] = bf2f(v.y >> 16); }
            { const int k = tid >> 5, n4 = (tid & 31) * 4;
              *(LAS f32x4*)(Bs + k * 128 + n4) = *(const f32x4*)(W + (size_t)(k0 + k) * ldw + pn * 128 + n4); }
            __syncthreads();
#pragma unroll 2
            for (int k = 0; k < 16; ++k) {
                const f32x4 a0 = *(const LAS f32x4*)(As + k * 132 + ty * 8), a1 = *(const LAS f32x4*)(As + k * 132 + ty * 8 + 4), bv = *(const LAS f32x4*)(Bs + k * 128 + tx * 4);
                const float a[8] = {a0.x, a0.y, a0.z, a0.w, a1.x, a1.y, a1.z, a1.w}; const float bb[4] = {bv.x, bv.y, bv.z, bv.w};
#pragma unroll
                for (int i = 0; i < 8; ++i)
#pragma unroll
                    for (int j = 0; j < 4; ++j) acc[i][j] += a[i] * bb[j];
            }
            __syncthreads();
        }
#pragma unroll
        for (int i = 0; i < 8; ++i)
#pragma unroll
            for (int j = 0; j < 4; ++j) p.epi(b, pm * 128 + ty * 8 + i, pn * 128 + tx * 4 + j, acc[i][j]);
    }
}

struct PStoreBf16 {
    const bf16* A; int lda; const float* W; int ldw; bf16* O; int ldo; const float* bias; int act; int split;
    __device__ __forceinline__ void get(int, const bf16*& a, int& la, const float*& w, int& lw) const { a = A; la = lda; w = W; lw = ldw; }
    __device__ __forceinline__ void epi(int, int row, int col, float v) const {
        if (bias) v += bias[col];
        if (act == 1 || (act == 2 && col < split)) v = gelu_tanh(v);
        O[(size_t)row * ldo + col] = (bf16)f2bf(v); }
};
struct PResid {
    const bf16* A; int lda; const float* W; int ldw; float* out; const float* xp; const float* xs; const float* modl; int which; bool from_input;
    __device__ __forceinline__ void get(int, const bf16*& a, int& la, const float*& w, int& lw) const { a = A; la = lda; w = W; lw = ldw; }
    __device__ __forceinline__ void epi(int, int row, int col, float v) const {
        const float base = from_input ? (row < NPROMPT ? xp[(size_t)row * D + col] : xs[(size_t)(row - NPROMPT) * D + col]) : out[(size_t)row * D + col];
        out[(size_t)row * D + col] = base + modl[(size_t)(cidx_of(row) * 6 + which) * D + col] * v; }
};
struct PLruIn {
    const bf16* A; const float* W; bf16* GBp; bf16* RECp;
    __device__ __forceinline__ void get(int, const bf16*& a, int& la, const float*& w, int& lw) const { a = A; la = D; w = W; lw = 2 * DRNN; }
    __device__ __forceinline__ void epi(int, int row, int col, float v) const {
        if (col < DRNN) GBp[(size_t)row * DRNN + col] = (bf16)f2bf(gelu_tanh(v)); else RECp[(size_t)row * DRNN + col - DRNN] = (bf16)f2bf(v); }
};
struct PGates {
    const bf16* XC; const float* WG; const float* BG; bf16* O;
    __device__ __forceinline__ void get(int b, const bf16*& a, int& la, const float*& w, int& lw) const { a = XC + (b % 10) * 128; la = DRNN; w = WG + (size_t)b * 128 * 128; lw = 128; }
    __device__ __forceinline__ void epi(int b, int row, int col, float v) const { const int dg = b / 10, n = b % 10;
        O[((size_t)dg * M + row) * DRNN + n * 128 + col] = (bf16)f2bf(sigmoidf_(v + BG[dg * DRNN + n * 128 + col])); }
};

__device__ __forceinline__ void phase_lru_conv(Frame& F, int j, const bf16* REC, bf16* XC) {
    F.fresh();
    const float* cw = F.in[I_LRU_CW] + (size_t)j * 4 * DRNN; const float* cb = F.in[I_LRU_CB] + (size_t)j * DRNN;
    const int gt = F.bid * NT + F.tid, GT = F.G * NT;
    for (int i = gt; i < M * DRNN; i += GT) { const int row = i / DRNN, ch = i % DRNN;
        int t, T; if (row < NPROMPT) { t = row & 255; T = 256; } else { t = (row - NPROMPT) & 1023; T = 1024; }
        float s = cb[ch];
#pragma unroll
        for (int k = 0; k < 4; ++k) { const int tt = t + k - 2; if (tt >= 0 && tt < T) s += cw[k * DRNN + ch] * bf2f(REC[(size_t)(row + k - 2) * DRNN + ch]); }
        XC[i] = (bf16)f2bf(s); }
}
__device__ __forceinline__ void phase_lru_scan(Frame& F, int j, const bf16* GATES, const bf16* XC, const bf16* GB, bf16* HS) {
    F.fresh();
    const int gt = F.bid * NT + F.tid, GT = F.G * NT;
    const int NL = (2 + 32) * DRNN;
    for (int line = gt; line < NL; line += GT) {
        const int s = line / DRNN, ch = line % DRNN;
        int base, T; float h0f = 0.f, h0b = 0.f;
        if (s < 2) { base = NPROMPT + s * 1024; T = 1024; h0f = F.in[I_STATE][((size_t)(s * 2 + j) * 2 + 0) * DRNN + ch]; h0b = F.in[I_STATE][((size_t)(s * 2 + j) * 2 + 1) * DRNN + ch]; }
        else { base = (s - 2) * 256; T = 256; }
        const float spf = softplusf_(-F.in[I_LRU_LAM][(size_t)(j * 2 + 0) * DRNN + ch]), spb = softplusf_(-F.in[I_LRU_LAM][(size_t)(j * 2 + 1) * DRNN + ch]);
        float h = h0f;
        for (int t = 0; t < T; ++t) { const size_t o = (size_t)(base + t) * DRNN + ch;
            const float r = bf2f(GATES[o]), ig = bf2f(GATES[(size_t)M * DRNN + o]), xc = bf2f(XC[o]);
            const float la = -8.f * r * spf, a = expf(la), bx = sqrtf(-expm1f(2.f * la)) * (ig * xc);
            h = a * h + bx; HS[o] = (bf16)f2bf(h); }
        const float ff = h;
        h = h0b;
        for (int t = T - 1; t >= 0; --t) { const size_t o = (size_t)(base + t) * DRNN + ch;
            const float r = bf2f(GATES[(size_t)2 * M * DRNN + o]), ig = bf2f(GATES[(size_t)3 * M * DRNN + o]), xc = bf2f(XC[o]);
            const float la = -8.f * r * spb, a = expf(la), bx = sqrtf(-expm1f(2.f * la)) * (ig * xc);
            h = a * h + bx; HS[o] = (bf16)f2bf(bf2f(GB[o]) * (bf2f(HS[o]) + h)); }
        if (s >= 2) { float* st = F.out + O_STATE + ((size_t)((s - 2) * 2 + j) * 2) * DRNN; st[ch] = ff; st[DRNN + ch] = h; }
    }
}


typedef short bf16x8 __attribute__((ext_vector_type(8)));
constexpr int LRU_XS = 272;
constexpr int LRU_XC_OFF = 0, LRU_GB_OFF = 256 * LRU_XS;
template <bool REV>
__device__ __forceinline__ float lru_dir(LAS const unsigned char* xct, LAS unsigned char* hft, const bf16* wgt  ,
                                         const bf16* gbp  , float br, float bi, float sp, float hc, int wave, int lane, bool wantp, bf16* Pdst) {
    const int c = lane & 15, q = lane >> 4, qq = REV ? 3 - q : q;
    bf16x8 Br[4], Bi[4], Id;
#pragma unroll
    for (int ks = 0; ks < 4; ++ks) { Br[ks] = *(const GAS bf16x8*)(wgt + (size_t)(16 * wave + c) * 128 + 32 * ks + 8 * q);
                                     Bi[ks] = *(const GAS bf16x8*)(wgt + (size_t)10 * 128 * 128 + (size_t)(16 * wave + c) * 128 + 32 * ks + 8 * q); }
#pragma unroll
    for (int jj = 0; jj < 8; ++jj) Id[jj] = (8 * q + jj == 16 * (wave & 1) + c) ? (short)0x3F80 : (short)0;
    const int ksel = wave >> 1;
    float Pc = 1.f;
#pragma unroll 2
    for (int it = 0; it < 16; ++it) {
        const int mi = REV ? 15 - it : it;
        LAS const unsigned char* rp = xct + (16 * mi + c) * LRU_XS + 16 * q;
        float gbv[4];
        if (REV) {
#pragma unroll
            for (int k = 0; k < 4; ++k) gbv[k] = bf2f(*(const GAS unsigned short*)(gbp + (size_t)(16 * mi + 4 * q + k) * DRNN)); }
        bf16x8 Af[4];
#pragma unroll
        for (int ks = 0; ks < 4; ++ks) Af[ks] = *(LAS const bf16x8*)(rp + 64 * ks);
        const bf16x8 Ax = *(LAS const bf16x8*)(rp + 64 * ksel);
        f32x4 r = {0.f, 0.f, 0.f, 0.f}, ig = {0.f, 0.f, 0.f, 0.f};
#pragma unroll
        for (int ks = 0; ks < 4; ++ks) { r = __builtin_amdgcn_mfma_f32_16x16x32_bf16(Af[ks], Br[ks], r, 0, 0, 0); ig = __builtin_amdgcn_mfma_f32_16x16x32_bf16(Af[ks], Bi[ks], ig, 0, 0, 0); }
        const f32x4 xc = __builtin_amdgcn_mfma_f32_16x16x32_bf16(Ax, Id, (f32x4){0.f, 0.f, 0.f, 0.f}, 0, 0, 0);
        float av[4], bv[4];
#pragma unroll
        for (int k = 0; k < 4; ++k) { const float rg = sigmoidf_(r[k] + br), iv = sigmoidf_(ig[k] + bi);
            const float la = -8.f * rg * sp, x = 2.f * la;
            const float oms = -x * (1.f + x * (0.5f + x * (0.16666667f + x * (0.041666668f + x * 0.0083333338f))));
            const float om = x > -0.25f ? oms : 1.f - __expf(x);
            av[k] = __expf(la); bv[k] = sqrtf(om) * (iv * xc[k]); }
        float pA[4], pB[4];
#pragma unroll
        for (int kk = 0; kk < 4; ++kk) { const int k = REV ? 3 - kk : kk;
            if (kk == 0) { pA[k] = av[k]; pB[k] = bv[k]; } else { const int kp = REV ? k + 1 : k - 1; pA[k] = pA[kp] * av[k]; pB[k] = pB[kp] * av[k] + bv[k]; } }
        const int kl = REV ? 0 : 3;
        float gA = pA[kl], gB = pB[kl];
        { const float tA = REV ? __shfl_down(gA, 16) : __shfl_up(gA, 16), tB = REV ? __shfl_down(gB, 16) : __shfl_up(gB, 16); if (qq >= 1) { gB = tB * gA + gB; gA = tA * gA; } }
        { const float tA = REV ? __shfl_down(gA, 32) : __shfl_up(gA, 32), tB = REV ? __shfl_down(gB, 32) : __shfl_up(gB, 32); if (qq >= 2) { gB = tB * gA + gB; gA = tA * gA; } }
        float eA = REV ? __shfl_down(gA, 16) : __shfl_up(gA, 16), eB = REV ? __shfl_down(gB, 16) : __shfl_up(gB, 16); if (qq == 0) { eA = 1.f; eB = 0.f; }
        const int src = (REV ? 0 : 48) + c;
        const float totA = __shfl(gA, src), totB = __shfl(gB, src);
        const float hin = eA * hc + eB;
#pragma unroll
        for (int k = 0; k < 4; ++k) { const float h = pA[k] * hin + pB[k]; const int row = 16 * mi + 4 * q + k;
            if (wantp) Pdst[(size_t)row * DRNN] = (bf16)f2bf(pA[k] * eA * Pc);
            LAS unsigned short* hp = (LAS unsigned short*)(hft + row * LRU_XS + 2 * (16 * wave + c));
            if (!REV) *hp = (unsigned short)f2bf(h); else *hp = (unsigned short)f2bf(gbv[k] * (bf2f(*hp) + h)); }
        hc = totA * hc + totB; Pc *= totA;
    }
    return hc;
}
__device__ __forceinline__ void lru_unit(Frame& F, int j, int pm, int n, const bf16* REC, const bf16* GB, bf16* HS, bf16* PF, bf16* PB, float* AGG, const bf16* WGT) {
    const int tid = F.tid, lane = F.lane, wave = F.wave, r0 = 256 * pm;
    const bool smp = pm >= 32; const int tix = smp ? (pm - 32) & 3 : 0, sq = smp ? (pm - 32) >> 2 : 0;
    const int t0 = smp ? 256 * tix : 0, T = smp ? 1024 : 256;
    LAS unsigned char* xct = F.lds + LRU_XC_OFF; LAS unsigned char* hft = F.lds + LRU_GB_OFF;
    { const float* cw = F.in[I_LRU_CW] + (size_t)j * 4 * DRNN + n * 128 + 2 * lane; const float* cb = F.in[I_LRU_CB] + (size_t)j * DRNN + n * 128 + 2 * lane;
      float w0[4], w1[4];
#pragma unroll
      for (int k = 0; k < 4; ++k) { w0[k] = cw[k * DRNN]; w1[k] = cw[k * DRNN + 1]; }
      const float b0 = cb[0], b1 = cb[1];
      unsigned v[35];
#pragma unroll
      for (int i = 0; i < 35; ++i) { const int tl = 32 * wave + i - 2, tt = t0 + tl;
          v[i] = (tt >= 0 && tt < T) ? *(const GAS unsigned*)(REC + (size_t)(r0 + tl) * DRNN + n * 128 + 2 * lane) : 0u; }
#pragma unroll
      for (int i = 0; i < 32; ++i) { float s0 = b0, s1 = b1;
#pragma unroll
          for (int k = 0; k < 4; ++k) { s0 += w0[k] * bf2f(v[i + k]); s1 += w1[k] * bf2f(v[i + k] >> 16); }
          *(LAS unsigned*)(xct + (32 * wave + i) * LRU_XS + 4 * lane) = f2bf(s0) | (f2bf(s1) << 16); } }
    __syncthreads();
    const int c = lane & 15, q = lane >> 4, ch = n * 128 + 16 * wave + c;
    const float* bg = F.in[I_LRU_BG] + (size_t)j * 4 * DRNN; const float* lam = F.in[I_LRU_LAM] + (size_t)j * 2 * DRNN;
    const bf16* gbp = GB + (size_t)r0 * DRNN + ch;
    bf16* pf = PF + (size_t)(smp ? r0 - NPROMPT : 0) * DRNN + ch; bf16* pb = PB + (size_t)(smp ? r0 - NPROMPT : 0) * DRNN + ch;
    { float h0 = 0.f; if (smp && tix == 0) h0 = F.in[I_STATE][((size_t)(sq * 2 + j) * 2 + 0) * DRNN + ch];
      const float hfin = lru_dir<false>(xct, hft, WGT + (size_t)(0 * 10 + n) * 128 * 128, gbp, bg[0 * DRNN + ch], bg[1 * DRNN + ch], softplusf_(-lam[ch]), h0, wave, lane, smp, pf);
      if (q == 0) { if (smp) AGG[(size_t)((sq * 4 + tix) * 2 + 0) * DRNN + ch] = hfin; else F.out[O_STATE + ((size_t)(pm * 2 + j) * 2 + 0) * DRNN + ch] = hfin; } }
    { float h0 = 0.f; if (smp && tix == 3) h0 = F.in[I_STATE][((size_t)(sq * 2 + j) * 2 + 1) * DRNN + ch];
      const float hfin = lru_dir<true>(xct, hft, WGT + (size_t)(2 * 10 + n) * 128 * 128, gbp, bg[2 * DRNN + ch], bg[3 * DRNN + ch], softplusf_(-lam[DRNN + ch]), h0, wave, lane, smp, pb);
      if (q == 0) { if (smp) AGG[(size_t)((sq * 4 + tix) * 2 + 1) * DRNN + ch] = hfin; else F.out[O_STATE + ((size_t)(pm * 2 + j) * 2 + 1) * DRNN + ch] = hfin; } }
    __syncthreads();
#pragma unroll
    for (int i = 0; i < 8; ++i) { const int id = i * NT + tid, row = id >> 4, cc = id & 15;
        *(GAS u32x4*)(HS + (size_t)(r0 + row) * DRNN + n * 128 + 8 * cc) = *(LAS const u32x4*)(hft + row * LRU_XS + 16 * cc); }
    __syncthreads();
}
__device__ __forceinline__ void phase_lru_core(Frame& F, int j, const bf16* REC, const bf16* GB, bf16* HS, bf16* PF, bf16* PB, float* AGG, const bf16* WGT) {
    F.fresh();
    for (int u = F.bid; u < 400; u += F.G) {
        const int pm = u < 80 ? 32 + u / 10 : (u - 80) / 10, n = u % 10;
        lru_unit(F, j, pm, n, REC, GB, HS, PF, PB, AGG, WGT); }
}
__device__ __forceinline__ void phase_lru_fixup(Frame& F, const bf16* GB, bf16* HS, const bf16* PF, const bf16* PB, const float* AGG) {
    F.fresh();
    const int gt = F.bid * NT + F.tid, GT = F.G * NT;
    for (int i = gt; i < NSAMPLE * DRNN; i += GT) { const int rs = i / DRNN, ch = i % DRNN, sq = rs >> 10, tix = (rs >> 8) & 3;
        float cf = 0.f, cbk = 0.f;
        if (tix > 0) { for (int t = 0; t < tix; ++t) { const float At = bf2f(PF[(size_t)(sq * 1024 + t * 256 + 255) * DRNN + ch]); cf = At * cf + AGG[(size_t)((sq * 4 + t) * 2 + 0) * DRNN + ch]; } }
        if (tix < 3) { for (int t = 3; t > tix; --t) { const float At = bf2f(PB[(size_t)(sq * 1024 + t * 256) * DRNN + ch]); cbk = At * cbk + AGG[(size_t)((sq * 4 + t) * 2 + 1) * DRNN + ch]; } }
        const size_t o = (size_t)(NPROMPT + rs) * DRNN + ch;
        HS[o] = (bf16)f2bf(bf2f(HS[o]) + bf2f(GB[o]) * (bf2f(PF[(size_t)rs * DRNN + ch]) * cf + bf2f(PB[(size_t)rs * DRNN + ch]) * cbk)); }
}

__device__ __forceinline__ void phase_cmlp_rstd(Frame& F, const bf16* UV) {
    F.fresh();
    const int gw = F.bid * NWAVES + F.wave, NGW = F.G * NWAVES;
    for (int row = gw; row < M; row += NGW) { float s = 0.f;
        for (int c = F.lane; c < DB; c += 64) { const float v = bf2f(UV[(size_t)row * 2 * DB + DB + c]); s += v * v; }
        s = wave_sum(s); if (F.lane == 0) F.rstd[row] = rsqrtf(s * (1.f / DB) + EPS); }
}
__device__ __forceinline__ void phase_cmlp_spatial(Frame& F, const bf16* UV, bf16* ACT) {
    F.fresh();
    const float* ws = F.in[I_CM_WS]; const float* bs = F.in[I_CM_BS]; const float* ng = F.in[I_CM_NG];
    const int gt = F.bid * NT + F.tid, GT = F.G * NT;
    for (int i = gt; i < M * DB; i += GT) { const int row = i / DB, ch = i % DB, g = ch >> 8, p = row & 127, r0 = row & ~127;
        float s = 0.f;
        for (int q = 0; q < 128; ++q) s += ws[(size_t)(g * 128 + p) * 128 + q] * F.rstd[r0 + q] * bf2f(UV[(size_t)(r0 + q) * 2 * DB + DB + ch]);
        const float sv = s * ng[ch] + bs[g * 128 + p];
        ACT[i] = (bf16)f2bf(bf2f(UV[(size_t)row * 2 * DB + ch]) * sv); }
}

__device__ __forceinline__ void phase_qkv_post(Frame& F, const bf16* QKV, bf16* Q, bf16* KP, bf16* VP) {
    F.fresh();
    const int gw = F.bid * NWAVES + F.wave, NGW = F.G * NWAVES;
    const float* qkg = F.in[I_AT_QKG];
    for (int row = gw; row < M; row += NGW) {
        const bool smp = row >= NPROMPT; const int sb = smp ? (row - NPROMPT) >> 10 : 0, t = smp ? (row - NPROMPT) & 1023 : 0;
        const float cs = smp ? F.rope[t * 32 + (F.lane & 31)] : 1.f, sn = smp ? F.rope[32768 + t * 32 + (F.lane & 31)] : 0.f;
        for (int grp = 0; grp < 32; ++grp) {
            const float v = bf2f(QKV[(size_t)row * 3072 + grp * 64 + F.lane]);
            const float ms = wave_sum(v * v) * (1.f / 64.f);
            float n = v * rsqrtf(ms + EPS) * qkg[(grp >> 4) * 64 + F.lane];
            const float keep = n;
            if (smp) { const float pr = __shfl_xor(n, 32); n = F.lane < 32 ? n * cs - pr * sn : n * cs + pr * sn; }
            if (grp < 16) Q[(size_t)row * D + grp * 64 + F.lane] = (bf16)f2bf(n);
            else { const int c = (grp - 16) * 64 + F.lane;
                if (smp) F.KS[((size_t)sb * TKS + PAST + t) * D + c] = (bf16)f2bf(n);
                else { KP[(size_t)row * D + c] = (bf16)f2bf(keep); F.out[O_CK + (size_t)row * D + c] = keep; } }
        }
        for (int c = F.lane; c < D; c += 64) { const bf16 vb = QKV[(size_t)row * 3072 + 2048 + c];
            if (smp) F.VS[((size_t)sb * TKS + PAST + t) * D + c] = vb; else { VP[(size_t)row * D + c] = vb; F.out[O_CV + (size_t)row * D + c] = bf2f(vb); } }
    }
}
__device__ __forceinline__ void phase_attn_naive(Frame& F, int l, const bf16* Q, const bf16* KP, const bf16* VP, bf16* O) {
    F.fresh();
    const int gw = F.bid * NWAVES + F.wave, NGW = F.G * NWAVES;
    LAS float* s1 = (LAS float*)F.lds + F.wave * 3328; LAS float* s2 = s1 + 1536; LAS float* qs = s2 + 1536;
    const float* al = F.in[I_AT_LAM];
    const float lam_init = 0.8f - 0.6f * expf(-0.3f * (float)l);
    const float lam = expf(wave_sum(al[F.lane] * al[64 + F.lane])) - expf(wave_sum(al[128 + F.lane] * al[192 + F.lane])) + lam_init;
    const float* sg = F.in[I_AT_SUBG];
    for (int item = gw; item < M * 8; item += NGW) {
        const int row = item >> 3, h = item & 7;
        const bf16 *Kb, *Vb; int Tk;
        if (row < NPROMPT) { Kb = KP + (size_t)(row & ~255) * D; Vb = VP + (size_t)(row & ~255) * D; Tk = 256; }
        else { const int sb = (row - NPROMPT) >> 10; Kb = F.KS + (size_t)sb * TKS * D; Vb = F.VS + (size_t)sb * TKS * D; Tk = TKS; }
        qs[F.lane] = bf2f(Q[(size_t)row * D + h * 128 + F.lane]); qs[64 + F.lane] = bf2f(Q[(size_t)row * D + h * 128 + 64 + F.lane]);
        asm volatile("s_waitcnt lgkmcnt(0)" ::: "memory");
        float m1 = -1e30f, m2 = -1e30f;
        for (int k = F.lane; k < Tk; k += 64) { const bf16* kr = Kb + (size_t)k * D + h * 128; float d1 = 0.f, d2 = 0.f;
#pragma unroll 4
            for (int d = 0; d < 64; d += 2) { const unsigned a = *(const unsigned*)(kr + d), b = *(const unsigned*)(kr + 64 + d);
                d1 += qs[d] * bf2f(a) + qs[d + 1] * bf2f(a >> 16); d2 += qs[64 + d] * bf2f(b) + qs[64 + d + 1] * bf2f(b >> 16); }
            d1 *= 0.125f; d2 *= 0.125f; s1[k] = d1; s2[k] = d2; m1 = fmaxf(m1, d1); m2 = fmaxf(m2, d2); }
        m1 = wave_max(m1); m2 = wave_max(m2);
        float l1 = 0.f, l2 = 0.f;
        for (int k = F.lane; k < Tk; k += 64) { const float e1 = expf(s1[k] - m1), e2 = expf(s2[k] - m2); s1[k] = e1; s2[k] = e2; l1 += e1; l2 += e2; }
        l1 = wave_sum(l1); l2 = wave_sum(l2);
        const float i1 = 1.f / l1, i2 = lam / l2;
        for (int k = F.lane; k < Tk; k += 64) s1[k] = bf2f(f2bf(s1[k] * i1 - s2[k] * i2));
        asm volatile("s_waitcnt lgkmcnt(0)" ::: "memory");
        float o0 = 0.f, o1 = 0.f;
        for (int k = 0; k < Tk; ++k) { const unsigned vv = *(const unsigned*)(Vb + (size_t)k * D + h * 128 + 2 * F.lane); const float w = s1[k]; o0 += w * bf2f(vv); o1 += w * bf2f(vv >> 16); }
        const float ms = wave_sum(o0 * o0 + o1 * o1) * (1.f / 128.f), rs = rsqrtf(ms + EPS) * (1.f - lam_init);
        o0 = o0 * rs * sg[2 * F.lane]; o1 = o1 * rs * sg[2 * F.lane + 1];
        *(unsigned*)(O + (size_t)row * D + h * 128 + 2 * F.lane) = f2bf(o0) | (f2bf(o1) << 16);
        asm volatile("s_waitcnt lgkmcnt(0)" ::: "memory");
    }
}

__device__ __forceinline__ void phase_ffn_convgate(Frame& F, int l, const bf16* Z, bf16* ACT) {
    F.fresh();
    const float* cw = F.in[I_FF_CW] + (size_t)l * 3 * 2 * DFF; const float* cb = F.in[I_FF_CB] + (size_t)l * 2 * DFF;
    const int gt = F.bid * NT + F.tid, GT = F.G * NT;
    for (int i = gt; i < M * DFF; i += GT) { const int row = i / DFF, j = i % DFF;
        int t, T; if (row < NPROMPT) { t = row & 255; T = 256; } else { t = (row - NPROMPT) & 1023; T = 1024; }
        float g = cb[j], u = cb[DFF + j];
#pragma unroll
        for (int k = 0; k < 3; ++k) { const int tt = t + k - 1; if (tt >= 0 && tt < T) { const bf16* zr = Z + (size_t)(row + k - 1) * 2 * DFF; g += cw[k * 2 * DFF + j] * bf2f(zr[j]); u += cw[k * 2 * DFF + DFF + j] * bf2f(zr[DFF + j]); } }
        ACT[i] = (bf16)f2bf(siluf_(g) * u); }
}

constexpr int LDS_BYTES = 163840;
constexpr int MISC_OFF = LDS_BYTES - 256;
__global__ void __launch_bounds__(NT, 2) mk_fwd(Params prm) {
    extern __shared__ __attribute__((aligned(16))) unsigned char lds_raw[];
    Frame F;
    F.lds = (LAS unsigned char*)lds_raw; F.G = gridDim.x; F.in = prm.in; F.out0 = prm.out; F.ws0 = prm.ws;
    F.fresh();
    volatile LAS unsigned* MISC = (volatile LAS unsigned*)(F.lds + MISC_OFF);
    if (F.tid < 32) MISC[F.tid] = 0u;
    __syncthreads();
    XcdBarrier bar = xcd_barrier_post((unsigned*)(prm.ws + WS_CTL) + CW_BAR, MISC + 8);
#define GRID_BAR() xcd_barrier(bar)

#define GEMM_BF16(ACT, A_, Bt_, N_, K_, O_, ldc_, bias_, splitc_, splits_) do { pg8::Gemm g{A_, Bt_, M, N_, K_}; pg8::StaticOrder S; S.init(M, N_, F.G, F.bid); \
        pg8::EpiBf16<ACT> E{O_, ldc_, bias_, splitc_, splits_}; pg8::gemm_phase<pg8::EpiBf16<ACT>, pg8::StaticOrder, true, true>(F.lds, g, S, E); } while (0)
#define GEMM_RESID(A_, Bt_, K_, which_, fromin_) do { pg8::Gemm g{A_, Bt_, M, D, K_}; pg8::StaticOrder S; S.init(M, D, F.G, F.bid); \
        pg8::EpiResid E{F.out, F.in[I_XP], F.in[I_XS], F.mod + (size_t)l * 18 * D, which_, fromin_}; pg8::gemm_phase<pg8::EpiResid, pg8::StaticOrder, true, true>(F.lds, g, S, E); } while (0)

    phase_prologue(F);
    GRID_BAR();
#pragma unroll 1
    for (int l = 0; l < DEPTH; ++l) {
        const int kind = l % 3, j = l / 3;
        phase_modulate(F, l, 0);
        F.fresh();
        GRID_BAR();
        if (kind == 0) {
            bf16 *GB = F.T2, *REC = F.T2 + (size_t)M * DRNN, *PF = F.T3, *PB = F.T3 + (size_t)NSAMPLE * DRNN, *HS = F.T3 + (size_t)6 * 1024 * 1024;
            float* AGG = (float*)(F.T3 + (size_t)2 * NSAMPLE * DRNN);
            GEMM_BF16(2, F.H, F.WT + WE_LRU_IN + (size_t)j * 2 * DRNN * D, 2 * DRNN, D, GB, DRNN, nullptr, DRNN, (size_t)M * DRNN);
            GRID_BAR();
            phase_lru_core(F, j, REC, GB, HS, PF, PB, AGG, F.WT + WE_WG + (size_t)j * 40 * 128 * 128);
            GRID_BAR();
            phase_lru_fixup(F, GB, HS, PF, PB, AGG);
            GRID_BAR();
            GEMM_RESID(HS, F.WT + WE_LRU_OUT + (size_t)j * D * DRNN, DRNN, 2, l == 0);
        } else if (kind == 1) {
            bf16 *UV = F.T1, *ACT = F.T2;
            GEMM_BF16(1, F.H, F.WT + WE_CM_IN, 2 * DB, D, UV, 2 * DB, F.in[I_CM_BIN], 0, 0);
            GRID_BAR();
            phase_cmlp_rstd(F, UV);
            GRID_BAR();
            phase_cmlp_spatial(F, UV, ACT);
            GRID_BAR();
            GEMM_RESID(ACT, F.WT + WE_CM_OUT, DB, 2, false);
        } else {
            bf16 *QKV = F.T1, *Q = F.T2, *KP = F.T2 + (size_t)M * D, *VP = KP + (size_t)NPROMPT * D, *O = F.T3;
            GEMM_BF16(0, F.H, F.WT + WE_QKV, 3 * D, D, QKV, 3 * D, nullptr, 0, 0);
            GRID_BAR();
            phase_qkv_post(F, QKV, Q, KP, VP);
            GRID_BAR();
            phase_attn_naive(F, l, Q, KP, VP, O);
            GRID_BAR();
            GEMM_RESID(O, F.WT + WE_AT_OUT, D, 2, false);
        }
        GRID_BAR();
        phase_modulate(F, l, 1);
        GRID_BAR();
        GEMM_BF16(0, F.H, F.WT + WE_UP + (size_t)l * 2 * DFF * D, 2 * DFF, D, F.T1, 2 * DFF, nullptr, 0, 0);
        GRID_BAR();
        phase_ffn_convgate(F, l, F.T1, F.T2);
        GRID_BAR();
        GEMM_RESID(F.T2, F.WT + WE_DN + (size_t)l * D * DFF, DFF, 5, false);
        GRID_BAR();
    }
}

extern "C" void kernel_launch(void* const* d_in, const int* in_sizes, int n_in, void* d_out, int out_size, void* d_ws, size_t ws_size, hipStream_t stream) {
    static int grid = 0;
    if (grid == 0) {
        if (n_in != N_IN || ws_size < WS_END) { fprintf(stderr, "kernel_launch: unexpected n_in %d or ws_size %zu\n", n_in, ws_size); grid = -1; return; }
        int dev = 0, cus = 0, per_cu = 0;
        hipGetDevice(&dev); hipDeviceGetAttribute(&cus, hipDeviceAttributeMultiprocessorCount, dev);
        hipFuncSetAttribute((const void*)mk_fwd, hipFuncAttributeMaxDynamicSharedMemorySize, LDS_BYTES);
        hipOccupancyMaxActiveBlocksPerMultiprocessor(&per_cu, (const void*)mk_fwd, NT, LDS_BYTES);
        (void)hipGetLastError();
        if (per_cu < 1) { fprintf(stderr, "kernel_launch: occupancy query says %d blocks per CU\n", per_cu); per_cu = 1; }
        grid = cus;
    }
    if (grid < 0) return;
    hipMemsetAsync((char*)d_ws + WS_CTL, 0, CTL_ZERO_BYTES, stream);
    Params p{};
    for (int i = 0; i < N_IN; ++i) p.in[i] = (const float*)d_in[i];
    p.out = (float*)d_out; p.ws = (unsigned char*)d_ws;
    void* args[] = {&p};
    hipError_t e = hipLaunchCooperativeKernel((const void*)mk_fwd, dim3(grid), dim3(NT), args, LDS_BYTES, stream);
    if (e != hipSuccess) fprintf(stderr, "kernel_launch: cooperative launch failed: %s (grid %d)\n", hipGetErrorString(e), grid);
}
```

```cpp
#include <hip/hip_runtime.h>
#include <cstdio>
#include <cstdint>

#define GAS __attribute__((address_space(1)))
#define LAS __attribute__((address_space(3)))
typedef unsigned short bf16;
typedef float f32x4 __attribute__((ext_vector_type(4)));
typedef unsigned u32x2 __attribute__((ext_vector_type(2)));
typedef unsigned u32x4 __attribute__((ext_vector_type(4)));

constexpr int D = 1024, NPROMPT = 32 * 256, NSAMPLE = 2 * 1024, M = NPROMPT + NSAMPLE;
constexpr int DEPTH = 4, DRNN = 1280, DB = 2048, DFF = 2816, PAST = 512, TKS = PAST + 1024;
constexpr float EPS = 1e-6f;
constexpr int NWAVES = 8, NT = NWAVES * 64;

enum { I_XP = 0, I_XS, I_STATE, I_CK, I_CV, I_C, I_CCTX, I_WMOD, I_BMOD, I_NORMG, I_LRU_WIN, I_LRU_CW, I_LRU_CB, I_LRU_WG, I_LRU_BG, I_LRU_LAM, I_LRU_WOUT,
       I_CM_WIN, I_CM_BIN, I_CM_NG, I_CM_WS, I_CM_BS, I_CM_WOUT, I_AT_WQKV, I_AT_QKG, I_AT_LAM, I_AT_SUBG, I_AT_WOUT, I_FF_WUP, I_FF_CW, I_FF_CB, I_FF_WDN, N_IN };
constexpr size_t O_YP = 0, O_YS = (size_t)NPROMPT * D, O_STATE = (size_t)M * D, O_CK = O_STATE + 32 * 2 * 2 * DRNN, O_CV = O_CK + (size_t)NPROMPT * D;

constexpr size_t MiB = 1u << 20;
constexpr size_t WS_CTL = 0, CTL_ZERO_BYTES = 64 * 1024;
constexpr size_t WS_MOD = 1 * MiB;
constexpr size_t WS_RSTD = WS_MOD + 512 * 1024;
constexpr size_t WS_ROPE = WS_RSTD + 256 * 1024;
constexpr size_t WS_H = 2 * MiB;
constexpr size_t WS_T1 = 22 * MiB;
constexpr size_t WS_T2 = 132 * MiB;
constexpr size_t WS_T3 = 187 * MiB;
constexpr size_t WS_KS = 237 * MiB, WS_VS = 243 * MiB;
constexpr size_t WS_W = 249 * MiB;
constexpr size_t WE_LRU_IN = 0, WE_LRU_OUT = WE_LRU_IN + (size_t)2 * 2560 * 1024, WE_CM_IN = WE_LRU_OUT + (size_t)2 * 1024 * 1280, WE_CM_OUT = WE_CM_IN + (size_t)4096 * 1024,
                 WE_QKV = WE_CM_OUT + (size_t)1024 * 2048, WE_AT_OUT = WE_QKV + (size_t)3072 * 1024, WE_UP = WE_AT_OUT + (size_t)1024 * 1024, WE_DN = WE_UP + (size_t)4 * 5632 * 1024,
                 WE_WG = WE_DN + (size_t)4 * 1024 * 2816, WE_END = WE_WG + (size_t)80 * 128 * 128;
constexpr size_t WS_END = WS_W + 106 * MiB;
static_assert(WE_END * 2 <= 106 * MiB, "weight copies fit");
constexpr int CW_BAR = 1024;

__device__ __forceinline__ unsigned f2bf(float f) { unsigned u = __builtin_bit_cast(unsigned, f); return (u + 0x7fffu + ((u >> 16) & 1u)) >> 16; }
__device__ __forceinline__ float bf2f(unsigned b) { return __builtin_bit_cast(float, (b & 0xffffu) << 16); }
__device__ __forceinline__ float wave_sum(float v) {
#pragma unroll
    for (int o = 1; o < 64; o <<= 1) v += __shfl_xor(v, o);
    return v;
}
__device__ __forceinline__ float wave_max(float v) {
#pragma unroll
    for (int o = 1; o < 64; o <<= 1) v = fmaxf(v, __shfl_xor(v, o));
    return v;
}
__device__ __forceinline__ float gelu_tanh(float x) { const float y = 0.7978845608028654f * (x + 0.044715f * x * x * x); const float t = 1.f - 2.f / (__expf(2.f * y) + 1.f); return 0.5f * x * (1.f + t); }
__device__ __forceinline__ float sigmoidf_(float x) { return 1.f / (1.f + __expf(-x)); }
__device__ __forceinline__ float siluf_(float x) { return x / (1.f + __expf(-x)); }
__device__ __forceinline__ float softplusf_(float x) { return fmaxf(x, 0.f) + log1pf(expf(-fabsf(x))); }

#define XB_TMO      128
#define XB_XCNT(j)  (256  + 64 * (j))
#define XB_XSUB(j)  (1280 + 64 * (j))
#define XB_XGEN(j)  (2304 + 64 * (j))
#define XB_TOP      3328
#define XB_TOPGEN   3392
#define XCD_BAR_WORDS 3456
#define XB_SPIN_CAP (1u << 22)
__device__ __forceinline__ unsigned xb_ld(unsigned* p)              { return __hip_atomic_load(p, __ATOMIC_RELAXED, __HIP_MEMORY_SCOPE_AGENT); }
__device__ __forceinline__ unsigned xb_add(unsigned* p, unsigned v) { return __hip_atomic_fetch_add(p, v, __ATOMIC_RELAXED, __HIP_MEMORY_SCOPE_AGENT); }
__device__ __forceinline__ unsigned xb_xcc_id() { return (unsigned)__builtin_amdgcn_s_getreg((3 << 11) | 20) & 0xFu; }
#define XB_SPIN(cond, bar) do { unsigned _sp = 0; while (cond) { __builtin_amdgcn_s_sleep(1); \
    if ((++_sp & 255u) == 0u) { if (xb_ld(&(bar)[XB_TMO])) break; if (_sp > XB_SPIN_CAP) { atomicAdd(&(bar)[XB_TMO], 1u); break; } } } } while (0)
struct XcdBarrier { unsigned* bar; unsigned x; volatile LAS unsigned* st; };
__device__ __forceinline__ XcdBarrier xcd_barrier_post(unsigned* bar, volatile LAS unsigned* st) {
    XcdBarrier b; b.bar = bar; b.x = xb_xcc_id(); b.st = st;
    if (threadIdx.x == 0) (void)xb_add(&bar[XB_XCNT(b.x)], 1u);
    return b;
}
__device__ __forceinline__ void xcd_barrier_complete(unsigned* bar, unsigned x, unsigned& nloc, unsigned& nx) {
    const unsigned G = gridDim.x * gridDim.y * gridDim.z;
    unsigned sum, cnt, mine, sp = 0u;
    for (;;) {
        sum = 0u; cnt = 0u; mine = 0u;
#pragma unroll
        for (unsigned j = 0; j < 16; ++j) { const unsigned c = xb_ld(&bar[XB_XCNT(j)]); sum += c; cnt += (c > 0u) ? 1u : 0u; mine = (j == x) ? c : mine; }
        if (sum == G) break;
        __builtin_amdgcn_s_sleep(1);
        if ((++sp & 255u) == 0u) { if (xb_ld(&bar[XB_TMO])) break; if (sp > XB_SPIN_CAP) { atomicAdd(&bar[XB_TMO], 1u); break; } }
    }
    nloc = mine > 0u ? mine : 1u; nx = cnt > 0u ? cnt : 1u;
}
__device__ __forceinline__ void xcd_barrier(const XcdBarrier& b) {
    asm volatile("s_waitcnt vmcnt(0)" ::: "memory");
    __syncthreads();
    if (threadIdx.x == 0) {
        unsigned* bar = b.bar;
        __builtin_amdgcn_s_waitcnt(0);
        unsigned nloc = b.st[0], nx = b.st[1];
        if (nloc == 0u) { xcd_barrier_complete(bar, b.x, nloc, nx); b.st[0] = nloc; b.st[1] = nx; }
        const unsigned old = xb_add(&bar[XB_XSUB(b.x)], 1u);
        const unsigned gen = old / nloc;
        if (old + 1u == (gen + 1u) * nloc) {
            __builtin_amdgcn_fence(__ATOMIC_RELEASE, "agent");
            asm volatile("s_waitcnt vmcnt(0)" ::: "memory");
            const unsigned og = xb_add(&bar[XB_TOP], 1u);
            const unsigned tg = og / nx;
            if (og + 1u == (tg + 1u) * nx) xb_add(&bar[XB_TOPGEN], 1u);
            else XB_SPIN(xb_ld(&bar[XB_TOPGEN]) == tg, bar);
            __builtin_amdgcn_fence(__ATOMIC_ACQUIRE, "agent");
            xb_add(&bar[XB_XGEN(b.x)], 1u);
            asm volatile("s_waitcnt vmcnt(0)" ::: "memory");
        } else {
            XB_SPIN(xb_ld(&bar[XB_XGEN(b.x)]) == gen, bar);
            __builtin_amdgcn_fence(__ATOMIC_ACQUIRE, "agent");
            asm volatile("s_waitcnt vmcnt(0)" ::: "memory");
        }
    }
    __syncthreads();
}

namespace pg8 {
#define PG8_LAS __attribute__((address_space(3)))
typedef unsigned short bf16_t;
typedef short bf16x8 __attribute__((ext_vector_type(8)));
typedef float f32x4 __attribute__((ext_vector_type(4)));
typedef unsigned u32x4 __attribute__((ext_vector_type(4)));
constexpr int BM = 256, BK = 64, HALF = 128, HTB = HALF * BK * 2  , STAGE_BYTES = 8 * HTB, NXCD = 8, WGM = 8;

__host__ __device__ __forceinline__ int lds_byte(int r, int c) { const int st = (r >> 4) * 2 + (c >> 5), rr = r & 15, cc = c & 31, ob = rr * 64 + cc * 2; return st * 1024 + (ob ^ (((ob >> 9) & 1) << 5)); }
__host__ __device__ __forceinline__ void stage_rc(int b, int& R, int& C) { const int st = b / 1024, sb = b % 1024, swz = sb ^ (((sb >> 9) & 1) << 5); R = (st >> 1) * 16 + swz / 64; C = (st & 1) * 32 + (swz % 64) / 2; }
__host__ __device__ __forceinline__ int perm32(int rho) { const int n = rho >> 4, i = rho & 15; return 8 * (i >> 2) + 4 * n + (i & 3); }

struct Unit { int pm, pn; };
struct Gemm { const bf16_t* A; const bf16_t* Bt; int M, N, K; };

struct StaticOrder {
    int nM, nN, nwg, G, c;
    __host__ __device__ void init(int M, int N, int G_, int c_) { nM = M / BM; nN = N / BM; nwg = nM * nN; G = G_; c = c_; }
    __host__ __device__ bool next(int i, Unit& u) const {
        const long L = (long)i * G + c; if (L >= nwg) return false;
        int wgid = (int)L; { const int q = nwg / NXCD, r = nwg % NXCD, xcd = wgid % NXCD, off = wgid / NXCD; wgid = (xcd < r ? xcd * (q + 1) : r * (q + 1) + (xcd - r) * q) + off; }
        const int nig = WGM * nN, gid = wgid / nig, fm = gid * WGM, gsz = (nM - fm) < WGM ? (nM - fm) : WGM;
        u.pm = fm + ((wgid % nig) % gsz); u.pn = (wgid % nig) / gsz; return true;
    }
    __device__ __forceinline__ void a_ready(const Unit&) const {}
    __device__ __forceinline__ void done(const Unit&) const {}
};

template <class Epi, class Sched, bool ALIGN_EPI = false, bool SP2 = false>
__device__ __forceinline__ void gemm_phase(PG8_LAS unsigned char* lds, const Gemm g, const Sched& S, const Epi& E) {
    int tid_ = threadIdx.x; asm volatile("" : "+v"(tid_));
    const int tid = tid_, wid = __builtin_amdgcn_readfirstlane(tid >> 6), lane = tid & 63, wr = wid >> 2, wc = wid & 3, fr = lane & 15, fq = lane >> 4;
    const int K = g.K, nt = K / BK;
    unsigned voffA[2], voffB[2];
#pragma unroll
    for (int i = 0; i < 2; ++i) { int R, C; stage_rc(tid * 16 + i * 8192, R, C); const int Rb = Epi::PERM ? ((R & ~31) + perm32(R & 31)) : R;
        voffA[i] = (unsigned)(R * K + C) * 2u; voffB[i] = (unsigned)(Rb * K + C) * 2u; }
    const size_t kstep = (size_t)(BK * 2);
    const size_t hstep = (size_t)HALF * K * 2;
    const size_t tstep = 2 * hstep;
    const unsigned ldsw = (unsigned)wid * 1024u;
    const int aoff = lds_byte(wr * 64 + fr, fq * 8), boff = lds_byte(wc * 32 + fr, fq * 8);
#define PG8_SA(b, h) (((b) * 2 + (h)) * HTB)
#define PG8_SB(b, h) ((4 + (b) * 2 + (h)) * HTB)
#define PG8_STAGE(bufoff, gbase, voff) do { _Pragma("unroll") for (int _i = 0; _i < 2; ++_i) \
        __builtin_amdgcn_global_load_lds((const unsigned*)((const char*)(gbase) + (voff)[_i]), (PG8_LAS unsigned*)(lds + (bufoff) + ldsw + _i * 8192), 16, 0, 0); } while (0)
#define PG8_LDA(dst, b, h) do { _Pragma("unroll") for (int m = 0; m < 4; ++m) _Pragma("unroll") for (int k = 0; k < 2; ++k) dst[m][k] = *(const PG8_LAS bf16x8*)(lds + PG8_SA(b, h) + aoff + m * 2048 + k * 1024); } while (0)
#define PG8_LDB(dst, b, h) do { _Pragma("unroll") for (int n = 0; n < 2; ++n) _Pragma("unroll") for (int k = 0; k < 2; ++k) dst[n][k] = *(const PG8_LAS bf16x8*)(lds + PG8_SB(b, h) + boff + n * 2048 + k * 1024); } while (0)
#define PG8_MMA(ai, bj, At, Bt) do { __builtin_amdgcn_s_setprio(1); _Pragma("unroll") for (int m = 0; m < 4; ++m) _Pragma("unroll") for (int n = 0; n < 2; ++n) _Pragma("unroll") for (int k = 0; k < 2; ++k) \
        acc[ai][bj][m][n] = __builtin_amdgcn_mfma_f32_16x16x32_bf16(Bt[n][k], At[m][k], acc[ai][bj][m][n], 0, 0, 0); __builtin_amdgcn_s_setprio(0); } while (0)
#define PG8_WAIT_V(n) asm volatile("s_waitcnt vmcnt(" #n ")" ::: "memory")
#define PG8_WAIT_L(n) asm volatile("s_waitcnt lgkmcnt(" #n ")" ::: "memory")
#define PG8_BAR __builtin_amdgcn_s_barrier()
#define PG8_SCHED __builtin_amdgcn_sched_barrier(0)
    Unit cur, nxt; int ui = 0;
    if (!S.next(0, cur)) return;
    f32x4 acc[2][2][4][2];
#pragma unroll
    for (int a = 0; a < 2; ++a)
#pragma unroll
        for (int b = 0; b < 2; ++b)
#pragma unroll
            for (int m = 0; m < 4; ++m)
#pragma unroll
                for (int n = 0; n < 2; ++n) acc[a][b][m][n] = (f32x4){0.f, 0.f, 0.f, 0.f};
    bf16x8 At[4][2], B0[2][2], B1[2][2];
    const char* cA = (const char*)g.A + (size_t)cur.pm * tstep; const char* cB = (const char*)g.Bt + (size_t)cur.pn * tstep;
    S.a_ready(cur);
    if constexpr (SP2) {
        PG8_STAGE(PG8_SB(0, 0), cB, voffB); PG8_STAGE(PG8_SB(0, 1), cB + hstep, voffB); PG8_STAGE(PG8_SA(0, 0), cA, voffA); PG8_STAGE(PG8_SA(0, 1), cA + hstep, voffA);
        if (wr == 1) PG8_BAR;
        PG8_WAIT_V(2); PG8_BAR;
        PG8_STAGE(PG8_SB(1, 0), cB + kstep, voffB); PG8_STAGE(PG8_SA(1, 0), cA + kstep, voffA); PG8_STAGE(PG8_SB(1, 1), cB + hstep + kstep, voffB);
        PG8_WAIT_V(6); PG8_BAR;
    } else {
        PG8_STAGE(PG8_SB(0, 0), cB, voffB); PG8_STAGE(PG8_SA(0, 0), cA, voffA); PG8_STAGE(PG8_SB(0, 1), cB + hstep, voffB); PG8_STAGE(PG8_SA(0, 1), cA + hstep, voffA);
        if (wr == 1) PG8_BAR;
        PG8_WAIT_V(4); PG8_BAR;
        PG8_STAGE(PG8_SB(1, 0), cB + kstep, voffB); PG8_STAGE(PG8_SA(1, 0), cA + kstep, voffA); PG8_STAGE(PG8_SB(1, 1), cB + hstep + kstep, voffB);
        PG8_WAIT_V(6); PG8_BAR;
    }
    for (;;) {
        const bool has_next = S.next(ui + 1, nxt);
        const char* nA = has_next ? (const char*)g.A + (size_t)nxt.pm * tstep : cA; const char* nB = has_next ? (const char*)g.Bt + (size_t)nxt.pn * tstep : cB;
        for (int t = 0; t < nt; t += 2) {
            const bool last = (t == nt - 2);
            const char* a1 = cA + (size_t)(t + 1) * kstep;
            const char* a2 = last ? nA : cA + (size_t)(t + 2) * kstep; const char* b2 = last ? nB : cB + (size_t)(t + 2) * kstep;
            const char* a3 = a2 + kstep; const char* b3 = b2 + kstep;
            if (last && has_next) S.a_ready(nxt);
            if constexpr (SP2) {
            PG8_LDB(B0, 0, 0); PG8_LDB(B1, 0, 1); PG8_SCHED; PG8_LDA(At, 0, 0); PG8_STAGE(PG8_SA(1, 1), a1 + hstep, voffA);
            PG8_WAIT_V(8); PG8_WAIT_L(0); PG8_BAR; PG8_MMA(0, 0, At, B0); PG8_MMA(0, 1, At, B1); PG8_BAR; PG8_SCHED;
            PG8_LDA(At, 0, 1); PG8_STAGE(PG8_SB(0, 0), b2, voffB); PG8_STAGE(PG8_SB(0, 1), b2 + hstep, voffB); PG8_STAGE(PG8_SA(0, 0), a2, voffA);
            PG8_WAIT_V(8); PG8_WAIT_L(0); PG8_BAR; PG8_MMA(1, 0, At, B0); PG8_MMA(1, 1, At, B1); PG8_BAR; PG8_SCHED;
            PG8_LDB(B0, 1, 0); PG8_LDB(B1, 1, 1); PG8_SCHED; PG8_LDA(At, 1, 0); PG8_STAGE(PG8_SA(0, 1), a2 + hstep, voffA);
            PG8_WAIT_V(8); PG8_WAIT_L(0); PG8_BAR; PG8_MMA(0, 0, At, B0); PG8_MMA(0, 1, At, B1); PG8_BAR; PG8_SCHED;
            PG8_LDA(At, 1, 1); PG8_STAGE(PG8_SB(1, 0), b3, voffB); PG8_STAGE(PG8_SB(1, 1), b3 + hstep, voffB); PG8_STAGE(PG8_SA(1, 0), a3, voffA);
            PG8_WAIT_V(8); PG8_WAIT_L(0); PG8_BAR; PG8_MMA(1, 0, At, B0); PG8_MMA(1, 1, At, B1); PG8_BAR; PG8_SCHED;
            } else {
            PG8_LDB(B0, 0, 0); PG8_SCHED; PG8_LDA(At, 0, 0); PG8_STAGE(PG8_SA(1, 1), a1 + hstep, voffA);
            PG8_WAIT_L(8); PG8_BAR; PG8_WAIT_L(0); PG8_MMA(0, 0, At, B0); PG8_BAR; PG8_SCHED;
            PG8_LDB(B1, 0, 1); PG8_STAGE(PG8_SB(0, 0), b2, voffB);
            PG8_BAR; PG8_WAIT_L(0); PG8_MMA(0, 1, At, B1); PG8_BAR;
            PG8_LDA(At, 0, 1); PG8_STAGE(PG8_SA(0, 0), a2, voffA);
            PG8_BAR; PG8_WAIT_L(0); PG8_MMA(1, 0, At, B0); PG8_BAR; PG8_SCHED;
            PG8_STAGE(PG8_SB(0, 1), b2 + hstep, voffB);
            PG8_WAIT_V(6); PG8_BAR; PG8_MMA(1, 1, At, B1); PG8_BAR;
            PG8_LDB(B0, 1, 0); PG8_SCHED; PG8_LDA(At, 1, 0); PG8_STAGE(PG8_SA(0, 1), a2 + hstep, voffA);
            PG8_WAIT_L(8); PG8_BAR; PG8_WAIT_L(0); PG8_MMA(0, 0, At, B0); PG8_BAR; PG8_SCHED;
            PG8_LDB(B1, 1, 1); PG8_STAGE(PG8_SB(1, 0), b3, voffB);
            PG8_BAR; PG8_WAIT_L(0); PG8_MMA(0, 1, At, B1); PG8_BAR;
            PG8_LDA(At, 1, 1); PG8_STAGE(PG8_SA(1, 0), a3, voffA);
            PG8_BAR; PG8_WAIT_L(0); PG8_MMA(1, 0, At, B0); PG8_BAR; PG8_SCHED;
            PG8_STAGE(PG8_SB(1, 1), b3 + hstep, voffB);
            PG8_WAIT_V(6); PG8_BAR; PG8_MMA(1, 1, At, B1); PG8_BAR;
            }
        }
        if constexpr (ALIGN_EPI) { if (wr == 0) PG8_BAR; }
        if constexpr (!Epi::AFTER_DRAIN) { E(acc, cur, wr, wc, fr, fq); S.done(cur); }
        if (!has_next) break;
#pragma unroll
        for (int a = 0; a < 2; ++a)
#pragma unroll
            for (int b = 0; b < 2; ++b)
#pragma unroll
                for (int m = 0; m < 4; ++m)
#pragma unroll
                    for (int n = 0; n < 2; ++n) acc[a][b][m][n] = (f32x4){0.f, 0.f, 0.f, 0.f};
        cur = nxt; cA = nA; cB = nB; ++ui;
        if constexpr (ALIGN_EPI) { if (wr == 1) PG8_BAR; }
    }
    PG8_WAIT_V(0);
    if constexpr (!ALIGN_EPI) { if (wr == 0) PG8_BAR; }
    PG8_BAR;
    if constexpr (Epi::AFTER_DRAIN) { E.fused(acc, cur, wr, wc, fr, fq, lds, wid, lane); S.done(cur); }
#undef PG8_SA
#undef PG8_SB
#undef PG8_STAGE
#undef PG8_LDA
#undef PG8_LDB
#undef PG8_MMA
#undef PG8_WAIT_V
#undef PG8_WAIT_L
#undef PG8_BAR
#undef PG8_SCHED
}
}

namespace pg8 {
__device__ __forceinline__ unsigned cvt_pk_bf16(float lo, float hi) { unsigned r; asm volatile("v_cvt_pk_bf16_f32 %0, %1, %2" : "=v"(r) : "v"(lo), "v"(hi)); return r; }
__device__ __forceinline__ f32x4 gelu4(f32x4 v) { f32x4 o; o.x = gelu_tanh(v.x); o.y = gelu_tanh(v.y); o.z = gelu_tanh(v.z); o.w = gelu_tanh(v.w); return o; }
template <int ACT> struct EpiBf16 {
    static constexpr bool PERM = true, AFTER_DRAIN = false;
    bf16_t* O; int ldc; const float* bias; int split_cols; size_t split_stride;
    __device__ __forceinline__ void operator()(const f32x4 (&acc)[2][2][4][2], const Unit& u, int wr, int wc, int fr, int fq) const {
        const int row0 = u.pm * BM + wr * 64 + fr; int colt = u.pn * BM; bf16_t* base = O; int t = 0;
        if (split_cols) { t = colt / split_cols; base += (size_t)t * split_stride; colt -= t * split_cols; }
        const bool act = (ACT == 1) || (ACT == 2 && t == 0);
        const int col0 = colt + wc * 32 + 8 * fq, bcol0 = u.pn * BM + wc * 32 + 8 * fq;
        f32x4 bv[2][2];
#pragma unroll
        for (int bj = 0; bj < 2; ++bj)
#pragma unroll
            for (int n = 0; n < 2; ++n) bv[bj][n] = bias ? *(const GAS f32x4*)(bias + bcol0 + bj * HALF + 4 * n) : (f32x4){0.f, 0.f, 0.f, 0.f};
#pragma unroll
        for (int ai = 0; ai < 2; ++ai)
#pragma unroll
            for (int m = 0; m < 4; ++m) { bf16_t* rowp = base + (size_t)(row0 + ai * HALF + m * 16) * ldc + col0;
#pragma unroll
                for (int bj = 0; bj < 2; ++bj) { f32x4 v0 = acc[ai][bj][m][0] + bv[bj][0], v1 = acc[ai][bj][m][1] + bv[bj][1];
                    if (ACT != 0) { if (act) { v0 = gelu4(v0); v1 = gelu4(v1); } }
                    u32x4 w; w.x = cvt_pk_bf16(v0[0], v0[1]); w.y = cvt_pk_bf16(v0[2], v0[3]); w.z = cvt_pk_bf16(v1[0], v1[1]); w.w = cvt_pk_bf16(v1[2], v1[3]);
                    *(GAS u32x4*)(rowp + bj * HALF) = w; } }
    }
};
struct EpiResid {
    static constexpr bool PERM = false, AFTER_DRAIN = false;
    float* out; const float* xp; const float* xs; const float* modl; int which; bool from_input;
    __device__ __forceinline__ void operator()(const f32x4 (&acc)[2][2][4][2], const Unit& u, int wr, int wc, int fr, int fq) const {
        const int trow = u.pm * BM, row0 = wr * 64 + fr, col0 = u.pn * BM + wc * 32 + 4 * fq;
        const int ci = trow < NPROMPT ? 0 : 1 + ((trow - NPROMPT) >> 10);
        const float* gp = modl + (size_t)(ci * 6 + which) * D + col0;
        const float* bp = from_input ? (trow < NPROMPT ? xp + (size_t)trow * D : xs + (size_t)(trow - NPROMPT) * D) : out + (size_t)trow * D;
        GAS float* op = (GAS float*)(out + (size_t)trow * D); const GAS float* bpg = (const GAS float*)bp; const GAS float* gpg = (const GAS float*)gp;
        f32x4 gv[2][2];
#pragma unroll
        for (int bj = 0; bj < 2; ++bj)
#pragma unroll
            for (int n = 0; n < 2; ++n) gv[bj][n] = *(const GAS f32x4*)(gpg + bj * HALF + n * 16);
#pragma unroll
        for (int ai = 0; ai < 2; ++ai)
#pragma unroll
            for (int m = 0; m < 4; ++m) { const size_t off = (size_t)(row0 + ai * HALF + m * 16) * D + col0;
                f32x4 bs[2][2];
#pragma unroll
                for (int bj = 0; bj < 2; ++bj)
#pragma unroll
                    for (int n = 0; n < 2; ++n) bs[bj][n] = *(const GAS f32x4*)(bpg + off + bj * HALF + n * 16);
#pragma unroll
                for (int bj = 0; bj < 2; ++bj)
#pragma unroll
                    for (int n = 0; n < 2; ++n) *(GAS f32x4*)(op + off + bj * HALF + n * 16) = bs[bj][n] + gv[bj][n] * acc[ai][bj][m][n];
                asm volatile("" ::: "memory"); }
    }
};
}

struct Params { const float* in[N_IN]; float* out; unsigned char* ws; };
struct Frame {
    LAS unsigned char* lds; int tid, lane, wave, bid, G;
    const float* const* in; float* out; unsigned char* ws; float* out0; unsigned char* ws0;
    float* mod; float* rstd; float* rope; bf16 *H, *T1, *T2, *T3, *KS, *VS, *WT;
    __device__ __forceinline__ void fresh() {
        int t = threadIdx.x; asm volatile("" : "+v"(t)); tid = t; lane = t & 63; wave = __builtin_amdgcn_readfirstlane(t >> 6);
        int b = blockIdx.x; asm volatile("" : "+s"(b)); bid = b;
        unsigned char* w = ws0; asm volatile("" : "+s"(w)); ws = w; float* o = out0; asm volatile("" : "+s"(o)); out = o;
        mod = (float*)(w + WS_MOD); rstd = (float*)(w + WS_RSTD); rope = (float*)(w + WS_ROPE);
        H = (bf16*)(w + WS_H); T1 = (bf16*)(w + WS_T1); T2 = (bf16*)(w + WS_T2); T3 = (bf16*)(w + WS_T3); KS = (bf16*)(w + WS_KS); VS = (bf16*)(w + WS_VS); WT = (bf16*)(w + WS_W);
    }
};
__device__ __forceinline__ const float* xin_row(const Frame& F, int row) { return row < NPROMPT ? F.in[I_XP] + (size_t)row * D : F.in[I_XS] + (size_t)(row - NPROMPT) * D; }
__device__ __forceinline__ int cidx_of(int row) { return row < NPROMPT ? 0 : 1 + ((row - NPROMPT) >> 10); }
__device__ __forceinline__ const float* modp(const Frame& F, int l, int row, int which) { return F.mod + (size_t)((l * 3 + cidx_of(row)) * 6 + which) * D; }


__device__ __forceinline__ void transpose_item(const float* W, int K, int N, bf16* WT, LAS float* scr, int item, int lane) {
    const int nblk = N / 32, kb = item / nblk, nb = item % nblk, k0 = 64 * kb, n0 = 32 * nb;
#pragma unroll 8
    for (int i = 0; i < 32; ++i) { const int kk = 2 * i + (lane >> 5); scr[kk * 33 + (lane & 31)] = W[(size_t)(k0 + kk) * N + n0 + (lane & 31)]; }
    asm volatile("s_waitcnt lgkmcnt(0)" ::: "memory");
    const int c = lane & 7;
#pragma unroll
    for (int j = 0; j < 4; ++j) { const int n = (lane >> 3) + 8 * j; const LAS float* sp = scr + (8 * c) * 33 + n;
        u32x4 o; o.x = f2bf(sp[0 * 33]) | (f2bf(sp[1 * 33]) << 16); o.y = f2bf(sp[2 * 33]) | (f2bf(sp[3 * 33]) << 16); o.z = f2bf(sp[4 * 33]) | (f2bf(sp[5 * 33]) << 16); o.w = f2bf(sp[6 * 33]) | (f2bf(sp[7 * 33]) << 16);
        *(u32x4*)(WT + (size_t)(n0 + n) * K + k0 + 8 * c) = o; }
    asm volatile("s_waitcnt lgkmcnt(0)" ::: "memory");
}
__device__ __forceinline__ bool transpose_group(int& r, const float* W, int nmat, int K, int N, bf16* WT, LAS float* scr, int lane) {
    const int per = (K / 64) * (N / 32), tot = nmat * per;
    if (r >= tot) { r -= tot; return false; }
    const int mi = r / per; transpose_item(W + (size_t)mi * K * N, K, N, WT + (size_t)mi * K * N, scr, r % per, lane); return true;
}
__device__ __forceinline__ void phase_prologue(Frame& F) {
    F.fresh();
    LAS float* sc = (LAS float*)F.lds;
    const float* c = F.in[I_C]; const float* cctx = F.in[I_CCTX];
    for (int i = F.tid; i < 3 * D; i += NT) { const int ci = i >> 10, k = i & 1023; const float v = ci == 0 ? cctx[k] : c[(ci - 1) * D + k]; sc[i] = siluf_(v); }
    __syncthreads();
    LAS float* part = sc + 3 * D;
    const int kp = F.tid >> 6, cl = F.tid & 63;
    for (int item = F.bid; item < DEPTH * 6 * D / 64; item += F.G) {
        const int col = item * 64 + cl, l = col / (6 * D), cc = col % (6 * D);
        const float* w = F.in[I_WMOD] + (size_t)l * D * 6 * D + cc;
        float s0 = 0.f, s1 = 0.f, s2 = 0.f;
        for (int k = kp * 128; k < kp * 128 + 128; ++k) { const float wv = w[(size_t)k * 6 * D]; s0 += sc[k] * wv; s1 += sc[D + k] * wv; s2 += sc[2 * D + k] * wv; }
        part[(kp * 3 + 0) * 64 + cl] = s0; part[(kp * 3 + 1) * 64 + cl] = s1; part[(kp * 3 + 2) * 64 + cl] = s2;
        __syncthreads();
        if (F.tid < 192) { const int ci = F.tid >> 6; float s = F.in[I_BMOD][l * 6 * D + cc];
            for (int q = 0; q < 8; ++q) s += part[(q * 3 + ci) * 64 + cl];
            F.mod[(size_t)((l * 3 + ci) * 6) * D + cc] = s; }
        __syncthreads();
    }
    { __syncthreads();
      LAS float* scr = (LAS float*)(F.lds + F.wave * 16384);
      const int gw = F.bid * NWAVES + F.wave, NGW = F.G * NWAVES;
      constexpr int NITEMS = (int)(WE_END / 2048);
      for (int it = gw; it < NITEMS; it += NGW) { int r = it;
          if (transpose_group(r, F.in[I_FF_WUP], 4, D, 2 * DFF, F.WT + WE_UP, scr, F.lane)) continue;
          if (transpose_group(r, F.in[I_FF_WDN], 4, DFF, D, F.WT + WE_DN, scr, F.lane)) continue;
          if (transpose_group(r, F.in[I_LRU_WIN], 2, D, 2 * DRNN, F.WT + WE_LRU_IN, scr, F.lane)) continue;
          if (transpose_group(r, F.in[I_LRU_WOUT], 2, DRNN, D, F.WT + WE_LRU_OUT, scr, F.lane)) continue;
          if (transpose_group(r, F.in[I_CM_WIN], 1, D, 2 * DB, F.WT + WE_CM_IN, scr, F.lane)) continue;
          if (transpose_group(r, F.in[I_CM_WOUT], 1, DB, D, F.WT + WE_CM_OUT, scr, F.lane)) continue;
          if (transpose_group(r, F.in[I_AT_WQKV], 1, D, 3 * D, F.WT + WE_QKV, scr, F.lane)) continue;
          if (transpose_group(r, F.in[I_AT_WOUT], 1, D, D, F.WT + WE_AT_OUT, scr, F.lane)) continue;
          transpose_group(r, F.in[I_LRU_WG], 80, 128, 128, F.WT + WE_WG, scr, F.lane); } }
    const int gt = F.bid * NT + F.tid, GT = F.G * NT;
    for (int i = gt; i < 1024 * 32; i += GT) { const int t = i >> 5, j = i & 31; const float inv = powf(10000.f, -(float)(j & 15) / 16.f); const float pos = (float)(j < 16 ? (t >> 6) : (t & 63));
        const float ang = pos * inv; F.rope[i] = cosf(ang); F.rope[32768 + i] = sinf(ang); }
    for (int i = gt; i < 2 * PAST * D; i += GT) { const int b = i / (PAST * D), r = i % (PAST * D);
        F.KS[(size_t)b * TKS * D + r] = (bf16)f2bf(F.in[I_CK][i]); F.VS[(size_t)b * TKS * D + r] = (bf16)f2bf(F.in[I_CV][i]); }
}

__device__ __forceinline__ void phase_modulate(Frame& F, int l, int sub) {
    F.fresh();
    const int gw = F.bid * NWAVES + F.wave, NGW = F.G * NWAVES;
    const float* g = F.in[I_NORMG] + (size_t)(l * 2 + sub) * D;
    for (int row = gw; row < M; row += NGW) {
        const float* xr = (l == 0 && sub == 0) ? xin_row(F, row) : F.out + (size_t)row * D;
        const float* sh = modp(F, l, row, sub * 3 + 0); const float* scl = modp(F, l, row, sub * 3 + 1);
        f32x4 v[4]; float s = 0.f;
#pragma unroll
        for (int j = 0; j < 4; ++j) { v[j] = *(const f32x4*)(xr + 4 * F.lane + 256 * j); s += v[j].x * v[j].x + v[j].y * v[j].y + v[j].z * v[j].z + v[j].w * v[j].w; }
        const float rstd = rsqrtf(wave_sum(s) * (1.f / D) + EPS);
#pragma unroll
        for (int j = 0; j < 4; ++j) { const int c0 = 4 * F.lane + 256 * j; const f32x4 gg = *(const f32x4*)(g + c0), s4 = *(const f32x4*)(sh + c0), c4 = *(const f32x4*)(scl + c0);
            const f32x4 o = v[j] * rstd * gg * (1.f + c4) + s4; u32x2 w; w.x = f2bf(o.x) | (f2bf(o.y) << 16); w.y = f2bf(o.z) | (f2bf(o.w) << 16);
            *(u32x2*)(F.H + (size_t)row * D + c0) = w; }
    }
}

template <class P>
__device__ __forceinline__ void gemm_naive(Frame& F, const P& p, int nbatch, int Mr, int N, int K) {
    F.fresh();
    LAS float* As = (LAS float*)F.lds;
    LAS float* Bs = As + 16 * 132;
    const int tid = F.tid, tx = tid & 31, ty = tid >> 5;
    const int tm = Mr / 128, tn = N / 128, per = tm * tn, total = per * nbatch;
    for (int t = F.bid; t < total; t += F.G) {
        const int b = t / per, r = t % per, pn = r / tm, pm = r % tm;
        const bf16* A; int lda; const float* W; int ldw; p.get(b, A, lda, W, ldw);
        float acc[8][4];
#pragma unroll
        for (int i = 0; i < 8; ++i)
#pragma unroll
            for (int j = 0; j < 4; ++j) acc[i][j] = 0.f;
        for (int k0 = 0; k0 < K; k0 += 16) {
            { const int row = tid >> 2, kq = (tid & 3) * 4;
              const u32x2 v = *(const u32x2*)(A + (size_t)(pm * 128 + row) * lda + k0 + kq);
              As[(kq + 0) * 132 + row] = bf2f(v.x); As[(kq + 1) * 132 + row] = bf2f(v.x >> 16); As[(kq + 2) * 132 + row] = bf2f(v.y); As[(kq + 3) * 132 + row] = bf2f(v.y >> 16); }
            { const int k = tid >> 5, n4 = (tid & 31) * 4;
              *(LAS f32x4*)(Bs + k * 128 + n4) = *(const f32x4*)(W + (size_t)(k0 + k) * ldw + pn * 128 + n4); }
            __syncthreads();
#pragma unroll 2
            for (int k = 0; k < 16; ++k) {
                const f32x4 a0 = *(const LAS f32x4*)(As + k * 132 + ty * 8), a1 = *(const LAS f32x4*)(As + k * 132 + ty * 8 + 4), bv = *(const LAS f32x4*)(Bs + k * 128 + tx * 4);
                const float a[8] = {a0.x, a0.y, a0.z, a0.w, a1.x, a1.y, a1.z, a1.w}; const float bb[4] = {bv.x, bv.y, bv.z, bv.w};
#pragma unroll
                for (int i = 0; i < 8; ++i)
#pragma unroll
                    for (int j = 0; j < 4; ++j) acc[i][j] += a[i] * bb[j];
            }
            __syncthreads();
        }
#pragma unroll
        for (int i = 0; i < 8; ++i)
#pragma unroll
            for (int j = 0; j < 4; ++j) p.epi(b, pm * 128 + ty * 8 + i, pn * 128 + tx * 4 + j, acc[i][j]);
    }
}

struct PStoreBf16 {
    const bf16* A; int lda; const float* W; int ldw; bf16* O; int ldo; const float* bias; int act; int split;
    __device__ __forceinline__ void get(int, const bf16*& a, int& la, const float*& w, int& lw) const { a = A; la = lda; w = W; lw = ldw; }
    __device__ __forceinline__ void epi(int, int row, int col, float v) const {
        if (bias) v += bias[col];
        if (act == 1 || (act == 2 && col < split)) v = gelu_tanh(v);
        O[(size_t)row * ldo + col] = (bf16)f2bf(v); }
};
struct PResid {
    const bf16* A; int lda; const float* W; int ldw; float* out; const float* xp; const float* xs; const float* modl; int which; bool from_input;
    __device__ __forceinline__ void get(int, const bf16*& a, int& la, const float*& w, int& lw) const { a = A; la = lda; w = W; lw = ldw; }
    __device__ __forceinline__ void epi(int, int row, int col, float v) const {
        const float base = from_input ? (row < NPROMPT ? xp[(size_t)row * D + col] : xs[(size_t)(row - NPROMPT) * D + col]) : out[(size_t)row * D + col];
        out[(size_t)row * D + col] = base + modl[(size_t)(cidx_of(row) * 6 + which) * D + col] * v; }
};
struct PLruIn {
    const bf16* A; const float* W; bf16* GBp; bf16* RECp;
    __device__ __forceinline__ void get(int, const bf16*& a, int& la, const float*& w, int& lw) const { a = A; la = D; w = W; lw = 2 * DRNN; }
    __device__ __forceinline__ void epi(int, int row, int col, float v) const {
        if (col < DRNN) GBp[(size_t)row * DRNN + col] = (bf16)f2bf(gelu_tanh(v)); else RECp[(size_t)row * DRNN + col - DRNN] = (bf16)f2bf(v); }
};
struct PGates {
    const bf16* XC; const float* WG; const float* BG; bf16* O;
    __device__ __forceinline__ void get(int b, const bf16*& a, int& la, const float*& w, int& lw) const { a = XC + (b % 10) * 128; la = DRNN; w = WG + (size_t)b * 128 * 128; lw = 128; }
    __device__ __forceinline__ void epi(int b, int row, int col, float v) const { const int dg = b / 10, n = b % 10;
        O[((size_t)dg * M + row) * DRNN + n * 128 + col] = (bf16)f2bf(sigmoidf_(v + BG[dg * DRNN + n * 128 + col])); }
};

__device__ __forceinline__ void phase_lru_conv(Frame& F, int j, const bf16* REC, bf16* XC) {
    F.fresh();
    const float* cw = F.in[I_LRU_CW] + (size_t)j * 4 * DRNN; const float* cb = F.in[I_LRU_CB] + (size_t)j * DRNN;
    const int gt = F.bid * NT + F.tid, GT = F.G * NT;
    for (int i = gt; i < M * DRNN; i += GT) { const int row = i / DRNN, ch = i % DRNN;
        int t, T; if (row < NPROMPT) { t = row & 255; T = 256; } else { t = (row - NPROMPT) & 1023; T = 1024; }
        float s = cb[ch];
#pragma unroll
        for (int k = 0; k < 4; ++k) { const int tt = t + k - 2; if (tt >= 0 && tt < T) s += cw[k * DRNN + ch] * bf2f(REC[(size_t)(row + k - 2) * DRNN + ch]); }
        XC[i] = (bf16)f2bf(s); }
}
__device__ __forceinline__ void phase_lru_scan(Frame& F, int j, const bf16* GATES, const bf16* XC, const bf16* GB, bf16* HS) {
    F.fresh();
    const int gt = F.bid * NT + F.tid, GT = F.G * NT;
    const int NL = (2 + 32) * DRNN;
    for (int line = gt; line < NL; line += GT) {
        const int s = line / DRNN, ch = line % DRNN;
        int base, T; float h0f = 0.f, h0b = 0.f;
        if (s < 2) { base = NPROMPT + s * 1024; T = 1024; h0f = F.in[I_STATE][((size_t)(s * 2 + j) * 2 + 0) * DRNN + ch]; h0b = F.in[I_STATE][((size_t)(s * 2 + j) * 2 + 1) * DRNN + ch]; }
        else { base = (s - 2) * 256; T = 256; }
        const float spf = softplusf_(-F.in[I_LRU_LAM][(size_t)(j * 2 + 0) * DRNN + ch]), spb = softplusf_(-F.in[I_LRU_LAM][(size_t)(j * 2 + 1) * DRNN + ch]);
        float h = h0f;
        for (int t = 0; t < T; ++t) { const size_t o = (size_t)(base + t) * DRNN + ch;
            const float r = bf2f(GATES[o]), ig = bf2f(GATES[(size_t)M * DRNN + o]), xc = bf2f(XC[o]);
            const float la = -8.f * r * spf, a = expf(la), bx = sqrtf(-expm1f(2.f * la)) * (ig * xc);
            h = a * h + bx; HS[o] = (bf16)f2bf(h); }
        const float ff = h;
        h = h0b;
        for (int t = T - 1; t >= 0; --t) { const size_t o = (size_t)(base + t) * DRNN + ch;
            const float r = bf2f(GATES[(size_t)2 * M * DRNN + o]), ig = bf2f(GATES[(size_t)3 * M * DRNN + o]), xc = bf2f(XC[o]);
            const float la = -8.f * r * spb, a = expf(la), bx = sqrtf(-expm1f(2.f * la)) * (ig * xc);
            h = a * h + bx; HS[o] = (bf16)f2bf(bf2f(GB[o]) * (bf2f(HS[o]) + h)); }
        if (s >= 2) { float* st = F.out + O_STATE + ((size_t)((s - 2) * 2 + j) * 2) * DRNN; st[ch] = ff; st[DRNN + ch] = h; }
    }
}


typedef short bf16x8 __attribute__((ext_vector_type(8)));
constexpr int LRU_XS = 272;
constexpr int LRU_XC_OFF = 0, LRU_GB_OFF = 256 * LRU_XS;
template <bool REV>
__device__ __forceinline__ float lru_dir(LAS const unsigned char* xct, LAS unsigned char* hft, const bf16* wgt  ,
                                         const bf16* gbp  , float br, float bi, float sp, float hc, int wave, int lane, bool wantp, bf16* Pdst) {
    const int c = lane & 15, q = lane >> 4, qq = REV ? 3 - q : q;
    bf16x8 Br[4], Bi[4], Id;
#pragma unroll
    for (int ks = 0; ks < 4; ++ks) { Br[ks] = *(const GAS bf16x8*)(wgt + (size_t)(16 * wave + c) * 128 + 32 * ks + 8 * q);
                                     Bi[ks] = *(const GAS bf16x8*)(wgt + (size_t)10 * 128 * 128 + (size_t)(16 * wave + c) * 128 + 32 * ks + 8 * q); }
#pragma unroll
    for (int jj = 0; jj < 8; ++jj) Id[jj] = (8 * q + jj == 16 * (wave & 1) + c) ? (short)0x3F80 : (short)0;
    const int ksel = wave >> 1;
    float Pc = 1.f;
#pragma unroll 2
    for (int it = 0; it < 16; ++it) {
        const int mi = REV ? 15 - it : it;
        LAS const unsigned char* rp = xct + (16 * mi + c) * LRU_XS + 16 * q;
        float gbv[4];
        if (REV) {
#pragma unroll
            for (int k = 0; k < 4; ++k) gbv[k] = bf2f(*(const GAS unsigned short*)(gbp + (size_t)(16 * mi + 4 * q + k) * DRNN)); }
        bf16x8 Af[4];
#pragma unroll
        for (int ks = 0; ks < 4; ++ks) Af[ks] = *(LAS const bf16x8*)(rp + 64 * ks);
        const bf16x8 Ax = *(LAS const bf16x8*)(rp + 64 * ksel);
        f32x4 r = {0.f, 0.f, 0.f, 0.f}, ig = {0.f, 0.f, 0.f, 0.f};
#pragma unroll
        for (int ks = 0; ks < 4; ++ks) { r = __builtin_amdgcn_mfma_f32_16x16x32_bf16(Af[ks], Br[ks], r, 0, 0, 0); ig = __builtin_amdgcn_mfma_f32_16x16x32_bf16(Af[ks], Bi[ks], ig, 0, 0, 0); }
        const f32x4 xc = __builtin_amdgcn_mfma_f32_16x16x32_bf16(Ax, Id, (f32x4){0.f, 0.f, 0.f, 0.f}, 0, 0, 0);
        float av[4], bv[4];
#pragma unroll
        for (int k = 0; k < 4; ++k) { const float rg = sigmoidf_(r[k] + br), iv = sigmoidf_(ig[k] + bi);
            const float la = -8.f * rg * sp, x = 2.f * la;
            const float oms = -x * (1.f + x * (0.5f + x * (0.16666667f + x * (0.041666668f + x * 0.0083333338f))));
            const float om = x > -0.25f ? oms : 1.f - __expf(x);
            av[k] = __expf(la); bv[k] = sqrtf(om) * (iv * xc[k]); }
        float pA[4], pB[4];
#pragma unroll
        for (int kk = 0; kk < 4; ++kk) { const int k = REV ? 3 - kk : kk;
            if (kk == 0) { pA[k] = av[k]; pB[k] = bv[k]; } else { const int kp = REV ? k + 1 : k - 1; pA[k] = pA[kp] * av[k]; pB[k] = pB[kp] * av[k] + bv[k]; } }
        const int kl = REV ? 0 : 3;
        float gA = pA[kl], gB = pB[kl];
        { const float tA = REV ? __shfl_down(gA, 16) : __shfl_up(gA, 16), tB = REV ? __shfl_down(gB, 16) : __shfl_up(gB, 16); if (qq >= 1) { gB = tB * gA + gB; gA = tA * gA; } }
        { const float tA = REV ? __shfl_down(gA, 32) : __shfl_up(gA, 32), tB = REV ? __shfl_down(gB, 32) : __shfl_up(gB, 32); if (qq >= 2) { gB = tB * gA + gB; gA = tA * gA; } }
        float eA = REV ? __shfl_down(gA, 16) : __shfl_up(gA, 16), eB = REV ? __shfl_down(gB, 16) : __shfl_up(gB, 16); if (qq == 0) { eA = 1.f; eB = 0.f; }
        const int src = (REV ? 0 : 48) + c;
        const float totA = __shfl(gA, src), totB = __shfl(gB, src);
        const float hin = eA * hc + eB;
#pragma unroll
        for (int k = 0; k < 4; ++k) { const float h = pA[k] * hin + pB[k]; const int row = 16 * mi + 4 * q + k;
            if (wantp) Pdst[(size_t)row * DRNN] = (bf16)f2bf(pA[k] * eA * Pc);
            LAS unsigned short* hp = (LAS unsigned short*)(hft + row * LRU_XS + 2 * (16 * wave + c));
            if (!REV) *hp = (unsigned short)f2bf(h); else *hp = (unsigned short)f2bf(gbv[k] * (bf2f(*hp) + h)); }
        hc = totA * hc + totB; Pc *= totA;
    }
    return hc;
}
__device__ __forceinline__ void lru_unit(Frame& F, int j, int pm, int n, const bf16* REC, const bf16* GB, bf16* HS, bf16* PF, bf16* PB, float* AGG, const bf16* WGT) {
    const int tid = F.tid, lane = F.lane, wave = F.wave, r0 = 256 * pm;
    const bool smp = pm >= 32; const int tix = smp ? (pm - 32) & 3 : 0, sq = smp ? (pm - 32) >> 2 : 0;
    const int t0 = smp ? 256 * tix : 0, T = smp ? 1024 : 256;
    LAS unsigned char* xct = F.lds + LRU_XC_OFF; LAS unsigned char* hft = F.lds + LRU_GB_OFF;
    { const float* cw = F.in[I_LRU_CW] + (size_t)j * 4 * DRNN + n * 128 + 2 * lane; const float* cb = F.in[I_LRU_CB] + (size_t)j * DRNN + n * 128 + 2 * lane;
      float w0[4], w1[4];
#pragma unroll
      for (int k = 0; k < 4; ++k) { w0[k] = cw[k * DRNN]; w1[k] = cw[k * DRNN + 1]; }
      const float b0 = cb[0], b1 = cb[1];
      unsigned v[35];
#pragma unroll
      for (int i = 0; i < 35; ++i) { const int tl = 32 * wave + i - 2, tt = t0 + tl;
          v[i] = (tt >= 0 && tt < T) ? *(const GAS unsigned*)(REC + (size_t)(r0 + tl) * DRNN + n * 128 + 2 * lane) : 0u; }
#pragma unroll
      for (int i = 0; i < 32; ++i) { float s0 = b0, s1 = b1;
#pragma unroll
          for (int k = 0; k < 4; ++k) { s0 += w0[k] * bf2f(v[i + k]); s1 += w1[k] * bf2f(v[i + k] >> 16); }
          *(LAS unsigned*)(xct + (32 * wave + i) * LRU_XS + 4 * lane) = f2bf(s0) | (f2bf(s1) << 16); } }
    __syncthreads();
    const int c = lane & 15, q = lane >> 4, ch = n * 128 + 16 * wave + c;
    const float* bg = F.in[I_LRU_BG] + (size_t)j * 4 * DRNN; const float* lam = F.in[I_LRU_LAM] + (size_t)j * 2 * DRNN;
    const bf16* gbp = GB + (size_t)r0 * DRNN + ch;
    bf16* pf = PF + (size_t)(smp ? r0 - NPROMPT : 0) * DRNN + ch; bf16* pb = PB + (size_t)(smp ? r0 - NPROMPT : 0) * DRNN + ch;
    { float h0 = 0.f; if (smp && tix == 0) h0 = F.in[I_STATE][((size_t)(sq * 2 + j) * 2 + 0) * DRNN + ch];
      const float hfin = lru_dir<false>(xct, hft, WGT + (size_t)(0 * 10 + n) * 128 * 128, gbp, bg[0 * DRNN + ch], bg[1 * DRNN + ch], softplusf_(-lam[ch]), h0, wave, lane, smp, pf);
      if (q == 0) { if (smp) AGG[(size_t)((sq * 4 + tix) * 2 + 0) * DRNN + ch] = hfin; else F.out[O_STATE + ((size_t)(pm * 2 + j) * 2 + 0) * DRNN + ch] = hfin; } }
    { float h0 = 0.f; if (smp && tix == 3) h0 = F.in[I_STATE][((size_t)(sq * 2 + j) * 2 + 1) * DRNN + ch];
      const float hfin = lru_dir<true>(xct, hft, WGT + (size_t)(2 * 10 + n) * 128 * 128, gbp, bg[2 * DRNN + ch], bg[3 * DRNN + ch], softplusf_(-lam[DRNN + ch]), h0, wave, lane, smp, pb);
      if (q == 0) { if (smp) AGG[(size_t)((sq * 4 + tix) * 2 + 1) * DRNN + ch] = hfin; else F.out[O_STATE + ((size_t)(pm * 2 + j) * 2 + 1) * DRNN + ch] = hfin; } }
    __syncthreads();
#pragma unroll
    for (int i = 0; i < 8; ++i) { const int id = i * NT + tid, row = id >> 4, cc = id & 15;
        *(GAS u32x4*)(HS + (size_t)(r0 + row) * DRNN + n * 128 + 8 * cc) = *(LAS const u32x4*)(hft + row * LRU_XS + 16 * cc); }
    __syncthreads();
}
__device__ __forceinline__ void phase_lru_core(Frame& F, int j, const bf16* REC, const bf16* GB, bf16* HS, bf16* PF, bf16* PB, float* AGG, const bf16* WGT) {
    F.fresh();
    for (int u = F.bid; u < 400; u += F.G) {
        const int pm = u < 80 ? 32 + u / 10 : (u - 80) / 10, n = u % 10;
        lru_unit(F, j, pm, n, REC, GB, HS, PF, PB, AGG, WGT); }
}
__device__ __forceinline__ void phase_lru_fixup(Frame& F, const bf16* GB, bf16* HS, const bf16* PF, const bf16* PB, const float* AGG) {
    F.fresh();
    const int gt = F.bid * NT + F.tid, GT = F.G * NT;
    for (int i = gt; i < NSAMPLE * DRNN; i += GT) { const int rs = i / DRNN, ch = i % DRNN, sq = rs >> 10, tix = (rs >> 8) & 3;
        float cf = 0.f, cbk = 0.f;
        if (tix > 0) { for (int t = 0; t < tix; ++t) { const float At = bf2f(PF[(size_t)(sq * 1024 + t * 256 + 255) * DRNN + ch]); cf = At * cf + AGG[(size_t)((sq * 4 + t) * 2 + 0) * DRNN + ch]; } }
        if (tix < 3) { for (int t = 3; t > tix; --t) { const float At = bf2f(PB[(size_t)(sq * 1024 + t * 256) * DRNN + ch]); cbk = At * cbk + AGG[(size_t)((sq * 4 + t) * 2 + 1) * DRNN + ch]; } }
        const size_t o = (size_t)(NPROMPT + rs) * DRNN + ch;
        HS[o] = (bf16)f2bf(bf2f(HS[o]) + bf2f(GB[o]) * (bf2f(PF[(size_t)rs * DRNN + ch]) * cf + bf2f(PB[(size_t)rs * DRNN + ch]) * cbk)); }
}

__device__ __forceinline__ void phase_cmlp_rstd(Frame& F, const bf16* UV) {
    F.fresh();
    const int gw = F.bid * NWAVES + F.wave, NGW = F.G * NWAVES;
    for (int row = gw; row < M; row += NGW) { float s = 0.f;
        for (int c = F.lane; c < DB; c += 64) { const float v = bf2f(UV[(size_t)row * 2 * DB + DB + c]); s += v * v; }
        s = wave_sum(s); if (F.lane == 0) F.rstd[row] = rsqrtf(s * (1.f / DB) + EPS); }
}
__device__ __forceinline__ void phase_cmlp_spatial(Frame& F, const bf16* UV, bf16* ACT) {
    F.fresh();
    const float* ws = F.in[I_CM_WS]; const float* bs = F.in[I_CM_BS]; const float* ng = F.in[I_CM_NG];
    const int gt = F.bid * NT + F.tid, GT = F.G * NT;
    for (int i = gt; i < M * DB; i += GT) { const int row = i / DB, ch = i % DB, g = ch >> 8, p = row & 127, r0 = row & ~127;
        float s = 0.f;
        for (int q = 0; q < 128; ++q) s += ws[(size_t)(g * 128 + p) * 128 + q] * F.rstd[r0 + q] * bf2f(UV[(size_t)(r0 + q) * 2 * DB + DB + ch]);
        const float sv = s * ng[ch] + bs[g * 128 + p];
        ACT[i] = (bf16)f2bf(bf2f(UV[(size_t)row * 2 * DB + ch]) * sv); }
}

__device__ __forceinline__ void phase_qkv_post(Frame& F, const bf16* QKV, bf16* Q, bf16* KP, bf16* VP) {
    F.fresh();
    const int gw = F.bid * NWAVES + F.wave, NGW = F.G * NWAVES;
    const float* qkg = F.in[I_AT_QKG];
    for (int row = gw; row < M; row += NGW) {
        const bool smp = row >= NPROMPT; const int sb = smp ? (row - NPROMPT) >> 10 : 0, t = smp ? (row - NPROMPT) & 1023 : 0;
        const float cs = smp ? F.rope[t * 32 + (F.lane & 31)] : 1.f, sn = smp ? F.rope[32768 + t * 32 + (F.lane & 31)] : 0.f;
        for (int grp = 0; grp < 32; ++grp) {
            const float v = bf2f(QKV[(size_t)row * 3072 + grp * 64 + F.lane]);
            const float ms = wave_sum(v * v) * (1.f / 64.f);
            float n = v * rsqrtf(ms + EPS) * qkg[(grp >> 4) * 64 + F.lane];
            const float keep = n;
            if (smp) { const float pr = __shfl_xor(n, 32); n = F.lane < 32 ? n * cs - pr * sn : n * cs + pr * sn; }
            if (grp < 16) Q[(size_t)row * D + grp * 64 + F.lane] = (bf16)f2bf(n);
            else { const int c = (grp - 16) * 64 + F.lane;
                if (smp) F.KS[((size_t)sb * TKS + PAST + t) * D + c] = (bf16)f2bf(n);
                else { KP[(size_t)row * D + c] = (bf16)f2bf(keep); F.out[O_CK + (size_t)row * D + c] = keep; } }
        }
        for (int c = F.lane; c < D; c += 64) { const bf16 vb = QKV[(size_t)row * 3072 + 2048 + c];
            if (smp) F.VS[((size_t)sb * TKS + PAST + t) * D + c] = vb; else { VP[(size_t)row * D + c] = vb; F.out[O_CV + (size_t)row * D + c] = bf2f(vb); } }
    }
}
__device__ __forceinline__ void phase_attn_naive(Frame& F, int l, const bf16* Q, const bf16* KP, const bf16* VP, bf16* O) {
    F.fresh();
    const int gw = F.bid * NWAVES + F.wave, NGW = F.G * NWAVES;
    LAS float* s1 = (LAS float*)F.lds + F.wave * 3328; LAS float* s2 = s1 + 1536; LAS float* qs = s2 + 1536;
    const float* al = F.in[I_AT_LAM];
    const float lam_init = 0.8f - 0.6f * expf(-0.3f * (float)l);
    const float lam = expf(wave_sum(al[F.lane] * al[64 + F.lane])) - expf(wave_sum(al[128 + F.lane] * al[192 + F.lane])) + lam_init;
    const float* sg = F.in[I_AT_SUBG];
    for (int item = gw; item < M * 8; item += NGW) {
        const int row = item >> 3, h = item & 7;
        const bf16 *Kb, *Vb; int Tk;
        if (row < NPROMPT) { Kb = KP + (size_t)(row & ~255) * D; Vb = VP + (size_t)(row & ~255) * D; Tk = 256; }
        else { const int sb = (row - NPROMPT) >> 10; Kb = F.KS + (size_t)sb * TKS * D; Vb = F.VS + (size_t)sb * TKS * D; Tk = TKS; }
        qs[F.lane] = bf2f(Q[(size_t)row * D + h * 128 + F.lane]); qs[64 + F.lane] = bf2f(Q[(size_t)row * D + h * 128 + 64 + F.lane]);
        asm volatile("s_waitcnt lgkmcnt(0)" ::: "memory");
        float m1 = -1e30f, m2 = -1e30f;
        for (int k = F.lane; k < Tk; k += 64) { const bf16* kr = Kb + (size_t)k * D + h * 128; float d1 = 0.f, d2 = 0.f;
#pragma unroll 4
            for (int d = 0; d < 64; d += 2) { const unsigned a = *(const unsigned*)(kr + d), b = *(const unsigned*)(kr + 64 + d);
                d1 += qs[d] * bf2f(a) + qs[d + 1] * bf2f(a >> 16); d2 += qs[64 + d] * bf2f(b) + qs[64 + d + 1] * bf2f(b >> 16); }
            d1 *= 0.125f; d2 *= 0.125f; s1[k] = d1; s2[k] = d2; m1 = fmaxf(m1, d1); m2 = fmaxf(m2, d2); }
        m1 = wave_max(m1); m2 = wave_max(m2);
        float l1 = 0.f, l2 = 0.f;
        for (int k = F.lane; k < Tk; k += 64) { const float e1 = expf(s1[k] - m1), e2 = expf(s2[k] - m2); s1[k] = e1; s2[k] = e2; l1 += e1; l2 += e2; }
        l1 = wave_sum(l1); l2 = wave_sum(l2);
        const float i1 = 1.f / l1, i2 = lam / l2;
        for (int k = F.lane; k < Tk; k += 64) s1[k] = bf2f(f2bf(s1[k] * i1 - s2[k] * i2));
        asm volatile("s_waitcnt lgkmcnt(0)" ::: "memory");
        float o0 = 0.f, o1 = 0.f;
        for (int k = 0; k < Tk; ++k) { const unsigned vv = *(const unsigned*)(Vb + (size_t)k * D + h * 128 + 2 * F.lane); const float w = s1[k]; o0 += w * bf2f(vv); o1 += w * bf2f(vv >> 16); }
        const float ms = wave_sum(o0 * o0 + o1 * o1) * (1.f / 128.f), rs = rsqrtf(ms + EPS) * (1.f - lam_init);
        o0 = o0 * rs * sg[2 * F.lane]; o1 = o1 * rs * sg[2 * F.lane + 1];
        *(unsigned*)(O + (size_t)row * D + h * 128 + 2 * F.lane) = f2bf(o0) | (f2bf(o1) << 16);
        asm volatile("s_waitcnt lgkmcnt(0)" ::: "memory");
    }
}


typedef short v4i16_t __attribute__((ext_vector_type(4)));
constexpr int AT_KS = 272, AT_VS = 288, AT_KBYTES = 64 * AT_KS, AT_VBYTES = 64 * AT_VS, AT_BUF = AT_KBYTES + AT_VBYTES;
__device__ __forceinline__ void attn_unit(Frame& F, int l, const bf16* Qrows  , const bf16* Kb, const bf16* Vb, int Tk, bf16* Orows, int h, float lam, float lam_init) {
    const int tid = F.tid, lane = F.lane, wave = F.wave, c = lane & 15, q4 = lane >> 4;
    LAS unsigned char* lds = F.lds;
    const float SC = 0.18033688f;
    bf16x8 Qf[2][2];
#pragma unroll
    for (int cp = 0; cp < 2; ++cp)
#pragma unroll
        for (int ks = 0; ks < 2; ++ks) Qf[cp][ks] = *(const GAS bf16x8*)(Qrows + (size_t)(16 * wave + c) * D + h * 128 + cp * 64 + 32 * ks + 8 * q4);
    const int nt = Tk / 64;
    const int key0 = tid >> 4, cc0 = tid & 15;
    u32x4 kreg[2], vreg[2];
    float m1 = -1e30f, m2 = -1e30f, l1 = 0.f, l2 = 0.f;
#pragma unroll
    for (int i = 0; i < 2; ++i) kreg[i] = *(const GAS u32x4*)(Kb + (size_t)(key0 + 32 * i) * D + h * 128 + 8 * cc0);
#pragma unroll
    for (int i = 0; i < 2; ++i) *(LAS u32x4*)(lds + (key0 + 32 * i) * AT_KS + 16 * cc0) = kreg[i];
    __syncthreads();
    for (int t = 0; t < nt; ++t) {
        LAS const unsigned char* kt = lds + (t & 1) * AT_BUF;
        if (t + 1 < nt) {
#pragma unroll
            for (int i = 0; i < 2; ++i) kreg[i] = *(const GAS u32x4*)(Kb + (size_t)((t + 1) * 64 + key0 + 32 * i) * D + h * 128 + 8 * cc0); }
        f32x4 S[2][4];
#pragma unroll
        for (int cp = 0; cp < 2; ++cp)
#pragma unroll
            for (int mf = 0; mf < 4; ++mf) { S[cp][mf] = (f32x4){0.f, 0.f, 0.f, 0.f};
#pragma unroll
                for (int ks = 0; ks < 2; ++ks) { const bf16x8 kf = *(LAS const bf16x8*)(kt + (16 * mf + c) * AT_KS + cp * 128 + ks * 64 + 16 * q4);
                    S[cp][mf] = __builtin_amdgcn_mfma_f32_16x16x32_bf16(kf, Qf[cp][ks], S[cp][mf], 0, 0, 0); } }
        float x1 = -1e30f, x2 = -1e30f;
#pragma unroll
        for (int mf = 0; mf < 4; ++mf)
#pragma unroll
            for (int k = 0; k < 4; ++k) { x1 = fmaxf(x1, S[0][mf][k]); x2 = fmaxf(x2, S[1][mf][k]); }
        x1 = fmaxf(x1, __shfl_xor(x1, 16)); x1 = fmaxf(x1, __shfl_xor(x1, 32)); x2 = fmaxf(x2, __shfl_xor(x2, 16)); x2 = fmaxf(x2, __shfl_xor(x2, 32));
        const float n1 = fmaxf(m1, x1), n2 = fmaxf(m2, x2);
        l1 *= exp2f((m1 - n1) * SC); l2 *= exp2f((m2 - n2) * SC); m1 = n1; m2 = n2;
#pragma unroll
        for (int mf = 0; mf < 4; ++mf)
#pragma unroll
            for (int k = 0; k < 4; ++k) { l1 += exp2f((S[0][mf][k] - m1) * SC); l2 += exp2f((S[1][mf][k] - m2) * SC); }
        if (t + 1 < nt) {
#pragma unroll
            for (int i = 0; i < 2; ++i) *(LAS u32x4*)(lds + ((t + 1) & 1) * AT_BUF + (key0 + 32 * i) * AT_KS + 16 * cc0) = kreg[i]; }
        __syncthreads();
    }
    l1 += __shfl_xor(l1, 16); l1 += __shfl_xor(l1, 32); l2 += __shfl_xor(l2, 16); l2 += __shfl_xor(l2, 32);
    const float i1 = 1.f / l1, i2 = lam / l2;
    f32x4 Ot[8];
#pragma unroll
    for (int md = 0; md < 8; ++md) Ot[md] = (f32x4){0.f, 0.f, 0.f, 0.f};
#pragma unroll
    for (int i = 0; i < 2; ++i) { kreg[i] = *(const GAS u32x4*)(Kb + (size_t)(key0 + 32 * i) * D + h * 128 + 8 * cc0); vreg[i] = *(const GAS u32x4*)(Vb + (size_t)(key0 + 32 * i) * D + h * 128 + 8 * cc0); }
#pragma unroll
    for (int i = 0; i < 2; ++i) { *(LAS u32x4*)(lds + (key0 + 32 * i) * AT_KS + 16 * cc0) = kreg[i]; *(LAS u32x4*)(lds + AT_KBYTES + (key0 + 32 * i) * AT_VS + 16 * cc0) = vreg[i]; }
    __syncthreads();
    for (int t = 0; t < nt; ++t) {
        LAS const unsigned char* kt = lds + (t & 1) * AT_BUF; LAS const unsigned char* vt = kt + AT_KBYTES;
        if (t + 1 < nt) {
#pragma unroll
            for (int i = 0; i < 2; ++i) { kreg[i] = *(const GAS u32x4*)(Kb + (size_t)((t + 1) * 64 + key0 + 32 * i) * D + h * 128 + 8 * cc0);
                                          vreg[i] = *(const GAS u32x4*)(Vb + (size_t)((t + 1) * 64 + key0 + 32 * i) * D + h * 128 + 8 * cc0); } }
        f32x4 S[2][4];
#pragma unroll
        for (int cp = 0; cp < 2; ++cp)
#pragma unroll
            for (int mf = 0; mf < 4; ++mf) { S[cp][mf] = (f32x4){0.f, 0.f, 0.f, 0.f};
#pragma unroll
                for (int ks = 0; ks < 2; ++ks) { const bf16x8 kf = *(LAS const bf16x8*)(kt + (16 * mf + c) * AT_KS + cp * 128 + ks * 64 + 16 * q4);
                    S[cp][mf] = __builtin_amdgcn_mfma_f32_16x16x32_bf16(kf, Qf[cp][ks], S[cp][mf], 0, 0, 0); } }
        bf16x8 Wf[2];
#pragma unroll
        for (int kk = 0; kk < 2; ++kk)
#pragma unroll
            for (int jj = 0; jj < 8; ++jj) { const int mf = 2 * kk + (jj >> 2), k = jj & 3;
                const float w = exp2f((S[0][mf][k] - m1) * SC) * i1 - exp2f((S[1][mf][k] - m2) * SC) * i2; Wf[kk][jj] = (short)f2bf(w); }
#pragma unroll
        for (int md = 0; md < 8; ++md)
#pragma unroll
            for (int kk = 0; kk < 2; ++kk) { LAS const unsigned char* vp = vt + (32 * kk + 4 * q4 + (c >> 2)) * AT_VS + (16 * md + 4 * (c & 3)) * 2;
                const v4i16_t lo = __builtin_amdgcn_ds_read_tr16_b64_v4i16((LAS v4i16_t*)vp), hi = __builtin_amdgcn_ds_read_tr16_b64_v4i16((LAS v4i16_t*)(vp + 16 * AT_VS));
                const bf16x8 vf = {lo[0], lo[1], lo[2], lo[3], hi[0], hi[1], hi[2], hi[3]};
                Ot[md] = __builtin_amdgcn_mfma_f32_16x16x32_bf16(vf, Wf[kk], Ot[md], 0, 0, 0); }
        if (t + 1 < nt) {
#pragma unroll
            for (int i = 0; i < 2; ++i) { *(LAS u32x4*)(lds + ((t + 1) & 1) * AT_BUF + (key0 + 32 * i) * AT_KS + 16 * cc0) = kreg[i];
                                          *(LAS u32x4*)(lds + ((t + 1) & 1) * AT_BUF + AT_KBYTES + (key0 + 32 * i) * AT_VS + 16 * cc0) = vreg[i]; } }
        __syncthreads();
    }
    float ss = 0.f;
#pragma unroll
    for (int md = 0; md < 8; ++md)
#pragma unroll
        for (int k = 0; k < 4; ++k) ss += Ot[md][k] * Ot[md][k];
    ss += __shfl_xor(ss, 16); ss += __shfl_xor(ss, 32);
    const float rs = rsqrtf(ss * (1.f / 128.f) + EPS) * (1.f - lam_init);
    const float* sg = F.in[I_AT_SUBG];
#pragma unroll
    for (int md = 0; md < 8; ++md) { const int d0 = 16 * md + 4 * q4; const f32x4 g4 = *(const GAS f32x4*)(sg + d0);
        u32x2 w; w.x = f2bf(Ot[md][0] * rs * g4.x) | (f2bf(Ot[md][1] * rs * g4.y) << 16); w.y = f2bf(Ot[md][2] * rs * g4.z) | (f2bf(Ot[md][3] * rs * g4.w) << 16);
        *(GAS u32x2*)(Orows + (size_t)(16 * wave + c) * D + h * 128 + d0) = w; }
}
__device__ __forceinline__ void phase_attn(Frame& F, int l, const bf16* Q, const bf16* KP, const bf16* VP, bf16* O) {
    F.fresh();
    const float* al = F.in[I_AT_LAM];
    const float lam_init = 0.8f - 0.6f * expf(-0.3f * (float)l);
    const float lam = expf(wave_sum(al[F.lane] * al[64 + F.lane])) - expf(wave_sum(al[128 + F.lane] * al[192 + F.lane])) + lam_init;
    for (int s = 0; ; ++s) {
        int u;
        if (F.G == 256) { if (F.bid < 128) { if (s > 0) break; u = F.bid; } else { if (s > 3) break; u = 128 + 4 * (F.bid - 128) + s; } }
        else { u = F.bid + s * F.G; if (u >= 640) break; }
        if (u < 128) { const int sb = u >> 6, h = (u >> 3) & 7, qt = u & 7; const size_t r0 = (size_t)NPROMPT + sb * 1024 + qt * 128;
            attn_unit(F, l, Q + r0 * D, F.KS + (size_t)sb * TKS * D, F.VS + (size_t)sb * TKS * D, TKS, O + r0 * D, h, lam, lam_init); }
        else { const int v = u - 128, b = v >> 4, h = (v >> 1) & 7, qt = v & 1; const size_t r0 = (size_t)b * 256 + qt * 128;
            attn_unit(F, l, Q + r0 * D, KP + (size_t)b * 256 * D, VP + (size_t)b * 256 * D, 256, O + r0 * D, h, lam, lam_init); }
    }
}

__device__ __forceinline__ void phase_ffn_convgate(Frame& F, int l, const bf16* Z, bf16* ACT) {
    F.fresh();
    const float* cw = F.in[I_FF_CW] + (size_t)l * 3 * 2 * DFF; const float* cb = F.in[I_FF_CB] + (size_t)l * 2 * DFF;
    const int gt = F.bid * NT + F.tid, GT = F.G * NT;
    for (int i = gt; i < M * DFF; i += GT) { const int row = i / DFF, j = i % DFF;
        int t, T; if (row < NPROMPT) { t = row & 255; T = 256; } else { t = (row - NPROMPT) & 1023; T = 1024; }
        float g = cb[j], u = cb[DFF + j];
#pragma unroll
        for (int k = 0; k < 3; ++k) { const int tt = t + k - 1; if (tt >= 0 && tt < T) { const bf16* zr = Z + (size_t)(row + k - 1) * 2 * DFF; g += cw[k * 2 * DFF + j] * bf2f(zr[j]); u += cw[k * 2 * DFF + DFF + j] * bf2f(zr[DFF + j]); } }
        ACT[i] = (bf16)f2bf(siluf_(g) * u); }
}

constexpr int LDS_BYTES = 163840;
constexpr int MISC_OFF = LDS_BYTES - 256;
__global__ void __launch_bounds__(NT, 2) mk_fwd(Params prm) {
    extern __shared__ __attribute__((aligned(16))) unsigned char lds_raw[];
    Frame F;
    F.lds = (LAS unsigned char*)lds_raw; F.G = gridDim.x; F.in = prm.in; F.out0 = prm.out; F.ws0 = prm.ws;
    F.fresh();
    volatile LAS unsigned* MISC = (volatile LAS unsigned*)(F.lds + MISC_OFF);
    if (F.tid < 32) MISC[F.tid] = 0u;
    __syncthreads();
    (void)xcd_barrier_post((unsigned*)(prm.ws + WS_CTL) + CW_BAR, MISC + 8);
#define GRID_BAR() do { XcdBarrier bar_; bar_.bar = (unsigned*)(prm.ws + WS_CTL) + CW_BAR; bar_.x = xb_xcc_id(); bar_.st = (volatile LAS unsigned*)(F.lds + MISC_OFF) + 8; xcd_barrier(bar_); } while (0)

#define GEMM_BF16(ACT, A_, Bt_, N_, K_, O_, ldc_, bias_, splitc_, splits_) do { pg8::Gemm g{A_, Bt_, M, N_, K_}; pg8::StaticOrder S; S.init(M, N_, F.G, F.bid); \
        pg8::EpiBf16<ACT> E{O_, ldc_, bias_, splitc_, splits_}; pg8::gemm_phase<pg8::EpiBf16<ACT>, pg8::StaticOrder, true, true>(F.lds, g, S, E); } while (0)
#define GEMM_RESID(A_, Bt_, K_, which_, fromin_) do { pg8::Gemm g{A_, Bt_, M, D, K_}; pg8::StaticOrder S; S.init(M, D, F.G, F.bid); \
        pg8::EpiResid E{F.out, F.in[I_XP], F.in[I_XS], F.mod + (size_t)l * 18 * D, which_, fromin_}; pg8::gemm_phase<pg8::EpiResid, pg8::StaticOrder, true, true>(F.lds, g, S, E); } while (0)

    phase_prologue(F);
    GRID_BAR();
#pragma unroll 1
    for (int l = 0; l < DEPTH; ++l) {
        const int kind = l % 3, j = l / 3;
        phase_modulate(F, l, 0);
        F.fresh();
        GRID_BAR();
        if (kind == 0) {
            bf16 *GB = F.T2, *REC = F.T2 + (size_t)M * DRNN, *PF = F.T3, *PB = F.T3 + (size_t)NSAMPLE * DRNN, *HS = F.T3 + (size_t)6 * 1024 * 1024;
            float* AGG = (float*)(F.T3 + (size_t)2 * NSAMPLE * DRNN);
            GEMM_BF16(2, F.H, F.WT + WE_LRU_IN + (size_t)j * 2 * DRNN * D, 2 * DRNN, D, GB, DRNN, nullptr, DRNN, (size_t)M * DRNN);
            GRID_BAR();
            phase_lru_core(F, j, REC, GB, HS, PF, PB, AGG, F.WT + WE_WG + (size_t)j * 40 * 128 * 128);
            GRID_BAR();
            phase_lru_fixup(F, GB, HS, PF, PB, AGG);
            GRID_BAR();
            GEMM_RESID(HS, F.WT + WE_LRU_OUT + (size_t)j * D * DRNN, DRNN, 2, l == 0);
        } else if (kind == 1) {
            bf16 *UV = F.T1, *ACT = F.T2;
            GEMM_BF16(1, F.H, F.WT + WE_CM_IN, 2 * DB, D, UV, 2 * DB, F.in[I_CM_BIN], 0, 0);
            GRID_BAR();
            phase_cmlp_rstd(F, UV);
            GRID_BAR();
            phase_cmlp_spatial(F, UV, ACT);
            GRID_BAR();
            GEMM_RESID(ACT, F.WT + WE_CM_OUT, DB, 2, false);
        } else {
            bf16 *QKV = F.T1, *Q = F.T2, *KP = F.T2 + (size_t)M * D, *VP = KP + (size_t)NPROMPT * D, *O = F.T3;
            GEMM_BF16(0, F.H, F.WT + WE_QKV, 3 * D, D, QKV, 3 * D, nullptr, 0, 0);
            GRID_BAR();
            phase_qkv_post(F, QKV, Q, KP, VP);
            GRID_BAR();
            phase_attn(F, l, Q, KP, VP, O);
            GRID_BAR();
            GEMM_RESID(O, F.WT + WE_AT_OUT, D, 2, false);
        }
        GRID_BAR();
        phase_modulate(F, l, 1);
        GRID_BAR();
        GEMM_BF16(0, F.H, F.WT + WE_UP + (size_t)l * 2 * DFF * D, 2 * DFF, D, F.T1, 2 * DFF, nullptr, 0, 0);
        GRID_BAR();
        phase_ffn_convgate(F, l, F.T1, F.T2);
        GRID_BAR();
        GEMM_RESID(F.T2, F.WT + WE_DN + (size_t)l * D * DFF, DFF, 5, false);
        GRID_BAR();
    }
}

extern "C" void kernel_launch(void* const* d_in, const int* in_sizes, int n_in, void* d_out, int out_size, void* d_ws, size_t ws_size, hipStream_t stream) {
    static int grid = 0;
    if (grid == 0) {
        if (n_in != N_IN || ws_size < WS_END) { fprintf(stderr, "kernel_launch: unexpected n_in %d or ws_size %zu\n", n_in, ws_size); grid = -1; return; }
        int dev = 0, cus = 0, per_cu = 0;
        hipGetDevice(&dev); hipDeviceGetAttribute(&cus, hipDeviceAttributeMultiprocessorCount, dev);
        hipFuncSetAttribute((const void*)mk_fwd, hipFuncAttributeMaxDynamicSharedMemorySize, LDS_BYTES);
        hipOccupancyMaxActiveBlocksPerMultiprocessor(&per_cu, (const void*)mk_fwd, NT, LDS_BYTES);
        (void)hipGetLastError();
        if (per_cu < 1) { fprintf(stderr, "kernel_launch: occupancy query says %d blocks per CU\n", per_cu); per_cu = 1; }
        grid = cus;
    }
    if (grid < 0) return;
    hipMemsetAsync((char*)d_ws + WS_CTL, 0, CTL_ZERO_BYTES, stream);
    Params p{};
    for (int i = 0; i < N_IN; ++i) p.in[i] = (const float*)d_in[i];
    p.out = (float*)d_out; p.ws = (unsigned char*)d_ws;
    void* args[] = {&p};
    hipError_t e = hipLaunchCooperativeKernel((const void*)mk_fwd, dim3(grid), dim3(NT), args, LDS_BYTES, stream);
    if (e != hipSuccess) fprintf(stderr, "kernel_launch: cooperative launch failed: %s (grid %d)\n", hipGetErrorString(e), grid);
}
```

```cpp
#include <hip/hip_runtime.h>
#include <cstdio>
#include <cstdint>

#define GAS __attribute__((address_space(1)))
#define LAS __attribute__((address_space(3)))
typedef unsigned short bf16;
typedef float f32x4 __attribute__((ext_vector_type(4)));
typedef unsigned u32x2 __attribute__((ext_vector_type(2)));
typedef unsigned u32x4 __attribute__((ext_vector_type(4)));

constexpr int D = 1024, NPROMPT = 32 * 256, NSAMPLE = 2 * 1024, M = NPROMPT + NSAMPLE;
constexpr int DEPTH = 4, DRNN = 1280, DB = 2048, DFF = 2816, PAST = 512, TKS = PAST + 1024;
constexpr float EPS = 1e-6f;
constexpr int NWAVES = 8, NT = NWAVES * 64;

enum { I_XP = 0, I_XS, I_STATE, I_CK, I_CV, I_C, I_CCTX, I_WMOD, I_BMOD, I_NORMG, I_LRU_WIN, I_LRU_CW, I_LRU_CB, I_LRU_WG, I_LRU_BG, I_LRU_LAM, I_LRU_WOUT,
       I_CM_WIN, I_CM_BIN, I_CM_NG, I_CM_WS, I_CM_BS, I_CM_WOUT, I_AT_WQKV, I_AT_QKG, I_AT_LAM, I_AT_SUBG, I_AT_WOUT, I_FF_WUP, I_FF_CW, I_FF_CB, I_FF_WDN, N_IN };
constexpr size_t O_YP = 0, O_YS = (size_t)NPROMPT * D, O_STATE = (size_t)M * D, O_CK = O_STATE + 32 * 2 * 2 * DRNN, O_CV = O_CK + (size_t)NPROMPT * D;

constexpr size_t MiB = 1u << 20;
constexpr size_t WS_CTL = 0, CTL_ZERO_BYTES = 64 * 1024;
constexpr size_t WS_MOD = 1 * MiB;
constexpr size_t WS_RSTD = WS_MOD + 512 * 1024;
constexpr size_t WS_ROPE = WS_RSTD + 256 * 1024;
constexpr size_t WS_H = 2 * MiB;
constexpr size_t WS_T1 = 22 * MiB;
constexpr size_t WS_T2 = 132 * MiB;
constexpr size_t WS_T3 = 187 * MiB;
constexpr size_t WS_KS = 237 * MiB, WS_VS = 243 * MiB;
constexpr size_t WS_W = 249 * MiB;
constexpr size_t WE_LRU_IN = 0, WE_LRU_OUT = WE_LRU_IN + (size_t)2 * 2560 * 1024, WE_CM_IN = WE_LRU_OUT + (size_t)2 * 1024 * 1280, WE_CM_OUT = WE_CM_IN + (size_t)4096 * 1024,
                 WE_QKV = WE_CM_OUT + (size_t)1024 * 2048, WE_AT_OUT = WE_QKV + (size_t)3072 * 1024, WE_UP = WE_AT_OUT + (size_t)1024 * 1024, WE_DN = WE_UP + (size_t)4 * 5632 * 1024,
                 WE_WG = WE_DN + (size_t)4 * 1024 * 2816, WE_WSB = WE_WG + (size_t)80 * 128 * 128, WE_END = WE_WSB + (size_t)8 * 128 * 128;
constexpr size_t WS_END = WS_W + 106 * MiB;
static_assert(WE_END * 2 <= 106 * MiB, "weight copies fit");
constexpr int CW_BAR = 1024;

__device__ __forceinline__ unsigned f2bf(float f) { unsigned u = __builtin_bit_cast(unsigned, f); return (u + 0x7fffu + ((u >> 16) & 1u)) >> 16; }
__device__ __forceinline__ float bf2f(unsigned b) { return __builtin_bit_cast(float, (b & 0xffffu) << 16); }
__device__ __forceinline__ float wave_sum(float v) {
#pragma unroll
    for (int o = 1; o < 64; o <<= 1) v += __shfl_xor(v, o);
    return v;
}
__device__ __forceinline__ float wave_max(float v) {
#pragma unroll
    for (int o = 1; o < 64; o <<= 1) v = fmaxf(v, __shfl_xor(v, o));
    return v;
}
__device__ __forceinline__ float gelu_tanh(float x) { const float y = 0.7978845608028654f * (x + 0.044715f * x * x * x); const float t = 1.f - 2.f / (__expf(2.f * y) + 1.f); return 0.5f * x * (1.f + t); }
__device__ __forceinline__ float sigmoidf_(float x) { return 1.f / (1.f + __expf(-x)); }
__device__ __forceinline__ float siluf_(float x) { return x / (1.f + __expf(-x)); }
__device__ __forceinline__ float softplusf_(float x) { return fmaxf(x, 0.f) + log1pf(expf(-fabsf(x))); }

#define XB_TMO      128
#define XB_XCNT(j)  (256  + 64 * (j))
#define XB_XSUB(j)  (1280 + 64 * (j))
#define XB_XGEN(j)  (2304 + 64 * (j))
#define XB_TOP      3328
#define XB_TOPGEN   3392
#define XCD_BAR_WORDS 3456
#define XB_SPIN_CAP (1u << 22)
__device__ __forceinline__ unsigned xb_ld(unsigned* p)              { return __hip_atomic_load(p, __ATOMIC_RELAXED, __HIP_MEMORY_SCOPE_AGENT); }
__device__ __forceinline__ unsigned xb_add(unsigned* p, unsigned v) { return __hip_atomic_fetch_add(p, v, __ATOMIC_RELAXED, __HIP_MEMORY_SCOPE_AGENT); }
__device__ __forceinline__ unsigned xb_xcc_id() { return (unsigned)__builtin_amdgcn_s_getreg((3 << 11) | 20) & 0xFu; }
#define XB_SPIN(cond, bar) do { unsigned _sp = 0; while (cond) { __builtin_amdgcn_s_sleep(1); \
    if ((++_sp & 255u) == 0u) { if (xb_ld(&(bar)[XB_TMO])) break; if (_sp > XB_SPIN_CAP) { atomicAdd(&(bar)[XB_TMO], 1u); break; } } } } while (0)
struct XcdBarrier { unsigned* bar; unsigned x; volatile LAS unsigned* st; };
__device__ __forceinline__ XcdBarrier xcd_barrier_post(unsigned* bar, volatile LAS unsigned* st) {
    XcdBarrier b; b.bar = bar; b.x = xb_xcc_id(); b.st = st;
    if (threadIdx.x == 0) (void)xb_add(&bar[XB_XCNT(b.x)], 1u);
    return b;
}
__device__ __forceinline__ void xcd_barrier_complete(unsigned* bar, unsigned x, unsigned& nloc, unsigned& nx) {
    const unsigned G = gridDim.x * gridDim.y * gridDim.z;
    unsigned sum, cnt, mine, sp = 0u;
    for (;;) {
        sum = 0u; cnt = 0u; mine = 0u;
#pragma unroll
        for (unsigned j = 0; j < 16; ++j) { const unsigned c = xb_ld(&bar[XB_XCNT(j)]); sum += c; cnt += (c > 0u) ? 1u : 0u; mine = (j == x) ? c : mine; }
        if (sum == G) break;
        __builtin_amdgcn_s_sleep(1);
        if ((++sp & 255u) == 0u) { if (xb_ld(&bar[XB_TMO])) break; if (sp > XB_SPIN_CAP) { atomicAdd(&bar[XB_TMO], 1u); break; } }
    }
    nloc = mine > 0u ? mine : 1u; nx = cnt > 0u ? cnt : 1u;
}
__device__ __forceinline__ void xcd_barrier(const XcdBarrier& b) {
    asm volatile("s_waitcnt vmcnt(0)" ::: "memory");
    __syncthreads();
    if (threadIdx.x == 0) {
        unsigned* bar = b.bar;
        __builtin_amdgcn_s_waitcnt(0);
        unsigned nloc = b.st[0], nx = b.st[1];
        if (nloc == 0u) { xcd_barrier_complete(bar, b.x, nloc, nx); b.st[0] = nloc; b.st[1] = nx; }
        const unsigned old = xb_add(&bar[XB_XSUB(b.x)], 1u);
        const unsigned gen = old / nloc;
        if (old + 1u == (gen + 1u) * nloc) {
            __builtin_amdgcn_fence(__ATOMIC_RELEASE, "agent");
            asm volatile("s_waitcnt vmcnt(0)" ::: "memory");
            const unsigned og = xb_add(&bar[XB_TOP], 1u);
            const unsigned tg = og / nx;
            if (og + 1u == (tg + 1u) * nx) xb_add(&bar[XB_TOPGEN], 1u);
            else XB_SPIN(xb_ld(&bar[XB_TOPGEN]) == tg, bar);
            __builtin_amdgcn_fence(__ATOMIC_ACQUIRE, "agent");
            xb_add(&bar[XB_XGEN(b.x)], 1u);
            asm volatile("s_waitcnt vmcnt(0)" ::: "memory");
        } else {
            XB_SPIN(xb_ld(&bar[XB_XGEN(b.x)]) == gen, bar);
            __builtin_amdgcn_fence(__ATOMIC_ACQUIRE, "agent");
            asm volatile("s_waitcnt vmcnt(0)" ::: "memory");
        }
    }
    __syncthreads();
}

namespace pg8 {
#define PG8_LAS __attribute__((address_space(3)))
typedef unsigned short bf16_t;
typedef short bf16x8 __attribute__((ext_vector_type(8)));
typedef float f32x4 __attribute__((ext_vector_type(4)));
typedef unsigned u32x4 __attribute__((ext_vector_type(4)));
constexpr int BM = 256, BK = 64, HALF = 128, HTB = HALF * BK * 2  , STAGE_BYTES = 8 * HTB, NXCD = 8, WGM = 8;

__host__ __device__ __forceinline__ int lds_byte(int r, int c) { const int st = (r >> 4) * 2 + (c >> 5), rr = r & 15, cc = c & 31, ob = rr * 64 + cc * 2; return st * 1024 + (ob ^ (((ob >> 9) & 1) << 5)); }
__host__ __device__ __forceinline__ void stage_rc(int b, int& R, int& C) { const int st = b / 1024, sb = b % 1024, swz = sb ^ (((sb >> 9) & 1) << 5); R = (st >> 1) * 16 + swz / 64; C = (st & 1) * 32 + (swz % 64) / 2; }
__host__ __device__ __forceinline__ int perm32(int rho) { const int n = rho >> 4, i = rho & 15; return 8 * (i >> 2) + 4 * n + (i & 3); }

struct Unit { int pm, pn; };
struct Gemm { const bf16_t* A; const bf16_t* Bt; int M, N, K; };

struct StaticOrder {
    int nM, nN, nwg, G, c;
    __host__ __device__ void init(int M, int N, int G_, int c_) { nM = M / BM; nN = N / BM; nwg = nM * nN; G = G_; c = c_; }
    __host__ __device__ bool next(int i, Unit& u) const {
        const long L = (long)i * G + c; if (L >= nwg) return false;
        int wgid = (int)L; { const int q = nwg / NXCD, r = nwg % NXCD, xcd = wgid % NXCD, off = wgid / NXCD; wgid = (xcd < r ? xcd * (q + 1) : r * (q + 1) + (xcd - r) * q) + off; }
        const int nig = WGM * nN, gid = wgid / nig, fm = gid * WGM, gsz = (nM - fm) < WGM ? (nM - fm) : WGM;
        u.pm = fm + ((wgid % nig) % gsz); u.pn = (wgid % nig) / gsz; return true;
    }
    __device__ __forceinline__ void a_ready(const Unit&) const {}
    __device__ __forceinline__ void done(const Unit&) const {}
};

template <class Epi, class Sched, bool ALIGN_EPI = false, bool SP2 = false>
__device__ __forceinline__ void gemm_phase(PG8_LAS unsigned char* lds, const Gemm g, const Sched& S, const Epi& E) {
    int tid_ = threadIdx.x; asm volatile("" : "+v"(tid_));
    const int tid = tid_, wid = __builtin_amdgcn_readfirstlane(tid >> 6), lane = tid & 63, wr = wid >> 2, wc = wid & 3, fr = lane & 15, fq = lane >> 4;
    const int K = g.K, nt = K / BK;
    unsigned voffA[2], voffB[2];
#pragma unroll
    for (int i = 0; i < 2; ++i) { int R, C; stage_rc(tid * 16 + i * 8192, R, C); const int Rb = Epi::PERM ? ((R & ~31) + perm32(R & 31)) : R;
        voffA[i] = (unsigned)(R * K + C) * 2u; voffB[i] = (unsigned)(Rb * K + C) * 2u; }
    const size_t kstep = (size_t)(BK * 2);
    const size_t hstep = (size_t)HALF * K * 2;
    const size_t tstep = 2 * hstep;
    const unsigned ldsw = (unsigned)wid * 1024u;
    const int aoff = lds_byte(wr * 64 + fr, fq * 8), boff = lds_byte(wc * 32 + fr, fq * 8);
#define PG8_SA(b, h) (((b) * 2 + (h)) * HTB)
#define PG8_SB(b, h) ((4 + (b) * 2 + (h)) * HTB)
#define PG8_STAGE(bufoff, gbase, voff) do { _Pragma("unroll") for (int _i = 0; _i < 2; ++_i) \
        __builtin_amdgcn_global_load_lds((const unsigned*)((const char*)(gbase) + (voff)[_i]), (PG8_LAS unsigned*)(lds + (bufoff) + ldsw + _i * 8192), 16, 0, 0); } while (0)
#define PG8_LDA(dst, b, h) do { _Pragma("unroll") for (int m = 0; m < 4; ++m) _Pragma("unroll") for (int k = 0; k < 2; ++k) dst[m][k] = *(const PG8_LAS bf16x8*)(lds + PG8_SA(b, h) + aoff + m * 2048 + k * 1024); } while (0)
#define PG8_LDB(dst, b, h) do { _Pragma("unroll") for (int n = 0; n < 2; ++n) _Pragma("unroll") for (int k = 0; k < 2; ++k) dst[n][k] = *(const PG8_LAS bf16x8*)(lds + PG8_SB(b, h) + boff + n * 2048 + k * 1024); } while (0)
#define PG8_MMA(ai, bj, At, Bt) do { __builtin_amdgcn_s_setprio(1); _Pragma("unroll") for (int m = 0; m < 4; ++m) _Pragma("unroll") for (int n = 0; n < 2; ++n) _Pragma("unroll") for (int k = 0; k < 2; ++k) \
        acc[ai][bj][m][n] = __builtin_amdgcn_mfma_f32_16x16x32_bf16(Bt[n][k], At[m][k], acc[ai][bj][m][n], 0, 0, 0); __builtin_amdgcn_s_setprio(0); } while (0)
#define PG8_WAIT_V(n) asm volatile("s_waitcnt vmcnt(" #n ")" ::: "memory")
#define PG8_WAIT_L(n) asm volatile("s_waitcnt lgkmcnt(" #n ")" ::: "memory")
#define PG8_BAR __builtin_amdgcn_s_barrier()
#define PG8_SCHED __builtin_amdgcn_sched_barrier(0)
    Unit cur, nxt; int ui = 0;
    if (!S.next(0, cur)) return;
    f32x4 acc[2][2][4][2];
#pragma unroll
    for (int a = 0; a < 2; ++a)
#pragma unroll
        for (int b = 0; b < 2; ++b)
#pragma unroll
            for (int m = 0; m < 4; ++m)
#pragma unroll
                for (int n = 0; n < 2; ++n) acc[a][b][m][n] = (f32x4){0.f, 0.f, 0.f, 0.f};
    bf16x8 At[4][2], B0[2][2], B1[2][2];
    const char* cA = (const char*)g.A + (size_t)cur.pm * tstep; const char* cB = (const char*)g.Bt + (size_t)cur.pn * tstep;
    S.a_ready(cur);
    if constexpr (SP2) {
        PG8_STAGE(PG8_SB(0, 0), cB, voffB); PG8_STAGE(PG8_SB(0, 1), cB + hstep, voffB); PG8_STAGE(PG8_SA(0, 0), cA, voffA); PG8_STAGE(PG8_SA(0, 1), cA + hstep, voffA);
        if (wr == 1) PG8_BAR;
        PG8_WAIT_V(2); PG8_BAR;
        PG8_STAGE(PG8_SB(1, 0), cB + kstep, voffB); PG8_STAGE(PG8_SA(1, 0), cA + kstep, voffA); PG8_STAGE(PG8_SB(1, 1), cB + hstep + kstep, voffB);
        PG8_WAIT_V(6); PG8_BAR;
    } else {
        PG8_STAGE(PG8_SB(0, 0), cB, voffB); PG8_STAGE(PG8_SA(0, 0), cA, voffA); PG8_STAGE(PG8_SB(0, 1), cB + hstep, voffB); PG8_STAGE(PG8_SA(0, 1), cA + hstep, voffA);
        if (wr == 1) PG8_BAR;
        PG8_WAIT_V(4); PG8_BAR;
        PG8_STAGE(PG8_SB(1, 0), cB + kstep, voffB); PG8_STAGE(PG8_SA(1, 0), cA + kstep, voffA); PG8_STAGE(PG8_SB(1, 1), cB + hstep + kstep, voffB);
        PG8_WAIT_V(6); PG8_BAR;
    }
    for (;;) {
        const bool has_next = S.next(ui + 1, nxt);
        const char* nA = has_next ? (const char*)g.A + (size_t)nxt.pm * tstep : cA; const char* nB = has_next ? (const char*)g.Bt + (size_t)nxt.pn * tstep : cB;
        for (int t = 0; t < nt; t += 2) {
            const bool last = (t == nt - 2);
            const char* a1 = cA + (size_t)(t + 1) * kstep;
            const char* a2 = last ? nA : cA + (size_t)(t + 2) * kstep; const char* b2 = last ? nB : cB + (size_t)(t + 2) * kstep;
            const char* a3 = a2 + kstep; const char* b3 = b2 + kstep;
            if (last && has_next) S.a_ready(nxt);
            if constexpr (SP2) {
            PG8_LDB(B0, 0, 0); PG8_LDB(B1, 0, 1); PG8_SCHED; PG8_LDA(At, 0, 0); PG8_STAGE(PG8_SA(1, 1), a1 + hstep, voffA);
            PG8_WAIT_V(8); PG8_WAIT_L(0); PG8_BAR; PG8_MMA(0, 0, At, B0); PG8_MMA(0, 1, At, B1); PG8_BAR; PG8_SCHED;
            PG8_LDA(At, 0, 1); PG8_STAGE(PG8_SB(0, 0), b2, voffB); PG8_STAGE(PG8_SB(0, 1), b2 + hstep, voffB); PG8_STAGE(PG8_SA(0, 0), a2, voffA);
            PG8_WAIT_V(8); PG8_WAIT_L(0); PG8_BAR; PG8_MMA(1, 0, At, B0); PG8_MMA(1, 1, At, B1); PG8_BAR; PG8_SCHED;
            PG8_LDB(B0, 1, 0); PG8_LDB(B1, 1, 1); PG8_SCHED; PG8_LDA(At, 1, 0); PG8_STAGE(PG8_SA(0, 1), a2 + hstep, voffA);
            PG8_WAIT_V(8); PG8_WAIT_L(0); PG8_BAR; PG8_MMA(0, 0, At, B0); PG8_MMA(0, 1, At, B1); PG8_BAR; PG8_SCHED;
            PG8_LDA(At, 1, 1); PG8_STAGE(PG8_SB(1, 0), b3, voffB); PG8_STAGE(PG8_SB(1, 1), b3 + hstep, voffB); PG8_STAGE(PG8_SA(1, 0), a3, voffA);
            PG8_WAIT_V(8); PG8_WAIT_L(0); PG8_BAR; PG8_MMA(1, 0, At, B0); PG8_MMA(1, 1, At, B1); PG8_BAR; PG8_SCHED;
            } else {
            PG8_LDB(B0, 0, 0); PG8_SCHED; PG8_LDA(At, 0, 0); PG8_STAGE(PG8_SA(1, 1), a1 + hstep, voffA);
            PG8_WAIT_L(8); PG8_BAR; PG8_WAIT_L(0); PG8_MMA(0, 0, At, B0); PG8_BAR; PG8_SCHED;
            PG8_LDB(B1, 0, 1); PG8_STAGE(PG8_SB(0, 0), b2, voffB);
            PG8_BAR; PG8_WAIT_L(0); PG8_MMA(0, 1, At, B1); PG8_BAR;
            PG8_LDA(At, 0, 1); PG8_STAGE(PG8_SA(0, 0), a2, voffA);
            PG8_BAR; PG8_WAIT_L(0); PG8_MMA(1, 0, At, B0); PG8_BAR; PG8_SCHED;
            PG8_STAGE(PG8_SB(0, 1), b2 + hstep, voffB);
            PG8_WAIT_V(6); PG8_BAR; PG8_MMA(1, 1, At, B1); PG8_BAR;
            PG8_LDB(B0, 1, 0); PG8_SCHED; PG8_LDA(At, 1, 0); PG8_STAGE(PG8_SA(0, 1), a2 + hstep, voffA);
            PG8_WAIT_L(8); PG8_BAR; PG8_WAIT_L(0); PG8_MMA(0, 0, At, B0); PG8_BAR; PG8_SCHED;
            PG8_LDB(B1, 1, 1); PG8_STAGE(PG8_SB(1, 0), b3, voffB);
            PG8_BAR; PG8_WAIT_L(0); PG8_MMA(0, 1, At, B1); PG8_BAR;
            PG8_LDA(At, 1, 1); PG8_STAGE(PG8_SA(1, 0), a3, voffA);
            PG8_BAR; PG8_WAIT_L(0); PG8_MMA(1, 0, At, B0); PG8_BAR; PG8_SCHED;
            PG8_STAGE(PG8_SB(1, 1), b3 + hstep, voffB);
            PG8_WAIT_V(6); PG8_BAR; PG8_MMA(1, 1, At, B1); PG8_BAR;
            }
        }
        if constexpr (ALIGN_EPI) { if (wr == 0) PG8_BAR; }
        if constexpr (!Epi::AFTER_DRAIN) { E(acc, cur, wr, wc, fr, fq); S.done(cur); }
        if (!has_next) break;
#pragma unroll
        for (int a = 0; a < 2; ++a)
#pragma unroll
            for (int b = 0; b < 2; ++b)
#pragma unroll
                for (int m = 0; m < 4; ++m)
#pragma unroll
                    for (int n = 0; n < 2; ++n) acc[a][b][m][n] = (f32x4){0.f, 0.f, 0.f, 0.f};
        cur = nxt; cA = nA; cB = nB; ++ui;
        if constexpr (ALIGN_EPI) { if (wr == 1) PG8_BAR; }
    }
    PG8_WAIT_V(0);
    if constexpr (!ALIGN_EPI) { if (wr == 0) PG8_BAR; }
    PG8_BAR;
    if constexpr (Epi::AFTER_DRAIN) { E.fused(acc, cur, wr, wc, fr, fq, lds, wid, lane); S.done(cur); }
#undef PG8_SA
#undef PG8_SB
#undef PG8_STAGE
#undef PG8_LDA
#undef PG8_LDB
#undef PG8_MMA
#undef PG8_WAIT_V
#undef PG8_WAIT_L
#undef PG8_BAR
#undef PG8_SCHED
}
}

namespace pg8 {
__device__ __forceinline__ unsigned cvt_pk_bf16(float lo, float hi) { unsigned r; asm volatile("v_cvt_pk_bf16_f32 %0, %1, %2" : "=v"(r) : "v"(lo), "v"(hi)); return r; }
__device__ __forceinline__ f32x4 gelu4(f32x4 v) { f32x4 o; o.x = gelu_tanh(v.x); o.y = gelu_tanh(v.y); o.z = gelu_tanh(v.z); o.w = gelu_tanh(v.w); return o; }
template <int ACT> struct EpiBf16 {
    static constexpr bool PERM = true, AFTER_DRAIN = false;
    bf16_t* O; int ldc; const float* bias; int split_cols; size_t split_stride;
    __device__ __forceinline__ void operator()(const f32x4 (&acc)[2][2][4][2], const Unit& u, int wr, int wc, int fr, int fq) const {
        const int row0 = u.pm * BM + wr * 64 + fr; int colt = u.pn * BM; bf16_t* base = O; int t = 0;
        if (split_cols) { t = colt / split_cols; base += (size_t)t * split_stride; colt -= t * split_cols; }
        const bool act = (ACT == 1) || (ACT == 2 && t == 0);
        const int col0 = colt + wc * 32 + 8 * fq, bcol0 = u.pn * BM + wc * 32 + 8 * fq;
        f32x4 bv[2][2];
#pragma unroll
        for (int bj = 0; bj < 2; ++bj)
#pragma unroll
            for (int n = 0; n < 2; ++n) bv[bj][n] = bias ? *(const GAS f32x4*)(bias + bcol0 + bj * HALF + 4 * n) : (f32x4){0.f, 0.f, 0.f, 0.f};
#pragma unroll
        for (int ai = 0; ai < 2; ++ai)
#pragma unroll
            for (int m = 0; m < 4; ++m) { bf16_t* rowp = base + (size_t)(row0 + ai * HALF + m * 16) * ldc + col0;
#pragma unroll
                for (int bj = 0; bj < 2; ++bj) { f32x4 v0 = acc[ai][bj][m][0] + bv[bj][0], v1 = acc[ai][bj][m][1] + bv[bj][1];
                    if (ACT != 0) { if (act) { v0 = gelu4(v0); v1 = gelu4(v1); } }
                    u32x4 w; w.x = cvt_pk_bf16(v0[0], v0[1]); w.y = cvt_pk_bf16(v0[2], v0[3]); w.z = cvt_pk_bf16(v1[0], v1[1]); w.w = cvt_pk_bf16(v1[2], v1[3]);
                    *(GAS u32x4*)(rowp + bj * HALF) = w; } }
    }
};
struct EpiResid {
    static constexpr bool PERM = false, AFTER_DRAIN = false;
    float* out; const float* xp; const float* xs; const float* modl; int which; bool from_input;
    __device__ __forceinline__ void operator()(const f32x4 (&acc)[2][2][4][2], const Unit& u, int wr, int wc, int fr, int fq) const {
        const int trow = u.pm * BM, row0 = wr * 64 + fr, col0 = u.pn * BM + wc * 32 + 4 * fq;
        const int ci = trow < NPROMPT ? 0 : 1 + ((trow - NPROMPT) >> 10);
        const float* gp = modl + (size_t)(ci * 6 + which) * D + col0;
        const float* bp = from_input ? (trow < NPROMPT ? xp + (size_t)trow * D : xs + (size_t)(trow - NPROMPT) * D) : out + (size_t)trow * D;
        GAS float* op = (GAS float*)(out + (size_t)trow * D); const GAS float* bpg = (const GAS float*)bp; const GAS float* gpg = (const GAS float*)gp;
        f32x4 gv[2][2];
#pragma unroll
        for (int bj = 0; bj < 2; ++bj)
#pragma unroll
            for (int n = 0; n < 2; ++n) gv[bj][n] = *(const GAS f32x4*)(gpg + bj * HALF + n * 16);
#pragma unroll
        for (int ai = 0; ai < 2; ++ai)
#pragma unroll
            for (int m = 0; m < 4; ++m) { const size_t off = (size_t)(row0 + ai * HALF + m * 16) * D + col0;
                f32x4 bs[2][2];
#pragma unroll
                for (int bj = 0; bj < 2; ++bj)
#pragma unroll
                    for (int n = 0; n < 2; ++n) bs[bj][n] = *(const GAS f32x4*)(bpg + off + bj * HALF + n * 16);
#pragma unroll
                for (int bj = 0; bj < 2; ++bj)
#pragma unroll
                    for (int n = 0; n < 2; ++n) *(GAS f32x4*)(op + off + bj * HALF + n * 16) = bs[bj][n] + gv[bj][n] * acc[ai][bj][m][n];
                asm volatile("" ::: "memory"); }
    }
};
}

struct Params { const float* in[N_IN]; float* out; unsigned char* ws; };
struct Frame {
    LAS unsigned char* lds; int tid, lane, wave, bid, G;
    const float* const* in; float* out; unsigned char* ws; float* out0; unsigned char* ws0;
    float* mod; float* rstd; float* rope; bf16 *H, *T1, *T2, *T3, *KS, *VS, *WT;
    __device__ __forceinline__ void fresh() {
        int t = threadIdx.x; asm volatile("" : "+v"(t)); tid = t; lane = t & 63; wave = __builtin_amdgcn_readfirstlane(t >> 6);
        int b = blockIdx.x; asm volatile("" : "+s"(b)); bid = b;
        unsigned char* w = ws0; asm volatile("" : "+s"(w)); ws = w; float* o = out0; asm volatile("" : "+s"(o)); out = o;
        mod = (float*)(w + WS_MOD); rstd = (float*)(w + WS_RSTD); rope = (float*)(w + WS_ROPE);
        H = (bf16*)(w + WS_H); T1 = (bf16*)(w + WS_T1); T2 = (bf16*)(w + WS_T2); T3 = (bf16*)(w + WS_T3); KS = (bf16*)(w + WS_KS); VS = (bf16*)(w + WS_VS); WT = (bf16*)(w + WS_W);
    }
};
__device__ __forceinline__ const float* xin_row(const Frame& F, int row) { return row < NPROMPT ? F.in[I_XP] + (size_t)row * D : F.in[I_XS] + (size_t)(row - NPROMPT) * D; }
__device__ __forceinline__ int cidx_of(int row) { return row < NPROMPT ? 0 : 1 + ((row - NPROMPT) >> 10); }
__device__ __forceinline__ const float* modp(const Frame& F, int l, int row, int which) { return F.mod + (size_t)((l * 3 + cidx_of(row)) * 6 + which) * D; }


__device__ __forceinline__ void transpose_item(const float* W, int K, int N, bf16* WT, LAS float* scr, int item, int lane) {
    const int nblk = N / 32, kb = item / nblk, nb = item % nblk, k0 = 64 * kb, n0 = 32 * nb;
#pragma unroll 8
    for (int i = 0; i < 32; ++i) { const int kk = 2 * i + (lane >> 5); scr[kk * 33 + (lane & 31)] = W[(size_t)(k0 + kk) * N + n0 + (lane & 31)]; }
    asm volatile("s_waitcnt lgkmcnt(0)" ::: "memory");
    const int c = lane & 7;
#pragma unroll
    for (int j = 0; j < 4; ++j) { const int n = (lane >> 3) + 8 * j; const LAS float* sp = scr + (8 * c) * 33 + n;
        u32x4 o; o.x = f2bf(sp[0 * 33]) | (f2bf(sp[1 * 33]) << 16); o.y = f2bf(sp[2 * 33]) | (f2bf(sp[3 * 33]) << 16); o.z = f2bf(sp[4 * 33]) | (f2bf(sp[5 * 33]) << 16); o.w = f2bf(sp[6 * 33]) | (f2bf(sp[7 * 33]) << 16);
        *(u32x4*)(WT + (size_t)(n0 + n) * K + k0 + 8 * c) = o; }
    asm volatile("s_waitcnt lgkmcnt(0)" ::: "memory");
}
__device__ __forceinline__ bool transpose_group(int& r, const float* W, int nmat, int K, int N, bf16* WT, LAS float* scr, int lane) {
    const int per = (K / 64) * (N / 32), tot = nmat * per;
    if (r >= tot) { r -= tot; return false; }
    const int mi = r / per; transpose_item(W + (size_t)mi * K * N, K, N, WT + (size_t)mi * K * N, scr, r % per, lane); return true;
}
__device__ __forceinline__ void phase_prologue(Frame& F) {
    F.fresh();
    LAS float* sc = (LAS float*)F.lds;
    const float* c = F.in[I_C]; const float* cctx = F.in[I_CCTX];
    for (int i = F.tid; i < 3 * D; i += NT) { const int ci = i >> 10, k = i & 1023; const float v = ci == 0 ? cctx[k] : c[(ci - 1) * D + k]; sc[i] = siluf_(v); }
    __syncthreads();
    LAS float* part = sc + 3 * D;
    const int kp = F.tid >> 6, cl = F.tid & 63;
    for (int item = F.bid; item < DEPTH * 6 * D / 64; item += F.G) {
        const int col = item * 64 + cl, l = col / (6 * D), cc = col % (6 * D);
        const float* w = F.in[I_WMOD] + (size_t)l * D * 6 * D + cc;
        float s0 = 0.f, s1 = 0.f, s2 = 0.f;
        for (int k = kp * 128; k < kp * 128 + 128; ++k) { const float wv = w[(size_t)k * 6 * D]; s0 += sc[k] * wv; s1 += sc[D + k] * wv; s2 += sc[2 * D + k] * wv; }
        part[(kp * 3 + 0) * 64 + cl] = s0; part[(kp * 3 + 1) * 64 + cl] = s1; part[(kp * 3 + 2) * 64 + cl] = s2;
        __syncthreads();
        if (F.tid < 192) { const int ci = F.tid >> 6; float s = F.in[I_BMOD][l * 6 * D + cc];
            for (int q = 0; q < 8; ++q) s += part[(q * 3 + ci) * 64 + cl];
            F.mod[(size_t)((l * 3 + ci) * 6) * D + cc] = s; }
        __syncthreads();
    }
    { __syncthreads();
      LAS float* scr = (LAS float*)(F.lds + F.wave * 16384);
      const int gw = F.bid * NWAVES + F.wave, NGW = F.G * NWAVES;
      constexpr int NITEMS = (int)(WE_END / 2048);
      for (int it = gw; it < NITEMS; it += NGW) { int r = it;
          if (transpose_group(r, F.in[I_FF_WUP], 4, D, 2 * DFF, F.WT + WE_UP, scr, F.lane)) continue;
          if (transpose_group(r, F.in[I_FF_WDN], 4, DFF, D, F.WT + WE_DN, scr, F.lane)) continue;
          if (transpose_group(r, F.in[I_LRU_WIN], 2, D, 2 * DRNN, F.WT + WE_LRU_IN, scr, F.lane)) continue;
          if (transpose_group(r, F.in[I_LRU_WOUT], 2, DRNN, D, F.WT + WE_LRU_OUT, scr, F.lane)) continue;
          if (transpose_group(r, F.in[I_CM_WIN], 1, D, 2 * DB, F.WT + WE_CM_IN, scr, F.lane)) continue;
          if (transpose_group(r, F.in[I_CM_WOUT], 1, DB, D, F.WT + WE_CM_OUT, scr, F.lane)) continue;
          if (transpose_group(r, F.in[I_AT_WQKV], 1, D, 3 * D, F.WT + WE_QKV, scr, F.lane)) continue;
          if (transpose_group(r, F.in[I_AT_WOUT], 1, D, D, F.WT + WE_AT_OUT, scr, F.lane)) continue;
          transpose_group(r, F.in[I_LRU_WG], 80, 128, 128, F.WT + WE_WG, scr, F.lane); } }
    const int gt = F.bid * NT + F.tid, GT = F.G * NT;
    for (int i = gt; i < 1024 * 32; i += GT) { const int t = i >> 5, j = i & 31; const float inv = powf(10000.f, -(float)(j & 15) / 16.f); const float pos = (float)(j < 16 ? (t >> 6) : (t & 63));
        const float ang = pos * inv; F.rope[i] = cosf(ang); F.rope[32768 + i] = sinf(ang); }
    for (int i = gt; i < 8 * 8 * 4 * 64; i += GT) { const int ln = i & 63, ks = (i >> 6) & 3, nf = (i >> 8) & 7, g = i >> 11, cq = ln >> 4, p = 16 * nf + (ln & 15);
        const float* wr = F.in[I_CM_WS] + (size_t)(g * 128 + p) * 128 + 32 * ks + 4 * cq;
        u32x4 o; o.x = f2bf(wr[0]) | (f2bf(wr[1]) << 16); o.y = f2bf(wr[2]) | (f2bf(wr[3]) << 16); o.z = f2bf(wr[16]) | (f2bf(wr[17]) << 16); o.w = f2bf(wr[18]) | (f2bf(wr[19]) << 16);
        *(u32x4*)(F.WT + WE_WSB + (size_t)i * 8) = o; }
    for (int i = gt; i < 2 * PAST * D; i += GT) { const int b = i / (PAST * D), r = i % (PAST * D);
        F.KS[(size_t)b * TKS * D + r] = (bf16)f2bf(F.in[I_CK][i]); F.VS[(size_t)b * TKS * D + r] = (bf16)f2bf(F.in[I_CV][i]); }
}

__device__ __forceinline__ void phase_modulate(Frame& F, int l, int sub) {
    F.fresh();
    const int gw = F.bid * NWAVES + F.wave, NGW = F.G * NWAVES;
    const float* g = F.in[I_NORMG] + (size_t)(l * 2 + sub) * D;
    for (int row = gw; row < M; row += NGW) {
        const float* xr = (l == 0 && sub == 0) ? xin_row(F, row) : F.out + (size_t)row * D;
        const float* sh = modp(F, l, row, sub * 3 + 0); const float* scl = modp(F, l, row, sub * 3 + 1);
        f32x4 v[4]; float s = 0.f;
#pragma unroll
        for (int j = 0; j < 4; ++j) { v[j] = *(const f32x4*)(xr + 4 * F.lane + 256 * j); s += v[j].x * v[j].x + v[j].y * v[j].y + v[j].z * v[j].z + v[j].w * v[j].w; }
        const float rstd = rsqrtf(wave_sum(s) * (1.f / D) + EPS);
#pragma unroll
        for (int j = 0; j < 4; ++j) { const int c0 = 4 * F.lane + 256 * j; const f32x4 gg = *(const f32x4*)(g + c0), s4 = *(const f32x4*)(sh + c0), c4 = *(const f32x4*)(scl + c0);
            const f32x4 o = v[j] * rstd * gg * (1.f + c4) + s4; u32x2 w; w.x = f2bf(o.x) | (f2bf(o.y) << 16); w.y = f2bf(o.z) | (f2bf(o.w) << 16);
            *(u32x2*)(F.H + (size_t)row * D + c0) = w; }
    }
}

template <class P>
__device__ __forceinline__ void gemm_naive(Frame& F, const P& p, int nbatch, int Mr, int N, int K) {
    F.fresh();
    LAS float* As = (LAS float*)F.lds;
    LAS float* Bs = As + 16 * 132;
    const int tid = F.tid, tx = tid & 31, ty = tid >> 5;
    const int tm = Mr / 128, tn = N / 128, per = tm * tn, total = per * nbatch;
    for (int t = F.bid; t < total; t += F.G) {
        const int b = t / per, r = t % per, pn = r / tm, pm = r % tm;
        const bf16* A; int lda; const float* W; int ldw; p.get(b, A, lda, W, ldw);
        float acc[8][4];
#pragma unroll
        for (int i = 0; i < 8; ++i)
#pragma unroll
            for (int j = 0; j < 4; ++j) acc[i][j] = 0.f;
        for (int k0 = 0; k0 < K; k0 += 16) {
            { const int row = tid >> 2, kq = (tid & 3) * 4;
              const u32x2 v = *(const u32x2*)(A + (size_t)(pm * 128 + row) * lda + k0 + kq);
              As[(kq + 0) * 132 + row] = bf2f(v.x); As[(kq + 1) * 132 + row] = bf2f(v.x >> 16); As[(kq + 2) * 132 + row] = bf2f(v.y); As[(kq + 3) * 132 + row] = bf2f(v.y >> 16); }
            { const int k = tid >> 5, n4 = (tid & 31) * 4;
              *(LAS f32x4*)(Bs + k * 128 + n4) = *(const f32x4*)(W + (size_t)(k0 + k) * ldw + pn * 128 + n4); }
            __syncthreads();
#pragma unroll 2
            for (int k = 0; k < 16; ++k) {
                const f32x4 a0 = *(const LAS f32x4*)(As + k * 132 + ty * 8), a1 = *(const LAS f32x4*)(As + k * 132 + ty * 8 + 4), bv = *(const LAS f32x4*)(Bs + k * 128 + tx * 4);
                const float a[8] = {a0.x, a0.y, a0.z, a0.w, a1.x, a1.y, a1.z, a1.w}; const float bb[4] = {bv.x, bv.y, bv.z, bv.w};
#pragma unroll
                for (int i = 0; i < 8; ++i)
#pragma unroll
                    for (int j = 0; j < 4; ++j) acc[i][j] += a[i] * bb[j];
            }
            __syncthreads();
        }
#pragma unroll
        for (int i = 0; i < 8; ++i)
#pragma unroll
            for (int j = 0; j < 4; ++j) p.epi(b, pm * 128 + ty * 8 + i, pn * 128 + tx * 4 + j, acc[i][j]);
    }
}

struct PStoreBf16 {
    const bf16* A; int lda; const float* W; int ldw; bf16* O; int ldo; const float* bias; int act; int split;
    __device__ __forceinline__ void get(int, const bf16*& a, int& la, const float*& w, int& lw) const { a = A; la = lda; w = W; lw = ldw; }
    __device__ __forceinline__ void epi(int, int row, int col, float v) const {
        if (bias) v += bias[col];
        if (act == 1 || (act == 2 && col < split)) v = gelu_tanh(v);
        O[(size_t)row * ldo + col] = (bf16)f2bf(v); }
};
struct PResid {
    const bf16* A; int lda; const float* W; int ldw; float* out; const float* xp; const float* xs; const float* modl; int which; bool from_input;
    __device__ __forceinline__ void get(int, const bf16*& a, int& la, const float*& w, int& lw) const { a = A; la = lda; w = W; lw = ldw; }
    __device__ __forceinline__ void epi(int, int row, int col, float v) const {
        const float base = from_input ? (row < NPROMPT ? xp[(size_t)row * D + col] : xs[(size_t)(row - NPROMPT) * D + col]) : out[(size_t)row * D + col];
        out[(size_t)row * D + col] = base + modl[(size_t)(cidx_of(row) * 6 + which) * D + col] * v; }
};
struct PLruIn {
    const bf16* A; const float* W; bf16* GBp; bf16* RECp;
    __device__ __forceinline__ void get(int, const bf16*& a, int& la, const float*& w, int& lw) const { a = A; la = D; w = W; lw = 2 * DRNN; }
    __device__ __forceinline__ void epi(int, int row, int col, float v) const {
        if (col < DRNN) GBp[(size_t)row * DRNN + col] = (bf16)f2bf(gelu_tanh(v)); else RECp[(size_t)row * DRNN + col - DRNN] = (bf16)f2bf(v); }
};
struct PGates {
    const bf16* XC; const float* WG; const float* BG; bf16* O;
    __device__ __forceinline__ void get(int b, const bf16*& a, int& la, const float*& w, int& lw) const { a = XC + (b % 10) * 128; la = DRNN; w = WG + (size_t)b * 128 * 128; lw = 128; }
    __device__ __forceinline__ void epi(int b, int row, int col, float v) const { const int dg = b / 10, n = b % 10;
        O[((size_t)dg * M + row) * DRNN + n * 128 + col] = (bf16)f2bf(sigmoidf_(v + BG[dg * DRNN + n * 128 + col])); }
};

__device__ __forceinline__ void phase_lru_conv(Frame& F, int j, const bf16* REC, bf16* XC) {
    F.fresh();
    const float* cw = F.in[I_LRU_CW] + (size_t)j * 4 * DRNN; const float* cb = F.in[I_LRU_CB] + (size_t)j * DRNN;
    const int gt = F.bid * NT + F.tid, GT = F.G * NT;
    for (int i = gt; i < M * DRNN; i += GT) { const int row = i / DRNN, ch = i % DRNN;
        int t, T; if (row < NPROMPT) { t = row & 255; T = 256; } else { t = (row - NPROMPT) & 1023; T = 1024; }
        float s = cb[ch];
#pragma unroll
        for (int k = 0; k < 4; ++k) { const int tt = t + k - 2; if (tt >= 0 && tt < T) s += cw[k * DRNN + ch] * bf2f(REC[(size_t)(row + k - 2) * DRNN + ch]); }
        XC[i] = (bf16)f2bf(s); }
}
__device__ __forceinline__ void phase_lru_scan(Frame& F, int j, const bf16* GATES, const bf16* XC, const bf16* GB, bf16* HS) {
    F.fresh();
    const int gt = F.bid * NT + F.tid, GT = F.G * NT;
    const int NL = (2 + 32) * DRNN;
    for (int line = gt; line < NL; line += GT) {
        const int s = line / DRNN, ch = line % DRNN;
        int base, T; float h0f = 0.f, h0b = 0.f;
        if (s < 2) { base = NPROMPT + s * 1024; T = 1024; h0f = F.in[I_STATE][((size_t)(s * 2 + j) * 2 + 0) * DRNN + ch]; h0b = F.in[I_STATE][((size_t)(s * 2 + j) * 2 + 1) * DRNN + ch]; }
        else { base = (s - 2) * 256; T = 256; }
        const float spf = softplusf_(-F.in[I_LRU_LAM][(size_t)(j * 2 + 0) * DRNN + ch]), spb = softplusf_(-F.in[I_LRU_LAM][(size_t)(j * 2 + 1) * DRNN + ch]);
        float h = h0f;
        for (int t = 0; t < T; ++t) { const size_t o = (size_t)(base + t) * DRNN + ch;
            const float r = bf2f(GATES[o]), ig = bf2f(GATES[(size_t)M * DRNN + o]), xc = bf2f(XC[o]);
            const float la = -8.f * r * spf, a = expf(la), bx = sqrtf(-expm1f(2.f * la)) * (ig * xc);
            h = a * h + bx; HS[o] = (bf16)f2bf(h); }
        const float ff = h;
        h = h0b;
        for (int t = T - 1; t >= 0; --t) { const size_t o = (size_t)(base + t) * DRNN + ch;
            const float r = bf2f(GATES[(size_t)2 * M * DRNN + o]), ig = bf2f(GATES[(size_t)3 * M * DRNN + o]), xc = bf2f(XC[o]);
            const float la = -8.f * r * spb, a = expf(la), bx = sqrtf(-expm1f(2.f * la)) * (ig * xc);
            h = a * h + bx; HS[o] = (bf16)f2bf(bf2f(GB[o]) * (bf2f(HS[o]) + h)); }
        if (s >= 2) { float* st = F.out + O_STATE + ((size_t)((s - 2) * 2 + j) * 2) * DRNN; st[ch] = ff; st[DRNN + ch] = h; }
    }
}


typedef short bf16x8 __attribute__((ext_vector_type(8)));
typedef short v4i16_t __attribute__((ext_vector_type(4)));
constexpr int LRU_XS = 272;
constexpr int LRU_XC_OFF = 0, LRU_GB_OFF = 256 * LRU_XS;
template <bool REV>
__device__ __forceinline__ float lru_dir(LAS const unsigned char* xct, LAS unsigned char* hft, const bf16* wgt  ,
                                         const bf16* gbp  , float br, float bi, float sp, float hc, int wave, int lane, bool wantp, bf16* Pdst) {
    const int c = lane & 15, q = lane >> 4, qq = REV ? 3 - q : q;
    bf16x8 Br[4], Bi[4], Id;
#pragma unroll
    for (int ks = 0; ks < 4; ++ks) { Br[ks] = *(const GAS bf16x8*)(wgt + (size_t)(16 * wave + c) * 128 + 32 * ks + 8 * q);
                                     Bi[ks] = *(const GAS bf16x8*)(wgt + (size_t)10 * 128 * 128 + (size_t)(16 * wave + c) * 128 + 32 * ks + 8 * q); }
#pragma unroll
    for (int jj = 0; jj < 8; ++jj) Id[jj] = (8 * q + jj == 16 * (wave & 1) + c) ? (short)0x3F80 : (short)0;
    const int ksel = wave >> 1;
    float Pc = 1.f;
#pragma unroll 2
    for (int it = 0; it < 16; ++it) {
        const int mi = REV ? 15 - it : it;
        LAS const unsigned char* rp = xct + (16 * mi + c) * LRU_XS + 16 * q;
        float gbv[4];
        if (REV) {
#pragma unroll
            for (int k = 0; k < 4; ++k) gbv[k] = bf2f(*(const GAS unsigned short*)(gbp + (size_t)(16 * mi + 4 * q + k) * DRNN)); }
        bf16x8 Af[4];
#pragma unroll
        for (int ks = 0; ks < 4; ++ks) Af[ks] = *(LAS const bf16x8*)(rp + 64 * ks);
        const bf16x8 Ax = *(LAS const bf16x8*)(rp + 64 * ksel);
        f32x4 r = {0.f, 0.f, 0.f, 0.f}, ig = {0.f, 0.f, 0.f, 0.f};
#pragma unroll
        for (int ks = 0; ks < 4; ++ks) { r = __builtin_amdgcn_mfma_f32_16x16x32_bf16(Af[ks], Br[ks], r, 0, 0, 0); ig = __builtin_amdgcn_mfma_f32_16x16x32_bf16(Af[ks], Bi[ks], ig, 0, 0, 0); }
        const f32x4 xc = __builtin_amdgcn_mfma_f32_16x16x32_bf16(Ax, Id, (f32x4){0.f, 0.f, 0.f, 0.f}, 0, 0, 0);
        float av[4], bv[4];
#pragma unroll
        for (int k = 0; k < 4; ++k) { const float rg = sigmoidf_(r[k] + br), iv = sigmoidf_(ig[k] + bi);
            const float la = -8.f * rg * sp, x = 2.f * la;
            const float oms = -x * (1.f + x * (0.5f + x * (0.16666667f + x * (0.041666668f + x * 0.0083333338f))));
            const float om = x > -0.25f ? oms : 1.f - __expf(x);
            av[k] = __expf(la); bv[k] = sqrtf(om) * (iv * xc[k]); }
        float pA[4], pB[4];
#pragma unroll
        for (int kk = 0; kk < 4; ++kk) { const int k = REV ? 3 - kk : kk;
            if (kk == 0) { pA[k] = av[k]; pB[k] = bv[k]; } else { const int kp = REV ? k + 1 : k - 1; pA[k] = pA[kp] * av[k]; pB[k] = pB[kp] * av[k] + bv[k]; } }
        const int kl = REV ? 0 : 3;
        float gA = pA[kl], gB = pB[kl];
        { const float tA = REV ? __shfl_down(gA, 16) : __shfl_up(gA, 16), tB = REV ? __shfl_down(gB, 16) : __shfl_up(gB, 16); if (qq >= 1) { gB = tB * gA + gB; gA = tA * gA; } }
        { const float tA = REV ? __shfl_down(gA, 32) : __shfl_up(gA, 32), tB = REV ? __shfl_down(gB, 32) : __shfl_up(gB, 32); if (qq >= 2) { gB = tB * gA + gB; gA = tA * gA; } }
        float eA = REV ? __shfl_down(gA, 16) : __shfl_up(gA, 16), eB = REV ? __shfl_down(gB, 16) : __shfl_up(gB, 16); if (qq == 0) { eA = 1.f; eB = 0.f; }
        const int src = (REV ? 0 : 48) + c;
        const float totA = __shfl(gA, src), totB = __shfl(gB, src);
        const float hin = eA * hc + eB;
#pragma unroll
        for (int k = 0; k < 4; ++k) { const float h = pA[k] * hin + pB[k]; const int row = 16 * mi + 4 * q + k;
            if (wantp) Pdst[(size_t)row * DRNN] = (bf16)f2bf(pA[k] * eA * Pc);
            LAS unsigned short* hp = (LAS unsigned short*)(hft + row * LRU_XS + 2 * (16 * wave + c));
            if (!REV) *hp = (unsigned short)f2bf(h); else *hp = (unsigned short)f2bf(gbv[k] * (bf2f(*hp) + h)); }
        hc = totA * hc + totB; Pc *= totA;
    }
    return hc;
}
__device__ __forceinline__ void lru_unit(Frame& F, int j, int pm, int n, const bf16* REC, const bf16* GB, bf16* HS, bf16* PF, bf16* PB, float* AGG, const bf16* WGT) {
    const int tid = F.tid, lane = F.lane, wave = F.wave, r0 = 256 * pm;
    const bool smp = pm >= 32; const int tix = smp ? (pm - 32) & 3 : 0, sq = smp ? (pm - 32) >> 2 : 0;
    const int t0 = smp ? 256 * tix : 0, T = smp ? 1024 : 256;
    LAS unsigned char* xct = F.lds + LRU_XC_OFF; LAS unsigned char* hft = F.lds + LRU_GB_OFF;
    { const float* cw = F.in[I_LRU_CW] + (size_t)j * 4 * DRNN + n * 128 + 2 * lane; const float* cb = F.in[I_LRU_CB] + (size_t)j * DRNN + n * 128 + 2 * lane;
      float w0[4], w1[4];
#pragma unroll
      for (int k = 0; k < 4; ++k) { w0[k] = cw[k * DRNN]; w1[k] = cw[k * DRNN + 1]; }
      const float b0 = cb[0], b1 = cb[1];
      unsigned v[35];
#pragma unroll
      for (int i = 0; i < 35; ++i) { const int tl = 32 * wave + i - 2, tt = t0 + tl;
          v[i] = (tt >= 0 && tt < T) ? *(const GAS unsigned*)(REC + (size_t)(r0 + tl) * DRNN + n * 128 + 2 * lane) : 0u; }
#pragma unroll
      for (int i = 0; i < 32; ++i) { float s0 = b0, s1 = b1;
#pragma unroll
          for (int k = 0; k < 4; ++k) { s0 += w0[k] * bf2f(v[i + k]); s1 += w1[k] * bf2f(v[i + k] >> 16); }
          *(LAS unsigned*)(xct + (32 * wave + i) * LRU_XS + 4 * lane) = f2bf(s0) | (f2bf(s1) << 16); } }
    __syncthreads();
    const int c = lane & 15, q = lane >> 4, ch = n * 128 + 16 * wave + c;
    const float* bg = F.in[I_LRU_BG] + (size_t)j * 4 * DRNN; const float* lam = F.in[I_LRU_LAM] + (size_t)j * 2 * DRNN;
    const bf16* gbp = GB + (size_t)r0 * DRNN + ch;
    bf16* pf = PF + (size_t)(smp ? r0 - NPROMPT : 0) * DRNN + ch; bf16* pb = PB + (size_t)(smp ? r0 - NPROMPT : 0) * DRNN + ch;
    { float h0 = 0.f; if (smp && tix == 0) h0 = F.in[I_STATE][((size_t)(sq * 2 + j) * 2 + 0) * DRNN + ch];
      const float hfin = lru_dir<false>(xct, hft, WGT + (size_t)(0 * 10 + n) * 128 * 128, gbp, bg[0 * DRNN + ch], bg[1 * DRNN + ch], softplusf_(-lam[ch]), h0, wave, lane, smp, pf);
      if (q == 0) { if (smp) AGG[(size_t)((sq * 4 + tix) * 2 + 0) * DRNN + ch] = hfin; else F.out[O_STATE + ((size_t)(pm * 2 + j) * 2 + 0) * DRNN + ch] = hfin; } }
    { float h0 = 0.f; if (smp && tix == 3) h0 = F.in[I_STATE][((size_t)(sq * 2 + j) * 2 + 1) * DRNN + ch];
      const float hfin = lru_dir<true>(xct, hft, WGT + (size_t)(2 * 10 + n) * 128 * 128, gbp, bg[2 * DRNN + ch], bg[3 * DRNN + ch], softplusf_(-lam[DRNN + ch]), h0, wave, lane, smp, pb);
      if (q == 0) { if (smp) AGG[(size_t)((sq * 4 + tix) * 2 + 1) * DRNN + ch] = hfin; else F.out[O_STATE + ((size_t)(pm * 2 + j) * 2 + 1) * DRNN + ch] = hfin; } }
    __syncthreads();
#pragma unroll
    for (int i = 0; i < 8; ++i) { const int id = i * NT + tid, row = id >> 4, cc = id & 15;
        *(GAS u32x4*)(HS + (size_t)(r0 + row) * DRNN + n * 128 + 8 * cc) = *(LAS const u32x4*)(hft + row * LRU_XS + 16 * cc); }
    __syncthreads();
}
__device__ __forceinline__ void phase_lru_core(Frame& F, int j, const bf16* REC, const bf16* GB, bf16* HS, bf16* PF, bf16* PB, float* AGG, const bf16* WGT) {
    F.fresh();
    for (int u = F.bid; u < 400; u += F.G) {
        const int pm = u < 80 ? 32 + u / 10 : (u - 80) / 10, n = u % 10;
        lru_unit(F, j, pm, n, REC, GB, HS, PF, PB, AGG, WGT); }
}
__device__ __forceinline__ void phase_lru_fixup(Frame& F, const bf16* GB, bf16* HS, const bf16* PF, const bf16* PB, const float* AGG) {
    F.fresh();
    const int gt = F.bid * NT + F.tid, GT = F.G * NT;
    for (int i = gt; i < NSAMPLE * DRNN; i += GT) { const int rs = i / DRNN, ch = i % DRNN, sq = rs >> 10, tix = (rs >> 8) & 3;
        float cf = 0.f, cbk = 0.f;
        if (tix > 0) { for (int t = 0; t < tix; ++t) { const float At = bf2f(PF[(size_t)(sq * 1024 + t * 256 + 255) * DRNN + ch]); cf = At * cf + AGG[(size_t)((sq * 4 + t) * 2 + 0) * DRNN + ch]; } }
        if (tix < 3) { for (int t = 3; t > tix; --t) { const float At = bf2f(PB[(size_t)(sq * 1024 + t * 256) * DRNN + ch]); cbk = At * cbk + AGG[(size_t)((sq * 4 + t) * 2 + 1) * DRNN + ch]; } }
        const size_t o = (size_t)(NPROMPT + rs) * DRNN + ch;
        HS[o] = (bf16)f2bf(bf2f(HS[o]) + bf2f(GB[o]) * (bf2f(PF[(size_t)rs * DRNN + ch]) * cf + bf2f(PB[(size_t)rs * DRNN + ch]) * cbk)); }
}

__device__ __forceinline__ void phase_cmlp_rstd(Frame& F, const bf16* UV) {
    F.fresh();
    const int gw = F.bid * NWAVES + F.wave, NGW = F.G * NWAVES;
    for (int row = gw; row < M; row += NGW) { float s = 0.f;
        for (int c = F.lane; c < DB; c += 64) { const float v = bf2f(UV[(size_t)row * 2 * DB + DB + c]); s += v * v; }
        s = wave_sum(s); if (F.lane == 0) F.rstd[row] = rsqrtf(s * (1.f / DB) + EPS); }
}
__device__ __forceinline__ void phase_cmlp_spatial(Frame& F, const bf16* UV, bf16* ACT) {
    F.fresh();
    const float* ws = F.in[I_CM_WS]; const float* bs = F.in[I_CM_BS]; const float* ng = F.in[I_CM_NG];
    const int gt = F.bid * NT + F.tid, GT = F.G * NT;
    for (int i = gt; i < M * DB; i += GT) { const int row = i / DB, ch = i % DB, g = ch >> 8, p = row & 127, r0 = row & ~127;
        float s = 0.f;
        for (int q = 0; q < 128; ++q) s += ws[(size_t)(g * 128 + p) * 128 + q] * F.rstd[r0 + q] * bf2f(UV[(size_t)(r0 + q) * 2 * DB + DB + ch]);
        const float sv = s * ng[ch] + bs[g * 128 + p];
        ACT[i] = (bf16)f2bf(bf2f(UV[(size_t)row * 2 * DB + ch]) * sv); }
}


constexpr int CM_VS = 544;
__device__ __forceinline__ void phase_cmlp_spatial_mfma(Frame& F, const bf16* UV, bf16* ACT, const bf16* WSB) {
    F.fresh();
    const int tid = F.tid, lane = F.lane, wave = F.wave, c = lane & 15, q4 = lane >> 4;
    LAS unsigned char* vt = F.lds;
    const float* ng = F.in[I_CM_NG]; const float* bs = F.in[I_CM_BS];
    for (int u = F.bid; u < 640; u += F.G) {
        const int chunk = u >> 3, g = u & 7, r0 = chunk * 128;
#pragma unroll
        for (int i = 0; i < 8; ++i) { const int id = i * NT + tid, row = id >> 5, cc = id & 31;
            const u32x4 x = *(const GAS u32x4*)(UV + (size_t)(r0 + row) * 2 * DB + DB + g * 256 + 8 * cc); const float rs = F.rstd[r0 + row];
            u32x4 y; y.x = f2bf(bf2f(x.x) * rs) | (f2bf(bf2f(x.x >> 16) * rs) << 16); y.y = f2bf(bf2f(x.y) * rs) | (f2bf(bf2f(x.y >> 16) * rs) << 16);
            y.z = f2bf(bf2f(x.z) * rs) | (f2bf(bf2f(x.z >> 16) * rs) << 16); y.w = f2bf(bf2f(x.w) * rs) | (f2bf(bf2f(x.w >> 16) * rs) << 16);
            *(LAS u32x4*)(vt + row * CM_VS + 16 * cc) = y; }
        __syncthreads();
        bf16x8 vf[2][4];
#pragma unroll
        for (int mfc = 0; mfc < 2; ++mfc)
#pragma unroll
            for (int ks = 0; ks < 4; ++ks) { LAS const unsigned char* vp = vt + (32 * ks + 4 * q4 + (c >> 2)) * CM_VS + (32 * wave + 16 * mfc + 4 * (c & 3)) * 2;
                const v4i16_t lo = __builtin_amdgcn_ds_read_tr16_b64_v4i16((LAS v4i16_t*)vp), hi = __builtin_amdgcn_ds_read_tr16_b64_v4i16((LAS v4i16_t*)(vp + 16 * CM_VS));
                vf[mfc][ks] = (bf16x8){lo[0], lo[1], lo[2], lo[3], hi[0], hi[1], hi[2], hi[3]}; }
#pragma unroll
        for (int nf = 0; nf < 8; ++nf) {
            bf16x8 Bf[4];
#pragma unroll
            for (int ks = 0; ks < 4; ++ks) Bf[ks] = *(const GAS bf16x8*)(WSB + ((size_t)((g * 8 + nf) * 4 + ks) * 64 + lane) * 8);
            const int p = 16 * nf + c; const float bsv = bs[g * 128 + p];
#pragma unroll
            for (int mfc = 0; mfc < 2; ++mfc) { f32x4 acc = {0.f, 0.f, 0.f, 0.f};
#pragma unroll
                for (int ks = 0; ks < 4; ++ks) acc = __builtin_amdgcn_mfma_f32_16x16x32_bf16(vf[mfc][ks], Bf[ks], acc, 0, 0, 0);
                const int ch = g * 256 + 32 * wave + 16 * mfc + 4 * q4;
                const f32x4 g4 = *(const GAS f32x4*)(ng + ch); const u32x2 uu = *(const GAS u32x2*)(UV + (size_t)(r0 + p) * 2 * DB + ch);
                const float o0 = bf2f(uu.x) * (acc[0] * g4.x + bsv), o1 = bf2f(uu.x >> 16) * (acc[1] * g4.y + bsv), o2 = bf2f(uu.y) * (acc[2] * g4.z + bsv), o3 = bf2f(uu.y >> 16) * (acc[3] * g4.w + bsv);
                u32x2 w; w.x = f2bf(o0) | (f2bf(o1) << 16); w.y = f2bf(o2) | (f2bf(o3) << 16);
                *(GAS u32x2*)(ACT + (size_t)(r0 + p) * DB + ch) = w; }
        }
        __syncthreads();
    }
}

__device__ __forceinline__ void phase_qkv_post(Frame& F, const bf16* QKV, bf16* Q, bf16* KP, bf16* VP) {
    F.fresh();
    const int gw = F.bid * NWAVES + F.wave, NGW = F.G * NWAVES;
    const float* qkg = F.in[I_AT_QKG];
    for (int row = gw; row < M; row += NGW) {
        const bool smp = row >= NPROMPT; const int sb = smp ? (row - NPROMPT) >> 10 : 0, t = smp ? (row - NPROMPT) & 1023 : 0;
        const float cs = smp ? F.rope[t * 32 + (F.lane & 31)] : 1.f, sn = smp ? F.rope[32768 + t * 32 + (F.lane & 31)] : 0.f;
        for (int grp = 0; grp < 32; ++grp) {
            const float v = bf2f(QKV[(size_t)row * 3072 + grp * 64 + F.lane]);
            const float ms = wave_sum(v * v) * (1.f / 64.f);
            float n = v * rsqrtf(ms + EPS) * qkg[(grp >> 4) * 64 + F.lane];
            const float keep = n;
            if (smp) { const float pr = __shfl_xor(n, 32); n = F.lane < 32 ? n * cs - pr * sn : n * cs + pr * sn; }
            if (grp < 16) Q[(size_t)row * D + grp * 64 + F.lane] = (bf16)f2bf(n);
            else { const int c = (grp - 16) * 64 + F.lane;
                if (smp) F.KS[((size_t)sb * TKS + PAST + t) * D + c] = (bf16)f2bf(n);
                else { KP[(size_t)row * D + c] = (bf16)f2bf(keep); F.out[O_CK + (size_t)row * D + c] = keep; } }
        }
        for (int c = F.lane; c < D; c += 64) { const bf16 vb = QKV[(size_t)row * 3072 + 2048 + c];
            if (smp) F.VS[((size_t)sb * TKS + PAST + t) * D + c] = vb; else { VP[(size_t)row * D + c] = vb; F.out[O_CV + (size_t)row * D + c] = bf2f(vb); } }
    }
}
__device__ __forceinline__ void phase_attn_naive(Frame& F, int l, const bf16* Q, const bf16* KP, const bf16* VP, bf16* O) {
    F.fresh();
    const int gw = F.bid * NWAVES + F.wave, NGW = F.G * NWAVES;
    LAS float* s1 = (LAS float*)F.lds + F.wave * 3328; LAS float* s2 = s1 + 1536; LAS float* qs = s2 + 1536;
    const float* al = F.in[I_AT_LAM];
    const float lam_init = 0.8f - 0.6f * expf(-0.3f * (float)l);
    const float lam = expf(wave_sum(al[F.lane] * al[64 + F.lane])) - expf(wave_sum(al[128 + F.lane] * al[192 + F.lane])) + lam_init;
    const float* sg = F.in[I_AT_SUBG];
    for (int item = gw; item < M * 8; item += NGW) {
        const int row = item >> 3, h = item & 7;
        const bf16 *Kb, *Vb; int Tk;
        if (row < NPROMPT) { Kb = KP + (size_t)(row & ~255) * D; Vb = VP + (size_t)(row & ~255) * D; Tk = 256; }
        else { const int sb = (row - NPROMPT) >> 10; Kb = F.KS + (size_t)sb * TKS * D; Vb = F.VS + (size_t)sb * TKS * D; Tk = TKS; }
        qs[F.lane] = bf2f(Q[(size_t)row * D + h * 128 + F.lane]); qs[64 + F.lane] = bf2f(Q[(size_t)row * D + h * 128 + 64 + F.lane]);
        asm volatile("s_waitcnt lgkmcnt(0)" ::: "memory");
        float m1 = -1e30f, m2 = -1e30f;
        for (int k = F.lane; k < Tk; k += 64) { const bf16* kr = Kb + (size_t)k * D + h * 128; float d1 = 0.f, d2 = 0.f;
#pragma unroll 4
            for (int d = 0; d < 64; d += 2) { const unsigned a = *(const unsigned*)(kr + d), b = *(const unsigned*)(kr + 64 + d);
                d1 += qs[d] * bf2f(a) + qs[d + 1] * bf2f(a >> 16); d2 += qs[64 + d] * bf2f(b) + qs[64 + d + 1] * bf2f(b >> 16); }
            d1 *= 0.125f; d2 *= 0.125f; s1[k] = d1; s2[k] = d2; m1 = fmaxf(m1, d1); m2 = fmaxf(m2, d2); }
        m1 = wave_max(m1); m2 = wave_max(m2);
        float l1 = 0.f, l2 = 0.f;
        for (int k = F.lane; k < Tk; k += 64) { const float e1 = expf(s1[k] - m1), e2 = expf(s2[k] - m2); s1[k] = e1; s2[k] = e2; l1 += e1; l2 += e2; }
        l1 = wave_sum(l1); l2 = wave_sum(l2);
        const float i1 = 1.f / l1, i2 = lam / l2;
        for (int k = F.lane; k < Tk; k += 64) s1[k] = bf2f(f2bf(s1[k] * i1 - s2[k] * i2));
        asm volatile("s_waitcnt lgkmcnt(0)" ::: "memory");
        float o0 = 0.f, o1 = 0.f;
        for (int k = 0; k < Tk; ++k) { const unsigned vv = *(const unsigned*)(Vb + (size_t)k * D + h * 128 + 2 * F.lane); const float w = s1[k]; o0 += w * bf2f(vv); o1 += w * bf2f(vv >> 16); }
        const float ms = wave_sum(o0 * o0 + o1 * o1) * (1.f / 128.f), rs = rsqrtf(ms + EPS) * (1.f - lam_init);
        o0 = o0 * rs * sg[2 * F.lane]; o1 = o1 * rs * sg[2 * F.lane + 1];
        *(unsigned*)(O + (size_t)row * D + h * 128 + 2 * F.lane) = f2bf(o0) | (f2bf(o1) << 16);
        asm volatile("s_waitcnt lgkmcnt(0)" ::: "memory");
    }
}


constexpr int AT_KS = 272, AT_VS = 288, AT_KBYTES = 64 * AT_KS, AT_VBYTES = 64 * AT_VS, AT_BUF = AT_KBYTES + AT_VBYTES;
__device__ __forceinline__ void attn_unit(Frame& F, int l, const bf16* Qrows  , const bf16* Kb, const bf16* Vb, int Tk, bf16* Orows, int h, float lam, float lam_init) {
    const int tid = F.tid, lane = F.lane, wave = F.wave, c = lane & 15, q4 = lane >> 4;
    LAS unsigned char* lds = F.lds;
    const float SC = 0.18033688f;
    bf16x8 Qf[2][2];
#pragma unroll
    for (int cp = 0; cp < 2; ++cp)
#pragma unroll
        for (int ks = 0; ks < 2; ++ks) Qf[cp][ks] = *(const GAS bf16x8*)(Qrows + (size_t)(16 * wave + c) * D + h * 128 + cp * 64 + 32 * ks + 8 * q4);
    const int nt = Tk / 64;
    const int key0 = tid >> 4, cc0 = tid & 15;
    u32x4 kreg[2], vreg[2];
    float m1 = -1e30f, m2 = -1e30f, l1 = 0.f, l2 = 0.f;
#pragma unroll
    for (int i = 0; i < 2; ++i) kreg[i] = *(const GAS u32x4*)(Kb + (size_t)(key0 + 32 * i) * D + h * 128 + 8 * cc0);
#pragma unroll
    for (int i = 0; i < 2; ++i) *(LAS u32x4*)(lds + (key0 + 32 * i) * AT_KS + 16 * cc0) = kreg[i];
    __syncthreads();
    for (int t = 0; t < nt; ++t) {
        LAS const unsigned char* kt = lds + (t & 1) * AT_BUF;
        if (t + 1 < nt) {
#pragma unroll
            for (int i = 0; i < 2; ++i) kreg[i] = *(const GAS u32x4*)(Kb + (size_t)((t + 1) * 64 + key0 + 32 * i) * D + h * 128 + 8 * cc0); }
        f32x4 S[2][4];
#pragma unroll
        for (int cp = 0; cp < 2; ++cp)
#pragma unroll
            for (int mf = 0; mf < 4; ++mf) { S[cp][mf] = (f32x4){0.f, 0.f, 0.f, 0.f};
#pragma unroll
                for (int ks = 0; ks < 2; ++ks) { const bf16x8 kf = *(LAS const bf16x8*)(kt + (16 * mf + c) * AT_KS + cp * 128 + ks * 64 + 16 * q4);
                    S[cp][mf] = __builtin_amdgcn_mfma_f32_16x16x32_bf16(kf, Qf[cp][ks], S[cp][mf], 0, 0, 0); } }
        float x1 = -1e30f, x2 = -1e30f;
#pragma unroll
        for (int mf = 0; mf < 4; ++mf)
#pragma unroll
            for (int k = 0; k < 4; ++k) { x1 = fmaxf(x1, S[0][mf][k]); x2 = fmaxf(x2, S[1][mf][k]); }
        x1 = fmaxf(x1, __shfl_xor(x1, 16)); x1 = fmaxf(x1, __shfl_xor(x1, 32)); x2 = fmaxf(x2, __shfl_xor(x2, 16)); x2 = fmaxf(x2, __shfl_xor(x2, 32));
        const float n1 = fmaxf(m1, x1), n2 = fmaxf(m2, x2);
        l1 *= exp2f((m1 - n1) * SC); l2 *= exp2f((m2 - n2) * SC); m1 = n1; m2 = n2;
#pragma unroll
        for (int mf = 0; mf < 4; ++mf)
#pragma unroll
            for (int k = 0; k < 4; ++k) { l1 += exp2f((S[0][mf][k] - m1) * SC); l2 += exp2f((S[1][mf][k] - m2) * SC); }
        if (t + 1 < nt) {
#pragma unroll
            for (int i = 0; i < 2; ++i) *(LAS u32x4*)(lds + ((t + 1) & 1) * AT_BUF + (key0 + 32 * i) * AT_KS + 16 * cc0) = kreg[i]; }
        __syncthreads();
    }
    l1 += __shfl_xor(l1, 16); l1 += __shfl_xor(l1, 32); l2 += __shfl_xor(l2, 16); l2 += __shfl_xor(l2, 32);
    const float i1 = 1.f / l1, i2 = lam / l2;
    f32x4 Ot[8];
#pragma unroll
    for (int md = 0; md < 8; ++md) Ot[md] = (f32x4){0.f, 0.f, 0.f, 0.f};
#pragma unroll
    for (int i = 0; i < 2; ++i) { kreg[i] = *(const GAS u32x4*)(Kb + (size_t)(key0 + 32 * i) * D + h * 128 + 8 * cc0); vreg[i] = *(const GAS u32x4*)(Vb + (size_t)(key0 + 32 * i) * D + h * 128 + 8 * cc0); }
#pragma unroll
    for (int i = 0; i < 2; ++i) { *(LAS u32x4*)(lds + (key0 + 32 * i) * AT_KS + 16 * cc0) = kreg[i]; *(LAS u32x4*)(lds + AT_KBYTES + (key0 + 32 * i) * AT_VS + 16 * cc0) = vreg[i]; }
    __syncthreads();
    for (int t = 0; t < nt; ++t) {
        LAS const unsigned char* kt = lds + (t & 1) * AT_BUF; LAS const unsigned char* vt = kt + AT_KBYTES;
        if (t + 1 < nt) {
#pragma unroll
            for (int i = 0; i < 2; ++i) { kreg[i] = *(const GAS u32x4*)(Kb + (size_t)((t + 1) * 64 + key0 + 32 * i) * D + h * 128 + 8 * cc0);
                                          vreg[i] = *(const GAS u32x4*)(Vb + (size_t)((t + 1) * 64 + key0 + 32 * i) * D + h * 128 + 8 * cc0); } }
        f32x4 S[2][4];
#pragma unroll
        for (int cp = 0; cp < 2; ++cp)
#pragma unroll
            for (int mf = 0; mf < 4; ++mf) { S[cp][mf] = (f32x4){0.f, 0.f, 0.f, 0.f};
#pragma unroll
                for (int ks = 0; ks < 2; ++ks) { const bf16x8 kf = *(LAS const bf16x8*)(kt + (16 * mf + c) * AT_KS + cp * 128 + ks * 64 + 16 * q4);
                    S[cp][mf] = __builtin_amdgcn_mfma_f32_16x16x32_bf16(kf, Qf[cp][ks], S[cp][mf], 0, 0, 0); } }
        bf16x8 Wf[2];
#pragma unroll
        for (int kk = 0; kk < 2; ++kk)
#pragma unroll
            for (int jj = 0; jj < 8; ++jj) { const int mf = 2 * kk + (jj >> 2), k = jj & 3;
                const float w = exp2f((S[0][mf][k] - m1) * SC) * i1 - exp2f((S[1][mf][k] - m2) * SC) * i2; Wf[kk][jj] = (short)f2bf(w); }
#pragma unroll
        for (int md = 0; md < 8; ++md)
#pragma unroll
            for (int kk = 0; kk < 2; ++kk) { LAS const unsigned char* vp = vt + (32 * kk + 4 * q4 + (c >> 2)) * AT_VS + (16 * md + 4 * (c & 3)) * 2;
                const v4i16_t lo = __builtin_amdgcn_ds_read_tr16_b64_v4i16((LAS v4i16_t*)vp), hi = __builtin_amdgcn_ds_read_tr16_b64_v4i16((LAS v4i16_t*)(vp + 16 * AT_VS));
                const bf16x8 vf = {lo[0], lo[1], lo[2], lo[3], hi[0], hi[1], hi[2], hi[3]};
                Ot[md] = __builtin_amdgcn_mfma_f32_16x16x32_bf16(vf, Wf[kk], Ot[md], 0, 0, 0); }
        if (t + 1 < nt) {
#pragma unroll
            for (int i = 0; i < 2; ++i) { *(LAS u32x4*)(lds + ((t + 1) & 1) * AT_BUF + (key0 + 32 * i) * AT_KS + 16 * cc0) = kreg[i];
                                          *(LAS u32x4*)(lds + ((t + 1) & 1) * AT_BUF + AT_KBYTES + (key0 + 32 * i) * AT_VS + 16 * cc0) = vreg[i]; } }
        __syncthreads();
    }
    float ss = 0.f;
#pragma unroll
    for (int md = 0; md < 8; ++md)
#pragma unroll
        for (int k = 0; k < 4; ++k) ss += Ot[md][k] * Ot[md][k];
    ss += __shfl_xor(ss, 16); ss += __shfl_xor(ss, 32);
    const float rs = rsqrtf(ss * (1.f / 128.f) + EPS) * (1.f - lam_init);
    const float* sg = F.in[I_AT_SUBG];
#pragma unroll
    for (int md = 0; md < 8; ++md) { const int d0 = 16 * md + 4 * q4; const f32x4 g4 = *(const GAS f32x4*)(sg + d0);
        u32x2 w; w.x = f2bf(Ot[md][0] * rs * g4.x) | (f2bf(Ot[md][1] * rs * g4.y) << 16); w.y = f2bf(Ot[md][2] * rs * g4.z) | (f2bf(Ot[md][3] * rs * g4.w) << 16);
        *(GAS u32x2*)(Orows + (size_t)(16 * wave + c) * D + h * 128 + d0) = w; }
}
__device__ __forceinline__ void phase_attn(Frame& F, int l, const bf16* Q, const bf16* KP, const bf16* VP, bf16* O) {
    F.fresh();
    const float* al = F.in[I_AT_LAM];
    const float lam_init = 0.8f - 0.6f * expf(-0.3f * (float)l);
    const float lam = expf(wave_sum(al[F.lane] * al[64 + F.lane])) - expf(wave_sum(al[128 + F.lane] * al[192 + F.lane])) + lam_init;
    for (int s = 0; ; ++s) {
        int u;
        if (F.G == 256) { if (F.bid < 128) { if (s > 0) break; u = F.bid; } else { if (s > 3) break; u = 128 + 4 * (F.bid - 128) + s; } }
        else { u = F.bid + s * F.G; if (u >= 640) break; }
        if (u < 128) { const int sb = u >> 6, h = (u >> 3) & 7, qt = u & 7; const size_t r0 = (size_t)NPROMPT + sb * 1024 + qt * 128;
            attn_unit(F, l, Q + r0 * D, F.KS + (size_t)sb * TKS * D, F.VS + (size_t)sb * TKS * D, TKS, O + r0 * D, h, lam, lam_init); }
        else { const int v = u - 128, b = v >> 4, h = (v >> 1) & 7, qt = v & 1; const size_t r0 = (size_t)b * 256 + qt * 128;
            attn_unit(F, l, Q + r0 * D, KP + (size_t)b * 256 * D, VP + (size_t)b * 256 * D, 256, O + r0 * D, h, lam, lam_init); }
    }
}

__device__ __forceinline__ void phase_ffn_convgate(Frame& F, int l, const bf16* Z, bf16* ACT) {
    F.fresh();
    const float* cw = F.in[I_FF_CW] + (size_t)l * 3 * 2 * DFF; const float* cb = F.in[I_FF_CB] + (size_t)l * 2 * DFF;
    const int gt = F.bid * NT + F.tid, GT = F.G * NT;
    for (int i = gt; i < M * DFF; i += GT) { const int row = i / DFF, j = i % DFF;
        int t, T; if (row < NPROMPT) { t = row & 255; T = 256; } else { t = (row - NPROMPT) & 1023; T = 1024; }
        float g = cb[j], u = cb[DFF + j];
#pragma unroll
        for (int k = 0; k < 3; ++k) { const int tt = t + k - 1; if (tt >= 0 && tt < T) { const bf16* zr = Z + (size_t)(row + k - 1) * 2 * DFF; g += cw[k * 2 * DFF + j] * bf2f(zr[j]); u += cw[k * 2 * DFF + DFF + j] * bf2f(zr[DFF + j]); } }
        ACT[i] = (bf16)f2bf(siluf_(g) * u); }
}

constexpr int LDS_BYTES = 163840;
constexpr int MISC_OFF = LDS_BYTES - 256;
__global__ void __launch_bounds__(NT, 2) mk_fwd(Params prm) {
    extern __shared__ __attribute__((aligned(16))) unsigned char lds_raw[];
    Frame F;
    F.lds = (LAS unsigned char*)lds_raw; F.G = gridDim.x; F.in = prm.in; F.out0 = prm.out; F.ws0 = prm.ws;
    F.fresh();
    volatile LAS unsigned* MISC = (volatile LAS unsigned*)(F.lds + MISC_OFF);
    if (F.tid < 32) MISC[F.tid] = 0u;
    __syncthreads();
    (void)xcd_barrier_post((unsigned*)(prm.ws + WS_CTL) + CW_BAR, MISC + 8);
#define GRID_BAR() do { XcdBarrier bar_; bar_.bar = (unsigned*)(prm.ws + WS_CTL) + CW_BAR; bar_.x = xb_xcc_id(); bar_.st = (volatile LAS unsigned*)(F.lds + MISC_OFF) + 8; xcd_barrier(bar_); } while (0)

#define GEMM_BF16(ACT, A_, Bt_, N_, K_, O_, ldc_, bias_, splitc_, splits_) do { pg8::Gemm g{A_, Bt_, M, N_, K_}; pg8::StaticOrder S; S.init(M, N_, F.G, F.bid); \
        pg8::EpiBf16<ACT> E{O_, ldc_, bias_, splitc_, splits_}; pg8::gemm_phase<pg8::EpiBf16<ACT>, pg8::StaticOrder, true, true>(F.lds, g, S, E); } while (0)
#define GEMM_RESID(A_, Bt_, K_, which_, fromin_) do { pg8::Gemm g{A_, Bt_, M, D, K_}; pg8::StaticOrder S; S.init(M, D, F.G, F.bid); \
        pg8::EpiResid E{F.out, F.in[I_XP], F.in[I_XS], F.mod + (size_t)l * 18 * D, which_, fromin_}; pg8::gemm_phase<pg8::EpiResid, pg8::StaticOrder, true, true>(F.lds, g, S, E); } while (0)

    phase_prologue(F);
    GRID_BAR();
#pragma unroll 1
    for (int l = 0; l < DEPTH; ++l) {
        const int kind = l % 3, j = l / 3;
        phase_modulate(F, l, 0);
        F.fresh();
        GRID_BAR();
        if (kind == 0) {
            bf16 *GB = F.T2, *REC = F.T2 + (size_t)M * DRNN, *PF = F.T3, *PB = F.T3 + (size_t)NSAMPLE * DRNN, *HS = F.T3 + (size_t)6 * 1024 * 1024;
            float* AGG = (float*)(F.T3 + (size_t)2 * NSAMPLE * DRNN);
            GEMM_BF16(2, F.H, F.WT + WE_LRU_IN + (size_t)j * 2 * DRNN * D, 2 * DRNN, D, GB, DRNN, nullptr, DRNN, (size_t)M * DRNN);
            GRID_BAR();
            phase_lru_core(F, j, REC, GB, HS, PF, PB, AGG, F.WT + WE_WG + (size_t)j * 40 * 128 * 128);
            GRID_BAR();
            phase_lru_fixup(F, GB, HS, PF, PB, AGG);
            GRID_BAR();
            GEMM_RESID(HS, F.WT + WE_LRU_OUT + (size_t)j * D * DRNN, DRNN, 2, l == 0);
        } else if (kind == 1) {
            bf16 *UV = F.T1, *ACT = F.T2;
            GEMM_BF16(1, F.H, F.WT + WE_CM_IN, 2 * DB, D, UV, 2 * DB, F.in[I_CM_BIN], 0, 0);
            GRID_BAR();
            phase_cmlp_rstd(F, UV);
            GRID_BAR();
            phase_cmlp_spatial_mfma(F, UV, ACT, F.WT + WE_WSB);
            GRID_BAR();
            GEMM_RESID(ACT, F.WT + WE_CM_OUT, DB, 2, false);
        } else {
            bf16 *QKV = F.T1, *Q = F.T2, *KP = F.T2 + (size_t)M * D, *VP = KP + (size_t)NPROMPT * D, *O = F.T3;
            GEMM_BF16(0, F.H, F.WT + WE_QKV, 3 * D, D, QKV, 3 * D, nullptr, 0, 0);
            GRID_BAR();
            phase_qkv_post(F, QKV, Q, KP, VP);
            GRID_BAR();
            phase_attn(F, l, Q, KP, VP, O);
            GRID_BAR();
            GEMM_RESID(O, F.WT + WE_AT_OUT, D, 2, false);
        }
        GRID_BAR();
        phase_modulate(F, l, 1);
        GRID_BAR();
        GEMM_BF16(0, F.H, F.WT + WE_UP + (size_t)l * 2 * DFF * D, 2 * DFF, D, F.T1, 2 * DFF, nullptr, 0, 0);
        GRID_BAR();
        phase_ffn_convgate(F, l, F.T1, F.T2);
        GRID_BAR();
        GEMM_RESID(F.T2, F.WT + WE_DN + (size_t)l * D * DFF, DFF, 5, false);
        GRID_BAR();
    }
}

extern "C" void kernel_launch(void* const* d_in, const int* in_sizes, int n_in, void* d_out, int out_size, void* d_ws, size_t ws_size, hipStream_t stream) {
    static int grid = 0;
    if (grid == 0) {
        if (n_in != N_IN || ws_size < WS_END) { fprintf(stderr, "kernel_launch: unexpected n_in %d or ws_size %zu\n", n_in, ws_size); grid = -1; return; }
        int dev = 0, cus = 0, per_cu = 0;
        hipGetDevice(&dev); hipDeviceGetAttribute(&cus, hipDeviceAttributeMultiprocessorCount, dev);
        hipFuncSetAttribute((const void*)mk_fwd, hipFuncAttributeMaxDynamicSharedMemorySize, LDS_BYTES);
        hipOccupancyMaxActiveBlocksPerMultiprocessor(&per_cu, (const void*)mk_fwd, NT, LDS_BYTES);
        (void)hipGetLastError();
        if (per_cu < 1) { fprintf(stderr, "kernel_launch: occupancy query says %d blocks per CU\n", per_cu); per_cu = 1; }
        grid = cus;
    }
    if (grid < 0) return;
    hipMemsetAsync((char*)d_ws + WS_CTL, 0, CTL_ZERO_BYTES, stream);
    Params p{};
    for (int i = 0; i < N_IN; ++i) p.in[i] = (const float*)d_in[i];
    p.out = (float*)d_out; p.ws = (unsigned char*)d_ws;
    void* args[] = {&p};
    hipError_t e = hipLaunchCooperativeKernel((const void*)mk_fwd, dim3(grid), dim3(NT), args, LDS_BYTES, stream);
    if (e != hipSuccess) fprintf(stderr, "kernel_launch: cooperative launch failed: %s (grid %d)\n", hipGetErrorString(e), grid);
}
```

```cpp
#include <hip/hip_runtime.h>
#include <cstdio>
#include <cstdint>

#define GAS __attribute__((address_space(1)))
#define LAS __attribute__((address_space(3)))
typedef unsigned short bf16;
typedef float f32x4 __attribute__((ext_vector_type(4)));
typedef unsigned u32x2 __attribute__((ext_vector_type(2)));
typedef unsigned u32x4 __attribute__((ext_vector_type(4)));

constexpr int D = 1024, NPROMPT = 32 * 256, NSAMPLE = 2 * 1024, M = NPROMPT + NSAMPLE;
constexpr int DEPTH = 4, DRNN = 1280, DB = 2048, DFF = 2816, PAST = 512, TKS = PAST + 1024;
constexpr float EPS = 1e-6f;
constexpr int NWAVES = 8, NT = NWAVES * 64;

enum { I_XP = 0, I_XS, I_STATE, I_CK, I_CV, I_C, I_CCTX, I_WMOD, I_BMOD, I_NORMG, I_LRU_WIN, I_LRU_CW, I_LRU_CB, I_LRU_WG, I_LRU_BG, I_LRU_LAM, I_LRU_WOUT,
       I_CM_WIN, I_CM_BIN, I_CM_NG, I_CM_WS, I_CM_BS, I_CM_WOUT, I_AT_WQKV, I_AT_QKG, I_AT_LAM, I_AT_SUBG, I_AT_WOUT, I_FF_WUP, I_FF_CW, I_FF_CB, I_FF_WDN, N_IN };
constexpr size_t O_YP = 0, O_YS = (size_t)NPROMPT * D, O_STATE = (size_t)M * D, O_CK = O_STATE + 32 * 2 * 2 * DRNN, O_CV = O_CK + (size_t)NPROMPT * D;

constexpr size_t MiB = 1u << 20;
constexpr size_t WS_CTL = 0, CTL_ZERO_BYTES = 64 * 1024;
constexpr size_t WS_MOD = 1 * MiB;
constexpr size_t WS_RSTD = WS_MOD + 512 * 1024;
constexpr size_t WS_ROPE = WS_RSTD + 256 * 1024;
constexpr size_t WS_H = 2 * MiB;
constexpr size_t WS_T1 = 22 * MiB;
constexpr size_t WS_T2 = 132 * MiB;
constexpr size_t WS_T3 = 187 * MiB;
constexpr size_t WS_KS = 237 * MiB, WS_VS = 243 * MiB;
constexpr size_t WS_W = 249 * MiB;
constexpr size_t WE_LRU_IN = 0, WE_LRU_OUT = WE_LRU_IN + (size_t)2 * 2560 * 1024, WE_CM_IN = WE_LRU_OUT + (size_t)2 * 1024 * 1280, WE_CM_OUT = WE_CM_IN + (size_t)4096 * 1024,
                 WE_QKV = WE_CM_OUT + (size_t)1024 * 2048, WE_AT_OUT = WE_QKV + (size_t)3072 * 1024, WE_UP = WE_AT_OUT + (size_t)1024 * 1024, WE_DN = WE_UP + (size_t)4 * 5632 * 1024,
                 WE_WG = WE_DN + (size_t)4 * 1024 * 2816, WE_WSB = WE_WG + (size_t)80 * 128 * 128, WE_END = WE_WSB + (size_t)8 * 128 * 128;
constexpr size_t WS_END = WS_W + 106 * MiB;
static_assert(WE_END * 2 <= 106 * MiB, "weight copies fit");
constexpr int CW_BAR = 1024;

__device__ __forceinline__ unsigned f2bf(float f) { unsigned u = __builtin_bit_cast(unsigned, f); return (u + 0x7fffu + ((u >> 16) & 1u)) >> 16; }
__device__ __forceinline__ float bf2f(unsigned b) { return __builtin_bit_cast(float, (b & 0xffffu) << 16); }
__device__ __forceinline__ float wave_sum(float v) {
#pragma unroll
    for (int o = 1; o < 64; o <<= 1) v += __shfl_xor(v, o);
    return v;
}
__device__ __forceinline__ float wave_max(float v) {
#pragma unroll
    for (int o = 1; o < 64; o <<= 1) v = fmaxf(v, __shfl_xor(v, o));
    return v;
}
__device__ __forceinline__ float gelu_tanh(float x) { const float y = 0.7978845608028654f * (x + 0.044715f * x * x * x); const float t = 1.f - 2.f / (__expf(2.f * y) + 1.f); return 0.5f * x * (1.f + t); }
__device__ __forceinline__ float sigmoidf_(float x) { return 1.f / (1.f + __expf(-x)); }
__device__ __forceinline__ float siluf_(float x) { return x / (1.f + __expf(-x)); }
__device__ __forceinline__ float softplusf_(float x) { return fmaxf(x, 0.f) + log1pf(expf(-fabsf(x))); }

#define XB_TMO      128
#define XB_XCNT(j)  (256  + 64 * (j))
#define XB_XSUB(j)  (1280 + 64 * (j))
#define XB_XGEN(j)  (2304 + 64 * (j))
#define XB_TOP      3328
#define XB_TOPGEN   3392
#define XCD_BAR_WORDS 3456
#define XB_SPIN_CAP (1u << 22)
__device__ __forceinline__ unsigned xb_ld(unsigned* p)              { return __hip_atomic_load(p, __ATOMIC_RELAXED, __HIP_MEMORY_SCOPE_AGENT); }
__device__ __forceinline__ unsigned xb_add(unsigned* p, unsigned v) { return __hip_atomic_fetch_add(p, v, __ATOMIC_RELAXED, __HIP_MEMORY_SCOPE_AGENT); }
__device__ __forceinline__ unsigned xb_xcc_id() { return (unsigned)__builtin_amdgcn_s_getreg((3 << 11) | 20) & 0xFu; }
#define XB_SPIN(cond, bar) do { unsigned _sp = 0; while (cond) { __builtin_amdgcn_s_sleep(1); \
    if ((++_sp & 255u) == 0u) { if (xb_ld(&(bar)[XB_TMO])) break; if (_sp > XB_SPIN_CAP) { atomicAdd(&(bar)[XB_TMO], 1u); break; } } } } while (0)
struct XcdBarrier { unsigned* bar; unsigned x; volatile LAS unsigned* st; };
__device__ __forceinline__ XcdBarrier xcd_barrier_post(unsigned* bar, volatile LAS unsigned* st) {
    XcdBarrier b; b.bar = bar; b.x = xb_xcc_id(); b.st = st;
    if (threadIdx.x == 0) (void)xb_add(&bar[XB_XCNT(b.x)], 1u);
    return b;
}
__device__ __forceinline__ void xcd_barrier_complete(unsigned* bar, unsigned x, unsigned& nloc, unsigned& nx) {
    const unsigned G = gridDim.x * gridDim.y * gridDim.z;
    unsigned sum, cnt, mine, sp = 0u;
    for (;;) {
        sum = 0u; cnt = 0u; mine = 0u;
#pragma unroll
        for (unsigned j = 0; j < 16; ++j) { const unsigned c = xb_ld(&bar[XB_XCNT(j)]); sum += c; cnt += (c > 0u) ? 1u : 0u; mine = (j == x) ? c : mine; }
        if (sum == G) break;
        __builtin_amdgcn_s_sleep(1);
        if ((++sp & 255u) == 0u) { if (xb_ld(&bar[XB_TMO])) break; if (sp > XB_SPIN_CAP) { atomicAdd(&bar[XB_TMO], 1u); break; } }
    }
    nloc = mine > 0u ? mine : 1u; nx = cnt > 0u ? cnt : 1u;
}
__device__ __forceinline__ void xcd_barrier(const XcdBarrier& b) {
    asm volatile("s_waitcnt vmcnt(0)" ::: "memory");
    __syncthreads();
    if (threadIdx.x == 0) {
        unsigned* bar = b.bar;
        __builtin_amdgcn_s_waitcnt(0);
        unsigned nloc = b.st[0], nx = b.st[1];
        if (nloc == 0u) { xcd_barrier_complete(bar, b.x, nloc, nx); b.st[0] = nloc; b.st[1] = nx; }
        const unsigned old = xb_add(&bar[XB_XSUB(b.x)], 1u);
        const unsigned gen = old / nloc;
        if (old + 1u == (gen + 1u) * nloc) {
            __builtin_amdgcn_fence(__ATOMIC_RELEASE, "agent");
            asm volatile("s_waitcnt vmcnt(0)" ::: "memory");
            const unsigned og = xb_add(&bar[XB_TOP], 1u);
            const unsigned tg = og / nx;
            if (og + 1u == (tg + 1u) * nx) xb_add(&bar[XB_TOPGEN], 1u);
            else XB_SPIN(xb_ld(&bar[XB_TOPGEN]) == tg, bar);
            __builtin_amdgcn_fence(__ATOMIC_ACQUIRE, "agent");
            xb_add(&bar[XB_XGEN(b.x)], 1u);
            asm volatile("s_waitcnt vmcnt(0)" ::: "memory");
        } else {
            XB_SPIN(xb_ld(&bar[XB_XGEN(b.x)]) == gen, bar);
            __builtin_amdgcn_fence(__ATOMIC_ACQUIRE, "agent");
            asm volatile("s_waitcnt vmcnt(0)" ::: "memory");
        }
    }
    __syncthreads();
}

namespace pg8 {
#define PG8_LAS __attribute__((address_space(3)))
typedef unsigned short bf16_t;
typedef short bf16x8 __attribute__((ext_vector_type(8)));
typedef float f32x4 __attribute__((ext_vector_type(4)));
typedef unsigned u32x4 __attribute__((ext_vector_type(4)));
constexpr int BM = 256, BK = 64, HALF = 128, HTB = HALF * BK * 2  , STAGE_BYTES = 8 * HTB, NXCD = 8, WGM = 8;

__host__ __device__ __forceinline__ int lds_byte(int r, int c) { const int st = (r >> 4) * 2 + (c >> 5), rr = r & 15, cc = c & 31, ob = rr * 64 + cc * 2; return st * 1024 + (ob ^ (((ob >> 9) & 1) << 5)); }
__host__ __device__ __forceinline__ void stage_rc(int b, int& R, int& C) { const int st = b / 1024, sb = b % 1024, swz = sb ^ (((sb >> 9) & 1) << 5); R = (st >> 1) * 16 + swz / 64; C = (st & 1) * 32 + (swz % 64) / 2; }
__host__ __device__ __forceinline__ int perm32(int rho) { const int n = rho >> 4, i = rho & 15; return 8 * (i >> 2) + 4 * n + (i & 3); }

struct Unit { int pm, pn; };
struct Gemm { const bf16_t* A; const bf16_t* Bt; int M, N, K; };

struct StaticOrder {
    int nM, nN, nwg, G, c;
    __host__ __device__ void init(int M, int N, int G_, int c_) { nM = M / BM; nN = N / BM; nwg = nM * nN; G = G_; c = c_; }
    __host__ __device__ bool next(int i, Unit& u) const {
        const long L = (long)i * G + c; if (L >= nwg) return false;
        int wgid = (int)L; { const int q = nwg / NXCD, r = nwg % NXCD, xcd = wgid % NXCD, off = wgid / NXCD; wgid = (xcd < r ? xcd * (q + 1) : r * (q + 1) + (xcd - r) * q) + off; }
        const int nig = WGM * nN, gid = wgid / nig, fm = gid * WGM, gsz = (nM - fm) < WGM ? (nM - fm) : WGM;
        u.pm = fm + ((wgid % nig) % gsz); u.pn = (wgid % nig) / gsz; return true;
    }
    __device__ __forceinline__ int arow(int pm) const { return pm * BM; }
    __device__ __forceinline__ void a_ready(const Unit&) const {}
    __device__ __forceinline__ void done(const Unit&) const {}
};

template <class Epi, class Sched, bool ALIGN_EPI = false, bool SP2 = false>
__device__ __forceinline__ void gemm_phase(PG8_LAS unsigned char* lds, const Gemm g, const Sched& S, const Epi& E) {
    int tid_ = threadIdx.x; asm volatile("" : "+v"(tid_));
    const int tid = tid_, wid = __builtin_amdgcn_readfirstlane(tid >> 6), lane = tid & 63, wr = wid >> 2, wc = wid & 3, fr = lane & 15, fq = lane >> 4;
    const int K = g.K, nt = K / BK;
    unsigned voffA[2], voffB[2];
#pragma unroll
    for (int i = 0; i < 2; ++i) { int R, C; stage_rc(tid * 16 + i * 8192, R, C); const int Rb = Epi::PERM ? ((R & ~31) + perm32(R & 31)) : R;
        voffA[i] = (unsigned)(R * K + C) * 2u; voffB[i] = (unsigned)(Rb * K + C) * 2u; }
    const size_t kstep = (size_t)(BK * 2);
    const size_t hstep = (size_t)HALF * K * 2;
    const size_t tstep = 2 * hstep;
    const unsigned ldsw = (unsigned)wid * 1024u;
    const int aoff = lds_byte(wr * 64 + fr, fq * 8), boff = lds_byte(wc * 32 + fr, fq * 8);
#define PG8_SA(b, h) (((b) * 2 + (h)) * HTB)
#define PG8_SB(b, h) ((4 + (b) * 2 + (h)) * HTB)
#define PG8_STAGE(bufoff, gbase, voff) do { _Pragma("unroll") for (int _i = 0; _i < 2; ++_i) \
        __builtin_amdgcn_global_load_lds((const unsigned*)((const char*)(gbase) + (voff)[_i]), (PG8_LAS unsigned*)(lds + (bufoff) + ldsw + _i * 8192), 16, 0, 0); } while (0)
#define PG8_LDA(dst, b, h) do { _Pragma("unroll") for (int m = 0; m < 4; ++m) _Pragma("unroll") for (int k = 0; k < 2; ++k) dst[m][k] = *(const PG8_LAS bf16x8*)(lds + PG8_SA(b, h) + aoff + m * 2048 + k * 1024); } while (0)
#define PG8_LDB(dst, b, h) do { _Pragma("unroll") for (int n = 0; n < 2; ++n) _Pragma("unroll") for (int k = 0; k < 2; ++k) dst[n][k] = *(const PG8_LAS bf16x8*)(lds + PG8_SB(b, h) + boff + n * 2048 + k * 1024); } while (0)
#define PG8_MMA(ai, bj, At, Bt) do { __builtin_amdgcn_s_setprio(1); _Pragma("unroll") for (int m = 0; m < 4; ++m) _Pragma("unroll") for (int n = 0; n < 2; ++n) _Pragma("unroll") for (int k = 0; k < 2; ++k) \
        acc[ai][bj][m][n] = __builtin_amdgcn_mfma_f32_16x16x32_bf16(Bt[n][k], At[m][k], acc[ai][bj][m][n], 0, 0, 0); __builtin_amdgcn_s_setprio(0); } while (0)
#define PG8_WAIT_V(n) asm volatile("s_waitcnt vmcnt(" #n ")" ::: "memory")
#define PG8_WAIT_L(n) asm volatile("s_waitcnt lgkmcnt(" #n ")" ::: "memory")
#define PG8_BAR __builtin_amdgcn_s_barrier()
#define PG8_SCHED __builtin_amdgcn_sched_barrier(0)
    Unit cur, nxt; int ui = 0;
    if (!S.next(0, cur)) return;
    f32x4 acc[2][2][4][2];
#pragma unroll
    for (int a = 0; a < 2; ++a)
#pragma unroll
        for (int b = 0; b < 2; ++b)
#pragma unroll
            for (int m = 0; m < 4; ++m)
#pragma unroll
                for (int n = 0; n < 2; ++n) acc[a][b][m][n] = (f32x4){0.f, 0.f, 0.f, 0.f};
    bf16x8 At[4][2], B0[2][2], B1[2][2];
    const char* cA = (const char*)g.A + (size_t)S.arow(cur.pm) * (size_t)K * 2; const char* cB = (const char*)g.Bt + (size_t)cur.pn * tstep;
    S.a_ready(cur);
    if constexpr (SP2) {
        PG8_STAGE(PG8_SB(0, 0), cB, voffB); PG8_STAGE(PG8_SB(0, 1), cB + hstep, voffB); PG8_STAGE(PG8_SA(0, 0), cA, voffA); PG8_STAGE(PG8_SA(0, 1), cA + hstep, voffA);
        if (wr == 1) PG8_BAR;
        PG8_WAIT_V(2); PG8_BAR;
        PG8_STAGE(PG8_SB(1, 0), cB + kstep, voffB); PG8_STAGE(PG8_SA(1, 0), cA + kstep, voffA); PG8_STAGE(PG8_SB(1, 1), cB + hstep + kstep, voffB);
        PG8_WAIT_V(6); PG8_BAR;
    } else {
        PG8_STAGE(PG8_SB(0, 0), cB, voffB); PG8_STAGE(PG8_SA(0, 0), cA, voffA); PG8_STAGE(PG8_SB(0, 1), cB + hstep, voffB); PG8_STAGE(PG8_SA(0, 1), cA + hstep, voffA);
        if (wr == 1) PG8_BAR;
        PG8_WAIT_V(4); PG8_BAR;
        PG8_STAGE(PG8_SB(1, 0), cB + kstep, voffB); PG8_STAGE(PG8_SA(1, 0), cA + kstep, voffA); PG8_STAGE(PG8_SB(1, 1), cB + hstep + kstep, voffB);
        PG8_WAIT_V(6); PG8_BAR;
    }
    for (;;) {
        const bool has_next = S.next(ui + 1, nxt);
        const char* nA = has_next ? (const char*)g.A + (size_t)S.arow(nxt.pm) * (size_t)K * 2 : cA; const char* nB = has_next ? (const char*)g.Bt + (size_t)nxt.pn * tstep : cB;
        for (int t = 0; t < nt; t += 2) {
            const bool last = (t == nt - 2);
            const char* a1 = cA + (size_t)(t + 1) * kstep;
            const char* a2 = last ? nA : cA + (size_t)(t + 2) * kstep; const char* b2 = last ? nB : cB + (size_t)(t + 2) * kstep;
            const char* a3 = a2 + kstep; const char* b3 = b2 + kstep;
            if (last && has_next) S.a_ready(nxt);
            if constexpr (SP2) {
            PG8_LDB(B0, 0, 0); PG8_LDB(B1, 0, 1); PG8_SCHED; PG8_LDA(At, 0, 0); PG8_STAGE(PG8_SA(1, 1), a1 + hstep, voffA);
            PG8_WAIT_V(8); PG8_WAIT_L(0); PG8_BAR; PG8_MMA(0, 0, At, B0); PG8_MMA(0, 1, At, B1); PG8_BAR; PG8_SCHED;
            PG8_LDA(At, 0, 1); PG8_STAGE(PG8_SB(0, 0), b2, voffB); PG8_STAGE(PG8_SB(0, 1), b2 + hstep, voffB); PG8_STAGE(PG8_SA(0, 0), a2, voffA);
            PG8_WAIT_V(8); PG8_WAIT_L(0); PG8_BAR; PG8_MMA(1, 0, At, B0); PG8_MMA(1, 1, At, B1); PG8_BAR; PG8_SCHED;
            PG8_LDB(B0, 1, 0); PG8_LDB(B1, 1, 1); PG8_SCHED; PG8_LDA(At, 1, 0); PG8_STAGE(PG8_SA(0, 1), a2 + hstep, voffA);
            PG8_WAIT_V(8); PG8_WAIT_L(0); PG8_BAR; PG8_MMA(0, 0, At, B0); PG8_MMA(0, 1, At, B1); PG8_BAR; PG8_SCHED;
            PG8_LDA(At, 1, 1); PG8_STAGE(PG8_SB(1, 0), b3, voffB); PG8_STAGE(PG8_SB(1, 1), b3 + hstep, voffB); PG8_STAGE(PG8_SA(1, 0), a3, voffA);
            PG8_WAIT_V(8); PG8_WAIT_L(0); PG8_BAR; PG8_MMA(1, 0, At, B0); PG8_MMA(1, 1, At, B1); PG8_BAR; PG8_SCHED;
            } else {
            PG8_LDB(B0, 0, 0); PG8_SCHED; PG8_LDA(At, 0, 0); PG8_STAGE(PG8_SA(1, 1), a1 + hstep, voffA);
            PG8_WAIT_L(8); PG8_BAR; PG8_WAIT_L(0); PG8_MMA(0, 0, At, B0); PG8_BAR; PG8_SCHED;
            PG8_LDB(B1, 0, 1); PG8_STAGE(PG8_SB(0, 0), b2, voffB);
            PG8_BAR; PG8_WAIT_L(0); PG8_MMA(0, 1, At, B1); PG8_BAR;
            PG8_LDA(At, 0, 1); PG8_STAGE(PG8_SA(0, 0), a2, voffA);
            PG8_BAR; PG8_WAIT_L(0); PG8_MMA(1, 0, At, B0); PG8_BAR; PG8_SCHED;
            PG8_STAGE(PG8_SB(0, 1), b2 + hstep, voffB);
            PG8_WAIT_V(6); PG8_BAR; PG8_MMA(1, 1, At, B1); PG8_BAR;
            PG8_LDB(B0, 1, 0); PG8_SCHED; PG8_LDA(At, 1, 0); PG8_STAGE(PG8_SA(0, 1), a2 + hstep, voffA);
            PG8_WAIT_L(8); PG8_BAR; PG8_WAIT_L(0); PG8_MMA(0, 0, At, B0); PG8_BAR; PG8_SCHED;
            PG8_LDB(B1, 1, 1); PG8_STAGE(PG8_SB(1, 0), b3, voffB);
            PG8_BAR; PG8_WAIT_L(0); PG8_MMA(0, 1, At, B1); PG8_BAR;
            PG8_LDA(At, 1, 1); PG8_STAGE(PG8_SA(1, 0), a3, voffA);
            PG8_BAR; PG8_WAIT_L(0); PG8_MMA(1, 0, At, B0); PG8_BAR; PG8_SCHED;
            PG8_STAGE(PG8_SB(1, 1), b3 + hstep, voffB);
            PG8_WAIT_V(6); PG8_BAR; PG8_MMA(1, 1, At, B1); PG8_BAR;
            }
        }
        if constexpr (ALIGN_EPI) { if (wr == 0) PG8_BAR; }
        if constexpr (!Epi::AFTER_DRAIN) { E(acc, cur, wr, wc, fr, fq); S.done(cur); }
        if (!has_next) break;
#pragma unroll
        for (int a = 0; a < 2; ++a)
#pragma unroll
            for (int b = 0; b < 2; ++b)
#pragma unroll
                for (int m = 0; m < 4; ++m)
#pragma unroll
                    for (int n = 0; n < 2; ++n) acc[a][b][m][n] = (f32x4){0.f, 0.f, 0.f, 0.f};
        cur = nxt; cA = nA; cB = nB; ++ui;
        if constexpr (ALIGN_EPI) { if (wr == 1) PG8_BAR; }
    }
    PG8_WAIT_V(0);
    if constexpr (!ALIGN_EPI) { if (wr == 0) PG8_BAR; }
    PG8_BAR;
    if constexpr (Epi::AFTER_DRAIN) { E.fused(acc, cur, wr, wc, fr, fq, lds, wid, lane); S.done(cur); }
#undef PG8_SA
#undef PG8_SB
#undef PG8_STAGE
#undef PG8_LDA
#undef PG8_LDB
#undef PG8_MMA
#undef PG8_WAIT_V
#undef PG8_WAIT_L
#undef PG8_BAR
#undef PG8_SCHED
}
}

namespace pg8 {
__device__ __forceinline__ unsigned cvt_pk_bf16(float lo, float hi) { unsigned r; asm volatile("v_cvt_pk_bf16_f32 %0, %1, %2" : "=v"(r) : "v"(lo), "v"(hi)); return r; }
__device__ __forceinline__ f32x4 gelu4(f32x4 v) { f32x4 o; o.x = gelu_tanh(v.x); o.y = gelu_tanh(v.y); o.z = gelu_tanh(v.z); o.w = gelu_tanh(v.w); return o; }
template <int ACT> struct EpiBf16 {
    static constexpr bool PERM = true, AFTER_DRAIN = false;
    bf16_t* O; int ldc; const float* bias; int split_cols; size_t split_stride;
    __device__ __forceinline__ void operator()(const f32x4 (&acc)[2][2][4][2], const Unit& u, int wr, int wc, int fr, int fq) const {
        const int row0 = u.pm * BM + wr * 64 + fr; int colt = u.pn * BM; bf16_t* base = O; int t = 0;
        if (split_cols) { t = colt / split_cols; base += (size_t)t * split_stride; colt -= t * split_cols; }
        const bool act = (ACT == 1) || (ACT == 2 && t == 0);
        const int col0 = colt + wc * 32 + 8 * fq, bcol0 = u.pn * BM + wc * 32 + 8 * fq;
        f32x4 bv[2][2];
#pragma unroll
        for (int bj = 0; bj < 2; ++bj)
#pragma unroll
            for (int n = 0; n < 2; ++n) bv[bj][n] = bias ? *(const GAS f32x4*)(bias + bcol0 + bj * HALF + 4 * n) : (f32x4){0.f, 0.f, 0.f, 0.f};
#pragma unroll
        for (int ai = 0; ai < 2; ++ai)
#pragma unroll
            for (int m = 0; m < 4; ++m) { bf16_t* rowp = base + (size_t)(row0 + ai * HALF + m * 16) * ldc + col0;
#pragma unroll
                for (int bj = 0; bj < 2; ++bj) { f32x4 v0 = acc[ai][bj][m][0] + bv[bj][0], v1 = acc[ai][bj][m][1] + bv[bj][1];
                    if (ACT != 0) { if (act) { v0 = gelu4(v0); v1 = gelu4(v1); } }
                    u32x4 w; w.x = cvt_pk_bf16(v0[0], v0[1]); w.y = cvt_pk_bf16(v0[2], v0[3]); w.z = cvt_pk_bf16(v1[0], v1[1]); w.w = cvt_pk_bf16(v1[2], v1[3]);
                    *(GAS u32x4*)(rowp + bj * HALF) = w; } }
    }
};
struct EpiResid {
    static constexpr bool PERM = false, AFTER_DRAIN = false;
    float* out; const float* xp; const float* xs; const float* modl; int which; bool from_input;
    __device__ __forceinline__ void operator()(const f32x4 (&acc)[2][2][4][2], const Unit& u, int wr, int wc, int fr, int fq) const {
        const int trow = u.pm * BM, row0 = wr * 64 + fr, col0 = u.pn * BM + wc * 32 + 4 * fq;
        const int ci = trow < NPROMPT ? 0 : 1 + ((trow - NPROMPT) >> 10);
        const float* gp = modl + (size_t)(ci * 6 + which) * D + col0;
        const float* bp = from_input ? (trow < NPROMPT ? xp + (size_t)trow * D : xs + (size_t)(trow - NPROMPT) * D) : out + (size_t)trow * D;
        GAS float* op = (GAS float*)(out + (size_t)trow * D); const GAS float* bpg = (const GAS float*)bp; const GAS float* gpg = (const GAS float*)gp;
        f32x4 gv[2][2];
#pragma unroll
        for (int bj = 0; bj < 2; ++bj)
#pragma unroll
            for (int n = 0; n < 2; ++n) gv[bj][n] = *(const GAS f32x4*)(gpg + bj * HALF + n * 16);
#pragma unroll
        for (int ai = 0; ai < 2; ++ai)
#pragma unroll
            for (int m = 0; m < 4; ++m) { const size_t off = (size_t)(row0 + ai * HALF + m * 16) * D + col0;
                f32x4 bs[2][2];
#pragma unroll
                for (int bj = 0; bj < 2; ++bj)
#pragma unroll
                    for (int n = 0; n < 2; ++n) bs[bj][n] = *(const GAS f32x4*)(bpg + off + bj * HALF + n * 16);
#pragma unroll
                for (int bj = 0; bj < 2; ++bj)
#pragma unroll
                    for (int n = 0; n < 2; ++n) *(GAS f32x4*)(op + off + bj * HALF + n * 16) = bs[bj][n] + gv[bj][n] * acc[ai][bj][m][n];
                asm volatile("" ::: "memory"); }
    }
};

__device__ __forceinline__ void ffn_tile_geom(int pm, int& rs, int& vlo, int& vhi) {
    if (pm < 32) { rs = 256 * pm; vlo = 0; vhi = 255; }
    else { const int sq = (pm - 32) / 5, i = (pm - 32) % 5; rs = NPROMPT + 1024 * sq + (i < 4 ? 254 * i : 768); vlo = i == 0 ? 0 : (i < 4 ? 1 : 249); vhi = i < 4 ? 254 : 255; }
}
struct FfnOrder : StaticOrder {
    __device__ __forceinline__ int arow(int pm) const { int rs, a, b; ffn_tile_geom(pm, rs, a, b); return rs; }
};
__device__ __forceinline__ float dpp_prev(float oldv, float v) {
    return __builtin_bit_cast(float, __builtin_amdgcn_update_dpp(__builtin_bit_cast(int, oldv), __builtin_bit_cast(int, v), 0x111, 0xf, 0xf, false)); }
__device__ __forceinline__ float dpp_next(float oldv, float v) {
    return __builtin_bit_cast(float, __builtin_amdgcn_update_dpp(__builtin_bit_cast(int, oldv), __builtin_bit_cast(int, v), 0x101, 0xf, 0xf, false)); }
__device__ __forceinline__ float dpp_ror1(float v) { return __builtin_bit_cast(float, __builtin_amdgcn_update_dpp(0, __builtin_bit_cast(int, v), 0x121, 0xf, 0xf, false)); }
__device__ __forceinline__ float dpp_ror15(float v) { return __builtin_bit_cast(float, __builtin_amdgcn_update_dpp(0, __builtin_bit_cast(int, v), 0x12F, 0xf, 0xf, false)); }
struct EpiFfn {
    static constexpr bool PERM = true, AFTER_DRAIN = false;
    bf16_t* ACT; const float* cw; const float* cb; PG8_LAS float* xb;
    __device__ __forceinline__ void operator()(const f32x4 (&acc)[2][2][4][2], const Unit& u, int wr, int wc, int fr, int fq) const {
        int rs, vlo, vhi; ffn_tile_geom(u.pm, rs, vlo, vhi);
        const int colw = wc * 32 + 8 * fq;
#pragma unroll
        for (int ai = 0; ai < 2; ++ai) { const int b = 2 * ai + wr;
            if (fr == 0) {
#pragma unroll
                for (int bj = 0; bj < 2; ++bj)
#pragma unroll
                    for (int n = 0; n < 2; ++n) *(PG8_LAS f32x4*)(xb + (b * 2 + 0) * 256 + bj * 128 + colw + 4 * n) = acc[ai][bj][0][n]; }
            if (fr == 15) {
#pragma unroll
                for (int bj = 0; bj < 2; ++bj)
#pragma unroll
                    for (int n = 0; n < 2; ++n) *(PG8_LAS f32x4*)(xb + (b * 2 + 1) * 256 + bj * 128 + colw + 4 * n) = acc[ai][bj][3][n]; } }
        asm volatile("s_waitcnt lgkmcnt(0)" ::: "memory"); __builtin_amdgcn_s_barrier(); asm volatile("" ::: "memory");
#pragma unroll
        for (int n = 0; n < 2; ++n) {
            const int ch = u.pn * 128 + colw + 4 * n;
            f32x4 wg[3], wu[3];
#pragma unroll
            for (int k = 0; k < 3; ++k) { wg[k] = *(const GAS f32x4*)(cw + (size_t)k * 2 * DFF + ch); wu[k] = *(const GAS f32x4*)(cw + (size_t)k * 2 * DFF + DFF + ch); }
            const f32x4 bgv = *(const GAS f32x4*)(cb + ch), buv = *(const GAS f32x4*)(cb + DFF + ch);
#pragma unroll
            for (int ai = 0; ai < 2; ++ai) { const int b = 2 * ai + wr;
                f32x4 pz[2], nz[2];
#pragma unroll
                for (int bj = 0; bj < 2; ++bj) { pz[bj] = b > 0 ? *(PG8_LAS const f32x4*)(xb + ((b - 1) * 2 + 1) * 256 + bj * 128 + colw + 4 * n) : (f32x4){0.f, 0.f, 0.f, 0.f};
                                                 nz[bj] = b < 3 ? *(PG8_LAS const f32x4*)(xb + ((b + 1) * 2 + 0) * 256 + bj * 128 + colw + 4 * n) : (f32x4){0.f, 0.f, 0.f, 0.f}; }
#pragma unroll
                for (int m = 0; m < 4; ++m) { f32x4 zc[2];
#pragma unroll
                    for (int bj = 0; bj < 2; ++bj) { const f32x4 z = acc[ai][bj][m][n]; const f32x4* w3 = bj == 0 ? wg : wu; f32x4 o = bj == 0 ? bgv : buv;
#pragma unroll
                        for (int e = 0; e < 4; ++e) { const float up = m > 0 ? dpp_ror1(acc[ai][bj][m - 1][n][e]) : pz[bj][e], dn = m < 3 ? dpp_ror15(acc[ai][bj][m + 1][n][e]) : nz[bj][e];
                            o[e] += w3[0][e] * dpp_prev(up, z[e]) + w3[1][e] * z[e] + w3[2][e] * dpp_next(dn, z[e]); }
                        zc[bj] = o; }
                    const int lr = 128 * ai + 64 * wr + 16 * m + fr;
                    if (lr >= vlo && lr <= vhi) { u32x2 w; w.x = cvt_pk_bf16(siluf_(zc[0][0]) * zc[1][0], siluf_(zc[0][1]) * zc[1][1]); w.y = cvt_pk_bf16(siluf_(zc[0][2]) * zc[1][2], siluf_(zc[0][3]) * zc[1][3]);
                        *(GAS u32x2*)(ACT + (size_t)(rs + lr) * DFF + ch) = w; } } }
        }
    }
};
}

struct Params { const float* in[N_IN]; float* out; unsigned char* ws; };
struct Frame {
    LAS unsigned char* lds; int tid, lane, wave, bid, G;
    const float* const* in; float* out; unsigned char* ws; float* out0; unsigned char* ws0;
    float* mod; float* rstd; float* rope; bf16 *H, *T1, *T2, *T3, *KS, *VS, *WT;
    __device__ __forceinline__ void fresh() {
        int t = threadIdx.x; asm volatile("" : "+v"(t)); tid = t; lane = t & 63; wave = __builtin_amdgcn_readfirstlane(t >> 6);
        int b = blockIdx.x; asm volatile("" : "+s"(b)); bid = b;
        unsigned char* w = ws0; asm volatile("" : "+s"(w)); ws = w; float* o = out0; asm volatile("" : "+s"(o)); out = o;
        mod = (float*)(w + WS_MOD); rstd = (float*)(w + WS_RSTD); rope = (float*)(w + WS_ROPE);
        H = (bf16*)(w + WS_H); T1 = (bf16*)(w + WS_T1); T2 = (bf16*)(w + WS_T2); T3 = (bf16*)(w + WS_T3); KS = (bf16*)(w + WS_KS); VS = (bf16*)(w + WS_VS); WT = (bf16*)(w + WS_W);
    }
};
__device__ __forceinline__ const float* xin_row(const Frame& F, int row) { return row < NPROMPT ? F.in[I_XP] + (size_t)row * D : F.in[I_XS] + (size_t)(row - NPROMPT) * D; }
__device__ __forceinline__ int cidx_of(int row) { return row < NPROMPT ? 0 : 1 + ((row - NPROMPT) >> 10); }
__device__ __forceinline__ const float* modp(const Frame& F, int l, int row, int which) { return F.mod + (size_t)((l * 3 + cidx_of(row)) * 6 + which) * D; }


template <int MODE  >
__device__ __forceinline__ void transpose_item(const float* W, int K, int N, bf16* WT, LAS float* scr, int item, int lane) {
    const int nblk = N / 32, kb = item / nblk, nb = item % nblk, k0 = 64 * kb, n0 = 32 * nb;
    int d0 = n0; if (MODE == 1) { const int isu = n0 >= DFF, jj = n0 - isu * DFF; d0 = (jj >> 7) * 256 + isu * 128 + (jj & 127); }
#pragma unroll 8
    for (int i = 0; i < 32; ++i) { const int kk = 2 * i + (lane >> 5); scr[kk * 33 + (lane & 31)] = W[(size_t)(k0 + kk) * N + n0 + (lane & 31)]; }
    asm volatile("s_waitcnt lgkmcnt(0)" ::: "memory");
    const int c = lane & 7;
#pragma unroll
    for (int j = 0; j < 4; ++j) { const int n = (lane >> 3) + 8 * j; const LAS float* sp = scr + (8 * c) * 33 + n;
        u32x4 o; o.x = f2bf(sp[0 * 33]) | (f2bf(sp[1 * 33]) << 16); o.y = f2bf(sp[2 * 33]) | (f2bf(sp[3 * 33]) << 16); o.z = f2bf(sp[4 * 33]) | (f2bf(sp[5 * 33]) << 16); o.w = f2bf(sp[6 * 33]) | (f2bf(sp[7 * 33]) << 16);
        *(u32x4*)(WT + (size_t)(d0 + n) * K + k0 + 8 * c) = o; }
    asm volatile("s_waitcnt lgkmcnt(0)" ::: "memory");
}
template <int MODE = 0>
__device__ __forceinline__ bool transpose_group(int& r, const float* W, int nmat, int K, int N, bf16* WT, LAS float* scr, int lane) {
    const int per = (K / 64) * (N / 32), tot = nmat * per;
    if (r >= tot) { r -= tot; return false; }
    const int mi = r / per; transpose_item<MODE>(W + (size_t)mi * K * N, K, N, WT + (size_t)mi * K * N, scr, r % per, lane); return true;
}
__device__ __forceinline__ void phase_prologue(Frame& F) {
    F.fresh();
    LAS float* sc = (LAS float*)F.lds;
    const float* c = F.in[I_C]; const float* cctx = F.in[I_CCTX];
    for (int i = F.tid; i < 3 * D; i += NT) { const int ci = i >> 10, k = i & 1023; const float v = ci == 0 ? cctx[k] : c[(ci - 1) * D + k]; sc[i] = siluf_(v); }
    __syncthreads();
    LAS float* part = sc + 3 * D;
    const int kp = F.tid >> 6, cl = F.tid & 63;
    for (int item = F.bid; item < DEPTH * 6 * D / 64; item += F.G) {
        const int col = item * 64 + cl, l = col / (6 * D), cc = col % (6 * D);
        const float* w = F.in[I_WMOD] + (size_t)l * D * 6 * D + cc;
        float s0 = 0.f, s1 = 0.f, s2 = 0.f;
        for (int k = kp * 128; k < kp * 128 + 128; ++k) { const float wv = w[(size_t)k * 6 * D]; s0 += sc[k] * wv; s1 += sc[D + k] * wv; s2 += sc[2 * D + k] * wv; }
        part[(kp * 3 + 0) * 64 + cl] = s0; part[(kp * 3 + 1) * 64 + cl] = s1; part[(kp * 3 + 2) * 64 + cl] = s2;
        __syncthreads();
        if (F.tid < 192) { const int ci = F.tid >> 6; float s = F.in[I_BMOD][l * 6 * D + cc];
            for (int q = 0; q < 8; ++q) s += part[(q * 3 + ci) * 64 + cl];
            F.mod[(size_t)((l * 3 + ci) * 6) * D + cc] = s; }
        __syncthreads();
    }
    { __syncthreads();
      LAS float* scr = (LAS float*)(F.lds + F.wave * 16384);
      const int gw = F.bid * NWAVES + F.wave, NGW = F.G * NWAVES;
      constexpr int NITEMS = (int)(WE_END / 2048);
      for (int it = gw; it < NITEMS; it += NGW) { int r = it;
          if (transpose_group<1>(r, F.in[I_FF_WUP], 4, D, 2 * DFF, F.WT + WE_UP, scr, F.lane)) continue;
          if (transpose_group(r, F.in[I_FF_WDN], 4, DFF, D, F.WT + WE_DN, scr, F.lane)) continue;
          if (transpose_group(r, F.in[I_LRU_WIN], 2, D, 2 * DRNN, F.WT + WE_LRU_IN, scr, F.lane)) continue;
          if (transpose_group(r, F.in[I_LRU_WOUT], 2, DRNN, D, F.WT + WE_LRU_OUT, scr, F.lane)) continue;
          if (transpose_group(r, F.in[I_CM_WIN], 1, D, 2 * DB, F.WT + WE_CM_IN, scr, F.lane)) continue;
          if (transpose_group(r, F.in[I_CM_WOUT], 1, DB, D, F.WT + WE_CM_OUT, scr, F.lane)) continue;
          if (transpose_group(r, F.in[I_AT_WQKV], 1, D, 3 * D, F.WT + WE_QKV, scr, F.lane)) continue;
          if (transpose_group(r, F.in[I_AT_WOUT], 1, D, D, F.WT + WE_AT_OUT, scr, F.lane)) continue;
          transpose_group(r, F.in[I_LRU_WG], 80, 128, 128, F.WT + WE_WG, scr, F.lane); } }
    const int gt = F.bid * NT + F.tid, GT = F.G * NT;
    for (int i = gt; i < 1024 * 32; i += GT) { const int t = i >> 5, j = i & 31; const float inv = powf(10000.f, -(float)(j & 15) / 16.f); const float pos = (float)(j < 16 ? (t >> 6) : (t & 63));
        const float ang = pos * inv; F.rope[i] = cosf(ang); F.rope[32768 + i] = sinf(ang); }
    for (int i = gt; i < 8 * 8 * 4 * 64; i += GT) { const int ln = i & 63, ks = (i >> 6) & 3, nf = (i >> 8) & 7, g = i >> 11, cq = ln >> 4, p = 16 * nf + (ln & 15);
        const float* wr = F.in[I_CM_WS] + (size_t)(g * 128 + p) * 128 + 32 * ks + 4 * cq;
        u32x4 o; o.x = f2bf(wr[0]) | (f2bf(wr[1]) << 16); o.y = f2bf(wr[2]) | (f2bf(wr[3]) << 16); o.z = f2bf(wr[16]) | (f2bf(wr[17]) << 16); o.w = f2bf(wr[18]) | (f2bf(wr[19]) << 16);
        *(u32x4*)(F.WT + WE_WSB + (size_t)i * 8) = o; }
    for (int i = gt; i < 2 * PAST * D; i += GT) { const int b = i / (PAST * D), r = i % (PAST * D);
        F.KS[(size_t)b * TKS * D + r] = (bf16)f2bf(F.in[I_CK][i]); F.VS[(size_t)b * TKS * D + r] = (bf16)f2bf(F.in[I_CV][i]); }
}

__device__ __forceinline__ void phase_modulate(Frame& F, int l, int sub) {
    F.fresh();
    const int gw = F.bid * NWAVES + F.wave, NGW = F.G * NWAVES;
    const float* g = F.in[I_NORMG] + (size_t)(l * 2 + sub) * D;
    for (int row = gw; row < M; row += NGW) {
        const float* xr = (l == 0 && sub == 0) ? xin_row(F, row) : F.out + (size_t)row * D;
        const float* sh = modp(F, l, row, sub * 3 + 0); const float* scl = modp(F, l, row, sub * 3 + 1);
        f32x4 v[4]; float s = 0.f;
#pragma unroll
        for (int j = 0; j < 4; ++j) { v[j] = *(const f32x4*)(xr + 4 * F.lane + 256 * j); s += v[j].x * v[j].x + v[j].y * v[j].y + v[j].z * v[j].z + v[j].w * v[j].w; }
        const float rstd = rsqrtf(wave_sum(s) * (1.f / D) + EPS);
#pragma unroll
        for (int j = 0; j < 4; ++j) { const int c0 = 4 * F.lane + 256 * j; const f32x4 gg = *(const f32x4*)(g + c0), s4 = *(const f32x4*)(sh + c0), c4 = *(const f32x4*)(scl + c0);
            const f32x4 o = v[j] * rstd * gg * (1.f + c4) + s4; u32x2 w; w.x = f2bf(o.x) | (f2bf(o.y) << 16); w.y = f2bf(o.z) | (f2bf(o.w) << 16);
            *(u32x2*)(F.H + (size_t)row * D + c0) = w; }
    }
}

template <class P>
__device__ __forceinline__ void gemm_naive(Frame& F, const P& p, int nbatch, int Mr, int N, int K) {
    F.fresh();
    LAS float* As = (LAS float*)F.lds;
    LAS float* Bs = As + 16 * 132;
    const int tid = F.tid, tx = tid & 31, ty = tid >> 5;
    const int tm = Mr / 128, tn = N / 128, per = tm * tn, total = per * nbatch;
    for (int t = F.bid; t < total; t += F.G) {
        const int b = t / per, r = t % per, pn = r / tm, pm = r % tm;
        const bf16* A; int lda; const float* W; int ldw; p.get(b, A, lda, W, ldw);
        float acc[8][4];
#pragma unroll
        for (int i = 0; i < 8; ++i)
#pragma unroll
            for (int j = 0; j < 4; ++j) acc[i][j] = 0.f;
        for (int k0 = 0; k0 < K; k0 += 16) {
            { const int row = tid >> 2, kq = (tid & 3) * 4;
              const u32x2 v = *(const u32x2*)(A + (size_t)(pm * 128 + row) * lda + k0 + kq);
              As[(kq + 0) * 132 + row] = bf2f(v.x); As[(kq + 1) * 132 + row] = bf2f(v.x >> 16); As[(kq + 2) * 132 + row] = bf2f(v.y); As[(kq + 3) * 132 + row] = bf2f(v.y >> 16); }
            { const int k = tid >> 5, n4 = (tid & 31) * 4;
              *(LAS f32x4*)(Bs + k * 128 + n4) = *(const f32x4*)(W + (size_t)(k0 + k) * ldw + pn * 128 + n4); }
            __syncthreads();
#pragma unroll 2
            for (int k = 0; k < 16; ++k) {
                const f32x4 a0 = *(const LAS f32x4*)(As + k * 132 + ty * 8), a1 = *(const LAS f32x4*)(As + k * 132 + ty * 8 + 4), bv = *(const LAS f32x4*)(Bs + k * 128 + tx * 4);
                const float a[8] = {a0.x, a0.y, a0.z, a0.w, a1.x, a1.y, a1.z, a1.w}; const float bb[4] = {bv.x, bv.y, bv.z, bv.w};
#pragma unroll
                for (int i = 0; i < 8; ++i)
#pragma unroll
                    for (int j = 0; j < 4; ++j) acc[i][j] += a[i] * bb[j];
            }
            __syncthreads();
        }
#pragma unroll
        for (int i = 0; i < 8; ++i)
#pragma unroll
            for (int j = 0; j < 4; ++j) p.epi(b, pm * 128 + ty * 8 + i, pn * 128 + tx * 4 + j, acc[i][j]);
    }
}

struct PStoreBf16 {
    const bf16* A; int lda; const float* W; int ldw; bf16* O; int ldo; const float* bias; int act; int split;
    __device__ __forceinline__ void get(int, const bf16*& a, int& la, const float*& w, int& lw) const { a = A; la = lda; w = W; lw = ldw; }
    __device__ __forceinline__ void epi(int, int row, int col, float v) const {
        if (bias) v += bias[col];
        if (act == 1 || (act == 2 && col < split)) v = gelu_tanh(v);
        O[(size_t)row * ldo + col] = (bf16)f2bf(v); }
};
struct PResid {
    const bf16* A; int lda; const float* W; int ldw; float* out; const float* xp; const float* xs; const float* modl; int which; bool from_input;
    __device__ __forceinline__ void get(int, const bf16*& a, int& la, const float*& w, int& lw) const { a = A; la = lda; w = W; lw = ldw; }
    __device__ __forceinline__ void epi(int, int row, int col, float v) const {
        const float base = from_input ? (row < NPROMPT ? xp[(size_t)row * D + col] : xs[(size_t)(row - NPROMPT) * D + col]) : out[(size_t)row * D + col];
        out[(size_t)row * D + col] = base + modl[(size_t)(cidx_of(row) * 6 + which) * D + col] * v; }
};
struct PLruIn {
    const bf16* A; const float* W; bf16* GBp; bf16* RECp;
    __device__ __forceinline__ void get(int, const bf16*& a, int& la, const float*& w, int& lw) const { a = A; la = D; w = W; lw = 2 * DRNN; }
    __device__ __forceinline__ void epi(int, int row, int col, float v) const {
        if (col < DRNN) GBp[(size_t)row * DRNN + col] = (bf16)f2bf(gelu_tanh(v)); else RECp[(size_t)row * DRNN + col - DRNN] = (bf16)f2bf(v); }
};
struct PGates {
    const bf16* XC; const float* WG; const float* BG; bf16* O;
    __device__ __forceinline__ void get(int b, const bf16*& a, int& la, const float*& w, int& lw) const { a = XC + (b % 10) * 128; la = DRNN; w = WG + (size_t)b * 128 * 128; lw = 128; }
    __device__ __forceinline__ void epi(int b, int row, int col, float v) const { const int dg = b / 10, n = b % 10;
        O[((size_t)dg * M + row) * DRNN + n * 128 + col] = (bf16)f2bf(sigmoidf_(v + BG[dg * DRNN + n * 128 + col])); }
};

__device__ __forceinline__ void phase_lru_conv(Frame& F, int j, const bf16* REC, bf16* XC) {
    F.fresh();
    const float* cw = F.in[I_LRU_CW] + (size_t)j * 4 * DRNN; const float* cb = F.in[I_LRU_CB] + (size_t)j * DRNN;
    const int gt = F.bid * NT + F.tid, GT = F.G * NT;
    for (int i = gt; i < M * DRNN; i += GT) { const int row = i / DRNN, ch = i % DRNN;
        int t, T; if (row < NPROMPT) { t = row & 255; T = 256; } else { t = (row - NPROMPT) & 1023; T = 1024; }
        float s = cb[ch];
#pragma unroll
        for (int k = 0; k < 4; ++k) { const int tt = t + k - 2; if (tt >= 0 && tt < T) s += cw[k * DRNN + ch] * bf2f(REC[(size_t)(row + k - 2) * DRNN + ch]); }
        XC[i] = (bf16)f2bf(s); }
}
__device__ __forceinline__ void phase_lru_scan(Frame& F, int j, const bf16* GATES, const bf16* XC, const bf16* GB, bf16* HS) {
    F.fresh();
    const int gt = F.bid * NT + F.tid, GT = F.G * NT;
    const int NL = (2 + 32) * DRNN;
    for (int line = gt; line < NL; line += GT) {
        const int s = line / DRNN, ch = line % DRNN;
        int base, T; float h0f = 0.f, h0b = 0.f;
        if (s < 2) { base = NPROMPT + s * 1024; T = 1024; h0f = F.in[I_STATE][((size_t)(s * 2 + j) * 2 + 0) * DRNN + ch]; h0b = F.in[I_STATE][((size_t)(s * 2 + j) * 2 + 1) * DRNN + ch]; }
        else { base = (s - 2) * 256; T = 256; }
        const float spf = softplusf_(-F.in[I_LRU_LAM][(size_t)(j * 2 + 0) * DRNN + ch]), spb = softplusf_(-F.in[I_LRU_LAM][(size_t)(j * 2 + 1) * DRNN + ch]);
        float h = h0f;
        for (int t = 0; t < T; ++t) { const size_t o = (size_t)(base + t) * DRNN + ch;
            const float r = bf2f(GATES[o]), ig = bf2f(GATES[(size_t)M * DRNN + o]), xc = bf2f(XC[o]);
            const float la = -8.f * r * spf, a = expf(la), bx = sqrtf(-expm1f(2.f * la)) * (ig * xc);
            h = a * h + bx; HS[o] = (bf16)f2bf(h); }
        const float ff = h;
        h = h0b;
        for (int t = T - 1; t >= 0; --t) { const size_t o = (size_t)(base + t) * DRNN + ch;
            const float r = bf2f(GATES[(size_t)2 * M * DRNN + o]), ig = bf2f(GATES[(size_t)3 * M * DRNN + o]), xc = bf2f(XC[o]);
            const float la = -8.f * r * spb, a = expf(la), bx = sqrtf(-expm1f(2.f * la)) * (ig * xc);
            h = a * h + bx; HS[o] = (bf16)f2bf(bf2f(GB[o]) * (bf2f(HS[o]) + h)); }
        if (s >= 2) { float* st = F.out + O_STATE + ((size_t)((s - 2) * 2 + j) * 2) * DRNN; st[ch] = ff; st[DRNN + ch] = h; }
    }
}


typedef short bf16x8 __attribute__((ext_vector_type(8)));
typedef short v4i16_t __attribute__((ext_vector_type(4)));
constexpr int LRU_XS = 272;
constexpr int LRU_XC_OFF = 0, LRU_GB_OFF = 256 * LRU_XS;
template <bool REV>
__device__ __forceinline__ float lru_dir(LAS const unsigned char* xct, LAS unsigned char* hft, const bf16* wgt  ,
                                         const bf16* gbp  , float br, float bi, float sp, float hc, int wave, int lane, bool wantp, bf16* Pdst) {
    const int c = lane & 15, q = lane >> 4, qq = REV ? 3 - q : q;
    bf16x8 Br[4], Bi[4], Id;
#pragma unroll
    for (int ks = 0; ks < 4; ++ks) { Br[ks] = *(const GAS bf16x8*)(wgt + (size_t)(16 * wave + c) * 128 + 32 * ks + 8 * q);
                                     Bi[ks] = *(const GAS bf16x8*)(wgt + (size_t)10 * 128 * 128 + (size_t)(16 * wave + c) * 128 + 32 * ks + 8 * q); }
#pragma unroll
    for (int jj = 0; jj < 8; ++jj) Id[jj] = (8 * q + jj == 16 * (wave & 1) + c) ? (short)0x3F80 : (short)0;
    const int ksel = wave >> 1;
    float Pc = 1.f;
#pragma unroll 2
    for (int it = 0; it < 16; ++it) {
        const int mi = REV ? 15 - it : it;
        LAS const unsigned char* rp = xct + (16 * mi + c) * LRU_XS + 16 * q;
        float gbv[4];
        if (REV) {
#pragma unroll
            for (int k = 0; k < 4; ++k) gbv[k] = bf2f(*(const GAS unsigned short*)(gbp + (size_t)(16 * mi + 4 * q + k) * DRNN)); }
        bf16x8 Af[4];
#pragma unroll
        for (int ks = 0; ks < 4; ++ks) Af[ks] = *(LAS const bf16x8*)(rp + 64 * ks);
        const bf16x8 Ax = *(LAS const bf16x8*)(rp + 64 * ksel);
        f32x4 r = {0.f, 0.f, 0.f, 0.f}, ig = {0.f, 0.f, 0.f, 0.f};
#pragma unroll
        for (int ks = 0; ks < 4; ++ks) { r = __builtin_amdgcn_mfma_f32_16x16x32_bf16(Af[ks], Br[ks], r, 0, 0, 0); ig = __builtin_amdgcn_mfma_f32_16x16x32_bf16(Af[ks], Bi[ks], ig, 0, 0, 0); }
        const f32x4 xc = __builtin_amdgcn_mfma_f32_16x16x32_bf16(Ax, Id, (f32x4){0.f, 0.f, 0.f, 0.f}, 0, 0, 0);
        float av[4], bv[4];
#pragma unroll
        for (int k = 0; k < 4; ++k) { const float rg = sigmoidf_(r[k] + br), iv = sigmoidf_(ig[k] + bi);
            const float la = -8.f * rg * sp, x = 2.f * la;
            const float oms = -x * (1.f + x * (0.5f + x * (0.16666667f + x * (0.041666668f + x * 0.0083333338f))));
            const float om = x > -0.25f ? oms : 1.f - __expf(x);
            av[k] = __expf(la); bv[k] = sqrtf(om) * (iv * xc[k]); }
        float pA[4], pB[4];
#pragma unroll
        for (int kk = 0; kk < 4; ++kk) { const int k = REV ? 3 - kk : kk;
            if (kk == 0) { pA[k] = av[k]; pB[k] = bv[k]; } else { const int kp = REV ? k + 1 : k - 1; pA[k] = pA[kp] * av[k]; pB[k] = pB[kp] * av[k] + bv[k]; } }
        const int kl = REV ? 0 : 3;
        float gA = pA[kl], gB = pB[kl];
        { const float tA = REV ? __shfl_down(gA, 16) : __shfl_up(gA, 16), tB = REV ? __shfl_down(gB, 16) : __shfl_up(gB, 16); if (qq >= 1) { gB = tB * gA + gB; gA = tA * gA; } }
        { const float tA = REV ? __shfl_down(gA, 32) : __shfl_up(gA, 32), tB = REV ? __shfl_down(gB, 32) : __shfl_up(gB, 32); if (qq >= 2) { gB = tB * gA + gB; gA = tA * gA; } }
        float eA = REV ? __shfl_down(gA, 16) : __shfl_up(gA, 16), eB = REV ? __shfl_down(gB, 16) : __shfl_up(gB, 16); if (qq == 0) { eA = 1.f; eB = 0.f; }
        const int src = (REV ? 0 : 48) + c;
        const float totA = __shfl(gA, src), totB = __shfl(gB, src);
        const float hin = eA * hc + eB;
#pragma unroll
        for (int k = 0; k < 4; ++k) { const float h = pA[k] * hin + pB[k]; const int row = 16 * mi + 4 * q + k;
            if (wantp) Pdst[(size_t)row * DRNN] = (bf16)f2bf(pA[k] * eA * Pc);
            LAS unsigned short* hp = (LAS unsigned short*)(hft + row * LRU_XS + 2 * (16 * wave + c));
            if (!REV) *hp = (unsigned short)f2bf(h); else *hp = (unsigned short)f2bf(gbv[k] * (bf2f(*hp) + h)); }
        hc = totA * hc + totB; Pc *= totA;
    }
    return hc;
}
__device__ __forceinline__ void lru_unit(Frame& F, int j, int pm, int n, const bf16* REC, const bf16* GB, bf16* HS, bf16* PF, bf16* PB, float* AGG, const bf16* WGT) {
    const int tid = F.tid, lane = F.lane, wave = F.wave, r0 = 256 * pm;
    const bool smp = pm >= 32; const int tix = smp ? (pm - 32) & 3 : 0, sq = smp ? (pm - 32) >> 2 : 0;
    const int t0 = smp ? 256 * tix : 0, T = smp ? 1024 : 256;
    LAS unsigned char* xct = F.lds + LRU_XC_OFF; LAS unsigned char* hft = F.lds + LRU_GB_OFF;
    { const float* cw = F.in[I_LRU_CW] + (size_t)j * 4 * DRNN + n * 128 + 2 * lane; const float* cb = F.in[I_LRU_CB] + (size_t)j * DRNN + n * 128 + 2 * lane;
      float w0[4], w1[4];
#pragma unroll
      for (int k = 0; k < 4; ++k) { w0[k] = cw[k * DRNN]; w1[k] = cw[k * DRNN + 1]; }
      const float b0 = cb[0], b1 = cb[1];
      unsigned v[35];
#pragma unroll
      for (int i = 0; i < 35; ++i) { const int tl = 32 * wave + i - 2, tt = t0 + tl;
          v[i] = (tt >= 0 && tt < T) ? *(const GAS unsigned*)(REC + (size_t)(r0 + tl) * DRNN + n * 128 + 2 * lane) : 0u; }
#pragma unroll
      for (int i = 0; i < 32; ++i) { float s0 = b0, s1 = b1;
#pragma unroll
          for (int k = 0; k < 4; ++k) { s0 += w0[k] * bf2f(v[i + k]); s1 += w1[k] * bf2f(v[i + k] >> 16); }
          *(LAS unsigned*)(xct + (32 * wave + i) * LRU_XS + 4 * lane) = f2bf(s0) | (f2bf(s1) << 16); } }
    __syncthreads();
    const int c = lane & 15, q = lane >> 4, ch = n * 128 + 16 * wave + c;
    const float* bg = F.in[I_LRU_BG] + (size_t)j * 4 * DRNN; const float* lam = F.in[I_LRU_LAM] + (size_t)j * 2 * DRNN;
    const bf16* gbp = GB + (size_t)r0 * DRNN + ch;
    bf16* pf = PF + (size_t)(smp ? r0 - NPROMPT : 0) * DRNN + ch; bf16* pb = PB + (size_t)(smp ? r0 - NPROMPT : 0) * DRNN + ch;
    { float h0 = 0.f; if (smp && tix == 0) h0 = F.in[I_STATE][((size_t)(sq * 2 + j) * 2 + 0) * DRNN + ch];
      const float hfin = lru_dir<false>(xct, hft, WGT + (size_t)(0 * 10 + n) * 128 * 128, gbp, bg[0 * DRNN + ch], bg[1 * DRNN + ch], softplusf_(-lam[ch]), h0, wave, lane, smp, pf);
      if (q == 0) { if (smp) AGG[(size_t)((sq * 4 + tix) * 2 + 0) * DRNN + ch] = hfin; else F.out[O_STATE + ((size_t)(pm * 2 + j) * 2 + 0) * DRNN + ch] = hfin; } }
    { float h0 = 0.f; if (smp && tix == 3) h0 = F.in[I_STATE][((size_t)(sq * 2 + j) * 2 + 1) * DRNN + ch];
      const float hfin = lru_dir<true>(xct, hft, WGT + (size_t)(2 * 10 + n) * 128 * 128, gbp, bg[2 * DRNN + ch], bg[3 * DRNN + ch], softplusf_(-lam[DRNN + ch]), h0, wave, lane, smp, pb);
      if (q == 0) { if (smp) AGG[(size_t)((sq * 4 + tix) * 2 + 1) * DRNN + ch] = hfin; else F.out[O_STATE + ((size_t)(pm * 2 + j) * 2 + 1) * DRNN + ch] = hfin; } }
    __syncthreads();
#pragma unroll
    for (int i = 0; i < 8; ++i) { const int id = i * NT + tid, row = id >> 4, cc = id & 15;
        *(GAS u32x4*)(HS + (size_t)(r0 + row) * DRNN + n * 128 + 8 * cc) = *(LAS const u32x4*)(hft + row * LRU_XS + 16 * cc); }
    __syncthreads();
}
__device__ __forceinline__ void phase_lru_core(Frame& F, int j, const bf16* REC, const bf16* GB, bf16* HS, bf16* PF, bf16* PB, float* AGG, const bf16* WGT) {
    F.fresh();
    for (int u = F.bid; u < 400; u += F.G) {
        const int pm = u < 80 ? 32 + u / 10 : (u - 80) / 10, n = u % 10;
        lru_unit(F, j, pm, n, REC, GB, HS, PF, PB, AGG, WGT); }
}
__device__ __forceinline__ void phase_lru_fixup(Frame& F, const bf16* GB, bf16* HS, const bf16* PF, const bf16* PB, const float* AGG) {
    F.fresh();
    const int gt = F.bid * NT + F.tid, GT = F.G * NT;
    for (int i = gt; i < NSAMPLE * DRNN; i += GT) { const int rs = i / DRNN, ch = i % DRNN, sq = rs >> 10, tix = (rs >> 8) & 3;
        float cf = 0.f, cbk = 0.f;
        if (tix > 0) { for (int t = 0; t < tix; ++t) { const float At = bf2f(PF[(size_t)(sq * 1024 + t * 256 + 255) * DRNN + ch]); cf = At * cf + AGG[(size_t)((sq * 4 + t) * 2 + 0) * DRNN + ch]; } }
        if (tix < 3) { for (int t = 3; t > tix; --t) { const float At = bf2f(PB[(size_t)(sq * 1024 + t * 256) * DRNN + ch]); cbk = At * cbk + AGG[(size_t)((sq * 4 + t) * 2 + 1) * DRNN + ch]; } }
        const size_t o = (size_t)(NPROMPT + rs) * DRNN + ch;
        HS[o] = (bf16)f2bf(bf2f(HS[o]) + bf2f(GB[o]) * (bf2f(PF[(size_t)rs * DRNN + ch]) * cf + bf2f(PB[(size_t)rs * DRNN + ch]) * cbk)); }
}

__device__ __forceinline__ void phase_cmlp_rstd(Frame& F, const bf16* UV) {
    F.fresh();
    const int gw = F.bid * NWAVES + F.wave, NGW = F.G * NWAVES;
    for (int row = gw; row < M; row += NGW) { float s = 0.f;
        for (int c = F.lane; c < DB; c += 64) { const float v = bf2f(UV[(size_t)row * 2 * DB + DB + c]); s += v * v; }
        s = wave_sum(s); if (F.lane == 0) F.rstd[row] = rsqrtf(s * (1.f / DB) + EPS); }
}
__device__ __forceinline__ void phase_cmlp_spatial(Frame& F, const bf16* UV, bf16* ACT) {
    F.fresh();
    const float* ws = F.in[I_CM_WS]; const float* bs = F.in[I_CM_BS]; const float* ng = F.in[I_CM_NG];
    const int gt = F.bid * NT + F.tid, GT = F.G * NT;
    for (int i = gt; i < M * DB; i += GT) { const int row = i / DB, ch = i % DB, g = ch >> 8, p = row & 127, r0 = row & ~127;
        float s = 0.f;
        for (int q = 0; q < 128; ++q) s += ws[(size_t)(g * 128 + p) * 128 + q] * F.rstd[r0 + q] * bf2f(UV[(size_t)(r0 + q) * 2 * DB + DB + ch]);
        const float sv = s * ng[ch] + bs[g * 128 + p];
        ACT[i] = (bf16)f2bf(bf2f(UV[(size_t)row * 2 * DB + ch]) * sv); }
}


constexpr int CM_VS = 544;
__device__ __forceinline__ void phase_cmlp_spatial_mfma(Frame& F, const bf16* UV, bf16* ACT, const bf16* WSB) {
    F.fresh();
    const int tid = F.tid, lane = F.lane, wave = F.wave, c = lane & 15, q4 = lane >> 4;
    LAS unsigned char* vt = F.lds;
    const float* ng = F.in[I_CM_NG]; const float* bs = F.in[I_CM_BS];
    for (int u = F.bid; u < 640; u += F.G) {
        const int chunk = u >> 3, g = u & 7, r0 = chunk * 128;
#pragma unroll
        for (int i = 0; i < 8; ++i) { const int id = i * NT + tid, row = id >> 5, cc = id & 31;
            const u32x4 x = *(const GAS u32x4*)(UV + (size_t)(r0 + row) * 2 * DB + DB + g * 256 + 8 * cc); const float rs = F.rstd[r0 + row];
            u32x4 y; y.x = f2bf(bf2f(x.x) * rs) | (f2bf(bf2f(x.x >> 16) * rs) << 16); y.y = f2bf(bf2f(x.y) * rs) | (f2bf(bf2f(x.y >> 16) * rs) << 16);
            y.z = f2bf(bf2f(x.z) * rs) | (f2bf(bf2f(x.z >> 16) * rs) << 16); y.w = f2bf(bf2f(x.w) * rs) | (f2bf(bf2f(x.w >> 16) * rs) << 16);
            *(LAS u32x4*)(vt + row * CM_VS + 16 * cc) = y; }
        __syncthreads();
        bf16x8 vf[2][4];
#pragma unroll
        for (int mfc = 0; mfc < 2; ++mfc)
#pragma unroll
            for (int ks = 0; ks < 4; ++ks) { LAS const unsigned char* vp = vt + (32 * ks + 4 * q4 + (c >> 2)) * CM_VS + (32 * wave + 16 * mfc + 4 * (c & 3)) * 2;
                const v4i16_t lo = __builtin_amdgcn_ds_read_tr16_b64_v4i16((LAS v4i16_t*)vp), hi = __builtin_amdgcn_ds_read_tr16_b64_v4i16((LAS v4i16_t*)(vp + 16 * CM_VS));
                vf[mfc][ks] = (bf16x8){lo[0], lo[1], lo[2], lo[3], hi[0], hi[1], hi[2], hi[3]}; }
#pragma unroll
        for (int nf = 0; nf < 8; ++nf) {
            bf16x8 Bf[4];
#pragma unroll
            for (int ks = 0; ks < 4; ++ks) Bf[ks] = *(const GAS bf16x8*)(WSB + ((size_t)((g * 8 + nf) * 4 + ks) * 64 + lane) * 8);
            const int p = 16 * nf + c; const float bsv = bs[g * 128 + p];
#pragma unroll
            for (int mfc = 0; mfc < 2; ++mfc) { f32x4 acc = {0.f, 0.f, 0.f, 0.f};
#pragma unroll
                for (int ks = 0; ks < 4; ++ks) acc = __builtin_amdgcn_mfma_f32_16x16x32_bf16(vf[mfc][ks], Bf[ks], acc, 0, 0, 0);
                const int ch = g * 256 + 32 * wave + 16 * mfc + 4 * q4;
                const f32x4 g4 = *(const GAS f32x4*)(ng + ch); const u32x2 uu = *(const GAS u32x2*)(UV + (size_t)(r0 + p) * 2 * DB + ch);
                const float o0 = bf2f(uu.x) * (acc[0] * g4.x + bsv), o1 = bf2f(uu.x >> 16) * (acc[1] * g4.y + bsv), o2 = bf2f(uu.y) * (acc[2] * g4.z + bsv), o3 = bf2f(uu.y >> 16) * (acc[3] * g4.w + bsv);
                u32x2 w; w.x = f2bf(o0) | (f2bf(o1) << 16); w.y = f2bf(o2) | (f2bf(o3) << 16);
                *(GAS u32x2*)(ACT + (size_t)(r0 + p) * DB + ch) = w; }
        }
        __syncthreads();
    }
}

__device__ __forceinline__ void phase_qkv_post(Frame& F, const bf16* QKV, bf16* Q, bf16* KP, bf16* VP) {
    F.fresh();
    const int gw = F.bid * NWAVES + F.wave, NGW = F.G * NWAVES;
    const float* qkg = F.in[I_AT_QKG];
    for (int row = gw; row < M; row += NGW) {
        const bool smp = row >= NPROMPT; const int sb = smp ? (row - NPROMPT) >> 10 : 0, t = smp ? (row - NPROMPT) & 1023 : 0;
        const float cs = smp ? F.rope[t * 32 + (F.lane & 31)] : 1.f, sn = smp ? F.rope[32768 + t * 32 + (F.lane & 31)] : 0.f;
        for (int grp = 0; grp < 32; ++grp) {
            const float v = bf2f(QKV[(size_t)row * 3072 + grp * 64 + F.lane]);
            const float ms = wave_sum(v * v) * (1.f / 64.f);
            float n = v * rsqrtf(ms + EPS) * qkg[(grp >> 4) * 64 + F.lane];
            const float keep = n;
            if (smp) { const float pr = __shfl_xor(n, 32); n = F.lane < 32 ? n * cs - pr * sn : n * cs + pr * sn; }
            if (grp < 16) Q[(size_t)row * D + grp * 64 + F.lane] = (bf16)f2bf(n);
            else { const int c = (grp - 16) * 64 + F.lane;
                if (smp) F.KS[((size_t)sb * TKS + PAST + t) * D + c] = (bf16)f2bf(n);
                else { KP[(size_t)row * D + c] = (bf16)f2bf(keep); F.out[O_CK + (size_t)row * D + c] = keep; } }
        }
        for (int c = F.lane; c < D; c += 64) { const bf16 vb = QKV[(size_t)row * 3072 + 2048 + c];
            if (smp) F.VS[((size_t)sb * TKS + PAST + t) * D + c] = vb; else { VP[(size_t)row * D + c] = vb; F.out[O_CV + (size_t)row * D + c] = bf2f(vb); } }
    }
}
__device__ __forceinline__ void phase_attn_naive(Frame& F, int l, const bf16* Q, const bf16* KP, const bf16* VP, bf16* O) {
    F.fresh();
    const int gw = F.bid * NWAVES + F.wave, NGW = F.G * NWAVES;
    LAS float* s1 = (LAS float*)F.lds + F.wave * 3328; LAS float* s2 = s1 + 1536; LAS float* qs = s2 + 1536;
    const float* al = F.in[I_AT_LAM];
    const float lam_init = 0.8f - 0.6f * expf(-0.3f * (float)l);
    const float lam = expf(wave_sum(al[F.lane] * al[64 + F.lane])) - expf(wave_sum(al[128 + F.lane] * al[192 + F.lane])) + lam_init;
    const float* sg = F.in[I_AT_SUBG];
    for (int item = gw; item < M * 8; item += NGW) {
        const int row = item >> 3, h = item & 7;
        const bf16 *Kb, *Vb; int Tk;
        if (row < NPROMPT) { Kb = KP + (size_t)(row & ~255) * D; Vb = VP + (size_t)(row & ~255) * D; Tk = 256; }
        else { const int sb = (row - NPROMPT) >> 10; Kb = F.KS + (size_t)sb * TKS * D; Vb = F.VS + (size_t)sb * TKS * D; Tk = TKS; }
        qs[F.lane] = bf2f(Q[(size_t)row * D + h * 128 + F.lane]); qs[64 + F.lane] = bf2f(Q[(size_t)row * D + h * 128 + 64 + F.lane]);
        asm volatile("s_waitcnt lgkmcnt(0)" ::: "memory");
        float m1 = -1e30f, m2 = -1e30f;
        for (int k = F.lane; k < Tk; k += 64) { const bf16* kr = Kb + (size_t)k * D + h * 128; float d1 = 0.f, d2 = 0.f;
#pragma unroll 4
            for (int d = 0; d < 64; d += 2) { const unsigned a = *(const unsigned*)(kr + d), b = *(const unsigned*)(kr + 64 + d);
                d1 += qs[d] * bf2f(a) + qs[d + 1] * bf2f(a >> 16); d2 += qs[64 + d] * bf2f(b) + qs[64 + d + 1] * bf2f(b >> 16); }
            d1 *= 0.125f; d2 *= 0.125f; s1[k] = d1; s2[k] = d2; m1 = fmaxf(m1, d1); m2 = fmaxf(m2, d2); }
        m1 = wave_max(m1); m2 = wave_max(m2);
        float l1 = 0.f, l2 = 0.f;
        for (int k = F.lane; k < Tk; k += 64) { const float e1 = expf(s1[k] - m1), e2 = expf(s2[k] - m2); s1[k] = e1; s2[k] = e2; l1 += e1; l2 += e2; }
        l1 = wave_sum(l1); l2 = wave_sum(l2);
        const float i1 = 1.f / l1, i2 = lam / l2;
        for (int k = F.lane; k < Tk; k += 64) s1[k] = bf2f(f2bf(s1[k] * i1 - s2[k] * i2));
        asm volatile("s_waitcnt lgkmcnt(0)" ::: "memory");
        float o0 = 0.f, o1 = 0.f;
        for (int k = 0; k < Tk; ++k) { const unsigned vv = *(const unsigned*)(Vb + (size_t)k * D + h * 128 + 2 * F.lane); const float w = s1[k]; o0 += w * bf2f(vv); o1 += w * bf2f(vv >> 16); }
        const float ms = wave_sum(o0 * o0 + o1 * o1) * (1.f / 128.f), rs = rsqrtf(ms + EPS) * (1.f - lam_init);
        o0 = o0 * rs * sg[2 * F.lane]; o1 = o1 * rs * sg[2 * F.lane + 1];
        *(unsigned*)(O + (size_t)row * D + h * 128 + 2 * F.lane) = f2bf(o0) | (f2bf(o1) << 16);
        asm volatile("s_waitcnt lgkmcnt(0)" ::: "memory");
    }
}


constexpr int AT_KS = 272, AT_VS = 288, AT_KBYTES = 64 * AT_KS, AT_VBYTES = 64 * AT_VS, AT_BUF = AT_KBYTES + AT_VBYTES;
__device__ __forceinline__ void attn_unit(Frame& F, int l, const bf16* Qrows  , const bf16* Kb, const bf16* Vb, int Tk, bf16* Orows, int h, float lam, float lam_init) {
    const int tid = F.tid, lane = F.lane, wave = F.wave, c = lane & 15, q4 = lane >> 4;
    LAS unsigned char* lds = F.lds;
    const float SC = 0.18033688f;
    bf16x8 Qf[2][2];
#pragma unroll
    for (int cp = 0; cp < 2; ++cp)
#pragma unroll
        for (int ks = 0; ks < 2; ++ks) Qf[cp][ks] = *(const GAS bf16x8*)(Qrows + (size_t)(16 * wave + c) * D + h * 128 + cp * 64 + 32 * ks + 8 * q4);
    const int nt = Tk / 64;
    const int key0 = tid >> 4, cc0 = tid & 15;
    u32x4 kreg[2], vreg[2];
    float m1 = -1e30f, m2 = -1e30f, l1 = 0.f, l2 = 0.f;
#pragma unroll
    for (int i = 0; i < 2; ++i) kreg[i] = *(const GAS u32x4*)(Kb + (size_t)(key0 + 32 * i) * D + h * 128 + 8 * cc0);
#pragma unroll
    for (int i = 0; i < 2; ++i) *(LAS u32x4*)(lds + (key0 + 32 * i) * AT_KS + 16 * cc0) = kreg[i];
    __syncthreads();
    for (int t = 0; t < nt; ++t) {
        LAS const unsigned char* kt = lds + (t & 1) * AT_BUF;
        if (t + 1 < nt) {
#pragma unroll
            for (int i = 0; i < 2; ++i) kreg[i] = *(const GAS u32x4*)(Kb + (size_t)((t + 1) * 64 + key0 + 32 * i) * D + h * 128 + 8 * cc0); }
        f32x4 S[2][4];
#pragma unroll
        for (int cp = 0; cp < 2; ++cp)
#pragma unroll
            for (int mf = 0; mf < 4; ++mf) { S[cp][mf] = (f32x4){0.f, 0.f, 0.f, 0.f};
#pragma unroll
                for (int ks = 0; ks < 2; ++ks) { const bf16x8 kf = *(LAS const bf16x8*)(kt + (16 * mf + c) * AT_KS + cp * 128 + ks * 64 + 16 * q4);
                    S[cp][mf] = __builtin_amdgcn_mfma_f32_16x16x32_bf16(kf, Qf[cp][ks], S[cp][mf], 0, 0, 0); } }
        float x1 = -1e30f, x2 = -1e30f;
#pragma unroll
        for (int mf = 0; mf < 4; ++mf)
#pragma unroll
            for (int k = 0; k < 4; ++k) { x1 = fmaxf(x1, S[0][mf][k]); x2 = fmaxf(x2, S[1][mf][k]); }
        x1 = fmaxf(x1, __shfl_xor(x1, 16)); x1 = fmaxf(x1, __shfl_xor(x1, 32)); x2 = fmaxf(x2, __shfl_xor(x2, 16)); x2 = fmaxf(x2, __shfl_xor(x2, 32));
        const float n1 = fmaxf(m1, x1), n2 = fmaxf(m2, x2);
        l1 *= exp2f((m1 - n1) * SC); l2 *= exp2f((m2 - n2) * SC); m1 = n1; m2 = n2;
#pragma unroll
        for (int mf = 0; mf < 4; ++mf)
#pragma unroll
            for (int k = 0; k < 4; ++k) { l1 += exp2f((S[0][mf][k] - m1) * SC); l2 += exp2f((S[1][mf][k] - m2) * SC); }
        if (t + 1 < nt) {
#pragma unroll
            for (int i = 0; i < 2; ++i) *(LAS u32x4*)(lds + ((t + 1) & 1) * AT_BUF + (key0 + 32 * i) * AT_KS + 16 * cc0) = kreg[i]; }
        __syncthreads();
    }
    l1 += __shfl_xor(l1, 16); l1 += __shfl_xor(l1, 32); l2 += __shfl_xor(l2, 16); l2 += __shfl_xor(l2, 32);
    const float i1 = 1.f / l1, i2 = lam / l2;
    f32x4 Ot[8];
#pragma unroll
    for (int md = 0; md < 8; ++md) Ot[md] = (f32x4){0.f, 0.f, 0.f, 0.f};
#pragma unroll
    for (int i = 0; i < 2; ++i) { kreg[i] = *(const GAS u32x4*)(Kb + (size_t)(key0 + 32 * i) * D + h * 128 + 8 * cc0); vreg[i] = *(const GAS u32x4*)(Vb + (size_t)(key0 + 32 * i) * D + h * 128 + 8 * cc0); }
#pragma unroll
    for (int i = 0; i < 2; ++i) { *(LAS u32x4*)(lds + (key0 + 32 * i) * AT_KS + 16 * cc0) = kreg[i]; *(LAS u32x4*)(lds + AT_KBYTES + (key0 + 32 * i) * AT_VS + 16 * cc0) = vreg[i]; }
    __syncthreads();
    for (int t = 0; t < nt; ++t) {
        LAS const unsigned char* kt = lds + (t & 1) * AT_BUF; LAS const unsigned char* vt = kt + AT_KBYTES;
        if (t + 1 < nt) {
#pragma unroll
            for (int i = 0; i < 2; ++i) { kreg[i] = *(const GAS u32x4*)(Kb + (size_t)((t + 1) * 64 + key0 + 32 * i) * D + h * 128 + 8 * cc0);
                                          vreg[i] = *(const GAS u32x4*)(Vb + (size_t)((t + 1) * 64 + key0 + 32 * i) * D + h * 128 + 8 * cc0); } }
        f32x4 S[2][4];
#pragma unroll
        for (int cp = 0; cp < 2; ++cp)
#pragma unroll
            for (int mf = 0; mf < 4; ++mf) { S[cp][mf] = (f32x4){0.f, 0.f, 0.f, 0.f};
#pragma unroll
                for (int ks = 0; ks < 2; ++ks) { const bf16x8 kf = *(LAS const bf16x8*)(kt + (16 * mf + c) * AT_KS + cp * 128 + ks * 64 + 16 * q4);
                    S[cp][mf] = __builtin_amdgcn_mfma_f32_16x16x32_bf16(kf, Qf[cp][ks], S[cp][mf], 0, 0, 0); } }
        bf16x8 Wf[2];
#pragma unroll
        for (int kk = 0; kk < 2; ++kk)
#pragma unroll
            for (int jj = 0; jj < 8; ++jj) { const int mf = 2 * kk + (jj >> 2), k = jj & 3;
                const float w = exp2f((S[0][mf][k] - m1) * SC) * i1 - exp2f((S[1][mf][k] - m2) * SC) * i2; Wf[kk][jj] = (short)f2bf(w); }
#pragma unroll
        for (int md = 0; md < 8; ++md)
#pragma unroll
            for (int kk = 0; kk < 2; ++kk) { LAS const unsigned char* vp = vt + (32 * kk + 4 * q4 + (c >> 2)) * AT_VS + (16 * md + 4 * (c & 3)) * 2;
                const v4i16_t lo = __builtin_amdgcn_ds_read_tr16_b64_v4i16((LAS v4i16_t*)vp), hi = __builtin_amdgcn_ds_read_tr16_b64_v4i16((LAS v4i16_t*)(vp + 16 * AT_VS));
                const bf16x8 vf = {lo[0], lo[1], lo[2], lo[3], hi[0], hi[1], hi[2], hi[3]};
                Ot[md] = __builtin_amdgcn_mfma_f32_16x16x32_bf16(vf, Wf[kk], Ot[md], 0, 0, 0); }
        if (t + 1 < nt) {
#pragma unroll
            for (int i = 0; i < 2; ++i) { *(LAS u32x4*)(lds + ((t + 1) & 1) * AT_BUF + (key0 + 32 * i) * AT_KS + 16 * cc0) = kreg[i];
                                          *(LAS u32x4*)(lds + ((t + 1) & 1) * AT_BUF + AT_KBYTES + (key0 + 32 * i) * AT_VS + 16 * cc0) = vreg[i]; } }
        __syncthreads();
    }
    float ss = 0.f;
#pragma unroll
    for (int md = 0; md < 8; ++md)
#pragma unroll
        for (int k = 0; k < 4; ++k) ss += Ot[md][k] * Ot[md][k];
    ss += __shfl_xor(ss, 16); ss += __shfl_xor(ss, 32);
    const float rs = rsqrtf(ss * (1.f / 128.f) + EPS) * (1.f - lam_init);
    const float* sg = F.in[I_AT_SUBG];
#pragma unroll
    for (int md = 0; md < 8; ++md) { const int d0 = 16 * md + 4 * q4; const f32x4 g4 = *(const GAS f32x4*)(sg + d0);
        u32x2 w; w.x = f2bf(Ot[md][0] * rs * g4.x) | (f2bf(Ot[md][1] * rs * g4.y) << 16); w.y = f2bf(Ot[md][2] * rs * g4.z) | (f2bf(Ot[md][3] * rs * g4.w) << 16);
        *(GAS u32x2*)(Orows + (size_t)(16 * wave + c) * D + h * 128 + d0) = w; }
}
__device__ __forceinline__ void phase_attn(Frame& F, int l, const bf16* Q, const bf16* KP, const bf16* VP, bf16* O) {
    F.fresh();
    const float* al = F.in[I_AT_LAM];
    const float lam_init = 0.8f - 0.6f * expf(-0.3f * (float)l);
    const float lam = expf(wave_sum(al[F.lane] * al[64 + F.lane])) - expf(wave_sum(al[128 + F.lane] * al[192 + F.lane])) + lam_init;
    for (int s = 0; ; ++s) {
        int u;
        if (F.G == 256) { if (F.bid < 128) { if (s > 0) break; u = F.bid; } else { if (s > 3) break; u = 128 + 4 * (F.bid - 128) + s; } }
        else { u = F.bid + s * F.G; if (u >= 640) break; }
        if (u < 128) { const int sb = u >> 6, h = (u >> 3) & 7, qt = u & 7; const size_t r0 = (size_t)NPROMPT + sb * 1024 + qt * 128;
            attn_unit(F, l, Q + r0 * D, F.KS + (size_t)sb * TKS * D, F.VS + (size_t)sb * TKS * D, TKS, O + r0 * D, h, lam, lam_init); }
        else { const int v = u - 128, b = v >> 4, h = (v >> 1) & 7, qt = v & 1; const size_t r0 = (size_t)b * 256 + qt * 128;
            attn_unit(F, l, Q + r0 * D, KP + (size_t)b * 256 * D, VP + (size_t)b * 256 * D, 256, O + r0 * D, h, lam, lam_init); }
    }
}

__device__ __forceinline__ void phase_ffn_convgate(Frame& F, int l, const bf16* Z, bf16* ACT) {
    F.fresh();
    const float* cw = F.in[I_FF_CW] + (size_t)l * 3 * 2 * DFF; const float* cb = F.in[I_FF_CB] + (size_t)l * 2 * DFF;
    const int gt = F.bid * NT + F.tid, GT = F.G * NT;
    for (int i = gt; i < M * DFF; i += GT) { const int row = i / DFF, j = i % DFF;
        int t, T; if (row < NPROMPT) { t = row & 255; T = 256; } else { t = (row - NPROMPT) & 1023; T = 1024; }
        float g = cb[j], u = cb[DFF + j];
#pragma unroll
        for (int k = 0; k < 3; ++k) { const int tt = t + k - 1; if (tt >= 0 && tt < T) { const bf16* zr = Z + (size_t)(row + k - 1) * 2 * DFF; g += cw[k * 2 * DFF + j] * bf2f(zr[j]); u += cw[k * 2 * DFF + DFF + j] * bf2f(zr[DFF + j]); } }
        ACT[i] = (bf16)f2bf(siluf_(g) * u); }
}

constexpr int LDS_BYTES = 163840;
constexpr int MISC_OFF = LDS_BYTES - 256;
__global__ void __launch_bounds__(NT, 2) mk_fwd(Params prm) {
    extern __shared__ __attribute__((aligned(16))) unsigned char lds_raw[];
    Frame F;
    F.lds = (LAS unsigned char*)lds_raw; F.G = gridDim.x; F.in = prm.in; F.out0 = prm.out; F.ws0 = prm.ws;
    F.fresh();
    volatile LAS unsigned* MISC = (volatile LAS unsigned*)(F.lds + MISC_OFF);
    if (F.tid < 32) MISC[F.tid] = 0u;
    __syncthreads();
    (void)xcd_barrier_post((unsigned*)(prm.ws + WS_CTL) + CW_BAR, MISC + 8);
#define GRID_BAR() do { XcdBarrier bar_; bar_.bar = (unsigned*)(prm.ws + WS_CTL) + CW_BAR; bar_.x = xb_xcc_id(); bar_.st = (volatile LAS unsigned*)(F.lds + MISC_OFF) + 8; xcd_barrier(bar_); } while (0)

#define GEMM_BF16(ACT, A_, Bt_, N_, K_, O_, ldc_, bias_, splitc_, splits_) do { pg8::Gemm g{A_, Bt_, M, N_, K_}; pg8::StaticOrder S; S.init(M, N_, F.G, F.bid); \
        pg8::EpiBf16<ACT> E{O_, ldc_, bias_, splitc_, splits_}; pg8::gemm_phase<pg8::EpiBf16<ACT>, pg8::StaticOrder, true, true>(F.lds, g, S, E); } while (0)
#define GEMM_RESID(A_, Bt_, K_, which_, fromin_) do { pg8::Gemm g{A_, Bt_, M, D, K_}; pg8::StaticOrder S; S.init(M, D, F.G, F.bid); \
        pg8::EpiResid E{F.out, F.in[I_XP], F.in[I_XS], F.mod + (size_t)l * 18 * D, which_, fromin_}; pg8::gemm_phase<pg8::EpiResid, pg8::StaticOrder, true, true>(F.lds, g, S, E); } while (0)

    phase_prologue(F);
    GRID_BAR();
#pragma unroll 1
    for (int l = 0; l < DEPTH; ++l) {
        const int kind = l % 3, j = l / 3;
        phase_modulate(F, l, 0);
        F.fresh();
        GRID_BAR();
        if (kind == 0) {
            bf16 *GB = F.T2, *REC = F.T2 + (size_t)M * DRNN, *PF = F.T3, *PB = F.T3 + (size_t)NSAMPLE * DRNN, *HS = F.T3 + (size_t)6 * 1024 * 1024;
            float* AGG = (float*)(F.T3 + (size_t)2 * NSAMPLE * DRNN);
            GEMM_BF16(2, F.H, F.WT + WE_LRU_IN + (size_t)j * 2 * DRNN * D, 2 * DRNN, D, GB, DRNN, nullptr, DRNN, (size_t)M * DRNN);
            GRID_BAR();
            phase_lru_core(F, j, REC, GB, HS, PF, PB, AGG, F.WT + WE_WG + (size_t)j * 40 * 128 * 128);
            GRID_BAR();
            phase_lru_fixup(F, GB, HS, PF, PB, AGG);
            GRID_BAR();
            GEMM_RESID(HS, F.WT + WE_LRU_OUT + (size_t)j * D * DRNN, DRNN, 2, l == 0);
        } else if (kind == 1) {
            bf16 *UV = F.T1, *ACT = F.T2;
            GEMM_BF16(1, F.H, F.WT + WE_CM_IN, 2 * DB, D, UV, 2 * DB, F.in[I_CM_BIN], 0, 0);
            GRID_BAR();
            phase_cmlp_rstd(F, UV);
            GRID_BAR();
            phase_cmlp_spatial_mfma(F, UV, ACT, F.WT + WE_WSB);
            GRID_BAR();
            GEMM_RESID(ACT, F.WT + WE_CM_OUT, DB, 2, false);
        } else {
            bf16 *QKV = F.T1, *Q = F.T2, *KP = F.T2 + (size_t)M * D, *VP = KP + (size_t)NPROMPT * D, *O = F.T3;
            GEMM_BF16(0, F.H, F.WT + WE_QKV, 3 * D, D, QKV, 3 * D, nullptr, 0, 0);
            GRID_BAR();
            phase_qkv_post(F, QKV, Q, KP, VP);
            GRID_BAR();
            phase_attn(F, l, Q, KP, VP, O);
            GRID_BAR();
            GEMM_RESID(O, F.WT + WE_AT_OUT, D, 2, false);
        }
        GRID_BAR();
        phase_modulate(F, l, 1);
        GRID_BAR();
        { pg8::Gemm g{F.H, F.WT + WE_UP + (size_t)l * 2 * DFF * D, 42 * 256, 2 * DFF, D}; pg8::FfnOrder S; S.init(42 * 256, 2 * DFF, F.G, F.bid);
          pg8::EpiFfn E{F.T2, F.in[I_FF_CW] + (size_t)l * 3 * 2 * DFF, F.in[I_FF_CB] + (size_t)l * 2 * DFF, (LAS float*)(F.lds + 131072)};
          pg8::gemm_phase<pg8::EpiFfn, pg8::FfnOrder, true, true>(F.lds, g, S, E); }
        GRID_BAR();
        GEMM_RESID(F.T2, F.WT + WE_DN + (size_t)l * D * DFF, DFF, 5, false);
        GRID_BAR();
    }
}

extern "C" void kernel_launch(void* const* d_in, const int* in_sizes, int n_in, void* d_out, int out_size, void* d_ws, size_t ws_size, hipStream_t stream) {
    static int grid = 0;
    if (grid == 0) {
        if (n_in != N_IN || ws_size < WS_END) { fprintf(stderr, "kernel_launch: unexpected n_in %d or ws_size %zu\n", n_in, ws_size); grid = -1; return; }
        int dev = 0, cus = 0, per_cu = 0;
        hipGetDevice(&dev); hipDeviceGetAttribute(&cus, hipDeviceAttributeMultiprocessorCount, dev);
        hipFuncSetAttribute((const void*)mk_fwd, hipFuncAttributeMaxDynamicSharedMemorySize, LDS_BYTES);
        hipOccupancyMaxActiveBlocksPerMultiprocessor(&per_cu, (const void*)mk_fwd, NT, LDS_BYTES);
        (void)hipGetLastError();
        if (per_cu < 1) { fprintf(stderr, "kernel_launch: occupancy query says %d blocks per CU\n", per_cu); per_cu = 1; }
        grid = cus;
    }
    if (grid < 0) return;
    hipMemsetAsync((char*)d_ws + WS_CTL, 0, CTL_ZERO_BYTES, stream);
    Params p{};
    for (int i = 0; i < N_IN; ++i) p.in[i] = (const float*)d_in[i];
    p.out = (float*)d_out; p.ws = (unsigned char*)d_ws;
    void* args[] = {&p};
    hipError_t e = hipLaunchCooperativeKernel((const void*)mk_fwd, dim3(grid), dim3(NT), args, LDS_BYTES, stream);
    if (e != hipSuccess) fprintf(stderr, "kernel_launch: cooperative launch failed: %s (grid %d)\n", hipGetErrorString(e), grid);
}
```

```cpp
#include <hip/hip_runtime.h>
#include <cstdio>
#include <cstdint>

#define GAS __attribute__((address_space(1)))
#define LAS __attribute__((address_space(3)))
typedef unsigned short bf16;
typedef float f32x4 __attribute__((ext_vector_type(4)));
typedef unsigned u32x2 __attribute__((ext_vector_type(2)));
typedef unsigned u32x4 __attribute__((ext_vector_type(4)));

constexpr int D = 1024, NPROMPT = 32 * 256, NSAMPLE = 2 * 1024, M = NPROMPT + NSAMPLE;
constexpr int DEPTH = 4, DRNN = 1280, DB = 2048, DFF = 2816, PAST = 512, TKS = PAST + 1024;
constexpr float EPS = 1e-6f;
constexpr int NWAVES = 8, NT = NWAVES * 64;

enum { I_XP = 0, I_XS, I_STATE, I_CK, I_CV, I_C, I_CCTX, I_WMOD, I_BMOD, I_NORMG, I_LRU_WIN, I_LRU_CW, I_LRU_CB, I_LRU_WG, I_LRU_BG, I_LRU_LAM, I_LRU_WOUT,
       I_CM_WIN, I_CM_BIN, I_CM_NG, I_CM_WS, I_CM_BS, I_CM_WOUT, I_AT_WQKV, I_AT_QKG, I_AT_LAM, I_AT_SUBG, I_AT_WOUT, I_FF_WUP, I_FF_CW, I_FF_CB, I_FF_WDN, N_IN };
constexpr size_t O_YP = 0, O_YS = (size_t)NPROMPT * D, O_STATE = (size_t)M * D, O_CK = O_STATE + 32 * 2 * 2 * DRNN, O_CV = O_CK + (size_t)NPROMPT * D;

constexpr size_t MiB = 1u << 20;
constexpr size_t WS_CTL = 0, CTL_ZERO_BYTES = 64 * 1024;
constexpr size_t WS_MOD = 1 * MiB;
constexpr size_t WS_RSTD = WS_MOD + 512 * 1024;
constexpr size_t WS_ROPE = WS_RSTD + 256 * 1024;
constexpr size_t WS_H = 2 * MiB;
constexpr size_t WS_T1 = 22 * MiB;
constexpr size_t WS_T2 = 132 * MiB;
constexpr size_t WS_T3 = 187 * MiB;
constexpr size_t WS_KS = 237 * MiB, WS_VS = 243 * MiB;
constexpr size_t WS_W = 249 * MiB;
constexpr size_t WE_LRU_IN = 0, WE_LRU_OUT = WE_LRU_IN + (size_t)2 * 2560 * 1024, WE_CM_IN = WE_LRU_OUT + (size_t)2 * 1024 * 1280, WE_CM_OUT = WE_CM_IN + (size_t)4096 * 1024,
                 WE_QKV = WE_CM_OUT + (size_t)1024 * 2048, WE_AT_OUT = WE_QKV + (size_t)3072 * 1024, WE_UP = WE_AT_OUT + (size_t)1024 * 1024, WE_DN = WE_UP + (size_t)4 * 5632 * 1024,
                 WE_WG = WE_DN + (size_t)4 * 1024 * 2816, WE_WSB = WE_WG + (size_t)80 * 128 * 128, WE_END = WE_WSB + (size_t)8 * 128 * 128;
constexpr size_t WS_END = WS_W + 106 * MiB;
static_assert(WE_END * 2 <= 106 * MiB, "weight copies fit");
constexpr int CW_BAR = 1024;

__device__ __forceinline__ unsigned f2bf(float f) { unsigned u = __builtin_bit_cast(unsigned, f); return (u + 0x7fffu + ((u >> 16) & 1u)) >> 16; }
__device__ __forceinline__ float bf2f(unsigned b) { return __builtin_bit_cast(float, (b & 0xffffu) << 16); }
__device__ __forceinline__ float wave_sum(float v) {
#pragma unroll
    for (int o = 1; o < 64; o <<= 1) v += __shfl_xor(v, o);
    return v;
}
__device__ __forceinline__ float wave_max(float v) {
#pragma unroll
    for (int o = 1; o < 64; o <<= 1) v = fmaxf(v, __shfl_xor(v, o));
    return v;
}
__device__ __forceinline__ float gelu_tanh(float x) { const float y = 0.7978845608028654f * (x + 0.044715f * x * x * x); const float t = 1.f - 2.f / (__expf(2.f * y) + 1.f); return 0.5f * x * (1.f + t); }
__device__ __forceinline__ float sigmoidf_(float x) { return 1.f / (1.f + __expf(-x)); }
__device__ __forceinline__ float siluf_(float x) { return x / (1.f + __expf(-x)); }
__device__ __forceinline__ float softplusf_(float x) { return fmaxf(x, 0.f) + log1pf(expf(-fabsf(x))); }

#define XB_TMO      128
#define XB_XCNT(j)  (256  + 64 * (j))
#define XB_XSUB(j)  (1280 + 64 * (j))
#define XB_XGEN(j)  (2304 + 64 * (j))
#define XB_TOP      3328
#define XB_TOPGEN   3392
#define XCD_BAR_WORDS 3456
#define XB_SPIN_CAP (1u << 22)
__device__ __forceinline__ unsigned xb_ld(unsigned* p)              { return __hip_atomic_load(p, __ATOMIC_RELAXED, __HIP_MEMORY_SCOPE_AGENT); }
__device__ __forceinline__ unsigned xb_add(unsigned* p, unsigned v) { return __hip_atomic_fetch_add(p, v, __ATOMIC_RELAXED, __HIP_MEMORY_SCOPE_AGENT); }
__device__ __forceinline__ unsigned xb_xcc_id() { return (unsigned)__builtin_amdgcn_s_getreg((3 << 11) | 20) & 0xFu; }
#define XB_SPIN(cond, bar) do { unsigned _sp = 0; while (cond) { __builtin_amdgcn_s_sleep(1); \
    if ((++_sp & 255u) == 0u) { if (xb_ld(&(bar)[XB_TMO])) break; if (_sp > XB_SPIN_CAP) { atomicAdd(&(bar)[XB_TMO], 1u); break; } } } } while (0)
struct XcdBarrier { unsigned* bar; unsigned x; volatile LAS unsigned* st; };
__device__ __forceinline__ XcdBarrier xcd_barrier_post(unsigned* bar, volatile LAS unsigned* st) {
    XcdBarrier b; b.bar = bar; b.x = xb_xcc_id(); b.st = st;
    if (threadIdx.x == 0) (void)xb_add(&bar[XB_XCNT(b.x)], 1u);
    return b;
}
__device__ __forceinline__ void xcd_barrier_complete(unsigned* bar, unsigned x, unsigned& nloc, unsigned& nx) {
    const unsigned G = gridDim.x * gridDim.y * gridDim.z;
    unsigned sum, cnt, mine, sp = 0u;
    for (;;) {
        sum = 0u; cnt = 0u; mine = 0u;
#pragma unroll
        for (unsigned j = 0; j < 16; ++j) { const unsigned c = xb_ld(&bar[XB_XCNT(j)]); sum += c; cnt += (c > 0u) ? 1u : 0u; mine = (j == x) ? c : mine; }
        if (sum == G) break;
        __builtin_amdgcn_s_sleep(1);
        if ((++sp & 255u) == 0u) { if (xb_ld(&bar[XB_TMO])) break; if (sp > XB_SPIN_CAP) { atomicAdd(&bar[XB_TMO], 1u); break; } }
    }
    nloc = mine > 0u ? mine : 1u; nx = cnt > 0u ? cnt : 1u;
}
__device__ __forceinline__ void xcd_barrier(const XcdBarrier& b) {
    asm volatile("s_waitcnt vmcnt(0)" ::: "memory");
    __syncthreads();
    if (threadIdx.x == 0) {
        unsigned* bar = b.bar;
        __builtin_amdgcn_s_waitcnt(0);
        unsigned nloc = b.st[0], nx = b.st[1];
        if (nloc == 0u) { xcd_barrier_complete(bar, b.x, nloc, nx); b.st[0] = nloc; b.st[1] = nx; }
        const unsigned old = xb_add(&bar[XB_XSUB(b.x)], 1u);
        const unsigned gen = old / nloc;
        if (old + 1u == (gen + 1u) * nloc) {
            __builtin_amdgcn_fence(__ATOMIC_RELEASE, "agent");
            asm volatile("s_waitcnt vmcnt(0)" ::: "memory");
            const unsigned og = xb_add(&bar[XB_TOP], 1u);
            const unsigned tg = og / nx;
            if (og + 1u == (tg + 1u) * nx) xb_add(&bar[XB_TOPGEN], 1u);
            else XB_SPIN(xb_ld(&bar[XB_TOPGEN]) == tg, bar);
            __builtin_amdgcn_fence(__ATOMIC_ACQUIRE, "agent");
            xb_add(&bar[XB_XGEN(b.x)], 1u);
            asm volatile("s_waitcnt vmcnt(0)" ::: "memory");
        } else {
            XB_SPIN(xb_ld(&bar[XB_XGEN(b.x)]) == gen, bar);
            __builtin_amdgcn_fence(__ATOMIC_ACQUIRE, "agent");
            asm volatile("s_waitcnt vmcnt(0)" ::: "memory");
        }
    }
    __syncthreads();
}

namespace pg8 {
#define PG8_LAS __attribute__((address_space(3)))
typedef unsigned short bf16_t;
typedef short bf16x8 __attribute__((ext_vector_type(8)));
typedef float f32x4 __attribute__((ext_vector_type(4)));
typedef unsigned u32x4 __attribute__((ext_vector_type(4)));
constexpr int BM = 256, BK = 64, HALF = 128, HTB = HALF * BK * 2  , STAGE_BYTES = 8 * HTB, NXCD = 8, WGM = 8;

__host__ __device__ __forceinline__ int lds_byte(int r, int c) { const int st = (r >> 4) * 2 + (c >> 5), rr = r & 15, cc = c & 31, ob = rr * 64 + cc * 2; return st * 1024 + (ob ^ (((ob >> 9) & 1) << 5)); }
__host__ __device__ __forceinline__ void stage_rc(int b, int& R, int& C) { const int st = b / 1024, sb = b % 1024, swz = sb ^ (((sb >> 9) & 1) << 5); R = (st >> 1) * 16 + swz / 64; C = (st & 1) * 32 + (swz % 64) / 2; }
__host__ __device__ __forceinline__ int perm32(int rho) { const int n = rho >> 4, i = rho & 15; return 8 * (i >> 2) + 4 * n + (i & 3); }

struct Unit { int pm, pn; };
struct Gemm { const bf16_t* A; const bf16_t* Bt; int M, N, K; };

struct StaticOrder {
    int nM, nN, nwg, G, c;
    __host__ __device__ void init(int M, int N, int G_, int c_) { nM = M / BM; nN = N / BM; nwg = nM * nN; G = G_; c = c_; }
    __host__ __device__ bool next(int i, Unit& u) const {
        const long L = (long)i * G + c; if (L >= nwg) return false;
        int wgid = (int)L; { const int q = nwg / NXCD, r = nwg % NXCD, xcd = wgid % NXCD, off = wgid / NXCD; wgid = (xcd < r ? xcd * (q + 1) : r * (q + 1) + (xcd - r) * q) + off; }
        const int nig = WGM * nN, gid = wgid / nig, fm = gid * WGM, gsz = (nM - fm) < WGM ? (nM - fm) : WGM;
        u.pm = fm + ((wgid % nig) % gsz); u.pn = (wgid % nig) / gsz; return true;
    }
    __device__ __forceinline__ int arow(int pm) const { return pm * BM; }
    __device__ __forceinline__ void a_ready(const Unit&) const {}
    __device__ __forceinline__ void done(const Unit&) const {}
};

template <class Epi, class Sched, bool ALIGN_EPI = false, bool SP2 = false>
__device__ __forceinline__ void gemm_phase(PG8_LAS unsigned char* lds, const Gemm g, const Sched& S, const Epi& E) {
    int tid_ = threadIdx.x; asm volatile("" : "+v"(tid_));
    const int tid = tid_, wid = __builtin_amdgcn_readfirstlane(tid >> 6), lane = tid & 63, wr = wid >> 2, wc = wid & 3, fr = lane & 15, fq = lane >> 4;
    const int K = g.K, nt = K / BK;
    unsigned voffA[2], voffB[2];
#pragma unroll
    for (int i = 0; i < 2; ++i) { int R, C; stage_rc(tid * 16 + i * 8192, R, C); const int Rb = Epi::PERM ? ((R & ~31) + perm32(R & 31)) : R;
        voffA[i] = (unsigned)(R * K + C) * 2u; voffB[i] = (unsigned)(Rb * K + C) * 2u; }
    const size_t kstep = (size_t)(BK * 2);
    const size_t hstep = (size_t)HALF * K * 2;
    const size_t tstep = 2 * hstep;
    const unsigned ldsw = (unsigned)wid * 1024u;
    const int aoff = lds_byte(wr * 64 + fr, fq * 8), boff = lds_byte(wc * 32 + fr, fq * 8);
#define PG8_SA(b, h) (((b) * 2 + (h)) * HTB)
#define PG8_SB(b, h) ((4 + (b) * 2 + (h)) * HTB)
#define PG8_STAGE(bufoff, gbase, voff) do { _Pragma("unroll") for (int _i = 0; _i < 2; ++_i) \
        __builtin_amdgcn_global_load_lds((const unsigned*)((const char*)(gbase) + (voff)[_i]), (PG8_LAS unsigned*)(lds + (bufoff) + ldsw + _i * 8192), 16, 0, 0); } while (0)
#define PG8_LDA(dst, b, h) do { _Pragma("unroll") for (int m = 0; m < 4; ++m) _Pragma("unroll") for (int k = 0; k < 2; ++k) dst[m][k] = *(const PG8_LAS bf16x8*)(lds + PG8_SA(b, h) + aoff + m * 2048 + k * 1024); } while (0)
#define PG8_LDB(dst, b, h) do { _Pragma("unroll") for (int n = 0; n < 2; ++n) _Pragma("unroll") for (int k = 0; k < 2; ++k) dst[n][k] = *(const PG8_LAS bf16x8*)(lds + PG8_SB(b, h) + boff + n * 2048 + k * 1024); } while (0)
#define PG8_MMA(ai, bj, At, Bt) do { __builtin_amdgcn_s_setprio(1); _Pragma("unroll") for (int m = 0; m < 4; ++m) _Pragma("unroll") for (int n = 0; n < 2; ++n) _Pragma("unroll") for (int k = 0; k < 2; ++k) \
        acc[ai][bj][m][n] = __builtin_amdgcn_mfma_f32_16x16x32_bf16(Bt[n][k], At[m][k], acc[ai][bj][m][n], 0, 0, 0); __builtin_amdgcn_s_setprio(0); } while (0)
#define PG8_WAIT_V(n) asm volatile("s_waitcnt vmcnt(" #n ")" ::: "memory")
#define PG8_WAIT_L(n) asm volatile("s_waitcnt lgkmcnt(" #n ")" ::: "memory")
#define PG8_BAR __builtin_amdgcn_s_barrier()
#define PG8_SCHED __builtin_amdgcn_sched_barrier(0)
    Unit cur, nxt; int ui = 0;
    if (!S.next(0, cur)) return;
    f32x4 acc[2][2][4][2];
#pragma unroll
    for (int a = 0; a < 2; ++a)
#pragma unroll
        for (int b = 0; b < 2; ++b)
#pragma unroll
            for (int m = 0; m < 4; ++m)
#pragma unroll
                for (int n = 0; n < 2; ++n) acc[a][b][m][n] = (f32x4){0.f, 0.f, 0.f, 0.f};
    bf16x8 At[4][2], B0[2][2], B1[2][2];
    const char* cA = (const char*)g.A + (size_t)S.arow(cur.pm) * (size_t)K * 2; const char* cB = (const char*)g.Bt + (size_t)cur.pn * tstep;
    S.a_ready(cur);
    if constexpr (SP2) {
        PG8_STAGE(PG8_SB(0, 0), cB, voffB); PG8_STAGE(PG8_SB(0, 1), cB + hstep, voffB); PG8_STAGE(PG8_SA(0, 0), cA, voffA); PG8_STAGE(PG8_SA(0, 1), cA + hstep, voffA);
        if (wr == 1) PG8_BAR;
        PG8_WAIT_V(2); PG8_BAR;
        PG8_STAGE(PG8_SB(1, 0), cB + kstep, voffB); PG8_STAGE(PG8_SA(1, 0), cA + kstep, voffA); PG8_STAGE(PG8_SB(1, 1), cB + hstep + kstep, voffB);
        PG8_WAIT_V(6); PG8_BAR;
    } else {
        PG8_STAGE(PG8_SB(0, 0), cB, voffB); PG8_STAGE(PG8_SA(0, 0), cA, voffA); PG8_STAGE(PG8_SB(0, 1), cB + hstep, voffB); PG8_STAGE(PG8_SA(0, 1), cA + hstep, voffA);
        if (wr == 1) PG8_BAR;
        PG8_WAIT_V(4); PG8_BAR;
        PG8_STAGE(PG8_SB(1, 0), cB + kstep, voffB); PG8_STAGE(PG8_SA(1, 0), cA + kstep, voffA); PG8_STAGE(PG8_SB(1, 1), cB + hstep + kstep, voffB);
        PG8_WAIT_V(6); PG8_BAR;
    }
    for (;;) {
        const bool has_next = S.next(ui + 1, nxt);
        const char* nA = has_next ? (const char*)g.A + (size_t)S.arow(nxt.pm) * (size_t)K * 2 : cA; const char* nB = has_next ? (const char*)g.Bt + (size_t)nxt.pn * tstep : cB;
        for (int t = 0; t < nt; t += 2) {
            const bool last = (t == nt - 2);
            const char* a1 = cA + (size_t)(t + 1) * kstep;
            const char* a2 = last ? nA : cA + (size_t)(t + 2) * kstep; const char* b2 = last ? nB : cB + (size_t)(t + 2) * kstep;
            const char* a3 = a2 + kstep; const char* b3 = b2 + kstep;
            if (last && has_next) S.a_ready(nxt);
            if constexpr (SP2) {
            PG8_LDB(B0, 0, 0); PG8_LDB(B1, 0, 1); PG8_SCHED; PG8_LDA(At, 0, 0); PG8_STAGE(PG8_SA(1, 1), a1 + hstep, voffA);
            PG8_WAIT_V(8); PG8_WAIT_L(0); PG8_BAR; PG8_MMA(0, 0, At, B0); PG8_MMA(0, 1, At, B1); PG8_BAR; PG8_SCHED;
            PG8_LDA(At, 0, 1); PG8_STAGE(PG8_SB(0, 0), b2, voffB); PG8_STAGE(PG8_SB(0, 1), b2 + hstep, voffB); PG8_STAGE(PG8_SA(0, 0), a2, voffA);
            PG8_WAIT_V(8); PG8_WAIT_L(0); PG8_BAR; PG8_MMA(1, 0, At, B0); PG8_MMA(1, 1, At, B1); PG8_BAR; PG8_SCHED;
            PG8_LDB(B0, 1, 0); PG8_LDB(B1, 1, 1); PG8_SCHED; PG8_LDA(At, 1, 0); PG8_STAGE(PG8_SA(0, 1), a2 + hstep, voffA);
            PG8_WAIT_V(8); PG8_WAIT_L(0); PG8_BAR; PG8_MMA(0, 0, At, B0); PG8_MMA(0, 1, At, B1); PG8_BAR; PG8_SCHED;
            PG8_LDA(At, 1, 1); PG8_STAGE(PG8_SB(1, 0), b3, voffB); PG8_STAGE(PG8_SB(1, 1), b3 + hstep, voffB); PG8_STAGE(PG8_SA(1, 0), a3, voffA);
            PG8_WAIT_V(8); PG8_WAIT_L(0); PG8_BAR; PG8_MMA(1, 0, At, B0); PG8_MMA(1, 1, At, B1); PG8_BAR; PG8_SCHED;
            } else {
            PG8_LDB(B0, 0, 0); PG8_SCHED; PG8_LDA(At, 0, 0); PG8_STAGE(PG8_SA(1, 1), a1 + hstep, voffA);
            PG8_WAIT_L(8); PG8_BAR; PG8_WAIT_L(0); PG8_MMA(0, 0, At, B0); PG8_BAR; PG8_SCHED;
            PG8_LDB(B1, 0, 1); PG8_STAGE(PG8_SB(0, 0), b2, voffB);
            PG8_BAR; PG8_WAIT_L(0); PG8_MMA(0, 1, At, B1); PG8_BAR;
            PG8_LDA(At, 0, 1); PG8_STAGE(PG8_SA(0, 0), a2, voffA);
            PG8_BAR; PG8_WAIT_L(0); PG8_MMA(1, 0, At, B0); PG8_BAR; PG8_SCHED;
            PG8_STAGE(PG8_SB(0, 1), b2 + hstep, voffB);
            PG8_WAIT_V(6); PG8_BAR; PG8_MMA(1, 1, At, B1); PG8_BAR;
            PG8_LDB(B0, 1, 0); PG8_SCHED; PG8_LDA(At, 1, 0); PG8_STAGE(PG8_SA(0, 1), a2 + hstep, voffA);
            PG8_WAIT_L(8); PG8_BAR; PG8_WAIT_L(0); PG8_MMA(0, 0, At, B0); PG8_BAR; PG8_SCHED;
            PG8_LDB(B1, 1, 1); PG8_STAGE(PG8_SB(1, 0), b3, voffB);
            PG8_BAR; PG8_WAIT_L(0); PG8_MMA(0, 1, At, B1); PG8_BAR;
            PG8_LDA(At, 1, 1); PG8_STAGE(PG8_SA(1, 0), a3, voffA);
            PG8_BAR; PG8_WAIT_L(0); PG8_MMA(1, 0, At, B0); PG8_BAR; PG8_SCHED;
            PG8_STAGE(PG8_SB(1, 1), b3 + hstep, voffB);
            PG8_WAIT_V(6); PG8_BAR; PG8_MMA(1, 1, At, B1); PG8_BAR;
            }
        }
        if constexpr (ALIGN_EPI) { if (wr == 0) PG8_BAR; }
        if constexpr (!Epi::AFTER_DRAIN) { E(acc, cur, wr, wc, fr, fq); S.done(cur); }
        if (!has_next) break;
#pragma unroll
        for (int a = 0; a < 2; ++a)
#pragma unroll
            for (int b = 0; b < 2; ++b)
#pragma unroll
                for (int m = 0; m < 4; ++m)
#pragma unroll
                    for (int n = 0; n < 2; ++n) acc[a][b][m][n] = (f32x4){0.f, 0.f, 0.f, 0.f};
        cur = nxt; cA = nA; cB = nB; ++ui;
        if constexpr (ALIGN_EPI) { if (wr == 1) PG8_BAR; }
    }
    PG8_WAIT_V(0);
    if constexpr (!ALIGN_EPI) { if (wr == 0) PG8_BAR; }
    PG8_BAR;
    if constexpr (Epi::AFTER_DRAIN) { E.fused(acc, cur, wr, wc, fr, fq, lds, wid, lane); S.done(cur); }
#undef PG8_SA
#undef PG8_SB
#undef PG8_STAGE
#undef PG8_LDA
#undef PG8_LDB
#undef PG8_MMA
#undef PG8_WAIT_V
#undef PG8_WAIT_L
#undef PG8_BAR
#undef PG8_SCHED
}
}

namespace pg8 {
__device__ __forceinline__ unsigned cvt_pk_bf16(float lo, float hi) { unsigned r; asm volatile("v_cvt_pk_bf16_f32 %0, %1, %2" : "=v"(r) : "v"(lo), "v"(hi)); return r; }
__device__ __forceinline__ f32x4 gelu4(f32x4 v) { f32x4 o; o.x = gelu_tanh(v.x); o.y = gelu_tanh(v.y); o.z = gelu_tanh(v.z); o.w = gelu_tanh(v.w); return o; }
template <int ACT> struct EpiBf16 {
    static constexpr bool PERM = true, AFTER_DRAIN = false;
    bf16_t* O; int ldc; const float* bias; int split_cols; size_t split_stride;
    __device__ __forceinline__ void operator()(const f32x4 (&acc)[2][2][4][2], const Unit& u, int wr, int wc, int fr, int fq) const {
        const int row0 = u.pm * BM + wr * 64 + fr; int colt = u.pn * BM; bf16_t* base = O; int t = 0;
        if (split_cols) { t = colt / split_cols; base += (size_t)t * split_stride; colt -= t * split_cols; }
        const bool act = (ACT == 1) || (ACT == 2 && t == 0);
        const int col0 = colt + wc * 32 + 8 * fq, bcol0 = u.pn * BM + wc * 32 + 8 * fq;
        f32x4 bv[2][2];
#pragma unroll
        for (int bj = 0; bj < 2; ++bj)
#pragma unroll
            for (int n = 0; n < 2; ++n) bv[bj][n] = bias ? *(const GAS f32x4*)(bias + bcol0 + bj * HALF + 4 * n) : (f32x4){0.f, 0.f, 0.f, 0.f};
#pragma unroll
        for (int ai = 0; ai < 2; ++ai)
#pragma unroll
            for (int m = 0; m < 4; ++m) { bf16_t* rowp = base + (size_t)(row0 + ai * HALF + m * 16) * ldc + col0;
#pragma unroll
                for (int bj = 0; bj < 2; ++bj) { f32x4 v0 = acc[ai][bj][m][0] + bv[bj][0], v1 = acc[ai][bj][m][1] + bv[bj][1];
                    if (ACT != 0) { if (act) { v0 = gelu4(v0); v1 = gelu4(v1); } }
                    u32x4 w; w.x = cvt_pk_bf16(v0[0], v0[1]); w.y = cvt_pk_bf16(v0[2], v0[3]); w.z = cvt_pk_bf16(v1[0], v1[1]); w.w = cvt_pk_bf16(v1[2], v1[3]);
                    *(GAS u32x4*)(rowp + bj * HALF) = w; } }
    }
};
struct EpiResid {
    static constexpr bool PERM = false, AFTER_DRAIN = false;
    float* out; const float* xp; const float* xs; const float* modl; int which; bool from_input;
    __device__ __forceinline__ void operator()(const f32x4 (&acc)[2][2][4][2], const Unit& u, int wr, int wc, int fr, int fq) const {
        const int trow = u.pm * BM, row0 = wr * 64 + fr, col0 = u.pn * BM + wc * 32 + 4 * fq;
        const int ci = trow < NPROMPT ? 0 : 1 + ((trow - NPROMPT) >> 10);
        const float* gp = modl + (size_t)(ci * 6 + which) * D + col0;
        const float* bp = from_input ? (trow < NPROMPT ? xp + (size_t)trow * D : xs + (size_t)(trow - NPROMPT) * D) : out + (size_t)trow * D;
        GAS float* op = (GAS float*)(out + (size_t)trow * D); const GAS float* bpg = (const GAS float*)bp; const GAS float* gpg = (const GAS float*)gp;
        f32x4 gv[2][2];
#pragma unroll
        for (int bj = 0; bj < 2; ++bj)
#pragma unroll
            for (int n = 0; n < 2; ++n) gv[bj][n] = *(const GAS f32x4*)(gpg + bj * HALF + n * 16);
#pragma unroll
        for (int ai = 0; ai < 2; ++ai)
#pragma unroll
            for (int m = 0; m < 4; ++m) { const size_t off = (size_t)(row0 + ai * HALF + m * 16) * D + col0;
                f32x4 bs[2][2];
#pragma unroll
                for (int bj = 0; bj < 2; ++bj)
#pragma unroll
                    for (int n = 0; n < 2; ++n) bs[bj][n] = *(const GAS f32x4*)(bpg + off + bj * HALF + n * 16);
#pragma unroll
                for (int bj = 0; bj < 2; ++bj)
#pragma unroll
                    for (int n = 0; n < 2; ++n) *(GAS f32x4*)(op + off + bj * HALF + n * 16) = bs[bj][n] + gv[bj][n] * acc[ai][bj][m][n];
                asm volatile("" ::: "memory"); }
    }
};

__device__ __forceinline__ void ffn_tile_geom(int pm, int& rs, int& vlo, int& vhi) {
    if (pm < 32) { rs = 256 * pm; vlo = 0; vhi = 255; }
    else { const int sq = (pm - 32) / 5, i = (pm - 32) % 5; rs = NPROMPT + 1024 * sq + (i < 4 ? 254 * i : 768); vlo = i == 0 ? 0 : (i < 4 ? 1 : 249); vhi = i < 4 ? 254 : 255; }
}
struct FfnOrder : StaticOrder {
    __device__ __forceinline__ int arow(int pm) const { int rs, a, b; ffn_tile_geom(pm, rs, a, b); return rs; }
};
__device__ __forceinline__ float dpp_prev(float oldv, float v) {
    return __builtin_bit_cast(float, __builtin_amdgcn_update_dpp(__builtin_bit_cast(int, oldv), __builtin_bit_cast(int, v), 0x111, 0xf, 0xf, false)); }
__device__ __forceinline__ float dpp_next(float oldv, float v) {
    return __builtin_bit_cast(float, __builtin_amdgcn_update_dpp(__builtin_bit_cast(int, oldv), __builtin_bit_cast(int, v), 0x101, 0xf, 0xf, false)); }
__device__ __forceinline__ float dpp_ror1(float v) { return __builtin_bit_cast(float, __builtin_amdgcn_update_dpp(0, __builtin_bit_cast(int, v), 0x121, 0xf, 0xf, false)); }
__device__ __forceinline__ float dpp_ror15(float v) { return __builtin_bit_cast(float, __builtin_amdgcn_update_dpp(0, __builtin_bit_cast(int, v), 0x12F, 0xf, 0xf, false)); }
struct EpiFfn {
    static constexpr bool PERM = true, AFTER_DRAIN = false;
    bf16_t* ACT; const float* cw; const float* cb; PG8_LAS float* xb;
    __device__ __forceinline__ void operator()(const f32x4 (&acc)[2][2][4][2], const Unit& u, int wr, int wc, int fr, int fq) const {
        int rs, vlo, vhi; ffn_tile_geom(u.pm, rs, vlo, vhi);
        const int colw = wc * 32 + 8 * fq;
#pragma unroll
        for (int ai = 0; ai < 2; ++ai) { const int b = 2 * ai + wr;
            if (fr == 0) {
#pragma unroll
                for (int bj = 0; bj < 2; ++bj)
#pragma unroll
                    for (int n = 0; n < 2; ++n) *(PG8_LAS f32x4*)(xb + (b * 2 + 0) * 256 + bj * 128 + colw + 4 * n) = acc[ai][bj][0][n]; }
            if (fr == 15) {
#pragma unroll
                for (int bj = 0; bj < 2; ++bj)
#pragma unroll
                    for (int n = 0; n < 2; ++n) *(PG8_LAS f32x4*)(xb + (b * 2 + 1) * 256 + bj * 128 + colw + 4 * n) = acc[ai][bj][3][n]; } }
        asm volatile("s_waitcnt lgkmcnt(0)" ::: "memory"); __builtin_amdgcn_s_barrier(); asm volatile("" ::: "memory");
#pragma unroll
        for (int n = 0; n < 2; ++n) {
            const int ch = u.pn * 128 + colw + 4 * n;
            f32x4 wg[3], wu[3];
#pragma unroll
            for (int k = 0; k < 3; ++k) { wg[k] = *(const GAS f32x4*)(cw + (size_t)k * 2 * DFF + ch); wu[k] = *(const GAS f32x4*)(cw + (size_t)k * 2 * DFF + DFF + ch); }
            const f32x4 bgv = *(const GAS f32x4*)(cb + ch), buv = *(const GAS f32x4*)(cb + DFF + ch);
#pragma unroll
            for (int ai = 0; ai < 2; ++ai) { const int b = 2 * ai + wr;
                f32x4 pz[2], nz[2];
#pragma unroll
                for (int bj = 0; bj < 2; ++bj) { pz[bj] = b > 0 ? *(PG8_LAS const f32x4*)(xb + ((b - 1) * 2 + 1) * 256 + bj * 128 + colw + 4 * n) : (f32x4){0.f, 0.f, 0.f, 0.f};
                                                 nz[bj] = b < 3 ? *(PG8_LAS const f32x4*)(xb + ((b + 1) * 2 + 0) * 256 + bj * 128 + colw + 4 * n) : (f32x4){0.f, 0.f, 0.f, 0.f}; }
#pragma unroll
                for (int m = 0; m < 4; ++m) { f32x4 zc[2];
#pragma unroll
                    for (int bj = 0; bj < 2; ++bj) { const f32x4 z = acc[ai][bj][m][n]; const f32x4* w3 = bj == 0 ? wg : wu; f32x4 o = bj == 0 ? bgv : buv;
#pragma unroll
                        for (int e = 0; e < 4; ++e) { const float up = m > 0 ? dpp_ror1(acc[ai][bj][m - 1][n][e]) : pz[bj][e], dn = m < 3 ? dpp_ror15(acc[ai][bj][m + 1][n][e]) : nz[bj][e];
                            o[e] += w3[0][e] * dpp_prev(up, z[e]) + w3[1][e] * z[e] + w3[2][e] * dpp_next(dn, z[e]); }
                        zc[bj] = o; }
                    const int lr = 128 * ai + 64 * wr + 16 * m + fr;
                    if (lr >= vlo && lr <= vhi) { u32x2 w; w.x = cvt_pk_bf16(siluf_(zc[0][0]) * zc[1][0], siluf_(zc[0][1]) * zc[1][1]); w.y = cvt_pk_bf16(siluf_(zc[0][2]) * zc[1][2], siluf_(zc[0][3]) * zc[1][3]);
                        *(GAS u32x2*)(ACT + (size_t)(rs + lr) * DFF + ch) = w; } } }
        }
    }
};
}

struct Params { const float* in[N_IN]; float* out; unsigned char* ws; };
struct Frame {
    LAS unsigned char* lds; int tid, lane, wave, bid, G;
    const float* const* in; float* out; unsigned char* ws; float* out0; unsigned char* ws0;
    float* mod; float* rstd; float* rope; bf16 *H, *T1, *T2, *T3, *KS, *VS, *WT;
    __device__ __forceinline__ void fresh() {
        int t = threadIdx.x; asm volatile("" : "+v"(t)); tid = t; lane = t & 63; wave = __builtin_amdgcn_readfirstlane(t >> 6);
        int b = blockIdx.x; asm volatile("" : "+s"(b)); bid = b;
        unsigned char* w = ws0; asm volatile("" : "+s"(w)); ws = w; float* o = out0; asm volatile("" : "+s"(o)); out = o;
        mod = (float*)(w + WS_MOD); rstd = (float*)(w + WS_RSTD); rope = (float*)(w + WS_ROPE);
        H = (bf16*)(w + WS_H); T1 = (bf16*)(w + WS_T1); T2 = (bf16*)(w + WS_T2); T3 = (bf16*)(w + WS_T3); KS = (bf16*)(w + WS_KS); VS = (bf16*)(w + WS_VS); WT = (bf16*)(w + WS_W);
    }
};
__device__ __forceinline__ const float* xin_row(const Frame& F, int row) { return row < NPROMPT ? F.in[I_XP] + (size_t)row * D : F.in[I_XS] + (size_t)(row - NPROMPT) * D; }
__device__ __forceinline__ int cidx_of(int row) { return row < NPROMPT ? 0 : 1 + ((row - NPROMPT) >> 10); }
__device__ __forceinline__ const float* modp(const Frame& F, int l, int row, int which) { return F.mod + (size_t)((l * 3 + cidx_of(row)) * 6 + which) * D; }


template <int MODE  >
__device__ __forceinline__ void transpose_item(const float* W, int K, int N, bf16* WT, LAS float* scr, int item, int lane) {
    const int nblk = N / 32, kb = item / nblk, nb = item % nblk, k0 = 64 * kb, n0 = 32 * nb;
    int d0 = n0; if (MODE == 1) { const int isu = n0 >= DFF, jj = n0 - isu * DFF; d0 = (jj >> 7) * 256 + isu * 128 + (jj & 127); }
#pragma unroll 8
    for (int i = 0; i < 32; ++i) { const int kk = 2 * i + (lane >> 5); scr[kk * 33 + (lane & 31)] = W[(size_t)(k0 + kk) * N + n0 + (lane & 31)]; }
    asm volatile("s_waitcnt lgkmcnt(0)" ::: "memory");
    const int c = lane & 7;
#pragma unroll
    for (int j = 0; j < 4; ++j) { const int n = (lane >> 3) + 8 * j; const LAS float* sp = scr + (8 * c) * 33 + n;
        u32x4 o; o.x = f2bf(sp[0 * 33]) | (f2bf(sp[1 * 33]) << 16); o.y = f2bf(sp[2 * 33]) | (f2bf(sp[3 * 33]) << 16); o.z = f2bf(sp[4 * 33]) | (f2bf(sp[5 * 33]) << 16); o.w = f2bf(sp[6 * 33]) | (f2bf(sp[7 * 33]) << 16);
        *(u32x4*)(WT + (size_t)(d0 + n) * K + k0 + 8 * c) = o; }
    asm volatile("s_waitcnt lgkmcnt(0)" ::: "memory");
}
template <int MODE = 0>
__device__ __forceinline__ bool transpose_group(int& r, const float* W, int nmat, int K, int N, bf16* WT, LAS float* scr, int lane) {
    const int per = (K / 64) * (N / 32), tot = nmat * per;
    if (r >= tot) { r -= tot; return false; }
    const int mi = r / per; transpose_item<MODE>(W + (size_t)mi * K * N, K, N, WT + (size_t)mi * K * N, scr, r % per, lane); return true;
}
__device__ __forceinline__ void phase_prologue(Frame& F) {
    F.fresh();
    LAS float* sc = (LAS float*)F.lds;
    const float* c = F.in[I_C]; const float* cctx = F.in[I_CCTX];
    for (int i = F.tid; i < 3 * D; i += NT) { const int ci = i >> 10, k = i & 1023; const float v = ci == 0 ? cctx[k] : c[(ci - 1) * D + k]; sc[i] = siluf_(v); }
    __syncthreads();
    LAS float* part = sc + 3 * D;
    const int kp = F.tid >> 6, cl = F.tid & 63;
    for (int item = F.bid; item < DEPTH * 6 * D / 64; item += F.G) {
        const int col = item * 64 + cl, l = col / (6 * D), cc = col % (6 * D);
        const float* w = F.in[I_WMOD] + (size_t)l * D * 6 * D + cc;
        float s0 = 0.f, s1 = 0.f, s2 = 0.f;
        for (int k = kp * 128; k < kp * 128 + 128; ++k) { const float wv = w[(size_t)k * 6 * D]; s0 += sc[k] * wv; s1 += sc[D + k] * wv; s2 += sc[2 * D + k] * wv; }
        part[(kp * 3 + 0) * 64 + cl] = s0; part[(kp * 3 + 1) * 64 + cl] = s1; part[(kp * 3 + 2) * 64 + cl] = s2;
        __syncthreads();
        if (F.tid < 192) { const int ci = F.tid >> 6; float s = F.in[I_BMOD][l * 6 * D + cc];
            for (int q = 0; q < 8; ++q) s += part[(q * 3 + ci) * 64 + cl];
            F.mod[(size_t)((l * 3 + ci) * 6) * D + cc] = s; }
        __syncthreads();
    }
    { __syncthreads();
      LAS float* scr = (LAS float*)(F.lds + F.wave * 16384);
      const int gw = F.bid * NWAVES + F.wave, NGW = F.G * NWAVES;
      constexpr int NITEMS = (int)(WE_END / 2048);
      for (int it = gw; it < NITEMS; it += NGW) { int r = it;
          if (transpose_group<1>(r, F.in[I_FF_WUP], 4, D, 2 * DFF, F.WT + WE_UP, scr, F.lane)) continue;
          if (transpose_group(r, F.in[I_FF_WDN], 4, DFF, D, F.WT + WE_DN, scr, F.lane)) continue;
          if (transpose_group(r, F.in[I_LRU_WIN], 2, D, 2 * DRNN, F.WT + WE_LRU_IN, scr, F.lane)) continue;
          if (transpose_group(r, F.in[I_LRU_WOUT], 2, DRNN, D, F.WT + WE_LRU_OUT, scr, F.lane)) continue;
          if (transpose_group(r, F.in[I_CM_WIN], 1, D, 2 * DB, F.WT + WE_CM_IN, scr, F.lane)) continue;
          if (transpose_group(r, F.in[I_CM_WOUT], 1, DB, D, F.WT + WE_CM_OUT, scr, F.lane)) continue;
          if (transpose_group(r, F.in[I_AT_WQKV], 1, D, 3 * D, F.WT + WE_QKV, scr, F.lane)) continue;
          if (transpose_group(r, F.in[I_AT_WOUT], 1, D, D, F.WT + WE_AT_OUT, scr, F.lane)) continue;
          transpose_group(r, F.in[I_LRU_WG], 80, 128, 128, F.WT + WE_WG, scr, F.lane); } }
    const int gt = F.bid * NT + F.tid, GT = F.G * NT;
    for (int i = gt; i < 1024 * 32; i += GT) { const int t = i >> 5, j = i & 31; const float inv = powf(10000.f, -(float)(j & 15) / 16.f); const float pos = (float)(j < 16 ? (t >> 6) : (t & 63));
        const float ang = pos * inv; F.rope[i] = cosf(ang); F.rope[32768 + i] = sinf(ang); }
    for (int i = gt; i < 8 * 8 * 4 * 64; i += GT) { const int ln = i & 63, ks = (i >> 6) & 3, nf = (i >> 8) & 7, g = i >> 11, cq = ln >> 4, p = 16 * nf + (ln & 15);
        const float* wr = F.in[I_CM_WS] + (size_t)(g * 128 + p) * 128 + 32 * ks + 4 * cq;
        u32x4 o; o.x = f2bf(wr[0]) | (f2bf(wr[1]) << 16); o.y = f2bf(wr[2]) | (f2bf(wr[3]) << 16); o.z = f2bf(wr[16]) | (f2bf(wr[17]) << 16); o.w = f2bf(wr[18]) | (f2bf(wr[19]) << 16);
        *(u32x4*)(F.WT + WE_WSB + (size_t)i * 8) = o; }
    for (int i = gt; i < 2 * PAST * D; i += GT) { const int b = i / (PAST * D), r = i % (PAST * D);
        F.KS[(size_t)b * TKS * D + r] = (bf16)f2bf(F.in[I_CK][i]); F.VS[(size_t)b * TKS * D + r] = (bf16)f2bf(F.in[I_CV][i]); }
}

__device__ __forceinline__ void phase_modulate(Frame& F, int l, int sub) {
    F.fresh();
    const int gw = F.bid * NWAVES + F.wave, NGW = F.G * NWAVES;
    const float* g = F.in[I_NORMG] + (size_t)(l * 2 + sub) * D;
    for (int row = gw; row < M; row += NGW) {
        const float* xr = (l == 0 && sub == 0) ? xin_row(F, row) : F.out + (size_t)row * D;
        const float* sh = modp(F, l, row, sub * 3 + 0); const float* scl = modp(F, l, row, sub * 3 + 1);
        f32x4 v[4]; float s = 0.f;
#pragma unroll
        for (int j = 0; j < 4; ++j) { v[j] = *(const f32x4*)(xr + 4 * F.lane + 256 * j); s += v[j].x * v[j].x + v[j].y * v[j].y + v[j].z * v[j].z + v[j].w * v[j].w; }
        const float rstd = rsqrtf(wave_sum(s) * (1.f / D) + EPS);
#pragma unroll
        for (int j = 0; j < 4; ++j) { const int c0 = 4 * F.lane + 256 * j; const f32x4 gg = *(const f32x4*)(g + c0), s4 = *(const f32x4*)(sh + c0), c4 = *(const f32x4*)(scl + c0);
            const f32x4 o = v[j] * rstd * gg * (1.f + c4) + s4; u32x2 w; w.x = f2bf(o.x) | (f2bf(o.y) << 16); w.y = f2bf(o.z) | (f2bf(o.w) << 16);
            *(u32x2*)(F.H + (size_t)row * D + c0) = w; }
    }
}

template <class P>
__device__ __forceinline__ void gemm_naive(Frame& F, const P& p, int nbatch, int Mr, int N, int K) {
    F.fresh();
    LAS float* As = (LAS float*)F.lds;
    LAS float* Bs = As + 16 * 132;
    const int tid = F.tid, tx = tid & 31, ty = tid >> 5;
    const int tm = Mr / 128, tn = N / 128, per = tm * tn, total = per * nbatch;
    for (int t = F.bid; t < total; t += F.G) {
        const int b = t / per, r = t % per, pn = r / tm, pm = r % tm;
        const bf16* A; int lda; const float* W; int ldw; p.get(b, A, lda, W, ldw);
        float acc[8][4];
#pragma unroll
        for (int i = 0; i < 8; ++i)
#pragma unroll
            for (int j = 0; j < 4; ++j) acc[i][j] = 0.f;
        for (int k0 = 0; k0 < K; k0 += 16) {
            { const int row = tid >> 2, kq = (tid & 3) * 4;
              const u32x2 v = *(const u32x2*)(A + (size_t)(pm * 128 + row) * lda + k0 + kq);
              As[(kq + 0) * 132 + row] = bf2f(v.x); As[(kq + 1) * 132 + row] = bf2f(v.x >> 16); As[(kq + 2) * 132 + row] = bf2f(v.y); As[(kq + 3) * 132 + row] = bf2f(v.y >> 16); }
            { const int k = tid >> 5, n4 = (tid & 31) * 4;
              *(LAS f32x4*)(Bs + k * 128 + n4) = *(const f32x4*)(W + (size_t)(k0 + k) * ldw + pn * 128 + n4); }
            __syncthreads();
#pragma unroll 2
            for (int k = 0; k < 16; ++k) {
                const f32x4 a0 = *(const LAS f32x4*)(As + k * 132 + ty * 8), a1 = *(const LAS f32x4*)(As + k * 132 + ty * 8 + 4), bv = *(const LAS f32x4*)(Bs + k * 128 + tx * 4);
                const float a[8] = {a0.x, a0.y, a0.z, a0.w, a1.x, a1.y, a1.z, a1.w}; const float bb[4] = {bv.x, bv.y, bv.z, bv.w};
#pragma unroll
                for (int i = 0; i < 8; ++i)
#pragma unroll
                    for (int j = 0; j < 4; ++j) acc[i][j] += a[i] * bb[j];
            }
            __syncthreads();
        }
#pragma unroll
        for (int i = 0; i < 8; ++i)
#pragma unroll
            for (int j = 0; j < 4; ++j) p.epi(b, pm * 128 + ty * 8 + i, pn * 128 + tx * 4 + j, acc[i][j]);
    }
}

struct PStoreBf16 {
    const bf16* A; int lda; const float* W; int ldw; bf16* O; int ldo; const float* bias; int act; int split;
    __device__ __forceinline__ void get(int, const bf16*& a, int& la, const float*& w, int& lw) const { a = A; la = lda; w = W; lw = ldw; }
    __device__ __forceinline__ void epi(int, int row, int col, float v) const {
        if (bias) v += bias[col];
        if (act == 1 || (act == 2 && col < split)) v = gelu_tanh(v);
        O[(size_t)row * ldo + col] = (bf16)f2bf(v); }
};
struct PResid {
    const bf16* A; int lda; const float* W; int ldw; float* out; const float* xp; const float* xs; const float* modl; int which; bool from_input;
    __device__ __forceinline__ void get(int, const bf16*& a, int& la, const float*& w, int& lw) const { a = A; la = lda; w = W; lw = ldw; }
    __device__ __forceinline__ void epi(int, int row, int col, float v) const {
        const float base = from_input ? (row < NPROMPT ? xp[(size_t)row * D + col] : xs[(size_t)(row - NPROMPT) * D + col]) : out[(size_t)row * D + col];
        out[(size_t)row * D + col] = base + modl[(size_t)(cidx_of(row) * 6 + which) * D + col] * v; }
};
struct PLruIn {
    const bf16* A; const float* W; bf16* GBp; bf16* RECp;
    __device__ __forceinline__ void get(int, const bf16*& a, int& la, const float*& w, int& lw) const { a = A; la = D; w = W; lw = 2 * DRNN; }
    __device__ __forceinline__ void epi(int, int row, int col, float v) const {
        if (col < DRNN) GBp[(size_t)row * DRNN + col] = (bf16)f2bf(gelu_tanh(v)); else RECp[(size_t)row * DRNN + col - DRNN] = (bf16)f2bf(v); }
};
struct PGates {
    const bf16* XC; const float* WG; const float* BG; bf16* O;
    __device__ __forceinline__ void get(int b, const bf16*& a, int& la, const float*& w, int& lw) const { a = XC + (b % 10) * 128; la = DRNN; w = WG + (size_t)b * 128 * 128; lw = 128; }
    __device__ __forceinline__ void epi(int b, int row, int col, float v) const { const int dg = b / 10, n = b % 10;
        O[((size_t)dg * M + row) * DRNN + n * 128 + col] = (bf16)f2bf(sigmoidf_(v + BG[dg * DRNN + n * 128 + col])); }
};

__device__ __forceinline__ void phase_lru_conv(Frame& F, int j, const bf16* REC, bf16* XC) {
    F.fresh();
    const float* cw = F.in[I_LRU_CW] + (size_t)j * 4 * DRNN; const float* cb = F.in[I_LRU_CB] + (size_t)j * DRNN;
    const int gt = F.bid * NT + F.tid, GT = F.G * NT;
    for (int i = gt; i < M * DRNN; i += GT) { const int row = i / DRNN, ch = i % DRNN;
        int t, T; if (row < NPROMPT) { t = row & 255; T = 256; } else { t = (row - NPROMPT) & 1023; T = 1024; }
        float s = cb[ch];
#pragma unroll
        for (int k = 0; k < 4; ++k) { const int tt = t + k - 2; if (tt >= 0 && tt < T) s += cw[k * DRNN + ch] * bf2f(REC[(size_t)(row + k - 2) * DRNN + ch]); }
        XC[i] = (bf16)f2bf(s); }
}
__device__ __forceinline__ void phase_lru_scan(Frame& F, int j, const bf16* GATES, const bf16* XC, const bf16* GB, bf16* HS) {
    F.fresh();
    const int gt = F.bid * NT + F.tid, GT = F.G * NT;
    const int NL = (2 + 32) * DRNN;
    for (int line = gt; line < NL; line += GT) {
        const int s = line / DRNN, ch = line % DRNN;
        int base, T; float h0f = 0.f, h0b = 0.f;
        if (s < 2) { base = NPROMPT + s * 1024; T = 1024; h0f = F.in[I_STATE][((size_t)(s * 2 + j) * 2 + 0) * DRNN + ch]; h0b = F.in[I_STATE][((size_t)(s * 2 + j) * 2 + 1) * DRNN + ch]; }
        else { base = (s - 2) * 256; T = 256; }
        const float spf = softplusf_(-F.in[I_LRU_LAM][(size_t)(j * 2 + 0) * DRNN + ch]), spb = softplusf_(-F.in[I_LRU_LAM][(size_t)(j * 2 + 1) * DRNN + ch]);
        float h = h0f;
        for (int t = 0; t < T; ++t) { const size_t o = (size_t)(base + t) * DRNN + ch;
            const float r = bf2f(GATES[o]), ig = bf2f(GATES[(size_t)M * DRNN + o]), xc = bf2f(XC[o]);
            const float la = -8.f * r * spf, a = expf(la), bx = sqrtf(-expm1f(2.f * la)) * (ig * xc);
            h = a * h + bx; HS[o] = (bf16)f2bf(h); }
        const float ff = h;
        h = h0b;
        for (int t = T - 1; t >= 0; --t) { const size_t o = (size_t)(base + t) * DRNN + ch;
            const float r = bf2f(GATES[(size_t)2 * M * DRNN + o]), ig = bf2f(GATES[(size_t)3 * M * DRNN + o]), xc = bf2f(XC[o]);
            const float la = -8.f * r * spb, a = expf(la), bx = sqrtf(-expm1f(2.f * la)) * (ig * xc);
            h = a * h + bx; HS[o] = (bf16)f2bf(bf2f(GB[o]) * (bf2f(HS[o]) + h)); }
        if (s >= 2) { float* st = F.out + O_STATE + ((size_t)((s - 2) * 2 + j) * 2) * DRNN; st[ch] = ff; st[DRNN + ch] = h; }
    }
}


typedef short bf16x8 __attribute__((ext_vector_type(8)));
typedef short v4i16_t __attribute__((ext_vector_type(4)));
constexpr int LRU_XS = 272;
constexpr int LRU_XC_OFF = 0, LRU_GB_OFF = 256 * LRU_XS;
template <bool REV>
__device__ __forceinline__ float lru_dir(LAS const unsigned char* xct, LAS unsigned char* hft, const bf16* wgt  ,
                                         const bf16* gbp  , float br, float bi, float sp, float hc, int wave, int lane, bool wantp, bf16* Pdst) {
    const int c = lane & 15, q = lane >> 4, qq = REV ? 3 - q : q;
    bf16x8 Br[4], Bi[4], Id;
#pragma unroll
    for (int ks = 0; ks < 4; ++ks) { Br[ks] = *(const GAS bf16x8*)(wgt + (size_t)(16 * wave + c) * 128 + 32 * ks + 8 * q);
                                     Bi[ks] = *(const GAS bf16x8*)(wgt + (size_t)10 * 128 * 128 + (size_t)(16 * wave + c) * 128 + 32 * ks + 8 * q); }
#pragma unroll
    for (int jj = 0; jj < 8; ++jj) Id[jj] = (8 * q + jj == 16 * (wave & 1) + c) ? (short)0x3F80 : (short)0;
    const int ksel = wave >> 1;
    const float nsp8 = -8.f * sp * 1.44269504f;
    float Pc = 1.f;
    unsigned short gcur[16], gnxt[16];
#pragma unroll
    for (int i = 0; i < 16; ++i) { gcur[i] = 0; gnxt[i] = 0; }
    if (REV) {
#pragma unroll
        for (int i = 0; i < 16; ++i) gcur[i] = *(const GAS unsigned short*)(gbp + (size_t)(16 * (12 + (i >> 2)) + 4 * q + (i & 3)) * DRNN); }
#pragma unroll 1
    for (int og = 0; og < 4; ++og) {
        if (REV && og < 3) {
#pragma unroll
            for (int i = 0; i < 16; ++i) gnxt[i] = *(const GAS unsigned short*)(gbp + (size_t)(16 * (4 * (2 - og) + (i >> 2)) + 4 * q + (i & 3)) * DRNN); }
#pragma unroll
        for (int ii = 0; ii < 4; ++ii) {
        const int it = 4 * og + ii, mi = REV ? 15 - it : it, mloc = REV ? 3 - ii : ii;
        LAS const unsigned char* rp = xct + (16 * mi + c) * LRU_XS + 16 * q;
        bf16x8 Af[4];
#pragma unroll
        for (int ks = 0; ks < 4; ++ks) Af[ks] = *(LAS const bf16x8*)(rp + 64 * ks);
        const bf16x8 Ax = *(LAS const bf16x8*)(rp + 64 * ksel);
        f32x4 r = {0.f, 0.f, 0.f, 0.f}, ig = {0.f, 0.f, 0.f, 0.f};
#pragma unroll
        for (int ks = 0; ks < 4; ++ks) { r = __builtin_amdgcn_mfma_f32_16x16x32_bf16(Af[ks], Br[ks], r, 0, 0, 0); ig = __builtin_amdgcn_mfma_f32_16x16x32_bf16(Af[ks], Bi[ks], ig, 0, 0, 0); }
        const f32x4 xc = __builtin_amdgcn_mfma_f32_16x16x32_bf16(Ax, Id, (f32x4){0.f, 0.f, 0.f, 0.f}, 0, 0, 0);
        float av[4], bv[4];
#pragma unroll
        for (int k = 0; k < 4; ++k) { const float rg = __builtin_amdgcn_rcpf(1.f + __builtin_amdgcn_exp2f(-1.44269504f * (r[k] + br))), iv = __builtin_amdgcn_rcpf(1.f + __builtin_amdgcn_exp2f(-1.44269504f * (ig[k] + bi)));
            const float l2a = nsp8 * rg, x = 1.38629436f * l2a;
            const float oms = -x * (1.f + x * (0.5f + x * (0.16666667f + x * (0.041666668f + x * 0.0083333338f))));
            const float om = x > -0.25f ? oms : 1.f - __builtin_amdgcn_exp2f(2.f * l2a);
            av[k] = __builtin_amdgcn_exp2f(l2a); bv[k] = __builtin_amdgcn_sqrtf(om) * (iv * xc[k]); }
        float pA[4], pB[4];
#pragma unroll
        for (int kk = 0; kk < 4; ++kk) { const int k = REV ? 3 - kk : kk;
            if (kk == 0) { pA[k] = av[k]; pB[k] = bv[k]; } else { const int kp = REV ? k + 1 : k - 1; pA[k] = pA[kp] * av[k]; pB[k] = pB[kp] * av[k] + bv[k]; } }
        const int kl = REV ? 0 : 3;
        float gA[4], gB[4];
#pragma unroll
        for (int g = 0; g < 4; ++g) { const int src = 16 * (REV ? 3 - g : g) + c; gA[g] = __shfl(pA[kl], src); gB[g] = __shfl(pB[kl], src); }
        float eA = 1.f, eB = 0.f, tA = 1.f, tB = 0.f;
#pragma unroll
        for (int g = 0; g < 4; ++g) { if (g == qq) { eA = tA; eB = tB; } tB = tB * gA[g] + gB[g]; tA = tA * gA[g]; }
        const float hin = eA * hc + eB;
#pragma unroll
        for (int k = 0; k < 4; ++k) { const float h = pA[k] * hin + pB[k]; const int row = 16 * mi + 4 * q + k;
            if (wantp) Pdst[(size_t)row * DRNN] = (bf16)f2bf(pA[k] * eA * Pc);
            LAS unsigned short* hp = (LAS unsigned short*)(hft + row * LRU_XS + 2 * (16 * wave + c));
            if (!REV) *hp = (unsigned short)f2bf(h); else *hp = (unsigned short)f2bf(bf2f(gcur[4 * mloc + k]) * (bf2f(*hp) + h)); }
        hc = tA * hc + tB; Pc *= tA;
        }
        if (REV) {
#pragma unroll
            for (int i = 0; i < 16; ++i) gcur[i] = gnxt[i]; }
    }
    return hc;
}
__device__ __forceinline__ void lru_unit(Frame& F, int j, int pm, int n, const bf16* REC, const bf16* GB, bf16* HS, bf16* PF, bf16* PB, float* AGG, const bf16* WGT) {
    const int tid = F.tid, lane = F.lane, wave = F.wave, r0 = 256 * pm;
    const bool smp = pm >= 32; const int tix = smp ? (pm - 32) & 3 : 0, sq = smp ? (pm - 32) >> 2 : 0;
    const int t0 = smp ? 256 * tix : 0, T = smp ? 1024 : 256;
    LAS unsigned char* xct = F.lds + LRU_XC_OFF; LAS unsigned char* hft = F.lds + LRU_GB_OFF;
    { const float* cw = F.in[I_LRU_CW] + (size_t)j * 4 * DRNN + n * 128 + 2 * lane; const float* cb = F.in[I_LRU_CB] + (size_t)j * DRNN + n * 128 + 2 * lane;
      float w0[4], w1[4];
#pragma unroll
      for (int k = 0; k < 4; ++k) { w0[k] = cw[k * DRNN]; w1[k] = cw[k * DRNN + 1]; }
      const float b0 = cb[0], b1 = cb[1];
      unsigned v[35];
#pragma unroll
      for (int i = 0; i < 35; ++i) { const int tl = 32 * wave + i - 2, tt = t0 + tl;
          v[i] = (tt >= 0 && tt < T) ? *(const GAS unsigned*)(REC + (size_t)(r0 + tl) * DRNN + n * 128 + 2 * lane) : 0u; }
#pragma unroll
      for (int i = 0; i < 32; ++i) { float s0 = b0, s1 = b1;
#pragma unroll
          for (int k = 0; k < 4; ++k) { s0 += w0[k] * bf2f(v[i + k]); s1 += w1[k] * bf2f(v[i + k] >> 16); }
          *(LAS unsigned*)(xct + (32 * wave + i) * LRU_XS + 4 * lane) = f2bf(s0) | (f2bf(s1) << 16); } }
    __syncthreads();
    const int c = lane & 15, q = lane >> 4, ch = n * 128 + 16 * wave + c;
    const float* bg = F.in[I_LRU_BG] + (size_t)j * 4 * DRNN; const float* lam = F.in[I_LRU_LAM] + (size_t)j * 2 * DRNN;
    const bf16* gbp = GB + (size_t)r0 * DRNN + ch;
    bf16* pf = PF + (size_t)(smp ? r0 - NPROMPT : 0) * DRNN + ch; bf16* pb = PB + (size_t)(smp ? r0 - NPROMPT : 0) * DRNN + ch;
    { float h0 = 0.f; if (smp && tix == 0) h0 = F.in[I_STATE][((size_t)(sq * 2 + j) * 2 + 0) * DRNN + ch];
      const float hfin = lru_dir<false>(xct, hft, WGT + (size_t)(0 * 10 + n) * 128 * 128, gbp, bg[0 * DRNN + ch], bg[1 * DRNN + ch], softplusf_(-lam[ch]), h0, wave, lane, smp, pf);
      if (q == 0) { if (smp) AGG[(size_t)((sq * 4 + tix) * 2 + 0) * DRNN + ch] = hfin; else F.out[O_STATE + ((size_t)(pm * 2 + j) * 2 + 0) * DRNN + ch] = hfin; } }
    { float h0 = 0.f; if (smp && tix == 3) h0 = F.in[I_STATE][((size_t)(sq * 2 + j) * 2 + 1) * DRNN + ch];
      const float hfin = lru_dir<true>(xct, hft, WGT + (size_t)(2 * 10 + n) * 128 * 128, gbp, bg[2 * DRNN + ch], bg[3 * DRNN + ch], softplusf_(-lam[DRNN + ch]), h0, wave, lane, smp, pb);
      if (q == 0) { if (smp) AGG[(size_t)((sq * 4 + tix) * 2 + 1) * DRNN + ch] = hfin; else F.out[O_STATE + ((size_t)(pm * 2 + j) * 2 + 1) * DRNN + ch] = hfin; } }
    __syncthreads();
#pragma unroll
    for (int i = 0; i < 8; ++i) { const int id = i * NT + tid, row = id >> 4, cc = id & 15;
        *(GAS u32x4*)(HS + (size_t)(r0 + row) * DRNN + n * 128 + 8 * cc) = *(LAS const u32x4*)(hft + row * LRU_XS + 16 * cc); }
    __syncthreads();
}
__device__ __forceinline__ void phase_lru_core(Frame& F, int j, const bf16* REC, const bf16* GB, bf16* HS, bf16* PF, bf16* PB, float* AGG, const bf16* WGT) {
    F.fresh();
    for (int u = F.bid; u < 400; u += F.G) {
        const int pm = u < 80 ? 32 + u / 10 : (u - 80) / 10, n = u % 10;
        lru_unit(F, j, pm, n, REC, GB, HS, PF, PB, AGG, WGT); }
}
__device__ __forceinline__ void phase_lru_fixup(Frame& F, const bf16* GB, bf16* HS, const bf16* PF, const bf16* PB, const float* AGG) {
    F.fresh();
    const int gt = F.bid * NT + F.tid, GT = F.G * NT;
    for (int i = gt; i < NSAMPLE * DRNN; i += GT) { const int rs = i / DRNN, ch = i % DRNN, sq = rs >> 10, tix = (rs >> 8) & 3;
        float cf = 0.f, cbk = 0.f;
        if (tix > 0) { for (int t = 0; t < tix; ++t) { const float At = bf2f(PF[(size_t)(sq * 1024 + t * 256 + 255) * DRNN + ch]); cf = At * cf + AGG[(size_t)((sq * 4 + t) * 2 + 0) * DRNN + ch]; } }
        if (tix < 3) { for (int t = 3; t > tix; --t) { const float At = bf2f(PB[(size_t)(sq * 1024 + t * 256) * DRNN + ch]); cbk = At * cbk + AGG[(size_t)((sq * 4 + t) * 2 + 1) * DRNN + ch]; } }
        const size_t o = (size_t)(NPROMPT + rs) * DRNN + ch;
        HS[o] = (bf16)f2bf(bf2f(HS[o]) + bf2f(GB[o]) * (bf2f(PF[(size_t)rs * DRNN + ch]) * cf + bf2f(PB[(size_t)rs * DRNN + ch]) * cbk)); }
}

__device__ __forceinline__ void phase_cmlp_rstd(Frame& F, const bf16* UV) {
    F.fresh();
    const int gw = F.bid * NWAVES + F.wave, NGW = F.G * NWAVES;
    for (int row = gw; row < M; row += NGW) { float s = 0.f;
        for (int c = F.lane; c < DB; c += 64) { const float v = bf2f(UV[(size_t)row * 2 * DB + DB + c]); s += v * v; }
        s = wave_sum(s); if (F.lane == 0) F.rstd[row] = rsqrtf(s * (1.f / DB) + EPS); }
}
__device__ __forceinline__ void phase_cmlp_spatial(Frame& F, const bf16* UV, bf16* ACT) {
    F.fresh();
    const float* ws = F.in[I_CM_WS]; const float* bs = F.in[I_CM_BS]; const float* ng = F.in[I_CM_NG];
    const int gt = F.bid * NT + F.tid, GT = F.G * NT;
    for (int i = gt; i < M * DB; i += GT) { const int row = i / DB, ch = i % DB, g = ch >> 8, p = row & 127, r0 = row & ~127;
        float s = 0.f;
        for (int q = 0; q < 128; ++q) s += ws[(size_t)(g * 128 + p) * 128 + q] * F.rstd[r0 + q] * bf2f(UV[(size_t)(r0 + q) * 2 * DB + DB + ch]);
        const float sv = s * ng[ch] + bs[g * 128 + p];
        ACT[i] = (bf16)f2bf(bf2f(UV[(size_t)row * 2 * DB + ch]) * sv); }
}


constexpr int CM_VS = 544;
__device__ __forceinline__ void phase_cmlp_spatial_mfma(Frame& F, const bf16* UV, bf16* ACT, const bf16* WSB) {
    F.fresh();
    const int tid = F.tid, lane = F.lane, wave = F.wave, c = lane & 15, q4 = lane >> 4;
    LAS unsigned char* vt = F.lds;
    const float* ng = F.in[I_CM_NG]; const float* bs = F.in[I_CM_BS];
    for (int u = F.bid; u < 640; u += F.G) {
        const int chunk = u >> 3, g = u & 7, r0 = chunk * 128;
#pragma unroll
        for (int i = 0; i < 8; ++i) { const int id = i * NT + tid, row = id >> 5, cc = id & 31;
            const u32x4 x = *(const GAS u32x4*)(UV + (size_t)(r0 + row) * 2 * DB + DB + g * 256 + 8 * cc); const float rs = F.rstd[r0 + row];
            u32x4 y; y.x = f2bf(bf2f(x.x) * rs) | (f2bf(bf2f(x.x >> 16) * rs) << 16); y.y = f2bf(bf2f(x.y) * rs) | (f2bf(bf2f(x.y >> 16) * rs) << 16);
            y.z = f2bf(bf2f(x.z) * rs) | (f2bf(bf2f(x.z >> 16) * rs) << 16); y.w = f2bf(bf2f(x.w) * rs) | (f2bf(bf2f(x.w >> 16) * rs) << 16);
            *(LAS u32x4*)(vt + row * CM_VS + 16 * cc) = y; }
        __syncthreads();
        bf16x8 vf[2][4];
#pragma unroll
        for (int mfc = 0; mfc < 2; ++mfc)
#pragma unroll
            for (int ks = 0; ks < 4; ++ks) { LAS const unsigned char* vp = vt + (32 * ks + 4 * q4 + (c >> 2)) * CM_VS + (32 * wave + 16 * mfc + 4 * (c & 3)) * 2;
                const v4i16_t lo = __builtin_amdgcn_ds_read_tr16_b64_v4i16((LAS v4i16_t*)vp), hi = __builtin_amdgcn_ds_read_tr16_b64_v4i16((LAS v4i16_t*)(vp + 16 * CM_VS));
                vf[mfc][ks] = (bf16x8){lo[0], lo[1], lo[2], lo[3], hi[0], hi[1], hi[2], hi[3]}; }
#pragma unroll
        for (int nf = 0; nf < 8; ++nf) {
            bf16x8 Bf[4];
#pragma unroll
            for (int ks = 0; ks < 4; ++ks) Bf[ks] = *(const GAS bf16x8*)(WSB + ((size_t)((g * 8 + nf) * 4 + ks) * 64 + lane) * 8);
            const int p = 16 * nf + c; const float bsv = bs[g * 128 + p];
#pragma unroll
            for (int mfc = 0; mfc < 2; ++mfc) { f32x4 acc = {0.f, 0.f, 0.f, 0.f};
#pragma unroll
                for (int ks = 0; ks < 4; ++ks) acc = __builtin_amdgcn_mfma_f32_16x16x32_bf16(vf[mfc][ks], Bf[ks], acc, 0, 0, 0);
                const int ch = g * 256 + 32 * wave + 16 * mfc + 4 * q4;
                const f32x4 g4 = *(const GAS f32x4*)(ng + ch); const u32x2 uu = *(const GAS u32x2*)(UV + (size_t)(r0 + p) * 2 * DB + ch);
                const float o0 = bf2f(uu.x) * (acc[0] * g4.x + bsv), o1 = bf2f(uu.x >> 16) * (acc[1] * g4.y + bsv), o2 = bf2f(uu.y) * (acc[2] * g4.z + bsv), o3 = bf2f(uu.y >> 16) * (acc[3] * g4.w + bsv);
                u32x2 w; w.x = f2bf(o0) | (f2bf(o1) << 16); w.y = f2bf(o2) | (f2bf(o3) << 16);
                *(GAS u32x2*)(ACT + (size_t)(r0 + p) * DB + ch) = w; }
        }
        __syncthreads();
    }
}

__device__ __forceinline__ void phase_qkv_post(Frame& F, const bf16* QKV, bf16* Q, bf16* KP, bf16* VP) {
    F.fresh();
    const int gw = F.bid * NWAVES + F.wave, NGW = F.G * NWAVES;
    const float* qkg = F.in[I_AT_QKG];
    for (int row = gw; row < M; row += NGW) {
        const bool smp = row >= NPROMPT; const int sb = smp ? (row - NPROMPT) >> 10 : 0, t = smp ? (row - NPROMPT) & 1023 : 0;
        const float cs = smp ? F.rope[t * 32 + (F.lane & 31)] : 1.f, sn = smp ? F.rope[32768 + t * 32 + (F.lane & 31)] : 0.f;
        for (int grp = 0; grp < 32; ++grp) {
            const float v = bf2f(QKV[(size_t)row * 3072 + grp * 64 + F.lane]);
            const float ms = wave_sum(v * v) * (1.f / 64.f);
            float n = v * rsqrtf(ms + EPS) * qkg[(grp >> 4) * 64 + F.lane];
            const float keep = n;
            if (smp) { const float pr = __shfl_xor(n, 32); n = F.lane < 32 ? n * cs - pr * sn : n * cs + pr * sn; }
            if (grp < 16) Q[(size_t)row * D + grp * 64 + F.lane] = (bf16)f2bf(n);
            else { const int c = (grp - 16) * 64 + F.lane;
                if (smp) F.KS[((size_t)sb * TKS + PAST + t) * D + c] = (bf16)f2bf(n);
                else { KP[(size_t)row * D + c] = (bf16)f2bf(keep); F.out[O_CK + (size_t)row * D + c] = keep; } }
        }
        for (int c = F.lane; c < D; c += 64) { const bf16 vb = QKV[(size_t)row * 3072 + 2048 + c];
            if (smp) F.VS[((size_t)sb * TKS + PAST + t) * D + c] = vb; else { VP[(size_t)row * D + c] = vb; F.out[O_CV + (size_t)row * D + c] = bf2f(vb); } }
    }
}
__device__ __forceinline__ void phase_attn_naive(Frame& F, int l, const bf16* Q, const bf16* KP, const bf16* VP, bf16* O) {
    F.fresh();
    const int gw = F.bid * NWAVES + F.wave, NGW = F.G * NWAVES;
    LAS float* s1 = (LAS float*)F.lds + F.wave * 3328; LAS float* s2 = s1 + 1536; LAS float* qs = s2 + 1536;
    const float* al = F.in[I_AT_LAM];
    const float lam_init = 0.8f - 0.6f * expf(-0.3f * (float)l);
    const float lam = expf(wave_sum(al[F.lane] * al[64 + F.lane])) - expf(wave_sum(al[128 + F.lane] * al[192 + F.lane])) + lam_init;
    const float* sg = F.in[I_AT_SUBG];
    for (int item = gw; item < M * 8; item += NGW) {
        const int row = item >> 3, h = item & 7;
        const bf16 *Kb, *Vb; int Tk;
        if (row < NPROMPT) { Kb = KP + (size_t)(row & ~255) * D; Vb = VP + (size_t)(row & ~255) * D; Tk = 256; }
        else { const int sb = (row - NPROMPT) >> 10; Kb = F.KS + (size_t)sb * TKS * D; Vb = F.VS + (size_t)sb * TKS * D; Tk = TKS; }
        qs[F.lane] = bf2f(Q[(size_t)row * D + h * 128 + F.lane]); qs[64 + F.lane] = bf2f(Q[(size_t)row * D + h * 128 + 64 + F.lane]);
        asm volatile("s_waitcnt lgkmcnt(0)" ::: "memory");
        float m1 = -1e30f, m2 = -1e30f;
        for (int k = F.lane; k < Tk; k += 64) { const bf16* kr = Kb + (size_t)k * D + h * 128; float d1 = 0.f, d2 = 0.f;
#pragma unroll 4
            for (int d = 0; d < 64; d += 2) { const unsigned a = *(const unsigned*)(kr + d), b = *(const unsigned*)(kr + 64 + d);
                d1 += qs[d] * bf2f(a) + qs[d + 1] * bf2f(a >> 16); d2 += qs[64 + d] * bf2f(b) + qs[64 + d + 1] * bf2f(b >> 16); }
            d1 *= 0.125f; d2 *= 0.125f; s1[k] = d1; s2[k] = d2; m1 = fmaxf(m1, d1); m2 = fmaxf(m2, d2); }
        m1 = wave_max(m1); m2 = wave_max(m2);
        float l1 = 0.f, l2 = 0.f;
        for (int k = F.lane; k < Tk; k += 64) { const float e1 = expf(s1[k] - m1), e2 = expf(s2[k] - m2); s1[k] = e1; s2[k] = e2; l1 += e1; l2 += e2; }
        l1 = wave_sum(l1); l2 = wave_sum(l2);
        const float i1 = 1.f / l1, i2 = lam / l2;
        for (int k = F.lane; k < Tk; k += 64) s1[k] = bf2f(f2bf(s1[k] * i1 - s2[k] * i2));
        asm volatile("s_waitcnt lgkmcnt(0)" ::: "memory");
        float o0 = 0.f, o1 = 0.f;
        for (int k = 0; k < Tk; ++k) { const unsigned vv = *(const unsigned*)(Vb + (size_t)k * D + h * 128 + 2 * F.lane); const float w = s1[k]; o0 += w * bf2f(vv); o1 += w * bf2f(vv >> 16); }
        const float ms = wave_sum(o0 * o0 + o1 * o1) * (1.f / 128.f), rs = rsqrtf(ms + EPS) * (1.f - lam_init);
        o0 = o0 * rs * sg[2 * F.lane]; o1 = o1 * rs * sg[2 * F.lane + 1];
        *(unsigned*)(O + (size_t)row * D + h * 128 + 2 * F.lane) = f2bf(o0) | (f2bf(o1) << 16);
        asm volatile("s_waitcnt lgkmcnt(0)" ::: "memory");
    }
}


constexpr int AT_KS = 272, AT_VS = 288, AT_KBYTES = 64 * AT_KS, AT_VBYTES = 64 * AT_VS, AT_BUF = AT_KBYTES + AT_VBYTES;
__device__ __forceinline__ void attn_unit(Frame& F, int l, const bf16* Qrows  , const bf16* Kb, const bf16* Vb, int Tk, bf16* Orows, int h, float lam, float lam_init) {
    const int tid = F.tid, lane = F.lane, wave = F.wave, c = lane & 15, q4 = lane >> 4;
    LAS unsigned char* lds = F.lds;
    const float SC = 0.18033688f;
    bf16x8 Qf[2][2];
#pragma unroll
    for (int cp = 0; cp < 2; ++cp)
#pragma unroll
        for (int ks = 0; ks < 2; ++ks) Qf[cp][ks] = *(const GAS bf16x8*)(Qrows + (size_t)(16 * wave + c) * D + h * 128 + cp * 64 + 32 * ks + 8 * q4);
    const int nt = Tk / 64;
    const int key0 = tid >> 4, cc0 = tid & 15;
    u32x4 kreg[2], vreg[2];
    float m1 = -1e30f, m2 = -1e30f, l1 = 0.f, l2 = 0.f;
#pragma unroll
    for (int i = 0; i < 2; ++i) kreg[i] = *(const GAS u32x4*)(Kb + (size_t)(key0 + 32 * i) * D + h * 128 + 8 * cc0);
#pragma unroll
    for (int i = 0; i < 2; ++i) *(LAS u32x4*)(lds + (key0 + 32 * i) * AT_KS + 16 * cc0) = kreg[i];
    __syncthreads();
    for (int t = 0; t < nt; ++t) {
        LAS const unsigned char* kt = lds + (t & 1) * AT_BUF;
        if (t + 1 < nt) {
#pragma unroll
            for (int i = 0; i < 2; ++i) kreg[i] = *(const GAS u32x4*)(Kb + (size_t)((t + 1) * 64 + key0 + 32 * i) * D + h * 128 + 8 * cc0); }
        f32x4 S[2][4];
#pragma unroll
        for (int cp = 0; cp < 2; ++cp)
#pragma unroll
            for (int mf = 0; mf < 4; ++mf) { S[cp][mf] = (f32x4){0.f, 0.f, 0.f, 0.f};
#pragma unroll
                for (int ks = 0; ks < 2; ++ks) { const bf16x8 kf = *(LAS const bf16x8*)(kt + (16 * mf + c) * AT_KS + cp * 128 + ks * 64 + 16 * q4);
                    S[cp][mf] = __builtin_amdgcn_mfma_f32_16x16x32_bf16(kf, Qf[cp][ks], S[cp][mf], 0, 0, 0); } }
        float x1 = -1e30f, x2 = -1e30f;
#pragma unroll
        for (int mf = 0; mf < 4; ++mf)
#pragma unroll
            for (int k = 0; k < 4; ++k) { x1 = fmaxf(x1, S[0][mf][k]); x2 = fmaxf(x2, S[1][mf][k]); }
        x1 = fmaxf(x1, __shfl_xor(x1, 16)); x1 = fmaxf(x1, __shfl_xor(x1, 32)); x2 = fmaxf(x2, __shfl_xor(x2, 16)); x2 = fmaxf(x2, __shfl_xor(x2, 32));
        const float n1 = fmaxf(m1, x1), n2 = fmaxf(m2, x2);
        l1 *= exp2f((m1 - n1) * SC); l2 *= exp2f((m2 - n2) * SC); m1 = n1; m2 = n2;
#pragma unroll
        for (int mf = 0; mf < 4; ++mf)
#pragma unroll
            for (int k = 0; k < 4; ++k) { l1 += exp2f((S[0][mf][k] - m1) * SC); l2 += exp2f((S[1][mf][k] - m2) * SC); }
        if (t + 1 < nt) {
#pragma unroll
            for (int i = 0; i < 2; ++i) *(LAS u32x4*)(lds + ((t + 1) & 1) * AT_BUF + (key0 + 32 * i) * AT_KS + 16 * cc0) = kreg[i]; }
        __syncthreads();
    }
    l1 += __shfl_xor(l1, 16); l1 += __shfl_xor(l1, 32); l2 += __shfl_xor(l2, 16); l2 += __shfl_xor(l2, 32);
    const float i1 = 1.f / l1, i2 = lam / l2;
    f32x4 Ot[8];
#pragma unroll
    for (int md = 0; md < 8; ++md) Ot[md] = (f32x4){0.f, 0.f, 0.f, 0.f};
#pragma unroll
    for (int i = 0; i < 2; ++i) { kreg[i] = *(const GAS u32x4*)(Kb + (size_t)(key0 + 32 * i) * D + h * 128 + 8 * cc0); vreg[i] = *(const GAS u32x4*)(Vb + (size_t)(key0 + 32 * i) * D + h * 128 + 8 * cc0); }
#pragma unroll
    for (int i = 0; i < 2; ++i) { *(LAS u32x4*)(lds + (key0 + 32 * i) * AT_KS + 16 * cc0) = kreg[i]; *(LAS u32x4*)(lds + AT_KBYTES + (key0 + 32 * i) * AT_VS + 16 * cc0) = vreg[i]; }
    __syncthreads();
    for (int t = 0; t < nt; ++t) {
        LAS const unsigned char* kt = lds + (t & 1) * AT_BUF; LAS const unsigned char* vt = kt + AT_KBYTES;
        if (t + 1 < nt) {
#pragma unroll
            for (int i = 0; i < 2; ++i) { kreg[i] = *(const GAS u32x4*)(Kb + (size_t)((t + 1) * 64 + key0 + 32 * i) * D + h * 128 + 8 * cc0);
                                          vreg[i] = *(const GAS u32x4*)(Vb + (size_t)((t + 1) * 64 + key0 + 32 * i) * D + h * 128 + 8 * cc0); } }
        f32x4 S[2][4];
#pragma unroll
        for (int cp = 0; cp < 2; ++cp)
#pragma unroll
            for (int mf = 0; mf < 4; ++mf) { S[cp][mf] = (f32x4){0.f, 0.f, 0.f, 0.f};
#pragma unroll
                for (int ks = 0; ks < 2; ++ks) { const bf16x8 kf = *(LAS const bf16x8*)(kt + (16 * mf + c) * AT_KS + cp * 128 + ks * 64 + 16 * q4);
                    S[cp][mf] = __builtin_amdgcn_mfma_f32_16x16x32_bf16(kf, Qf[cp][ks], S[cp][mf], 0, 0, 0); } }
        bf16x8 Wf[2];
#pragma unroll
        for (int kk = 0; kk < 2; ++kk)
#pragma unroll
            for (int jj = 0; jj < 8; ++jj) { const int mf = 2 * kk + (jj >> 2), k = jj & 3;
                const float w = exp2f((S[0][mf][k] - m1) * SC) * i1 - exp2f((S[1][mf][k] - m2) * SC) * i2; Wf[kk][jj] = (short)f2bf(w); }
#pragma unroll
        for (int md = 0; md < 8; ++md)
#pragma unroll
            for (int kk = 0; kk < 2; ++kk) { LAS const unsigned char* vp = vt + (32 * kk + 4 * q4 + (c >> 2)) * AT_VS + (16 * md + 4 * (c & 3)) * 2;
                const v4i16_t lo = __builtin_amdgcn_ds_read_tr16_b64_v4i16((LAS v4i16_t*)vp), hi = __builtin_amdgcn_ds_read_tr16_b64_v4i16((LAS v4i16_t*)(vp + 16 * AT_VS));
                const bf16x8 vf = {lo[0], lo[1], lo[2], lo[3], hi[0], hi[1], hi[2], hi[3]};
                Ot[md] = __builtin_amdgcn_mfma_f32_16x16x32_bf16(vf, Wf[kk], Ot[md], 0, 0, 0); }
        if (t + 1 < nt) {
#pragma unroll
            for (int i = 0; i < 2; ++i) { *(LAS u32x4*)(lds + ((t + 1) & 1) * AT_BUF + (key0 + 32 * i) * AT_KS + 16 * cc0) = kreg[i];
                                          *(LAS u32x4*)(lds + ((t + 1) & 1) * AT_BUF + AT_KBYTES + (key0 + 32 * i) * AT_VS + 16 * cc0) = vreg[i]; } }
        __syncthreads();
    }
    float ss = 0.f;
#pragma unroll
    for (int md = 0; md < 8; ++md)
#pragma unroll
        for (int k = 0; k < 4; ++k) ss += Ot[md][k] * Ot[md][k];
    ss += __shfl_xor(ss, 16); ss += __shfl_xor(ss, 32);
    const float rs = rsqrtf(ss * (1.f / 128.f) + EPS) * (1.f - lam_init);
    const float* sg = F.in[I_AT_SUBG];
#pragma unroll
    for (int md = 0; md < 8; ++md) { const int d0 = 16 * md + 4 * q4; const f32x4 g4 = *(const GAS f32x4*)(sg + d0);
        u32x2 w; w.x = f2bf(Ot[md][0] * rs * g4.x) | (f2bf(Ot[md][1] * rs * g4.y) << 16); w.y = f2bf(Ot[md][2] * rs * g4.z) | (f2bf(Ot[md][3] * rs * g4.w) << 16);
        *(GAS u32x2*)(Orows + (size_t)(16 * wave + c) * D + h * 128 + d0) = w; }
}
__device__ __forceinline__ void phase_attn(Frame& F, int l, const bf16* Q, const bf16* KP, const bf16* VP, bf16* O) {
    F.fresh();
    const float* al = F.in[I_AT_LAM];
    const float lam_init = 0.8f - 0.6f * expf(-0.3f * (float)l);
    const float lam = expf(wave_sum(al[F.lane] * al[64 + F.lane])) - expf(wave_sum(al[128 + F.lane] * al[192 + F.lane])) + lam_init;
    for (int s = 0; ; ++s) {
        int u;
        if (F.G == 256) { if (F.bid < 128) { if (s > 0) break; u = F.bid; } else { if (s > 3) break; u = 128 + 4 * (F.bid - 128) + s; } }
        else { u = F.bid + s * F.G; if (u >= 640) break; }
        if (u < 128) { const int sb = u >> 6, h = (u >> 3) & 7, qt = u & 7; const size_t r0 = (size_t)NPROMPT + sb * 1024 + qt * 128;
            attn_unit(F, l, Q + r0 * D, F.KS + (size_t)sb * TKS * D, F.VS + (size_t)sb * TKS * D, TKS, O + r0 * D, h, lam, lam_init); }
        else { const int v = u - 128, b = v >> 4, h = (v >> 1) & 7, qt = v & 1; const size_t r0 = (size_t)b * 256 + qt * 128;
            attn_unit(F, l, Q + r0 * D, KP + (size_t)b * 256 * D, VP + (size_t)b * 256 * D, 256, O + r0 * D, h, lam, lam_init); }
    }
}

__device__ __forceinline__ void phase_ffn_convgate(Frame& F, int l, const bf16* Z, bf16* ACT) {
    F.fresh();
    const float* cw = F.in[I_FF_CW] + (size_t)l * 3 * 2 * DFF; const float* cb = F.in[I_FF_CB] + (size_t)l * 2 * DFF;
    const int gt = F.bid * NT + F.tid, GT = F.G * NT;
    for (int i = gt; i < M * DFF; i += GT) { const int row = i / DFF, j = i % DFF;
        int t, T; if (row < NPROMPT) { t = row & 255; T = 256; } else { t = (row - NPROMPT) & 1023; T = 1024; }
        float g = cb[j], u = cb[DFF + j];
#pragma unroll
        for (int k = 0; k < 3; ++k) { const int tt = t + k - 1; if (tt >= 0 && tt < T) { const bf16* zr = Z + (size_t)(row + k - 1) * 2 * DFF; g += cw[k * 2 * DFF + j] * bf2f(zr[j]); u += cw[k * 2 * DFF + DFF + j] * bf2f(zr[DFF + j]); } }
        ACT[i] = (bf16)f2bf(siluf_(g) * u); }
}

constexpr int LDS_BYTES = 163840;
constexpr int MISC_OFF = LDS_BYTES - 256;
__global__ void __launch_bounds__(NT, 2) mk_fwd(Params prm) {
    extern __shared__ __attribute__((aligned(16))) unsigned char lds_raw[];
    Frame F;
    F.lds = (LAS unsigned char*)lds_raw; F.G = gridDim.x; F.in = prm.in; F.out0 = prm.out; F.ws0 = prm.ws;
    F.fresh();
    volatile LAS unsigned* MISC = (volatile LAS unsigned*)(F.lds + MISC_OFF);
    if (F.tid < 32) MISC[F.tid] = 0u;
    __syncthreads();
    (void)xcd_barrier_post((unsigned*)(prm.ws + WS_CTL) + CW_BAR, MISC + 8);
#define GRID_BAR() do { XcdBarrier bar_; bar_.bar = (unsigned*)(prm.ws + WS_CTL) + CW_BAR; bar_.x = xb_xcc_id(); bar_.st = (volatile LAS unsigned*)(F.lds + MISC_OFF) + 8; xcd_barrier(bar_); } while (0)

#define GEMM_BF16(ACT, A_, Bt_, N_, K_, O_, ldc_, bias_, splitc_, splits_) do { pg8::Gemm g{A_, Bt_, M, N_, K_}; pg8::StaticOrder S; S.init(M, N_, F.G, F.bid); \
        pg8::EpiBf16<ACT> E{O_, ldc_, bias_, splitc_, splits_}; pg8::gemm_phase<pg8::EpiBf16<ACT>, pg8::StaticOrder, true, true>(F.lds, g, S, E); } while (0)
#define GEMM_RESID(A_, Bt_, K_, which_, fromin_) do { pg8::Gemm g{A_, Bt_, M, D, K_}; pg8::StaticOrder S; S.init(M, D, F.G, F.bid); \
        pg8::EpiResid E{F.out, F.in[I_XP], F.in[I_XS], F.mod + (size_t)l * 18 * D, which_, fromin_}; pg8::gemm_phase<pg8::EpiResid, pg8::StaticOrder, true, true>(F.lds, g, S, E); } while (0)

    phase_prologue(F);
    GRID_BAR();
#pragma unroll 1
    for (int l = 0; l < DEPTH; ++l) {
        const int kind = l % 3, j = l / 3;
        phase_modulate(F, l, 0);
        F.fresh();
        GRID_BAR();
        if (kind == 0) {
            bf16 *GB = F.T2, *REC = F.T2 + (size_t)M * DRNN, *PF = F.T3, *PB = F.T3 + (size_t)NSAMPLE * DRNN, *HS = F.T3 + (size_t)6 * 1024 * 1024;
            float* AGG = (float*)(F.T3 + (size_t)2 * NSAMPLE * DRNN);
            GEMM_BF16(2, F.H, F.WT + WE_LRU_IN + (size_t)j * 2 * DRNN * D, 2 * DRNN, D, GB, DRNN, nullptr, DRNN, (size_t)M * DRNN);
            GRID_BAR();
            phase_lru_core(F, j, REC, GB, HS, PF, PB, AGG, F.WT + WE_WG + (size_t)j * 40 * 128 * 128);
            GRID_BAR();
            phase_lru_fixup(F, GB, HS, PF, PB, AGG);
            GRID_BAR();
            GEMM_RESID(HS, F.WT + WE_LRU_OUT + (size_t)j * D * DRNN, DRNN, 2, l == 0);
        } else if (kind == 1) {
            bf16 *UV = F.T1, *ACT = F.T2;
            GEMM_BF16(1, F.H, F.WT + WE_CM_IN, 2 * DB, D, UV, 2 * DB, F.in[I_CM_BIN], 0, 0);
            GRID_BAR();
            phase_cmlp_rstd(F, UV);
            GRID_BAR();
            phase_cmlp_spatial_mfma(F, UV, ACT, F.WT + WE_WSB);
            GRID_BAR();
            GEMM_RESID(ACT, F.WT + WE_CM_OUT, DB, 2, false);
        } else {
            bf16 *QKV = F.T1, *Q = F.T2, *KP = F.T2 + (size_t)M * D, *VP = KP + (size_t)NPROMPT * D, *O = F.T3;
            GEMM_BF16(0, F.H, F.WT + WE_QKV, 3 * D, D, QKV, 3 * D, nullptr, 0, 0);
            GRID_BAR();
            phase_qkv_post(F, QKV, Q, KP, VP);
            GRID_BAR();
            phase_attn(F, l, Q, KP, VP, O);
            GRID_BAR();
            GEMM_RESID(O, F.WT + WE_AT_OUT, D, 2, false);
        }
        GRID_BAR();
        phase_modulate(F, l, 1);
        GRID_BAR();
        { pg8::Gemm g{F.H, F.WT + WE_UP + (size_t)l * 2 * DFF * D, 42 * 256, 2 * DFF, D}; pg8::FfnOrder S; S.init(42 * 256, 2 * DFF, F.G, F.bid);
          pg8::EpiFfn E{F.T2, F.in[I_FF_CW] + (size_t)l * 3 * 2 * DFF, F.in[I_FF_CB] + (size_t)l * 2 * DFF, (LAS float*)(F.lds + 131072)};
          pg8::gemm_phase<pg8::EpiFfn, pg8::FfnOrder, true, true>(F.lds, g, S, E); }
        GRID_BAR();
        GEMM_RESID(F.T2, F.WT + WE_DN + (size_t)l * D * DFF, DFF, 5, false);
        GRID_BAR();
    }
}

extern "C" void kernel_launch(void* const* d_in, const int* in_sizes, int n_in, void* d_out, int out_size, void* d_ws, size_t ws_size, hipStream_t stream) {
    static int grid = 0;
    if (grid == 0) {
        if (n_in != N_IN || ws_size < WS_END) { fprintf(stderr, "kernel_launch: unexpected n_in %d or ws_size %zu\n", n_in, ws_size); grid = -1; return; }
        int dev = 0, cus = 0, per_cu = 0;
        hipGetDevice(&dev); hipDeviceGetAttribute(&cus, hipDeviceAttributeMultiprocessorCount, dev);
        hipFuncSetAttribute((const void*)mk_fwd, hipFuncAttributeMaxDynamicSharedMemorySize, LDS_BYTES);
        hipOccupancyMaxActiveBlocksPerMultiprocessor(&per_cu, (const void*)mk_fwd, NT, LDS_BYTES);
        (void)hipGetLastError();
        if (per_cu < 1) { fprintf(stderr, "kernel_launch: occupancy query says %d blocks per CU\n", per_cu); per_cu = 1; }
        grid = cus;
    }
    if (grid < 0) return;
    hipMemsetAsync((char*)d_ws + WS_CTL, 0, CTL_ZERO_BYTES, stream);
    Params p{};
    for (int i = 0; i < N_IN; ++i) p.in[i] = (const float*)d_in[i];
    p.out = (float*)d_out; p.ws = (unsigned char*)d_ws;
    void* args[] = {&p};
    hipError_t e = hipLaunchCooperativeKernel((const void*)mk_fwd, dim3(grid), dim3(NT), args, LDS_BYTES, stream);
    if (e != hipSuccess) fprintf(stderr, "kernel_launch: cooperative launch failed: %s (grid %d)\n", hipGetErrorString(e), grid);
}
```

```cpp
#include <hip/hip_runtime.h>
#include <cstdio>
#include <cstdint>

#define GAS __attribute__((address_space(1)))
#define LAS __attribute__((address_space(3)))
typedef unsigned short bf16;
typedef float f32x4 __attribute__((ext_vector_type(4)));
typedef unsigned u32x2 __attribute__((ext_vector_type(2)));
typedef unsigned u32x4 __attribute__((ext_vector_type(4)));

constexpr int D = 1024, NPROMPT = 32 * 256, NSAMPLE = 2 * 1024, M = NPROMPT + NSAMPLE;
constexpr int DEPTH = 4, DRNN = 1280, DB = 2048, DFF = 2816, PAST = 512, TKS = PAST + 1024;
constexpr float EPS = 1e-6f;
constexpr int NWAVES = 8, NT = NWAVES * 64;

enum { I_XP = 0, I_XS, I_STATE, I_CK, I_CV, I_C, I_CCTX, I_WMOD, I_BMOD, I_NORMG, I_LRU_WIN, I_LRU_CW, I_LRU_CB, I_LRU_WG, I_LRU_BG, I_LRU_LAM, I_LRU_WOUT,
       I_CM_WIN, I_CM_BIN, I_CM_NG, I_CM_WS, I_CM_BS, I_CM_WOUT, I_AT_WQKV, I_AT_QKG, I_AT_LAM, I_AT_SUBG, I_AT_WOUT, I_FF_WUP, I_FF_CW, I_FF_CB, I_FF_WDN, N_IN };
constexpr size_t O_YP = 0, O_YS = (size_t)NPROMPT * D, O_STATE = (size_t)M * D, O_CK = O_STATE + 32 * 2 * 2 * DRNN, O_CV = O_CK + (size_t)NPROMPT * D;

constexpr size_t MiB = 1u << 20;
constexpr size_t WS_CTL = 0, CTL_ZERO_BYTES = 64 * 1024;
constexpr size_t WS_MOD = 1 * MiB;
constexpr size_t WS_RSTD = WS_MOD + 512 * 1024;
constexpr size_t WS_ROPE = WS_RSTD + 256 * 1024;
constexpr size_t WS_H = 2 * MiB;
constexpr size_t WS_T1 = 22 * MiB;
constexpr size_t WS_T2 = 132 * MiB;
constexpr size_t WS_T3 = 187 * MiB;
constexpr size_t WS_X = WS_T3 + 40 * MiB;
constexpr size_t B2_LRU = 0, B2_CM = B2_LRU + (size_t)2 * 3 * 2560, B2_QKV = B2_CM + (size_t)3 * 4096, B2_UP = B2_QKV + (size_t)3 * 3072, B2_END = B2_UP + (size_t)4 * 3 * 5632;
constexpr size_t WS_KS = 237 * MiB, WS_VS = 243 * MiB;
constexpr size_t WS_W = 249 * MiB;
constexpr size_t WE_LRU_IN = 0, WE_LRU_OUT = WE_LRU_IN + (size_t)2 * 2560 * 1024, WE_CM_IN = WE_LRU_OUT + (size_t)2 * 1024 * 1280, WE_CM_OUT = WE_CM_IN + (size_t)4096 * 1024,
                 WE_QKV = WE_CM_OUT + (size_t)1024 * 2048, WE_AT_OUT = WE_QKV + (size_t)3072 * 1024, WE_UP = WE_AT_OUT + (size_t)1024 * 1024, WE_DN = WE_UP + (size_t)4 * 5632 * 1024,
                 WE_WG = WE_DN + (size_t)4 * 1024 * 2816, WE_WSB = WE_WG + (size_t)80 * 128 * 128, WE_END = WE_WSB + (size_t)8 * 128 * 128;
constexpr size_t WS_END = WS_W + 106 * MiB;
static_assert(WE_END * 2 <= 106 * MiB, "weight copies fit");
constexpr int CW_BAR = 1024;

constexpr int LDS_BYTES = 163840;
constexpr int MISC_OFF = LDS_BYTES - 256, PTR_OFF = LDS_BYTES - 1024;

__device__ __forceinline__ unsigned f2bf(float f) { unsigned u = __builtin_bit_cast(unsigned, f); return (u + 0x7fffu + ((u >> 16) & 1u)) >> 16; }
__device__ __forceinline__ float bf2f(unsigned b) { return __builtin_bit_cast(float, (b & 0xffffu) << 16); }
template <int CTRL> __device__ __forceinline__ float dppf(float v) { return __builtin_bit_cast(float, __builtin_amdgcn_update_dpp(0, __builtin_bit_cast(int, v), CTRL, 0xf, 0xf, false)); }
__device__ __forceinline__ float swz_xor16(float v) { return __builtin_bit_cast(float, __builtin_amdgcn_ds_swizzle(__builtin_bit_cast(int, v), 0x401F)); }
__device__ __forceinline__ float sum_x32(float v) { auto r = __builtin_amdgcn_permlane32_swap(__builtin_bit_cast(unsigned, v), __builtin_bit_cast(unsigned, v), false, false);
    return __builtin_bit_cast(float, (unsigned)r[0]) + __builtin_bit_cast(float, (unsigned)r[1]); }
__device__ __forceinline__ float max_x32(float v) { auto r = __builtin_amdgcn_permlane32_swap(__builtin_bit_cast(unsigned, v), __builtin_bit_cast(unsigned, v), false, false);
    return fmaxf(__builtin_bit_cast(float, (unsigned)r[0]), __builtin_bit_cast(float, (unsigned)r[1])); }
__device__ __forceinline__ float sum_q4(float v) { v += swz_xor16(v); return sum_x32(v); }
__device__ __forceinline__ float max_q4(float v) { v = fmaxf(v, swz_xor16(v)); return max_x32(v); }
__device__ __forceinline__ float wave_sum(float v) { v += dppf<0xB1>(v); v += dppf<0x4E>(v); v += dppf<0x141>(v); v += dppf<0x140>(v); return sum_q4(v); }
__device__ __forceinline__ float wave_max(float v) { v = fmaxf(v, dppf<0xB1>(v)); v = fmaxf(v, dppf<0x4E>(v)); v = fmaxf(v, dppf<0x141>(v)); v = fmaxf(v, dppf<0x140>(v)); return max_q4(v); }
__device__ __forceinline__ float bperm(float v, int src_lane) { return __builtin_bit_cast(float, __builtin_amdgcn_ds_bpermute(src_lane << 2, __builtin_bit_cast(int, v))); }
__device__ __forceinline__ float gelu_tanh(float x) { const float y = 0.7978845608028654f * (x + 0.044715f * x * x * x); const float t = 1.f - 2.f / (__expf(2.f * y) + 1.f); return 0.5f * x * (1.f + t); }
__device__ __forceinline__ float sigmoidf_(float x) { return 1.f / (1.f + __expf(-x)); }
__device__ __forceinline__ float siluf_(float x) { return x / (1.f + __expf(-x)); }
__device__ __forceinline__ float softplusf_(float x) { return fmaxf(x, 0.f) + log1pf(expf(-fabsf(x))); }

#define XB_TMO      128
#define XB_XCNT(j)  (256  + 64 * (j))
#define XB_XSUB(j)  (1280 + 64 * (j))
#define XB_XGEN(j)  (2304 + 64 * (j))
#define XB_TOP      3328
#define XB_TOPGEN   3392
#define XCD_BAR_WORDS 3456
#define XB_SPIN_CAP (1u << 22)
__device__ __forceinline__ unsigned xb_ld(unsigned* p)              { return __hip_atomic_load(p, __ATOMIC_RELAXED, __HIP_MEMORY_SCOPE_AGENT); }
__device__ __forceinline__ unsigned xb_add(unsigned* p, unsigned v) { return __hip_atomic_fetch_add(p, v, __ATOMIC_RELAXED, __HIP_MEMORY_SCOPE_AGENT); }
__device__ __forceinline__ unsigned xb_xcc_id() { return (unsigned)__builtin_amdgcn_s_getreg((3 << 11) | 20) & 0xFu; }
#define XB_SPIN(cond, bar) do { unsigned _sp = 0; while (cond) { __builtin_amdgcn_s_sleep(1); \
    if ((++_sp & 255u) == 0u) { if (xb_ld(&(bar)[XB_TMO])) break; if (_sp > XB_SPIN_CAP) { atomicAdd(&(bar)[XB_TMO], 1u); break; } } } } while (0)
struct XcdBarrier { unsigned* bar; unsigned x; volatile LAS unsigned* st; bool t0; };
__device__ __forceinline__ XcdBarrier xcd_barrier_post(unsigned* bar, volatile LAS unsigned* st, bool t0) {
    XcdBarrier b; b.bar = bar; b.x = xb_xcc_id(); b.st = st; b.t0 = t0;
    if (t0) (void)xb_add(&bar[XB_XCNT(b.x)], 1u);
    return b;
}
__device__ __forceinline__ void xcd_barrier_complete(unsigned* bar, unsigned x, unsigned& nloc, unsigned& nx) {
    const unsigned G = gridDim.x * gridDim.y * gridDim.z;
    unsigned sum, cnt, mine, sp = 0u;
    for (;;) {
        sum = 0u; cnt = 0u; mine = 0u;
#pragma unroll
        for (unsigned j = 0; j < 16; ++j) { const unsigned c = xb_ld(&bar[XB_XCNT(j)]); sum += c; cnt += (c > 0u) ? 1u : 0u; mine = (j == x) ? c : mine; }
        if (sum == G) break;
        __builtin_amdgcn_s_sleep(1);
        if ((++sp & 255u) == 0u) { if (xb_ld(&bar[XB_TMO])) break; if (sp > XB_SPIN_CAP) { atomicAdd(&bar[XB_TMO], 1u); break; } }
    }
    nloc = mine > 0u ? mine : 1u; nx = cnt > 0u ? cnt : 1u;
}
__device__ __forceinline__ void xcd_barrier(const XcdBarrier& b) {
    asm volatile("s_waitcnt vmcnt(0)" ::: "memory");
    __syncthreads();
    if (b.t0) {
        unsigned* bar = b.bar;
        __builtin_amdgcn_s_waitcnt(0);
        unsigned nloc = b.st[0], nx = b.st[1];
        if (nloc == 0u) { xcd_barrier_complete(bar, b.x, nloc, nx); b.st[0] = nloc; b.st[1] = nx; }
        const unsigned old = xb_add(&bar[XB_XSUB(b.x)], 1u);
        const unsigned gen = old / nloc;
        if (old + 1u == (gen + 1u) * nloc) {
            __builtin_amdgcn_fence(__ATOMIC_RELEASE, "agent");
            asm volatile("s_waitcnt vmcnt(0)" ::: "memory");
            const unsigned og = xb_add(&bar[XB_TOP], 1u);
            const unsigned tg = og / nx;
            if (og + 1u == (tg + 1u) * nx) xb_add(&bar[XB_TOPGEN], 1u);
            else XB_SPIN(xb_ld(&bar[XB_TOPGEN]) == tg, bar);
            __builtin_amdgcn_fence(__ATOMIC_ACQUIRE, "agent");
            xb_add(&bar[XB_XGEN(b.x)], 1u);
            asm volatile("s_waitcnt vmcnt(0)" ::: "memory");
        } else {
            XB_SPIN(xb_ld(&bar[XB_XGEN(b.x)]) == gen, bar);
            __builtin_amdgcn_fence(__ATOMIC_ACQUIRE, "agent");
            asm volatile("s_waitcnt vmcnt(0)" ::: "memory");
        }
    }
    __syncthreads();
}

namespace pg8 {
#define PG8_LAS __attribute__((address_space(3)))
typedef unsigned short bf16_t;
typedef short bf16x8 __attribute__((ext_vector_type(8)));
typedef float f32x4 __attribute__((ext_vector_type(4)));
typedef unsigned u32x4 __attribute__((ext_vector_type(4)));
constexpr int BM = 256, BK = 64, HALF = 128, HTB = HALF * BK * 2  , STAGE_BYTES = 8 * HTB, NXCD = 8, WGM = 8;

__host__ __device__ __forceinline__ int lds_byte(int r, int c) { const int st = (r >> 4) * 2 + (c >> 5), rr = r & 15, cc = c & 31, ob = rr * 64 + cc * 2; return st * 1024 + (ob ^ (((ob >> 9) & 1) << 5)); }
__host__ __device__ __forceinline__ void stage_rc(int b, int& R, int& C) { const int st = b / 1024, sb = b % 1024, swz = sb ^ (((sb >> 9) & 1) << 5); R = (st >> 1) * 16 + swz / 64; C = (st & 1) * 32 + (swz % 64) / 2; }
__host__ __device__ __forceinline__ int perm32(int rho) { const int n = rho >> 4, i = rho & 15; return 8 * (i >> 2) + 4 * n + (i & 3); }

struct Unit { int pm, pn; };
struct Gemm { const bf16_t* A; const bf16_t* Bt; int M, N, K; };

struct StaticOrder {
    int nM, nN, nwg, G, c, wave;
    __host__ __device__ void init(int M, int N, int G_, int c_) { nM = M / BM; nN = N / BM; nwg = nM * nN; G = G_; c = c_; }
    __host__ __device__ bool next(int i, Unit& u) const {
        const long L = (long)i * G + c; if (L >= nwg) return false;
        int wgid = (int)L; { const int q = nwg / NXCD, r = nwg % NXCD, xcd = wgid % NXCD, off = wgid / NXCD; wgid = (xcd < r ? xcd * (q + 1) : r * (q + 1) + (xcd - r) * q) + off; }
        const int nig = WGM * nN, gid = wgid / nig, fm = gid * WGM, gsz = (nM - fm) < WGM ? (nM - fm) : WGM;
        u.pm = fm + ((wgid % nig) % gsz); u.pn = (wgid % nig) / gsz; return true;
    }
    __device__ __forceinline__ int arow(int pm) const { return pm * BM; }
    __device__ __forceinline__ void a_ready(const Unit&) const {}
    __device__ __forceinline__ void done(const Unit&) const {}
};

template <class Epi, class Sched, bool ALIGN_EPI = false, bool SP2 = false>
__device__ __forceinline__ void gemm_phase(PG8_LAS unsigned char* lds, const Gemm g, const Sched& S, const Epi& E) {
    int z_ = 0; asm volatile("" : "+v"(z_));
    const int lane = __builtin_amdgcn_mbcnt_hi(~0u, __builtin_amdgcn_mbcnt_lo(~0u, z_)), wid = S.wave, tid = wid * 64 + lane, wr = wid >> 2, wc = wid & 3, fr = lane & 15, fq = lane >> 4;
    const int K = g.K, nt = K / BK;
    unsigned voffA[2], voffB[2];
#pragma unroll
    for (int i = 0; i < 2; ++i) { int R, C; stage_rc(tid * 16 + i * 8192, R, C); const int Rb = Epi::PERM ? ((R & ~31) + perm32(R & 31)) : R;
        voffA[i] = (unsigned)(R * K + C) * 2u; voffB[i] = (unsigned)(Rb * K + C) * 2u; }
    const size_t kstep = (size_t)(BK * 2);
    const size_t hstep = (size_t)HALF * K * 2;
    const size_t tstep = 2 * hstep;
    const unsigned ldsw = (unsigned)wid * 1024u;
    const int aoff = lds_byte(wr * 64 + fr, fq * 8), boff = lds_byte(wc * 32 + fr, fq * 8);
#define PG8_SA(b, h) (((b) * 2 + (h)) * HTB)
#define PG8_SB(b, h) ((4 + (b) * 2 + (h)) * HTB)
#define PG8_STAGE(bufoff, gbase, voff) do { _Pragma("unroll") for (int _i = 0; _i < 2; ++_i) \
        __builtin_amdgcn_global_load_lds((const unsigned*)((const char*)(gbase) + (voff)[_i]), (PG8_LAS unsigned*)(lds + (bufoff) + ldsw + _i * 8192), 16, 0, 0); } while (0)
#define PG8_LDA(dst, b, h) do { _Pragma("unroll") for (int m = 0; m < 4; ++m) _Pragma("unroll") for (int k = 0; k < 2; ++k) dst[m][k] = *(const PG8_LAS bf16x8*)(lds + PG8_SA(b, h) + aoff + m * 2048 + k * 1024); } while (0)
#define PG8_LDB(dst, b, h) do { _Pragma("unroll") for (int n = 0; n < 2; ++n) _Pragma("unroll") for (int k = 0; k < 2; ++k) dst[n][k] = *(const PG8_LAS bf16x8*)(lds + PG8_SB(b, h) + boff + n * 2048 + k * 1024); } while (0)
#define PG8_MMA(ai, bj, At, Bt) do { __builtin_amdgcn_s_setprio(1); _Pragma("unroll") for (int m = 0; m < 4; ++m) _Pragma("unroll") for (int n = 0; n < 2; ++n) _Pragma("unroll") for (int k = 0; k < 2; ++k) \
        acc[ai][bj][m][n] = __builtin_amdgcn_mfma_f32_16x16x32_bf16(Bt[n][k], At[m][k], acc[ai][bj][m][n], 0, 0, 0); __builtin_amdgcn_s_setprio(0); } while (0)
#define PG8_WAIT_V(n) asm volatile("s_waitcnt vmcnt(" #n ")" ::: "memory")
#define PG8_WAIT_L(n) asm volatile("s_waitcnt lgkmcnt(" #n ")" ::: "memory")
#define PG8_BAR __builtin_amdgcn_s_barrier()
#define PG8_SCHED __builtin_amdgcn_sched_barrier(0)
    Unit cur, nxt; int ui = 0;
    if (!S.next(0, cur)) return;
    f32x4 acc[2][2][4][2];
#pragma unroll
    for (int a = 0; a < 2; ++a)
#pragma unroll
        for (int b = 0; b < 2; ++b)
#pragma unroll
            for (int m = 0; m < 4; ++m)
#pragma unroll
                for (int n = 0; n < 2; ++n) acc[a][b][m][n] = (f32x4){0.f, 0.f, 0.f, 0.f};
    bf16x8 At[4][2], B0[2][2], B1[2][2];
    const char* cA = (const char*)g.A + (size_t)S.arow(cur.pm) * (size_t)K * 2; const char* cB = (const char*)g.Bt + (size_t)cur.pn * tstep;
    S.a_ready(cur);
    if constexpr (SP2) {
        PG8_STAGE(PG8_SB(0, 0), cB, voffB); PG8_STAGE(PG8_SB(0, 1), cB + hstep, voffB); PG8_STAGE(PG8_SA(0, 0), cA, voffA); PG8_STAGE(PG8_SA(0, 1), cA + hstep, voffA);
        if (wr == 1) PG8_BAR;
        PG8_WAIT_V(2); PG8_BAR;
        PG8_STAGE(PG8_SB(1, 0), cB + kstep, voffB); PG8_STAGE(PG8_SA(1, 0), cA + kstep, voffA); PG8_STAGE(PG8_SB(1, 1), cB + hstep + kstep, voffB);
        PG8_WAIT_V(6); PG8_BAR;
    } else {
        PG8_STAGE(PG8_SB(0, 0), cB, voffB); PG8_STAGE(PG8_SA(0, 0), cA, voffA); PG8_STAGE(PG8_SB(0, 1), cB + hstep, voffB); PG8_STAGE(PG8_SA(0, 1), cA + hstep, voffA);
        if (wr == 1) PG8_BAR;
        PG8_WAIT_V(4); PG8_BAR;
        PG8_STAGE(PG8_SB(1, 0), cB + kstep, voffB); PG8_STAGE(PG8_SA(1, 0), cA + kstep, voffA); PG8_STAGE(PG8_SB(1, 1), cB + hstep + kstep, voffB);
        PG8_WAIT_V(6); PG8_BAR;
    }
    for (;;) {
        const bool has_next = S.next(ui + 1, nxt);
        const char* nA = has_next ? (const char*)g.A + (size_t)S.arow(nxt.pm) * (size_t)K * 2 : cA; const char* nB = has_next ? (const char*)g.Bt + (size_t)nxt.pn * tstep : cB;
        for (int t = 0; t < nt; t += 2) {
            const bool last = (t == nt - 2);
            const char* a1 = cA + (size_t)(t + 1) * kstep;
            const char* a2 = last ? nA : cA + (size_t)(t + 2) * kstep; const char* b2 = last ? nB : cB + (size_t)(t + 2) * kstep;
            const char* a3 = a2 + kstep; const char* b3 = b2 + kstep;
            if (last && has_next) S.a_ready(nxt);
            if constexpr (SP2) {
            PG8_LDB(B0, 0, 0); PG8_LDB(B1, 0, 1); PG8_SCHED; PG8_LDA(At, 0, 0); PG8_STAGE(PG8_SA(1, 1), a1 + hstep, voffA);
            PG8_WAIT_V(8); PG8_WAIT_L(0); PG8_BAR; PG8_MMA(0, 0, At, B0); PG8_MMA(0, 1, At, B1); PG8_BAR; PG8_SCHED;
            PG8_LDA(At, 0, 1); PG8_STAGE(PG8_SB(0, 0), b2, voffB); PG8_STAGE(PG8_SB(0, 1), b2 + hstep, voffB); PG8_STAGE(PG8_SA(0, 0), a2, voffA);
            PG8_WAIT_V(8); PG8_WAIT_L(0); PG8_BAR; PG8_MMA(1, 0, At, B0); PG8_MMA(1, 1, At, B1); PG8_BAR; PG8_SCHED;
            PG8_LDB(B0, 1, 0); PG8_LDB(B1, 1, 1); PG8_SCHED; PG8_LDA(At, 1, 0); PG8_STAGE(PG8_SA(0, 1), a2 + hstep, voffA);
            PG8_WAIT_V(8); PG8_WAIT_L(0); PG8_BAR; PG8_MMA(0, 0, At, B0); PG8_MMA(0, 1, At, B1); PG8_BAR; PG8_SCHED;
            PG8_LDA(At, 1, 1); PG8_STAGE(PG8_SB(1, 0), b3, voffB); PG8_STAGE(PG8_SB(1, 1), b3 + hstep, voffB); PG8_STAGE(PG8_SA(1, 0), a3, voffA);
            PG8_WAIT_V(8); PG8_WAIT_L(0); PG8_BAR; PG8_MMA(1, 0, At, B0); PG8_MMA(1, 1, At, B1); PG8_BAR; PG8_SCHED;
            } else {
            PG8_LDB(B0, 0, 0); PG8_SCHED; PG8_LDA(At, 0, 0); PG8_STAGE(PG8_SA(1, 1), a1 + hstep, voffA);
            PG8_WAIT_L(8); PG8_BAR; PG8_WAIT_L(0); PG8_MMA(0, 0, At, B0); PG8_BAR; PG8_SCHED;
            PG8_LDB(B1, 0, 1); PG8_STAGE(PG8_SB(0, 0), b2, voffB);
            PG8_BAR; PG8_WAIT_L(0); PG8_MMA(0, 1, At, B1); PG8_BAR;
            PG8_LDA(At, 0, 1); PG8_STAGE(PG8_SA(0, 0), a2, voffA);
            PG8_BAR; PG8_WAIT_L(0); PG8_MMA(1, 0, At, B0); PG8_BAR; PG8_SCHED;
            PG8_STAGE(PG8_SB(0, 1), b2 + hstep, voffB);
            PG8_WAIT_V(6); PG8_BAR; PG8_MMA(1, 1, At, B1); PG8_BAR;
            PG8_LDB(B0, 1, 0); PG8_SCHED; PG8_LDA(At, 1, 0); PG8_STAGE(PG8_SA(0, 1), a2 + hstep, voffA);
            PG8_WAIT_L(8); PG8_BAR; PG8_WAIT_L(0); PG8_MMA(0, 0, At, B0); PG8_BAR; PG8_SCHED;
            PG8_LDB(B1, 1, 1); PG8_STAGE(PG8_SB(1, 0), b3, voffB);
            PG8_BAR; PG8_WAIT_L(0); PG8_MMA(0, 1, At, B1); PG8_BAR;
            PG8_LDA(At, 1, 1); PG8_STAGE(PG8_SA(1, 0), a3, voffA);
            PG8_BAR; PG8_WAIT_L(0); PG8_MMA(1, 0, At, B0); PG8_BAR; PG8_SCHED;
            PG8_STAGE(PG8_SB(1, 1), b3 + hstep, voffB);
            PG8_WAIT_V(6); PG8_BAR; PG8_MMA(1, 1, At, B1); PG8_BAR;
            }
        }
        if constexpr (ALIGN_EPI) { if (wr == 0) PG8_BAR; }
        if constexpr (!Epi::AFTER_DRAIN) { E(acc, cur, wr, wc, fr, fq); S.done(cur); }
        if (!has_next) break;
#pragma unroll
        for (int a = 0; a < 2; ++a)
#pragma unroll
            for (int b = 0; b < 2; ++b)
#pragma unroll
                for (int m = 0; m < 4; ++m)
#pragma unroll
                    for (int n = 0; n < 2; ++n) acc[a][b][m][n] = (f32x4){0.f, 0.f, 0.f, 0.f};
        cur = nxt; cA = nA; cB = nB; ++ui;
        if constexpr (ALIGN_EPI) { if (wr == 1) PG8_BAR; }
    }
    PG8_WAIT_V(0);
    if constexpr (!ALIGN_EPI) { if (wr == 0) PG8_BAR; }
    PG8_BAR;
    if constexpr (Epi::AFTER_DRAIN) { E.fused(acc, cur, wr, wc, fr, fq, lds, wid, lane); S.done(cur); }
#undef PG8_SA
#undef PG8_SB
#undef PG8_STAGE
#undef PG8_LDA
#undef PG8_LDB
#undef PG8_MMA
#undef PG8_WAIT_V
#undef PG8_WAIT_L
#undef PG8_BAR
#undef PG8_SCHED
}
}

namespace pg8 {
__device__ __forceinline__ unsigned cvt_pk_bf16(float lo, float hi) { unsigned r; asm volatile("v_cvt_pk_bf16_f32 %0, %1, %2" : "=v"(r) : "v"(lo), "v"(hi)); return r; }
__device__ __forceinline__ f32x4 gelu4(f32x4 v) { f32x4 o; o.x = gelu_tanh(v.x); o.y = gelu_tanh(v.y); o.z = gelu_tanh(v.z); o.w = gelu_tanh(v.w); return o; }
__device__ __forceinline__ float row_rstd(const float* rsq, int row) {
    const GAS f32x4* p = (const GAS f32x4*)(rsq + (size_t)row * 16);
    const f32x4 a = p[0], b = p[1], c = p[2], d = p[3];
    const float s = ((a.x + a.y) + (a.z + a.w)) + ((b.x + b.y) + (b.z + b.w)) + ((c.x + c.y) + (c.z + c.w)) + ((d.x + d.y) + (d.z + d.w));
    return rsqrtf(s * (1.f / D) + EPS);
}
__device__ __forceinline__ int tile_cidx(int trow) { return trow < NPROMPT ? 0 : 1 + ((trow - NPROMPT) >> 10); }
__device__ __forceinline__ void rstd_table(PG8_LAS float* tab, const float* rsq, int row_start, int wr, int wc, int fr, int fq) {
    const int t = (wr * 4 + wc) * 64 + fq * 16 + fr;
    if (t < 256) tab[t] = row_rstd(rsq, row_start + t);
    asm volatile("s_waitcnt lgkmcnt(0)" ::: "memory"); __builtin_amdgcn_s_barrier(); asm volatile("" ::: "memory");
}
template <int ACT> struct EpiBf16 {
    static constexpr bool PERM = true, AFTER_DRAIN = false;
    bf16_t* O; int ldc; const float* bias; int split_cols; size_t split_stride; const float* rsq; const float* b2; int N; float* rsqv; int vt0; PG8_LAS float* tab;
    __device__ __forceinline__ void operator()(f32x4 (&acc)[2][2][4][2], const Unit& u, int wr, int wc, int fr, int fq) const {
        asm volatile("" : "+v"(fr), "+v"(fq));
        rstd_table(tab, rsq, u.pm * BM, wr, wc, fr, fq);
        const int lrow0 = wr * 64 + fr; int colt = u.pn * BM; bf16_t* base = O; int t = 0;
        if (split_cols) { t = colt / split_cols; base += (size_t)t * split_stride; colt -= t * split_cols; }
        const bool act = (ACT == 1) || (ACT == 2 && t == 0);
        const int col0 = colt + wc * 32 + 8 * fq, bcol0 = u.pn * BM + wc * 32 + 8 * fq;
        const float* b2p = b2 + (size_t)tile_cidx(u.pm * BM) * N + bcol0;
        const bool wantv = rsqv != nullptr && u.pn >= vt0;
        float ss[8];
#pragma unroll
        for (int i = 0; i < 8; ++i) ss[i] = 0.f;
#pragma unroll
        for (int bj = 0; bj < 2; ++bj) { f32x4 bv0 = *(const GAS f32x4*)(b2p + bj * HALF), bv1 = *(const GAS f32x4*)(b2p + bj * HALF + 4);
            if (bias) { bv0 += *(const GAS f32x4*)(bias + bcol0 + bj * HALF); bv1 += *(const GAS f32x4*)(bias + bcol0 + bj * HALF + 4); }
#pragma unroll
            for (int ai = 0; ai < 2; ++ai)
#pragma unroll
                for (int m = 0; m < 4; ++m) { const int lrow = lrow0 + ai * HALF + m * 16; const float rs = tab[lrow];
                    f32x4 v0 = acc[ai][bj][m][0] * rs + bv0, v1 = acc[ai][bj][m][1] * rs + bv1;
                    if (ACT != 0) { if (act) { v0 = gelu4(v0); v1 = gelu4(v1); } }
                    ss[ai * 4 + m] += (v0[0] * v0[0] + v0[1] * v0[1]) + (v0[2] * v0[2] + v0[3] * v0[3]) + (v1[0] * v1[0] + v1[1] * v1[1]) + (v1[2] * v1[2] + v1[3] * v1[3]);
                    u32x4 w; w.x = cvt_pk_bf16(v0[0], v0[1]); w.y = cvt_pk_bf16(v0[2], v0[3]); w.z = cvt_pk_bf16(v1[0], v1[1]); w.w = cvt_pk_bf16(v1[2], v1[3]);
                    *(GAS u32x4*)(base + (size_t)(u.pm * BM + lrow) * ldc + col0 + bj * HALF) = w; } }
        if (wantv) {
#pragma unroll
            for (int i = 0; i < 8; ++i) { float q = ss[i]; q = sum_q4(q);
                if (fq == 0) *(GAS float*)(rsqv + (size_t)(u.pm * BM + lrow0 + (i >> 2) * HALF + (i & 3) * 16) * 32 + (u.pn - vt0) * 4 + wc) = q; } }
    }
};
struct EpiResid {
    static constexpr bool PERM = true, AFTER_DRAIN = false;
    float* out; const float* xp; const float* xs; const float* modl; int which; bool from_input;
    bf16_t* H; const float* ng; const float* modn; int whichs; float* rsq_out;
    __device__ __forceinline__ void operator()(f32x4 (&acc)[2][2][4][2], const Unit& u, int wr, int wc, int fr, int fq) const {
        asm volatile("" : "+v"(fr), "+v"(fq));
        const int trow = u.pm * BM, row0 = wr * 64 + fr, col0 = u.pn * BM + wc * 32 + 8 * fq, ci = tile_cidx(trow);
        const GAS float* gpg = (const GAS float*)(modl + (size_t)(ci * 6 + which) * D + col0);
        const GAS float* bpg = (const GAS float*)(from_input ? (trow < NPROMPT ? xp + (size_t)trow * D : xs + (size_t)(trow - NPROMPT) * D) : out + (size_t)trow * D);
        GAS float* op = (GAS float*)(out + (size_t)trow * D);
        float ss[8];
#pragma unroll
        for (int i = 0; i < 8; ++i) ss[i] = 0.f;
#pragma unroll
        for (int bj = 0; bj < 2; ++bj) {
            const f32x4 gv0 = *(const GAS f32x4*)(gpg + bj * HALF), gv1 = *(const GAS f32x4*)(gpg + bj * HALF + 4);
            f32x4 gs0 = {0.f, 0.f, 0.f, 0.f}, gs1 = {0.f, 0.f, 0.f, 0.f};
            if (H) { const GAS float* sp = (const GAS float*)(modn + (size_t)(ci * 6 + whichs) * D + col0 + bj * HALF); const GAS float* np = (const GAS float*)(ng + col0 + bj * HALF);
                gs0 = *(const GAS f32x4*)np * (1.f + *(const GAS f32x4*)sp); gs1 = *(const GAS f32x4*)(np + 4) * (1.f + *(const GAS f32x4*)(sp + 4)); }
#pragma unroll
            for (int ai = 0; ai < 2; ++ai)
#pragma unroll
                for (int m = 0; m < 4; ++m) { const int lrow = row0 + ai * HALF + m * 16; const size_t off = (size_t)lrow * D + col0 + bj * HALF;
                    f32x4 x0 = *(const GAS f32x4*)(bpg + off), x1 = *(const GAS f32x4*)(bpg + off + 4);
                    x0 += gv0 * acc[ai][bj][m][0]; x1 += gv1 * acc[ai][bj][m][1];
                    *(GAS f32x4*)(op + off) = x0; *(GAS f32x4*)(op + off + 4) = x1;
                    if (H) { ss[ai * 4 + m] += (x0[0] * x0[0] + x0[1] * x0[1]) + (x0[2] * x0[2] + x0[3] * x0[3]) + (x1[0] * x1[0] + x1[1] * x1[1]) + (x1[2] * x1[2] + x1[3] * x1[3]);
                        const f32x4 a0 = x0 * gs0, a1 = x1 * gs1;
                        u32x4 w; w.x = cvt_pk_bf16(a0[0], a0[1]); w.y = cvt_pk_bf16(a0[2], a0[3]); w.z = cvt_pk_bf16(a1[0], a1[1]); w.w = cvt_pk_bf16(a1[2], a1[3]);
                        *(GAS u32x4*)(H + (size_t)(trow + lrow) * D + col0 + bj * HALF) = w; }
                    if (m & 1) asm volatile("" ::: "memory"); } }
        if (H) {
#pragma unroll
            for (int i = 0; i < 8; ++i) { float q = ss[i]; q = sum_q4(q);
                if (fq == 0) *(GAS float*)(rsq_out + (size_t)(trow + row0 + (i >> 2) * HALF + (i & 3) * 16) * 16 + u.pn * 4 + wc) = q; } }
    }
};

__device__ __forceinline__ void ffn_tile_geom(int pm, int& rs, int& vlo, int& vhi) {
    if (pm < 32) { rs = 256 * pm; vlo = 0; vhi = 255; }
    else { const int sq = (pm - 32) / 5, i = (pm - 32) % 5; rs = NPROMPT + 1024 * sq + (i < 4 ? 254 * i : 768); vlo = i == 0 ? 0 : (i < 4 ? 1 : 249); vhi = i < 4 ? 254 : 255; }
}
struct FfnOrder : StaticOrder {
    __device__ __forceinline__ int arow(int pm) const { int rs, a, b; ffn_tile_geom(pm, rs, a, b); return rs; }
};
__device__ __forceinline__ float dpp_prev(float oldv, float v) {
    return __builtin_bit_cast(float, __builtin_amdgcn_update_dpp(__builtin_bit_cast(int, oldv), __builtin_bit_cast(int, v), 0x111, 0xf, 0xf, false)); }
__device__ __forceinline__ float dpp_next(float oldv, float v) {
    return __builtin_bit_cast(float, __builtin_amdgcn_update_dpp(__builtin_bit_cast(int, oldv), __builtin_bit_cast(int, v), 0x101, 0xf, 0xf, false)); }
__device__ __forceinline__ float dpp_ror1(float v) { return __builtin_bit_cast(float, __builtin_amdgcn_update_dpp(0, __builtin_bit_cast(int, v), 0x121, 0xf, 0xf, false)); }
__device__ __forceinline__ float dpp_ror15(float v) { return __builtin_bit_cast(float, __builtin_amdgcn_update_dpp(0, __builtin_bit_cast(int, v), 0x12F, 0xf, 0xf, false)); }
struct EpiFfn {
    static constexpr bool PERM = true, AFTER_DRAIN = false;
    bf16_t* ACT; const float* cw; const float* cb; PG8_LAS float* xb; const float* rsq; const float* b2;
    __device__ __forceinline__ void operator()(f32x4 (&acc)[2][2][4][2], const Unit& u, int wr, int wc, int fr, int fq) const {
        asm volatile("" : "+v"(fr), "+v"(fq));
        int rs, vlo, vhi; ffn_tile_geom(u.pm, rs, vlo, vhi);
        const int colw = wc * 32 + 8 * fq;
        rstd_table(xb + 2048, rsq, rs, wr, wc, fr, fq);
        { const float* b2p = b2 + (size_t)tile_cidx(rs) * 2 * DFF + u.pn * 256 + colw;
#pragma unroll
          for (int bj = 0; bj < 2; ++bj) { const f32x4 bz0 = *(const GAS f32x4*)(b2p + bj * 128), bz1 = *(const GAS f32x4*)(b2p + bj * 128 + 4);
#pragma unroll
              for (int ai = 0; ai < 2; ++ai)
#pragma unroll
                  for (int m = 0; m < 4; ++m) { const float rsd = xb[2048 + 128 * ai + 64 * wr + 16 * m + fr];
                      acc[ai][bj][m][0] = acc[ai][bj][m][0] * rsd + bz0; acc[ai][bj][m][1] = acc[ai][bj][m][1] * rsd + bz1; } } }
#pragma unroll
        for (int ai = 0; ai < 2; ++ai) { const int b = 2 * ai + wr;
            if (fr == 0) {
#pragma unroll
                for (int bj = 0; bj < 2; ++bj)
#pragma unroll
                    for (int n = 0; n < 2; ++n) *(PG8_LAS f32x4*)(xb + (b * 2 + 0) * 256 + bj * 128 + colw + 4 * n) = acc[ai][bj][0][n]; }
            if (fr == 15) {
#pragma unroll
                for (int bj = 0; bj < 2; ++bj)
#pragma unroll
                    for (int n = 0; n < 2; ++n) *(PG8_LAS f32x4*)(xb + (b * 2 + 1) * 256 + bj * 128 + colw + 4 * n) = acc[ai][bj][3][n]; } }
        asm volatile("s_waitcnt lgkmcnt(0)" ::: "memory"); __builtin_amdgcn_s_barrier(); asm volatile("" ::: "memory");
        GAS unsigned char* actb = (GAS unsigned char*)ACT;
        const unsigned lane_off = (unsigned)((rs + 64 * wr + fr) * DFF + u.pn * 128 + colw) * 2u;
#pragma unroll
        for (int n = 0; n < 2; ++n) {
            const int ch = u.pn * 128 + colw + 4 * n;
            f32x4 wg[3], wu[3];
#pragma unroll
            for (int k = 0; k < 3; ++k) { wg[k] = *(const GAS f32x4*)(cw + (size_t)k * 2 * DFF + ch); wu[k] = *(const GAS f32x4*)(cw + (size_t)k * 2 * DFF + DFF + ch); }
            const f32x4 bgv = *(const GAS f32x4*)(cb + ch), buv = *(const GAS f32x4*)(cb + DFF + ch);
#pragma unroll
            for (int ai = 0; ai < 2; ++ai) { const int b = 2 * ai + wr;
                f32x4 pz[2], nz[2];
#pragma unroll
                for (int bj = 0; bj < 2; ++bj) { pz[bj] = b > 0 ? *(PG8_LAS const f32x4*)(xb + ((b - 1) * 2 + 1) * 256 + bj * 128 + colw + 4 * n) : (f32x4){0.f, 0.f, 0.f, 0.f};
                                                 nz[bj] = b < 3 ? *(PG8_LAS const f32x4*)(xb + ((b + 1) * 2 + 0) * 256 + bj * 128 + colw + 4 * n) : (f32x4){0.f, 0.f, 0.f, 0.f}; }
#pragma unroll
                for (int m = 0; m < 4; ++m) { f32x4 zc[2];
#pragma unroll
                    for (int bj = 0; bj < 2; ++bj) { const f32x4 z = acc[ai][bj][m][n]; const f32x4* w3 = bj == 0 ? wg : wu; f32x4 o = bj == 0 ? bgv : buv;
#pragma unroll
                        for (int e = 0; e < 4; ++e) { const float up = m > 0 ? dpp_ror1(acc[ai][bj][m - 1][n][e]) : pz[bj][e], dn = m < 3 ? dpp_ror15(acc[ai][bj][m + 1][n][e]) : nz[bj][e];
                            o[e] += w3[0][e] * dpp_prev(up, z[e]) + w3[1][e] * z[e] + w3[2][e] * dpp_next(dn, z[e]); }
                        zc[bj] = o; }
                    const int lr = 128 * ai + 64 * wr + 16 * m + fr;
                    if (lr >= vlo && lr <= vhi) { u32x2 w; w.x = cvt_pk_bf16(siluf_(zc[0][0]) * zc[1][0], siluf_(zc[0][1]) * zc[1][1]); w.y = cvt_pk_bf16(siluf_(zc[0][2]) * zc[1][2], siluf_(zc[0][3]) * zc[1][3]);
                        *(GAS u32x2*)(actb + (lane_off + (unsigned)((128 * ai + 16 * m) * DFF + 4 * n) * 2u)) = w; } }
                asm volatile("" ::: "memory"); }
        }
    }
};
}

struct Params { const float* in[N_IN]; float* out; unsigned char* ws; };
struct Frame {
    LAS unsigned char* lds; int tid, lane, wave, bid, G, wave0;
    float* out; unsigned char* ws; float* out0; unsigned char* ws0;
    __device__ __forceinline__ const float* inp(int i) const { const unsigned long long v = ((LAS const unsigned long long*)(lds + PTR_OFF))[i];
        const unsigned lo = __builtin_amdgcn_readfirstlane((unsigned)v), hi = __builtin_amdgcn_readfirstlane((unsigned)(v >> 32)); return (const float*)(const GAS float*)(((unsigned long long)hi << 32) | lo); }
    float* mod; float* rstd; float* rope; bf16 *H, *T1, *T2, *T3, *KS, *VS, *WT; float *rsq0, *rsq1, *rsqv, *bias2;
    __device__ __forceinline__ void fresh() {
        int z = 0; asm volatile("" : "+v"(z));
        lane = __builtin_amdgcn_mbcnt_hi(~0u, __builtin_amdgcn_mbcnt_lo(~0u, z)); int wv = wave0; asm volatile("" : "+s"(wv)); wave = wv; tid = wv * 64 + lane;
        int b = blockIdx.x; asm volatile("" : "+s"(b)); bid = b;
        unsigned char* w = ws0; asm volatile("" : "+s"(w)); w = (unsigned char*)(GAS unsigned char*)(unsigned long long)w; ws = w; float* o = out0; asm volatile("" : "+s"(o)); o = (float*)(GAS float*)(unsigned long long)o; out = o;
        mod = (float*)(w + WS_MOD); rstd = (float*)(w + WS_RSTD); rope = (float*)(w + WS_ROPE);
        H = (bf16*)(w + WS_H); T1 = (bf16*)(w + WS_T1); T2 = (bf16*)(w + WS_T2); T3 = (bf16*)(w + WS_T3); KS = (bf16*)(w + WS_KS); VS = (bf16*)(w + WS_VS); WT = (bf16*)(w + WS_W);
        rsq0 = (float*)(w + WS_X); rsq1 = (float*)(w + WS_X + MiB); rsqv = (float*)(w + WS_X + 2 * MiB); bias2 = (float*)(w + WS_X + 4 * MiB);
    }
};
__device__ __forceinline__ const float* xin_row(const Frame& F, int row) { return row < NPROMPT ? F.inp(I_XP) + (size_t)row * D : F.inp(I_XS) + (size_t)(row - NPROMPT) * D; }
__device__ __forceinline__ int cidx_of(int row) { return row < NPROMPT ? 0 : 1 + ((row - NPROMPT) >> 10); }
__device__ __forceinline__ const float* modp(const Frame& F, int l, int row, int which) { return F.mod + (size_t)((l * 3 + cidx_of(row)) * 6 + which) * D; }


template <int MODE  >
__device__ __forceinline__ void transpose_item(const float* W, int K, int N, bf16* WT, LAS float* scr, int item, int lane) {
    const int nblk = N / 32, kb = item / nblk, nb = item % nblk, k0 = 64 * kb, n0 = 32 * nb;
    int d0 = n0; if (MODE == 1) { const int isu = n0 >= DFF, jj = n0 - isu * DFF; d0 = (jj >> 7) * 256 + isu * 128 + (jj & 127); }
#pragma unroll 8
    for (int i = 0; i < 32; ++i) { const int kk = 2 * i + (lane >> 5); scr[kk * 33 + (lane & 31)] = W[(size_t)(k0 + kk) * N + n0 + (lane & 31)]; }
    asm volatile("s_waitcnt lgkmcnt(0)" ::: "memory");
    const int c = lane & 7;
#pragma unroll
    for (int j = 0; j < 4; ++j) { const int n = (lane >> 3) + 8 * j; const LAS float* sp = scr + (8 * c) * 33 + n;
        u32x4 o; o.x = f2bf(sp[0 * 33]) | (f2bf(sp[1 * 33]) << 16); o.y = f2bf(sp[2 * 33]) | (f2bf(sp[3 * 33]) << 16); o.z = f2bf(sp[4 * 33]) | (f2bf(sp[5 * 33]) << 16); o.w = f2bf(sp[6 * 33]) | (f2bf(sp[7 * 33]) << 16);
        *(u32x4*)(WT + (size_t)(d0 + n) * K + k0 + 8 * c) = o; }
    asm volatile("s_waitcnt lgkmcnt(0)" ::: "memory");
}
template <int MODE = 0>
__device__ __forceinline__ bool transpose_group(int& r, const float* W, int nmat, int K, int N, bf16* WT, LAS float* scr, int lane) {
    const int per = (K / 64) * (N / 32), tot = nmat * per;
    if (r >= tot) { r -= tot; return false; }
    const int mi = r / per; transpose_item<MODE>(W + (size_t)mi * K * N, K, N, WT + (size_t)mi * K * N, scr, r % per, lane); return true;
}
__device__ __forceinline__ void phase_prologue(Frame& F) {
    F.fresh();
    LAS float* sc = (LAS float*)F.lds;
    const float* c = F.inp(I_C); const float* cctx = F.inp(I_CCTX);
    for (int i = F.tid; i < 3 * D; i += NT) { const int ci = i >> 10, k = i & 1023; const float v = ci == 0 ? cctx[k] : c[(ci - 1) * D + k]; sc[i] = siluf_(v); }
    __syncthreads();
    LAS float* part = sc + 3 * D;
    const int kp = F.tid >> 6, cl = F.tid & 63;
    for (int item = F.bid; item < DEPTH * 6 * D / 64; item += F.G) {
        const int col = item * 64 + cl, l = col / (6 * D), cc = col % (6 * D);
        const float* w = F.inp(I_WMOD) + (size_t)l * D * 6 * D + cc;
        float s0 = 0.f, s1 = 0.f, s2 = 0.f;
        for (int k = kp * 128; k < kp * 128 + 128; ++k) { const float wv = w[(size_t)k * 6 * D]; s0 += sc[k] * wv; s1 += sc[D + k] * wv; s2 += sc[2 * D + k] * wv; }
        part[(kp * 3 + 0) * 64 + cl] = s0; part[(kp * 3 + 1) * 64 + cl] = s1; part[(kp * 3 + 2) * 64 + cl] = s2;
        __syncthreads();
        if (F.tid < 192) { const int ci = F.tid >> 6; float s = F.inp(I_BMOD)[l * 6 * D + cc];
            for (int q = 0; q < 8; ++q) s += part[(q * 3 + ci) * 64 + cl];
            F.mod[(size_t)((l * 3 + ci) * 6) * D + cc] = s; }
        __syncthreads();
    }
    { __syncthreads();
      LAS float* scr = (LAS float*)(F.lds + F.wave * 16384);
      const int gw = F.bid * NWAVES + F.wave, NGW = F.G * NWAVES;
      constexpr int NITEMS = (int)(WE_END / 2048);
      for (int it = gw; it < NITEMS; it += NGW) { int r = it;
          if (transpose_group<1>(r, F.inp(I_FF_WUP), 4, D, 2 * DFF, F.WT + WE_UP, scr, F.lane)) continue;
          if (transpose_group(r, F.inp(I_FF_WDN), 4, DFF, D, F.WT + WE_DN, scr, F.lane)) continue;
          if (transpose_group(r, F.inp(I_LRU_WIN), 2, D, 2 * DRNN, F.WT + WE_LRU_IN, scr, F.lane)) continue;
          if (transpose_group(r, F.inp(I_LRU_WOUT), 2, DRNN, D, F.WT + WE_LRU_OUT, scr, F.lane)) continue;
          if (transpose_group(r, F.inp(I_CM_WIN), 1, D, 2 * DB, F.WT + WE_CM_IN, scr, F.lane)) continue;
          if (transpose_group(r, F.inp(I_CM_WOUT), 1, DB, D, F.WT + WE_CM_OUT, scr, F.lane)) continue;
          if (transpose_group(r, F.inp(I_AT_WQKV), 1, D, 3 * D, F.WT + WE_QKV, scr, F.lane)) continue;
          if (transpose_group(r, F.inp(I_AT_WOUT), 1, D, D, F.WT + WE_AT_OUT, scr, F.lane)) continue;
          transpose_group(r, F.inp(I_LRU_WG), 80, 128, 128, F.WT + WE_WG, scr, F.lane); } }
    const int gt = F.bid * NT + F.tid, GT = F.G * NT;
    for (int i = gt; i < 1024 * 32; i += GT) { const int t = i >> 5, j = i & 31; const float inv = powf(10000.f, -(float)(j & 15) / 16.f); const float pos = (float)(j < 16 ? (t >> 6) : (t & 63));
        const float ang = pos * inv; F.rope[i] = cosf(ang); F.rope[32768 + i] = sinf(ang); }
    for (int i = gt; i < 8 * 8 * 4 * 64; i += GT) { const int ln = i & 63, ks = (i >> 6) & 3, nf = (i >> 8) & 7, g = i >> 11, cq = ln >> 4, p = 16 * nf + (ln & 15);
        const float* wr = F.inp(I_CM_WS) + (size_t)(g * 128 + p) * 128 + 32 * ks + 4 * cq;
        u32x4 o; o.x = f2bf(wr[0]) | (f2bf(wr[1]) << 16); o.y = f2bf(wr[2]) | (f2bf(wr[3]) << 16); o.z = f2bf(wr[16]) | (f2bf(wr[17]) << 16); o.w = f2bf(wr[18]) | (f2bf(wr[19]) << 16);
        *(u32x4*)(F.WT + WE_WSB + (size_t)i * 8) = o; }
    for (int i = gt; i < 2 * PAST * D; i += GT) { const int b = i / (PAST * D), r = i % (PAST * D);
        F.KS[(size_t)b * TKS * D + r] = (bf16)f2bf(F.inp(I_CK)[i]); F.VS[(size_t)b * TKS * D + r] = (bf16)f2bf(F.inp(I_CV)[i]); }
}

__device__ __forceinline__ void bias2_gemm(Frame& F, const bf16* Wt, int N, int l, int sub, float* outp) {
    const int gw = F.bid * NWAVES + F.wave, NGW = F.G * NWAVES;
    float sh[3][16];
#pragma unroll
    for (int ci = 0; ci < 3; ++ci) { const GAS f32x4* sp = (const GAS f32x4*)(F.mod + (size_t)((l * 3 + ci) * 6 + sub * 3) * D + 16 * F.lane);
#pragma unroll
        for (int i = 0; i < 4; ++i) { const f32x4 v = sp[i]; sh[ci][4 * i] = v.x; sh[ci][4 * i + 1] = v.y; sh[ci][4 * i + 2] = v.z; sh[ci][4 * i + 3] = v.w; } }
    for (int n = gw; n < N; n += NGW) { const GAS u32x4* wp = (const GAS u32x4*)(Wt + (size_t)n * D + 16 * F.lane); const u32x4 w0 = wp[0], w1 = wp[1];
        const unsigned ww[8] = {w0.x, w0.y, w0.z, w0.w, w1.x, w1.y, w1.z, w1.w};
        float d0 = 0.f, d1 = 0.f, d2 = 0.f;
#pragma unroll
        for (int i = 0; i < 8; ++i) { const float lo = bf2f(ww[i]), hi = bf2f(ww[i] >> 16); d0 += sh[0][2 * i] * lo + sh[0][2 * i + 1] * hi; d1 += sh[1][2 * i] * lo + sh[1][2 * i + 1] * hi; d2 += sh[2][2 * i] * lo + sh[2][2 * i + 1] * hi; }
        d0 = wave_sum(d0); d1 = wave_sum(d1); d2 = wave_sum(d2);
        if (F.lane == 0) { outp[n] = d0; outp[(size_t)N + n] = d1; outp[(size_t)2 * N + n] = d2; } }
}
__device__ __forceinline__ void phase_modulate0(Frame& F) {
    F.fresh();
    const int gw = F.bid * NWAVES + F.wave, NGW = F.G * NWAVES;
    const float* g = F.inp(I_NORMG);
    for (int row = gw; row < M; row += NGW) {
        const float* xr = xin_row(F, row); const float* scl = modp(F, 0, row, 1);
        f32x4 v[4]; float s = 0.f;
#pragma unroll
        for (int j = 0; j < 4; ++j) { v[j] = *(const GAS f32x4*)(xr + 4 * F.lane + 256 * j); s += v[j].x * v[j].x + v[j].y * v[j].y + v[j].z * v[j].z + v[j].w * v[j].w; }
        s = wave_sum(s);
        if (F.lane < 16) F.rsq0[(size_t)row * 16 + F.lane] = F.lane == 0 ? s : 0.f;
#pragma unroll
        for (int j = 0; j < 4; ++j) { const int c0 = 4 * F.lane + 256 * j; const f32x4 gg = *(const GAS f32x4*)(g + c0), c4 = *(const GAS f32x4*)(scl + c0);
            const f32x4 o = v[j] * gg * (1.f + c4); u32x2 w; w.x = f2bf(o.x) | (f2bf(o.y) << 16); w.y = f2bf(o.z) | (f2bf(o.w) << 16);
            *(GAS u32x2*)(F.H + (size_t)row * D + c0) = w; }
    }
    bias2_gemm(F, F.WT + WE_LRU_IN, 2 * DRNN, 0, 0, F.bias2 + B2_LRU);
    bias2_gemm(F, F.WT + WE_LRU_IN + (size_t)2 * DRNN * D, 2 * DRNN, 3, 0, F.bias2 + B2_LRU + 3 * 2560);
    bias2_gemm(F, F.WT + WE_CM_IN, 2 * DB, 1, 0, F.bias2 + B2_CM);
    bias2_gemm(F, F.WT + WE_QKV, 3 * D, 2, 0, F.bias2 + B2_QKV);
#pragma unroll 1
    for (int l = 0; l < DEPTH; ++l) bias2_gemm(F, F.WT + WE_UP + (size_t)l * 2 * DFF * D, 2 * DFF, l, 1, F.bias2 + B2_UP + (size_t)l * 3 * 5632);
}

template <class P>
__device__ __forceinline__ void gemm_naive(Frame& F, const P& p, int nbatch, int Mr, int N, int K) {
    F.fresh();
    LAS float* As = (LAS float*)F.lds;
    LAS float* Bs = As + 16 * 132;
    const int tid = F.tid, tx = tid & 31, ty = tid >> 5;
    const int tm = Mr / 128, tn = N / 128, per = tm * tn, total = per * nbatch;
    for (int t = F.bid; t < total; t += F.G) {
        const int b = t / per, r = t % per, pn = r / tm, pm = r % tm;
        const bf16* A; int lda; const float* W; int ldw; p.get(b, A, lda, W, ldw);
        float acc[8][4];
#pragma unroll
        for (int i = 0; i < 8; ++i)
#pragma unroll
            for (int j = 0; j < 4; ++j) acc[i][j] = 0.f;
        for (int k0 = 0; k0 < K; k0 += 16) {
            { const int row = tid >> 2, kq = (tid & 3) * 4;
              const u32x2 v = *(const u32x2*)(A + (size_t)(pm * 128 + row) * lda + k0 + kq);
              As[(kq + 0) * 132 + row] = bf2f(v.x); As[(kq + 1) * 132 + row] = bf2f(v.x >> 16); As[(kq + 2) * 132 + row] = bf2f(v.y); As[(kq + 3) * 132 + row] = bf2f(v.y >> 16); }
            { const int k = tid >> 5, n4 = (tid & 31) * 4;
              *(LAS f32x4*)(Bs + k * 128 + n4) = *(const f32x4*)(W + (size_t)(k0 + k) * ldw + pn * 128 + n4); }
            __syncthreads();
#pragma unroll 2
            for (int k = 0; k < 16; ++k) {
                const f32x4 a0 = *(const LAS f32x4*)(As + k * 132 + ty * 8), a1 = *(const LAS f32x4*)(As + k * 132 + ty * 8 + 4), bv = *(const LAS f32x4*)(Bs + k * 128 + tx * 4);
                const float a[8] = {a0.x, a0.y, a0.z, a0.w, a1.x, a1.y, a1.z, a1.w}; const float bb[4] = {bv.x, bv.y, bv.z, bv.w};
#pragma unroll
                for (int i = 0; i < 8; ++i)
#pragma unroll
                    for (int j = 0; j < 4; ++j) acc[i][j] += a[i] * bb[j];
            }
            __syncthreads();
        }
#pragma unroll
        for (int i = 0; i < 8; ++i)
#pragma unroll
            for (int j = 0; j < 4; ++j) p.epi(b, pm * 128 + ty * 8 + i, pn * 128 + tx * 4 + j, acc[i][j]);
    }
}

struct PStoreBf16 {
    const bf16* A; int lda; const float* W; int ldw; bf16* O; int ldo; const float* bias; int act; int split;
    __device__ __forceinline__ void get(int, const bf16*& a, int& la, const float*& w, int& lw) const { a = A; la = lda; w = W; lw = ldw; }
    __device__ __forceinline__ void epi(int, int row, int col, float v) const {
        if (bias) v += bias[col];
        if (act == 1 || (act == 2 && col < split)) v = gelu_tanh(v);
        O[(size_t)row * ldo + col] = (bf16)f2bf(v); }
};
struct PResid {
    const bf16* A; int lda; const float* W; int ldw; float* out; const float* xp; const float* xs; const float* modl; int which; bool from_input;
    __device__ __forceinline__ void get(int, const bf16*& a, int& la, const float*& w, int& lw) const { a = A; la = lda; w = W; lw = ldw; }
    __device__ __forceinline__ void epi(int, int row, int col, float v) const {
        const float base = from_input ? (row < NPROMPT ? xp[(size_t)row * D + col] : xs[(size_t)(row - NPROMPT) * D + col]) : out[(size_t)row * D + col];
        out[(size_t)row * D + col] = base + modl[(size_t)(cidx_of(row) * 6 + which) * D + col] * v; }
};
struct PLruIn {
    const bf16* A; const float* W; bf16* GBp; bf16* RECp;
    __device__ __forceinline__ void get(int, const bf16*& a, int& la, const float*& w, int& lw) const { a = A; la = D; w = W; lw = 2 * DRNN; }
    __device__ __forceinline__ void epi(int, int row, int col, float v) const {
        if (col < DRNN) GBp[(size_t)row * DRNN + col] = (bf16)f2bf(gelu_tanh(v)); else RECp[(size_t)row * DRNN + col - DRNN] = (bf16)f2bf(v); }
};
struct PGates {
    const bf16* XC; const float* WG; const float* BG; bf16* O;
    __device__ __forceinline__ void get(int b, const bf16*& a, int& la, const float*& w, int& lw) const { a = XC + (b % 10) * 128; la = DRNN; w = WG + (size_t)b * 128 * 128; lw = 128; }
    __device__ __forceinline__ void epi(int b, int row, int col, float v) const { const int dg = b / 10, n = b % 10;
        O[((size_t)dg * M + row) * DRNN + n * 128 + col] = (bf16)f2bf(sigmoidf_(v + BG[dg * DRNN + n * 128 + col])); }
};

__device__ __forceinline__ void phase_lru_conv(Frame& F, int j, const bf16* REC, bf16* XC) {
    F.fresh();
    const float* cw = F.inp(I_LRU_CW) + (size_t)j * 4 * DRNN; const float* cb = F.inp(I_LRU_CB) + (size_t)j * DRNN;
    const int gt = F.bid * NT + F.tid, GT = F.G * NT;
    for (int i = gt; i < M * DRNN; i += GT) { const int row = i / DRNN, ch = i % DRNN;
        int t, T; if (row < NPROMPT) { t = row & 255; T = 256; } else { t = (row - NPROMPT) & 1023; T = 1024; }
        float s = cb[ch];
#pragma unroll
        for (int k = 0; k < 4; ++k) { const int tt = t + k - 2; if (tt >= 0 && tt < T) s += cw[k * DRNN + ch] * bf2f(REC[(size_t)(row + k - 2) * DRNN + ch]); }
        XC[i] = (bf16)f2bf(s); }
}
__device__ __forceinline__ void phase_lru_scan(Frame& F, int j, const bf16* GATES, const bf16* XC, const bf16* GB, bf16* HS) {
    F.fresh();
    const int gt = F.bid * NT + F.tid, GT = F.G * NT;
    const int NL = (2 + 32) * DRNN;
    for (int line = gt; line < NL; line += GT) {
        const int s = line / DRNN, ch = line % DRNN;
        int base, T; float h0f = 0.f, h0b = 0.f;
        if (s < 2) { base = NPROMPT + s * 1024; T = 1024; h0f = F.inp(I_STATE)[((size_t)(s * 2 + j) * 2 + 0) * DRNN + ch]; h0b = F.inp(I_STATE)[((size_t)(s * 2 + j) * 2 + 1) * DRNN + ch]; }
        else { base = (s - 2) * 256; T = 256; }
        const float spf = softplusf_(-F.inp(I_LRU_LAM)[(size_t)(j * 2 + 0) * DRNN + ch]), spb = softplusf_(-F.inp(I_LRU_LAM)[(size_t)(j * 2 + 1) * DRNN + ch]);
        float h = h0f;
        for (int t = 0; t < T; ++t) { const size_t o = (size_t)(base + t) * DRNN + ch;
            const float r = bf2f(GATES[o]), ig = bf2f(GATES[(size_t)M * DRNN + o]), xc = bf2f(XC[o]);
            const float la = -8.f * r * spf, a = expf(la), bx = sqrtf(-expm1f(2.f * la)) * (ig * xc);
            h = a * h + bx; HS[o] = (bf16)f2bf(h); }
        const float ff = h;
        h = h0b;
        for (int t = T - 1; t >= 0; --t) { const size_t o = (size_t)(base + t) * DRNN + ch;
            const float r = bf2f(GATES[(size_t)2 * M * DRNN + o]), ig = bf2f(GATES[(size_t)3 * M * DRNN + o]), xc = bf2f(XC[o]);
            const float la = -8.f * r * spb, a = expf(la), bx = sqrtf(-expm1f(2.f * la)) * (ig * xc);
            h = a * h + bx; HS[o] = (bf16)f2bf(bf2f(GB[o]) * (bf2f(HS[o]) + h)); }
        if (s >= 2) { float* st = F.out + O_STATE + ((size_t)((s - 2) * 2 + j) * 2) * DRNN; st[ch] = ff; st[DRNN + ch] = h; }
    }
}


typedef short bf16x8 __attribute__((ext_vector_type(8)));
typedef short v4i16_t __attribute__((ext_vector_type(4)));
constexpr int LRU_XS = 272;
constexpr int LRU_XC_OFF = 0, LRU_GB_OFF = 256 * LRU_XS;
template <bool REV>
__device__ __forceinline__ float lru_dir(LAS const unsigned char* xct, LAS unsigned char* hft, const bf16* wgt  ,
                                         const bf16* gbp  , float br, float bi, float sp, float hc, int wave, int lane, bool wantp, bf16* Pdst) {
    const int c = lane & 15, q = lane >> 4, qq = REV ? 3 - q : q;
    bf16x8 Br[4], Bi[4], Id;
#pragma unroll
    for (int ks = 0; ks < 4; ++ks) { Br[ks] = *(const GAS bf16x8*)(wgt + (size_t)(16 * wave + c) * 128 + 32 * ks + 8 * q);
                                     Bi[ks] = *(const GAS bf16x8*)(wgt + (size_t)10 * 128 * 128 + (size_t)(16 * wave + c) * 128 + 32 * ks + 8 * q); }
#pragma unroll
    for (int jj = 0; jj < 8; ++jj) Id[jj] = (8 * q + jj == 16 * (wave & 1) + c) ? (short)0x3F80 : (short)0;
    const int ksel = wave >> 1;
    const float nsp8 = -8.f * sp * 1.44269504f;
    float Pc = 1.f;
    unsigned short gcur[16], gnxt[16];
#pragma unroll
    for (int i = 0; i < 16; ++i) { gcur[i] = 0; gnxt[i] = 0; }
    if (REV) {
#pragma unroll
        for (int i = 0; i < 16; ++i) gcur[i] = *(const GAS unsigned short*)(gbp + (size_t)(16 * (12 + (i >> 2)) + 4 * q + (i & 3)) * DRNN); }
#pragma unroll 1
    for (int og = 0; og < 4; ++og) {
        if (REV && og < 3) {
#pragma unroll
            for (int i = 0; i < 16; ++i) gnxt[i] = *(const GAS unsigned short*)(gbp + (size_t)(16 * (4 * (2 - og) + (i >> 2)) + 4 * q + (i & 3)) * DRNN); }
#pragma unroll
        for (int ii = 0; ii < 4; ++ii) {
        const int it = 4 * og + ii, mi = REV ? 15 - it : it, mloc = REV ? 3 - ii : ii;
        LAS const unsigned char* rp = xct + (16 * mi + c) * LRU_XS + 16 * q;
        bf16x8 Af[4];
#pragma unroll
        for (int ks = 0; ks < 4; ++ks) Af[ks] = *(LAS const bf16x8*)(rp + 64 * ks);
        const bf16x8 Ax = *(LAS const bf16x8*)(rp + 64 * ksel);
        f32x4 r = {0.f, 0.f, 0.f, 0.f}, ig = {0.f, 0.f, 0.f, 0.f};
#pragma unroll
        for (int ks = 0; ks < 4; ++ks) { r = __builtin_amdgcn_mfma_f32_16x16x32_bf16(Af[ks], Br[ks], r, 0, 0, 0); ig = __builtin_amdgcn_mfma_f32_16x16x32_bf16(Af[ks], Bi[ks], ig, 0, 0, 0); }
        const f32x4 xc = __builtin_amdgcn_mfma_f32_16x16x32_bf16(Ax, Id, (f32x4){0.f, 0.f, 0.f, 0.f}, 0, 0, 0);
        float av[4], bv[4];
#pragma unroll
        for (int k = 0; k < 4; ++k) { const float rg = __builtin_amdgcn_rcpf(1.f + __builtin_amdgcn_exp2f(-1.44269504f * (r[k] + br))), iv = __builtin_amdgcn_rcpf(1.f + __builtin_amdgcn_exp2f(-1.44269504f * (ig[k] + bi)));
            const float l2a = nsp8 * rg, x = 1.38629436f * l2a;
            const float oms = -x * (1.f + x * (0.5f + x * (0.16666667f + x * (0.041666668f + x * 0.0083333338f))));
            const float om = x > -0.25f ? oms : 1.f - __builtin_amdgcn_exp2f(2.f * l2a);
            av[k] = __builtin_amdgcn_exp2f(l2a); bv[k] = __builtin_amdgcn_sqrtf(om) * (iv * xc[k]); }
        float pA[4], pB[4];
#pragma unroll
        for (int kk = 0; kk < 4; ++kk) { const int k = REV ? 3 - kk : kk;
            if (kk == 0) { pA[k] = av[k]; pB[k] = bv[k]; } else { const int kp = REV ? k + 1 : k - 1; pA[k] = pA[kp] * av[k]; pB[k] = pB[kp] * av[k] + bv[k]; } }
        const int kl = REV ? 0 : 3;
        float gA[4], gB[4];
#pragma unroll
        for (int g = 0; g < 4; ++g) { const int src = 16 * (REV ? 3 - g : g) + c; gA[g] = bperm(pA[kl], src); gB[g] = bperm(pB[kl], src); }
        float eA = 1.f, eB = 0.f, tA = 1.f, tB = 0.f;
#pragma unroll
        for (int g = 0; g < 4; ++g) { if (g == qq) { eA = tA; eB = tB; } tB = tB * gA[g] + gB[g]; tA = tA * gA[g]; }
        const float hin = eA * hc + eB;
#pragma unroll
        for (int k = 0; k < 4; ++k) { const float h = pA[k] * hin + pB[k]; const int row = 16 * mi + 4 * q + k;
            if (wantp) Pdst[(size_t)row * DRNN] = (bf16)f2bf(pA[k] * eA * Pc);
            LAS unsigned short* hp = (LAS unsigned short*)(hft + row * LRU_XS + 2 * (16 * wave + c));
            if (!REV) *hp = (unsigned short)f2bf(h); else *hp = (unsigned short)f2bf(bf2f(gcur[4 * mloc + k]) * (bf2f(*hp) + h)); }
        hc = tA * hc + tB; Pc *= tA;
        }
        if (REV) {
#pragma unroll
            for (int i = 0; i < 16; ++i) gcur[i] = gnxt[i]; }
    }
    return hc;
}
__device__ __forceinline__ void lru_unit(Frame& F, int j, int pm, int n, const bf16* REC, const bf16* GB, bf16* HS, bf16* PF, bf16* PB, float* AGG, const bf16* WGT) {
    const int tid = F.tid, lane = F.lane, wave = F.wave, r0 = 256 * pm;
    const bool smp = pm >= 32; const int tix = smp ? (pm - 32) & 3 : 0, sq = smp ? (pm - 32) >> 2 : 0;
    const int t0 = smp ? 256 * tix : 0, T = smp ? 1024 : 256;
    LAS unsigned char* xct = F.lds + LRU_XC_OFF; LAS unsigned char* hft = F.lds + LRU_GB_OFF;
    { const float* cw = F.inp(I_LRU_CW) + (size_t)j * 4 * DRNN + n * 128 + 2 * lane; const float* cb = F.inp(I_LRU_CB) + (size_t)j * DRNN + n * 128 + 2 * lane;
      float w0[4], w1[4];
#pragma unroll
      for (int k = 0; k < 4; ++k) { w0[k] = cw[k * DRNN]; w1[k] = cw[k * DRNN + 1]; }
      const float b0 = cb[0], b1 = cb[1];
      unsigned v[35];
#pragma unroll
      for (int i = 0; i < 35; ++i) { const int tl = 32 * wave + i - 2, tt = t0 + tl;
          v[i] = (tt >= 0 && tt < T) ? *(const GAS unsigned*)(REC + (size_t)(r0 + tl) * DRNN + n * 128 + 2 * lane) : 0u; }
#pragma unroll
      for (int i = 0; i < 32; ++i) { float s0 = b0, s1 = b1;
#pragma unroll
          for (int k = 0; k < 4; ++k) { s0 += w0[k] * bf2f(v[i + k]); s1 += w1[k] * bf2f(v[i + k] >> 16); }
          *(LAS unsigned*)(xct + (32 * wave + i) * LRU_XS + 4 * lane) = f2bf(s0) | (f2bf(s1) << 16); } }
    __syncthreads();
    const int c = lane & 15, q = lane >> 4, ch = n * 128 + 16 * wave + c;
    const float* bg = F.inp(I_LRU_BG) + (size_t)j * 4 * DRNN; const float* lam = F.inp(I_LRU_LAM) + (size_t)j * 2 * DRNN;
    const bf16* gbp = GB + (size_t)r0 * DRNN + ch;
    bf16* pf = PF + (size_t)(smp ? r0 - NPROMPT : 0) * DRNN + ch; bf16* pb = PB + (size_t)(smp ? r0 - NPROMPT : 0) * DRNN + ch;
    { float h0 = 0.f; if (smp && tix == 0) h0 = F.inp(I_STATE)[((size_t)(sq * 2 + j) * 2 + 0) * DRNN + ch];
      const float hfin = lru_dir<false>(xct, hft, WGT + (size_t)(0 * 10 + n) * 128 * 128, gbp, bg[0 * DRNN + ch], bg[1 * DRNN + ch], softplusf_(-lam[ch]), h0, wave, lane, smp, pf);
      if (q == 0) { if (smp) AGG[(size_t)((sq * 4 + tix) * 2 + 0) * DRNN + ch] = hfin; else F.out[O_STATE + ((size_t)(pm * 2 + j) * 2 + 0) * DRNN + ch] = hfin; } }
    { float h0 = 0.f; if (smp && tix == 3) h0 = F.inp(I_STATE)[((size_t)(sq * 2 + j) * 2 + 1) * DRNN + ch];
      const float hfin = lru_dir<true>(xct, hft, WGT + (size_t)(2 * 10 + n) * 128 * 128, gbp, bg[2 * DRNN + ch], bg[3 * DRNN + ch], softplusf_(-lam[DRNN + ch]), h0, wave, lane, smp, pb);
      if (q == 0) { if (smp) AGG[(size_t)((sq * 4 + tix) * 2 + 1) * DRNN + ch] = hfin; else F.out[O_STATE + ((size_t)(pm * 2 + j) * 2 + 1) * DRNN + ch] = hfin; } }
    __syncthreads();
#pragma unroll
    for (int i = 0; i < 8; ++i) { const int id = i * NT + tid, row = id >> 4, cc = id & 15;
        *(GAS u32x4*)(HS + (size_t)(r0 + row) * DRNN + n * 128 + 8 * cc) = *(LAS const u32x4*)(hft + row * LRU_XS + 16 * cc); }
    __syncthreads();
}
__device__ __forceinline__ void phase_lru_core(Frame& F, int j, const bf16* REC, const bf16* GB, bf16* HS, bf16* PF, bf16* PB, float* AGG, const bf16* WGT) {
    F.fresh();
    for (int u = F.bid; u < 400; u += F.G) {
        const int pm = u < 80 ? 32 + u / 10 : (u - 80) / 10, n = u % 10;
        lru_unit(F, j, pm, n, REC, GB, HS, PF, PB, AGG, WGT); }
}
__device__ __forceinline__ void phase_lru_fixup(Frame& F, const bf16* GB, bf16* HS, const bf16* PF, const bf16* PB, const float* AGG) {
    F.fresh();
    const int gt = F.bid * NT + F.tid, GT = F.G * NT;
    for (int i = gt; i < NSAMPLE * DRNN; i += GT) { const int rs = i / DRNN, ch = i % DRNN, sq = rs >> 10, tix = (rs >> 8) & 3;
        float cf = 0.f, cbk = 0.f;
        if (tix > 0) { for (int t = 0; t < tix; ++t) { const float At = bf2f(PF[(size_t)(sq * 1024 + t * 256 + 255) * DRNN + ch]); cf = At * cf + AGG[(size_t)((sq * 4 + t) * 2 + 0) * DRNN + ch]; } }
        if (tix < 3) { for (int t = 3; t > tix; --t) { const float At = bf2f(PB[(size_t)(sq * 1024 + t * 256) * DRNN + ch]); cbk = At * cbk + AGG[(size_t)((sq * 4 + t) * 2 + 1) * DRNN + ch]; } }
        const size_t o = (size_t)(NPROMPT + rs) * DRNN + ch;
        HS[o] = (bf16)f2bf(bf2f(HS[o]) + bf2f(GB[o]) * (bf2f(PF[(size_t)rs * DRNN + ch]) * cf + bf2f(PB[(size_t)rs * DRNN + ch]) * cbk)); }
}

__device__ __forceinline__ void phase_cmlp_rstd(Frame& F, const bf16* UV) {
    F.fresh();
    const int gw = F.bid * NWAVES + F.wave, NGW = F.G * NWAVES;
    for (int row = gw; row < M; row += NGW) { float s = 0.f;
        for (int c = F.lane; c < DB; c += 64) { const float v = bf2f(UV[(size_t)row * 2 * DB + DB + c]); s += v * v; }
        s = wave_sum(s); if (F.lane == 0) F.rstd[row] = rsqrtf(s * (1.f / DB) + EPS); }
}
__device__ __forceinline__ void phase_cmlp_spatial(Frame& F, const bf16* UV, bf16* ACT) {
    F.fresh();
    const float* ws = F.inp(I_CM_WS); const float* bs = F.inp(I_CM_BS); const float* ng = F.inp(I_CM_NG);
    const int gt = F.bid * NT + F.tid, GT = F.G * NT;
    for (int i = gt; i < M * DB; i += GT) { const int row = i / DB, ch = i % DB, g = ch >> 8, p = row & 127, r0 = row & ~127;
        float s = 0.f;
        for (int q = 0; q < 128; ++q) s += ws[(size_t)(g * 128 + p) * 128 + q] * F.rstd[r0 + q] * bf2f(UV[(size_t)(r0 + q) * 2 * DB + DB + ch]);
        const float sv = s * ng[ch] + bs[g * 128 + p];
        ACT[i] = (bf16)f2bf(bf2f(UV[(size_t)row * 2 * DB + ch]) * sv); }
}


constexpr int CM_VS = 544;
__device__ __forceinline__ void phase_cmlp_spatial_mfma(Frame& F, const bf16* UV, bf16* ACT, const bf16* WSB) {
    F.fresh();
    const int tid = F.tid, lane = F.lane, wave = F.wave, c = lane & 15, q4 = lane >> 4;
    LAS unsigned char* vt = F.lds;
    const float* ng = F.inp(I_CM_NG); const float* bs = F.inp(I_CM_BS);
    for (int u = F.bid; u < 640; u += F.G) {
        const int chunk = u >> 3, g = u & 7, r0 = chunk * 128;
        LAS float* rsl = (LAS float*)(vt + 128 * CM_VS);
        if (tid < 128) { const GAS f32x4* p = (const GAS f32x4*)(F.rsqv + (size_t)(r0 + tid) * 32); float sm = 0.f;
#pragma unroll
            for (int i = 0; i < 8; ++i) { const f32x4 t4 = p[i]; sm += (t4.x + t4.y) + (t4.z + t4.w); }
            rsl[tid] = rsqrtf(sm * (1.f / DB) + EPS); }
        __syncthreads();
#pragma unroll
        for (int i = 0; i < 8; ++i) { const int id = i * NT + tid, row = id >> 5, cc = id & 31;
            const u32x4 x = *(const GAS u32x4*)(UV + (size_t)(r0 + row) * 2 * DB + DB + g * 256 + 8 * cc); const float rs = rsl[row];
            u32x4 y; y.x = f2bf(bf2f(x.x) * rs) | (f2bf(bf2f(x.x >> 16) * rs) << 16); y.y = f2bf(bf2f(x.y) * rs) | (f2bf(bf2f(x.y >> 16) * rs) << 16);
            y.z = f2bf(bf2f(x.z) * rs) | (f2bf(bf2f(x.z >> 16) * rs) << 16); y.w = f2bf(bf2f(x.w) * rs) | (f2bf(bf2f(x.w >> 16) * rs) << 16);
            *(LAS u32x4*)(vt + row * CM_VS + 16 * cc) = y; }
        __syncthreads();
        bf16x8 vf[2][4];
#pragma unroll
        for (int mfc = 0; mfc < 2; ++mfc)
#pragma unroll
            for (int ks = 0; ks < 4; ++ks) { LAS const unsigned char* vp = vt + (32 * ks + 4 * q4 + (c >> 2)) * CM_VS + (32 * wave + 16 * mfc + 4 * (c & 3)) * 2;
                const v4i16_t lo = __builtin_amdgcn_ds_read_tr16_b64_v4i16((LAS v4i16_t*)vp), hi = __builtin_amdgcn_ds_read_tr16_b64_v4i16((LAS v4i16_t*)(vp + 16 * CM_VS));
                vf[mfc][ks] = (bf16x8){lo[0], lo[1], lo[2], lo[3], hi[0], hi[1], hi[2], hi[3]}; }
#pragma unroll
        for (int nf = 0; nf < 8; ++nf) {
            bf16x8 Bf[4];
#pragma unroll
            for (int ks = 0; ks < 4; ++ks) Bf[ks] = *(const GAS bf16x8*)(WSB + ((size_t)((g * 8 + nf) * 4 + ks) * 64 + lane) * 8);
            const int p = 16 * nf + c; const float bsv = bs[g * 128 + p];
#pragma unroll
            for (int mfc = 0; mfc < 2; ++mfc) { f32x4 acc = {0.f, 0.f, 0.f, 0.f};
#pragma unroll
                for (int ks = 0; ks < 4; ++ks) acc = __builtin_amdgcn_mfma_f32_16x16x32_bf16(vf[mfc][ks], Bf[ks], acc, 0, 0, 0);
                const int ch = g * 256 + 32 * wave + 16 * mfc + 4 * q4;
                const f32x4 g4 = *(const GAS f32x4*)(ng + ch); const u32x2 uu = *(const GAS u32x2*)(UV + (size_t)(r0 + p) * 2 * DB + ch);
                const float o0 = bf2f(uu.x) * (acc[0] * g4.x + bsv), o1 = bf2f(uu.x >> 16) * (acc[1] * g4.y + bsv), o2 = bf2f(uu.y) * (acc[2] * g4.z + bsv), o3 = bf2f(uu.y >> 16) * (acc[3] * g4.w + bsv);
                u32x2 w; w.x = f2bf(o0) | (f2bf(o1) << 16); w.y = f2bf(o2) | (f2bf(o3) << 16);
                *(GAS u32x2*)(ACT + (size_t)(r0 + p) * DB + ch) = w; }
        }
        __syncthreads();
    }
}

__device__ __forceinline__ void phase_qkv_post(Frame& F, const bf16* QKV, bf16* Q, bf16* KP, bf16* VP) {
    F.fresh();
    const int gw = F.bid * NWAVES + F.wave, NGW = F.G * NWAVES;
    const float* qkg = F.inp(I_AT_QKG);
    for (int row = gw; row < M; row += NGW) {
        const bool smp = row >= NPROMPT; const int sb = smp ? (row - NPROMPT) >> 10 : 0, t = smp ? (row - NPROMPT) & 1023 : 0;
        const float cs = smp ? F.rope[t * 32 + (F.lane & 31)] : 1.f, sn = smp ? F.rope[32768 + t * 32 + (F.lane & 31)] : 0.f;
        for (int grp = 0; grp < 32; ++grp) {
            const float v = bf2f(QKV[(size_t)row * 3072 + grp * 64 + F.lane]);
            const float ms = wave_sum(v * v) * (1.f / 64.f);
            float n = v * rsqrtf(ms + EPS) * qkg[(grp >> 4) * 64 + F.lane];
            const float keep = n;
            if (smp) { float pr; { auto r_ = __builtin_amdgcn_permlane32_swap(__builtin_bit_cast(unsigned, n), __builtin_bit_cast(unsigned, n), false, false); pr = __builtin_bit_cast(float, F.lane < 32 ? (unsigned)r_[1] : (unsigned)r_[0]); } n = F.lane < 32 ? n * cs - pr * sn : n * cs + pr * sn; }
            if (grp < 16) Q[(size_t)row * D + grp * 64 + F.lane] = (bf16)f2bf(n);
            else { const int c = (grp - 16) * 64 + F.lane;
                if (smp) F.KS[((size_t)sb * TKS + PAST + t) * D + c] = (bf16)f2bf(n);
                else { KP[(size_t)row * D + c] = (bf16)f2bf(keep); F.out[O_CK + (size_t)row * D + c] = keep; } }
        }
        for (int c = F.lane; c < D; c += 64) { const bf16 vb = QKV[(size_t)row * 3072 + 2048 + c];
            if (smp) F.VS[((size_t)sb * TKS + PAST + t) * D + c] = vb; else { VP[(size_t)row * D + c] = vb; F.out[O_CV + (size_t)row * D + c] = bf2f(vb); } }
    }
}
__device__ __forceinline__ void phase_attn_naive(Frame& F, int l, const bf16* Q, const bf16* KP, const bf16* VP, bf16* O) {
    F.fresh();
    const int gw = F.bid * NWAVES + F.wave, NGW = F.G * NWAVES;
    LAS float* s1 = (LAS float*)F.lds + F.wave * 3328; LAS float* s2 = s1 + 1536; LAS float* qs = s2 + 1536;
    const float* al = F.inp(I_AT_LAM);
    const float lam_init = 0.8f - 0.6f * expf(-0.3f * (float)l);
    const float lam = expf(wave_sum(al[F.lane] * al[64 + F.lane])) - expf(wave_sum(al[128 + F.lane] * al[192 + F.lane])) + lam_init;
    const float* sg = F.inp(I_AT_SUBG);
    for (int item = gw; item < M * 8; item += NGW) {
        const int row = item >> 3, h = item & 7;
        const bf16 *Kb, *Vb; int Tk;
        if (row < NPROMPT) { Kb = KP + (size_t)(row & ~255) * D; Vb = VP + (size_t)(row & ~255) * D; Tk = 256; }
        else { const int sb = (row - NPROMPT) >> 10; Kb = F.KS + (size_t)sb * TKS * D; Vb = F.VS + (size_t)sb * TKS * D; Tk = TKS; }
        qs[F.lane] = bf2f(Q[(size_t)row * D + h * 128 + F.lane]); qs[64 + F.lane] = bf2f(Q[(size_t)row * D + h * 128 + 64 + F.lane]);
        asm volatile("s_waitcnt lgkmcnt(0)" ::: "memory");
        float m1 = -1e30f, m2 = -1e30f;
        for (int k = F.lane; k < Tk; k += 64) { const bf16* kr = Kb + (size_t)k * D + h * 128; float d1 = 0.f, d2 = 0.f;
#pragma unroll 4
            for (int d = 0; d < 64; d += 2) { const unsigned a = *(const unsigned*)(kr + d), b = *(const unsigned*)(kr + 64 + d);
                d1 += qs[d] * bf2f(a) + qs[d + 1] * bf2f(a >> 16); d2 += qs[64 + d] * bf2f(b) + qs[64 + d + 1] * bf2f(b >> 16); }
            d1 *= 0.125f; d2 *= 0.125f; s1[k] = d1; s2[k] = d2; m1 = fmaxf(m1, d1); m2 = fmaxf(m2, d2); }
        m1 = wave_max(m1); m2 = wave_max(m2);
        float l1 = 0.f, l2 = 0.f;
        for (int k = F.lane; k < Tk; k += 64) { const float e1 = expf(s1[k] - m1), e2 = expf(s2[k] - m2); s1[k] = e1; s2[k] = e2; l1 += e1; l2 += e2; }
        l1 = wave_sum(l1); l2 = wave_sum(l2);
        const float i1 = 1.f / l1, i2 = lam / l2;
        for (int k = F.lane; k < Tk; k += 64) s1[k] = bf2f(f2bf(s1[k] * i1 - s2[k] * i2));
        asm volatile("s_waitcnt lgkmcnt(0)" ::: "memory");
        float o0 = 0.f, o1 = 0.f;
        for (int k = 0; k < Tk; ++k) { const unsigned vv = *(const unsigned*)(Vb + (size_t)k * D + h * 128 + 2 * F.lane); const float w = s1[k]; o0 += w * bf2f(vv); o1 += w * bf2f(vv >> 16); }
        const float ms = wave_sum(o0 * o0 + o1 * o1) * (1.f / 128.f), rs = rsqrtf(ms + EPS) * (1.f - lam_init);
        o0 = o0 * rs * sg[2 * F.lane]; o1 = o1 * rs * sg[2 * F.lane + 1];
        *(unsigned*)(O + (size_t)row * D + h * 128 + 2 * F.lane) = f2bf(o0) | (f2bf(o1) << 16);
        asm volatile("s_waitcnt lgkmcnt(0)" ::: "memory");
    }
}


constexpr int AT_KS = 272, AT_VS = 288, AT_KBYTES = 64 * AT_KS, AT_VBYTES = 64 * AT_VS, AT_BUF = AT_KBYTES + AT_VBYTES;
__device__ __forceinline__ void attn_unit(Frame& F, int l, const bf16* Qrows  , const bf16* Kb, const bf16* Vb, int Tk, bf16* Orows, int h, float lam, float lam_init) {
    const int tid = F.tid, lane = F.lane, wave = F.wave, c = lane & 15, q4 = lane >> 4;
    LAS unsigned char* lds = F.lds;
    const float SC = 0.18033688f;
    bf16x8 Qf[2][2];
#pragma unroll
    for (int cp = 0; cp < 2; ++cp)
#pragma unroll
        for (int ks = 0; ks < 2; ++ks) Qf[cp][ks] = *(const GAS bf16x8*)(Qrows + (size_t)(16 * wave + c) * D + h * 128 + cp * 64 + 32 * ks + 8 * q4);
    const int nt = Tk / 64;
    const int key0 = tid >> 4, cc0 = tid & 15;
    u32x4 kreg[2], vreg[2];
    float m1 = -1e30f, m2 = -1e30f, l1 = 0.f, l2 = 0.f;
#pragma unroll
    for (int i = 0; i < 2; ++i) kreg[i] = *(const GAS u32x4*)(Kb + (size_t)(key0 + 32 * i) * D + h * 128 + 8 * cc0);
#pragma unroll
    for (int i = 0; i < 2; ++i) *(LAS u32x4*)(lds + (key0 + 32 * i) * AT_KS + 16 * cc0) = kreg[i];
    __syncthreads();
    for (int t = 0; t < nt; ++t) {
        LAS const unsigned char* kt = lds + (t & 1) * AT_BUF;
        if (t + 1 < nt) {
#pragma unroll
            for (int i = 0; i < 2; ++i) kreg[i] = *(const GAS u32x4*)(Kb + (size_t)((t + 1) * 64 + key0 + 32 * i) * D + h * 128 + 8 * cc0); }
        f32x4 S[2][4];
#pragma unroll
        for (int cp = 0; cp < 2; ++cp)
#pragma unroll
            for (int mf = 0; mf < 4; ++mf) { S[cp][mf] = (f32x4){0.f, 0.f, 0.f, 0.f};
#pragma unroll
                for (int ks = 0; ks < 2; ++ks) { const bf16x8 kf = *(LAS const bf16x8*)(kt + (16 * mf + c) * AT_KS + cp * 128 + ks * 64 + 16 * q4);
                    S[cp][mf] = __builtin_amdgcn_mfma_f32_16x16x32_bf16(kf, Qf[cp][ks], S[cp][mf], 0, 0, 0); } }
        float x1 = -1e30f, x2 = -1e30f;
#pragma unroll
        for (int mf = 0; mf < 4; ++mf)
#pragma unroll
            for (int k = 0; k < 4; ++k) { x1 = fmaxf(x1, S[0][mf][k]); x2 = fmaxf(x2, S[1][mf][k]); }
        x1 = max_q4(x1); x2 = max_q4(x2);
        const float n1 = fmaxf(m1, x1), n2 = fmaxf(m2, x2);
        l1 *= exp2f((m1 - n1) * SC); l2 *= exp2f((m2 - n2) * SC); m1 = n1; m2 = n2;
#pragma unroll
        for (int mf = 0; mf < 4; ++mf)
#pragma unroll
            for (int k = 0; k < 4; ++k) { l1 += exp2f((S[0][mf][k] - m1) * SC); l2 += exp2f((S[1][mf][k] - m2) * SC); }
        if (t + 1 < nt) {
#pragma unroll
            for (int i = 0; i < 2; ++i) *(LAS u32x4*)(lds + ((t + 1) & 1) * AT_BUF + (key0 + 32 * i) * AT_KS + 16 * cc0) = kreg[i]; }
        __syncthreads();
    }
    l1 = sum_q4(l1); l2 = sum_q4(l2);
    const float i1 = 1.f / l1, i2 = lam / l2;
    f32x4 Ot[8];
#pragma unroll
    for (int md = 0; md < 8; ++md) Ot[md] = (f32x4){0.f, 0.f, 0.f, 0.f};
#pragma unroll
    for (int i = 0; i < 2; ++i) { kreg[i] = *(const GAS u32x4*)(Kb + (size_t)(key0 + 32 * i) * D + h * 128 + 8 * cc0); vreg[i] = *(const GAS u32x4*)(Vb + (size_t)(key0 + 32 * i) * D + h * 128 + 8 * cc0); }
#pragma unroll
    for (int i = 0; i < 2; ++i) { *(LAS u32x4*)(lds + (key0 + 32 * i) * AT_KS + 16 * cc0) = kreg[i]; *(LAS u32x4*)(lds + AT_KBYTES + (key0 + 32 * i) * AT_VS + 16 * cc0) = vreg[i]; }
    __syncthreads();
    for (int t = 0; t < nt; ++t) {
        LAS const unsigned char* kt = lds + (t & 1) * AT_BUF; LAS const unsigned char* vt = kt + AT_KBYTES;
        if (t + 1 < nt) {
#pragma unroll
            for (int i = 0; i < 2; ++i) { kreg[i] = *(const GAS u32x4*)(Kb + (size_t)((t + 1) * 64 + key0 + 32 * i) * D + h * 128 + 8 * cc0);
                                          vreg[i] = *(const GAS u32x4*)(Vb + (size_t)((t + 1) * 64 + key0 + 32 * i) * D + h * 128 + 8 * cc0); } }
        f32x4 S[2][4];
#pragma unroll
        for (int cp = 0; cp < 2; ++cp)
#pragma unroll
            for (int mf = 0; mf < 4; ++mf) { S[cp][mf] = (f32x4){0.f, 0.f, 0.f, 0.f};
#pragma unroll
                for (int ks = 0; ks < 2; ++ks) { const bf16x8 kf = *(LAS const bf16x8*)(kt + (16 * mf + c) * AT_KS + cp * 128 + ks * 64 + 16 * q4);
                    S[cp][mf] = __builtin_amdgcn_mfma_f32_16x16x32_bf16(kf, Qf[cp][ks], S[cp][mf], 0, 0, 0); } }
        bf16x8 Wf[2];
#pragma unroll
        for (int kk = 0; kk < 2; ++kk)
#pragma unroll
            for (int jj = 0; jj < 8; ++jj) { const int mf = 2 * kk + (jj >> 2), k = jj & 3;
                const float w = exp2f((S[0][mf][k] - m1) * SC) * i1 - exp2f((S[1][mf][k] - m2) * SC) * i2; Wf[kk][jj] = (short)f2bf(w); }
#pragma unroll
        for (int md = 0; md < 8; ++md)
#pragma unroll
            for (int kk = 0; kk < 2; ++kk) { LAS const unsigned char* vp = vt + (32 * kk + 4 * q4 + (c >> 2)) * AT_VS + (16 * md + 4 * (c & 3)) * 2;
                const v4i16_t lo = __builtin_amdgcn_ds_read_tr16_b64_v4i16((LAS v4i16_t*)vp), hi = __builtin_amdgcn_ds_read_tr16_b64_v4i16((LAS v4i16_t*)(vp + 16 * AT_VS));
                const bf16x8 vf = {lo[0], lo[1], lo[2], lo[3], hi[0], hi[1], hi[2], hi[3]};
                Ot[md] = __builtin_amdgcn_mfma_f32_16x16x32_bf16(vf, Wf[kk], Ot[md], 0, 0, 0); }
        if (t + 1 < nt) {
#pragma unroll
            for (int i = 0; i < 2; ++i) { *(LAS u32x4*)(lds + ((t + 1) & 1) * AT_BUF + (key0 + 32 * i) * AT_KS + 16 * cc0) = kreg[i];
                                          *(LAS u32x4*)(lds + ((t + 1) & 1) * AT_BUF + AT_KBYTES + (key0 + 32 * i) * AT_VS + 16 * cc0) = vreg[i]; } }
        __syncthreads();
    }
    float ss = 0.f;
#pragma unroll
    for (int md = 0; md < 8; ++md)
#pragma unroll
        for (int k = 0; k < 4; ++k) ss += Ot[md][k] * Ot[md][k];
    ss = sum_q4(ss);
    const float rs = rsqrtf(ss * (1.f / 128.f) + EPS) * (1.f - lam_init);
    const float* sg = F.inp(I_AT_SUBG);
#pragma unroll
    for (int md = 0; md < 8; ++md) { const int d0 = 16 * md + 4 * q4; const f32x4 g4 = *(const GAS f32x4*)(sg + d0);
        u32x2 w; w.x = f2bf(Ot[md][0] * rs * g4.x) | (f2bf(Ot[md][1] * rs * g4.y) << 16); w.y = f2bf(Ot[md][2] * rs * g4.z) | (f2bf(Ot[md][3] * rs * g4.w) << 16);
        *(GAS u32x2*)(Orows + (size_t)(16 * wave + c) * D + h * 128 + d0) = w; }
}
__device__ __forceinline__ void phase_attn(Frame& F, int l, const bf16* Q, const bf16* KP, const bf16* VP, bf16* O) {
    F.fresh();
    const float* al = F.inp(I_AT_LAM);
    const float lam_init = 0.8f - 0.6f * expf(-0.3f * (float)l);
    const float lam = expf(wave_sum(al[F.lane] * al[64 + F.lane])) - expf(wave_sum(al[128 + F.lane] * al[192 + F.lane])) + lam_init;
    for (int s = 0; ; ++s) {
        int u;
        if (F.G == 256) { if (F.bid < 128) { if (s > 0) break; u = F.bid; } else { if (s > 3) break; u = 128 + 4 * (F.bid - 128) + s; } }
        else { u = F.bid + s * F.G; if (u >= 640) break; }
        if (u < 128) { const int sb = u >> 6, h = (u >> 3) & 7, qt = u & 7; const size_t r0 = (size_t)NPROMPT + sb * 1024 + qt * 128;
            attn_unit(F, l, Q + r0 * D, F.KS + (size_t)sb * TKS * D, F.VS + (size_t)sb * TKS * D, TKS, O + r0 * D, h, lam, lam_init); }
        else { const int v = u - 128, b = v >> 4, h = (v >> 1) & 7, qt = v & 1; const size_t r0 = (size_t)b * 256 + qt * 128;
            attn_unit(F, l, Q + r0 * D, KP + (size_t)b * 256 * D, VP + (size_t)b * 256 * D, 256, O + r0 * D, h, lam, lam_init); }
    }
}

__device__ __forceinline__ void phase_ffn_convgate(Frame& F, int l, const bf16* Z, bf16* ACT) {
    F.fresh();
    const float* cw = F.inp(I_FF_CW) + (size_t)l * 3 * 2 * DFF; const float* cb = F.inp(I_FF_CB) + (size_t)l * 2 * DFF;
    const int gt = F.bid * NT + F.tid, GT = F.G * NT;
    for (int i = gt; i < M * DFF; i += GT) { const int row = i / DFF, j = i % DFF;
        int t, T; if (row < NPROMPT) { t = row & 255; T = 256; } else { t = (row - NPROMPT) & 1023; T = 1024; }
        float g = cb[j], u = cb[DFF + j];
#pragma unroll
        for (int k = 0; k < 3; ++k) { const int tt = t + k - 1; if (tt >= 0 && tt < T) { const bf16* zr = Z + (size_t)(row + k - 1) * 2 * DFF; g += cw[k * 2 * DFF + j] * bf2f(zr[j]); u += cw[k * 2 * DFF + DFF + j] * bf2f(zr[DFF + j]); } }
        ACT[i] = (bf16)f2bf(siluf_(g) * u); }
}

__global__ void __launch_bounds__(NT, 2) mk_fwd(Params prm) {
    extern __shared__ __attribute__((aligned(16))) unsigned char lds_raw[];
    Frame F;
    F.lds = (LAS unsigned char*)lds_raw; F.G = gridDim.x; F.out0 = prm.out; F.ws0 = prm.ws; F.wave0 = __builtin_amdgcn_readfirstlane(threadIdx.x >> 6);
    F.fresh();
    if (F.tid < N_IN) ((LAS unsigned long long*)(F.lds + PTR_OFF))[F.tid] = (unsigned long long)prm.in[F.tid];
    volatile LAS unsigned* MISC = (volatile LAS unsigned*)(F.lds + MISC_OFF);
    if (F.tid < 32) MISC[F.tid] = 0u;
    __syncthreads();
    (void)xcd_barrier_post((unsigned*)(prm.ws + WS_CTL) + CW_BAR, MISC + 8, F.tid == 0);
#define GRID_BAR() do { F.fresh(); XcdBarrier bar_; bar_.t0 = F.tid == 0; { unsigned* bp_ = (unsigned*)(prm.ws + WS_CTL) + CW_BAR; asm volatile("" : "+s"(bp_)); bar_.bar = bp_; } bar_.x = xb_xcc_id(); bar_.st = (volatile LAS unsigned*)(F.lds + MISC_OFF) + 8; xcd_barrier(bar_); } while (0)

#define GEMM_BF16(ACT, A_, Bt_, N_, K_, O_, ldc_, bias_, splitc_, splits_, rsq_, b2_, rsqv_, vt0_) do { pg8::Gemm g{A_, Bt_, M, N_, K_}; pg8::StaticOrder S; S.init(M, N_, F.G, F.bid); S.wave = F.wave; \
        pg8::EpiBf16<ACT> E{O_, ldc_, bias_, splitc_, splits_, rsq_, b2_, N_, rsqv_, vt0_, (LAS float*)(F.lds + 131072)}; pg8::gemm_phase<pg8::EpiBf16<ACT>, pg8::StaticOrder, true, true>(F.lds, g, S, E); } while (0)
#define GEMM_RESID(A_, Bt_, K_, sub_, fromin_) do { pg8::Gemm g{A_, Bt_, M, D, K_}; pg8::StaticOrder S; S.init(M, D, F.G, F.bid); S.wave = F.wave; \
        const int nl_ = (sub_) == 0 ? l : l + 1, ns_ = (sub_) == 0 ? 1 : 0; const bool last_ = nl_ >= DEPTH; \
        pg8::EpiResid E{F.out, F.inp(I_XP), F.inp(I_XS), F.mod + (size_t)l * 18 * D, (sub_) * 3 + 2, fromin_, last_ ? nullptr : F.H, F.inp(I_NORMG) + (size_t)((last_ ? 0 : nl_) * 2 + ns_) * D, \
                          F.mod + (size_t)(last_ ? 0 : nl_) * 18 * D, ns_ * 3 + 1, (sub_) == 0 ? F.rsq1 : F.rsq0}; \
        pg8::gemm_phase<pg8::EpiResid, pg8::StaticOrder, true, true>(F.lds, g, S, E); } while (0)

    phase_prologue(F);
    GRID_BAR();
    phase_modulate0(F);
    GRID_BAR();
#pragma unroll 1
    for (int l = 0; l < DEPTH; ++l) {
        const int kind = l % 3, j = l / 3;
        F.fresh();
        if (kind == 0) {
            bf16 *GB = F.T2, *REC = F.T2 + (size_t)M * DRNN, *PF = F.T3, *PB = F.T3 + (size_t)NSAMPLE * DRNN, *HS = F.T3 + (size_t)6 * 1024 * 1024;
            float* AGG = (float*)(F.T3 + (size_t)2 * NSAMPLE * DRNN);
            GEMM_BF16(2, F.H, F.WT + WE_LRU_IN + (size_t)j * 2 * DRNN * D, 2 * DRNN, D, GB, DRNN, nullptr, DRNN, (size_t)M * DRNN, F.rsq0, F.bias2 + B2_LRU + (size_t)j * 3 * 2560, nullptr, 0);
            GRID_BAR();
            phase_lru_core(F, j, REC, GB, HS, PF, PB, AGG, F.WT + WE_WG + (size_t)j * 40 * 128 * 128);
            GRID_BAR();
            phase_lru_fixup(F, GB, HS, PF, PB, AGG);
            GRID_BAR();
            GEMM_RESID(HS, F.WT + WE_LRU_OUT + (size_t)j * D * DRNN, DRNN, 0, l == 0);
        } else if (kind == 1) {
            bf16 *UV = F.T1, *ACT = F.T2;
            GEMM_BF16(1, F.H, F.WT + WE_CM_IN, 2 * DB, D, UV, 2 * DB, F.inp(I_CM_BIN), 0, 0, F.rsq0, F.bias2 + B2_CM, F.rsqv, 8);
            GRID_BAR();
            phase_cmlp_spatial_mfma(F, UV, ACT, F.WT + WE_WSB);
            GRID_BAR();
            GEMM_RESID(ACT, F.WT + WE_CM_OUT, DB, 0, false);
        } else {
            bf16 *QKV = F.T1, *Q = F.T2, *KP = F.T2 + (size_t)M * D, *VP = KP + (size_t)NPROMPT * D, *O = F.T3;
            GEMM_BF16(0, F.H, F.WT + WE_QKV, 3 * D, D, QKV, 3 * D, nullptr, 0, 0, F.rsq0, F.bias2 + B2_QKV, nullptr, 0);
            GRID_BAR();
            phase_qkv_post(F, QKV, Q, KP, VP);
            GRID_BAR();
            phase_attn(F, l, Q, KP, VP, O);
            GRID_BAR();
            GEMM_RESID(O, F.WT + WE_AT_OUT, D, 0, false);
        }
        GRID_BAR();
        { pg8::Gemm g{F.H, F.WT + WE_UP + (size_t)l * 2 * DFF * D, 42 * 256, 2 * DFF, D}; pg8::FfnOrder S; S.init(42 * 256, 2 * DFF, F.G, F.bid); S.wave = F.wave;
          pg8::EpiFfn E{F.T2, F.inp(I_FF_CW) + (size_t)l * 3 * 2 * DFF, F.inp(I_FF_CB) + (size_t)l * 2 * DFF, (LAS float*)(F.lds + 131072), F.rsq1, F.bias2 + B2_UP + (size_t)l * 3 * 5632};
          pg8::gemm_phase<pg8::EpiFfn, pg8::FfnOrder, true, true>(F.lds, g, S, E); }
        GRID_BAR();
        GEMM_RESID(F.T2, F.WT + WE_DN + (size_t)l * D * DFF, DFF, 1, false);
        GRID_BAR();
    }
}

extern "C" void kernel_launch(void* const* d_in, const int* in_sizes, int n_in, void* d_out, int out_size, void* d_ws, size_t ws_size, hipStream_t stream) {
    static int grid = 0;
    if (grid == 0) {
        if (n_in != N_IN || ws_size < WS_END) { fprintf(stderr, "kernel_launch: unexpected n_in %d or ws_size %zu\n", n_in, ws_size); grid = -1; return; }
        int dev = 0, cus = 0, per_cu = 0;
        hipGetDevice(&dev); hipDeviceGetAttribute(&cus, hipDeviceAttributeMultiprocessorCount, dev);
        hipFuncSetAttribute((const void*)mk_fwd, hipFuncAttributeMaxDynamicSharedMemorySize, LDS_BYTES);
        hipOccupancyMaxActiveBlocksPerMultiprocessor(&per_cu, (const void*)mk_fwd, NT, LDS_BYTES);
        (void)hipGetLastError();
        if (per_cu < 1) { fprintf(stderr, "kernel_launch: occupancy query says %d blocks per CU\n", per_cu); per_cu = 1; }
        grid = cus;
    }
    if (grid < 0) return;
    hipMemsetAsync((char*)d_ws + WS_CTL, 0, CTL_ZERO_BYTES, stream);
    Params p{};
    for (int i = 0; i < N_IN; ++i) p.in[i] = (const float*)d_in[i];
    p.out = (float*)d_out; p.ws = (unsigned char*)d_ws;
    void* args[] = {&p};
    hipError_t e = hipLaunchCooperativeKernel((const void*)mk_fwd, dim3(grid), dim3(NT), args, LDS_BYTES, stream);
    if (e != hipSuccess) fprintf(stderr, "kernel_launch: cooperative launch failed: %s (grid %d)\n", hipGetErrorString(e), grid);
}
```

```cpp
#include <hip/hip_runtime.h>
#include <cstdio>
#include <cstdint>

#define GAS __attribute__((address_space(1)))
#define LAS __attribute__((address_space(3)))
typedef unsigned short bf16;
typedef float f32x4 __attribute__((ext_vector_type(4)));
typedef unsigned u32x2 __attribute__((ext_vector_type(2)));
typedef unsigned u32x4 __attribute__((ext_vector_type(4)));

constexpr int D = 1024, NPROMPT = 32 * 256, NSAMPLE = 2 * 1024, M = NPROMPT + NSAMPLE;
constexpr int DEPTH = 4, DRNN = 1280, DB = 2048, DFF = 2816, PAST = 512, TKS = PAST + 1024;
constexpr float EPS = 1e-6f;
constexpr int NWAVES = 8, NT = NWAVES * 64;

enum { I_XP = 0, I_XS, I_STATE, I_CK, I_CV, I_C, I_CCTX, I_WMOD, I_BMOD, I_NORMG, I_LRU_WIN, I_LRU_CW, I_LRU_CB, I_LRU_WG, I_LRU_BG, I_LRU_LAM, I_LRU_WOUT,
       I_CM_WIN, I_CM_BIN, I_CM_NG, I_CM_WS, I_CM_BS, I_CM_WOUT, I_AT_WQKV, I_AT_QKG, I_AT_LAM, I_AT_SUBG, I_AT_WOUT, I_FF_WUP, I_FF_CW, I_FF_CB, I_FF_WDN, N_IN };
constexpr size_t O_YP = 0, O_YS = (size_t)NPROMPT * D, O_STATE = (size_t)M * D, O_CK = O_STATE + 32 * 2 * 2 * DRNN, O_CV = O_CK + (size_t)NPROMPT * D;

constexpr size_t MiB = 1u << 20;
constexpr size_t WS_CTL = 0, CTL_ZERO_BYTES = 64 * 1024;
constexpr size_t WS_MOD = 1 * MiB;
constexpr size_t WS_RSTD = WS_MOD + 512 * 1024;
constexpr size_t WS_ROPE = WS_RSTD + 256 * 1024;
constexpr size_t WS_H = 2 * MiB;
constexpr size_t WS_T1 = 22 * MiB;
constexpr size_t WS_T2 = 132 * MiB;
constexpr size_t WS_T3 = 187 * MiB;
constexpr size_t WS_X = WS_T3 + 40 * MiB;
constexpr size_t B2_LRU = 0, B2_CM = B2_LRU + (size_t)2 * 3 * 2560, B2_QKV = B2_CM + (size_t)3 * 4096, B2_UP = B2_QKV + (size_t)3 * 3072, B2_END = B2_UP + (size_t)4 * 3 * 5632;
constexpr size_t WS_KS = 237 * MiB, WS_VS = 243 * MiB;
constexpr size_t WS_W = 249 * MiB;
constexpr size_t WE_LRU_IN = 0, WE_LRU_OUT = WE_LRU_IN + (size_t)2 * 2560 * 1024, WE_CM_IN = WE_LRU_OUT + (size_t)2 * 1024 * 1280, WE_CM_OUT = WE_CM_IN + (size_t)4096 * 1024,
                 WE_QKV = WE_CM_OUT + (size_t)1024 * 2048, WE_AT_OUT = WE_QKV + (size_t)3072 * 1024, WE_UP = WE_AT_OUT + (size_t)1024 * 1024, WE_DN = WE_UP + (size_t)4 * 5632 * 1024,
                 WE_WG = WE_DN + (size_t)4 * 1024 * 2816, WE_WSB = WE_WG + (size_t)80 * 128 * 128, WE_END = WE_WSB + (size_t)8 * 128 * 128;
constexpr size_t WS_END = WS_W + 106 * MiB;
static_assert(WE_END * 2 <= 106 * MiB, "weight copies fit");
constexpr int CW_BAR = 1024;

constexpr int LDS_BYTES = 163840;
constexpr int MISC_OFF = LDS_BYTES - 256, PTR_OFF = LDS_BYTES - 1024;

__device__ __forceinline__ unsigned f2bf(float f) { unsigned u = __builtin_bit_cast(unsigned, f); return (u + 0x7fffu + ((u >> 16) & 1u)) >> 16; }
__device__ __forceinline__ float bf2f(unsigned b) { return __builtin_bit_cast(float, (b & 0xffffu) << 16); }
template <int CTRL> __device__ __forceinline__ float dppf(float v) { return __builtin_bit_cast(float, __builtin_amdgcn_update_dpp(0, __builtin_bit_cast(int, v), CTRL, 0xf, 0xf, false)); }
__device__ __forceinline__ float swz_xor16(float v) { return __builtin_bit_cast(float, __builtin_amdgcn_ds_swizzle(__builtin_bit_cast(int, v), 0x401F)); }
__device__ __forceinline__ float sum_x32(float v) { auto r = __builtin_amdgcn_permlane32_swap(__builtin_bit_cast(unsigned, v), __builtin_bit_cast(unsigned, v), false, false);
    return __builtin_bit_cast(float, (unsigned)r[0]) + __builtin_bit_cast(float, (unsigned)r[1]); }
__device__ __forceinline__ float max_x32(float v) { auto r = __builtin_amdgcn_permlane32_swap(__builtin_bit_cast(unsigned, v), __builtin_bit_cast(unsigned, v), false, false);
    return fmaxf(__builtin_bit_cast(float, (unsigned)r[0]), __builtin_bit_cast(float, (unsigned)r[1])); }
__device__ __forceinline__ float sum_q4(float v) { v += swz_xor16(v); return sum_x32(v); }
__device__ __forceinline__ float max_q4(float v) { v = fmaxf(v, swz_xor16(v)); return max_x32(v); }
__device__ __forceinline__ float wave_sum(float v) { v += dppf<0xB1>(v); v += dppf<0x4E>(v); v += dppf<0x141>(v); v += dppf<0x140>(v); return sum_q4(v); }
__device__ __forceinline__ float wave_max(float v) { v = fmaxf(v, dppf<0xB1>(v)); v = fmaxf(v, dppf<0x4E>(v)); v = fmaxf(v, dppf<0x141>(v)); v = fmaxf(v, dppf<0x140>(v)); return max_q4(v); }
__device__ __forceinline__ float bperm(float v, int src_lane) { return __builtin_bit_cast(float, __builtin_amdgcn_ds_bpermute(src_lane << 2, __builtin_bit_cast(int, v))); }
__device__ __forceinline__ float gelu_tanh(float x) { const float y = 0.7978845608028654f * (x + 0.044715f * x * x * x); const float t = 1.f - 2.f / (__expf(2.f * y) + 1.f); return 0.5f * x * (1.f + t); }
__device__ __forceinline__ float sigmoidf_(float x) { return 1.f / (1.f + __expf(-x)); }
__device__ __forceinline__ float siluf_(float x) { return x / (1.f + __expf(-x)); }
__device__ __forceinline__ float softplusf_(float x) { return fmaxf(x, 0.f) + log1pf(expf(-fabsf(x))); }

#define XB_TMO      128
#define XB_XCNT(j)  (256  + 64 * (j))
#define XB_XSUB(j)  (1280 + 64 * (j))
#define XB_XGEN(j)  (2304 + 64 * (j))
#define XB_TOP      3328
#define XB_TOPGEN   3392
#define XCD_BAR_WORDS 3456
#define XB_SPIN_CAP (1u << 22)
__device__ __forceinline__ unsigned xb_ld(unsigned* p)              { return __hip_atomic_load(p, __ATOMIC_RELAXED, __HIP_MEMORY_SCOPE_AGENT); }
__device__ __forceinline__ unsigned xb_add(unsigned* p, unsigned v) { return __hip_atomic_fetch_add(p, v, __ATOMIC_RELAXED, __HIP_MEMORY_SCOPE_AGENT); }
__device__ __forceinline__ unsigned xb_xcc_id() { return (unsigned)__builtin_amdgcn_s_getreg((3 << 11) | 20) & 0xFu; }
#define XB_SPIN(cond, bar) do { unsigned _sp = 0; while (cond) { __builtin_amdgcn_s_sleep(1); \
    if ((++_sp & 255u) == 0u) { if (xb_ld(&(bar)[XB_TMO])) break; if (_sp > XB_SPIN_CAP) { atomicAdd(&(bar)[XB_TMO], 1u); break; } } } } while (0)
struct XcdBarrier { unsigned* bar; unsigned x; volatile LAS unsigned* st; bool t0; };
__device__ __forceinline__ XcdBarrier xcd_barrier_post(unsigned* bar, volatile LAS unsigned* st, bool t0) {
    XcdBarrier b; b.bar = bar; b.x = xb_xcc_id(); b.st = st; b.t0 = t0;
    if (t0) (void)xb_add(&bar[XB_XCNT(b.x)], 1u);
    return b;
}
__device__ __forceinline__ void xcd_barrier_complete(unsigned* bar, unsigned x, unsigned& nloc, unsigned& nx) {
    const unsigned G = gridDim.x * gridDim.y * gridDim.z;
    unsigned sum, cnt, mine, sp = 0u;
    for (;;) {
        sum = 0u; cnt = 0u; mine = 0u;
#pragma unroll
        for (unsigned j = 0; j < 16; ++j) { const unsigned c = xb_ld(&bar[XB_XCNT(j)]); sum += c; cnt += (c > 0u) ? 1u : 0u; mine = (j == x) ? c : mine; }
        if (sum == G) break;
        __builtin_amdgcn_s_sleep(1);
        if ((++sp & 255u) == 0u) { if (xb_ld(&bar[XB_TMO])) break; if (sp > XB_SPIN_CAP) { atomicAdd(&bar[XB_TMO], 1u); break; } }
    }
    nloc = mine > 0u ? mine : 1u; nx = cnt > 0u ? cnt : 1u;
}
__device__ __forceinline__ void xcd_barrier(const XcdBarrier& b) {
    asm volatile("s_waitcnt vmcnt(0)" ::: "memory");
    __syncthreads();
    if (b.t0) {
        unsigned* bar = b.bar;
        __builtin_amdgcn_s_waitcnt(0);
        unsigned nloc = b.st[0], nx = b.st[1];
        if (nloc == 0u) { xcd_barrier_complete(bar, b.x, nloc, nx); b.st[0] = nloc; b.st[1] = nx; }
        const unsigned old = xb_add(&bar[XB_XSUB(b.x)], 1u);
        const unsigned gen = old / nloc;
        if (old + 1u == (gen + 1u) * nloc) {
            __builtin_amdgcn_fence(__ATOMIC_RELEASE, "agent");
            asm volatile("s_waitcnt vmcnt(0)" ::: "memory");
            const unsigned og = xb_add(&bar[XB_TOP], 1u);
            const unsigned tg = og / nx;
            if (og + 1u == (tg + 1u) * nx) xb_add(&bar[XB_TOPGEN], 1u);
            else XB_SPIN(xb_ld(&bar[XB_TOPGEN]) == tg, bar);
            __builtin_amdgcn_fence(__ATOMIC_ACQUIRE, "agent");
            xb_add(&bar[XB_XGEN(b.x)], 1u);
            asm volatile("s_waitcnt vmcnt(0)" ::: "memory");
        } else {
            XB_SPIN(xb_ld(&bar[XB_XGEN(b.x)]) == gen, bar);
            __builtin_amdgcn_fence(__ATOMIC_ACQUIRE, "agent");
            asm volatile("s_waitcnt vmcnt(0)" ::: "memory");
        }
    }
    __syncthreads();
}

namespace pg8 {
#define PG8_LAS __attribute__((address_space(3)))
typedef unsigned short bf16_t;
typedef short bf16x8 __attribute__((ext_vector_type(8)));
typedef float f32x4 __attribute__((ext_vector_type(4)));
typedef unsigned u32x4 __attribute__((ext_vector_type(4)));
constexpr int BM = 256, BK = 64, HALF = 128, HTB = HALF * BK * 2  , STAGE_BYTES = 8 * HTB, NXCD = 8, WGM = 8;

__host__ __device__ __forceinline__ int lds_byte(int r, int c) { const int st = (r >> 4) * 2 + (c >> 5), rr = r & 15, cc = c & 31, ob = rr * 64 + cc * 2; return st * 1024 + (ob ^ (((ob >> 9) & 1) << 5)); }
__host__ __device__ __forceinline__ void stage_rc(int b, int& R, int& C) { const int st = b / 1024, sb = b % 1024, swz = sb ^ (((sb >> 9) & 1) << 5); R = (st >> 1) * 16 + swz / 64; C = (st & 1) * 32 + (swz % 64) / 2; }
__host__ __device__ __forceinline__ int perm32(int rho) { const int n = rho >> 4, i = rho & 15; return 8 * (i >> 2) + 4 * n + (i & 3); }

struct Unit { int pm, pn; };
struct Gemm { const bf16_t* A; const bf16_t* Bt; int M, N, K; };

struct StaticOrder {
    int nM, nN, nwg, G, c, wave;
    __host__ __device__ void init(int M, int N, int G_, int c_) { nM = M / BM; nN = N / BM; nwg = nM * nN; G = G_; c = c_; }
    __host__ __device__ bool next(int i, Unit& u) const {
        const long L = (long)i * G + c; if (L >= nwg) return false;
        int wgid = (int)L; { const int q = nwg / NXCD, r = nwg % NXCD, xcd = wgid % NXCD, off = wgid / NXCD; wgid = (xcd < r ? xcd * (q + 1) : r * (q + 1) + (xcd - r) * q) + off; }
        const int nig = WGM * nN, gid = wgid / nig, fm = gid * WGM, gsz = (nM - fm) < WGM ? (nM - fm) : WGM;
        u.pm = fm + ((wgid % nig) % gsz); u.pn = (wgid % nig) / gsz; return true;
    }
    __device__ __forceinline__ int arow(int pm) const { return pm * BM; }
    __device__ __forceinline__ void a_ready(const Unit&) const {}
    __device__ __forceinline__ void done(const Unit&) const {}
};

template <class Epi, class Sched, bool ALIGN_EPI = false, bool SP2 = false>
__device__ __forceinline__ void gemm_phase(PG8_LAS unsigned char* lds, const Gemm g, const Sched& S, const Epi& E) {
    int z_ = 0; asm volatile("" : "+v"(z_));
    const int lane = __builtin_amdgcn_mbcnt_hi(~0u, __builtin_amdgcn_mbcnt_lo(~0u, z_)), wid = S.wave, tid = wid * 64 + lane, wr = wid >> 2, wc = wid & 3, fr = lane & 15, fq = lane >> 4;
    const int K = g.K, nt = K / BK;
    unsigned voffA[2], voffB[2];
#pragma unroll
    for (int i = 0; i < 2; ++i) { int R, C; stage_rc(tid * 16 + i * 8192, R, C); const int Rb = Epi::PERM ? ((R & ~31) + perm32(R & 31)) : R;
        voffA[i] = (unsigned)(R * K + C) * 2u; voffB[i] = (unsigned)(Rb * K + C) * 2u; }
    const size_t kstep = (size_t)(BK * 2);
    const size_t hstep = (size_t)HALF * K * 2;
    const size_t tstep = 2 * hstep;
    const unsigned ldsw = (unsigned)wid * 1024u;
    const int aoff = lds_byte(wr * 64 + fr, fq * 8), boff = lds_byte(wc * 32 + fr, fq * 8);
#define PG8_SA(b, h) (((b) * 2 + (h)) * HTB)
#define PG8_SB(b, h) ((4 + (b) * 2 + (h)) * HTB)
#define PG8_STAGE(bufoff, gbase, voff) do { _Pragma("unroll") for (int _i = 0; _i < 2; ++_i) \
        __builtin_amdgcn_global_load_lds((const unsigned*)((const char*)(gbase) + (voff)[_i]), (PG8_LAS unsigned*)(lds + (bufoff) + ldsw + _i * 8192), 16, 0, 0); } while (0)
#define PG8_LDA(dst, b, h) do { _Pragma("unroll") for (int m = 0; m < 4; ++m) _Pragma("unroll") for (int k = 0; k < 2; ++k) dst[m][k] = *(const PG8_LAS bf16x8*)(lds + PG8_SA(b, h) + aoff + m * 2048 + k * 1024); } while (0)
#define PG8_LDB(dst, b, h) do { _Pragma("unroll") for (int n = 0; n < 2; ++n) _Pragma("unroll") for (int k = 0; k < 2; ++k) dst[n][k] = *(const PG8_LAS bf16x8*)(lds + PG8_SB(b, h) + boff + n * 2048 + k * 1024); } while (0)
#define PG8_MMA(ai, bj, At, Bt) do { __builtin_amdgcn_s_setprio(1); _Pragma("unroll") for (int m = 0; m < 4; ++m) _Pragma("unroll") for (int n = 0; n < 2; ++n) _Pragma("unroll") for (int k = 0; k < 2; ++k) \
        acc[ai][bj][m][n] = __builtin_amdgcn_mfma_f32_16x16x32_bf16(Bt[n][k], At[m][k], acc[ai][bj][m][n], 0, 0, 0); __builtin_amdgcn_s_setprio(0); } while (0)
#define PG8_WAIT_V(n) asm volatile("s_waitcnt vmcnt(" #n ")" ::: "memory")
#define PG8_WAIT_L(n) asm volatile("s_waitcnt lgkmcnt(" #n ")" ::: "memory")
#define PG8_BAR __builtin_amdgcn_s_barrier()
#define PG8_SCHED __builtin_amdgcn_sched_barrier(0)
    Unit cur, nxt; int ui = 0;
    if (!S.next(0, cur)) return;
    f32x4 acc[2][2][4][2];
#pragma unroll
    for (int a = 0; a < 2; ++a)
#pragma unroll
        for (int b = 0; b < 2; ++b)
#pragma unroll
            for (int m = 0; m < 4; ++m)
#pragma unroll
                for (int n = 0; n < 2; ++n) acc[a][b][m][n] = (f32x4){0.f, 0.f, 0.f, 0.f};
    bf16x8 At[4][2], B0[2][2], B1[2][2];
    const char* cA = (const char*)g.A + (size_t)S.arow(cur.pm) * (size_t)K * 2; const char* cB = (const char*)g.Bt + (size_t)cur.pn * tstep;
    S.a_ready(cur);
    if constexpr (SP2) {
        PG8_STAGE(PG8_SB(0, 0), cB, voffB); PG8_STAGE(PG8_SB(0, 1), cB + hstep, voffB); PG8_STAGE(PG8_SA(0, 0), cA, voffA); PG8_STAGE(PG8_SA(0, 1), cA + hstep, voffA);
        if (wr == 1) PG8_BAR;
        PG8_WAIT_V(2); PG8_BAR;
        PG8_STAGE(PG8_SB(1, 0), cB + kstep, voffB); PG8_STAGE(PG8_SA(1, 0), cA + kstep, voffA); PG8_STAGE(PG8_SB(1, 1), cB + hstep + kstep, voffB);
        PG8_WAIT_V(6); PG8_BAR;
    } else {
        PG8_STAGE(PG8_SB(0, 0), cB, voffB); PG8_STAGE(PG8_SA(0, 0), cA, voffA); PG8_STAGE(PG8_SB(0, 1), cB + hstep, voffB); PG8_STAGE(PG8_SA(0, 1), cA + hstep, voffA);
        if (wr == 1) PG8_BAR;
        PG8_WAIT_V(4); PG8_BAR;
        PG8_STAGE(PG8_SB(1, 0), cB + kstep, voffB); PG8_STAGE(PG8_SA(1, 0), cA + kstep, voffA); PG8_STAGE(PG8_SB(1, 1), cB + hstep + kstep, voffB);
        PG8_WAIT_V(6); PG8_BAR;
    }
    for (;;) {
        const bool has_next = S.next(ui + 1, nxt);
        const char* nA = has_next ? (const char*)g.A + (size_t)S.arow(nxt.pm) * (size_t)K * 2 : cA; const char* nB = has_next ? (const char*)g.Bt + (size_t)nxt.pn * tstep : cB;
        for (int t = 0; t < nt; t += 2) {
            const bool last = (t == nt - 2);
            const char* a1 = cA + (size_t)(t + 1) * kstep;
            const char* a2 = last ? nA : cA + (size_t)(t + 2) * kstep; const char* b2 = last ? nB : cB + (size_t)(t + 2) * kstep;
            const char* a3 = a2 + kstep; const char* b3 = b2 + kstep;
            if (last && has_next) S.a_ready(nxt);
            if constexpr (SP2) {
            PG8_LDB(B0, 0, 0); PG8_LDB(B1, 0, 1); PG8_SCHED; PG8_LDA(At, 0, 0); PG8_STAGE(PG8_SA(1, 1), a1 + hstep, voffA);
            PG8_WAIT_V(8); PG8_WAIT_L(0); PG8_BAR; PG8_MMA(0, 0, At, B0); PG8_MMA(0, 1, At, B1); PG8_BAR; PG8_SCHED;
            PG8_LDA(At, 0, 1); PG8_STAGE(PG8_SB(0, 0), b2, voffB); PG8_STAGE(PG8_SB(0, 1), b2 + hstep, voffB); PG8_STAGE(PG8_SA(0, 0), a2, voffA);
            PG8_WAIT_V(8); PG8_WAIT_L(0); PG8_BAR; PG8_MMA(1, 0, At, B0); PG8_MMA(1, 1, At, B1); PG8_BAR; PG8_SCHED;
            PG8_LDB(B0, 1, 0); PG8_LDB(B1, 1, 1); PG8_SCHED; PG8_LDA(At, 1, 0); PG8_STAGE(PG8_SA(0, 1), a2 + hstep, voffA);
            PG8_WAIT_V(8); PG8_WAIT_L(0); PG8_BAR; PG8_MMA(0, 0, At, B0); PG8_MMA(0, 1, At, B1); PG8_BAR; PG8_SCHED;
            PG8_LDA(At, 1, 1); PG8_STAGE(PG8_SB(1, 0), b3, voffB); PG8_STAGE(PG8_SB(1, 1), b3 + hstep, voffB); PG8_STAGE(PG8_SA(1, 0), a3, voffA);
            PG8_WAIT_V(8); PG8_WAIT_L(0); PG8_BAR; PG8_MMA(1, 0, At, B0); PG8_MMA(1, 1, At, B1); PG8_BAR; PG8_SCHED;
            } else {
            PG8_LDB(B0, 0, 0); PG8_SCHED; PG8_LDA(At, 0, 0); PG8_STAGE(PG8_SA(1, 1), a1 + hstep, voffA);
            PG8_WAIT_L(8); PG8_BAR; PG8_WAIT_L(0); PG8_MMA(0, 0, At, B0); PG8_BAR; PG8_SCHED;
            PG8_LDB(B1, 0, 1); PG8_STAGE(PG8_SB(0, 0), b2, voffB);
            PG8_BAR; PG8_WAIT_L(0); PG8_MMA(0, 1, At, B1); PG8_BAR;
            PG8_LDA(At, 0, 1); PG8_STAGE(PG8_SA(0, 0), a2, voffA);
            PG8_BAR; PG8_WAIT_L(0); PG8_MMA(1, 0, At, B0); PG8_BAR; PG8_SCHED;
            PG8_STAGE(PG8_SB(0, 1), b2 + hstep, voffB);
            PG8_WAIT_V(6); PG8_BAR; PG8_MMA(1, 1, At, B1); PG8_BAR;
            PG8_LDB(B0, 1, 0); PG8_SCHED; PG8_LDA(At, 1, 0); PG8_STAGE(PG8_SA(0, 1), a2 + hstep, voffA);
            PG8_WAIT_L(8); PG8_BAR; PG8_WAIT_L(0); PG8_MMA(0, 0, At, B0); PG8_BAR; PG8_SCHED;
            PG8_LDB(B1, 1, 1); PG8_STAGE(PG8_SB(1, 0), b3, voffB);
            PG8_BAR; PG8_WAIT_L(0); PG8_MMA(0, 1, At, B1); PG8_BAR;
            PG8_LDA(At, 1, 1); PG8_STAGE(PG8_SA(1, 0), a3, voffA);
            PG8_BAR; PG8_WAIT_L(0); PG8_MMA(1, 0, At, B0); PG8_BAR; PG8_SCHED;
            PG8_STAGE(PG8_SB(1, 1), b3 + hstep, voffB);
            PG8_WAIT_V(6); PG8_BAR; PG8_MMA(1, 1, At, B1); PG8_BAR;
            }
        }
        if constexpr (ALIGN_EPI) { if (wr == 0) PG8_BAR; }
        if constexpr (!Epi::AFTER_DRAIN) { E(acc, cur, wr, wc, fr, fq); S.done(cur); }
        if (!has_next) break;
#pragma unroll
        for (int a = 0; a < 2; ++a)
#pragma unroll
            for (int b = 0; b < 2; ++b)
#pragma unroll
                for (int m = 0; m < 4; ++m)
#pragma unroll
                    for (int n = 0; n < 2; ++n) acc[a][b][m][n] = (f32x4){0.f, 0.f, 0.f, 0.f};
        cur = nxt; cA = nA; cB = nB; ++ui;
        if constexpr (ALIGN_EPI) { if (wr == 1) PG8_BAR; }
    }
    PG8_WAIT_V(0);
    if constexpr (!ALIGN_EPI) { if (wr == 0) PG8_BAR; }
    PG8_BAR;
    if constexpr (Epi::AFTER_DRAIN) { E.fused(acc, cur, wr, wc, fr, fq, lds, wid, lane); S.done(cur); }
#undef PG8_SA
#undef PG8_SB
#undef PG8_STAGE
#undef PG8_LDA
#undef PG8_LDB
#undef PG8_MMA
#undef PG8_WAIT_V
#undef PG8_WAIT_L
#undef PG8_BAR
#undef PG8_SCHED
}
}

namespace pg8 {
__device__ __forceinline__ unsigned cvt_pk_bf16(float lo, float hi) { unsigned r; asm volatile("v_cvt_pk_bf16_f32 %0, %1, %2" : "=v"(r) : "v"(lo), "v"(hi)); return r; }
__device__ __forceinline__ f32x4 gelu4(f32x4 v) { f32x4 o; o.x = gelu_tanh(v.x); o.y = gelu_tanh(v.y); o.z = gelu_tanh(v.z); o.w = gelu_tanh(v.w); return o; }
__device__ __forceinline__ float row_rstd(const float* rsq, int row) {
    const GAS f32x4* p = (const GAS f32x4*)(rsq + (size_t)row * 16);
    const f32x4 a = p[0], b = p[1], c = p[2], d = p[3];
    const float s = ((a.x + a.y) + (a.z + a.w)) + ((b.x + b.y) + (b.z + b.w)) + ((c.x + c.y) + (c.z + c.w)) + ((d.x + d.y) + (d.z + d.w));
    return rsqrtf(s * (1.f / D) + EPS);
}
__device__ __forceinline__ int tile_cidx(int trow) { return trow < NPROMPT ? 0 : 1 + ((trow - NPROMPT) >> 10); }
__device__ __forceinline__ void rstd_table(PG8_LAS float* tab, const float* rsq, int row_start, int wr, int wc, int fr, int fq) {
    const int t = (wr * 4 + wc) * 64 + fq * 16 + fr;
    if (t < 256) tab[t] = row_rstd(rsq, row_start + t);
    asm volatile("s_waitcnt lgkmcnt(0)" ::: "memory"); __builtin_amdgcn_s_barrier(); asm volatile("" ::: "memory");
}
template <int ACT> struct EpiBf16 {
    static constexpr bool PERM = true, AFTER_DRAIN = false;
    bf16_t* O; int ldc; const float* bias; int split_cols; size_t split_stride; const float* rsq; const float* b2; int N; float* rsqv; int vt0; PG8_LAS float* tab;
    __device__ __forceinline__ void operator()(f32x4 (&acc)[2][2][4][2], const Unit& u, int wr, int wc, int fr, int fq) const {
        asm volatile("" : "+v"(fr), "+v"(fq));
        rstd_table(tab, rsq, u.pm * BM, wr, wc, fr, fq);
        const int lrow0 = wr * 64 + fr; int colt = u.pn * BM; bf16_t* base = O; int t = 0;
        if (split_cols) { t = colt / split_cols; base += (size_t)t * split_stride; colt -= t * split_cols; }
        const bool act = (ACT == 1) || (ACT == 2 && t == 0);
        const int col0 = colt + wc * 32 + 8 * fq, bcol0 = u.pn * BM + wc * 32 + 8 * fq;
        const float* b2p = b2 + (size_t)tile_cidx(u.pm * BM) * N + bcol0;
        const bool wantv = rsqv != nullptr && u.pn >= vt0;
        float ss[8];
#pragma unroll
        for (int i = 0; i < 8; ++i) ss[i] = 0.f;
#pragma unroll
        for (int bj = 0; bj < 2; ++bj) { f32x4 bv0 = *(const GAS f32x4*)(b2p + bj * HALF), bv1 = *(const GAS f32x4*)(b2p + bj * HALF + 4);
            if (bias) { bv0 += *(const GAS f32x4*)(bias + bcol0 + bj * HALF); bv1 += *(const GAS f32x4*)(bias + bcol0 + bj * HALF + 4); }
#pragma unroll
            for (int ai = 0; ai < 2; ++ai)
#pragma unroll
                for (int m = 0; m < 4; ++m) { const int lrow = lrow0 + ai * HALF + m * 16; const float rs = tab[lrow];
                    f32x4 v0 = acc[ai][bj][m][0] * rs + bv0, v1 = acc[ai][bj][m][1] * rs + bv1;
                    if (ACT != 0) { if (act) { v0 = gelu4(v0); v1 = gelu4(v1); } }
                    ss[ai * 4 + m] += (v0[0] * v0[0] + v0[1] * v0[1]) + (v0[2] * v0[2] + v0[3] * v0[3]) + (v1[0] * v1[0] + v1[1] * v1[1]) + (v1[2] * v1[2] + v1[3] * v1[3]);
                    u32x4 w; w.x = cvt_pk_bf16(v0[0], v0[1]); w.y = cvt_pk_bf16(v0[2], v0[3]); w.z = cvt_pk_bf16(v1[0], v1[1]); w.w = cvt_pk_bf16(v1[2], v1[3]);
                    *(GAS u32x4*)(base + (size_t)(u.pm * BM + lrow) * ldc + col0 + bj * HALF) = w; } }
        if (wantv) {
#pragma unroll
            for (int i = 0; i < 8; ++i) { float q = ss[i]; q = sum_q4(q);
                if (fq == 0) *(GAS float*)(rsqv + (size_t)(u.pm * BM + lrow0 + (i >> 2) * HALF + (i & 3) * 16) * 32 + (u.pn - vt0) * 4 + wc) = q; } }
    }
};
struct EpiResid {
    static constexpr bool PERM = true, AFTER_DRAIN = false;
    float* out; const float* xp; const float* xs; const float* modl; int which; bool from_input;
    bf16_t* H; const float* ng; const float* modn; int whichs; float* rsq_out;
    __device__ __forceinline__ void operator()(f32x4 (&acc)[2][2][4][2], const Unit& u, int wr, int wc, int fr, int fq) const {
        asm volatile("" : "+v"(fr), "+v"(fq));
        const int trow = u.pm * BM, row0 = wr * 64 + fr, col0 = u.pn * BM + wc * 32 + 8 * fq, ci = tile_cidx(trow);
        const GAS float* gpg = (const GAS float*)(modl + (size_t)(ci * 6 + which) * D + col0);
        const GAS float* bpg = (const GAS float*)(from_input ? (trow < NPROMPT ? xp + (size_t)trow * D : xs + (size_t)(trow - NPROMPT) * D) : out + (size_t)trow * D);
        GAS float* op = (GAS float*)(out + (size_t)trow * D);
        float ss[8];
#pragma unroll
        for (int i = 0; i < 8; ++i) ss[i] = 0.f;
#pragma unroll
        for (int bj = 0; bj < 2; ++bj) {
            const f32x4 gv0 = *(const GAS f32x4*)(gpg + bj * HALF), gv1 = *(const GAS f32x4*)(gpg + bj * HALF + 4);
            f32x4 gs0 = {0.f, 0.f, 0.f, 0.f}, gs1 = {0.f, 0.f, 0.f, 0.f};
            if (H) { const GAS float* sp = (const GAS float*)(modn + (size_t)(ci * 6 + whichs) * D + col0 + bj * HALF); const GAS float* np = (const GAS float*)(ng + col0 + bj * HALF);
                gs0 = *(const GAS f32x4*)np * (1.f + *(const GAS f32x4*)sp); gs1 = *(const GAS f32x4*)(np + 4) * (1.f + *(const GAS f32x4*)(sp + 4)); }
#pragma unroll
            for (int ai = 0; ai < 2; ++ai)
#pragma unroll
                for (int m = 0; m < 4; ++m) { const int lrow = row0 + ai * HALF + m * 16; const size_t off = (size_t)lrow * D + col0 + bj * HALF;
                    f32x4 x0 = *(const GAS f32x4*)(bpg + off), x1 = *(const GAS f32x4*)(bpg + off + 4);
                    x0 += gv0 * acc[ai][bj][m][0]; x1 += gv1 * acc[ai][bj][m][1];
                    *(GAS f32x4*)(op + off) = x0; *(GAS f32x4*)(op + off + 4) = x1;
                    if (H) { ss[ai * 4 + m] += (x0[0] * x0[0] + x0[1] * x0[1]) + (x0[2] * x0[2] + x0[3] * x0[3]) + (x1[0] * x1[0] + x1[1] * x1[1]) + (x1[2] * x1[2] + x1[3] * x1[3]);
                        const f32x4 a0 = x0 * gs0, a1 = x1 * gs1;
                        u32x4 w; w.x = cvt_pk_bf16(a0[0], a0[1]); w.y = cvt_pk_bf16(a0[2], a0[3]); w.z = cvt_pk_bf16(a1[0], a1[1]); w.w = cvt_pk_bf16(a1[2], a1[3]);
                        *(GAS u32x4*)(H + (size_t)(trow + lrow) * D + col0 + bj * HALF) = w; }
                    if (m & 1) asm volatile("" ::: "memory"); } }
        if (H) {
#pragma unroll
            for (int i = 0; i < 8; ++i) { float q = ss[i]; q = sum_q4(q);
                if (fq == 0) *(GAS float*)(rsq_out + (size_t)(trow + row0 + (i >> 2) * HALF + (i & 3) * 16) * 16 + u.pn * 4 + wc) = q; } }
    }
};

__device__ __forceinline__ void ffn_tile_geom(int pm, int& rs, int& vlo, int& vhi) {
    if (pm < 32) { rs = 256 * pm; vlo = 0; vhi = 255; }
    else { const int sq = (pm - 32) / 5, i = (pm - 32) % 5; rs = NPROMPT + 1024 * sq + (i < 4 ? 254 * i : 768); vlo = i == 0 ? 0 : (i < 4 ? 1 : 249); vhi = i < 4 ? 254 : 255; }
}
struct FfnOrder : StaticOrder {
    __device__ __forceinline__ int arow(int pm) const { int rs, a, b; ffn_tile_geom(pm, rs, a, b); return rs; }
};
__device__ __forceinline__ float dpp_prev(float oldv, float v) {
    return __builtin_bit_cast(float, __builtin_amdgcn_update_dpp(__builtin_bit_cast(int, oldv), __builtin_bit_cast(int, v), 0x111, 0xf, 0xf, false)); }
__device__ __forceinline__ float dpp_next(float oldv, float v) {
    return __builtin_bit_cast(float, __builtin_amdgcn_update_dpp(__builtin_bit_cast(int, oldv), __builtin_bit_cast(int, v), 0x101, 0xf, 0xf, false)); }
__device__ __forceinline__ float dpp_ror1(float v) { return __builtin_bit_cast(float, __builtin_amdgcn_update_dpp(0, __builtin_bit_cast(int, v), 0x121, 0xf, 0xf, false)); }
__device__ __forceinline__ float dpp_ror15(float v) { return __builtin_bit_cast(float, __builtin_amdgcn_update_dpp(0, __builtin_bit_cast(int, v), 0x12F, 0xf, 0xf, false)); }
struct EpiFfn {
    static constexpr bool PERM = true, AFTER_DRAIN = false;
    bf16_t* ACT; const float* cw; const float* cb; PG8_LAS float* xb; const float* rsq; const float* b2;
    __device__ __forceinline__ void operator()(f32x4 (&acc)[2][2][4][2], const Unit& u, int wr, int wc, int fr, int fq) const {
        asm volatile("" : "+v"(fr), "+v"(fq));
        int rs, vlo, vhi; ffn_tile_geom(u.pm, rs, vlo, vhi);
        const int colw = wc * 32 + 8 * fq;
        rstd_table(xb + 2048, rsq, rs, wr, wc, fr, fq);
        { const float* b2p = b2 + (size_t)tile_cidx(rs) * 2 * DFF + u.pn * 256 + colw;
#pragma unroll
          for (int bj = 0; bj < 2; ++bj) { const f32x4 bz0 = *(const GAS f32x4*)(b2p + bj * 128), bz1 = *(const GAS f32x4*)(b2p + bj * 128 + 4);
#pragma unroll
              for (int ai = 0; ai < 2; ++ai)
#pragma unroll
                  for (int m = 0; m < 4; ++m) { const float rsd = xb[2048 + 128 * ai + 64 * wr + 16 * m + fr];
                      acc[ai][bj][m][0] = acc[ai][bj][m][0] * rsd + bz0; acc[ai][bj][m][1] = acc[ai][bj][m][1] * rsd + bz1; } } }
#pragma unroll
        for (int ai = 0; ai < 2; ++ai) { const int b = 2 * ai + wr;
            if (fr == 0) {
#pragma unroll
                for (int bj = 0; bj < 2; ++bj)
#pragma unroll
                    for (int n = 0; n < 2; ++n) *(PG8_LAS f32x4*)(xb + (b * 2 + 0) * 256 + bj * 128 + colw + 4 * n) = acc[ai][bj][0][n]; }
            if (fr == 15) {
#pragma unroll
                for (int bj = 0; bj < 2; ++bj)
#pragma unroll
                    for (int n = 0; n < 2; ++n) *(PG8_LAS f32x4*)(xb + (b * 2 + 1) * 256 + bj * 128 + colw + 4 * n) = acc[ai][bj][3][n]; } }
        asm volatile("s_waitcnt lgkmcnt(0)" ::: "memory"); __builtin_amdgcn_s_barrier(); asm volatile("" ::: "memory");
        GAS unsigned char* actb = (GAS unsigned char*)ACT;
        const unsigned lane_off = (unsigned)((rs + 64 * wr + fr) * DFF + u.pn * 128 + colw) * 2u;
#pragma unroll
        for (int n = 0; n < 2; ++n) {
            const int ch = u.pn * 128 + colw + 4 * n;
            f32x4 wg[3], wu[3];
#pragma unroll
            for (int k = 0; k < 3; ++k) { wg[k] = *(const GAS f32x4*)(cw + (size_t)k * 2 * DFF + ch); wu[k] = *(const GAS f32x4*)(cw + (size_t)k * 2 * DFF + DFF + ch); }
            const f32x4 bgv = *(const GAS f32x4*)(cb + ch), buv = *(const GAS f32x4*)(cb + DFF + ch);
#pragma unroll
            for (int ai = 0; ai < 2; ++ai) { const int b = 2 * ai + wr;
                f32x4 pz[2], nz[2];
#pragma unroll
                for (int bj = 0; bj < 2; ++bj) { pz[bj] = b > 0 ? *(PG8_LAS const f32x4*)(xb + ((b - 1) * 2 + 1) * 256 + bj * 128 + colw + 4 * n) : (f32x4){0.f, 0.f, 0.f, 0.f};
                                                 nz[bj] = b < 3 ? *(PG8_LAS const f32x4*)(xb + ((b + 1) * 2 + 0) * 256 + bj * 128 + colw + 4 * n) : (f32x4){0.f, 0.f, 0.f, 0.f}; }
#pragma unroll
                for (int m = 0; m < 4; ++m) { f32x4 zc[2];
#pragma unroll
                    for (int bj = 0; bj < 2; ++bj) { const f32x4 z = acc[ai][bj][m][n]; const f32x4* w3 = bj == 0 ? wg : wu; f32x4 o = bj == 0 ? bgv : buv;
#pragma unroll
                        for (int e = 0; e < 4; ++e) { const float up = m > 0 ? dpp_ror1(acc[ai][bj][m - 1][n][e]) : pz[bj][e], dn = m < 3 ? dpp_ror15(acc[ai][bj][m + 1][n][e]) : nz[bj][e];
                            o[e] += w3[0][e] * dpp_prev(up, z[e]) + w3[1][e] * z[e] + w3[2][e] * dpp_next(dn, z[e]); }
                        zc[bj] = o; }
                    const int lr = 128 * ai + 64 * wr + 16 * m + fr;
                    if (lr >= vlo && lr <= vhi) { u32x2 w; w.x = cvt_pk_bf16(siluf_(zc[0][0]) * zc[1][0], siluf_(zc[0][1]) * zc[1][1]); w.y = cvt_pk_bf16(siluf_(zc[0][2]) * zc[1][2], siluf_(zc[0][3]) * zc[1][3]);
                        *(GAS u32x2*)(actb + (lane_off + (unsigned)((128 * ai + 16 * m) * DFF + 4 * n) * 2u)) = w; } }
                asm volatile("" ::: "memory"); }
        }
    }
};

struct EpiQkv {
    static constexpr bool PERM = true, AFTER_DRAIN = false;
    unsigned char* ws; float* out; const float* rsq; const float* b2; PG8_LAS float* tab; const float* qkg; const float* rope;
    __device__ __forceinline__ void operator()(f32x4 (&acc)[2][2][4][2], const Unit& u, int wr, int wc, int fr, int fq) const {
        asm volatile("" : "+v"(fr), "+v"(fq));
        const int trow = u.pm * BM; const bool smp = trow >= NPROMPT; const int sb = smp ? (trow - NPROMPT) >> 10 : 0, tq0 = smp ? (trow - NPROMPT) & 1023 : 0;
        rstd_table(tab, rsq, trow, wr, wc, fr, fq);
        const int kind = u.pn >> 2, tcol = u.pn * BM + wc * 32 + 8 * fq;
        const float* b2p = b2 + (size_t)tile_cidx(trow) * 3 * D + tcol;
        if (kind < 2) {
            const int oc = (u.pn & 3) * 256 + wc * 64 + 8 * fq;
            f32x4 bz[2][2], gq[2][2];
#pragma unroll
            for (int bj = 0; bj < 2; ++bj)
#pragma unroll
                for (int n = 0; n < 2; ++n) { bz[bj][n] = *(const GAS f32x4*)(b2p + bj * HALF + 4 * n); gq[bj][n] = *(const GAS f32x4*)(qkg + kind * 64 + 32 * bj + 8 * fq + 4 * n); }
#pragma unroll
            for (int ai = 0; ai < 2; ++ai)
#pragma unroll
                for (int m = 0; m < 4; ++m) { const int lrow = 128 * ai + 64 * wr + 16 * m + fr; const float rs = tab[lrow];
                    f32x4 v[2][2]; float ss = 0.f;
#pragma unroll
                    for (int bj = 0; bj < 2; ++bj)
#pragma unroll
                        for (int n = 0; n < 2; ++n) { v[bj][n] = acc[ai][bj][m][n] * rs + bz[bj][n]; ss += (v[bj][n][0] * v[bj][n][0] + v[bj][n][1] * v[bj][n][1]) + (v[bj][n][2] * v[bj][n][2] + v[bj][n][3] * v[bj][n][3]); }
                    ss = sum_q4(ss);
                    const float rn = rsqrtf(ss * (1.f / 64.f) + EPS);
#pragma unroll
                    for (int bj = 0; bj < 2; ++bj)
#pragma unroll
                        for (int n = 0; n < 2; ++n) v[bj][n] = v[bj][n] * rn * gq[bj][n];
                    const unsigned row = (unsigned)(trow + lrow);
                    if (!smp) {
                        if (kind == 1) {
#pragma unroll
                            for (int bj = 0; bj < 2; ++bj)
#pragma unroll
                                for (int n = 0; n < 2; ++n) *(GAS f32x4*)((GAS unsigned char*)out + O_CK * 4 + (row * (unsigned)D + oc + 32 * bj + 4 * n) * 4u) = v[bj][n]; }
                    } else { const int t = tq0 + lrow;
#pragma unroll
                        for (int n = 0; n < 2; ++n) { const f32x4 cs = *(const GAS f32x4*)(rope + t * 32 + 8 * fq + 4 * n), sn = *(const GAS f32x4*)(rope + 32768 + t * 32 + 8 * fq + 4 * n);
                            const f32x4 x1 = v[0][n], x2 = v[1][n]; v[0][n] = x1 * cs - x2 * sn; v[1][n] = x2 * cs + x1 * sn; } }
                    const size_t doff = kind == 0 ? WS_T2 : (smp ? WS_KS : WS_T2 + (size_t)M * D * 2); GAS unsigned char* dst = (GAS unsigned char*)ws + doff;
                    const unsigned drow = (kind == 1 && smp) ? (unsigned)(sb * TKS + PAST + tq0 + lrow) : row;
#pragma unroll
                    for (int bj = 0; bj < 2; ++bj) { u32x4 w; w.x = cvt_pk_bf16(v[bj][0][0], v[bj][0][1]); w.y = cvt_pk_bf16(v[bj][0][2], v[bj][0][3]); w.z = cvt_pk_bf16(v[bj][1][0], v[bj][1][1]); w.w = cvt_pk_bf16(v[bj][1][2], v[bj][1][3]);
                        *(GAS u32x4*)(dst + (drow * (unsigned)D + oc + 32 * bj) * 2u) = w; }
                    if (m & 1) asm volatile("" ::: "memory"); }
        } else {
            const int oc = (u.pn - 8) * 256 + wc * 32 + 8 * fq;
            const size_t doff = smp ? WS_VS : WS_T2 + (size_t)M * D * 2 + (size_t)NPROMPT * D * 2; GAS unsigned char* dst = (GAS unsigned char*)ws + doff;
#pragma unroll
            for (int bj = 0; bj < 2; ++bj) { const f32x4 bz0 = *(const GAS f32x4*)(b2p + bj * HALF), bz1 = *(const GAS f32x4*)(b2p + bj * HALF + 4);
#pragma unroll
                for (int ai = 0; ai < 2; ++ai)
#pragma unroll
                    for (int m = 0; m < 4; ++m) { const int lrow = 128 * ai + 64 * wr + 16 * m + fr; const float rs = tab[lrow];
                        const f32x4 v0 = acc[ai][bj][m][0] * rs + bz0, v1 = acc[ai][bj][m][1] * rs + bz1;
                        const unsigned row = (unsigned)(trow + lrow), drow = smp ? (unsigned)(sb * TKS + PAST + tq0 + lrow) : row;
                        u32x4 w; w.x = cvt_pk_bf16(v0[0], v0[1]); w.y = cvt_pk_bf16(v0[2], v0[3]); w.z = cvt_pk_bf16(v1[0], v1[1]); w.w = cvt_pk_bf16(v1[2], v1[3]);
                        *(GAS u32x4*)(dst + (drow * (unsigned)D + oc + 128 * bj) * 2u) = w;
                        if (!smp) { *(GAS f32x4*)((GAS unsigned char*)out + O_CV * 4 + (row * (unsigned)D + oc + 128 * bj) * 4u) = v0; *(GAS f32x4*)((GAS unsigned char*)out + O_CV * 4 + (row * (unsigned)D + oc + 128 * bj + 4) * 4u) = v1; } } }
        }
    }
};
}

struct Params { const float* in[N_IN]; float* out; unsigned char* ws; };
struct Frame {
    LAS unsigned char* lds; int tid, lane, wave, bid, G, wave0;
    float* out; unsigned char* ws; float* out0; unsigned char* ws0;
    __device__ __forceinline__ const float* inp(int i) const { const unsigned long long v = ((LAS const unsigned long long*)(lds + PTR_OFF))[i];
        const unsigned lo = __builtin_amdgcn_readfirstlane((unsigned)v), hi = __builtin_amdgcn_readfirstlane((unsigned)(v >> 32)); return (const float*)(const GAS float*)(((unsigned long long)hi << 32) | lo); }
    float* mod; float* rstd; float* rope; bf16 *H, *T1, *T2, *T3, *KS, *VS, *WT; float *rsq0, *rsq1, *rsqv, *bias2;
    __device__ __forceinline__ void fresh() {
        int z = 0; asm volatile("" : "+v"(z));
        lane = __builtin_amdgcn_mbcnt_hi(~0u, __builtin_amdgcn_mbcnt_lo(~0u, z)); int wv = wave0; asm volatile("" : "+s"(wv)); wave = wv; tid = wv * 64 + lane;
        int b = blockIdx.x; asm volatile("" : "+s"(b)); bid = b;
        unsigned char* w = ws0; asm volatile("" : "+s"(w)); w = (unsigned char*)(GAS unsigned char*)(unsigned long long)w; ws = w; float* o = out0; asm volatile("" : "+s"(o)); o = (float*)(GAS float*)(unsigned long long)o; out = o;
        mod = (float*)(w + WS_MOD); rstd = (float*)(w + WS_RSTD); rope = (float*)(w + WS_ROPE);
        H = (bf16*)(w + WS_H); T1 = (bf16*)(w + WS_T1); T2 = (bf16*)(w + WS_T2); T3 = (bf16*)(w + WS_T3); KS = (bf16*)(w + WS_KS); VS = (bf16*)(w + WS_VS); WT = (bf16*)(w + WS_W);
        rsq0 = (float*)(w + WS_X); rsq1 = (float*)(w + WS_X + MiB); rsqv = (float*)(w + WS_X + 2 * MiB); bias2 = (float*)(w + WS_X + 4 * MiB);
    }
};
__device__ __forceinline__ const float* xin_row(const Frame& F, int row) { return row < NPROMPT ? F.inp(I_XP) + (size_t)row * D : F.inp(I_XS) + (size_t)(row - NPROMPT) * D; }
__device__ __forceinline__ int cidx_of(int row) { return row < NPROMPT ? 0 : 1 + ((row - NPROMPT) >> 10); }
__device__ __forceinline__ const float* modp(const Frame& F, int l, int row, int which) { return F.mod + (size_t)((l * 3 + cidx_of(row)) * 6 + which) * D; }


template <int MODE  >
__device__ __forceinline__ void transpose_item(const float* W, int K, int N, bf16* WT, LAS float* scr, int item, int lane) {
    const int nblk = N / 32, kb = item / nblk, nb = item % nblk, k0 = 64 * kb, n0 = 32 * nb;
    int d0 = n0; if (MODE == 1) { const int isu = n0 >= DFF, jj = n0 - isu * DFF; d0 = (jj >> 7) * 256 + isu * 128 + (jj & 127); }
    if (MODE == 2 && n0 < 2 * D) { const int w = n0 & 255; d0 = (n0 & ~255) + ((w >> 5) & 1) * 128 + (w >> 6) * 32; }
#pragma unroll 8
    for (int i = 0; i < 32; ++i) { const int kk = 2 * i + (lane >> 5); scr[kk * 33 + (lane & 31)] = W[(size_t)(k0 + kk) * N + n0 + (lane & 31)]; }
    asm volatile("s_waitcnt lgkmcnt(0)" ::: "memory");
    const int c = lane & 7;
#pragma unroll
    for (int j = 0; j < 4; ++j) { const int n = (lane >> 3) + 8 * j; const LAS float* sp = scr + (8 * c) * 33 + n;
        u32x4 o; o.x = f2bf(sp[0 * 33]) | (f2bf(sp[1 * 33]) << 16); o.y = f2bf(sp[2 * 33]) | (f2bf(sp[3 * 33]) << 16); o.z = f2bf(sp[4 * 33]) | (f2bf(sp[5 * 33]) << 16); o.w = f2bf(sp[6 * 33]) | (f2bf(sp[7 * 33]) << 16);
        *(u32x4*)(WT + (size_t)(d0 + n) * K + k0 + 8 * c) = o; }
    asm volatile("s_waitcnt lgkmcnt(0)" ::: "memory");
}
template <int MODE = 0>
__device__ __forceinline__ bool transpose_group(int& r, const float* W, int nmat, int K, int N, bf16* WT, LAS float* scr, int lane) {
    const int per = (K / 64) * (N / 32), tot = nmat * per;
    if (r >= tot) { r -= tot; return false; }
    const int mi = r / per; transpose_item<MODE>(W + (size_t)mi * K * N, K, N, WT + (size_t)mi * K * N, scr, r % per, lane); return true;
}
__device__ __forceinline__ void phase_prologue(Frame& F) {
    F.fresh();
    LAS float* sc = (LAS float*)F.lds;
    const float* c = F.inp(I_C); const float* cctx = F.inp(I_CCTX);
    for (int i = F.tid; i < 3 * D; i += NT) { const int ci = i >> 10, k = i & 1023; const float v = ci == 0 ? cctx[k] : c[(ci - 1) * D + k]; sc[i] = siluf_(v); }
    __syncthreads();
    LAS float* part = sc + 3 * D;
    const int kp = F.tid >> 6, cl = F.tid & 63;
    for (int item = F.bid; item < DEPTH * 6 * D / 64; item += F.G) {
        const int col = item * 64 + cl, l = col / (6 * D), cc = col % (6 * D);
        const float* w = F.inp(I_WMOD) + (size_t)l * D * 6 * D + cc;
        float s0 = 0.f, s1 = 0.f, s2 = 0.f;
        for (int k = kp * 128; k < kp * 128 + 128; ++k) { const float wv = w[(size_t)k * 6 * D]; s0 += sc[k] * wv; s1 += sc[D + k] * wv; s2 += sc[2 * D + k] * wv; }
        part[(kp * 3 + 0) * 64 + cl] = s0; part[(kp * 3 + 1) * 64 + cl] = s1; part[(kp * 3 + 2) * 64 + cl] = s2;
        __syncthreads();
        if (F.tid < 192) { const int ci = F.tid >> 6; float s = F.inp(I_BMOD)[l * 6 * D + cc];
            for (int q = 0; q < 8; ++q) s += part[(q * 3 + ci) * 64 + cl];
            F.mod[(size_t)((l * 3 + ci) * 6) * D + cc] = s; }
        __syncthreads();
    }
    { __syncthreads();
      LAS float* scr = (LAS float*)(F.lds + F.wave * 16384);
      const int gw = F.bid * NWAVES + F.wave, NGW = F.G * NWAVES;
      constexpr int NITEMS = (int)(WE_END / 2048);
      for (int it = gw; it < NITEMS; it += NGW) { int r = it;
          if (transpose_group<1>(r, F.inp(I_FF_WUP), 4, D, 2 * DFF, F.WT + WE_UP, scr, F.lane)) continue;
          if (transpose_group(r, F.inp(I_FF_WDN), 4, DFF, D, F.WT + WE_DN, scr, F.lane)) continue;
          if (transpose_group(r, F.inp(I_LRU_WIN), 2, D, 2 * DRNN, F.WT + WE_LRU_IN, scr, F.lane)) continue;
          if (transpose_group(r, F.inp(I_LRU_WOUT), 2, DRNN, D, F.WT + WE_LRU_OUT, scr, F.lane)) continue;
          if (transpose_group(r, F.inp(I_CM_WIN), 1, D, 2 * DB, F.WT + WE_CM_IN, scr, F.lane)) continue;
          if (transpose_group(r, F.inp(I_CM_WOUT), 1, DB, D, F.WT + WE_CM_OUT, scr, F.lane)) continue;
          if (transpose_group<2>(r, F.inp(I_AT_WQKV), 1, D, 3 * D, F.WT + WE_QKV, scr, F.lane)) continue;
          if (transpose_group(r, F.inp(I_AT_WOUT), 1, D, D, F.WT + WE_AT_OUT, scr, F.lane)) continue;
          transpose_group(r, F.inp(I_LRU_WG), 80, 128, 128, F.WT + WE_WG, scr, F.lane); } }
    const int gt = F.bid * NT + F.tid, GT = F.G * NT;
    for (int i = gt; i < 1024 * 32; i += GT) { const int t = i >> 5, j = i & 31; const float inv = powf(10000.f, -(float)(j & 15) / 16.f); const float pos = (float)(j < 16 ? (t >> 6) : (t & 63));
        const float ang = pos * inv; F.rope[i] = cosf(ang); F.rope[32768 + i] = sinf(ang); }
    for (int i = gt; i < 8 * 8 * 4 * 64; i += GT) { const int ln = i & 63, ks = (i >> 6) & 3, nf = (i >> 8) & 7, g = i >> 11, cq = ln >> 4, p = 16 * nf + (ln & 15);
        const float* wr = F.inp(I_CM_WS) + (size_t)(g * 128 + p) * 128 + 32 * ks + 4 * cq;
        u32x4 o; o.x = f2bf(wr[0]) | (f2bf(wr[1]) << 16); o.y = f2bf(wr[2]) | (f2bf(wr[3]) << 16); o.z = f2bf(wr[16]) | (f2bf(wr[17]) << 16); o.w = f2bf(wr[18]) | (f2bf(wr[19]) << 16);
        *(u32x4*)(F.WT + WE_WSB + (size_t)i * 8) = o; }
    for (int i = gt; i < 2 * PAST * D; i += GT) { const int b = i / (PAST * D), r = i % (PAST * D);
        F.KS[(size_t)b * TKS * D + r] = (bf16)f2bf(F.inp(I_CK)[i]); F.VS[(size_t)b * TKS * D + r] = (bf16)f2bf(F.inp(I_CV)[i]); }
}

__device__ __forceinline__ void bias2_gemm(Frame& F, const bf16* Wt, int N, int l, int sub, float* outp) {
    const int gw = F.bid * NWAVES + F.wave, NGW = F.G * NWAVES;
    float sh[3][16];
#pragma unroll
    for (int ci = 0; ci < 3; ++ci) { const GAS f32x4* sp = (const GAS f32x4*)(F.mod + (size_t)((l * 3 + ci) * 6 + sub * 3) * D + 16 * F.lane);
#pragma unroll
        for (int i = 0; i < 4; ++i) { const f32x4 v = sp[i]; sh[ci][4 * i] = v.x; sh[ci][4 * i + 1] = v.y; sh[ci][4 * i + 2] = v.z; sh[ci][4 * i + 3] = v.w; } }
    for (int n = gw; n < N; n += NGW) { const GAS u32x4* wp = (const GAS u32x4*)(Wt + (size_t)n * D + 16 * F.lane); const u32x4 w0 = wp[0], w1 = wp[1];
        const unsigned ww[8] = {w0.x, w0.y, w0.z, w0.w, w1.x, w1.y, w1.z, w1.w};
        float d0 = 0.f, d1 = 0.f, d2 = 0.f;
#pragma unroll
        for (int i = 0; i < 8; ++i) { const float lo = bf2f(ww[i]), hi = bf2f(ww[i] >> 16); d0 += sh[0][2 * i] * lo + sh[0][2 * i + 1] * hi; d1 += sh[1][2 * i] * lo + sh[1][2 * i + 1] * hi; d2 += sh[2][2 * i] * lo + sh[2][2 * i + 1] * hi; }
        d0 = wave_sum(d0); d1 = wave_sum(d1); d2 = wave_sum(d2);
        if (F.lane == 0) { outp[n] = d0; outp[(size_t)N + n] = d1; outp[(size_t)2 * N + n] = d2; } }
}
__device__ __forceinline__ void phase_modulate0(Frame& F) {
    F.fresh();
    const int gw = F.bid * NWAVES + F.wave, NGW = F.G * NWAVES;
    const float* g = F.inp(I_NORMG);
    for (int row = gw; row < M; row += NGW) {
        const float* xr = xin_row(F, row); const float* scl = modp(F, 0, row, 1);
        f32x4 v[4]; float s = 0.f;
#pragma unroll
        for (int j = 0; j < 4; ++j) { v[j] = *(const GAS f32x4*)(xr + 4 * F.lane + 256 * j); s += v[j].x * v[j].x + v[j].y * v[j].y + v[j].z * v[j].z + v[j].w * v[j].w; }
        s = wave_sum(s);
        if (F.lane < 16) F.rsq0[(size_t)row * 16 + F.lane] = F.lane == 0 ? s : 0.f;
#pragma unroll
        for (int j = 0; j < 4; ++j) { const int c0 = 4 * F.lane + 256 * j; const f32x4 gg = *(const GAS f32x4*)(g + c0), c4 = *(const GAS f32x4*)(scl + c0);
            const f32x4 o = v[j] * gg * (1.f + c4); u32x2 w; w.x = f2bf(o.x) | (f2bf(o.y) << 16); w.y = f2bf(o.z) | (f2bf(o.w) << 16);
            *(GAS u32x2*)(F.H + (size_t)row * D + c0) = w; }
    }
    bias2_gemm(F, F.WT + WE_LRU_IN, 2 * DRNN, 0, 0, F.bias2 + B2_LRU);
    bias2_gemm(F, F.WT + WE_LRU_IN + (size_t)2 * DRNN * D, 2 * DRNN, 3, 0, F.bias2 + B2_LRU + 3 * 2560);
    bias2_gemm(F, F.WT + WE_CM_IN, 2 * DB, 1, 0, F.bias2 + B2_CM);
    bias2_gemm(F, F.WT + WE_QKV, 3 * D, 2, 0, F.bias2 + B2_QKV);
#pragma unroll 1
    for (int l = 0; l < DEPTH; ++l) bias2_gemm(F, F.WT + WE_UP + (size_t)l * 2 * DFF * D, 2 * DFF, l, 1, F.bias2 + B2_UP + (size_t)l * 3 * 5632);
}

template <class P>
__device__ __forceinline__ void gemm_naive(Frame& F, const P& p, int nbatch, int Mr, int N, int K) {
    F.fresh();
    LAS float* As = (LAS float*)F.lds;
    LAS float* Bs = As + 16 * 132;
    const int tid = F.tid, tx = tid & 31, ty = tid >> 5;
    const int tm = Mr / 128, tn = N / 128, per = tm * tn, total = per * nbatch;
    for (int t = F.bid; t < total; t += F.G) {
        const int b = t / per, r = t % per, pn = r / tm, pm = r % tm;
        const bf16* A; int lda; const float* W; int ldw; p.get(b, A, lda, W, ldw);
        float acc[8][4];
#pragma unroll
        for (int i = 0; i < 8; ++i)
#pragma unroll
            for (int j = 0; j < 4; ++j) acc[i][j] = 0.f;
        for (int k0 = 0; k0 < K; k0 += 16) {
            { const int row = tid >> 2, kq = (tid & 3) * 4;
              const u32x2 v = *(const u32x2*)(A + (size_t)(pm * 128 + row) * lda + k0 + kq);
              As[(kq + 0) * 132 + row] = bf2f(v.x); As[(kq + 1) * 132 + row] = bf2f(v.x >> 16); As[(kq + 2) * 132 + row] = bf2f(v.y); As[(kq + 3) * 132 + row] = bf2f(v.y >> 16); }
            { const int k = tid >> 5, n4 = (tid & 31) * 4;
              *(LAS f32x4*)(Bs + k * 128 + n4) = *(const f32x4*)(W + (size_t)(k0 + k) * ldw + pn * 128 + n4); }
            __syncthreads();
#pragma unroll 2
            for (int k = 0; k < 16; ++k) {
                const f32x4 a0 = *(const LAS f32x4*)(As + k * 132 + ty * 8), a1 = *(const LAS f32x4*)(As + k * 132 + ty * 8 + 4), bv = *(const LAS f32x4*)(Bs + k * 128 + tx * 4);
                const float a[8] = {a0.x, a0.y, a0.z, a0.w, a1.x, a1.y, a1.z, a1.w}; const float bb[4] = {bv.x, bv.y, bv.z, bv.w};
#pragma unroll
                for (int i = 0; i < 8; ++i)
#pragma unroll
                    for (int j = 0; j < 4; ++j) acc[i][j] += a[i] * bb[j];
            }
            __syncthreads();
        }
#pragma unroll
        for (int i = 0; i < 8; ++i)
#pragma unroll
            for (int j = 0; j < 4; ++j) p.epi(b, pm * 128 + ty * 8 + i, pn * 128 + tx * 4 + j, acc[i][j]);
    }
}

struct PStoreBf16 {
    const bf16* A; int lda; const float* W; int ldw; bf16* O; int ldo; const float* bias; int act; int split;
    __device__ __forceinline__ void get(int, const bf16*& a, int& la, const float*& w, int& lw) const { a = A; la = lda; w = W; lw = ldw; }
    __device__ __forceinline__ void epi(int, int row, int col, float v) const {
        if (bias) v += bias[col];
        if (act == 1 || (act == 2 && col < split)) v = gelu_tanh(v);
        O[(size_t)row * ldo + col] = (bf16)f2bf(v); }
};
struct PResid {
    const bf16* A; int lda; const float* W; int ldw; float* out; const float* xp; const float* xs; const float* modl; int which; bool from_input;
    __device__ __forceinline__ void get(int, const bf16*& a, int& la, const float*& w, int& lw) const { a = A; la = lda; w = W; lw = ldw; }
    __device__ __forceinline__ void epi(int, int row, int col, float v) const {
        const float base = from_input ? (row < NPROMPT ? xp[(size_t)row * D + col] : xs[(size_t)(row - NPROMPT) * D + col]) : out[(size_t)row * D + col];
        out[(size_t)row * D + col] = base + modl[(size_t)(cidx_of(row) * 6 + which) * D + col] * v; }
};
struct PLruIn {
    const bf16* A; const float* W; bf16* GBp; bf16* RECp;
    __device__ __forceinline__ void get(int, const bf16*& a, int& la, const float*& w, int& lw) const { a = A; la = D; w = W; lw = 2 * DRNN; }
    __device__ __forceinline__ void epi(int, int row, int col, float v) const {
        if (col < DRNN) GBp[(size_t)row * DRNN + col] = (bf16)f2bf(gelu_tanh(v)); else RECp[(size_t)row * DRNN + col - DRNN] = (bf16)f2bf(v); }
};
struct PGates {
    const bf16* XC; const float* WG; const float* BG; bf16* O;
    __device__ __forceinline__ void get(int b, const bf16*& a, int& la, const float*& w, int& lw) const { a = XC + (b % 10) * 128; la = DRNN; w = WG + (size_t)b * 128 * 128; lw = 128; }
    __device__ __forceinline__ void epi(int b, int row, int col, float v) const { const int dg = b / 10, n = b % 10;
        O[((size_t)dg * M + row) * DRNN + n * 128 + col] = (bf16)f2bf(sigmoidf_(v + BG[dg * DRNN + n * 128 + col])); }
};

__device__ __forceinline__ void phase_lru_conv(Frame& F, int j, const bf16* REC, bf16* XC) {
    F.fresh();
    const float* cw = F.inp(I_LRU_CW) + (size_t)j * 4 * DRNN; const float* cb = F.inp(I_LRU_CB) + (size_t)j * DRNN;
    const int gt = F.bid * NT + F.tid, GT = F.G * NT;
    for (int i = gt; i < M * DRNN; i += GT) { const int row = i / DRNN, ch = i % DRNN;
        int t, T; if (row < NPROMPT) { t = row & 255; T = 256; } else { t = (row - NPROMPT) & 1023; T = 1024; }
        float s = cb[ch];
#pragma unroll
        for (int k = 0; k < 4; ++k) { const int tt = t + k - 2; if (tt >= 0 && tt < T) s += cw[k * DRNN + ch] * bf2f(REC[(size_t)(row + k - 2) * DRNN + ch]); }
        XC[i] = (bf16)f2bf(s); }
}
__device__ __forceinline__ void phase_lru_scan(Frame& F, int j, const bf16* GATES, const bf16* XC, const bf16* GB, bf16* HS) {
    F.fresh();
    const int gt = F.bid * NT + F.tid, GT = F.G * NT;
    const int NL = (2 + 32) * DRNN;
    for (int line = gt; line < NL; line += GT) {
        const int s = line / DRNN, ch = line % DRNN;
        int base, T; float h0f = 0.f, h0b = 0.f;
        if (s < 2) { base = NPROMPT + s * 1024; T = 1024; h0f = F.inp(I_STATE)[((size_t)(s * 2 + j) * 2 + 0) * DRNN + ch]; h0b = F.inp(I_STATE)[((size_t)(s * 2 + j) * 2 + 1) * DRNN + ch]; }
        else { base = (s - 2) * 256; T = 256; }
        const float spf = softplusf_(-F.inp(I_LRU_LAM)[(size_t)(j * 2 + 0) * DRNN + ch]), spb = softplusf_(-F.inp(I_LRU_LAM)[(size_t)(j * 2 + 1) * DRNN + ch]);
        float h = h0f;
        for (int t = 0; t < T; ++t) { const size_t o = (size_t)(base + t) * DRNN + ch;
            const float r = bf2f(GATES[o]), ig = bf2f(GATES[(size_t)M * DRNN + o]), xc = bf2f(XC[o]);
            const float la = -8.f * r * spf, a = expf(la), bx = sqrtf(-expm1f(2.f * la)) * (ig * xc);
            h = a * h + bx; HS[o] = (bf16)f2bf(h); }
        const float ff = h;
        h = h0b;
        for (int t = T - 1; t >= 0; --t) { const size_t o = (size_t)(base + t) * DRNN + ch;
            const float r = bf2f(GATES[(size_t)2 * M * DRNN + o]), ig = bf2f(GATES[(size_t)3 * M * DRNN + o]), xc = bf2f(XC[o]);
            const float la = -8.f * r * spb, a = expf(la), bx = sqrtf(-expm1f(2.f * la)) * (ig * xc);
            h = a * h + bx; HS[o] = (bf16)f2bf(bf2f(GB[o]) * (bf2f(HS[o]) + h)); }
        if (s >= 2) { float* st = F.out + O_STATE + ((size_t)((s - 2) * 2 + j) * 2) * DRNN; st[ch] = ff; st[DRNN + ch] = h; }
    }
}


typedef short bf16x8 __attribute__((ext_vector_type(8)));
typedef short v4i16_t __attribute__((ext_vector_type(4)));
constexpr int LRU_XS = 272;
constexpr int LRU_XC_OFF = 0, LRU_GB_OFF = 256 * LRU_XS;
template <bool REV>
__device__ __forceinline__ float lru_dir(LAS const unsigned char* xct, LAS unsigned char* hft, const bf16* wgt  ,
                                         const bf16* gbp  , float br, float bi, float sp, float hc, int wave, int lane, bool wantp, bf16* Pdst) {
    const int c = lane & 15, q = lane >> 4, qq = REV ? 3 - q : q;
    bf16x8 Br[4], Bi[4], Id;
#pragma unroll
    for (int ks = 0; ks < 4; ++ks) { Br[ks] = *(const GAS bf16x8*)(wgt + (size_t)(16 * wave + c) * 128 + 32 * ks + 8 * q);
                                     Bi[ks] = *(const GAS bf16x8*)(wgt + (size_t)10 * 128 * 128 + (size_t)(16 * wave + c) * 128 + 32 * ks + 8 * q); }
#pragma unroll
    for (int jj = 0; jj < 8; ++jj) Id[jj] = (8 * q + jj == 16 * (wave & 1) + c) ? (short)0x3F80 : (short)0;
    const int ksel = wave >> 1;
    const float nsp8 = -8.f * sp * 1.44269504f;
    float Pc = 1.f;
    unsigned short gcur[16], gnxt[16];
#pragma unroll
    for (int i = 0; i < 16; ++i) { gcur[i] = 0; gnxt[i] = 0; }
    if (REV) {
#pragma unroll
        for (int i = 0; i < 16; ++i) gcur[i] = *(const GAS unsigned short*)(gbp + (size_t)(16 * (12 + (i >> 2)) + 4 * q + (i & 3)) * DRNN); }
#pragma unroll 1
    for (int og = 0; og < 4; ++og) {
        if (REV && og < 3) {
#pragma unroll
            for (int i = 0; i < 16; ++i) gnxt[i] = *(const GAS unsigned short*)(gbp + (size_t)(16 * (4 * (2 - og) + (i >> 2)) + 4 * q + (i & 3)) * DRNN); }
#pragma unroll
        for (int ii = 0; ii < 4; ++ii) {
        const int it = 4 * og + ii, mi = REV ? 15 - it : it, mloc = REV ? 3 - ii : ii;
        LAS const unsigned char* rp = xct + (16 * mi + c) * LRU_XS + 16 * q;
        bf16x8 Af[4];
#pragma unroll
        for (int ks = 0; ks < 4; ++ks) Af[ks] = *(LAS const bf16x8*)(rp + 64 * ks);
        const bf16x8 Ax = *(LAS const bf16x8*)(rp + 64 * ksel);
        f32x4 r = {0.f, 0.f, 0.f, 0.f}, ig = {0.f, 0.f, 0.f, 0.f};
#pragma unroll
        for (int ks = 0; ks < 4; ++ks) { r = __builtin_amdgcn_mfma_f32_16x16x32_bf16(Af[ks], Br[ks], r, 0, 0, 0); ig = __builtin_amdgcn_mfma_f32_16x16x32_bf16(Af[ks], Bi[ks], ig, 0, 0, 0); }
        const f32x4 xc = __builtin_amdgcn_mfma_f32_16x16x32_bf16(Ax, Id, (f32x4){0.f, 0.f, 0.f, 0.f}, 0, 0, 0);
        float av[4], bv[4];
#pragma unroll
        for (int k = 0; k < 4; ++k) { const float rg = __builtin_amdgcn_rcpf(1.f + __builtin_amdgcn_exp2f(-1.44269504f * (r[k] + br))), iv = __builtin_amdgcn_rcpf(1.f + __builtin_amdgcn_exp2f(-1.44269504f * (ig[k] + bi)));
            const float l2a = nsp8 * rg, x = 1.38629436f * l2a;
            const float oms = -x * (1.f + x * (0.5f + x * (0.16666667f + x * (0.041666668f + x * 0.0083333338f))));
            const float om = x > -0.25f ? oms : 1.f - __builtin_amdgcn_exp2f(2.f * l2a);
            av[k] = __builtin_amdgcn_exp2f(l2a); bv[k] = __builtin_amdgcn_sqrtf(om) * (iv * xc[k]); }
        float pA[4], pB[4];
#pragma unroll
        for (int kk = 0; kk < 4; ++kk) { const int k = REV ? 3 - kk : kk;
            if (kk == 0) { pA[k] = av[k]; pB[k] = bv[k]; } else { const int kp = REV ? k + 1 : k - 1; pA[k] = pA[kp] * av[k]; pB[k] = pB[kp] * av[k] + bv[k]; } }
        const int kl = REV ? 0 : 3;
        float gA[4], gB[4];
#pragma unroll
        for (int g = 0; g < 4; ++g) { const int src = 16 * (REV ? 3 - g : g) + c; gA[g] = bperm(pA[kl], src); gB[g] = bperm(pB[kl], src); }
        float eA = 1.f, eB = 0.f, tA = 1.f, tB = 0.f;
#pragma unroll
        for (int g = 0; g < 4; ++g) { if (g == qq) { eA = tA; eB = tB; } tB = tB * gA[g] + gB[g]; tA = tA * gA[g]; }
        const float hin = eA * hc + eB;
#pragma unroll
        for (int k = 0; k < 4; ++k) { const float h = pA[k] * hin + pB[k]; const int row = 16 * mi + 4 * q + k;
            if (wantp) Pdst[(size_t)row * DRNN] = (bf16)f2bf(pA[k] * eA * Pc);
            LAS unsigned short* hp = (LAS unsigned short*)(hft + row * LRU_XS + 2 * (16 * wave + c));
            if (!REV) *hp = (unsigned short)f2bf(h); else *hp = (unsigned short)f2bf(bf2f(gcur[4 * mloc + k]) * (bf2f(*hp) + h)); }
        hc = tA * hc + tB; Pc *= tA;
        }
        if (REV) {
#pragma unroll
            for (int i = 0; i < 16; ++i) gcur[i] = gnxt[i]; }
    }
    return hc;
}
__device__ __forceinline__ void lru_unit(Frame& F, int j, int pm, int n, const bf16* REC, const bf16* GB, bf16* HS, bf16* PF, bf16* PB, float* AGG, const bf16* WGT) {
    const int tid = F.tid, lane = F.lane, wave = F.wave, r0 = 256 * pm;
    const bool smp = pm >= 32; const int tix = smp ? (pm - 32) & 3 : 0, sq = smp ? (pm - 32) >> 2 : 0;
    const int t0 = smp ? 256 * tix : 0, T = smp ? 1024 : 256;
    LAS unsigned char* xct = F.lds + LRU_XC_OFF; LAS unsigned char* hft = F.lds + LRU_GB_OFF;
    { const float* cw = F.inp(I_LRU_CW) + (size_t)j * 4 * DRNN + n * 128 + 2 * lane; const float* cb = F.inp(I_LRU_CB) + (size_t)j * DRNN + n * 128 + 2 * lane;
      float w0[4], w1[4];
#pragma unroll
      for (int k = 0; k < 4; ++k) { w0[k] = cw[k * DRNN]; w1[k] = cw[k * DRNN + 1]; }
      const float b0 = cb[0], b1 = cb[1];
      unsigned v[35];
#pragma unroll
      for (int i = 0; i < 35; ++i) { const int tl = 32 * wave + i - 2, tt = t0 + tl;
          v[i] = (tt >= 0 && tt < T) ? *(const GAS unsigned*)(REC + (size_t)(r0 + tl) * DRNN + n * 128 + 2 * lane) : 0u; }
#pragma unroll
      for (int i = 0; i < 32; ++i) { float s0 = b0, s1 = b1;
#pragma unroll
          for (int k = 0; k < 4; ++k) { s0 += w0[k] * bf2f(v[i + k]); s1 += w1[k] * bf2f(v[i + k] >> 16); }
          *(LAS unsigned*)(xct + (32 * wave + i) * LRU_XS + 4 * lane) = f2bf(s0) | (f2bf(s1) << 16); } }
    __syncthreads();
    const int c = lane & 15, q = lane >> 4, ch = n * 128 + 16 * wave + c;
    const float* bg = F.inp(I_LRU_BG) + (size_t)j * 4 * DRNN; const float* lam = F.inp(I_LRU_LAM) + (size_t)j * 2 * DRNN;
    const bf16* gbp = GB + (size_t)r0 * DRNN + ch;
    bf16* pf = PF + (size_t)(smp ? r0 - NPROMPT : 0) * DRNN + ch; bf16* pb = PB + (size_t)(smp ? r0 - NPROMPT : 0) * DRNN + ch;
    { float h0 = 0.f; if (smp && tix == 0) h0 = F.inp(I_STATE)[((size_t)(sq * 2 + j) * 2 + 0) * DRNN + ch];
      const float hfin = lru_dir<false>(xct, hft, WGT + (size_t)(0 * 10 + n) * 128 * 128, gbp, bg[0 * DRNN + ch], bg[1 * DRNN + ch], softplusf_(-lam[ch]), h0, wave, lane, smp, pf);
      if (q == 0) { if (smp) AGG[(size_t)((sq * 4 + tix) * 2 + 0) * DRNN + ch] = hfin; else F.out[O_STATE + ((size_t)(pm * 2 + j) * 2 + 0) * DRNN + ch] = hfin; } }
    { float h0 = 0.f; if (smp && tix == 3) h0 = F.inp(I_STATE)[((size_t)(sq * 2 + j) * 2 + 1) * DRNN + ch];
      const float hfin = lru_dir<true>(xct, hft, WGT + (size_t)(2 * 10 + n) * 128 * 128, gbp, bg[2 * DRNN + ch], bg[3 * DRNN + ch], softplusf_(-lam[DRNN + ch]), h0, wave, lane, smp, pb);
      if (q == 0) { if (smp) AGG[(size_t)((sq * 4 + tix) * 2 + 1) * DRNN + ch] = hfin; else F.out[O_STATE + ((size_t)(pm * 2 + j) * 2 + 1) * DRNN + ch] = hfin; } }
    __syncthreads();
#pragma unroll
    for (int i = 0; i < 8; ++i) { const int id = i * NT + tid, row = id >> 4, cc = id & 15;
        *(GAS u32x4*)(HS + (size_t)(r0 + row) * DRNN + n * 128 + 8 * cc) = *(LAS const u32x4*)(hft + row * LRU_XS + 16 * cc); }
    __syncthreads();
}
__device__ __forceinline__ void phase_lru_core(Frame& F, int j, const bf16* REC, const bf16* GB, bf16* HS, bf16* PF, bf16* PB, float* AGG, const bf16* WGT) {
    F.fresh();
    for (int u = F.bid; u < 400; u += F.G) {
        const int pm = u < 80 ? 32 + u / 10 : (u - 80) / 10, n = u % 10;
        lru_unit(F, j, pm, n, REC, GB, HS, PF, PB, AGG, WGT); }
}
__device__ __forceinline__ void phase_lru_fixup(Frame& F, const bf16* GB, bf16* HS, const bf16* PF, const bf16* PB, const float* AGG) {
    F.fresh();
    const int gt = F.bid * NT + F.tid, GT = F.G * NT;
    for (int i = gt; i < NSAMPLE * DRNN; i += GT) { const int rs = i / DRNN, ch = i % DRNN, sq = rs >> 10, tix = (rs >> 8) & 3;
        float cf = 0.f, cbk = 0.f;
        if (tix > 0) { for (int t = 0; t < tix; ++t) { const float At = bf2f(PF[(size_t)(sq * 1024 + t * 256 + 255) * DRNN + ch]); cf = At * cf + AGG[(size_t)((sq * 4 + t) * 2 + 0) * DRNN + ch]; } }
        if (tix < 3) { for (int t = 3; t > tix; --t) { const float At = bf2f(PB[(size_t)(sq * 1024 + t * 256) * DRNN + ch]); cbk = At * cbk + AGG[(size_t)((sq * 4 + t) * 2 + 1) * DRNN + ch]; } }
        const size_t o = (size_t)(NPROMPT + rs) * DRNN + ch;
        HS[o] = (bf16)f2bf(bf2f(HS[o]) + bf2f(GB[o]) * (bf2f(PF[(size_t)rs * DRNN + ch]) * cf + bf2f(PB[(size_t)rs * DRNN + ch]) * cbk)); }
}

__device__ __forceinline__ void phase_cmlp_rstd(Frame& F, const bf16* UV) {
    F.fresh();
    const int gw = F.bid * NWAVES + F.wave, NGW = F.G * NWAVES;
    for (int row = gw; row < M; row += NGW) { float s = 0.f;
        for (int c = F.lane; c < DB; c += 64) { const float v = bf2f(UV[(size_t)row * 2 * DB + DB + c]); s += v * v; }
        s = wave_sum(s); if (F.lane == 0) F.rstd[row] = rsqrtf(s * (1.f / DB) + EPS); }
}
__device__ __forceinline__ void phase_cmlp_spatial(Frame& F, const bf16* UV, bf16* ACT) {
    F.fresh();
    const float* ws = F.inp(I_CM_WS); const float* bs = F.inp(I_CM_BS); const float* ng = F.inp(I_CM_NG);
    const int gt = F.bid * NT + F.tid, GT = F.G * NT;
    for (int i = gt; i < M * DB; i += GT) { const int row = i / DB, ch = i % DB, g = ch >> 8, p = row & 127, r0 = row & ~127;
        float s = 0.f;
        for (int q = 0; q < 128; ++q) s += ws[(size_t)(g * 128 + p) * 128 + q] * F.rstd[r0 + q] * bf2f(UV[(size_t)(r0 + q) * 2 * DB + DB + ch]);
        const float sv = s * ng[ch] + bs[g * 128 + p];
        ACT[i] = (bf16)f2bf(bf2f(UV[(size_t)row * 2 * DB + ch]) * sv); }
}


constexpr int CM_VS = 544;
__device__ __forceinline__ void phase_cmlp_spatial_mfma(Frame& F, const bf16* UV, bf16* ACT, const bf16* WSB) {
    F.fresh();
    const int tid = F.tid, lane = F.lane, wave = F.wave, c = lane & 15, q4 = lane >> 4;
    LAS unsigned char* vt = F.lds;
    const float* ng = F.inp(I_CM_NG); const float* bs = F.inp(I_CM_BS);
    for (int u = F.bid; u < 640; u += F.G) {
        const int chunk = u >> 3, g = u & 7, r0 = chunk * 128;
        LAS float* rsl = (LAS float*)(vt + 128 * CM_VS);
        if (tid < 128) { const GAS f32x4* p = (const GAS f32x4*)(F.rsqv + (size_t)(r0 + tid) * 32); float sm = 0.f;
#pragma unroll
            for (int i = 0; i < 8; ++i) { const f32x4 t4 = p[i]; sm += (t4.x + t4.y) + (t4.z + t4.w); }
            rsl[tid] = rsqrtf(sm * (1.f / DB) + EPS); }
        __syncthreads();
#pragma unroll
        for (int i = 0; i < 8; ++i) { const int id = i * NT + tid, row = id >> 5, cc = id & 31;
            const u32x4 x = *(const GAS u32x4*)(UV + (size_t)(r0 + row) * 2 * DB + DB + g * 256 + 8 * cc); const float rs = rsl[row];
            u32x4 y; y.x = f2bf(bf2f(x.x) * rs) | (f2bf(bf2f(x.x >> 16) * rs) << 16); y.y = f2bf(bf2f(x.y) * rs) | (f2bf(bf2f(x.y >> 16) * rs) << 16);
            y.z = f2bf(bf2f(x.z) * rs) | (f2bf(bf2f(x.z >> 16) * rs) << 16); y.w = f2bf(bf2f(x.w) * rs) | (f2bf(bf2f(x.w >> 16) * rs) << 16);
            *(LAS u32x4*)(vt + row * CM_VS + 16 * cc) = y; }
        __syncthreads();
        bf16x8 vf[2][4];
#pragma unroll
        for (int mfc = 0; mfc < 2; ++mfc)
#pragma unroll
            for (int ks = 0; ks < 4; ++ks) { LAS const unsigned char* vp = vt + (32 * ks + 4 * q4 + (c >> 2)) * CM_VS + (32 * wave + 16 * mfc + 4 * (c & 3)) * 2;
                const v4i16_t lo = __builtin_amdgcn_ds_read_tr16_b64_v4i16((LAS v4i16_t*)vp), hi = __builtin_amdgcn_ds_read_tr16_b64_v4i16((LAS v4i16_t*)(vp + 16 * CM_VS));
                vf[mfc][ks] = (bf16x8){lo[0], lo[1], lo[2], lo[3], hi[0], hi[1], hi[2], hi[3]}; }
#pragma unroll
        for (int nf = 0; nf < 8; ++nf) {
            bf16x8 Bf[4];
#pragma unroll
            for (int ks = 0; ks < 4; ++ks) Bf[ks] = *(const GAS bf16x8*)(WSB + ((size_t)((g * 8 + nf) * 4 + ks) * 64 + lane) * 8);
            const int p = 16 * nf + c; const float bsv = bs[g * 128 + p];
#pragma unroll
            for (int mfc = 0; mfc < 2; ++mfc) { f32x4 acc = {0.f, 0.f, 0.f, 0.f};
#pragma unroll
                for (int ks = 0; ks < 4; ++ks) acc = __builtin_amdgcn_mfma_f32_16x16x32_bf16(vf[mfc][ks], Bf[ks], acc, 0, 0, 0);
                const int ch = g * 256 + 32 * wave + 16 * mfc + 4 * q4;
                const f32x4 g4 = *(const GAS f32x4*)(ng + ch); const u32x2 uu = *(const GAS u32x2*)(UV + (size_t)(r0 + p) * 2 * DB + ch);
                const float o0 = bf2f(uu.x) * (acc[0] * g4.x + bsv), o1 = bf2f(uu.x >> 16) * (acc[1] * g4.y + bsv), o2 = bf2f(uu.y) * (acc[2] * g4.z + bsv), o3 = bf2f(uu.y >> 16) * (acc[3] * g4.w + bsv);
                u32x2 w; w.x = f2bf(o0) | (f2bf(o1) << 16); w.y = f2bf(o2) | (f2bf(o3) << 16);
                *(GAS u32x2*)(ACT + (size_t)(r0 + p) * DB + ch) = w; }
        }
        __syncthreads();
    }
}

__device__ __forceinline__ void phase_qkv_post(Frame& F, const bf16* QKV, bf16* Q, bf16* KP, bf16* VP) {
    F.fresh();
    const int gw = F.bid * NWAVES + F.wave, NGW = F.G * NWAVES;
    const float* qkg = F.inp(I_AT_QKG);
    for (int row = gw; row < M; row += NGW) {
        const bool smp = row >= NPROMPT; const int sb = smp ? (row - NPROMPT) >> 10 : 0, t = smp ? (row - NPROMPT) & 1023 : 0;
        const float cs = smp ? F.rope[t * 32 + (F.lane & 31)] : 1.f, sn = smp ? F.rope[32768 + t * 32 + (F.lane & 31)] : 0.f;
        for (int grp = 0; grp < 32; ++grp) {
            const float v = bf2f(QKV[(size_t)row * 3072 + grp * 64 + F.lane]);
            const float ms = wave_sum(v * v) * (1.f / 64.f);
            float n = v * rsqrtf(ms + EPS) * qkg[(grp >> 4) * 64 + F.lane];
            const float keep = n;
            if (smp) { float pr; { auto r_ = __builtin_amdgcn_permlane32_swap(__builtin_bit_cast(unsigned, n), __builtin_bit_cast(unsigned, n), false, false); pr = __builtin_bit_cast(float, F.lane < 32 ? (unsigned)r_[1] : (unsigned)r_[0]); } n = F.lane < 32 ? n * cs - pr * sn : n * cs + pr * sn; }
            if (grp < 16) Q[(size_t)row * D + grp * 64 + F.lane] = (bf16)f2bf(n);
            else { const int c = (grp - 16) * 64 + F.lane;
                if (smp) F.KS[((size_t)sb * TKS + PAST + t) * D + c] = (bf16)f2bf(n);
                else { KP[(size_t)row * D + c] = (bf16)f2bf(keep); F.out[O_CK + (size_t)row * D + c] = keep; } }
        }
        for (int c = F.lane; c < D; c += 64) { const bf16 vb = QKV[(size_t)row * 3072 + 2048 + c];
            if (smp) F.VS[((size_t)sb * TKS + PAST + t) * D + c] = vb; else { VP[(size_t)row * D + c] = vb; F.out[O_CV + (size_t)row * D + c] = bf2f(vb); } }
    }
}
__device__ __forceinline__ void phase_attn_naive(Frame& F, int l, const bf16* Q, const bf16* KP, const bf16* VP, bf16* O) {
    F.fresh();
    const int gw = F.bid * NWAVES + F.wave, NGW = F.G * NWAVES;
    LAS float* s1 = (LAS float*)F.lds + F.wave * 3328; LAS float* s2 = s1 + 1536; LAS float* qs = s2 + 1536;
    const float* al = F.inp(I_AT_LAM);
    const float lam_init = 0.8f - 0.6f * expf(-0.3f * (float)l);
    const float lam = expf(wave_sum(al[F.lane] * al[64 + F.lane])) - expf(wave_sum(al[128 + F.lane] * al[192 + F.lane])) + lam_init;
    const float* sg = F.inp(I_AT_SUBG);
    for (int item = gw; item < M * 8; item += NGW) {
        const int row = item >> 3, h = item & 7;
        const bf16 *Kb, *Vb; int Tk;
        if (row < NPROMPT) { Kb = KP + (size_t)(row & ~255) * D; Vb = VP + (size_t)(row & ~255) * D; Tk = 256; }
        else { const int sb = (row - NPROMPT) >> 10; Kb = F.KS + (size_t)sb * TKS * D; Vb = F.VS + (size_t)sb * TKS * D; Tk = TKS; }
        qs[F.lane] = bf2f(Q[(size_t)row * D + h * 128 + F.lane]); qs[64 + F.lane] = bf2f(Q[(size_t)row * D + h * 128 + 64 + F.lane]);
        asm volatile("s_waitcnt lgkmcnt(0)" ::: "memory");
        float m1 = -1e30f, m2 = -1e30f;
        for (int k = F.lane; k < Tk; k += 64) { const bf16* kr = Kb + (size_t)k * D + h * 128; float d1 = 0.f, d2 = 0.f;
#pragma unroll 4
            for (int d = 0; d < 64; d += 2) { const unsigned a = *(const unsigned*)(kr + d), b = *(const unsigned*)(kr + 64 + d);
                d1 += qs[d] * bf2f(a) + qs[d + 1] * bf2f(a >> 16); d2 += qs[64 + d] * bf2f(b) + qs[64 + d + 1] * bf2f(b >> 16); }
            d1 *= 0.125f; d2 *= 0.125f; s1[k] = d1; s2[k] = d2; m1 = fmaxf(m1, d1); m2 = fmaxf(m2, d2); }
        m1 = wave_max(m1); m2 = wave_max(m2);
        float l1 = 0.f, l2 = 0.f;
        for (int k = F.lane; k < Tk; k += 64) { const float e1 = expf(s1[k] - m1), e2 = expf(s2[k] - m2); s1[k] = e1; s2[k] = e2; l1 += e1; l2 += e2; }
        l1 = wave_sum(l1); l2 = wave_sum(l2);
        const float i1 = 1.f / l1, i2 = lam / l2;
        for (int k = F.lane; k < Tk; k += 64) s1[k] = bf2f(f2bf(s1[k] * i1 - s2[k] * i2));
        asm volatile("s_waitcnt lgkmcnt(0)" ::: "memory");
        float o0 = 0.f, o1 = 0.f;
        for (int k = 0; k < Tk; ++k) { const unsigned vv = *(const unsigned*)(Vb + (size_t)k * D + h * 128 + 2 * F.lane); const float w = s1[k]; o0 += w * bf2f(vv); o1 += w * bf2f(vv >> 16); }
        const float ms = wave_sum(o0 * o0 + o1 * o1) * (1.f / 128.f), rs = rsqrtf(ms + EPS) * (1.f - lam_init);
        o0 = o0 * rs * sg[2 * F.lane]; o1 = o1 * rs * sg[2 * F.lane + 1];
        *(unsigned*)(O + (size_t)row * D + h * 128 + 2 * F.lane) = f2bf(o0) | (f2bf(o1) << 16);
        asm volatile("s_waitcnt lgkmcnt(0)" ::: "memory");
    }
}


constexpr int AT_KS = 272, AT_VS = 288, AT_KBYTES = 64 * AT_KS, AT_VBYTES = 64 * AT_VS, AT_BUF = AT_KBYTES + AT_VBYTES;
__device__ __forceinline__ void attn_unit(Frame& F, int l, const bf16* Qrows  , const bf16* Kb, const bf16* Vb, int Tk, bf16* Orows, int h, float lam, float lam_init) {
    const int tid = F.tid, lane = F.lane, wave = F.wave, c = lane & 15, q4 = lane >> 4;
    LAS unsigned char* lds = F.lds;
    const float SC = 0.18033688f;
    bf16x8 Qf[2][2];
#pragma unroll
    for (int cp = 0; cp < 2; ++cp)
#pragma unroll
        for (int ks = 0; ks < 2; ++ks) Qf[cp][ks] = *(const GAS bf16x8*)(Qrows + (size_t)(16 * wave + c) * D + h * 128 + cp * 64 + 32 * ks + 8 * q4);
    const int nt = Tk / 64;
    const int key0 = tid >> 4, cc0 = tid & 15;
    u32x4 kreg[2], vreg[2];
    float m1 = -1e30f, m2 = -1e30f, l1 = 0.f, l2 = 0.f;
#pragma unroll
    for (int i = 0; i < 2; ++i) kreg[i] = *(const GAS u32x4*)(Kb + (size_t)(key0 + 32 * i) * D + h * 128 + 8 * cc0);
#pragma unroll
    for (int i = 0; i < 2; ++i) *(LAS u32x4*)(lds + (key0 + 32 * i) * AT_KS + 16 * cc0) = kreg[i];
    __syncthreads();
    for (int t = 0; t < nt; ++t) {
        LAS const unsigned char* kt = lds + (t & 1) * AT_BUF;
        if (t + 1 < nt) {
#pragma unroll
            for (int i = 0; i < 2; ++i) kreg[i] = *(const GAS u32x4*)(Kb + (size_t)((t + 1) * 64 + key0 + 32 * i) * D + h * 128 + 8 * cc0); }
        f32x4 S[2][4];
#pragma unroll
        for (int cp = 0; cp < 2; ++cp)
#pragma unroll
            for (int mf = 0; mf < 4; ++mf) { S[cp][mf] = (f32x4){0.f, 0.f, 0.f, 0.f};
#pragma unroll
                for (int ks = 0; ks < 2; ++ks) { const bf16x8 kf = *(LAS const bf16x8*)(kt + (16 * mf + c) * AT_KS + cp * 128 + ks * 64 + 16 * q4);
                    S[cp][mf] = __builtin_amdgcn_mfma_f32_16x16x32_bf16(kf, Qf[cp][ks], S[cp][mf], 0, 0, 0); } }
        float x1 = -1e30f, x2 = -1e30f;
#pragma unroll
        for (int mf = 0; mf < 4; ++mf)
#pragma unroll
            for (int k = 0; k < 4; ++k) { x1 = fmaxf(x1, S[0][mf][k]); x2 = fmaxf(x2, S[1][mf][k]); }
        x1 = max_q4(x1); x2 = max_q4(x2);
        const float n1 = fmaxf(m1, x1), n2 = fmaxf(m2, x2);
        l1 *= exp2f((m1 - n1) * SC); l2 *= exp2f((m2 - n2) * SC); m1 = n1; m2 = n2;
#pragma unroll
        for (int mf = 0; mf < 4; ++mf)
#pragma unroll
            for (int k = 0; k < 4; ++k) { l1 += exp2f((S[0][mf][k] - m1) * SC); l2 += exp2f((S[1][mf][k] - m2) * SC); }
        if (t + 1 < nt) {
#pragma unroll
            for (int i = 0; i < 2; ++i) *(LAS u32x4*)(lds + ((t + 1) & 1) * AT_BUF + (key0 + 32 * i) * AT_KS + 16 * cc0) = kreg[i]; }
        __syncthreads();
    }
    l1 = sum_q4(l1); l2 = sum_q4(l2);
    const float i1 = 1.f / l1, i2 = lam / l2;
    f32x4 Ot[8];
#pragma unroll
    for (int md = 0; md < 8; ++md) Ot[md] = (f32x4){0.f, 0.f, 0.f, 0.f};
#pragma unroll
    for (int i = 0; i < 2; ++i) { kreg[i] = *(const GAS u32x4*)(Kb + (size_t)(key0 + 32 * i) * D + h * 128 + 8 * cc0); vreg[i] = *(const GAS u32x4*)(Vb + (size_t)(key0 + 32 * i) * D + h * 128 + 8 * cc0); }
#pragma unroll
    for (int i = 0; i < 2; ++i) { *(LAS u32x4*)(lds + (key0 + 32 * i) * AT_KS + 16 * cc0) = kreg[i]; *(LAS u32x4*)(lds + AT_KBYTES + (key0 + 32 * i) * AT_VS + 16 * cc0) = vreg[i]; }
    __syncthreads();
    for (int t = 0; t < nt; ++t) {
        LAS const unsigned char* kt = lds + (t & 1) * AT_BUF; LAS const unsigned char* vt = kt + AT_KBYTES;
        if (t + 1 < nt) {
#pragma unroll
            for (int i = 0; i < 2; ++i) { kreg[i] = *(const GAS u32x4*)(Kb + (size_t)((t + 1) * 64 + key0 + 32 * i) * D + h * 128 + 8 * cc0);
                                          vreg[i] = *(const GAS u32x4*)(Vb + (size_t)((t + 1) * 64 + key0 + 32 * i) * D + h * 128 + 8 * cc0); } }
        f32x4 S[2][4];
#pragma unroll
        for (int cp = 0; cp < 2; ++cp)
#pragma unroll
            for (int mf = 0; mf < 4; ++mf) { S[cp][mf] = (f32x4){0.f, 0.f, 0.f, 0.f};
#pragma unroll
                for (int ks = 0; ks < 2; ++ks) { const bf16x8 kf = *(LAS const bf16x8*)(kt + (16 * mf + c) * AT_KS + cp * 128 + ks * 64 + 16 * q4);
                    S[cp][mf] = __builtin_amdgcn_mfma_f32_16x16x32_bf16(kf, Qf[cp][ks], S[cp][mf], 0, 0, 0); } }
        bf16x8 Wf[2];
#pragma unroll
        for (int kk = 0; kk < 2; ++kk)
#pragma unroll
            for (int jj = 0; jj < 8; ++jj) { const int mf = 2 * kk + (jj >> 2), k = jj & 3;
                const float w = exp2f((S[0][mf][k] - m1) * SC) * i1 - exp2f((S[1][mf][k] - m2) * SC) * i2; Wf[kk][jj] = (short)f2bf(w); }
#pragma unroll
        for (int md = 0; md < 8; ++md)
#pragma unroll
            for (int kk = 0; kk < 2; ++kk) { LAS const unsigned char* vp = vt + (32 * kk + 4 * q4 + (c >> 2)) * AT_VS + (16 * md + 4 * (c & 3)) * 2;
                const v4i16_t lo = __builtin_amdgcn_ds_read_tr16_b64_v4i16((LAS v4i16_t*)vp), hi = __builtin_amdgcn_ds_read_tr16_b64_v4i16((LAS v4i16_t*)(vp + 16 * AT_VS));
                const bf16x8 vf = {lo[0], lo[1], lo[2], lo[3], hi[0], hi[1], hi[2], hi[3]};
                Ot[md] = __builtin_amdgcn_mfma_f32_16x16x32_bf16(vf, Wf[kk], Ot[md], 0, 0, 0); }
        if (t + 1 < nt) {
#pragma unroll
            for (int i = 0; i < 2; ++i) { *(LAS u32x4*)(lds + ((t + 1) & 1) * AT_BUF + (key0 + 32 * i) * AT_KS + 16 * cc0) = kreg[i];
                                          *(LAS u32x4*)(lds + ((t + 1) & 1) * AT_BUF + AT_KBYTES + (key0 + 32 * i) * AT_VS + 16 * cc0) = vreg[i]; } }
        __syncthreads();
    }
    float ss = 0.f;
#pragma unroll
    for (int md = 0; md < 8; ++md)
#pragma unroll
        for (int k = 0; k < 4; ++k) ss += Ot[md][k] * Ot[md][k];
    ss = sum_q4(ss);
    const float rs = rsqrtf(ss * (1.f / 128.f) + EPS) * (1.f - lam_init);
    const float* sg = F.inp(I_AT_SUBG);
#pragma unroll
    for (int md = 0; md < 8; ++md) { const int d0 = 16 * md + 4 * q4; const f32x4 g4 = *(const GAS f32x4*)(sg + d0);
        u32x2 w; w.x = f2bf(Ot[md][0] * rs * g4.x) | (f2bf(Ot[md][1] * rs * g4.y) << 16); w.y = f2bf(Ot[md][2] * rs * g4.z) | (f2bf(Ot[md][3] * rs * g4.w) << 16);
        *(GAS u32x2*)(Orows + (size_t)(16 * wave + c) * D + h * 128 + d0) = w; }
}
__device__ __forceinline__ void phase_attn(Frame& F, int l, const bf16* Q, const bf16* KP, const bf16* VP, bf16* O) {
    F.fresh();
    const float* al = F.inp(I_AT_LAM);
    const float lam_init = 0.8f - 0.6f * expf(-0.3f * (float)l);
    const float lam = expf(wave_sum(al[F.lane] * al[64 + F.lane])) - expf(wave_sum(al[128 + F.lane] * al[192 + F.lane])) + lam_init;
    for (int s = 0; ; ++s) {
        int u;
        if (F.G == 256) { if (F.bid < 128) { if (s > 0) break; u = F.bid; } else { if (s > 3) break; u = 128 + 4 * (F.bid - 128) + s; } }
        else { u = F.bid + s * F.G; if (u >= 640) break; }
        if (u < 128) { const int sb = u >> 6, h = (u >> 3) & 7, qt = u & 7; const size_t r0 = (size_t)NPROMPT + sb * 1024 + qt * 128;
            attn_unit(F, l, Q + r0 * D, F.KS + (size_t)sb * TKS * D, F.VS + (size_t)sb * TKS * D, TKS, O + r0 * D, h, lam, lam_init); }
        else { const int v = u - 128, b = v >> 4, h = (v >> 1) & 7, qt = v & 1; const size_t r0 = (size_t)b * 256 + qt * 128;
            attn_unit(F, l, Q + r0 * D, KP + (size_t)b * 256 * D, VP + (size_t)b * 256 * D, 256, O + r0 * D, h, lam, lam_init); }
    }
}

__device__ __forceinline__ void phase_ffn_convgate(Frame& F, int l, const bf16* Z, bf16* ACT) {
    F.fresh();
    const float* cw = F.inp(I_FF_CW) + (size_t)l * 3 * 2 * DFF; const float* cb = F.inp(I_FF_CB) + (size_t)l * 2 * DFF;
    const int gt = F.bid * NT + F.tid, GT = F.G * NT;
    for (int i = gt; i < M * DFF; i += GT) { const int row = i / DFF, j = i % DFF;
        int t, T; if (row < NPROMPT) { t = row & 255; T = 256; } else { t = (row - NPROMPT) & 1023; T = 1024; }
        float g = cb[j], u = cb[DFF + j];
#pragma unroll
        for (int k = 0; k < 3; ++k) { const int tt = t + k - 1; if (tt >= 0 && tt < T) { const bf16* zr = Z + (size_t)(row + k - 1) * 2 * DFF; g += cw[k * 2 * DFF + j] * bf2f(zr[j]); u += cw[k * 2 * DFF + DFF + j] * bf2f(zr[DFF + j]); } }
        ACT[i] = (bf16)f2bf(siluf_(g) * u); }
}

__global__ void __launch_bounds__(NT, 2) mk_fwd(Params prm) {
    extern __shared__ __attribute__((aligned(16))) unsigned char lds_raw[];
    Frame F;
    F.lds = (LAS unsigned char*)lds_raw; F.G = gridDim.x; F.out0 = prm.out; F.ws0 = prm.ws; F.wave0 = __builtin_amdgcn_readfirstlane(threadIdx.x >> 6);
    F.fresh();
    if (F.tid < N_IN) ((LAS unsigned long long*)(F.lds + PTR_OFF))[F.tid] = (unsigned long long)prm.in[F.tid];
    volatile LAS unsigned* MISC = (volatile LAS unsigned*)(F.lds + MISC_OFF);
    if (F.tid < 32) MISC[F.tid] = 0u;
    __syncthreads();
    (void)xcd_barrier_post((unsigned*)(prm.ws + WS_CTL) + CW_BAR, MISC + 8, F.tid == 0);
#define GRID_BAR() do { F.fresh(); XcdBarrier bar_; bar_.t0 = F.tid == 0; { unsigned* bp_ = (unsigned*)(prm.ws + WS_CTL) + CW_BAR; asm volatile("" : "+s"(bp_)); bar_.bar = bp_; } bar_.x = xb_xcc_id(); bar_.st = (volatile LAS unsigned*)(F.lds + MISC_OFF) + 8; xcd_barrier(bar_); } while (0)

#define GEMM_BF16(ACT, A_, Bt_, N_, K_, O_, ldc_, bias_, splitc_, splits_, rsq_, b2_, rsqv_, vt0_) do { pg8::Gemm g{A_, Bt_, M, N_, K_}; pg8::StaticOrder S; S.init(M, N_, F.G, F.bid); S.wave = F.wave; \
        pg8::EpiBf16<ACT> E{O_, ldc_, bias_, splitc_, splits_, rsq_, b2_, N_, rsqv_, vt0_, (LAS float*)(F.lds + 131072)}; pg8::gemm_phase<pg8::EpiBf16<ACT>, pg8::StaticOrder, true, true>(F.lds, g, S, E); } while (0)
#define GEMM_RESID(A_, Bt_, K_, sub_, fromin_) do { pg8::Gemm g{A_, Bt_, M, D, K_}; pg8::StaticOrder S; S.init(M, D, F.G, F.bid); S.wave = F.wave; \
        const int nl_ = (sub_) == 0 ? l : l + 1, ns_ = (sub_) == 0 ? 1 : 0; const bool last_ = nl_ >= DEPTH; \
        pg8::EpiResid E{F.out, F.inp(I_XP), F.inp(I_XS), F.mod + (size_t)l * 18 * D, (sub_) * 3 + 2, fromin_, last_ ? nullptr : F.H, F.inp(I_NORMG) + (size_t)((last_ ? 0 : nl_) * 2 + ns_) * D, \
                          F.mod + (size_t)(last_ ? 0 : nl_) * 18 * D, ns_ * 3 + 1, (sub_) == 0 ? F.rsq1 : F.rsq0}; \
        pg8::gemm_phase<pg8::EpiResid, pg8::StaticOrder, true, true>(F.lds, g, S, E); } while (0)

    phase_prologue(F);
    GRID_BAR();
    phase_modulate0(F);
    GRID_BAR();
#pragma unroll 1
    for (int l = 0; l < DEPTH; ++l) {
        const int kind = l % 3, j = l / 3;
        F.fresh();
        if (kind == 0) {
            bf16 *GB = F.T2, *REC = F.T2 + (size_t)M * DRNN, *PF = F.T3, *PB = F.T3 + (size_t)NSAMPLE * DRNN, *HS = F.T3 + (size_t)6 * 1024 * 1024;
            float* AGG = (float*)(F.T3 + (size_t)2 * NSAMPLE * DRNN);
            GEMM_BF16(2, F.H, F.WT + WE_LRU_IN + (size_t)j * 2 * DRNN * D, 2 * DRNN, D, GB, DRNN, nullptr, DRNN, (size_t)M * DRNN, F.rsq0, F.bias2 + B2_LRU + (size_t)j * 3 * 2560, nullptr, 0);
            GRID_BAR();
            phase_lru_core(F, j, REC, GB, HS, PF, PB, AGG, F.WT + WE_WG + (size_t)j * 40 * 128 * 128);
            GRID_BAR();
            phase_lru_fixup(F, GB, HS, PF, PB, AGG);
            GRID_BAR();
            GEMM_RESID(HS, F.WT + WE_LRU_OUT + (size_t)j * D * DRNN, DRNN, 0, l == 0);
        } else if (kind == 1) {
            bf16 *UV = F.T1, *ACT = F.T2;
            GEMM_BF16(1, F.H, F.WT + WE_CM_IN, 2 * DB, D, UV, 2 * DB, F.inp(I_CM_BIN), 0, 0, F.rsq0, F.bias2 + B2_CM, F.rsqv, 8);
            GRID_BAR();
            phase_cmlp_spatial_mfma(F, UV, ACT, F.WT + WE_WSB);
            GRID_BAR();
            GEMM_RESID(ACT, F.WT + WE_CM_OUT, DB, 0, false);
        } else {
            bf16 *Q = F.T2, *KP = F.T2 + (size_t)M * D, *VP = KP + (size_t)NPROMPT * D, *O = F.T3;
            { pg8::Gemm g{F.H, F.WT + WE_QKV, M, 3 * D, D}; pg8::StaticOrder S; S.init(M, 3 * D, F.G, F.bid); S.wave = F.wave;
              pg8::EpiQkv E{F.ws, F.out, F.rsq0, F.bias2 + B2_QKV, (LAS float*)(F.lds + 131072), F.inp(I_AT_QKG), F.rope};
              pg8::gemm_phase<pg8::EpiQkv, pg8::StaticOrder, true, true>(F.lds, g, S, E); }
            GRID_BAR();
            phase_attn(F, l, Q, KP, VP, O);
            GRID_BAR();
            GEMM_RESID(O, F.WT + WE_AT_OUT, D, 0, false);
        }
        GRID_BAR();
        { pg8::Gemm g{F.H, F.WT + WE_UP + (size_t)l * 2 * DFF * D, 42 * 256, 2 * DFF, D}; pg8::FfnOrder S; S.init(42 * 256, 2 * DFF, F.G, F.bid); S.wave = F.wave;
          pg8::EpiFfn E{F.T2, F.inp(I_FF_CW) + (size_t)l * 3 * 2 * DFF, F.inp(I_FF_CB) + (size_t)l * 2 * DFF, (LAS float*)(F.lds + 131072), F.rsq1, F.bias2 + B2_UP + (size_t)l * 3 * 5632};
          pg8::gemm_phase<pg8::EpiFfn, pg8::FfnOrder, true, true>(F.lds, g, S, E); }
        GRID_BAR();
        GEMM_RESID(F.T2, F.WT + WE_DN + (size_t)l * D * DFF, DFF, 1, false);
        GRID_BAR();
    }
}

extern "C" void kernel_launch(void* const* d_in, const int* in_sizes, int n_in, void* d_out, int out_size, void* d_ws, size_t ws_size, hipStream_t stream) {
    static int grid = 0;
    if (grid == 0) {
        if (n_in != N_IN || ws_size < WS_END) { fprintf(stderr, "kernel_launch: unexpected n_in %d or ws_size %zu\n", n_in, ws_size); grid = -1; return; }
        int dev = 0, cus = 0, per_cu = 0;
        hipGetDevice(&dev); hipDeviceGetAttribute(&cus, hipDeviceAttributeMultiprocessorCount, dev);
        hipFuncSetAttribute((const void*)mk_fwd, hipFuncAttributeMaxDynamicSharedMemorySize, LDS_BYTES);
        hipOccupancyMaxActiveBlocksPerMultiprocessor(&per_cu, (const void*)mk_fwd, NT, LDS_BYTES);
        (void)hipGetLastError();
        if (per_cu < 1) { fprintf(stderr, "kernel_launch: occupancy query says %d blocks per CU\n", per_cu); per_cu = 1; }
        grid = cus;
    }
    if (grid < 0) return;
    hipMemsetAsync((char*)d_ws + WS_CTL, 0, CTL_ZERO_BYTES, stream);
    Params p{};
    for (int i = 0; i < N_IN; ++i) p.in[i] = (const float*)d_in[i];
    p.out = (float*)d_out; p.ws = (unsigned char*)d_ws;
    void* args[] = {&p};
    hipError_t e = hipLaunchCooperativeKernel((const void*)mk_fwd, dim3(grid), dim3(NT), args, LDS_BYTES, stream);
    if (e != hipSuccess) fprintf(stderr, "kernel_launch: cooperative launch failed: %s (grid %d)\n", hipGetErrorString(e), grid);
}
```

```cpp
#include <hip/hip_runtime.h>
#include <cstdio>
#include <cstdint>

#define GAS __attribute__((address_space(1)))
#define LAS __attribute__((address_space(3)))
typedef unsigned short bf16;
typedef float f32x4 __attribute__((ext_vector_type(4)));
typedef unsigned u32x2 __attribute__((ext_vector_type(2)));
typedef unsigned u32x4 __attribute__((ext_vector_type(4)));

constexpr int D = 1024, NPROMPT = 32 * 256, NSAMPLE = 2 * 1024, M = NPROMPT + NSAMPLE;
constexpr int DEPTH = 4, DRNN = 1280, DB = 2048, DFF = 2816, PAST = 512, TKS = PAST + 1024;
constexpr float EPS = 1e-6f;
constexpr int NWAVES = 8, NT = NWAVES * 64;

enum { I_XP = 0, I_XS, I_STATE, I_CK, I_CV, I_C, I_CCTX, I_WMOD, I_BMOD, I_NORMG, I_LRU_WIN, I_LRU_CW, I_LRU_CB, I_LRU_WG, I_LRU_BG, I_LRU_LAM, I_LRU_WOUT,
       I_CM_WIN, I_CM_BIN, I_CM_NG, I_CM_WS, I_CM_BS, I_CM_WOUT, I_AT_WQKV, I_AT_QKG, I_AT_LAM, I_AT_SUBG, I_AT_WOUT, I_FF_WUP, I_FF_CW, I_FF_CB, I_FF_WDN, N_IN };
constexpr size_t O_YP = 0, O_YS = (size_t)NPROMPT * D, O_STATE = (size_t)M * D, O_CK = O_STATE + 32 * 2 * 2 * DRNN, O_CV = O_CK + (size_t)NPROMPT * D;

constexpr size_t MiB = 1u << 20;
constexpr size_t WS_CTL = 0, CTL_ZERO_BYTES = 64 * 1024;
constexpr size_t WS_MOD = 1 * MiB;
constexpr size_t WS_RSTD = WS_MOD + 512 * 1024;
constexpr size_t WS_ROPE = WS_RSTD + 256 * 1024;
constexpr size_t WS_H = 2 * MiB;
constexpr size_t WS_T1 = 22 * MiB;
constexpr size_t WS_T2 = 132 * MiB;
constexpr size_t WS_T3 = 187 * MiB;
constexpr size_t WS_X = WS_T3 + 40 * MiB;
constexpr size_t B2_LRU = 0, B2_CM = B2_LRU + (size_t)2 * 3 * 2560, B2_QKV = B2_CM + (size_t)3 * 4096, B2_UP = B2_QKV + (size_t)3 * 3072, B2_END = B2_UP + (size_t)4 * 3 * 5632;
constexpr size_t WS_KS = 237 * MiB, WS_VS = 243 * MiB;
constexpr size_t WS_W = 249 * MiB;
constexpr size_t WE_LRU_IN = 0, WE_LRU_OUT = WE_LRU_IN + (size_t)2 * 2560 * 1024, WE_CM_IN = WE_LRU_OUT + (size_t)2 * 1024 * 1280, WE_CM_OUT = WE_CM_IN + (size_t)4096 * 1024,
                 WE_QKV = WE_CM_OUT + (size_t)1024 * 2048, WE_AT_OUT = WE_QKV + (size_t)3072 * 1024, WE_UP = WE_AT_OUT + (size_t)1024 * 1024, WE_DN = WE_UP + (size_t)4 * 5632 * 1024,
                 WE_WG = WE_DN + (size_t)4 * 1024 * 2816, WE_WSB = WE_WG + (size_t)80 * 128 * 128, WE_END = WE_WSB + (size_t)8 * 128 * 128;
constexpr size_t WS_END = WS_W + 106 * MiB;
static_assert(WE_END * 2 <= 106 * MiB, "weight copies fit");
constexpr int CW_BAR = 1024;

constexpr int LDS_BYTES = 163840;
constexpr int MISC_OFF = LDS_BYTES - 256, PTR_OFF = LDS_BYTES - 1024;

__device__ __forceinline__ unsigned f2bf(float f) { unsigned u = __builtin_bit_cast(unsigned, f); return (u + 0x7fffu + ((u >> 16) & 1u)) >> 16; }
__device__ __forceinline__ float bf2f(unsigned b) { return __builtin_bit_cast(float, (b & 0xffffu) << 16); }
template <int CTRL> __device__ __forceinline__ float dppf(float v) { return __builtin_bit_cast(float, __builtin_amdgcn_update_dpp(0, __builtin_bit_cast(int, v), CTRL, 0xf, 0xf, false)); }
__device__ __forceinline__ float swz_xor16(float v) { return __builtin_bit_cast(float, __builtin_amdgcn_ds_swizzle(__builtin_bit_cast(int, v), 0x401F)); }
__device__ __forceinline__ float sum_x32(float v) { auto r = __builtin_amdgcn_permlane32_swap(__builtin_bit_cast(unsigned, v), __builtin_bit_cast(unsigned, v), false, false);
    return __builtin_bit_cast(float, (unsigned)r[0]) + __builtin_bit_cast(float, (unsigned)r[1]); }
__device__ __forceinline__ float max_x32(float v) { auto r = __builtin_amdgcn_permlane32_swap(__builtin_bit_cast(unsigned, v), __builtin_bit_cast(unsigned, v), false, false);
    return fmaxf(__builtin_bit_cast(float, (unsigned)r[0]), __builtin_bit_cast(float, (unsigned)r[1])); }
__device__ __forceinline__ float sum_q4(float v) { v += swz_xor16(v); return sum_x32(v); }
__device__ __forceinline__ float max_q4(float v) { v = fmaxf(v, swz_xor16(v)); return max_x32(v); }
__device__ __forceinline__ float wave_sum(float v) { v += dppf<0xB1>(v); v += dppf<0x4E>(v); v += dppf<0x141>(v); v += dppf<0x140>(v); return sum_q4(v); }
__device__ __forceinline__ float wave_max(float v) { v = fmaxf(v, dppf<0xB1>(v)); v = fmaxf(v, dppf<0x4E>(v)); v = fmaxf(v, dppf<0x141>(v)); v = fmaxf(v, dppf<0x140>(v)); return max_q4(v); }
__device__ __forceinline__ float bperm(float v, int src_lane) { return __builtin_bit_cast(float, __builtin_amdgcn_ds_bpermute(src_lane << 2, __builtin_bit_cast(int, v))); }
__device__ __forceinline__ float gelu_tanh(float x) { const float y = 0.7978845608028654f * (x + 0.044715f * x * x * x); const float t = 1.f - 2.f / (__expf(2.f * y) + 1.f); return 0.5f * x * (1.f + t); }
__device__ __forceinline__ float sigmoidf_(float x) { return 1.f / (1.f + __expf(-x)); }
__device__ __forceinline__ float siluf_(float x) { return x / (1.f + __expf(-x)); }
__device__ __forceinline__ float softplusf_(float x) { return fmaxf(x, 0.f) + log1pf(expf(-fabsf(x))); }

#define XB_TMO      128
#define XB_XCNT(j)  (256  + 64 * (j))
#define XB_XSUB(j)  (1280 + 64 * (j))
#define XB_XGEN(j)  (2304 + 64 * (j))
#define XB_TOP      3328
#define XB_TOPGEN   3392
#define XCD_BAR_WORDS 3456
#define XB_SPIN_CAP (1u << 22)
__device__ __forceinline__ unsigned xb_ld(unsigned* p)              { return __hip_atomic_load(p, __ATOMIC_RELAXED, __HIP_MEMORY_SCOPE_AGENT); }
__device__ __forceinline__ unsigned xb_add(unsigned* p, unsigned v) { return __hip_atomic_fetch_add(p, v, __ATOMIC_RELAXED, __HIP_MEMORY_SCOPE_AGENT); }
__device__ __forceinline__ unsigned xb_xcc_id() { return (unsigned)__builtin_amdgcn_s_getreg((3 << 11) | 20) & 0xFu; }
#define XB_SPIN(cond, bar) do { unsigned _sp = 0; while (cond) { __builtin_amdgcn_s_sleep(1); \
    if ((++_sp & 255u) == 0u) { if (xb_ld(&(bar)[XB_TMO])) break; if (_sp > XB_SPIN_CAP) { atomicAdd(&(bar)[XB_TMO], 1u); break; } } } } while (0)
struct XcdBarrier { unsigned* bar; unsigned x; volatile LAS unsigned* st; bool t0; };
__device__ __forceinline__ XcdBarrier xcd_barrier_post(unsigned* bar, volatile LAS unsigned* st, bool t0) {
    XcdBarrier b; b.bar = bar; b.x = xb_xcc_id(); b.st = st; b.t0 = t0;
    if (t0) (void)xb_add(&bar[XB_XCNT(b.x)], 1u);
    return b;
}
__device__ __forceinline__ void xcd_barrier_complete(unsigned* bar, unsigned x, unsigned& nloc, unsigned& nx) {
    const unsigned G = gridDim.x * gridDim.y * gridDim.z;
    unsigned sum, cnt, mine, sp = 0u;
    for (;;) {
        sum = 0u; cnt = 0u; mine = 0u;
#pragma unroll
        for (unsigned j = 0; j < 16; ++j) { const unsigned c = xb_ld(&bar[XB_XCNT(j)]); sum += c; cnt += (c > 0u) ? 1u : 0u; mine = (j == x) ? c : mine; }
        if (sum == G) break;
        __builtin_amdgcn_s_sleep(1);
        if ((++sp & 255u) == 0u) { if (xb_ld(&bar[XB_TMO])) break; if (sp > XB_SPIN_CAP) { atomicAdd(&bar[XB_TMO], 1u); break; } }
    }
    nloc = mine > 0u ? mine : 1u; nx = cnt > 0u ? cnt : 1u;
}
__device__ __forceinline__ void xcd_barrier(const XcdBarrier& b) {
    asm volatile("s_waitcnt vmcnt(0)" ::: "memory");
    __syncthreads();
    if (b.t0) {
        unsigned* bar = b.bar;
        __builtin_amdgcn_s_waitcnt(0);
        unsigned nloc = b.st[0], nx = b.st[1];
        if (nloc == 0u) { xcd_barrier_complete(bar, b.x, nloc, nx); b.st[0] = nloc; b.st[1] = nx; }
        const unsigned old = xb_add(&bar[XB_XSUB(b.x)], 1u);
        const unsigned gen = old / nloc;
        if (old + 1u == (gen + 1u) * nloc) {
            __builtin_amdgcn_fence(__ATOMIC_RELEASE, "agent");
            asm volatile("s_waitcnt vmcnt(0)" ::: "memory");
            const unsigned og = xb_add(&bar[XB_TOP], 1u);
            const unsigned tg = og / nx;
            if (og + 1u == (tg + 1u) * nx) xb_add(&bar[XB_TOPGEN], 1u);
            else XB_SPIN(xb_ld(&bar[XB_TOPGEN]) == tg, bar);
            __builtin_amdgcn_fence(__ATOMIC_ACQUIRE, "agent");
            xb_add(&bar[XB_XGEN(b.x)], 1u);
            asm volatile("s_waitcnt vmcnt(0)" ::: "memory");
        } else {
            XB_SPIN(xb_ld(&bar[XB_XGEN(b.x)]) == gen, bar);
            __builtin_amdgcn_fence(__ATOMIC_ACQUIRE, "agent");
            asm volatile("s_waitcnt vmcnt(0)" ::: "memory");
        }
    }
    __syncthreads();
}

namespace pg8 {
#define PG8_LAS __attribute__((address_space(3)))
typedef unsigned short bf16_t;
typedef short bf16x8 __attribute__((ext_vector_type(8)));
typedef float f32x4 __attribute__((ext_vector_type(4)));
typedef unsigned u32x4 __attribute__((ext_vector_type(4)));
constexpr int BM = 256, BK = 64, HALF = 128, HTB = HALF * BK * 2  , STAGE_BYTES = 8 * HTB, NXCD = 8, WGM = 8;

__host__ __device__ __forceinline__ int lds_byte(int r, int c) { const int st = (r >> 4) * 2 + (c >> 5), rr = r & 15, cc = c & 31, ob = rr * 64 + cc * 2; return st * 1024 + (ob ^ (((ob >> 9) & 1) << 5)); }
__host__ __device__ __forceinline__ void stage_rc(int b, int& R, int& C) { const int st = b / 1024, sb = b % 1024, swz = sb ^ (((sb >> 9) & 1) << 5); R = (st >> 1) * 16 + swz / 64; C = (st & 1) * 32 + (swz % 64) / 2; }
__host__ __device__ __forceinline__ int perm32(int rho) { const int n = rho >> 4, i = rho & 15; return 8 * (i >> 2) + 4 * n + (i & 3); }

struct Unit { int pm, pn; };
struct Gemm { const bf16_t* A; const bf16_t* Bt; int M, N, K; };

struct StaticOrder {
    int nM, nN, nwg, G, c, wave;
    __host__ __device__ void init(int M, int N, int G_, int c_) { nM = M / BM; nN = N / BM; nwg = nM * nN; G = G_; c = c_; }
    __host__ __device__ bool next(int i, Unit& u) const {
        const long L = (long)i * G + c; if (L >= nwg) return false;
        int wgid = (int)L; { const int q = nwg / NXCD, r = nwg % NXCD, xcd = wgid % NXCD, off = wgid / NXCD; wgid = (xcd < r ? xcd * (q + 1) : r * (q + 1) + (xcd - r) * q) + off; }
        const int nig = WGM * nN, gid = wgid / nig, fm = gid * WGM, gsz = (nM - fm) < WGM ? (nM - fm) : WGM;
        u.pm = fm + ((wgid % nig) % gsz); u.pn = (wgid % nig) / gsz; return true;
    }
    __device__ __forceinline__ int arow(int pm) const { return pm * BM; }
    __device__ __forceinline__ void a_ready(const Unit&) const {}
    __device__ __forceinline__ void done(const Unit&) const {}
};

template <class Epi, class Sched, bool ALIGN_EPI = false, bool SP2 = false>
__device__ __forceinline__ void gemm_phase(PG8_LAS unsigned char* lds, const Gemm g, const Sched& S, const Epi& E) {
    int z_ = 0; asm volatile("" : "+v"(z_));
    const int lane = __builtin_amdgcn_mbcnt_hi(~0u, __builtin_amdgcn_mbcnt_lo(~0u, z_)), wid = S.wave, tid = wid * 64 + lane, wr = wid >> 2, wc = wid & 3, fr = lane & 15, fq = lane >> 4;
    const int K = g.K, nt = K / BK;
    unsigned voffA[2], voffB[2];
#pragma unroll
    for (int i = 0; i < 2; ++i) { int R, C; stage_rc(tid * 16 + i * 8192, R, C); const int Rb = Epi::PERM ? ((R & ~31) + perm32(R & 31)) : R;
        voffA[i] = (unsigned)(R * K + C) * 2u; voffB[i] = (unsigned)(Rb * K + C) * 2u; }
    const size_t kstep = (size_t)(BK * 2);
    const size_t hstep = (size_t)HALF * K * 2;
    const size_t tstep = 2 * hstep;
    const unsigned ldsw = (unsigned)wid * 1024u;
    const int aoff = lds_byte(wr * 64 + fr, fq * 8), boff = lds_byte(wc * 32 + fr, fq * 8);
#define PG8_SA(b, h) (((b) * 2 + (h)) * HTB)
#define PG8_SB(b, h) ((4 + (b) * 2 + (h)) * HTB)
#define PG8_STAGE(bufoff, gbase, voff) do { _Pragma("unroll") for (int _i = 0; _i < 2; ++_i) \
        __builtin_amdgcn_global_load_lds((const unsigned*)((const char*)(gbase) + (voff)[_i]), (PG8_LAS unsigned*)(lds + (bufoff) + ldsw + _i * 8192), 16, 0, 0); } while (0)
#define PG8_LDA(dst, b, h) do { _Pragma("unroll") for (int m = 0; m < 4; ++m) _Pragma("unroll") for (int k = 0; k < 2; ++k) dst[m][k] = *(const PG8_LAS bf16x8*)(lds + PG8_SA(b, h) + aoff + m * 2048 + k * 1024); } while (0)
#define PG8_LDB(dst, b, h) do { _Pragma("unroll") for (int n = 0; n < 2; ++n) _Pragma("unroll") for (int k = 0; k < 2; ++k) dst[n][k] = *(const PG8_LAS bf16x8*)(lds + PG8_SB(b, h) + boff + n * 2048 + k * 1024); } while (0)
#define PG8_MMA(ai, bj, At, Bt) do { __builtin_amdgcn_s_setprio(1); _Pragma("unroll") for (int m = 0; m < 4; ++m) _Pragma("unroll") for (int n = 0; n < 2; ++n) _Pragma("unroll") for (int k = 0; k < 2; ++k) \
        acc[ai][bj][m][n] = __builtin_amdgcn_mfma_f32_16x16x32_bf16(Bt[n][k], At[m][k], acc[ai][bj][m][n], 0, 0, 0); __builtin_amdgcn_s_setprio(0); } while (0)
#define PG8_WAIT_V(n) asm volatile("s_waitcnt vmcnt(" #n ")" ::: "memory")
#define PG8_WAIT_L(n) asm volatile("s_waitcnt lgkmcnt(" #n ")" ::: "memory")
#define PG8_BAR __builtin_amdgcn_s_barrier()
#define PG8_SCHED __builtin_amdgcn_sched_barrier(0)
    Unit cur, nxt; int ui = 0;
    if (!S.next(0, cur)) return;
    f32x4 acc[2][2][4][2];
#pragma unroll
    for (int a = 0; a < 2; ++a)
#pragma unroll
        for (int b = 0; b < 2; ++b)
#pragma unroll
            for (int m = 0; m < 4; ++m)
#pragma unroll
                for (int n = 0; n < 2; ++n) acc[a][b][m][n] = (f32x4){0.f, 0.f, 0.f, 0.f};
    bf16x8 At[4][2], B0[2][2], B1[2][2];
    const char* cA = (const char*)g.A + (size_t)S.arow(cur.pm) * (size_t)K * 2; const char* cB = (const char*)g.Bt + (size_t)cur.pn * tstep;
    S.a_ready(cur);
    if constexpr (SP2) {
        PG8_STAGE(PG8_SB(0, 0), cB, voffB); PG8_STAGE(PG8_SB(0, 1), cB + hstep, voffB); PG8_STAGE(PG8_SA(0, 0), cA, voffA); PG8_STAGE(PG8_SA(0, 1), cA + hstep, voffA);
        if (wr == 1) PG8_BAR;
        PG8_WAIT_V(2); PG8_BAR;
        PG8_STAGE(PG8_SB(1, 0), cB + kstep, voffB); PG8_STAGE(PG8_SA(1, 0), cA + kstep, voffA); PG8_STAGE(PG8_SB(1, 1), cB + hstep + kstep, voffB);
        PG8_WAIT_V(6); PG8_BAR;
    } else {
        PG8_STAGE(PG8_SB(0, 0), cB, voffB); PG8_STAGE(PG8_SA(0, 0), cA, voffA); PG8_STAGE(PG8_SB(0, 1), cB + hstep, voffB); PG8_STAGE(PG8_SA(0, 1), cA + hstep, voffA);
        if (wr == 1) PG8_BAR;
        PG8_WAIT_V(4); PG8_BAR;
        PG8_STAGE(PG8_SB(1, 0), cB + kstep, voffB); PG8_STAGE(PG8_SA(1, 0), cA + kstep, voffA); PG8_STAGE(PG8_SB(1, 1), cB + hstep + kstep, voffB);
        PG8_WAIT_V(6); PG8_BAR;
    }
    for (;;) {
        const bool has_next = S.next(ui + 1, nxt);
        const char* nA = has_next ? (const char*)g.A + (size_t)S.arow(nxt.pm) * (size_t)K * 2 : cA; const char* nB = has_next ? (const char*)g.Bt + (size_t)nxt.pn * tstep : cB;
        for (int t = 0; t < nt; t += 2) {
            const bool last = (t == nt - 2);
            const char* a1 = cA + (size_t)(t + 1) * kstep;
            const char* a2 = last ? nA : cA + (size_t)(t + 2) * kstep; const char* b2 = last ? nB : cB + (size_t)(t + 2) * kstep;
            const char* a3 = a2 + kstep; const char* b3 = b2 + kstep;
            if (last && has_next) S.a_ready(nxt);
            if constexpr (SP2) {
            PG8_LDB(B0, 0, 0); PG8_LDB(B1, 0, 1); PG8_SCHED; PG8_LDA(At, 0, 0); PG8_STAGE(PG8_SA(1, 1), a1 + hstep, voffA);
            PG8_WAIT_V(8); PG8_WAIT_L(0); PG8_BAR; PG8_MMA(0, 0, At, B0); PG8_MMA(0, 1, At, B1); PG8_BAR; PG8_SCHED;
            PG8_LDA(At, 0, 1); PG8_STAGE(PG8_SB(0, 0), b2, voffB); PG8_STAGE(PG8_SB(0, 1), b2 + hstep, voffB); PG8_STAGE(PG8_SA(0, 0), a2, voffA);
            PG8_WAIT_V(8); PG8_WAIT_L(0); PG8_BAR; PG8_MMA(1, 0, At, B0); PG8_MMA(1, 1, At, B1); PG8_BAR; PG8_SCHED;
            PG8_LDB(B0, 1, 0); PG8_LDB(B1, 1, 1); PG8_SCHED; PG8_LDA(At, 1, 0); PG8_STAGE(PG8_SA(0, 1), a2 + hstep, voffA);
            PG8_WAIT_V(8); PG8_WAIT_L(0); PG8_BAR; PG8_MMA(0, 0, At, B0); PG8_MMA(0, 1, At, B1); PG8_BAR; PG8_SCHED;
            PG8_LDA(At, 1, 1); PG8_STAGE(PG8_SB(1, 0), b3, voffB); PG8_STAGE(PG8_SB(1, 1), b3 + hstep, voffB); PG8_STAGE(PG8_SA(1, 0), a3, voffA);
            PG8_WAIT_V(8); PG8_WAIT_L(0); PG8_BAR; PG8_MMA(1, 0, At, B0); PG8_MMA(1, 1, At, B1); PG8_BAR; PG8_SCHED;
            } else {
            PG8_LDB(B0, 0, 0); PG8_SCHED; PG8_LDA(At, 0, 0); PG8_STAGE(PG8_SA(1, 1), a1 + hstep, voffA);
            PG8_WAIT_L(8); PG8_BAR; PG8_WAIT_L(0); PG8_MMA(0, 0, At, B0); PG8_BAR; PG8_SCHED;
            PG8_LDB(B1, 0, 1); PG8_STAGE(PG8_SB(0, 0), b2, voffB);
            PG8_BAR; PG8_WAIT_L(0); PG8_MMA(0, 1, At, B1); PG8_BAR;
            PG8_LDA(At, 0, 1); PG8_STAGE(PG8_SA(0, 0), a2, voffA);
            PG8_BAR; PG8_WAIT_L(0); PG8_MMA(1, 0, At, B0); PG8_BAR; PG8_SCHED;
            PG8_STAGE(PG8_SB(0, 1), b2 + hstep, voffB);
            PG8_WAIT_V(6); PG8_BAR; PG8_MMA(1, 1, At, B1); PG8_BAR;
            PG8_LDB(B0, 1, 0); PG8_SCHED; PG8_LDA(At, 1, 0); PG8_STAGE(PG8_SA(0, 1), a2 + hstep, voffA);
            PG8_WAIT_L(8); PG8_BAR; PG8_WAIT_L(0); PG8_MMA(0, 0, At, B0); PG8_BAR; PG8_SCHED;
            PG8_LDB(B1, 1, 1); PG8_STAGE(PG8_SB(1, 0), b3, voffB);
            PG8_BAR; PG8_WAIT_L(0); PG8_MMA(0, 1, At, B1); PG8_BAR;
            PG8_LDA(At, 1, 1); PG8_STAGE(PG8_SA(1, 0), a3, voffA);
            PG8_BAR; PG8_WAIT_L(0); PG8_MMA(1, 0, At, B0); PG8_BAR; PG8_SCHED;
            PG8_STAGE(PG8_SB(1, 1), b3 + hstep, voffB);
            PG8_WAIT_V(6); PG8_BAR; PG8_MMA(1, 1, At, B1); PG8_BAR;
            }
        }
        if constexpr (ALIGN_EPI) { if (wr == 0) PG8_BAR; }
        if constexpr (!Epi::AFTER_DRAIN) { E(acc, cur, wr, wc, fr, fq); S.done(cur); }
        if (!has_next) break;
#pragma unroll
        for (int a = 0; a < 2; ++a)
#pragma unroll
            for (int b = 0; b < 2; ++b)
#pragma unroll
                for (int m = 0; m < 4; ++m)
#pragma unroll
                    for (int n = 0; n < 2; ++n) acc[a][b][m][n] = (f32x4){0.f, 0.f, 0.f, 0.f};
        cur = nxt; cA = nA; cB = nB; ++ui;
        if constexpr (ALIGN_EPI) { if (wr == 1) PG8_BAR; }
    }
    PG8_WAIT_V(0);
    if constexpr (!ALIGN_EPI) { if (wr == 0) PG8_BAR; }
    PG8_BAR;
    if constexpr (Epi::AFTER_DRAIN) { E.fused(acc, cur, wr, wc, fr, fq, lds, wid, lane); S.done(cur); }
#undef PG8_SA
#undef PG8_SB
#undef PG8_STAGE
#undef PG8_LDA
#undef PG8_LDB
#undef PG8_MMA
#undef PG8_WAIT_V
#undef PG8_WAIT_L
#undef PG8_BAR
#undef PG8_SCHED
}
}

namespace pg8 {
__device__ __forceinline__ unsigned cvt_pk_bf16(float lo, float hi) { unsigned r; asm volatile("v_cvt_pk_bf16_f32 %0, %1, %2" : "=v"(r) : "v"(lo), "v"(hi)); return r; }
__device__ __forceinline__ f32x4 gelu4(f32x4 v) { f32x4 o; o.x = gelu_tanh(v.x); o.y = gelu_tanh(v.y); o.z = gelu_tanh(v.z); o.w = gelu_tanh(v.w); return o; }
__device__ __forceinline__ float row_rstd(const float* rsq, int row) {
    const GAS f32x4* p = (const GAS f32x4*)(rsq + (size_t)row * 16);
    const f32x4 a = p[0], b = p[1], c = p[2], d = p[3];
    const float s = ((a.x + a.y) + (a.z + a.w)) + ((b.x + b.y) + (b.z + b.w)) + ((c.x + c.y) + (c.z + c.w)) + ((d.x + d.y) + (d.z + d.w));
    return rsqrtf(s * (1.f / D) + EPS);
}
__device__ __forceinline__ int tile_cidx(int trow) { return trow < NPROMPT ? 0 : 1 + ((trow - NPROMPT) >> 10); }
__device__ __forceinline__ void rstd_table(PG8_LAS float* tab, const float* rsq, int row_start, int wr, int wc, int fr, int fq) {
    const int t = (wr * 4 + wc) * 64 + fq * 16 + fr;
    if (t < 256) tab[t] = row_rstd(rsq, row_start + t);
    asm volatile("s_waitcnt lgkmcnt(0)" ::: "memory"); __builtin_amdgcn_s_barrier(); asm volatile("" ::: "memory");
}
template <int ACT> struct EpiBf16 {
    static constexpr bool PERM = true, AFTER_DRAIN = false;
    bf16_t* O; int ldc; const float* bias; int split_cols; size_t split_stride; const float* rsq; const float* b2; int N; float* rsqv; int vt0; PG8_LAS float* tab;
    __device__ __forceinline__ void operator()(f32x4 (&acc)[2][2][4][2], const Unit& u, int wr, int wc, int fr, int fq) const {
        asm volatile("" : "+v"(fr), "+v"(fq));
        rstd_table(tab, rsq, u.pm * BM, wr, wc, fr, fq);
        const int lrow0 = wr * 64 + fr; int colt = u.pn * BM; bf16_t* base = O; int t = 0;
        if (split_cols) { t = colt / split_cols; base += (size_t)t * split_stride; colt -= t * split_cols; }
        const bool act = (ACT == 1) || (ACT == 2 && t == 0);
        const int col0 = colt + wc * 32 + 8 * fq, bcol0 = u.pn * BM + wc * 32 + 8 * fq;
        const float* b2p = b2 + (size_t)tile_cidx(u.pm * BM) * N + bcol0;
        const bool wantv = rsqv != nullptr && u.pn >= vt0;
        float ss[8];
#pragma unroll
        for (int i = 0; i < 8; ++i) ss[i] = 0.f;
#pragma unroll
        for (int bj = 0; bj < 2; ++bj) { f32x4 bv0 = *(const GAS f32x4*)(b2p + bj * HALF), bv1 = *(const GAS f32x4*)(b2p + bj * HALF + 4);
            if (bias) { bv0 += *(const GAS f32x4*)(bias + bcol0 + bj * HALF); bv1 += *(const GAS f32x4*)(bias + bcol0 + bj * HALF + 4); }
#pragma unroll
            for (int ai = 0; ai < 2; ++ai)
#pragma unroll
                for (int m = 0; m < 4; ++m) { const int lrow = lrow0 + ai * HALF + m * 16; const float rs = tab[lrow];
                    f32x4 v0 = acc[ai][bj][m][0] * rs + bv0, v1 = acc[ai][bj][m][1] * rs + bv1;
                    if (ACT != 0) { if (act) { v0 = gelu4(v0); v1 = gelu4(v1); } }
                    ss[ai * 4 + m] += (v0[0] * v0[0] + v0[1] * v0[1]) + (v0[2] * v0[2] + v0[3] * v0[3]) + (v1[0] * v1[0] + v1[1] * v1[1]) + (v1[2] * v1[2] + v1[3] * v1[3]);
                    u32x4 w; w.x = cvt_pk_bf16(v0[0], v0[1]); w.y = cvt_pk_bf16(v0[2], v0[3]); w.z = cvt_pk_bf16(v1[0], v1[1]); w.w = cvt_pk_bf16(v1[2], v1[3]);
                    *(GAS u32x4*)(base + (size_t)(u.pm * BM + lrow) * ldc + col0 + bj * HALF) = w; } }
        if (wantv) {
#pragma unroll
            for (int i = 0; i < 8; ++i) { float q = ss[i]; q = sum_q4(q);
                if (fq == 0) *(GAS float*)(rsqv + (size_t)(u.pm * BM + lrow0 + (i >> 2) * HALF + (i & 3) * 16) * 32 + (u.pn - vt0) * 4 + wc) = q; } }
    }
};
struct EpiResid {
    static constexpr bool PERM = true, AFTER_DRAIN = false;
    float* out; const float* xp; const float* xs; const float* modl; int which; bool from_input;
    bf16_t* H; const float* ng; const float* modn; int whichs; float* rsq_out;
    __device__ __forceinline__ void operator()(f32x4 (&acc)[2][2][4][2], const Unit& u, int wr, int wc, int fr, int fq) const {
        asm volatile("" : "+v"(fr), "+v"(fq));
        const int trow = u.pm * BM, row0 = wr * 64 + fr, col0 = u.pn * BM + wc * 32 + 8 * fq, ci = tile_cidx(trow);
        const GAS float* gpg = (const GAS float*)(modl + (size_t)(ci * 6 + which) * D + col0);
        const GAS float* bpg = (const GAS float*)(from_input ? (trow < NPROMPT ? xp + (size_t)trow * D : xs + (size_t)(trow - NPROMPT) * D) : out + (size_t)trow * D);
        GAS float* op = (GAS float*)(out + (size_t)trow * D);
        float ss[8];
#pragma unroll
        for (int i = 0; i < 8; ++i) ss[i] = 0.f;
#pragma unroll
        for (int bj = 0; bj < 2; ++bj) {
            const f32x4 gv0 = *(const GAS f32x4*)(gpg + bj * HALF), gv1 = *(const GAS f32x4*)(gpg + bj * HALF + 4);
            f32x4 gs0 = {0.f, 0.f, 0.f, 0.f}, gs1 = {0.f, 0.f, 0.f, 0.f};
            if (H) { const GAS float* sp = (const GAS float*)(modn + (size_t)(ci * 6 + whichs) * D + col0 + bj * HALF); const GAS float* np = (const GAS float*)(ng + col0 + bj * HALF);
                gs0 = *(const GAS f32x4*)np * (1.f + *(const GAS f32x4*)sp); gs1 = *(const GAS f32x4*)(np + 4) * (1.f + *(const GAS f32x4*)(sp + 4)); }
#pragma unroll
            for (int ai = 0; ai < 2; ++ai)
#pragma unroll
                for (int m = 0; m < 4; ++m) { const int lrow = row0 + ai * HALF + m * 16; const size_t off = (size_t)lrow * D + col0 + bj * HALF;
                    f32x4 x0 = *(const GAS f32x4*)(bpg + off), x1 = *(const GAS f32x4*)(bpg + off + 4);
                    x0 += gv0 * acc[ai][bj][m][0]; x1 += gv1 * acc[ai][bj][m][1];
                    *(GAS f32x4*)(op + off) = x0; *(GAS f32x4*)(op + off + 4) = x1;
                    if (H) { ss[ai * 4 + m] += (x0[0] * x0[0] + x0[1] * x0[1]) + (x0[2] * x0[2] + x0[3] * x0[3]) + (x1[0] * x1[0] + x1[1] * x1[1]) + (x1[2] * x1[2] + x1[3] * x1[3]);
                        const f32x4 a0 = x0 * gs0, a1 = x1 * gs1;
                        u32x4 w; w.x = cvt_pk_bf16(a0[0], a0[1]); w.y = cvt_pk_bf16(a0[2], a0[3]); w.z = cvt_pk_bf16(a1[0], a1[1]); w.w = cvt_pk_bf16(a1[2], a1[3]);
                        *(GAS u32x4*)(H + (size_t)(trow + lrow) * D + col0 + bj * HALF) = w; }
                    if (m & 1) asm volatile("" ::: "memory"); } }
        if (H) {
#pragma unroll
            for (int i = 0; i < 8; ++i) { float q = ss[i]; q = sum_q4(q);
                if (fq == 0) *(GAS float*)(rsq_out + (size_t)(trow + row0 + (i >> 2) * HALF + (i & 3) * 16) * 16 + u.pn * 4 + wc) = q; } }
    }
};

__device__ __forceinline__ void ffn_tile_geom(int pm, int& rs, int& vlo, int& vhi) {
    if (pm < 32) { rs = 256 * pm; vlo = 0; vhi = 255; }
    else { const int sq = (pm - 32) / 5, i = (pm - 32) % 5; rs = NPROMPT + 1024 * sq + (i < 4 ? 254 * i : 768); vlo = i == 0 ? 0 : (i < 4 ? 1 : 249); vhi = i < 4 ? 254 : 255; }
}
struct FfnOrder : StaticOrder {
    __device__ __forceinline__ int arow(int pm) const { int rs, a, b; ffn_tile_geom(pm, rs, a, b); return rs; }
};
__device__ __forceinline__ float dpp_prev(float oldv, float v) {
    return __builtin_bit_cast(float, __builtin_amdgcn_update_dpp(__builtin_bit_cast(int, oldv), __builtin_bit_cast(int, v), 0x111, 0xf, 0xf, false)); }
__device__ __forceinline__ float dpp_next(float oldv, float v) {
    return __builtin_bit_cast(float, __builtin_amdgcn_update_dpp(__builtin_bit_cast(int, oldv), __builtin_bit_cast(int, v), 0x101, 0xf, 0xf, false)); }
__device__ __forceinline__ float dpp_ror1(float v) { return __builtin_bit_cast(float, __builtin_amdgcn_update_dpp(0, __builtin_bit_cast(int, v), 0x121, 0xf, 0xf, false)); }
__device__ __forceinline__ float dpp_ror15(float v) { return __builtin_bit_cast(float, __builtin_amdgcn_update_dpp(0, __builtin_bit_cast(int, v), 0x12F, 0xf, 0xf, false)); }
struct EpiFfn {
    static constexpr bool PERM = true, AFTER_DRAIN = false;
    bf16_t* ACT; const float* cw; const float* cb; PG8_LAS float* xb; const float* rsq; const float* b2;
    __device__ __forceinline__ void operator()(f32x4 (&acc)[2][2][4][2], const Unit& u, int wr, int wc, int fr, int fq) const {
        asm volatile("" : "+v"(fr), "+v"(fq));
        int rs, vlo, vhi; ffn_tile_geom(u.pm, rs, vlo, vhi);
        const int colw = wc * 32 + 8 * fq;
        rstd_table(xb + 2048, rsq, rs, wr, wc, fr, fq);
        { const float* b2p = b2 + (size_t)tile_cidx(rs) * 2 * DFF + u.pn * 256 + colw;
#pragma unroll
          for (int bj = 0; bj < 2; ++bj) { const f32x4 bz0 = *(const GAS f32x4*)(b2p + bj * 128), bz1 = *(const GAS f32x4*)(b2p + bj * 128 + 4);
#pragma unroll
              for (int ai = 0; ai < 2; ++ai)
#pragma unroll
                  for (int m = 0; m < 4; ++m) { const float rsd = xb[2048 + 128 * ai + 64 * wr + 16 * m + fr];
                      acc[ai][bj][m][0] = acc[ai][bj][m][0] * rsd + bz0; acc[ai][bj][m][1] = acc[ai][bj][m][1] * rsd + bz1; } } }
#pragma unroll
        for (int ai = 0; ai < 2; ++ai) { const int b = 2 * ai + wr;
            if (fr == 0) {
#pragma unroll
                for (int bj = 0; bj < 2; ++bj)
#pragma unroll
                    for (int n = 0; n < 2; ++n) *(PG8_LAS f32x4*)(xb + (b * 2 + 0) * 256 + bj * 128 + colw + 4 * n) = acc[ai][bj][0][n]; }
            if (fr == 15) {
#pragma unroll
                for (int bj = 0; bj < 2; ++bj)
#pragma unroll
                    for (int n = 0; n < 2; ++n) *(PG8_LAS f32x4*)(xb + (b * 2 + 1) * 256 + bj * 128 + colw + 4 * n) = acc[ai][bj][3][n]; } }
        asm volatile("s_waitcnt lgkmcnt(0)" ::: "memory"); __builtin_amdgcn_s_barrier(); asm volatile("" ::: "memory");
        GAS unsigned char* actb = (GAS unsigned char*)ACT;
        const unsigned lane_off = (unsigned)((rs + 64 * wr + fr) * DFF + u.pn * 128 + colw) * 2u;
#pragma unroll
        for (int n = 0; n < 2; ++n) {
            const int ch = u.pn * 128 + colw + 4 * n;
            f32x4 wg[3], wu[3];
#pragma unroll
            for (int k = 0; k < 3; ++k) { wg[k] = *(const GAS f32x4*)(cw + (size_t)k * 2 * DFF + ch); wu[k] = *(const GAS f32x4*)(cw + (size_t)k * 2 * DFF + DFF + ch); }
            const f32x4 bgv = *(const GAS f32x4*)(cb + ch), buv = *(const GAS f32x4*)(cb + DFF + ch);
#pragma unroll
            for (int ai = 0; ai < 2; ++ai) { const int b = 2 * ai + wr;
                f32x4 pz[2], nz[2];
#pragma unroll
                for (int bj = 0; bj < 2; ++bj) { pz[bj] = b > 0 ? *(PG8_LAS const f32x4*)(xb + ((b - 1) * 2 + 1) * 256 + bj * 128 + colw + 4 * n) : (f32x4){0.f, 0.f, 0.f, 0.f};
                                                 nz[bj] = b < 3 ? *(PG8_LAS const f32x4*)(xb + ((b + 1) * 2 + 0) * 256 + bj * 128 + colw + 4 * n) : (f32x4){0.f, 0.f, 0.f, 0.f}; }
#pragma unroll
                for (int m = 0; m < 4; ++m) { f32x4 zc[2];
#pragma unroll
                    for (int bj = 0; bj < 2; ++bj) { const f32x4 z = acc[ai][bj][m][n]; const f32x4* w3 = bj == 0 ? wg : wu; f32x4 o = bj == 0 ? bgv : buv;
#pragma unroll
                        for (int e = 0; e < 4; ++e) { const float up = m > 0 ? dpp_ror1(acc[ai][bj][m - 1][n][e]) : pz[bj][e], dn = m < 3 ? dpp_ror15(acc[ai][bj][m + 1][n][e]) : nz[bj][e];
                            o[e] += w3[0][e] * dpp_prev(up, z[e]) + w3[1][e] * z[e] + w3[2][e] * dpp_next(dn, z[e]); }
                        zc[bj] = o; }
                    const int lr = 128 * ai + 64 * wr + 16 * m + fr;
                    if (lr >= vlo && lr <= vhi) { u32x2 w; w.x = cvt_pk_bf16(siluf_(zc[0][0]) * zc[1][0], siluf_(zc[0][1]) * zc[1][1]); w.y = cvt_pk_bf16(siluf_(zc[0][2]) * zc[1][2], siluf_(zc[0][3]) * zc[1][3]);
                        *(GAS u32x2*)(actb + (lane_off + (unsigned)((128 * ai + 16 * m) * DFF + 4 * n) * 2u)) = w; } }
                asm volatile("" ::: "memory"); }
        }
    }
};

struct EpiQkv {
    static constexpr bool PERM = true, AFTER_DRAIN = false;
    unsigned char* ws; float* out; const float* rsq; const float* b2; PG8_LAS float* tab; const float* qkg; const float* rope;
    __device__ __forceinline__ void operator()(f32x4 (&acc)[2][2][4][2], const Unit& u, int wr, int wc, int fr, int fq) const {
        asm volatile("" : "+v"(fr), "+v"(fq));
        const int trow = u.pm * BM; const bool smp = trow >= NPROMPT; const int sb = smp ? (trow - NPROMPT) >> 10 : 0, tq0 = smp ? (trow - NPROMPT) & 1023 : 0;
        rstd_table(tab, rsq, trow, wr, wc, fr, fq);
        const int kind = u.pn >> 2, tcol = u.pn * BM + wc * 32 + 8 * fq;
        const float* b2p = b2 + (size_t)tile_cidx(trow) * 3 * D + tcol;
        if (kind < 2) {
            const int oc = (u.pn & 3) * 256 + wc * 64 + 8 * fq;
            f32x4 bz[2][2], gq[2][2];
#pragma unroll
            for (int bj = 0; bj < 2; ++bj)
#pragma unroll
                for (int n = 0; n < 2; ++n) { bz[bj][n] = *(const GAS f32x4*)(b2p + bj * HALF + 4 * n); gq[bj][n] = *(const GAS f32x4*)(qkg + kind * 64 + 32 * bj + 8 * fq + 4 * n); }
#pragma unroll
            for (int ai = 0; ai < 2; ++ai)
#pragma unroll
                for (int m = 0; m < 4; ++m) { const int lrow = 128 * ai + 64 * wr + 16 * m + fr; const float rs = tab[lrow];
                    f32x4 v[2][2]; float ss = 0.f;
#pragma unroll
                    for (int bj = 0; bj < 2; ++bj)
#pragma unroll
                        for (int n = 0; n < 2; ++n) { v[bj][n] = acc[ai][bj][m][n] * rs + bz[bj][n]; ss += (v[bj][n][0] * v[bj][n][0] + v[bj][n][1] * v[bj][n][1]) + (v[bj][n][2] * v[bj][n][2] + v[bj][n][3] * v[bj][n][3]); }
                    ss = sum_q4(ss);
                    const float rn = rsqrtf(ss * (1.f / 64.f) + EPS);
#pragma unroll
                    for (int bj = 0; bj < 2; ++bj)
#pragma unroll
                        for (int n = 0; n < 2; ++n) v[bj][n] = v[bj][n] * rn * gq[bj][n];
                    const unsigned row = (unsigned)(trow + lrow);
                    if (!smp) {
                        if (kind == 1) {
#pragma unroll
                            for (int bj = 0; bj < 2; ++bj)
#pragma unroll
                                for (int n = 0; n < 2; ++n) *(GAS f32x4*)((GAS unsigned char*)out + O_CK * 4 + (row * (unsigned)D + oc + 32 * bj + 4 * n) * 4u) = v[bj][n]; }
                    } else { const int t = tq0 + lrow;
#pragma unroll
                        for (int n = 0; n < 2; ++n) { const f32x4 cs = *(const GAS f32x4*)(rope + t * 32 + 8 * fq + 4 * n), sn = *(const GAS f32x4*)(rope + 32768 + t * 32 + 8 * fq + 4 * n);
                            const f32x4 x1 = v[0][n], x2 = v[1][n]; v[0][n] = x1 * cs - x2 * sn; v[1][n] = x2 * cs + x1 * sn; } }
                    const size_t doff = kind == 0 ? WS_T2 : (smp ? WS_KS : WS_T2 + (size_t)M * D * 2); GAS unsigned char* dst = (GAS unsigned char*)ws + doff;
                    const unsigned drow = (kind == 1 && smp) ? (unsigned)(sb * TKS + PAST + tq0 + lrow) : row;
#pragma unroll
                    for (int bj = 0; bj < 2; ++bj) { u32x4 w; w.x = cvt_pk_bf16(v[bj][0][0], v[bj][0][1]); w.y = cvt_pk_bf16(v[bj][0][2], v[bj][0][3]); w.z = cvt_pk_bf16(v[bj][1][0], v[bj][1][1]); w.w = cvt_pk_bf16(v[bj][1][2], v[bj][1][3]);
                        *(GAS u32x4*)(dst + (drow * (unsigned)D + oc + 32 * bj) * 2u) = w; }
                    if (m & 1) asm volatile("" ::: "memory"); }
        } else {
            const int oc = (u.pn - 8) * 256 + wc * 32 + 8 * fq;
            const size_t doff = smp ? WS_VS : WS_T2 + (size_t)M * D * 2 + (size_t)NPROMPT * D * 2; GAS unsigned char* dst = (GAS unsigned char*)ws + doff;
#pragma unroll
            for (int bj = 0; bj < 2; ++bj) { const f32x4 bz0 = *(const GAS f32x4*)(b2p + bj * HALF), bz1 = *(const GAS f32x4*)(b2p + bj * HALF + 4);
#pragma unroll
                for (int ai = 0; ai < 2; ++ai)
#pragma unroll
                    for (int m = 0; m < 4; ++m) { const int lrow = 128 * ai + 64 * wr + 16 * m + fr; const float rs = tab[lrow];
                        const f32x4 v0 = acc[ai][bj][m][0] * rs + bz0, v1 = acc[ai][bj][m][1] * rs + bz1;
                        const unsigned row = (unsigned)(trow + lrow), drow = smp ? (unsigned)(sb * TKS + PAST + tq0 + lrow) : row;
                        u32x4 w; w.x = cvt_pk_bf16(v0[0], v0[1]); w.y = cvt_pk_bf16(v0[2], v0[3]); w.z = cvt_pk_bf16(v1[0], v1[1]); w.w = cvt_pk_bf16(v1[2], v1[3]);
                        *(GAS u32x4*)(dst + (drow * (unsigned)D + oc + 128 * bj) * 2u) = w;
                        if (!smp) { *(GAS f32x4*)((GAS unsigned char*)out + O_CV * 4 + (row * (unsigned)D + oc + 128 * bj) * 4u) = v0; *(GAS f32x4*)((GAS unsigned char*)out + O_CV * 4 + (row * (unsigned)D + oc + 128 * bj + 4) * 4u) = v1; } } }
        }
    }
};
}

struct Params { const float* in[N_IN]; float* out; unsigned char* ws; };
struct Frame {
    LAS unsigned char* lds; int tid, lane, wave, bid, G, wave0;
    float* out; unsigned char* ws; float* out0; unsigned char* ws0;
    __device__ __forceinline__ const float* inp(int i) const { const unsigned long long v = ((LAS const unsigned long long*)(lds + PTR_OFF))[i];
        const unsigned lo = __builtin_amdgcn_readfirstlane((unsigned)v), hi = __builtin_amdgcn_readfirstlane((unsigned)(v >> 32)); return (const float*)(const GAS float*)(((unsigned long long)hi << 32) | lo); }
    float* mod; float* rstd; float* rope; bf16 *H, *T1, *T2, *T3, *KS, *VS, *WT; float *rsq0, *rsq1, *rsqv, *bias2;
    __device__ __forceinline__ void fresh() {
        int z = 0; asm volatile("" : "+v"(z));
        lane = __builtin_amdgcn_mbcnt_hi(~0u, __builtin_amdgcn_mbcnt_lo(~0u, z)); int wv = wave0; asm volatile("" : "+s"(wv)); wave = wv; tid = wv * 64 + lane;
        int b = blockIdx.x; asm volatile("" : "+s"(b)); bid = b;
        unsigned char* w = ws0; asm volatile("" : "+s"(w)); w = (unsigned char*)(GAS unsigned char*)(unsigned long long)w; ws = w; float* o = out0; asm volatile("" : "+s"(o)); o = (float*)(GAS float*)(unsigned long long)o; out = o;
        mod = (float*)(w + WS_MOD); rstd = (float*)(w + WS_RSTD); rope = (float*)(w + WS_ROPE);
        H = (bf16*)(w + WS_H); T1 = (bf16*)(w + WS_T1); T2 = (bf16*)(w + WS_T2); T3 = (bf16*)(w + WS_T3); KS = (bf16*)(w + WS_KS); VS = (bf16*)(w + WS_VS); WT = (bf16*)(w + WS_W);
        rsq0 = (float*)(w + WS_X); rsq1 = (float*)(w + WS_X + MiB); rsqv = (float*)(w + WS_X + 2 * MiB); bias2 = (float*)(w + WS_X + 4 * MiB);
    }
};
__device__ __forceinline__ const float* xin_row(const Frame& F, int row) { return row < NPROMPT ? F.inp(I_XP) + (size_t)row * D : F.inp(I_XS) + (size_t)(row - NPROMPT) * D; }
__device__ __forceinline__ int cidx_of(int row) { return row < NPROMPT ? 0 : 1 + ((row - NPROMPT) >> 10); }
__device__ __forceinline__ const float* modp(const Frame& F, int l, int row, int which) { return F.mod + (size_t)((l * 3 + cidx_of(row)) * 6 + which) * D; }


template <int MODE  >
__device__ __forceinline__ void transpose_item(const float* W, int K, int N, bf16* WT, LAS float* scr, int item, int lane) {
    const int nblk = N / 32, kb = item / nblk, nb = item % nblk, k0 = 64 * kb, n0 = 32 * nb;
    int d0 = n0; if (MODE == 1) { const int isu = n0 >= DFF, jj = n0 - isu * DFF; d0 = (jj >> 7) * 256 + isu * 128 + (jj & 127); }
    if (MODE == 2 && n0 < 2 * D) { const int w = n0 & 255; d0 = (n0 & ~255) + ((w >> 5) & 1) * 128 + (w >> 6) * 32; }
    float wv[32];
    const GAS float* wp = (const GAS float*)W + (size_t)(k0 + (lane >> 5)) * N + n0 + (lane & 31);
#pragma unroll
    for (int i = 0; i < 32; ++i) wv[i] = wp[(size_t)(2 * i) * N];
#pragma unroll
    for (int i = 0; i < 32; ++i) scr[(2 * i + (lane >> 5)) * 33 + (lane & 31)] = wv[i];
    asm volatile("s_waitcnt lgkmcnt(0)" ::: "memory");
    const int c = lane & 7;
#pragma unroll
    for (int j = 0; j < 4; ++j) { const int n = (lane >> 3) + 8 * j; const LAS float* sp = scr + (8 * c) * 33 + n;
        u32x4 o; o.x = f2bf(sp[0 * 33]) | (f2bf(sp[1 * 33]) << 16); o.y = f2bf(sp[2 * 33]) | (f2bf(sp[3 * 33]) << 16); o.z = f2bf(sp[4 * 33]) | (f2bf(sp[5 * 33]) << 16); o.w = f2bf(sp[6 * 33]) | (f2bf(sp[7 * 33]) << 16);
        *(u32x4*)(WT + (size_t)(d0 + n) * K + k0 + 8 * c) = o; }
    asm volatile("s_waitcnt lgkmcnt(0)" ::: "memory");
}
template <int MODE = 0>
__device__ __forceinline__ bool transpose_group(int& r, const float* W, int nmat, int K, int N, bf16* WT, LAS float* scr, int lane) {
    const int per = (K / 64) * (N / 32), tot = nmat * per;
    if (r >= tot) { r -= tot; return false; }
    const int mi = r / per; transpose_item<MODE>(W + (size_t)mi * K * N, K, N, WT + (size_t)mi * K * N, scr, r % per, lane); return true;
}

template <int SLOT>
__device__ __forceinline__ void convert_slot(Frame& F, int gw, int NGW) {
    LAS float* scr = (LAS float*)(F.lds + F.wave * 16384);
    constexpr size_t UPE = (size_t)2 * DFF * D, DNE = (size_t)D * DFF;
    constexpr int I_UP1 = (D / 64) * (2 * DFF / 32), I_DN1 = (DFF / 64) * (D / 32), I_LIN = (D / 64) * (2 * DRNN / 32), I_LOUT = (DRNN / 64) * (D / 32), I_WG = 80 * 2 * 4,
                  I_CIN = (D / 64) * (2 * DB / 32), I_COUT = (DB / 64) * (D / 32), I_QKV = (D / 64) * (3 * D / 32), I_AOUT = (D / 64) * (D / 32);
    constexpr int NIT = SLOT == 0 ? I_LIN + I_LOUT + I_WG + I_UP1 + I_DN1 : SLOT == 1 ? I_CIN + I_COUT + I_UP1 : SLOT == 2 ? I_DN1 + I_QKV + I_AOUT + I_UP1 : SLOT == 3 ? I_DN1 + I_LIN + I_LOUT : I_UP1 + I_DN1;
    for (int it = gw; it < NIT; it += NGW) { int r = it;
        if (SLOT == 0) {
            if (transpose_group(r, F.inp(I_LRU_WIN), 1, D, 2 * DRNN, F.WT + WE_LRU_IN, scr, F.lane)) continue;
            if (transpose_group(r, F.inp(I_LRU_WOUT), 1, DRNN, D, F.WT + WE_LRU_OUT, scr, F.lane)) continue;
            if (transpose_group(r, F.inp(I_LRU_WG), 80, 128, 128, F.WT + WE_WG, scr, F.lane)) continue;
            if (transpose_group<1>(r, F.inp(I_FF_WUP), 1, D, 2 * DFF, F.WT + WE_UP, scr, F.lane)) continue;
            transpose_group(r, F.inp(I_FF_WDN), 1, DFF, D, F.WT + WE_DN, scr, F.lane);
        } else if (SLOT == 1) {
            if (transpose_group(r, F.inp(I_CM_WIN), 1, D, 2 * DB, F.WT + WE_CM_IN, scr, F.lane)) continue;
            if (transpose_group(r, F.inp(I_CM_WOUT), 1, DB, D, F.WT + WE_CM_OUT, scr, F.lane)) continue;
            transpose_group<1>(r, F.inp(I_FF_WUP) + UPE, 1, D, 2 * DFF, F.WT + WE_UP + UPE, scr, F.lane);
        } else if (SLOT == 2) {
            if (transpose_group(r, F.inp(I_FF_WDN) + DNE, 1, DFF, D, F.WT + WE_DN + DNE, scr, F.lane)) continue;
            if (transpose_group<2>(r, F.inp(I_AT_WQKV), 1, D, 3 * D, F.WT + WE_QKV, scr, F.lane)) continue;
            if (transpose_group(r, F.inp(I_AT_WOUT), 1, D, D, F.WT + WE_AT_OUT, scr, F.lane)) continue;
            transpose_group<1>(r, F.inp(I_FF_WUP) + 2 * UPE, 1, D, 2 * DFF, F.WT + WE_UP + 2 * UPE, scr, F.lane);
        } else if (SLOT == 3) {
            if (transpose_group(r, F.inp(I_FF_WDN) + 2 * DNE, 1, DFF, D, F.WT + WE_DN + 2 * DNE, scr, F.lane)) continue;
            if (transpose_group(r, F.inp(I_LRU_WIN) + (size_t)D * 2 * DRNN, 1, D, 2 * DRNN, F.WT + WE_LRU_IN + (size_t)D * 2 * DRNN, scr, F.lane)) continue;
            transpose_group(r, F.inp(I_LRU_WOUT) + (size_t)DRNN * D, 1, DRNN, D, F.WT + WE_LRU_OUT + (size_t)DRNN * D, scr, F.lane);
        } else {
            if (transpose_group<1>(r, F.inp(I_FF_WUP) + 3 * UPE, 1, D, 2 * DFF, F.WT + WE_UP + 3 * UPE, scr, F.lane)) continue;
            transpose_group(r, F.inp(I_FF_WDN) + 3 * DNE, 1, DFF, D, F.WT + WE_DN + 3 * DNE, scr, F.lane);
        }
    }
}
__device__ __forceinline__ void phase_prologue(Frame& F) {
    F.fresh();
    LAS float* sc = (LAS float*)F.lds;
    const float* c = F.inp(I_C); const float* cctx = F.inp(I_CCTX);
    for (int i = F.tid; i < 3 * D; i += NT) { const int ci = i >> 10, k = i & 1023; const float v = ci == 0 ? cctx[k] : c[(ci - 1) * D + k]; sc[i] = siluf_(v); }
    __syncthreads();
    LAS float* part = sc + 3 * D;
    const int kp = F.tid >> 6, cl = F.tid & 63;
    for (int item = F.bid; item < DEPTH * 6 * D / 64; item += F.G) {
        const int col = item * 64 + cl, l = col / (6 * D), cc = col % (6 * D);
        const float* w = F.inp(I_WMOD) + (size_t)l * D * 6 * D + cc;
        float s0 = 0.f, s1 = 0.f, s2 = 0.f;
#pragma unroll 1
        for (int kb = kp * 128; kb < kp * 128 + 128; kb += 32) { float wv[32];
#pragma unroll
            for (int i = 0; i < 32; ++i) wv[i] = ((const GAS float*)w)[(size_t)(kb + i) * 6 * D];
#pragma unroll
            for (int i = 0; i < 32; ++i) { s0 += sc[kb + i] * wv[i]; s1 += sc[D + kb + i] * wv[i]; s2 += sc[2 * D + kb + i] * wv[i]; } }
        part[(kp * 3 + 0) * 64 + cl] = s0; part[(kp * 3 + 1) * 64 + cl] = s1; part[(kp * 3 + 2) * 64 + cl] = s2;
        __syncthreads();
        if (F.tid < 192) { const int ci = F.tid >> 6; float s = F.inp(I_BMOD)[l * 6 * D + cc];
            for (int q = 0; q < 8; ++q) s += part[(q * 3 + ci) * 64 + cl];
            F.mod[(size_t)((l * 3 + ci) * 6) * D + cc] = s; }
        __syncthreads();
    }
    { __syncthreads(); convert_slot<0>(F, F.bid * NWAVES + F.wave, F.G * NWAVES); }
    const int gt = F.bid * NT + F.tid, GT = F.G * NT;
    for (int i = gt; i < 1024 * 32; i += GT) { const int t = i >> 5, j = i & 31; const float inv = powf(10000.f, -(float)(j & 15) / 16.f); const float pos = (float)(j < 16 ? (t >> 6) : (t & 63));
        const float ang = pos * inv; F.rope[i] = cosf(ang); F.rope[32768 + i] = sinf(ang); }
    for (int i = gt; i < 8 * 8 * 4 * 64; i += GT) { const int ln = i & 63, ks = (i >> 6) & 3, nf = (i >> 8) & 7, g = i >> 11, cq = ln >> 4, p = 16 * nf + (ln & 15);
        const float* wr = F.inp(I_CM_WS) + (size_t)(g * 128 + p) * 128 + 32 * ks + 4 * cq;
        u32x4 o; o.x = f2bf(wr[0]) | (f2bf(wr[1]) << 16); o.y = f2bf(wr[2]) | (f2bf(wr[3]) << 16); o.z = f2bf(wr[16]) | (f2bf(wr[17]) << 16); o.w = f2bf(wr[18]) | (f2bf(wr[19]) << 16);
        *(u32x4*)(F.WT + WE_WSB + (size_t)i * 8) = o; }
    for (int i = gt; i < 2 * PAST * D; i += GT) { const int b = i / (PAST * D), r = i % (PAST * D);
        F.KS[(size_t)b * TKS * D + r] = (bf16)f2bf(F.inp(I_CK)[i]); F.VS[(size_t)b * TKS * D + r] = (bf16)f2bf(F.inp(I_CV)[i]); }
}

__device__ __forceinline__ void bias2_gemm(Frame& F, const bf16* Wt, int N, int l, int sub, float* outp, int gw, int NGW) {
    float sh[3][16];
#pragma unroll
    for (int ci = 0; ci < 3; ++ci) { const GAS f32x4* sp = (const GAS f32x4*)(F.mod + (size_t)((l * 3 + ci) * 6 + sub * 3) * D + 16 * F.lane);
#pragma unroll
        for (int i = 0; i < 4; ++i) { const f32x4 v = sp[i]; sh[ci][4 * i] = v.x; sh[ci][4 * i + 1] = v.y; sh[ci][4 * i + 2] = v.z; sh[ci][4 * i + 3] = v.w; } }
    for (int n = gw; n < N; n += NGW) { const GAS u32x4* wp = (const GAS u32x4*)(Wt + (size_t)n * D + 16 * F.lane); const u32x4 w0 = wp[0], w1 = wp[1];
        const unsigned ww[8] = {w0.x, w0.y, w0.z, w0.w, w1.x, w1.y, w1.z, w1.w};
        float d0 = 0.f, d1 = 0.f, d2 = 0.f;
#pragma unroll
        for (int i = 0; i < 8; ++i) { const float lo = bf2f(ww[i]), hi = bf2f(ww[i] >> 16); d0 += sh[0][2 * i] * lo + sh[0][2 * i + 1] * hi; d1 += sh[1][2 * i] * lo + sh[1][2 * i + 1] * hi; d2 += sh[2][2 * i] * lo + sh[2][2 * i + 1] * hi; }
        d0 = wave_sum(d0); d1 = wave_sum(d1); d2 = wave_sum(d2);
        if (F.lane == 0) { outp[n] = d0; outp[(size_t)N + n] = d1; outp[(size_t)2 * N + n] = d2; } }
}
__device__ __forceinline__ void bias2_slot(Frame& F, int slot, int gw, int NGW) {
    if (slot == 2) bias2_gemm(F, F.WT + WE_CM_IN, 2 * DB, 1, 0, F.bias2 + B2_CM, gw, NGW);
    else if (slot == 3) bias2_gemm(F, F.WT + WE_UP + (size_t)1 * 2 * DFF * D, 2 * DFF, 1, 1, F.bias2 + B2_UP + (size_t)1 * 3 * 5632, gw, NGW);
    else if (slot == 4) bias2_gemm(F, F.WT + WE_QKV, 3 * D, 2, 0, F.bias2 + B2_QKV, gw, NGW);
    else if (slot == 5) bias2_gemm(F, F.WT + WE_UP + (size_t)2 * 2 * DFF * D, 2 * DFF, 2, 1, F.bias2 + B2_UP + (size_t)2 * 3 * 5632, gw, NGW);
    else if (slot == 6) bias2_gemm(F, F.WT + WE_LRU_IN + (size_t)2 * DRNN * D, 2 * DRNN, 3, 0, F.bias2 + B2_LRU + 3 * 2560, gw, NGW);
    else if (slot == 7) bias2_gemm(F, F.WT + WE_UP + (size_t)3 * 2 * DFF * D, 2 * DFF, 3, 1, F.bias2 + B2_UP + (size_t)3 * 3 * 5632, gw, NGW);
}
__device__ __forceinline__ void side_job(Frame& F, int slot) {
    F.fresh();
    const int nwk = F.G > 160 ? F.G - 160 : F.G, wk = F.G > 160 ? F.bid - 160 : F.bid;
    if (wk < 0) return;
    const int gw = wk * NWAVES + F.wave, NGW = nwk * NWAVES;
    bias2_slot(F, slot, gw, NGW);
    if (slot == 1) convert_slot<1>(F, gw, NGW); else if (slot == 2) convert_slot<2>(F, gw, NGW); else if (slot == 3) convert_slot<3>(F, gw, NGW); else if (slot == 4) convert_slot<4>(F, gw, NGW);
}
__device__ __forceinline__ void phase_modulate0(Frame& F) {
    F.fresh();
    const int gw = F.bid * NWAVES + F.wave, NGW = F.G * NWAVES;
    const float* g = F.inp(I_NORMG);
    for (int row = gw; row < M; row += NGW) {
        const float* xr = xin_row(F, row); const float* scl = modp(F, 0, row, 1);
        f32x4 v[4]; float s = 0.f;
#pragma unroll
        for (int j = 0; j < 4; ++j) { v[j] = *(const GAS f32x4*)(xr + 4 * F.lane + 256 * j); s += v[j].x * v[j].x + v[j].y * v[j].y + v[j].z * v[j].z + v[j].w * v[j].w; }
        s = wave_sum(s);
        if (F.lane < 16) F.rsq0[(size_t)row * 16 + F.lane] = F.lane == 0 ? s : 0.f;
#pragma unroll
        for (int j = 0; j < 4; ++j) { const int c0 = 4 * F.lane + 256 * j; const f32x4 gg = *(const GAS f32x4*)(g + c0), c4 = *(const GAS f32x4*)(scl + c0);
            const f32x4 o = v[j] * gg * (1.f + c4); u32x2 w; w.x = f2bf(o.x) | (f2bf(o.y) << 16); w.y = f2bf(o.z) | (f2bf(o.w) << 16);
            *(GAS u32x2*)(F.H + (size_t)row * D + c0) = w; }
    }
    bias2_gemm(F, F.WT + WE_LRU_IN, 2 * DRNN, 0, 0, F.bias2 + B2_LRU, gw, NGW);
    bias2_gemm(F, F.WT + WE_UP, 2 * DFF, 0, 1, F.bias2 + B2_UP, gw, NGW);
}

template <class P>
__device__ __forceinline__ void gemm_naive(Frame& F, const P& p, int nbatch, int Mr, int N, int K) {
    F.fresh();
    LAS float* As = (LAS float*)F.lds;
    LAS float* Bs = As + 16 * 132;
    const int tid = F.tid, tx = tid & 31, ty = tid >> 5;
    const int tm = Mr / 128, tn = N / 128, per = tm * tn, total = per * nbatch;
    for (int t = F.bid; t < total; t += F.G) {
        const int b = t / per, r = t % per, pn = r / tm, pm = r % tm;
        const bf16* A; int lda; const float* W; int ldw; p.get(b, A, lda, W, ldw);
        float acc[8][4];
#pragma unroll
        for (int i = 0; i < 8; ++i)
#pragma unroll
            for (int j = 0; j < 4; ++j) acc[i][j] = 0.f;
        for (int k0 = 0; k0 < K; k0 += 16) {
            { const int row = tid >> 2, kq = (tid & 3) * 4;
              const u32x2 v = *(const u32x2*)(A + (size_t)(pm * 128 + row) * lda + k0 + kq);
              As[(kq + 0) * 132 + row] = bf2f(v.x); As[(kq + 1) * 132 + row] = bf2f(v.x >> 16); As[(kq + 2) * 132 + row] = bf2f(v.y); As[(kq + 3) * 132 + row] = bf2f(v.y >> 16); }
            { const int k = tid >> 5, n4 = (tid & 31) * 4;
              *(LAS f32x4*)(Bs + k * 128 + n4) = *(const f32x4*)(W + (size_t)(k0 + k) * ldw + pn * 128 + n4); }
            __syncthreads();
#pragma unroll 2
            for (int k = 0; k < 16; ++k) {
                const f32x4 a0 = *(const LAS f32x4*)(As + k * 132 + ty * 8), a1 = *(const LAS f32x4*)(As + k * 132 + ty * 8 + 4), bv = *(const LAS f32x4*)(Bs + k * 128 + tx * 4);
                const float a[8] = {a0.x, a0.y, a0.z, a0.w, a1.x, a1.y, a1.z, a1.w}; const float bb[4] = {bv.x, bv.y, bv.z, bv.w};
#pragma unroll
                for (int i = 0; i < 8; ++i)
#pragma unroll
                    for (int j = 0; j < 4; ++j) acc[i][j] += a[i] * bb[j];
            }
            __syncthreads();
        }
#pragma unroll
        for (int i = 0; i < 8; ++i)
#pragma unroll
            for (int j = 0; j < 4; ++j) p.epi(b, pm * 128 + ty * 8 + i, pn * 128 + tx * 4 + j, acc[i][j]);
    }
}

struct PStoreBf16 {
    const bf16* A; int lda; const float* W; int ldw; bf16* O; int ldo; const float* bias; int act; int split;
    __device__ __forceinline__ void get(int, const bf16*& a, int& la, const float*& w, int& lw) const { a = A; la = lda; w = W; lw = ldw; }
    __device__ __forceinline__ void epi(int, int row, int col, float v) const {
        if (bias) v += bias[col];
        if (act == 1 || (act == 2 && col < split)) v = gelu_tanh(v);
        O[(size_t)row * ldo + col] = (bf16)f2bf(v); }
};
struct PResid {
    const bf16* A; int lda; const float* W; int ldw; float* out; const float* xp; const float* xs; const float* modl; int which; bool from_input;
    __device__ __forceinline__ void get(int, const bf16*& a, int& la, const float*& w, int& lw) const { a = A; la = lda; w = W; lw = ldw; }
    __device__ __forceinline__ void epi(int, int row, int col, float v) const {
        const float base = from_input ? (row < NPROMPT ? xp[(size_t)row * D + col] : xs[(size_t)(row - NPROMPT) * D + col]) : out[(size_t)row * D + col];
        out[(size_t)row * D + col] = base + modl[(size_t)(cidx_of(row) * 6 + which) * D + col] * v; }
};
struct PLruIn {
    const bf16* A; const float* W; bf16* GBp; bf16* RECp;
    __device__ __forceinline__ void get(int, const bf16*& a, int& la, const float*& w, int& lw) const { a = A; la = D; w = W; lw = 2 * DRNN; }
    __device__ __forceinline__ void epi(int, int row, int col, float v) const {
        if (col < DRNN) GBp[(size_t)row * DRNN + col] = (bf16)f2bf(gelu_tanh(v)); else RECp[(size_t)row * DRNN + col - DRNN] = (bf16)f2bf(v); }
};
struct PGates {
    const bf16* XC; const float* WG; const float* BG; bf16* O;
    __device__ __forceinline__ void get(int b, const bf16*& a, int& la, const float*& w, int& lw) const { a = XC + (b % 10) * 128; la = DRNN; w = WG + (size_t)b * 128 * 128; lw = 128; }
    __device__ __forceinline__ void epi(int b, int row, int col, float v) const { const int dg = b / 10, n = b % 10;
        O[((size_t)dg * M + row) * DRNN + n * 128 + col] = (bf16)f2bf(sigmoidf_(v + BG[dg * DRNN + n * 128 + col])); }
};

__device__ __forceinline__ void phase_lru_conv(Frame& F, int j, const bf16* REC, bf16* XC) {
    F.fresh();
    const float* cw = F.inp(I_LRU_CW) + (size_t)j * 4 * DRNN; const float* cb = F.inp(I_LRU_CB) + (size_t)j * DRNN;
    const int gt = F.bid * NT + F.tid, GT = F.G * NT;
    for (int i = gt; i < M * DRNN; i += GT) { const int row = i / DRNN, ch = i % DRNN;
        int t, T; if (row < NPROMPT) { t = row & 255; T = 256; } else { t = (row - NPROMPT) & 1023; T = 1024; }
        float s = cb[ch];
#pragma unroll
        for (int k = 0; k < 4; ++k) { const int tt = t + k - 2; if (tt >= 0 && tt < T) s += cw[k * DRNN + ch] * bf2f(REC[(size_t)(row + k - 2) * DRNN + ch]); }
        XC[i] = (bf16)f2bf(s); }
}
__device__ __forceinline__ void phase_lru_scan(Frame& F, int j, const bf16* GATES, const bf16* XC, const bf16* GB, bf16* HS) {
    F.fresh();
    const int gt = F.bid * NT + F.tid, GT = F.G * NT;
    const int NL = (2 + 32) * DRNN;
    for (int line = gt; line < NL; line += GT) {
        const int s = line / DRNN, ch = line % DRNN;
        int base, T; float h0f = 0.f, h0b = 0.f;
        if (s < 2) { base = NPROMPT + s * 1024; T = 1024; h0f = F.inp(I_STATE)[((size_t)(s * 2 + j) * 2 + 0) * DRNN + ch]; h0b = F.inp(I_STATE)[((size_t)(s * 2 + j) * 2 + 1) * DRNN + ch]; }
        else { base = (s - 2) * 256; T = 256; }
        const float spf = softplusf_(-F.inp(I_LRU_LAM)[(size_t)(j * 2 + 0) * DRNN + ch]), spb = softplusf_(-F.inp(I_LRU_LAM)[(size_t)(j * 2 + 1) * DRNN + ch]);
        float h = h0f;
        for (int t = 0; t < T; ++t) { const size_t o = (size_t)(base + t) * DRNN + ch;
            const float r = bf2f(GATES[o]), ig = bf2f(GATES[(size_t)M * DRNN + o]), xc = bf2f(XC[o]);
            const float la = -8.f * r * spf, a = expf(la), bx = sqrtf(-expm1f(2.f * la)) * (ig * xc);
            h = a * h + bx; HS[o] = (bf16)f2bf(h); }
        const float ff = h;
        h = h0b;
        for (int t = T - 1; t >= 0; --t) { const size_t o = (size_t)(base + t) * DRNN + ch;
            const float r = bf2f(GATES[(size_t)2 * M * DRNN + o]), ig = bf2f(GATES[(size_t)3 * M * DRNN + o]), xc = bf2f(XC[o]);
            const float la = -8.f * r * spb, a = expf(la), bx = sqrtf(-expm1f(2.f * la)) * (ig * xc);
            h = a * h + bx; HS[o] = (bf16)f2bf(bf2f(GB[o]) * (bf2f(HS[o]) + h)); }
        if (s >= 2) { float* st = F.out + O_STATE + ((size_t)((s - 2) * 2 + j) * 2) * DRNN; st[ch] = ff; st[DRNN + ch] = h; }
    }
}


typedef short bf16x8 __attribute__((ext_vector_type(8)));
typedef short v4i16_t __attribute__((ext_vector_type(4)));
constexpr int LRU_XS = 272;
constexpr int LRU_XC_OFF = 0, LRU_GB_OFF = 256 * LRU_XS;
template <bool REV>
__device__ __forceinline__ float lru_dir(LAS const unsigned char* xct, LAS unsigned char* hft, const bf16* wgt  ,
                                         const bf16* gbp  , float br, float bi, float sp, float hc, int wave, int lane, bool wantp, bf16* Pdst) {
    const int c = lane & 15, q = lane >> 4, qq = REV ? 3 - q : q;
    bf16x8 Br[4], Bi[4], Id;
#pragma unroll
    for (int ks = 0; ks < 4; ++ks) { Br[ks] = *(const GAS bf16x8*)(wgt + (size_t)(16 * wave + c) * 128 + 32 * ks + 8 * q);
                                     Bi[ks] = *(const GAS bf16x8*)(wgt + (size_t)10 * 128 * 128 + (size_t)(16 * wave + c) * 128 + 32 * ks + 8 * q); }
#pragma unroll
    for (int jj = 0; jj < 8; ++jj) Id[jj] = (8 * q + jj == 16 * (wave & 1) + c) ? (short)0x3F80 : (short)0;
    const int ksel = wave >> 1;
    const float nsp8 = -8.f * sp * 1.44269504f;
    float Pc = 1.f;
    unsigned short gcur[16], gnxt[16];
#pragma unroll
    for (int i = 0; i < 16; ++i) { gcur[i] = 0; gnxt[i] = 0; }
    if (REV) {
#pragma unroll
        for (int i = 0; i < 16; ++i) gcur[i] = *(const GAS unsigned short*)(gbp + (size_t)(16 * (12 + (i >> 2)) + 4 * q + (i & 3)) * DRNN); }
#pragma unroll 1
    for (int og = 0; og < 4; ++og) {
        if (REV && og < 3) {
#pragma unroll
            for (int i = 0; i < 16; ++i) gnxt[i] = *(const GAS unsigned short*)(gbp + (size_t)(16 * (4 * (2 - og) + (i >> 2)) + 4 * q + (i & 3)) * DRNN); }
#pragma unroll
        for (int ii = 0; ii < 4; ++ii) {
        const int it = 4 * og + ii, mi = REV ? 15 - it : it, mloc = REV ? 3 - ii : ii;
        LAS const unsigned char* rp = xct + (16 * mi + c) * LRU_XS + 16 * q;
        bf16x8 Af[4];
#pragma unroll
        for (int ks = 0; ks < 4; ++ks) Af[ks] = *(LAS const bf16x8*)(rp + 64 * ks);
        const bf16x8 Ax = *(LAS const bf16x8*)(rp + 64 * ksel);
        f32x4 r = {0.f, 0.f, 0.f, 0.f}, ig = {0.f, 0.f, 0.f, 0.f};
#pragma unroll
        for (int ks = 0; ks < 4; ++ks) { r = __builtin_amdgcn_mfma_f32_16x16x32_bf16(Af[ks], Br[ks], r, 0, 0, 0); ig = __builtin_amdgcn_mfma_f32_16x16x32_bf16(Af[ks], Bi[ks], ig, 0, 0, 0); }
        const f32x4 xc = __builtin_amdgcn_mfma_f32_16x16x32_bf16(Ax, Id, (f32x4){0.f, 0.f, 0.f, 0.f}, 0, 0, 0);
        float av[4], bv[4];
#pragma unroll
        for (int k = 0; k < 4; ++k) { const float rg = __builtin_amdgcn_rcpf(1.f + __builtin_amdgcn_exp2f(-1.44269504f * (r[k] + br))), iv = __builtin_amdgcn_rcpf(1.f + __builtin_amdgcn_exp2f(-1.44269504f * (ig[k] + bi)));
            const float l2a = nsp8 * rg, x = 1.38629436f * l2a;
            const float oms = -x * (1.f + x * (0.5f + x * (0.16666667f + x * (0.041666668f + x * 0.0083333338f))));
            const float om = x > -0.25f ? oms : 1.f - __builtin_amdgcn_exp2f(2.f * l2a);
            av[k] = __builtin_amdgcn_exp2f(l2a); bv[k] = __builtin_amdgcn_sqrtf(om) * (iv * xc[k]); }
        float pA[4], pB[4];
#pragma unroll
        for (int kk = 0; kk < 4; ++kk) { const int k = REV ? 3 - kk : kk;
            if (kk == 0) { pA[k] = av[k]; pB[k] = bv[k]; } else { const int kp = REV ? k + 1 : k - 1; pA[k] = pA[kp] * av[k]; pB[k] = pB[kp] * av[k] + bv[k]; } }
        const int kl = REV ? 0 : 3;
        float gA[4], gB[4];
#pragma unroll
        for (int g = 0; g < 4; ++g) { const int src = 16 * (REV ? 3 - g : g) + c; gA[g] = bperm(pA[kl], src); gB[g] = bperm(pB[kl], src); }
        float eA = 1.f, eB = 0.f, tA = 1.f, tB = 0.f;
#pragma unroll
        for (int g = 0; g < 4; ++g) { if (g == qq) { eA = tA; eB = tB; } tB = tB * gA[g] + gB[g]; tA = tA * gA[g]; }
        const float hin = eA * hc + eB;
#pragma unroll
        for (int k = 0; k < 4; ++k) { const float h = pA[k] * hin + pB[k]; const int row = 16 * mi + 4 * q + k;
            if (wantp) Pdst[(size_t)row * DRNN] = (bf16)f2bf(pA[k] * eA * Pc);
            LAS unsigned short* hp = (LAS unsigned short*)(hft + row * LRU_XS + 2 * (16 * wave + c));
            if (!REV) *hp = (unsigned short)f2bf(h); else *hp = (unsigned short)f2bf(bf2f(gcur[4 * mloc + k]) * (bf2f(*hp) + h)); }
        hc = tA * hc + tB; Pc *= tA;
        }
        if (REV) {
#pragma unroll
            for (int i = 0; i < 16; ++i) gcur[i] = gnxt[i]; }
    }
    return hc;
}
__device__ __forceinline__ void lru_unit(Frame& F, int j, int pm, int n, const bf16* REC, const bf16* GB, bf16* HS, bf16* PF, bf16* PB, float* AGG, const bf16* WGT) {
    const int tid = F.tid, lane = F.lane, wave = F.wave, r0 = 256 * pm;
    const bool smp = pm >= 32; const int tix = smp ? (pm - 32) & 3 : 0, sq = smp ? (pm - 32) >> 2 : 0;
    const int t0 = smp ? 256 * tix : 0, T = smp ? 1024 : 256;
    LAS unsigned char* xct = F.lds + LRU_XC_OFF; LAS unsigned char* hft = F.lds + LRU_GB_OFF;
    { const float* cw = F.inp(I_LRU_CW) + (size_t)j * 4 * DRNN + n * 128 + 2 * lane; const float* cb = F.inp(I_LRU_CB) + (size_t)j * DRNN + n * 128 + 2 * lane;
      float w0[4], w1[4];
#pragma unroll
      for (int k = 0; k < 4; ++k) { w0[k] = cw[k * DRNN]; w1[k] = cw[k * DRNN + 1]; }
      const float b0 = cb[0], b1 = cb[1];
      unsigned v[35];
#pragma unroll
      for (int i = 0; i < 35; ++i) { const int tl = 32 * wave + i - 2, tt = t0 + tl;
          v[i] = (tt >= 0 && tt < T) ? *(const GAS unsigned*)(REC + (size_t)(r0 + tl) * DRNN + n * 128 + 2 * lane) : 0u; }
#pragma unroll
      for (int i = 0; i < 32; ++i) { float s0 = b0, s1 = b1;
#pragma unroll
          for (int k = 0; k < 4; ++k) { s0 += w0[k] * bf2f(v[i + k]); s1 += w1[k] * bf2f(v[i + k] >> 16); }
          *(LAS unsigned*)(xct + (32 * wave + i) * LRU_XS + 4 * lane) = f2bf(s0) | (f2bf(s1) << 16); } }
    __syncthreads();
    const int c = lane & 15, q = lane >> 4, ch = n * 128 + 16 * wave + c;
    const float* bg = F.inp(I_LRU_BG) + (size_t)j * 4 * DRNN; const float* lam = F.inp(I_LRU_LAM) + (size_t)j * 2 * DRNN;
    const bf16* gbp = GB + (size_t)r0 * DRNN + ch;
    bf16* pf = PF + (size_t)(smp ? r0 - NPROMPT : 0) * DRNN + ch; bf16* pb = PB + (size_t)(smp ? r0 - NPROMPT : 0) * DRNN + ch;
    { float h0 = 0.f; if (smp && tix == 0) h0 = F.inp(I_STATE)[((size_t)(sq * 2 + j) * 2 + 0) * DRNN + ch];
      const float hfin = lru_dir<false>(xct, hft, WGT + (size_t)(0 * 10 + n) * 128 * 128, gbp, bg[0 * DRNN + ch], bg[1 * DRNN + ch], softplusf_(-lam[ch]), h0, wave, lane, smp, pf);
      if (q == 0) { if (smp) AGG[(size_t)((sq * 4 + tix) * 2 + 0) * DRNN + ch] = hfin; else F.out[O_STATE + ((size_t)(pm * 2 + j) * 2 + 0) * DRNN + ch] = hfin; } }
    { float h0 = 0.f; if (smp && tix == 3) h0 = F.inp(I_STATE)[((size_t)(sq * 2 + j) * 2 + 1) * DRNN + ch];
      const float hfin = lru_dir<true>(xct, hft, WGT + (size_t)(2 * 10 + n) * 128 * 128, gbp, bg[2 * DRNN + ch], bg[3 * DRNN + ch], softplusf_(-lam[DRNN + ch]), h0, wave, lane, smp, pb);
      if (q == 0) { if (smp) AGG[(size_t)((sq * 4 + tix) * 2 + 1) * DRNN + ch] = hfin; else F.out[O_STATE + ((size_t)(pm * 2 + j) * 2 + 1) * DRNN + ch] = hfin; } }
    __syncthreads();
#pragma unroll
    for (int i = 0; i < 8; ++i) { const int id = i * NT + tid, row = id >> 4, cc = id & 15;
        *(GAS u32x4*)(HS + (size_t)(r0 + row) * DRNN + n * 128 + 8 * cc) = *(LAS const u32x4*)(hft + row * LRU_XS + 16 * cc); }
    __syncthreads();
}
__device__ __forceinline__ void phase_lru_core(Frame& F, int j, const bf16* REC, const bf16* GB, bf16* HS, bf16* PF, bf16* PB, float* AGG, const bf16* WGT) {
    F.fresh();
    for (int u = F.bid; u < 400; u += F.G) {
        const int pm = u < 80 ? 32 + u / 10 : (u - 80) / 10, n = u % 10;
        lru_unit(F, j, pm, n, REC, GB, HS, PF, PB, AGG, WGT); }
}
__device__ __forceinline__ void phase_lru_fixup(Frame& F, const bf16* GB, bf16* HS, const bf16* PF, const bf16* PB, const float* AGG) {
    F.fresh();
    const int gt = F.bid * NT + F.tid, GT = F.G * NT;
    for (int i = gt; i < NSAMPLE * DRNN; i += GT) { const int rs = i / DRNN, ch = i % DRNN, sq = rs >> 10, tix = (rs >> 8) & 3;
        float cf = 0.f, cbk = 0.f;
        if (tix > 0) { for (int t = 0; t < tix; ++t) { const float At = bf2f(PF[(size_t)(sq * 1024 + t * 256 + 255) * DRNN + ch]); cf = At * cf + AGG[(size_t)((sq * 4 + t) * 2 + 0) * DRNN + ch]; } }
        if (tix < 3) { for (int t = 3; t > tix; --t) { const float At = bf2f(PB[(size_t)(sq * 1024 + t * 256) * DRNN + ch]); cbk = At * cbk + AGG[(size_t)((sq * 4 + t) * 2 + 1) * DRNN + ch]; } }
        const size_t o = (size_t)(NPROMPT + rs) * DRNN + ch;
        HS[o] = (bf16)f2bf(bf2f(HS[o]) + bf2f(GB[o]) * (bf2f(PF[(size_t)rs * DRNN + ch]) * cf + bf2f(PB[(size_t)rs * DRNN + ch]) * cbk)); }
}

__device__ __forceinline__ void phase_cmlp_rstd(Frame& F, const bf16* UV) {
    F.fresh();
    const int gw = F.bid * NWAVES + F.wave, NGW = F.G * NWAVES;
    for (int row = gw; row < M; row += NGW) { float s = 0.f;
        for (int c = F.lane; c < DB; c += 64) { const float v = bf2f(UV[(size_t)row * 2 * DB + DB + c]); s += v * v; }
        s = wave_sum(s); if (F.lane == 0) F.rstd[row] = rsqrtf(s * (1.f / DB) + EPS); }
}
__device__ __forceinline__ void phase_cmlp_spatial(Frame& F, const bf16* UV, bf16* ACT) {
    F.fresh();
    const float* ws = F.inp(I_CM_WS); const float* bs = F.inp(I_CM_BS); const float* ng = F.inp(I_CM_NG);
    const int gt = F.bid * NT + F.tid, GT = F.G * NT;
    for (int i = gt; i < M * DB; i += GT) { const int row = i / DB, ch = i % DB, g = ch >> 8, p = row & 127, r0 = row & ~127;
        float s = 0.f;
        for (int q = 0; q < 128; ++q) s += ws[(size_t)(g * 128 + p) * 128 + q] * F.rstd[r0 + q] * bf2f(UV[(size_t)(r0 + q) * 2 * DB + DB + ch]);
        const float sv = s * ng[ch] + bs[g * 128 + p];
        ACT[i] = (bf16)f2bf(bf2f(UV[(size_t)row * 2 * DB + ch]) * sv); }
}


constexpr int CM_VS = 544;
__device__ __forceinline__ void phase_cmlp_spatial_mfma(Frame& F, const bf16* UV, bf16* ACT, const bf16* WSB) {
    F.fresh();
    const int tid = F.tid, lane = F.lane, wave = F.wave, c = lane & 15, q4 = lane >> 4;
    LAS unsigned char* vt = F.lds;
    const float* ng = F.inp(I_CM_NG); const float* bs = F.inp(I_CM_BS);
    for (int u = F.bid; u < 640; u += F.G) {
        const int chunk = u >> 3, g = u & 7, r0 = chunk * 128;
        LAS float* rsl = (LAS float*)(vt + 128 * CM_VS);
        if (tid < 128) { const GAS f32x4* p = (const GAS f32x4*)(F.rsqv + (size_t)(r0 + tid) * 32); float sm = 0.f;
#pragma unroll
            for (int i = 0; i < 8; ++i) { const f32x4 t4 = p[i]; sm += (t4.x + t4.y) + (t4.z + t4.w); }
            rsl[tid] = rsqrtf(sm * (1.f / DB) + EPS); }
        __syncthreads();
#pragma unroll
        for (int i = 0; i < 8; ++i) { const int id = i * NT + tid, row = id >> 5, cc = id & 31;
            const u32x4 x = *(const GAS u32x4*)(UV + (size_t)(r0 + row) * 2 * DB + DB + g * 256 + 8 * cc); const float rs = rsl[row];
            u32x4 y; y.x = f2bf(bf2f(x.x) * rs) | (f2bf(bf2f(x.x >> 16) * rs) << 16); y.y = f2bf(bf2f(x.y) * rs) | (f2bf(bf2f(x.y >> 16) * rs) << 16);
            y.z = f2bf(bf2f(x.z) * rs) | (f2bf(bf2f(x.z >> 16) * rs) << 16); y.w = f2bf(bf2f(x.w) * rs) | (f2bf(bf2f(x.w >> 16) * rs) << 16);
            *(LAS u32x4*)(vt + row * CM_VS + 16 * cc) = y; }
        __syncthreads();
        bf16x8 vf[2][4];
#pragma unroll
        for (int mfc = 0; mfc < 2; ++mfc)
#pragma unroll
            for (int ks = 0; ks < 4; ++ks) { LAS const unsigned char* vp = vt + (32 * ks + 4 * q4 + (c >> 2)) * CM_VS + (32 * wave + 16 * mfc + 4 * (c & 3)) * 2;
                const v4i16_t lo = __builtin_amdgcn_ds_read_tr16_b64_v4i16((LAS v4i16_t*)vp), hi = __builtin_amdgcn_ds_read_tr16_b64_v4i16((LAS v4i16_t*)(vp + 16 * CM_VS));
                vf[mfc][ks] = (bf16x8){lo[0], lo[1], lo[2], lo[3], hi[0], hi[1], hi[2], hi[3]}; }
#pragma unroll
        for (int nf = 0; nf < 8; ++nf) {
            bf16x8 Bf[4];
#pragma unroll
            for (int ks = 0; ks < 4; ++ks) Bf[ks] = *(const GAS bf16x8*)(WSB + ((size_t)((g * 8 + nf) * 4 + ks) * 64 + lane) * 8);
            const int p = 16 * nf + c; const float bsv = bs[g * 128 + p];
#pragma unroll
            for (int mfc = 0; mfc < 2; ++mfc) { f32x4 acc = {0.f, 0.f, 0.f, 0.f};
#pragma unroll
                for (int ks = 0; ks < 4; ++ks) acc = __builtin_amdgcn_mfma_f32_16x16x32_bf16(vf[mfc][ks], Bf[ks], acc, 0, 0, 0);
                const int ch = g * 256 + 32 * wave + 16 * mfc + 4 * q4;
                const f32x4 g4 = *(const GAS f32x4*)(ng + ch); const u32x2 uu = *(const GAS u32x2*)(UV + (size_t)(r0 + p) * 2 * DB + ch);
                const float o0 = bf2f(uu.x) * (acc[0] * g4.x + bsv), o1 = bf2f(uu.x >> 16) * (acc[1] * g4.y + bsv), o2 = bf2f(uu.y) * (acc[2] * g4.z + bsv), o3 = bf2f(uu.y >> 16) * (acc[3] * g4.w + bsv);
                u32x2 w; w.x = f2bf(o0) | (f2bf(o1) << 16); w.y = f2bf(o2) | (f2bf(o3) << 16);
                *(GAS u32x2*)(ACT + (size_t)(r0 + p) * DB + ch) = w; }
        }
        __syncthreads();
    }
}

__device__ __forceinline__ void phase_qkv_post(Frame& F, const bf16* QKV, bf16* Q, bf16* KP, bf16* VP) {
    F.fresh();
    const int gw = F.bid * NWAVES + F.wave, NGW = F.G * NWAVES;
    const float* qkg = F.inp(I_AT_QKG);
    for (int row = gw; row < M; row += NGW) {
        const bool smp = row >= NPROMPT; const int sb = smp ? (row - NPROMPT) >> 10 : 0, t = smp ? (row - NPROMPT) & 1023 : 0;
        const float cs = smp ? F.rope[t * 32 + (F.lane & 31)] : 1.f, sn = smp ? F.rope[32768 + t * 32 + (F.lane & 31)] : 0.f;
        for (int grp = 0; grp < 32; ++grp) {
            const float v = bf2f(QKV[(size_t)row * 3072 + grp * 64 + F.lane]);
            const float ms = wave_sum(v * v) * (1.f / 64.f);
            float n = v * rsqrtf(ms + EPS) * qkg[(grp >> 4) * 64 + F.lane];
            const float keep = n;
            if (smp) { float pr; { auto r_ = __builtin_amdgcn_permlane32_swap(__builtin_bit_cast(unsigned, n), __builtin_bit_cast(unsigned, n), false, false); pr = __builtin_bit_cast(float, F.lane < 32 ? (unsigned)r_[1] : (unsigned)r_[0]); } n = F.lane < 32 ? n * cs - pr * sn : n * cs + pr * sn; }
            if (grp < 16) Q[(size_t)row * D + grp * 64 + F.lane] = (bf16)f2bf(n);
            else { const int c = (grp - 16) * 64 + F.lane;
                if (smp) F.KS[((size_t)sb * TKS + PAST + t) * D + c] = (bf16)f2bf(n);
                else { KP[(size_t)row * D + c] = (bf16)f2bf(keep); F.out[O_CK + (size_t)row * D + c] = keep; } }
        }
        for (int c = F.lane; c < D; c += 64) { const bf16 vb = QKV[(size_t)row * 3072 + 2048 + c];
            if (smp) F.VS[((size_t)sb * TKS + PAST + t) * D + c] = vb; else { VP[(size_t)row * D + c] = vb; F.out[O_CV + (size_t)row * D + c] = bf2f(vb); } }
    }
}
__device__ __forceinline__ void phase_attn_naive(Frame& F, int l, const bf16* Q, const bf16* KP, const bf16* VP, bf16* O) {
    F.fresh();
    const int gw = F.bid * NWAVES + F.wave, NGW = F.G * NWAVES;
    LAS float* s1 = (LAS float*)F.lds + F.wave * 3328; LAS float* s2 = s1 + 1536; LAS float* qs = s2 + 1536;
    const float* al = F.inp(I_AT_LAM);
    const float lam_init = 0.8f - 0.6f * expf(-0.3f * (float)l);
    const float lam = expf(wave_sum(al[F.lane] * al[64 + F.lane])) - expf(wave_sum(al[128 + F.lane] * al[192 + F.lane])) + lam_init;
    const float* sg = F.inp(I_AT_SUBG);
    for (int item = gw; item < M * 8; item += NGW) {
        const int row = item >> 3, h = item & 7;
        const bf16 *Kb, *Vb; int Tk;
        if (row < NPROMPT) { Kb = KP + (size_t)(row & ~255) * D; Vb = VP + (size_t)(row & ~255) * D; Tk = 256; }
        else { const int sb = (row - NPROMPT) >> 10; Kb = F.KS + (size_t)sb * TKS * D; Vb = F.VS + (size_t)sb * TKS * D; Tk = TKS; }
        qs[F.lane] = bf2f(Q[(size_t)row * D + h * 128 + F.lane]); qs[64 + F.lane] = bf2f(Q[(size_t)row * D + h * 128 + 64 + F.lane]);
        asm volatile("s_waitcnt lgkmcnt(0)" ::: "memory");
        float m1 = -1e30f, m2 = -1e30f;
        for (int k = F.lane; k < Tk; k += 64) { const bf16* kr = Kb + (size_t)k * D + h * 128; float d1 = 0.f, d2 = 0.f;
#pragma unroll 4
            for (int d = 0; d < 64; d += 2) { const unsigned a = *(const unsigned*)(kr + d), b = *(const unsigned*)(kr + 64 + d);
                d1 += qs[d] * bf2f(a) + qs[d + 1] * bf2f(a >> 16); d2 += qs[64 + d] * bf2f(b) + qs[64 + d + 1] * bf2f(b >> 16); }
            d1 *= 0.125f; d2 *= 0.125f; s1[k] = d1; s2[k] = d2; m1 = fmaxf(m1, d1); m2 = fmaxf(m2, d2); }
        m1 = wave_max(m1); m2 = wave_max(m2);
        float l1 = 0.f, l2 = 0.f;
        for (int k = F.lane; k < Tk; k += 64) { const float e1 = expf(s1[k] - m1), e2 = expf(s2[k] - m2); s1[k] = e1; s2[k] = e2; l1 += e1; l2 += e2; }
        l1 = wave_sum(l1); l2 = wave_sum(l2);
        const float i1 = 1.f / l1, i2 = lam / l2;
        for (int k = F.lane; k < Tk; k += 64) s1[k] = bf2f(f2bf(s1[k] * i1 - s2[k] * i2));
        asm volatile("s_waitcnt lgkmcnt(0)" ::: "memory");
        float o0 = 0.f, o1 = 0.f;
        for (int k = 0; k < Tk; ++k) { const unsigned vv = *(const unsigned*)(Vb + (size_t)k * D + h * 128 + 2 * F.lane); const float w = s1[k]; o0 += w * bf2f(vv); o1 += w * bf2f(vv >> 16); }
        const float ms = wave_sum(o0 * o0 + o1 * o1) * (1.f / 128.f), rs = rsqrtf(ms + EPS) * (1.f - lam_init);
        o0 = o0 * rs * sg[2 * F.lane]; o1 = o1 * rs * sg[2 * F.lane + 1];
        *(unsigned*)(O + (size_t)row * D + h * 128 + 2 * F.lane) = f2bf(o0) | (f2bf(o1) << 16);
        asm volatile("s_waitcnt lgkmcnt(0)" ::: "memory");
    }
}


constexpr int AT_KS = 272, AT_VS = 288, AT_KBYTES = 64 * AT_KS, AT_VBYTES = 64 * AT_VS, AT_BUF = AT_KBYTES + AT_VBYTES;
__device__ __forceinline__ void attn_unit(Frame& F, int l, const bf16* Qrows  , const bf16* Kb, const bf16* Vb, int Tk, bf16* Orows, int h, float lam, float lam_init) {
    const int tid = F.tid, lane = F.lane, wave = F.wave, c = lane & 15, q4 = lane >> 4;
    LAS unsigned char* lds = F.lds;
    const float SC = 0.18033688f;
    bf16x8 Qf[2][2];
#pragma unroll
    for (int cp = 0; cp < 2; ++cp)
#pragma unroll
        for (int ks = 0; ks < 2; ++ks) Qf[cp][ks] = *(const GAS bf16x8*)(Qrows + (size_t)(16 * wave + c) * D + h * 128 + cp * 64 + 32 * ks + 8 * q4);
    const int nt = Tk / 64;
    const int key0 = tid >> 4, cc0 = tid & 15;
    u32x4 kreg[2], vreg[2];
    float m1 = -1e30f, m2 = -1e30f, l1 = 0.f, l2 = 0.f;
#pragma unroll
    for (int i = 0; i < 2; ++i) kreg[i] = *(const GAS u32x4*)(Kb + (size_t)(key0 + 32 * i) * D + h * 128 + 8 * cc0);
#pragma unroll
    for (int i = 0; i < 2; ++i) *(LAS u32x4*)(lds + (key0 + 32 * i) * AT_KS + 16 * cc0) = kreg[i];
    __syncthreads();
    for (int t = 0; t < nt; ++t) {
        LAS const unsigned char* kt = lds + (t & 1) * AT_BUF;
        if (t + 1 < nt) {
#pragma unroll
            for (int i = 0; i < 2; ++i) kreg[i] = *(const GAS u32x4*)(Kb + (size_t)((t + 1) * 64 + key0 + 32 * i) * D + h * 128 + 8 * cc0); }
        f32x4 S[2][4];
#pragma unroll
        for (int cp = 0; cp < 2; ++cp)
#pragma unroll
            for (int mf = 0; mf < 4; ++mf) { S[cp][mf] = (f32x4){0.f, 0.f, 0.f, 0.f};
#pragma unroll
                for (int ks = 0; ks < 2; ++ks) { const bf16x8 kf = *(LAS const bf16x8*)(kt + (16 * mf + c) * AT_KS + cp * 128 + ks * 64 + 16 * q4);
                    S[cp][mf] = __builtin_amdgcn_mfma_f32_16x16x32_bf16(kf, Qf[cp][ks], S[cp][mf], 0, 0, 0); } }
        float x1 = -1e30f, x2 = -1e30f;
#pragma unroll
        for (int mf = 0; mf < 4; ++mf)
#pragma unroll
            for (int k = 0; k < 4; ++k) { x1 = fmaxf(x1, S[0][mf][k]); x2 = fmaxf(x2, S[1][mf][k]); }
        x1 = max_q4(x1); x2 = max_q4(x2);
        const float n1 = fmaxf(m1, x1), n2 = fmaxf(m2, x2);
        l1 *= exp2f((m1 - n1) * SC); l2 *= exp2f((m2 - n2) * SC); m1 = n1; m2 = n2;
#pragma unroll
        for (int mf = 0; mf < 4; ++mf)
#pragma unroll
            for (int k = 0; k < 4; ++k) { l1 += exp2f((S[0][mf][k] - m1) * SC); l2 += exp2f((S[1][mf][k] - m2) * SC); }
        if (t + 1 < nt) {
#pragma unroll
            for (int i = 0; i < 2; ++i) *(LAS u32x4*)(lds + ((t + 1) & 1) * AT_BUF + (key0 + 32 * i) * AT_KS + 16 * cc0) = kreg[i]; }
        __syncthreads();
    }
    l1 = sum_q4(l1); l2 = sum_q4(l2);
    const float i1 = 1.f / l1, i2 = lam / l2;
    f32x4 Ot[8];
#pragma unroll
    for (int md = 0; md < 8; ++md) Ot[md] = (f32x4){0.f, 0.f, 0.f, 0.f};
#pragma unroll
    for (int i = 0; i < 2; ++i) { kreg[i] = *(const GAS u32x4*)(Kb + (size_t)(key0 + 32 * i) * D + h * 128 + 8 * cc0); vreg[i] = *(const GAS u32x4*)(Vb + (size_t)(key0 + 32 * i) * D + h * 128 + 8 * cc0); }
#pragma unroll
    for (int i = 0; i < 2; ++i) { *(LAS u32x4*)(lds + (key0 + 32 * i) * AT_KS + 16 * cc0) = kreg[i]; *(LAS u32x4*)(lds + AT_KBYTES + (key0 + 32 * i) * AT_VS + 16 * cc0) = vreg[i]; }
    __syncthreads();
    for (int t = 0; t < nt; ++t) {
        LAS const unsigned char* kt = lds + (t & 1) * AT_BUF; LAS const unsigned char* vt = kt + AT_KBYTES;
        if (t + 1 < nt) {
#pragma unroll
            for (int i = 0; i < 2; ++i) { kreg[i] = *(const GAS u32x4*)(Kb + (size_t)((t + 1) * 64 + key0 + 32 * i) * D + h * 128 + 8 * cc0);
                                          vreg[i] = *(const GAS u32x4*)(Vb + (size_t)((t + 1) * 64 + key0 + 32 * i) * D + h * 128 + 8 * cc0); } }
        f32x4 S[2][4];
#pragma unroll
        for (int cp = 0; cp < 2; ++cp)
#pragma unroll
            for (int mf = 0; mf < 4; ++mf) { S[cp][mf] = (f32x4){0.f, 0.f, 0.f, 0.f};
#pragma unroll
                for (int ks = 0; ks < 2; ++ks) { const bf16x8 kf = *(LAS const bf16x8*)(kt + (16 * mf + c) * AT_KS + cp * 128 + ks * 64 + 16 * q4);
                    S[cp][mf] = __builtin_amdgcn_mfma_f32_16x16x32_bf16(kf, Qf[cp][ks], S[cp][mf], 0, 0, 0); } }
        bf16x8 Wf[2];
#pragma unroll
        for (int kk = 0; kk < 2; ++kk)
#pragma unroll
            for (int jj = 0; jj < 8; ++jj) { const int mf = 2 * kk + (jj >> 2), k = jj & 3;
                const float w = exp2f((S[0][mf][k] - m1) * SC) * i1 - exp2f((S[1][mf][k] - m2) * SC) * i2; Wf[kk][jj] = (short)f2bf(w); }
#pragma unroll
        for (int md = 0; md < 8; ++md)
#pragma unroll
            for (int kk = 0; kk < 2; ++kk) { LAS const unsigned char* vp = vt + (32 * kk + 4 * q4 + (c >> 2)) * AT_VS + (16 * md + 4 * (c & 3)) * 2;
                const v4i16_t lo = __builtin_amdgcn_ds_read_tr16_b64_v4i16((LAS v4i16_t*)vp), hi = __builtin_amdgcn_ds_read_tr16_b64_v4i16((LAS v4i16_t*)(vp + 16 * AT_VS));
                const bf16x8 vf = {lo[0], lo[1], lo[2], lo[3], hi[0], hi[1], hi[2], hi[3]};
                Ot[md] = __builtin_amdgcn_mfma_f32_16x16x32_bf16(vf, Wf[kk], Ot[md], 0, 0, 0); }
        if (t + 1 < nt) {
#pragma unroll
            for (int i = 0; i < 2; ++i) { *(LAS u32x4*)(lds + ((t + 1) & 1) * AT_BUF + (key0 + 32 * i) * AT_KS + 16 * cc0) = kreg[i];
                                          *(LAS u32x4*)(lds + ((t + 1) & 1) * AT_BUF + AT_KBYTES + (key0 + 32 * i) * AT_VS + 16 * cc0) = vreg[i]; } }
        __syncthreads();
    }
    float ss = 0.f;
#pragma unroll
    for (int md = 0; md < 8; ++md)
#pragma unroll
        for (int k = 0; k < 4; ++k) ss += Ot[md][k] * Ot[md][k];
    ss = sum_q4(ss);
    const float rs = rsqrtf(ss * (1.f / 128.f) + EPS) * (1.f - lam_init);
    const float* sg = F.inp(I_AT_SUBG);
#pragma unroll
    for (int md = 0; md < 8; ++md) { const int d0 = 16 * md + 4 * q4; const f32x4 g4 = *(const GAS f32x4*)(sg + d0);
        u32x2 w; w.x = f2bf(Ot[md][0] * rs * g4.x) | (f2bf(Ot[md][1] * rs * g4.y) << 16); w.y = f2bf(Ot[md][2] * rs * g4.z) | (f2bf(Ot[md][3] * rs * g4.w) << 16);
        *(GAS u32x2*)(Orows + (size_t)(16 * wave + c) * D + h * 128 + d0) = w; }
}
__device__ __forceinline__ void phase_attn(Frame& F, int l, const bf16* Q, const bf16* KP, const bf16* VP, bf16* O) {
    F.fresh();
    const float* al = F.inp(I_AT_LAM);
    const float lam_init = 0.8f - 0.6f * expf(-0.3f * (float)l);
    const float lam = expf(wave_sum(al[F.lane] * al[64 + F.lane])) - expf(wave_sum(al[128 + F.lane] * al[192 + F.lane])) + lam_init;
    for (int s = 0; ; ++s) {
        int u;
        if (F.G == 256) { if (F.bid < 128) { if (s > 0) break; u = F.bid; } else { if (s > 3) break; u = 128 + 4 * (F.bid - 128) + s; } }
        else { u = F.bid + s * F.G; if (u >= 640) break; }
        if (u < 128) { const int sb = u >> 6, h = (u >> 3) & 7, qt = u & 7; const size_t r0 = (size_t)NPROMPT + sb * 1024 + qt * 128;
            attn_unit(F, l, Q + r0 * D, F.KS + (size_t)sb * TKS * D, F.VS + (size_t)sb * TKS * D, TKS, O + r0 * D, h, lam, lam_init); }
        else { const int v = u - 128, b = v >> 4, h = (v >> 1) & 7, qt = v & 1; const size_t r0 = (size_t)b * 256 + qt * 128;
            attn_unit(F, l, Q + r0 * D, KP + (size_t)b * 256 * D, VP + (size_t)b * 256 * D, 256, O + r0 * D, h, lam, lam_init); }
    }
}

__device__ __forceinline__ void phase_ffn_convgate(Frame& F, int l, const bf16* Z, bf16* ACT) {
    F.fresh();
    const float* cw = F.inp(I_FF_CW) + (size_t)l * 3 * 2 * DFF; const float* cb = F.inp(I_FF_CB) + (size_t)l * 2 * DFF;
    const int gt = F.bid * NT + F.tid, GT = F.G * NT;
    for (int i = gt; i < M * DFF; i += GT) { const int row = i / DFF, j = i % DFF;
        int t, T; if (row < NPROMPT) { t = row & 255; T = 256; } else { t = (row - NPROMPT) & 1023; T = 1024; }
        float g = cb[j], u = cb[DFF + j];
#pragma unroll
        for (int k = 0; k < 3; ++k) { const int tt = t + k - 1; if (tt >= 0 && tt < T) { const bf16* zr = Z + (size_t)(row + k - 1) * 2 * DFF; g += cw[k * 2 * DFF + j] * bf2f(zr[j]); u += cw[k * 2 * DFF + DFF + j] * bf2f(zr[DFF + j]); } }
        ACT[i] = (bf16)f2bf(siluf_(g) * u); }
}

__global__ void __launch_bounds__(NT, 2) mk_fwd(Params prm) {
    extern __shared__ __attribute__((aligned(16))) unsigned char lds_raw[];
    Frame F;
    F.lds = (LAS unsigned char*)lds_raw; F.G = gridDim.x; F.out0 = prm.out; F.ws0 = prm.ws; F.wave0 = __builtin_amdgcn_readfirstlane(threadIdx.x >> 6);
    F.fresh();
    if (F.tid < N_IN) ((LAS unsigned long long*)(F.lds + PTR_OFF))[F.tid] = (unsigned long long)prm.in[F.tid];
    volatile LAS unsigned* MISC = (volatile LAS unsigned*)(F.lds + MISC_OFF);
    if (F.tid < 32) MISC[F.tid] = 0u;
    __syncthreads();
    (void)xcd_barrier_post((unsigned*)(prm.ws + WS_CTL) + CW_BAR, MISC + 8, F.tid == 0);
#define GRID_BAR() do { F.fresh(); XcdBarrier bar_; bar_.t0 = F.tid == 0; { unsigned* bp_ = (unsigned*)(prm.ws + WS_CTL) + CW_BAR; asm volatile("" : "+s"(bp_)); bar_.bar = bp_; } bar_.x = xb_xcc_id(); bar_.st = (volatile LAS unsigned*)(F.lds + MISC_OFF) + 8; xcd_barrier(bar_); } while (0)

#define GEMM_BF16(ACT, A_, Bt_, N_, K_, O_, ldc_, bias_, splitc_, splits_, rsq_, b2_, rsqv_, vt0_) do { pg8::Gemm g{A_, Bt_, M, N_, K_}; pg8::StaticOrder S; S.init(M, N_, F.G, F.bid); S.wave = F.wave; \
        pg8::EpiBf16<ACT> E{O_, ldc_, bias_, splitc_, splits_, rsq_, b2_, N_, rsqv_, vt0_, (LAS float*)(F.lds + 131072)}; pg8::gemm_phase<pg8::EpiBf16<ACT>, pg8::StaticOrder, true, true>(F.lds, g, S, E); } while (0)
#define GEMM_RESID(A_, Bt_, K_, sub_, fromin_) do { pg8::Gemm g{A_, Bt_, M, D, K_}; pg8::StaticOrder S; S.init(M, D, F.G, F.bid); S.wave = F.wave; \
        const int nl_ = (sub_) == 0 ? l : l + 1, ns_ = (sub_) == 0 ? 1 : 0; const bool last_ = nl_ >= DEPTH; \
        pg8::EpiResid E{F.out, F.inp(I_XP), F.inp(I_XS), F.mod + (size_t)l * 18 * D, (sub_) * 3 + 2, fromin_, last_ ? nullptr : F.H, F.inp(I_NORMG) + (size_t)((last_ ? 0 : nl_) * 2 + ns_) * D, \
                          F.mod + (size_t)(last_ ? 0 : nl_) * 18 * D, ns_ * 3 + 1, (sub_) == 0 ? F.rsq1 : F.rsq0}; \
        pg8::gemm_phase<pg8::EpiResid, pg8::StaticOrder, true, true>(F.lds, g, S, E); side_job(F, 2 * l + (sub_) + 1); } while (0)

    phase_prologue(F);
    GRID_BAR();
    phase_modulate0(F);
    GRID_BAR();
#pragma unroll 1
    for (int l = 0; l < DEPTH; ++l) {
        const int kind = l % 3, j = l / 3;
        F.fresh();
        if (kind == 0) {
            bf16 *GB = F.T2, *REC = F.T2 + (size_t)M * DRNN, *PF = F.T3, *PB = F.T3 + (size_t)NSAMPLE * DRNN, *HS = F.T3 + (size_t)6 * 1024 * 1024;
            float* AGG = (float*)(F.T3 + (size_t)2 * NSAMPLE * DRNN);
            GEMM_BF16(2, F.H, F.WT + WE_LRU_IN + (size_t)j * 2 * DRNN * D, 2 * DRNN, D, GB, DRNN, nullptr, DRNN, (size_t)M * DRNN, F.rsq0, F.bias2 + B2_LRU + (size_t)j * 3 * 2560, nullptr, 0);
            GRID_BAR();
            phase_lru_core(F, j, REC, GB, HS, PF, PB, AGG, F.WT + WE_WG + (size_t)j * 40 * 128 * 128);
            GRID_BAR();
            phase_lru_fixup(F, GB, HS, PF, PB, AGG);
            GRID_BAR();
            GEMM_RESID(HS, F.WT + WE_LRU_OUT + (size_t)j * D * DRNN, DRNN, 0, l == 0);
        } else if (kind == 1) {
            bf16 *UV = F.T1, *ACT = F.T2;
            GEMM_BF16(1, F.H, F.WT + WE_CM_IN, 2 * DB, D, UV, 2 * DB, F.inp(I_CM_BIN), 0, 0, F.rsq0, F.bias2 + B2_CM, F.rsqv, 8);
            GRID_BAR();
            phase_cmlp_spatial_mfma(F, UV, ACT, F.WT + WE_WSB);
            GRID_BAR();
            GEMM_RESID(ACT, F.WT + WE_CM_OUT, DB, 0, false);
        } else {
            bf16 *Q = F.T2, *KP = F.T2 + (size_t)M * D, *VP = KP + (size_t)NPROMPT * D, *O = F.T3;
            { pg8::Gemm g{F.H, F.WT + WE_QKV, M, 3 * D, D}; pg8::StaticOrder S; S.init(M, 3 * D, F.G, F.bid); S.wave = F.wave;
              pg8::EpiQkv E{F.ws, F.out, F.rsq0, F.bias2 + B2_QKV, (LAS float*)(F.lds + 131072), F.inp(I_AT_QKG), F.rope};
              pg8::gemm_phase<pg8::EpiQkv, pg8::StaticOrder, true, true>(F.lds, g, S, E); }
            GRID_BAR();
            phase_attn(F, l, Q, KP, VP, O);
            GRID_BAR();
            GEMM_RESID(O, F.WT + WE_AT_OUT, D, 0, false);
        }
        GRID_BAR();
        { pg8::Gemm g{F.H, F.WT + WE_UP + (size_t)l * 2 * DFF * D, 42 * 256, 2 * DFF, D}; pg8::FfnOrder S; S.init(42 * 256, 2 * DFF, F.G, F.bid); S.wave = F.wave;
          pg8::EpiFfn E{F.T2, F.inp(I_FF_CW) + (size_t)l * 3 * 2 * DFF, F.inp(I_FF_CB) + (size_t)l * 2 * DFF, (LAS float*)(F.lds + 131072), F.rsq1, F.bias2 + B2_UP + (size_t)l * 3 * 5632};
          pg8::gemm_phase<pg8::EpiFfn, pg8::FfnOrder, true, true>(F.lds, g, S, E); }
        GRID_BAR();
        GEMM_RESID(F.T2, F.WT + WE_DN + (size_t)l * D * DFF, DFF, 1, false);
        GRID_BAR();
    }
}

extern "C" void kernel_launch(void* const* d_in, const int* in_sizes, int n_in, void* d_out, int out_size, void* d_ws, size_t ws_size, hipStream_t stream) {
    static int grid = 0;
    if (grid == 0) {
        if (n_in != N_IN || ws_size < WS_END) { fprintf(stderr, "kernel_launch: unexpected n_in %d or ws_size %zu\n", n_in, ws_size); grid = -1; return; }
        int dev = 0, cus = 0, per_cu = 0;
        hipGetDevice(&dev); hipDeviceGetAttribute(&cus, hipDeviceAttributeMultiprocessorCount, dev);
        hipFuncSetAttribute((const void*)mk_fwd, hipFuncAttributeMaxDynamicSharedMemorySize, LDS_BYTES);
        hipOccupancyMaxActiveBlocksPerMultiprocessor(&per_cu, (const void*)mk_fwd, NT, LDS_BYTES);
        (void)hipGetLastError();
        if (per_cu < 1) { fprintf(stderr, "kernel_launch: occupancy query says %d blocks per CU\n", per_cu); per_cu = 1; }
        grid = cus;
    }
    if (grid < 0) return;
    hipMemsetAsync((char*)d_ws + WS_CTL, 0, CTL_ZERO_BYTES, stream);
    Params p{};
    for (int i = 0; i < N_IN; ++i) p.in[i] = (const float*)d_in[i];
    p.out = (float*)d_out; p.ws = (unsigned char*)d_ws;
    void* args[] = {&p};
    hipError_t e = hipLaunchCooperativeKernel((const void*)mk_fwd, dim3(grid), dim3(NT), args, LDS_BYTES, stream);
    if (e != hipSuccess) fprintf(stderr, "kernel_launch: cooperative launch failed: %s (grid %d)\n", hipGetErrorString(e), grid);
}
```

```cpp
#include <hip/hip_runtime.h>
#include <cstdio>
#include <cstdint>

#define GAS __attribute__((address_space(1)))
#define LAS __attribute__((address_space(3)))
typedef unsigned short bf16;
typedef float f32x4 __attribute__((ext_vector_type(4)));
typedef unsigned u32x2 __attribute__((ext_vector_type(2)));
typedef unsigned u32x4 __attribute__((ext_vector_type(4)));

constexpr int D = 1024, NPROMPT = 32 * 256, NSAMPLE = 2 * 1024, M = NPROMPT + NSAMPLE;
constexpr int DEPTH = 4, DRNN = 1280, DB = 2048, DFF = 2816, PAST = 512, TKS = PAST + 1024;
constexpr float EPS = 1e-6f;
constexpr int NWAVES = 8, NT = NWAVES * 64;

enum { I_XP = 0, I_XS, I_STATE, I_CK, I_CV, I_C, I_CCTX, I_WMOD, I_BMOD, I_NORMG, I_LRU_WIN, I_LRU_CW, I_LRU_CB, I_LRU_WG, I_LRU_BG, I_LRU_LAM, I_LRU_WOUT,
       I_CM_WIN, I_CM_BIN, I_CM_NG, I_CM_WS, I_CM_BS, I_CM_WOUT, I_AT_WQKV, I_AT_QKG, I_AT_LAM, I_AT_SUBG, I_AT_WOUT, I_FF_WUP, I_FF_CW, I_FF_CB, I_FF_WDN, N_IN };
constexpr size_t O_YP = 0, O_YS = (size_t)NPROMPT * D, O_STATE = (size_t)M * D, O_CK = O_STATE + 32 * 2 * 2 * DRNN, O_CV = O_CK + (size_t)NPROMPT * D;

constexpr size_t MiB = 1u << 20;
constexpr size_t WS_CTL = 0, CTL_ZERO_BYTES = 64 * 1024;
constexpr size_t WS_MOD = 1 * MiB;
constexpr size_t WS_RSTD = WS_MOD + 512 * 1024;
constexpr size_t WS_ROPE = WS_RSTD + 256 * 1024;
constexpr size_t WS_H = 2 * MiB;
constexpr size_t WS_T1 = 22 * MiB;
constexpr size_t WS_T2 = 132 * MiB;
constexpr size_t WS_T3 = 187 * MiB;
constexpr size_t WS_X = WS_T3 + 40 * MiB;
constexpr size_t B2_LRU = 0, B2_CM = B2_LRU + (size_t)2 * 3 * 2560, B2_QKV = B2_CM + (size_t)3 * 4096, B2_UP = B2_QKV + (size_t)3 * 3072, B2_END = B2_UP + (size_t)4 * 3 * 5632;
constexpr size_t WS_KS = 237 * MiB, WS_VS = 243 * MiB;
constexpr size_t WS_W = 249 * MiB;
constexpr size_t WE_LRU_IN = 0, WE_LRU_OUT = WE_LRU_IN + (size_t)2 * 2560 * 1024, WE_CM_IN = WE_LRU_OUT + (size_t)2 * 1024 * 1280, WE_CM_OUT = WE_CM_IN + (size_t)4096 * 1024,
                 WE_QKV = WE_CM_OUT + (size_t)1024 * 2048, WE_AT_OUT = WE_QKV + (size_t)3072 * 1024, WE_UP = WE_AT_OUT + (size_t)1024 * 1024, WE_DN = WE_UP + (size_t)4 * 5632 * 1024,
                 WE_WG = WE_DN + (size_t)4 * 1024 * 2816, WE_WSB = WE_WG + (size_t)80 * 128 * 128, WE_END = WE_WSB + (size_t)8 * 128 * 128;
constexpr size_t WS_END = WS_W + 106 * MiB;
static_assert(WE_END * 2 <= 106 * MiB, "weight copies fit");
constexpr int CW_BAR = 1024;

constexpr int LDS_BYTES = 163840;
constexpr int MISC_OFF = LDS_BYTES - 256, PTR_OFF = LDS_BYTES - 1024;

__device__ __forceinline__ unsigned f2bf(float f) { unsigned u = __builtin_bit_cast(unsigned, f); return (u + 0x7fffu + ((u >> 16) & 1u)) >> 16; }
__device__ __forceinline__ float bf2f(unsigned b) { return __builtin_bit_cast(float, (b & 0xffffu) << 16); }
template <int CTRL> __device__ __forceinline__ float dppf(float v) { return __builtin_bit_cast(float, __builtin_amdgcn_update_dpp(0, __builtin_bit_cast(int, v), CTRL, 0xf, 0xf, false)); }
__device__ __forceinline__ float swz_xor16(float v) { return __builtin_bit_cast(float, __builtin_amdgcn_ds_swizzle(__builtin_bit_cast(int, v), 0x401F)); }
__device__ __forceinline__ float sum_x32(float v) { auto r = __builtin_amdgcn_permlane32_swap(__builtin_bit_cast(unsigned, v), __builtin_bit_cast(unsigned, v), false, false);
    return __builtin_bit_cast(float, (unsigned)r[0]) + __builtin_bit_cast(float, (unsigned)r[1]); }
__device__ __forceinline__ float max_x32(float v) { auto r = __builtin_amdgcn_permlane32_swap(__builtin_bit_cast(unsigned, v), __builtin_bit_cast(unsigned, v), false, false);
    return fmaxf(__builtin_bit_cast(float, (unsigned)r[0]), __builtin_bit_cast(float, (unsigned)r[1])); }
__device__ __forceinline__ float sum_q4(float v) { v += swz_xor16(v); return sum_x32(v); }
__device__ __forceinline__ float max_q4(float v) { v = fmaxf(v, swz_xor16(v)); return max_x32(v); }
__device__ __forceinline__ float wave_sum(float v) { v += dppf<0xB1>(v); v += dppf<0x4E>(v); v += dppf<0x141>(v); v += dppf<0x140>(v); return sum_q4(v); }
__device__ __forceinline__ float wave_max(float v) { v = fmaxf(v, dppf<0xB1>(v)); v = fmaxf(v, dppf<0x4E>(v)); v = fmaxf(v, dppf<0x141>(v)); v = fmaxf(v, dppf<0x140>(v)); return max_q4(v); }
__device__ __forceinline__ float bperm(float v, int src_lane) { return __builtin_bit_cast(float, __builtin_amdgcn_ds_bpermute(src_lane << 2, __builtin_bit_cast(int, v))); }
__device__ __forceinline__ float gelu_tanh(float x) { const float y2 = 2.302208198f * (x + 0.044715f * x * x * x);
    const float t = 1.f - 2.f * __builtin_amdgcn_rcpf(__builtin_amdgcn_exp2f(y2) + 1.f); return 0.5f * x * (1.f + t); }
__device__ __forceinline__ float sigmoidf_(float x) { return __builtin_amdgcn_rcpf(1.f + __builtin_amdgcn_exp2f(-1.44269504f * x)); }
__device__ __forceinline__ float siluf_(float x) { return x * __builtin_amdgcn_rcpf(1.f + __builtin_amdgcn_exp2f(-1.44269504f * x)); }
__device__ __forceinline__ float softplusf_(float x) { return fmaxf(x, 0.f) + log1pf(expf(-fabsf(x))); }

#define XB_TMO      128
#define XB_XCNT(j)  (256  + 64 * (j))
#define XB_XSUB(j)  (1280 + 64 * (j))
#define XB_XGEN(j)  (2304 + 64 * (j))
#define XB_TOP      3328
#define XB_TOPGEN   3392
#define XCD_BAR_WORDS 3456
#define XB_SPIN_CAP (1u << 22)
__device__ __forceinline__ unsigned xb_ld(unsigned* p)              { return __hip_atomic_load(p, __ATOMIC_RELAXED, __HIP_MEMORY_SCOPE_AGENT); }
__device__ __forceinline__ unsigned xb_add(unsigned* p, unsigned v) { return __hip_atomic_fetch_add(p, v, __ATOMIC_RELAXED, __HIP_MEMORY_SCOPE_AGENT); }
__device__ __forceinline__ unsigned xb_xcc_id() { return (unsigned)__builtin_amdgcn_s_getreg((3 << 11) | 20) & 0xFu; }
#define XB_SPIN(cond, bar) do { unsigned _sp = 0; while (cond) { __builtin_amdgcn_s_sleep(1); \
    if ((++_sp & 255u) == 0u) { if (xb_ld(&(bar)[XB_TMO])) break; if (_sp > XB_SPIN_CAP) { atomicAdd(&(bar)[XB_TMO], 1u); break; } } } } while (0)
struct XcdBarrier { unsigned* bar; unsigned x; volatile LAS unsigned* st; bool t0; };
__device__ __forceinline__ XcdBarrier xcd_barrier_post(unsigned* bar, volatile LAS unsigned* st, bool t0) {
    XcdBarrier b; b.bar = bar; b.x = xb_xcc_id(); b.st = st; b.t0 = t0;
    if (t0) (void)xb_add(&bar[XB_XCNT(b.x)], 1u);
    return b;
}
__device__ __forceinline__ void xcd_barrier_complete(unsigned* bar, unsigned x, unsigned& nloc, unsigned& nx) {
    const unsigned G = gridDim.x * gridDim.y * gridDim.z;
    unsigned sum, cnt, mine, sp = 0u;
    for (;;) {
        sum = 0u; cnt = 0u; mine = 0u;
#pragma unroll
        for (unsigned j = 0; j < 16; ++j) { const unsigned c = xb_ld(&bar[XB_XCNT(j)]); sum += c; cnt += (c > 0u) ? 1u : 0u; mine = (j == x) ? c : mine; }
        if (sum == G) break;
        __builtin_amdgcn_s_sleep(1);
        if ((++sp & 255u) == 0u) { if (xb_ld(&bar[XB_TMO])) break; if (sp > XB_SPIN_CAP) { atomicAdd(&bar[XB_TMO], 1u); break; } }
    }
    nloc = mine > 0u ? mine : 1u; nx = cnt > 0u ? cnt : 1u;
}
__device__ __forceinline__ void xcd_barrier(const XcdBarrier& b) {
    asm volatile("s_waitcnt vmcnt(0)" ::: "memory");
    __syncthreads();
    if (b.t0) {
        unsigned* bar = b.bar;
        __builtin_amdgcn_s_waitcnt(0);
        unsigned nloc = b.st[0], nx = b.st[1];
        if (nloc == 0u) { xcd_barrier_complete(bar, b.x, nloc, nx); b.st[0] = nloc; b.st[1] = nx; }
        const unsigned old = xb_add(&bar[XB_XSUB(b.x)], 1u);
        const unsigned gen = old / nloc;
        if (old + 1u == (gen + 1u) * nloc) {
            __builtin_amdgcn_fence(__ATOMIC_RELEASE, "agent");
            asm volatile("s_waitcnt vmcnt(0)" ::: "memory");
            const unsigned og = xb_add(&bar[XB_TOP], 1u);
            const unsigned tg = og / nx;
            if (og + 1u == (tg + 1u) * nx) xb_add(&bar[XB_TOPGEN], 1u);
            else XB_SPIN(xb_ld(&bar[XB_TOPGEN]) == tg, bar);
            __builtin_amdgcn_fence(__ATOMIC_ACQUIRE, "agent");
            xb_add(&bar[XB_XGEN(b.x)], 1u);
            asm volatile("s_waitcnt vmcnt(0)" ::: "memory");
        } else {
            XB_SPIN(xb_ld(&bar[XB_XGEN(b.x)]) == gen, bar);
            __builtin_amdgcn_fence(__ATOMIC_ACQUIRE, "agent");
            asm volatile("s_waitcnt vmcnt(0)" ::: "memory");
        }
    }
    __syncthreads();
}

namespace pg8 {
#define PG8_LAS __attribute__((address_space(3)))
typedef unsigned short bf16_t;
typedef short bf16x8 __attribute__((ext_vector_type(8)));
typedef float f32x4 __attribute__((ext_vector_type(4)));
typedef unsigned u32x4 __attribute__((ext_vector_type(4)));
constexpr int BM = 256, BK = 64, HALF = 128, HTB = HALF * BK * 2  , STAGE_BYTES = 8 * HTB, NXCD = 8, WGM = 8;

__host__ __device__ __forceinline__ int lds_byte(int r, int c) { const int st = (r >> 4) * 2 + (c >> 5), rr = r & 15, cc = c & 31, ob = rr * 64 + cc * 2; return st * 1024 + (ob ^ (((ob >> 9) & 1) << 5)); }
__host__ __device__ __forceinline__ void stage_rc(int b, int& R, int& C) { const int st = b / 1024, sb = b % 1024, swz = sb ^ (((sb >> 9) & 1) << 5); R = (st >> 1) * 16 + swz / 64; C = (st & 1) * 32 + (swz % 64) / 2; }
__host__ __device__ __forceinline__ int perm32(int rho) { const int n = rho >> 4, i = rho & 15; return 8 * (i >> 2) + 4 * n + (i & 3); }

struct Unit { int pm, pn; };
struct Gemm { const bf16_t* A; const bf16_t* Bt; int M, N, K; };

struct StaticOrder {
    int nM, nN, nwg, G, c, wave;
    __host__ __device__ void init(int M, int N, int G_, int c_) { nM = M / BM; nN = N / BM; nwg = nM * nN; G = G_; c = c_; }
    __host__ __device__ bool next(int i, Unit& u) const {
        const long L = (long)i * G + c; if (L >= nwg) return false;
        int wgid = (int)L; { const int q = nwg / NXCD, r = nwg % NXCD, xcd = wgid % NXCD, off = wgid / NXCD; wgid = (xcd < r ? xcd * (q + 1) : r * (q + 1) + (xcd - r) * q) + off; }
        const int nig = WGM * nN, gid = wgid / nig, fm = gid * WGM, gsz = (nM - fm) < WGM ? (nM - fm) : WGM;
        u.pm = fm + ((wgid % nig) % gsz); u.pn = (wgid % nig) / gsz; return true;
    }
    __device__ __forceinline__ int arow(int pm) const { return pm * BM; }
    __device__ __forceinline__ void a_ready(const Unit&) const {}
    __device__ __forceinline__ void done(const Unit&) const {}
};

template <class Epi, class Sched, bool ALIGN_EPI = false, bool SP2 = false>
__device__ __forceinline__ void gemm_phase(PG8_LAS unsigned char* lds, const Gemm g, const Sched& S, const Epi& E) {
    int z_ = 0; asm volatile("" : "+v"(z_));
    const int lane = __builtin_amdgcn_mbcnt_hi(~0u, __builtin_amdgcn_mbcnt_lo(~0u, z_)), wid = S.wave, tid = wid * 64 + lane, wr = wid >> 2, wc = wid & 3, fr = lane & 15, fq = lane >> 4;
    const int K = g.K, nt = K / BK;
    unsigned voffA[2], voffB[2];
#pragma unroll
    for (int i = 0; i < 2; ++i) { int R, C; stage_rc(tid * 16 + i * 8192, R, C); const int Rb = Epi::PERM ? ((R & ~31) + perm32(R & 31)) : R;
        voffA[i] = (unsigned)(R * K + C) * 2u; voffB[i] = (unsigned)(Rb * K + C) * 2u; }
    const size_t kstep = (size_t)(BK * 2);
    const size_t hstep = (size_t)HALF * K * 2;
    const size_t tstep = 2 * hstep;
    const unsigned ldsw = (unsigned)wid * 1024u;
    const int aoff = lds_byte(wr * 64 + fr, fq * 8), boff = lds_byte(wc * 32 + fr, fq * 8);
#define PG8_SA(b, h) (((b) * 2 + (h)) * HTB)
#define PG8_SB(b, h) ((4 + (b) * 2 + (h)) * HTB)
#define PG8_STAGE(bufoff, gbase, voff) do { _Pragma("unroll") for (int _i = 0; _i < 2; ++_i) \
        __builtin_amdgcn_global_load_lds((const unsigned*)((const char*)(gbase) + (voff)[_i]), (PG8_LAS unsigned*)(lds + (bufoff) + ldsw + _i * 8192), 16, 0, 0); } while (0)
#define PG8_LDA(dst, b, h) do { _Pragma("unroll") for (int m = 0; m < 4; ++m) _Pragma("unroll") for (int k = 0; k < 2; ++k) dst[m][k] = *(const PG8_LAS bf16x8*)(lds + PG8_SA(b, h) + aoff + m * 2048 + k * 1024); } while (0)
#define PG8_LDB(dst, b, h) do { _Pragma("unroll") for (int n = 0; n < 2; ++n) _Pragma("unroll") for (int k = 0; k < 2; ++k) dst[n][k] = *(const PG8_LAS bf16x8*)(lds + PG8_SB(b, h) + boff + n * 2048 + k * 1024); } while (0)
#define PG8_MMA(ai, bj, At, Bt) do { __builtin_amdgcn_s_setprio(1); _Pragma("unroll") for (int m = 0; m < 4; ++m) _Pragma("unroll") for (int n = 0; n < 2; ++n) _Pragma("unroll") for (int k = 0; k < 2; ++k) \
        acc[ai][bj][m][n] = __builtin_amdgcn_mfma_f32_16x16x32_bf16(Bt[n][k], At[m][k], acc[ai][bj][m][n], 0, 0, 0); __builtin_amdgcn_s_setprio(0); } while (0)
#define PG8_WAIT_V(n) asm volatile("s_waitcnt vmcnt(" #n ")" ::: "memory")
#define PG8_WAIT_L(n) asm volatile("s_waitcnt lgkmcnt(" #n ")" ::: "memory")
#define PG8_BAR __builtin_amdgcn_s_barrier()
#define PG8_SCHED __builtin_amdgcn_sched_barrier(0)
    Unit cur, nxt; int ui = 0;
    if (!S.next(0, cur)) return;
    f32x4 acc[2][2][4][2];
#pragma unroll
    for (int a = 0; a < 2; ++a)
#pragma unroll
        for (int b = 0; b < 2; ++b)
#pragma unroll
            for (int m = 0; m < 4; ++m)
#pragma unroll
                for (int n = 0; n < 2; ++n) acc[a][b][m][n] = (f32x4){0.f, 0.f, 0.f, 0.f};
    bf16x8 At[4][2], B0[2][2], B1[2][2];
    const char* cA = (const char*)g.A + (size_t)S.arow(cur.pm) * (size_t)K * 2; const char* cB = (const char*)g.Bt + (size_t)cur.pn * tstep;
    S.a_ready(cur);
    if constexpr (SP2) {
        PG8_STAGE(PG8_SB(0, 0), cB, voffB); PG8_STAGE(PG8_SB(0, 1), cB + hstep, voffB); PG8_STAGE(PG8_SA(0, 0), cA, voffA); PG8_STAGE(PG8_SA(0, 1), cA + hstep, voffA);
        if (wr == 1) PG8_BAR;
        PG8_WAIT_V(2); PG8_BAR;
        PG8_STAGE(PG8_SB(1, 0), cB + kstep, voffB); PG8_STAGE(PG8_SA(1, 0), cA + kstep, voffA); PG8_STAGE(PG8_SB(1, 1), cB + hstep + kstep, voffB);
        PG8_WAIT_V(6); PG8_BAR;
    } else {
        PG8_STAGE(PG8_SB(0, 0), cB, voffB); PG8_STAGE(PG8_SA(0, 0), cA, voffA); PG8_STAGE(PG8_SB(0, 1), cB + hstep, voffB); PG8_STAGE(PG8_SA(0, 1), cA + hstep, voffA);
        if (wr == 1) PG8_BAR;
        PG8_WAIT_V(4); PG8_BAR;
        PG8_STAGE(PG8_SB(1, 0), cB + kstep, voffB); PG8_STAGE(PG8_SA(1, 0), cA + kstep, voffA); PG8_STAGE(PG8_SB(1, 1), cB + hstep + kstep, voffB);
        PG8_WAIT_V(6); PG8_BAR;
    }
    for (;;) {
        const bool has_next = S.next(ui + 1, nxt);
        const char* nA = has_next ? (const char*)g.A + (size_t)S.arow(nxt.pm) * (size_t)K * 2 : cA; const char* nB = has_next ? (const char*)g.Bt + (size_t)nxt.pn * tstep : cB;
        for (int t = 0; t < nt; t += 2) {
            const bool last = (t == nt - 2);
            const char* a1 = cA + (size_t)(t + 1) * kstep;
            const char* a2 = last ? nA : cA + (size_t)(t + 2) * kstep; const char* b2 = last ? nB : cB + (size_t)(t + 2) * kstep;
            const char* a3 = a2 + kstep; const char* b3 = b2 + kstep;
            if (last && has_next) S.a_ready(nxt);
            if constexpr (SP2) {
            PG8_LDB(B0, 0, 0); PG8_LDB(B1, 0, 1); PG8_SCHED; PG8_LDA(At, 0, 0); PG8_STAGE(PG8_SA(1, 1), a1 + hstep, voffA);
            PG8_WAIT_V(8); PG8_WAIT_L(0); PG8_BAR; PG8_MMA(0, 0, At, B0); PG8_MMA(0, 1, At, B1); PG8_BAR; PG8_SCHED;
            PG8_LDA(At, 0, 1); PG8_STAGE(PG8_SB(0, 0), b2, voffB); PG8_STAGE(PG8_SB(0, 1), b2 + hstep, voffB); PG8_STAGE(PG8_SA(0, 0), a2, voffA);
            PG8_WAIT_V(8); PG8_WAIT_L(0); PG8_BAR; PG8_MMA(1, 0, At, B0); PG8_MMA(1, 1, At, B1); PG8_BAR; PG8_SCHED;
            PG8_LDB(B0, 1, 0); PG8_LDB(B1, 1, 1); PG8_SCHED; PG8_LDA(At, 1, 0); PG8_STAGE(PG8_SA(0, 1), a2 + hstep, voffA);
            PG8_WAIT_V(8); PG8_WAIT_L(0); PG8_BAR; PG8_MMA(0, 0, At, B0); PG8_MMA(0, 1, At, B1); PG8_BAR; PG8_SCHED;
            PG8_LDA(At, 1, 1); PG8_STAGE(PG8_SB(1, 0), b3, voffB); PG8_STAGE(PG8_SB(1, 1), b3 + hstep, voffB); PG8_STAGE(PG8_SA(1, 0), a3, voffA);
            PG8_WAIT_V(8); PG8_WAIT_L(0); PG8_BAR; PG8_MMA(1, 0, At, B0); PG8_MMA(1, 1, At, B1); PG8_BAR; PG8_SCHED;
            } else {
            PG8_LDB(B0, 0, 0); PG8_SCHED; PG8_LDA(At, 0, 0); PG8_STAGE(PG8_SA(1, 1), a1 + hstep, voffA);
            PG8_WAIT_L(8); PG8_BAR; PG8_WAIT_L(0); PG8_MMA(0, 0, At, B0); PG8_BAR; PG8_SCHED;
            PG8_LDB(B1, 0, 1); PG8_STAGE(PG8_SB(0, 0), b2, voffB);
            PG8_BAR; PG8_WAIT_L(0); PG8_MMA(0, 1, At, B1); PG8_BAR;
            PG8_LDA(At, 0, 1); PG8_STAGE(PG8_SA(0, 0), a2, voffA);
            PG8_BAR; PG8_WAIT_L(0); PG8_MMA(1, 0, At, B0); PG8_BAR; PG8_SCHED;
            PG8_STAGE(PG8_SB(0, 1), b2 + hstep, voffB);
            PG8_WAIT_V(6); PG8_BAR; PG8_MMA(1, 1, At, B1); PG8_BAR;
            PG8_LDB(B0, 1, 0); PG8_SCHED; PG8_LDA(At, 1, 0); PG8_STAGE(PG8_SA(0, 1), a2 + hstep, voffA);
            PG8_WAIT_L(8); PG8_BAR; PG8_WAIT_L(0); PG8_MMA(0, 0, At, B0); PG8_BAR; PG8_SCHED;
            PG8_LDB(B1, 1, 1); PG8_STAGE(PG8_SB(1, 0), b3, voffB);
            PG8_BAR; PG8_WAIT_L(0); PG8_MMA(0, 1, At, B1); PG8_BAR;
            PG8_LDA(At, 1, 1); PG8_STAGE(PG8_SA(1, 0), a3, voffA);
            PG8_BAR; PG8_WAIT_L(0); PG8_MMA(1, 0, At, B0); PG8_BAR; PG8_SCHED;
            PG8_STAGE(PG8_SB(1, 1), b3 + hstep, voffB);
            PG8_WAIT_V(6); PG8_BAR; PG8_MMA(1, 1, At, B1); PG8_BAR;
            }
        }
        if constexpr (ALIGN_EPI) { if (wr == 0) PG8_BAR; }
        if constexpr (!Epi::AFTER_DRAIN) { E(acc, cur, ui, wr, wc, fr, fq); S.done(cur); }
        if (!has_next) break;
#pragma unroll
        for (int a = 0; a < 2; ++a)
#pragma unroll
            for (int b = 0; b < 2; ++b)
#pragma unroll
                for (int m = 0; m < 4; ++m)
#pragma unroll
                    for (int n = 0; n < 2; ++n) acc[a][b][m][n] = (f32x4){0.f, 0.f, 0.f, 0.f};
        cur = nxt; cA = nA; cB = nB; ++ui;
        if constexpr (ALIGN_EPI) { if (wr == 1) PG8_BAR; }
    }
    PG8_WAIT_V(0);
    if constexpr (!ALIGN_EPI) { if (wr == 0) PG8_BAR; }
    PG8_BAR;
    if constexpr (Epi::AFTER_DRAIN) { E.fused(acc, cur, wr, wc, fr, fq, lds, wid, lane); S.done(cur); }
#undef PG8_SA
#undef PG8_SB
#undef PG8_STAGE
#undef PG8_LDA
#undef PG8_LDB
#undef PG8_MMA
#undef PG8_WAIT_V
#undef PG8_WAIT_L
#undef PG8_BAR
#undef PG8_SCHED
}
}

namespace pg8 {
__device__ __forceinline__ unsigned cvt_pk_bf16(float lo, float hi) { unsigned r; asm volatile("v_cvt_pk_bf16_f32 %0, %1, %2" : "=v"(r) : "v"(lo), "v"(hi)); return r; }
__device__ __forceinline__ f32x4 gelu4(f32x4 v) { f32x4 o; o.x = gelu_tanh(v.x); o.y = gelu_tanh(v.y); o.z = gelu_tanh(v.z); o.w = gelu_tanh(v.w); return o; }
constexpr int ETAB_OFF = 131072 + 8192, ETAB_SLOT = 4608, ETAB_MAXU = 4;
__device__ __forceinline__ float row_rstd(const float* rsq, int row) {
    const GAS f32x4* p = (const GAS f32x4*)(rsq + (size_t)row * 16);
    const f32x4 a = p[0], b = p[1], c = p[2], d = p[3];
    const float s = ((a.x + a.y) + (a.z + a.w)) + ((b.x + b.y) + (b.z + b.w)) + ((c.x + c.y) + (c.z + c.w)) + ((d.x + d.y) + (d.z + d.w));
    return rsqrtf(s * (1.f / D) + EPS);
}
__device__ __forceinline__ int tile_cidx(int trow) { return trow < NPROMPT ? 0 : 1 + ((trow - NPROMPT) >> 10); }
__device__ __forceinline__ PG8_LAS float* etab(PG8_LAS unsigned char* lds, int ui) { return (PG8_LAS float*)(lds + ETAB_OFF + ui * ETAB_SLOT); }

template <int ACT> struct EpiBf16 {
    static constexpr bool PERM = true, AFTER_DRAIN = false;
    bf16_t* O; int ldc; const float* bias; int split_cols; size_t split_stride; const float* rsq; const float* b2; int N; float* rsqv; int vt0; PG8_LAS unsigned char* lds;
    template <class Sched> __device__ __forceinline__ void prep(const Sched& S, int tid) const {
        Unit u;
        for (int i = 0; i < ETAB_MAXU && S.next(i, u); ++i) { PG8_LAS float* t = etab(lds, i);
            if (tid < 256) t[tid] = row_rstd(rsq, S.arow(u.pm) + tid);
            else { const int c = tid - 256, col = u.pn * BM + c; float v = b2[(size_t)tile_cidx(S.arow(u.pm)) * N + col]; if (bias) v += bias[col]; t[256 + c] = v; } }
        __syncthreads();
    }
    __device__ __forceinline__ void operator()(f32x4 (&acc)[2][2][4][2], const Unit& u, int ui, int wr, int wc, int fr, int fq) const {
        asm volatile("" : "+v"(fr), "+v"(fq));
        PG8_LAS const float* tb = etab(lds, ui);
        const int lrow0 = wr * 64 + fr; int colt = u.pn * BM; bf16_t* base = O; int t = 0;
        if (split_cols) { t = colt / split_cols; base += (size_t)t * split_stride; colt -= t * split_cols; }
        const bool act = (ACT == 1) || (ACT == 2 && t == 0);
        const int col0 = colt + wc * 32 + 8 * fq, tc0 = wc * 32 + 8 * fq;
        const bool wantv = rsqv != nullptr && u.pn >= vt0;
        GAS unsigned char* ob = (GAS unsigned char*)base;
        float ss[8];
#pragma unroll
        for (int i = 0; i < 8; ++i) ss[i] = 0.f;
#pragma unroll
        for (int bj = 0; bj < 2; ++bj) { const f32x4 bv0 = *(PG8_LAS const f32x4*)(tb + 256 + tc0 + bj * HALF), bv1 = *(PG8_LAS const f32x4*)(tb + 256 + tc0 + bj * HALF + 4);
#pragma unroll
            for (int ai = 0; ai < 2; ++ai)
#pragma unroll
                for (int m = 0; m < 4; ++m) { const int lrow = lrow0 + ai * HALF + m * 16; const float rs = tb[lrow];
                    f32x4 v0 = acc[ai][bj][m][0] * rs + bv0, v1 = acc[ai][bj][m][1] * rs + bv1;
                    if (ACT != 0) { if (act) { v0 = gelu4(v0); v1 = gelu4(v1); } }
                    ss[ai * 4 + m] += (v0[0] * v0[0] + v0[1] * v0[1]) + (v0[2] * v0[2] + v0[3] * v0[3]) + (v1[0] * v1[0] + v1[1] * v1[1]) + (v1[2] * v1[2] + v1[3] * v1[3]);
                    u32x4 w; w.x = cvt_pk_bf16(v0[0], v0[1]); w.y = cvt_pk_bf16(v0[2], v0[3]); w.z = cvt_pk_bf16(v1[0], v1[1]); w.w = cvt_pk_bf16(v1[2], v1[3]);
                    *(GAS u32x4*)(ob + ((unsigned)(u.pm * BM + lrow) * (unsigned)ldc + col0 + bj * HALF) * 2u) = w;
                    __builtin_amdgcn_sched_barrier(0); } }
        if (wantv) {
#pragma unroll
            for (int i = 0; i < 8; ++i) { const float q = sum_q4(ss[i]);
                if (fq == 0) *(GAS float*)(rsqv + (size_t)(u.pm * BM + lrow0 + (i >> 2) * HALF + (i & 3) * 16) * 32 + (u.pn - vt0) * 4 + wc) = q; } }
    }
};
struct EpiResid {
    static constexpr bool PERM = true, AFTER_DRAIN = false;
    float* out; const float* xp; const float* xs; const float* modl; int which; bool from_input;
    bf16_t* H; const float* ng; const float* modn; int whichs; float* rsq_out; PG8_LAS unsigned char* lds;
    template <class Sched> __device__ __forceinline__ void prep(const Sched& S, int tid) const {
        Unit u;
        for (int i = 0; i < ETAB_MAXU && S.next(i, u); ++i) { PG8_LAS float* t = etab(lds, i);
            if (tid < 256) { const int ci = tile_cidx(u.pm * BM), col = u.pn * BM + tid; t[256 + tid] = modl[(size_t)(ci * 6 + which) * D + col];
                t[512 + tid] = H ? ng[col] * (1.f + modn[(size_t)(ci * 6 + whichs) * D + col]) : 0.f; } }
        __syncthreads();
    }
    __device__ __forceinline__ void operator()(f32x4 (&acc)[2][2][4][2], const Unit& u, int ui, int wr, int wc, int fr, int fq) const {
        asm volatile("" : "+v"(fr), "+v"(fq));
        PG8_LAS const float* tb = etab(lds, ui);
        const int trow = u.pm * BM, row0 = wr * 64 + fr, tc0 = wc * 32 + 8 * fq, col0 = u.pn * BM + tc0;
        const GAS unsigned char* bpg = (const GAS unsigned char*)(from_input ? (trow < NPROMPT ? xp + (size_t)trow * D : xs + (size_t)(trow - NPROMPT) * D) : out + (size_t)trow * D);
        GAS unsigned char* op = (GAS unsigned char*)(out + (size_t)trow * D); GAS unsigned char* hb = (GAS unsigned char*)H;
#pragma unroll
        for (int ai = 0; ai < 2; ++ai) {
            f32x4 x[2][4][2];
#pragma unroll
            for (int bj = 0; bj < 2; ++bj)
#pragma unroll
                for (int m = 0; m < 4; ++m)
#pragma unroll
                    for (int n = 0; n < 2; ++n) x[bj][m][n] = *(const GAS f32x4*)(bpg + ((unsigned)(row0 + ai * HALF + m * 16) * (unsigned)D + col0 + bj * HALF + 4 * n) * 4u);
            float ss[4] = {0.f, 0.f, 0.f, 0.f};
#pragma unroll
            for (int bj = 0; bj < 2; ++bj) { const f32x4 gv0 = *(PG8_LAS const f32x4*)(tb + 256 + tc0 + bj * HALF), gv1 = *(PG8_LAS const f32x4*)(tb + 256 + tc0 + bj * HALF + 4);
                const f32x4 gs0 = *(PG8_LAS const f32x4*)(tb + 512 + tc0 + bj * HALF), gs1 = *(PG8_LAS const f32x4*)(tb + 512 + tc0 + bj * HALF + 4);
#pragma unroll
                for (int m = 0; m < 4; ++m) { const unsigned lrow = row0 + ai * HALF + m * 16, eo = lrow * (unsigned)D + col0 + bj * HALF;
                    const f32x4 x0 = x[bj][m][0] + gv0 * acc[ai][bj][m][0], x1 = x[bj][m][1] + gv1 * acc[ai][bj][m][1];
                    *(GAS f32x4*)(op + eo * 4u) = x0; *(GAS f32x4*)(op + eo * 4u + 16) = x1;
                    if (H) { ss[m] += (x0[0] * x0[0] + x0[1] * x0[1]) + (x0[2] * x0[2] + x0[3] * x0[3]) + (x1[0] * x1[0] + x1[1] * x1[1]) + (x1[2] * x1[2] + x1[3] * x1[3]);
                        const f32x4 a0 = x0 * gs0, a1 = x1 * gs1;
                        u32x4 w; w.x = cvt_pk_bf16(a0[0], a0[1]); w.y = cvt_pk_bf16(a0[2], a0[3]); w.z = cvt_pk_bf16(a1[0], a1[1]); w.w = cvt_pk_bf16(a1[2], a1[3]);
                        *(GAS u32x4*)(hb + ((unsigned)trow * (unsigned)D + eo) * 2u) = w; } } }
            if (H) {
#pragma unroll
                for (int m = 0; m < 4; ++m) { const float q = sum_q4(ss[m]);
                    if (fq == 0) *(GAS float*)(rsq_out + (size_t)(trow + row0 + ai * HALF + m * 16) * 16 + u.pn * 4 + wc) = q; } }
            asm volatile("" ::: "memory");
        }
    }
};

__device__ __forceinline__ void ffn_tile_geom(int pm, int& rs, int& vlo, int& vhi) {
    if (pm < 32) { rs = 256 * pm; vlo = 0; vhi = 255; }
    else { const int sq = (pm - 32) / 5, i = (pm - 32) % 5; rs = NPROMPT + 1024 * sq + (i < 4 ? 254 * i : 768); vlo = i == 0 ? 0 : (i < 4 ? 1 : 249); vhi = i < 4 ? 254 : 255; }
}
struct FfnOrder : StaticOrder {
    __device__ __forceinline__ int arow(int pm) const { int rs, a, b; ffn_tile_geom(pm, rs, a, b); return rs; }
};
__device__ __forceinline__ float dpp_prev(float oldv, float v) {
    return __builtin_bit_cast(float, __builtin_amdgcn_update_dpp(__builtin_bit_cast(int, oldv), __builtin_bit_cast(int, v), 0x111, 0xf, 0xf, false)); }
__device__ __forceinline__ float dpp_next(float oldv, float v) {
    return __builtin_bit_cast(float, __builtin_amdgcn_update_dpp(__builtin_bit_cast(int, oldv), __builtin_bit_cast(int, v), 0x101, 0xf, 0xf, false)); }
__device__ __forceinline__ float dpp_ror1(float v) { return __builtin_bit_cast(float, __builtin_amdgcn_update_dpp(0, __builtin_bit_cast(int, v), 0x121, 0xf, 0xf, false)); }
__device__ __forceinline__ float dpp_ror15(float v) { return __builtin_bit_cast(float, __builtin_amdgcn_update_dpp(0, __builtin_bit_cast(int, v), 0x12F, 0xf, 0xf, false)); }
struct EpiFfn {
    static constexpr bool PERM = true, AFTER_DRAIN = false;
    bf16_t* ACT; const float* cw; const float* cb; const float* rsq; const float* b2; PG8_LAS unsigned char* lds;
    template <class Sched> __device__ __forceinline__ void prep(const Sched& S, int tid) const {
        Unit u;
        for (int i = 0; i < ETAB_MAXU && S.next(i, u); ++i) { PG8_LAS float* t = etab(lds, i); const int rs = S.arow(u.pm);
            if (tid < 256) t[tid] = row_rstd(rsq, rs + tid);
            else { const int c = tid - 256, ch = (c < 128 ? 0 : DFF) + u.pn * 128 + (c & 127);
                t[256 + c] = b2[(size_t)tile_cidx(rs) * 2 * DFF + u.pn * 256 + c]; t[512 + c] = cb[ch];
                PG8_LAS unsigned short* tw = (PG8_LAS unsigned short*)(t + 768);
#pragma unroll
                for (int k = 0; k < 3; ++k) tw[k * 256 + c] = (unsigned short)f2bf(cw[(size_t)k * 2 * DFF + ch]); } }
        __syncthreads();
    }
    __device__ __forceinline__ void operator()(f32x4 (&acc)[2][2][4][2], const Unit& u, int ui, int wr, int wc, int fr, int fq) const {
        asm volatile("" : "+v"(fr), "+v"(fq));
        PG8_LAS const float* tb = etab(lds, ui); PG8_LAS float* xb = (PG8_LAS float*)(lds + 131072);
        int rs, vlo, vhi; ffn_tile_geom(u.pm, rs, vlo, vhi);
        const int colw = wc * 32 + 8 * fq;
#pragma unroll
        for (int bj = 0; bj < 2; ++bj) { const f32x4 bz0 = *(PG8_LAS const f32x4*)(tb + 256 + bj * 128 + colw), bz1 = *(PG8_LAS const f32x4*)(tb + 256 + bj * 128 + colw + 4);
#pragma unroll
            for (int ai = 0; ai < 2; ++ai)
#pragma unroll
                for (int m = 0; m < 4; ++m) { const float rsd = tb[128 * ai + 64 * wr + 16 * m + fr];
                    acc[ai][bj][m][0] = acc[ai][bj][m][0] * rsd + bz0; acc[ai][bj][m][1] = acc[ai][bj][m][1] * rsd + bz1; } }
#pragma unroll
        for (int ai = 0; ai < 2; ++ai) { const int b = 2 * ai + wr;
            if (fr == 0) {
#pragma unroll
                for (int bj = 0; bj < 2; ++bj)
#pragma unroll
                    for (int n = 0; n < 2; ++n) *(PG8_LAS f32x4*)(xb + (b * 2 + 0) * 256 + bj * 128 + colw + 4 * n) = acc[ai][bj][0][n]; }
            if (fr == 15) {
#pragma unroll
                for (int bj = 0; bj < 2; ++bj)
#pragma unroll
                    for (int n = 0; n < 2; ++n) *(PG8_LAS f32x4*)(xb + (b * 2 + 1) * 256 + bj * 128 + colw + 4 * n) = acc[ai][bj][3][n]; } }
        asm volatile("s_waitcnt lgkmcnt(0)" ::: "memory"); __builtin_amdgcn_s_barrier(); asm volatile("" ::: "memory");
        GAS unsigned char* actb = (GAS unsigned char*)ACT;
        const unsigned lane_off = (unsigned)((rs + 64 * wr + fr) * DFF + u.pn * 128 + colw) * 2u;
        PG8_LAS const unsigned short* tw = (PG8_LAS const unsigned short*)(tb + 768);
#pragma unroll
        for (int n = 0; n < 2; ++n) {
            f32x4 wg[3], wu[3];
#pragma unroll
            for (int k = 0; k < 3; ++k) { const u32x2 pg = *(PG8_LAS const u32x2*)(tw + k * 256 + colw + 4 * n), pu = *(PG8_LAS const u32x2*)(tw + k * 256 + 128 + colw + 4 * n);
                wg[k] = (f32x4){__builtin_bit_cast(float, pg.x << 16), __builtin_bit_cast(float, pg.x & 0xffff0000u), __builtin_bit_cast(float, pg.y << 16), __builtin_bit_cast(float, pg.y & 0xffff0000u)};
                wu[k] = (f32x4){__builtin_bit_cast(float, pu.x << 16), __builtin_bit_cast(float, pu.x & 0xffff0000u), __builtin_bit_cast(float, pu.y << 16), __builtin_bit_cast(float, pu.y & 0xffff0000u)}; }
            const f32x4 bgv = *(PG8_LAS const f32x4*)(tb + 512 + colw + 4 * n), buv = *(PG8_LAS const f32x4*)(tb + 512 + 128 + colw + 4 * n);
#pragma unroll
            for (int ai = 0; ai < 2; ++ai) { const int b = 2 * ai + wr;
                f32x4 pz[2], nz[2];
#pragma unroll
                for (int bj = 0; bj < 2; ++bj) { pz[bj] = b > 0 ? *(PG8_LAS const f32x4*)(xb + ((b - 1) * 2 + 1) * 256 + bj * 128 + colw + 4 * n) : (f32x4){0.f, 0.f, 0.f, 0.f};
                                                 nz[bj] = b < 3 ? *(PG8_LAS const f32x4*)(xb + ((b + 1) * 2 + 0) * 256 + bj * 128 + colw + 4 * n) : (f32x4){0.f, 0.f, 0.f, 0.f}; }
#pragma unroll
                for (int m = 0; m < 4; ++m) { f32x4 zc[2];
#pragma unroll
                    for (int bj = 0; bj < 2; ++bj) { const f32x4 z = acc[ai][bj][m][n]; const f32x4* w3 = bj == 0 ? wg : wu; f32x4 o = bj == 0 ? bgv : buv;
#pragma unroll
                        for (int e = 0; e < 4; ++e) { const float up = m > 0 ? dpp_ror1(acc[ai][bj][m - 1][n][e]) : pz[bj][e], dn = m < 3 ? dpp_ror15(acc[ai][bj][m + 1][n][e]) : nz[bj][e];
                            o[e] += w3[0][e] * dpp_prev(up, z[e]) + w3[1][e] * z[e] + w3[2][e] * dpp_next(dn, z[e]); }
                        zc[bj] = o; }
                    const int lr = 128 * ai + 64 * wr + 16 * m + fr;
                    if (lr >= vlo && lr <= vhi) { u32x2 w; w.x = cvt_pk_bf16(siluf_(zc[0][0]) * zc[1][0], siluf_(zc[0][1]) * zc[1][1]); w.y = cvt_pk_bf16(siluf_(zc[0][2]) * zc[1][2], siluf_(zc[0][3]) * zc[1][3]);
                        *(GAS u32x2*)(actb + (lane_off + (unsigned)((128 * ai + 16 * m) * DFF + 4 * n) * 2u)) = w; } } }
        }
    }
};

struct EpiQkv {
    static constexpr bool PERM = true, AFTER_DRAIN = false;
    unsigned char* ws; float* out; const float* rsq; const float* b2; PG8_LAS unsigned char* lds; const float* qkg; const float* rope;
    template <class Sched> __device__ __forceinline__ void prep(const Sched& S, int tid) const {
        Unit u;
        for (int i = 0; i < ETAB_MAXU && S.next(i, u); ++i) { PG8_LAS float* t = etab(lds, i);
            if (tid < 256) t[tid] = row_rstd(rsq, u.pm * BM + tid);
            else { const int c = tid - 256; t[256 + c] = b2[(size_t)tile_cidx(u.pm * BM) * 3 * D + u.pn * BM + c]; } }
        __syncthreads();
    }
    __device__ __forceinline__ void operator()(f32x4 (&acc)[2][2][4][2], const Unit& u, int ui, int wr, int wc, int fr, int fq) const {
        asm volatile("" : "+v"(fr), "+v"(fq));
        PG8_LAS const float* tb = etab(lds, ui);
        const int trow = u.pm * BM; const bool smp = trow >= NPROMPT; const int sb = smp ? (trow - NPROMPT) >> 10 : 0, tq0 = smp ? (trow - NPROMPT) & 1023 : 0;
        const int kind = u.pn >> 2, tc0 = wc * 32 + 8 * fq;
        if (kind < 2) {
            const int oc = (u.pn & 3) * 256 + wc * 64 + 8 * fq;
            f32x4 bz[2][2], gq[2][2];
#pragma unroll
            for (int bj = 0; bj < 2; ++bj)
#pragma unroll
                for (int n = 0; n < 2; ++n) { bz[bj][n] = *(PG8_LAS const f32x4*)(tb + 256 + tc0 + bj * HALF + 4 * n); gq[bj][n] = *(const GAS f32x4*)(qkg + kind * 64 + 32 * bj + 8 * fq + 4 * n); }
            const size_t doff = kind == 0 ? WS_T2 : (smp ? WS_KS : WS_T2 + (size_t)M * D * 2); GAS unsigned char* dst = (GAS unsigned char*)ws + doff;
#pragma unroll
            for (int ai = 0; ai < 2; ++ai) {
                f32x4 cs[4][2], sn[4][2];
#pragma unroll
                for (int m = 0; m < 4; ++m) { const int lrow = 128 * ai + 64 * wr + 16 * m + fr; const float rs = tb[lrow];
                    if (smp && (m & 1) == 0) {
#pragma unroll
                        for (int mm = m; mm < m + 2; ++mm)
#pragma unroll
                            for (int n = 0; n < 2; ++n) { const int t = tq0 + 128 * ai + 64 * wr + 16 * mm + fr; cs[mm][n] = *(const GAS f32x4*)(rope + t * 32 + 8 * fq + 4 * n); sn[mm][n] = *(const GAS f32x4*)(rope + 32768 + t * 32 + 8 * fq + 4 * n); } }
                    f32x4 v[2][2]; float ss = 0.f;
#pragma unroll
                    for (int bj = 0; bj < 2; ++bj)
#pragma unroll
                        for (int n = 0; n < 2; ++n) { v[bj][n] = acc[ai][bj][m][n] * rs + bz[bj][n]; ss += (v[bj][n][0] * v[bj][n][0] + v[bj][n][1] * v[bj][n][1]) + (v[bj][n][2] * v[bj][n][2] + v[bj][n][3] * v[bj][n][3]); }
                    ss = sum_q4(ss);
                    const float rn = rsqrtf(ss * (1.f / 64.f) + EPS);
#pragma unroll
                    for (int bj = 0; bj < 2; ++bj)
#pragma unroll
                        for (int n = 0; n < 2; ++n) v[bj][n] = v[bj][n] * rn * gq[bj][n];
                    const unsigned row = (unsigned)(trow + lrow);
                    if (!smp) {
                        if (kind == 1) {
#pragma unroll
                            for (int bj = 0; bj < 2; ++bj)
#pragma unroll
                                for (int n = 0; n < 2; ++n) *(GAS f32x4*)((GAS unsigned char*)out + O_CK * 4 + (row * (unsigned)D + oc + 32 * bj + 4 * n) * 4u) = v[bj][n]; }
                    } else {
#pragma unroll
                        for (int n = 0; n < 2; ++n) { const f32x4 x1 = v[0][n], x2 = v[1][n]; v[0][n] = x1 * cs[m][n] - x2 * sn[m][n]; v[1][n] = x2 * cs[m][n] + x1 * sn[m][n]; } }
                    const unsigned drow = (kind == 1 && smp) ? (unsigned)(sb * TKS + PAST + tq0 + lrow) : row;
#pragma unroll
                    for (int bj = 0; bj < 2; ++bj) { u32x4 w; w.x = cvt_pk_bf16(v[bj][0][0], v[bj][0][1]); w.y = cvt_pk_bf16(v[bj][0][2], v[bj][0][3]); w.z = cvt_pk_bf16(v[bj][1][0], v[bj][1][1]); w.w = cvt_pk_bf16(v[bj][1][2], v[bj][1][3]);
                        *(GAS u32x4*)(dst + (drow * (unsigned)D + oc + 32 * bj) * 2u) = w; }
                    if (m & 1) { asm volatile("" ::: "memory"); __builtin_amdgcn_sched_barrier(0); } } }
        } else {
            const int oc = (u.pn - 8) * 256 + wc * 32 + 8 * fq;
            const size_t doff = smp ? WS_VS : WS_T2 + (size_t)M * D * 2 + (size_t)NPROMPT * D * 2; GAS unsigned char* dst = (GAS unsigned char*)ws + doff;
#pragma unroll
            for (int bj = 0; bj < 2; ++bj) { const f32x4 bz0 = *(PG8_LAS const f32x4*)(tb + 256 + tc0 + bj * HALF), bz1 = *(PG8_LAS const f32x4*)(tb + 256 + tc0 + bj * HALF + 4);
#pragma unroll
                for (int ai = 0; ai < 2; ++ai)
#pragma unroll
                    for (int m = 0; m < 4; ++m) { const int lrow = 128 * ai + 64 * wr + 16 * m + fr; const float rs = tb[lrow];
                        const f32x4 v0 = acc[ai][bj][m][0] * rs + bz0, v1 = acc[ai][bj][m][1] * rs + bz1;
                        const unsigned row = (unsigned)(trow + lrow), drow = smp ? (unsigned)(sb * TKS + PAST + tq0 + lrow) : row;
                        u32x4 w; w.x = cvt_pk_bf16(v0[0], v0[1]); w.y = cvt_pk_bf16(v0[2], v0[3]); w.z = cvt_pk_bf16(v1[0], v1[1]); w.w = cvt_pk_bf16(v1[2], v1[3]);
                        *(GAS u32x4*)(dst + (drow * (unsigned)D + oc + 128 * bj) * 2u) = w;
                        if (!smp) { *(GAS f32x4*)((GAS unsigned char*)out + O_CV * 4 + (row * (unsigned)D + oc + 128 * bj) * 4u) = v0; *(GAS f32x4*)((GAS unsigned char*)out + O_CV * 4 + (row * (unsigned)D + oc + 128 * bj + 4) * 4u) = v1; } } }
        }
    }
};
}

struct Params { const float* in[N_IN]; float* out; unsigned char* ws; };
struct Frame {
    LAS unsigned char* lds; int tid, lane, wave, bid, G, wave0;
    float* out; unsigned char* ws; float* out0; unsigned char* ws0;
    __device__ __forceinline__ const float* inp(int i) const { const unsigned long long v = ((LAS const unsigned long long*)(lds + PTR_OFF))[i];
        const unsigned lo = __builtin_amdgcn_readfirstlane((unsigned)v), hi = __builtin_amdgcn_readfirstlane((unsigned)(v >> 32)); return (const float*)(const GAS float*)(((unsigned long long)hi << 32) | lo); }
    float* mod; float* rstd; float* rope; bf16 *H, *T1, *T2, *T3, *KS, *VS, *WT; float *rsq0, *rsq1, *rsqv, *bias2;
    __device__ __forceinline__ void fresh() {
        int z = 0; asm volatile("" : "+v"(z));
        lane = __builtin_amdgcn_mbcnt_hi(~0u, __builtin_amdgcn_mbcnt_lo(~0u, z)); int wv = wave0; asm volatile("" : "+s"(wv)); wave = wv; tid = wv * 64 + lane;
        int b = blockIdx.x; asm volatile("" : "+s"(b)); bid = b;
        unsigned char* w = ws0; asm volatile("" : "+s"(w)); w = (unsigned char*)(GAS unsigned char*)(unsigned long long)w; ws = w; float* o = out0; asm volatile("" : "+s"(o)); o = (float*)(GAS float*)(unsigned long long)o; out = o;
        mod = (float*)(w + WS_MOD); rstd = (float*)(w + WS_RSTD); rope = (float*)(w + WS_ROPE);
        H = (bf16*)(w + WS_H); T1 = (bf16*)(w + WS_T1); T2 = (bf16*)(w + WS_T2); T3 = (bf16*)(w + WS_T3); KS = (bf16*)(w + WS_KS); VS = (bf16*)(w + WS_VS); WT = (bf16*)(w + WS_W);
        rsq0 = (float*)(w + WS_X); rsq1 = (float*)(w + WS_X + MiB); rsqv = (float*)(w + WS_X + 2 * MiB); bias2 = (float*)(w + WS_X + 4 * MiB);
    }
};
__device__ __forceinline__ const float* xin_row(const Frame& F, int row) { return row < NPROMPT ? F.inp(I_XP) + (size_t)row * D : F.inp(I_XS) + (size_t)(row - NPROMPT) * D; }
__device__ __forceinline__ int cidx_of(int row) { return row < NPROMPT ? 0 : 1 + ((row - NPROMPT) >> 10); }
__device__ __forceinline__ const float* modp(const Frame& F, int l, int row, int which) { return F.mod + (size_t)((l * 3 + cidx_of(row)) * 6 + which) * D; }


template <int MODE  >
__device__ __forceinline__ void transpose_item(const float* W, int K, int N, bf16* WT, LAS float* scr, int item, int lane) {
    const int nblk = N / 32, kb = item / nblk, nb = item % nblk, k0 = 64 * kb, n0 = 32 * nb;
    int d0 = n0; if (MODE == 1) { const int isu = n0 >= DFF, jj = n0 - isu * DFF; d0 = (jj >> 7) * 256 + isu * 128 + (jj & 127); }
    if (MODE == 2 && n0 < 2 * D) { const int w = n0 & 255; d0 = (n0 & ~255) + ((w >> 5) & 1) * 128 + (w >> 6) * 32; }
    float wv[32];
    const GAS float* wp = (const GAS float*)W + (size_t)(k0 + (lane >> 5)) * N + n0 + (lane & 31);
#pragma unroll
    for (int i = 0; i < 32; ++i) wv[i] = wp[(size_t)(2 * i) * N];
#pragma unroll
    for (int i = 0; i < 32; ++i) scr[(2 * i + (lane >> 5)) * 33 + (lane & 31)] = wv[i];
    asm volatile("s_waitcnt lgkmcnt(0)" ::: "memory");
    const int c = lane & 7;
#pragma unroll
    for (int j = 0; j < 4; ++j) { const int n = (lane >> 3) + 8 * j; const LAS float* sp = scr + (8 * c) * 33 + n;
        u32x4 o; o.x = f2bf(sp[0 * 33]) | (f2bf(sp[1 * 33]) << 16); o.y = f2bf(sp[2 * 33]) | (f2bf(sp[3 * 33]) << 16); o.z = f2bf(sp[4 * 33]) | (f2bf(sp[5 * 33]) << 16); o.w = f2bf(sp[6 * 33]) | (f2bf(sp[7 * 33]) << 16);
        *(u32x4*)(WT + (size_t)(d0 + n) * K + k0 + 8 * c) = o; }
    asm volatile("s_waitcnt lgkmcnt(0)" ::: "memory");
}
template <int MODE = 0>
__device__ __forceinline__ bool transpose_group(int& r, const float* W, int nmat, int K, int N, bf16* WT, LAS float* scr, int lane) {
    const int per = (K / 64) * (N / 32), tot = nmat * per;
    if (r >= tot) { r -= tot; return false; }
    const int mi = r / per; transpose_item<MODE>(W + (size_t)mi * K * N, K, N, WT + (size_t)mi * K * N, scr, r % per, lane); return true;
}

template <int SLOT>
__device__ __forceinline__ void convert_slot(Frame& F, int gw, int NGW) {
    LAS float* scr = (LAS float*)(F.lds + F.wave * 16384);
    constexpr size_t UPE = (size_t)2 * DFF * D, DNE = (size_t)D * DFF;
    constexpr int I_UP1 = (D / 64) * (2 * DFF / 32), I_DN1 = (DFF / 64) * (D / 32), I_LIN = (D / 64) * (2 * DRNN / 32), I_LOUT = (DRNN / 64) * (D / 32), I_WG = 80 * 2 * 4,
                  I_CIN = (D / 64) * (2 * DB / 32), I_COUT = (DB / 64) * (D / 32), I_QKV = (D / 64) * (3 * D / 32), I_AOUT = (D / 64) * (D / 32);
    constexpr int NIT = SLOT == 0 ? I_LIN + I_LOUT + I_WG + I_UP1 + I_DN1 : SLOT == 1 ? I_CIN + I_COUT + I_UP1 : SLOT == 2 ? I_DN1 + I_QKV + I_AOUT + I_UP1 : SLOT == 3 ? I_DN1 + I_LIN + I_LOUT : I_UP1 + I_DN1;
    for (int it = gw; it < NIT; it += NGW) { int r = it;
        if (SLOT == 0) {
            if (transpose_group(r, F.inp(I_LRU_WIN), 1, D, 2 * DRNN, F.WT + WE_LRU_IN, scr, F.lane)) continue;
            if (transpose_group(r, F.inp(I_LRU_WOUT), 1, DRNN, D, F.WT + WE_LRU_OUT, scr, F.lane)) continue;
            if (transpose_group(r, F.inp(I_LRU_WG), 80, 128, 128, F.WT + WE_WG, scr, F.lane)) continue;
            if (transpose_group<1>(r, F.inp(I_FF_WUP), 1, D, 2 * DFF, F.WT + WE_UP, scr, F.lane)) continue;
            transpose_group(r, F.inp(I_FF_WDN), 1, DFF, D, F.WT + WE_DN, scr, F.lane);
        } else if (SLOT == 1) {
            if (transpose_group(r, F.inp(I_CM_WIN), 1, D, 2 * DB, F.WT + WE_CM_IN, scr, F.lane)) continue;
            if (transpose_group(r, F.inp(I_CM_WOUT), 1, DB, D, F.WT + WE_CM_OUT, scr, F.lane)) continue;
            transpose_group<1>(r, F.inp(I_FF_WUP) + UPE, 1, D, 2 * DFF, F.WT + WE_UP + UPE, scr, F.lane);
        } else if (SLOT == 2) {
            if (transpose_group(r, F.inp(I_FF_WDN) + DNE, 1, DFF, D, F.WT + WE_DN + DNE, scr, F.lane)) continue;
            if (transpose_group<2>(r, F.inp(I_AT_WQKV), 1, D, 3 * D, F.WT + WE_QKV, scr, F.lane)) continue;
            if (transpose_group(r, F.inp(I_AT_WOUT), 1, D, D, F.WT + WE_AT_OUT, scr, F.lane)) continue;
            transpose_group<1>(r, F.inp(I_FF_WUP) + 2 * UPE, 1, D, 2 * DFF, F.WT + WE_UP + 2 * UPE, scr, F.lane);
        } else if (SLOT == 3) {
            if (transpose_group(r, F.inp(I_FF_WDN) + 2 * DNE, 1, DFF, D, F.WT + WE_DN + 2 * DNE, scr, F.lane)) continue;
            if (transpose_group(r, F.inp(I_LRU_WIN) + (size_t)D * 2 * DRNN, 1, D, 2 * DRNN, F.WT + WE_LRU_IN + (size_t)D * 2 * DRNN, scr, F.lane)) continue;
            transpose_group(r, F.inp(I_LRU_WOUT) + (size_t)DRNN * D, 1, DRNN, D, F.WT + WE_LRU_OUT + (size_t)DRNN * D, scr, F.lane);
        } else {
            if (transpose_group<1>(r, F.inp(I_FF_WUP) + 3 * UPE, 1, D, 2 * DFF, F.WT + WE_UP + 3 * UPE, scr, F.lane)) continue;
            transpose_group(r, F.inp(I_FF_WDN) + 3 * DNE, 1, DFF, D, F.WT + WE_DN + 3 * DNE, scr, F.lane);
        }
    }
}
__device__ __forceinline__ void phase_prologue(Frame& F) {
    F.fresh();
    LAS float* sc = (LAS float*)F.lds;
    const float* c = F.inp(I_C); const float* cctx = F.inp(I_CCTX);
    for (int i = F.tid; i < 3 * D; i += NT) { const int ci = i >> 10, k = i & 1023; const float v = ci == 0 ? cctx[k] : c[(ci - 1) * D + k]; sc[i] = siluf_(v); }
    __syncthreads();
    LAS float* part = sc + 3 * D;
    const int kp = F.tid >> 6, cl = F.tid & 63;
    for (int item = F.bid; item < DEPTH * 6 * D / 64; item += F.G) {
        const int col = item * 64 + cl, l = col / (6 * D), cc = col % (6 * D);
        const float* w = F.inp(I_WMOD) + (size_t)l * D * 6 * D + cc;
        float s0 = 0.f, s1 = 0.f, s2 = 0.f;
#pragma unroll 1
        for (int kb = kp * 128; kb < kp * 128 + 128; kb += 32) { float wv[32];
#pragma unroll
            for (int i = 0; i < 32; ++i) wv[i] = ((const GAS float*)w)[(size_t)(kb + i) * 6 * D];
#pragma unroll
            for (int i = 0; i < 32; ++i) { s0 += sc[kb + i] * wv[i]; s1 += sc[D + kb + i] * wv[i]; s2 += sc[2 * D + kb + i] * wv[i]; } }
        part[(kp * 3 + 0) * 64 + cl] = s0; part[(kp * 3 + 1) * 64 + cl] = s1; part[(kp * 3 + 2) * 64 + cl] = s2;
        __syncthreads();
        if (F.tid < 192) { const int ci = F.tid >> 6; float s = F.inp(I_BMOD)[l * 6 * D + cc];
            for (int q = 0; q < 8; ++q) s += part[(q * 3 + ci) * 64 + cl];
            F.mod[(size_t)((l * 3 + ci) * 6) * D + cc] = s; }
        __syncthreads();
    }
    { __syncthreads(); convert_slot<0>(F, F.bid * NWAVES + F.wave, F.G * NWAVES); }
    const int gt = F.bid * NT + F.tid, GT = F.G * NT;
    for (int i = gt; i < 1024 * 32; i += GT) { const int t = i >> 5, j = i & 31; const float inv = powf(10000.f, -(float)(j & 15) / 16.f); const float pos = (float)(j < 16 ? (t >> 6) : (t & 63));
        const float ang = pos * inv; F.rope[i] = cosf(ang); F.rope[32768 + i] = sinf(ang); }
    for (int i = gt; i < 8 * 8 * 4 * 64; i += GT) { const int ln = i & 63, ks = (i >> 6) & 3, nf = (i >> 8) & 7, g = i >> 11, cq = ln >> 4, p = 16 * nf + (ln & 15);
        const float* wr = F.inp(I_CM_WS) + (size_t)(g * 128 + p) * 128 + 32 * ks + 4 * cq;
        u32x4 o; o.x = f2bf(wr[0]) | (f2bf(wr[1]) << 16); o.y = f2bf(wr[2]) | (f2bf(wr[3]) << 16); o.z = f2bf(wr[16]) | (f2bf(wr[17]) << 16); o.w = f2bf(wr[18]) | (f2bf(wr[19]) << 16);
        *(u32x4*)(F.WT + WE_WSB + (size_t)i * 8) = o; }
    for (int i = gt; i < 2 * PAST * D; i += GT) { const int b = i / (PAST * D), r = i % (PAST * D);
        F.KS[(size_t)b * TKS * D + r] = (bf16)f2bf(F.inp(I_CK)[i]); F.VS[(size_t)b * TKS * D + r] = (bf16)f2bf(F.inp(I_CV)[i]); }
}

__device__ __forceinline__ void bias2_gemm(Frame& F, const bf16* Wt, int N, int l, int sub, float* outp, int gw, int NGW) {
    float sh[3][16];
#pragma unroll
    for (int ci = 0; ci < 3; ++ci) { const GAS f32x4* sp = (const GAS f32x4*)(F.mod + (size_t)((l * 3 + ci) * 6 + sub * 3) * D + 16 * F.lane);
#pragma unroll
        for (int i = 0; i < 4; ++i) { const f32x4 v = sp[i]; sh[ci][4 * i] = v.x; sh[ci][4 * i + 1] = v.y; sh[ci][4 * i + 2] = v.z; sh[ci][4 * i + 3] = v.w; } }
    for (int n = gw; n < N; n += NGW) { const GAS u32x4* wp = (const GAS u32x4*)(Wt + (size_t)n * D + 16 * F.lane); const u32x4 w0 = wp[0], w1 = wp[1];
        const unsigned ww[8] = {w0.x, w0.y, w0.z, w0.w, w1.x, w1.y, w1.z, w1.w};
        float d0 = 0.f, d1 = 0.f, d2 = 0.f;
#pragma unroll
        for (int i = 0; i < 8; ++i) { const float lo = bf2f(ww[i]), hi = bf2f(ww[i] >> 16); d0 += sh[0][2 * i] * lo + sh[0][2 * i + 1] * hi; d1 += sh[1][2 * i] * lo + sh[1][2 * i + 1] * hi; d2 += sh[2][2 * i] * lo + sh[2][2 * i + 1] * hi; }
        d0 = wave_sum(d0); d1 = wave_sum(d1); d2 = wave_sum(d2);
        if (F.lane == 0) { outp[n] = d0; outp[(size_t)N + n] = d1; outp[(size_t)2 * N + n] = d2; } }
}
__device__ __forceinline__ void bias2_slot(Frame& F, int slot, int gw, int NGW) {
    if (slot == 2) bias2_gemm(F, F.WT + WE_CM_IN, 2 * DB, 1, 0, F.bias2 + B2_CM, gw, NGW);
    else if (slot == 3) bias2_gemm(F, F.WT + WE_UP + (size_t)1 * 2 * DFF * D, 2 * DFF, 1, 1, F.bias2 + B2_UP + (size_t)1 * 3 * 5632, gw, NGW);
    else if (slot == 4) bias2_gemm(F, F.WT + WE_QKV, 3 * D, 2, 0, F.bias2 + B2_QKV, gw, NGW);
    else if (slot == 5) bias2_gemm(F, F.WT + WE_UP + (size_t)2 * 2 * DFF * D, 2 * DFF, 2, 1, F.bias2 + B2_UP + (size_t)2 * 3 * 5632, gw, NGW);
    else if (slot == 6) bias2_gemm(F, F.WT + WE_LRU_IN + (size_t)2 * DRNN * D, 2 * DRNN, 3, 0, F.bias2 + B2_LRU + 3 * 2560, gw, NGW);
    else if (slot == 7) bias2_gemm(F, F.WT + WE_UP + (size_t)3 * 2 * DFF * D, 2 * DFF, 3, 1, F.bias2 + B2_UP + (size_t)3 * 3 * 5632, gw, NGW);
}
__device__ __forceinline__ void side_job(Frame& F, int slot) {
    F.fresh();
    const int nwk = F.G > 160 ? F.G - 160 : F.G, wk = F.G > 160 ? F.bid - 160 : F.bid;
    if (wk < 0) return;
    const int gw = wk * NWAVES + F.wave, NGW = nwk * NWAVES;
    bias2_slot(F, slot, gw, NGW);
    if (slot == 1) convert_slot<1>(F, gw, NGW); else if (slot == 2) convert_slot<2>(F, gw, NGW); else if (slot == 3) convert_slot<3>(F, gw, NGW); else if (slot == 4) convert_slot<4>(F, gw, NGW);
}
__device__ __forceinline__ void phase_modulate0(Frame& F) {
    F.fresh();
    const int gw = F.bid * NWAVES + F.wave, NGW = F.G * NWAVES;
    const float* g = F.inp(I_NORMG);
    for (int row = gw; row < M; row += NGW) {
        const float* xr = xin_row(F, row); const float* scl = modp(F, 0, row, 1);
        f32x4 v[4]; float s = 0.f;
#pragma unroll
        for (int j = 0; j < 4; ++j) { v[j] = *(const GAS f32x4*)(xr + 4 * F.lane + 256 * j); s += v[j].x * v[j].x + v[j].y * v[j].y + v[j].z * v[j].z + v[j].w * v[j].w; }
        s = wave_sum(s);
        if (F.lane < 16) F.rsq0[(size_t)row * 16 + F.lane] = F.lane == 0 ? s : 0.f;
#pragma unroll
        for (int j = 0; j < 4; ++j) { const int c0 = 4 * F.lane + 256 * j; const f32x4 gg = *(const GAS f32x4*)(g + c0), c4 = *(const GAS f32x4*)(scl + c0);
            const f32x4 o = v[j] * gg * (1.f + c4); u32x2 w; w.x = f2bf(o.x) | (f2bf(o.y) << 16); w.y = f2bf(o.z) | (f2bf(o.w) << 16);
            *(GAS u32x2*)(F.H + (size_t)row * D + c0) = w; }
    }
    bias2_gemm(F, F.WT + WE_LRU_IN, 2 * DRNN, 0, 0, F.bias2 + B2_LRU, gw, NGW);
    bias2_gemm(F, F.WT + WE_UP, 2 * DFF, 0, 1, F.bias2 + B2_UP, gw, NGW);
}

template <class P>
__device__ __forceinline__ void gemm_naive(Frame& F, const P& p, int nbatch, int Mr, int N, int K) {
    F.fresh();
    LAS float* As = (LAS float*)F.lds;
    LAS float* Bs = As + 16 * 132;
    const int tid = F.tid, tx = tid & 31, ty = tid >> 5;
    const int tm = Mr / 128, tn = N / 128, per = tm * tn, total = per * nbatch;
    for (int t = F.bid; t < total; t += F.G) {
        const int b = t / per, r = t % per, pn = r / tm, pm = r % tm;
        const bf16* A; int lda; const float* W; int ldw; p.get(b, A, lda, W, ldw);
        float acc[8][4];
#pragma unroll
        for (int i = 0; i < 8; ++i)
#pragma unroll
            for (int j = 0; j < 4; ++j) acc[i][j] = 0.f;
        for (int k0 = 0; k0 < K; k0 += 16) {
            { const int row = tid >> 2, kq = (tid & 3) * 4;
              const u32x2 v = *(const u32x2*)(A + (size_t)(pm * 128 + row) * lda + k0 + kq);
              As[(kq + 0) * 132 + row] = bf2f(v.x); As[(kq + 1) * 132 + row] = bf2f(v.x >> 16); As[(kq + 2) * 132 + row] = bf2f(v.y); As[(kq + 3) * 132 + row] = bf2f(v.y >> 16); }
            { const int k = tid >> 5, n4 = (tid & 31) * 4;
              *(LAS f32x4*)(Bs + k * 128 + n4) = *(const f32x4*)(W + (size_t)(k0 + k) * ldw + pn * 128 + n4); }
            __syncthreads();
#pragma unroll 2
            for (int k = 0; k < 16; ++k) {
                const f32x4 a0 = *(const LAS f32x4*)(As + k * 132 + ty * 8), a1 = *(const LAS f32x4*)(As + k * 132 + ty * 8 + 4), bv = *(const LAS f32x4*)(Bs + k * 128 + tx * 4);
                const float a[8] = {a0.x, a0.y, a0.z, a0.w, a1.x, a1.y, a1.z, a1.w}; const float bb[4] = {bv.x, bv.y, bv.z, bv.w};
#pragma unroll
                for (int i = 0; i < 8; ++i)
#pragma unroll
                    for (int j = 0; j < 4; ++j) acc[i][j] += a[i] * bb[j];
            }
            __syncthreads();
        }
#pragma unroll
        for (int i = 0; i < 8; ++i)
#pragma unroll
            for (int j = 0; j < 4; ++j) p.epi(b, pm * 128 + ty * 8 + i, pn * 128 + tx * 4 + j, acc[i][j]);
    }
}

struct PStoreBf16 {
    const bf16* A; int lda; const float* W; int ldw; bf16* O; int ldo; const float* bias; int act; int split;
    __device__ __forceinline__ void get(int, const bf16*& a, int& la, const float*& w, int& lw) const { a = A; la = lda; w = W; lw = ldw; }
    __device__ __forceinline__ void epi(int, int row, int col, float v) const {
        if (bias) v += bias[col];
        if (act == 1 || (act == 2 && col < split)) v = gelu_tanh(v);
        O[(size_t)row * ldo + col] = (bf16)f2bf(v); }
};
struct PResid {
    const bf16* A; int lda; const float* W; int ldw; float* out; const float* xp; const float* xs; const float* modl; int which; bool from_input;
    __device__ __forceinline__ void get(int, const bf16*& a, int& la, const float*& w, int& lw) const { a = A; la = lda; w = W; lw = ldw; }
    __device__ __forceinline__ void epi(int, int row, int col, float v) const {
        const float base = from_input ? (row < NPROMPT ? xp[(size_t)row * D + col] : xs[(size_t)(row - NPROMPT) * D + col]) : out[(size_t)row * D + col];
        out[(size_t)row * D + col] = base + modl[(size_t)(cidx_of(row) * 6 + which) * D + col] * v; }
};
struct PLruIn {
    const bf16* A; const float* W; bf16* GBp; bf16* RECp;
    __device__ __forceinline__ void get(int, const bf16*& a, int& la, const float*& w, int& lw) const { a = A; la = D; w = W; lw = 2 * DRNN; }
    __device__ __forceinline__ void epi(int, int row, int col, float v) const {
        if (col < DRNN) GBp[(size_t)row * DRNN + col] = (bf16)f2bf(gelu_tanh(v)); else RECp[(size_t)row * DRNN + col - DRNN] = (bf16)f2bf(v); }
};
struct PGates {
    const bf16* XC; const float* WG; const float* BG; bf16* O;
    __device__ __forceinline__ void get(int b, const bf16*& a, int& la, const float*& w, int& lw) const { a = XC + (b % 10) * 128; la = DRNN; w = WG + (size_t)b * 128 * 128; lw = 128; }
    __device__ __forceinline__ void epi(int b, int row, int col, float v) const { const int dg = b / 10, n = b % 10;
        O[((size_t)dg * M + row) * DRNN + n * 128 + col] = (bf16)f2bf(sigmoidf_(v + BG[dg * DRNN + n * 128 + col])); }
};

__device__ __forceinline__ void phase_lru_conv(Frame& F, int j, const bf16* REC, bf16* XC) {
    F.fresh();
    const float* cw = F.inp(I_LRU_CW) + (size_t)j * 4 * DRNN; const float* cb = F.inp(I_LRU_CB) + (size_t)j * DRNN;
    const int gt = F.bid * NT + F.tid, GT = F.G * NT;
    for (int i = gt; i < M * DRNN; i += GT) { const int row = i / DRNN, ch = i % DRNN;
        int t, T; if (row < NPROMPT) { t = row & 255; T = 256; } else { t = (row - NPROMPT) & 1023; T = 1024; }
        float s = cb[ch];
#pragma unroll
        for (int k = 0; k < 4; ++k) { const int tt = t + k - 2; if (tt >= 0 && tt < T) s += cw[k * DRNN + ch] * bf2f(REC[(size_t)(row + k - 2) * DRNN + ch]); }
        XC[i] = (bf16)f2bf(s); }
}
__device__ __forceinline__ void phase_lru_scan(Frame& F, int j, const bf16* GATES, const bf16* XC, const bf16* GB, bf16* HS) {
    F.fresh();
    const int gt = F.bid * NT + F.tid, GT = F.G * NT;
    const int NL = (2 + 32) * DRNN;
    for (int line = gt; line < NL; line += GT) {
        const int s = line / DRNN, ch = line % DRNN;
        int base, T; float h0f = 0.f, h0b = 0.f;
        if (s < 2) { base = NPROMPT + s * 1024; T = 1024; h0f = F.inp(I_STATE)[((size_t)(s * 2 + j) * 2 + 0) * DRNN + ch]; h0b = F.inp(I_STATE)[((size_t)(s * 2 + j) * 2 + 1) * DRNN + ch]; }
        else { base = (s - 2) * 256; T = 256; }
        const float spf = softplusf_(-F.inp(I_LRU_LAM)[(size_t)(j * 2 + 0) * DRNN + ch]), spb = softplusf_(-F.inp(I_LRU_LAM)[(size_t)(j * 2 + 1) * DRNN + ch]);
        float h = h0f;
        for (int t = 0; t < T; ++t) { const size_t o = (size_t)(base + t) * DRNN + ch;
            const float r = bf2f(GATES[o]), ig = bf2f(GATES[(size_t)M * DRNN + o]), xc = bf2f(XC[o]);
            const float la = -8.f * r * spf, a = expf(la), bx = sqrtf(-expm1f(2.f * la)) * (ig * xc);
            h = a * h + bx; HS[o] = (bf16)f2bf(h); }
        const float ff = h;
        h = h0b;
        for (int t = T - 1; t >= 0; --t) { const size_t o = (size_t)(base + t) * DRNN + ch;
            const float r = bf2f(GATES[(size_t)2 * M * DRNN + o]), ig = bf2f(GATES[(size_t)3 * M * DRNN + o]), xc = bf2f(XC[o]);
            const float la = -8.f * r * spb, a = expf(la), bx = sqrtf(-expm1f(2.f * la)) * (ig * xc);
            h = a * h + bx; HS[o] = (bf16)f2bf(bf2f(GB[o]) * (bf2f(HS[o]) + h)); }
        if (s >= 2) { float* st = F.out + O_STATE + ((size_t)((s - 2) * 2 + j) * 2) * DRNN; st[ch] = ff; st[DRNN + ch] = h; }
    }
}


typedef short bf16x8 __attribute__((ext_vector_type(8)));
typedef short v4i16_t __attribute__((ext_vector_type(4)));
constexpr int LRU_XS = 272;
constexpr int LRU_XC_OFF = 0, LRU_GB_OFF = 256 * LRU_XS;
template <bool REV>
__device__ __forceinline__ float lru_dir(LAS const unsigned char* xct, LAS unsigned char* hft, const bf16* wgt  ,
                                         const bf16* gbp  , float br, float bi, float sp, float hc, int wave, int lane, bool wantp, bf16* Pdst) {
    const int c = lane & 15, q = lane >> 4, qq = REV ? 3 - q : q;
    bf16x8 Br[4], Bi[4], Id;
#pragma unroll
    for (int ks = 0; ks < 4; ++ks) { Br[ks] = *(const GAS bf16x8*)(wgt + (size_t)(16 * wave + c) * 128 + 32 * ks + 8 * q);
                                     Bi[ks] = *(const GAS bf16x8*)(wgt + (size_t)10 * 128 * 128 + (size_t)(16 * wave + c) * 128 + 32 * ks + 8 * q); }
#pragma unroll
    for (int jj = 0; jj < 8; ++jj) Id[jj] = (8 * q + jj == 16 * (wave & 1) + c) ? (short)0x3F80 : (short)0;
    const int ksel = wave >> 1;
    const float nsp8 = -8.f * sp * 1.44269504f;
    float Pc = 1.f;
    unsigned short gcur[16], gnxt[16];
#pragma unroll
    for (int i = 0; i < 16; ++i) { gcur[i] = 0; gnxt[i] = 0; }
    if (REV) {
#pragma unroll
        for (int i = 0; i < 16; ++i) gcur[i] = *(const GAS unsigned short*)(gbp + (size_t)(16 * (12 + (i >> 2)) + 4 * q + (i & 3)) * DRNN); }
#pragma unroll 1
    for (int og = 0; og < 4; ++og) {
        if (REV && og < 3) {
#pragma unroll
            for (int i = 0; i < 16; ++i) gnxt[i] = *(const GAS unsigned short*)(gbp + (size_t)(16 * (4 * (2 - og) + (i >> 2)) + 4 * q + (i & 3)) * DRNN); }
#pragma unroll
        for (int ii = 0; ii < 4; ++ii) {
        const int it = 4 * og + ii, mi = REV ? 15 - it : it, mloc = REV ? 3 - ii : ii;
        LAS const unsigned char* rp = xct + (16 * mi + c) * LRU_XS + 16 * q;
        bf16x8 Af[4];
#pragma unroll
        for (int ks = 0; ks < 4; ++ks) Af[ks] = *(LAS const bf16x8*)(rp + 64 * ks);
        const bf16x8 Ax = *(LAS const bf16x8*)(rp + 64 * ksel);
        f32x4 r = {0.f, 0.f, 0.f, 0.f}, ig = {0.f, 0.f, 0.f, 0.f};
#pragma unroll
        for (int ks = 0; ks < 4; ++ks) { r = __builtin_amdgcn_mfma_f32_16x16x32_bf16(Af[ks], Br[ks], r, 0, 0, 0); ig = __builtin_amdgcn_mfma_f32_16x16x32_bf16(Af[ks], Bi[ks], ig, 0, 0, 0); }
        const f32x4 xc = __builtin_amdgcn_mfma_f32_16x16x32_bf16(Ax, Id, (f32x4){0.f, 0.f, 0.f, 0.f}, 0, 0, 0);
        float av[4], bv[4];
#pragma unroll
        for (int k = 0; k < 4; ++k) { const float rg = __builtin_amdgcn_rcpf(1.f + __builtin_amdgcn_exp2f(-1.44269504f * (r[k] + br))), iv = __builtin_amdgcn_rcpf(1.f + __builtin_amdgcn_exp2f(-1.44269504f * (ig[k] + bi)));
            const float l2a = nsp8 * rg, x = 1.38629436f * l2a;
            const float oms = -x * (1.f + x * (0.5f + x * (0.16666667f + x * (0.041666668f + x * 0.0083333338f))));
            const float om = x > -0.25f ? oms : 1.f - __builtin_amdgcn_exp2f(2.f * l2a);
            av[k] = __builtin_amdgcn_exp2f(l2a); bv[k] = __builtin_amdgcn_sqrtf(om) * (iv * xc[k]); }
        float pA[4], pB[4];
#pragma unroll
        for (int kk = 0; kk < 4; ++kk) { const int k = REV ? 3 - kk : kk;
            if (kk == 0) { pA[k] = av[k]; pB[k] = bv[k]; } else { const int kp = REV ? k + 1 : k - 1; pA[k] = pA[kp] * av[k]; pB[k] = pB[kp] * av[k] + bv[k]; } }
        const int kl = REV ? 0 : 3;
        float gA[4], gB[4];
#pragma unroll
        for (int g = 0; g < 4; ++g) { const int src = 16 * (REV ? 3 - g : g) + c; gA[g] = bperm(pA[kl], src); gB[g] = bperm(pB[kl], src); }
        float eA = 1.f, eB = 0.f, tA = 1.f, tB = 0.f;
#pragma unroll
        for (int g = 0; g < 4; ++g) { if (g == qq) { eA = tA; eB = tB; } tB = tB * gA[g] + gB[g]; tA = tA * gA[g]; }
        const float hin = eA * hc + eB;
#pragma unroll
        for (int k = 0; k < 4; ++k) { const float h = pA[k] * hin + pB[k]; const int row = 16 * mi + 4 * q + k;
            if (wantp) Pdst[(size_t)row * DRNN] = (bf16)f2bf(pA[k] * eA * Pc);
            LAS unsigned short* hp = (LAS unsigned short*)(hft + row * LRU_XS + 2 * (16 * wave + c));
            if (!REV) *hp = (unsigned short)f2bf(h); else *hp = (unsigned short)f2bf(bf2f(gcur[4 * mloc + k]) * (bf2f(*hp) + h)); }
        hc = tA * hc + tB; Pc *= tA;
        }
        if (REV) {
#pragma unroll
            for (int i = 0; i < 16; ++i) gcur[i] = gnxt[i]; }
    }
    return hc;
}
__device__ __forceinline__ void lru_unit(Frame& F, int j, int pm, int n, const bf16* REC, const bf16* GB, bf16* HS, bf16* PF, bf16* PB, float* AGG, const bf16* WGT) {
    const int tid = F.tid, lane = F.lane, wave = F.wave, r0 = 256 * pm;
    const bool smp = pm >= 32; const int tix = smp ? (pm - 32) & 3 : 0, sq = smp ? (pm - 32) >> 2 : 0;
    const int t0 = smp ? 256 * tix : 0, T = smp ? 1024 : 256;
    LAS unsigned char* xct = F.lds + LRU_XC_OFF; LAS unsigned char* hft = F.lds + LRU_GB_OFF;
    { const float* cw = F.inp(I_LRU_CW) + (size_t)j * 4 * DRNN + n * 128 + 2 * lane; const float* cb = F.inp(I_LRU_CB) + (size_t)j * DRNN + n * 128 + 2 * lane;
      float w0[4], w1[4];
#pragma unroll
      for (int k = 0; k < 4; ++k) { w0[k] = cw[k * DRNN]; w1[k] = cw[k * DRNN + 1]; }
      const float b0 = cb[0], b1 = cb[1];
      unsigned v[35];
#pragma unroll
      for (int i = 0; i < 35; ++i) { const int tl = 32 * wave + i - 2, tt = t0 + tl;
          v[i] = (tt >= 0 && tt < T) ? *(const GAS unsigned*)(REC + (size_t)(r0 + tl) * DRNN + n * 128 + 2 * lane) : 0u; }
#pragma unroll
      for (int i = 0; i < 32; ++i) { float s0 = b0, s1 = b1;
#pragma unroll
          for (int k = 0; k < 4; ++k) { s0 += w0[k] * bf2f(v[i + k]); s1 += w1[k] * bf2f(v[i + k] >> 16); }
          *(LAS unsigned*)(xct + (32 * wave + i) * LRU_XS + 4 * lane) = f2bf(s0) | (f2bf(s1) << 16); } }
    __syncthreads();
    const int c = lane & 15, q = lane >> 4, ch = n * 128 + 16 * wave + c;
    const float* bg = F.inp(I_LRU_BG) + (size_t)j * 4 * DRNN; const float* lam = F.inp(I_LRU_LAM) + (size_t)j * 2 * DRNN;
    const bf16* gbp = GB + (size_t)r0 * DRNN + ch;
    bf16* pf = PF + (size_t)(smp ? r0 - NPROMPT : 0) * DRNN + ch; bf16* pb = PB + (size_t)(smp ? r0 - NPROMPT : 0) * DRNN + ch;
    { float h0 = 0.f; if (smp && tix == 0) h0 = F.inp(I_STATE)[((size_t)(sq * 2 + j) * 2 + 0) * DRNN + ch];
      const float hfin = lru_dir<false>(xct, hft, WGT + (size_t)(0 * 10 + n) * 128 * 128, gbp, bg[0 * DRNN + ch], bg[1 * DRNN + ch], softplusf_(-lam[ch]), h0, wave, lane, smp, pf);
      if (q == 0) { if (smp) AGG[(size_t)((sq * 4 + tix) * 2 + 0) * DRNN + ch] = hfin; else F.out[O_STATE + ((size_t)(pm * 2 + j) * 2 + 0) * DRNN + ch] = hfin; } }
    { float h0 = 0.f; if (smp && tix == 3) h0 = F.inp(I_STATE)[((size_t)(sq * 2 + j) * 2 + 1) * DRNN + ch];
      const float hfin = lru_dir<true>(xct, hft, WGT + (size_t)(2 * 10 + n) * 128 * 128, gbp, bg[2 * DRNN + ch], bg[3 * DRNN + ch], softplusf_(-lam[DRNN + ch]), h0, wave, lane, smp, pb);
      if (q == 0) { if (smp) AGG[(size_t)((sq * 4 + tix) * 2 + 1) * DRNN + ch] = hfin; else F.out[O_STATE + ((size_t)(pm * 2 + j) * 2 + 1) * DRNN + ch] = hfin; } }
    __syncthreads();
#pragma unroll
    for (int i = 0; i < 8; ++i) { const int id = i * NT + tid, row = id >> 4, cc = id & 15;
        *(GAS u32x4*)(HS + (size_t)(r0 + row) * DRNN + n * 128 + 8 * cc) = *(LAS const u32x4*)(hft + row * LRU_XS + 16 * cc); }
    __syncthreads();
}
__device__ __forceinline__ void phase_lru_core(Frame& F, int j, const bf16* REC, const bf16* GB, bf16* HS, bf16* PF, bf16* PB, float* AGG, const bf16* WGT) {
    F.fresh();
    for (int u = F.bid; u < 400; u += F.G) {
        const int pm = u < 80 ? 32 + u / 10 : (u - 80) / 10, n = u % 10;
        lru_unit(F, j, pm, n, REC, GB, HS, PF, PB, AGG, WGT); }
}
__device__ __forceinline__ void phase_lru_fixup(Frame& F, const bf16* GB, bf16* HS, const bf16* PF, const bf16* PB, const float* AGG) {
    F.fresh();
    const int gt = F.bid * NT + F.tid, GT = F.G * NT;
    for (int i = gt; i < NSAMPLE * DRNN; i += GT) { const int rs = i / DRNN, ch = i % DRNN, sq = rs >> 10, tix = (rs >> 8) & 3;
        float cf = 0.f, cbk = 0.f;
        if (tix > 0) { for (int t = 0; t < tix; ++t) { const float At = bf2f(PF[(size_t)(sq * 1024 + t * 256 + 255) * DRNN + ch]); cf = At * cf + AGG[(size_t)((sq * 4 + t) * 2 + 0) * DRNN + ch]; } }
        if (tix < 3) { for (int t = 3; t > tix; --t) { const float At = bf2f(PB[(size_t)(sq * 1024 + t * 256) * DRNN + ch]); cbk = At * cbk + AGG[(size_t)((sq * 4 + t) * 2 + 1) * DRNN + ch]; } }
        const size_t o = (size_t)(NPROMPT + rs) * DRNN + ch;
        HS[o] = (bf16)f2bf(bf2f(HS[o]) + bf2f(GB[o]) * (bf2f(PF[(size_t)rs * DRNN + ch]) * cf + bf2f(PB[(size_t)rs * DRNN + ch]) * cbk)); }
}

__device__ __forceinline__ void phase_cmlp_rstd(Frame& F, const bf16* UV) {
    F.fresh();
    const int gw = F.bid * NWAVES + F.wave, NGW = F.G * NWAVES;
    for (int row = gw; row < M; row += NGW) { float s = 0.f;
        for (int c = F.lane; c < DB; c += 64) { const float v = bf2f(UV[(size_t)row * 2 * DB + DB + c]); s += v * v; }
        s = wave_sum(s); if (F.lane == 0) F.rstd[row] = rsqrtf(s * (1.f / DB) + EPS); }
}
__device__ __forceinline__ void phase_cmlp_spatial(Frame& F, const bf16* UV, bf16* ACT) {
    F.fresh();
    const float* ws = F.inp(I_CM_WS); const float* bs = F.inp(I_CM_BS); const float* ng = F.inp(I_CM_NG);
    const int gt = F.bid * NT + F.tid, GT = F.G * NT;
    for (int i = gt; i < M * DB; i += GT) { const int row = i / DB, ch = i % DB, g = ch >> 8, p = row & 127, r0 = row & ~127;
        float s = 0.f;
        for (int q = 0; q < 128; ++q) s += ws[(size_t)(g * 128 + p) * 128 + q] * F.rstd[r0 + q] * bf2f(UV[(size_t)(r0 + q) * 2 * DB + DB + ch]);
        const float sv = s * ng[ch] + bs[g * 128 + p];
        ACT[i] = (bf16)f2bf(bf2f(UV[(size_t)row * 2 * DB + ch]) * sv); }
}


constexpr int CM_VS = 544;
__device__ __forceinline__ void phase_cmlp_spatial_mfma(Frame& F, const bf16* UV, bf16* ACT, const bf16* WSB) {
    F.fresh();
    const int tid = F.tid, lane = F.lane, wave = F.wave, c = lane & 15, q4 = lane >> 4;
    LAS unsigned char* vt = F.lds;
    const float* ng = F.inp(I_CM_NG); const float* bs = F.inp(I_CM_BS);
    for (int u = F.bid; u < 640; u += F.G) {
        const int chunk = u >> 3, g = u & 7, r0 = chunk * 128;
        LAS float* rsl = (LAS float*)(vt + 128 * CM_VS);
        if (tid < 128) { const GAS f32x4* p = (const GAS f32x4*)(F.rsqv + (size_t)(r0 + tid) * 32); float sm = 0.f;
#pragma unroll
            for (int i = 0; i < 8; ++i) { const f32x4 t4 = p[i]; sm += (t4.x + t4.y) + (t4.z + t4.w); }
            rsl[tid] = rsqrtf(sm * (1.f / DB) + EPS); }
        __syncthreads();
#pragma unroll
        for (int i = 0; i < 8; ++i) { const int id = i * NT + tid, row = id >> 5, cc = id & 31;
            const u32x4 x = *(const GAS u32x4*)(UV + (size_t)(r0 + row) * 2 * DB + DB + g * 256 + 8 * cc); const float rs = rsl[row];
            u32x4 y; y.x = f2bf(bf2f(x.x) * rs) | (f2bf(bf2f(x.x >> 16) * rs) << 16); y.y = f2bf(bf2f(x.y) * rs) | (f2bf(bf2f(x.y >> 16) * rs) << 16);
            y.z = f2bf(bf2f(x.z) * rs) | (f2bf(bf2f(x.z >> 16) * rs) << 16); y.w = f2bf(bf2f(x.w) * rs) | (f2bf(bf2f(x.w >> 16) * rs) << 16);
            *(LAS u32x4*)(vt + row * CM_VS + 16 * cc) = y; }
        __syncthreads();
        bf16x8 vf[2][4];
#pragma unroll
        for (int mfc = 0; mfc < 2; ++mfc)
#pragma unroll
            for (int ks = 0; ks < 4; ++ks) { LAS const unsigned char* vp = vt + (32 * ks + 4 * q4 + (c >> 2)) * CM_VS + (32 * wave + 16 * mfc + 4 * (c & 3)) * 2;
                const v4i16_t lo = __builtin_amdgcn_ds_read_tr16_b64_v4i16((LAS v4i16_t*)vp), hi = __builtin_amdgcn_ds_read_tr16_b64_v4i16((LAS v4i16_t*)(vp + 16 * CM_VS));
                vf[mfc][ks] = (bf16x8){lo[0], lo[1], lo[2], lo[3], hi[0], hi[1], hi[2], hi[3]}; }
#pragma unroll
        for (int nf = 0; nf < 8; ++nf) {
            bf16x8 Bf[4];
#pragma unroll
            for (int ks = 0; ks < 4; ++ks) Bf[ks] = *(const GAS bf16x8*)(WSB + ((size_t)((g * 8 + nf) * 4 + ks) * 64 + lane) * 8);
            const int p = 16 * nf + c; const float bsv = bs[g * 128 + p];
#pragma unroll
            for (int mfc = 0; mfc < 2; ++mfc) { f32x4 acc = {0.f, 0.f, 0.f, 0.f};
#pragma unroll
                for (int ks = 0; ks < 4; ++ks) acc = __builtin_amdgcn_mfma_f32_16x16x32_bf16(vf[mfc][ks], Bf[ks], acc, 0, 0, 0);
                const int ch = g * 256 + 32 * wave + 16 * mfc + 4 * q4;
                const f32x4 g4 = *(const GAS f32x4*)(ng + ch); const u32x2 uu = *(const GAS u32x2*)(UV + (size_t)(r0 + p) * 2 * DB + ch);
                const float o0 = bf2f(uu.x) * (acc[0] * g4.x + bsv), o1 = bf2f(uu.x >> 16) * (acc[1] * g4.y + bsv), o2 = bf2f(uu.y) * (acc[2] * g4.z + bsv), o3 = bf2f(uu.y >> 16) * (acc[3] * g4.w + bsv);
                u32x2 w; w.x = f2bf(o0) | (f2bf(o1) << 16); w.y = f2bf(o2) | (f2bf(o3) << 16);
                *(GAS u32x2*)(ACT + (size_t)(r0 + p) * DB + ch) = w; }
        }
        __syncthreads();
    }
}

__device__ __forceinline__ void phase_qkv_post(Frame& F, const bf16* QKV, bf16* Q, bf16* KP, bf16* VP) {
    F.fresh();
    const int gw = F.bid * NWAVES + F.wave, NGW = F.G * NWAVES;
    const float* qkg = F.inp(I_AT_QKG);
    for (int row = gw; row < M; row += NGW) {
        const bool smp = row >= NPROMPT; const int sb = smp ? (row - NPROMPT) >> 10 : 0, t = smp ? (row - NPROMPT) & 1023 : 0;
        const float cs = smp ? F.rope[t * 32 + (F.lane & 31)] : 1.f, sn = smp ? F.rope[32768 + t * 32 + (F.lane & 31)] : 0.f;
        for (int grp = 0; grp < 32; ++grp) {
            const float v = bf2f(QKV[(size_t)row * 3072 + grp * 64 + F.lane]);
            const float ms = wave_sum(v * v) * (1.f / 64.f);
            float n = v * rsqrtf(ms + EPS) * qkg[(grp >> 4) * 64 + F.lane];
            const float keep = n;
            if (smp) { float pr; { auto r_ = __builtin_amdgcn_permlane32_swap(__builtin_bit_cast(unsigned, n), __builtin_bit_cast(unsigned, n), false, false); pr = __builtin_bit_cast(float, F.lane < 32 ? (unsigned)r_[1] : (unsigned)r_[0]); } n = F.lane < 32 ? n * cs - pr * sn : n * cs + pr * sn; }
            if (grp < 16) Q[(size_t)row * D + grp * 64 + F.lane] = (bf16)f2bf(n);
            else { const int c = (grp - 16) * 64 + F.lane;
                if (smp) F.KS[((size_t)sb * TKS + PAST + t) * D + c] = (bf16)f2bf(n);
                else { KP[(size_t)row * D + c] = (bf16)f2bf(keep); F.out[O_CK + (size_t)row * D + c] = keep; } }
        }
        for (int c = F.lane; c < D; c += 64) { const bf16 vb = QKV[(size_t)row * 3072 + 2048 + c];
            if (smp) F.VS[((size_t)sb * TKS + PAST + t) * D + c] = vb; else { VP[(size_t)row * D + c] = vb; F.out[O_CV + (size_t)row * D + c] = bf2f(vb); } }
    }
}
__device__ __forceinline__ void phase_attn_naive(Frame& F, int l, const bf16* Q, const bf16* KP, const bf16* VP, bf16* O) {
    F.fresh();
    const int gw = F.bid * NWAVES + F.wave, NGW = F.G * NWAVES;
    LAS float* s1 = (LAS float*)F.lds + F.wave * 3328; LAS float* s2 = s1 + 1536; LAS float* qs = s2 + 1536;
    const float* al = F.inp(I_AT_LAM);
    const float lam_init = 0.8f - 0.6f * expf(-0.3f * (float)l);
    const float lam = expf(wave_sum(al[F.lane] * al[64 + F.lane])) - expf(wave_sum(al[128 + F.lane] * al[192 + F.lane])) + lam_init;
    const float* sg = F.inp(I_AT_SUBG);
    for (int item = gw; item < M * 8; item += NGW) {
        const int row = item >> 3, h = item & 7;
        const bf16 *Kb, *Vb; int Tk;
        if (row < NPROMPT) { Kb = KP + (size_t)(row & ~255) * D; Vb = VP + (size_t)(row & ~255) * D; Tk = 256; }
        else { const int sb = (row - NPROMPT) >> 10; Kb = F.KS + (size_t)sb * TKS * D; Vb = F.VS + (size_t)sb * TKS * D; Tk = TKS; }
        qs[F.lane] = bf2f(Q[(size_t)row * D + h * 128 + F.lane]); qs[64 + F.lane] = bf2f(Q[(size_t)row * D + h * 128 + 64 + F.lane]);
        asm volatile("s_waitcnt lgkmcnt(0)" ::: "memory");
        float m1 = -1e30f, m2 = -1e30f;
        for (int k = F.lane; k < Tk; k += 64) { const bf16* kr = Kb + (size_t)k * D + h * 128; float d1 = 0.f, d2 = 0.f;
#pragma unroll 4
            for (int d = 0; d < 64; d += 2) { const unsigned a = *(const unsigned*)(kr + d), b = *(const unsigned*)(kr + 64 + d);
                d1 += qs[d] * bf2f(a) + qs[d + 1] * bf2f(a >> 16); d2 += qs[64 + d] * bf2f(b) + qs[64 + d + 1] * bf2f(b >> 16); }
            d1 *= 0.125f; d2 *= 0.125f; s1[k] = d1; s2[k] = d2; m1 = fmaxf(m1, d1); m2 = fmaxf(m2, d2); }
        m1 = wave_max(m1); m2 = wave_max(m2);
        float l1 = 0.f, l2 = 0.f;
        for (int k = F.lane; k < Tk; k += 64) { const float e1 = expf(s1[k] - m1), e2 = expf(s2[k] - m2); s1[k] = e1; s2[k] = e2; l1 += e1; l2 += e2; }
        l1 = wave_sum(l1); l2 = wave_sum(l2);
        const float i1 = 1.f / l1, i2 = lam / l2;
        for (int k = F.lane; k < Tk; k += 64) s1[k] = bf2f(f2bf(s1[k] * i1 - s2[k] * i2));
        asm volatile("s_waitcnt lgkmcnt(0)" ::: "memory");
        float o0 = 0.f, o1 = 0.f;
        for (int k = 0; k < Tk; ++k) { const unsigned vv = *(const unsigned*)(Vb + (size_t)k * D + h * 128 + 2 * F.lane); const float w = s1[k]; o0 += w * bf2f(vv); o1 += w * bf2f(vv >> 16); }
        const float ms = wave_sum(o0 * o0 + o1 * o1) * (1.f / 128.f), rs = rsqrtf(ms + EPS) * (1.f - lam_init);
        o0 = o0 * rs * sg[2 * F.lane]; o1 = o1 * rs * sg[2 * F.lane + 1];
        *(unsigned*)(O + (size_t)row * D + h * 128 + 2 * F.lane) = f2bf(o0) | (f2bf(o1) << 16);
        asm volatile("s_waitcnt lgkmcnt(0)" ::: "memory");
    }
}


constexpr int AT_KS = 272, AT_VS = 288, AT_KBYTES = 64 * AT_KS, AT_VBYTES = 64 * AT_VS, AT_BUF = AT_KBYTES + AT_VBYTES;
__device__ __forceinline__ void attn_unit(Frame& F, int l, const bf16* Qrows  , const bf16* Kb, const bf16* Vb, int Tk, bf16* Orows, int h, float lam, float lam_init) {
    const int tid = F.tid, lane = F.lane, wave = F.wave, c = lane & 15, q4 = lane >> 4;
    LAS unsigned char* lds = F.lds;
    const float SC = 0.18033688f;
    bf16x8 Qf[2][2];
#pragma unroll
    for (int cp = 0; cp < 2; ++cp)
#pragma unroll
        for (int ks = 0; ks < 2; ++ks) Qf[cp][ks] = *(const GAS bf16x8*)(Qrows + (size_t)(16 * wave + c) * D + h * 128 + cp * 64 + 32 * ks + 8 * q4);
    const int nt = Tk / 64;
    const int key0 = tid >> 4, cc0 = tid & 15;
    u32x4 kreg[2], vreg[2];
    float m1 = -1e30f, m2 = -1e30f, l1 = 0.f, l2 = 0.f;
#pragma unroll
    for (int i = 0; i < 2; ++i) kreg[i] = *(const GAS u32x4*)(Kb + (size_t)(key0 + 32 * i) * D + h * 128 + 8 * cc0);
#pragma unroll
    for (int i = 0; i < 2; ++i) *(LAS u32x4*)(lds + (key0 + 32 * i) * AT_KS + 16 * cc0) = kreg[i];
    __syncthreads();
    for (int t = 0; t < nt; ++t) {
        LAS const unsigned char* kt = lds + (t & 1) * AT_BUF;
        if (t + 1 < nt) {
#pragma unroll
            for (int i = 0; i < 2; ++i) kreg[i] = *(const GAS u32x4*)(Kb + (size_t)((t + 1) * 64 + key0 + 32 * i) * D + h * 128 + 8 * cc0); }
        f32x4 S[2][4];
#pragma unroll
        for (int cp = 0; cp < 2; ++cp)
#pragma unroll
            for (int mf = 0; mf < 4; ++mf) { S[cp][mf] = (f32x4){0.f, 0.f, 0.f, 0.f};
#pragma unroll
                for (int ks = 0; ks < 2; ++ks) { const bf16x8 kf = *(LAS const bf16x8*)(kt + (16 * mf + c) * AT_KS + cp * 128 + ks * 64 + 16 * q4);
                    S[cp][mf] = __builtin_amdgcn_mfma_f32_16x16x32_bf16(kf, Qf[cp][ks], S[cp][mf], 0, 0, 0); } }
        float x1 = -1e30f, x2 = -1e30f;
#pragma unroll
        for (int mf = 0; mf < 4; ++mf)
#pragma unroll
            for (int k = 0; k < 4; ++k) { x1 = fmaxf(x1, S[0][mf][k]); x2 = fmaxf(x2, S[1][mf][k]); }
        x1 = max_q4(x1); x2 = max_q4(x2);
        const float n1 = fmaxf(m1, x1), n2 = fmaxf(m2, x2);
        l1 *= exp2f((m1 - n1) * SC); l2 *= exp2f((m2 - n2) * SC); m1 = n1; m2 = n2;
#pragma unroll
        for (int mf = 0; mf < 4; ++mf)
#pragma unroll
            for (int k = 0; k < 4; ++k) { l1 += exp2f((S[0][mf][k] - m1) * SC); l2 += exp2f((S[1][mf][k] - m2) * SC); }
        if (t + 1 < nt) {
#pragma unroll
            for (int i = 0; i < 2; ++i) *(LAS u32x4*)(lds + ((t + 1) & 1) * AT_BUF + (key0 + 32 * i) * AT_KS + 16 * cc0) = kreg[i]; }
        __syncthreads();
    }
    l1 = sum_q4(l1); l2 = sum_q4(l2);
    const float i1 = 1.f / l1, i2 = lam / l2;
    f32x4 Ot[8];
#pragma unroll
    for (int md = 0; md < 8; ++md) Ot[md] = (f32x4){0.f, 0.f, 0.f, 0.f};
#pragma unroll
    for (int i = 0; i < 2; ++i) { kreg[i] = *(const GAS u32x4*)(Kb + (size_t)(key0 + 32 * i) * D + h * 128 + 8 * cc0); vreg[i] = *(const GAS u32x4*)(Vb + (size_t)(key0 + 32 * i) * D + h * 128 + 8 * cc0); }
#pragma unroll
    for (int i = 0; i < 2; ++i) { *(LAS u32x4*)(lds + (key0 + 32 * i) * AT_KS + 16 * cc0) = kreg[i]; *(LAS u32x4*)(lds + AT_KBYTES + (key0 + 32 * i) * AT_VS + 16 * cc0) = vreg[i]; }
    __syncthreads();
    for (int t = 0; t < nt; ++t) {
        LAS const unsigned char* kt = lds + (t & 1) * AT_BUF; LAS const unsigned char* vt = kt + AT_KBYTES;
        if (t + 1 < nt) {
#pragma unroll
            for (int i = 0; i < 2; ++i) { kreg[i] = *(const GAS u32x4*)(Kb + (size_t)((t + 1) * 64 + key0 + 32 * i) * D + h * 128 + 8 * cc0);
                                          vreg[i] = *(const GAS u32x4*)(Vb + (size_t)((t + 1) * 64 + key0 + 32 * i) * D + h * 128 + 8 * cc0); } }
        f32x4 S[2][4];
#pragma unroll
        for (int cp = 0; cp < 2; ++cp)
#pragma unroll
            for (int mf = 0; mf < 4; ++mf) { S[cp][mf] = (f32x4){0.f, 0.f, 0.f, 0.f};
#pragma unroll
                for (int ks = 0; ks < 2; ++ks) { const bf16x8 kf = *(LAS const bf16x8*)(kt + (16 * mf + c) * AT_KS + cp * 128 + ks * 64 + 16 * q4);
                    S[cp][mf] = __builtin_amdgcn_mfma_f32_16x16x32_bf16(kf, Qf[cp][ks], S[cp][mf], 0, 0, 0); } }
        bf16x8 Wf[2];
#pragma unroll
        for (int kk = 0; kk < 2; ++kk)
#pragma unroll
            for (int jj = 0; jj < 8; ++jj) { const int mf = 2 * kk + (jj >> 2), k = jj & 3;
                const float w = exp2f((S[0][mf][k] - m1) * SC) * i1 - exp2f((S[1][mf][k] - m2) * SC) * i2; Wf[kk][jj] = (short)f2bf(w); }
#pragma unroll
        for (int md = 0; md < 8; ++md)
#pragma unroll
            for (int kk = 0; kk < 2; ++kk) { LAS const unsigned char* vp = vt + (32 * kk + 4 * q4 + (c >> 2)) * AT_VS + (16 * md + 4 * (c & 3)) * 2;
                const v4i16_t lo = __builtin_amdgcn_ds_read_tr16_b64_v4i16((LAS v4i16_t*)vp), hi = __builtin_amdgcn_ds_read_tr16_b64_v4i16((LAS v4i16_t*)(vp + 16 * AT_VS));
                const bf16x8 vf = {lo[0], lo[1], lo[2], lo[3], hi[0], hi[1], hi[2], hi[3]};
                Ot[md] = __builtin_amdgcn_mfma_f32_16x16x32_bf16(vf, Wf[kk], Ot[md], 0, 0, 0); }
        if (t + 1 < nt) {
#pragma unroll
            for (int i = 0; i < 2; ++i) { *(LAS u32x4*)(lds + ((t + 1) & 1) * AT_BUF + (key0 + 32 * i) * AT_KS + 16 * cc0) = kreg[i];
                                          *(LAS u32x4*)(lds + ((t + 1) & 1) * AT_BUF + AT_KBYTES + (key0 + 32 * i) * AT_VS + 16 * cc0) = vreg[i]; } }
        __syncthreads();
    }
    float ss = 0.f;
#pragma unroll
    for (int md = 0; md < 8; ++md)
#pragma unroll
        for (int k = 0; k < 4; ++k) ss += Ot[md][k] * Ot[md][k];
    ss = sum_q4(ss);
    const float rs = rsqrtf(ss * (1.f / 128.f) + EPS) * (1.f - lam_init);
    const float* sg = F.inp(I_AT_SUBG);
#pragma unroll
    for (int md = 0; md < 8; ++md) { const int d0 = 16 * md + 4 * q4; const f32x4 g4 = *(const GAS f32x4*)(sg + d0);
        u32x2 w; w.x = f2bf(Ot[md][0] * rs * g4.x) | (f2bf(Ot[md][1] * rs * g4.y) << 16); w.y = f2bf(Ot[md][2] * rs * g4.z) | (f2bf(Ot[md][3] * rs * g4.w) << 16);
        *(GAS u32x2*)(Orows + (size_t)(16 * wave + c) * D + h * 128 + d0) = w; }
}
__device__ __forceinline__ void phase_attn(Frame& F, int l, const bf16* Q, const bf16* KP, const bf16* VP, bf16* O) {
    F.fresh();
    const float* al = F.inp(I_AT_LAM);
    const float lam_init = 0.8f - 0.6f * expf(-0.3f * (float)l);
    const float lam = expf(wave_sum(al[F.lane] * al[64 + F.lane])) - expf(wave_sum(al[128 + F.lane] * al[192 + F.lane])) + lam_init;
    for (int s = 0; ; ++s) {
        int u;
        if (F.G == 256) { if (F.bid < 128) { if (s > 0) break; u = F.bid; } else { if (s > 3) break; u = 128 + 4 * (F.bid - 128) + s; } }
        else { u = F.bid + s * F.G; if (u >= 640) break; }
        if (u < 128) { const int sb = u >> 6, h = (u >> 3) & 7, qt = u & 7; const size_t r0 = (size_t)NPROMPT + sb * 1024 + qt * 128;
            attn_unit(F, l, Q + r0 * D, F.KS + (size_t)sb * TKS * D, F.VS + (size_t)sb * TKS * D, TKS, O + r0 * D, h, lam, lam_init); }
        else { const int v = u - 128, b = v >> 4, h = (v >> 1) & 7, qt = v & 1; const size_t r0 = (size_t)b * 256 + qt * 128;
            attn_unit(F, l, Q + r0 * D, KP + (size_t)b * 256 * D, VP + (size_t)b * 256 * D, 256, O + r0 * D, h, lam, lam_init); }
    }
}

__device__ __forceinline__ void phase_ffn_convgate(Frame& F, int l, const bf16* Z, bf16* ACT) {
    F.fresh();
    const float* cw = F.inp(I_FF_CW) + (size_t)l * 3 * 2 * DFF; const float* cb = F.inp(I_FF_CB) + (size_t)l * 2 * DFF;
    const int gt = F.bid * NT + F.tid, GT = F.G * NT;
    for (int i = gt; i < M * DFF; i += GT) { const int row = i / DFF, j = i % DFF;
        int t, T; if (row < NPROMPT) { t = row & 255; T = 256; } else { t = (row - NPROMPT) & 1023; T = 1024; }
        float g = cb[j], u = cb[DFF + j];
#pragma unroll
        for (int k = 0; k < 3; ++k) { const int tt = t + k - 1; if (tt >= 0 && tt < T) { const bf16* zr = Z + (size_t)(row + k - 1) * 2 * DFF; g += cw[k * 2 * DFF + j] * bf2f(zr[j]); u += cw[k * 2 * DFF + DFF + j] * bf2f(zr[DFF + j]); } }
        ACT[i] = (bf16)f2bf(siluf_(g) * u); }
}

__global__ void __launch_bounds__(NT, 2) mk_fwd(Params prm) {
    extern __shared__ __attribute__((aligned(16))) unsigned char lds_raw[];
    Frame F;
    F.lds = (LAS unsigned char*)lds_raw; F.G = gridDim.x; F.out0 = prm.out; F.ws0 = prm.ws; F.wave0 = __builtin_amdgcn_readfirstlane(threadIdx.x >> 6);
    F.fresh();
    if (F.tid < N_IN) ((LAS unsigned long long*)(F.lds + PTR_OFF))[F.tid] = (unsigned long long)prm.in[F.tid];
    volatile LAS unsigned* MISC = (volatile LAS unsigned*)(F.lds + MISC_OFF);
    if (F.tid < 32) MISC[F.tid] = 0u;
    __syncthreads();
    (void)xcd_barrier_post((unsigned*)(prm.ws + WS_CTL) + CW_BAR, MISC + 8, F.tid == 0);
#define GRID_BAR() do { F.fresh(); XcdBarrier bar_; bar_.t0 = F.tid == 0; { unsigned* bp_ = (unsigned*)(prm.ws + WS_CTL) + CW_BAR; asm volatile("" : "+s"(bp_)); bar_.bar = bp_; } bar_.x = xb_xcc_id(); bar_.st = (volatile LAS unsigned*)(F.lds + MISC_OFF) + 8; xcd_barrier(bar_); } while (0)

#define GEMM_BF16(ACT, A_, Bt_, N_, K_, O_, ldc_, bias_, splitc_, splits_, rsq_, b2_, rsqv_, vt0_) do { pg8::Gemm g{A_, Bt_, M, N_, K_}; pg8::StaticOrder S; S.init(M, N_, F.G, F.bid); S.wave = F.wave; \
        pg8::EpiBf16<ACT> E{O_, ldc_, bias_, splitc_, splits_, rsq_, b2_, N_, rsqv_, vt0_, F.lds}; F.fresh(); E.prep(S, F.tid); pg8::gemm_phase<pg8::EpiBf16<ACT>, pg8::StaticOrder, true, true>(F.lds, g, S, E); } while (0)
#define GEMM_RESID(A_, Bt_, K_, sub_, fromin_) do { pg8::Gemm g{A_, Bt_, M, D, K_}; pg8::StaticOrder S; S.init(M, D, F.G, F.bid); S.wave = F.wave; \
        const int nl_ = (sub_) == 0 ? l : l + 1, ns_ = (sub_) == 0 ? 1 : 0; const bool last_ = nl_ >= DEPTH; \
        pg8::EpiResid E{F.out, F.inp(I_XP), F.inp(I_XS), F.mod + (size_t)l * 18 * D, (sub_) * 3 + 2, fromin_, last_ ? nullptr : F.H, F.inp(I_NORMG) + (size_t)((last_ ? 0 : nl_) * 2 + ns_) * D, \
                          F.mod + (size_t)(last_ ? 0 : nl_) * 18 * D, ns_ * 3 + 1, (sub_) == 0 ? F.rsq1 : F.rsq0, F.lds}; \
        F.fresh(); E.prep(S, F.tid); pg8::gemm_phase<pg8::EpiResid, pg8::StaticOrder, true, true>(F.lds, g, S, E); side_job(F, 2 * l + (sub_) + 1); } while (0)

    phase_prologue(F);
    GRID_BAR();
    phase_modulate0(F);
    GRID_BAR();
#pragma unroll 1
    for (int l = 0; l < DEPTH; ++l) {
        const int kind = l % 3, j = l / 3;
        F.fresh();
        if (kind == 0) {
            bf16 *GB = F.T2, *REC = F.T2 + (size_t)M * DRNN, *PF = F.T3, *PB = F.T3 + (size_t)NSAMPLE * DRNN, *HS = F.T3 + (size_t)6 * 1024 * 1024;
            float* AGG = (float*)(F.T3 + (size_t)2 * NSAMPLE * DRNN);
            GEMM_BF16(2, F.H, F.WT + WE_LRU_IN + (size_t)j * 2 * DRNN * D, 2 * DRNN, D, GB, DRNN, nullptr, DRNN, (size_t)M * DRNN, F.rsq0, F.bias2 + B2_LRU + (size_t)j * 3 * 2560, nullptr, 0);
            GRID_BAR();
            phase_lru_core(F, j, REC, GB, HS, PF, PB, AGG, F.WT + WE_WG + (size_t)j * 40 * 128 * 128);
            GRID_BAR();
            phase_lru_fixup(F, GB, HS, PF, PB, AGG);
            GRID_BAR();
            GEMM_RESID(HS, F.WT + WE_LRU_OUT + (size_t)j * D * DRNN, DRNN, 0, l == 0);
        } else if (kind == 1) {
            bf16 *UV = F.T1, *ACT = F.T2;
            GEMM_BF16(1, F.H, F.WT + WE_CM_IN, 2 * DB, D, UV, 2 * DB, F.inp(I_CM_BIN), 0, 0, F.rsq0, F.bias2 + B2_CM, F.rsqv, 8);
            GRID_BAR();
            phase_cmlp_spatial_mfma(F, UV, ACT, F.WT + WE_WSB);
            GRID_BAR();
            GEMM_RESID(ACT, F.WT + WE_CM_OUT, DB, 0, false);
        } else {
            bf16 *Q = F.T2, *KP = F.T2 + (size_t)M * D, *VP = KP + (size_t)NPROMPT * D, *O = F.T3;
            { pg8::Gemm g{F.H, F.WT + WE_QKV, M, 3 * D, D}; pg8::StaticOrder S; S.init(M, 3 * D, F.G, F.bid); S.wave = F.wave;
              pg8::EpiQkv E{F.ws, F.out, F.rsq0, F.bias2 + B2_QKV, F.lds, F.inp(I_AT_QKG), F.rope};
              F.fresh(); E.prep(S, F.tid); pg8::gemm_phase<pg8::EpiQkv, pg8::StaticOrder, true, true>(F.lds, g, S, E); }
            GRID_BAR();
            phase_attn(F, l, Q, KP, VP, O);
            GRID_BAR();
            GEMM_RESID(O, F.WT + WE_AT_OUT, D, 0, false);
        }
        GRID_BAR();
        { pg8::Gemm g{F.H, F.WT + WE_UP + (size_t)l * 2 * DFF * D, 42 * 256, 2 * DFF, D}; pg8::FfnOrder S; S.init(42 * 256, 2 * DFF, F.G, F.bid); S.wave = F.wave;
          pg8::EpiFfn E{F.T2, F.inp(I_FF_CW) + (size_t)l * 3 * 2 * DFF, F.inp(I_FF_CB) + (size_t)l * 2 * DFF, F.rsq1, F.bias2 + B2_UP + (size_t)l * 3 * 5632, F.lds};
          F.fresh(); E.prep(S, F.tid); pg8::gemm_phase<pg8::EpiFfn, pg8::FfnOrder, true, true>(F.lds, g, S, E); }
        GRID_BAR();
        GEMM_RESID(F.T2, F.WT + WE_DN + (size_t)l * D * DFF, DFF, 1, false);
        GRID_BAR();
    }
}

extern "C" void kernel_launch(void* const* d_in, const int* in_sizes, int n_in, void* d_out, int out_size, void* d_ws, size_t ws_size, hipStream_t stream) {
    static int grid = 0;
    if (grid == 0) {
        if (n_in != N_IN || ws_size < WS_END) { fprintf(stderr, "kernel_launch: unexpected n_in %d or ws_size %zu\n", n_in, ws_size); grid = -1; return; }
        int dev = 0, cus = 0, per_cu = 0;
        hipGetDevice(&dev); hipDeviceGetAttribute(&cus, hipDeviceAttributeMultiprocessorCount, dev);
        hipFuncSetAttribute((const void*)mk_fwd, hipFuncAttributeMaxDynamicSharedMemorySize, LDS_BYTES);
        hipOccupancyMaxActiveBlocksPerMultiprocessor(&per_cu, (const void*)mk_fwd, NT, LDS_BYTES);
        (void)hipGetLastError();
        if (per_cu < 1) { fprintf(stderr, "kernel_launch: occupancy query says %d blocks per CU\n", per_cu); per_cu = 1; }
        grid = cus;
    }
    if (grid < 0) return;
    hipMemsetAsync((char*)d_ws + WS_CTL, 0, CTL_ZERO_BYTES, stream);
    Params p{};
    for (int i = 0; i < N_IN; ++i) p.in[i] = (const float*)d_in[i];
    p.out = (float*)d_out; p.ws = (unsigned char*)d_ws;
    void* args[] = {&p};
    hipError_t e = hipLaunchCooperativeKernel((const void*)mk_fwd, dim3(grid), dim3(NT), args, LDS_BYTES, stream);
    if (e != hipSuccess) fprintf(stderr, "kernel_launch: cooperative launch failed: %s (grid %d)\n", hipGetErrorString(e), grid);
}
```

```cpp
#include <hip/hip_runtime.h>
#include <cstdio>
#include <cstdint>

#define GAS __attribute__((address_space(1)))
#define LAS __attribute__((address_space(3)))
typedef unsigned short bf16;
typedef float f32x4 __attribute__((ext_vector_type(4)));
typedef unsigned u32x2 __attribute__((ext_vector_type(2)));
typedef unsigned u32x4 __attribute__((ext_vector_type(4)));

constexpr int D = 1024, NPROMPT = 32 * 256, NSAMPLE = 2 * 1024, M = NPROMPT + NSAMPLE;
constexpr int DEPTH = 4, DRNN = 1280, DB = 2048, DFF = 2816, PAST = 512, TKS = PAST + 1024;
constexpr float EPS = 1e-6f;
constexpr int NWAVES = 8, NT = NWAVES * 64;

enum { I_XP = 0, I_XS, I_STATE, I_CK, I_CV, I_C, I_CCTX, I_WMOD, I_BMOD, I_NORMG, I_LRU_WIN, I_LRU_CW, I_LRU_CB, I_LRU_WG, I_LRU_BG, I_LRU_LAM, I_LRU_WOUT,
       I_CM_WIN, I_CM_BIN, I_CM_NG, I_CM_WS, I_CM_BS, I_CM_WOUT, I_AT_WQKV, I_AT_QKG, I_AT_LAM, I_AT_SUBG, I_AT_WOUT, I_FF_WUP, I_FF_CW, I_FF_CB, I_FF_WDN, N_IN };
constexpr size_t O_YP = 0, O_YS = (size_t)NPROMPT * D, O_STATE = (size_t)M * D, O_CK = O_STATE + 32 * 2 * 2 * DRNN, O_CV = O_CK + (size_t)NPROMPT * D;

constexpr size_t MiB = 1u << 20;
constexpr size_t WS_CTL = 0, CTL_ZERO_BYTES = 64 * 1024;
constexpr size_t WS_MOD = 1 * MiB;
constexpr size_t WS_RSTD = WS_MOD + 512 * 1024;
constexpr size_t WS_ROPE = WS_RSTD + 256 * 1024;
constexpr size_t WS_H = 2 * MiB;
constexpr size_t WS_T1 = 22 * MiB;
constexpr size_t WS_T2 = 132 * MiB;
constexpr size_t WS_T3 = 187 * MiB;
constexpr size_t WS_X = WS_T3 + 40 * MiB;
constexpr size_t B2_LRU = 0, B2_CM = B2_LRU + (size_t)2 * 3 * 2560, B2_QKV = B2_CM + (size_t)3 * 4096, B2_UP = B2_QKV + (size_t)3 * 3072, B2_END = B2_UP + (size_t)4 * 3 * 5632;
constexpr size_t WS_KS = 237 * MiB, WS_VS = 243 * MiB;
constexpr size_t WS_W = 249 * MiB;
constexpr size_t WE_LRU_IN = 0, WE_LRU_OUT = WE_LRU_IN + (size_t)2 * 2560 * 1024, WE_CM_IN = WE_LRU_OUT + (size_t)2 * 1024 * 1280, WE_CM_OUT = WE_CM_IN + (size_t)4096 * 1024,
                 WE_QKV = WE_CM_OUT + (size_t)1024 * 2048, WE_AT_OUT = WE_QKV + (size_t)3072 * 1024, WE_UP = WE_AT_OUT + (size_t)1024 * 1024, WE_DN = WE_UP + (size_t)4 * 5632 * 1024,
                 WE_WG = WE_DN + (size_t)4 * 1024 * 2816, WE_WSB = WE_WG + (size_t)80 * 128 * 128, WE_END = WE_WSB + (size_t)8 * 128 * 128;
constexpr size_t WS_END = WS_W + 106 * MiB;
static_assert(WE_END * 2 <= 106 * MiB, "weight copies fit");
constexpr int CW_BAR = 1024;

constexpr int LDS_BYTES = 163840;
constexpr int MISC_OFF = LDS_BYTES - 256, PTR_OFF = LDS_BYTES - 1024;

__device__ __forceinline__ unsigned f2bf(float f) { unsigned u = __builtin_bit_cast(unsigned, f); return (u + 0x7fffu + ((u >> 16) & 1u)) >> 16; }
__device__ __forceinline__ float bf2f(unsigned b) { return __builtin_bit_cast(float, (b & 0xffffu) << 16); }
template <int CTRL> __device__ __forceinline__ float dppf(float v) { return __builtin_bit_cast(float, __builtin_amdgcn_update_dpp(0, __builtin_bit_cast(int, v), CTRL, 0xf, 0xf, false)); }
__device__ __forceinline__ float swz_xor16(float v) { return __builtin_bit_cast(float, __builtin_amdgcn_ds_swizzle(__builtin_bit_cast(int, v), 0x401F)); }
__device__ __forceinline__ float sum_x32(float v) { auto r = __builtin_amdgcn_permlane32_swap(__builtin_bit_cast(unsigned, v), __builtin_bit_cast(unsigned, v), false, false);
    return __builtin_bit_cast(float, (unsigned)r[0]) + __builtin_bit_cast(float, (unsigned)r[1]); }
__device__ __forceinline__ float max_x32(float v) { auto r = __builtin_amdgcn_permlane32_swap(__builtin_bit_cast(unsigned, v), __builtin_bit_cast(unsigned, v), false, false);
    return fmaxf(__builtin_bit_cast(float, (unsigned)r[0]), __builtin_bit_cast(float, (unsigned)r[1])); }
__device__ __forceinline__ float sum_q4(float v) { v += swz_xor16(v); return sum_x32(v); }
__device__ __forceinline__ float max_q4(float v) { v = fmaxf(v, swz_xor16(v)); return max_x32(v); }
__device__ __forceinline__ float wave_sum(float v) { v += dppf<0xB1>(v); v += dppf<0x4E>(v); v += dppf<0x141>(v); v += dppf<0x140>(v); return sum_q4(v); }
__device__ __forceinline__ float wave_max(float v) { v = fmaxf(v, dppf<0xB1>(v)); v = fmaxf(v, dppf<0x4E>(v)); v = fmaxf(v, dppf<0x141>(v)); v = fmaxf(v, dppf<0x140>(v)); return max_q4(v); }
__device__ __forceinline__ float bperm(float v, int src_lane) { return __builtin_bit_cast(float, __builtin_amdgcn_ds_bpermute(src_lane << 2, __builtin_bit_cast(int, v))); }
__device__ __forceinline__ float gelu_tanh(float x) { const float y2 = 2.302208198f * (x + 0.044715f * x * x * x);
    const float t = 1.f - 2.f * __builtin_amdgcn_rcpf(__builtin_amdgcn_exp2f(y2) + 1.f); return 0.5f * x * (1.f + t); }
__device__ __forceinline__ float sigmoidf_(float x) { return __builtin_amdgcn_rcpf(1.f + __builtin_amdgcn_exp2f(-1.44269504f * x)); }
__device__ __forceinline__ float siluf_(float x) { return x * __builtin_amdgcn_rcpf(1.f + __builtin_amdgcn_exp2f(-1.44269504f * x)); }
__device__ __forceinline__ float softplusf_(float x) { return fmaxf(x, 0.f) + log1pf(expf(-fabsf(x))); }

#define XB_TMO      128
#define XB_XCNT(j)  (256  + 64 * (j))
#define XB_XSUB(j)  (1280 + 64 * (j))
#define XB_XGEN(j)  (2304 + 64 * (j))
#define XB_TOP      3328
#define XB_TOPGEN   3392
#define XCD_BAR_WORDS 3456
#define XB_SPIN_CAP (1u << 22)
__device__ __forceinline__ unsigned xb_ld(unsigned* p)              { return __hip_atomic_load(p, __ATOMIC_RELAXED, __HIP_MEMORY_SCOPE_AGENT); }
__device__ __forceinline__ unsigned xb_add(unsigned* p, unsigned v) { return __hip_atomic_fetch_add(p, v, __ATOMIC_RELAXED, __HIP_MEMORY_SCOPE_AGENT); }
__device__ __forceinline__ unsigned xb_xcc_id() { return (unsigned)__builtin_amdgcn_s_getreg((3 << 11) | 20) & 0xFu; }
#define XB_SPIN(cond, bar) do { unsigned _sp = 0; while (cond) { __builtin_amdgcn_s_sleep(1); \
    if ((++_sp & 255u) == 0u) { if (xb_ld(&(bar)[XB_TMO])) break; if (_sp > XB_SPIN_CAP) { atomicAdd(&(bar)[XB_TMO], 1u); break; } } } } while (0)
struct XcdBarrier { unsigned* bar; unsigned x; volatile LAS unsigned* st; bool t0; };
__device__ __forceinline__ XcdBarrier xcd_barrier_post(unsigned* bar, volatile LAS unsigned* st, bool t0) {
    XcdBarrier b; b.bar = bar; b.x = xb_xcc_id(); b.st = st; b.t0 = t0;
    if (t0) (void)xb_add(&bar[XB_XCNT(b.x)], 1u);
    return b;
}
__device__ __forceinline__ void xcd_barrier_complete(unsigned* bar, unsigned x, unsigned& nloc, unsigned& nx) {
    const unsigned G = gridDim.x * gridDim.y * gridDim.z;
    unsigned sum, cnt, mine, sp = 0u;
    for (;;) {
        sum = 0u; cnt = 0u; mine = 0u;
#pragma unroll
        for (unsigned j = 0; j < 16; ++j) { const unsigned c = xb_ld(&bar[XB_XCNT(j)]); sum += c; cnt += (c > 0u) ? 1u : 0u; mine = (j == x) ? c : mine; }
        if (sum == G) break;
        __builtin_amdgcn_s_sleep(1);
        if ((++sp & 255u) == 0u) { if (xb_ld(&bar[XB_TMO])) break; if (sp > XB_SPIN_CAP) { atomicAdd(&bar[XB_TMO], 1u); break; } }
    }
    nloc = mine > 0u ? mine : 1u; nx = cnt > 0u ? cnt : 1u;
}
__device__ __forceinline__ void xcd_barrier(const XcdBarrier& b) {
    asm volatile("s_waitcnt vmcnt(0)" ::: "memory");
    __syncthreads();
    if (b.t0) {
        unsigned* bar = b.bar;
        __builtin_amdgcn_s_waitcnt(0);
        unsigned nloc = b.st[0], nx = b.st[1];
        if (nloc == 0u) { xcd_barrier_complete(bar, b.x, nloc, nx); b.st[0] = nloc; b.st[1] = nx; }
        const unsigned old = xb_add(&bar[XB_XSUB(b.x)], 1u);
        const unsigned gen = old / nloc;
        if (old + 1u == (gen + 1u) * nloc) {
            __builtin_amdgcn_fence(__ATOMIC_RELEASE, "agent");
            asm volatile("s_waitcnt vmcnt(0)" ::: "memory");
            const unsigned og = xb_add(&bar[XB_TOP], 1u);
            const unsigned tg = og / nx;
            if (og + 1u == (tg + 1u) * nx) xb_add(&bar[XB_TOPGEN], 1u);
            else XB_SPIN(xb_ld(&bar[XB_TOPGEN]) == tg, bar);
            __builtin_amdgcn_fence(__ATOMIC_ACQUIRE, "agent");
            xb_add(&bar[XB_XGEN(b.x)], 1u);
            asm volatile("s_waitcnt vmcnt(0)" ::: "memory");
        } else {
            XB_SPIN(xb_ld(&bar[XB_XGEN(b.x)]) == gen, bar);
            __builtin_amdgcn_fence(__ATOMIC_ACQUIRE, "agent");
            asm volatile("s_waitcnt vmcnt(0)" ::: "memory");
        }
    }
    __syncthreads();
}

namespace pg8 {
#define PG8_LAS __attribute__((address_space(3)))
typedef unsigned short bf16_t;
typedef short bf16x8 __attribute__((ext_vector_type(8)));
typedef float f32x4 __attribute__((ext_vector_type(4)));
typedef unsigned u32x4 __attribute__((ext_vector_type(4)));
constexpr int BM = 256, BK = 64, HALF = 128, HTB = HALF * BK * 2  , STAGE_BYTES = 8 * HTB, NXCD = 8, WGM = 8;

__host__ __device__ __forceinline__ int lds_byte(int r, int c) { const int st = (r >> 4) * 2 + (c >> 5), rr = r & 15, cc = c & 31, ob = rr * 64 + cc * 2; return st * 1024 + (ob ^ (((ob >> 9) & 1) << 5)); }
__host__ __device__ __forceinline__ void stage_rc(int b, int& R, int& C) { const int st = b / 1024, sb = b % 1024, swz = sb ^ (((sb >> 9) & 1) << 5); R = (st >> 1) * 16 + swz / 64; C = (st & 1) * 32 + (swz % 64) / 2; }
__host__ __device__ __forceinline__ int perm32(int rho) { const int n = rho >> 4, i = rho & 15; return 8 * (i >> 2) + 4 * n + (i & 3); }

struct Unit { int pm, pn; };
struct Gemm { const bf16_t* A; const bf16_t* Bt; int M, N, K; };

struct StaticOrder {
    int nM, nN, nwg, G, c, wave;
    __host__ __device__ void init(int M, int N, int G_, int c_) { nM = M / BM; nN = N / BM; nwg = nM * nN; G = G_; c = c_; }
    __host__ __device__ bool next(int i, Unit& u) const {
        const long L = (long)i * G + c; if (L >= nwg) return false;
        int wgid = (int)L; { const int q = nwg / NXCD, r = nwg % NXCD, xcd = wgid % NXCD, off = wgid / NXCD; wgid = (xcd < r ? xcd * (q + 1) : r * (q + 1) + (xcd - r) * q) + off; }
        const int nig = WGM * nN, gid = wgid / nig, fm = gid * WGM, gsz = (nM - fm) < WGM ? (nM - fm) : WGM;
        u.pm = fm + ((wgid % nig) % gsz); u.pn = (wgid % nig) / gsz; return true;
    }
    __device__ __forceinline__ int arow(int pm) const { return pm * BM; }
    __device__ __forceinline__ void a_ready(const Unit&) const {}
    __device__ __forceinline__ void done(const Unit&) const {}
};

template <class Epi, class Sched, bool ALIGN_EPI = false, bool SP2 = false>
__device__ __forceinline__ void gemm_phase(PG8_LAS unsigned char* lds, const Gemm g, const Sched& S, const Epi& E) {
    int z_ = 0; asm volatile("" : "+v"(z_));
    const int lane = __builtin_amdgcn_mbcnt_hi(~0u, __builtin_amdgcn_mbcnt_lo(~0u, z_)), wid = S.wave, tid = wid * 64 + lane, wr = wid >> 2, wc = wid & 3, fr = lane & 15, fq = lane >> 4;
    const int K = g.K, nt = K / BK;
    unsigned voffA[2], voffB[2];
#pragma unroll
    for (int i = 0; i < 2; ++i) { int R, C; stage_rc(tid * 16 + i * 8192, R, C); const int Rb = Epi::PERM ? ((R & ~31) + perm32(R & 31)) : R;
        voffA[i] = (unsigned)(R * K + C) * 2u; voffB[i] = (unsigned)(Rb * K + C) * 2u; }
    const size_t kstep = (size_t)(BK * 2);
    const size_t hstep = (size_t)HALF * K * 2;
    const size_t tstep = 2 * hstep;
    const unsigned ldsw = (unsigned)wid * 1024u;
    const int aoff = lds_byte(wr * 64 + fr, fq * 8), boff = lds_byte(wc * 32 + fr, fq * 8);
#define PG8_SA(b, h) (((b) * 2 + (h)) * HTB)
#define PG8_SB(b, h) ((4 + (b) * 2 + (h)) * HTB)
#define PG8_STAGE(bufoff, gbase, voff) do { _Pragma("unroll") for (int _i = 0; _i < 2; ++_i) \
        __builtin_amdgcn_global_load_lds((const unsigned*)((const char*)(gbase) + (voff)[_i]), (PG8_LAS unsigned*)(lds + (bufoff) + ldsw + _i * 8192), 16, 0, 0); } while (0)
#define PG8_LDA(dst, b, h) do { _Pragma("unroll") for (int m = 0; m < 4; ++m) _Pragma("unroll") for (int k = 0; k < 2; ++k) dst[m][k] = *(const PG8_LAS bf16x8*)(lds + PG8_SA(b, h) + aoff + m * 2048 + k * 1024); } while (0)
#define PG8_LDB(dst, b, h) do { _Pragma("unroll") for (int n = 0; n < 2; ++n) _Pragma("unroll") for (int k = 0; k < 2; ++k) dst[n][k] = *(const PG8_LAS bf16x8*)(lds + PG8_SB(b, h) + boff + n * 2048 + k * 1024); } while (0)
#define PG8_MMA(ai, bj, At, Bt) do { __builtin_amdgcn_s_setprio(1); _Pragma("unroll") for (int m = 0; m < 4; ++m) _Pragma("unroll") for (int n = 0; n < 2; ++n) _Pragma("unroll") for (int k = 0; k < 2; ++k) \
        acc[ai][bj][m][n] = __builtin_amdgcn_mfma_f32_16x16x32_bf16(Bt[n][k], At[m][k], acc[ai][bj][m][n], 0, 0, 0); __builtin_amdgcn_s_setprio(0); } while (0)
#define PG8_WAIT_V(n) asm volatile("s_waitcnt vmcnt(" #n ")" ::: "memory")
#define PG8_WAIT_L(n) asm volatile("s_waitcnt lgkmcnt(" #n ")" ::: "memory")
#define PG8_BAR __builtin_amdgcn_s_barrier()
#define PG8_SCHED __builtin_amdgcn_sched_barrier(0)
    Unit cur, nxt; int ui = 0;
    if (!S.next(0, cur)) return;
    f32x4 acc[2][2][4][2];
#pragma unroll
    for (int a = 0; a < 2; ++a)
#pragma unroll
        for (int b = 0; b < 2; ++b)
#pragma unroll
            for (int m = 0; m < 4; ++m)
#pragma unroll
                for (int n = 0; n < 2; ++n) acc[a][b][m][n] = (f32x4){0.f, 0.f, 0.f, 0.f};
    bf16x8 At[4][2], B0[2][2], B1[2][2];
    const char* cA = (const char*)g.A + (size_t)S.arow(cur.pm) * (size_t)K * 2; const char* cB = (const char*)g.Bt + (size_t)cur.pn * tstep;
    S.a_ready(cur);
    if constexpr (SP2) {
        PG8_STAGE(PG8_SB(0, 0), cB, voffB); PG8_STAGE(PG8_SB(0, 1), cB + hstep, voffB); PG8_STAGE(PG8_SA(0, 0), cA, voffA); PG8_STAGE(PG8_SA(0, 1), cA + hstep, voffA);
        if (wr == 1) PG8_BAR;
        PG8_WAIT_V(2); PG8_BAR;
        PG8_STAGE(PG8_SB(1, 0), cB + kstep, voffB); PG8_STAGE(PG8_SA(1, 0), cA + kstep, voffA); PG8_STAGE(PG8_SB(1, 1), cB + hstep + kstep, voffB);
        PG8_WAIT_V(6); PG8_BAR;
    } else {
        PG8_STAGE(PG8_SB(0, 0), cB, voffB); PG8_STAGE(PG8_SA(0, 0), cA, voffA); PG8_STAGE(PG8_SB(0, 1), cB + hstep, voffB); PG8_STAGE(PG8_SA(0, 1), cA + hstep, voffA);
        if (wr == 1) PG8_BAR;
        PG8_WAIT_V(4); PG8_BAR;
        PG8_STAGE(PG8_SB(1, 0), cB + kstep, voffB); PG8_STAGE(PG8_SA(1, 0), cA + kstep, voffA); PG8_STAGE(PG8_SB(1, 1), cB + hstep + kstep, voffB);
        PG8_WAIT_V(6); PG8_BAR;
    }
    for (;;) {
        const bool has_next = S.next(ui + 1, nxt);
        const char* nA = has_next ? (const char*)g.A + (size_t)S.arow(nxt.pm) * (size_t)K * 2 : cA; const char* nB = has_next ? (const char*)g.Bt + (size_t)nxt.pn * tstep : cB;
        for (int t = 0; t < nt; t += 2) {
            const bool last = (t == nt - 2);
            const char* a1 = cA + (size_t)(t + 1) * kstep;
            const char* a2 = last ? nA : cA + (size_t)(t + 2) * kstep; const char* b2 = last ? nB : cB + (size_t)(t + 2) * kstep;
            const char* a3 = a2 + kstep; const char* b3 = b2 + kstep;
            if (last && has_next) S.a_ready(nxt);
            if constexpr (SP2) {
            PG8_LDB(B0, 0, 0); PG8_LDB(B1, 0, 1); PG8_SCHED; PG8_LDA(At, 0, 0); PG8_STAGE(PG8_SA(1, 1), a1 + hstep, voffA);
            PG8_WAIT_V(8); PG8_WAIT_L(0); PG8_BAR; PG8_MMA(0, 0, At, B0); PG8_MMA(0, 1, At, B1); PG8_BAR; PG8_SCHED;
            PG8_LDA(At, 0, 1); PG8_STAGE(PG8_SB(0, 0), b2, voffB); PG8_STAGE(PG8_SB(0, 1), b2 + hstep, voffB); PG8_STAGE(PG8_SA(0, 0), a2, voffA);
            PG8_WAIT_V(8); PG8_WAIT_L(0); PG8_BAR; PG8_MMA(1, 0, At, B0); PG8_MMA(1, 1, At, B1); PG8_BAR; PG8_SCHED;
            PG8_LDB(B0, 1, 0); PG8_LDB(B1, 1, 1); PG8_SCHED; PG8_LDA(At, 1, 0); PG8_STAGE(PG8_SA(0, 1), a2 + hstep, voffA);
            PG8_WAIT_V(8); PG8_WAIT_L(0); PG8_BAR; PG8_MMA(0, 0, At, B0); PG8_MMA(0, 1, At, B1); PG8_BAR; PG8_SCHED;
            PG8_LDA(At, 1, 1); PG8_STAGE(PG8_SB(1, 0), b3, voffB); PG8_STAGE(PG8_SB(1, 1), b3 + hstep, voffB); PG8_STAGE(PG8_SA(1, 0), a3, voffA);
            PG8_WAIT_V(8); PG8_WAIT_L(0); PG8_BAR; PG8_MMA(1, 0, At, B0); PG8_MMA(1, 1, At, B1); PG8_BAR; PG8_SCHED;
            } else {
            PG8_LDB(B0, 0, 0); PG8_SCHED; PG8_LDA(At, 0, 0); PG8_STAGE(PG8_SA(1, 1), a1 + hstep, voffA);
            PG8_WAIT_L(8); PG8_BAR; PG8_WAIT_L(0); PG8_MMA(0, 0, At, B0); PG8_BAR; PG8_SCHED;
            PG8_LDB(B1, 0, 1); PG8_STAGE(PG8_SB(0, 0), b2, voffB);
            PG8_BAR; PG8_WAIT_L(0); PG8_MMA(0, 1, At, B1); PG8_BAR;
            PG8_LDA(At, 0, 1); PG8_STAGE(PG8_SA(0, 0), a2, voffA);
            PG8_BAR; PG8_WAIT_L(0); PG8_MMA(1, 0, At, B0); PG8_BAR; PG8_SCHED;
            PG8_STAGE(PG8_SB(0, 1), b2 + hstep, voffB);
            PG8_WAIT_V(6); PG8_BAR; PG8_MMA(1, 1, At, B1); PG8_BAR;
            PG8_LDB(B0, 1, 0); PG8_SCHED; PG8_LDA(At, 1, 0); PG8_STAGE(PG8_SA(0, 1), a2 + hstep, voffA);
            PG8_WAIT_L(8); PG8_BAR; PG8_WAIT_L(0); PG8_MMA(0, 0, At, B0); PG8_BAR; PG8_SCHED;
            PG8_LDB(B1, 1, 1); PG8_STAGE(PG8_SB(1, 0), b3, voffB);
            PG8_BAR; PG8_WAIT_L(0); PG8_MMA(0, 1, At, B1); PG8_BAR;
            PG8_LDA(At, 1, 1); PG8_STAGE(PG8_SA(1, 0), a3, voffA);
            PG8_BAR; PG8_WAIT_L(0); PG8_MMA(1, 0, At, B0); PG8_BAR; PG8_SCHED;
            PG8_STAGE(PG8_SB(1, 1), b3 + hstep, voffB);
            PG8_WAIT_V(6); PG8_BAR; PG8_MMA(1, 1, At, B1); PG8_BAR;
            }
        }
        if constexpr (ALIGN_EPI) { if (wr == 0) PG8_BAR; }
        if constexpr (!Epi::AFTER_DRAIN) { E(acc, cur, ui, wr, wc, fr, fq); S.done(cur); }
        if (!has_next) break;
#pragma unroll
        for (int a = 0; a < 2; ++a)
#pragma unroll
            for (int b = 0; b < 2; ++b)
#pragma unroll
                for (int m = 0; m < 4; ++m)
#pragma unroll
                    for (int n = 0; n < 2; ++n) acc[a][b][m][n] = (f32x4){0.f, 0.f, 0.f, 0.f};
        cur = nxt; cA = nA; cB = nB; ++ui;
        if constexpr (ALIGN_EPI) { if (wr == 1) PG8_BAR; }
    }
    PG8_WAIT_V(0);
    if constexpr (!ALIGN_EPI) { if (wr == 0) PG8_BAR; }
    PG8_BAR;
    if constexpr (Epi::AFTER_DRAIN) { E.fused(acc, cur, wr, wc, fr, fq, lds, wid, lane); S.done(cur); }
#undef PG8_SA
#undef PG8_SB
#undef PG8_STAGE
#undef PG8_LDA
#undef PG8_LDB
#undef PG8_MMA
#undef PG8_WAIT_V
#undef PG8_WAIT_L
#undef PG8_BAR
#undef PG8_SCHED
}
}

namespace pg8 {
__device__ __forceinline__ unsigned cvt_pk_bf16(float lo, float hi) { unsigned r; asm volatile("v_cvt_pk_bf16_f32 %0, %1, %2" : "=v"(r) : "v"(lo), "v"(hi)); return r; }
__device__ __forceinline__ f32x4 gelu4(f32x4 v) { f32x4 o; o.x = gelu_tanh(v.x); o.y = gelu_tanh(v.y); o.z = gelu_tanh(v.z); o.w = gelu_tanh(v.w); return o; }
constexpr int ETAB_OFF = 131072 + 8192, ETAB_SLOT = 4608, ETAB_MAXU = 4;
__device__ __forceinline__ float row_rstd(const float* rsq, int row) {
    const GAS f32x4* p = (const GAS f32x4*)(rsq + (size_t)row * 16);
    const f32x4 a = p[0], b = p[1], c = p[2], d = p[3];
    const float s = ((a.x + a.y) + (a.z + a.w)) + ((b.x + b.y) + (b.z + b.w)) + ((c.x + c.y) + (c.z + c.w)) + ((d.x + d.y) + (d.z + d.w));
    return rsqrtf(s * (1.f / D) + EPS);
}
__device__ __forceinline__ int tile_cidx(int trow) { return trow < NPROMPT ? 0 : 1 + ((trow - NPROMPT) >> 10); }
__device__ __forceinline__ PG8_LAS float* etab(PG8_LAS unsigned char* lds, int ui) { return (PG8_LAS float*)(lds + ETAB_OFF + ui * ETAB_SLOT); }

template <int ACT> struct EpiBf16 {
    static constexpr bool PERM = true, AFTER_DRAIN = false;
    bf16_t* O; int ldc; const float* bias; int split_cols; size_t split_stride; const float* rsq; const float* b2; int N; float* rsqv; int vt0; PG8_LAS unsigned char* lds;
    template <class Sched> __device__ __forceinline__ void prep(const Sched& S, int tid) const {
        Unit u;
        for (int i = 0; i < ETAB_MAXU && S.next(i, u); ++i) { PG8_LAS float* t = etab(lds, i);
            if (tid < 256) t[tid] = row_rstd(rsq, S.arow(u.pm) + tid);
            else { const int c = tid - 256, col = u.pn * BM + c; float v = b2[(size_t)tile_cidx(S.arow(u.pm)) * N + col]; if (bias) v += bias[col]; t[256 + c] = v; } }
        __syncthreads();
    }
    __device__ __forceinline__ void operator()(f32x4 (&acc)[2][2][4][2], const Unit& u, int ui, int wr, int wc, int fr, int fq) const {
        asm volatile("" : "+v"(fr), "+v"(fq));
        PG8_LAS const float* tb = etab(lds, ui);
        const int lrow0 = wr * 64 + fr; int colt = u.pn * BM; bf16_t* base = O; int t = 0;
        if (split_cols) { t = colt / split_cols; base += (size_t)t * split_stride; colt -= t * split_cols; }
        const bool act = (ACT == 1) || (ACT == 2 && t == 0);
        const int col0 = colt + wc * 32 + 8 * fq, tc0 = wc * 32 + 8 * fq;
        const bool wantv = rsqv != nullptr && u.pn >= vt0;
        GAS unsigned char* ob = (GAS unsigned char*)base;
        float ss[8];
#pragma unroll
        for (int i = 0; i < 8; ++i) ss[i] = 0.f;
#pragma unroll
        for (int bj = 0; bj < 2; ++bj) { const f32x4 bv0 = *(PG8_LAS const f32x4*)(tb + 256 + tc0 + bj * HALF), bv1 = *(PG8_LAS const f32x4*)(tb + 256 + tc0 + bj * HALF + 4);
#pragma unroll
            for (int ai = 0; ai < 2; ++ai)
#pragma unroll
                for (int m = 0; m < 4; ++m) { const int lrow = lrow0 + ai * HALF + m * 16; const float rs = tb[lrow];
                    f32x4 v0 = acc[ai][bj][m][0] * rs + bv0, v1 = acc[ai][bj][m][1] * rs + bv1;
                    if (ACT != 0) { if (act) { v0 = gelu4(v0); v1 = gelu4(v1); } }
                    ss[ai * 4 + m] += (v0[0] * v0[0] + v0[1] * v0[1]) + (v0[2] * v0[2] + v0[3] * v0[3]) + (v1[0] * v1[0] + v1[1] * v1[1]) + (v1[2] * v1[2] + v1[3] * v1[3]);
                    u32x4 w; w.x = cvt_pk_bf16(v0[0], v0[1]); w.y = cvt_pk_bf16(v0[2], v0[3]); w.z = cvt_pk_bf16(v1[0], v1[1]); w.w = cvt_pk_bf16(v1[2], v1[3]);
                    *(GAS u32x4*)(ob + ((unsigned)(u.pm * BM + lrow) * (unsigned)ldc + col0 + bj * HALF) * 2u) = w;
                    __builtin_amdgcn_sched_barrier(0); } }
        if (wantv) {
#pragma unroll
            for (int i = 0; i < 8; ++i) { const float q = sum_q4(ss[i]);
                if (fq == 0) *(GAS float*)(rsqv + (size_t)(u.pm * BM + lrow0 + (i >> 2) * HALF + (i & 3) * 16) * 32 + (u.pn - vt0) * 4 + wc) = q; } }
    }
};
struct EpiResid {
    static constexpr bool PERM = true, AFTER_DRAIN = false;
    float* out; const float* xp; const float* xs; const float* modl; int which; bool from_input;
    bf16_t* H; const float* ng; const float* modn; int whichs; float* rsq_out; PG8_LAS unsigned char* lds;
    template <class Sched> __device__ __forceinline__ void prep(const Sched& S, int tid) const {
        Unit u;
        for (int i = 0; i < ETAB_MAXU && S.next(i, u); ++i) { PG8_LAS float* t = etab(lds, i);
            if (tid < 256) { const int ci = tile_cidx(u.pm * BM), col = u.pn * BM + tid; t[256 + tid] = modl[(size_t)(ci * 6 + which) * D + col];
                t[512 + tid] = H ? ng[col] * (1.f + modn[(size_t)(ci * 6 + whichs) * D + col]) : 0.f; } }
        __syncthreads();
    }
    __device__ __forceinline__ void operator()(f32x4 (&acc)[2][2][4][2], const Unit& u, int ui, int wr, int wc, int fr, int fq) const {
        asm volatile("" : "+v"(fr), "+v"(fq));
        PG8_LAS const float* tb = etab(lds, ui);
        const int trow = u.pm * BM, row0 = wr * 64 + fr, tc0 = wc * 32 + 8 * fq, col0 = u.pn * BM + tc0;
        const GAS unsigned char* bpg = (const GAS unsigned char*)(from_input ? (trow < NPROMPT ? xp + (size_t)trow * D : xs + (size_t)(trow - NPROMPT) * D) : out + (size_t)trow * D);
        GAS unsigned char* op = (GAS unsigned char*)(out + (size_t)trow * D); GAS unsigned char* hb = (GAS unsigned char*)H;
#pragma unroll
        for (int ai = 0; ai < 2; ++ai) {
            f32x4 x[2][4][2];
#pragma unroll
            for (int bj = 0; bj < 2; ++bj)
#pragma unroll
                for (int m = 0; m < 4; ++m)
#pragma unroll
                    for (int n = 0; n < 2; ++n) x[bj][m][n] = *(const GAS f32x4*)(bpg + ((unsigned)(row0 + ai * HALF + m * 16) * (unsigned)D + col0 + bj * HALF + 4 * n) * 4u);
            float ss[4] = {0.f, 0.f, 0.f, 0.f};
#pragma unroll
            for (int bj = 0; bj < 2; ++bj) { const f32x4 gv0 = *(PG8_LAS const f32x4*)(tb + 256 + tc0 + bj * HALF), gv1 = *(PG8_LAS const f32x4*)(tb + 256 + tc0 + bj * HALF + 4);
                const f32x4 gs0 = *(PG8_LAS const f32x4*)(tb + 512 + tc0 + bj * HALF), gs1 = *(PG8_LAS const f32x4*)(tb + 512 + tc0 + bj * HALF + 4);
#pragma unroll
                for (int m = 0; m < 4; ++m) { const unsigned lrow = row0 + ai * HALF + m * 16, eo = lrow * (unsigned)D + col0 + bj * HALF;
                    const f32x4 x0 = x[bj][m][0] + gv0 * acc[ai][bj][m][0], x1 = x[bj][m][1] + gv1 * acc[ai][bj][m][1];
                    *(GAS f32x4*)(op + eo * 4u) = x0; *(GAS f32x4*)(op + eo * 4u + 16) = x1;
                    if (H) { ss[m] += (x0[0] * x0[0] + x0[1] * x0[1]) + (x0[2] * x0[2] + x0[3] * x0[3]) + (x1[0] * x1[0] + x1[1] * x1[1]) + (x1[2] * x1[2] + x1[3] * x1[3]);
                        const f32x4 a0 = x0 * gs0, a1 = x1 * gs1;
                        u32x4 w; w.x = cvt_pk_bf16(a0[0], a0[1]); w.y = cvt_pk_bf16(a0[2], a0[3]); w.z = cvt_pk_bf16(a1[0], a1[1]); w.w = cvt_pk_bf16(a1[2], a1[3]);
                        *(GAS u32x4*)(hb + ((unsigned)trow * (unsigned)D + eo) * 2u) = w; } } }
            if (H) {
#pragma unroll
                for (int m = 0; m < 4; ++m) { const float q = sum_q4(ss[m]);
                    if (fq == 0) *(GAS float*)(rsq_out + (size_t)(trow + row0 + ai * HALF + m * 16) * 16 + u.pn * 4 + wc) = q; } }
            asm volatile("" ::: "memory");
        }
    }
};

__device__ __forceinline__ void ffn_tile_geom(int pm, int& rs, int& vlo, int& vhi) {
    if (pm < 32) { rs = 256 * pm; vlo = 0; vhi = 255; }
    else { const int sq = (pm - 32) / 5, i = (pm - 32) % 5; rs = NPROMPT + 1024 * sq + (i < 4 ? 254 * i : 768); vlo = i == 0 ? 0 : (i < 4 ? 1 : 249); vhi = i < 4 ? 254 : 255; }
}
struct FfnOrder : StaticOrder {
    __device__ __forceinline__ int arow(int pm) const { int rs, a, b; ffn_tile_geom(pm, rs, a, b); return rs; }
};
template <int CTRL> __device__ __forceinline__ float dpp0(float v) { return __builtin_bit_cast(float, __builtin_amdgcn_update_dpp(0, __builtin_bit_cast(int, v), CTRL, 0xf, 0xf, true)); }
struct EpiFfn {
    static constexpr bool PERM = true, AFTER_DRAIN = false;
    bf16_t* ACT; const float* cw; const float* cb; const float* rsq; const float* b2; PG8_LAS unsigned char* lds;
    template <class Sched> __device__ __forceinline__ void prep(const Sched& S, int tid) const {
        Unit u;
        for (int i = 0; i < ETAB_MAXU && S.next(i, u); ++i) { PG8_LAS float* t = etab(lds, i); const int rs = S.arow(u.pm);
            if (tid < 256) t[tid] = row_rstd(rsq, rs + tid);
            else { const int c = tid - 256, ch = (c < 128 ? 0 : DFF) + u.pn * 128 + (c & 127);
                t[256 + c] = b2[(size_t)tile_cidx(rs) * 2 * DFF + u.pn * 256 + c]; t[512 + c] = cb[ch];
                PG8_LAS unsigned short* tw = (PG8_LAS unsigned short*)(t + 768);
#pragma unroll
                for (int k = 0; k < 3; ++k) tw[k * 256 + c] = (unsigned short)f2bf(cw[(size_t)k * 2 * DFF + ch]); } }
        __syncthreads();
    }
    __device__ __forceinline__ void operator()(f32x4 (&acc)[2][2][4][2], const Unit& u, int ui, int wr, int wc, int fr, int fq) const {
        asm volatile("" : "+v"(fr), "+v"(fq));
        PG8_LAS const float* tb = etab(lds, ui); PG8_LAS float* xb = (PG8_LAS float*)(lds + 131072);
        int rs, vlo, vhi; ffn_tile_geom(u.pm, rs, vlo, vhi);
        const int colw = wc * 32 + 8 * fq;
#pragma unroll
        for (int bj = 0; bj < 2; ++bj) { const f32x4 bz0 = *(PG8_LAS const f32x4*)(tb + 256 + bj * 128 + colw), bz1 = *(PG8_LAS const f32x4*)(tb + 256 + bj * 128 + colw + 4);
#pragma unroll
            for (int ai = 0; ai < 2; ++ai)
#pragma unroll
                for (int m = 0; m < 4; ++m) { const float rsd = tb[128 * ai + 64 * wr + 16 * m + fr];
                    acc[ai][bj][m][0] = acc[ai][bj][m][0] * rsd + bz0; acc[ai][bj][m][1] = acc[ai][bj][m][1] * rsd + bz1; } }
#pragma unroll
        for (int ai = 0; ai < 2; ++ai) { const int b = 2 * ai + wr;
            if (fr == 0) {
#pragma unroll
                for (int bj = 0; bj < 2; ++bj)
#pragma unroll
                    for (int n = 0; n < 2; ++n) *(PG8_LAS f32x4*)(xb + (b * 2 + 0) * 256 + bj * 128 + colw + 4 * n) = acc[ai][bj][0][n]; }
            if (fr == 15) {
#pragma unroll
                for (int bj = 0; bj < 2; ++bj)
#pragma unroll
                    for (int n = 0; n < 2; ++n) *(PG8_LAS f32x4*)(xb + (b * 2 + 1) * 256 + bj * 128 + colw + 4 * n) = acc[ai][bj][3][n]; } }
        asm volatile("s_waitcnt lgkmcnt(0)" ::: "memory"); __builtin_amdgcn_s_barrier(); asm volatile("" ::: "memory");
        GAS unsigned char* actb = (GAS unsigned char*)ACT;
        const unsigned lane_off = (unsigned)((rs + 64 * wr + fr) * DFF + u.pn * 128 + colw) * 2u;
        PG8_LAS const unsigned short* tw = (PG8_LAS const unsigned short*)(tb + 768);
#pragma unroll
        for (int n = 0; n < 2; ++n) {
            f32x4 wg[3], wu[3];
#pragma unroll
            for (int k = 0; k < 3; ++k) { const u32x2 pg = *(PG8_LAS const u32x2*)(tw + k * 256 + colw + 4 * n), pu = *(PG8_LAS const u32x2*)(tw + k * 256 + 128 + colw + 4 * n);
                wg[k] = (f32x4){__builtin_bit_cast(float, pg.x << 16), __builtin_bit_cast(float, pg.x & 0xffff0000u), __builtin_bit_cast(float, pg.y << 16), __builtin_bit_cast(float, pg.y & 0xffff0000u)};
                wu[k] = (f32x4){__builtin_bit_cast(float, pu.x << 16), __builtin_bit_cast(float, pu.x & 0xffff0000u), __builtin_bit_cast(float, pu.y << 16), __builtin_bit_cast(float, pu.y & 0xffff0000u)}; }
            const f32x4 bgv = *(PG8_LAS const f32x4*)(tb + 512 + colw + 4 * n), buv = *(PG8_LAS const f32x4*)(tb + 512 + 128 + colw + 4 * n);
#pragma unroll
            for (int ai = 0; ai < 2; ++ai) { const int b = 2 * ai + wr;
                f32x4 pz[2], nz[2];
#pragma unroll
                for (int bj = 0; bj < 2; ++bj) { pz[bj] = b > 0 ? *(PG8_LAS const f32x4*)(xb + ((b - 1) * 2 + 1) * 256 + bj * 128 + colw + 4 * n) : (f32x4){0.f, 0.f, 0.f, 0.f};
                                                 nz[bj] = b < 3 ? *(PG8_LAS const f32x4*)(xb + ((b + 1) * 2 + 0) * 256 + bj * 128 + colw + 4 * n) : (f32x4){0.f, 0.f, 0.f, 0.f}; }
#pragma unroll
                for (int m = 0; m < 4; ++m) { f32x4 zc[2];
#pragma unroll
                    for (int bj = 0; bj < 2; ++bj) { const f32x4 z = acc[ai][bj][m][n]; const f32x4* w3 = bj == 0 ? wg : wu; f32x4 o = bj == 0 ? bgv : buv;
#pragma unroll
                        for (int e = 0; e < 4; ++e) { float a = fmaf(w3[1][e], z[e], o[e]);
                            const float w0e = fr == 0 ? w3[0][e] : 0.f, w2e = fr == 15 ? w3[2][e] : 0.f;
                            asm("v_fmac_f32_dpp %0, %1, %2 row_shr:1 row_mask:0xf bank_mask:0xf bound_ctrl:1" : "+v"(a) : "v"(z[e]), "v"(w3[0][e]));
                            asm("v_fmac_f32_dpp %0, %1, %2 row_shl:1 row_mask:0xf bank_mask:0xf bound_ctrl:1" : "+v"(a) : "v"(z[e]), "v"(w3[2][e]));
                            if (m > 0) { const float zp = acc[ai][bj][m - 1][n][e]; asm("v_fmac_f32_dpp %0, %1, %2 row_ror:1 row_mask:0xf bank_mask:0xf bound_ctrl:1" : "+v"(a) : "v"(zp), "v"(w0e)); } else a = fmaf(pz[bj][e], w0e, a);
                            if (m < 3) { const float zn = acc[ai][bj][m + 1][n][e]; asm("v_fmac_f32_dpp %0, %1, %2 row_ror:15 row_mask:0xf bank_mask:0xf bound_ctrl:1" : "+v"(a) : "v"(zn), "v"(w2e)); } else a = fmaf(nz[bj][e], w2e, a);
                            o[e] = a; }
                        zc[bj] = o; }
                    const int lr = 128 * ai + 64 * wr + 16 * m + fr;
                    if (lr >= vlo && lr <= vhi) { u32x2 w; w.x = cvt_pk_bf16(siluf_(zc[0][0]) * zc[1][0], siluf_(zc[0][1]) * zc[1][1]); w.y = cvt_pk_bf16(siluf_(zc[0][2]) * zc[1][2], siluf_(zc[0][3]) * zc[1][3]);
                        *(GAS u32x2*)(actb + (lane_off + (unsigned)((128 * ai + 16 * m) * DFF + 4 * n) * 2u)) = w; } } }
        }
    }
};

struct EpiQkv {
    static constexpr bool PERM = true, AFTER_DRAIN = false;
    unsigned char* ws; float* out; const float* rsq; const float* b2; PG8_LAS unsigned char* lds; const float* qkg; const float* rope;
    template <class Sched> __device__ __forceinline__ void prep(const Sched& S, int tid) const {
        Unit u;
        for (int i = 0; i < ETAB_MAXU && S.next(i, u); ++i) { PG8_LAS float* t = etab(lds, i);
            if (tid < 256) t[tid] = row_rstd(rsq, u.pm * BM + tid);
            else { const int c = tid - 256; t[256 + c] = b2[(size_t)tile_cidx(u.pm * BM) * 3 * D + u.pn * BM + c]; } }
        __syncthreads();
    }
    __device__ __forceinline__ void operator()(f32x4 (&acc)[2][2][4][2], const Unit& u, int ui, int wr, int wc, int fr, int fq) const {
        asm volatile("" : "+v"(fr), "+v"(fq));
        PG8_LAS const float* tb = etab(lds, ui);
        const int trow = u.pm * BM; const bool smp = trow >= NPROMPT; const int sb = smp ? (trow - NPROMPT) >> 10 : 0, tq0 = smp ? (trow - NPROMPT) & 1023 : 0;
        const int kind = u.pn >> 2, tc0 = wc * 32 + 8 * fq;
        if (kind < 2) {
            const int oc = (u.pn & 3) * 256 + wc * 64 + 8 * fq;
            f32x4 bz[2][2], gq[2][2];
#pragma unroll
            for (int bj = 0; bj < 2; ++bj)
#pragma unroll
                for (int n = 0; n < 2; ++n) { bz[bj][n] = *(PG8_LAS const f32x4*)(tb + 256 + tc0 + bj * HALF + 4 * n); gq[bj][n] = *(const GAS f32x4*)(qkg + kind * 64 + 32 * bj + 8 * fq + 4 * n); }
            const size_t doff = kind == 0 ? WS_T2 : (smp ? WS_KS : WS_T2 + (size_t)M * D * 2); GAS unsigned char* dst = (GAS unsigned char*)ws + doff;
#pragma unroll
            for (int ai = 0; ai < 2; ++ai) {
                f32x4 cs[4][2], sn[4][2];
#pragma unroll
                for (int m = 0; m < 4; ++m) { const int lrow = 128 * ai + 64 * wr + 16 * m + fr; const float rs = tb[lrow];
                    if (smp && (m & 1) == 0) {
#pragma unroll
                        for (int mm = m; mm < m + 2; ++mm)
#pragma unroll
                            for (int n = 0; n < 2; ++n) { const int t = tq0 + 128 * ai + 64 * wr + 16 * mm + fr; cs[mm][n] = *(const GAS f32x4*)(rope + t * 32 + 8 * fq + 4 * n); sn[mm][n] = *(const GAS f32x4*)(rope + 32768 + t * 32 + 8 * fq + 4 * n); } }
                    f32x4 v[2][2]; float ss = 0.f;
#pragma unroll
                    for (int bj = 0; bj < 2; ++bj)
#pragma unroll
                        for (int n = 0; n < 2; ++n) { v[bj][n] = acc[ai][bj][m][n] * rs + bz[bj][n]; ss += (v[bj][n][0] * v[bj][n][0] + v[bj][n][1] * v[bj][n][1]) + (v[bj][n][2] * v[bj][n][2] + v[bj][n][3] * v[bj][n][3]); }
                    ss = sum_q4(ss);
                    const float rn = rsqrtf(ss * (1.f / 64.f) + EPS);
#pragma unroll
                    for (int bj = 0; bj < 2; ++bj)
#pragma unroll
                        for (int n = 0; n < 2; ++n) v[bj][n] = v[bj][n] * rn * gq[bj][n];
                    const unsigned row = (unsigned)(trow + lrow);
                    if (!smp) {
                        if (kind == 1) {
#pragma unroll
                            for (int bj = 0; bj < 2; ++bj)
#pragma unroll
                                for (int n = 0; n < 2; ++n) *(GAS f32x4*)((GAS unsigned char*)out + O_CK * 4 + (row * (unsigned)D + oc + 32 * bj + 4 * n) * 4u) = v[bj][n]; }
                    } else {
#pragma unroll
                        for (int n = 0; n < 2; ++n) { const f32x4 x1 = v[0][n], x2 = v[1][n]; v[0][n] = x1 * cs[m][n] - x2 * sn[m][n]; v[1][n] = x2 * cs[m][n] + x1 * sn[m][n]; } }
                    const unsigned drow = (kind == 1 && smp) ? (unsigned)(sb * TKS + PAST + tq0 + lrow) : row;
#pragma unroll
                    for (int bj = 0; bj < 2; ++bj) { u32x4 w; w.x = cvt_pk_bf16(v[bj][0][0], v[bj][0][1]); w.y = cvt_pk_bf16(v[bj][0][2], v[bj][0][3]); w.z = cvt_pk_bf16(v[bj][1][0], v[bj][1][1]); w.w = cvt_pk_bf16(v[bj][1][2], v[bj][1][3]);
                        *(GAS u32x4*)(dst + (drow * (unsigned)D + oc + 32 * bj) * 2u) = w; }
                    if (m & 1) { asm volatile("" ::: "memory"); __builtin_amdgcn_sched_barrier(0); } } }
        } else {
            const int oc = (u.pn - 8) * 256 + wc * 32 + 8 * fq;
            const size_t doff = smp ? WS_VS : WS_T2 + (size_t)M * D * 2 + (size_t)NPROMPT * D * 2; GAS unsigned char* dst = (GAS unsigned char*)ws + doff;
#pragma unroll
            for (int bj = 0; bj < 2; ++bj) { const f32x4 bz0 = *(PG8_LAS const f32x4*)(tb + 256 + tc0 + bj * HALF), bz1 = *(PG8_LAS const f32x4*)(tb + 256 + tc0 + bj * HALF + 4);
#pragma unroll
                for (int ai = 0; ai < 2; ++ai)
#pragma unroll
                    for (int m = 0; m < 4; ++m) { const int lrow = 128 * ai + 64 * wr + 16 * m + fr; const float rs = tb[lrow];
                        const f32x4 v0 = acc[ai][bj][m][0] * rs + bz0, v1 = acc[ai][bj][m][1] * rs + bz1;
                        const unsigned row = (unsigned)(trow + lrow), drow = smp ? (unsigned)(sb * TKS + PAST + tq0 + lrow) : row;
                        u32x4 w; w.x = cvt_pk_bf16(v0[0], v0[1]); w.y = cvt_pk_bf16(v0[2], v0[3]); w.z = cvt_pk_bf16(v1[0], v1[1]); w.w = cvt_pk_bf16(v1[2], v1[3]);
                        *(GAS u32x4*)(dst + (drow * (unsigned)D + oc + 128 * bj) * 2u) = w;
                        if (!smp) { *(GAS f32x4*)((GAS unsigned char*)out + O_CV * 4 + (row * (unsigned)D + oc + 128 * bj) * 4u) = v0; *(GAS f32x4*)((GAS unsigned char*)out + O_CV * 4 + (row * (unsigned)D + oc + 128 * bj + 4) * 4u) = v1; } } }
        }
    }
};
}

struct Params { const float* in[N_IN]; float* out; unsigned char* ws; };
struct Frame {
    LAS unsigned char* lds; int tid, lane, wave, bid, G, wave0;
    float* out; unsigned char* ws; float* out0; unsigned char* ws0;
    __device__ __forceinline__ const float* inp(int i) const { const unsigned long long v = ((LAS const unsigned long long*)(lds + PTR_OFF))[i];
        const unsigned lo = __builtin_amdgcn_readfirstlane((unsigned)v), hi = __builtin_amdgcn_readfirstlane((unsigned)(v >> 32)); return (const float*)(const GAS float*)(((unsigned long long)hi << 32) | lo); }
    float* mod; float* rstd; float* rope; bf16 *H, *T1, *T2, *T3, *KS, *VS, *WT; float *rsq0, *rsq1, *rsqv, *bias2;
    __device__ __forceinline__ void fresh() {
        int z = 0; asm volatile("" : "+v"(z));
        lane = __builtin_amdgcn_mbcnt_hi(~0u, __builtin_amdgcn_mbcnt_lo(~0u, z)); int wv = wave0; asm volatile("" : "+s"(wv)); wave = wv; tid = wv * 64 + lane;
        int b = blockIdx.x; asm volatile("" : "+s"(b)); bid = b;
        unsigned char* w = ws0; asm volatile("" : "+s"(w)); w = (unsigned char*)(GAS unsigned char*)(unsigned long long)w; ws = w; float* o = out0; asm volatile("" : "+s"(o)); o = (float*)(GAS float*)(unsigned long long)o; out = o;
        mod = (float*)(w + WS_MOD); rstd = (float*)(w + WS_RSTD); rope = (float*)(w + WS_ROPE);
        H = (bf16*)(w + WS_H); T1 = (bf16*)(w + WS_T1); T2 = (bf16*)(w + WS_T2); T3 = (bf16*)(w + WS_T3); KS = (bf16*)(w + WS_KS); VS = (bf16*)(w + WS_VS); WT = (bf16*)(w + WS_W);
        rsq0 = (float*)(w + WS_X); rsq1 = (float*)(w + WS_X + MiB); rsqv = (float*)(w + WS_X + 2 * MiB); bias2 = (float*)(w + WS_X + 4 * MiB);
    }
};
__device__ __forceinline__ const float* xin_row(const Frame& F, int row) { return row < NPROMPT ? F.inp(I_XP) + (size_t)row * D : F.inp(I_XS) + (size_t)(row - NPROMPT) * D; }
__device__ __forceinline__ int cidx_of(int row) { return row < NPROMPT ? 0 : 1 + ((row - NPROMPT) >> 10); }
__device__ __forceinline__ const float* modp(const Frame& F, int l, int row, int which) { return F.mod + (size_t)((l * 3 + cidx_of(row)) * 6 + which) * D; }


template <int MODE  >
__device__ __forceinline__ void transpose_item(const float* W, int K, int N, bf16* WT, LAS float* scr, int item, int lane) {
    const int nblk = N / 32, kb = item / nblk, nb = item % nblk, k0 = 64 * kb, n0 = 32 * nb;
    int d0 = n0; if (MODE == 1) { const int isu = n0 >= DFF, jj = n0 - isu * DFF; d0 = (jj >> 7) * 256 + isu * 128 + (jj & 127); }
    if (MODE == 2 && n0 < 2 * D) { const int w = n0 & 255; d0 = (n0 & ~255) + ((w >> 5) & 1) * 128 + (w >> 6) * 32; }
    float wv[32];
    const GAS float* wp = (const GAS float*)W + (size_t)(k0 + (lane >> 5)) * N + n0 + (lane & 31);
#pragma unroll
    for (int i = 0; i < 32; ++i) wv[i] = wp[(size_t)(2 * i) * N];
#pragma unroll
    for (int i = 0; i < 32; ++i) scr[(2 * i + (lane >> 5)) * 33 + (lane & 31)] = wv[i];
    asm volatile("s_waitcnt lgkmcnt(0)" ::: "memory");
    const int c = lane & 7;
#pragma unroll
    for (int j = 0; j < 4; ++j) { const int n = (lane >> 3) + 8 * j; const LAS float* sp = scr + (8 * c) * 33 + n;
        u32x4 o; o.x = f2bf(sp[0 * 33]) | (f2bf(sp[1 * 33]) << 16); o.y = f2bf(sp[2 * 33]) | (f2bf(sp[3 * 33]) << 16); o.z = f2bf(sp[4 * 33]) | (f2bf(sp[5 * 33]) << 16); o.w = f2bf(sp[6 * 33]) | (f2bf(sp[7 * 33]) << 16);
        *(u32x4*)(WT + (size_t)(d0 + n) * K + k0 + 8 * c) = o; }
    asm volatile("s_waitcnt lgkmcnt(0)" ::: "memory");
}
template <int MODE = 0>
__device__ __forceinline__ bool transpose_group(int& r, const float* W, int nmat, int K, int N, bf16* WT, LAS float* scr, int lane) {
    const int per = (K / 64) * (N / 32), tot = nmat * per;
    if (r >= tot) { r -= tot; return false; }
    const int mi = r / per; transpose_item<MODE>(W + (size_t)mi * K * N, K, N, WT + (size_t)mi * K * N, scr, r % per, lane); return true;
}

template <int SLOT>
__device__ __forceinline__ void convert_slot(Frame& F, int gw, int NGW) {
    LAS float* scr = (LAS float*)(F.lds + F.wave * 16384);
    constexpr size_t UPE = (size_t)2 * DFF * D, DNE = (size_t)D * DFF;
    constexpr int I_UP1 = (D / 64) * (2 * DFF / 32), I_DN1 = (DFF / 64) * (D / 32), I_LIN = (D / 64) * (2 * DRNN / 32), I_LOUT = (DRNN / 64) * (D / 32), I_WG = 80 * 2 * 4,
                  I_CIN = (D / 64) * (2 * DB / 32), I_COUT = (DB / 64) * (D / 32), I_QKV = (D / 64) * (3 * D / 32), I_AOUT = (D / 64) * (D / 32);
    constexpr int NIT = SLOT == 0 ? I_LIN + I_LOUT + I_WG + I_UP1 + I_DN1 : SLOT == 1 ? I_CIN + I_COUT + I_UP1 : SLOT == 2 ? I_DN1 + I_QKV + I_AOUT + I_UP1 : SLOT == 3 ? I_DN1 + I_LIN + I_LOUT : I_UP1 + I_DN1;
    for (int it = gw; it < NIT; it += NGW) { int r = it;
        if (SLOT == 0) {
            if (transpose_group(r, F.inp(I_LRU_WIN), 1, D, 2 * DRNN, F.WT + WE_LRU_IN, scr, F.lane)) continue;
            if (transpose_group(r, F.inp(I_LRU_WOUT), 1, DRNN, D, F.WT + WE_LRU_OUT, scr, F.lane)) continue;
            if (transpose_group(r, F.inp(I_LRU_WG), 80, 128, 128, F.WT + WE_WG, scr, F.lane)) continue;
            if (transpose_group<1>(r, F.inp(I_FF_WUP), 1, D, 2 * DFF, F.WT + WE_UP, scr, F.lane)) continue;
            transpose_group(r, F.inp(I_FF_WDN), 1, DFF, D, F.WT + WE_DN, scr, F.lane);
        } else if (SLOT == 1) {
            if (transpose_group(r, F.inp(I_CM_WIN), 1, D, 2 * DB, F.WT + WE_CM_IN, scr, F.lane)) continue;
            if (transpose_group(r, F.inp(I_CM_WOUT), 1, DB, D, F.WT + WE_CM_OUT, scr, F.lane)) continue;
            transpose_group<1>(r, F.inp(I_FF_WUP) + UPE, 1, D, 2 * DFF, F.WT + WE_UP + UPE, scr, F.lane);
        } else if (SLOT == 2) {
            if (transpose_group(r, F.inp(I_FF_WDN) + DNE, 1, DFF, D, F.WT + WE_DN + DNE, scr, F.lane)) continue;
            if (transpose_group<2>(r, F.inp(I_AT_WQKV), 1, D, 3 * D, F.WT + WE_QKV, scr, F.lane)) continue;
            if (transpose_group(r, F.inp(I_AT_WOUT), 1, D, D, F.WT + WE_AT_OUT, scr, F.lane)) continue;
            transpose_group<1>(r, F.inp(I_FF_WUP) + 2 * UPE, 1, D, 2 * DFF, F.WT + WE_UP + 2 * UPE, scr, F.lane);
        } else if (SLOT == 3) {
            if (transpose_group(r, F.inp(I_FF_WDN) + 2 * DNE, 1, DFF, D, F.WT + WE_DN + 2 * DNE, scr, F.lane)) continue;
            if (transpose_group(r, F.inp(I_LRU_WIN) + (size_t)D * 2 * DRNN, 1, D, 2 * DRNN, F.WT + WE_LRU_IN + (size_t)D * 2 * DRNN, scr, F.lane)) continue;
            transpose_group(r, F.inp(I_LRU_WOUT) + (size_t)DRNN * D, 1, DRNN, D, F.WT + WE_LRU_OUT + (size_t)DRNN * D, scr, F.lane);
        } else {
            if (transpose_group<1>(r, F.inp(I_FF_WUP) + 3 * UPE, 1, D, 2 * DFF, F.WT + WE_UP + 3 * UPE, scr, F.lane)) continue;
            transpose_group(r, F.inp(I_FF_WDN) + 3 * DNE, 1, DFF, D, F.WT + WE_DN + 3 * DNE, scr, F.lane);
        }
    }
}
__device__ __forceinline__ void phase_prologue(Frame& F) {
    F.fresh();
    LAS float* sc = (LAS float*)F.lds;
    const float* c = F.inp(I_C); const float* cctx = F.inp(I_CCTX);
    for (int i = F.tid; i < 3 * D; i += NT) { const int ci = i >> 10, k = i & 1023; const float v = ci == 0 ? cctx[k] : c[(ci - 1) * D + k]; sc[i] = siluf_(v); }
    __syncthreads();
    LAS float* part = sc + 3 * D;
    const int kp = F.tid >> 6, cl = F.tid & 63;
    for (int item = F.bid; item < DEPTH * 6 * D / 64; item += F.G) {
        const int col = item * 64 + cl, l = col / (6 * D), cc = col % (6 * D);
        const float* w = F.inp(I_WMOD) + (size_t)l * D * 6 * D + cc;
        float s0 = 0.f, s1 = 0.f, s2 = 0.f;
#pragma unroll 1
        for (int kb = kp * 128; kb < kp * 128 + 128; kb += 32) { float wv[32];
#pragma unroll
            for (int i = 0; i < 32; ++i) wv[i] = ((const GAS float*)w)[(size_t)(kb + i) * 6 * D];
#pragma unroll
            for (int i = 0; i < 32; ++i) { s0 += sc[kb + i] * wv[i]; s1 += sc[D + kb + i] * wv[i]; s2 += sc[2 * D + kb + i] * wv[i]; } }
        part[(kp * 3 + 0) * 64 + cl] = s0; part[(kp * 3 + 1) * 64 + cl] = s1; part[(kp * 3 + 2) * 64 + cl] = s2;
        __syncthreads();
        if (F.tid < 192) { const int ci = F.tid >> 6; float s = F.inp(I_BMOD)[l * 6 * D + cc];
            for (int q = 0; q < 8; ++q) s += part[(q * 3 + ci) * 64 + cl];
            F.mod[(size_t)((l * 3 + ci) * 6) * D + cc] = s; }
        __syncthreads();
    }
    { __syncthreads(); convert_slot<0>(F, F.bid * NWAVES + F.wave, F.G * NWAVES); }
    const int gt = F.bid * NT + F.tid, GT = F.G * NT;
    for (int i = gt; i < 1024 * 32; i += GT) { const int t = i >> 5, j = i & 31; const float inv = powf(10000.f, -(float)(j & 15) / 16.f); const float pos = (float)(j < 16 ? (t >> 6) : (t & 63));
        const float ang = pos * inv; F.rope[i] = cosf(ang); F.rope[32768 + i] = sinf(ang); }
    for (int i = gt; i < 8 * 8 * 4 * 64; i += GT) { const int ln = i & 63, ks = (i >> 6) & 3, nf = (i >> 8) & 7, g = i >> 11, cq = ln >> 4, p = 16 * nf + (ln & 15);
        const float* wr = F.inp(I_CM_WS) + (size_t)(g * 128 + p) * 128 + 32 * ks + 4 * cq;
        u32x4 o; o.x = f2bf(wr[0]) | (f2bf(wr[1]) << 16); o.y = f2bf(wr[2]) | (f2bf(wr[3]) << 16); o.z = f2bf(wr[16]) | (f2bf(wr[17]) << 16); o.w = f2bf(wr[18]) | (f2bf(wr[19]) << 16);
        *(u32x4*)(F.WT + WE_WSB + (size_t)i * 8) = o; }
    for (int i = gt; i < 2 * PAST * D; i += GT) { const int b = i / (PAST * D), r = i % (PAST * D);
        F.KS[(size_t)b * TKS * D + r] = (bf16)f2bf(F.inp(I_CK)[i]); F.VS[(size_t)b * TKS * D + r] = (bf16)f2bf(F.inp(I_CV)[i]); }
}

__device__ __forceinline__ void bias2_gemm(Frame& F, const bf16* Wt, int N, int l, int sub, float* outp, int gw, int NGW) {
    float sh[3][16];
#pragma unroll
    for (int ci = 0; ci < 3; ++ci) { const GAS f32x4* sp = (const GAS f32x4*)(F.mod + (size_t)((l * 3 + ci) * 6 + sub * 3) * D + 16 * F.lane);
#pragma unroll
        for (int i = 0; i < 4; ++i) { const f32x4 v = sp[i]; sh[ci][4 * i] = v.x; sh[ci][4 * i + 1] = v.y; sh[ci][4 * i + 2] = v.z; sh[ci][4 * i + 3] = v.w; } }
    for (int n = gw; n < N; n += NGW) { const GAS u32x4* wp = (const GAS u32x4*)(Wt + (size_t)n * D + 16 * F.lane); const u32x4 w0 = wp[0], w1 = wp[1];
        const unsigned ww[8] = {w0.x, w0.y, w0.z, w0.w, w1.x, w1.y, w1.z, w1.w};
        float d0 = 0.f, d1 = 0.f, d2 = 0.f;
#pragma unroll
        for (int i = 0; i < 8; ++i) { const float lo = bf2f(ww[i]), hi = bf2f(ww[i] >> 16); d0 += sh[0][2 * i] * lo + sh[0][2 * i + 1] * hi; d1 += sh[1][2 * i] * lo + sh[1][2 * i + 1] * hi; d2 += sh[2][2 * i] * lo + sh[2][2 * i + 1] * hi; }
        d0 = wave_sum(d0); d1 = wave_sum(d1); d2 = wave_sum(d2);
        if (F.lane == 0) { outp[n] = d0; outp[(size_t)N + n] = d1; outp[(size_t)2 * N + n] = d2; } }
}
__device__ __forceinline__ void bias2_slot(Frame& F, int slot, int gw, int NGW) {
    if (slot == 2) bias2_gemm(F, F.WT + WE_CM_IN, 2 * DB, 1, 0, F.bias2 + B2_CM, gw, NGW);
    else if (slot == 3) bias2_gemm(F, F.WT + WE_UP + (size_t)1 * 2 * DFF * D, 2 * DFF, 1, 1, F.bias2 + B2_UP + (size_t)1 * 3 * 5632, gw, NGW);
    else if (slot == 4) bias2_gemm(F, F.WT + WE_QKV, 3 * D, 2, 0, F.bias2 + B2_QKV, gw, NGW);
    else if (slot == 5) bias2_gemm(F, F.WT + WE_UP + (size_t)2 * 2 * DFF * D, 2 * DFF, 2, 1, F.bias2 + B2_UP + (size_t)2 * 3 * 5632, gw, NGW);
    else if (slot == 6) bias2_gemm(F, F.WT + WE_LRU_IN + (size_t)2 * DRNN * D, 2 * DRNN, 3, 0, F.bias2 + B2_LRU + 3 * 2560, gw, NGW);
    else if (slot == 7) bias2_gemm(F, F.WT + WE_UP + (size_t)3 * 2 * DFF * D, 2 * DFF, 3, 1, F.bias2 + B2_UP + (size_t)3 * 3 * 5632, gw, NGW);
}
__device__ __forceinline__ void side_job(Frame& F, int slot) {
    F.fresh();
    const int nwk = F.G > 160 ? F.G - 160 : F.G, wk = F.G > 160 ? F.bid - 160 : F.bid;
    if (wk < 0) return;
    const int gw = wk * NWAVES + F.wave, NGW = nwk * NWAVES;
    bias2_slot(F, slot, gw, NGW);
    if (slot == 1) convert_slot<1>(F, gw, NGW); else if (slot == 2) convert_slot<2>(F, gw, NGW); else if (slot == 3) convert_slot<3>(F, gw, NGW); else if (slot == 4) convert_slot<4>(F, gw, NGW);
}
__device__ __forceinline__ void phase_modulate0(Frame& F) {
    F.fresh();
    const int gw = F.bid * NWAVES + F.wave, NGW = F.G * NWAVES;
    const float* g = F.inp(I_NORMG);
    for (int row = gw; row < M; row += NGW) {
        const float* xr = xin_row(F, row); const float* scl = modp(F, 0, row, 1);
        f32x4 v[4]; float s = 0.f;
#pragma unroll
        for (int j = 0; j < 4; ++j) { v[j] = *(const GAS f32x4*)(xr + 4 * F.lane + 256 * j); s += v[j].x * v[j].x + v[j].y * v[j].y + v[j].z * v[j].z + v[j].w * v[j].w; }
        s = wave_sum(s);
        if (F.lane < 16) F.rsq0[(size_t)row * 16 + F.lane] = F.lane == 0 ? s : 0.f;
#pragma unroll
        for (int j = 0; j < 4; ++j) { const int c0 = 4 * F.lane + 256 * j; const f32x4 gg = *(const GAS f32x4*)(g + c0), c4 = *(const GAS f32x4*)(scl + c0);
            const f32x4 o = v[j] * gg * (1.f + c4); u32x2 w; w.x = f2bf(o.x) | (f2bf(o.y) << 16); w.y = f2bf(o.z) | (f2bf(o.w) << 16);
            *(GAS u32x2*)(F.H + (size_t)row * D + c0) = w; }
    }
    bias2_gemm(F, F.WT + WE_LRU_IN, 2 * DRNN, 0, 0, F.bias2 + B2_LRU, gw, NGW);
    bias2_gemm(F, F.WT + WE_UP, 2 * DFF, 0, 1, F.bias2 + B2_UP, gw, NGW);
}

template <class P>
__device__ __forceinline__ void gemm_naive(Frame& F, const P& p, int nbatch, int Mr, int N, int K) {
    F.fresh();
    LAS float* As = (LAS float*)F.lds;
    LAS float* Bs = As + 16 * 132;
    const int tid = F.tid, tx = tid & 31, ty = tid >> 5;
    const int tm = Mr / 128, tn = N / 128, per = tm * tn, total = per * nbatch;
    for (int t = F.bid; t < total; t += F.G) {
        const int b = t / per, r = t % per, pn = r / tm, pm = r % tm;
        const bf16* A; int lda; const float* W; int ldw; p.get(b, A, lda, W, ldw);
        float acc[8][4];
#pragma unroll
        for (int i = 0; i < 8; ++i)
#pragma unroll
            for (int j = 0; j < 4; ++j) acc[i][j] = 0.f;
        for (int k0 = 0; k0 < K; k0 += 16) {
            { const int row = tid >> 2, kq = (tid & 3) * 4;
              const u32x2 v = *(const u32x2*)(A + (size_t)(pm * 128 + row) * lda + k0 + kq);
              As[(kq + 0) * 132 + row] = bf2f(v.x); As[(kq + 1) * 132 + row] = bf2f(v.x >> 16); As[(kq + 2) * 132 + row] = bf2f(v.y); As[(kq + 3) * 132 + row] = bf2f(v.y >> 16); }
            { const int k = tid >> 5, n4 = (tid & 31) * 4;
              *(LAS f32x4*)(Bs + k * 128 + n4) = *(const f32x4*)(W + (size_t)(k0 + k) * ldw + pn * 128 + n4); }
            __syncthreads();
#pragma unroll 2
            for (int k = 0; k < 16; ++k) {
                const f32x4 a0 = *(const LAS f32x4*)(As + k * 132 + ty * 8), a1 = *(const LAS f32x4*)(As + k * 132 + ty * 8 + 4), bv = *(const LAS f32x4*)(Bs + k * 128 + tx * 4);
                const float a[8] = {a0.x, a0.y, a0.z, a0.w, a1.x, a1.y, a1.z, a1.w}; const float bb[4] = {bv.x, bv.y, bv.z, bv.w};
#pragma unroll
                for (int i = 0; i < 8; ++i)
#pragma unroll
                    for (int j = 0; j < 4; ++j) acc[i][j] += a[i] * bb[j];
            }
            __syncthreads();
        }
#pragma unroll
        for (int i = 0; i < 8; ++i)
#pragma unroll
            for (int j = 0; j < 4; ++j) p.epi(b, pm * 128 + ty * 8 + i, pn * 128 + tx * 4 + j, acc[i][j]);
    }
}

struct PStoreBf16 {
    const bf16* A; int lda; const float* W; int ldw; bf16* O; int ldo; const float* bias; int act; int split;
    __device__ __forceinline__ void get(int, const bf16*& a, int& la, const float*& w, int& lw) const { a = A; la = lda; w = W; lw = ldw; }
    __device__ __forceinline__ void epi(int, int row, int col, float v) const {
        if (bias) v += bias[col];
        if (act == 1 || (act == 2 && col < split)) v = gelu_tanh(v);
        O[(size_t)row * ldo + col] = (bf16)f2bf(v); }
};
struct PResid {
    const bf16* A; int lda; const float* W; int ldw; float* out; const float* xp; const float* xs; const float* modl; int which; bool from_input;
    __device__ __forceinline__ void get(int, const bf16*& a, int& la, const float*& w, int& lw) const { a = A; la = lda; w = W; lw = ldw; }
    __device__ __forceinline__ void epi(int, int row, int col, float v) const {
        const float base = from_input ? (row < NPROMPT ? xp[(size_t)row * D + col] : xs[(size_t)(row - NPROMPT) * D + col]) : out[(size_t)row * D + col];
        out[(size_t)row * D + col] = base + modl[(size_t)(cidx_of(row) * 6 + which) * D + col] * v; }
};
struct PLruIn {
    const bf16* A; const float* W; bf16* GBp; bf16* RECp;
    __device__ __forceinline__ void get(int, const bf16*& a, int& la, const float*& w, int& lw) const { a = A; la = D; w = W; lw = 2 * DRNN; }
    __device__ __forceinline__ void epi(int, int row, int col, float v) const {
        if (col < DRNN) GBp[(size_t)row * DRNN + col] = (bf16)f2bf(gelu_tanh(v)); else RECp[(size_t)row * DRNN + col - DRNN] = (bf16)f2bf(v); }
};
struct PGates {
    const bf16* XC; const float* WG; const float* BG; bf16* O;
    __device__ __forceinline__ void get(int b, const bf16*& a, int& la, const float*& w, int& lw) const { a = XC + (b % 10) * 128; la = DRNN; w = WG + (size_t)b * 128 * 128; lw = 128; }
    __device__ __forceinline__ void epi(int b, int row, int col, float v) const { const int dg = b / 10, n = b % 10;
        O[((size_t)dg * M + row) * DRNN + n * 128 + col] = (bf16)f2bf(sigmoidf_(v + BG[dg * DRNN + n * 128 + col])); }
};

__device__ __forceinline__ void phase_lru_conv(Frame& F, int j, const bf16* REC, bf16* XC) {
    F.fresh();
    const float* cw = F.inp(I_LRU_CW) + (size_t)j * 4 * DRNN; const float* cb = F.inp(I_LRU_CB) + (size_t)j * DRNN;
    const int gt = F.bid * NT + F.tid, GT = F.G * NT;
    for (int i = gt; i < M * DRNN; i += GT) { const int row = i / DRNN, ch = i % DRNN;
        int t, T; if (row < NPROMPT) { t = row & 255; T = 256; } else { t = (row - NPROMPT) & 1023; T = 1024; }
        float s = cb[ch];
#pragma unroll
        for (int k = 0; k < 4; ++k) { const int tt = t + k - 2; if (tt >= 0 && tt < T) s += cw[k * DRNN + ch] * bf2f(REC[(size_t)(row + k - 2) * DRNN + ch]); }
        XC[i] = (bf16)f2bf(s); }
}
__device__ __forceinline__ void phase_lru_scan(Frame& F, int j, const bf16* GATES, const bf16* XC, const bf16* GB, bf16* HS) {
    F.fresh();
    const int gt = F.bid * NT + F.tid, GT = F.G * NT;
    const int NL = (2 + 32) * DRNN;
    for (int line = gt; line < NL; line += GT) {
        const int s = line / DRNN, ch = line % DRNN;
        int base, T; float h0f = 0.f, h0b = 0.f;
        if (s < 2) { base = NPROMPT + s * 1024; T = 1024; h0f = F.inp(I_STATE)[((size_t)(s * 2 + j) * 2 + 0) * DRNN + ch]; h0b = F.inp(I_STATE)[((size_t)(s * 2 + j) * 2 + 1) * DRNN + ch]; }
        else { base = (s - 2) * 256; T = 256; }
        const float spf = softplusf_(-F.inp(I_LRU_LAM)[(size_t)(j * 2 + 0) * DRNN + ch]), spb = softplusf_(-F.inp(I_LRU_LAM)[(size_t)(j * 2 + 1) * DRNN + ch]);
        float h = h0f;
        for (int t = 0; t < T; ++t) { const size_t o = (size_t)(base + t) * DRNN + ch;
            const float r = bf2f(GATES[o]), ig = bf2f(GATES[(size_t)M * DRNN + o]), xc = bf2f(XC[o]);
            const float la = -8.f * r * spf, a = expf(la), bx = sqrtf(-expm1f(2.f * la)) * (ig * xc);
            h = a * h + bx; HS[o] = (bf16)f2bf(h); }
        const float ff = h;
        h = h0b;
        for (int t = T - 1; t >= 0; --t) { const size_t o = (size_t)(base + t) * DRNN + ch;
            const float r = bf2f(GATES[(size_t)2 * M * DRNN + o]), ig = bf2f(GATES[(size_t)3 * M * DRNN + o]), xc = bf2f(XC[o]);
            const float la = -8.f * r * spb, a = expf(la), bx = sqrtf(-expm1f(2.f * la)) * (ig * xc);
            h = a * h + bx; HS[o] = (bf16)f2bf(bf2f(GB[o]) * (bf2f(HS[o]) + h)); }
        if (s >= 2) { float* st = F.out + O_STATE + ((size_t)((s - 2) * 2 + j) * 2) * DRNN; st[ch] = ff; st[DRNN + ch] = h; }
    }
}


typedef short bf16x8 __attribute__((ext_vector_type(8)));
typedef short v4i16_t __attribute__((ext_vector_type(4)));
constexpr int LRU_XS = 272;
constexpr int LRU_XC_OFF = 0, LRU_GB_OFF = 256 * LRU_XS;
template <bool REV>
__device__ __forceinline__ float lru_dir(LAS const unsigned char* xct, LAS unsigned char* hft, const bf16* wgt  ,
                                         const bf16* gbp  , float br, float bi, float sp, float hc, int wave, int lane, bool wantp, bf16* Pdst) {
    const int c = lane & 15, q = lane >> 4, qq = REV ? 3 - q : q;
    bf16x8 Br[4], Bi[4], Id;
#pragma unroll
    for (int ks = 0; ks < 4; ++ks) { Br[ks] = *(const GAS bf16x8*)(wgt + (size_t)(16 * wave + c) * 128 + 32 * ks + 8 * q);
                                     Bi[ks] = *(const GAS bf16x8*)(wgt + (size_t)10 * 128 * 128 + (size_t)(16 * wave + c) * 128 + 32 * ks + 8 * q); }
#pragma unroll
    for (int jj = 0; jj < 8; ++jj) Id[jj] = (8 * q + jj == 16 * (wave & 1) + c) ? (short)0x3F80 : (short)0;
    const int ksel = wave >> 1;
    const float nsp8 = -8.f * sp * 1.44269504f;
    float Pc = 1.f;
    unsigned short gcur[16], gnxt[16];
#pragma unroll
    for (int i = 0; i < 16; ++i) { gcur[i] = 0; gnxt[i] = 0; }
    if (REV) {
#pragma unroll
        for (int i = 0; i < 16; ++i) gcur[i] = *(const GAS unsigned short*)(gbp + (size_t)(16 * (12 + (i >> 2)) + 4 * q + (i & 3)) * DRNN); }
#pragma unroll 1
    for (int og = 0; og < 4; ++og) {
        if (REV && og < 3) {
#pragma unroll
            for (int i = 0; i < 16; ++i) gnxt[i] = *(const GAS unsigned short*)(gbp + (size_t)(16 * (4 * (2 - og) + (i >> 2)) + 4 * q + (i & 3)) * DRNN); }
#pragma unroll
        for (int ii = 0; ii < 4; ++ii) {
        const int it = 4 * og + ii, mi = REV ? 15 - it : it, mloc = REV ? 3 - ii : ii;
        LAS const unsigned char* rp = xct + (16 * mi + c) * LRU_XS + 16 * q;
        bf16x8 Af[4];
#pragma unroll
        for (int ks = 0; ks < 4; ++ks) Af[ks] = *(LAS const bf16x8*)(rp + 64 * ks);
        const bf16x8 Ax = *(LAS const bf16x8*)(rp + 64 * ksel);
        f32x4 r = {0.f, 0.f, 0.f, 0.f}, ig = {0.f, 0.f, 0.f, 0.f};
#pragma unroll
        for (int ks = 0; ks < 4; ++ks) { r = __builtin_amdgcn_mfma_f32_16x16x32_bf16(Af[ks], Br[ks], r, 0, 0, 0); ig = __builtin_amdgcn_mfma_f32_16x16x32_bf16(Af[ks], Bi[ks], ig, 0, 0, 0); }
        const f32x4 xc = __builtin_amdgcn_mfma_f32_16x16x32_bf16(Ax, Id, (f32x4){0.f, 0.f, 0.f, 0.f}, 0, 0, 0);
        float av[4], bv[4];
#pragma unroll
        for (int k = 0; k < 4; ++k) { const float rg = __builtin_amdgcn_rcpf(1.f + __builtin_amdgcn_exp2f(-1.44269504f * (r[k] + br))), iv = __builtin_amdgcn_rcpf(1.f + __builtin_amdgcn_exp2f(-1.44269504f * (ig[k] + bi)));
            const float l2a = nsp8 * rg, x = 1.38629436f * l2a;
            const float oms = -x * (1.f + x * (0.5f + x * (0.16666667f + x * (0.041666668f + x * 0.0083333338f))));
            const float om = x > -0.25f ? oms : 1.f - __builtin_amdgcn_exp2f(2.f * l2a);
            av[k] = __builtin_amdgcn_exp2f(l2a); bv[k] = __builtin_amdgcn_sqrtf(om) * (iv * xc[k]); }
        float pA[4], pB[4];
#pragma unroll
        for (int kk = 0; kk < 4; ++kk) { const int k = REV ? 3 - kk : kk;
            if (kk == 0) { pA[k] = av[k]; pB[k] = bv[k]; } else { const int kp = REV ? k + 1 : k - 1; pA[k] = pA[kp] * av[k]; pB[k] = pB[kp] * av[k] + bv[k]; } }
        const int kl = REV ? 0 : 3;
        float gA[4], gB[4];
#pragma unroll
        for (int g = 0; g < 4; ++g) { const int src = 16 * (REV ? 3 - g : g) + c; gA[g] = bperm(pA[kl], src); gB[g] = bperm(pB[kl], src); }
        float eA = 1.f, eB = 0.f, tA = 1.f, tB = 0.f;
#pragma unroll
        for (int g = 0; g < 4; ++g) { if (g == qq) { eA = tA; eB = tB; } tB = tB * gA[g] + gB[g]; tA = tA * gA[g]; }
        const float hin = eA * hc + eB;
#pragma unroll
        for (int k = 0; k < 4; ++k) { const float h = pA[k] * hin + pB[k]; const int row = 16 * mi + 4 * q + k;
            if (wantp) Pdst[(size_t)row * DRNN] = (bf16)f2bf(pA[k] * eA * Pc);
            LAS unsigned short* hp = (LAS unsigned short*)(hft + row * LRU_XS + 2 * (16 * wave + c));
            if (!REV) *hp = (unsigned short)f2bf(h); else *hp = (unsigned short)f2bf(bf2f(gcur[4 * mloc + k]) * (bf2f(*hp) + h)); }
        hc = tA * hc + tB; Pc *= tA;
        }
        if (REV) {
#pragma unroll
            for (int i = 0; i < 16; ++i) gcur[i] = gnxt[i]; }
    }
    return hc;
}
__device__ __forceinline__ void lru_unit(Frame& F, int j, int pm, int n, const bf16* REC, const bf16* GB, bf16* HS, bf16* PF, bf16* PB, float* AGG, const bf16* WGT) {
    const int tid = F.tid, lane = F.lane, wave = F.wave, r0 = 256 * pm;
    const bool smp = pm >= 32; const int tix = smp ? (pm - 32) & 3 : 0, sq = smp ? (pm - 32) >> 2 : 0;
    const int t0 = smp ? 256 * tix : 0, T = smp ? 1024 : 256;
    LAS unsigned char* xct = F.lds + LRU_XC_OFF; LAS unsigned char* hft = F.lds + LRU_GB_OFF;
    { const float* cw = F.inp(I_LRU_CW) + (size_t)j * 4 * DRNN + n * 128 + 2 * lane; const float* cb = F.inp(I_LRU_CB) + (size_t)j * DRNN + n * 128 + 2 * lane;
      float w0[4], w1[4];
#pragma unroll
      for (int k = 0; k < 4; ++k) { w0[k] = cw[k * DRNN]; w1[k] = cw[k * DRNN + 1]; }
      const float b0 = cb[0], b1 = cb[1];
      unsigned v[35];
#pragma unroll
      for (int i = 0; i < 35; ++i) { const int tl = 32 * wave + i - 2, tt = t0 + tl;
          v[i] = (tt >= 0 && tt < T) ? *(const GAS unsigned*)(REC + (size_t)(r0 + tl) * DRNN + n * 128 + 2 * lane) : 0u; }
#pragma unroll
      for (int i = 0; i < 32; ++i) { float s0 = b0, s1 = b1;
#pragma unroll
          for (int k = 0; k < 4; ++k) { s0 += w0[k] * bf2f(v[i + k]); s1 += w1[k] * bf2f(v[i + k] >> 16); }
          *(LAS unsigned*)(xct + (32 * wave + i) * LRU_XS + 4 * lane) = f2bf(s0) | (f2bf(s1) << 16); } }
    __syncthreads();
    const int c = lane & 15, q = lane >> 4, ch = n * 128 + 16 * wave + c;
    const float* bg = F.inp(I_LRU_BG) + (size_t)j * 4 * DRNN; const float* lam = F.inp(I_LRU_LAM) + (size_t)j * 2 * DRNN;
    const bf16* gbp = GB + (size_t)r0 * DRNN + ch;
    bf16* pf = PF + (size_t)(smp ? r0 - NPROMPT : 0) * DRNN + ch; bf16* pb = PB + (size_t)(smp ? r0 - NPROMPT : 0) * DRNN + ch;
    { float h0 = 0.f; if (smp && tix == 0) h0 = F.inp(I_STATE)[((size_t)(sq * 2 + j) * 2 + 0) * DRNN + ch];
      const float hfin = lru_dir<false>(xct, hft, WGT + (size_t)(0 * 10 + n) * 128 * 128, gbp, bg[0 * DRNN + ch], bg[1 * DRNN + ch], softplusf_(-lam[ch]), h0, wave, lane, smp, pf);
      if (q == 0) { if (smp) AGG[(size_t)((sq * 4 + tix) * 2 + 0) * DRNN + ch] = hfin; else F.out[O_STATE + ((size_t)(pm * 2 + j) * 2 + 0) * DRNN + ch] = hfin; } }
    { float h0 = 0.f; if (smp && tix == 3) h0 = F.inp(I_STATE)[((size_t)(sq * 2 + j) * 2 + 1) * DRNN + ch];
      const float hfin = lru_dir<true>(xct, hft, WGT + (size_t)(2 * 10 + n) * 128 * 128, gbp, bg[2 * DRNN + ch], bg[3 * DRNN + ch], softplusf_(-lam[DRNN + ch]), h0, wave, lane, smp, pb);
      if (q == 0) { if (smp) AGG[(size_t)((sq * 4 + tix) * 2 + 1) * DRNN + ch] = hfin; else F.out[O_STATE + ((size_t)(pm * 2 + j) * 2 + 1) * DRNN + ch] = hfin; } }
    __syncthreads();
#pragma unroll
    for (int i = 0; i < 8; ++i) { const int id = i * NT + tid, row = id >> 4, cc = id & 15;
        *(GAS u32x4*)(HS + (size_t)(r0 + row) * DRNN + n * 128 + 8 * cc) = *(LAS const u32x4*)(hft + row * LRU_XS + 16 * cc); }
    __syncthreads();
}
__device__ __forceinline__ void phase_lru_core(Frame& F, int j, const bf16* REC, const bf16* GB, bf16* HS, bf16* PF, bf16* PB, float* AGG, const bf16* WGT) {
    F.fresh();
    for (int u = F.bid; u < 400; u += F.G) {
        const int pm = u < 80 ? 32 + u / 10 : (u - 80) / 10, n = u % 10;
        lru_unit(F, j, pm, n, REC, GB, HS, PF, PB, AGG, WGT); }
}
__device__ __forceinline__ void phase_lru_fixup(Frame& F, const bf16* GB, bf16* HS, const bf16* PF, const bf16* PB, const float* AGG) {
    F.fresh();
    const int gt = F.bid * NT + F.tid, GT = F.G * NT;
    for (int i = gt; i < NSAMPLE * DRNN; i += GT) { const int rs = i / DRNN, ch = i % DRNN, sq = rs >> 10, tix = (rs >> 8) & 3;
        float cf = 0.f, cbk = 0.f;
        if (tix > 0) { for (int t = 0; t < tix; ++t) { const float At = bf2f(PF[(size_t)(sq * 1024 + t * 256 + 255) * DRNN + ch]); cf = At * cf + AGG[(size_t)((sq * 4 + t) * 2 + 0) * DRNN + ch]; } }
        if (tix < 3) { for (int t = 3; t > tix; --t) { const float At = bf2f(PB[(size_t)(sq * 1024 + t * 256) * DRNN + ch]); cbk = At * cbk + AGG[(size_t)((sq * 4 + t) * 2 + 1) * DRNN + ch]; } }
        const size_t o = (size_t)(NPROMPT + rs) * DRNN + ch;
        HS[o] = (bf16)f2bf(bf2f(HS[o]) + bf2f(GB[o]) * (bf2f(PF[(size_t)rs * DRNN + ch]) * cf + bf2f(PB[(size_t)rs * DRNN + ch]) * cbk)); }
}

__device__ __forceinline__ void phase_cmlp_rstd(Frame& F, const bf16* UV) {
    F.fresh();
    const int gw = F.bid * NWAVES + F.wave, NGW = F.G * NWAVES;
    for (int row = gw; row < M; row += NGW) { float s = 0.f;
        for (int c = F.lane; c < DB; c += 64) { const float v = bf2f(UV[(size_t)row * 2 * DB + DB + c]); s += v * v; }
        s = wave_sum(s); if (F.lane == 0) F.rstd[row] = rsqrtf(s * (1.f / DB) + EPS); }
}
__device__ __forceinline__ void phase_cmlp_spatial(Frame& F, const bf16* UV, bf16* ACT) {
    F.fresh();
    const float* ws = F.inp(I_CM_WS); const float* bs = F.inp(I_CM_BS); const float* ng = F.inp(I_CM_NG);
    const int gt = F.bid * NT + F.tid, GT = F.G * NT;
    for (int i = gt; i < M * DB; i += GT) { const int row = i / DB, ch = i % DB, g = ch >> 8, p = row & 127, r0 = row & ~127;
        float s = 0.f;
        for (int q = 0; q < 128; ++q) s += ws[(size_t)(g * 128 + p) * 128 + q] * F.rstd[r0 + q] * bf2f(UV[(size_t)(r0 + q) * 2 * DB + DB + ch]);
        const float sv = s * ng[ch] + bs[g * 128 + p];
        ACT[i] = (bf16)f2bf(bf2f(UV[(size_t)row * 2 * DB + ch]) * sv); }
}


constexpr int CM_VS = 544;
__device__ __forceinline__ void phase_cmlp_spatial_mfma(Frame& F, const bf16* UV, bf16* ACT, const bf16* WSB) {
    F.fresh();
    const int tid = F.tid, lane = F.lane, wave = F.wave, c = lane & 15, q4 = lane >> 4;
    LAS unsigned char* vt = F.lds;
    const float* ng = F.inp(I_CM_NG); const float* bs = F.inp(I_CM_BS);
    for (int u = F.bid; u < 640; u += F.G) {
        const int chunk = u >> 3, g = u & 7, r0 = chunk * 128;
        LAS float* rsl = (LAS float*)(vt + 128 * CM_VS);
        if (tid < 128) { const GAS f32x4* p = (const GAS f32x4*)(F.rsqv + (size_t)(r0 + tid) * 32); float sm = 0.f;
#pragma unroll
            for (int i = 0; i < 8; ++i) { const f32x4 t4 = p[i]; sm += (t4.x + t4.y) + (t4.z + t4.w); }
            rsl[tid] = rsqrtf(sm * (1.f / DB) + EPS); }
        __syncthreads();
#pragma unroll
        for (int i = 0; i < 8; ++i) { const int id = i * NT + tid, row = id >> 5, cc = id & 31;
            const u32x4 x = *(const GAS u32x4*)(UV + (size_t)(r0 + row) * 2 * DB + DB + g * 256 + 8 * cc); const float rs = rsl[row];
            u32x4 y; y.x = f2bf(bf2f(x.x) * rs) | (f2bf(bf2f(x.x >> 16) * rs) << 16); y.y = f2bf(bf2f(x.y) * rs) | (f2bf(bf2f(x.y >> 16) * rs) << 16);
            y.z = f2bf(bf2f(x.z) * rs) | (f2bf(bf2f(x.z >> 16) * rs) << 16); y.w = f2bf(bf2f(x.w) * rs) | (f2bf(bf2f(x.w >> 16) * rs) << 16);
            *(LAS u32x4*)(vt + row * CM_VS + 16 * cc) = y; }
        __syncthreads();
        bf16x8 vf[2][4];
#pragma unroll
        for (int mfc = 0; mfc < 2; ++mfc)
#pragma unroll
            for (int ks = 0; ks < 4; ++ks) { LAS const unsigned char* vp = vt + (32 * ks + 4 * q4 + (c >> 2)) * CM_VS + (32 * wave + 16 * mfc + 4 * (c & 3)) * 2;
                const v4i16_t lo = __builtin_amdgcn_ds_read_tr16_b64_v4i16((LAS v4i16_t*)vp), hi = __builtin_amdgcn_ds_read_tr16_b64_v4i16((LAS v4i16_t*)(vp + 16 * CM_VS));
                vf[mfc][ks] = (bf16x8){lo[0], lo[1], lo[2], lo[3], hi[0], hi[1], hi[2], hi[3]}; }
#pragma unroll
        for (int nf = 0; nf < 8; ++nf) {
            bf16x8 Bf[4];
#pragma unroll
            for (int ks = 0; ks < 4; ++ks) Bf[ks] = *(const GAS bf16x8*)(WSB + ((size_t)((g * 8 + nf) * 4 + ks) * 64 + lane) * 8);
            const int p = 16 * nf + c; const float bsv = bs[g * 128 + p];
#pragma unroll
            for (int mfc = 0; mfc < 2; ++mfc) { f32x4 acc = {0.f, 0.f, 0.f, 0.f};
#pragma unroll
                for (int ks = 0; ks < 4; ++ks) acc = __builtin_amdgcn_mfma_f32_16x16x32_bf16(vf[mfc][ks], Bf[ks], acc, 0, 0, 0);
                const int ch = g * 256 + 32 * wave + 16 * mfc + 4 * q4;
                const f32x4 g4 = *(const GAS f32x4*)(ng + ch); const u32x2 uu = *(const GAS u32x2*)(UV + (size_t)(r0 + p) * 2 * DB + ch);
                const float o0 = bf2f(uu.x) * (acc[0] * g4.x + bsv), o1 = bf2f(uu.x >> 16) * (acc[1] * g4.y + bsv), o2 = bf2f(uu.y) * (acc[2] * g4.z + bsv), o3 = bf2f(uu.y >> 16) * (acc[3] * g4.w + bsv);
                u32x2 w; w.x = f2bf(o0) | (f2bf(o1) << 16); w.y = f2bf(o2) | (f2bf(o3) << 16);
                *(GAS u32x2*)(ACT + (size_t)(r0 + p) * DB + ch) = w; }
        }
        __syncthreads();
    }
}

__device__ __forceinline__ void phase_qkv_post(Frame& F, const bf16* QKV, bf16* Q, bf16* KP, bf16* VP) {
    F.fresh();
    const int gw = F.bid * NWAVES + F.wave, NGW = F.G * NWAVES;
    const float* qkg = F.inp(I_AT_QKG);
    for (int row = gw; row < M; row += NGW) {
        const bool smp = row >= NPROMPT; const int sb = smp ? (row - NPROMPT) >> 10 : 0, t = smp ? (row - NPROMPT) & 1023 : 0;
        const float cs = smp ? F.rope[t * 32 + (F.lane & 31)] : 1.f, sn = smp ? F.rope[32768 + t * 32 + (F.lane & 31)] : 0.f;
        for (int grp = 0; grp < 32; ++grp) {
            const float v = bf2f(QKV[(size_t)row * 3072 + grp * 64 + F.lane]);
            const float ms = wave_sum(v * v) * (1.f / 64.f);
            float n = v * rsqrtf(ms + EPS) * qkg[(grp >> 4) * 64 + F.lane];
            const float keep = n;
            if (smp) { float pr; { auto r_ = __builtin_amdgcn_permlane32_swap(__builtin_bit_cast(unsigned, n), __builtin_bit_cast(unsigned, n), false, false); pr = __builtin_bit_cast(float, F.lane < 32 ? (unsigned)r_[1] : (unsigned)r_[0]); } n = F.lane < 32 ? n * cs - pr * sn : n * cs + pr * sn; }
            if (grp < 16) Q[(size_t)row * D + grp * 64 + F.lane] = (bf16)f2bf(n);
            else { const int c = (grp - 16) * 64 + F.lane;
                if (smp) F.KS[((size_t)sb * TKS + PAST + t) * D + c] = (bf16)f2bf(n);
                else { KP[(size_t)row * D + c] = (bf16)f2bf(keep); F.out[O_CK + (size_t)row * D + c] = keep; } }
        }
        for (int c = F.lane; c < D; c += 64) { const bf16 vb = QKV[(size_t)row * 3072 + 2048 + c];
            if (smp) F.VS[((size_t)sb * TKS + PAST + t) * D + c] = vb; else { VP[(size_t)row * D + c] = vb; F.out[O_CV + (size_t)row * D + c] = bf2f(vb); } }
    }
}
__device__ __forceinline__ void phase_attn_naive(Frame& F, int l, const bf16* Q, const bf16* KP, const bf16* VP, bf16* O) {
    F.fresh();
    const int gw = F.bid * NWAVES + F.wave, NGW = F.G * NWAVES;
    LAS float* s1 = (LAS float*)F.lds + F.wave * 3328; LAS float* s2 = s1 + 1536; LAS float* qs = s2 + 1536;
    const float* al = F.inp(I_AT_LAM);
    const float lam_init = 0.8f - 0.6f * expf(-0.3f * (float)l);
    const float lam = expf(wave_sum(al[F.lane] * al[64 + F.lane])) - expf(wave_sum(al[128 + F.lane] * al[192 + F.lane])) + lam_init;
    const float* sg = F.inp(I_AT_SUBG);
    for (int item = gw; item < M * 8; item += NGW) {
        const int row = item >> 3, h = item & 7;
        const bf16 *Kb, *Vb; int Tk;
        if (row < NPROMPT) { Kb = KP + (size_t)(row & ~255) * D; Vb = VP + (size_t)(row & ~255) * D; Tk = 256; }
        else { const int sb = (row - NPROMPT) >> 10; Kb = F.KS + (size_t)sb * TKS * D; Vb = F.VS + (size_t)sb * TKS * D; Tk = TKS; }
        qs[F.lane] = bf2f(Q[(size_t)row * D + h * 128 + F.lane]); qs[64 + F.lane] = bf2f(Q[(size_t)row * D + h * 128 + 64 + F.lane]);
        asm volatile("s_waitcnt lgkmcnt(0)" ::: "memory");
        float m1 = -1e30f, m2 = -1e30f;
        for (int k = F.lane; k < Tk; k += 64) { const bf16* kr = Kb + (size_t)k * D + h * 128; float d1 = 0.f, d2 = 0.f;
#pragma unroll 4
            for (int d = 0; d < 64; d += 2) { const unsigned a = *(const unsigned*)(kr + d), b = *(const unsigned*)(kr + 64 + d);
                d1 += qs[d] * bf2f(a) + qs[d + 1] * bf2f(a >> 16); d2 += qs[64 + d] * bf2f(b) + qs[64 + d + 1] * bf2f(b >> 16); }
            d1 *= 0.125f; d2 *= 0.125f; s1[k] = d1; s2[k] = d2; m1 = fmaxf(m1, d1); m2 = fmaxf(m2, d2); }
        m1 = wave_max(m1); m2 = wave_max(m2);
        float l1 = 0.f, l2 = 0.f;
        for (int k = F.lane; k < Tk; k += 64) { const float e1 = expf(s1[k] - m1), e2 = expf(s2[k] - m2); s1[k] = e1; s2[k] = e2; l1 += e1; l2 += e2; }
        l1 = wave_sum(l1); l2 = wave_sum(l2);
        const float i1 = 1.f / l1, i2 = lam / l2;
        for (int k = F.lane; k < Tk; k += 64) s1[k] = bf2f(f2bf(s1[k] * i1 - s2[k] * i2));
        asm volatile("s_waitcnt lgkmcnt(0)" ::: "memory");
        float o0 = 0.f, o1 = 0.f;
        for (int k = 0; k < Tk; ++k) { const unsigned vv = *(const unsigned*)(Vb + (size_t)k * D + h * 128 + 2 * F.lane); const float w = s1[k]; o0 += w * bf2f(vv); o1 += w * bf2f(vv >> 16); }
        const float ms = wave_sum(o0 * o0 + o1 * o1) * (1.f / 128.f), rs = rsqrtf(ms + EPS) * (1.f - lam_init);
        o0 = o0 * rs * sg[2 * F.lane]; o1 = o1 * rs * sg[2 * F.lane + 1];
        *(unsigned*)(O + (size_t)row * D + h * 128 + 2 * F.lane) = f2bf(o0) | (f2bf(o1) << 16);
        asm volatile("s_waitcnt lgkmcnt(0)" ::: "memory");
    }
}


constexpr int AT_KS = 272, AT_VS = 288, AT_KBYTES = 64 * AT_KS, AT_VBYTES = 64 * AT_VS, AT_BUF = AT_KBYTES + AT_VBYTES;
__device__ __forceinline__ void attn_unit(Frame& F, int l, const bf16* Qrows  , const bf16* Kb, const bf16* Vb, int Tk, bf16* Orows, int h, float lam, float lam_init) {
    const int tid = F.tid, lane = F.lane, wave = F.wave, c = lane & 15, q4 = lane >> 4;
    LAS unsigned char* lds = F.lds;
    const float SC = 0.18033688f;
    bf16x8 Qf[2][2];
#pragma unroll
    for (int cp = 0; cp < 2; ++cp)
#pragma unroll
        for (int ks = 0; ks < 2; ++ks) Qf[cp][ks] = *(const GAS bf16x8*)(Qrows + (size_t)(16 * wave + c) * D + h * 128 + cp * 64 + 32 * ks + 8 * q4);
    const int nt = Tk / 64;
    const int key0 = tid >> 4, cc0 = tid & 15;
    u32x4 kreg[2], vreg[2];
    float m1 = -1e30f, m2 = -1e30f, l1 = 0.f, l2 = 0.f;
#pragma unroll
    for (int i = 0; i < 2; ++i) kreg[i] = *(const GAS u32x4*)(Kb + (size_t)(key0 + 32 * i) * D + h * 128 + 8 * cc0);
#pragma unroll
    for (int i = 0; i < 2; ++i) *(LAS u32x4*)(lds + (key0 + 32 * i) * AT_KS + 16 * cc0) = kreg[i];
    __syncthreads();
    for (int t = 0; t < nt; ++t) {
        LAS const unsigned char* kt = lds + (t & 1) * AT_BUF;
        if (t + 1 < nt) {
#pragma unroll
            for (int i = 0; i < 2; ++i) kreg[i] = *(const GAS u32x4*)(Kb + (size_t)((t + 1) * 64 + key0 + 32 * i) * D + h * 128 + 8 * cc0); }
        f32x4 S[2][4];
#pragma unroll
        for (int cp = 0; cp < 2; ++cp)
#pragma unroll
            for (int mf = 0; mf < 4; ++mf) { S[cp][mf] = (f32x4){0.f, 0.f, 0.f, 0.f};
#pragma unroll
                for (int ks = 0; ks < 2; ++ks) { const bf16x8 kf = *(LAS const bf16x8*)(kt + (16 * mf + c) * AT_KS + cp * 128 + ks * 64 + 16 * q4);
                    S[cp][mf] = __builtin_amdgcn_mfma_f32_16x16x32_bf16(kf, Qf[cp][ks], S[cp][mf], 0, 0, 0); } }
        float x1 = -1e30f, x2 = -1e30f;
#pragma unroll
        for (int mf = 0; mf < 4; ++mf)
#pragma unroll
            for (int k = 0; k < 4; ++k) { x1 = fmaxf(x1, S[0][mf][k]); x2 = fmaxf(x2, S[1][mf][k]); }
        x1 = max_q4(x1); x2 = max_q4(x2);
        const float n1 = fmaxf(m1, x1), n2 = fmaxf(m2, x2);
        l1 *= exp2f((m1 - n1) * SC); l2 *= exp2f((m2 - n2) * SC); m1 = n1; m2 = n2;
#pragma unroll
        for (int mf = 0; mf < 4; ++mf)
#pragma unroll
            for (int k = 0; k < 4; ++k) { l1 += exp2f((S[0][mf][k] - m1) * SC); l2 += exp2f((S[1][mf][k] - m2) * SC); }
        if (t + 1 < nt) {
#pragma unroll
            for (int i = 0; i < 2; ++i) *(LAS u32x4*)(lds + ((t + 1) & 1) * AT_BUF + (key0 + 32 * i) * AT_KS + 16 * cc0) = kreg[i]; }
        __syncthreads();
    }
    l1 = sum_q4(l1); l2 = sum_q4(l2);
    const float i1 = 1.f / l1, i2 = lam / l2;
    f32x4 Ot[8];
#pragma unroll
    for (int md = 0; md < 8; ++md) Ot[md] = (f32x4){0.f, 0.f, 0.f, 0.f};
#pragma unroll
    for (int i = 0; i < 2; ++i) { kreg[i] = *(const GAS u32x4*)(Kb + (size_t)(key0 + 32 * i) * D + h * 128 + 8 * cc0); vreg[i] = *(const GAS u32x4*)(Vb + (size_t)(key0 + 32 * i) * D + h * 128 + 8 * cc0); }
#pragma unroll
    for (int i = 0; i < 2; ++i) { *(LAS u32x4*)(lds + (key0 + 32 * i) * AT_KS + 16 * cc0) = kreg[i]; *(LAS u32x4*)(lds + AT_KBYTES + (key0 + 32 * i) * AT_VS + 16 * cc0) = vreg[i]; }
    __syncthreads();
    for (int t = 0; t < nt; ++t) {
        LAS const unsigned char* kt = lds + (t & 1) * AT_BUF; LAS const unsigned char* vt = kt + AT_KBYTES;
        if (t + 1 < nt) {
#pragma unroll
            for (int i = 0; i < 2; ++i) { kreg[i] = *(const GAS u32x4*)(Kb + (size_t)((t + 1) * 64 + key0 + 32 * i) * D + h * 128 + 8 * cc0);
                                          vreg[i] = *(const GAS u32x4*)(Vb + (size_t)((t + 1) * 64 + key0 + 32 * i) * D + h * 128 + 8 * cc0); } }
        f32x4 S[2][4];
#pragma unroll
        for (int cp = 0; cp < 2; ++cp)
#pragma unroll
            for (int mf = 0; mf < 4; ++mf) { S[cp][mf] = (f32x4){0.f, 0.f, 0.f, 0.f};
#pragma unroll
                for (int ks = 0; ks < 2; ++ks) { const bf16x8 kf = *(LAS const bf16x8*)(kt + (16 * mf + c) * AT_KS + cp * 128 + ks * 64 + 16 * q4);
                    S[cp][mf] = __builtin_amdgcn_mfma_f32_16x16x32_bf16(kf, Qf[cp][ks], S[cp][mf], 0, 0, 0); } }
        bf16x8 Wf[2];
#pragma unroll
        for (int kk = 0; kk < 2; ++kk)
#pragma unroll
            for (int jj = 0; jj < 8; ++jj) { const int mf = 2 * kk + (jj >> 2), k = jj & 3;
                const float w = exp2f((S[0][mf][k] - m1) * SC) * i1 - exp2f((S[1][mf][k] - m2) * SC) * i2; Wf[kk][jj] = (short)f2bf(w); }
#pragma unroll
        for (int md = 0; md < 8; ++md)
#pragma unroll
            for (int kk = 0; kk < 2; ++kk) { LAS const unsigned char* vp = vt + (32 * kk + 4 * q4 + (c >> 2)) * AT_VS + (16 * md + 4 * (c & 3)) * 2;
                const v4i16_t lo = __builtin_amdgcn_ds_read_tr16_b64_v4i16((LAS v4i16_t*)vp), hi = __builtin_amdgcn_ds_read_tr16_b64_v4i16((LAS v4i16_t*)(vp + 16 * AT_VS));
                const bf16x8 vf = {lo[0], lo[1], lo[2], lo[3], hi[0], hi[1], hi[2], hi[3]};
                Ot[md] = __builtin_amdgcn_mfma_f32_16x16x32_bf16(vf, Wf[kk], Ot[md], 0, 0, 0); }
        if (t + 1 < nt) {
#pragma unroll
            for (int i = 0; i < 2; ++i) { *(LAS u32x4*)(lds + ((t + 1) & 1) * AT_BUF + (key0 + 32 * i) * AT_KS + 16 * cc0) = kreg[i];
                                          *(LAS u32x4*)(lds + ((t + 1) & 1) * AT_BUF + AT_KBYTES + (key0 + 32 * i) * AT_VS + 16 * cc0) = vreg[i]; } }
        __syncthreads();
    }
    float ss = 0.f;
#pragma unroll
    for (int md = 0; md < 8; ++md)
#pragma unroll
        for (int k = 0; k < 4; ++k) ss += Ot[md][k] * Ot[md][k];
    ss = sum_q4(ss);
    const float rs = rsqrtf(ss * (1.f / 128.f) + EPS) * (1.f - lam_init);
    const float* sg = F.inp(I_AT_SUBG);
#pragma unroll
    for (int md = 0; md < 8; ++md) { const int d0 = 16 * md + 4 * q4; const f32x4 g4 = *(const GAS f32x4*)(sg + d0);
        u32x2 w; w.x = f2bf(Ot[md][0] * rs * g4.x) | (f2bf(Ot[md][1] * rs * g4.y) << 16); w.y = f2bf(Ot[md][2] * rs * g4.z) | (f2bf(Ot[md][3] * rs * g4.w) << 16);
        *(GAS u32x2*)(Orows + (size_t)(16 * wave + c) * D + h * 128 + d0) = w; }
}
__device__ __forceinline__ void phase_attn(Frame& F, int l, const bf16* Q, const bf16* KP, const bf16* VP, bf16* O) {
    F.fresh();
    const float* al = F.inp(I_AT_LAM);
    const float lam_init = 0.8f - 0.6f * expf(-0.3f * (float)l);
    const float lam = expf(wave_sum(al[F.lane] * al[64 + F.lane])) - expf(wave_sum(al[128 + F.lane] * al[192 + F.lane])) + lam_init;
    for (int s = 0; ; ++s) {
        int u;
        if (F.G == 256) { if (F.bid < 128) { if (s > 0) break; u = F.bid; } else { if (s > 3) break; u = 128 + 4 * (F.bid - 128) + s; } }
        else { u = F.bid + s * F.G; if (u >= 640) break; }
        if (u < 128) { const int sb = u >> 6, h = (u >> 3) & 7, qt = u & 7; const size_t r0 = (size_t)NPROMPT + sb * 1024 + qt * 128;
            attn_unit(F, l, Q + r0 * D, F.KS + (size_t)sb * TKS * D, F.VS + (size_t)sb * TKS * D, TKS, O + r0 * D, h, lam, lam_init); }
        else { const int v = u - 128, b = v >> 4, h = (v >> 1) & 7, qt = v & 1; const size_t r0 = (size_t)b * 256 + qt * 128;
            attn_unit(F, l, Q + r0 * D, KP + (size_t)b * 256 * D, VP + (size_t)b * 256 * D, 256, O + r0 * D, h, lam, lam_init); }
    }
}

__device__ __forceinline__ void phase_ffn_convgate(Frame& F, int l, const bf16* Z, bf16* ACT) {
    F.fresh();
    const float* cw = F.inp(I_FF_CW) + (size_t)l * 3 * 2 * DFF; const float* cb = F.inp(I_FF_CB) + (size_t)l * 2 * DFF;
    const int gt = F.bid * NT + F.tid, GT = F.G * NT;
    for (int i = gt; i < M * DFF; i += GT) { const int row = i / DFF, j = i % DFF;
        int t, T; if (row < NPROMPT) { t = row & 255; T = 256; } else { t = (row - NPROMPT) & 1023; T = 1024; }
        float g = cb[j], u = cb[DFF + j];
#pragma unroll
        for (int k = 0; k < 3; ++k) { const int tt = t + k - 1; if (tt >= 0 && tt < T) { const bf16* zr = Z + (size_t)(row + k - 1) * 2 * DFF; g += cw[k * 2 * DFF + j] * bf2f(zr[j]); u += cw[k * 2 * DFF + DFF + j] * bf2f(zr[DFF + j]); } }
        ACT[i] = (bf16)f2bf(siluf_(g) * u); }
}

__global__ void __launch_bounds__(NT, 2) mk_fwd(Params prm) {
    extern __shared__ __attribute__((aligned(16))) unsigned char lds_raw[];
    Frame F;
    F.lds = (LAS unsigned char*)lds_raw; F.G = gridDim.x; F.out0 = prm.out; F.ws0 = prm.ws; F.wave0 = __builtin_amdgcn_readfirstlane(threadIdx.x >> 6);
    F.fresh();
    if (F.tid < N_IN) ((LAS unsigned long long*)(F.lds + PTR_OFF))[F.tid] = (unsigned long long)prm.in[F.tid];
    volatile LAS unsigned* MISC = (volatile LAS unsigned*)(F.lds + MISC_OFF);
    if (F.tid < 32) MISC[F.tid] = 0u;
    __syncthreads();
    (void)xcd_barrier_post((unsigned*)(prm.ws + WS_CTL) + CW_BAR, MISC + 8, F.tid == 0);
#define GRID_BAR() do { F.fresh(); XcdBarrier bar_; bar_.t0 = F.tid == 0; { unsigned* bp_ = (unsigned*)(prm.ws + WS_CTL) + CW_BAR; asm volatile("" : "+s"(bp_)); bar_.bar = bp_; } bar_.x = xb_xcc_id(); bar_.st = (volatile LAS unsigned*)(F.lds + MISC_OFF) + 8; xcd_barrier(bar_); } while (0)

#define GEMM_BF16(ACT, A_, Bt_, N_, K_, O_, ldc_, bias_, splitc_, splits_, rsq_, b2_, rsqv_, vt0_) do { pg8::Gemm g{A_, Bt_, M, N_, K_}; pg8::StaticOrder S; S.init(M, N_, F.G, F.bid); S.wave = F.wave; \
        pg8::EpiBf16<ACT> E{O_, ldc_, bias_, splitc_, splits_, rsq_, b2_, N_, rsqv_, vt0_, F.lds}; F.fresh(); E.prep(S, F.tid); pg8::gemm_phase<pg8::EpiBf16<ACT>, pg8::StaticOrder, true, true>(F.lds, g, S, E); } while (0)
#define GEMM_RESID(A_, Bt_, K_, sub_, fromin_) do { pg8::Gemm g{A_, Bt_, M, D, K_}; pg8::StaticOrder S; S.init(M, D, F.G, F.bid); S.wave = F.wave; \
        const int nl_ = (sub_) == 0 ? l : l + 1, ns_ = (sub_) == 0 ? 1 : 0; const bool last_ = nl_ >= DEPTH; \
        pg8::EpiResid E{F.out, F.inp(I_XP), F.inp(I_XS), F.mod + (size_t)l * 18 * D, (sub_) * 3 + 2, fromin_, last_ ? nullptr : F.H, F.inp(I_NORMG) + (size_t)((last_ ? 0 : nl_) * 2 + ns_) * D, \
                          F.mod + (size_t)(last_ ? 0 : nl_) * 18 * D, ns_ * 3 + 1, (sub_) == 0 ? F.rsq1 : F.rsq0, F.lds}; \
        F.fresh(); E.prep(S, F.tid); pg8::gemm_phase<pg8::EpiResid, pg8::StaticOrder, true, true>(F.lds, g, S, E); side_job(F, 2 * l + (sub_) + 1); } while (0)

    phase_prologue(F);
    GRID_BAR();
    phase_modulate0(F);
    GRID_BAR();
#pragma unroll 1
    for (int l = 0; l < DEPTH; ++l) {
        const int kind = l % 3, j = l / 3;
        F.fresh();
        if (kind == 0) {
            bf16 *GB = F.T2, *REC = F.T2 + (size_t)M * DRNN, *PF = F.T3, *PB = F.T3 + (size_t)NSAMPLE * DRNN, *HS = F.T3 + (size_t)6 * 1024 * 1024;
            float* AGG = (float*)(F.T3 + (size_t)2 * NSAMPLE * DRNN);
            GEMM_BF16(2, F.H, F.WT + WE_LRU_IN + (size_t)j * 2 * DRNN * D, 2 * DRNN, D, GB, DRNN, nullptr, DRNN, (size_t)M * DRNN, F.rsq0, F.bias2 + B2_LRU + (size_t)j * 3 * 2560, nullptr, 0);
            GRID_BAR();
            phase_lru_core(F, j, REC, GB, HS, PF, PB, AGG, F.WT + WE_WG + (size_t)j * 40 * 128 * 128);
            GRID_BAR();
            phase_lru_fixup(F, GB, HS, PF, PB, AGG);
            GRID_BAR();
            GEMM_RESID(HS, F.WT + WE_LRU_OUT + (size_t)j * D * DRNN, DRNN, 0, l == 0);
        } else if (kind == 1) {
            bf16 *UV = F.T1, *ACT = F.T2;
            GEMM_BF16(1, F.H, F.WT + WE_CM_IN, 2 * DB, D, UV, 2 * DB, F.inp(I_CM_BIN), 0, 0, F.rsq0, F.bias2 + B2_CM, F.rsqv, 8);
            GRID_BAR();
            phase_cmlp_spatial_mfma(F, UV, ACT, F.WT + WE_WSB);
            GRID_BAR();
            GEMM_RESID(ACT, F.WT + WE_CM_OUT, DB, 0, false);
        } else {
            bf16 *Q = F.T2, *KP = F.T2 + (size_t)M * D, *VP = KP + (size_t)NPROMPT * D, *O = F.T3;
            { pg8::Gemm g{F.H, F.WT + WE_QKV, M, 3 * D, D}; pg8::StaticOrder S; S.init(M, 3 * D, F.G, F.bid); S.wave = F.wave;
              pg8::EpiQkv E{F.ws, F.out, F.rsq0, F.bias2 + B2_QKV, F.lds, F.inp(I_AT_QKG), F.rope};
              F.fresh(); E.prep(S, F.tid); pg8::gemm_phase<pg8::EpiQkv, pg8::StaticOrder, true, true>(F.lds, g, S, E); }
            GRID_BAR();
            phase_attn(F, l, Q, KP, VP, O);
            GRID_BAR();
            GEMM_RESID(O, F.WT + WE_AT_OUT, D, 0, false);
        }
        GRID_BAR();
        { pg8::Gemm g{F.H, F.WT + WE_UP + (size_t)l * 2 * DFF * D, 42 * 256, 2 * DFF, D}; pg8::FfnOrder S; S.init(42 * 256, 2 * DFF, F.G, F.bid); S.wave = F.wave;
          pg8::EpiFfn E{F.T2, F.inp(I_FF_CW) + (size_t)l * 3 * 2 * DFF, F.inp(I_FF_CB) + (size_t)l * 2 * DFF, F.rsq1, F.bias2 + B2_UP + (size_t)l * 3 * 5632, F.lds};
          F.fresh(); E.prep(S, F.tid); pg8::gemm_phase<pg8::EpiFfn, pg8::FfnOrder, true, true>(F.lds, g, S, E); }
        GRID_BAR();
        GEMM_RESID(F.T2, F.WT + WE_DN + (size_t)l * D * DFF, DFF, 1, false);
        GRID_BAR();
    }
}

extern "C" void kernel_launch(void* const* d_in, const int* in_sizes, int n_in, void* d_out, int out_size, void* d_ws, size_t ws_size, hipStream_t stream) {
    static int grid = 0;
    if (grid == 0) {
        if (n_in != N_IN || ws_size < WS_END) { fprintf(stderr, "kernel_launch: unexpected n_in %d or ws_size %zu\n", n_in, ws_size); grid = -1; return; }
        int dev = 0, cus = 0, per_cu = 0;
        hipGetDevice(&dev); hipDeviceGetAttribute(&cus, hipDeviceAttributeMultiprocessorCount, dev);
        hipFuncSetAttribute((const void*)mk_fwd, hipFuncAttributeMaxDynamicSharedMemorySize, LDS_BYTES);
        hipOccupancyMaxActiveBlocksPerMultiprocessor(&per_cu, (const void*)mk_fwd, NT, LDS_BYTES);
        (void)hipGetLastError();
        if (per_cu < 1) { fprintf(stderr, "kernel_launch: occupancy query says %d blocks per CU\n", per_cu); per_cu = 1; }
        grid = cus;
    }
    if (grid < 0) return;
    hipMemsetAsync((char*)d_ws + WS_CTL, 0, CTL_ZERO_BYTES, stream);
    Params p{};
    for (int i = 0; i < N_IN; ++i) p.in[i] = (const float*)d_in[i];
    p.out = (float*)d_out; p.ws = (unsigned char*)d_ws;
    void* args[] = {&p};
    hipError_t e = hipLaunchCooperativeKernel((const void*)mk_fwd, dim3(grid), dim3(NT), args, LDS_BYTES, stream);
    if (e != hipSuccess) fprintf(stderr, "kernel_launch: cooperative launch failed: %s (grid %d)\n", hipGetErrorString(e), grid);
}
```

```cpp
#include <hip/hip_runtime.h>
#include <cstdio>
#include <cstdint>

#define GAS __attribute__((address_space(1)))
#define LAS __attribute__((address_space(3)))
typedef unsigned short bf16;
typedef float f32x4 __attribute__((ext_vector_type(4)));
typedef unsigned u32x2 __attribute__((ext_vector_type(2)));
typedef unsigned u32x4 __attribute__((ext_vector_type(4)));

constexpr int D = 1024, NPROMPT = 32 * 256, NSAMPLE = 2 * 1024, M = NPROMPT + NSAMPLE;
constexpr int DEPTH = 4, DRNN = 1280, DB = 2048, DFF = 2816, PAST = 512, TKS = PAST + 1024;
constexpr float EPS = 1e-6f;
constexpr int NWAVES = 8, NT = NWAVES * 64;

enum { I_XP = 0, I_XS, I_STATE, I_CK, I_CV, I_C, I_CCTX, I_WMOD, I_BMOD, I_NORMG, I_LRU_WIN, I_LRU_CW, I_LRU_CB, I_LRU_WG, I_LRU_BG, I_LRU_LAM, I_LRU_WOUT,
       I_CM_WIN, I_CM_BIN, I_CM_NG, I_CM_WS, I_CM_BS, I_CM_WOUT, I_AT_WQKV, I_AT_QKG, I_AT_LAM, I_AT_SUBG, I_AT_WOUT, I_FF_WUP, I_FF_CW, I_FF_CB, I_FF_WDN, N_IN };
constexpr size_t O_YP = 0, O_YS = (size_t)NPROMPT * D, O_STATE = (size_t)M * D, O_CK = O_STATE + 32 * 2 * 2 * DRNN, O_CV = O_CK + (size_t)NPROMPT * D;

constexpr size_t MiB = 1u << 20;
constexpr size_t WS_CTL = 0, CTL_ZERO_BYTES = 64 * 1024;
constexpr size_t WS_MOD = 1 * MiB;
constexpr size_t WS_RSTD = WS_MOD + 512 * 1024;
constexpr size_t WS_ROPE = WS_RSTD + 256 * 1024;
constexpr size_t WS_H = 2 * MiB;
constexpr size_t WS_T1 = 22 * MiB;
constexpr size_t WS_T2 = 132 * MiB;
constexpr size_t WS_T3 = 187 * MiB;
constexpr size_t WS_X = WS_T3 + 40 * MiB;
constexpr size_t B2_LRU = 0, B2_CM = B2_LRU + (size_t)2 * 3 * 2560, B2_QKV = B2_CM + (size_t)3 * 4096, B2_UP = B2_QKV + (size_t)3 * 3072, B2_END = B2_UP + (size_t)4 * 3 * 5632;
constexpr size_t WS_KS = 237 * MiB, WS_VS = 243 * MiB;
constexpr size_t WS_W = 249 * MiB;
constexpr size_t WE_LRU_IN = 0, WE_LRU_OUT = WE_LRU_IN + (size_t)2 * 2560 * 1024, WE_CM_IN = WE_LRU_OUT + (size_t)2 * 1024 * 1280, WE_CM_OUT = WE_CM_IN + (size_t)4096 * 1024,
                 WE_QKV = WE_CM_OUT + (size_t)1024 * 2048, WE_AT_OUT = WE_QKV + (size_t)3072 * 1024, WE_UP = WE_AT_OUT + (size_t)1024 * 1024, WE_DN = WE_UP + (size_t)4 * 5632 * 1024,
                 WE_WG = WE_DN + (size_t)4 * 1024 * 2816, WE_WSB = WE_WG + (size_t)80 * 128 * 128, WE_END = WE_WSB + (size_t)8 * 128 * 128;
constexpr size_t WS_END = WS_W + 106 * MiB;
static_assert(WE_END * 2 <= 106 * MiB, "weight copies fit");
constexpr int CW_BAR = 1024;

constexpr int LDS_BYTES = 163840;
constexpr int MISC_OFF = LDS_BYTES - 256, PTR_OFF = LDS_BYTES - 1024;

__device__ __forceinline__ unsigned f2bf(float f) { unsigned u = __builtin_bit_cast(unsigned, f); return (u + 0x7fffu + ((u >> 16) & 1u)) >> 16; }
__device__ __forceinline__ float bf2f(unsigned b) { return __builtin_bit_cast(float, (b & 0xffffu) << 16); }
template <int CTRL> __device__ __forceinline__ float dppf(float v) { return __builtin_bit_cast(float, __builtin_amdgcn_update_dpp(0, __builtin_bit_cast(int, v), CTRL, 0xf, 0xf, false)); }
__device__ __forceinline__ float swz_xor16(float v) { return __builtin_bit_cast(float, __builtin_amdgcn_ds_swizzle(__builtin_bit_cast(int, v), 0x401F)); }
__device__ __forceinline__ float sum_x32(float v) { auto r = __builtin_amdgcn_permlane32_swap(__builtin_bit_cast(unsigned, v), __builtin_bit_cast(unsigned, v), false, false);
    return __builtin_bit_cast(float, (unsigned)r[0]) + __builtin_bit_cast(float, (unsigned)r[1]); }
__device__ __forceinline__ float max_x32(float v) { auto r = __builtin_amdgcn_permlane32_swap(__builtin_bit_cast(unsigned, v), __builtin_bit_cast(unsigned, v), false, false);
    return fmaxf(__builtin_bit_cast(float, (unsigned)r[0]), __builtin_bit_cast(float, (unsigned)r[1])); }
__device__ __forceinline__ float sum_q4(float v) { v += swz_xor16(v); return sum_x32(v); }
__device__ __forceinline__ float max_q4(float v) { v = fmaxf(v, swz_xor16(v)); return max_x32(v); }
__device__ __forceinline__ float wave_sum(float v) { v += dppf<0xB1>(v); v += dppf<0x4E>(v); v += dppf<0x141>(v); v += dppf<0x140>(v); return sum_q4(v); }
__device__ __forceinline__ float wave_max(float v) { v = fmaxf(v, dppf<0xB1>(v)); v = fmaxf(v, dppf<0x4E>(v)); v = fmaxf(v, dppf<0x141>(v)); v = fmaxf(v, dppf<0x140>(v)); return max_q4(v); }
__device__ __forceinline__ float bperm(float v, int src_lane) { return __builtin_bit_cast(float, __builtin_amdgcn_ds_bpermute(src_lane << 2, __builtin_bit_cast(int, v))); }
__device__ __forceinline__ float gelu_tanh(float x) { const float y2 = 2.302208198f * (x + 0.044715f * x * x * x);
    const float t = 1.f - 2.f * __builtin_amdgcn_rcpf(__builtin_amdgcn_exp2f(y2) + 1.f); return 0.5f * x * (1.f + t); }
__device__ __forceinline__ float sigmoidf_(float x) { return __builtin_amdgcn_rcpf(1.f + __builtin_amdgcn_exp2f(-1.44269504f * x)); }
__device__ __forceinline__ float siluf_(float x) { return x * __builtin_amdgcn_rcpf(1.f + __builtin_amdgcn_exp2f(-1.44269504f * x)); }
__device__ __forceinline__ float softplusf_(float x) { return fmaxf(x, 0.f) + log1pf(expf(-fabsf(x))); }

#define XB_TMO      128
#define XB_XCNT(j)  (256  + 64 * (j))
#define XB_XSUB(j)  (1280 + 64 * (j))
#define XB_XGEN(j)  (2304 + 64 * (j))
#define XB_TOP      3328
#define XB_TOPGEN   3392
#define XCD_BAR_WORDS 3456
#define XB_SPIN_CAP (1u << 22)
__device__ __forceinline__ unsigned xb_ld(unsigned* p)              { return __hip_atomic_load(p, __ATOMIC_RELAXED, __HIP_MEMORY_SCOPE_AGENT); }
__device__ __forceinline__ unsigned xb_add(unsigned* p, unsigned v) { return __hip_atomic_fetch_add(p, v, __ATOMIC_RELAXED, __HIP_MEMORY_SCOPE_AGENT); }
__device__ __forceinline__ unsigned xb_xcc_id() { return (unsigned)__builtin_amdgcn_s_getreg((3 << 11) | 20) & 0xFu; }
#define XB_SPIN(cond, bar) do { unsigned _sp = 0; while (cond) { __builtin_amdgcn_s_sleep(1); \
    if ((++_sp & 255u) == 0u) { if (xb_ld(&(bar)[XB_TMO])) break; if (_sp > XB_SPIN_CAP) { atomicAdd(&(bar)[XB_TMO], 1u); break; } } } } while (0)
struct XcdBarrier { unsigned* bar; unsigned x; volatile LAS unsigned* st; bool t0; };
__device__ __forceinline__ XcdBarrier xcd_barrier_post(unsigned* bar, volatile LAS unsigned* st, bool t0) {
    XcdBarrier b; b.bar = bar; b.x = xb_xcc_id(); b.st = st; b.t0 = t0;
    if (t0) (void)xb_add(&bar[XB_XCNT(b.x)], 1u);
    return b;
}
__device__ __forceinline__ void xcd_barrier_complete(unsigned* bar, unsigned x, unsigned& nloc, unsigned& nx) {
    const unsigned G = gridDim.x * gridDim.y * gridDim.z;
    unsigned sum, cnt, mine, sp = 0u;
    for (;;) {
        sum = 0u; cnt = 0u; mine = 0u;
#pragma unroll
        for (unsigned j = 0; j < 16; ++j) { const unsigned c = xb_ld(&bar[XB_XCNT(j)]); sum += c; cnt += (c > 0u) ? 1u : 0u; mine = (j == x) ? c : mine; }
        if (sum == G) break;
        __builtin_amdgcn_s_sleep(1);
        if ((++sp & 255u) == 0u) { if (xb_ld(&bar[XB_TMO])) break; if (sp > XB_SPIN_CAP) { atomicAdd(&bar[XB_TMO], 1u); break; } }
    }
    nloc = mine > 0u ? mine : 1u; nx = cnt > 0u ? cnt : 1u;
}
__device__ __forceinline__ void xcd_barrier(const XcdBarrier& b) {
    asm volatile("s_waitcnt vmcnt(0)" ::: "memory");
    __syncthreads();
    if (b.t0) {
        unsigned* bar = b.bar;
        __builtin_amdgcn_s_waitcnt(0);
        unsigned nloc = b.st[0], nx = b.st[1];
        if (nloc == 0u) { xcd_barrier_complete(bar, b.x, nloc, nx); b.st[0] = nloc; b.st[1] = nx; }
        const unsigned old = xb_add(&bar[XB_XSUB(b.x)], 1u);
        const unsigned gen = old / nloc;
        if (old + 1u == (gen + 1u) * nloc) {
            __builtin_amdgcn_fence(__ATOMIC_RELEASE, "agent");
            asm volatile("s_waitcnt vmcnt(0)" ::: "memory");
            const unsigned og = xb_add(&bar[XB_TOP], 1u);
            const unsigned tg = og / nx;
            if (og + 1u == (tg + 1u) * nx) xb_add(&bar[XB_TOPGEN], 1u);
            else XB_SPIN(xb_ld(&bar[XB_TOPGEN]) == tg, bar);
            __builtin_amdgcn_fence(__ATOMIC_ACQUIRE, "agent");
            xb_add(&bar[XB_XGEN(b.x)], 1u);
            asm volatile("s_waitcnt vmcnt(0)" ::: "memory");
        } else {
            XB_SPIN(xb_ld(&bar[XB_XGEN(b.x)]) == gen, bar);
            __builtin_amdgcn_fence(__ATOMIC_ACQUIRE, "agent");
            asm volatile("s_waitcnt vmcnt(0)" ::: "memory");
        }
    }
    __syncthreads();
}

namespace pg8 {
#define PG8_LAS __attribute__((address_space(3)))
typedef unsigned short bf16_t;
typedef short bf16x8 __attribute__((ext_vector_type(8)));
typedef float f32x4 __attribute__((ext_vector_type(4)));
typedef unsigned u32x4 __attribute__((ext_vector_type(4)));
constexpr int BM = 256, BK = 64, HALF = 128, HTB = HALF * BK * 2  , STAGE_BYTES = 8 * HTB, NXCD = 8, WGM = 8;

__host__ __device__ __forceinline__ int lds_byte(int r, int c) { const int st = (r >> 4) * 2 + (c >> 5), rr = r & 15, cc = c & 31, ob = rr * 64 + cc * 2; return st * 1024 + (ob ^ (((ob >> 9) & 1) << 5)); }
__host__ __device__ __forceinline__ void stage_rc(int b, int& R, int& C) { const int st = b / 1024, sb = b % 1024, swz = sb ^ (((sb >> 9) & 1) << 5); R = (st >> 1) * 16 + swz / 64; C = (st & 1) * 32 + (swz % 64) / 2; }
__host__ __device__ __forceinline__ int perm32(int rho) { const int n = rho >> 4, i = rho & 15; return 8 * (i >> 2) + 4 * n + (i & 3); }

struct Unit { int pm, pn; };
struct Gemm { const bf16_t* A; const bf16_t* Bt; int M, N, K; };

struct StaticOrder {
    int nM, nN, nwg, G, c, wave;
    __host__ __device__ void init(int M, int N, int G_, int c_) { nM = M / BM; nN = N / BM; nwg = nM * nN; G = G_; c = c_; }
    __host__ __device__ bool next(int i, Unit& u) const {
        const long L = (long)i * G + c; if (L >= nwg) return false;
        int wgid = (int)L; { const int q = nwg / NXCD, r = nwg % NXCD, xcd = wgid % NXCD, off = wgid / NXCD; wgid = (xcd < r ? xcd * (q + 1) : r * (q + 1) + (xcd - r) * q) + off; }
        const int nig = WGM * nN, gid = wgid / nig, fm = gid * WGM, gsz = (nM - fm) < WGM ? (nM - fm) : WGM;
        u.pm = fm + ((wgid % nig) % gsz); u.pn = (wgid % nig) / gsz; return true;
    }
    __device__ __forceinline__ int arow(int pm) const { return pm * BM; }
    __device__ __forceinline__ void a_ready(const Unit&) const {}
    __device__ __forceinline__ void done(const Unit&) const {}
};

template <class Epi, class Sched, bool ALIGN_EPI = false, bool SP2 = false>
__device__ __forceinline__ void gemm_phase(PG8_LAS unsigned char* lds, const Gemm g, const Sched& S, const Epi& E) {
    int z_ = 0; asm volatile("" : "+v"(z_));
    const int lane = __builtin_amdgcn_mbcnt_hi(~0u, __builtin_amdgcn_mbcnt_lo(~0u, z_)), wid = S.wave, tid = wid * 64 + lane, wr = wid >> 2, wc = wid & 3, fr = lane & 15, fq = lane >> 4;
    const int K = g.K, nt = K / BK;
    unsigned voffA[2], voffB[2];
#pragma unroll
    for (int i = 0; i < 2; ++i) { int R, C; stage_rc(tid * 16 + i * 8192, R, C); const int Rb = Epi::PERM ? ((R & ~31) + perm32(R & 31)) : R;
        voffA[i] = (unsigned)(R * K + C) * 2u; voffB[i] = (unsigned)(Rb * K + C) * 2u; }
    const size_t kstep = (size_t)(BK * 2);
    const size_t hstep = (size_t)HALF * K * 2;
    const size_t tstep = 2 * hstep;
    const unsigned ldsw = (unsigned)wid * 1024u;
    const int aoff = lds_byte(wr * 64 + fr, fq * 8), boff = lds_byte(wc * 32 + fr, fq * 8);
#define PG8_SA(b, h) (((b) * 2 + (h)) * HTB)
#define PG8_SB(b, h) ((4 + (b) * 2 + (h)) * HTB)
#define PG8_STAGE(bufoff, gbase, voff) do { _Pragma("unroll") for (int _i = 0; _i < 2; ++_i) \
        __builtin_amdgcn_global_load_lds((const unsigned*)((const char*)(gbase) + (voff)[_i]), (PG8_LAS unsigned*)(lds + (bufoff) + ldsw + _i * 8192), 16, 0, 0); } while (0)
#define PG8_LDA(dst, b, h) do { _Pragma("unroll") for (int m = 0; m < 4; ++m) _Pragma("unroll") for (int k = 0; k < 2; ++k) dst[m][k] = *(const PG8_LAS bf16x8*)(lds + PG8_SA(b, h) + aoff + m * 2048 + k * 1024); } while (0)
#define PG8_LDB(dst, b, h) do { _Pragma("unroll") for (int n = 0; n < 2; ++n) _Pragma("unroll") for (int k = 0; k < 2; ++k) dst[n][k] = *(const PG8_LAS bf16x8*)(lds + PG8_SB(b, h) + boff + n * 2048 + k * 1024); } while (0)
#define PG8_MMA(ai, bj, At, Bt) do { __builtin_amdgcn_s_setprio(1); _Pragma("unroll") for (int m = 0; m < 4; ++m) _Pragma("unroll") for (int n = 0; n < 2; ++n) _Pragma("unroll") for (int k = 0; k < 2; ++k) \
        acc[ai][bj][m][n] = __builtin_amdgcn_mfma_f32_16x16x32_bf16(Bt[n][k], At[m][k], acc[ai][bj][m][n], 0, 0, 0); __builtin_amdgcn_s_setprio(0); } while (0)
#define PG8_WAIT_V(n) asm volatile("s_waitcnt vmcnt(" #n ")" ::: "memory")
#define PG8_WAIT_L(n) asm volatile("s_waitcnt lgkmcnt(" #n ")" ::: "memory")
#define PG8_BAR __builtin_amdgcn_s_barrier()
#define PG8_SCHED __builtin_amdgcn_sched_barrier(0)
    Unit cur, nxt; int ui = 0;
    if (!S.next(0, cur)) return;
    f32x4 acc[2][2][4][2];
#pragma unroll
    for (int a = 0; a < 2; ++a)
#pragma unroll
        for (int b = 0; b < 2; ++b)
#pragma unroll
            for (int m = 0; m < 4; ++m)
#pragma unroll
                for (int n = 0; n < 2; ++n) acc[a][b][m][n] = (f32x4){0.f, 0.f, 0.f, 0.f};
    bf16x8 At[4][2], B0[2][2], B1[2][2];
    const char* cA = (const char*)g.A + (size_t)S.arow(cur.pm) * (size_t)K * 2; const char* cB = (const char*)g.Bt + (size_t)cur.pn * tstep;
    S.a_ready(cur);
    if constexpr (SP2) {
        PG8_STAGE(PG8_SB(0, 0), cB, voffB); PG8_STAGE(PG8_SB(0, 1), cB + hstep, voffB); PG8_STAGE(PG8_SA(0, 0), cA, voffA); PG8_STAGE(PG8_SA(0, 1), cA + hstep, voffA);
        if (wr == 1) PG8_BAR;
        PG8_WAIT_V(2); PG8_BAR;
        PG8_STAGE(PG8_SB(1, 0), cB + kstep, voffB); PG8_STAGE(PG8_SA(1, 0), cA + kstep, voffA); PG8_STAGE(PG8_SB(1, 1), cB + hstep + kstep, voffB);
        PG8_WAIT_V(6); PG8_BAR;
    } else {
        PG8_STAGE(PG8_SB(0, 0), cB, voffB); PG8_STAGE(PG8_SA(0, 0), cA, voffA); PG8_STAGE(PG8_SB(0, 1), cB + hstep, voffB); PG8_STAGE(PG8_SA(0, 1), cA + hstep, voffA);
        if (wr == 1) PG8_BAR;
        PG8_WAIT_V(4); PG8_BAR;
        PG8_STAGE(PG8_SB(1, 0), cB + kstep, voffB); PG8_STAGE(PG8_SA(1, 0), cA + kstep, voffA); PG8_STAGE(PG8_SB(1, 1), cB + hstep + kstep, voffB);
        PG8_WAIT_V(6); PG8_BAR;
    }
    for (;;) {
        const bool has_next = S.next(ui + 1, nxt);
        const char* nA = has_next ? (const char*)g.A + (size_t)S.arow(nxt.pm) * (size_t)K * 2 : cA; const char* nB = has_next ? (const char*)g.Bt + (size_t)nxt.pn * tstep : cB;
        for (int t = 0; t < nt; t += 2) {
            const bool last = (t == nt - 2);
            const char* a1 = cA + (size_t)(t + 1) * kstep;
            const char* a2 = last ? nA : cA + (size_t)(t + 2) * kstep; const char* b2 = last ? nB : cB + (size_t)(t + 2) * kstep;
            const char* a3 = a2 + kstep; const char* b3 = b2 + kstep;
            if (last && has_next) S.a_ready(nxt);
            if constexpr (SP2) {
            PG8_LDB(B0, 0, 0); PG8_LDB(B1, 0, 1); PG8_SCHED; PG8_LDA(At, 0, 0); PG8_STAGE(PG8_SA(1, 1), a1 + hstep, voffA);
            PG8_WAIT_V(8); PG8_WAIT_L(0); PG8_BAR; PG8_MMA(0, 0, At, B0); PG8_MMA(0, 1, At, B1); PG8_BAR; PG8_SCHED;
            PG8_LDA(At, 0, 1); PG8_STAGE(PG8_SB(0, 0), b2, voffB); PG8_STAGE(PG8_SB(0, 1), b2 + hstep, voffB); PG8_STAGE(PG8_SA(0, 0), a2, voffA);
            PG8_WAIT_V(8); PG8_WAIT_L(0); PG8_BAR; PG8_MMA(1, 0, At, B0); PG8_MMA(1, 1, At, B1); PG8_BAR; PG8_SCHED;
            PG8_LDB(B0, 1, 0); PG8_LDB(B1, 1, 1); PG8_SCHED; PG8_LDA(At, 1, 0); PG8_STAGE(PG8_SA(0, 1), a2 + hstep, voffA);
            PG8_WAIT_V(8); PG8_WAIT_L(0); PG8_BAR; PG8_MMA(0, 0, At, B0); PG8_MMA(0, 1, At, B1); PG8_BAR; PG8_SCHED;
            PG8_LDA(At, 1, 1); PG8_STAGE(PG8_SB(1, 0), b3, voffB); PG8_STAGE(PG8_SB(1, 1), b3 + hstep, voffB); PG8_STAGE(PG8_SA(1, 0), a3, voffA);
            PG8_WAIT_V(8); PG8_WAIT_L(0); PG8_BAR; PG8_MMA(1, 0, At, B0); PG8_MMA(1, 1, At, B1); PG8_BAR; PG8_SCHED;
            } else {
            PG8_LDB(B0, 0, 0); PG8_SCHED; PG8_LDA(At, 0, 0); PG8_STAGE(PG8_SA(1, 1), a1 + hstep, voffA);
            PG8_WAIT_L(8); PG8_BAR; PG8_WAIT_L(0); PG8_MMA(0, 0, At, B0); PG8_BAR; PG8_SCHED;
            PG8_LDB(B1, 0, 1); PG8_STAGE(PG8_SB(0, 0), b2, voffB);
            PG8_BAR; PG8_WAIT_L(0); PG8_MMA(0, 1, At, B1); PG8_BAR;
            PG8_LDA(At, 0, 1); PG8_STAGE(PG8_SA(0, 0), a2, voffA);
            PG8_BAR; PG8_WAIT_L(0); PG8_MMA(1, 0, At, B0); PG8_BAR; PG8_SCHED;
            PG8_STAGE(PG8_SB(0, 1), b2 + hstep, voffB);
            PG8_WAIT_V(6); PG8_BAR; PG8_MMA(1, 1, At, B1); PG8_BAR;
            PG8_LDB(B0, 1, 0); PG8_SCHED; PG8_LDA(At, 1, 0); PG8_STAGE(PG8_SA(0, 1), a2 + hstep, voffA);
            PG8_WAIT_L(8); PG8_BAR; PG8_WAIT_L(0); PG8_MMA(0, 0, At, B0); PG8_BAR; PG8_SCHED;
            PG8_LDB(B1, 1, 1); PG8_STAGE(PG8_SB(1, 0), b3, voffB);
            PG8_BAR; PG8_WAIT_L(0); PG8_MMA(0, 1, At, B1); PG8_BAR;
            PG8_LDA(At, 1, 1); PG8_STAGE(PG8_SA(1, 0), a3, voffA);
            PG8_BAR; PG8_WAIT_L(0); PG8_MMA(1, 0, At, B0); PG8_BAR; PG8_SCHED;
            PG8_STAGE(PG8_SB(1, 1), b3 + hstep, voffB);
            PG8_WAIT_V(6); PG8_BAR; PG8_MMA(1, 1, At, B1); PG8_BAR;
            }
        }
        if constexpr (ALIGN_EPI) { if (wr == 0) PG8_BAR; }
        if constexpr (!Epi::AFTER_DRAIN) { E(acc, cur, ui, wr, wc, fr, fq); S.done(cur); }
        if (!has_next) break;
#pragma unroll
        for (int a = 0; a < 2; ++a)
#pragma unroll
            for (int b = 0; b < 2; ++b)
#pragma unroll
                for (int m = 0; m < 4; ++m)
#pragma unroll
                    for (int n = 0; n < 2; ++n) acc[a][b][m][n] = (f32x4){0.f, 0.f, 0.f, 0.f};
        cur = nxt; cA = nA; cB = nB; ++ui;
        if constexpr (ALIGN_EPI) { if (wr == 1) PG8_BAR; }
    }
    PG8_WAIT_V(0);
    if constexpr (!ALIGN_EPI) { if (wr == 0) PG8_BAR; }
    PG8_BAR;
    if constexpr (Epi::AFTER_DRAIN) { E.fused(acc, cur, wr, wc, fr, fq, lds, wid, lane); S.done(cur); }
#undef PG8_SA
#undef PG8_SB
#undef PG8_STAGE
#undef PG8_LDA
#undef PG8_LDB
#undef PG8_MMA
#undef PG8_WAIT_V
#undef PG8_WAIT_L
#undef PG8_BAR
#undef PG8_SCHED
}
}

namespace pg8 {
__device__ __forceinline__ unsigned cvt_pk_bf16(float lo, float hi) { unsigned r; asm volatile("v_cvt_pk_bf16_f32 %0, %1, %2" : "=v"(r) : "v"(lo), "v"(hi)); return r; }
__device__ __forceinline__ f32x4 gelu4(f32x4 v) { f32x4 o; o.x = gelu_tanh(v.x); o.y = gelu_tanh(v.y); o.z = gelu_tanh(v.z); o.w = gelu_tanh(v.w); return o; }
constexpr int ETAB_OFF = 131072 + 8192, ETAB_SLOT = 4608, ETAB_MAXU = 4;
__device__ __forceinline__ float row_rstd(const float* rsq, int row) {
    const GAS f32x4* p = (const GAS f32x4*)(rsq + (size_t)row * 16);
    const f32x4 a = p[0], b = p[1], c = p[2], d = p[3];
    const float s = ((a.x + a.y) + (a.z + a.w)) + ((b.x + b.y) + (b.z + b.w)) + ((c.x + c.y) + (c.z + c.w)) + ((d.x + d.y) + (d.z + d.w));
    return rsqrtf(s * (1.f / D) + EPS);
}
__device__ __forceinline__ int tile_cidx(int trow) { return trow < NPROMPT ? 0 : 1 + ((trow - NPROMPT) >> 10); }
__device__ __forceinline__ PG8_LAS float* etab(PG8_LAS unsigned char* lds, int ui) { return (PG8_LAS float*)(lds + ETAB_OFF + ui * ETAB_SLOT); }

template <int ACT> struct EpiBf16 {
    static constexpr bool PERM = true, AFTER_DRAIN = false;
    bf16_t* O; int ldc; const float* bias; int split_cols; size_t split_stride; const float* rsq; const float* b2; int N; float* rsqv; int vt0; PG8_LAS unsigned char* lds;
    template <class Sched> __device__ __forceinline__ void prep(const Sched& S, int tid) const {
        Unit u;
        for (int i = 0; i < ETAB_MAXU && S.next(i, u); ++i) { PG8_LAS float* t = etab(lds, i);
            if (tid < 256) t[tid] = row_rstd(rsq, S.arow(u.pm) + tid);
            else { const int c = tid - 256, col = u.pn * BM + c; float v = b2[(size_t)tile_cidx(S.arow(u.pm)) * N + col]; if (bias) v += bias[col]; t[256 + c] = v; } }
        __syncthreads();
    }
    __device__ __forceinline__ void operator()(f32x4 (&acc)[2][2][4][2], const Unit& u, int ui, int wr, int wc, int fr, int fq) const {
        asm volatile("" : "+v"(fr), "+v"(fq));
        PG8_LAS const float* tb = etab(lds, ui);
        const int lrow0 = wr * 64 + fr; int colt = u.pn * BM; bf16_t* base = O; int t = 0;
        if (split_cols) { t = colt / split_cols; base += (size_t)t * split_stride; colt -= t * split_cols; }
        const bool act = (ACT == 1) || (ACT == 2 && t == 0);
        const int col0 = colt + wc * 32 + 8 * fq, tc0 = wc * 32 + 8 * fq;
        const bool wantv = rsqv != nullptr && u.pn >= vt0;
        GAS unsigned char* ob = (GAS unsigned char*)base;
        float ss[8];
#pragma unroll
        for (int i = 0; i < 8; ++i) ss[i] = 0.f;
#pragma unroll
        for (int bj = 0; bj < 2; ++bj) { const f32x4 bv0 = *(PG8_LAS const f32x4*)(tb + 256 + tc0 + bj * HALF), bv1 = *(PG8_LAS const f32x4*)(tb + 256 + tc0 + bj * HALF + 4);
#pragma unroll
            for (int ai = 0; ai < 2; ++ai)
#pragma unroll
                for (int m = 0; m < 4; ++m) { const int lrow = lrow0 + ai * HALF + m * 16; const float rs = tb[lrow];
                    f32x4 v0 = acc[ai][bj][m][0] * rs + bv0, v1 = acc[ai][bj][m][1] * rs + bv1;
                    if (ACT != 0) { if (act) { v0 = gelu4(v0); v1 = gelu4(v1); } }
                    ss[ai * 4 + m] += (v0[0] * v0[0] + v0[1] * v0[1]) + (v0[2] * v0[2] + v0[3] * v0[3]) + (v1[0] * v1[0] + v1[1] * v1[1]) + (v1[2] * v1[2] + v1[3] * v1[3]);
                    u32x4 w; w.x = cvt_pk_bf16(v0[0], v0[1]); w.y = cvt_pk_bf16(v0[2], v0[3]); w.z = cvt_pk_bf16(v1[0], v1[1]); w.w = cvt_pk_bf16(v1[2], v1[3]);
                    *(GAS u32x4*)(ob + ((unsigned)(u.pm * BM + lrow) * (unsigned)ldc + col0 + bj * HALF) * 2u) = w;
                    __builtin_amdgcn_sched_barrier(0); } }
        if (wantv) {
#pragma unroll
            for (int i = 0; i < 8; ++i) { const float q = sum_q4(ss[i]);
                if (fq == 0) *(GAS float*)(rsqv + (size_t)(u.pm * BM + lrow0 + (i >> 2) * HALF + (i & 3) * 16) * 32 + (u.pn - vt0) * 4 + wc) = q; } }
    }
};
struct EpiResid {
    static constexpr bool PERM = true, AFTER_DRAIN = false;
    float* out; const float* xp; const float* xs; const float* modl; int which; bool from_input;
    bf16_t* H; const float* ng; const float* modn; int whichs; float* rsq_out; PG8_LAS unsigned char* lds;
    template <class Sched> __device__ __forceinline__ void prep(const Sched& S, int tid) const {
        Unit u;
        for (int i = 0; i < ETAB_MAXU && S.next(i, u); ++i) { PG8_LAS float* t = etab(lds, i);
            if (tid < 256) { const int ci = tile_cidx(u.pm * BM), col = u.pn * BM + tid; t[256 + tid] = modl[(size_t)(ci * 6 + which) * D + col];
                t[512 + tid] = H ? ng[col] * (1.f + modn[(size_t)(ci * 6 + whichs) * D + col]) : 0.f; } }
        __syncthreads();
    }
    __device__ __forceinline__ void operator()(f32x4 (&acc)[2][2][4][2], const Unit& u, int ui, int wr, int wc, int fr, int fq) const {
        asm volatile("" : "+v"(fr), "+v"(fq));
        PG8_LAS const float* tb = etab(lds, ui);
        const int trow = u.pm * BM, row0 = wr * 64 + fr, tc0 = wc * 32 + 8 * fq, col0 = u.pn * BM + tc0;
        const GAS unsigned char* bpg = (const GAS unsigned char*)(from_input ? (trow < NPROMPT ? xp + (size_t)trow * D : xs + (size_t)(trow - NPROMPT) * D) : out + (size_t)trow * D);
        GAS unsigned char* op = (GAS unsigned char*)(out + (size_t)trow * D); GAS unsigned char* hb = (GAS unsigned char*)H;
#pragma unroll
        for (int ai = 0; ai < 2; ++ai) {
            f32x4 x[2][4][2];
#pragma unroll
            for (int bj = 0; bj < 2; ++bj)
#pragma unroll
                for (int m = 0; m < 4; ++m)
#pragma unroll
                    for (int n = 0; n < 2; ++n) x[bj][m][n] = *(const GAS f32x4*)(bpg + ((unsigned)(row0 + ai * HALF + m * 16) * (unsigned)D + col0 + bj * HALF + 4 * n) * 4u);
            float ss[4] = {0.f, 0.f, 0.f, 0.f};
#pragma unroll
            for (int bj = 0; bj < 2; ++bj) { const f32x4 gv0 = *(PG8_LAS const f32x4*)(tb + 256 + tc0 + bj * HALF), gv1 = *(PG8_LAS const f32x4*)(tb + 256 + tc0 + bj * HALF + 4);
                const f32x4 gs0 = *(PG8_LAS const f32x4*)(tb + 512 + tc0 + bj * HALF), gs1 = *(PG8_LAS const f32x4*)(tb + 512 + tc0 + bj * HALF + 4);
#pragma unroll
                for (int m = 0; m < 4; ++m) { const unsigned lrow = row0 + ai * HALF + m * 16, eo = lrow * (unsigned)D + col0 + bj * HALF;
                    const f32x4 x0 = x[bj][m][0] + gv0 * acc[ai][bj][m][0], x1 = x[bj][m][1] + gv1 * acc[ai][bj][m][1];
                    *(GAS f32x4*)(op + eo * 4u) = x0; *(GAS f32x4*)(op + eo * 4u + 16) = x1;
                    if (H) { ss[m] += (x0[0] * x0[0] + x0[1] * x0[1]) + (x0[2] * x0[2] + x0[3] * x0[3]) + (x1[0] * x1[0] + x1[1] * x1[1]) + (x1[2] * x1[2] + x1[3] * x1[3]);
                        const f32x4 a0 = x0 * gs0, a1 = x1 * gs1;
                        u32x4 w; w.x = cvt_pk_bf16(a0[0], a0[1]); w.y = cvt_pk_bf16(a0[2], a0[3]); w.z = cvt_pk_bf16(a1[0], a1[1]); w.w = cvt_pk_bf16(a1[2], a1[3]);
                        *(GAS u32x4*)(hb + ((unsigned)trow * (unsigned)D + eo) * 2u) = w; } } }
            if (H) {
#pragma unroll
                for (int m = 0; m < 4; ++m) { const float q = sum_q4(ss[m]);
                    if (fq == 0) *(GAS float*)(rsq_out + (size_t)(trow + row0 + ai * HALF + m * 16) * 16 + u.pn * 4 + wc) = q; } }
            asm volatile("" ::: "memory");
        }
    }
};

__device__ __forceinline__ void ffn_tile_geom(int pm, int& rs, int& vlo, int& vhi) {
    if (pm < 32) { rs = 256 * pm; vlo = 0; vhi = 255; }
    else { const int sq = (pm - 32) / 5, i = (pm - 32) % 5; rs = NPROMPT + 1024 * sq + (i < 4 ? 254 * i : 768); vlo = i == 0 ? 0 : (i < 4 ? 1 : 249); vhi = i < 4 ? 254 : 255; }
}
struct FfnOrder : StaticOrder {
    __device__ __forceinline__ int arow(int pm) const { int rs, a, b; ffn_tile_geom(pm, rs, a, b); return rs; }
};
template <int CTRL> __device__ __forceinline__ float dpp0(float v) { return __builtin_bit_cast(float, __builtin_amdgcn_update_dpp(0, __builtin_bit_cast(int, v), CTRL, 0xf, 0xf, true)); }
struct EpiFfn {
    static constexpr bool PERM = true, AFTER_DRAIN = false;
    bf16_t* ACT; const float* cw; const float* cb; const float* rsq; const float* b2; PG8_LAS unsigned char* lds;
    template <class Sched> __device__ __forceinline__ void prep(const Sched& S, int tid) const {
        Unit u;
        for (int i = 0; i < ETAB_MAXU && S.next(i, u); ++i) { PG8_LAS float* t = etab(lds, i); const int rs = S.arow(u.pm);
            if (tid < 256) t[tid] = row_rstd(rsq, rs + tid);
            else { const int c = tid - 256, ch = (c < 128 ? 0 : DFF) + u.pn * 128 + (c & 127);
                t[256 + c] = b2[(size_t)tile_cidx(rs) * 2 * DFF + u.pn * 256 + c]; t[512 + c] = cb[ch];
                PG8_LAS unsigned short* tw = (PG8_LAS unsigned short*)(t + 768);
#pragma unroll
                for (int k = 0; k < 3; ++k) tw[k * 256 + c] = (unsigned short)f2bf(cw[(size_t)k * 2 * DFF + ch]); } }
        __syncthreads();
    }
    __device__ __forceinline__ void operator()(f32x4 (&acc)[2][2][4][2], const Unit& u, int ui, int wr, int wc, int fr, int fq) const {
        asm volatile("" : "+v"(fr), "+v"(fq));
        PG8_LAS const float* tb = etab(lds, ui); PG8_LAS float* xb = (PG8_LAS float*)(lds + 131072);
        int rs, vlo, vhi; ffn_tile_geom(u.pm, rs, vlo, vhi);
        const int colw = wc * 32 + 8 * fq;
#pragma unroll
        for (int bj = 0; bj < 2; ++bj) { const f32x4 bz0 = *(PG8_LAS const f32x4*)(tb + 256 + bj * 128 + colw), bz1 = *(PG8_LAS const f32x4*)(tb + 256 + bj * 128 + colw + 4);
#pragma unroll
            for (int ai = 0; ai < 2; ++ai)
#pragma unroll
                for (int m = 0; m < 4; ++m) { const float rsd = tb[128 * ai + 64 * wr + 16 * m + fr];
                    acc[ai][bj][m][0] = acc[ai][bj][m][0] * rsd + bz0; acc[ai][bj][m][1] = acc[ai][bj][m][1] * rsd + bz1; } }
#pragma unroll
        for (int ai = 0; ai < 2; ++ai) { const int b = 2 * ai + wr;
            if (fr == 0) {
#pragma unroll
                for (int bj = 0; bj < 2; ++bj)
#pragma unroll
                    for (int n = 0; n < 2; ++n) *(PG8_LAS f32x4*)(xb + (b * 2 + 0) * 256 + bj * 128 + colw + 4 * n) = acc[ai][bj][0][n]; }
            if (fr == 15) {
#pragma unroll
                for (int bj = 0; bj < 2; ++bj)
#pragma unroll
                    for (int n = 0; n < 2; ++n) *(PG8_LAS f32x4*)(xb + (b * 2 + 1) * 256 + bj * 128 + colw + 4 * n) = acc[ai][bj][3][n]; } }
        asm volatile("s_waitcnt lgkmcnt(0)" ::: "memory"); __builtin_amdgcn_s_barrier(); asm volatile("" ::: "memory");
        GAS unsigned char* actb = (GAS unsigned char*)ACT;
        const unsigned lane_off = (unsigned)((rs + 64 * wr + fr) * DFF + u.pn * 128 + colw) * 2u;
        PG8_LAS const unsigned short* tw = (PG8_LAS const unsigned short*)(tb + 768);
#pragma unroll
        for (int n = 0; n < 2; ++n) {
            f32x4 wg[3], wu[3];
#pragma unroll
            for (int k = 0; k < 3; ++k) { const u32x2 pg = *(PG8_LAS const u32x2*)(tw + k * 256 + colw + 4 * n), pu = *(PG8_LAS const u32x2*)(tw + k * 256 + 128 + colw + 4 * n);
                wg[k] = (f32x4){__builtin_bit_cast(float, pg.x << 16), __builtin_bit_cast(float, pg.x & 0xffff0000u), __builtin_bit_cast(float, pg.y << 16), __builtin_bit_cast(float, pg.y & 0xffff0000u)};
                wu[k] = (f32x4){__builtin_bit_cast(float, pu.x << 16), __builtin_bit_cast(float, pu.x & 0xffff0000u), __builtin_bit_cast(float, pu.y << 16), __builtin_bit_cast(float, pu.y & 0xffff0000u)}; }
            const f32x4 bgv = *(PG8_LAS const f32x4*)(tb + 512 + colw + 4 * n), buv = *(PG8_LAS const f32x4*)(tb + 512 + 128 + colw + 4 * n);
#pragma unroll
            for (int ai = 0; ai < 2; ++ai) { const int b = 2 * ai + wr;
                f32x4 pz[2], nz[2];
#pragma unroll
                for (int bj = 0; bj < 2; ++bj) { pz[bj] = b > 0 ? *(PG8_LAS const f32x4*)(xb + ((b - 1) * 2 + 1) * 256 + bj * 128 + colw + 4 * n) : (f32x4){0.f, 0.f, 0.f, 0.f};
                                                 nz[bj] = b < 3 ? *(PG8_LAS const f32x4*)(xb + ((b + 1) * 2 + 0) * 256 + bj * 128 + colw + 4 * n) : (f32x4){0.f, 0.f, 0.f, 0.f}; }
#pragma unroll
                for (int m = 0; m < 4; ++m) { f32x4 zc[2];
#pragma unroll
                    for (int bj = 0; bj < 2; ++bj) { const f32x4 z = acc[ai][bj][m][n]; const f32x4* w3 = bj == 0 ? wg : wu; f32x4 o = bj == 0 ? bgv : buv;
#pragma unroll
                        for (int e = 0; e < 4; ++e) { float a = fmaf(w3[1][e], z[e], o[e]);
                            const float w0e = fr == 0 ? w3[0][e] : 0.f, w2e = fr == 15 ? w3[2][e] : 0.f;
                            asm("v_fmac_f32_dpp %0, %1, %2 row_shr:1 row_mask:0xf bank_mask:0xf bound_ctrl:1" : "+v"(a) : "v"(z[e]), "v"(w3[0][e]));
                            asm("v_fmac_f32_dpp %0, %1, %2 row_shl:1 row_mask:0xf bank_mask:0xf bound_ctrl:1" : "+v"(a) : "v"(z[e]), "v"(w3[2][e]));
                            if (m > 0) { const float zp = acc[ai][bj][m - 1][n][e]; asm("v_fmac_f32_dpp %0, %1, %2 row_ror:1 row_mask:0xf bank_mask:0xf bound_ctrl:1" : "+v"(a) : "v"(zp), "v"(w0e)); } else a = fmaf(pz[bj][e], w0e, a);
                            if (m < 3) { const float zn = acc[ai][bj][m + 1][n][e]; asm("v_fmac_f32_dpp %0, %1, %2 row_ror:15 row_mask:0xf bank_mask:0xf bound_ctrl:1" : "+v"(a) : "v"(zn), "v"(w2e)); } else a = fmaf(nz[bj][e], w2e, a);
                            o[e] = a; }
                        zc[bj] = o; }
                    const int lr = 128 * ai + 64 * wr + 16 * m + fr;
                    if (lr >= vlo && lr <= vhi) { u32x2 w; w.x = cvt_pk_bf16(siluf_(zc[0][0]) * zc[1][0], siluf_(zc[0][1]) * zc[1][1]); w.y = cvt_pk_bf16(siluf_(zc[0][2]) * zc[1][2], siluf_(zc[0][3]) * zc[1][3]);
                        *(GAS u32x2*)(actb + (lane_off + (unsigned)((128 * ai + 16 * m) * DFF + 4 * n) * 2u)) = w; } } }
        }
    }
};

struct EpiQkv {
    static constexpr bool PERM = true, AFTER_DRAIN = false;
    unsigned char* ws; float* out; const float* rsq; const float* b2; PG8_LAS unsigned char* lds; const float* qkg; const float* rope;
    template <class Sched> __device__ __forceinline__ void prep(const Sched& S, int tid) const {
        Unit u;
        for (int i = 0; i < ETAB_MAXU && S.next(i, u); ++i) { PG8_LAS float* t = etab(lds, i);
            if (tid < 256) t[tid] = row_rstd(rsq, u.pm * BM + tid);
            else { const int c = tid - 256; t[256 + c] = b2[(size_t)tile_cidx(u.pm * BM) * 3 * D + u.pn * BM + c]; } }
        __syncthreads();
    }
    __device__ __forceinline__ void operator()(f32x4 (&acc)[2][2][4][2], const Unit& u, int ui, int wr, int wc, int fr, int fq) const {
        asm volatile("" : "+v"(fr), "+v"(fq));
        PG8_LAS const float* tb = etab(lds, ui);
        const int trow = u.pm * BM; const bool smp = trow >= NPROMPT; const int sb = smp ? (trow - NPROMPT) >> 10 : 0, tq0 = smp ? (trow - NPROMPT) & 1023 : 0;
        const int kind = u.pn >> 2, tc0 = wc * 32 + 8 * fq;
        if (kind < 2) {
            const int oc = (u.pn & 3) * 256 + wc * 64 + 8 * fq;
            f32x4 bz[2][2], gq[2][2];
#pragma unroll
            for (int bj = 0; bj < 2; ++bj)
#pragma unroll
                for (int n = 0; n < 2; ++n) { bz[bj][n] = *(PG8_LAS const f32x4*)(tb + 256 + tc0 + bj * HALF + 4 * n); gq[bj][n] = *(const GAS f32x4*)(qkg + kind * 64 + 32 * bj + 8 * fq + 4 * n); }
            const size_t doff = kind == 0 ? WS_T2 : (smp ? WS_KS : WS_T2 + (size_t)M * D * 2); GAS unsigned char* dst = (GAS unsigned char*)ws + doff;
#pragma unroll
            for (int ai = 0; ai < 2; ++ai) {
                f32x4 cs[4][2], sn[4][2];
#pragma unroll
                for (int m = 0; m < 4; ++m) { const int lrow = 128 * ai + 64 * wr + 16 * m + fr; const float rs = tb[lrow];
                    if (smp && (m & 1) == 0) {
#pragma unroll
                        for (int mm = m; mm < m + 2; ++mm)
#pragma unroll
                            for (int n = 0; n < 2; ++n) { const int t = tq0 + 128 * ai + 64 * wr + 16 * mm + fr; cs[mm][n] = *(const GAS f32x4*)(rope + t * 32 + 8 * fq + 4 * n); sn[mm][n] = *(const GAS f32x4*)(rope + 32768 + t * 32 + 8 * fq + 4 * n); } }
                    f32x4 v[2][2]; float ss = 0.f;
#pragma unroll
                    for (int bj = 0; bj < 2; ++bj)
#pragma unroll
                        for (int n = 0; n < 2; ++n) { v[bj][n] = acc[ai][bj][m][n] * rs + bz[bj][n]; ss += (v[bj][n][0] * v[bj][n][0] + v[bj][n][1] * v[bj][n][1]) + (v[bj][n][2] * v[bj][n][2] + v[bj][n][3] * v[bj][n][3]); }
                    ss = sum_q4(ss);
                    const float rn = rsqrtf(ss * (1.f / 64.f) + EPS);
#pragma unroll
                    for (int bj = 0; bj < 2; ++bj)
#pragma unroll
                        for (int n = 0; n < 2; ++n) v[bj][n] = v[bj][n] * rn * gq[bj][n];
                    const unsigned row = (unsigned)(trow + lrow);
                    if (!smp) {
                        if (kind == 1) {
#pragma unroll
                            for (int bj = 0; bj < 2; ++bj)
#pragma unroll
                                for (int n = 0; n < 2; ++n) *(GAS f32x4*)((GAS unsigned char*)out + O_CK * 4 + (row * (unsigned)D + oc + 32 * bj + 4 * n) * 4u) = v[bj][n]; }
                    } else {
#pragma unroll
                        for (int n = 0; n < 2; ++n) { const f32x4 x1 = v[0][n], x2 = v[1][n]; v[0][n] = x1 * cs[m][n] - x2 * sn[m][n]; v[1][n] = x2 * cs[m][n] + x1 * sn[m][n]; } }
                    const unsigned drow = (kind == 1 && smp) ? (unsigned)(sb * TKS + PAST + tq0 + lrow) : row;
#pragma unroll
                    for (int bj = 0; bj < 2; ++bj) { u32x4 w; w.x = cvt_pk_bf16(v[bj][0][0], v[bj][0][1]); w.y = cvt_pk_bf16(v[bj][0][2], v[bj][0][3]); w.z = cvt_pk_bf16(v[bj][1][0], v[bj][1][1]); w.w = cvt_pk_bf16(v[bj][1][2], v[bj][1][3]);
                        *(GAS u32x4*)(dst + (drow * (unsigned)D + oc + 32 * bj) * 2u) = w; }
                    if (m & 1) { asm volatile("" ::: "memory"); __builtin_amdgcn_sched_barrier(0); } } }
        } else {
            const int oc = (u.pn - 8) * 256 + wc * 32 + 8 * fq;
            const size_t doff = smp ? WS_VS : WS_T2 + (size_t)M * D * 2 + (size_t)NPROMPT * D * 2; GAS unsigned char* dst = (GAS unsigned char*)ws + doff;
#pragma unroll
            for (int bj = 0; bj < 2; ++bj) { const f32x4 bz0 = *(PG8_LAS const f32x4*)(tb + 256 + tc0 + bj * HALF), bz1 = *(PG8_LAS const f32x4*)(tb + 256 + tc0 + bj * HALF + 4);
#pragma unroll
                for (int ai = 0; ai < 2; ++ai)
#pragma unroll
                    for (int m = 0; m < 4; ++m) { const int lrow = 128 * ai + 64 * wr + 16 * m + fr; const float rs = tb[lrow];
                        const f32x4 v0 = acc[ai][bj][m][0] * rs + bz0, v1 = acc[ai][bj][m][1] * rs + bz1;
                        const unsigned row = (unsigned)(trow + lrow), drow = smp ? (unsigned)(sb * TKS + PAST + tq0 + lrow) : row;
                        u32x4 w; w.x = cvt_pk_bf16(v0[0], v0[1]); w.y = cvt_pk_bf16(v0[2], v0[3]); w.z = cvt_pk_bf16(v1[0], v1[1]); w.w = cvt_pk_bf16(v1[2], v1[3]);
                        *(GAS u32x4*)(dst + (drow * (unsigned)D + oc + 128 * bj) * 2u) = w;
                        if (!smp) { *(GAS f32x4*)((GAS unsigned char*)out + O_CV * 4 + (row * (unsigned)D + oc + 128 * bj) * 4u) = v0; *(GAS f32x4*)((GAS unsigned char*)out + O_CV * 4 + (row * (unsigned)D + oc + 128 * bj + 4) * 4u) = v1; } } }
        }
    }
};
}

struct Params { const float* in[N_IN]; float* out; unsigned char* ws; };
struct Frame {
    LAS unsigned char* lds; int tid, lane, wave, bid, G, wave0;
    float* out; unsigned char* ws; float* out0; unsigned char* ws0;
    __device__ __forceinline__ const float* inp(int i) const { const unsigned long long v = ((LAS const unsigned long long*)(lds + PTR_OFF))[i];
        const unsigned lo = __builtin_amdgcn_readfirstlane((unsigned)v), hi = __builtin_amdgcn_readfirstlane((unsigned)(v >> 32)); return (const float*)(const GAS float*)(((unsigned long long)hi << 32) | lo); }
    float* mod; float* rstd; float* rope; bf16 *H, *T1, *T2, *T3, *KS, *VS, *WT; float *rsq0, *rsq1, *rsqv, *bias2;
    __device__ __forceinline__ void fresh() {
        int z = 0; asm volatile("" : "+v"(z));
        lane = __builtin_amdgcn_mbcnt_hi(~0u, __builtin_amdgcn_mbcnt_lo(~0u, z)); int wv = wave0; asm volatile("" : "+s"(wv)); wave = wv; tid = wv * 64 + lane;
        int b = blockIdx.x; asm volatile("" : "+s"(b)); bid = b;
        unsigned char* w = ws0; asm volatile("" : "+s"(w)); w = (unsigned char*)(GAS unsigned char*)(unsigned long long)w; ws = w; float* o = out0; asm volatile("" : "+s"(o)); o = (float*)(GAS float*)(unsigned long long)o; out = o;
        mod = (float*)(w + WS_MOD); rstd = (float*)(w + WS_RSTD); rope = (float*)(w + WS_ROPE);
        H = (bf16*)(w + WS_H); T1 = (bf16*)(w + WS_T1); T2 = (bf16*)(w + WS_T2); T3 = (bf16*)(w + WS_T3); KS = (bf16*)(w + WS_KS); VS = (bf16*)(w + WS_VS); WT = (bf16*)(w + WS_W);
        rsq0 = (float*)(w + WS_X); rsq1 = (float*)(w + WS_X + MiB); rsqv = (float*)(w + WS_X + 2 * MiB); bias2 = (float*)(w + WS_X + 4 * MiB);
    }
};
__device__ __forceinline__ const float* xin_row(const Frame& F, int row) { return row < NPROMPT ? F.inp(I_XP) + (size_t)row * D : F.inp(I_XS) + (size_t)(row - NPROMPT) * D; }
__device__ __forceinline__ int cidx_of(int row) { return row < NPROMPT ? 0 : 1 + ((row - NPROMPT) >> 10); }
__device__ __forceinline__ const float* modp(const Frame& F, int l, int row, int which) { return F.mod + (size_t)((l * 3 + cidx_of(row)) * 6 + which) * D; }


template <int MODE  >
__device__ __forceinline__ void transpose_item(const float* W, int K, int N, bf16* WT, LAS float* scr, int item, int lane) {
    const int nblk = N / 32, kb = item / nblk, nb = item % nblk, k0 = 64 * kb, n0 = 32 * nb;
    int d0 = n0; if (MODE == 1) { const int isu = n0 >= DFF, jj = n0 - isu * DFF; d0 = (jj >> 7) * 256 + isu * 128 + (jj & 127); }
    if (MODE == 2 && n0 < 2 * D) { const int w = n0 & 255; d0 = (n0 & ~255) + ((w >> 5) & 1) * 128 + (w >> 6) * 32; }
    float wv[32];
    const GAS float* wp = (const GAS float*)W + (size_t)(k0 + (lane >> 5)) * N + n0 + (lane & 31);
#pragma unroll
    for (int i = 0; i < 32; ++i) wv[i] = wp[(size_t)(2 * i) * N];
#pragma unroll
    for (int i = 0; i < 32; ++i) scr[(2 * i + (lane >> 5)) * 33 + (lane & 31)] = wv[i];
    asm volatile("s_waitcnt lgkmcnt(0)" ::: "memory");
    const int c = lane & 7;
#pragma unroll
    for (int j = 0; j < 4; ++j) { const int n = (lane >> 3) + 8 * j; const LAS float* sp = scr + (8 * c) * 33 + n;
        u32x4 o; o.x = f2bf(sp[0 * 33]) | (f2bf(sp[1 * 33]) << 16); o.y = f2bf(sp[2 * 33]) | (f2bf(sp[3 * 33]) << 16); o.z = f2bf(sp[4 * 33]) | (f2bf(sp[5 * 33]) << 16); o.w = f2bf(sp[6 * 33]) | (f2bf(sp[7 * 33]) << 16);
        *(u32x4*)(WT + (size_t)(d0 + n) * K + k0 + 8 * c) = o; }
    asm volatile("s_waitcnt lgkmcnt(0)" ::: "memory");
}
template <int MODE = 0>
__device__ __forceinline__ bool transpose_group(int& r, const float* W, int nmat, int K, int N, bf16* WT, LAS float* scr, int lane) {
    const int per = (K / 64) * (N / 32), tot = nmat * per;
    if (r >= tot) { r -= tot; return false; }
    const int mi = r / per; transpose_item<MODE>(W + (size_t)mi * K * N, K, N, WT + (size_t)mi * K * N, scr, r % per, lane); return true;
}

template <int SLOT>
__device__ __forceinline__ void convert_slot(Frame& F, int gw, int NGW) {
    LAS float* scr = (LAS float*)(F.lds + F.wave * 16384);
    constexpr size_t UPE = (size_t)2 * DFF * D, DNE = (size_t)D * DFF;
    constexpr int I_UP1 = (D / 64) * (2 * DFF / 32), I_DN1 = (DFF / 64) * (D / 32), I_LIN = (D / 64) * (2 * DRNN / 32), I_LOUT = (DRNN / 64) * (D / 32), I_WG = 80 * 2 * 4,
                  I_CIN = (D / 64) * (2 * DB / 32), I_COUT = (DB / 64) * (D / 32), I_QKV = (D / 64) * (3 * D / 32), I_AOUT = (D / 64) * (D / 32);
    constexpr int NIT = SLOT == 0 ? I_LIN + I_LOUT + I_WG + I_UP1 + I_DN1 : SLOT == 1 ? I_CIN + I_COUT + I_UP1 : SLOT == 2 ? I_DN1 + I_QKV + I_AOUT + I_UP1 : SLOT == 3 ? I_DN1 + I_LIN + I_LOUT : I_UP1 + I_DN1;
    for (int it = gw; it < NIT; it += NGW) { int r = it;
        if (SLOT == 0) {
            if (transpose_group(r, F.inp(I_LRU_WIN), 1, D, 2 * DRNN, F.WT + WE_LRU_IN, scr, F.lane)) continue;
            if (transpose_group(r, F.inp(I_LRU_WOUT), 1, DRNN, D, F.WT + WE_LRU_OUT, scr, F.lane)) continue;
            if (transpose_group(r, F.inp(I_LRU_WG), 80, 128, 128, F.WT + WE_WG, scr, F.lane)) continue;
            if (transpose_group<1>(r, F.inp(I_FF_WUP), 1, D, 2 * DFF, F.WT + WE_UP, scr, F.lane)) continue;
            transpose_group(r, F.inp(I_FF_WDN), 1, DFF, D, F.WT + WE_DN, scr, F.lane);
        } else if (SLOT == 1) {
            if (transpose_group(r, F.inp(I_CM_WIN), 1, D, 2 * DB, F.WT + WE_CM_IN, scr, F.lane)) continue;
            if (transpose_group(r, F.inp(I_CM_WOUT), 1, DB, D, F.WT + WE_CM_OUT, scr, F.lane)) continue;
            transpose_group<1>(r, F.inp(I_FF_WUP) + UPE, 1, D, 2 * DFF, F.WT + WE_UP + UPE, scr, F.lane);
        } else if (SLOT == 2) {
            if (transpose_group(r, F.inp(I_FF_WDN) + DNE, 1, DFF, D, F.WT + WE_DN + DNE, scr, F.lane)) continue;
            if (transpose_group<2>(r, F.inp(I_AT_WQKV), 1, D, 3 * D, F.WT + WE_QKV, scr, F.lane)) continue;
            if (transpose_group(r, F.inp(I_AT_WOUT), 1, D, D, F.WT + WE_AT_OUT, scr, F.lane)) continue;
            transpose_group<1>(r, F.inp(I_FF_WUP) + 2 * UPE, 1, D, 2 * DFF, F.WT + WE_UP + 2 * UPE, scr, F.lane);
        } else if (SLOT == 3) {
            if (transpose_group(r, F.inp(I_FF_WDN) + 2 * DNE, 1, DFF, D, F.WT + WE_DN + 2 * DNE, scr, F.lane)) continue;
            if (transpose_group(r, F.inp(I_LRU_WIN) + (size_t)D * 2 * DRNN, 1, D, 2 * DRNN, F.WT + WE_LRU_IN + (size_t)D * 2 * DRNN, scr, F.lane)) continue;
            transpose_group(r, F.inp(I_LRU_WOUT) + (size_t)DRNN * D, 1, DRNN, D, F.WT + WE_LRU_OUT + (size_t)DRNN * D, scr, F.lane);
        } else {
            if (transpose_group<1>(r, F.inp(I_FF_WUP) + 3 * UPE, 1, D, 2 * DFF, F.WT + WE_UP + 3 * UPE, scr, F.lane)) continue;
            transpose_group(r, F.inp(I_FF_WDN) + 3 * DNE, 1, DFF, D, F.WT + WE_DN + 3 * DNE, scr, F.lane);
        }
    }
}
__device__ __forceinline__ void phase_prologue(Frame& F) {
    F.fresh();
    LAS float* sc = (LAS float*)F.lds;
    const float* c = F.inp(I_C); const float* cctx = F.inp(I_CCTX);
    for (int i = F.tid; i < 3 * D; i += NT) { const int ci = i >> 10, k = i & 1023; const float v = ci == 0 ? cctx[k] : c[(ci - 1) * D + k]; sc[i] = siluf_(v); }
    __syncthreads();
    LAS float* part = sc + 3 * D;
    const int kp = F.tid >> 6, cl = F.tid & 63;
    for (int item = F.bid; item < DEPTH * 6 * D / 64; item += F.G) {
        const int col = item * 64 + cl, l = col / (6 * D), cc = col % (6 * D);
        const float* w = F.inp(I_WMOD) + (size_t)l * D * 6 * D + cc;
        float s0 = 0.f, s1 = 0.f, s2 = 0.f;
#pragma unroll 1
        for (int kb = kp * 128; kb < kp * 128 + 128; kb += 32) { float wv[32];
#pragma unroll
            for (int i = 0; i < 32; ++i) wv[i] = ((const GAS float*)w)[(size_t)(kb + i) * 6 * D];
#pragma unroll
            for (int i = 0; i < 32; ++i) { s0 += sc[kb + i] * wv[i]; s1 += sc[D + kb + i] * wv[i]; s2 += sc[2 * D + kb + i] * wv[i]; } }
        part[(kp * 3 + 0) * 64 + cl] = s0; part[(kp * 3 + 1) * 64 + cl] = s1; part[(kp * 3 + 2) * 64 + cl] = s2;
        __syncthreads();
        if (F.tid < 192) { const int ci = F.tid >> 6; float s = F.inp(I_BMOD)[l * 6 * D + cc];
            for (int q = 0; q < 8; ++q) s += part[(q * 3 + ci) * 64 + cl];
            F.mod[(size_t)((l * 3 + ci) * 6) * D + cc] = s; }
        __syncthreads();
    }
    { __syncthreads(); convert_slot<0>(F, F.bid * NWAVES + F.wave, F.G * NWAVES); }
    const int gt = F.bid * NT + F.tid, GT = F.G * NT;
    for (int i = gt; i < 1024 * 32; i += GT) { const int t = i >> 5, j = i & 31; const float inv = powf(10000.f, -(float)(j & 15) / 16.f); const float pos = (float)(j < 16 ? (t >> 6) : (t & 63));
        const float ang = pos * inv; F.rope[i] = cosf(ang); F.rope[32768 + i] = sinf(ang); }
    for (int i = gt; i < 8 * 8 * 4 * 64; i += GT) { const int ln = i & 63, ks = (i >> 6) & 3, nf = (i >> 8) & 7, g = i >> 11, cq = ln >> 4, p = 16 * nf + (ln & 15);
        const float* wr = F.inp(I_CM_WS) + (size_t)(g * 128 + p) * 128 + 32 * ks + 4 * cq;
        u32x4 o; o.x = f2bf(wr[0]) | (f2bf(wr[1]) << 16); o.y = f2bf(wr[2]) | (f2bf(wr[3]) << 16); o.z = f2bf(wr[16]) | (f2bf(wr[17]) << 16); o.w = f2bf(wr[18]) | (f2bf(wr[19]) << 16);
        *(u32x4*)(F.WT + WE_WSB + (size_t)i * 8) = o; }
    for (int i = gt; i < 2 * PAST * D; i += GT) { const int b = i / (PAST * D), r = i % (PAST * D);
        F.KS[(size_t)b * TKS * D + r] = (bf16)f2bf(F.inp(I_CK)[i]); F.VS[(size_t)b * TKS * D + r] = (bf16)f2bf(F.inp(I_CV)[i]); }
}

__device__ __forceinline__ void bias2_gemm(Frame& F, const bf16* Wt, int N, int l, int sub, float* outp, int gw, int NGW) {
    float sh[3][16];
#pragma unroll
    for (int ci = 0; ci < 3; ++ci) { const GAS f32x4* sp = (const GAS f32x4*)(F.mod + (size_t)((l * 3 + ci) * 6 + sub * 3) * D + 16 * F.lane);
#pragma unroll
        for (int i = 0; i < 4; ++i) { const f32x4 v = sp[i]; sh[ci][4 * i] = v.x; sh[ci][4 * i + 1] = v.y; sh[ci][4 * i + 2] = v.z; sh[ci][4 * i + 3] = v.w; } }
    for (int n = gw; n < N; n += NGW) { const GAS u32x4* wp = (const GAS u32x4*)(Wt + (size_t)n * D + 16 * F.lane); const u32x4 w0 = wp[0], w1 = wp[1];
        const unsigned ww[8] = {w0.x, w0.y, w0.z, w0.w, w1.x, w1.y, w1.z, w1.w};
        float d0 = 0.f, d1 = 0.f, d2 = 0.f;
#pragma unroll
        for (int i = 0; i < 8; ++i) { const float lo = bf2f(ww[i]), hi = bf2f(ww[i] >> 16); d0 += sh[0][2 * i] * lo + sh[0][2 * i + 1] * hi; d1 += sh[1][2 * i] * lo + sh[1][2 * i + 1] * hi; d2 += sh[2][2 * i] * lo + sh[2][2 * i + 1] * hi; }
        d0 = wave_sum(d0); d1 = wave_sum(d1); d2 = wave_sum(d2);
        if (F.lane == 0) { outp[n] = d0; outp[(size_t)N + n] = d1; outp[(size_t)2 * N + n] = d2; } }
}
__device__ __forceinline__ void bias2_slot(Frame& F, int slot, int gw, int NGW) {
    if (slot == 2) bias2_gemm(F, F.WT + WE_CM_IN, 2 * DB, 1, 0, F.bias2 + B2_CM, gw, NGW);
    else if (slot == 3) bias2_gemm(F, F.WT + WE_UP + (size_t)1 * 2 * DFF * D, 2 * DFF, 1, 1, F.bias2 + B2_UP + (size_t)1 * 3 * 5632, gw, NGW);
    else if (slot == 4) bias2_gemm(F, F.WT + WE_QKV, 3 * D, 2, 0, F.bias2 + B2_QKV, gw, NGW);
    else if (slot == 5) bias2_gemm(F, F.WT + WE_UP + (size_t)2 * 2 * DFF * D, 2 * DFF, 2, 1, F.bias2 + B2_UP + (size_t)2 * 3 * 5632, gw, NGW);
    else if (slot == 6) bias2_gemm(F, F.WT + WE_LRU_IN + (size_t)2 * DRNN * D, 2 * DRNN, 3, 0, F.bias2 + B2_LRU + 3 * 2560, gw, NGW);
    else if (slot == 7) bias2_gemm(F, F.WT + WE_UP + (size_t)3 * 2 * DFF * D, 2 * DFF, 3, 1, F.bias2 + B2_UP + (size_t)3 * 3 * 5632, gw, NGW);
}
__device__ __forceinline__ void side_job(Frame& F, int slot) {
    F.fresh();
    const int nwk = F.G > 160 ? F.G - 160 : F.G, wk = F.G > 160 ? F.bid - 160 : F.bid;
    if (wk < 0) return;
    const int gw = wk * NWAVES + F.wave, NGW = nwk * NWAVES;
    bias2_slot(F, slot, gw, NGW);
    if (slot == 1) convert_slot<1>(F, gw, NGW); else if (slot == 2) convert_slot<2>(F, gw, NGW); else if (slot == 3) convert_slot<3>(F, gw, NGW); else if (slot == 4) convert_slot<4>(F, gw, NGW);
}
__device__ __forceinline__ void phase_modulate0(Frame& F) {
    F.fresh();
    const int gw = F.bid * NWAVES + F.wave, NGW = F.G * NWAVES;
    const float* g = F.inp(I_NORMG);
    for (int row = gw; row < M; row += NGW) {
        const float* xr = xin_row(F, row); const float* scl = modp(F, 0, row, 1);
        f32x4 v[4]; float s = 0.f;
#pragma unroll
        for (int j = 0; j < 4; ++j) { v[j] = *(const GAS f32x4*)(xr + 4 * F.lane + 256 * j); s += v[j].x * v[j].x + v[j].y * v[j].y + v[j].z * v[j].z + v[j].w * v[j].w; }
        s = wave_sum(s);
        if (F.lane < 16) F.rsq0[(size_t)row * 16 + F.lane] = F.lane == 0 ? s : 0.f;
#pragma unroll
        for (int j = 0; j < 4; ++j) { const int c0 = 4 * F.lane + 256 * j; const f32x4 gg = *(const GAS f32x4*)(g + c0), c4 = *(const GAS f32x4*)(scl + c0);
            const f32x4 o = v[j] * gg * (1.f + c4); u32x2 w; w.x = f2bf(o.x) | (f2bf(o.y) << 16); w.y = f2bf(o.z) | (f2bf(o.w) << 16);
            *(GAS u32x2*)(F.H + (size_t)row * D + c0) = w; }
    }
    bias2_gemm(F, F.WT + WE_LRU_IN, 2 * DRNN, 0, 0, F.bias2 + B2_LRU, gw, NGW);
    bias2_gemm(F, F.WT + WE_UP, 2 * DFF, 0, 1, F.bias2 + B2_UP, gw, NGW);
}

template <class P>
__device__ __forceinline__ void gemm_naive(Frame& F, const P& p, int nbatch, int Mr, int N, int K) {
    F.fresh();
    LAS float* As = (LAS float*)F.lds;
    LAS float* Bs = As + 16 * 132;
    const int tid = F.tid, tx = tid & 31, ty = tid >> 5;
    const int tm = Mr / 128, tn = N / 128, per = tm * tn, total = per * nbatch;
    for (int t = F.bid; t < total; t += F.G) {
        const int b = t / per, r = t % per, pn = r / tm, pm = r % tm;
        const bf16* A; int lda; const float* W; int ldw; p.get(b, A, lda, W, ldw);
        float acc[8][4];
#pragma unroll
        for (int i = 0; i < 8; ++i)
#pragma unroll
            for (int j = 0; j < 4; ++j) acc[i][j] = 0.f;
        for (int k0 = 0; k0 < K; k0 += 16) {
            { const int row = tid >> 2, kq = (tid & 3) * 4;
              const u32x2 v = *(const u32x2*)(A + (size_t)(pm * 128 + row) * lda + k0 + kq);
              As[(kq + 0) * 132 + row] = bf2f(v.x); As[(kq + 1) * 132 + row] = bf2f(v.x >> 16); As[(kq + 2) * 132 + row] = bf2f(v.y); As[(kq + 3) * 132 + row] = bf2f(v.y >> 16); }
            { const int k = tid >> 5, n4 = (tid & 31) * 4;
              *(LAS f32x4*)(Bs + k * 128 + n4) = *(const f32x4*)(W + (size_t)(k0 + k) * ldw + pn * 128 + n4); }
            __syncthreads();
#pragma unroll 2
            for (int k = 0; k < 16; ++k) {
                const f32x4 a0 = *(const LAS f32x4*)(As + k * 132 + ty * 8), a1 = *(const LAS f32x4*)(As + k * 132 + ty * 8 + 4), bv = *(const LAS f32x4*)(Bs + k * 128 + tx * 4);
                const float a[8] = {a0.x, a0.y, a0.z, a0.w, a1.x, a1.y, a1.z, a1.w}; const float bb[4] = {bv.x, bv.y, bv.z, bv.w};
#pragma unroll
                for (int i = 0; i < 8; ++i)
#pragma unroll
                    for (int j = 0; j < 4; ++j) acc[i][j] += a[i] * bb[j];
            }
            __syncthreads();
        }
#pragma unroll
        for (int i = 0; i < 8; ++i)
#pragma unroll
            for (int j = 0; j < 4; ++j) p.epi(b, pm * 128 + ty * 8 + i, pn * 128 + tx * 4 + j, acc[i][j]);
    }
}

struct PStoreBf16 {
    const bf16* A; int lda; const float* W; int ldw; bf16* O; int ldo; const float* bias; int act; int split;
    __device__ __forceinline__ void get(int, const bf16*& a, int& la, const float*& w, int& lw) const { a = A; la = lda; w = W; lw = ldw; }
    __device__ __forceinline__ void epi(int, int row, int col, float v) const {
        if (bias) v += bias[col];
        if (act == 1 || (act == 2 && col < split)) v = gelu_tanh(v);
        O[(size_t)row * ldo + col] = (bf16)f2bf(v); }
};
struct PResid {
    const bf16* A; int lda; const float* W; int ldw; float* out; const float* xp; const float* xs; const float* modl; int which; bool from_input;
    __device__ __forceinline__ void get(int, const bf16*& a, int& la, const float*& w, int& lw) const { a = A; la = lda; w = W; lw = ldw; }
    __device__ __forceinline__ void epi(int, int row, int col, float v) const {
        const float base = from_input ? (row < NPROMPT ? xp[(size_t)row * D + col] : xs[(size_t)(row - NPROMPT) * D + col]) : out[(size_t)row * D + col];
        out[(size_t)row * D + col] = base + modl[(size_t)(cidx_of(row) * 6 + which) * D + col] * v; }
};
struct PLruIn {
    const bf16* A; const float* W; bf16* GBp; bf16* RECp;
    __device__ __forceinline__ void get(int, const bf16*& a, int& la, const float*& w, int& lw) const { a = A; la = D; w = W; lw = 2 * DRNN; }
    __device__ __forceinline__ void epi(int, int row, int col, float v) const {
        if (col < DRNN) GBp[(size_t)row * DRNN + col] = (bf16)f2bf(gelu_tanh(v)); else RECp[(size_t)row * DRNN + col - DRNN] = (bf16)f2bf(v); }
};
struct PGates {
    const bf16* XC; const float* WG; const float* BG; bf16* O;
    __device__ __forceinline__ void get(int b, const bf16*& a, int& la, const float*& w, int& lw) const { a = XC + (b % 10) * 128; la = DRNN; w = WG + (size_t)b * 128 * 128; lw = 128; }
    __device__ __forceinline__ void epi(int b, int row, int col, float v) const { const int dg = b / 10, n = b % 10;
        O[((size_t)dg * M + row) * DRNN + n * 128 + col] = (bf16)f2bf(sigmoidf_(v + BG[dg * DRNN + n * 128 + col])); }
};

__device__ __forceinline__ void phase_lru_conv(Frame& F, int j, const bf16* REC, bf16* XC) {
    F.fresh();
    const float* cw = F.inp(I_LRU_CW) + (size_t)j * 4 * DRNN; const float* cb = F.inp(I_LRU_CB) + (size_t)j * DRNN;
    const int gt = F.bid * NT + F.tid, GT = F.G * NT;
    for (int i = gt; i < M * DRNN; i += GT) { const int row = i / DRNN, ch = i % DRNN;
        int t, T; if (row < NPROMPT) { t = row & 255; T = 256; } else { t = (row - NPROMPT) & 1023; T = 1024; }
        float s = cb[ch];
#pragma unroll
        for (int k = 0; k < 4; ++k) { const int tt = t + k - 2; if (tt >= 0 && tt < T) s += cw[k * DRNN + ch] * bf2f(REC[(size_t)(row + k - 2) * DRNN + ch]); }
        XC[i] = (bf16)f2bf(s); }
}
__device__ __forceinline__ void phase_lru_scan(Frame& F, int j, const bf16* GATES, const bf16* XC, const bf16* GB, bf16* HS) {
    F.fresh();
    const int gt = F.bid * NT + F.tid, GT = F.G * NT;
    const int NL = (2 + 32) * DRNN;
    for (int line = gt; line < NL; line += GT) {
        const int s = line / DRNN, ch = line % DRNN;
        int base, T; float h0f = 0.f, h0b = 0.f;
        if (s < 2) { base = NPROMPT + s * 1024; T = 1024; h0f = F.inp(I_STATE)[((size_t)(s * 2 + j) * 2 + 0) * DRNN + ch]; h0b = F.inp(I_STATE)[((size_t)(s * 2 + j) * 2 + 1) * DRNN + ch]; }
        else { base = (s - 2) * 256; T = 256; }
        const float spf = softplusf_(-F.inp(I_LRU_LAM)[(size_t)(j * 2 + 0) * DRNN + ch]), spb = softplusf_(-F.inp(I_LRU_LAM)[(size_t)(j * 2 + 1) * DRNN + ch]);
        float h = h0f;
        for (int t = 0; t < T; ++t) { const size_t o = (size_t)(base + t) * DRNN + ch;
            const float r = bf2f(GATES[o]), ig = bf2f(GATES[(size_t)M * DRNN + o]), xc = bf2f(XC[o]);
            const float la = -8.f * r * spf, a = expf(la), bx = sqrtf(-expm1f(2.f * la)) * (ig * xc);
            h = a * h + bx; HS[o] = (bf16)f2bf(h); }
        const float ff = h;
        h = h0b;
        for (int t = T - 1; t >= 0; --t) { const size_t o = (size_t)(base + t) * DRNN + ch;
            const float r = bf2f(GATES[(size_t)2 * M * DRNN + o]), ig = bf2f(GATES[(size_t)3 * M * DRNN + o]), xc = bf2f(XC[o]);
            const float la = -8.f * r * spb, a = expf(la), bx = sqrtf(-expm1f(2.f * la)) * (ig * xc);
            h = a * h + bx; HS[o] = (bf16)f2bf(bf2f(GB[o]) * (bf2f(HS[o]) + h)); }
        if (s >= 2) { float* st = F.out + O_STATE + ((size_t)((s - 2) * 2 + j) * 2) * DRNN; st[ch] = ff; st[DRNN + ch] = h; }
    }
}


typedef short bf16x8 __attribute__((ext_vector_type(8)));
typedef short v4i16_t __attribute__((ext_vector_type(4)));
constexpr int LRU_XS = 272;
constexpr int LRU_XC_OFF = 0, LRU_GB_OFF = 256 * LRU_XS;
template <bool REV>
__device__ __forceinline__ float lru_dir(LAS const unsigned char* xct, LAS unsigned char* hft, const bf16* wgt  ,
                                         const bf16* gbp  , float br, float bi, float sp, float hc, int wave, int lane, bool wantp, bf16* Pdst) {
    const int c = lane & 15, q = lane >> 4, qq = REV ? 3 - q : q;
    bf16x8 Br[4], Bi[4], Id;
#pragma unroll
    for (int ks = 0; ks < 4; ++ks) { Br[ks] = *(const GAS bf16x8*)(wgt + (size_t)(16 * wave + c) * 128 + 32 * ks + 8 * q);
                                     Bi[ks] = *(const GAS bf16x8*)(wgt + (size_t)10 * 128 * 128 + (size_t)(16 * wave + c) * 128 + 32 * ks + 8 * q); }
#pragma unroll
    for (int jj = 0; jj < 8; ++jj) Id[jj] = (8 * q + jj == 16 * (wave & 1) + c) ? (short)0x3F80 : (short)0;
    const int ksel = wave >> 1;
    const float nsp8 = -8.f * sp * 1.44269504f;
    float Pc = 1.f;
    unsigned short gcur[16], gnxt[16];
#pragma unroll
    for (int i = 0; i < 16; ++i) { gcur[i] = 0; gnxt[i] = 0; }
    if (REV) {
#pragma unroll
        for (int i = 0; i < 16; ++i) gcur[i] = *(const GAS unsigned short*)(gbp + (size_t)(16 * (12 + (i >> 2)) + 4 * q + (i & 3)) * DRNN); }
#pragma unroll 1
    for (int og = 0; og < 4; ++og) {
        if (REV && og < 3) {
#pragma unroll
            for (int i = 0; i < 16; ++i) gnxt[i] = *(const GAS unsigned short*)(gbp + (size_t)(16 * (4 * (2 - og) + (i >> 2)) + 4 * q + (i & 3)) * DRNN); }
#pragma unroll
        for (int ii = 0; ii < 4; ++ii) {
        const int it = 4 * og + ii, mi = REV ? 15 - it : it, mloc = REV ? 3 - ii : ii;
        LAS const unsigned char* rp = xct + (16 * mi + c) * LRU_XS + 16 * q;
        bf16x8 Af[4];
#pragma unroll
        for (int ks = 0; ks < 4; ++ks) Af[ks] = *(LAS const bf16x8*)(rp + 64 * ks);
        const bf16x8 Ax = *(LAS const bf16x8*)(rp + 64 * ksel);
        f32x4 r = {0.f, 0.f, 0.f, 0.f}, ig = {0.f, 0.f, 0.f, 0.f};
#pragma unroll
        for (int ks = 0; ks < 4; ++ks) { r = __builtin_amdgcn_mfma_f32_16x16x32_bf16(Af[ks], Br[ks], r, 0, 0, 0); ig = __builtin_amdgcn_mfma_f32_16x16x32_bf16(Af[ks], Bi[ks], ig, 0, 0, 0); }
        const f32x4 xc = __builtin_amdgcn_mfma_f32_16x16x32_bf16(Ax, Id, (f32x4){0.f, 0.f, 0.f, 0.f}, 0, 0, 0);
        float av[4], bv[4];
#pragma unroll
        for (int k = 0; k < 4; ++k) { const float rg = __builtin_amdgcn_rcpf(1.f + __builtin_amdgcn_exp2f(-1.44269504f * (r[k] + br))), iv = __builtin_amdgcn_rcpf(1.f + __builtin_amdgcn_exp2f(-1.44269504f * (ig[k] + bi)));
            const float l2a = nsp8 * rg, x = 1.38629436f * l2a;
            const float oms = -x * (1.f + x * (0.5f + x * (0.16666667f + x * (0.041666668f + x * 0.0083333338f))));
            const float om = x > -0.25f ? oms : 1.f - __builtin_amdgcn_exp2f(2.f * l2a);
            av[k] = __builtin_amdgcn_exp2f(l2a); bv[k] = __builtin_amdgcn_sqrtf(om) * (iv * xc[k]); }
        float pA[4], pB[4];
#pragma unroll
        for (int kk = 0; kk < 4; ++kk) { const int k = REV ? 3 - kk : kk;
            if (kk == 0) { pA[k] = av[k]; pB[k] = bv[k]; } else { const int kp = REV ? k + 1 : k - 1; pA[k] = pA[kp] * av[k]; pB[k] = pB[kp] * av[k] + bv[k]; } }
        const int kl = REV ? 0 : 3;
        float gA[4], gB[4];
#pragma unroll
        for (int g = 0; g < 4; ++g) { const int src = 16 * (REV ? 3 - g : g) + c; gA[g] = bperm(pA[kl], src); gB[g] = bperm(pB[kl], src); }
        float eA = 1.f, eB = 0.f, tA = 1.f, tB = 0.f;
#pragma unroll
        for (int g = 0; g < 4; ++g) { if (g == qq) { eA = tA; eB = tB; } tB = tB * gA[g] + gB[g]; tA = tA * gA[g]; }
        const float hin = eA * hc + eB;
#pragma unroll
        for (int k = 0; k < 4; ++k) { const float h = pA[k] * hin + pB[k]; const int row = 16 * mi + 4 * q + k;
            if (wantp) Pdst[(size_t)row * DRNN] = (bf16)f2bf(pA[k] * eA * Pc);
            LAS unsigned short* hp = (LAS unsigned short*)(hft + row * LRU_XS + 2 * (16 * wave + c));
            if (!REV) *hp = (unsigned short)f2bf(h); else *hp = (unsigned short)f2bf(bf2f(gcur[4 * mloc + k]) * (bf2f(*hp) + h)); }
        hc = tA * hc + tB; Pc *= tA;
        }
        if (REV) {
#pragma unroll
            for (int i = 0; i < 16; ++i) gcur[i] = gnxt[i]; }
    }
    return hc;
}
__device__ __forceinline__ void lru_unit(Frame& F, int j, int pm, int n, const bf16* REC, const bf16* GB, bf16* HS, bf16* PF, bf16* PB, float* AGG, const bf16* WGT) {
    const int tid = F.tid, lane = F.lane, wave = F.wave, r0 = 256 * pm;
    const bool smp = pm >= 32; const int tix = smp ? (pm - 32) & 3 : 0, sq = smp ? (pm - 32) >> 2 : 0;
    const int t0 = smp ? 256 * tix : 0, T = smp ? 1024 : 256;
    LAS unsigned char* xct = F.lds + LRU_XC_OFF; LAS unsigned char* hft = F.lds + LRU_GB_OFF;
    { const float* cw = F.inp(I_LRU_CW) + (size_t)j * 4 * DRNN + n * 128 + 2 * lane; const float* cb = F.inp(I_LRU_CB) + (size_t)j * DRNN + n * 128 + 2 * lane;
      float w0[4], w1[4];
#pragma unroll
      for (int k = 0; k < 4; ++k) { w0[k] = cw[k * DRNN]; w1[k] = cw[k * DRNN + 1]; }
      const float b0 = cb[0], b1 = cb[1];
      unsigned v[35];
#pragma unroll
      for (int i = 0; i < 35; ++i) { const int tl = 32 * wave + i - 2, tt = t0 + tl;
          v[i] = (tt >= 0 && tt < T) ? *(const GAS unsigned*)(REC + (size_t)(r0 + tl) * DRNN + n * 128 + 2 * lane) : 0u; }
#pragma unroll
      for (int i = 0; i < 32; ++i) { float s0 = b0, s1 = b1;
#pragma unroll
          for (int k = 0; k < 4; ++k) { s0 += w0[k] * bf2f(v[i + k]); s1 += w1[k] * bf2f(v[i + k] >> 16); }
          *(LAS unsigned*)(xct + (32 * wave + i) * LRU_XS + 4 * lane) = f2bf(s0) | (f2bf(s1) << 16); } }
    __syncthreads();
    const int c = lane & 15, q = lane >> 4, ch = n * 128 + 16 * wave + c;
    const float* bg = F.inp(I_LRU_BG) + (size_t)j * 4 * DRNN; const float* lam = F.inp(I_LRU_LAM) + (size_t)j * 2 * DRNN;
    const bf16* gbp = GB + (size_t)r0 * DRNN + ch;
    bf16* pf = PF + (size_t)(smp ? r0 - NPROMPT : 0) * DRNN + ch; bf16* pb = PB + (size_t)(smp ? r0 - NPROMPT : 0) * DRNN + ch;
    { float h0 = 0.f; if (smp && tix == 0) h0 = F.inp(I_STATE)[((size_t)(sq * 2 + j) * 2 + 0) * DRNN + ch];
      const float hfin = lru_dir<false>(xct, hft, WGT + (size_t)(0 * 10 + n) * 128 * 128, gbp, bg[0 * DRNN + ch], bg[1 * DRNN + ch], softplusf_(-lam[ch]), h0, wave, lane, smp, pf);
      if (q == 0) { if (smp) AGG[(size_t)((sq * 4 + tix) * 2 + 0) * DRNN + ch] = hfin; else F.out[O_STATE + ((size_t)(pm * 2 + j) * 2 + 0) * DRNN + ch] = hfin; } }
    { float h0 = 0.f; if (smp && tix == 3) h0 = F.inp(I_STATE)[((size_t)(sq * 2 + j) * 2 + 1) * DRNN + ch];
      const float hfin = lru_dir<true>(xct, hft, WGT + (size_t)(2 * 10 + n) * 128 * 128, gbp, bg[2 * DRNN + ch], bg[3 * DRNN + ch], softplusf_(-lam[DRNN + ch]), h0, wave, lane, smp, pb);
      if (q == 0) { if (smp) AGG[(size_t)((sq * 4 + tix) * 2 + 1) * DRNN + ch] = hfin; else F.out[O_STATE + ((size_t)(pm * 2 + j) * 2 + 1) * DRNN + ch] = hfin; } }
    __syncthreads();
#pragma unroll
    for (int i = 0; i < 8; ++i) { const int id = i * NT + tid, row = id >> 4, cc = id & 15;
        *(GAS u32x4*)(HS + (size_t)(r0 + row) * DRNN + n * 128 + 8 * cc) = *(LAS const u32x4*)(hft + row * LRU_XS + 16 * cc); }
    __syncthreads();
}
__device__ __forceinline__ void phase_lru_core(Frame& F, int j, const bf16* REC, const bf16* GB, bf16* HS, bf16* PF, bf16* PB, float* AGG, const bf16* WGT) {
    F.fresh();
    for (int u = F.bid; u < 400; u += F.G) {
        const int pm = u < 80 ? 32 + u / 10 : (u - 80) / 10, n = u % 10;
        lru_unit(F, j, pm, n, REC, GB, HS, PF, PB, AGG, WGT); }
}
__device__ __forceinline__ void phase_lru_fixup(Frame& F, const bf16* GB, bf16* HS, const bf16* PF, const bf16* PB, const float* AGG) {
    F.fresh();
    const int gt = F.bid * NT + F.tid, GT = F.G * NT;
    for (int i = gt; i < NSAMPLE * DRNN; i += GT) { const int rs = i / DRNN, ch = i % DRNN, sq = rs >> 10, tix = (rs >> 8) & 3;
        float cf = 0.f, cbk = 0.f;
        if (tix > 0) { for (int t = 0; t < tix; ++t) { const float At = bf2f(PF[(size_t)(sq * 1024 + t * 256 + 255) * DRNN + ch]); cf = At * cf + AGG[(size_t)((sq * 4 + t) * 2 + 0) * DRNN + ch]; } }
        if (tix < 3) { for (int t = 3; t > tix; --t) { const float At = bf2f(PB[(size_t)(sq * 1024 + t * 256) * DRNN + ch]); cbk = At * cbk + AGG[(size_t)((sq * 4 + t) * 2 + 1) * DRNN + ch]; } }
        const size_t o = (size_t)(NPROMPT + rs) * DRNN + ch;
        HS[o] = (bf16)f2bf(bf2f(HS[o]) + bf2f(GB[o]) * (bf2f(PF[(size_t)rs * DRNN + ch]) * cf + bf2f(PB[(size_t)rs * DRNN + ch]) * cbk)); }
}

__device__ __forceinline__ void phase_cmlp_rstd(Frame& F, const bf16* UV) {
    F.fresh();
    const int gw = F.bid * NWAVES + F.wave, NGW = F.G * NWAVES;
    for (int row = gw; row < M; row += NGW) { float s = 0.f;
        for (int c = F.lane; c < DB; c += 64) { const float v = bf2f(UV[(size_t)row * 2 * DB + DB + c]); s += v * v; }
        s = wave_sum(s); if (F.lane == 0) F.rstd[row] = rsqrtf(s * (1.f / DB) + EPS); }
}
__device__ __forceinline__ void phase_cmlp_spatial(Frame& F, const bf16* UV, bf16* ACT) {
    F.fresh();
    const float* ws = F.inp(I_CM_WS); const float* bs = F.inp(I_CM_BS); const float* ng = F.inp(I_CM_NG);
    const int gt = F.bid * NT + F.tid, GT = F.G * NT;
    for (int i = gt; i < M * DB; i += GT) { const int row = i / DB, ch = i % DB, g = ch >> 8, p = row & 127, r0 = row & ~127;
        float s = 0.f;
        for (int q = 0; q < 128; ++q) s += ws[(size_t)(g * 128 + p) * 128 + q] * F.rstd[r0 + q] * bf2f(UV[(size_t)(r0 + q) * 2 * DB + DB + ch]);
        const float sv = s * ng[ch] + bs[g * 128 + p];
        ACT[i] = (bf16)f2bf(bf2f(UV[(size_t)row * 2 * DB + ch]) * sv); }
}


constexpr int CM_VS = 544;
__device__ __forceinline__ void phase_cmlp_spatial_mfma(Frame& F, const bf16* UV, bf16* ACT, const bf16* WSB) {
    F.fresh();
    const int tid = F.tid, lane = F.lane, wave = F.wave, c = lane & 15, q4 = lane >> 4;
    LAS unsigned char* vt = F.lds;
    const float* ng = F.inp(I_CM_NG); const float* bs = F.inp(I_CM_BS);
    for (int u = F.bid; u < 640; u += F.G) {
        const int chunk = u >> 3, g = u & 7, r0 = chunk * 128;
        LAS float* rsl = (LAS float*)(vt + 128 * CM_VS);
        if (tid < 128) { const GAS f32x4* p = (const GAS f32x4*)(F.rsqv + (size_t)(r0 + tid) * 32); float sm = 0.f;
#pragma unroll
            for (int i = 0; i < 8; ++i) { const f32x4 t4 = p[i]; sm += (t4.x + t4.y) + (t4.z + t4.w); }
            rsl[tid] = rsqrtf(sm * (1.f / DB) + EPS); }
        __syncthreads();
#pragma unroll
        for (int i = 0; i < 8; ++i) { const int id = i * NT + tid, row = id >> 5, cc = id & 31;
            const u32x4 x = *(const GAS u32x4*)(UV + (size_t)(r0 + row) * 2 * DB + DB + g * 256 + 8 * cc); const float rs = rsl[row];
            u32x4 y; y.x = f2bf(bf2f(x.x) * rs) | (f2bf(bf2f(x.x >> 16) * rs) << 16); y.y = f2bf(bf2f(x.y) * rs) | (f2bf(bf2f(x.y >> 16) * rs) << 16);
            y.z = f2bf(bf2f(x.z) * rs) | (f2bf(bf2f(x.z >> 16) * rs) << 16); y.w = f2bf(bf2f(x.w) * rs) | (f2bf(bf2f(x.w >> 16) * rs) << 16);
            *(LAS u32x4*)(vt + row * CM_VS + 16 * cc) = y; }
        __syncthreads();
        bf16x8 vf[2][4];
#pragma unroll
        for (int mfc = 0; mfc < 2; ++mfc)
#pragma unroll
            for (int ks = 0; ks < 4; ++ks) { LAS const unsigned char* vp = vt + (32 * ks + 4 * q4 + (c >> 2)) * CM_VS + (32 * wave + 16 * mfc + 4 * (c & 3)) * 2;
                const v4i16_t lo = __builtin_amdgcn_ds_read_tr16_b64_v4i16((LAS v4i16_t*)vp), hi = __builtin_amdgcn_ds_read_tr16_b64_v4i16((LAS v4i16_t*)(vp + 16 * CM_VS));
                vf[mfc][ks] = (bf16x8){lo[0], lo[1], lo[2], lo[3], hi[0], hi[1], hi[2], hi[3]}; }
#pragma unroll
        for (int nf = 0; nf < 8; ++nf) {
            bf16x8 Bf[4];
#pragma unroll
            for (int ks = 0; ks < 4; ++ks) Bf[ks] = *(const GAS bf16x8*)(WSB + ((size_t)((g * 8 + nf) * 4 + ks) * 64 + lane) * 8);
            const int p = 16 * nf + c; const float bsv = bs[g * 128 + p];
#pragma unroll
            for (int mfc = 0; mfc < 2; ++mfc) { f32x4 acc = {0.f, 0.f, 0.f, 0.f};
#pragma unroll
                for (int ks = 0; ks < 4; ++ks) acc = __builtin_amdgcn_mfma_f32_16x16x32_bf16(vf[mfc][ks], Bf[ks], acc, 0, 0, 0);
                const int ch = g * 256 + 32 * wave + 16 * mfc + 4 * q4;
                const f32x4 g4 = *(const GAS f32x4*)(ng + ch); const u32x2 uu = *(const GAS u32x2*)(UV + (size_t)(r0 + p) * 2 * DB + ch);
                const float o0 = bf2f(uu.x) * (acc[0] * g4.x + bsv), o1 = bf2f(uu.x >> 16) * (acc[1] * g4.y + bsv), o2 = bf2f(uu.y) * (acc[2] * g4.z + bsv), o3 = bf2f(uu.y >> 16) * (acc[3] * g4.w + bsv);
                u32x2 w; w.x = f2bf(o0) | (f2bf(o1) << 16); w.y = f2bf(o2) | (f2bf(o3) << 16);
                *(GAS u32x2*)(ACT + (size_t)(r0 + p) * DB + ch) = w; }
        }
        __syncthreads();
    }
}

__device__ __forceinline__ void phase_qkv_post(Frame& F, const bf16* QKV, bf16* Q, bf16* KP, bf16* VP) {
    F.fresh();
    const int gw = F.bid * NWAVES + F.wave, NGW = F.G * NWAVES;
    const float* qkg = F.inp(I_AT_QKG);
    for (int row = gw; row < M; row += NGW) {
        const bool smp = row >= NPROMPT; const int sb = smp ? (row - NPROMPT) >> 10 : 0, t = smp ? (row - NPROMPT) & 1023 : 0;
        const float cs = smp ? F.rope[t * 32 + (F.lane & 31)] : 1.f, sn = smp ? F.rope[32768 + t * 32 + (F.lane & 31)] : 0.f;
        for (int grp = 0; grp < 32; ++grp) {
            const float v = bf2f(QKV[(size_t)row * 3072 + grp * 64 + F.lane]);
            const float ms = wave_sum(v * v) * (1.f / 64.f);
            float n = v * rsqrtf(ms + EPS) * qkg[(grp >> 4) * 64 + F.lane];
            const float keep = n;
            if (smp) { float pr; { auto r_ = __builtin_amdgcn_permlane32_swap(__builtin_bit_cast(unsigned, n), __builtin_bit_cast(unsigned, n), false, false); pr = __builtin_bit_cast(float, F.lane < 32 ? (unsigned)r_[1] : (unsigned)r_[0]); } n = F.lane < 32 ? n * cs - pr * sn : n * cs + pr * sn; }
            if (grp < 16) Q[(size_t)row * D + grp * 64 + F.lane] = (bf16)f2bf(n);
            else { const int c = (grp - 16) * 64 + F.lane;
                if (smp) F.KS[((size_t)sb * TKS + PAST + t) * D + c] = (bf16)f2bf(n);
                else { KP[(size_t)row * D + c] = (bf16)f2bf(keep); F.out[O_CK + (size_t)row * D + c] = keep; } }
        }
        for (int c = F.lane; c < D; c += 64) { const bf16 vb = QKV[(size_t)row * 3072 + 2048 + c];
            if (smp) F.VS[((size_t)sb * TKS + PAST + t) * D + c] = vb; else { VP[(size_t)row * D + c] = vb; F.out[O_CV + (size_t)row * D + c] = bf2f(vb); } }
    }
}
__device__ __forceinline__ void phase_attn_naive(Frame& F, int l, const bf16* Q, const bf16* KP, const bf16* VP, bf16* O) {
    F.fresh();
    const int gw = F.bid * NWAVES + F.wave, NGW = F.G * NWAVES;
    LAS float* s1 = (LAS float*)F.lds + F.wave * 3328; LAS float* s2 = s1 + 1536; LAS float* qs = s2 + 1536;
    const float* al = F.inp(I_AT_LAM);
    const float lam_init = 0.8f - 0.6f * expf(-0.3f * (float)l);
    const float lam = expf(wave_sum(al[F.lane] * al[64 + F.lane])) - expf(wave_sum(al[128 + F.lane] * al[192 + F.lane])) + lam_init;
    const float* sg = F.inp(I_AT_SUBG);
    for (int item = gw; item < M * 8; item += NGW) {
        const int row = item >> 3, h = item & 7;
        const bf16 *Kb, *Vb; int Tk;
        if (row < NPROMPT) { Kb = KP + (size_t)(row & ~255) * D; Vb = VP + (size_t)(row & ~255) * D; Tk = 256; }
        else { const int sb = (row - NPROMPT) >> 10; Kb = F.KS + (size_t)sb * TKS * D; Vb = F.VS + (size_t)sb * TKS * D; Tk = TKS; }
        qs[F.lane] = bf2f(Q[(size_t)row * D + h * 128 + F.lane]); qs[64 + F.lane] = bf2f(Q[(size_t)row * D + h * 128 + 64 + F.lane]);
        asm volatile("s_waitcnt lgkmcnt(0)" ::: "memory");
        float m1 = -1e30f, m2 = -1e30f;
        for (int k = F.lane; k < Tk; k += 64) { const bf16* kr = Kb + (size_t)k * D + h * 128; float d1 = 0.f, d2 = 0.f;
#pragma unroll 4
            for (int d = 0; d < 64; d += 2) { const unsigned a = *(const unsigned*)(kr + d), b = *(const unsigned*)(kr + 64 + d);
                d1 += qs[d] * bf2f(a) + qs[d + 1] * bf2f(a >> 16); d2 += qs[64 + d] * bf2f(b) + qs[64 + d + 1] * bf2f(b >> 16); }
            d1 *= 0.125f; d2 *= 0.125f; s1[k] = d1; s2[k] = d2; m1 = fmaxf(m1, d1); m2 = fmaxf(m2, d2); }
        m1 = wave_max(m1); m2 = wave_max(m2);
        float l1 = 0.f, l2 = 0.f;
        for (int k = F.lane; k < Tk; k += 64) { const float e1 = expf(s1[k] - m1), e2 = expf(s2[k] - m2); s1[k] = e1; s2[k] = e2; l1 += e1; l2 += e2; }
        l1 = wave_sum(l1); l2 = wave_sum(l2);
        const float i1 = 1.f / l1, i2 = lam / l2;
        for (int k = F.lane; k < Tk; k += 64) s1[k] = bf2f(f2bf(s1[k] * i1 - s2[k] * i2));
        asm volatile("s_waitcnt lgkmcnt(0)" ::: "memory");
        float o0 = 0.f, o1 = 0.f;
        for (int k = 0; k < Tk; ++k) { const unsigned vv = *(const unsigned*)(Vb + (size_t)k * D + h * 128 + 2 * F.lane); const float w = s1[k]; o0 += w * bf2f(vv); o1 += w * bf2f(vv >> 16); }
        const float ms = wave_sum(o0 * o0 + o1 * o1) * (1.f / 128.f), rs = rsqrtf(ms + EPS) * (1.f - lam_init);
        o0 = o0 * rs * sg[2 * F.lane]; o1 = o1 * rs * sg[2 * F.lane + 1];
        *(unsigned*)(O + (size_t)row * D + h * 128 + 2 * F.lane) = f2bf(o0) | (f2bf(o1) << 16);
        asm volatile("s_waitcnt lgkmcnt(0)" ::: "memory");
    }
}


constexpr int AT_KT = 128, AT_NMF = AT_KT / 16, AT_NCH = AT_KT / 32;
constexpr int AT_KS = 272, AT_VS = 288, AT_KBYTES = AT_KT * AT_KS, AT_VBYTES = AT_KT * AT_VS, AT_BUF = AT_KBYTES + AT_VBYTES;
__device__ __forceinline__ void attn_unit(Frame& F, int l, const bf16* Qrows  , const bf16* Kb, const bf16* Vb, int Tk, bf16* Orows, int h, float lam, float lam_init) {
    const int tid = F.tid, lane = F.lane, wave = F.wave, c = lane & 15, q4 = lane >> 4;
    LAS unsigned char* lds = F.lds;
    const float SC = 0.18033688f;
    bf16x8 Qf[2][2];
#pragma unroll
    for (int cp = 0; cp < 2; ++cp)
#pragma unroll
        for (int ks = 0; ks < 2; ++ks) Qf[cp][ks] = *(const GAS bf16x8*)(Qrows + (size_t)(16 * wave + c) * D + h * 128 + cp * 64 + 32 * ks + 8 * q4);
    const int nt = Tk / AT_KT;
    const int key0 = tid >> 4, cc0 = tid & 15;
    u32x4 kreg[AT_NCH], vreg[AT_NCH];
    float m1 = -1e30f, m2 = -1e30f, l1 = 0.f, l2 = 0.f;
#pragma unroll
    for (int i = 0; i < AT_NCH; ++i) kreg[i] = *(const GAS u32x4*)(Kb + (size_t)(key0 + 32 * i) * D + h * 128 + 8 * cc0);
#pragma unroll
    for (int i = 0; i < AT_NCH; ++i) *(LAS u32x4*)(lds + (key0 + 32 * i) * AT_KS + 16 * cc0) = kreg[i];
    __syncthreads();
    for (int t = 0; t < nt; ++t) {
        LAS const unsigned char* kt = lds + (t & 1) * AT_BUF;
        if (t + 1 < nt) {
#pragma unroll
            for (int i = 0; i < AT_NCH; ++i) kreg[i] = *(const GAS u32x4*)(Kb + (size_t)((t + 1) * AT_KT + key0 + 32 * i) * D + h * 128 + 8 * cc0); }
#pragma unroll
        for (int hf = 0; hf < AT_NMF / 4; ++hf) {
            f32x4 S[2][4];
#pragma unroll
            for (int cp = 0; cp < 2; ++cp)
#pragma unroll
                for (int mf = 0; mf < 4; ++mf) { S[cp][mf] = (f32x4){0.f, 0.f, 0.f, 0.f};
#pragma unroll
                    for (int ks = 0; ks < 2; ++ks) { const bf16x8 kf = *(LAS const bf16x8*)(kt + (64 * hf + 16 * mf + c) * AT_KS + cp * 128 + ks * 64 + 16 * q4);
                        S[cp][mf] = __builtin_amdgcn_mfma_f32_16x16x32_bf16(kf, Qf[cp][ks], S[cp][mf], 0, 0, 0); } }
            float x1 = -1e30f, x2 = -1e30f;
#pragma unroll
            for (int mf = 0; mf < 4; ++mf)
#pragma unroll
                for (int k = 0; k < 4; ++k) { x1 = fmaxf(x1, S[0][mf][k]); x2 = fmaxf(x2, S[1][mf][k]); }
            x1 = max_q4(x1); x2 = max_q4(x2);
            const float n1 = fmaxf(m1, x1), n2 = fmaxf(m2, x2);
            l1 *= __builtin_amdgcn_exp2f((m1 - n1) * SC); l2 *= __builtin_amdgcn_exp2f((m2 - n2) * SC); m1 = n1; m2 = n2;
            const float o1 = m1 * SC, o2 = m2 * SC;
#pragma unroll
            for (int mf = 0; mf < 4; ++mf)
#pragma unroll
                for (int k = 0; k < 4; ++k) { l1 += __builtin_amdgcn_exp2f(S[0][mf][k] * SC - o1); l2 += __builtin_amdgcn_exp2f(S[1][mf][k] * SC - o2); }
        }
        if (t + 1 < nt) {
#pragma unroll
            for (int i = 0; i < AT_NCH; ++i) *(LAS u32x4*)(lds + ((t + 1) & 1) * AT_BUF + (key0 + 32 * i) * AT_KS + 16 * cc0) = kreg[i]; }
        __syncthreads();
    }
    l1 = sum_q4(l1); l2 = sum_q4(l2);
    const float i1 = 1.f / l1, i2 = lam / l2, o1 = m1 * SC, o2 = m2 * SC;
    f32x4 Ot[8];
#pragma unroll
    for (int md = 0; md < 8; ++md) Ot[md] = (f32x4){0.f, 0.f, 0.f, 0.f};
#pragma unroll
    for (int i = 0; i < AT_NCH; ++i) { kreg[i] = *(const GAS u32x4*)(Kb + (size_t)(key0 + 32 * i) * D + h * 128 + 8 * cc0); vreg[i] = *(const GAS u32x4*)(Vb + (size_t)(key0 + 32 * i) * D + h * 128 + 8 * cc0); }
#pragma unroll
    for (int i = 0; i < AT_NCH; ++i) { *(LAS u32x4*)(lds + (key0 + 32 * i) * AT_KS + 16 * cc0) = kreg[i]; *(LAS u32x4*)(lds + AT_KBYTES + (key0 + 32 * i) * AT_VS + 16 * cc0) = vreg[i]; }
    __syncthreads();
    for (int t = 0; t < nt; ++t) {
        LAS const unsigned char* kt = lds + (t & 1) * AT_BUF; LAS const unsigned char* vt = kt + AT_KBYTES;
        if (t + 1 < nt) {
#pragma unroll
            for (int i = 0; i < AT_NCH; ++i) { kreg[i] = *(const GAS u32x4*)(Kb + (size_t)((t + 1) * AT_KT + key0 + 32 * i) * D + h * 128 + 8 * cc0);
                                               vreg[i] = *(const GAS u32x4*)(Vb + (size_t)((t + 1) * AT_KT + key0 + 32 * i) * D + h * 128 + 8 * cc0); } }
#pragma unroll
        for (int hf = 0; hf < AT_NMF / 4; ++hf) {
            f32x4 S[2][4];
#pragma unroll
            for (int cp = 0; cp < 2; ++cp)
#pragma unroll
                for (int mf = 0; mf < 4; ++mf) { S[cp][mf] = (f32x4){0.f, 0.f, 0.f, 0.f};
#pragma unroll
                    for (int ks = 0; ks < 2; ++ks) { const bf16x8 kf = *(LAS const bf16x8*)(kt + (64 * hf + 16 * mf + c) * AT_KS + cp * 128 + ks * 64 + 16 * q4);
                        S[cp][mf] = __builtin_amdgcn_mfma_f32_16x16x32_bf16(kf, Qf[cp][ks], S[cp][mf], 0, 0, 0); } }
            bf16x8 Wf[2];
#pragma unroll
            for (int kk = 0; kk < 2; ++kk) { float w[8];
#pragma unroll
                for (int jj = 0; jj < 8; ++jj) { const int mf = 2 * kk + (jj >> 2), k = jj & 3;
                    w[jj] = __builtin_amdgcn_exp2f(S[0][mf][k] * SC - o1) * i1 - __builtin_amdgcn_exp2f(S[1][mf][k] * SC - o2) * i2; }
                const unsigned p0 = pg8::cvt_pk_bf16(w[0], w[1]), p1 = pg8::cvt_pk_bf16(w[2], w[3]), p2 = pg8::cvt_pk_bf16(w[4], w[5]), p3 = pg8::cvt_pk_bf16(w[6], w[7]);
                Wf[kk] = __builtin_bit_cast(bf16x8, (u32x4){p0, p1, p2, p3}); }
#pragma unroll
            for (int md = 0; md < 8; ++md)
#pragma unroll
                for (int kk = 0; kk < 2; ++kk) { LAS const unsigned char* vp = vt + (64 * hf + 32 * kk + 4 * q4 + (c >> 2)) * AT_VS + (16 * md + 4 * (c & 3)) * 2;
                    const v4i16_t lo = __builtin_amdgcn_ds_read_tr16_b64_v4i16((LAS v4i16_t*)vp), hi = __builtin_amdgcn_ds_read_tr16_b64_v4i16((LAS v4i16_t*)(vp + 16 * AT_VS));
                    const bf16x8 vf = {lo[0], lo[1], lo[2], lo[3], hi[0], hi[1], hi[2], hi[3]};
                    Ot[md] = __builtin_amdgcn_mfma_f32_16x16x32_bf16(vf, Wf[kk], Ot[md], 0, 0, 0); }
        }
        if (t + 1 < nt) {
#pragma unroll
            for (int i = 0; i < AT_NCH; ++i) { *(LAS u32x4*)(lds + ((t + 1) & 1) * AT_BUF + (key0 + 32 * i) * AT_KS + 16 * cc0) = kreg[i];
                                               *(LAS u32x4*)(lds + ((t + 1) & 1) * AT_BUF + AT_KBYTES + (key0 + 32 * i) * AT_VS + 16 * cc0) = vreg[i]; } }
        __syncthreads();
    }
    float ss = 0.f;
#pragma unroll
    for (int md = 0; md < 8; ++md)
#pragma unroll
        for (int k = 0; k < 4; ++k) ss += Ot[md][k] * Ot[md][k];
    ss = sum_q4(ss);
    const float rs = rsqrtf(ss * (1.f / 128.f) + EPS) * (1.f - lam_init);
    const float* sg = F.inp(I_AT_SUBG);
#pragma unroll
    for (int md = 0; md < 8; ++md) { const int d0 = 16 * md + 4 * q4; const f32x4 g4 = *(const GAS f32x4*)(sg + d0);
        u32x2 w; w.x = pg8::cvt_pk_bf16(Ot[md][0] * rs * g4.x, Ot[md][1] * rs * g4.y); w.y = pg8::cvt_pk_bf16(Ot[md][2] * rs * g4.z, Ot[md][3] * rs * g4.w);
        *(GAS u32x2*)(Orows + (size_t)(16 * wave + c) * D + h * 128 + d0) = w; }
}
__device__ __forceinline__ void phase_attn(Frame& F, int l, const bf16* Q, const bf16* KP, const bf16* VP, bf16* O) {
    F.fresh();
    const float* al = F.inp(I_AT_LAM);
    const float lam_init = 0.8f - 0.6f * expf(-0.3f * (float)l);
    const float lam = expf(wave_sum(al[F.lane] * al[64 + F.lane])) - expf(wave_sum(al[128 + F.lane] * al[192 + F.lane])) + lam_init;
    for (int s = 0; ; ++s) {
        int u;
        if (F.G == 256) { if (F.bid < 128) { if (s > 0) break; u = F.bid; } else { if (s > 3) break; u = 128 + 4 * (F.bid - 128) + s; } }
        else { u = F.bid + s * F.G; if (u >= 640) break; }
        if (u < 128) { const int sb = u >> 6, h = (u >> 3) & 7, qt = u & 7; const size_t r0 = (size_t)NPROMPT + sb * 1024 + qt * 128;
            attn_unit(F, l, Q + r0 * D, F.KS + (size_t)sb * TKS * D, F.VS + (size_t)sb * TKS * D, TKS, O + r0 * D, h, lam, lam_init); }
        else { const int v = u - 128, b = v >> 4, h = (v >> 1) & 7, qt = v & 1; const size_t r0 = (size_t)b * 256 + qt * 128;
            attn_unit(F, l, Q + r0 * D, KP + (size_t)b * 256 * D, VP + (size_t)b * 256 * D, 256, O + r0 * D, h, lam, lam_init); }
    }
}

__device__ __forceinline__ void phase_ffn_convgate(Frame& F, int l, const bf16* Z, bf16* ACT) {
    F.fresh();
    const float* cw = F.inp(I_FF_CW) + (size_t)l * 3 * 2 * DFF; const float* cb = F.inp(I_FF_CB) + (size_t)l * 2 * DFF;
    const int gt = F.bid * NT + F.tid, GT = F.G * NT;
    for (int i = gt; i < M * DFF; i += GT) { const int row = i / DFF, j = i % DFF;
        int t, T; if (row < NPROMPT) { t = row & 255; T = 256; } else { t = (row - NPROMPT) & 1023; T = 1024; }
        float g = cb[j], u = cb[DFF + j];
#pragma unroll
        for (int k = 0; k < 3; ++k) { const int tt = t + k - 1; if (tt >= 0 && tt < T) { const bf16* zr = Z + (size_t)(row + k - 1) * 2 * DFF; g += cw[k * 2 * DFF + j] * bf2f(zr[j]); u += cw[k * 2 * DFF + DFF + j] * bf2f(zr[DFF + j]); } }
        ACT[i] = (bf16)f2bf(siluf_(g) * u); }
}

__global__ void __launch_bounds__(NT, 2) mk_fwd(Params prm) {
    extern __shared__ __attribute__((aligned(16))) unsigned char lds_raw[];
    Frame F;
    F.lds = (LAS unsigned char*)lds_raw; F.G = gridDim.x; F.out0 = prm.out; F.ws0 = prm.ws; F.wave0 = __builtin_amdgcn_readfirstlane(threadIdx.x >> 6);
    F.fresh();
    if (F.tid < N_IN) ((LAS unsigned long long*)(F.lds + PTR_OFF))[F.tid] = (unsigned long long)prm.in[F.tid];
    volatile LAS unsigned* MISC = (volatile LAS unsigned*)(F.lds + MISC_OFF);
    if (F.tid < 32) MISC[F.tid] = 0u;
    __syncthreads();
    (void)xcd_barrier_post((unsigned*)(prm.ws + WS_CTL) + CW_BAR, MISC + 8, F.tid == 0);
#define GRID_BAR() do { F.fresh(); XcdBarrier bar_; bar_.t0 = F.tid == 0; { unsigned* bp_ = (unsigned*)(prm.ws + WS_CTL) + CW_BAR; asm volatile("" : "+s"(bp_)); bar_.bar = bp_; } bar_.x = xb_xcc_id(); bar_.st = (volatile LAS unsigned*)(F.lds + MISC_OFF) + 8; xcd_barrier(bar_); } while (0)

#define GEMM_BF16(ACT, A_, Bt_, N_, K_, O_, ldc_, bias_, splitc_, splits_, rsq_, b2_, rsqv_, vt0_) do { pg8::Gemm g{A_, Bt_, M, N_, K_}; pg8::StaticOrder S; S.init(M, N_, F.G, F.bid); S.wave = F.wave; \
        pg8::EpiBf16<ACT> E{O_, ldc_, bias_, splitc_, splits_, rsq_, b2_, N_, rsqv_, vt0_, F.lds}; F.fresh(); E.prep(S, F.tid); pg8::gemm_phase<pg8::EpiBf16<ACT>, pg8::StaticOrder, true, true>(F.lds, g, S, E); } while (0)
#define GEMM_RESID(A_, Bt_, K_, sub_, fromin_) do { pg8::Gemm g{A_, Bt_, M, D, K_}; pg8::StaticOrder S; S.init(M, D, F.G, F.bid); S.wave = F.wave; \
        const int nl_ = (sub_) == 0 ? l : l + 1, ns_ = (sub_) == 0 ? 1 : 0; const bool last_ = nl_ >= DEPTH; \
        pg8::EpiResid E{F.out, F.inp(I_XP), F.inp(I_XS), F.mod + (size_t)l * 18 * D, (sub_) * 3 + 2, fromin_, last_ ? nullptr : F.H, F.inp(I_NORMG) + (size_t)((last_ ? 0 : nl_) * 2 + ns_) * D, \
                          F.mod + (size_t)(last_ ? 0 : nl_) * 18 * D, ns_ * 3 + 1, (sub_) == 0 ? F.rsq1 : F.rsq0, F.lds}; \
        F.fresh(); E.prep(S, F.tid); pg8::gemm_phase<pg8::EpiResid, pg8::StaticOrder, true, true>(F.lds, g, S, E); side_job(F, 2 * l + (sub_) + 1); } while (0)

    phase_prologue(F);
    GRID_BAR();
    phase_modulate0(F);
    GRID_BAR();
#pragma unroll 1
    for (int l = 0; l < DEPTH; ++l) {
        const int kind = l % 3, j = l / 3;
        F.fresh();
        if (kind == 0) {
            bf16 *GB = F.T2, *REC = F.T2 + (size_t)M * DRNN, *PF = F.T3, *PB = F.T3 + (size_t)NSAMPLE * DRNN, *HS = F.T3 + (size_t)6 * 1024 * 1024;
            float* AGG = (float*)(F.T3 + (size_t)2 * NSAMPLE * DRNN);
            GEMM_BF16(2, F.H, F.WT + WE_LRU_IN + (size_t)j * 2 * DRNN * D, 2 * DRNN, D, GB, DRNN, nullptr, DRNN, (size_t)M * DRNN, F.rsq0, F.bias2 + B2_LRU + (size_t)j * 3 * 2560, nullptr, 0);
            GRID_BAR();
            phase_lru_core(F, j, REC, GB, HS, PF, PB, AGG, F.WT + WE_WG + (size_t)j * 40 * 128 * 128);
            GRID_BAR();
            phase_lru_fixup(F, GB, HS, PF, PB, AGG);
            GRID_BAR();
            GEMM_RESID(HS, F.WT + WE_LRU_OUT + (size_t)j * D * DRNN, DRNN, 0, l == 0);
        } else if (kind == 1) {
            bf16 *UV = F.T1, *ACT = F.T2;
            GEMM_BF16(1, F.H, F.WT + WE_CM_IN, 2 * DB, D, UV, 2 * DB, F.inp(I_CM_BIN), 0, 0, F.rsq0, F.bias2 + B2_CM, F.rsqv, 8);
            GRID_BAR();
            phase_cmlp_spatial_mfma(F, UV, ACT, F.WT + WE_WSB);
            GRID_BAR();
            GEMM_RESID(ACT, F.WT + WE_CM_OUT, DB, 0, false);
        } else {
            bf16 *Q = F.T2, *KP = F.T2 + (size_t)M * D, *VP = KP + (size_t)NPROMPT * D, *O = F.T3;
            { pg8::Gemm g{F.H, F.WT + WE_QKV, M, 3 * D, D}; pg8::StaticOrder S; S.init(M, 3 * D, F.G, F.bid); S.wave = F.wave;
              pg8::EpiQkv E{F.ws, F.out, F.rsq0, F.bias2 + B2_QKV, F.lds, F.inp(I_AT_QKG), F.rope};
              F.fresh(); E.prep(S, F.tid); pg8::gemm_phase<pg8::EpiQkv, pg8::StaticOrder, true, true>(F.lds, g, S, E); }
            GRID_BAR();
            phase_attn(F, l, Q, KP, VP, O);
            GRID_BAR();
            GEMM_RESID(O, F.WT + WE_AT_OUT, D, 0, false);
        }
        GRID_BAR();
        { pg8::Gemm g{F.H, F.WT + WE_UP + (size_t)l * 2 * DFF * D, 42 * 256, 2 * DFF, D}; pg8::FfnOrder S; S.init(42 * 256, 2 * DFF, F.G, F.bid); S.wave = F.wave;
          pg8::EpiFfn E{F.T2, F.inp(I_FF_CW) + (size_t)l * 3 * 2 * DFF, F.inp(I_FF_CB) + (size_t)l * 2 * DFF, F.rsq1, F.bias2 + B2_UP + (size_t)l * 3 * 5632, F.lds};
          F.fresh(); E.prep(S, F.tid); pg8::gemm_phase<pg8::EpiFfn, pg8::FfnOrder, true, true>(F.lds, g, S, E); }
        GRID_BAR();
        GEMM_RESID(F.T2, F.WT + WE_DN + (size_t)l * D * DFF, DFF, 1, false);
        GRID_BAR();
    }
}

extern "C" void kernel_launch(void* const* d_in, const int* in_sizes, int n_in, void* d_out, int out_size, void* d_ws, size_t ws_size, hipStream_t stream) {
    static int grid = 0;
    if (grid == 0) {
        if (n_in != N_IN || ws_size < WS_END) { fprintf(stderr, "kernel_launch: unexpected n_in %d or ws_size %zu\n", n_in, ws_size); grid = -1; return; }
        int dev = 0, cus = 0, per_cu = 0;
        hipGetDevice(&dev); hipDeviceGetAttribute(&cus, hipDeviceAttributeMultiprocessorCount, dev);
        hipFuncSetAttribute((const void*)mk_fwd, hipFuncAttributeMaxDynamicSharedMemorySize, LDS_BYTES);
        hipOccupancyMaxActiveBlocksPerMultiprocessor(&per_cu, (const void*)mk_fwd, NT, LDS_BYTES);
        (void)hipGetLastError();
        if (per_cu < 1) { fprintf(stderr, "kernel_launch: occupancy query says %d blocks per CU\n", per_cu); per_cu = 1; }
        grid = cus;
    }
    if (grid < 0) return;
    hipMemsetAsync((char*)d_ws + WS_CTL, 0, CTL_ZERO_BYTES, stream);
    Params p{};
    for (int i = 0; i < N_IN; ++i) p.in[i] = (const float*)d_in[i];
    p.out = (float*)d_out; p.ws = (unsigned char*)d_ws;
    void* args[] = {&p};
    hipError_t e = hipLaunchCooperativeKernel((const void*)mk_fwd, dim3(grid), dim3(NT), args, LDS_BYTES, stream);
    if (e != hipSuccess) fprintf(stderr, "kernel_launch: cooperative launch failed: %s (grid %d)\n", hipGetErrorString(e), grid);
}
```

```cpp
#include <hip/hip_runtime.h>
#include <cstdio>
#include <cstdint>

#define GAS __attribute__((address_space(1)))
#define LAS __attribute__((address_space(3)))
typedef unsigned short bf16;
typedef float f32x4 __attribute__((ext_vector_type(4)));
typedef unsigned u32x2 __attribute__((ext_vector_type(2)));
typedef unsigned u32x4 __attribute__((ext_vector_type(4)));

constexpr int D = 1024, NPROMPT = 32 * 256, NSAMPLE = 2 * 1024, M = NPROMPT + NSAMPLE;
constexpr int DEPTH = 4, DRNN = 1280, DB = 2048, DFF = 2816, PAST = 512, TKS = PAST + 1024;
constexpr float EPS = 1e-6f;
constexpr int NWAVES = 8, NT = NWAVES * 64;

enum { I_XP = 0, I_XS, I_STATE, I_CK, I_CV, I_C, I_CCTX, I_WMOD, I_BMOD, I_NORMG, I_LRU_WIN, I_LRU_CW, I_LRU_CB, I_LRU_WG, I_LRU_BG, I_LRU_LAM, I_LRU_WOUT,
       I_CM_WIN, I_CM_BIN, I_CM_NG, I_CM_WS, I_CM_BS, I_CM_WOUT, I_AT_WQKV, I_AT_QKG, I_AT_LAM, I_AT_SUBG, I_AT_WOUT, I_FF_WUP, I_FF_CW, I_FF_CB, I_FF_WDN, N_IN };
constexpr size_t O_YP = 0, O_YS = (size_t)NPROMPT * D, O_STATE = (size_t)M * D, O_CK = O_STATE + 32 * 2 * 2 * DRNN, O_CV = O_CK + (size_t)NPROMPT * D;

constexpr size_t MiB = 1u << 20;
constexpr size_t WS_CTL = 0, CTL_ZERO_BYTES = 64 * 1024;
constexpr size_t WS_MOD = 1 * MiB;
constexpr size_t WS_RSTD = WS_MOD + 512 * 1024;
constexpr size_t WS_ROPE = WS_RSTD + 256 * 1024;
constexpr size_t WS_H = 2 * MiB;
constexpr size_t WS_T1 = 22 * MiB;
constexpr size_t WS_T2 = 132 * MiB;
constexpr size_t WS_T3 = 187 * MiB;
constexpr size_t WS_X = WS_T3 + 40 * MiB;
constexpr size_t B2_LRU = 0, B2_CM = B2_LRU + (size_t)2 * 3 * 2560, B2_QKV = B2_CM + (size_t)3 * 4096, B2_UP = B2_QKV + (size_t)3 * 3072, B2_END = B2_UP + (size_t)4 * 3 * 5632;
constexpr size_t WS_KS = 237 * MiB, WS_VS = 243 * MiB;
constexpr size_t WS_W = 249 * MiB;
constexpr size_t WE_LRU_IN = 0, WE_LRU_OUT = WE_LRU_IN + (size_t)2 * 2560 * 1024, WE_CM_IN = WE_LRU_OUT + (size_t)2 * 1024 * 1280, WE_CM_OUT = WE_CM_IN + (size_t)4096 * 1024,
                 WE_QKV = WE_CM_OUT + (size_t)1024 * 2048, WE_AT_OUT = WE_QKV + (size_t)3072 * 1024, WE_UP = WE_AT_OUT + (size_t)1024 * 1024, WE_DN = WE_UP + (size_t)4 * 5632 * 1024,
                 WE_WG = WE_DN + (size_t)4 * 1024 * 2816, WE_WSB = WE_WG + (size_t)80 * 128 * 128, WE_END = WE_WSB + (size_t)8 * 128 * 128;
constexpr size_t WS_END = WS_W + 106 * MiB;
static_assert(WE_END * 2 <= 106 * MiB, "weight copies fit");
constexpr int CW_BAR = 1024;

constexpr int LDS_BYTES = 163840;
constexpr int MISC_OFF = LDS_BYTES - 256, PTR_OFF = LDS_BYTES - 1024;

__device__ __forceinline__ unsigned f2bf(float f) { unsigned u = __builtin_bit_cast(unsigned, f); return (u + 0x7fffu + ((u >> 16) & 1u)) >> 16; }
__device__ __forceinline__ float bf2f(unsigned b) { return __builtin_bit_cast(float, (b & 0xffffu) << 16); }
template <int CTRL> __device__ __forceinline__ float dppf(float v) { return __builtin_bit_cast(float, __builtin_amdgcn_update_dpp(0, __builtin_bit_cast(int, v), CTRL, 0xf, 0xf, false)); }
__device__ __forceinline__ float swz_xor16(float v) { return __builtin_bit_cast(float, __builtin_amdgcn_ds_swizzle(__builtin_bit_cast(int, v), 0x401F)); }
__device__ __forceinline__ float sum_x32(float v) { auto r = __builtin_amdgcn_permlane32_swap(__builtin_bit_cast(unsigned, v), __builtin_bit_cast(unsigned, v), false, false);
    return __builtin_bit_cast(float, (unsigned)r[0]) + __builtin_bit_cast(float, (unsigned)r[1]); }
__device__ __forceinline__ float max_x32(float v) { auto r = __builtin_amdgcn_permlane32_swap(__builtin_bit_cast(unsigned, v), __builtin_bit_cast(unsigned, v), false, false);
    return fmaxf(__builtin_bit_cast(float, (unsigned)r[0]), __builtin_bit_cast(float, (unsigned)r[1])); }
__device__ __forceinline__ float sum_q4(float v) { v += swz_xor16(v); return sum_x32(v); }
__device__ __forceinline__ float max_q4(float v) { v = fmaxf(v, swz_xor16(v)); return max_x32(v); }
__device__ __forceinline__ float wave_sum(float v) { v += dppf<0xB1>(v); v += dppf<0x4E>(v); v += dppf<0x141>(v); v += dppf<0x140>(v); return sum_q4(v); }
__device__ __forceinline__ float wave_max(float v) { v = fmaxf(v, dppf<0xB1>(v)); v = fmaxf(v, dppf<0x4E>(v)); v = fmaxf(v, dppf<0x141>(v)); v = fmaxf(v, dppf<0x140>(v)); return max_q4(v); }
__device__ __forceinline__ float bperm(float v, int src_lane) { return __builtin_bit_cast(float, __builtin_amdgcn_ds_bpermute(src_lane << 2, __builtin_bit_cast(int, v))); }
__device__ __forceinline__ float gelu_tanh(float x) { const float y2 = 2.302208198f * (x + 0.044715f * x * x * x);
    const float t = 1.f - 2.f * __builtin_amdgcn_rcpf(__builtin_amdgcn_exp2f(y2) + 1.f); return 0.5f * x * (1.f + t); }
__device__ __forceinline__ float sigmoidf_(float x) { return __builtin_amdgcn_rcpf(1.f + __builtin_amdgcn_exp2f(-1.44269504f * x)); }
__device__ __forceinline__ float siluf_(float x) { return x * __builtin_amdgcn_rcpf(1.f + __builtin_amdgcn_exp2f(-1.44269504f * x)); }
__device__ __forceinline__ float softplusf_(float x) { return fmaxf(x, 0.f) + log1pf(expf(-fabsf(x))); }

#define XB_TMO      128
#define XB_XCNT(j)  (256  + 64 * (j))
#define XB_XSUB(j)  (1280 + 64 * (j))
#define XB_XGEN(j)  (2304 + 64 * (j))
#define XB_TOP      3328
#define XB_TOPGEN   3392
#define XCD_BAR_WORDS 3456
#define XB_SPIN_CAP (1u << 22)
__device__ __forceinline__ unsigned xb_ld(unsigned* p)              { return __hip_atomic_load(p, __ATOMIC_RELAXED, __HIP_MEMORY_SCOPE_AGENT); }
__device__ __forceinline__ unsigned xb_add(unsigned* p, unsigned v) { return __hip_atomic_fetch_add(p, v, __ATOMIC_RELAXED, __HIP_MEMORY_SCOPE_AGENT); }
__device__ __forceinline__ unsigned xb_xcc_id() { return (unsigned)__builtin_amdgcn_s_getreg((3 << 11) | 20) & 0xFu; }
#define XB_SPIN(cond, bar) do { unsigned _sp = 0; while (cond) { __builtin_amdgcn_s_sleep(1); \
    if ((++_sp & 255u) == 0u) { if (xb_ld(&(bar)[XB_TMO])) break; if (_sp > XB_SPIN_CAP) { atomicAdd(&(bar)[XB_TMO], 1u); break; } } } } while (0)
struct XcdBarrier { unsigned* bar; unsigned x; volatile LAS unsigned* st; bool t0; };
__device__ __forceinline__ XcdBarrier xcd_barrier_post(unsigned* bar, volatile LAS unsigned* st, bool t0) {
    XcdBarrier b; b.bar = bar; b.x = xb_xcc_id(); b.st = st; b.t0 = t0;
    if (t0) (void)xb_add(&bar[XB_XCNT(b.x)], 1u);
    return b;
}
__device__ __forceinline__ void xcd_barrier_complete(unsigned* bar, unsigned x, unsigned& nloc, unsigned& nx) {
    const unsigned G = gridDim.x * gridDim.y * gridDim.z;
    unsigned sum, cnt, mine, sp = 0u;
    for (;;) {
        sum = 0u; cnt = 0u; mine = 0u;
#pragma unroll
        for (unsigned j = 0; j < 16; ++j) { const unsigned c = xb_ld(&bar[XB_XCNT(j)]); sum += c; cnt += (c > 0u) ? 1u : 0u; mine = (j == x) ? c : mine; }
        if (sum == G) break;
        __builtin_amdgcn_s_sleep(1);
        if ((++sp & 255u) == 0u) { if (xb_ld(&bar[XB_TMO])) break; if (sp > XB_SPIN_CAP) { atomicAdd(&bar[XB_TMO], 1u); break; } }
    }
    nloc = mine > 0u ? mine : 1u; nx = cnt > 0u ? cnt : 1u;
}
__device__ __forceinline__ void xcd_barrier(const XcdBarrier& b) {
    asm volatile("s_waitcnt vmcnt(0)" ::: "memory");
    __syncthreads();
    if (b.t0) {
        unsigned* bar = b.bar;
        __builtin_amdgcn_s_waitcnt(0);
        unsigned nloc = b.st[0], nx = b.st[1];
        if (nloc == 0u) { xcd_barrier_complete(bar, b.x, nloc, nx); b.st[0] = nloc; b.st[1] = nx; }
        const unsigned old = xb_add(&bar[XB_XSUB(b.x)], 1u);
        const unsigned gen = old / nloc;
        if (old + 1u == (gen + 1u) * nloc) {
            __builtin_amdgcn_fence(__ATOMIC_RELEASE, "agent");
            asm volatile("s_waitcnt vmcnt(0)" ::: "memory");
            const unsigned og = xb_add(&bar[XB_TOP], 1u);
            const unsigned tg = og / nx;
            if (og + 1u == (tg + 1u) * nx) xb_add(&bar[XB_TOPGEN], 1u);
            else XB_SPIN(xb_ld(&bar[XB_TOPGEN]) == tg, bar);
            __builtin_amdgcn_fence(__ATOMIC_ACQUIRE, "agent");
            xb_add(&bar[XB_XGEN(b.x)], 1u);
            asm volatile("s_waitcnt vmcnt(0)" ::: "memory");
        } else {
            XB_SPIN(xb_ld(&bar[XB_XGEN(b.x)]) == gen, bar);
            __builtin_amdgcn_fence(__ATOMIC_ACQUIRE, "agent");
            asm volatile("s_waitcnt vmcnt(0)" ::: "memory");
        }
    }
    __syncthreads();
}

namespace pg8 {
#define PG8_LAS __attribute__((address_space(3)))
typedef unsigned short bf16_t;
typedef short bf16x8 __attribute__((ext_vector_type(8)));
typedef float f32x4 __attribute__((ext_vector_type(4)));
typedef unsigned u32x4 __attribute__((ext_vector_type(4)));
constexpr int BM = 256, BK = 64, HALF = 128, HTB = HALF * BK * 2  , STAGE_BYTES = 8 * HTB, NXCD = 8, WGM = 8;

__host__ __device__ __forceinline__ int lds_byte(int r, int c) { const int st = (r >> 4) * 2 + (c >> 5), rr = r & 15, cc = c & 31, ob = rr * 64 + cc * 2; return st * 1024 + (ob ^ (((ob >> 9) & 1) << 5)); }
__host__ __device__ __forceinline__ void stage_rc(int b, int& R, int& C) { const int st = b / 1024, sb = b % 1024, swz = sb ^ (((sb >> 9) & 1) << 5); R = (st >> 1) * 16 + swz / 64; C = (st & 1) * 32 + (swz % 64) / 2; }
__host__ __device__ __forceinline__ int perm32(int rho) { const int n = rho >> 4, i = rho & 15; return 8 * (i >> 2) + 4 * n + (i & 3); }

struct Unit { int pm, pn; };
struct Gemm { const bf16_t* A; const bf16_t* Bt; int M, N, K; };

struct StaticOrder {
    int nM, nN, nwg, G, c, wave;
    __host__ __device__ void init(int M, int N, int G_, int c_) { nM = M / BM; nN = N / BM; nwg = nM * nN; G = G_; c = c_; }
    __host__ __device__ bool next(int i, Unit& u) const {
        const long L = (long)i * G + c; if (L >= nwg) return false;
        int wgid = (int)L; { const int q = nwg / NXCD, r = nwg % NXCD, xcd = wgid % NXCD, off = wgid / NXCD; wgid = (xcd < r ? xcd * (q + 1) : r * (q + 1) + (xcd - r) * q) + off; }
        const int nig = WGM * nN, gid = wgid / nig, fm = gid * WGM, gsz = (nM - fm) < WGM ? (nM - fm) : WGM;
        u.pm = fm + ((wgid % nig) % gsz); u.pn = (wgid % nig) / gsz; return true;
    }
    __device__ __forceinline__ int arow(int pm) const { return pm * BM; }
    __device__ __forceinline__ void a_ready(const Unit&) const {}
    __device__ __forceinline__ void done(const Unit&) const {}
};

template <class Epi, class Sched, bool ALIGN_EPI = false, bool SP2 = false>
__device__ __forceinline__ void gemm_phase(PG8_LAS unsigned char* lds, const Gemm g, const Sched& S, const Epi& E) {
    int z_ = 0; asm volatile("" : "+v"(z_));
    const int lane = __builtin_amdgcn_mbcnt_hi(~0u, __builtin_amdgcn_mbcnt_lo(~0u, z_)), wid = S.wave, tid = wid * 64 + lane, wr = wid >> 2, wc = wid & 3, fr = lane & 15, fq = lane >> 4;
    const int K = g.K, nt = K / BK;
    unsigned voffA[2], voffB[2];
#pragma unroll
    for (int i = 0; i < 2; ++i) { int R, C; stage_rc(tid * 16 + i * 8192, R, C); const int Rb = Epi::PERM ? ((R & ~31) + perm32(R & 31)) : R;
        voffA[i] = (unsigned)(R * K + C) * 2u; voffB[i] = (unsigned)(Rb * K + C) * 2u; }
    const size_t kstep = (size_t)(BK * 2);
    const size_t hstep = (size_t)HALF * K * 2;
    const size_t tstep = 2 * hstep;
    const unsigned ldsw = (unsigned)wid * 1024u;
    const int aoff = lds_byte(wr * 64 + fr, fq * 8), boff = lds_byte(wc * 32 + fr, fq * 8);
#define PG8_SA(b, h) (((b) * 2 + (h)) * HTB)
#define PG8_SB(b, h) ((4 + (b) * 2 + (h)) * HTB)
#define PG8_STAGE(bufoff, gbase, voff) do { _Pragma("unroll") for (int _i = 0; _i < 2; ++_i) \
        __builtin_amdgcn_global_load_lds((const unsigned*)((const char*)(gbase) + (voff)[_i]), (PG8_LAS unsigned*)(lds + (bufoff) + ldsw + _i * 8192), 16, 0, 0); } while (0)
#define PG8_LDA(dst, b, h) do { _Pragma("unroll") for (int m = 0; m < 4; ++m) _Pragma("unroll") for (int k = 0; k < 2; ++k) dst[m][k] = *(const PG8_LAS bf16x8*)(lds + PG8_SA(b, h) + aoff + m * 2048 + k * 1024); } while (0)
#define PG8_LDB(dst, b, h) do { _Pragma("unroll") for (int n = 0; n < 2; ++n) _Pragma("unroll") for (int k = 0; k < 2; ++k) dst[n][k] = *(const PG8_LAS bf16x8*)(lds + PG8_SB(b, h) + boff + n * 2048 + k * 1024); } while (0)
#define PG8_MMA(ai, bj, At, Bt) do { __builtin_amdgcn_s_setprio(1); _Pragma("unroll") for (int m = 0; m < 4; ++m) _Pragma("unroll") for (int n = 0; n < 2; ++n) _Pragma("unroll") for (int k = 0; k < 2; ++k) \
        acc[ai][bj][m][n] = __builtin_amdgcn_mfma_f32_16x16x32_bf16(Bt[n][k], At[m][k], acc[ai][bj][m][n], 0, 0, 0); __builtin_amdgcn_s_setprio(0); } while (0)
#define PG8_WAIT_V(n) asm volatile("s_waitcnt vmcnt(" #n ")" ::: "memory")
#define PG8_WAIT_L(n) asm volatile("s_waitcnt lgkmcnt(" #n ")" ::: "memory")
#define PG8_BAR __builtin_amdgcn_s_barrier()
#define PG8_SCHED __builtin_amdgcn_sched_barrier(0)
    Unit cur, nxt; int ui = 0;
    if (!S.next(0, cur)) return;
    f32x4 acc[2][2][4][2];
#pragma unroll
    for (int a = 0; a < 2; ++a)
#pragma unroll
        for (int b = 0; b < 2; ++b)
#pragma unroll
            for (int m = 0; m < 4; ++m)
#pragma unroll
                for (int n = 0; n < 2; ++n) acc[a][b][m][n] = (f32x4){0.f, 0.f, 0.f, 0.f};
    bf16x8 At[4][2], B0[2][2], B1[2][2];
    const char* cA = (const char*)g.A + (size_t)S.arow(cur.pm) * (size_t)K * 2; const char* cB = (const char*)g.Bt + (size_t)cur.pn * tstep;
    S.a_ready(cur);
    if constexpr (SP2) {
        PG8_STAGE(PG8_SB(0, 0), cB, voffB); PG8_STAGE(PG8_SB(0, 1), cB + hstep, voffB); PG8_STAGE(PG8_SA(0, 0), cA, voffA); PG8_STAGE(PG8_SA(0, 1), cA + hstep, voffA);
        if (wr == 1) PG8_BAR;
        PG8_WAIT_V(2); PG8_BAR;
        PG8_STAGE(PG8_SB(1, 0), cB + kstep, voffB); PG8_STAGE(PG8_SA(1, 0), cA + kstep, voffA); PG8_STAGE(PG8_SB(1, 1), cB + hstep + kstep, voffB);
        PG8_WAIT_V(6); PG8_BAR;
    } else {
        PG8_STAGE(PG8_SB(0, 0), cB, voffB); PG8_STAGE(PG8_SA(0, 0), cA, voffA); PG8_STAGE(PG8_SB(0, 1), cB + hstep, voffB); PG8_STAGE(PG8_SA(0, 1), cA + hstep, voffA);
        if (wr == 1) PG8_BAR;
        PG8_WAIT_V(4); PG8_BAR;
        PG8_STAGE(PG8_SB(1, 0), cB + kstep, voffB); PG8_STAGE(PG8_SA(1, 0), cA + kstep, voffA); PG8_STAGE(PG8_SB(1, 1), cB + hstep + kstep, voffB);
        PG8_WAIT_V(6); PG8_BAR;
    }
    for (;;) {
        const bool has_next = S.next(ui + 1, nxt);
        const char* nA = has_next ? (const char*)g.A + (size_t)S.arow(nxt.pm) * (size_t)K * 2 : cA; const char* nB = has_next ? (const char*)g.Bt + (size_t)nxt.pn * tstep : cB;
        for (int t = 0; t < nt; t += 2) {
            const bool last = (t == nt - 2);
            const char* a1 = cA + (size_t)(t + 1) * kstep;
            const char* a2 = last ? nA : cA + (size_t)(t + 2) * kstep; const char* b2 = last ? nB : cB + (size_t)(t + 2) * kstep;
            const char* a3 = a2 + kstep; const char* b3 = b2 + kstep;
            if (last && has_next) S.a_ready(nxt);
            if constexpr (SP2) {
            PG8_LDB(B0, 0, 0); PG8_LDB(B1, 0, 1); PG8_SCHED; PG8_LDA(At, 0, 0); PG8_STAGE(PG8_SA(1, 1), a1 + hstep, voffA);
            PG8_WAIT_V(8); PG8_WAIT_L(0); PG8_BAR; PG8_MMA(0, 0, At, B0); PG8_MMA(0, 1, At, B1); PG8_BAR; PG8_SCHED;
            PG8_LDA(At, 0, 1); PG8_STAGE(PG8_SB(0, 0), b2, voffB); PG8_STAGE(PG8_SB(0, 1), b2 + hstep, voffB); PG8_STAGE(PG8_SA(0, 0), a2, voffA);
            PG8_WAIT_V(8); PG8_WAIT_L(0); PG8_BAR; PG8_MMA(1, 0, At, B0); PG8_MMA(1, 1, At, B1); PG8_BAR; PG8_SCHED;
            PG8_LDB(B0, 1, 0); PG8_LDB(B1, 1, 1); PG8_SCHED; PG8_LDA(At, 1, 0); PG8_STAGE(PG8_SA(0, 1), a2 + hstep, voffA);
            PG8_WAIT_V(8); PG8_WAIT_L(0); PG8_BAR; PG8_MMA(0, 0, At, B0); PG8_MMA(0, 1, At, B1); PG8_BAR; PG8_SCHED;
            PG8_LDA(At, 1, 1); PG8_STAGE(PG8_SB(1, 0), b3, voffB); PG8_STAGE(PG8_SB(1, 1), b3 + hstep, voffB); PG8_STAGE(PG8_SA(1, 0), a3, voffA);
            PG8_WAIT_V(8); PG8_WAIT_L(0); PG8_BAR; PG8_MMA(1, 0, At, B0); PG8_MMA(1, 1, At, B1); PG8_BAR; PG8_SCHED;
            } else {
            PG8_LDB(B0, 0, 0); PG8_SCHED; PG8_LDA(At, 0, 0); PG8_STAGE(PG8_SA(1, 1), a1 + hstep, voffA);
            PG8_WAIT_L(8); PG8_BAR; PG8_WAIT_L(0); PG8_MMA(0, 0, At, B0); PG8_BAR; PG8_SCHED;
            PG8_LDB(B1, 0, 1); PG8_STAGE(PG8_SB(0, 0), b2, voffB);
            PG8_BAR; PG8_WAIT_L(0); PG8_MMA(0, 1, At, B1); PG8_BAR;
            PG8_LDA(At, 0, 1); PG8_STAGE(PG8_SA(0, 0), a2, voffA);
            PG8_BAR; PG8_WAIT_L(0); PG8_MMA(1, 0, At, B0); PG8_BAR; PG8_SCHED;
            PG8_STAGE(PG8_SB(0, 1), b2 + hstep, voffB);
            PG8_WAIT_V(6); PG8_BAR; PG8_MMA(1, 1, At, B1); PG8_BAR;
            PG8_LDB(B0, 1, 0); PG8_SCHED; PG8_LDA(At, 1, 0); PG8_STAGE(PG8_SA(0, 1), a2 + hstep, voffA);
            PG8_WAIT_L(8); PG8_BAR; PG8_WAIT_L(0); PG8_MMA(0, 0, At, B0); PG8_BAR; PG8_SCHED;
            PG8_LDB(B1, 1, 1); PG8_STAGE(PG8_SB(1, 0), b3, voffB);
            PG8_BAR; PG8_WAIT_L(0); PG8_MMA(0, 1, At, B1); PG8_BAR;
            PG8_LDA(At, 1, 1); PG8_STAGE(PG8_SA(1, 0), a3, voffA);
            PG8_BAR; PG8_WAIT_L(0); PG8_MMA(1, 0, At, B0); PG8_BAR; PG8_SCHED;
            PG8_STAGE(PG8_SB(1, 1), b3 + hstep, voffB);
            PG8_WAIT_V(6); PG8_BAR; PG8_MMA(1, 1, At, B1); PG8_BAR;
            }
        }
        if constexpr (ALIGN_EPI) { if (wr == 0) PG8_BAR; }
        if constexpr (!Epi::AFTER_DRAIN) { E(acc, cur, ui, wr, wc, fr, fq); S.done(cur); }
        if (!has_next) break;
#pragma unroll
        for (int a = 0; a < 2; ++a)
#pragma unroll
            for (int b = 0; b < 2; ++b)
#pragma unroll
                for (int m = 0; m < 4; ++m)
#pragma unroll
                    for (int n = 0; n < 2; ++n) acc[a][b][m][n] = (f32x4){0.f, 0.f, 0.f, 0.f};
        cur = nxt; cA = nA; cB = nB; ++ui;
        if constexpr (ALIGN_EPI) { if (wr == 1) PG8_BAR; }
    }
    PG8_WAIT_V(0);
    if constexpr (!ALIGN_EPI) { if (wr == 0) PG8_BAR; }
    PG8_BAR;
    if constexpr (Epi::AFTER_DRAIN) { E.fused(acc, cur, wr, wc, fr, fq, lds, wid, lane); S.done(cur); }
#undef PG8_SA
#undef PG8_SB
#undef PG8_STAGE
#undef PG8_LDA
#undef PG8_LDB
#undef PG8_MMA
#undef PG8_WAIT_V
#undef PG8_WAIT_L
#undef PG8_BAR
#undef PG8_SCHED
}
}

namespace pg8 {
__device__ __forceinline__ unsigned cvt_pk_bf16(float lo, float hi) { unsigned r; asm volatile("v_cvt_pk_bf16_f32 %0, %1, %2" : "=v"(r) : "v"(lo), "v"(hi)); return r; }
__device__ __forceinline__ f32x4 gelu4(f32x4 v) { f32x4 o; o.x = gelu_tanh(v.x); o.y = gelu_tanh(v.y); o.z = gelu_tanh(v.z); o.w = gelu_tanh(v.w); return o; }
constexpr int ETAB_OFF = 131072 + 8192, ETAB_SLOT = 4608, ETAB_MAXU = 4;
__device__ __forceinline__ float row_rstd(const float* rsq, int row) {
    const GAS f32x4* p = (const GAS f32x4*)(rsq + (size_t)row * 16);
    const f32x4 a = p[0], b = p[1], c = p[2], d = p[3];
    const float s = ((a.x + a.y) + (a.z + a.w)) + ((b.x + b.y) + (b.z + b.w)) + ((c.x + c.y) + (c.z + c.w)) + ((d.x + d.y) + (d.z + d.w));
    return rsqrtf(s * (1.f / D) + EPS);
}
__device__ __forceinline__ int tile_cidx(int trow) { return trow < NPROMPT ? 0 : 1 + ((trow - NPROMPT) >> 10); }
__device__ __forceinline__ PG8_LAS float* etab(PG8_LAS unsigned char* lds, int ui) { return (PG8_LAS float*)(lds + ETAB_OFF + ui * ETAB_SLOT); }

template <int ACT> struct EpiBf16 {
    static constexpr bool PERM = true, AFTER_DRAIN = false;
    bf16_t* O; int ldc; const float* bias; int split_cols; size_t split_stride; const float* rsq; const float* b2; int N; float* rsqv; int vt0; PG8_LAS unsigned char* lds;
    template <class Sched> __device__ __forceinline__ void prep(const Sched& S, int tid) const {
        Unit u;
        for (int i = 0; i < ETAB_MAXU && S.next(i, u); ++i) { PG8_LAS float* t = etab(lds, i);
            if (tid < 256) t[tid] = row_rstd(rsq, S.arow(u.pm) + tid);
            else { const int c = tid - 256, col = u.pn * BM + c; float v = b2[(size_t)tile_cidx(S.arow(u.pm)) * N + col]; if (bias) v += bias[col]; t[256 + c] = v; } }
        __syncthreads();
    }
    __device__ __forceinline__ void operator()(f32x4 (&acc)[2][2][4][2], const Unit& u, int ui, int wr, int wc, int fr, int fq) const {
        asm volatile("" : "+v"(fr), "+v"(fq));
        PG8_LAS const float* tb = etab(lds, ui);
        const int lrow0 = wr * 64 + fr; int colt = u.pn * BM; bf16_t* base = O; int t = 0;
        if (split_cols) { t = colt / split_cols; base += (size_t)t * split_stride; colt -= t * split_cols; }
        const bool act = (ACT == 1) || (ACT == 2 && t == 0);
        const int col0 = colt + wc * 32 + 8 * fq, tc0 = wc * 32 + 8 * fq;
        const bool wantv = rsqv != nullptr && u.pn >= vt0;
        GAS unsigned char* ob = (GAS unsigned char*)base;
        float ss[8];
#pragma unroll
        for (int i = 0; i < 8; ++i) ss[i] = 0.f;
#pragma unroll
        for (int bj = 0; bj < 2; ++bj) { const f32x4 bv0 = *(PG8_LAS const f32x4*)(tb + 256 + tc0 + bj * HALF), bv1 = *(PG8_LAS const f32x4*)(tb + 256 + tc0 + bj * HALF + 4);
#pragma unroll
            for (int ai = 0; ai < 2; ++ai)
#pragma unroll
                for (int m = 0; m < 4; ++m) { const int lrow = lrow0 + ai * HALF + m * 16; const float rs = tb[lrow];
                    f32x4 v0 = acc[ai][bj][m][0] * rs + bv0, v1 = acc[ai][bj][m][1] * rs + bv1;
                    if (ACT != 0) { if (act) { v0 = gelu4(v0); v1 = gelu4(v1); } }
                    ss[ai * 4 + m] += (v0[0] * v0[0] + v0[1] * v0[1]) + (v0[2] * v0[2] + v0[3] * v0[3]) + (v1[0] * v1[0] + v1[1] * v1[1]) + (v1[2] * v1[2] + v1[3] * v1[3]);
                    u32x4 w; w.x = cvt_pk_bf16(v0[0], v0[1]); w.y = cvt_pk_bf16(v0[2], v0[3]); w.z = cvt_pk_bf16(v1[0], v1[1]); w.w = cvt_pk_bf16(v1[2], v1[3]);
                    *(GAS u32x4*)(ob + ((unsigned)(u.pm * BM + lrow) * (unsigned)ldc + col0 + bj * HALF) * 2u) = w;
                    __builtin_amdgcn_sched_barrier(0); } }
        if (wantv) {
#pragma unroll
            for (int i = 0; i < 8; ++i) { const float q = sum_q4(ss[i]);
                if (fq == 0) *(GAS float*)(rsqv + (size_t)(u.pm * BM + lrow0 + (i >> 2) * HALF + (i & 3) * 16) * 32 + (u.pn - vt0) * 4 + wc) = q; } }
    }
};
struct EpiResid {
    static constexpr bool PERM = true, AFTER_DRAIN = false;
    float* out; const float* xp; const float* xs; const float* modl; int which; bool from_input;
    bf16_t* H; const float* ng; const float* modn; int whichs; float* rsq_out; PG8_LAS unsigned char* lds;
    template <class Sched> __device__ __forceinline__ void prep(const Sched& S, int tid) const {
        Unit u;
        for (int i = 0; i < ETAB_MAXU && S.next(i, u); ++i) { PG8_LAS float* t = etab(lds, i);
            if (tid < 256) { const int ci = tile_cidx(u.pm * BM), col = u.pn * BM + tid; t[256 + tid] = modl[(size_t)(ci * 6 + which) * D + col];
                t[512 + tid] = H ? ng[col] * (1.f + modn[(size_t)(ci * 6 + whichs) * D + col]) : 0.f; } }
        __syncthreads();
    }
    __device__ __forceinline__ void operator()(f32x4 (&acc)[2][2][4][2], const Unit& u, int ui, int wr, int wc, int fr, int fq) const {
        asm volatile("" : "+v"(fr), "+v"(fq));
        PG8_LAS const float* tb = etab(lds, ui);
        const int trow = u.pm * BM, row0 = wr * 64 + fr, tc0 = wc * 32 + 8 * fq, col0 = u.pn * BM + tc0;
        const GAS unsigned char* bpg = (const GAS unsigned char*)(from_input ? (trow < NPROMPT ? xp + (size_t)trow * D : xs + (size_t)(trow - NPROMPT) * D) : out + (size_t)trow * D);
        GAS unsigned char* op = (GAS unsigned char*)(out + (size_t)trow * D); GAS unsigned char* hb = (GAS unsigned char*)H;
#pragma unroll
        for (int ai = 0; ai < 2; ++ai) {
            f32x4 x[2][4][2];
#pragma unroll
            for (int bj = 0; bj < 2; ++bj)
#pragma unroll
                for (int m = 0; m < 4; ++m)
#pragma unroll
                    for (int n = 0; n < 2; ++n) x[bj][m][n] = *(const GAS f32x4*)(bpg + ((unsigned)(row0 + ai * HALF + m * 16) * (unsigned)D + col0 + bj * HALF + 4 * n) * 4u);
            float ss[4] = {0.f, 0.f, 0.f, 0.f};
#pragma unroll
            for (int bj = 0; bj < 2; ++bj) { const f32x4 gv0 = *(PG8_LAS const f32x4*)(tb + 256 + tc0 + bj * HALF), gv1 = *(PG8_LAS const f32x4*)(tb + 256 + tc0 + bj * HALF + 4);
                const f32x4 gs0 = *(PG8_LAS const f32x4*)(tb + 512 + tc0 + bj * HALF), gs1 = *(PG8_LAS const f32x4*)(tb + 512 + tc0 + bj * HALF + 4);
#pragma unroll
                for (int m = 0; m < 4; ++m) { const unsigned lrow = row0 + ai * HALF + m * 16, eo = lrow * (unsigned)D + col0 + bj * HALF;
                    const f32x4 x0 = x[bj][m][0] + gv0 * acc[ai][bj][m][0], x1 = x[bj][m][1] + gv1 * acc[ai][bj][m][1];
                    *(GAS f32x4*)(op + eo * 4u) = x0; *(GAS f32x4*)(op + eo * 4u + 16) = x1;
                    if (H) { ss[m] += (x0[0] * x0[0] + x0[1] * x0[1]) + (x0[2] * x0[2] + x0[3] * x0[3]) + (x1[0] * x1[0] + x1[1] * x1[1]) + (x1[2] * x1[2] + x1[3] * x1[3]);
                        const f32x4 a0 = x0 * gs0, a1 = x1 * gs1;
                        u32x4 w; w.x = cvt_pk_bf16(a0[0], a0[1]); w.y = cvt_pk_bf16(a0[2], a0[3]); w.z = cvt_pk_bf16(a1[0], a1[1]); w.w = cvt_pk_bf16(a1[2], a1[3]);
                        *(GAS u32x4*)(hb + ((unsigned)trow * (unsigned)D + eo) * 2u) = w; } } }
            if (H) {
#pragma unroll
                for (int m = 0; m < 4; ++m) { const float q = sum_q4(ss[m]);
                    if (fq == 0) *(GAS float*)(rsq_out + (size_t)(trow + row0 + ai * HALF + m * 16) * 16 + u.pn * 4 + wc) = q; } }
            asm volatile("" ::: "memory");
        }
    }
};

__device__ __forceinline__ void ffn_tile_geom(int pm, int& rs, int& vlo, int& vhi) {
    if (pm < 32) { rs = 256 * pm; vlo = 0; vhi = 255; }
    else { const int sq = (pm - 32) / 5, i = (pm - 32) % 5; rs = NPROMPT + 1024 * sq + (i < 4 ? 254 * i : 768); vlo = i == 0 ? 0 : (i < 4 ? 1 : 249); vhi = i < 4 ? 254 : 255; }
}
struct FfnOrder : StaticOrder {
    __device__ __forceinline__ int arow(int pm) const { int rs, a, b; ffn_tile_geom(pm, rs, a, b); return rs; }
};
template <int CTRL> __device__ __forceinline__ float dpp0(float v) { return __builtin_bit_cast(float, __builtin_amdgcn_update_dpp(0, __builtin_bit_cast(int, v), CTRL, 0xf, 0xf, true)); }
struct EpiFfn {
    static constexpr bool PERM = true, AFTER_DRAIN = false;
    bf16_t* ACT; const float* cw; const float* cb; const float* rsq; const float* b2; PG8_LAS unsigned char* lds;
    template <class Sched> __device__ __forceinline__ void prep(const Sched& S, int tid) const {
        Unit u;
        for (int i = 0; i < ETAB_MAXU && S.next(i, u); ++i) { PG8_LAS float* t = etab(lds, i); const int rs = S.arow(u.pm);
            if (tid < 256) t[tid] = row_rstd(rsq, rs + tid);
            else { const int c = tid - 256, ch = (c < 128 ? 0 : DFF) + u.pn * 128 + (c & 127);
                t[256 + c] = b2[(size_t)tile_cidx(rs) * 2 * DFF + u.pn * 256 + c]; t[512 + c] = cb[ch];
                PG8_LAS unsigned short* tw = (PG8_LAS unsigned short*)(t + 768);
#pragma unroll
                for (int k = 0; k < 3; ++k) tw[k * 256 + c] = (unsigned short)f2bf(cw[(size_t)k * 2 * DFF + ch]); } }
        __syncthreads();
    }
    __device__ __forceinline__ void operator()(f32x4 (&acc)[2][2][4][2], const Unit& u, int ui, int wr, int wc, int fr, int fq) const {
        asm volatile("" : "+v"(fr), "+v"(fq));
        PG8_LAS const float* tb = etab(lds, ui); PG8_LAS float* xb = (PG8_LAS float*)(lds + 131072);
        int rs, vlo, vhi; ffn_tile_geom(u.pm, rs, vlo, vhi);
        const int colw = wc * 32 + 8 * fq;
#pragma unroll
        for (int bj = 0; bj < 2; ++bj) { const f32x4 bz0 = *(PG8_LAS const f32x4*)(tb + 256 + bj * 128 + colw), bz1 = *(PG8_LAS const f32x4*)(tb + 256 + bj * 128 + colw + 4);
#pragma unroll
            for (int ai = 0; ai < 2; ++ai)
#pragma unroll
                for (int m = 0; m < 4; ++m) { const float rsd = tb[128 * ai + 64 * wr + 16 * m + fr];
                    acc[ai][bj][m][0] = acc[ai][bj][m][0] * rsd + bz0; acc[ai][bj][m][1] = acc[ai][bj][m][1] * rsd + bz1; } }
#pragma unroll
        for (int ai = 0; ai < 2; ++ai) { const int b = 2 * ai + wr;
            if (fr == 0) {
#pragma unroll
                for (int bj = 0; bj < 2; ++bj)
#pragma unroll
                    for (int n = 0; n < 2; ++n) *(PG8_LAS f32x4*)(xb + (b * 2 + 0) * 256 + bj * 128 + colw + 4 * n) = acc[ai][bj][0][n]; }
            if (fr == 15) {
#pragma unroll
                for (int bj = 0; bj < 2; ++bj)
#pragma unroll
                    for (int n = 0; n < 2; ++n) *(PG8_LAS f32x4*)(xb + (b * 2 + 1) * 256 + bj * 128 + colw + 4 * n) = acc[ai][bj][3][n]; } }
        asm volatile("s_waitcnt lgkmcnt(0)" ::: "memory"); __builtin_amdgcn_s_barrier(); asm volatile("" ::: "memory");
        GAS unsigned char* actb = (GAS unsigned char*)ACT;
        const unsigned lane_off = (unsigned)((rs + 64 * wr + fr) * DFF + u.pn * 128 + colw) * 2u;
        PG8_LAS const unsigned short* tw = (PG8_LAS const unsigned short*)(tb + 768);
#pragma unroll
        for (int n = 0; n < 2; ++n) {
            f32x4 wg[3], wu[3];
#pragma unroll
            for (int k = 0; k < 3; ++k) { const u32x2 pg = *(PG8_LAS const u32x2*)(tw + k * 256 + colw + 4 * n), pu = *(PG8_LAS const u32x2*)(tw + k * 256 + 128 + colw + 4 * n);
                wg[k] = (f32x4){__builtin_bit_cast(float, pg.x << 16), __builtin_bit_cast(float, pg.x & 0xffff0000u), __builtin_bit_cast(float, pg.y << 16), __builtin_bit_cast(float, pg.y & 0xffff0000u)};
                wu[k] = (f32x4){__builtin_bit_cast(float, pu.x << 16), __builtin_bit_cast(float, pu.x & 0xffff0000u), __builtin_bit_cast(float, pu.y << 16), __builtin_bit_cast(float, pu.y & 0xffff0000u)}; }
            const f32x4 bgv = *(PG8_LAS const f32x4*)(tb + 512 + colw + 4 * n), buv = *(PG8_LAS const f32x4*)(tb + 512 + 128 + colw + 4 * n);
#pragma unroll
            for (int ai = 0; ai < 2; ++ai) { const int b = 2 * ai + wr;
                f32x4 pz[2], nz[2];
#pragma unroll
                for (int bj = 0; bj < 2; ++bj) { pz[bj] = b > 0 ? *(PG8_LAS const f32x4*)(xb + ((b - 1) * 2 + 1) * 256 + bj * 128 + colw + 4 * n) : (f32x4){0.f, 0.f, 0.f, 0.f};
                                                 nz[bj] = b < 3 ? *(PG8_LAS const f32x4*)(xb + ((b + 1) * 2 + 0) * 256 + bj * 128 + colw + 4 * n) : (f32x4){0.f, 0.f, 0.f, 0.f}; }
#pragma unroll
                for (int m = 0; m < 4; ++m) { f32x4 zc[2];
#pragma unroll
                    for (int bj = 0; bj < 2; ++bj) { const f32x4 z = acc[ai][bj][m][n]; const f32x4* w3 = bj == 0 ? wg : wu; f32x4 o = bj == 0 ? bgv : buv;
#pragma unroll
                        for (int e = 0; e < 4; ++e) { float a = fmaf(w3[1][e], z[e], o[e]);
                            const float w0e = fr == 0 ? w3[0][e] : 0.f, w2e = fr == 15 ? w3[2][e] : 0.f;
                            asm("v_fmac_f32_dpp %0, %1, %2 row_shr:1 row_mask:0xf bank_mask:0xf bound_ctrl:1" : "+v"(a) : "v"(z[e]), "v"(w3[0][e]));
                            asm("v_fmac_f32_dpp %0, %1, %2 row_shl:1 row_mask:0xf bank_mask:0xf bound_ctrl:1" : "+v"(a) : "v"(z[e]), "v"(w3[2][e]));
                            if (m > 0) { const float zp = acc[ai][bj][m - 1][n][e]; asm("v_fmac_f32_dpp %0, %1, %2 row_ror:1 row_mask:0xf bank_mask:0xf bound_ctrl:1" : "+v"(a) : "v"(zp), "v"(w0e)); } else a = fmaf(pz[bj][e], w0e, a);
                            if (m < 3) { const float zn = acc[ai][bj][m + 1][n][e]; asm("v_fmac_f32_dpp %0, %1, %2 row_ror:15 row_mask:0xf bank_mask:0xf bound_ctrl:1" : "+v"(a) : "v"(zn), "v"(w2e)); } else a = fmaf(nz[bj][e], w2e, a);
                            o[e] = a; }
                        zc[bj] = o; }
                    const int lr = 128 * ai + 64 * wr + 16 * m + fr;
                    if (lr >= vlo && lr <= vhi) { u32x2 w; w.x = cvt_pk_bf16(siluf_(zc[0][0]) * zc[1][0], siluf_(zc[0][1]) * zc[1][1]); w.y = cvt_pk_bf16(siluf_(zc[0][2]) * zc[1][2], siluf_(zc[0][3]) * zc[1][3]);
                        *(GAS u32x2*)(actb + (lane_off + (unsigned)((128 * ai + 16 * m) * DFF + 4 * n) * 2u)) = w; } } }
        }
    }
};

struct EpiQkv {
    static constexpr bool PERM = true, AFTER_DRAIN = false;
    unsigned char* ws; float* out; const float* rsq; const float* b2; PG8_LAS unsigned char* lds; const float* qkg; const float* rope;
    template <class Sched> __device__ __forceinline__ void prep(const Sched& S, int tid) const {
        Unit u;
        for (int i = 0; i < ETAB_MAXU && S.next(i, u); ++i) { PG8_LAS float* t = etab(lds, i);
            if (tid < 256) t[tid] = row_rstd(rsq, u.pm * BM + tid);
            else { const int c = tid - 256; t[256 + c] = b2[(size_t)tile_cidx(u.pm * BM) * 3 * D + u.pn * BM + c]; } }
        __syncthreads();
    }
    __device__ __forceinline__ void operator()(f32x4 (&acc)[2][2][4][2], const Unit& u, int ui, int wr, int wc, int fr, int fq) const {
        asm volatile("" : "+v"(fr), "+v"(fq));
        PG8_LAS const float* tb = etab(lds, ui);
        const int trow = u.pm * BM; const bool smp = trow >= NPROMPT; const int sb = smp ? (trow - NPROMPT) >> 10 : 0, tq0 = smp ? (trow - NPROMPT) & 1023 : 0;
        const int kind = u.pn >> 2, tc0 = wc * 32 + 8 * fq;
        if (kind < 2) {
            const int oc = (u.pn & 3) * 256 + wc * 64 + 8 * fq;
            f32x4 bz[2][2], gq[2][2];
#pragma unroll
            for (int bj = 0; bj < 2; ++bj)
#pragma unroll
                for (int n = 0; n < 2; ++n) { bz[bj][n] = *(PG8_LAS const f32x4*)(tb + 256 + tc0 + bj * HALF + 4 * n); gq[bj][n] = *(const GAS f32x4*)(qkg + kind * 64 + 32 * bj + 8 * fq + 4 * n); }
            const size_t doff = kind == 0 ? WS_T2 : (smp ? WS_KS : WS_T2 + (size_t)M * D * 2); GAS unsigned char* dst = (GAS unsigned char*)ws + doff;
#pragma unroll
            for (int ai = 0; ai < 2; ++ai) {
                f32x4 cs[4][2], sn[4][2];
#pragma unroll
                for (int m = 0; m < 4; ++m) { const int lrow = 128 * ai + 64 * wr + 16 * m + fr; const float rs = tb[lrow];
                    if (smp && (m & 1) == 0) {
#pragma unroll
                        for (int mm = m; mm < m + 2; ++mm)
#pragma unroll
                            for (int n = 0; n < 2; ++n) { const int t = tq0 + 128 * ai + 64 * wr + 16 * mm + fr; cs[mm][n] = *(const GAS f32x4*)(rope + t * 32 + 8 * fq + 4 * n); sn[mm][n] = *(const GAS f32x4*)(rope + 32768 + t * 32 + 8 * fq + 4 * n); } }
                    f32x4 v[2][2]; float ss = 0.f;
#pragma unroll
                    for (int bj = 0; bj < 2; ++bj)
#pragma unroll
                        for (int n = 0; n < 2; ++n) { v[bj][n] = acc[ai][bj][m][n] * rs + bz[bj][n]; ss += (v[bj][n][0] * v[bj][n][0] + v[bj][n][1] * v[bj][n][1]) + (v[bj][n][2] * v[bj][n][2] + v[bj][n][3] * v[bj][n][3]); }
                    ss = sum_q4(ss);
                    const float rn = rsqrtf(ss * (1.f / 64.f) + EPS);
#pragma unroll
                    for (int bj = 0; bj < 2; ++bj)
#pragma unroll
                        for (int n = 0; n < 2; ++n) v[bj][n] = v[bj][n] * rn * gq[bj][n];
                    const unsigned row = (unsigned)(trow + lrow);
                    if (!smp) {
                        if (kind == 1) {
#pragma unroll
                            for (int bj = 0; bj < 2; ++bj)
#pragma unroll
                                for (int n = 0; n < 2; ++n) *(GAS f32x4*)((GAS unsigned char*)out + O_CK * 4 + (row * (unsigned)D + oc + 32 * bj + 4 * n) * 4u) = v[bj][n]; }
                    } else {
#pragma unroll
                        for (int n = 0; n < 2; ++n) { const f32x4 x1 = v[0][n], x2 = v[1][n]; v[0][n] = x1 * cs[m][n] - x2 * sn[m][n]; v[1][n] = x2 * cs[m][n] + x1 * sn[m][n]; } }
                    const unsigned drow = (kind == 1 && smp) ? (unsigned)(sb * TKS + PAST + tq0 + lrow) : row;
#pragma unroll
                    for (int bj = 0; bj < 2; ++bj) { u32x4 w; w.x = cvt_pk_bf16(v[bj][0][0], v[bj][0][1]); w.y = cvt_pk_bf16(v[bj][0][2], v[bj][0][3]); w.z = cvt_pk_bf16(v[bj][1][0], v[bj][1][1]); w.w = cvt_pk_bf16(v[bj][1][2], v[bj][1][3]);
                        *(GAS u32x4*)(dst + (drow * (unsigned)D + oc + 32 * bj) * 2u) = w; }
                    if (m & 1) { asm volatile("" ::: "memory"); __builtin_amdgcn_sched_barrier(0); } } }
        } else {
            const int oc = (u.pn - 8) * 256 + wc * 32 + 8 * fq;
            const size_t doff = smp ? WS_VS : WS_T2 + (size_t)M * D * 2 + (size_t)NPROMPT * D * 2; GAS unsigned char* dst = (GAS unsigned char*)ws + doff;
#pragma unroll
            for (int bj = 0; bj < 2; ++bj) { const f32x4 bz0 = *(PG8_LAS const f32x4*)(tb + 256 + tc0 + bj * HALF), bz1 = *(PG8_LAS const f32x4*)(tb + 256 + tc0 + bj * HALF + 4);
#pragma unroll
                for (int ai = 0; ai < 2; ++ai)
#pragma unroll
                    for (int m = 0; m < 4; ++m) { const int lrow = 128 * ai + 64 * wr + 16 * m + fr; const float rs = tb[lrow];
                        const f32x4 v0 = acc[ai][bj][m][0] * rs + bz0, v1 = acc[ai][bj][m][1] * rs + bz1;
                        const unsigned row = (unsigned)(trow + lrow), drow = smp ? (unsigned)(sb * TKS + PAST + tq0 + lrow) : row;
                        u32x4 w; w.x = cvt_pk_bf16(v0[0], v0[1]); w.y = cvt_pk_bf16(v0[2], v0[3]); w.z = cvt_pk_bf16(v1[0], v1[1]); w.w = cvt_pk_bf16(v1[2], v1[3]);
                        *(GAS u32x4*)(dst + (drow * (unsigned)D + oc + 128 * bj) * 2u) = w;
                        if (!smp) { *(GAS f32x4*)((GAS unsigned char*)out + O_CV * 4 + (row * (unsigned)D + oc + 128 * bj) * 4u) = v0; *(GAS f32x4*)((GAS unsigned char*)out + O_CV * 4 + (row * (unsigned)D + oc + 128 * bj + 4) * 4u) = v1; } } }
        }
    }
};
}

struct Params { const float* in[N_IN]; float* out; unsigned char* ws; };
struct Frame {
    LAS unsigned char* lds; int tid, lane, wave, bid, G, wave0;
    float* out; unsigned char* ws; float* out0; unsigned char* ws0;
    __device__ __forceinline__ const float* inp(int i) const { const unsigned long long v = ((LAS const unsigned long long*)(lds + PTR_OFF))[i];
        const unsigned lo = __builtin_amdgcn_readfirstlane((unsigned)v), hi = __builtin_amdgcn_readfirstlane((unsigned)(v >> 32)); return (const float*)(const GAS float*)(((unsigned long long)hi << 32) | lo); }
    float* mod; float* rstd; float* rope; bf16 *H, *T1, *T2, *T3, *KS, *VS, *WT; float *rsq0, *rsq1, *rsqv, *bias2;
    __device__ __forceinline__ void fresh() {
        int z = 0; asm volatile("" : "+v"(z));
        lane = __builtin_amdgcn_mbcnt_hi(~0u, __builtin_amdgcn_mbcnt_lo(~0u, z)); int wv = wave0; asm volatile("" : "+s"(wv)); wave = wv; tid = wv * 64 + lane;
        int b = blockIdx.x; asm volatile("" : "+s"(b)); bid = b;
        unsigned char* w = ws0; asm volatile("" : "+s"(w)); w = (unsigned char*)(GAS unsigned char*)(unsigned long long)w; ws = w; float* o = out0; asm volatile("" : "+s"(o)); o = (float*)(GAS float*)(unsigned long long)o; out = o;
        mod = (float*)(w + WS_MOD); rstd = (float*)(w + WS_RSTD); rope = (float*)(w + WS_ROPE);
        H = (bf16*)(w + WS_H); T1 = (bf16*)(w + WS_T1); T2 = (bf16*)(w + WS_T2); T3 = (bf16*)(w + WS_T3); KS = (bf16*)(w + WS_KS); VS = (bf16*)(w + WS_VS); WT = (bf16*)(w + WS_W);
        rsq0 = (float*)(w + WS_X); rsq1 = (float*)(w + WS_X + MiB); rsqv = (float*)(w + WS_X + 2 * MiB); bias2 = (float*)(w + WS_X + 4 * MiB);
    }
};
__device__ __forceinline__ const float* xin_row(const Frame& F, int row) { return row < NPROMPT ? F.inp(I_XP) + (size_t)row * D : F.inp(I_XS) + (size_t)(row - NPROMPT) * D; }
__device__ __forceinline__ int cidx_of(int row) { return row < NPROMPT ? 0 : 1 + ((row - NPROMPT) >> 10); }
__device__ __forceinline__ const float* modp(const Frame& F, int l, int row, int which) { return F.mod + (size_t)((l * 3 + cidx_of(row)) * 6 + which) * D; }


template <int MODE  >
__device__ __forceinline__ void transpose_item(const float* W, int K, int N, bf16* WT, LAS float* scr, int item, int lane) {
    const int nblk = N / 32, kb = item / nblk, nb = item % nblk, k0 = 64 * kb, n0 = 32 * nb;
    int d0 = n0; if (MODE == 1) { const int isu = n0 >= DFF, jj = n0 - isu * DFF; d0 = (jj >> 7) * 256 + isu * 128 + (jj & 127); }
    if (MODE == 2 && n0 < 2 * D) { const int w = n0 & 255; d0 = (n0 & ~255) + ((w >> 5) & 1) * 128 + (w >> 6) * 32; }
    float wv[32];
    const GAS float* wp = (const GAS float*)W + (size_t)(k0 + (lane >> 5)) * N + n0 + (lane & 31);
#pragma unroll
    for (int i = 0; i < 32; ++i) wv[i] = wp[(size_t)(2 * i) * N];
#pragma unroll
    for (int i = 0; i < 32; ++i) scr[(2 * i + (lane >> 5)) * 33 + (lane & 31)] = wv[i];
    asm volatile("s_waitcnt lgkmcnt(0)" ::: "memory");
    const int c = lane & 7;
#pragma unroll
    for (int j = 0; j < 4; ++j) { const int n = (lane >> 3) + 8 * j; const LAS float* sp = scr + (8 * c) * 33 + n;
        u32x4 o; o.x = f2bf(sp[0 * 33]) | (f2bf(sp[1 * 33]) << 16); o.y = f2bf(sp[2 * 33]) | (f2bf(sp[3 * 33]) << 16); o.z = f2bf(sp[4 * 33]) | (f2bf(sp[5 * 33]) << 16); o.w = f2bf(sp[6 * 33]) | (f2bf(sp[7 * 33]) << 16);
        *(u32x4*)(WT + (size_t)(d0 + n) * K + k0 + 8 * c) = o; }
    asm volatile("s_waitcnt lgkmcnt(0)" ::: "memory");
}
template <int MODE = 0>
__device__ __forceinline__ bool transpose_group(int& r, const float* W, int nmat, int K, int N, bf16* WT, LAS float* scr, int lane) {
    const int per = (K / 64) * (N / 32), tot = nmat * per;
    if (r >= tot) { r -= tot; return false; }
    const int mi = r / per; transpose_item<MODE>(W + (size_t)mi * K * N, K, N, WT + (size_t)mi * K * N, scr, r % per, lane); return true;
}

template <int SLOT>
__device__ __forceinline__ void convert_slot(Frame& F, int gw, int NGW) {
    LAS float* scr = (LAS float*)(F.lds + F.wave * 16384);
    constexpr size_t UPE = (size_t)2 * DFF * D, DNE = (size_t)D * DFF;
    constexpr int I_UP1 = (D / 64) * (2 * DFF / 32), I_DN1 = (DFF / 64) * (D / 32), I_LIN = (D / 64) * (2 * DRNN / 32), I_LOUT = (DRNN / 64) * (D / 32), I_WG = 80 * 2 * 4,
                  I_CIN = (D / 64) * (2 * DB / 32), I_COUT = (DB / 64) * (D / 32), I_QKV = (D / 64) * (3 * D / 32), I_AOUT = (D / 64) * (D / 32);
    constexpr int NIT = SLOT == 0 ? I_LIN + I_LOUT + I_WG + I_UP1 + I_DN1 : SLOT == 1 ? I_CIN + I_COUT + I_UP1 : SLOT == 2 ? I_DN1 + I_QKV + I_AOUT + I_UP1 : SLOT == 3 ? I_DN1 + I_LIN + I_LOUT : I_UP1 + I_DN1;
    for (int it = gw; it < NIT; it += NGW) { int r = it;
        if (SLOT == 0) {
            if (transpose_group(r, F.inp(I_LRU_WIN), 1, D, 2 * DRNN, F.WT + WE_LRU_IN, scr, F.lane)) continue;
            if (transpose_group(r, F.inp(I_LRU_WOUT), 1, DRNN, D, F.WT + WE_LRU_OUT, scr, F.lane)) continue;
            if (transpose_group(r, F.inp(I_LRU_WG), 80, 128, 128, F.WT + WE_WG, scr, F.lane)) continue;
            if (transpose_group<1>(r, F.inp(I_FF_WUP), 1, D, 2 * DFF, F.WT + WE_UP, scr, F.lane)) continue;
            transpose_group(r, F.inp(I_FF_WDN), 1, DFF, D, F.WT + WE_DN, scr, F.lane);
        } else if (SLOT == 1) {
            if (transpose_group(r, F.inp(I_CM_WIN), 1, D, 2 * DB, F.WT + WE_CM_IN, scr, F.lane)) continue;
            if (transpose_group(r, F.inp(I_CM_WOUT), 1, DB, D, F.WT + WE_CM_OUT, scr, F.lane)) continue;
            transpose_group<1>(r, F.inp(I_FF_WUP) + UPE, 1, D, 2 * DFF, F.WT + WE_UP + UPE, scr, F.lane);
        } else if (SLOT == 2) {
            if (transpose_group(r, F.inp(I_FF_WDN) + DNE, 1, DFF, D, F.WT + WE_DN + DNE, scr, F.lane)) continue;
            if (transpose_group<2>(r, F.inp(I_AT_WQKV), 1, D, 3 * D, F.WT + WE_QKV, scr, F.lane)) continue;
            if (transpose_group(r, F.inp(I_AT_WOUT), 1, D, D, F.WT + WE_AT_OUT, scr, F.lane)) continue;
            transpose_group<1>(r, F.inp(I_FF_WUP) + 2 * UPE, 1, D, 2 * DFF, F.WT + WE_UP + 2 * UPE, scr, F.lane);
        } else if (SLOT == 3) {
            if (transpose_group(r, F.inp(I_FF_WDN) + 2 * DNE, 1, DFF, D, F.WT + WE_DN + 2 * DNE, scr, F.lane)) continue;
            if (transpose_group(r, F.inp(I_LRU_WIN) + (size_t)D * 2 * DRNN, 1, D, 2 * DRNN, F.WT + WE_LRU_IN + (size_t)D * 2 * DRNN, scr, F.lane)) continue;
            transpose_group(r, F.inp(I_LRU_WOUT) + (size_t)DRNN * D, 1, DRNN, D, F.WT + WE_LRU_OUT + (size_t)DRNN * D, scr, F.lane);
        } else {
            if (transpose_group<1>(r, F.inp(I_FF_WUP) + 3 * UPE, 1, D, 2 * DFF, F.WT + WE_UP + 3 * UPE, scr, F.lane)) continue;
            transpose_group(r, F.inp(I_FF_WDN) + 3 * DNE, 1, DFF, D, F.WT + WE_DN + 3 * DNE, scr, F.lane);
        }
    }
}
__device__ __forceinline__ void adaln_layer(Frame& F, int l, int wk, int nwk) {
    LAS float* sc = (LAS float*)F.lds;
    const float* c = F.inp(I_C); const float* cctx = F.inp(I_CCTX);
    __syncthreads();
    for (int i = F.tid; i < 3 * D; i += NT) { const int ci = i >> 10, k = i & 1023; const float v = ci == 0 ? cctx[k] : c[(ci - 1) * D + k]; sc[i] = siluf_(v); }
    __syncthreads();
    LAS float* part = sc + 3 * D;
    const int kp = F.tid >> 6, cl = F.tid & 63;
    for (int item = wk; item < 6 * D / 64; item += nwk) {
        const int cc = item * 64 + cl;
        const float* w = F.inp(I_WMOD) + (size_t)l * D * 6 * D + cc;
        float s0 = 0.f, s1 = 0.f, s2 = 0.f;
#pragma unroll 1
        for (int kb = kp * 128; kb < kp * 128 + 128; kb += 32) { float wv[32];
#pragma unroll
            for (int i = 0; i < 32; ++i) wv[i] = ((const GAS float*)w)[(size_t)(kb + i) * 6 * D];
#pragma unroll
            for (int i = 0; i < 32; ++i) { s0 += sc[kb + i] * wv[i]; s1 += sc[D + kb + i] * wv[i]; s2 += sc[2 * D + kb + i] * wv[i]; } }
        part[(kp * 3 + 0) * 64 + cl] = s0; part[(kp * 3 + 1) * 64 + cl] = s1; part[(kp * 3 + 2) * 64 + cl] = s2;
        __syncthreads();
        if (F.tid < 192) { const int ci = F.tid >> 6; float s = F.inp(I_BMOD)[l * 6 * D + cc];
            for (int q = 0; q < 8; ++q) s += part[(q * 3 + ci) * 64 + cl];
            F.mod[(size_t)((l * 3 + ci) * 6) * D + cc] = s; }
        __syncthreads();
    }
}
__device__ __forceinline__ void phase_prologue(Frame& F) {
    F.fresh();
    adaln_layer(F, 0, F.bid, F.G);
    { __syncthreads(); convert_slot<0>(F, F.bid * NWAVES + F.wave, F.G * NWAVES); }
    const int gt = F.bid * NT + F.tid, GT = F.G * NT;
    for (int i = gt; i < 1024 * 32; i += GT) { const int t = i >> 5, j = i & 31; const float inv = powf(10000.f, -(float)(j & 15) / 16.f); const float pos = (float)(j < 16 ? (t >> 6) : (t & 63));
        const float ang = pos * inv; F.rope[i] = cosf(ang); F.rope[32768 + i] = sinf(ang); }
    for (int i = gt; i < 8 * 8 * 4 * 64; i += GT) { const int ln = i & 63, ks = (i >> 6) & 3, nf = (i >> 8) & 7, g = i >> 11, cq = ln >> 4, p = 16 * nf + (ln & 15);
        const float* wr = F.inp(I_CM_WS) + (size_t)(g * 128 + p) * 128 + 32 * ks + 4 * cq;
        u32x4 o; o.x = f2bf(wr[0]) | (f2bf(wr[1]) << 16); o.y = f2bf(wr[2]) | (f2bf(wr[3]) << 16); o.z = f2bf(wr[16]) | (f2bf(wr[17]) << 16); o.w = f2bf(wr[18]) | (f2bf(wr[19]) << 16);
        *(u32x4*)(F.WT + WE_WSB + (size_t)i * 8) = o; }
    for (int i = gt; i < 2 * PAST * D; i += GT) { const int b = i / (PAST * D), r = i % (PAST * D);
        F.KS[(size_t)b * TKS * D + r] = (bf16)f2bf(F.inp(I_CK)[i]); F.VS[(size_t)b * TKS * D + r] = (bf16)f2bf(F.inp(I_CV)[i]); }
}

__device__ __forceinline__ void bias2_gemm(Frame& F, const bf16* Wt, int N, int l, int sub, float* outp, int gw, int NGW) {
    float sh[3][16];
#pragma unroll
    for (int ci = 0; ci < 3; ++ci) { const GAS f32x4* sp = (const GAS f32x4*)(F.mod + (size_t)((l * 3 + ci) * 6 + sub * 3) * D + 16 * F.lane);
#pragma unroll
        for (int i = 0; i < 4; ++i) { const f32x4 v = sp[i]; sh[ci][4 * i] = v.x; sh[ci][4 * i + 1] = v.y; sh[ci][4 * i + 2] = v.z; sh[ci][4 * i + 3] = v.w; } }
    for (int n = gw; n < N; n += NGW) { const GAS u32x4* wp = (const GAS u32x4*)(Wt + (size_t)n * D + 16 * F.lane); const u32x4 w0 = wp[0], w1 = wp[1];
        const unsigned ww[8] = {w0.x, w0.y, w0.z, w0.w, w1.x, w1.y, w1.z, w1.w};
        float d0 = 0.f, d1 = 0.f, d2 = 0.f;
#pragma unroll
        for (int i = 0; i < 8; ++i) { const float lo = bf2f(ww[i]), hi = bf2f(ww[i] >> 16); d0 += sh[0][2 * i] * lo + sh[0][2 * i + 1] * hi; d1 += sh[1][2 * i] * lo + sh[1][2 * i + 1] * hi; d2 += sh[2][2 * i] * lo + sh[2][2 * i + 1] * hi; }
        d0 = wave_sum(d0); d1 = wave_sum(d1); d2 = wave_sum(d2);
        if (F.lane == 0) { outp[n] = d0; outp[(size_t)N + n] = d1; outp[(size_t)2 * N + n] = d2; } }
}
__device__ __forceinline__ void bias2_slot(Frame& F, int slot, int gw, int NGW) {
    if (slot == 2) bias2_gemm(F, F.WT + WE_CM_IN, 2 * DB, 1, 0, F.bias2 + B2_CM, gw, NGW);
    else if (slot == 3) bias2_gemm(F, F.WT + WE_UP + (size_t)1 * 2 * DFF * D, 2 * DFF, 1, 1, F.bias2 + B2_UP + (size_t)1 * 3 * 5632, gw, NGW);
    else if (slot == 4) bias2_gemm(F, F.WT + WE_QKV, 3 * D, 2, 0, F.bias2 + B2_QKV, gw, NGW);
    else if (slot == 5) bias2_gemm(F, F.WT + WE_UP + (size_t)2 * 2 * DFF * D, 2 * DFF, 2, 1, F.bias2 + B2_UP + (size_t)2 * 3 * 5632, gw, NGW);
    else if (slot == 6) bias2_gemm(F, F.WT + WE_LRU_IN + (size_t)2 * DRNN * D, 2 * DRNN, 3, 0, F.bias2 + B2_LRU + 3 * 2560, gw, NGW);
    else if (slot == 7) bias2_gemm(F, F.WT + WE_UP + (size_t)3 * 2 * DFF * D, 2 * DFF, 3, 1, F.bias2 + B2_UP + (size_t)3 * 3 * 5632, gw, NGW);
}
__device__ __forceinline__ void side_job(Frame& F, int slot) {
    F.fresh();
    const int nwk = F.G > 160 ? F.G - 160 : F.G, wk = F.G > 160 ? F.bid - 160 : F.bid;
    if (wk < 0) return;
    const int gw = wk * NWAVES + F.wave, NGW = nwk * NWAVES;
    bias2_slot(F, slot, gw, NGW);
    if (slot == 1) adaln_layer(F, 1, wk, nwk); else if (slot == 3) adaln_layer(F, 2, wk, nwk); else if (slot == 5) adaln_layer(F, 3, wk, nwk);
    if (slot == 1) convert_slot<1>(F, gw, NGW); else if (slot == 2) convert_slot<2>(F, gw, NGW); else if (slot == 3) convert_slot<3>(F, gw, NGW); else if (slot == 4) convert_slot<4>(F, gw, NGW);
}
__device__ __forceinline__ void phase_modulate0(Frame& F) {
    F.fresh();
    const int gw = F.bid * NWAVES + F.wave, NGW = F.G * NWAVES;
    const float* g = F.inp(I_NORMG);
    for (int row = gw; row < M; row += NGW) {
        const float* xr = xin_row(F, row); const float* scl = modp(F, 0, row, 1);
        f32x4 v[4]; float s = 0.f;
#pragma unroll
        for (int j = 0; j < 4; ++j) { v[j] = *(const GAS f32x4*)(xr + 4 * F.lane + 256 * j); s += v[j].x * v[j].x + v[j].y * v[j].y + v[j].z * v[j].z + v[j].w * v[j].w; }
        s = wave_sum(s);
        if (F.lane < 16) F.rsq0[(size_t)row * 16 + F.lane] = F.lane == 0 ? s : 0.f;
#pragma unroll
        for (int j = 0; j < 4; ++j) { const int c0 = 4 * F.lane + 256 * j; const f32x4 gg = *(const GAS f32x4*)(g + c0), c4 = *(const GAS f32x4*)(scl + c0);
            const f32x4 o = v[j] * gg * (1.f + c4); u32x2 w; w.x = f2bf(o.x) | (f2bf(o.y) << 16); w.y = f2bf(o.z) | (f2bf(o.w) << 16);
            *(GAS u32x2*)(F.H + (size_t)row * D + c0) = w; }
    }
    bias2_gemm(F, F.WT + WE_LRU_IN, 2 * DRNN, 0, 0, F.bias2 + B2_LRU, gw, NGW);
    bias2_gemm(F, F.WT + WE_UP, 2 * DFF, 0, 1, F.bias2 + B2_UP, gw, NGW);
}

template <class P>
__device__ __forceinline__ void gemm_naive(Frame& F, const P& p, int nbatch, int Mr, int N, int K) {
    F.fresh();
    LAS float* As = (LAS float*)F.lds;
    LAS float* Bs = As + 16 * 132;
    const int tid = F.tid, tx = tid & 31, ty = tid >> 5;
    const int tm = Mr / 128, tn = N / 128, per = tm * tn, total = per * nbatch;
    for (int t = F.bid; t < total; t += F.G) {
        const int b = t / per, r = t % per, pn = r / tm, pm = r % tm;
        const bf16* A; int lda; const float* W; int ldw; p.get(b, A, lda, W, ldw);
        float acc[8][4];
#pragma unroll
        for (int i = 0; i < 8; ++i)
#pragma unroll
            for (int j = 0; j < 4; ++j) acc[i][j] = 0.f;
        for (int k0 = 0; k0 < K; k0 += 16) {
            { const int row = tid >> 2, kq = (tid & 3) * 4;
              const u32x2 v = *(const u32x2*)(A + (size_t)(pm * 128 + row) * lda + k0 + kq);
              As[(kq + 0) * 132 + row] = bf2f(v.x); As[(kq + 1) * 132 + row] = bf2f(v.x >> 16); As[(kq + 2) * 132 + row] = bf2f(v.y); As[(kq + 3) * 132 + row] = bf2f(v.y >> 16); }
            { const int k = tid >> 5, n4 = (tid & 31) * 4;
              *(LAS f32x4*)(Bs + k * 128 + n4) = *(const f32x4*)(W + (size_t)(k0 + k) * ldw + pn * 128 + n4); }
            __syncthreads();
#pragma unroll 2
            for (int k = 0; k < 16; ++k) {
                const f32x4 a0 = *(const LAS f32x4*)(As + k * 132 + ty * 8), a1 = *(const LAS f32x4*)(As + k * 132 + ty * 8 + 4), bv = *(const LAS f32x4*)(Bs + k * 128 + tx * 4);
                const float a[8] = {a0.x, a0.y, a0.z, a0.w, a1.x, a1.y, a1.z, a1.w}; const float bb[4] = {bv.x, bv.y, bv.z, bv.w};
#pragma unroll
                for (int i = 0; i < 8; ++i)
#pragma unroll
                    for (int j = 0; j < 4; ++j) acc[i][j] += a[i] * bb[j];
            }
            __syncthreads();
        }
#pragma unroll
        for (int i = 0; i < 8; ++i)
#pragma unroll
            for (int j = 0; j < 4; ++j) p.epi(b, pm * 128 + ty * 8 + i, pn * 128 + tx * 4 + j, acc[i][j]);
    }
}

struct PStoreBf16 {
    const bf16* A; int lda; const float* W; int ldw; bf16* O; int ldo; const float* bias; int act; int split;
    __device__ __forceinline__ void get(int, const bf16*& a, int& la, const float*& w, int& lw) const { a = A; la = lda; w = W; lw = ldw; }
    __device__ __forceinline__ void epi(int, int row, int col, float v) const {
        if (bias) v += bias[col];
        if (act == 1 || (act == 2 && col < split)) v = gelu_tanh(v);
        O[(size_t)row * ldo + col] = (bf16)f2bf(v); }
};
struct PResid {
    const bf16* A; int lda; const float* W; int ldw; float* out; const float* xp; const float* xs; const float* modl; int which; bool from_input;
    __device__ __forceinline__ void get(int, const bf16*& a, int& la, const float*& w, int& lw) const { a = A; la = lda; w = W; lw = ldw; }
    __device__ __forceinline__ void epi(int, int row, int col, float v) const {
        const float base = from_input ? (row < NPROMPT ? xp[(size_t)row * D + col] : xs[(size_t)(row - NPROMPT) * D + col]) : out[(size_t)row * D + col];
        out[(size_t)row * D + col] = base + modl[(size_t)(cidx_of(row) * 6 + which) * D + col] * v; }
};
struct PLruIn {
    const bf16* A; const float* W; bf16* GBp; bf16* RECp;
    __device__ __forceinline__ void get(int, const bf16*& a, int& la, const float*& w, int& lw) const { a = A; la = D; w = W; lw = 2 * DRNN; }
    __device__ __forceinline__ void epi(int, int row, int col, float v) const {
        if (col < DRNN) GBp[(size_t)row * DRNN + col] = (bf16)f2bf(gelu_tanh(v)); else RECp[(size_t)row * DRNN + col - DRNN] = (bf16)f2bf(v); }
};
struct PGates {
    const bf16* XC; const float* WG; const float* BG; bf16* O;
    __device__ __forceinline__ void get(int b, const bf16*& a, int& la, const float*& w, int& lw) const { a = XC + (b % 10) * 128; la = DRNN; w = WG + (size_t)b * 128 * 128; lw = 128; }
    __device__ __forceinline__ void epi(int b, int row, int col, float v) const { const int dg = b / 10, n = b % 10;
        O[((size_t)dg * M + row) * DRNN + n * 128 + col] = (bf16)f2bf(sigmoidf_(v + BG[dg * DRNN + n * 128 + col])); }
};

__device__ __forceinline__ void phase_lru_conv(Frame& F, int j, const bf16* REC, bf16* XC) {
    F.fresh();
    const float* cw = F.inp(I_LRU_CW) + (size_t)j * 4 * DRNN; const float* cb = F.inp(I_LRU_CB) + (size_t)j * DRNN;
    const int gt = F.bid * NT + F.tid, GT = F.G * NT;
    for (int i = gt; i < M * DRNN; i += GT) { const int row = i / DRNN, ch = i % DRNN;
        int t, T; if (row < NPROMPT) { t = row & 255; T = 256; } else { t = (row - NPROMPT) & 1023; T = 1024; }
        float s = cb[ch];
#pragma unroll
        for (int k = 0; k < 4; ++k) { const int tt = t + k - 2; if (tt >= 0 && tt < T) s += cw[k * DRNN + ch] * bf2f(REC[(size_t)(row + k - 2) * DRNN + ch]); }
        XC[i] = (bf16)f2bf(s); }
}
__device__ __forceinline__ void phase_lru_scan(Frame& F, int j, const bf16* GATES, const bf16* XC, const bf16* GB, bf16* HS) {
    F.fresh();
    const int gt = F.bid * NT + F.tid, GT = F.G * NT;
    const int NL = (2 + 32) * DRNN;
    for (int line = gt; line < NL; line += GT) {
        const int s = line / DRNN, ch = line % DRNN;
        int base, T; float h0f = 0.f, h0b = 0.f;
        if (s < 2) { base = NPROMPT + s * 1024; T = 1024; h0f = F.inp(I_STATE)[((size_t)(s * 2 + j) * 2 + 0) * DRNN + ch]; h0b = F.inp(I_STATE)[((size_t)(s * 2 + j) * 2 + 1) * DRNN + ch]; }
        else { base = (s - 2) * 256; T = 256; }
        const float spf = softplusf_(-F.inp(I_LRU_LAM)[(size_t)(j * 2 + 0) * DRNN + ch]), spb = softplusf_(-F.inp(I_LRU_LAM)[(size_t)(j * 2 + 1) * DRNN + ch]);
        float h = h0f;
        for (int t = 0; t < T; ++t) { const size_t o = (size_t)(base + t) * DRNN + ch;
            const float r = bf2f(GATES[o]), ig = bf2f(GATES[(size_t)M * DRNN + o]), xc = bf2f(XC[o]);
            const float la = -8.f * r * spf, a = expf(la), bx = sqrtf(-expm1f(2.f * la)) * (ig * xc);
            h = a * h + bx; HS[o] = (bf16)f2bf(h); }
        const float ff = h;
        h = h0b;
        for (int t = T - 1; t >= 0; --t) { const size_t o = (size_t)(base + t) * DRNN + ch;
            const float r = bf2f(GATES[(size_t)2 * M * DRNN + o]), ig = bf2f(GATES[(size_t)3 * M * DRNN + o]), xc = bf2f(XC[o]);
            const float la = -8.f * r * spb, a = expf(la), bx = sqrtf(-expm1f(2.f * la)) * (ig * xc);
            h = a * h + bx; HS[o] = (bf16)f2bf(bf2f(GB[o]) * (bf2f(HS[o]) + h)); }
        if (s >= 2) { float* st = F.out + O_STATE + ((size_t)((s - 2) * 2 + j) * 2) * DRNN; st[ch] = ff; st[DRNN + ch] = h; }
    }
}


typedef short bf16x8 __attribute__((ext_vector_type(8)));
typedef short v4i16_t __attribute__((ext_vector_type(4)));
constexpr int LRU_XS = 272;
constexpr int LRU_XC_OFF = 0, LRU_GB_OFF = 256 * LRU_XS;
template <bool REV>
__device__ __forceinline__ float lru_dir(LAS const unsigned char* xct, LAS unsigned char* hft, const bf16* wgt  ,
                                         const bf16* gbp  , float br, float bi, float sp, float hc, int wave, int lane, bool wantp, bf16* Pdst) {
    const int c = lane & 15, q = lane >> 4, qq = REV ? 3 - q : q;
    bf16x8 Br[4], Bi[4], Id;
#pragma unroll
    for (int ks = 0; ks < 4; ++ks) { Br[ks] = *(const GAS bf16x8*)(wgt + (size_t)(16 * wave + c) * 128 + 32 * ks + 8 * q);
                                     Bi[ks] = *(const GAS bf16x8*)(wgt + (size_t)10 * 128 * 128 + (size_t)(16 * wave + c) * 128 + 32 * ks + 8 * q); }
#pragma unroll
    for (int jj = 0; jj < 8; ++jj) Id[jj] = (8 * q + jj == 16 * (wave & 1) + c) ? (short)0x3F80 : (short)0;
    const int ksel = wave >> 1;
    const float nsp8 = -8.f * sp * 1.44269504f;
    float Pc = 1.f;
    unsigned short gcur[16], gnxt[16];
#pragma unroll
    for (int i = 0; i < 16; ++i) { gcur[i] = 0; gnxt[i] = 0; }
    if (REV) {
#pragma unroll
        for (int i = 0; i < 16; ++i) gcur[i] = *(const GAS unsigned short*)(gbp + (size_t)(16 * (12 + (i >> 2)) + 4 * q + (i & 3)) * DRNN); }
#pragma unroll 1
    for (int og = 0; og < 4; ++og) {
        if (REV && og < 3) {
#pragma unroll
            for (int i = 0; i < 16; ++i) gnxt[i] = *(const GAS unsigned short*)(gbp + (size_t)(16 * (4 * (2 - og) + (i >> 2)) + 4 * q + (i & 3)) * DRNN); }
#pragma unroll
        for (int ii = 0; ii < 4; ++ii) {
        const int it = 4 * og + ii, mi = REV ? 15 - it : it, mloc = REV ? 3 - ii : ii;
        LAS const unsigned char* rp = xct + (16 * mi + c) * LRU_XS + 16 * q;
        bf16x8 Af[4];
#pragma unroll
        for (int ks = 0; ks < 4; ++ks) Af[ks] = *(LAS const bf16x8*)(rp + 64 * ks);
        const bf16x8 Ax = *(LAS const bf16x8*)(rp + 64 * ksel);
        f32x4 r = {0.f, 0.f, 0.f, 0.f}, ig = {0.f, 0.f, 0.f, 0.f};
#pragma unroll
        for (int ks = 0; ks < 4; ++ks) { r = __builtin_amdgcn_mfma_f32_16x16x32_bf16(Af[ks], Br[ks], r, 0, 0, 0); ig = __builtin_amdgcn_mfma_f32_16x16x32_bf16(Af[ks], Bi[ks], ig, 0, 0, 0); }
        const f32x4 xc = __builtin_amdgcn_mfma_f32_16x16x32_bf16(Ax, Id, (f32x4){0.f, 0.f, 0.f, 0.f}, 0, 0, 0);
        float av[4], bv[4];
#pragma unroll
        for (int k = 0; k < 4; ++k) { const float rg = __builtin_amdgcn_rcpf(1.f + __builtin_amdgcn_exp2f(-1.44269504f * (r[k] + br))), iv = __builtin_amdgcn_rcpf(1.f + __builtin_amdgcn_exp2f(-1.44269504f * (ig[k] + bi)));
            const float l2a = nsp8 * rg, x = 1.38629436f * l2a;
            const float oms = -x * (1.f + x * (0.5f + x * (0.16666667f + x * (0.041666668f + x * 0.0083333338f))));
            const float om = x > -0.25f ? oms : 1.f - __builtin_amdgcn_exp2f(2.f * l2a);
            av[k] = __builtin_amdgcn_exp2f(l2a); bv[k] = __builtin_amdgcn_sqrtf(om) * (iv * xc[k]); }
        float pA[4], pB[4];
#pragma unroll
        for (int kk = 0; kk < 4; ++kk) { const int k = REV ? 3 - kk : kk;
            if (kk == 0) { pA[k] = av[k]; pB[k] = bv[k]; } else { const int kp = REV ? k + 1 : k - 1; pA[k] = pA[kp] * av[k]; pB[k] = pB[kp] * av[k] + bv[k]; } }
        const int kl = REV ? 0 : 3;
        float gA[4], gB[4];
#pragma unroll
        for (int g = 0; g < 4; ++g) { const int src = 16 * (REV ? 3 - g : g) + c; gA[g] = bperm(pA[kl], src); gB[g] = bperm(pB[kl], src); }
        float eA = 1.f, eB = 0.f, tA = 1.f, tB = 0.f;
#pragma unroll
        for (int g = 0; g < 4; ++g) { if (g == qq) { eA = tA; eB = tB; } tB = tB * gA[g] + gB[g]; tA = tA * gA[g]; }
        const float hin = eA * hc + eB;
#pragma unroll
        for (int k = 0; k < 4; ++k) { const float h = pA[k] * hin + pB[k]; const int row = 16 * mi + 4 * q + k;
            if (wantp) Pdst[(size_t)row * DRNN] = (bf16)f2bf(pA[k] * eA * Pc);
            LAS unsigned short* hp = (LAS unsigned short*)(hft + row * LRU_XS + 2 * (16 * wave + c));
            if (!REV) *hp = (unsigned short)f2bf(h); else *hp = (unsigned short)f2bf(bf2f(gcur[4 * mloc + k]) * (bf2f(*hp) + h)); }
        hc = tA * hc + tB; Pc *= tA;
        }
        if (REV) {
#pragma unroll
            for (int i = 0; i < 16; ++i) gcur[i] = gnxt[i]; }
    }
    return hc;
}
__device__ __forceinline__ void lru_unit(Frame& F, int j, int pm, int n, const bf16* REC, const bf16* GB, bf16* HS, bf16* PF, bf16* PB, float* AGG, const bf16* WGT) {
    const int tid = F.tid, lane = F.lane, wave = F.wave, r0 = 256 * pm;
    const bool smp = pm >= 32; const int tix = smp ? (pm - 32) & 3 : 0, sq = smp ? (pm - 32) >> 2 : 0;
    const int t0 = smp ? 256 * tix : 0, T = smp ? 1024 : 256;
    LAS unsigned char* xct = F.lds + LRU_XC_OFF; LAS unsigned char* hft = F.lds + LRU_GB_OFF;
    { const float* cw = F.inp(I_LRU_CW) + (size_t)j * 4 * DRNN + n * 128 + 2 * lane; const float* cb = F.inp(I_LRU_CB) + (size_t)j * DRNN + n * 128 + 2 * lane;
      float w0[4], w1[4];
#pragma unroll
      for (int k = 0; k < 4; ++k) { w0[k] = cw[k * DRNN]; w1[k] = cw[k * DRNN + 1]; }
      const float b0 = cb[0], b1 = cb[1];
      unsigned v[35];
#pragma unroll
      for (int i = 0; i < 35; ++i) { const int tl = 32 * wave + i - 2, tt = t0 + tl;
          v[i] = (tt >= 0 && tt < T) ? *(const GAS unsigned*)(REC + (size_t)(r0 + tl) * DRNN + n * 128 + 2 * lane) : 0u; }
#pragma unroll
      for (int i = 0; i < 32; ++i) { float s0 = b0, s1 = b1;
#pragma unroll
          for (int k = 0; k < 4; ++k) { s0 += w0[k] * bf2f(v[i + k]); s1 += w1[k] * bf2f(v[i + k] >> 16); }
          *(LAS unsigned*)(xct + (32 * wave + i) * LRU_XS + 4 * lane) = f2bf(s0) | (f2bf(s1) << 16); } }
    __syncthreads();
    const int c = lane & 15, q = lane >> 4, ch = n * 128 + 16 * wave + c;
    const float* bg = F.inp(I_LRU_BG) + (size_t)j * 4 * DRNN; const float* lam = F.inp(I_LRU_LAM) + (size_t)j * 2 * DRNN;
    const bf16* gbp = GB + (size_t)r0 * DRNN + ch;
    bf16* pf = PF + (size_t)(smp ? r0 - NPROMPT : 0) * DRNN + ch; bf16* pb = PB + (size_t)(smp ? r0 - NPROMPT : 0) * DRNN + ch;
    { float h0 = 0.f; if (smp && tix == 0) h0 = F.inp(I_STATE)[((size_t)(sq * 2 + j) * 2 + 0) * DRNN + ch];
      const float hfin = lru_dir<false>(xct, hft, WGT + (size_t)(0 * 10 + n) * 128 * 128, gbp, bg[0 * DRNN + ch], bg[1 * DRNN + ch], softplusf_(-lam[ch]), h0, wave, lane, smp, pf);
      if (q == 0) { if (smp) AGG[(size_t)((sq * 4 + tix) * 2 + 0) * DRNN + ch] = hfin; else F.out[O_STATE + ((size_t)(pm * 2 + j) * 2 + 0) * DRNN + ch] = hfin; } }
    { float h0 = 0.f; if (smp && tix == 3) h0 = F.inp(I_STATE)[((size_t)(sq * 2 + j) * 2 + 1) * DRNN + ch];
      const float hfin = lru_dir<true>(xct, hft, WGT + (size_t)(2 * 10 + n) * 128 * 128, gbp, bg[2 * DRNN + ch], bg[3 * DRNN + ch], softplusf_(-lam[DRNN + ch]), h0, wave, lane, smp, pb);
      if (q == 0) { if (smp) AGG[(size_t)((sq * 4 + tix) * 2 + 1) * DRNN + ch] = hfin; else F.out[O_STATE + ((size_t)(pm * 2 + j) * 2 + 1) * DRNN + ch] = hfin; } }
    __syncthreads();
#pragma unroll
    for (int i = 0; i < 8; ++i) { const int id = i * NT + tid, row = id >> 4, cc = id & 15;
        *(GAS u32x4*)(HS + (size_t)(r0 + row) * DRNN + n * 128 + 8 * cc) = *(LAS const u32x4*)(hft + row * LRU_XS + 16 * cc); }
    __syncthreads();
}
__device__ __forceinline__ void phase_lru_core(Frame& F, int j, const bf16* REC, const bf16* GB, bf16* HS, bf16* PF, bf16* PB, float* AGG, const bf16* WGT) {
    F.fresh();
    for (int u = F.bid; u < 400; u += F.G) {
        const int pm = u < 80 ? 32 + u / 10 : (u - 80) / 10, n = u % 10;
        lru_unit(F, j, pm, n, REC, GB, HS, PF, PB, AGG, WGT); }
}
__device__ __forceinline__ void phase_lru_fixup(Frame& F, const bf16* GB, bf16* HS, const bf16* PF, const bf16* PB, const float* AGG) {
    F.fresh();
    const int gt = F.bid * NT + F.tid, GT = F.G * NT;
    for (int i = gt; i < NSAMPLE * DRNN; i += GT) { const int rs = i / DRNN, ch = i % DRNN, sq = rs >> 10, tix = (rs >> 8) & 3;
        float cf = 0.f, cbk = 0.f;
        if (tix > 0) { for (int t = 0; t < tix; ++t) { const float At = bf2f(PF[(size_t)(sq * 1024 + t * 256 + 255) * DRNN + ch]); cf = At * cf + AGG[(size_t)((sq * 4 + t) * 2 + 0) * DRNN + ch]; } }
        if (tix < 3) { for (int t = 3; t > tix; --t) { const float At = bf2f(PB[(size_t)(sq * 1024 + t * 256) * DRNN + ch]); cbk = At * cbk + AGG[(size_t)((sq * 4 + t) * 2 + 1) * DRNN + ch]; } }
        const size_t o = (size_t)(NPROMPT + rs) * DRNN + ch;
        HS[o] = (bf16)f2bf(bf2f(HS[o]) + bf2f(GB[o]) * (bf2f(PF[(size_t)rs * DRNN + ch]) * cf + bf2f(PB[(size_t)rs * DRNN + ch]) * cbk)); }
}

__device__ __forceinline__ void phase_cmlp_rstd(Frame& F, const bf16* UV) {
    F.fresh();
    const int gw = F.bid * NWAVES + F.wave, NGW = F.G * NWAVES;
    for (int row = gw; row < M; row += NGW) { float s = 0.f;
        for (int c = F.lane; c < DB; c += 64) { const float v = bf2f(UV[(size_t)row * 2 * DB + DB + c]); s += v * v; }
        s = wave_sum(s); if (F.lane == 0) F.rstd[row] = rsqrtf(s * (1.f / DB) + EPS); }
}
__device__ __forceinline__ void phase_cmlp_spatial(Frame& F, const bf16* UV, bf16* ACT) {
    F.fresh();
    const float* ws = F.inp(I_CM_WS); const float* bs = F.inp(I_CM_BS); const float* ng = F.inp(I_CM_NG);
    const int gt = F.bid * NT + F.tid, GT = F.G * NT;
    for (int i = gt; i < M * DB; i += GT) { const int row = i / DB, ch = i % DB, g = ch >> 8, p = row & 127, r0 = row & ~127;
        float s = 0.f;
        for (int q = 0; q < 128; ++q) s += ws[(size_t)(g * 128 + p) * 128 + q] * F.rstd[r0 + q] * bf2f(UV[(size_t)(r0 + q) * 2 * DB + DB + ch]);
        const float sv = s * ng[ch] + bs[g * 128 + p];
        ACT[i] = (bf16)f2bf(bf2f(UV[(size_t)row * 2 * DB + ch]) * sv); }
}


constexpr int CM_VS = 544;
__device__ __forceinline__ void phase_cmlp_spatial_mfma(Frame& F, const bf16* UV, bf16* ACT, const bf16* WSB) {
    F.fresh();
    const int tid = F.tid, lane = F.lane, wave = F.wave, c = lane & 15, q4 = lane >> 4;
    LAS unsigned char* vt = F.lds;
    const float* ng = F.inp(I_CM_NG); const float* bs = F.inp(I_CM_BS);
    for (int u = F.bid; u < 640; u += F.G) {
        const int chunk = u >> 3, g = u & 7, r0 = chunk * 128;
        LAS float* rsl = (LAS float*)(vt + 128 * CM_VS);
        if (tid < 128) { const GAS f32x4* p = (const GAS f32x4*)(F.rsqv + (size_t)(r0 + tid) * 32); float sm = 0.f;
#pragma unroll
            for (int i = 0; i < 8; ++i) { const f32x4 t4 = p[i]; sm += (t4.x + t4.y) + (t4.z + t4.w); }
            rsl[tid] = rsqrtf(sm * (1.f / DB) + EPS); }
        __syncthreads();
#pragma unroll
        for (int i = 0; i < 8; ++i) { const int id = i * NT + tid, row = id >> 5, cc = id & 31;
            const u32x4 x = *(const GAS u32x4*)(UV + (size_t)(r0 + row) * 2 * DB + DB + g * 256 + 8 * cc); const float rs = rsl[row];
            u32x4 y; y.x = f2bf(bf2f(x.x) * rs) | (f2bf(bf2f(x.x >> 16) * rs) << 16); y.y = f2bf(bf2f(x.y) * rs) | (f2bf(bf2f(x.y >> 16) * rs) << 16);
            y.z = f2bf(bf2f(x.z) * rs) | (f2bf(bf2f(x.z >> 16) * rs) << 16); y.w = f2bf(bf2f(x.w) * rs) | (f2bf(bf2f(x.w >> 16) * rs) << 16);
            *(LAS u32x4*)(vt + row * CM_VS + 16 * cc) = y; }
        __syncthreads();
        bf16x8 vf[2][4];
#pragma unroll
        for (int mfc = 0; mfc < 2; ++mfc)
#pragma unroll
            for (int ks = 0; ks < 4; ++ks) { LAS const unsigned char* vp = vt + (32 * ks + 4 * q4 + (c >> 2)) * CM_VS + (32 * wave + 16 * mfc + 4 * (c & 3)) * 2;
                const v4i16_t lo = __builtin_amdgcn_ds_read_tr16_b64_v4i16((LAS v4i16_t*)vp), hi = __builtin_amdgcn_ds_read_tr16_b64_v4i16((LAS v4i16_t*)(vp + 16 * CM_VS));
                vf[mfc][ks] = (bf16x8){lo[0], lo[1], lo[2], lo[3], hi[0], hi[1], hi[2], hi[3]}; }
#pragma unroll
        for (int nf = 0; nf < 8; ++nf) {
            bf16x8 Bf[4];
#pragma unroll
            for (int ks = 0; ks < 4; ++ks) Bf[ks] = *(const GAS bf16x8*)(WSB + ((size_t)((g * 8 + nf) * 4 + ks) * 64 + lane) * 8);
            const int p = 16 * nf + c; const float bsv = bs[g * 128 + p];
#pragma unroll
            for (int mfc = 0; mfc < 2; ++mfc) { f32x4 acc = {0.f, 0.f, 0.f, 0.f};
#pragma unroll
                for (int ks = 0; ks < 4; ++ks) acc = __builtin_amdgcn_mfma_f32_16x16x32_bf16(vf[mfc][ks], Bf[ks], acc, 0, 0, 0);
                const int ch = g * 256 + 32 * wave + 16 * mfc + 4 * q4;
                const f32x4 g4 = *(const GAS f32x4*)(ng + ch); const u32x2 uu = *(const GAS u32x2*)(UV + (size_t)(r0 + p) * 2 * DB + ch);
                const float o0 = bf2f(uu.x) * (acc[0] * g4.x + bsv), o1 = bf2f(uu.x >> 16) * (acc[1] * g4.y + bsv), o2 = bf2f(uu.y) * (acc[2] * g4.z + bsv), o3 = bf2f(uu.y >> 16) * (acc[3] * g4.w + bsv);
                u32x2 w; w.x = f2bf(o0) | (f2bf(o1) << 16); w.y = f2bf(o2) | (f2bf(o3) << 16);
                *(GAS u32x2*)(ACT + (size_t)(r0 + p) * DB + ch) = w; }
        }
        __syncthreads();
    }
}

__device__ __forceinline__ void phase_qkv_post(Frame& F, const bf16* QKV, bf16* Q, bf16* KP, bf16* VP) {
    F.fresh();
    const int gw = F.bid * NWAVES + F.wave, NGW = F.G * NWAVES;
    const float* qkg = F.inp(I_AT_QKG);
    for (int row = gw; row < M; row += NGW) {
        const bool smp = row >= NPROMPT; const int sb = smp ? (row - NPROMPT) >> 10 : 0, t = smp ? (row - NPROMPT) & 1023 : 0;
        const float cs = smp ? F.rope[t * 32 + (F.lane & 31)] : 1.f, sn = smp ? F.rope[32768 + t * 32 + (F.lane & 31)] : 0.f;
        for (int grp = 0; grp < 32; ++grp) {
            const float v = bf2f(QKV[(size_t)row * 3072 + grp * 64 + F.lane]);
            const float ms = wave_sum(v * v) * (1.f / 64.f);
            float n = v * rsqrtf(ms + EPS) * qkg[(grp >> 4) * 64 + F.lane];
            const float keep = n;
            if (smp) { float pr; { auto r_ = __builtin_amdgcn_permlane32_swap(__builtin_bit_cast(unsigned, n), __builtin_bit_cast(unsigned, n), false, false); pr = __builtin_bit_cast(float, F.lane < 32 ? (unsigned)r_[1] : (unsigned)r_[0]); } n = F.lane < 32 ? n * cs - pr * sn : n * cs + pr * sn; }
            if (grp < 16) Q[(size_t)row * D + grp * 64 + F.lane] = (bf16)f2bf(n);
            else { const int c = (grp - 16) * 64 + F.lane;
                if (smp) F.KS[((size_t)sb * TKS + PAST + t) * D + c] = (bf16)f2bf(n);
                else { KP[(size_t)row * D + c] = (bf16)f2bf(keep); F.out[O_CK + (size_t)row * D + c] = keep; } }
        }
        for (int c = F.lane; c < D; c += 64) { const bf16 vb = QKV[(size_t)row * 3072 + 2048 + c];
            if (smp) F.VS[((size_t)sb * TKS + PAST + t) * D + c] = vb; else { VP[(size_t)row * D + c] = vb; F.out[O_CV + (size_t)row * D + c] = bf2f(vb); } }
    }
}
__device__ __forceinline__ void phase_attn_naive(Frame& F, int l, const bf16* Q, const bf16* KP, const bf16* VP, bf16* O) {
    F.fresh();
    const int gw = F.bid * NWAVES + F.wave, NGW = F.G * NWAVES;
    LAS float* s1 = (LAS float*)F.lds + F.wave * 3328; LAS float* s2 = s1 + 1536; LAS float* qs = s2 + 1536;
    const float* al = F.inp(I_AT_LAM);
    const float lam_init = 0.8f - 0.6f * expf(-0.3f * (float)l);
    const float lam = expf(wave_sum(al[F.lane] * al[64 + F.lane])) - expf(wave_sum(al[128 + F.lane] * al[192 + F.lane])) + lam_init;
    const float* sg = F.inp(I_AT_SUBG);
    for (int item = gw; item < M * 8; item += NGW) {
        const int row = item >> 3, h = item & 7;
        const bf16 *Kb, *Vb; int Tk;
        if (row < NPROMPT) { Kb = KP + (size_t)(row & ~255) * D; Vb = VP + (size_t)(row & ~255) * D; Tk = 256; }
        else { const int sb = (row - NPROMPT) >> 10; Kb = F.KS + (size_t)sb * TKS * D; Vb = F.VS + (size_t)sb * TKS * D; Tk = TKS; }
        qs[F.lane] = bf2f(Q[(size_t)row * D + h * 128 + F.lane]); qs[64 + F.lane] = bf2f(Q[(size_t)row * D + h * 128 + 64 + F.lane]);
        asm volatile("s_waitcnt lgkmcnt(0)" ::: "memory");
        float m1 = -1e30f, m2 = -1e30f;
        for (int k = F.lane; k < Tk; k += 64) { const bf16* kr = Kb + (size_t)k * D + h * 128; float d1 = 0.f, d2 = 0.f;
#pragma unroll 4
            for (int d = 0; d < 64; d += 2) { const unsigned a = *(const unsigned*)(kr + d), b = *(const unsigned*)(kr + 64 + d);
                d1 += qs[d] * bf2f(a) + qs[d + 1] * bf2f(a >> 16); d2 += qs[64 + d] * bf2f(b) + qs[64 + d + 1] * bf2f(b >> 16); }
            d1 *= 0.125f; d2 *= 0.125f; s1[k] = d1; s2[k] = d2; m1 = fmaxf(m1, d1); m2 = fmaxf(m2, d2); }
        m1 = wave_max(m1); m2 = wave_max(m2);
        float l1 = 0.f, l2 = 0.f;
        for (int k = F.lane; k < Tk; k += 64) { const float e1 = expf(s1[k] - m1), e2 = expf(s2[k] - m2); s1[k] = e1; s2[k] = e2; l1 += e1; l2 += e2; }
        l1 = wave_sum(l1); l2 = wave_sum(l2);
        const float i1 = 1.f / l1, i2 = lam / l2;
        for (int k = F.lane; k < Tk; k += 64) s1[k] = bf2f(f2bf(s1[k] * i1 - s2[k] * i2));
        asm volatile("s_waitcnt lgkmcnt(0)" ::: "memory");
        float o0 = 0.f, o1 = 0.f;
        for (int k = 0; k < Tk; ++k) { const unsigned vv = *(const unsigned*)(Vb + (size_t)k * D + h * 128 + 2 * F.lane); const float w = s1[k]; o0 += w * bf2f(vv); o1 += w * bf2f(vv >> 16); }
        const float ms = wave_sum(o0 * o0 + o1 * o1) * (1.f / 128.f), rs = rsqrtf(ms + EPS) * (1.f - lam_init);
        o0 = o0 * rs * sg[2 * F.lane]; o1 = o1 * rs * sg[2 * F.lane + 1];
        *(unsigned*)(O + (size_t)row * D + h * 128 + 2 * F.lane) = f2bf(o0) | (f2bf(o1) << 16);
        asm volatile("s_waitcnt lgkmcnt(0)" ::: "memory");
    }
}


constexpr int AT_KT = 128, AT_NMF = AT_KT / 16, AT_NCH = AT_KT / 32;
constexpr int AT_KS = 272, AT_VS = 288, AT_KBYTES = AT_KT * AT_KS, AT_VBYTES = AT_KT * AT_VS, AT_BUF = AT_KBYTES + AT_VBYTES;
__device__ __forceinline__ void attn_unit(Frame& F, int l, const bf16* Qrows  , const bf16* Kb, const bf16* Vb, int Tk, bf16* Orows, int h, float lam, float lam_init) {
    const int tid = F.tid, lane = F.lane, wave = F.wave, c = lane & 15, q4 = lane >> 4;
    LAS unsigned char* lds = F.lds;
    const float SC = 0.18033688f;
    bf16x8 Qf[2][2];
#pragma unroll
    for (int cp = 0; cp < 2; ++cp)
#pragma unroll
        for (int ks = 0; ks < 2; ++ks) Qf[cp][ks] = *(const GAS bf16x8*)(Qrows + (size_t)(16 * wave + c) * D + h * 128 + cp * 64 + 32 * ks + 8 * q4);
    const int nt = Tk / AT_KT;
    const int key0 = tid >> 4, cc0 = tid & 15;
    u32x4 kreg[AT_NCH], vreg[AT_NCH];
    float m1 = -1e30f, m2 = -1e30f, l1 = 0.f, l2 = 0.f;
#pragma unroll
    for (int i = 0; i < AT_NCH; ++i) kreg[i] = *(const GAS u32x4*)(Kb + (size_t)(key0 + 32 * i) * D + h * 128 + 8 * cc0);
#pragma unroll
    for (int i = 0; i < AT_NCH; ++i) *(LAS u32x4*)(lds + (key0 + 32 * i) * AT_KS + 16 * cc0) = kreg[i];
    __syncthreads();
    for (int t = 0; t < nt; ++t) {
        LAS const unsigned char* kt = lds + (t & 1) * AT_BUF;
        if (t + 1 < nt) {
#pragma unroll
            for (int i = 0; i < AT_NCH; ++i) kreg[i] = *(const GAS u32x4*)(Kb + (size_t)((t + 1) * AT_KT + key0 + 32 * i) * D + h * 128 + 8 * cc0); }
#pragma unroll
        for (int hf = 0; hf < AT_NMF / 4; ++hf) {
            f32x4 S[2][4];
#pragma unroll
            for (int cp = 0; cp < 2; ++cp)
#pragma unroll
                for (int mf = 0; mf < 4; ++mf) { S[cp][mf] = (f32x4){0.f, 0.f, 0.f, 0.f};
#pragma unroll
                    for (int ks = 0; ks < 2; ++ks) { const bf16x8 kf = *(LAS const bf16x8*)(kt + (64 * hf + 16 * mf + c) * AT_KS + cp * 128 + ks * 64 + 16 * q4);
                        S[cp][mf] = __builtin_amdgcn_mfma_f32_16x16x32_bf16(kf, Qf[cp][ks], S[cp][mf], 0, 0, 0); } }
            float x1 = -1e30f, x2 = -1e30f;
#pragma unroll
            for (int mf = 0; mf < 4; ++mf)
#pragma unroll
                for (int k = 0; k < 4; ++k) { x1 = fmaxf(x1, S[0][mf][k]); x2 = fmaxf(x2, S[1][mf][k]); }
            x1 = max_q4(x1); x2 = max_q4(x2);
            const float n1 = fmaxf(m1, x1), n2 = fmaxf(m2, x2);
            l1 *= __builtin_amdgcn_exp2f((m1 - n1) * SC); l2 *= __builtin_amdgcn_exp2f((m2 - n2) * SC); m1 = n1; m2 = n2;
            const float o1 = m1 * SC, o2 = m2 * SC;
#pragma unroll
            for (int mf = 0; mf < 4; ++mf)
#pragma unroll
                for (int k = 0; k < 4; ++k) { l1 += __builtin_amdgcn_exp2f(S[0][mf][k] * SC - o1); l2 += __builtin_amdgcn_exp2f(S[1][mf][k] * SC - o2); }
        }
        if (t + 1 < nt) {
#pragma unroll
            for (int i = 0; i < AT_NCH; ++i) *(LAS u32x4*)(lds + ((t + 1) & 1) * AT_BUF + (key0 + 32 * i) * AT_KS + 16 * cc0) = kreg[i]; }
        __syncthreads();
    }
    l1 = sum_q4(l1); l2 = sum_q4(l2);
    const float i1 = 1.f / l1, i2 = lam / l2, o1 = m1 * SC, o2 = m2 * SC;
    f32x4 Ot[8];
#pragma unroll
    for (int md = 0; md < 8; ++md) Ot[md] = (f32x4){0.f, 0.f, 0.f, 0.f};
#pragma unroll
    for (int i = 0; i < AT_NCH; ++i) { kreg[i] = *(const GAS u32x4*)(Kb + (size_t)(key0 + 32 * i) * D + h * 128 + 8 * cc0); vreg[i] = *(const GAS u32x4*)(Vb + (size_t)(key0 + 32 * i) * D + h * 128 + 8 * cc0); }
#pragma unroll
    for (int i = 0; i < AT_NCH; ++i) { *(LAS u32x4*)(lds + (key0 + 32 * i) * AT_KS + 16 * cc0) = kreg[i]; *(LAS u32x4*)(lds + AT_KBYTES + (key0 + 32 * i) * AT_VS + 16 * cc0) = vreg[i]; }
    __syncthreads();
    for (int t = 0; t < nt; ++t) {
        LAS const unsigned char* kt = lds + (t & 1) * AT_BUF; LAS const unsigned char* vt = kt + AT_KBYTES;
        if (t + 1 < nt) {
#pragma unroll
            for (int i = 0; i < AT_NCH; ++i) { kreg[i] = *(const GAS u32x4*)(Kb + (size_t)((t + 1) * AT_KT + key0 + 32 * i) * D + h * 128 + 8 * cc0);
                                               vreg[i] = *(const GAS u32x4*)(Vb + (size_t)((t + 1) * AT_KT + key0 + 32 * i) * D + h * 128 + 8 * cc0); } }
#pragma unroll
        for (int hf = 0; hf < AT_NMF / 4; ++hf) {
            f32x4 S[2][4];
#pragma unroll
            for (int cp = 0; cp < 2; ++cp)
#pragma unroll
                for (int mf = 0; mf < 4; ++mf) { S[cp][mf] = (f32x4){0.f, 0.f, 0.f, 0.f};
#pragma unroll
                    for (int ks = 0; ks < 2; ++ks) { const bf16x8 kf = *(LAS const bf16x8*)(kt + (64 * hf + 16 * mf + c) * AT_KS + cp * 128 + ks * 64 + 16 * q4);
                        S[cp][mf] = __builtin_amdgcn_mfma_f32_16x16x32_bf16(kf, Qf[cp][ks], S[cp][mf], 0, 0, 0); } }
            bf16x8 Wf[2];
#pragma unroll
            for (int kk = 0; kk < 2; ++kk) { float w[8];
#pragma unroll
                for (int jj = 0; jj < 8; ++jj) { const int mf = 2 * kk + (jj >> 2), k = jj & 3;
                    w[jj] = __builtin_amdgcn_exp2f(S[0][mf][k] * SC - o1) * i1 - __builtin_amdgcn_exp2f(S[1][mf][k] * SC - o2) * i2; }
                const unsigned p0 = pg8::cvt_pk_bf16(w[0], w[1]), p1 = pg8::cvt_pk_bf16(w[2], w[3]), p2 = pg8::cvt_pk_bf16(w[4], w[5]), p3 = pg8::cvt_pk_bf16(w[6], w[7]);
                Wf[kk] = __builtin_bit_cast(bf16x8, (u32x4){p0, p1, p2, p3}); }
#pragma unroll
            for (int md = 0; md < 8; ++md)
#pragma unroll
                for (int kk = 0; kk < 2; ++kk) { LAS const unsigned char* vp = vt + (64 * hf + 32 * kk + 4 * q4 + (c >> 2)) * AT_VS + (16 * md + 4 * (c & 3)) * 2;
                    const v4i16_t lo = __builtin_amdgcn_ds_read_tr16_b64_v4i16((LAS v4i16_t*)vp), hi = __builtin_amdgcn_ds_read_tr16_b64_v4i16((LAS v4i16_t*)(vp + 16 * AT_VS));
                    const bf16x8 vf = {lo[0], lo[1], lo[2], lo[3], hi[0], hi[1], hi[2], hi[3]};
                    Ot[md] = __builtin_amdgcn_mfma_f32_16x16x32_bf16(vf, Wf[kk], Ot[md], 0, 0, 0); }
        }
        if (t + 1 < nt) {
#pragma unroll
            for (int i = 0; i < AT_NCH; ++i) { *(LAS u32x4*)(lds + ((t + 1) & 1) * AT_BUF + (key0 + 32 * i) * AT_KS + 16 * cc0) = kreg[i];
                                               *(LAS u32x4*)(lds + ((t + 1) & 1) * AT_BUF + AT_KBYTES + (key0 + 32 * i) * AT_VS + 16 * cc0) = vreg[i]; } }
        __syncthreads();
    }
    float ss = 0.f;
#pragma unroll
    for (int md = 0; md < 8; ++md)
#pragma unroll
        for (int k = 0; k < 4; ++k) ss += Ot[md][k] * Ot[md][k];
    ss = sum_q4(ss);
    const float rs = rsqrtf(ss * (1.f / 128.f) + EPS) * (1.f - lam_init);
    const float* sg = F.inp(I_AT_SUBG);
#pragma unroll
    for (int md = 0; md < 8; ++md) { const int d0 = 16 * md + 4 * q4; const f32x4 g4 = *(const GAS f32x4*)(sg + d0);
        u32x2 w; w.x = pg8::cvt_pk_bf16(Ot[md][0] * rs * g4.x, Ot[md][1] * rs * g4.y); w.y = pg8::cvt_pk_bf16(Ot[md][2] * rs * g4.z, Ot[md][3] * rs * g4.w);
        *(GAS u32x2*)(Orows + (size_t)(16 * wave + c) * D + h * 128 + d0) = w; }
}
__device__ __forceinline__ void phase_attn(Frame& F, int l, const bf16* Q, const bf16* KP, const bf16* VP, bf16* O) {
    F.fresh();
    const float* al = F.inp(I_AT_LAM);
    const float lam_init = 0.8f - 0.6f * expf(-0.3f * (float)l);
    const float lam = expf(wave_sum(al[F.lane] * al[64 + F.lane])) - expf(wave_sum(al[128 + F.lane] * al[192 + F.lane])) + lam_init;
    for (int s = 0; ; ++s) {
        int u;
        if (F.G == 256) { if (F.bid < 128) { if (s > 0) break; u = F.bid; } else { if (s > 3) break; u = 128 + 4 * (F.bid - 128) + s; } }
        else { u = F.bid + s * F.G; if (u >= 640) break; }
        if (u < 128) { const int sb = u >> 6, h = (u >> 3) & 7, qt = u & 7; const size_t r0 = (size_t)NPROMPT + sb * 1024 + qt * 128;
            attn_unit(F, l, Q + r0 * D, F.KS + (size_t)sb * TKS * D, F.VS + (size_t)sb * TKS * D, TKS, O + r0 * D, h, lam, lam_init); }
        else { const int v = u - 128, b = v >> 4, h = (v >> 1) & 7, qt = v & 1; const size_t r0 = (size_t)b * 256 + qt * 128;
            attn_unit(F, l, Q + r0 * D, KP + (size_t)b * 256 * D, VP + (size_t)b * 256 * D, 256, O + r0 * D, h, lam, lam_init); }
    }
}

__device__ __forceinline__ void phase_ffn_convgate(Frame& F, int l, const bf16* Z, bf16* ACT) {
    F.fresh();
    const float* cw = F.inp(I_FF_CW) + (size_t)l * 3 * 2 * DFF; const float* cb = F.inp(I_FF_CB) + (size_t)l * 2 * DFF;
    const int gt = F.bid * NT + F.tid, GT = F.G * NT;
    for (int i = gt; i < M * DFF; i += GT) { const int row = i / DFF, j = i % DFF;
        int t, T; if (row < NPROMPT) { t = row & 255; T = 256; } else { t = (row - NPROMPT) & 1023; T = 1024; }
        float g = cb[j], u = cb[DFF + j];
#pragma unroll
        for (int k = 0; k < 3; ++k) { const int tt = t + k - 1; if (tt >= 0 && tt < T) { const bf16* zr = Z + (size_t)(row + k - 1) * 2 * DFF; g += cw[k * 2 * DFF + j] * bf2f(zr[j]); u += cw[k * 2 * DFF + DFF + j] * bf2f(zr[DFF + j]); } }
        ACT[i] = (bf16)f2bf(siluf_(g) * u); }
}

__global__ void __launch_bounds__(NT, 2) mk_fwd(Params prm) {
    extern __shared__ __attribute__((aligned(16))) unsigned char lds_raw[];
    Frame F;
    F.lds = (LAS unsigned char*)lds_raw; F.G = gridDim.x; F.out0 = prm.out; F.ws0 = prm.ws; F.wave0 = __builtin_amdgcn_readfirstlane(threadIdx.x >> 6);
    F.fresh();
    if (F.tid < N_IN) ((LAS unsigned long long*)(F.lds + PTR_OFF))[F.tid] = (unsigned long long)prm.in[F.tid];
    volatile LAS unsigned* MISC = (volatile LAS unsigned*)(F.lds + MISC_OFF);
    if (F.tid < 32) MISC[F.tid] = 0u;
    __syncthreads();
    (void)xcd_barrier_post((unsigned*)(prm.ws + WS_CTL) + CW_BAR, MISC + 8, F.tid == 0);
#define GRID_BAR() do { F.fresh(); XcdBarrier bar_; bar_.t0 = F.tid == 0; { unsigned* bp_ = (unsigned*)(prm.ws + WS_CTL) + CW_BAR; asm volatile("" : "+s"(bp_)); bar_.bar = bp_; } bar_.x = xb_xcc_id(); bar_.st = (volatile LAS unsigned*)(F.lds + MISC_OFF) + 8; xcd_barrier(bar_); } while (0)

#define GEMM_BF16(ACT, A_, Bt_, N_, K_, O_, ldc_, bias_, splitc_, splits_, rsq_, b2_, rsqv_, vt0_) do { pg8::Gemm g{A_, Bt_, M, N_, K_}; pg8::StaticOrder S; S.init(M, N_, F.G, F.bid); S.wave = F.wave; \
        pg8::EpiBf16<ACT> E{O_, ldc_, bias_, splitc_, splits_, rsq_, b2_, N_, rsqv_, vt0_, F.lds}; F.fresh(); E.prep(S, F.tid); pg8::gemm_phase<pg8::EpiBf16<ACT>, pg8::StaticOrder, true, true>(F.lds, g, S, E); } while (0)
#define GEMM_RESID(A_, Bt_, K_, sub_, fromin_) do { pg8::Gemm g{A_, Bt_, M, D, K_}; pg8::StaticOrder S; S.init(M, D, F.G, F.bid); S.wave = F.wave; \
        const int nl_ = (sub_) == 0 ? l : l + 1, ns_ = (sub_) == 0 ? 1 : 0; const bool last_ = nl_ >= DEPTH; \
        pg8::EpiResid E{F.out, F.inp(I_XP), F.inp(I_XS), F.mod + (size_t)l * 18 * D, (sub_) * 3 + 2, fromin_, last_ ? nullptr : F.H, F.inp(I_NORMG) + (size_t)((last_ ? 0 : nl_) * 2 + ns_) * D, \
                          F.mod + (size_t)(last_ ? 0 : nl_) * 18 * D, ns_ * 3 + 1, (sub_) == 0 ? F.rsq1 : F.rsq0, F.lds}; \
        F.fresh(); E.prep(S, F.tid); pg8::gemm_phase<pg8::EpiResid, pg8::StaticOrder, true, true>(F.lds, g, S, E); side_job(F, 2 * l + (sub_) + 1); } while (0)

    phase_prologue(F);
    GRID_BAR();
    phase_modulate0(F);
    GRID_BAR();
#pragma unroll 1
    for (int l = 0; l < DEPTH; ++l) {
        const int kind = l % 3, j = l / 3;
        F.fresh();
        if (kind == 0) {
            bf16 *GB = F.T2, *REC = F.T2 + (size_t)M * DRNN, *PF = F.T3, *PB = F.T3 + (size_t)NSAMPLE * DRNN, *HS = F.T3 + (size_t)6 * 1024 * 1024;
            float* AGG = (float*)(F.T3 + (size_t)2 * NSAMPLE * DRNN);
            GEMM_BF16(2, F.H, F.WT + WE_LRU_IN + (size_t)j * 2 * DRNN * D, 2 * DRNN, D, GB, DRNN, nullptr, DRNN, (size_t)M * DRNN, F.rsq0, F.bias2 + B2_LRU + (size_t)j * 3 * 2560, nullptr, 0);
            GRID_BAR();
            phase_lru_core(F, j, REC, GB, HS, PF, PB, AGG, F.WT + WE_WG + (size_t)j * 40 * 128 * 128);
            GRID_BAR();
            phase_lru_fixup(F, GB, HS, PF, PB, AGG);
            GRID_BAR();
            GEMM_RESID(HS, F.WT + WE_LRU_OUT + (size_t)j * D * DRNN, DRNN, 0, l == 0);
        } else if (kind == 1) {
            bf16 *UV = F.T1, *ACT = F.T2;
            GEMM_BF16(1, F.H, F.WT + WE_CM_IN, 2 * DB, D, UV, 2 * DB, F.inp(I_CM_BIN), 0, 0, F.rsq0, F.bias2 + B2_CM, F.rsqv, 8);
            GRID_BAR();
            phase_cmlp_spatial_mfma(F, UV, ACT, F.WT + WE_WSB);
            GRID_BAR();
            GEMM_RESID(ACT, F.WT + WE_CM_OUT, DB, 0, false);
        } else {
            bf16 *Q = F.T2, *KP = F.T2 + (size_t)M * D, *VP = KP + (size_t)NPROMPT * D, *O = F.T3;
            { pg8::Gemm g{F.H, F.WT + WE_QKV, M, 3 * D, D}; pg8::StaticOrder S; S.init(M, 3 * D, F.G, F.bid); S.wave = F.wave;
              pg8::EpiQkv E{F.ws, F.out, F.rsq0, F.bias2 + B2_QKV, F.lds, F.inp(I_AT_QKG), F.rope};
              F.fresh(); E.prep(S, F.tid); pg8::gemm_phase<pg8::EpiQkv, pg8::StaticOrder, true, true>(F.lds, g, S, E); }
            GRID_BAR();
            phase_attn(F, l, Q, KP, VP, O);
            GRID_BAR();
            GEMM_RESID(O, F.WT + WE_AT_OUT, D, 0, false);
        }
        GRID_BAR();
        { pg8::Gemm g{F.H, F.WT + WE_UP + (size_t)l * 2 * DFF * D, 42 * 256, 2 * DFF, D}; pg8::FfnOrder S; S.init(42 * 256, 2 * DFF, F.G, F.bid); S.wave = F.wave;
          pg8::EpiFfn E{F.T2, F.inp(I_FF_CW) + (size_t)l * 3 * 2 * DFF, F.inp(I_FF_CB) + (size_t)l * 2 * DFF, F.rsq1, F.bias2 + B2_UP + (size_t)l * 3 * 5632, F.lds};
          F.fresh(); E.prep(S, F.tid); pg8::gemm_phase<pg8::EpiFfn, pg8::FfnOrder, true, true>(F.lds, g, S, E); }
        GRID_BAR();
        GEMM_RESID(F.T2, F.WT + WE_DN + (size_t)l * D * DFF, DFF, 1, false);
        GRID_BAR();
    }
}

extern "C" void kernel_launch(void* const* d_in, const int* in_sizes, int n_in, void* d_out, int out_size, void* d_ws, size_t ws_size, hipStream_t stream) {
    static int grid = 0;
    if (grid == 0) {
        if (n_in != N_IN || ws_size < WS_END) { fprintf(stderr, "kernel_launch: unexpected n_in %d or ws_size %zu\n", n_in, ws_size); grid = -1; return; }
        int dev = 0, cus = 0, per_cu = 0;
        hipGetDevice(&dev); hipDeviceGetAttribute(&cus, hipDeviceAttributeMultiprocessorCount, dev);
        hipFuncSetAttribute((const void*)mk_fwd, hipFuncAttributeMaxDynamicSharedMemorySize, LDS_BYTES);
        hipOccupancyMaxActiveBlocksPerMultiprocessor(&per_cu, (const void*)mk_fwd, NT, LDS_BYTES);
        (void)hipGetLastError();
        if (per_cu < 1) { fprintf(stderr, "kernel_launch: occupancy query says %d blocks per CU\n", per_cu); per_cu = 1; }
        grid = cus;
    }
    if (grid < 0) return;
    hipMemsetAsync((char*)d_ws + WS_CTL, 0, CTL_ZERO_BYTES, stream);
    Params p{};
    for (int i = 0; i < N_IN; ++i) p.in[i] = (const float*)d_in[i];
    p.out = (float*)d_out; p.ws = (unsigned char*)d_ws;
    void* args[] = {&p};
    hipError_t e = hipLaunchCooperativeKernel((const void*)mk_fwd, dim3(grid), dim3(NT), args, LDS_BYTES, stream);
    if (e != hipSuccess) fprintf(stderr, "kernel_launch: cooperative launch failed: %s (grid %d)\n", hipGetErrorString(e), grid);
}
```

```cpp
#include <hip/hip_runtime.h>
#include <cstdio>
#include <cstdint>

#define GAS __attribute__((address_space(1)))
#define LAS __attribute__((address_space(3)))
typedef unsigned short bf16;
typedef float f32x4 __attribute__((ext_vector_type(4)));
typedef unsigned u32x2 __attribute__((ext_vector_type(2)));
typedef unsigned u32x4 __attribute__((ext_vector_type(4)));

constexpr int D = 1024, NPROMPT = 32 * 256, NSAMPLE = 2 * 1024, M = NPROMPT + NSAMPLE;
constexpr int DEPTH = 4, DRNN = 1280, DB = 2048, DFF = 2816, PAST = 512, TKS = PAST + 1024;
constexpr float EPS = 1e-6f;
constexpr int NWAVES = 8, NT = NWAVES * 64;

enum { I_XP = 0, I_XS, I_STATE, I_CK, I_CV, I_C, I_CCTX, I_WMOD, I_BMOD, I_NORMG, I_LRU_WIN, I_LRU_CW, I_LRU_CB, I_LRU_WG, I_LRU_BG, I_LRU_LAM, I_LRU_WOUT,
       I_CM_WIN, I_CM_BIN, I_CM_NG, I_CM_WS, I_CM_BS, I_CM_WOUT, I_AT_WQKV, I_AT_QKG, I_AT_LAM, I_AT_SUBG, I_AT_WOUT, I_FF_WUP, I_FF_CW, I_FF_CB, I_FF_WDN, N_IN };
constexpr size_t O_YP = 0, O_YS = (size_t)NPROMPT * D, O_STATE = (size_t)M * D, O_CK = O_STATE + 32 * 2 * 2 * DRNN, O_CV = O_CK + (size_t)NPROMPT * D;

constexpr size_t MiB = 1u << 20;
constexpr size_t WS_CTL = 0, CTL_ZERO_BYTES = 64 * 1024;
constexpr size_t WS_MOD = 1 * MiB;
constexpr size_t WS_RSTD = WS_MOD + 512 * 1024;
constexpr size_t WS_ROPE = WS_RSTD + 256 * 1024;
constexpr size_t WS_H = 2 * MiB;
constexpr size_t WS_T1 = 22 * MiB;
constexpr size_t WS_T2 = 132 * MiB;
constexpr size_t WS_T3 = 187 * MiB;
constexpr size_t WS_X = WS_T3 + 40 * MiB;
constexpr size_t B2_LRU = 0, B2_CM = B2_LRU + (size_t)2 * 3 * 2560, B2_QKV = B2_CM + (size_t)3 * 4096, B2_UP = B2_QKV + (size_t)3 * 3072, B2_END = B2_UP + (size_t)4 * 3 * 5632;
constexpr size_t WS_KS = 237 * MiB, WS_VS = 243 * MiB;
constexpr size_t WS_W = 249 * MiB;
constexpr size_t WE_LRU_IN = 0, WE_LRU_OUT = WE_LRU_IN + (size_t)2 * 2560 * 1024, WE_CM_IN = WE_LRU_OUT + (size_t)2 * 1024 * 1280, WE_CM_OUT = WE_CM_IN + (size_t)4096 * 1024,
                 WE_QKV = WE_CM_OUT + (size_t)1024 * 2048, WE_AT_OUT = WE_QKV + (size_t)3072 * 1024, WE_UP = WE_AT_OUT + (size_t)1024 * 1024, WE_DN = WE_UP + (size_t)4 * 5632 * 1024,
                 WE_WG = WE_DN + (size_t)4 * 1024 * 2816, WE_WSB = WE_WG + (size_t)80 * 128 * 128, WE_END = WE_WSB + (size_t)8 * 128 * 128;
constexpr size_t WS_END = WS_W + 106 * MiB;
static_assert(WE_END * 2 <= 106 * MiB, "weight copies fit");
constexpr int CW_BAR = 1024;

constexpr int LDS_BYTES = 163840;
constexpr int MISC_OFF = LDS_BYTES - 256, PTR_OFF = LDS_BYTES - 1024;

__device__ __forceinline__ unsigned f2bf(float f) { unsigned u = __builtin_bit_cast(unsigned, f); return (u + 0x7fffu + ((u >> 16) & 1u)) >> 16; }
__device__ __forceinline__ float bf2f(unsigned b) { return __builtin_bit_cast(float, (b & 0xffffu) << 16); }
template <int CTRL> __device__ __forceinline__ float dppf(float v) { return __builtin_bit_cast(float, __builtin_amdgcn_update_dpp(0, __builtin_bit_cast(int, v), CTRL, 0xf, 0xf, false)); }
__device__ __forceinline__ float swz_xor16(float v) { return __builtin_bit_cast(float, __builtin_amdgcn_ds_swizzle(__builtin_bit_cast(int, v), 0x401F)); }
__device__ __forceinline__ float sum_x32(float v) { auto r = __builtin_amdgcn_permlane32_swap(__builtin_bit_cast(unsigned, v), __builtin_bit_cast(unsigned, v), false, false);
    return __builtin_bit_cast(float, (unsigned)r[0]) + __builtin_bit_cast(float, (unsigned)r[1]); }
__device__ __forceinline__ float max_x32(float v) { auto r = __builtin_amdgcn_permlane32_swap(__builtin_bit_cast(unsigned, v), __builtin_bit_cast(unsigned, v), false, false);
    return fmaxf(__builtin_bit_cast(float, (unsigned)r[0]), __builtin_bit_cast(float, (unsigned)r[1])); }
__device__ __forceinline__ float sum_q4(float v) { v += swz_xor16(v); return sum_x32(v); }
__device__ __forceinline__ float max_q4(float v) { v = fmaxf(v, swz_xor16(v)); return max_x32(v); }
__device__ __forceinline__ float wave_sum(float v) { v += dppf<0xB1>(v); v += dppf<0x4E>(v); v += dppf<0x141>(v); v += dppf<0x140>(v); return sum_q4(v); }
__device__ __forceinline__ float wave_max(float v) { v = fmaxf(v, dppf<0xB1>(v)); v = fmaxf(v, dppf<0x4E>(v)); v = fmaxf(v, dppf<0x141>(v)); v = fmaxf(v, dppf<0x140>(v)); return max_q4(v); }
__device__ __forceinline__ float bperm(float v, int src_lane) { return __builtin_bit_cast(float, __builtin_amdgcn_ds_bpermute(src_lane << 2, __builtin_bit_cast(int, v))); }
__device__ __forceinline__ float gelu_tanh(float x) {
    const float t = x * x * (-0.102943174f) + (-2.302208198f);
    return x * __builtin_amdgcn_rcpf(1.f + __builtin_amdgcn_exp2f(t * x)); }
__device__ __forceinline__ float sigmoidf_(float x) { return __builtin_amdgcn_rcpf(1.f + __builtin_amdgcn_exp2f(-1.44269504f * x)); }
__device__ __forceinline__ float siluf_(float x) { return x * __builtin_amdgcn_rcpf(1.f + __builtin_amdgcn_exp2f(-1.44269504f * x)); }
__device__ __forceinline__ float softplusf_(float x) { return fmaxf(x, 0.f) + log1pf(expf(-fabsf(x))); }

#define XB_TMO      128
#define XB_XCNT(j)  (256  + 64 * (j))
#define XB_XSUB(j)  (1280 + 64 * (j))
#define XB_XGEN(j)  (2304 + 64 * (j))
#define XB_TOP      3328
#define XB_TOPGEN   3392
#define XCD_BAR_WORDS 3456
#define XB_SPIN_CAP (1u << 22)
__device__ __forceinline__ unsigned xb_ld(unsigned* p)              { return __hip_atomic_load(p, __ATOMIC_RELAXED, __HIP_MEMORY_SCOPE_AGENT); }
__device__ __forceinline__ unsigned xb_add(unsigned* p, unsigned v) { return __hip_atomic_fetch_add(p, v, __ATOMIC_RELAXED, __HIP_MEMORY_SCOPE_AGENT); }
__device__ __forceinline__ unsigned xb_xcc_id() { return (unsigned)__builtin_amdgcn_s_getreg((3 << 11) | 20) & 0xFu; }
#define XB_SPIN(cond, bar) do { unsigned _sp = 0; while (cond) { __builtin_amdgcn_s_sleep(1); \
    if ((++_sp & 255u) == 0u) { if (xb_ld(&(bar)[XB_TMO])) break; if (_sp > XB_SPIN_CAP) { atomicAdd(&(bar)[XB_TMO], 1u); break; } } } } while (0)
struct XcdBarrier { unsigned* bar; unsigned x; volatile LAS unsigned* st; bool t0; };
__device__ __forceinline__ XcdBarrier xcd_barrier_post(unsigned* bar, volatile LAS unsigned* st, bool t0) {
    XcdBarrier b; b.bar = bar; b.x = xb_xcc_id(); b.st = st; b.t0 = t0;
    if (t0) (void)xb_add(&bar[XB_XCNT(b.x)], 1u);
    return b;
}
__device__ __forceinline__ void xcd_barrier_complete(unsigned* bar, unsigned x, unsigned& nloc, unsigned& nx) {
    const unsigned G = gridDim.x * gridDim.y * gridDim.z;
    unsigned sum, cnt, mine, sp = 0u;
    for (;;) {
        sum = 0u; cnt = 0u; mine = 0u;
#pragma unroll
        for (unsigned j = 0; j < 16; ++j) { const unsigned c = xb_ld(&bar[XB_XCNT(j)]); sum += c; cnt += (c > 0u) ? 1u : 0u; mine = (j == x) ? c : mine; }
        if (sum == G) break;
        __builtin_amdgcn_s_sleep(1);
        if ((++sp & 255u) == 0u) { if (xb_ld(&bar[XB_TMO])) break; if (sp > XB_SPIN_CAP) { atomicAdd(&bar[XB_TMO], 1u); break; } }
    }
    nloc = mine > 0u ? mine : 1u; nx = cnt > 0u ? cnt : 1u;
}
__device__ __forceinline__ void xcd_barrier(const XcdBarrier& b) {
    asm volatile("s_waitcnt vmcnt(0)" ::: "memory");
    __syncthreads();
    if (b.t0) {
        unsigned* bar = b.bar;
        __builtin_amdgcn_s_waitcnt(0);
        unsigned nloc = b.st[0], nx = b.st[1];
        if (nloc == 0u) { xcd_barrier_complete(bar, b.x, nloc, nx); b.st[0] = nloc; b.st[1] = nx; }
        const unsigned old = xb_add(&bar[XB_XSUB(b.x)], 1u);
        const unsigned gen = old / nloc;
        if (old + 1u == (gen + 1u) * nloc) {
            __builtin_amdgcn_fence(__ATOMIC_RELEASE, "agent");
            asm volatile("s_waitcnt vmcnt(0)" ::: "memory");
            const unsigned og = xb_add(&bar[XB_TOP], 1u);
            const unsigned tg = og / nx;
            if (og + 1u == (tg + 1u) * nx) xb_add(&bar[XB_TOPGEN], 1u);
            else XB_SPIN(xb_ld(&bar[XB_TOPGEN]) == tg, bar);
            __builtin_amdgcn_fence(__ATOMIC_ACQUIRE, "agent");
            xb_add(&bar[XB_XGEN(b.x)], 1u);
            asm volatile("s_waitcnt vmcnt(0)" ::: "memory");
        } else {
            XB_SPIN(xb_ld(&bar[XB_XGEN(b.x)]) == gen, bar);
            __builtin_amdgcn_fence(__ATOMIC_ACQUIRE, "agent");
            asm volatile("s_waitcnt vmcnt(0)" ::: "memory");
        }
    }
    __syncthreads();
}

namespace pg8 {
#define PG8_LAS __attribute__((address_space(3)))
typedef unsigned short bf16_t;
typedef short bf16x8 __attribute__((ext_vector_type(8)));
typedef float f32x4 __attribute__((ext_vector_type(4)));
typedef unsigned u32x4 __attribute__((ext_vector_type(4)));
constexpr int BM = 256, BK = 64, HALF = 128, HTB = HALF * BK * 2  , STAGE_BYTES = 8 * HTB, NXCD = 8, WGM = 8;

__host__ __device__ __forceinline__ int lds_byte(int r, int c) { const int st = (r >> 4) * 2 + (c >> 5), rr = r & 15, cc = c & 31, ob = rr * 64 + cc * 2; return st * 1024 + (ob ^ (((ob >> 9) & 1) << 5)); }
__host__ __device__ __forceinline__ void stage_rc(int b, int& R, int& C) { const int st = b / 1024, sb = b % 1024, swz = sb ^ (((sb >> 9) & 1) << 5); R = (st >> 1) * 16 + swz / 64; C = (st & 1) * 32 + (swz % 64) / 2; }
__host__ __device__ __forceinline__ int perm32(int rho) { const int n = rho >> 4, i = rho & 15; return 8 * (i >> 2) + 4 * n + (i & 3); }

struct Unit { int pm, pn; };
struct Gemm { const bf16_t* A; const bf16_t* Bt; int M, N, K; };

struct StaticOrder {
    int nM, nN, nwg, G, c, wave;
    __host__ __device__ void init(int M, int N, int G_, int c_) { nM = M / BM; nN = N / BM; nwg = nM * nN; G = G_; c = c_; }
    __host__ __device__ bool next(int i, Unit& u) const {
        const long L = (long)i * G + c; if (L >= nwg) return false;
        int wgid = (int)L; { const int q = nwg / NXCD, r = nwg % NXCD, xcd = wgid % NXCD, off = wgid / NXCD; wgid = (xcd < r ? xcd * (q + 1) : r * (q + 1) + (xcd - r) * q) + off; }
        const int nig = WGM * nN, gid = wgid / nig, fm = gid * WGM, gsz = (nM - fm) < WGM ? (nM - fm) : WGM;
        u.pm = fm + ((wgid % nig) % gsz); u.pn = (wgid % nig) / gsz; return true;
    }
    __device__ __forceinline__ int arow(int pm) const { return pm * BM; }
    __device__ __forceinline__ void a_ready(const Unit&) const {}
    __device__ __forceinline__ void done(const Unit&) const {}
};

template <class Epi, class Sched, bool ALIGN_EPI = false, bool SP2 = false>
__device__ __forceinline__ void gemm_phase(PG8_LAS unsigned char* lds, const Gemm g, const Sched& S, const Epi& E) {
    int z_ = 0; asm volatile("" : "+v"(z_));
    const int lane = __builtin_amdgcn_mbcnt_hi(~0u, __builtin_amdgcn_mbcnt_lo(~0u, z_)), wid = S.wave, tid = wid * 64 + lane, wr = wid >> 2, wc = wid & 3, fr = lane & 15, fq = lane >> 4;
    const int K = g.K, nt = K / BK;
    unsigned voffA[2], voffB[2];
#pragma unroll
    for (int i = 0; i < 2; ++i) { int R, C; stage_rc(tid * 16 + i * 8192, R, C); const int Rb = Epi::PERM ? ((R & ~31) + perm32(R & 31)) : R;
        voffA[i] = (unsigned)(R * K + C) * 2u; voffB[i] = (unsigned)(Rb * K + C) * 2u; }
    const size_t kstep = (size_t)(BK * 2);
    const size_t hstep = (size_t)HALF * K * 2;
    const size_t tstep = 2 * hstep;
    const unsigned ldsw = (unsigned)wid * 1024u;
    const int aoff = lds_byte(wr * 64 + fr, fq * 8), boff = lds_byte(wc * 32 + fr, fq * 8);
#define PG8_SA(b, h) (((b) * 2 + (h)) * HTB)
#define PG8_SB(b, h) ((4 + (b) * 2 + (h)) * HTB)
#define PG8_STAGE(bufoff, gbase, voff) do { _Pragma("unroll") for (int _i = 0; _i < 2; ++_i) \
        __builtin_amdgcn_global_load_lds((const unsigned*)((const char*)(gbase) + (voff)[_i]), (PG8_LAS unsigned*)(lds + (bufoff) + ldsw + _i * 8192), 16, 0, 0); } while (0)
#define PG8_LDA(dst, b, h) do { _Pragma("unroll") for (int m = 0; m < 4; ++m) _Pragma("unroll") for (int k = 0; k < 2; ++k) dst[m][k] = *(const PG8_LAS bf16x8*)(lds + PG8_SA(b, h) + aoff + m * 2048 + k * 1024); } while (0)
#define PG8_LDB(dst, b, h) do { _Pragma("unroll") for (int n = 0; n < 2; ++n) _Pragma("unroll") for (int k = 0; k < 2; ++k) dst[n][k] = *(const PG8_LAS bf16x8*)(lds + PG8_SB(b, h) + boff + n * 2048 + k * 1024); } while (0)
#define PG8_MMA(ai, bj, At, Bt) do { __builtin_amdgcn_s_setprio(1); _Pragma("unroll") for (int m = 0; m < 4; ++m) _Pragma("unroll") for (int n = 0; n < 2; ++n) _Pragma("unroll") for (int k = 0; k < 2; ++k) \
        acc[ai][bj][m][n] = __builtin_amdgcn_mfma_f32_16x16x32_bf16(Bt[n][k], At[m][k], acc[ai][bj][m][n], 0, 0, 0); __builtin_amdgcn_s_setprio(0); } while (0)
#define PG8_WAIT_V(n) asm volatile("s_waitcnt vmcnt(" #n ")" ::: "memory")
#define PG8_WAIT_L(n) asm volatile("s_waitcnt lgkmcnt(" #n ")" ::: "memory")
#define PG8_BAR __builtin_amdgcn_s_barrier()
#define PG8_SCHED __builtin_amdgcn_sched_barrier(0)
    Unit cur, nxt; int ui = 0;
    if (!S.next(0, cur)) return;
    f32x4 acc[2][2][4][2];
#pragma unroll
    for (int a = 0; a < 2; ++a)
#pragma unroll
        for (int b = 0; b < 2; ++b)
#pragma unroll
            for (int m = 0; m < 4; ++m)
#pragma unroll
                for (int n = 0; n < 2; ++n) acc[a][b][m][n] = (f32x4){0.f, 0.f, 0.f, 0.f};
    bf16x8 At[4][2], B0[2][2], B1[2][2];
    const char* cA = (const char*)g.A + (size_t)S.arow(cur.pm) * (size_t)K * 2; const char* cB = (const char*)g.Bt + (size_t)cur.pn * tstep;
    S.a_ready(cur);
    if constexpr (SP2) {
        PG8_STAGE(PG8_SB(0, 0), cB, voffB); PG8_STAGE(PG8_SB(0, 1), cB + hstep, voffB); PG8_STAGE(PG8_SA(0, 0), cA, voffA); PG8_STAGE(PG8_SA(0, 1), cA + hstep, voffA);
        if (wr == 1) PG8_BAR;
        PG8_WAIT_V(2); PG8_BAR;
        PG8_STAGE(PG8_SB(1, 0), cB + kstep, voffB); PG8_STAGE(PG8_SA(1, 0), cA + kstep, voffA); PG8_STAGE(PG8_SB(1, 1), cB + hstep + kstep, voffB);
        PG8_WAIT_V(6); PG8_BAR;
    } else {
        PG8_STAGE(PG8_SB(0, 0), cB, voffB); PG8_STAGE(PG8_SA(0, 0), cA, voffA); PG8_STAGE(PG8_SB(0, 1), cB + hstep, voffB); PG8_STAGE(PG8_SA(0, 1), cA + hstep, voffA);
        if (wr == 1) PG8_BAR;
        PG8_WAIT_V(4); PG8_BAR;
        PG8_STAGE(PG8_SB(1, 0), cB + kstep, voffB); PG8_STAGE(PG8_SA(1, 0), cA + kstep, voffA); PG8_STAGE(PG8_SB(1, 1), cB + hstep + kstep, voffB);
        PG8_WAIT_V(6); PG8_BAR;
    }
    for (;;) {
        const bool has_next = S.next(ui + 1, nxt);
        const char* nA = has_next ? (const char*)g.A + (size_t)S.arow(nxt.pm) * (size_t)K * 2 : cA; const char* nB = has_next ? (const char*)g.Bt + (size_t)nxt.pn * tstep : cB;
        for (int t = 0; t < nt; t += 2) {
            const bool last = (t == nt - 2);
            const char* a1 = cA + (size_t)(t + 1) * kstep;
            const char* a2 = last ? nA : cA + (size_t)(t + 2) * kstep; const char* b2 = last ? nB : cB + (size_t)(t + 2) * kstep;
            const char* a3 = a2 + kstep; const char* b3 = b2 + kstep;
            if (last && has_next) S.a_ready(nxt);
            if constexpr (SP2) {
            PG8_LDB(B0, 0, 0); PG8_LDB(B1, 0, 1); PG8_SCHED; PG8_LDA(At, 0, 0); PG8_STAGE(PG8_SA(1, 1), a1 + hstep, voffA);
            PG8_WAIT_V(8); PG8_WAIT_L(0); PG8_BAR; PG8_MMA(0, 0, At, B0); PG8_MMA(0, 1, At, B1); PG8_BAR; PG8_SCHED;
            PG8_LDA(At, 0, 1); PG8_STAGE(PG8_SB(0, 0), b2, voffB); PG8_STAGE(PG8_SB(0, 1), b2 + hstep, voffB); PG8_STAGE(PG8_SA(0, 0), a2, voffA);
            PG8_WAIT_V(8); PG8_WAIT_L(0); PG8_BAR; PG8_MMA(1, 0, At, B0); PG8_MMA(1, 1, At, B1); PG8_BAR; PG8_SCHED;
            PG8_LDB(B0, 1, 0); PG8_LDB(B1, 1, 1); PG8_SCHED; PG8_LDA(At, 1, 0); PG8_STAGE(PG8_SA(0, 1), a2 + hstep, voffA);
            PG8_WAIT_V(8); PG8_WAIT_L(0); PG8_BAR; PG8_MMA(0, 0, At, B0); PG8_MMA(0, 1, At, B1); PG8_BAR; PG8_SCHED;
            PG8_LDA(At, 1, 1); PG8_STAGE(PG8_SB(1, 0), b3, voffB); PG8_STAGE(PG8_SB(1, 1), b3 + hstep, voffB); PG8_STAGE(PG8_SA(1, 0), a3, voffA);
            PG8_WAIT_V(8); PG8_WAIT_L(0); PG8_BAR; PG8_MMA(1, 0, At, B0); PG8_MMA(1, 1, At, B1); PG8_BAR; PG8_SCHED;
            } else {
            PG8_LDB(B0, 0, 0); PG8_SCHED; PG8_LDA(At, 0, 0); PG8_STAGE(PG8_SA(1, 1), a1 + hstep, voffA);
            PG8_WAIT_L(8); PG8_BAR; PG8_WAIT_L(0); PG8_MMA(0, 0, At, B0); PG8_BAR; PG8_SCHED;
            PG8_LDB(B1, 0, 1); PG8_STAGE(PG8_SB(0, 0), b2, voffB);
            PG8_BAR; PG8_WAIT_L(0); PG8_MMA(0, 1, At, B1); PG8_BAR;
            PG8_LDA(At, 0, 1); PG8_STAGE(PG8_SA(0, 0), a2, voffA);
            PG8_BAR; PG8_WAIT_L(0); PG8_MMA(1, 0, At, B0); PG8_BAR; PG8_SCHED;
            PG8_STAGE(PG8_SB(0, 1), b2 + hstep, voffB);
            PG8_WAIT_V(6); PG8_BAR; PG8_MMA(1, 1, At, B1); PG8_BAR;
            PG8_LDB(B0, 1, 0); PG8_SCHED; PG8_LDA(At, 1, 0); PG8_STAGE(PG8_SA(0, 1), a2 + hstep, voffA);
            PG8_WAIT_L(8); PG8_BAR; PG8_WAIT_L(0); PG8_MMA(0, 0, At, B0); PG8_BAR; PG8_SCHED;
            PG8_LDB(B1, 1, 1); PG8_STAGE(PG8_SB(1, 0), b3, voffB);
            PG8_BAR; PG8_WAIT_L(0); PG8_MMA(0, 1, At, B1); PG8_BAR;
            PG8_LDA(At, 1, 1); PG8_STAGE(PG8_SA(1, 0), a3, voffA);
            PG8_BAR; PG8_WAIT_L(0); PG8_MMA(1, 0, At, B0); PG8_BAR; PG8_SCHED;
            PG8_STAGE(PG8_SB(1, 1), b3 + hstep, voffB);
            PG8_WAIT_V(6); PG8_BAR; PG8_MMA(1, 1, At, B1); PG8_BAR;
            }
        }
        if constexpr (ALIGN_EPI) { if (wr == 0) PG8_BAR; }
        if constexpr (!Epi::AFTER_DRAIN) { E(acc, cur, ui, wr, wc, fr, fq); S.done(cur); }
        if (!has_next) break;
#pragma unroll
        for (int a = 0; a < 2; ++a)
#pragma unroll
            for (int b = 0; b < 2; ++b)
#pragma unroll
                for (int m = 0; m < 4; ++m)
#pragma unroll
                    for (int n = 0; n < 2; ++n) acc[a][b][m][n] = (f32x4){0.f, 0.f, 0.f, 0.f};
        cur = nxt; cA = nA; cB = nB; ++ui;
        if constexpr (ALIGN_EPI) { if (wr == 1) PG8_BAR; }
    }
    PG8_WAIT_V(0);
    if constexpr (!ALIGN_EPI) { if (wr == 0) PG8_BAR; }
    PG8_BAR;
    if constexpr (Epi::AFTER_DRAIN) { E.fused(acc, cur, wr, wc, fr, fq, lds, wid, lane); S.done(cur); }
#undef PG8_SA
#undef PG8_SB
#undef PG8_STAGE
#undef PG8_LDA
#undef PG8_LDB
#undef PG8_MMA
#undef PG8_WAIT_V
#undef PG8_WAIT_L
#undef PG8_BAR
#undef PG8_SCHED
}
}

namespace pg8 {
__device__ __forceinline__ unsigned cvt_pk_bf16(float lo, float hi) { unsigned r; asm volatile("v_cvt_pk_bf16_f32 %0, %1, %2" : "=v"(r) : "v"(lo), "v"(hi)); return r; }
__device__ __forceinline__ f32x4 gelu4(f32x4 v) { f32x4 o; o.x = gelu_tanh(v.x); o.y = gelu_tanh(v.y); o.z = gelu_tanh(v.z); o.w = gelu_tanh(v.w); return o; }
constexpr int ETAB_OFF = 131072 + 8192, ETAB_SLOT = 4608, ETAB_MAXU = 4;
__device__ __forceinline__ float row_rstd(const float* rsq, int row) {
    const GAS f32x4* p = (const GAS f32x4*)(rsq + (size_t)row * 16);
    const f32x4 a = p[0], b = p[1], c = p[2], d = p[3];
    const float s = ((a.x + a.y) + (a.z + a.w)) + ((b.x + b.y) + (b.z + b.w)) + ((c.x + c.y) + (c.z + c.w)) + ((d.x + d.y) + (d.z + d.w));
    return rsqrtf(s * (1.f / D) + EPS);
}
__device__ __forceinline__ int tile_cidx(int trow) { return trow < NPROMPT ? 0 : 1 + ((trow - NPROMPT) >> 10); }
__device__ __forceinline__ PG8_LAS float* etab(PG8_LAS unsigned char* lds, int ui) { return (PG8_LAS float*)(lds + ETAB_OFF + ui * ETAB_SLOT); }

template <int ACT> struct EpiBf16 {
    static constexpr bool PERM = true, AFTER_DRAIN = false;
    bf16_t* O; int ldc; const float* bias; int split_cols; size_t split_stride; const float* rsq; const float* b2; int N; float* rsqv; int vt0; PG8_LAS unsigned char* lds;
    template <class Sched> __device__ __forceinline__ void prep(const Sched& S, int tid) const {
        Unit u;
        for (int i = 0; i < ETAB_MAXU && S.next(i, u); ++i) { PG8_LAS float* t = etab(lds, i);
            if (tid < 256) t[tid] = row_rstd(rsq, S.arow(u.pm) + tid);
            else { const int c = tid - 256, col = u.pn * BM + c; float v = b2[(size_t)tile_cidx(S.arow(u.pm)) * N + col]; if (bias) v += bias[col]; t[256 + c] = v; } }
        __syncthreads();
    }
    __device__ __forceinline__ void operator()(f32x4 (&acc)[2][2][4][2], const Unit& u, int ui, int wr, int wc, int fr, int fq) const {
        asm volatile("" : "+v"(fr), "+v"(fq));
        PG8_LAS const float* tb = etab(lds, ui);
        const int lrow0 = wr * 64 + fr; int colt = u.pn * BM; bf16_t* base = O; int t = 0;
        if (split_cols) { t = colt / split_cols; base += (size_t)t * split_stride; colt -= t * split_cols; }
        const bool act = (ACT == 1) || (ACT == 2 && t == 0);
        const int col0 = colt + wc * 32 + 8 * fq, tc0 = wc * 32 + 8 * fq;
        const bool wantv = ACT == 1 && rsqv != nullptr && u.pn >= vt0;
        GAS unsigned char* ob = (GAS unsigned char*)base;
        float ss[8];
#pragma unroll
        for (int i = 0; i < 8; ++i) ss[i] = 0.f;
#pragma unroll
        for (int bj = 0; bj < 2; ++bj) { const f32x4 bv0 = *(PG8_LAS const f32x4*)(tb + 256 + tc0 + bj * HALF), bv1 = *(PG8_LAS const f32x4*)(tb + 256 + tc0 + bj * HALF + 4);
#pragma unroll
            for (int ai = 0; ai < 2; ++ai)
#pragma unroll
                for (int m = 0; m < 4; ++m) { const int lrow = lrow0 + ai * HALF + m * 16; const float rs = tb[lrow];
                    f32x4 v0 = acc[ai][bj][m][0] * rs + bv0, v1 = acc[ai][bj][m][1] * rs + bv1;
                    if (ACT != 0) { if (act) { v0 = gelu4(v0); v1 = gelu4(v1); } }
                    if (ACT == 1) ss[ai * 4 + m] += (v0[0] * v0[0] + v0[1] * v0[1]) + (v0[2] * v0[2] + v0[3] * v0[3]) + (v1[0] * v1[0] + v1[1] * v1[1]) + (v1[2] * v1[2] + v1[3] * v1[3]);
                    u32x4 w; w.x = cvt_pk_bf16(v0[0], v0[1]); w.y = cvt_pk_bf16(v0[2], v0[3]); w.z = cvt_pk_bf16(v1[0], v1[1]); w.w = cvt_pk_bf16(v1[2], v1[3]);
                    *(GAS u32x4*)(ob + ((unsigned)(u.pm * BM + lrow) * (unsigned)ldc + col0 + bj * HALF) * 2u) = w;
                    __builtin_amdgcn_sched_barrier(0); } }
        if (wantv) {
#pragma unroll
            for (int i = 0; i < 8; ++i) { const float q = sum_q4(ss[i]);
                if (fq == 0) *(GAS float*)(rsqv + (size_t)(u.pm * BM + lrow0 + (i >> 2) * HALF + (i & 3) * 16) * 32 + (u.pn - vt0) * 4 + wc) = q; } }
    }
};
struct EpiResid {
    static constexpr bool PERM = true, AFTER_DRAIN = false;
    float* out; const float* xp; const float* xs; const float* modl; int which; bool from_input;
    bf16_t* H; const float* ng; const float* modn; int whichs; float* rsq_out; PG8_LAS unsigned char* lds;
    template <class Sched> __device__ __forceinline__ void prep(const Sched& S, int tid) const {
        Unit u;
        for (int i = 0; i < ETAB_MAXU && S.next(i, u); ++i) { PG8_LAS float* t = etab(lds, i);
            if (tid < 256) { const int ci = tile_cidx(u.pm * BM), col = u.pn * BM + tid; t[256 + tid] = modl[(size_t)(ci * 6 + which) * D + col];
                t[512 + tid] = H ? ng[col] * (1.f + modn[(size_t)(ci * 6 + whichs) * D + col]) : 0.f; } }
        __syncthreads();
    }
    __device__ __forceinline__ void operator()(f32x4 (&acc)[2][2][4][2], const Unit& u, int ui, int wr, int wc, int fr, int fq) const {
        asm volatile("" : "+v"(fr), "+v"(fq));
        PG8_LAS const float* tb = etab(lds, ui);
        const int trow = u.pm * BM, row0 = wr * 64 + fr, tc0 = wc * 32 + 8 * fq, col0 = u.pn * BM + tc0;
        const GAS unsigned char* bpg = (const GAS unsigned char*)(from_input ? (trow < NPROMPT ? xp + (size_t)trow * D : xs + (size_t)(trow - NPROMPT) * D) : out + (size_t)trow * D);
        GAS unsigned char* op = (GAS unsigned char*)(out + (size_t)trow * D); GAS unsigned char* hb = (GAS unsigned char*)H;
#pragma unroll
        for (int ai = 0; ai < 2; ++ai) {
            f32x4 x[2][4][2];
#pragma unroll
            for (int bj = 0; bj < 2; ++bj)
#pragma unroll
                for (int m = 0; m < 4; ++m)
#pragma unroll
                    for (int n = 0; n < 2; ++n) x[bj][m][n] = *(const GAS f32x4*)(bpg + ((unsigned)(row0 + ai * HALF + m * 16) * (unsigned)D + col0 + bj * HALF + 4 * n) * 4u);
            float ss[4] = {0.f, 0.f, 0.f, 0.f};
#pragma unroll
            for (int bj = 0; bj < 2; ++bj) { const f32x4 gv0 = *(PG8_LAS const f32x4*)(tb + 256 + tc0 + bj * HALF), gv1 = *(PG8_LAS const f32x4*)(tb + 256 + tc0 + bj * HALF + 4);
                const f32x4 gs0 = *(PG8_LAS const f32x4*)(tb + 512 + tc0 + bj * HALF), gs1 = *(PG8_LAS const f32x4*)(tb + 512 + tc0 + bj * HALF + 4);
#pragma unroll
                for (int m = 0; m < 4; ++m) { const unsigned lrow = row0 + ai * HALF + m * 16, eo = lrow * (unsigned)D + col0 + bj * HALF;
                    const f32x4 x0 = x[bj][m][0] + gv0 * acc[ai][bj][m][0], x1 = x[bj][m][1] + gv1 * acc[ai][bj][m][1];
                    *(GAS f32x4*)(op + eo * 4u) = x0; *(GAS f32x4*)(op + eo * 4u + 16) = x1;
                    if (H) { ss[m] += (x0[0] * x0[0] + x0[1] * x0[1]) + (x0[2] * x0[2] + x0[3] * x0[3]) + (x1[0] * x1[0] + x1[1] * x1[1]) + (x1[2] * x1[2] + x1[3] * x1[3]);
                        const f32x4 a0 = x0 * gs0, a1 = x1 * gs1;
                        u32x4 w; w.x = cvt_pk_bf16(a0[0], a0[1]); w.y = cvt_pk_bf16(a0[2], a0[3]); w.z = cvt_pk_bf16(a1[0], a1[1]); w.w = cvt_pk_bf16(a1[2], a1[3]);
                        *(GAS u32x4*)(hb + ((unsigned)trow * (unsigned)D + eo) * 2u) = w; } } }
            if (H) {
#pragma unroll
                for (int m = 0; m < 4; ++m) { const float q = sum_q4(ss[m]);
                    if (fq == 0) *(GAS float*)(rsq_out + (size_t)(trow + row0 + ai * HALF + m * 16) * 16 + u.pn * 4 + wc) = q; } }
            asm volatile("" ::: "memory");
        }
    }
};

__device__ __forceinline__ void ffn_tile_geom(int pm, int& rs, int& vlo, int& vhi) {
    if (pm < 32) { rs = 256 * pm; vlo = 0; vhi = 255; }
    else { const int sq = (pm - 32) / 5, i = (pm - 32) % 5; rs = NPROMPT + 1024 * sq + (i < 4 ? 254 * i : 768); vlo = i == 0 ? 0 : (i < 4 ? 1 : 249); vhi = i < 4 ? 254 : 255; }
}
struct FfnOrder : StaticOrder {
    __device__ __forceinline__ int arow(int pm) const { int rs, a, b; ffn_tile_geom(pm, rs, a, b); return rs; }
};
template <int CTRL> __device__ __forceinline__ float dpp0(float v) { return __builtin_bit_cast(float, __builtin_amdgcn_update_dpp(0, __builtin_bit_cast(int, v), CTRL, 0xf, 0xf, true)); }
struct EpiFfn {
    static constexpr bool PERM = true, AFTER_DRAIN = false;
    bf16_t* ACT; const float* cw; const float* cb; const float* rsq; const float* b2; PG8_LAS unsigned char* lds;
    template <class Sched> __device__ __forceinline__ void prep(const Sched& S, int tid) const {
        Unit u;
        for (int i = 0; i < ETAB_MAXU && S.next(i, u); ++i) { PG8_LAS float* t = etab(lds, i); const int rs = S.arow(u.pm);
            if (tid < 256) t[tid] = row_rstd(rsq, rs + tid);
            else { const int c = tid - 256, ch = (c < 128 ? 0 : DFF) + u.pn * 128 + (c & 127);
                t[256 + c] = b2[(size_t)tile_cidx(rs) * 2 * DFF + u.pn * 256 + c]; t[512 + c] = cb[ch];
                PG8_LAS unsigned short* tw = (PG8_LAS unsigned short*)(t + 768);
#pragma unroll
                for (int k = 0; k < 3; ++k) tw[k * 256 + c] = (unsigned short)f2bf(cw[(size_t)k * 2 * DFF + ch]); } }
        __syncthreads();
    }
    __device__ __forceinline__ void operator()(f32x4 (&acc)[2][2][4][2], const Unit& u, int ui, int wr, int wc, int fr, int fq) const {
        asm volatile("" : "+v"(fr), "+v"(fq));
        PG8_LAS const float* tb = etab(lds, ui); PG8_LAS float* xb = (PG8_LAS float*)(lds + 131072);
        int rs, vlo, vhi; ffn_tile_geom(u.pm, rs, vlo, vhi);
        const int colw = wc * 32 + 8 * fq;
#pragma unroll
        for (int bj = 0; bj < 2; ++bj) { const f32x4 bz0 = *(PG8_LAS const f32x4*)(tb + 256 + bj * 128 + colw), bz1 = *(PG8_LAS const f32x4*)(tb + 256 + bj * 128 + colw + 4);
#pragma unroll
            for (int ai = 0; ai < 2; ++ai)
#pragma unroll
                for (int m = 0; m < 4; ++m) { const float rsd = tb[128 * ai + 64 * wr + 16 * m + fr];
                    acc[ai][bj][m][0] = acc[ai][bj][m][0] * rsd + bz0; acc[ai][bj][m][1] = acc[ai][bj][m][1] * rsd + bz1; } }
#pragma unroll
        for (int ai = 0; ai < 2; ++ai) { const int b = 2 * ai + wr;
            if (fr == 0) {
#pragma unroll
                for (int bj = 0; bj < 2; ++bj)
#pragma unroll
                    for (int n = 0; n < 2; ++n) *(PG8_LAS f32x4*)(xb + (b * 2 + 0) * 256 + bj * 128 + colw + 4 * n) = acc[ai][bj][0][n]; }
            if (fr == 15) {
#pragma unroll
                for (int bj = 0; bj < 2; ++bj)
#pragma unroll
                    for (int n = 0; n < 2; ++n) *(PG8_LAS f32x4*)(xb + (b * 2 + 1) * 256 + bj * 128 + colw + 4 * n) = acc[ai][bj][3][n]; } }
        asm volatile("s_waitcnt lgkmcnt(0)" ::: "memory"); __builtin_amdgcn_s_barrier(); asm volatile("" ::: "memory");
        GAS unsigned char* actb = (GAS unsigned char*)ACT;
        const unsigned lane_off = (unsigned)((rs + 64 * wr + fr) * DFF + u.pn * 128 + colw) * 2u;
        PG8_LAS const unsigned short* tw = (PG8_LAS const unsigned short*)(tb + 768);
#pragma unroll
        for (int n = 0; n < 2; ++n) {
            f32x4 wg[3], wu[3];
#pragma unroll
            for (int k = 0; k < 3; ++k) { const u32x2 pg = *(PG8_LAS const u32x2*)(tw + k * 256 + colw + 4 * n), pu = *(PG8_LAS const u32x2*)(tw + k * 256 + 128 + colw + 4 * n);
                wg[k] = (f32x4){__builtin_bit_cast(float, pg.x << 16), __builtin_bit_cast(float, pg.x & 0xffff0000u), __builtin_bit_cast(float, pg.y << 16), __builtin_bit_cast(float, pg.y & 0xffff0000u)};
                wu[k] = (f32x4){__builtin_bit_cast(float, pu.x << 16), __builtin_bit_cast(float, pu.x & 0xffff0000u), __builtin_bit_cast(float, pu.y << 16), __builtin_bit_cast(float, pu.y & 0xffff0000u)}; }
            const f32x4 bgv = *(PG8_LAS const f32x4*)(tb + 512 + colw + 4 * n), buv = *(PG8_LAS const f32x4*)(tb + 512 + 128 + colw + 4 * n);
#pragma unroll
            for (int ai = 0; ai < 2; ++ai) { const int b = 2 * ai + wr;
                f32x4 pz[2], nz[2];
#pragma unroll
                for (int bj = 0; bj < 2; ++bj) { pz[bj] = b > 0 ? *(PG8_LAS const f32x4*)(xb + ((b - 1) * 2 + 1) * 256 + bj * 128 + colw + 4 * n) : (f32x4){0.f, 0.f, 0.f, 0.f};
                                                 nz[bj] = b < 3 ? *(PG8_LAS const f32x4*)(xb + ((b + 1) * 2 + 0) * 256 + bj * 128 + colw + 4 * n) : (f32x4){0.f, 0.f, 0.f, 0.f}; }
#pragma unroll
                for (int m = 0; m < 4; ++m) { f32x4 zc[2];
#pragma unroll
                    for (int bj = 0; bj < 2; ++bj) { const f32x4 z = acc[ai][bj][m][n]; const f32x4* w3 = bj == 0 ? wg : wu; f32x4 o = bj == 0 ? bgv : buv;
#pragma unroll
                        for (int e = 0; e < 4; ++e) { float a = fmaf(w3[1][e], z[e], o[e]);
                            const float w0e = fr == 0 ? w3[0][e] : 0.f, w2e = fr == 15 ? w3[2][e] : 0.f;
                            asm("v_fmac_f32_dpp %0, %1, %2 row_shr:1 row_mask:0xf bank_mask:0xf bound_ctrl:1" : "+v"(a) : "v"(z[e]), "v"(w3[0][e]));
                            asm("v_fmac_f32_dpp %0, %1, %2 row_shl:1 row_mask:0xf bank_mask:0xf bound_ctrl:1" : "+v"(a) : "v"(z[e]), "v"(w3[2][e]));
                            if (m > 0) { const float zp = acc[ai][bj][m - 1][n][e]; asm("v_fmac_f32_dpp %0, %1, %2 row_ror:1 row_mask:0xf bank_mask:0xf bound_ctrl:1" : "+v"(a) : "v"(zp), "v"(w0e)); } else a = fmaf(pz[bj][e], w0e, a);
                            if (m < 3) { const float zn = acc[ai][bj][m + 1][n][e]; asm("v_fmac_f32_dpp %0, %1, %2 row_ror:15 row_mask:0xf bank_mask:0xf bound_ctrl:1" : "+v"(a) : "v"(zn), "v"(w2e)); } else a = fmaf(nz[bj][e], w2e, a);
                            o[e] = a; }
                        zc[bj] = o; }
                    const int lr = 128 * ai + 64 * wr + 16 * m + fr;
                    if (lr >= vlo && lr <= vhi) { u32x2 w; w.x = cvt_pk_bf16(siluf_(zc[0][0]) * zc[1][0], siluf_(zc[0][1]) * zc[1][1]); w.y = cvt_pk_bf16(siluf_(zc[0][2]) * zc[1][2], siluf_(zc[0][3]) * zc[1][3]);
                        *(GAS u32x2*)(actb + (lane_off + (unsigned)((128 * ai + 16 * m) * DFF + 4 * n) * 2u)) = w; } } }
        }
    }
};

struct EpiQkv {
    static constexpr bool PERM = true, AFTER_DRAIN = false;
    unsigned char* ws; float* out; const float* rsq; const float* b2; PG8_LAS unsigned char* lds; const float* qkg; const float* rope;
    template <class Sched> __device__ __forceinline__ void prep(const Sched& S, int tid) const {
        Unit u;
        for (int i = 0; i < ETAB_MAXU && S.next(i, u); ++i) { PG8_LAS float* t = etab(lds, i);
            if (tid < 256) t[tid] = row_rstd(rsq, u.pm * BM + tid);
            else { const int c = tid - 256; t[256 + c] = b2[(size_t)tile_cidx(u.pm * BM) * 3 * D + u.pn * BM + c]; } }
        __syncthreads();
    }
    __device__ __forceinline__ void operator()(f32x4 (&acc)[2][2][4][2], const Unit& u, int ui, int wr, int wc, int fr, int fq) const {
        asm volatile("" : "+v"(fr), "+v"(fq));
        PG8_LAS const float* tb = etab(lds, ui);
        const int trow = u.pm * BM; const bool smp = trow >= NPROMPT; const int sb = smp ? (trow - NPROMPT) >> 10 : 0, tq0 = smp ? (trow - NPROMPT) & 1023 : 0;
        const int kind = u.pn >> 2, tc0 = wc * 32 + 8 * fq;
        if (kind < 2) {
            const int oc = (u.pn & 3) * 256 + wc * 64 + 8 * fq;
            f32x4 bz[2][2], gq[2][2];
#pragma unroll
            for (int bj = 0; bj < 2; ++bj)
#pragma unroll
                for (int n = 0; n < 2; ++n) { bz[bj][n] = *(PG8_LAS const f32x4*)(tb + 256 + tc0 + bj * HALF + 4 * n); gq[bj][n] = *(const GAS f32x4*)(qkg + kind * 64 + 32 * bj + 8 * fq + 4 * n); }
            const size_t doff = kind == 0 ? WS_T2 : (smp ? WS_KS : WS_T2 + (size_t)M * D * 2); GAS unsigned char* dst = (GAS unsigned char*)ws + doff;
#pragma unroll
            for (int ai = 0; ai < 2; ++ai) {
                f32x4 cs[4][2], sn[4][2];
#pragma unroll
                for (int m = 0; m < 4; ++m) { const int lrow = 128 * ai + 64 * wr + 16 * m + fr; const float rs = tb[lrow];
                    if (smp && (m & 1) == 0) {
#pragma unroll
                        for (int mm = m; mm < m + 2; ++mm)
#pragma unroll
                            for (int n = 0; n < 2; ++n) { const int t = tq0 + 128 * ai + 64 * wr + 16 * mm + fr; cs[mm][n] = *(const GAS f32x4*)(rope + t * 32 + 8 * fq + 4 * n); sn[mm][n] = *(const GAS f32x4*)(rope + 32768 + t * 32 + 8 * fq + 4 * n); } }
                    f32x4 v[2][2]; float ss = 0.f;
#pragma unroll
                    for (int bj = 0; bj < 2; ++bj)
#pragma unroll
                        for (int n = 0; n < 2; ++n) { v[bj][n] = acc[ai][bj][m][n] * rs + bz[bj][n]; ss += (v[bj][n][0] * v[bj][n][0] + v[bj][n][1] * v[bj][n][1]) + (v[bj][n][2] * v[bj][n][2] + v[bj][n][3] * v[bj][n][3]); }
                    ss = sum_q4(ss);
                    const float rn = rsqrtf(ss * (1.f / 64.f) + EPS);
#pragma unroll
                    for (int bj = 0; bj < 2; ++bj)
#pragma unroll
                        for (int n = 0; n < 2; ++n) v[bj][n] = v[bj][n] * rn * gq[bj][n];
                    const unsigned row = (unsigned)(trow + lrow);
                    if (!smp) {
                        if (kind == 1) {
#pragma unroll
                            for (int bj = 0; bj < 2; ++bj)
#pragma unroll
                                for (int n = 0; n < 2; ++n) *(GAS f32x4*)((GAS unsigned char*)out + O_CK * 4 + (row * (unsigned)D + oc + 32 * bj + 4 * n) * 4u) = v[bj][n]; }
                    } else {
#pragma unroll
                        for (int n = 0; n < 2; ++n) { const f32x4 x1 = v[0][n], x2 = v[1][n]; v[0][n] = x1 * cs[m][n] - x2 * sn[m][n]; v[1][n] = x2 * cs[m][n] + x1 * sn[m][n]; } }
                    const unsigned drow = (kind == 1 && smp) ? (unsigned)(sb * TKS + PAST + tq0 + lrow) : row;
#pragma unroll
                    for (int bj = 0; bj < 2; ++bj) { u32x4 w; w.x = cvt_pk_bf16(v[bj][0][0], v[bj][0][1]); w.y = cvt_pk_bf16(v[bj][0][2], v[bj][0][3]); w.z = cvt_pk_bf16(v[bj][1][0], v[bj][1][1]); w.w = cvt_pk_bf16(v[bj][1][2], v[bj][1][3]);
                        *(GAS u32x4*)(dst + (drow * (unsigned)D + oc + 32 * bj) * 2u) = w; }
                    if (m & 1) { asm volatile("" ::: "memory"); __builtin_amdgcn_sched_barrier(0); } } }
        } else {
            const int oc = (u.pn - 8) * 256 + wc * 32 + 8 * fq;
            const size_t doff = smp ? WS_VS : WS_T2 + (size_t)M * D * 2 + (size_t)NPROMPT * D * 2; GAS unsigned char* dst = (GAS unsigned char*)ws + doff;
#pragma unroll
            for (int bj = 0; bj < 2; ++bj) { const f32x4 bz0 = *(PG8_LAS const f32x4*)(tb + 256 + tc0 + bj * HALF), bz1 = *(PG8_LAS const f32x4*)(tb + 256 + tc0 + bj * HALF + 4);
#pragma unroll
                for (int ai = 0; ai < 2; ++ai)
#pragma unroll
                    for (int m = 0; m < 4; ++m) { const int lrow = 128 * ai + 64 * wr + 16 * m + fr; const float rs = tb[lrow];
                        const f32x4 v0 = acc[ai][bj][m][0] * rs + bz0, v1 = acc[ai][bj][m][1] * rs + bz1;
                        const unsigned row = (unsigned)(trow + lrow), drow = smp ? (unsigned)(sb * TKS + PAST + tq0 + lrow) : row;
                        u32x4 w; w.x = cvt_pk_bf16(v0[0], v0[1]); w.y = cvt_pk_bf16(v0[2], v0[3]); w.z = cvt_pk_bf16(v1[0], v1[1]); w.w = cvt_pk_bf16(v1[2], v1[3]);
                        *(GAS u32x4*)(dst + (drow * (unsigned)D + oc + 128 * bj) * 2u) = w;
                        if (!smp) { *(GAS f32x4*)((GAS unsigned char*)out + O_CV * 4 + (row * (unsigned)D + oc + 128 * bj) * 4u) = v0; *(GAS f32x4*)((GAS unsigned char*)out + O_CV * 4 + (row * (unsigned)D + oc + 128 * bj + 4) * 4u) = v1; } } }
        }
    }
};
}

struct Params { const float* in[N_IN]; float* out; unsigned char* ws; };
struct Frame {
    LAS unsigned char* lds; int tid, lane, wave, bid, G, wave0;
    float* out; unsigned char* ws; float* out0; unsigned char* ws0;
    __device__ __forceinline__ const float* inp(int i) const { const unsigned long long v = ((LAS const unsigned long long*)(lds + PTR_OFF))[i];
        const unsigned lo = __builtin_amdgcn_readfirstlane((unsigned)v), hi = __builtin_amdgcn_readfirstlane((unsigned)(v >> 32)); return (const float*)(const GAS float*)(((unsigned long long)hi << 32) | lo); }
    float* mod; float* rstd; float* rope; bf16 *H, *T1, *T2, *T3, *KS, *VS, *WT; float *rsq0, *rsq1, *rsqv, *bias2;
    __device__ __forceinline__ void fresh() {
        int z = 0; asm volatile("" : "+v"(z));
        lane = __builtin_amdgcn_mbcnt_hi(~0u, __builtin_amdgcn_mbcnt_lo(~0u, z)); int wv = wave0; asm volatile("" : "+s"(wv)); wave = wv; tid = wv * 64 + lane;
        int b = blockIdx.x; asm volatile("" : "+s"(b)); bid = b;
        unsigned char* w = ws0; asm volatile("" : "+s"(w)); w = (unsigned char*)(GAS unsigned char*)(unsigned long long)w; ws = w; float* o = out0; asm volatile("" : "+s"(o)); o = (float*)(GAS float*)(unsigned long long)o; out = o;
        mod = (float*)(w + WS_MOD); rstd = (float*)(w + WS_RSTD); rope = (float*)(w + WS_ROPE);
        H = (bf16*)(w + WS_H); T1 = (bf16*)(w + WS_T1); T2 = (bf16*)(w + WS_T2); T3 = (bf16*)(w + WS_T3); KS = (bf16*)(w + WS_KS); VS = (bf16*)(w + WS_VS); WT = (bf16*)(w + WS_W);
        rsq0 = (float*)(w + WS_X); rsq1 = (float*)(w + WS_X + MiB); rsqv = (float*)(w + WS_X + 2 * MiB); bias2 = (float*)(w + WS_X + 4 * MiB);
    }
};
__device__ __forceinline__ const float* xin_row(const Frame& F, int row) { return row < NPROMPT ? F.inp(I_XP) + (size_t)row * D : F.inp(I_XS) + (size_t)(row - NPROMPT) * D; }
__device__ __forceinline__ int cidx_of(int row) { return row < NPROMPT ? 0 : 1 + ((row - NPROMPT) >> 10); }
__device__ __forceinline__ const float* modp(const Frame& F, int l, int row, int which) { return F.mod + (size_t)((l * 3 + cidx_of(row)) * 6 + which) * D; }


template <int MODE  >
__device__ __forceinline__ void transpose_item(const float* W, int K, int N, bf16* WT, LAS float* scr, int item, int lane) {
    const int nblk = N / 32, kb = item / nblk, nb = item % nblk, k0 = 64 * kb, n0 = 32 * nb;
    int d0 = n0; if (MODE == 1) { const int isu = n0 >= DFF, jj = n0 - isu * DFF; d0 = (jj >> 7) * 256 + isu * 128 + (jj & 127); }
    if (MODE == 2 && n0 < 2 * D) { const int w = n0 & 255; d0 = (n0 & ~255) + ((w >> 5) & 1) * 128 + (w >> 6) * 32; }
    float wv[32];
    const GAS float* wp = (const GAS float*)W + (size_t)(k0 + (lane >> 5)) * N + n0 + (lane & 31);
#pragma unroll
    for (int i = 0; i < 32; ++i) wv[i] = wp[(size_t)(2 * i) * N];
#pragma unroll
    for (int i = 0; i < 32; ++i) scr[(2 * i + (lane >> 5)) * 33 + (lane & 31)] = wv[i];
    asm volatile("s_waitcnt lgkmcnt(0)" ::: "memory");
    const int c = lane & 7;
#pragma unroll
    for (int j = 0; j < 4; ++j) { const int n = (lane >> 3) + 8 * j; const LAS float* sp = scr + (8 * c) * 33 + n;
        u32x4 o; o.x = f2bf(sp[0 * 33]) | (f2bf(sp[1 * 33]) << 16); o.y = f2bf(sp[2 * 33]) | (f2bf(sp[3 * 33]) << 16); o.z = f2bf(sp[4 * 33]) | (f2bf(sp[5 * 33]) << 16); o.w = f2bf(sp[6 * 33]) | (f2bf(sp[7 * 33]) << 16);
        *(u32x4*)(WT + (size_t)(d0 + n) * K + k0 + 8 * c) = o; }
    asm volatile("s_waitcnt lgkmcnt(0)" ::: "memory");
}
template <int MODE = 0>
__device__ __forceinline__ bool transpose_group(int& r, const float* W, int nmat, int K, int N, bf16* WT, LAS float* scr, int lane) {
    const int per = (K / 64) * (N / 32), tot = nmat * per;
    if (r >= tot) { r -= tot; return false; }
    const int mi = r / per; transpose_item<MODE>(W + (size_t)mi * K * N, K, N, WT + (size_t)mi * K * N, scr, r % per, lane); return true;
}

template <int SLOT>
__device__ __forceinline__ void convert_slot(Frame& F, int gw, int NGW) {
    LAS float* scr = (LAS float*)(F.lds + F.wave * 16384);
    constexpr size_t UPE = (size_t)2 * DFF * D, DNE = (size_t)D * DFF;
    constexpr int I_UP1 = (D / 64) * (2 * DFF / 32), I_DN1 = (DFF / 64) * (D / 32), I_LIN = (D / 64) * (2 * DRNN / 32), I_LOUT = (DRNN / 64) * (D / 32), I_WG = 80 * 2 * 4,
                  I_CIN = (D / 64) * (2 * DB / 32), I_COUT = (DB / 64) * (D / 32), I_QKV = (D / 64) * (3 * D / 32), I_AOUT = (D / 64) * (D / 32);
    constexpr int NIT = SLOT == 0 ? I_LIN + I_LOUT + I_WG + I_UP1 + I_DN1 : SLOT == 1 ? I_CIN + I_COUT + I_UP1 : SLOT == 2 ? I_DN1 + I_QKV + I_AOUT + I_UP1 : SLOT == 3 ? I_DN1 + I_LIN + I_LOUT : I_UP1 + I_DN1;
    for (int it = gw; it < NIT; it += NGW) { int r = it;
        if (SLOT == 0) {
            if (transpose_group(r, F.inp(I_LRU_WIN), 1, D, 2 * DRNN, F.WT + WE_LRU_IN, scr, F.lane)) continue;
            if (transpose_group(r, F.inp(I_LRU_WOUT), 1, DRNN, D, F.WT + WE_LRU_OUT, scr, F.lane)) continue;
            if (transpose_group(r, F.inp(I_LRU_WG), 80, 128, 128, F.WT + WE_WG, scr, F.lane)) continue;
            if (transpose_group<1>(r, F.inp(I_FF_WUP), 1, D, 2 * DFF, F.WT + WE_UP, scr, F.lane)) continue;
            transpose_group(r, F.inp(I_FF_WDN), 1, DFF, D, F.WT + WE_DN, scr, F.lane);
        } else if (SLOT == 1) {
            if (transpose_group(r, F.inp(I_CM_WIN), 1, D, 2 * DB, F.WT + WE_CM_IN, scr, F.lane)) continue;
            if (transpose_group(r, F.inp(I_CM_WOUT), 1, DB, D, F.WT + WE_CM_OUT, scr, F.lane)) continue;
            transpose_group<1>(r, F.inp(I_FF_WUP) + UPE, 1, D, 2 * DFF, F.WT + WE_UP + UPE, scr, F.lane);
        } else if (SLOT == 2) {
            if (transpose_group(r, F.inp(I_FF_WDN) + DNE, 1, DFF, D, F.WT + WE_DN + DNE, scr, F.lane)) continue;
            if (transpose_group<2>(r, F.inp(I_AT_WQKV), 1, D, 3 * D, F.WT + WE_QKV, scr, F.lane)) continue;
            if (transpose_group(r, F.inp(I_AT_WOUT), 1, D, D, F.WT + WE_AT_OUT, scr, F.lane)) continue;
            transpose_group<1>(r, F.inp(I_FF_WUP) + 2 * UPE, 1, D, 2 * DFF, F.WT + WE_UP + 2 * UPE, scr, F.lane);
        } else if (SLOT == 3) {
            if (transpose_group(r, F.inp(I_FF_WDN) + 2 * DNE, 1, DFF, D, F.WT + WE_DN + 2 * DNE, scr, F.lane)) continue;
            if (transpose_group(r, F.inp(I_LRU_WIN) + (size_t)D * 2 * DRNN, 1, D, 2 * DRNN, F.WT + WE_LRU_IN + (size_t)D * 2 * DRNN, scr, F.lane)) continue;
            transpose_group(r, F.inp(I_LRU_WOUT) + (size_t)DRNN * D, 1, DRNN, D, F.WT + WE_LRU_OUT + (size_t)DRNN * D, scr, F.lane);
        } else {
            if (transpose_group<1>(r, F.inp(I_FF_WUP) + 3 * UPE, 1, D, 2 * DFF, F.WT + WE_UP + 3 * UPE, scr, F.lane)) continue;
            transpose_group(r, F.inp(I_FF_WDN) + 3 * DNE, 1, DFF, D, F.WT + WE_DN + 3 * DNE, scr, F.lane);
        }
    }
}
__device__ __forceinline__ void adaln_layer(Frame& F, int l, int wk, int nwk) {
    LAS float* sc = (LAS float*)F.lds;
    const float* c = F.inp(I_C); const float* cctx = F.inp(I_CCTX);
    __syncthreads();
    for (int i = F.tid; i < 3 * D; i += NT) { const int ci = i >> 10, k = i & 1023; const float v = ci == 0 ? cctx[k] : c[(ci - 1) * D + k]; sc[i] = siluf_(v); }
    __syncthreads();
    LAS float* part = sc + 3 * D;
    const int kp = F.tid >> 6, cl = F.tid & 63;
    for (int item = wk; item < 6 * D / 64; item += nwk) {
        const int cc = item * 64 + cl;
        const float* w = F.inp(I_WMOD) + (size_t)l * D * 6 * D + cc;
        float s0 = 0.f, s1 = 0.f, s2 = 0.f;
#pragma unroll 1
        for (int kb = kp * 128; kb < kp * 128 + 128; kb += 32) { float wv[32];
#pragma unroll
            for (int i = 0; i < 32; ++i) wv[i] = ((const GAS float*)w)[(size_t)(kb + i) * 6 * D];
#pragma unroll
            for (int i = 0; i < 32; ++i) { s0 += sc[kb + i] * wv[i]; s1 += sc[D + kb + i] * wv[i]; s2 += sc[2 * D + kb + i] * wv[i]; } }
        part[(kp * 3 + 0) * 64 + cl] = s0; part[(kp * 3 + 1) * 64 + cl] = s1; part[(kp * 3 + 2) * 64 + cl] = s2;
        __syncthreads();
        if (F.tid < 192) { const int ci = F.tid >> 6; float s = F.inp(I_BMOD)[l * 6 * D + cc];
            for (int q = 0; q < 8; ++q) s += part[(q * 3 + ci) * 64 + cl];
            F.mod[(size_t)((l * 3 + ci) * 6) * D + cc] = s; }
        __syncthreads();
    }
}
__device__ __forceinline__ void phase_prologue(Frame& F) {
    F.fresh();
    adaln_layer(F, 0, F.bid, F.G);
    { __syncthreads(); convert_slot<0>(F, F.bid * NWAVES + F.wave, F.G * NWAVES); }
    const int gt = F.bid * NT + F.tid, GT = F.G * NT;
    for (int i = gt; i < 1024 * 32; i += GT) { const int t = i >> 5, j = i & 31; const float inv = powf(10000.f, -(float)(j & 15) / 16.f); const float pos = (float)(j < 16 ? (t >> 6) : (t & 63));
        const float ang = pos * inv; F.rope[i] = cosf(ang); F.rope[32768 + i] = sinf(ang); }
    for (int i = gt; i < 8 * 8 * 4 * 64; i += GT) { const int ln = i & 63, ks = (i >> 6) & 3, nf = (i >> 8) & 7, g = i >> 11, cq = ln >> 4, p = 16 * nf + (ln & 15);
        const float* wr = F.inp(I_CM_WS) + (size_t)(g * 128 + p) * 128 + 32 * ks + 4 * cq;
        u32x4 o; o.x = f2bf(wr[0]) | (f2bf(wr[1]) << 16); o.y = f2bf(wr[2]) | (f2bf(wr[3]) << 16); o.z = f2bf(wr[16]) | (f2bf(wr[17]) << 16); o.w = f2bf(wr[18]) | (f2bf(wr[19]) << 16);
        *(u32x4*)(F.WT + WE_WSB + (size_t)i * 8) = o; }
    for (int i = gt; i < 2 * PAST * D; i += GT) { const int b = i / (PAST * D), r = i % (PAST * D);
        F.KS[(size_t)b * TKS * D + r] = (bf16)f2bf(F.inp(I_CK)[i]); F.VS[(size_t)b * TKS * D + r] = (bf16)f2bf(F.inp(I_CV)[i]); }
}

__device__ __forceinline__ void bias2_gemm(Frame& F, const bf16* Wt, int N, int l, int sub, float* outp, int gw, int NGW) {
    float sh[3][16];
#pragma unroll
    for (int ci = 0; ci < 3; ++ci) { const GAS f32x4* sp = (const GAS f32x4*)(F.mod + (size_t)((l * 3 + ci) * 6 + sub * 3) * D + 16 * F.lane);
#pragma unroll
        for (int i = 0; i < 4; ++i) { const f32x4 v = sp[i]; sh[ci][4 * i] = v.x; sh[ci][4 * i + 1] = v.y; sh[ci][4 * i + 2] = v.z; sh[ci][4 * i + 3] = v.w; } }
    for (int n = gw; n < N; n += NGW) { const GAS u32x4* wp = (const GAS u32x4*)(Wt + (size_t)n * D + 16 * F.lane); const u32x4 w0 = wp[0], w1 = wp[1];
        const unsigned ww[8] = {w0.x, w0.y, w0.z, w0.w, w1.x, w1.y, w1.z, w1.w};
        float d0 = 0.f, d1 = 0.f, d2 = 0.f;
#pragma unroll
        for (int i = 0; i < 8; ++i) { const float lo = bf2f(ww[i]), hi = bf2f(ww[i] >> 16); d0 += sh[0][2 * i] * lo + sh[0][2 * i + 1] * hi; d1 += sh[1][2 * i] * lo + sh[1][2 * i + 1] * hi; d2 += sh[2][2 * i] * lo + sh[2][2 * i + 1] * hi; }
        d0 = wave_sum(d0); d1 = wave_sum(d1); d2 = wave_sum(d2);
        if (F.lane == 0) { outp[n] = d0; outp[(size_t)N + n] = d1; outp[(size_t)2 * N + n] = d2; } }
}
__device__ __forceinline__ void bias2_slot(Frame& F, int slot, int gw, int NGW) {
    if (slot == 2) bias2_gemm(F, F.WT + WE_CM_IN, 2 * DB, 1, 0, F.bias2 + B2_CM, gw, NGW);
    else if (slot == 3) bias2_gemm(F, F.WT + WE_UP + (size_t)1 * 2 * DFF * D, 2 * DFF, 1, 1, F.bias2 + B2_UP + (size_t)1 * 3 * 5632, gw, NGW);
    else if (slot == 4) bias2_gemm(F, F.WT + WE_QKV, 3 * D, 2, 0, F.bias2 + B2_QKV, gw, NGW);
    else if (slot == 5) bias2_gemm(F, F.WT + WE_UP + (size_t)2 * 2 * DFF * D, 2 * DFF, 2, 1, F.bias2 + B2_UP + (size_t)2 * 3 * 5632, gw, NGW);
    else if (slot == 6) bias2_gemm(F, F.WT + WE_LRU_IN + (size_t)2 * DRNN * D, 2 * DRNN, 3, 0, F.bias2 + B2_LRU + 3 * 2560, gw, NGW);
    else if (slot == 7) bias2_gemm(F, F.WT + WE_UP + (size_t)3 * 2 * DFF * D, 2 * DFF, 3, 1, F.bias2 + B2_UP + (size_t)3 * 3 * 5632, gw, NGW);
}
__device__ __forceinline__ void side_job(Frame& F, int slot) {
    F.fresh();
    const int nwk = F.G > 160 ? F.G - 160 : F.G, wk = F.G > 160 ? F.bid - 160 : F.bid;
    if (wk < 0) return;
    const int gw = wk * NWAVES + F.wave, NGW = nwk * NWAVES;
    bias2_slot(F, slot, gw, NGW);
    if (slot == 1) adaln_layer(F, 1, wk, nwk); else if (slot == 3) adaln_layer(F, 2, wk, nwk); else if (slot == 5) adaln_layer(F, 3, wk, nwk);
    if (slot == 1) convert_slot<1>(F, gw, NGW); else if (slot == 2) convert_slot<2>(F, gw, NGW); else if (slot == 3) convert_slot<3>(F, gw, NGW); else if (slot == 4) convert_slot<4>(F, gw, NGW);
}
__device__ __forceinline__ void phase_modulate0(Frame& F) {
    F.fresh();
    const int gw = F.bid * NWAVES + F.wave, NGW = F.G * NWAVES;
    const float* g = F.inp(I_NORMG);
    for (int row = gw; row < M; row += NGW) {
        const float* xr = xin_row(F, row); const float* scl = modp(F, 0, row, 1);
        f32x4 v[4]; float s = 0.f;
#pragma unroll
        for (int j = 0; j < 4; ++j) { v[j] = *(const GAS f32x4*)(xr + 4 * F.lane + 256 * j); s += v[j].x * v[j].x + v[j].y * v[j].y + v[j].z * v[j].z + v[j].w * v[j].w; }
        s = wave_sum(s);
        if (F.lane < 16) F.rsq0[(size_t)row * 16 + F.lane] = F.lane == 0 ? s : 0.f;
#pragma unroll
        for (int j = 0; j < 4; ++j) { const int c0 = 4 * F.lane + 256 * j; const f32x4 gg = *(const GAS f32x4*)(g + c0), c4 = *(const GAS f32x4*)(scl + c0);
            const f32x4 o = v[j] * gg * (1.f + c4); u32x2 w; w.x = f2bf(o.x) | (f2bf(o.y) << 16); w.y = f2bf(o.z) | (f2bf(o.w) << 16);
            *(GAS u32x2*)(F.H + (size_t)row * D + c0) = w; }
    }
    bias2_gemm(F, F.WT + WE_LRU_IN, 2 * DRNN, 0, 0, F.bias2 + B2_LRU, gw, NGW);
    bias2_gemm(F, F.WT + WE_UP, 2 * DFF, 0, 1, F.bias2 + B2_UP, gw, NGW);
}

template <class P>
__device__ __forceinline__ void gemm_naive(Frame& F, const P& p, int nbatch, int Mr, int N, int K) {
    F.fresh();
    LAS float* As = (LAS float*)F.lds;
    LAS float* Bs = As + 16 * 132;
    const int tid = F.tid, tx = tid & 31, ty = tid >> 5;
    const int tm = Mr / 128, tn = N / 128, per = tm * tn, total = per * nbatch;
    for (int t = F.bid; t < total; t += F.G) {
        const int b = t / per, r = t % per, pn = r / tm, pm = r % tm;
        const bf16* A; int lda; const float* W; int ldw; p.get(b, A, lda, W, ldw);
        float acc[8][4];
#pragma unroll
        for (int i = 0; i < 8; ++i)
#pragma unroll
            for (int j = 0; j < 4; ++j) acc[i][j] = 0.f;
        for (int k0 = 0; k0 < K; k0 += 16) {
            { const int row = tid >> 2, kq = (tid & 3) * 4;
              const u32x2 v = *(const u32x2*)(A + (size_t)(pm * 128 + row) * lda + k0 + kq);
              As[(kq + 0) * 132 + row] = bf2f(v.x); As[(kq + 1) * 132 + row] = bf2f(v.x >> 16); As[(kq + 2) * 132 + row] = bf2f(v.y); As[(kq + 3) * 132 + row] = bf2f(v.y >> 16); }
            { const int k = tid >> 5, n4 = (tid & 31) * 4;
              *(LAS f32x4*)(Bs + k * 128 + n4) = *(const f32x4*)(W + (size_t)(k0 + k) * ldw + pn * 128 + n4); }
            __syncthreads();
#pragma unroll 2
            for (int k = 0; k < 16; ++k) {
                const f32x4 a0 = *(const LAS f32x4*)(As + k * 132 + ty * 8), a1 = *(const LAS f32x4*)(As + k * 132 + ty * 8 + 4), bv = *(const LAS f32x4*)(Bs + k * 128 + tx * 4);
                const float a[8] = {a0.x, a0.y, a0.z, a0.w, a1.x, a1.y, a1.z, a1.w}; const float bb[4] = {bv.x, bv.y, bv.z, bv.w};
#pragma unroll
                for (int i = 0; i < 8; ++i)
#pragma unroll
                    for (int j = 0; j < 4; ++j) acc[i][j] += a[i] * bb[j];
            }
            __syncthreads();
        }
#pragma unroll
        for (int i = 0; i < 8; ++i)
#pragma unroll
            for (int j = 0; j < 4; ++j) p.epi(b, pm * 128 + ty * 8 + i, pn * 128 + tx * 4 + j, acc[i][j]);
    }
}

struct PStoreBf16 {
    const bf16* A; int lda; const float* W; int ldw; bf16* O; int ldo; const float* bias; int act; int split;
    __device__ __forceinline__ void get(int, const bf16*& a, int& la, const float*& w, int& lw) const { a = A; la = lda; w = W; lw = ldw; }
    __device__ __forceinline__ void epi(int, int row, int col, float v) const {
        if (bias) v += bias[col];
        if (act == 1 || (act == 2 && col < split)) v = gelu_tanh(v);
        O[(size_t)row * ldo + col] = (bf16)f2bf(v); }
};
struct PResid {
    const bf16* A; int lda; const float* W; int ldw; float* out; const float* xp; const float* xs; const float* modl; int which; bool from_input;
    __device__ __forceinline__ void get(int, const bf16*& a, int& la, const float*& w, int& lw) const { a = A; la = lda; w = W; lw = ldw; }
    __device__ __forceinline__ void epi(int, int row, int col, float v) const {
        const float base = from_input ? (row < NPROMPT ? xp[(size_t)row * D + col] : xs[(size_t)(row - NPROMPT) * D + col]) : out[(size_t)row * D + col];
        out[(size_t)row * D + col] = base + modl[(size_t)(cidx_of(row) * 6 + which) * D + col] * v; }
};
struct PLruIn {
    const bf16* A; const float* W; bf16* GBp; bf16* RECp;
    __device__ __forceinline__ void get(int, const bf16*& a, int& la, const float*& w, int& lw) const { a = A; la = D; w = W; lw = 2 * DRNN; }
    __device__ __forceinline__ void epi(int, int row, int col, float v) const {
        if (col < DRNN) GBp[(size_t)row * DRNN + col] = (bf16)f2bf(gelu_tanh(v)); else RECp[(size_t)row * DRNN + col - DRNN] = (bf16)f2bf(v); }
};
struct PGates {
    const bf16* XC; const float* WG; const float* BG; bf16* O;
    __device__ __forceinline__ void get(int b, const bf16*& a, int& la, const float*& w, int& lw) const { a = XC + (b % 10) * 128; la = DRNN; w = WG + (size_t)b * 128 * 128; lw = 128; }
    __device__ __forceinline__ void epi(int b, int row, int col, float v) const { const int dg = b / 10, n = b % 10;
        O[((size_t)dg * M + row) * DRNN + n * 128 + col] = (bf16)f2bf(sigmoidf_(v + BG[dg * DRNN + n * 128 + col])); }
};

__device__ __forceinline__ void phase_lru_conv(Frame& F, int j, const bf16* REC, bf16* XC) {
    F.fresh();
    const float* cw = F.inp(I_LRU_CW) + (size_t)j * 4 * DRNN; const float* cb = F.inp(I_LRU_CB) + (size_t)j * DRNN;
    const int gt = F.bid * NT + F.tid, GT = F.G * NT;
    for (int i = gt; i < M * DRNN; i += GT) { const int row = i / DRNN, ch = i % DRNN;
        int t, T; if (row < NPROMPT) { t = row & 255; T = 256; } else { t = (row - NPROMPT) & 1023; T = 1024; }
        float s = cb[ch];
#pragma unroll
        for (int k = 0; k < 4; ++k) { const int tt = t + k - 2; if (tt >= 0 && tt < T) s += cw[k * DRNN + ch] * bf2f(REC[(size_t)(row + k - 2) * DRNN + ch]); }
        XC[i] = (bf16)f2bf(s); }
}
__device__ __forceinline__ void phase_lru_scan(Frame& F, int j, const bf16* GATES, const bf16* XC, const bf16* GB, bf16* HS) {
    F.fresh();
    const int gt = F.bid * NT + F.tid, GT = F.G * NT;
    const int NL = (2 + 32) * DRNN;
    for (int line = gt; line < NL; line += GT) {
        const int s = line / DRNN, ch = line % DRNN;
        int base, T; float h0f = 0.f, h0b = 0.f;
        if (s < 2) { base = NPROMPT + s * 1024; T = 1024; h0f = F.inp(I_STATE)[((size_t)(s * 2 + j) * 2 + 0) * DRNN + ch]; h0b = F.inp(I_STATE)[((size_t)(s * 2 + j) * 2 + 1) * DRNN + ch]; }
        else { base = (s - 2) * 256; T = 256; }
        const float spf = softplusf_(-F.inp(I_LRU_LAM)[(size_t)(j * 2 + 0) * DRNN + ch]), spb = softplusf_(-F.inp(I_LRU_LAM)[(size_t)(j * 2 + 1) * DRNN + ch]);
        float h = h0f;
        for (int t = 0; t < T; ++t) { const size_t o = (size_t)(base + t) * DRNN + ch;
            const float r = bf2f(GATES[o]), ig = bf2f(GATES[(size_t)M * DRNN + o]), xc = bf2f(XC[o]);
            const float la = -8.f * r * spf, a = expf(la), bx = sqrtf(-expm1f(2.f * la)) * (ig * xc);
            h = a * h + bx; HS[o] = (bf16)f2bf(h); }
        const float ff = h;
        h = h0b;
        for (int t = T - 1; t >= 0; --t) { const size_t o = (size_t)(base + t) * DRNN + ch;
            const float r = bf2f(GATES[(size_t)2 * M * DRNN + o]), ig = bf2f(GATES[(size_t)3 * M * DRNN + o]), xc = bf2f(XC[o]);
            const float la = -8.f * r * spb, a = expf(la), bx = sqrtf(-expm1f(2.f * la)) * (ig * xc);
            h = a * h + bx; HS[o] = (bf16)f2bf(bf2f(GB[o]) * (bf2f(HS[o]) + h)); }
        if (s >= 2) { float* st = F.out + O_STATE + ((size_t)((s - 2) * 2 + j) * 2) * DRNN; st[ch] = ff; st[DRNN + ch] = h; }
    }
}


typedef short bf16x8 __attribute__((ext_vector_type(8)));
typedef short v4i16_t __attribute__((ext_vector_type(4)));
constexpr int LRU_XS = 272;
constexpr int LRU_XC_OFF = 0, LRU_GB_OFF = 256 * LRU_XS;
template <bool REV>
__device__ __forceinline__ float lru_dir(LAS const unsigned char* xct, LAS unsigned char* hft, const bf16* wgt  ,
                                         const bf16* gbp  , float br, float bi, float sp, float hc, int wave, int lane, bool wantp, bf16* Pdst) {
    const int c = lane & 15, q = lane >> 4, qq = REV ? 3 - q : q;
    bf16x8 Br[4], Bi[4], Id;
#pragma unroll
    for (int ks = 0; ks < 4; ++ks) { Br[ks] = *(const GAS bf16x8*)(wgt + (size_t)(16 * wave + c) * 128 + 32 * ks + 8 * q);
                                     Bi[ks] = *(const GAS bf16x8*)(wgt + (size_t)10 * 128 * 128 + (size_t)(16 * wave + c) * 128 + 32 * ks + 8 * q); }
#pragma unroll
    for (int jj = 0; jj < 8; ++jj) Id[jj] = (8 * q + jj == 16 * (wave & 1) + c) ? (short)0x3F80 : (short)0;
    const int ksel = wave >> 1;
    const float nsp8 = -8.f * sp * 1.44269504f;
    float Pc = 1.f;
    unsigned short gcur[16], gnxt[16];
#pragma unroll
    for (int i = 0; i < 16; ++i) { gcur[i] = 0; gnxt[i] = 0; }
    if (REV) {
#pragma unroll
        for (int i = 0; i < 16; ++i) gcur[i] = *(const GAS unsigned short*)(gbp + (size_t)(16 * (12 + (i >> 2)) + 4 * q + (i & 3)) * DRNN); }
    f32x4 r, ig, xc;
#define LRU_STAGE_A(MI, R_, I_, X_) do { LAS const unsigned char* rp_ = xct + (16 * (MI) + c) * LRU_XS + 16 * q; bf16x8 Af_[4]; \
        _Pragma("unroll") for (int ks = 0; ks < 4; ++ks) Af_[ks] = *(LAS const bf16x8*)(rp_ + 64 * ks); \
        const bf16x8 Ax_ = *(LAS const bf16x8*)(rp_ + 64 * ksel); \
        R_ = (f32x4){0.f, 0.f, 0.f, 0.f}; I_ = (f32x4){0.f, 0.f, 0.f, 0.f}; \
        _Pragma("unroll") for (int ks = 0; ks < 4; ++ks) { R_ = __builtin_amdgcn_mfma_f32_16x16x32_bf16(Af_[ks], Br[ks], R_, 0, 0, 0); I_ = __builtin_amdgcn_mfma_f32_16x16x32_bf16(Af_[ks], Bi[ks], I_, 0, 0, 0); } \
        X_ = __builtin_amdgcn_mfma_f32_16x16x32_bf16(Ax_, Id, (f32x4){0.f, 0.f, 0.f, 0.f}, 0, 0, 0); } while (0)
    LRU_STAGE_A(REV ? 15 : 0, r, ig, xc);
#pragma unroll 1
    for (int og = 0; og < 4; ++og) {
        if (REV && og < 3) {
#pragma unroll
            for (int i = 0; i < 16; ++i) gnxt[i] = *(const GAS unsigned short*)(gbp + (size_t)(16 * (4 * (2 - og) + (i >> 2)) + 4 * q + (i & 3)) * DRNN); }
#pragma unroll
        for (int ii = 0; ii < 4; ++ii) {
        const int it = 4 * og + ii, mi = REV ? 15 - it : it, mloc = REV ? 3 - ii : ii;
        f32x4 rn = r, ign = ig, xcn = xc;
        if (it < 15) { const int min_ = REV ? 14 - it : it + 1; LRU_STAGE_A(min_, rn, ign, xcn); }
        float av[4], bv[4];
#pragma unroll
        for (int k = 0; k < 4; ++k) { const float rg = __builtin_amdgcn_rcpf(1.f + __builtin_amdgcn_exp2f(-1.44269504f * (r[k] + br))), iv = __builtin_amdgcn_rcpf(1.f + __builtin_amdgcn_exp2f(-1.44269504f * (ig[k] + bi)));
            const float l2a = nsp8 * rg, x = 1.38629436f * l2a;
            const float om = -x * (1.f + x * (0.5f + x * (0.16666667f + x * (0.041666668f + x * (0.0083333338f + x * (0.0013888889f + x * 0.00019841270f))))));
            av[k] = __builtin_amdgcn_exp2f(l2a); bv[k] = __builtin_amdgcn_sqrtf(om) * (iv * xc[k]); }
        float pA[4], pB[4];
#pragma unroll
        for (int kk = 0; kk < 4; ++kk) { const int k = REV ? 3 - kk : kk;
            if (kk == 0) { pA[k] = av[k]; pB[k] = bv[k]; } else { const int kp = REV ? k + 1 : k - 1; pA[k] = pA[kp] * av[k]; pB[k] = pB[kp] * av[k] + bv[k]; } }
        const int kl = REV ? 0 : 3;
        float gA[4], gB[4];
#pragma unroll
        for (int g = 0; g < 4; ++g) { const int src = 16 * (REV ? 3 - g : g) + c; gA[g] = bperm(pA[kl], src); gB[g] = bperm(pB[kl], src); }
        float eA = 1.f, eB = 0.f, tA = 1.f, tB = 0.f;
#pragma unroll
        for (int g = 0; g < 4; ++g) { if (g == qq) { eA = tA; eB = tB; } tB = tB * gA[g] + gB[g]; tA = tA * gA[g]; }
        const float hin = eA * hc + eB;
        float hv[4];
#pragma unroll
        for (int k = 0; k < 4; ++k) { hv[k] = pA[k] * hin + pB[k];
            if (REV) { LAS const unsigned short* hp = (LAS const unsigned short*)(hft + (16 * mi + 4 * q + k) * LRU_XS + 2 * (16 * wave + c)); hv[k] = bf2f(gcur[4 * mloc + k]) * (bf2f(*hp) + hv[k]); } }
        { const unsigned w01 = pg8::cvt_pk_bf16(hv[0], hv[1]), w23 = pg8::cvt_pk_bf16(hv[2], hv[3]);
          LAS unsigned short* hp = (LAS unsigned short*)(hft + (16 * mi + 4 * q) * LRU_XS + 2 * (16 * wave + c));
          hp[0] = (unsigned short)w01; hp[LRU_XS / 2] = (unsigned short)(w01 >> 16); hp[LRU_XS] = (unsigned short)w23; hp[3 * LRU_XS / 2] = (unsigned short)(w23 >> 16); }
        if (wantp) { const float pe = eA * Pc; const unsigned p01 = pg8::cvt_pk_bf16(pA[0] * pe, pA[1] * pe), p23 = pg8::cvt_pk_bf16(pA[2] * pe, pA[3] * pe);
          bf16* pp = Pdst + (size_t)(16 * mi + 4 * q) * DRNN; pp[0] = (bf16)p01; pp[DRNN] = (bf16)(p01 >> 16); pp[2 * DRNN] = (bf16)p23; pp[3 * DRNN] = (bf16)(p23 >> 16); }
        hc = tA * hc + tB; Pc *= tA;
        r = rn; ig = ign; xc = xcn;
        }
        if (REV) {
#pragma unroll
            for (int i = 0; i < 16; ++i) gcur[i] = gnxt[i]; }
    }
#undef LRU_STAGE_A
    return hc;
}
__device__ __forceinline__ void lru_unit(Frame& F, int j, int pm, int n, const bf16* REC, const bf16* GB, bf16* HS, bf16* PF, bf16* PB, float* AGG, const bf16* WGT) {
    const int tid = F.tid, lane = F.lane, wave = F.wave, r0 = 256 * pm;
    const bool smp = pm >= 32; const int tix = smp ? (pm - 32) & 3 : 0, sq = smp ? (pm - 32) >> 2 : 0;
    const int t0 = smp ? 256 * tix : 0, T = smp ? 1024 : 256;
    LAS unsigned char* xct = F.lds + LRU_XC_OFF; LAS unsigned char* hft = F.lds + LRU_GB_OFF;
    { const float* cw = F.inp(I_LRU_CW) + (size_t)j * 4 * DRNN + n * 128 + 2 * lane; const float* cb = F.inp(I_LRU_CB) + (size_t)j * DRNN + n * 128 + 2 * lane;
      float w0[4], w1[4];
#pragma unroll
      for (int k = 0; k < 4; ++k) { w0[k] = cw[k * DRNN]; w1[k] = cw[k * DRNN + 1]; }
      const float b0 = cb[0], b1 = cb[1];
      unsigned v[35];
#pragma unroll
      for (int i = 0; i < 35; ++i) { const int tl = 32 * wave + i - 2, tt = t0 + tl;
          v[i] = (tt >= 0 && tt < T) ? *(const GAS unsigned*)(REC + (size_t)(r0 + tl) * DRNN + n * 128 + 2 * lane) : 0u; }
#pragma unroll
      for (int i = 0; i < 32; ++i) { float s0 = b0, s1 = b1;
#pragma unroll
          for (int k = 0; k < 4; ++k) { s0 += w0[k] * bf2f(v[i + k]); s1 += w1[k] * bf2f(v[i + k] >> 16); }
          *(LAS unsigned*)(xct + (32 * wave + i) * LRU_XS + 4 * lane) = f2bf(s0) | (f2bf(s1) << 16); } }
    __syncthreads();
    const int c = lane & 15, q = lane >> 4, ch = n * 128 + 16 * wave + c;
    const float* bg = F.inp(I_LRU_BG) + (size_t)j * 4 * DRNN; const float* lam = F.inp(I_LRU_LAM) + (size_t)j * 2 * DRNN;
    const bf16* gbp = GB + (size_t)r0 * DRNN + ch;
    bf16* pf = PF + (size_t)(smp ? r0 - NPROMPT : 0) * DRNN + ch; bf16* pb = PB + (size_t)(smp ? r0 - NPROMPT : 0) * DRNN + ch;
    { float h0 = 0.f; if (smp && tix == 0) h0 = F.inp(I_STATE)[((size_t)(sq * 2 + j) * 2 + 0) * DRNN + ch];
      const float hfin = lru_dir<false>(xct, hft, WGT + (size_t)(0 * 10 + n) * 128 * 128, gbp, bg[0 * DRNN + ch], bg[1 * DRNN + ch], softplusf_(-lam[ch]), h0, wave, lane, smp, pf);
      if (q == 0) { if (smp) AGG[(size_t)((sq * 4 + tix) * 2 + 0) * DRNN + ch] = hfin; else F.out[O_STATE + ((size_t)(pm * 2 + j) * 2 + 0) * DRNN + ch] = hfin; } }
    { float h0 = 0.f; if (smp && tix == 3) h0 = F.inp(I_STATE)[((size_t)(sq * 2 + j) * 2 + 1) * DRNN + ch];
      const float hfin = lru_dir<true>(xct, hft, WGT + (size_t)(2 * 10 + n) * 128 * 128, gbp, bg[2 * DRNN + ch], bg[3 * DRNN + ch], softplusf_(-lam[DRNN + ch]), h0, wave, lane, smp, pb);
      if (q == 0) { if (smp) AGG[(size_t)((sq * 4 + tix) * 2 + 1) * DRNN + ch] = hfin; else F.out[O_STATE + ((size_t)(pm * 2 + j) * 2 + 1) * DRNN + ch] = hfin; } }
    __syncthreads();
#pragma unroll
    for (int i = 0; i < 8; ++i) { const int id = i * NT + tid, row = id >> 4, cc = id & 15;
        *(GAS u32x4*)(HS + (size_t)(r0 + row) * DRNN + n * 128 + 8 * cc) = *(LAS const u32x4*)(hft + row * LRU_XS + 16 * cc); }
    __syncthreads();
}
__device__ __forceinline__ void phase_lru_core(Frame& F, int j, const bf16* REC, const bf16* GB, bf16* HS, bf16* PF, bf16* PB, float* AGG, const bf16* WGT) {
    F.fresh();
    for (int u = F.bid; u < 400; u += F.G) {
        const int pm = u < 80 ? 32 + u / 10 : (u - 80) / 10, n = u % 10;
        lru_unit(F, j, pm, n, REC, GB, HS, PF, PB, AGG, WGT); }
}
__device__ __forceinline__ void phase_lru_fixup(Frame& F, const bf16* GB, bf16* HS, const bf16* PF, const bf16* PB, const float* AGG) {
    F.fresh();
    const int gt = F.bid * NT + F.tid, GT = F.G * NT;
    for (int i = gt; i < NSAMPLE * DRNN; i += GT) { const int rs = i / DRNN, ch = i % DRNN, sq = rs >> 10, tix = (rs >> 8) & 3;
        float cf = 0.f, cbk = 0.f;
        if (tix > 0) { for (int t = 0; t < tix; ++t) { const float At = bf2f(PF[(size_t)(sq * 1024 + t * 256 + 255) * DRNN + ch]); cf = At * cf + AGG[(size_t)((sq * 4 + t) * 2 + 0) * DRNN + ch]; } }
        if (tix < 3) { for (int t = 3; t > tix; --t) { const float At = bf2f(PB[(size_t)(sq * 1024 + t * 256) * DRNN + ch]); cbk = At * cbk + AGG[(size_t)((sq * 4 + t) * 2 + 1) * DRNN + ch]; } }
        const size_t o = (size_t)(NPROMPT + rs) * DRNN + ch;
        HS[o] = (bf16)f2bf(bf2f(HS[o]) + bf2f(GB[o]) * (bf2f(PF[(size_t)rs * DRNN + ch]) * cf + bf2f(PB[(size_t)rs * DRNN + ch]) * cbk)); }
}

__device__ __forceinline__ void phase_cmlp_rstd(Frame& F, const bf16* UV) {
    F.fresh();
    const int gw = F.bid * NWAVES + F.wave, NGW = F.G * NWAVES;
    for (int row = gw; row < M; row += NGW) { float s = 0.f;
        for (int c = F.lane; c < DB; c += 64) { const float v = bf2f(UV[(size_t)row * 2 * DB + DB + c]); s += v * v; }
        s = wave_sum(s); if (F.lane == 0) F.rstd[row] = rsqrtf(s * (1.f / DB) + EPS); }
}
__device__ __forceinline__ void phase_cmlp_spatial(Frame& F, const bf16* UV, bf16* ACT) {
    F.fresh();
    const float* ws = F.inp(I_CM_WS); const float* bs = F.inp(I_CM_BS); const float* ng = F.inp(I_CM_NG);
    const int gt = F.bid * NT + F.tid, GT = F.G * NT;
    for (int i = gt; i < M * DB; i += GT) { const int row = i / DB, ch = i % DB, g = ch >> 8, p = row & 127, r0 = row & ~127;
        float s = 0.f;
        for (int q = 0; q < 128; ++q) s += ws[(size_t)(g * 128 + p) * 128 + q] * F.rstd[r0 + q] * bf2f(UV[(size_t)(r0 + q) * 2 * DB + DB + ch]);
        const float sv = s * ng[ch] + bs[g * 128 + p];
        ACT[i] = (bf16)f2bf(bf2f(UV[(size_t)row * 2 * DB + ch]) * sv); }
}


constexpr int CM_VS = 544;
__device__ __forceinline__ void phase_cmlp_spatial_mfma(Frame& F, const bf16* UV, bf16* ACT, const bf16* WSB) {
    F.fresh();
    const int tid = F.tid, lane = F.lane, wave = F.wave, c = lane & 15, q4 = lane >> 4;
    LAS unsigned char* vt = F.lds;
    const float* ng = F.inp(I_CM_NG); const float* bs = F.inp(I_CM_BS);
    for (int u = F.bid; u < 640; u += F.G) {
        const int chunk = u >> 3, g = u & 7, r0 = chunk * 128;
        LAS float* rsl = (LAS float*)(vt + 128 * CM_VS);
        if (tid < 128) { const GAS f32x4* p = (const GAS f32x4*)(F.rsqv + (size_t)(r0 + tid) * 32); float sm = 0.f;
#pragma unroll
            for (int i = 0; i < 8; ++i) { const f32x4 t4 = p[i]; sm += (t4.x + t4.y) + (t4.z + t4.w); }
            rsl[tid] = rsqrtf(sm * (1.f / DB) + EPS); }
        __syncthreads();
#pragma unroll
        for (int i = 0; i < 8; ++i) { const int id = i * NT + tid, row = id >> 5, cc = id & 31;
            const u32x4 x = *(const GAS u32x4*)(UV + (size_t)(r0 + row) * 2 * DB + DB + g * 256 + 8 * cc); const float rs = rsl[row];
            u32x4 y; y.x = f2bf(bf2f(x.x) * rs) | (f2bf(bf2f(x.x >> 16) * rs) << 16); y.y = f2bf(bf2f(x.y) * rs) | (f2bf(bf2f(x.y >> 16) * rs) << 16);
            y.z = f2bf(bf2f(x.z) * rs) | (f2bf(bf2f(x.z >> 16) * rs) << 16); y.w = f2bf(bf2f(x.w) * rs) | (f2bf(bf2f(x.w >> 16) * rs) << 16);
            *(LAS u32x4*)(vt + row * CM_VS + 16 * cc) = y; }
        __syncthreads();
        bf16x8 vf[2][4];
#pragma unroll
        for (int mfc = 0; mfc < 2; ++mfc)
#pragma unroll
            for (int ks = 0; ks < 4; ++ks) { LAS const unsigned char* vp = vt + (32 * ks + 4 * q4 + (c >> 2)) * CM_VS + (32 * wave + 16 * mfc + 4 * (c & 3)) * 2;
                const v4i16_t lo = __builtin_amdgcn_ds_read_tr16_b64_v4i16((LAS v4i16_t*)vp), hi = __builtin_amdgcn_ds_read_tr16_b64_v4i16((LAS v4i16_t*)(vp + 16 * CM_VS));
                vf[mfc][ks] = (bf16x8){lo[0], lo[1], lo[2], lo[3], hi[0], hi[1], hi[2], hi[3]}; }
#pragma unroll
        for (int nf = 0; nf < 8; ++nf) {
            bf16x8 Bf[4];
#pragma unroll
            for (int ks = 0; ks < 4; ++ks) Bf[ks] = *(const GAS bf16x8*)(WSB + ((size_t)((g * 8 + nf) * 4 + ks) * 64 + lane) * 8);
            const int p = 16 * nf + c; const float bsv = bs[g * 128 + p];
#pragma unroll
            for (int mfc = 0; mfc < 2; ++mfc) { f32x4 acc = {0.f, 0.f, 0.f, 0.f};
#pragma unroll
                for (int ks = 0; ks < 4; ++ks) acc = __builtin_amdgcn_mfma_f32_16x16x32_bf16(vf[mfc][ks], Bf[ks], acc, 0, 0, 0);
                const int ch = g * 256 + 32 * wave + 16 * mfc + 4 * q4;
                const f32x4 g4 = *(const GAS f32x4*)(ng + ch); const u32x2 uu = *(const GAS u32x2*)(UV + (size_t)(r0 + p) * 2 * DB + ch);
                const float o0 = bf2f(uu.x) * (acc[0] * g4.x + bsv), o1 = bf2f(uu.x >> 16) * (acc[1] * g4.y + bsv), o2 = bf2f(uu.y) * (acc[2] * g4.z + bsv), o3 = bf2f(uu.y >> 16) * (acc[3] * g4.w + bsv);
                u32x2 w; w.x = f2bf(o0) | (f2bf(o1) << 16); w.y = f2bf(o2) | (f2bf(o3) << 16);
                *(GAS u32x2*)(ACT + (size_t)(r0 + p) * DB + ch) = w; }
        }
        __syncthreads();
    }
}

__device__ __forceinline__ void phase_qkv_post(Frame& F, const bf16* QKV, bf16* Q, bf16* KP, bf16* VP) {
    F.fresh();
    const int gw = F.bid * NWAVES + F.wave, NGW = F.G * NWAVES;
    const float* qkg = F.inp(I_AT_QKG);
    for (int row = gw; row < M; row += NGW) {
        const bool smp = row >= NPROMPT; const int sb = smp ? (row - NPROMPT) >> 10 : 0, t = smp ? (row - NPROMPT) & 1023 : 0;
        const float cs = smp ? F.rope[t * 32 + (F.lane & 31)] : 1.f, sn = smp ? F.rope[32768 + t * 32 + (F.lane & 31)] : 0.f;
        for (int grp = 0; grp < 32; ++grp) {
            const float v = bf2f(QKV[(size_t)row * 3072 + grp * 64 + F.lane]);
            const float ms = wave_sum(v * v) * (1.f / 64.f);
            float n = v * rsqrtf(ms + EPS) * qkg[(grp >> 4) * 64 + F.lane];
            const float keep = n;
            if (smp) { float pr; { auto r_ = __builtin_amdgcn_permlane32_swap(__builtin_bit_cast(unsigned, n), __builtin_bit_cast(unsigned, n), false, false); pr = __builtin_bit_cast(float, F.lane < 32 ? (unsigned)r_[1] : (unsigned)r_[0]); } n = F.lane < 32 ? n * cs - pr * sn : n * cs + pr * sn; }
            if (grp < 16) Q[(size_t)row * D + grp * 64 + F.lane] = (bf16)f2bf(n);
            else { const int c = (grp - 16) * 64 + F.lane;
                if (smp) F.KS[((size_t)sb * TKS + PAST + t) * D + c] = (bf16)f2bf(n);
                else { KP[(size_t)row * D + c] = (bf16)f2bf(keep); F.out[O_CK + (size_t)row * D + c] = keep; } }
        }
        for (int c = F.lane; c < D; c += 64) { const bf16 vb = QKV[(size_t)row * 3072 + 2048 + c];
            if (smp) F.VS[((size_t)sb * TKS + PAST + t) * D + c] = vb; else { VP[(size_t)row * D + c] = vb; F.out[O_CV + (size_t)row * D + c] = bf2f(vb); } }
    }
}
__device__ __forceinline__ void phase_attn_naive(Frame& F, int l, const bf16* Q, const bf16* KP, const bf16* VP, bf16* O) {
    F.fresh();
    const int gw = F.bid * NWAVES + F.wave, NGW = F.G * NWAVES;
    LAS float* s1 = (LAS float*)F.lds + F.wave * 3328; LAS float* s2 = s1 + 1536; LAS float* qs = s2 + 1536;
    const float* al = F.inp(I_AT_LAM);
    const float lam_init = 0.8f - 0.6f * expf(-0.3f * (float)l);
    const float lam = expf(wave_sum(al[F.lane] * al[64 + F.lane])) - expf(wave_sum(al[128 + F.lane] * al[192 + F.lane])) + lam_init;
    const float* sg = F.inp(I_AT_SUBG);
    for (int item = gw; item < M * 8; item += NGW) {
        const int row = item >> 3, h = item & 7;
        const bf16 *Kb, *Vb; int Tk;
        if (row < NPROMPT) { Kb = KP + (size_t)(row & ~255) * D; Vb = VP + (size_t)(row & ~255) * D; Tk = 256; }
        else { const int sb = (row - NPROMPT) >> 10; Kb = F.KS + (size_t)sb * TKS * D; Vb = F.VS + (size_t)sb * TKS * D; Tk = TKS; }
        qs[F.lane] = bf2f(Q[(size_t)row * D + h * 128 + F.lane]); qs[64 + F.lane] = bf2f(Q[(size_t)row * D + h * 128 + 64 + F.lane]);
        asm volatile("s_waitcnt lgkmcnt(0)" ::: "memory");
        float m1 = -1e30f, m2 = -1e30f;
        for (int k = F.lane; k < Tk; k += 64) { const bf16* kr = Kb + (size_t)k * D + h * 128; float d1 = 0.f, d2 = 0.f;
#pragma unroll 4
            for (int d = 0; d < 64; d += 2) { const unsigned a = *(const unsigned*)(kr + d), b = *(const unsigned*)(kr + 64 + d);
                d1 += qs[d] * bf2f(a) + qs[d + 1] * bf2f(a >> 16); d2 += qs[64 + d] * bf2f(b) + qs[64 + d + 1] * bf2f(b >> 16); }
            d1 *= 0.125f; d2 *= 0.125f; s1[k] = d1; s2[k] = d2; m1 = fmaxf(m1, d1); m2 = fmaxf(m2, d2); }
        m1 = wave_max(m1); m2 = wave_max(m2);
        float l1 = 0.f, l2 = 0.f;
        for (int k = F.lane; k < Tk; k += 64) { const float e1 = expf(s1[k] - m1), e2 = expf(s2[k] - m2); s1[k] = e1; s2[k] = e2; l1 += e1; l2 += e2; }
        l1 = wave_sum(l1); l2 = wave_sum(l2);
        const float i1 = 1.f / l1, i2 = lam / l2;
        for (int k = F.lane; k < Tk; k += 64) s1[k] = bf2f(f2bf(s1[k] * i1 - s2[k] * i2));
        asm volatile("s_waitcnt lgkmcnt(0)" ::: "memory");
        float o0 = 0.f, o1 = 0.f;
        for (int k = 0; k < Tk; ++k) { const unsigned vv = *(const unsigned*)(Vb + (size_t)k * D + h * 128 + 2 * F.lane); const float w = s1[k]; o0 += w * bf2f(vv); o1 += w * bf2f(vv >> 16); }
        const float ms = wave_sum(o0 * o0 + o1 * o1) * (1.f / 128.f), rs = rsqrtf(ms + EPS) * (1.f - lam_init);
        o0 = o0 * rs * sg[2 * F.lane]; o1 = o1 * rs * sg[2 * F.lane + 1];
        *(unsigned*)(O + (size_t)row * D + h * 128 + 2 * F.lane) = f2bf(o0) | (f2bf(o1) << 16);
        asm volatile("s_waitcnt lgkmcnt(0)" ::: "memory");
    }
}


constexpr int AT_KT = 128, AT_NMF = AT_KT / 16, AT_NCH = AT_KT / 32;
constexpr int AT_KS = 272, AT_VS = 288, AT_KBYTES = AT_KT * AT_KS, AT_VBYTES = AT_KT * AT_VS, AT_BUF = AT_KBYTES + AT_VBYTES;
__device__ __forceinline__ void attn_unit(Frame& F, int l, const bf16* Qrows  , const bf16* Kb, const bf16* Vb, int Tk, bf16* Orows, int h, float lam, float lam_init) {
    const int tid = F.tid, lane = F.lane, wave = F.wave, c = lane & 15, q4 = lane >> 4;
    LAS unsigned char* lds = F.lds;
    const float SC = 0.18033688f;
    bf16x8 Qf[2][2];
#pragma unroll
    for (int cp = 0; cp < 2; ++cp)
#pragma unroll
        for (int ks = 0; ks < 2; ++ks) Qf[cp][ks] = *(const GAS bf16x8*)(Qrows + (size_t)(16 * wave + c) * D + h * 128 + cp * 64 + 32 * ks + 8 * q4);
    const int nt = Tk / AT_KT;
    const int key0 = tid >> 4, cc0 = tid & 15;
    u32x4 kreg[AT_NCH], vreg[AT_NCH];
    float m1 = -1e30f, m2 = -1e30f, l1 = 0.f, l2 = 0.f;
#pragma unroll
    for (int i = 0; i < AT_NCH; ++i) kreg[i] = *(const GAS u32x4*)(Kb + (size_t)(key0 + 32 * i) * D + h * 128 + 8 * cc0);
#pragma unroll
    for (int i = 0; i < AT_NCH; ++i) *(LAS u32x4*)(lds + (key0 + 32 * i) * AT_KS + 16 * cc0) = kreg[i];
    __syncthreads();
    for (int t = 0; t < nt; ++t) {
        LAS const unsigned char* kt = lds + (t & 1) * AT_BUF;
        if (t + 1 < nt) {
#pragma unroll
            for (int i = 0; i < AT_NCH; ++i) kreg[i] = *(const GAS u32x4*)(Kb + (size_t)((t + 1) * AT_KT + key0 + 32 * i) * D + h * 128 + 8 * cc0); }
#pragma unroll
        for (int hf = 0; hf < AT_NMF / 4; ++hf) {
            f32x4 S[2][4];
#pragma unroll
            for (int cp = 0; cp < 2; ++cp)
#pragma unroll
                for (int mf = 0; mf < 4; ++mf) { S[cp][mf] = (f32x4){0.f, 0.f, 0.f, 0.f};
#pragma unroll
                    for (int ks = 0; ks < 2; ++ks) { const bf16x8 kf = *(LAS const bf16x8*)(kt + (64 * hf + 16 * mf + c) * AT_KS + cp * 128 + ks * 64 + 16 * q4);
                        S[cp][mf] = __builtin_amdgcn_mfma_f32_16x16x32_bf16(kf, Qf[cp][ks], S[cp][mf], 0, 0, 0); } }
            float x1 = -1e30f, x2 = -1e30f;
#pragma unroll
            for (int mf = 0; mf < 4; ++mf)
#pragma unroll
                for (int k = 0; k < 4; ++k) { x1 = fmaxf(x1, S[0][mf][k]); x2 = fmaxf(x2, S[1][mf][k]); }
            x1 = max_q4(x1); x2 = max_q4(x2);
            const float n1 = fmaxf(m1, x1), n2 = fmaxf(m2, x2);
            l1 *= __builtin_amdgcn_exp2f((m1 - n1) * SC); l2 *= __builtin_amdgcn_exp2f((m2 - n2) * SC); m1 = n1; m2 = n2;
            const float o1 = m1 * SC, o2 = m2 * SC;
#pragma unroll
            for (int mf = 0; mf < 4; ++mf)
#pragma unroll
                for (int k = 0; k < 4; ++k) { l1 += __builtin_amdgcn_exp2f(S[0][mf][k] * SC - o1); l2 += __builtin_amdgcn_exp2f(S[1][mf][k] * SC - o2); }
        }
        if (t + 1 < nt) {
#pragma unroll
            for (int i = 0; i < AT_NCH; ++i) *(LAS u32x4*)(lds + ((t + 1) & 1) * AT_BUF + (key0 + 32 * i) * AT_KS + 16 * cc0) = kreg[i]; }
        __syncthreads();
    }
    l1 = sum_q4(l1); l2 = sum_q4(l2);
    const float i1 = 1.f / l1, i2 = lam / l2, o1 = m1 * SC, o2 = m2 * SC;
    f32x4 Ot[8];
#pragma unroll
    for (int md = 0; md < 8; ++md) Ot[md] = (f32x4){0.f, 0.f, 0.f, 0.f};
#pragma unroll
    for (int i = 0; i < AT_NCH; ++i) { kreg[i] = *(const GAS u32x4*)(Kb + (size_t)(key0 + 32 * i) * D + h * 128 + 8 * cc0); vreg[i] = *(const GAS u32x4*)(Vb + (size_t)(key0 + 32 * i) * D + h * 128 + 8 * cc0); }
#pragma unroll
    for (int i = 0; i < AT_NCH; ++i) { *(LAS u32x4*)(lds + (key0 + 32 * i) * AT_KS + 16 * cc0) = kreg[i]; *(LAS u32x4*)(lds + AT_KBYTES + (key0 + 32 * i) * AT_VS + 16 * cc0) = vreg[i]; }
    __syncthreads();
    for (int t = 0; t < nt; ++t) {
        LAS const unsigned char* kt = lds + (t & 1) * AT_BUF; LAS const unsigned char* vt = kt + AT_KBYTES;
        if (t + 1 < nt) {
#pragma unroll
            for (int i = 0; i < AT_NCH; ++i) { kreg[i] = *(const GAS u32x4*)(Kb + (size_t)((t + 1) * AT_KT + key0 + 32 * i) * D + h * 128 + 8 * cc0);
                                               vreg[i] = *(const GAS u32x4*)(Vb + (size_t)((t + 1) * AT_KT + key0 + 32 * i) * D + h * 128 + 8 * cc0); } }
#pragma unroll
        for (int hf = 0; hf < AT_NMF / 4; ++hf) {
            f32x4 S[2][4];
#pragma unroll
            for (int cp = 0; cp < 2; ++cp)
#pragma unroll
                for (int mf = 0; mf < 4; ++mf) { S[cp][mf] = (f32x4){0.f, 0.f, 0.f, 0.f};
#pragma unroll
                    for (int ks = 0; ks < 2; ++ks) { const bf16x8 kf = *(LAS const bf16x8*)(kt + (64 * hf + 16 * mf + c) * AT_KS + cp * 128 + ks * 64 + 16 * q4);
                        S[cp][mf] = __builtin_amdgcn_mfma_f32_16x16x32_bf16(kf, Qf[cp][ks], S[cp][mf], 0, 0, 0); } }
            bf16x8 Wf[2];
#pragma unroll
            for (int kk = 0; kk < 2; ++kk) { float w[8];
#pragma unroll
                for (int jj = 0; jj < 8; ++jj) { const int mf = 2 * kk + (jj >> 2), k = jj & 3;
                    w[jj] = __builtin_amdgcn_exp2f(S[0][mf][k] * SC - o1) * i1 - __builtin_amdgcn_exp2f(S[1][mf][k] * SC - o2) * i2; }
                const unsigned p0 = pg8::cvt_pk_bf16(w[0], w[1]), p1 = pg8::cvt_pk_bf16(w[2], w[3]), p2 = pg8::cvt_pk_bf16(w[4], w[5]), p3 = pg8::cvt_pk_bf16(w[6], w[7]);
                Wf[kk] = __builtin_bit_cast(bf16x8, (u32x4){p0, p1, p2, p3}); }
#pragma unroll
            for (int md = 0; md < 8; ++md)
#pragma unroll
                for (int kk = 0; kk < 2; ++kk) { LAS const unsigned char* vp = vt + (64 * hf + 32 * kk + 4 * q4 + (c >> 2)) * AT_VS + (16 * md + 4 * (c & 3)) * 2;
                    const v4i16_t lo = __builtin_amdgcn_ds_read_tr16_b64_v4i16((LAS v4i16_t*)vp), hi = __builtin_amdgcn_ds_read_tr16_b64_v4i16((LAS v4i16_t*)(vp + 16 * AT_VS));
                    const bf16x8 vf = {lo[0], lo[1], lo[2], lo[3], hi[0], hi[1], hi[2], hi[3]};
                    Ot[md] = __builtin_amdgcn_mfma_f32_16x16x32_bf16(vf, Wf[kk], Ot[md], 0, 0, 0); }
        }
        if (t + 1 < nt) {
#pragma unroll
            for (int i = 0; i < AT_NCH; ++i) { *(LAS u32x4*)(lds + ((t + 1) & 1) * AT_BUF + (key0 + 32 * i) * AT_KS + 16 * cc0) = kreg[i];
                                               *(LAS u32x4*)(lds + ((t + 1) & 1) * AT_BUF + AT_KBYTES + (key0 + 32 * i) * AT_VS + 16 * cc0) = vreg[i]; } }
        __syncthreads();
    }
    float ss = 0.f;
#pragma unroll
    for (int md = 0; md < 8; ++md)
#pragma unroll
        for (int k = 0; k < 4; ++k) ss += Ot[md][k] * Ot[md][k];
    ss = sum_q4(ss);
    const float rs = rsqrtf(ss * (1.f / 128.f) + EPS) * (1.f - lam_init);
    const float* sg = F.inp(I_AT_SUBG);
#pragma unroll
    for (int md = 0; md < 8; ++md) { const int d0 = 16 * md + 4 * q4; const f32x4 g4 = *(const GAS f32x4*)(sg + d0);
        u32x2 w; w.x = pg8::cvt_pk_bf16(Ot[md][0] * rs * g4.x, Ot[md][1] * rs * g4.y); w.y = pg8::cvt_pk_bf16(Ot[md][2] * rs * g4.z, Ot[md][3] * rs * g4.w);
        *(GAS u32x2*)(Orows + (size_t)(16 * wave + c) * D + h * 128 + d0) = w; }
}
__device__ __forceinline__ void phase_attn(Frame& F, int l, const bf16* Q, const bf16* KP, const bf16* VP, bf16* O) {
    F.fresh();
    const float* al = F.inp(I_AT_LAM);
    const float lam_init = 0.8f - 0.6f * expf(-0.3f * (float)l);
    const float lam = expf(wave_sum(al[F.lane] * al[64 + F.lane])) - expf(wave_sum(al[128 + F.lane] * al[192 + F.lane])) + lam_init;
    for (int s = 0; ; ++s) {
        int u;
        if (F.G == 256) { if (F.bid < 128) { if (s > 0) break; u = F.bid; } else { if (s > 3) break; u = 128 + 4 * (F.bid - 128) + s; } }
        else { u = F.bid + s * F.G; if (u >= 640) break; }
        if (u < 128) { const int sb = u >> 6, h = (u >> 3) & 7, qt = u & 7; const size_t r0 = (size_t)NPROMPT + sb * 1024 + qt * 128;
            attn_unit(F, l, Q + r0 * D, F.KS + (size_t)sb * TKS * D, F.VS + (size_t)sb * TKS * D, TKS, O + r0 * D, h, lam, lam_init); }
        else { const int v = u - 128, b = v >> 4, h = (v >> 1) & 7, qt = v & 1; const size_t r0 = (size_t)b * 256 + qt * 128;
            attn_unit(F, l, Q + r0 * D, KP + (size_t)b * 256 * D, VP + (size_t)b * 256 * D, 256, O + r0 * D, h, lam, lam_init); }
    }
}

__device__ __forceinline__ void phase_ffn_convgate(Frame& F, int l, const bf16* Z, bf16* ACT) {
    F.fresh();
    const float* cw = F.inp(I_FF_CW) + (size_t)l * 3 * 2 * DFF; const float* cb = F.inp(I_FF_CB) + (size_t)l * 2 * DFF;
    const int gt = F.bid * NT + F.tid, GT = F.G * NT;
    for (int i = gt; i < M * DFF; i += GT) { const int row = i / DFF, j = i % DFF;
        int t, T; if (row < NPROMPT) { t = row & 255; T = 256; } else { t = (row - NPROMPT) & 1023; T = 1024; }
        float g = cb[j], u = cb[DFF + j];
#pragma unroll
        for (int k = 0; k < 3; ++k) { const int tt = t + k - 1; if (tt >= 0 && tt < T) { const bf16* zr = Z + (size_t)(row + k - 1) * 2 * DFF; g += cw[k * 2 * DFF + j] * bf2f(zr[j]); u += cw[k * 2 * DFF + DFF + j] * bf2f(zr[DFF + j]); } }
        ACT[i] = (bf16)f2bf(siluf_(g) * u); }
}

__global__ void __launch_bounds__(NT, 2) mk_fwd(Params prm) {
    extern __shared__ __attribute__((aligned(16))) unsigned char lds_raw[];
    Frame F;
    F.lds = (LAS unsigned char*)lds_raw; F.G = gridDim.x; F.out0 = prm.out; F.ws0 = prm.ws; F.wave0 = __builtin_amdgcn_readfirstlane(threadIdx.x >> 6);
    F.fresh();
    if (F.tid < N_IN) ((LAS unsigned long long*)(F.lds + PTR_OFF))[F.tid] = (unsigned long long)prm.in[F.tid];
    volatile LAS unsigned* MISC = (volatile LAS unsigned*)(F.lds + MISC_OFF);
    if (F.tid < 32) MISC[F.tid] = 0u;
    __syncthreads();
    (void)xcd_barrier_post((unsigned*)(prm.ws + WS_CTL) + CW_BAR, MISC + 8, F.tid == 0);
#define GRID_BAR() do { F.fresh(); XcdBarrier bar_; bar_.t0 = F.tid == 0; { unsigned* bp_ = (unsigned*)(prm.ws + WS_CTL) + CW_BAR; asm volatile("" : "+s"(bp_)); bar_.bar = bp_; } bar_.x = xb_xcc_id(); bar_.st = (volatile LAS unsigned*)(F.lds + MISC_OFF) + 8; xcd_barrier(bar_); } while (0)

#define GEMM_BF16(ACT, A_, Bt_, N_, K_, O_, ldc_, bias_, splitc_, splits_, rsq_, b2_, rsqv_, vt0_) do { pg8::Gemm g{A_, Bt_, M, N_, K_}; pg8::StaticOrder S; S.init(M, N_, F.G, F.bid); S.wave = F.wave; \
        pg8::EpiBf16<ACT> E{O_, ldc_, bias_, splitc_, splits_, rsq_, b2_, N_, rsqv_, vt0_, F.lds}; F.fresh(); E.prep(S, F.tid); pg8::gemm_phase<pg8::EpiBf16<ACT>, pg8::StaticOrder, true, true>(F.lds, g, S, E); } while (0)
#define GEMM_RESID(A_, Bt_, K_, sub_, fromin_) do { pg8::Gemm g{A_, Bt_, M, D, K_}; pg8::StaticOrder S; S.init(M, D, F.G, F.bid); S.wave = F.wave; \
        const int nl_ = (sub_) == 0 ? l : l + 1, ns_ = (sub_) == 0 ? 1 : 0; const bool last_ = nl_ >= DEPTH; \
        pg8::EpiResid E{F.out, F.inp(I_XP), F.inp(I_XS), F.mod + (size_t)l * 18 * D, (sub_) * 3 + 2, fromin_, last_ ? nullptr : F.H, F.inp(I_NORMG) + (size_t)((last_ ? 0 : nl_) * 2 + ns_) * D, \
                          F.mod + (size_t)(last_ ? 0 : nl_) * 18 * D, ns_ * 3 + 1, (sub_) == 0 ? F.rsq1 : F.rsq0, F.lds}; \
        F.fresh(); E.prep(S, F.tid); pg8::gemm_phase<pg8::EpiResid, pg8::StaticOrder, true, true>(F.lds, g, S, E); side_job(F, 2 * l + (sub_) + 1); } while (0)

    phase_prologue(F);
    GRID_BAR();
    phase_modulate0(F);
    GRID_BAR();
#pragma unroll 1
    for (int l = 0; l < DEPTH; ++l) {
        const int kind = l % 3, j = l / 3;
        F.fresh();
        if (kind == 0) {
            bf16 *GB = F.T2, *REC = F.T2 + (size_t)M * DRNN, *PF = F.T3, *PB = F.T3 + (size_t)NSAMPLE * DRNN, *HS = F.T3 + (size_t)6 * 1024 * 1024;
            float* AGG = (float*)(F.T3 + (size_t)2 * NSAMPLE * DRNN);
            GEMM_BF16(2, F.H, F.WT + WE_LRU_IN + (size_t)j * 2 * DRNN * D, 2 * DRNN, D, GB, DRNN, nullptr, DRNN, (size_t)M * DRNN, F.rsq0, F.bias2 + B2_LRU + (size_t)j * 3 * 2560, nullptr, 0);
            GRID_BAR();
            phase_lru_core(F, j, REC, GB, HS, PF, PB, AGG, F.WT + WE_WG + (size_t)j * 40 * 128 * 128);
            GRID_BAR();
            phase_lru_fixup(F, GB, HS, PF, PB, AGG);
            GRID_BAR();
            GEMM_RESID(HS, F.WT + WE_LRU_OUT + (size_t)j * D * DRNN, DRNN, 0, l == 0);
        } else if (kind == 1) {
            bf16 *UV = F.T1, *ACT = F.T2;
            GEMM_BF16(1, F.H, F.WT + WE_CM_IN, 2 * DB, D, UV, 2 * DB, F.inp(I_CM_BIN), 0, 0, F.rsq0, F.bias2 + B2_CM, F.rsqv, 8);
            GRID_BAR();
            phase_cmlp_spatial_mfma(F, UV, ACT, F.WT + WE_WSB);
            GRID_BAR();
            GEMM_RESID(ACT, F.WT + WE_CM_OUT, DB, 0, false);
        } else {
            bf16 *Q = F.T2, *KP = F.T2 + (size_t)M * D, *VP = KP + (size_t)NPROMPT * D, *O = F.T3;
            { pg8::Gemm g{F.H, F.WT + WE_QKV, M, 3 * D, D}; pg8::StaticOrder S; S.init(M, 3 * D, F.G, F.bid); S.wave = F.wave;
              pg8::EpiQkv E{F.ws, F.out, F.rsq0, F.bias2 + B2_QKV, F.lds, F.inp(I_AT_QKG), F.rope};
              F.fresh(); E.prep(S, F.tid); pg8::gemm_phase<pg8::EpiQkv, pg8::StaticOrder, true, true>(F.lds, g, S, E); }
            GRID_BAR();
            phase_attn(F, l, Q, KP, VP, O);
            GRID_BAR();
            GEMM_RESID(O, F.WT + WE_AT_OUT, D, 0, false);
        }
        GRID_BAR();
        { pg8::Gemm g{F.H, F.WT + WE_UP + (size_t)l * 2 * DFF * D, 42 * 256, 2 * DFF, D}; pg8::FfnOrder S; S.init(42 * 256, 2 * DFF, F.G, F.bid); S.wave = F.wave;
          pg8::EpiFfn E{F.T2, F.inp(I_FF_CW) + (size_t)l * 3 * 2 * DFF, F.inp(I_FF_CB) + (size_t)l * 2 * DFF, F.rsq1, F.bias2 + B2_UP + (size_t)l * 3 * 5632, F.lds};
          F.fresh(); E.prep(S, F.tid); pg8::gemm_phase<pg8::EpiFfn, pg8::FfnOrder, true, true>(F.lds, g, S, E); }
        GRID_BAR();
        GEMM_RESID(F.T2, F.WT + WE_DN + (size_t)l * D * DFF, DFF, 1, false);
        GRID_BAR();
    }
}

extern "C" void kernel_launch(void* const* d_in, const int* in_sizes, int n_in, void* d_out, int out_size, void* d_ws, size_t ws_size, hipStream_t stream) {
    static int grid = 0;
    if (grid == 0) {
        if (n_in != N_IN || ws_size < WS_END) { fprintf(stderr, "kernel_launch: unexpected n_in %d or ws_size %zu\n", n_in, ws_size); grid = -1; return; }
        int dev = 0, cus = 0, per_cu = 0;
        hipGetDevice(&dev); hipDeviceGetAttribute(&cus, hipDeviceAttributeMultiprocessorCount, dev);
        hipFuncSetAttribute((const void*)mk_fwd, hipFuncAttributeMaxDynamicSharedMemorySize, LDS_BYTES);
        hipOccupancyMaxActiveBlocksPerMultiprocessor(&per_cu, (const void*)mk_fwd, NT, LDS_BYTES);
        (void)hipGetLastError();
        if (per_cu < 1) { fprintf(stderr, "kernel_launch: occupancy query says %d blocks per CU\n", per_cu); per_cu = 1; }
        grid = cus;
    }
    if (grid < 0) return;
    hipMemsetAsync((char*)d_ws + WS_CTL, 0, CTL_ZERO_BYTES, stream);
    Params p{};
    for (int i = 0; i < N_IN; ++i) p.in[i] = (const float*)d_in[i];
    p.out = (float*)d_out; p.ws = (unsigned char*)d_ws;
    void* args[] = {&p};
    hipError_t e = hipLaunchCooperativeKernel((const void*)mk_fwd, dim3(grid), dim3(NT), args, LDS_BYTES, stream);
    if (e != hipSuccess) fprintf(stderr, "kernel_launch: cooperative launch failed: %s (grid %d)\n", hipGetErrorString(e), grid);
}
```

```cpp
#include <hip/hip_runtime.h>
#include <cstdio>
#include <cstdint>

#define GAS __attribute__((address_space(1)))
#define LAS __attribute__((address_space(3)))
typedef unsigned short bf16;
typedef float f32x4 __attribute__((ext_vector_type(4)));
typedef unsigned u32x2 __attribute__((ext_vector_type(2)));
typedef unsigned u32x4 __attribute__((ext_vector_type(4)));

constexpr int D = 1024, NPROMPT = 32 * 256, NSAMPLE = 2 * 1024, M = NPROMPT + NSAMPLE;
constexpr int DEPTH = 4, DRNN = 1280, DB = 2048, DFF = 2816, PAST = 512, TKS = PAST + 1024;
constexpr float EPS = 1e-6f;
constexpr int NWAVES = 8, NT = NWAVES * 64;

enum { I_XP = 0, I_XS, I_STATE, I_CK, I_CV, I_C, I_CCTX, I_WMOD, I_BMOD, I_NORMG, I_LRU_WIN, I_LRU_CW, I_LRU_CB, I_LRU_WG, I_LRU_BG, I_LRU_LAM, I_LRU_WOUT,
       I_CM_WIN, I_CM_BIN, I_CM_NG, I_CM_WS, I_CM_BS, I_CM_WOUT, I_AT_WQKV, I_AT_QKG, I_AT_LAM, I_AT_SUBG, I_AT_WOUT, I_FF_WUP, I_FF_CW, I_FF_CB, I_FF_WDN, N_IN };
constexpr size_t O_YP = 0, O_YS = (size_t)NPROMPT * D, O_STATE = (size_t)M * D, O_CK = O_STATE + 32 * 2 * 2 * DRNN, O_CV = O_CK + (size_t)NPROMPT * D;

constexpr size_t MiB = 1u << 20;
constexpr size_t WS_CTL = 0, CTL_ZERO_BYTES = 64 * 1024;
constexpr size_t WS_MOD = 1 * MiB;
constexpr size_t WS_RSTD = WS_MOD + 512 * 1024;
constexpr size_t WS_ROPE = WS_RSTD + 256 * 1024;
constexpr size_t WS_H = 2 * MiB;
constexpr size_t WS_T1 = 22 * MiB;
constexpr size_t WS_T2 = 132 * MiB;
constexpr size_t WS_T3 = 187 * MiB;
constexpr size_t WS_X = WS_T3 + 40 * MiB;
constexpr size_t B2_LRU = 0, B2_CM = B2_LRU + (size_t)2 * 3 * 2560, B2_QKV = B2_CM + (size_t)3 * 4096, B2_UP = B2_QKV + (size_t)3 * 3072, B2_END = B2_UP + (size_t)4 * 3 * 5632;
constexpr size_t WS_KS = 237 * MiB, WS_VS = 243 * MiB;
constexpr size_t WS_W = 249 * MiB;
constexpr size_t WE_LRU_IN = 0, WE_LRU_OUT = WE_LRU_IN + (size_t)2 * 2560 * 1024, WE_CM_IN = WE_LRU_OUT + (size_t)2 * 1024 * 1280, WE_CM_OUT = WE_CM_IN + (size_t)4096 * 1024,
                 WE_QKV = WE_CM_OUT + (size_t)1024 * 2048, WE_AT_OUT = WE_QKV + (size_t)3072 * 1024, WE_UP = WE_AT_OUT + (size_t)1024 * 1024, WE_DN = WE_UP + (size_t)4 * 5632 * 1024,
                 WE_WG = WE_DN + (size_t)4 * 1024 * 2816, WE_WSB = WE_WG + (size_t)80 * 128 * 128, WE_END = WE_WSB + (size_t)8 * 128 * 128;
constexpr size_t WS_END = WS_W + 106 * MiB;
static_assert(WE_END * 2 <= 106 * MiB, "weight copies fit");
constexpr int CW_BAR = 1024;
constexpr int CW_LRU = 8192;

constexpr int LDS_BYTES = 163840;
constexpr int MISC_OFF = LDS_BYTES - 256, PTR_OFF = LDS_BYTES - 1024;

__device__ __forceinline__ unsigned f2bf(float f) { unsigned u = __builtin_bit_cast(unsigned, f); return (u + 0x7fffu + ((u >> 16) & 1u)) >> 16; }
__device__ __forceinline__ float bf2f(unsigned b) { return __builtin_bit_cast(float, (b & 0xffffu) << 16); }
template <int CTRL> __device__ __forceinline__ float dppf(float v) { return __builtin_bit_cast(float, __builtin_amdgcn_update_dpp(0, __builtin_bit_cast(int, v), CTRL, 0xf, 0xf, false)); }
__device__ __forceinline__ float swz_xor16(float v) { return __builtin_bit_cast(float, __builtin_amdgcn_ds_swizzle(__builtin_bit_cast(int, v), 0x401F)); }
__device__ __forceinline__ float sum_x32(float v) { auto r = __builtin_amdgcn_permlane32_swap(__builtin_bit_cast(unsigned, v), __builtin_bit_cast(unsigned, v), false, false);
    return __builtin_bit_cast(float, (unsigned)r[0]) + __builtin_bit_cast(float, (unsigned)r[1]); }
__device__ __forceinline__ float max_x32(float v) { auto r = __builtin_amdgcn_permlane32_swap(__builtin_bit_cast(unsigned, v), __builtin_bit_cast(unsigned, v), false, false);
    return fmaxf(__builtin_bit_cast(float, (unsigned)r[0]), __builtin_bit_cast(float, (unsigned)r[1])); }
__device__ __forceinline__ float sum_q4(float v) { v += swz_xor16(v); return sum_x32(v); }
__device__ __forceinline__ float max_q4(float v) { v = fmaxf(v, swz_xor16(v)); return max_x32(v); }
__device__ __forceinline__ float wave_sum(float v) { v += dppf<0xB1>(v); v += dppf<0x4E>(v); v += dppf<0x141>(v); v += dppf<0x140>(v); return sum_q4(v); }
__device__ __forceinline__ float wave_max(float v) { v = fmaxf(v, dppf<0xB1>(v)); v = fmaxf(v, dppf<0x4E>(v)); v = fmaxf(v, dppf<0x141>(v)); v = fmaxf(v, dppf<0x140>(v)); return max_q4(v); }
__device__ __forceinline__ float bperm(float v, int src_lane) { return __builtin_bit_cast(float, __builtin_amdgcn_ds_bpermute(src_lane << 2, __builtin_bit_cast(int, v))); }
__device__ __forceinline__ float gelu_tanh(float x) {
    const float t = x * x * (-0.102943174f) + (-2.302208198f);
    return x * __builtin_amdgcn_rcpf(1.f + __builtin_amdgcn_exp2f(t * x)); }
__device__ __forceinline__ float sigmoidf_(float x) { return __builtin_amdgcn_rcpf(1.f + __builtin_amdgcn_exp2f(-1.44269504f * x)); }
__device__ __forceinline__ float siluf_(float x) { return x * __builtin_amdgcn_rcpf(1.f + __builtin_amdgcn_exp2f(-1.44269504f * x)); }
__device__ __forceinline__ float softplusf_(float x) { return fmaxf(x, 0.f) + log1pf(expf(-fabsf(x))); }

#define XB_TMO      128
#define XB_XCNT(j)  (256  + 64 * (j))
#define XB_XSUB(j)  (1280 + 64 * (j))
#define XB_XGEN(j)  (2304 + 64 * (j))
#define XB_TOP      3328
#define XB_TOPGEN   3392
#define XCD_BAR_WORDS 3456
#define XB_SPIN_CAP (1u << 22)
__device__ __forceinline__ unsigned xb_ld(unsigned* p)              { return __hip_atomic_load(p, __ATOMIC_RELAXED, __HIP_MEMORY_SCOPE_AGENT); }
__device__ __forceinline__ unsigned xb_add(unsigned* p, unsigned v) { return __hip_atomic_fetch_add(p, v, __ATOMIC_RELAXED, __HIP_MEMORY_SCOPE_AGENT); }
__device__ __forceinline__ unsigned xb_xcc_id() { return (unsigned)__builtin_amdgcn_s_getreg((3 << 11) | 20) & 0xFu; }
#define XB_SPIN(cond, bar) do { unsigned _sp = 0; while (cond) { __builtin_amdgcn_s_sleep(1); \
    if ((++_sp & 255u) == 0u) { if (xb_ld(&(bar)[XB_TMO])) break; if (_sp > XB_SPIN_CAP) { atomicAdd(&(bar)[XB_TMO], 1u); break; } } } } while (0)
struct XcdBarrier { unsigned* bar; unsigned x; volatile LAS unsigned* st; bool t0; };
__device__ __forceinline__ XcdBarrier xcd_barrier_post(unsigned* bar, volatile LAS unsigned* st, bool t0) {
    XcdBarrier b; b.bar = bar; b.x = xb_xcc_id(); b.st = st; b.t0 = t0;
    if (t0) (void)xb_add(&bar[XB_XCNT(b.x)], 1u);
    return b;
}
__device__ __forceinline__ void xcd_barrier_complete(unsigned* bar, unsigned x, unsigned& nloc, unsigned& nx) {
    const unsigned G = gridDim.x * gridDim.y * gridDim.z;
    unsigned sum, cnt, mine, sp = 0u;
    for (;;) {
        sum = 0u; cnt = 0u; mine = 0u;
#pragma unroll
        for (unsigned j = 0; j < 16; ++j) { const unsigned c = xb_ld(&bar[XB_XCNT(j)]); sum += c; cnt += (c > 0u) ? 1u : 0u; mine = (j == x) ? c : mine; }
        if (sum == G) break;
        __builtin_amdgcn_s_sleep(1);
        if ((++sp & 255u) == 0u) { if (xb_ld(&bar[XB_TMO])) break; if (sp > XB_SPIN_CAP) { atomicAdd(&bar[XB_TMO], 1u); break; } }
    }
    nloc = mine > 0u ? mine : 1u; nx = cnt > 0u ? cnt : 1u;
}
__device__ __forceinline__ void xcd_barrier(const XcdBarrier& b) {
    asm volatile("s_waitcnt vmcnt(0)" ::: "memory");
    __syncthreads();
    if (b.t0) {
        unsigned* bar = b.bar;
        __builtin_amdgcn_s_waitcnt(0);
        unsigned nloc = b.st[0], nx = b.st[1];
        if (nloc == 0u) { xcd_barrier_complete(bar, b.x, nloc, nx); b.st[0] = nloc; b.st[1] = nx; }
        const unsigned old = xb_add(&bar[XB_XSUB(b.x)], 1u);
        const unsigned gen = old / nloc;
        if (old + 1u == (gen + 1u) * nloc) {
            __builtin_amdgcn_fence(__ATOMIC_RELEASE, "agent");
            asm volatile("s_waitcnt vmcnt(0)" ::: "memory");
            const unsigned og = xb_add(&bar[XB_TOP], 1u);
            const unsigned tg = og / nx;
            if (og + 1u == (tg + 1u) * nx) xb_add(&bar[XB_TOPGEN], 1u);
            else XB_SPIN(xb_ld(&bar[XB_TOPGEN]) == tg, bar);
            __builtin_amdgcn_fence(__ATOMIC_ACQUIRE, "agent");
            xb_add(&bar[XB_XGEN(b.x)], 1u);
            asm volatile("s_waitcnt vmcnt(0)" ::: "memory");
        } else {
            XB_SPIN(xb_ld(&bar[XB_XGEN(b.x)]) == gen, bar);
            __builtin_amdgcn_fence(__ATOMIC_ACQUIRE, "agent");
            asm volatile("s_waitcnt vmcnt(0)" ::: "memory");
        }
    }
    __syncthreads();
}

namespace pg8 {
#define PG8_LAS __attribute__((address_space(3)))
typedef unsigned short bf16_t;
typedef short bf16x8 __attribute__((ext_vector_type(8)));
typedef float f32x4 __attribute__((ext_vector_type(4)));
typedef unsigned u32x4 __attribute__((ext_vector_type(4)));
constexpr int BM = 256, BK = 64, HALF = 128, HTB = HALF * BK * 2  , STAGE_BYTES = 8 * HTB, NXCD = 8, WGM = 8;

__host__ __device__ __forceinline__ int lds_byte(int r, int c) { const int st = (r >> 4) * 2 + (c >> 5), rr = r & 15, cc = c & 31, ob = rr * 64 + cc * 2; return st * 1024 + (ob ^ (((ob >> 9) & 1) << 5)); }
__host__ __device__ __forceinline__ void stage_rc(int b, int& R, int& C) { const int st = b / 1024, sb = b % 1024, swz = sb ^ (((sb >> 9) & 1) << 5); R = (st >> 1) * 16 + swz / 64; C = (st & 1) * 32 + (swz % 64) / 2; }
__host__ __device__ __forceinline__ int perm32(int rho) { const int n = rho >> 4, i = rho & 15; return 8 * (i >> 2) + 4 * n + (i & 3); }

struct Unit { int pm, pn; };
struct Gemm { const bf16_t* A; const bf16_t* Bt; int M, N, K; };

struct StaticOrder {
    int nM, nN, nwg, G, c, wave;
    __host__ __device__ void init(int M, int N, int G_, int c_) { nM = M / BM; nN = N / BM; nwg = nM * nN; G = G_; c = c_; }
    __host__ __device__ bool next(int i, Unit& u) const {
        const long L = (long)i * G + c; if (L >= nwg) return false;
        int wgid = (int)L; { const int q = nwg / NXCD, r = nwg % NXCD, xcd = wgid % NXCD, off = wgid / NXCD; wgid = (xcd < r ? xcd * (q + 1) : r * (q + 1) + (xcd - r) * q) + off; }
        const int nig = WGM * nN, gid = wgid / nig, fm = gid * WGM, gsz = (nM - fm) < WGM ? (nM - fm) : WGM;
        u.pm = fm + ((wgid % nig) % gsz); u.pn = (wgid % nig) / gsz; return true;
    }
    __device__ __forceinline__ int arow(int pm) const { return pm * BM; }
    __device__ __forceinline__ void a_ready(const Unit&) const {}
    __device__ __forceinline__ void done(const Unit&) const {}
};

template <class Epi, class Sched, bool ALIGN_EPI = false, bool SP2 = false>
__device__ __forceinline__ void gemm_phase(PG8_LAS unsigned char* lds, const Gemm g, const Sched& S, const Epi& E) {
    int z_ = 0; asm volatile("" : "+v"(z_));
    const int lane = __builtin_amdgcn_mbcnt_hi(~0u, __builtin_amdgcn_mbcnt_lo(~0u, z_)), wid = S.wave, tid = wid * 64 + lane, wr = wid >> 2, wc = wid & 3, fr = lane & 15, fq = lane >> 4;
    const int K = g.K, nt = K / BK;
    unsigned voffA[2], voffB[2];
#pragma unroll
    for (int i = 0; i < 2; ++i) { int R, C; stage_rc(tid * 16 + i * 8192, R, C); const int Rb = Epi::PERM ? ((R & ~31) + perm32(R & 31)) : R;
        voffA[i] = (unsigned)(R * K + C) * 2u; voffB[i] = (unsigned)(Rb * K + C) * 2u; }
    const size_t kstep = (size_t)(BK * 2);
    const size_t hstep = (size_t)HALF * K * 2;
    const size_t tstep = 2 * hstep;
    const unsigned ldsw = (unsigned)wid * 1024u;
    const int aoff = lds_byte(wr * 64 + fr, fq * 8), boff = lds_byte(wc * 32 + fr, fq * 8);
#define PG8_SA(b, h) (((b) * 2 + (h)) * HTB)
#define PG8_SB(b, h) ((4 + (b) * 2 + (h)) * HTB)
#define PG8_STAGE(bufoff, gbase, voff) do { _Pragma("unroll") for (int _i = 0; _i < 2; ++_i) \
        __builtin_amdgcn_global_load_lds((const unsigned*)((const char*)(gbase) + (voff)[_i]), (PG8_LAS unsigned*)(lds + (bufoff) + ldsw + _i * 8192), 16, 0, 0); } while (0)
#define PG8_LDA(dst, b, h) do { _Pragma("unroll") for (int m = 0; m < 4; ++m) _Pragma("unroll") for (int k = 0; k < 2; ++k) dst[m][k] = *(const PG8_LAS bf16x8*)(lds + PG8_SA(b, h) + aoff + m * 2048 + k * 1024); } while (0)
#define PG8_LDB(dst, b, h) do { _Pragma("unroll") for (int n = 0; n < 2; ++n) _Pragma("unroll") for (int k = 0; k < 2; ++k) dst[n][k] = *(const PG8_LAS bf16x8*)(lds + PG8_SB(b, h) + boff + n * 2048 + k * 1024); } while (0)
#define PG8_MMA(ai, bj, At, Bt) do { __builtin_amdgcn_s_setprio(1); _Pragma("unroll") for (int m = 0; m < 4; ++m) _Pragma("unroll") for (int n = 0; n < 2; ++n) _Pragma("unroll") for (int k = 0; k < 2; ++k) \
        acc[ai][bj][m][n] = __builtin_amdgcn_mfma_f32_16x16x32_bf16(Bt[n][k], At[m][k], acc[ai][bj][m][n], 0, 0, 0); __builtin_amdgcn_s_setprio(0); } while (0)
#define PG8_WAIT_V(n) asm volatile("s_waitcnt vmcnt(" #n ")" ::: "memory")
#define PG8_WAIT_L(n) asm volatile("s_waitcnt lgkmcnt(" #n ")" ::: "memory")
#define PG8_BAR __builtin_amdgcn_s_barrier()
#define PG8_SCHED __builtin_amdgcn_sched_barrier(0)
    Unit cur, nxt; int ui = 0;
    if (!S.next(0, cur)) return;
    f32x4 acc[2][2][4][2];
#pragma unroll
    for (int a = 0; a < 2; ++a)
#pragma unroll
        for (int b = 0; b < 2; ++b)
#pragma unroll
            for (int m = 0; m < 4; ++m)
#pragma unroll
                for (int n = 0; n < 2; ++n) acc[a][b][m][n] = (f32x4){0.f, 0.f, 0.f, 0.f};
    bf16x8 At[4][2], B0[2][2], B1[2][2];
    const char* cA = (const char*)g.A + (size_t)S.arow(cur.pm) * (size_t)K * 2; const char* cB = (const char*)g.Bt + (size_t)cur.pn * tstep;
    S.a_ready(cur);
    if constexpr (SP2) {
        PG8_STAGE(PG8_SB(0, 0), cB, voffB); PG8_STAGE(PG8_SB(0, 1), cB + hstep, voffB); PG8_STAGE(PG8_SA(0, 0), cA, voffA); PG8_STAGE(PG8_SA(0, 1), cA + hstep, voffA);
        if (wr == 1) PG8_BAR;
        PG8_WAIT_V(2); PG8_BAR;
        PG8_STAGE(PG8_SB(1, 0), cB + kstep, voffB); PG8_STAGE(PG8_SA(1, 0), cA + kstep, voffA); PG8_STAGE(PG8_SB(1, 1), cB + hstep + kstep, voffB);
        PG8_WAIT_V(6); PG8_BAR;
    } else {
        PG8_STAGE(PG8_SB(0, 0), cB, voffB); PG8_STAGE(PG8_SA(0, 0), cA, voffA); PG8_STAGE(PG8_SB(0, 1), cB + hstep, voffB); PG8_STAGE(PG8_SA(0, 1), cA + hstep, voffA);
        if (wr == 1) PG8_BAR;
        PG8_WAIT_V(4); PG8_BAR;
        PG8_STAGE(PG8_SB(1, 0), cB + kstep, voffB); PG8_STAGE(PG8_SA(1, 0), cA + kstep, voffA); PG8_STAGE(PG8_SB(1, 1), cB + hstep + kstep, voffB);
        PG8_WAIT_V(6); PG8_BAR;
    }
    for (;;) {
        const bool has_next = S.next(ui + 1, nxt);
        const char* nA = has_next ? (const char*)g.A + (size_t)S.arow(nxt.pm) * (size_t)K * 2 : cA; const char* nB = has_next ? (const char*)g.Bt + (size_t)nxt.pn * tstep : cB;
        for (int t = 0; t < nt; t += 2) {
            const bool last = (t == nt - 2);
            const char* a1 = cA + (size_t)(t + 1) * kstep;
            const char* a2 = last ? nA : cA + (size_t)(t + 2) * kstep; const char* b2 = last ? nB : cB + (size_t)(t + 2) * kstep;
            const char* a3 = a2 + kstep; const char* b3 = b2 + kstep;
            if (last && has_next) S.a_ready(nxt);
            if constexpr (SP2) {
            PG8_LDB(B0, 0, 0); PG8_LDB(B1, 0, 1); PG8_SCHED; PG8_LDA(At, 0, 0); PG8_STAGE(PG8_SA(1, 1), a1 + hstep, voffA);
            PG8_WAIT_V(8); PG8_WAIT_L(0); PG8_BAR; PG8_MMA(0, 0, At, B0); PG8_MMA(0, 1, At, B1); PG8_BAR; PG8_SCHED;
            PG8_LDA(At, 0, 1); PG8_STAGE(PG8_SB(0, 0), b2, voffB); PG8_STAGE(PG8_SB(0, 1), b2 + hstep, voffB); PG8_STAGE(PG8_SA(0, 0), a2, voffA);
            PG8_WAIT_V(8); PG8_WAIT_L(0); PG8_BAR; PG8_MMA(1, 0, At, B0); PG8_MMA(1, 1, At, B1); PG8_BAR; PG8_SCHED;
            PG8_LDB(B0, 1, 0); PG8_LDB(B1, 1, 1); PG8_SCHED; PG8_LDA(At, 1, 0); PG8_STAGE(PG8_SA(0, 1), a2 + hstep, voffA);
            PG8_WAIT_V(8); PG8_WAIT_L(0); PG8_BAR; PG8_MMA(0, 0, At, B0); PG8_MMA(0, 1, At, B1); PG8_BAR; PG8_SCHED;
            PG8_LDA(At, 1, 1); PG8_STAGE(PG8_SB(1, 0), b3, voffB); PG8_STAGE(PG8_SB(1, 1), b3 + hstep, voffB); PG8_STAGE(PG8_SA(1, 0), a3, voffA);
            PG8_WAIT_V(8); PG8_WAIT_L(0); PG8_BAR; PG8_MMA(1, 0, At, B0); PG8_MMA(1, 1, At, B1); PG8_BAR; PG8_SCHED;
            } else {
            PG8_LDB(B0, 0, 0); PG8_SCHED; PG8_LDA(At, 0, 0); PG8_STAGE(PG8_SA(1, 1), a1 + hstep, voffA);
            PG8_WAIT_L(8); PG8_BAR; PG8_WAIT_L(0); PG8_MMA(0, 0, At, B0); PG8_BAR; PG8_SCHED;
            PG8_LDB(B1, 0, 1); PG8_STAGE(PG8_SB(0, 0), b2, voffB);
            PG8_BAR; PG8_WAIT_L(0); PG8_MMA(0, 1, At, B1); PG8_BAR;
            PG8_LDA(At, 0, 1); PG8_STAGE(PG8_SA(0, 0), a2, voffA);
            PG8_BAR; PG8_WAIT_L(0); PG8_MMA(1, 0, At, B0); PG8_BAR; PG8_SCHED;
            PG8_STAGE(PG8_SB(0, 1), b2 + hstep, voffB);
            PG8_WAIT_V(6); PG8_BAR; PG8_MMA(1, 1, At, B1); PG8_BAR;
            PG8_LDB(B0, 1, 0); PG8_SCHED; PG8_LDA(At, 1, 0); PG8_STAGE(PG8_SA(0, 1), a2 + hstep, voffA);
            PG8_WAIT_L(8); PG8_BAR; PG8_WAIT_L(0); PG8_MMA(0, 0, At, B0); PG8_BAR; PG8_SCHED;
            PG8_LDB(B1, 1, 1); PG8_STAGE(PG8_SB(1, 0), b3, voffB);
            PG8_BAR; PG8_WAIT_L(0); PG8_MMA(0, 1, At, B1); PG8_BAR;
            PG8_LDA(At, 1, 1); PG8_STAGE(PG8_SA(1, 0), a3, voffA);
            PG8_BAR; PG8_WAIT_L(0); PG8_MMA(1, 0, At, B0); PG8_BAR; PG8_SCHED;
            PG8_STAGE(PG8_SB(1, 1), b3 + hstep, voffB);
            PG8_WAIT_V(6); PG8_BAR; PG8_MMA(1, 1, At, B1); PG8_BAR;
            }
        }
        if constexpr (ALIGN_EPI) { if (wr == 0) PG8_BAR; }
        if constexpr (!Epi::AFTER_DRAIN) { E(acc, cur, ui, wr, wc, fr, fq); S.done(cur); }
        if (!has_next) break;
#pragma unroll
        for (int a = 0; a < 2; ++a)
#pragma unroll
            for (int b = 0; b < 2; ++b)
#pragma unroll
                for (int m = 0; m < 4; ++m)
#pragma unroll
                    for (int n = 0; n < 2; ++n) acc[a][b][m][n] = (f32x4){0.f, 0.f, 0.f, 0.f};
        cur = nxt; cA = nA; cB = nB; ++ui;
        if constexpr (ALIGN_EPI) { if (wr == 1) PG8_BAR; }
    }
    PG8_WAIT_V(0);
    if constexpr (!ALIGN_EPI) { if (wr == 0) PG8_BAR; }
    PG8_BAR;
    if constexpr (Epi::AFTER_DRAIN) { E.fused(acc, cur, wr, wc, fr, fq, lds, wid, lane); S.done(cur); }
#undef PG8_SA
#undef PG8_SB
#undef PG8_STAGE
#undef PG8_LDA
#undef PG8_LDB
#undef PG8_MMA
#undef PG8_WAIT_V
#undef PG8_WAIT_L
#undef PG8_BAR
#undef PG8_SCHED
}
}

namespace pg8 {
__device__ __forceinline__ unsigned cvt_pk_bf16(float lo, float hi) { unsigned r; asm volatile("v_cvt_pk_bf16_f32 %0, %1, %2" : "=v"(r) : "v"(lo), "v"(hi)); return r; }
__device__ __forceinline__ f32x4 gelu4(f32x4 v) { f32x4 o; o.x = gelu_tanh(v.x); o.y = gelu_tanh(v.y); o.z = gelu_tanh(v.z); o.w = gelu_tanh(v.w); return o; }
constexpr int ETAB_OFF = 131072 + 8192, ETAB_SLOT = 4608, ETAB_MAXU = 4;
__device__ __forceinline__ float row_rstd(const float* rsq, int row) {
    const GAS f32x4* p = (const GAS f32x4*)(rsq + (size_t)row * 16);
    const f32x4 a = p[0], b = p[1], c = p[2], d = p[3];
    const float s = ((a.x + a.y) + (a.z + a.w)) + ((b.x + b.y) + (b.z + b.w)) + ((c.x + c.y) + (c.z + c.w)) + ((d.x + d.y) + (d.z + d.w));
    return rsqrtf(s * (1.f / D) + EPS);
}
__device__ __forceinline__ int tile_cidx(int trow) { return trow < NPROMPT ? 0 : 1 + ((trow - NPROMPT) >> 10); }
__device__ __forceinline__ PG8_LAS float* etab(PG8_LAS unsigned char* lds, int ui) { return (PG8_LAS float*)(lds + ETAB_OFF + ui * ETAB_SLOT); }

template <int ACT> struct EpiBf16 {
    static constexpr bool PERM = true, AFTER_DRAIN = false;
    bf16_t* O; int ldc; const float* bias; int split_cols; size_t split_stride; const float* rsq; const float* b2; int N; float* rsqv; int vt0; PG8_LAS unsigned char* lds;
    template <class Sched> __device__ __forceinline__ void prep(const Sched& S, int tid) const {
        Unit u;
        for (int i = 0; i < ETAB_MAXU && S.next(i, u); ++i) { PG8_LAS float* t = etab(lds, i);
            if (tid < 256) t[tid] = row_rstd(rsq, S.arow(u.pm) + tid);
            else { const int c = tid - 256, col = u.pn * BM + c; float v = b2[(size_t)tile_cidx(S.arow(u.pm)) * N + col]; if (bias) v += bias[col]; t[256 + c] = v; } }
        __syncthreads();
    }
    __device__ __forceinline__ void operator()(f32x4 (&acc)[2][2][4][2], const Unit& u, int ui, int wr, int wc, int fr, int fq) const {
        asm volatile("" : "+v"(fr), "+v"(fq));
        PG8_LAS const float* tb = etab(lds, ui);
        const int lrow0 = wr * 64 + fr; int colt = u.pn * BM; bf16_t* base = O; int t = 0;
        if (split_cols) { t = colt / split_cols; base += (size_t)t * split_stride; colt -= t * split_cols; }
        const bool act = (ACT == 1) || (ACT == 2 && t == 0);
        const int col0 = colt + wc * 32 + 8 * fq, tc0 = wc * 32 + 8 * fq;
        const bool wantv = ACT == 1 && rsqv != nullptr && u.pn >= vt0;
        GAS unsigned char* ob = (GAS unsigned char*)base;
        float ss[8];
#pragma unroll
        for (int i = 0; i < 8; ++i) ss[i] = 0.f;
#pragma unroll
        for (int bj = 0; bj < 2; ++bj) { const f32x4 bv0 = *(PG8_LAS const f32x4*)(tb + 256 + tc0 + bj * HALF), bv1 = *(PG8_LAS const f32x4*)(tb + 256 + tc0 + bj * HALF + 4);
#pragma unroll
            for (int ai = 0; ai < 2; ++ai)
#pragma unroll
                for (int m = 0; m < 4; ++m) { const int lrow = lrow0 + ai * HALF + m * 16; const float rs = tb[lrow];
                    f32x4 v0 = acc[ai][bj][m][0] * rs + bv0, v1 = acc[ai][bj][m][1] * rs + bv1;
                    if (ACT != 0) { if (act) { v0 = gelu4(v0); v1 = gelu4(v1); } }
                    if (ACT == 1) ss[ai * 4 + m] += (v0[0] * v0[0] + v0[1] * v0[1]) + (v0[2] * v0[2] + v0[3] * v0[3]) + (v1[0] * v1[0] + v1[1] * v1[1]) + (v1[2] * v1[2] + v1[3] * v1[3]);
                    u32x4 w; w.x = cvt_pk_bf16(v0[0], v0[1]); w.y = cvt_pk_bf16(v0[2], v0[3]); w.z = cvt_pk_bf16(v1[0], v1[1]); w.w = cvt_pk_bf16(v1[2], v1[3]);
                    *(GAS u32x4*)(ob + ((unsigned)(u.pm * BM + lrow) * (unsigned)ldc + col0 + bj * HALF) * 2u) = w;
                    __builtin_amdgcn_sched_barrier(0); } }
        if (wantv) {
#pragma unroll
            for (int i = 0; i < 8; ++i) { const float q = sum_q4(ss[i]);
                if (fq == 0) *(GAS float*)(rsqv + (size_t)(u.pm * BM + lrow0 + (i >> 2) * HALF + (i & 3) * 16) * 32 + (u.pn - vt0) * 4 + wc) = q; } }
    }
};
struct EpiResid {
    static constexpr bool PERM = true, AFTER_DRAIN = false;
    float* out; const float* xp; const float* xs; const float* modl; int which; bool from_input;
    bf16_t* H; const float* ng; const float* modn; int whichs; float* rsq_out; PG8_LAS unsigned char* lds;
    template <class Sched> __device__ __forceinline__ void prep(const Sched& S, int tid) const {
        Unit u;
        for (int i = 0; i < ETAB_MAXU && S.next(i, u); ++i) { PG8_LAS float* t = etab(lds, i);
            if (tid < 256) { const int ci = tile_cidx(u.pm * BM), col = u.pn * BM + tid; t[256 + tid] = modl[(size_t)(ci * 6 + which) * D + col];
                t[512 + tid] = H ? ng[col] * (1.f + modn[(size_t)(ci * 6 + whichs) * D + col]) : 0.f; } }
        __syncthreads();
    }
    __device__ __forceinline__ void operator()(f32x4 (&acc)[2][2][4][2], const Unit& u, int ui, int wr, int wc, int fr, int fq) const {
        asm volatile("" : "+v"(fr), "+v"(fq));
        PG8_LAS const float* tb = etab(lds, ui);
        const int trow = u.pm * BM, row0 = wr * 64 + fr, tc0 = wc * 32 + 8 * fq, col0 = u.pn * BM + tc0;
        const GAS unsigned char* bpg = (const GAS unsigned char*)(from_input ? (trow < NPROMPT ? xp + (size_t)trow * D : xs + (size_t)(trow - NPROMPT) * D) : out + (size_t)trow * D);
        GAS unsigned char* op = (GAS unsigned char*)(out + (size_t)trow * D); GAS unsigned char* hb = (GAS unsigned char*)H;
#pragma unroll
        for (int ai = 0; ai < 2; ++ai) {
            f32x4 x[2][4][2];
#pragma unroll
            for (int bj = 0; bj < 2; ++bj)
#pragma unroll
                for (int m = 0; m < 4; ++m)
#pragma unroll
                    for (int n = 0; n < 2; ++n) x[bj][m][n] = *(const GAS f32x4*)(bpg + ((unsigned)(row0 + ai * HALF + m * 16) * (unsigned)D + col0 + bj * HALF + 4 * n) * 4u);
            float ss[4] = {0.f, 0.f, 0.f, 0.f};
#pragma unroll
            for (int bj = 0; bj < 2; ++bj) { const f32x4 gv0 = *(PG8_LAS const f32x4*)(tb + 256 + tc0 + bj * HALF), gv1 = *(PG8_LAS const f32x4*)(tb + 256 + tc0 + bj * HALF + 4);
                const f32x4 gs0 = *(PG8_LAS const f32x4*)(tb + 512 + tc0 + bj * HALF), gs1 = *(PG8_LAS const f32x4*)(tb + 512 + tc0 + bj * HALF + 4);
#pragma unroll
                for (int m = 0; m < 4; ++m) { const unsigned lrow = row0 + ai * HALF + m * 16, eo = lrow * (unsigned)D + col0 + bj * HALF;
                    const f32x4 x0 = x[bj][m][0] + gv0 * acc[ai][bj][m][0], x1 = x[bj][m][1] + gv1 * acc[ai][bj][m][1];
                    *(GAS f32x4*)(op + eo * 4u) = x0; *(GAS f32x4*)(op + eo * 4u + 16) = x1;
                    if (H) { ss[m] += (x0[0] * x0[0] + x0[1] * x0[1]) + (x0[2] * x0[2] + x0[3] * x0[3]) + (x1[0] * x1[0] + x1[1] * x1[1]) + (x1[2] * x1[2] + x1[3] * x1[3]);
                        const f32x4 a0 = x0 * gs0, a1 = x1 * gs1;
                        u32x4 w; w.x = cvt_pk_bf16(a0[0], a0[1]); w.y = cvt_pk_bf16(a0[2], a0[3]); w.z = cvt_pk_bf16(a1[0], a1[1]); w.w = cvt_pk_bf16(a1[2], a1[3]);
                        *(GAS u32x4*)(hb + ((unsigned)trow * (unsigned)D + eo) * 2u) = w; } } }
            if (H) {
#pragma unroll
                for (int m = 0; m < 4; ++m) { const float q = sum_q4(ss[m]);
                    if (fq == 0) *(GAS float*)(rsq_out + (size_t)(trow + row0 + ai * HALF + m * 16) * 16 + u.pn * 4 + wc) = q; } }
            asm volatile("" ::: "memory");
        }
    }
};

__device__ __forceinline__ void ffn_tile_geom(int pm, int& rs, int& vlo, int& vhi) {
    if (pm < 32) { rs = 256 * pm; vlo = 0; vhi = 255; }
    else { const int sq = (pm - 32) / 5, i = (pm - 32) % 5; rs = NPROMPT + 1024 * sq + (i < 4 ? 254 * i : 768); vlo = i == 0 ? 0 : (i < 4 ? 1 : 249); vhi = i < 4 ? 254 : 255; }
}
struct FfnOrder : StaticOrder {
    __device__ __forceinline__ int arow(int pm) const { int rs, a, b; ffn_tile_geom(pm, rs, a, b); return rs; }
};
template <int CTRL> __device__ __forceinline__ float dpp0(float v) { return __builtin_bit_cast(float, __builtin_amdgcn_update_dpp(0, __builtin_bit_cast(int, v), CTRL, 0xf, 0xf, true)); }
struct EpiFfn {
    static constexpr bool PERM = true, AFTER_DRAIN = false;
    bf16_t* ACT; const float* cw; const float* cb; const float* rsq; const float* b2; PG8_LAS unsigned char* lds;
    template <class Sched> __device__ __forceinline__ void prep(const Sched& S, int tid) const {
        Unit u;
        for (int i = 0; i < ETAB_MAXU && S.next(i, u); ++i) { PG8_LAS float* t = etab(lds, i); const int rs = S.arow(u.pm);
            if (tid < 256) t[tid] = row_rstd(rsq, rs + tid);
            else { const int c = tid - 256, ch = (c < 128 ? 0 : DFF) + u.pn * 128 + (c & 127);
                t[256 + c] = b2[(size_t)tile_cidx(rs) * 2 * DFF + u.pn * 256 + c]; t[512 + c] = cb[ch];
                PG8_LAS unsigned short* tw = (PG8_LAS unsigned short*)(t + 768);
#pragma unroll
                for (int k = 0; k < 3; ++k) tw[k * 256 + c] = (unsigned short)f2bf(cw[(size_t)k * 2 * DFF + ch]); } }
        __syncthreads();
    }
    __device__ __forceinline__ void operator()(f32x4 (&acc)[2][2][4][2], const Unit& u, int ui, int wr, int wc, int fr, int fq) const {
        asm volatile("" : "+v"(fr), "+v"(fq));
        PG8_LAS const float* tb = etab(lds, ui); PG8_LAS float* xb = (PG8_LAS float*)(lds + 131072);
        int rs, vlo, vhi; ffn_tile_geom(u.pm, rs, vlo, vhi);
        const int colw = wc * 32 + 8 * fq;
#pragma unroll
        for (int bj = 0; bj < 2; ++bj) { const f32x4 bz0 = *(PG8_LAS const f32x4*)(tb + 256 + bj * 128 + colw), bz1 = *(PG8_LAS const f32x4*)(tb + 256 + bj * 128 + colw + 4);
#pragma unroll
            for (int ai = 0; ai < 2; ++ai)
#pragma unroll
                for (int m = 0; m < 4; ++m) { const float rsd = tb[128 * ai + 64 * wr + 16 * m + fr];
                    acc[ai][bj][m][0] = acc[ai][bj][m][0] * rsd + bz0; acc[ai][bj][m][1] = acc[ai][bj][m][1] * rsd + bz1; } }
#pragma unroll
        for (int ai = 0; ai < 2; ++ai) { const int b = 2 * ai + wr;
            if (fr == 0) {
#pragma unroll
                for (int bj = 0; bj < 2; ++bj)
#pragma unroll
                    for (int n = 0; n < 2; ++n) *(PG8_LAS f32x4*)(xb + (b * 2 + 0) * 256 + bj * 128 + colw + 4 * n) = acc[ai][bj][0][n]; }
            if (fr == 15) {
#pragma unroll
                for (int bj = 0; bj < 2; ++bj)
#pragma unroll
                    for (int n = 0; n < 2; ++n) *(PG8_LAS f32x4*)(xb + (b * 2 + 1) * 256 + bj * 128 + colw + 4 * n) = acc[ai][bj][3][n]; } }
        asm volatile("s_waitcnt lgkmcnt(0)" ::: "memory"); __builtin_amdgcn_s_barrier(); asm volatile("" ::: "memory");
        GAS unsigned char* actb = (GAS unsigned char*)ACT;
        const unsigned lane_off = (unsigned)((rs + 64 * wr + fr) * DFF + u.pn * 128 + colw) * 2u;
        PG8_LAS const unsigned short* tw = (PG8_LAS const unsigned short*)(tb + 768);
#pragma unroll
        for (int n = 0; n < 2; ++n) {
            f32x4 wg[3], wu[3];
#pragma unroll
            for (int k = 0; k < 3; ++k) { const u32x2 pg = *(PG8_LAS const u32x2*)(tw + k * 256 + colw + 4 * n), pu = *(PG8_LAS const u32x2*)(tw + k * 256 + 128 + colw + 4 * n);
                wg[k] = (f32x4){__builtin_bit_cast(float, pg.x << 16), __builtin_bit_cast(float, pg.x & 0xffff0000u), __builtin_bit_cast(float, pg.y << 16), __builtin_bit_cast(float, pg.y & 0xffff0000u)};
                wu[k] = (f32x4){__builtin_bit_cast(float, pu.x << 16), __builtin_bit_cast(float, pu.x & 0xffff0000u), __builtin_bit_cast(float, pu.y << 16), __builtin_bit_cast(float, pu.y & 0xffff0000u)}; }
            const f32x4 bgv = *(PG8_LAS const f32x4*)(tb + 512 + colw + 4 * n), buv = *(PG8_LAS const f32x4*)(tb + 512 + 128 + colw + 4 * n);
#pragma unroll
            for (int ai = 0; ai < 2; ++ai) { const int b = 2 * ai + wr;
                f32x4 pz[2], nz[2];
#pragma unroll
                for (int bj = 0; bj < 2; ++bj) { pz[bj] = b > 0 ? *(PG8_LAS const f32x4*)(xb + ((b - 1) * 2 + 1) * 256 + bj * 128 + colw + 4 * n) : (f32x4){0.f, 0.f, 0.f, 0.f};
                                                 nz[bj] = b < 3 ? *(PG8_LAS const f32x4*)(xb + ((b + 1) * 2 + 0) * 256 + bj * 128 + colw + 4 * n) : (f32x4){0.f, 0.f, 0.f, 0.f}; }
#pragma unroll
                for (int m = 0; m < 4; ++m) { f32x4 zc[2];
#pragma unroll
                    for (int bj = 0; bj < 2; ++bj) { const f32x4 z = acc[ai][bj][m][n]; const f32x4* w3 = bj == 0 ? wg : wu; f32x4 o = bj == 0 ? bgv : buv;
#pragma unroll
                        for (int e = 0; e < 4; ++e) { float a = fmaf(w3[1][e], z[e], o[e]);
                            const float w0e = fr == 0 ? w3[0][e] : 0.f, w2e = fr == 15 ? w3[2][e] : 0.f;
                            asm("v_fmac_f32_dpp %0, %1, %2 row_shr:1 row_mask:0xf bank_mask:0xf bound_ctrl:1" : "+v"(a) : "v"(z[e]), "v"(w3[0][e]));
                            asm("v_fmac_f32_dpp %0, %1, %2 row_shl:1 row_mask:0xf bank_mask:0xf bound_ctrl:1" : "+v"(a) : "v"(z[e]), "v"(w3[2][e]));
                            if (m > 0) { const float zp = acc[ai][bj][m - 1][n][e]; asm("v_fmac_f32_dpp %0, %1, %2 row_ror:1 row_mask:0xf bank_mask:0xf bound_ctrl:1" : "+v"(a) : "v"(zp), "v"(w0e)); } else a = fmaf(pz[bj][e], w0e, a);
                            if (m < 3) { const float zn = acc[ai][bj][m + 1][n][e]; asm("v_fmac_f32_dpp %0, %1, %2 row_ror:15 row_mask:0xf bank_mask:0xf bound_ctrl:1" : "+v"(a) : "v"(zn), "v"(w2e)); } else a = fmaf(nz[bj][e], w2e, a);
                            o[e] = a; }
                        zc[bj] = o; }
                    const int lr = 128 * ai + 64 * wr + 16 * m + fr;
                    if (lr >= vlo && lr <= vhi) { u32x2 w; w.x = cvt_pk_bf16(siluf_(zc[0][0]) * zc[1][0], siluf_(zc[0][1]) * zc[1][1]); w.y = cvt_pk_bf16(siluf_(zc[0][2]) * zc[1][2], siluf_(zc[0][3]) * zc[1][3]);
                        *(GAS u32x2*)(actb + (lane_off + (unsigned)((128 * ai + 16 * m) * DFF + 4 * n) * 2u)) = w; } } }
        }
    }
};

struct EpiQkv {
    static constexpr bool PERM = true, AFTER_DRAIN = false;
    unsigned char* ws; float* out; const float* rsq; const float* b2; PG8_LAS unsigned char* lds; const float* qkg; const float* rope;
    template <class Sched> __device__ __forceinline__ void prep(const Sched& S, int tid) const {
        Unit u;
        for (int i = 0; i < ETAB_MAXU && S.next(i, u); ++i) { PG8_LAS float* t = etab(lds, i);
            if (tid < 256) t[tid] = row_rstd(rsq, u.pm * BM + tid);
            else { const int c = tid - 256; t[256 + c] = b2[(size_t)tile_cidx(u.pm * BM) * 3 * D + u.pn * BM + c]; } }
        __syncthreads();
    }
    __device__ __forceinline__ void operator()(f32x4 (&acc)[2][2][4][2], const Unit& u, int ui, int wr, int wc, int fr, int fq) const {
        asm volatile("" : "+v"(fr), "+v"(fq));
        PG8_LAS const float* tb = etab(lds, ui);
        const int trow = u.pm * BM; const bool smp = trow >= NPROMPT; const int sb = smp ? (trow - NPROMPT) >> 10 : 0, tq0 = smp ? (trow - NPROMPT) & 1023 : 0;
        const int kind = u.pn >> 2, tc0 = wc * 32 + 8 * fq;
        if (kind < 2) {
            const int oc = (u.pn & 3) * 256 + wc * 64 + 8 * fq;
            f32x4 bz[2][2], gq[2][2];
#pragma unroll
            for (int bj = 0; bj < 2; ++bj)
#pragma unroll
                for (int n = 0; n < 2; ++n) { bz[bj][n] = *(PG8_LAS const f32x4*)(tb + 256 + tc0 + bj * HALF + 4 * n); gq[bj][n] = *(const GAS f32x4*)(qkg + kind * 64 + 32 * bj + 8 * fq + 4 * n); }
            const size_t doff = kind == 0 ? WS_T2 : (smp ? WS_KS : WS_T2 + (size_t)M * D * 2); GAS unsigned char* dst = (GAS unsigned char*)ws + doff;
#pragma unroll
            for (int ai = 0; ai < 2; ++ai) {
                f32x4 cs[4][2], sn[4][2];
#pragma unroll
                for (int m = 0; m < 4; ++m) { const int lrow = 128 * ai + 64 * wr + 16 * m + fr; const float rs = tb[lrow];
                    if (smp && (m & 1) == 0) {
#pragma unroll
                        for (int mm = m; mm < m + 2; ++mm)
#pragma unroll
                            for (int n = 0; n < 2; ++n) { const int t = tq0 + 128 * ai + 64 * wr + 16 * mm + fr; cs[mm][n] = *(const GAS f32x4*)(rope + t * 32 + 8 * fq + 4 * n); sn[mm][n] = *(const GAS f32x4*)(rope + 32768 + t * 32 + 8 * fq + 4 * n); } }
                    f32x4 v[2][2]; float ss = 0.f;
#pragma unroll
                    for (int bj = 0; bj < 2; ++bj)
#pragma unroll
                        for (int n = 0; n < 2; ++n) { v[bj][n] = acc[ai][bj][m][n] * rs + bz[bj][n]; ss += (v[bj][n][0] * v[bj][n][0] + v[bj][n][1] * v[bj][n][1]) + (v[bj][n][2] * v[bj][n][2] + v[bj][n][3] * v[bj][n][3]); }
                    ss = sum_q4(ss);
                    const float rn = rsqrtf(ss * (1.f / 64.f) + EPS);
#pragma unroll
                    for (int bj = 0; bj < 2; ++bj)
#pragma unroll
                        for (int n = 0; n < 2; ++n) v[bj][n] = v[bj][n] * rn * gq[bj][n];
                    const unsigned row = (unsigned)(trow + lrow);
                    if (!smp) {
                        if (kind == 1) {
#pragma unroll
                            for (int bj = 0; bj < 2; ++bj)
#pragma unroll
                                for (int n = 0; n < 2; ++n) *(GAS f32x4*)((GAS unsigned char*)out + O_CK * 4 + (row * (unsigned)D + oc + 32 * bj + 4 * n) * 4u) = v[bj][n]; }
                    } else {
#pragma unroll
                        for (int n = 0; n < 2; ++n) { const f32x4 x1 = v[0][n], x2 = v[1][n]; v[0][n] = x1 * cs[m][n] - x2 * sn[m][n]; v[1][n] = x2 * cs[m][n] + x1 * sn[m][n]; } }
                    const unsigned drow = (kind == 1 && smp) ? (unsigned)(sb * TKS + PAST + tq0 + lrow) : row;
#pragma unroll
                    for (int bj = 0; bj < 2; ++bj) { u32x4 w; w.x = cvt_pk_bf16(v[bj][0][0], v[bj][0][1]); w.y = cvt_pk_bf16(v[bj][0][2], v[bj][0][3]); w.z = cvt_pk_bf16(v[bj][1][0], v[bj][1][1]); w.w = cvt_pk_bf16(v[bj][1][2], v[bj][1][3]);
                        *(GAS u32x4*)(dst + (drow * (unsigned)D + oc + 32 * bj) * 2u) = w; }
                    if (m & 1) { asm volatile("" ::: "memory"); __builtin_amdgcn_sched_barrier(0); } } }
        } else {
            const int oc = (u.pn - 8) * 256 + wc * 32 + 8 * fq;
            const size_t doff = smp ? WS_VS : WS_T2 + (size_t)M * D * 2 + (size_t)NPROMPT * D * 2; GAS unsigned char* dst = (GAS unsigned char*)ws + doff;
#pragma unroll
            for (int bj = 0; bj < 2; ++bj) { const f32x4 bz0 = *(PG8_LAS const f32x4*)(tb + 256 + tc0 + bj * HALF), bz1 = *(PG8_LAS const f32x4*)(tb + 256 + tc0 + bj * HALF + 4);
#pragma unroll
                for (int ai = 0; ai < 2; ++ai)
#pragma unroll
                    for (int m = 0; m < 4; ++m) { const int lrow = 128 * ai + 64 * wr + 16 * m + fr; const float rs = tb[lrow];
                        const f32x4 v0 = acc[ai][bj][m][0] * rs + bz0, v1 = acc[ai][bj][m][1] * rs + bz1;
                        const unsigned row = (unsigned)(trow + lrow), drow = smp ? (unsigned)(sb * TKS + PAST + tq0 + lrow) : row;
                        u32x4 w; w.x = cvt_pk_bf16(v0[0], v0[1]); w.y = cvt_pk_bf16(v0[2], v0[3]); w.z = cvt_pk_bf16(v1[0], v1[1]); w.w = cvt_pk_bf16(v1[2], v1[3]);
                        *(GAS u32x4*)(dst + (drow * (unsigned)D + oc + 128 * bj) * 2u) = w;
                        if (!smp) { *(GAS f32x4*)((GAS unsigned char*)out + O_CV * 4 + (row * (unsigned)D + oc + 128 * bj) * 4u) = v0; *(GAS f32x4*)((GAS unsigned char*)out + O_CV * 4 + (row * (unsigned)D + oc + 128 * bj + 4) * 4u) = v1; } } }
        }
    }
};
}

struct Params { const float* in[N_IN]; float* out; unsigned char* ws; };
struct Frame {
    LAS unsigned char* lds; int tid, lane, wave, bid, G, wave0;
    float* out; unsigned char* ws; float* out0; unsigned char* ws0;
    __device__ __forceinline__ const float* inp(int i) const { const unsigned long long v = ((LAS const unsigned long long*)(lds + PTR_OFF))[i];
        const unsigned lo = __builtin_amdgcn_readfirstlane((unsigned)v), hi = __builtin_amdgcn_readfirstlane((unsigned)(v >> 32)); return (const float*)(const GAS float*)(((unsigned long long)hi << 32) | lo); }
    float* mod; float* rstd; float* rope; bf16 *H, *T1, *T2, *T3, *KS, *VS, *WT; float *rsq0, *rsq1, *rsqv, *bias2;
    __device__ __forceinline__ void fresh() {
        int z = 0; asm volatile("" : "+v"(z));
        lane = __builtin_amdgcn_mbcnt_hi(~0u, __builtin_amdgcn_mbcnt_lo(~0u, z)); int wv = wave0; asm volatile("" : "+s"(wv)); wave = wv; tid = wv * 64 + lane;
        int b = blockIdx.x; asm volatile("" : "+s"(b)); bid = b;
        unsigned char* w = ws0; asm volatile("" : "+s"(w)); w = (unsigned char*)(GAS unsigned char*)(unsigned long long)w; ws = w; float* o = out0; asm volatile("" : "+s"(o)); o = (float*)(GAS float*)(unsigned long long)o; out = o;
        mod = (float*)(w + WS_MOD); rstd = (float*)(w + WS_RSTD); rope = (float*)(w + WS_ROPE);
        H = (bf16*)(w + WS_H); T1 = (bf16*)(w + WS_T1); T2 = (bf16*)(w + WS_T2); T3 = (bf16*)(w + WS_T3); KS = (bf16*)(w + WS_KS); VS = (bf16*)(w + WS_VS); WT = (bf16*)(w + WS_W);
        rsq0 = (float*)(w + WS_X); rsq1 = (float*)(w + WS_X + MiB); rsqv = (float*)(w + WS_X + 2 * MiB); bias2 = (float*)(w + WS_X + 4 * MiB);
    }
};
__device__ __forceinline__ const float* xin_row(const Frame& F, int row) { return row < NPROMPT ? F.inp(I_XP) + (size_t)row * D : F.inp(I_XS) + (size_t)(row - NPROMPT) * D; }
__device__ __forceinline__ int cidx_of(int row) { return row < NPROMPT ? 0 : 1 + ((row - NPROMPT) >> 10); }
__device__ __forceinline__ const float* modp(const Frame& F, int l, int row, int which) { return F.mod + (size_t)((l * 3 + cidx_of(row)) * 6 + which) * D; }


template <int MODE  >
__device__ __forceinline__ void transpose_item(const float* W, int K, int N, bf16* WT, LAS float* scr, int item, int lane) {
    const int nblk = N / 32, kb = item / nblk, nb = item % nblk, k0 = 64 * kb, n0 = 32 * nb;
    int d0 = n0; if (MODE == 1) { const int isu = n0 >= DFF, jj = n0 - isu * DFF; d0 = (jj >> 7) * 256 + isu * 128 + (jj & 127); }
    if (MODE == 2 && n0 < 2 * D) { const int w = n0 & 255; d0 = (n0 & ~255) + ((w >> 5) & 1) * 128 + (w >> 6) * 32; }
    float wv[32];
    const GAS float* wp = (const GAS float*)W + (size_t)(k0 + (lane >> 5)) * N + n0 + (lane & 31);
#pragma unroll
    for (int i = 0; i < 32; ++i) wv[i] = wp[(size_t)(2 * i) * N];
#pragma unroll
    for (int i = 0; i < 32; ++i) scr[(2 * i + (lane >> 5)) * 33 + (lane & 31)] = wv[i];
    asm volatile("s_waitcnt lgkmcnt(0)" ::: "memory");
    const int c = lane & 7;
#pragma unroll
    for (int j = 0; j < 4; ++j) { const int n = (lane >> 3) + 8 * j; const LAS float* sp = scr + (8 * c) * 33 + n;
        u32x4 o; o.x = f2bf(sp[0 * 33]) | (f2bf(sp[1 * 33]) << 16); o.y = f2bf(sp[2 * 33]) | (f2bf(sp[3 * 33]) << 16); o.z = f2bf(sp[4 * 33]) | (f2bf(sp[5 * 33]) << 16); o.w = f2bf(sp[6 * 33]) | (f2bf(sp[7 * 33]) << 16);
        *(u32x4*)(WT + (size_t)(d0 + n) * K + k0 + 8 * c) = o; }
    asm volatile("s_waitcnt lgkmcnt(0)" ::: "memory");
}
template <int MODE = 0>
__device__ __forceinline__ bool transpose_group(int& r, const float* W, int nmat, int K, int N, bf16* WT, LAS float* scr, int lane) {
    const int per = (K / 64) * (N / 32), tot = nmat * per;
    if (r >= tot) { r -= tot; return false; }
    const int mi = r / per; transpose_item<MODE>(W + (size_t)mi * K * N, K, N, WT + (size_t)mi * K * N, scr, r % per, lane); return true;
}

template <int SLOT>
__device__ __forceinline__ void convert_slot(Frame& F, int gw, int NGW) {
    LAS float* scr = (LAS float*)(F.lds + F.wave * 16384);
    constexpr size_t UPE = (size_t)2 * DFF * D, DNE = (size_t)D * DFF;
    constexpr int I_UP1 = (D / 64) * (2 * DFF / 32), I_DN1 = (DFF / 64) * (D / 32), I_LIN = (D / 64) * (2 * DRNN / 32), I_LOUT = (DRNN / 64) * (D / 32), I_WG = 80 * 2 * 4,
                  I_CIN = (D / 64) * (2 * DB / 32), I_COUT = (DB / 64) * (D / 32), I_QKV = (D / 64) * (3 * D / 32), I_AOUT = (D / 64) * (D / 32);
    constexpr int NIT = SLOT == 0 ? I_LIN + I_LOUT + I_WG + I_UP1 + I_DN1 : SLOT == 1 ? I_CIN + I_COUT + I_UP1 : SLOT == 2 ? I_DN1 + I_QKV + I_AOUT + I_UP1 : SLOT == 3 ? I_DN1 + I_LIN + I_LOUT : I_UP1 + I_DN1;
    for (int it = gw; it < NIT; it += NGW) { int r = it;
        if (SLOT == 0) {
            if (transpose_group(r, F.inp(I_LRU_WIN), 1, D, 2 * DRNN, F.WT + WE_LRU_IN, scr, F.lane)) continue;
            if (transpose_group(r, F.inp(I_LRU_WOUT), 1, DRNN, D, F.WT + WE_LRU_OUT, scr, F.lane)) continue;
            if (transpose_group(r, F.inp(I_LRU_WG), 80, 128, 128, F.WT + WE_WG, scr, F.lane)) continue;
            if (transpose_group<1>(r, F.inp(I_FF_WUP), 1, D, 2 * DFF, F.WT + WE_UP, scr, F.lane)) continue;
            transpose_group(r, F.inp(I_FF_WDN), 1, DFF, D, F.WT + WE_DN, scr, F.lane);
        } else if (SLOT == 1) {
            if (transpose_group(r, F.inp(I_CM_WIN), 1, D, 2 * DB, F.WT + WE_CM_IN, scr, F.lane)) continue;
            if (transpose_group(r, F.inp(I_CM_WOUT), 1, DB, D, F.WT + WE_CM_OUT, scr, F.lane)) continue;
            transpose_group<1>(r, F.inp(I_FF_WUP) + UPE, 1, D, 2 * DFF, F.WT + WE_UP + UPE, scr, F.lane);
        } else if (SLOT == 2) {
            if (transpose_group(r, F.inp(I_FF_WDN) + DNE, 1, DFF, D, F.WT + WE_DN + DNE, scr, F.lane)) continue;
            if (transpose_group<2>(r, F.inp(I_AT_WQKV), 1, D, 3 * D, F.WT + WE_QKV, scr, F.lane)) continue;
            if (transpose_group(r, F.inp(I_AT_WOUT), 1, D, D, F.WT + WE_AT_OUT, scr, F.lane)) continue;
            transpose_group<1>(r, F.inp(I_FF_WUP) + 2 * UPE, 1, D, 2 * DFF, F.WT + WE_UP + 2 * UPE, scr, F.lane);
        } else if (SLOT == 3) {
            if (transpose_group(r, F.inp(I_FF_WDN) + 2 * DNE, 1, DFF, D, F.WT + WE_DN + 2 * DNE, scr, F.lane)) continue;
            if (transpose_group(r, F.inp(I_LRU_WIN) + (size_t)D * 2 * DRNN, 1, D, 2 * DRNN, F.WT + WE_LRU_IN + (size_t)D * 2 * DRNN, scr, F.lane)) continue;
            transpose_group(r, F.inp(I_LRU_WOUT) + (size_t)DRNN * D, 1, DRNN, D, F.WT + WE_LRU_OUT + (size_t)DRNN * D, scr, F.lane);
        } else {
            if (transpose_group<1>(r, F.inp(I_FF_WUP) + 3 * UPE, 1, D, 2 * DFF, F.WT + WE_UP + 3 * UPE, scr, F.lane)) continue;
            transpose_group(r, F.inp(I_FF_WDN) + 3 * DNE, 1, DFF, D, F.WT + WE_DN + 3 * DNE, scr, F.lane);
        }
    }
}
__device__ __forceinline__ void adaln_layer(Frame& F, int l, int wk, int nwk) {
    LAS float* sc = (LAS float*)F.lds;
    const float* c = F.inp(I_C); const float* cctx = F.inp(I_CCTX);
    __syncthreads();
    for (int i = F.tid; i < 3 * D; i += NT) { const int ci = i >> 10, k = i & 1023; const float v = ci == 0 ? cctx[k] : c[(ci - 1) * D + k]; sc[i] = siluf_(v); }
    __syncthreads();
    LAS float* part = sc + 3 * D;
    const int kp = F.tid >> 6, cl = F.tid & 63;
    for (int item = wk; item < 6 * D / 64; item += nwk) {
        const int cc = item * 64 + cl;
        const float* w = F.inp(I_WMOD) + (size_t)l * D * 6 * D + cc;
        float s0 = 0.f, s1 = 0.f, s2 = 0.f;
#pragma unroll 1
        for (int kb = kp * 128; kb < kp * 128 + 128; kb += 32) { float wv[32];
#pragma unroll
            for (int i = 0; i < 32; ++i) wv[i] = ((const GAS float*)w)[(size_t)(kb + i) * 6 * D];
#pragma unroll
            for (int i = 0; i < 32; ++i) { s0 += sc[kb + i] * wv[i]; s1 += sc[D + kb + i] * wv[i]; s2 += sc[2 * D + kb + i] * wv[i]; } }
        part[(kp * 3 + 0) * 64 + cl] = s0; part[(kp * 3 + 1) * 64 + cl] = s1; part[(kp * 3 + 2) * 64 + cl] = s2;
        __syncthreads();
        if (F.tid < 192) { const int ci = F.tid >> 6; float s = F.inp(I_BMOD)[l * 6 * D + cc];
            for (int q = 0; q < 8; ++q) s += part[(q * 3 + ci) * 64 + cl];
            F.mod[(size_t)((l * 3 + ci) * 6) * D + cc] = s; }
        __syncthreads();
    }
}
__device__ __forceinline__ void phase_prologue(Frame& F) {
    F.fresh();
    adaln_layer(F, 0, F.bid, F.G);
    { __syncthreads(); convert_slot<0>(F, F.bid * NWAVES + F.wave, F.G * NWAVES); }
    const int gt = F.bid * NT + F.tid, GT = F.G * NT;
    for (int i = gt; i < 1024 * 32; i += GT) { const int t = i >> 5, j = i & 31; const float inv = powf(10000.f, -(float)(j & 15) / 16.f); const float pos = (float)(j < 16 ? (t >> 6) : (t & 63));
        const float ang = pos * inv; F.rope[i] = cosf(ang); F.rope[32768 + i] = sinf(ang); }
    for (int i = gt; i < 8 * 8 * 4 * 64; i += GT) { const int ln = i & 63, ks = (i >> 6) & 3, nf = (i >> 8) & 7, g = i >> 11, cq = ln >> 4, p = 16 * nf + (ln & 15);
        const float* wr = F.inp(I_CM_WS) + (size_t)(g * 128 + p) * 128 + 32 * ks + 4 * cq;
        u32x4 o; o.x = f2bf(wr[0]) | (f2bf(wr[1]) << 16); o.y = f2bf(wr[2]) | (f2bf(wr[3]) << 16); o.z = f2bf(wr[16]) | (f2bf(wr[17]) << 16); o.w = f2bf(wr[18]) | (f2bf(wr[19]) << 16);
        *(u32x4*)(F.WT + WE_WSB + (size_t)i * 8) = o; }
    for (int i = gt; i < 2 * PAST * D; i += GT) { const int b = i / (PAST * D), r = i % (PAST * D);
        F.KS[(size_t)b * TKS * D + r] = (bf16)f2bf(F.inp(I_CK)[i]); F.VS[(size_t)b * TKS * D + r] = (bf16)f2bf(F.inp(I_CV)[i]); }
}

__device__ __forceinline__ void bias2_gemm(Frame& F, const bf16* Wt, int N, int l, int sub, float* outp, int gw, int NGW) {
    float sh[3][16];
#pragma unroll
    for (int ci = 0; ci < 3; ++ci) { const GAS f32x4* sp = (const GAS f32x4*)(F.mod + (size_t)((l * 3 + ci) * 6 + sub * 3) * D + 16 * F.lane);
#pragma unroll
        for (int i = 0; i < 4; ++i) { const f32x4 v = sp[i]; sh[ci][4 * i] = v.x; sh[ci][4 * i + 1] = v.y; sh[ci][4 * i + 2] = v.z; sh[ci][4 * i + 3] = v.w; } }
    for (int n = gw; n < N; n += NGW) { const GAS u32x4* wp = (const GAS u32x4*)(Wt + (size_t)n * D + 16 * F.lane); const u32x4 w0 = wp[0], w1 = wp[1];
        const unsigned ww[8] = {w0.x, w0.y, w0.z, w0.w, w1.x, w1.y, w1.z, w1.w};
        float d0 = 0.f, d1 = 0.f, d2 = 0.f;
#pragma unroll
        for (int i = 0; i < 8; ++i) { const float lo = bf2f(ww[i]), hi = bf2f(ww[i] >> 16); d0 += sh[0][2 * i] * lo + sh[0][2 * i + 1] * hi; d1 += sh[1][2 * i] * lo + sh[1][2 * i + 1] * hi; d2 += sh[2][2 * i] * lo + sh[2][2 * i + 1] * hi; }
        d0 = wave_sum(d0); d1 = wave_sum(d1); d2 = wave_sum(d2);
        if (F.lane == 0) { outp[n] = d0; outp[(size_t)N + n] = d1; outp[(size_t)2 * N + n] = d2; } }
}
__device__ __forceinline__ void bias2_slot(Frame& F, int slot, int gw, int NGW) {
    if (slot == 2) bias2_gemm(F, F.WT + WE_CM_IN, 2 * DB, 1, 0, F.bias2 + B2_CM, gw, NGW);
    else if (slot == 3) bias2_gemm(F, F.WT + WE_UP + (size_t)1 * 2 * DFF * D, 2 * DFF, 1, 1, F.bias2 + B2_UP + (size_t)1 * 3 * 5632, gw, NGW);
    else if (slot == 4) bias2_gemm(F, F.WT + WE_QKV, 3 * D, 2, 0, F.bias2 + B2_QKV, gw, NGW);
    else if (slot == 5) bias2_gemm(F, F.WT + WE_UP + (size_t)2 * 2 * DFF * D, 2 * DFF, 2, 1, F.bias2 + B2_UP + (size_t)2 * 3 * 5632, gw, NGW);
    else if (slot == 6) bias2_gemm(F, F.WT + WE_LRU_IN + (size_t)2 * DRNN * D, 2 * DRNN, 3, 0, F.bias2 + B2_LRU + 3 * 2560, gw, NGW);
    else if (slot == 7) bias2_gemm(F, F.WT + WE_UP + (size_t)3 * 2 * DFF * D, 2 * DFF, 3, 1, F.bias2 + B2_UP + (size_t)3 * 3 * 5632, gw, NGW);
}
__device__ __forceinline__ void side_job(Frame& F, int slot) {
    F.fresh();
    const int nwk = F.G > 160 ? F.G - 160 : F.G, wk = F.G > 160 ? F.bid - 160 : F.bid;
    if (wk < 0) return;
    const int gw = wk * NWAVES + F.wave, NGW = nwk * NWAVES;
    bias2_slot(F, slot, gw, NGW);
    if (slot == 1) adaln_layer(F, 1, wk, nwk); else if (slot == 3) adaln_layer(F, 2, wk, nwk); else if (slot == 5) adaln_layer(F, 3, wk, nwk);
    if (slot == 1) convert_slot<1>(F, gw, NGW); else if (slot == 2) convert_slot<2>(F, gw, NGW); else if (slot == 3) convert_slot<3>(F, gw, NGW); else if (slot == 4) convert_slot<4>(F, gw, NGW);
}
__device__ __forceinline__ void phase_modulate0(Frame& F) {
    F.fresh();
    const int gw = F.bid * NWAVES + F.wave, NGW = F.G * NWAVES;
    const float* g = F.inp(I_NORMG);
    for (int row = gw; row < M; row += NGW) {
        const float* xr = xin_row(F, row); const float* scl = modp(F, 0, row, 1);
        f32x4 v[4]; float s = 0.f;
#pragma unroll
        for (int j = 0; j < 4; ++j) { v[j] = *(const GAS f32x4*)(xr + 4 * F.lane + 256 * j); s += v[j].x * v[j].x + v[j].y * v[j].y + v[j].z * v[j].z + v[j].w * v[j].w; }
        s = wave_sum(s);
        if (F.lane < 16) F.rsq0[(size_t)row * 16 + F.lane] = F.lane == 0 ? s : 0.f;
#pragma unroll
        for (int j = 0; j < 4; ++j) { const int c0 = 4 * F.lane + 256 * j; const f32x4 gg = *(const GAS f32x4*)(g + c0), c4 = *(const GAS f32x4*)(scl + c0);
            const f32x4 o = v[j] * gg * (1.f + c4); u32x2 w; w.x = f2bf(o.x) | (f2bf(o.y) << 16); w.y = f2bf(o.z) | (f2bf(o.w) << 16);
            *(GAS u32x2*)(F.H + (size_t)row * D + c0) = w; }
    }
    bias2_gemm(F, F.WT + WE_LRU_IN, 2 * DRNN, 0, 0, F.bias2 + B2_LRU, gw, NGW);
    bias2_gemm(F, F.WT + WE_UP, 2 * DFF, 0, 1, F.bias2 + B2_UP, gw, NGW);
}

template <class P>
__device__ __forceinline__ void gemm_naive(Frame& F, const P& p, int nbatch, int Mr, int N, int K) {
    F.fresh();
    LAS float* As = (LAS float*)F.lds;
    LAS float* Bs = As + 16 * 132;
    const int tid = F.tid, tx = tid & 31, ty = tid >> 5;
    const int tm = Mr / 128, tn = N / 128, per = tm * tn, total = per * nbatch;
    for (int t = F.bid; t < total; t += F.G) {
        const int b = t / per, r = t % per, pn = r / tm, pm = r % tm;
        const bf16* A; int lda; const float* W; int ldw; p.get(b, A, lda, W, ldw);
        float acc[8][4];
#pragma unroll
        for (int i = 0; i < 8; ++i)
#pragma unroll
            for (int j = 0; j < 4; ++j) acc[i][j] = 0.f;
        for (int k0 = 0; k0 < K; k0 += 16) {
            { const int row = tid >> 2, kq = (tid & 3) * 4;
              const u32x2 v = *(const u32x2*)(A + (size_t)(pm * 128 + row) * lda + k0 + kq);
              As[(kq + 0) * 132 + row] = bf2f(v.x); As[(kq + 1) * 132 + row] = bf2f(v.x >> 16); As[(kq + 2) * 132 + row] = bf2f(v.y); As[(kq + 3) * 132 + row] = bf2f(v.y >> 16); }
            { const int k = tid >> 5, n4 = (tid & 31) * 4;
              *(LAS f32x4*)(Bs + k * 128 + n4) = *(const f32x4*)(W + (size_t)(k0 + k) * ldw + pn * 128 + n4); }
            __syncthreads();
#pragma unroll 2
            for (int k = 0; k < 16; ++k) {
                const f32x4 a0 = *(const LAS f32x4*)(As + k * 132 + ty * 8), a1 = *(const LAS f32x4*)(As + k * 132 + ty * 8 + 4), bv = *(const LAS f32x4*)(Bs + k * 128 + tx * 4);
                const float a[8] = {a0.x, a0.y, a0.z, a0.w, a1.x, a1.y, a1.z, a1.w}; const float bb[4] = {bv.x, bv.y, bv.z, bv.w};
#pragma unroll
                for (int i = 0; i < 8; ++i)
#pragma unroll
                    for (int j = 0; j < 4; ++j) acc[i][j] += a[i] * bb[j];
            }
            __syncthreads();
        }
#pragma unroll
        for (int i = 0; i < 8; ++i)
#pragma unroll
            for (int j = 0; j < 4; ++j) p.epi(b, pm * 128 + ty * 8 + i, pn * 128 + tx * 4 + j, acc[i][j]);
    }
}

struct PStoreBf16 {
    const bf16* A; int lda; const float* W; int ldw; bf16* O; int ldo; const float* bias; int act; int split;
    __device__ __forceinline__ void get(int, const bf16*& a, int& la, const float*& w, int& lw) const { a = A; la = lda; w = W; lw = ldw; }
    __device__ __forceinline__ void epi(int, int row, int col, float v) const {
        if (bias) v += bias[col];
        if (act == 1 || (act == 2 && col < split)) v = gelu_tanh(v);
        O[(size_t)row * ldo + col] = (bf16)f2bf(v); }
};
struct PResid {
    const bf16* A; int lda; const float* W; int ldw; float* out; const float* xp; const float* xs; const float* modl; int which; bool from_input;
    __device__ __forceinline__ void get(int, const bf16*& a, int& la, const float*& w, int& lw) const { a = A; la = lda; w = W; lw = ldw; }
    __device__ __forceinline__ void epi(int, int row, int col, float v) const {
        const float base = from_input ? (row < NPROMPT ? xp[(size_t)row * D + col] : xs[(size_t)(row - NPROMPT) * D + col]) : out[(size_t)row * D + col];
        out[(size_t)row * D + col] = base + modl[(size_t)(cidx_of(row) * 6 + which) * D + col] * v; }
};
struct PLruIn {
    const bf16* A; const float* W; bf16* GBp; bf16* RECp;
    __device__ __forceinline__ void get(int, const bf16*& a, int& la, const float*& w, int& lw) const { a = A; la = D; w = W; lw = 2 * DRNN; }
    __device__ __forceinline__ void epi(int, int row, int col, float v) const {
        if (col < DRNN) GBp[(size_t)row * DRNN + col] = (bf16)f2bf(gelu_tanh(v)); else RECp[(size_t)row * DRNN + col - DRNN] = (bf16)f2bf(v); }
};
struct PGates {
    const bf16* XC; const float* WG; const float* BG; bf16* O;
    __device__ __forceinline__ void get(int b, const bf16*& a, int& la, const float*& w, int& lw) const { a = XC + (b % 10) * 128; la = DRNN; w = WG + (size_t)b * 128 * 128; lw = 128; }
    __device__ __forceinline__ void epi(int b, int row, int col, float v) const { const int dg = b / 10, n = b % 10;
        O[((size_t)dg * M + row) * DRNN + n * 128 + col] = (bf16)f2bf(sigmoidf_(v + BG[dg * DRNN + n * 128 + col])); }
};

__device__ __forceinline__ void phase_lru_conv(Frame& F, int j, const bf16* REC, bf16* XC) {
    F.fresh();
    const float* cw = F.inp(I_LRU_CW) + (size_t)j * 4 * DRNN; const float* cb = F.inp(I_LRU_CB) + (size_t)j * DRNN;
    const int gt = F.bid * NT + F.tid, GT = F.G * NT;
    for (int i = gt; i < M * DRNN; i += GT) { const int row = i / DRNN, ch = i % DRNN;
        int t, T; if (row < NPROMPT) { t = row & 255; T = 256; } else { t = (row - NPROMPT) & 1023; T = 1024; }
        float s = cb[ch];
#pragma unroll
        for (int k = 0; k < 4; ++k) { const int tt = t + k - 2; if (tt >= 0 && tt < T) s += cw[k * DRNN + ch] * bf2f(REC[(size_t)(row + k - 2) * DRNN + ch]); }
        XC[i] = (bf16)f2bf(s); }
}
__device__ __forceinline__ void phase_lru_scan(Frame& F, int j, const bf16* GATES, const bf16* XC, const bf16* GB, bf16* HS) {
    F.fresh();
    const int gt = F.bid * NT + F.tid, GT = F.G * NT;
    const int NL = (2 + 32) * DRNN;
    for (int line = gt; line < NL; line += GT) {
        const int s = line / DRNN, ch = line % DRNN;
        int base, T; float h0f = 0.f, h0b = 0.f;
        if (s < 2) { base = NPROMPT + s * 1024; T = 1024; h0f = F.inp(I_STATE)[((size_t)(s * 2 + j) * 2 + 0) * DRNN + ch]; h0b = F.inp(I_STATE)[((size_t)(s * 2 + j) * 2 + 1) * DRNN + ch]; }
        else { base = (s - 2) * 256; T = 256; }
        const float spf = softplusf_(-F.inp(I_LRU_LAM)[(size_t)(j * 2 + 0) * DRNN + ch]), spb = softplusf_(-F.inp(I_LRU_LAM)[(size_t)(j * 2 + 1) * DRNN + ch]);
        float h = h0f;
        for (int t = 0; t < T; ++t) { const size_t o = (size_t)(base + t) * DRNN + ch;
            const float r = bf2f(GATES[o]), ig = bf2f(GATES[(size_t)M * DRNN + o]), xc = bf2f(XC[o]);
            const float la = -8.f * r * spf, a = expf(la), bx = sqrtf(-expm1f(2.f * la)) * (ig * xc);
            h = a * h + bx; HS[o] = (bf16)f2bf(h); }
        const float ff = h;
        h = h0b;
        for (int t = T - 1; t >= 0; --t) { const size_t o = (size_t)(base + t) * DRNN + ch;
            const float r = bf2f(GATES[(size_t)2 * M * DRNN + o]), ig = bf2f(GATES[(size_t)3 * M * DRNN + o]), xc = bf2f(XC[o]);
            const float la = -8.f * r * spb, a = expf(la), bx = sqrtf(-expm1f(2.f * la)) * (ig * xc);
            h = a * h + bx; HS[o] = (bf16)f2bf(bf2f(GB[o]) * (bf2f(HS[o]) + h)); }
        if (s >= 2) { float* st = F.out + O_STATE + ((size_t)((s - 2) * 2 + j) * 2) * DRNN; st[ch] = ff; st[DRNN + ch] = h; }
    }
}


typedef short bf16x8 __attribute__((ext_vector_type(8)));
typedef short v4i16_t __attribute__((ext_vector_type(4)));
constexpr int LRU_XS = 272;
constexpr int LRU_XC_OFF = 0, LRU_GB_OFF = 256 * LRU_XS;
template <bool REV>
__device__ __forceinline__ float lru_dir(LAS const unsigned char* xct, LAS unsigned char* hft, const bf16* wgt  ,
                                         const bf16* gbp  , float br, float bi, float sp, float hc, int wave, int lane, bool wantp, bf16* Pdst, float& decay) {
    const int c = lane & 15, q = lane >> 4, qq = REV ? 3 - q : q;
    bf16x8 Br[4], Bi[4], Id;
#pragma unroll
    for (int ks = 0; ks < 4; ++ks) { Br[ks] = *(const GAS bf16x8*)(wgt + (size_t)(16 * wave + c) * 128 + 32 * ks + 8 * q);
                                     Bi[ks] = *(const GAS bf16x8*)(wgt + (size_t)10 * 128 * 128 + (size_t)(16 * wave + c) * 128 + 32 * ks + 8 * q); }
#pragma unroll
    for (int jj = 0; jj < 8; ++jj) Id[jj] = (8 * q + jj == 16 * (wave & 1) + c) ? (short)0x3F80 : (short)0;
    const int ksel = wave >> 1;
    const float nsp8 = -8.f * sp * 1.44269504f;
    float Pc = 1.f;
    unsigned short gcur[16], gnxt[16];
#pragma unroll
    for (int i = 0; i < 16; ++i) { gcur[i] = 0; gnxt[i] = 0; }
    if (REV) {
#pragma unroll
        for (int i = 0; i < 16; ++i) gcur[i] = *(const GAS unsigned short*)(gbp + (size_t)(16 * (12 + (i >> 2)) + 4 * q + (i & 3)) * DRNN); }
    f32x4 r, ig, xc;
#define LRU_STAGE_A(MI, R_, I_, X_) do { LAS const unsigned char* rp_ = xct + (16 * (MI) + c) * LRU_XS + 16 * q; bf16x8 Af_[4]; \
        _Pragma("unroll") for (int ks = 0; ks < 4; ++ks) Af_[ks] = *(LAS const bf16x8*)(rp_ + 64 * ks); \
        const bf16x8 Ax_ = *(LAS const bf16x8*)(rp_ + 64 * ksel); \
        R_ = (f32x4){0.f, 0.f, 0.f, 0.f}; I_ = (f32x4){0.f, 0.f, 0.f, 0.f}; \
        _Pragma("unroll") for (int ks = 0; ks < 4; ++ks) { R_ = __builtin_amdgcn_mfma_f32_16x16x32_bf16(Af_[ks], Br[ks], R_, 0, 0, 0); I_ = __builtin_amdgcn_mfma_f32_16x16x32_bf16(Af_[ks], Bi[ks], I_, 0, 0, 0); } \
        X_ = __builtin_amdgcn_mfma_f32_16x16x32_bf16(Ax_, Id, (f32x4){0.f, 0.f, 0.f, 0.f}, 0, 0, 0); } while (0)
    LRU_STAGE_A(REV ? 15 : 0, r, ig, xc);
#pragma unroll 1
    for (int og = 0; og < 4; ++og) {
        if (REV && og < 3) {
#pragma unroll
            for (int i = 0; i < 16; ++i) gnxt[i] = *(const GAS unsigned short*)(gbp + (size_t)(16 * (4 * (2 - og) + (i >> 2)) + 4 * q + (i & 3)) * DRNN); }
#pragma unroll
        for (int ii = 0; ii < 4; ++ii) {
        const int it = 4 * og + ii, mi = REV ? 15 - it : it, mloc = REV ? 3 - ii : ii;
        f32x4 rn = r, ign = ig, xcn = xc;
        if (it < 15) { const int min_ = REV ? 14 - it : it + 1; LRU_STAGE_A(min_, rn, ign, xcn); }
        float av[4], bv[4];
#pragma unroll
        for (int k = 0; k < 4; ++k) { const float rg = __builtin_amdgcn_rcpf(1.f + __builtin_amdgcn_exp2f(-1.44269504f * (r[k] + br))), iv = __builtin_amdgcn_rcpf(1.f + __builtin_amdgcn_exp2f(-1.44269504f * (ig[k] + bi)));
            const float l2a = nsp8 * rg, x = 1.38629436f * l2a;
            const float om = -x * (1.f + x * (0.5f + x * (0.16666667f + x * (0.041666668f + x * (0.0083333338f + x * (0.0013888889f + x * 0.00019841270f))))));
            av[k] = __builtin_amdgcn_exp2f(l2a); bv[k] = __builtin_amdgcn_sqrtf(om) * (iv * xc[k]); }
        float pA[4], pB[4];
#pragma unroll
        for (int kk = 0; kk < 4; ++kk) { const int k = REV ? 3 - kk : kk;
            if (kk == 0) { pA[k] = av[k]; pB[k] = bv[k]; } else { const int kp = REV ? k + 1 : k - 1; pA[k] = pA[kp] * av[k]; pB[k] = pB[kp] * av[k] + bv[k]; } }
        const int kl = REV ? 0 : 3;
        float gA[4], gB[4];
#pragma unroll
        for (int g = 0; g < 4; ++g) { const int src = 16 * (REV ? 3 - g : g) + c; gA[g] = bperm(pA[kl], src); gB[g] = bperm(pB[kl], src); }
        float eA = 1.f, eB = 0.f, tA = 1.f, tB = 0.f;
#pragma unroll
        for (int g = 0; g < 4; ++g) { if (g == qq) { eA = tA; eB = tB; } tB = tB * gA[g] + gB[g]; tA = tA * gA[g]; }
        const float hin = eA * hc + eB;
        float hv[4];
#pragma unroll
        for (int k = 0; k < 4; ++k) { hv[k] = pA[k] * hin + pB[k];
            if (REV) { LAS const unsigned short* hp = (LAS const unsigned short*)(hft + (16 * mi + 4 * q + k) * LRU_XS + 2 * (16 * wave + c)); hv[k] = bf2f(gcur[4 * mloc + k]) * (bf2f(*hp) + hv[k]); } }
        { const unsigned w01 = pg8::cvt_pk_bf16(hv[0], hv[1]), w23 = pg8::cvt_pk_bf16(hv[2], hv[3]);
          LAS unsigned short* hp = (LAS unsigned short*)(hft + (16 * mi + 4 * q) * LRU_XS + 2 * (16 * wave + c));
          hp[0] = (unsigned short)w01; hp[LRU_XS / 2] = (unsigned short)(w01 >> 16); hp[LRU_XS] = (unsigned short)w23; hp[3 * LRU_XS / 2] = (unsigned short)(w23 >> 16); }
        if (wantp) { const float pe = eA * Pc; const unsigned p01 = pg8::cvt_pk_bf16(pA[0] * pe, pA[1] * pe), p23 = pg8::cvt_pk_bf16(pA[2] * pe, pA[3] * pe);
          bf16* pp = Pdst + (size_t)(16 * mi + 4 * q) * DRNN; pp[0] = (bf16)p01; pp[DRNN] = (bf16)(p01 >> 16); pp[2 * DRNN] = (bf16)p23; pp[3 * DRNN] = (bf16)(p23 >> 16); }
        hc = tA * hc + tB; Pc *= tA;
        r = rn; ig = ign; xc = xcn;
        }
        if (REV) {
#pragma unroll
            for (int i = 0; i < 16; ++i) gcur[i] = gnxt[i]; }
    }
#undef LRU_STAGE_A
    decay = Pc;
    return hc;
}
__device__ __forceinline__ void lru_unit(Frame& F, int j, int pm, int n, const bf16* REC, const bf16* GB, bf16* HS, bf16* PF, bf16* PB, float* AGG, unsigned* cnt, const bf16* WGT) {
    const int tid = F.tid, lane = F.lane, wave = F.wave, r0 = 256 * pm;
    const bool smp = pm >= 32; const int tix = smp ? (pm - 32) & 3 : 0, sq = smp ? (pm - 32) >> 2 : 0;
    const int t0 = smp ? 256 * tix : 0, T = smp ? 1024 : 256;
    LAS unsigned char* xct = F.lds + LRU_XC_OFF; LAS unsigned char* hft = F.lds + LRU_GB_OFF;
    { const float* cw = F.inp(I_LRU_CW) + (size_t)j * 4 * DRNN + n * 128 + 2 * lane; const float* cb = F.inp(I_LRU_CB) + (size_t)j * DRNN + n * 128 + 2 * lane;
      float w0[4], w1[4];
#pragma unroll
      for (int k = 0; k < 4; ++k) { w0[k] = cw[k * DRNN]; w1[k] = cw[k * DRNN + 1]; }
      const float b0 = cb[0], b1 = cb[1];
      unsigned v[35];
#pragma unroll
      for (int i = 0; i < 35; ++i) { const int tl = 32 * wave + i - 2, tt = t0 + tl;
          v[i] = (tt >= 0 && tt < T) ? *(const GAS unsigned*)(REC + (size_t)(r0 + tl) * DRNN + n * 128 + 2 * lane) : 0u; }
#pragma unroll
      for (int i = 0; i < 32; ++i) { float s0 = b0, s1 = b1;
#pragma unroll
          for (int k = 0; k < 4; ++k) { s0 += w0[k] * bf2f(v[i + k]); s1 += w1[k] * bf2f(v[i + k] >> 16); }
          *(LAS unsigned*)(xct + (32 * wave + i) * LRU_XS + 4 * lane) = f2bf(s0) | (f2bf(s1) << 16); } }
    __syncthreads();
    const int c = lane & 15, q = lane >> 4, ch = n * 128 + 16 * wave + c;
    const float* bg = F.inp(I_LRU_BG) + (size_t)j * 4 * DRNN; const float* lam = F.inp(I_LRU_LAM) + (size_t)j * 2 * DRNN;
    const bf16* gbp = GB + (size_t)r0 * DRNN + ch;
    bf16* pf = PF + (size_t)(smp ? r0 - NPROMPT : 0) * DRNN + ch; bf16* pb = PB + (size_t)(smp ? r0 - NPROMPT : 0) * DRNN + ch;
    { float h0 = 0.f; if (smp && tix == 0) h0 = F.inp(I_STATE)[((size_t)(sq * 2 + j) * 2 + 0) * DRNN + ch];
      float dec;
      const float hfin = lru_dir<false>(xct, hft, WGT + (size_t)(0 * 10 + n) * 128 * 128, gbp, bg[0 * DRNN + ch], bg[1 * DRNN + ch], softplusf_(-lam[ch]), h0, wave, lane, smp, pf, dec);
      if (q == 0) { if (smp) { float* ag = AGG + (size_t)(((sq * 4 + tix) * 2 + 0) * 2) * DRNN + ch; __hip_atomic_store(ag, hfin, __ATOMIC_RELAXED, __HIP_MEMORY_SCOPE_AGENT); __hip_atomic_store(ag + DRNN, dec, __ATOMIC_RELAXED, __HIP_MEMORY_SCOPE_AGENT); }
                    else F.out[O_STATE + ((size_t)(pm * 2 + j) * 2 + 0) * DRNN + ch] = hfin; } }
    { float h0 = 0.f; if (smp && tix == 3) h0 = F.inp(I_STATE)[((size_t)(sq * 2 + j) * 2 + 1) * DRNN + ch];
      float dec;
      const float hfin = lru_dir<true>(xct, hft, WGT + (size_t)(2 * 10 + n) * 128 * 128, gbp, bg[2 * DRNN + ch], bg[3 * DRNN + ch], softplusf_(-lam[DRNN + ch]), h0, wave, lane, smp, pb, dec);
      if (q == 0) { if (smp) { float* ag = AGG + (size_t)(((sq * 4 + tix) * 2 + 1) * 2) * DRNN + ch; __hip_atomic_store(ag, hfin, __ATOMIC_RELAXED, __HIP_MEMORY_SCOPE_AGENT); __hip_atomic_store(ag + DRNN, dec, __ATOMIC_RELAXED, __HIP_MEMORY_SCOPE_AGENT); }
                    else F.out[O_STATE + ((size_t)(pm * 2 + j) * 2 + 1) * DRNN + ch] = hfin; } }
    if (smp) {
        asm volatile("s_waitcnt vmcnt(0)" ::: "memory");
        __syncthreads();
        if (tid == 0) { unsigned* cp = cnt + 64 * ((j * 2 + sq) * 10 + n);
            __hip_atomic_fetch_add(cp, 1u, __ATOMIC_RELAXED, __HIP_MEMORY_SCOPE_AGENT);
            unsigned sp_ = 0; while (__hip_atomic_load(cp, __ATOMIC_RELAXED, __HIP_MEMORY_SCOPE_AGENT) < 4u) { __builtin_amdgcn_s_sleep(2); if (++sp_ > (1u << 20)) break; }
            __builtin_amdgcn_fence(__ATOMIC_ACQUIRE, "agent"); asm volatile("s_waitcnt vmcnt(0)" ::: "memory"); }
        __syncthreads();
        LAS float* cfb = (LAS float*)(F.lds + LRU_GB_OFF + 256 * LRU_XS);
        if (tid < 128) { const int chn = n * 128 + tid; float cf = 0.f, cbk = 0.f;
            for (int t = 0; t < tix; ++t) { const float* ag = AGG + (size_t)(((sq * 4 + t) * 2 + 0) * 2) * DRNN + chn;
                cf = __hip_atomic_load(ag + DRNN, __ATOMIC_RELAXED, __HIP_MEMORY_SCOPE_AGENT) * cf + __hip_atomic_load(ag, __ATOMIC_RELAXED, __HIP_MEMORY_SCOPE_AGENT); }
            for (int t = 3; t > tix; --t) { const float* ag = AGG + (size_t)(((sq * 4 + t) * 2 + 1) * 2) * DRNN + chn;
                cbk = __hip_atomic_load(ag + DRNN, __ATOMIC_RELAXED, __HIP_MEMORY_SCOPE_AGENT) * cbk + __hip_atomic_load(ag, __ATOMIC_RELAXED, __HIP_MEMORY_SCOPE_AGENT); }
            cfb[tid] = cf; cfb[128 + tid] = cbk; }
        __syncthreads();
#pragma unroll 2
        for (int i = 0; i < 8; ++i) { const int id = i * NT + tid, row = id >> 4, cc = id & 15;
            const size_t go = (size_t)(r0 + row) * DRNN + n * 128 + 8 * cc, po = (size_t)(r0 - NPROMPT + row) * DRNN + n * 128 + 8 * cc;
            const u32x4 g4 = *(const GAS u32x4*)(GB + go), f4 = *(const GAS u32x4*)(PF + po), b4 = *(const GAS u32x4*)(PB + po); u32x4 h4 = *(LAS const u32x4*)(hft + row * LRU_XS + 16 * cc);
            const unsigned gg[4] = {g4.x, g4.y, g4.z, g4.w}, ff[4] = {f4.x, f4.y, f4.z, f4.w}, bb[4] = {b4.x, b4.y, b4.z, b4.w}; unsigned hh[4] = {h4.x, h4.y, h4.z, h4.w};
#pragma unroll
            for (int e = 0; e < 4; ++e) { const int c0 = 8 * cc + 2 * e;
                const float lo = bf2f(hh[e]) + bf2f(gg[e]) * (bf2f(ff[e]) * cfb[c0] + bf2f(bb[e]) * cfb[128 + c0]), hi = bf2f(hh[e] >> 16) + bf2f(gg[e] >> 16) * (bf2f(ff[e] >> 16) * cfb[c0 + 1] + bf2f(bb[e] >> 16) * cfb[128 + c0 + 1]);
                hh[e] = pg8::cvt_pk_bf16(lo, hi); }
            *(LAS u32x4*)(hft + row * LRU_XS + 16 * cc) = (u32x4){hh[0], hh[1], hh[2], hh[3]}; }
    }
    __syncthreads();
#pragma unroll
    for (int i = 0; i < 8; ++i) { const int id = i * NT + tid, row = id >> 4, cc = id & 15;
        *(GAS u32x4*)(HS + (size_t)(r0 + row) * DRNN + n * 128 + 8 * cc) = *(LAS const u32x4*)(hft + row * LRU_XS + 16 * cc); }
    __syncthreads();
}
__device__ __forceinline__ void phase_lru_core(Frame& F, int j, const bf16* REC, const bf16* GB, bf16* HS, bf16* PF, bf16* PB, float* AGG, unsigned* cnt, const bf16* WGT) {
    F.fresh();
    for (int u = F.bid; u < 400; u += F.G) {
        const int pm = u < 80 ? 32 + u / 10 : (u - 80) / 10, n = u % 10;
        lru_unit(F, j, pm, n, REC, GB, HS, PF, PB, AGG, cnt, WGT); }
}
__device__ __forceinline__ void phase_lru_fixup(Frame& F, const bf16* GB, bf16* HS, const bf16* PF, const bf16* PB, const float* AGG) {
    F.fresh();
    const int gt = F.bid * NT + F.tid, GT = F.G * NT;
    for (int i = gt; i < NSAMPLE * DRNN; i += GT) { const int rs = i / DRNN, ch = i % DRNN, sq = rs >> 10, tix = (rs >> 8) & 3;
        float cf = 0.f, cbk = 0.f;
        if (tix > 0) { for (int t = 0; t < tix; ++t) { const float At = bf2f(PF[(size_t)(sq * 1024 + t * 256 + 255) * DRNN + ch]); cf = At * cf + AGG[(size_t)((sq * 4 + t) * 2 + 0) * DRNN + ch]; } }
        if (tix < 3) { for (int t = 3; t > tix; --t) { const float At = bf2f(PB[(size_t)(sq * 1024 + t * 256) * DRNN + ch]); cbk = At * cbk + AGG[(size_t)((sq * 4 + t) * 2 + 1) * DRNN + ch]; } }
        const size_t o = (size_t)(NPROMPT + rs) * DRNN + ch;
        HS[o] = (bf16)f2bf(bf2f(HS[o]) + bf2f(GB[o]) * (bf2f(PF[(size_t)rs * DRNN + ch]) * cf + bf2f(PB[(size_t)rs * DRNN + ch]) * cbk)); }
}

__device__ __forceinline__ void phase_cmlp_rstd(Frame& F, const bf16* UV) {
    F.fresh();
    const int gw = F.bid * NWAVES + F.wave, NGW = F.G * NWAVES;
    for (int row = gw; row < M; row += NGW) { float s = 0.f;
        for (int c = F.lane; c < DB; c += 64) { const float v = bf2f(UV[(size_t)row * 2 * DB + DB + c]); s += v * v; }
        s = wave_sum(s); if (F.lane == 0) F.rstd[row] = rsqrtf(s * (1.f / DB) + EPS); }
}
__device__ __forceinline__ void phase_cmlp_spatial(Frame& F, const bf16* UV, bf16* ACT) {
    F.fresh();
    const float* ws = F.inp(I_CM_WS); const float* bs = F.inp(I_CM_BS); const float* ng = F.inp(I_CM_NG);
    const int gt = F.bid * NT + F.tid, GT = F.G * NT;
    for (int i = gt; i < M * DB; i += GT) { const int row = i / DB, ch = i % DB, g = ch >> 8, p = row & 127, r0 = row & ~127;
        float s = 0.f;
        for (int q = 0; q < 128; ++q) s += ws[(size_t)(g * 128 + p) * 128 + q] * F.rstd[r0 + q] * bf2f(UV[(size_t)(r0 + q) * 2 * DB + DB + ch]);
        const float sv = s * ng[ch] + bs[g * 128 + p];
        ACT[i] = (bf16)f2bf(bf2f(UV[(size_t)row * 2 * DB + ch]) * sv); }
}


constexpr int CM_VS = 544;
__device__ __forceinline__ void phase_cmlp_spatial_mfma(Frame& F, const bf16* UV, bf16* ACT, const bf16* WSB) {
    F.fresh();
    const int tid = F.tid, lane = F.lane, wave = F.wave, c = lane & 15, q4 = lane >> 4;
    LAS unsigned char* vt = F.lds;
    const float* ng = F.inp(I_CM_NG); const float* bs = F.inp(I_CM_BS);
    for (int u = F.bid; u < 640; u += F.G) {
        const int chunk = u >> 3, g = u & 7, r0 = chunk * 128;
        LAS float* rsl = (LAS float*)(vt + 128 * CM_VS);
        if (tid < 128) { const GAS f32x4* p = (const GAS f32x4*)(F.rsqv + (size_t)(r0 + tid) * 32); float sm = 0.f;
#pragma unroll
            for (int i = 0; i < 8; ++i) { const f32x4 t4 = p[i]; sm += (t4.x + t4.y) + (t4.z + t4.w); }
            rsl[tid] = rsqrtf(sm * (1.f / DB) + EPS); }
        __syncthreads();
#pragma unroll
        for (int i = 0; i < 8; ++i) { const int id = i * NT + tid, row = id >> 5, cc = id & 31;
            const u32x4 x = *(const GAS u32x4*)(UV + (size_t)(r0 + row) * 2 * DB + DB + g * 256 + 8 * cc); const float rs = rsl[row];
            u32x4 y; y.x = f2bf(bf2f(x.x) * rs) | (f2bf(bf2f(x.x >> 16) * rs) << 16); y.y = f2bf(bf2f(x.y) * rs) | (f2bf(bf2f(x.y >> 16) * rs) << 16);
            y.z = f2bf(bf2f(x.z) * rs) | (f2bf(bf2f(x.z >> 16) * rs) << 16); y.w = f2bf(bf2f(x.w) * rs) | (f2bf(bf2f(x.w >> 16) * rs) << 16);
            *(LAS u32x4*)(vt + row * CM_VS + 16 * cc) = y; }
        __syncthreads();
        bf16x8 vf[2][4];
#pragma unroll
        for (int mfc = 0; mfc < 2; ++mfc)
#pragma unroll
            for (int ks = 0; ks < 4; ++ks) { LAS const unsigned char* vp = vt + (32 * ks + 4 * q4 + (c >> 2)) * CM_VS + (32 * wave + 16 * mfc + 4 * (c & 3)) * 2;
                const v4i16_t lo = __builtin_amdgcn_ds_read_tr16_b64_v4i16((LAS v4i16_t*)vp), hi = __builtin_amdgcn_ds_read_tr16_b64_v4i16((LAS v4i16_t*)(vp + 16 * CM_VS));
                vf[mfc][ks] = (bf16x8){lo[0], lo[1], lo[2], lo[3], hi[0], hi[1], hi[2], hi[3]}; }
#pragma unroll
        for (int nf = 0; nf < 8; ++nf) {
            bf16x8 Bf[4];
#pragma unroll
            for (int ks = 0; ks < 4; ++ks) Bf[ks] = *(const GAS bf16x8*)(WSB + ((size_t)((g * 8 + nf) * 4 + ks) * 64 + lane) * 8);
            const int p = 16 * nf + c; const float bsv = bs[g * 128 + p];
#pragma unroll
            for (int mfc = 0; mfc < 2; ++mfc) { f32x4 acc = {0.f, 0.f, 0.f, 0.f};
#pragma unroll
                for (int ks = 0; ks < 4; ++ks) acc = __builtin_amdgcn_mfma_f32_16x16x32_bf16(vf[mfc][ks], Bf[ks], acc, 0, 0, 0);
                const int ch = g * 256 + 32 * wave + 16 * mfc + 4 * q4;
                const f32x4 g4 = *(const GAS f32x4*)(ng + ch); const u32x2 uu = *(const GAS u32x2*)(UV + (size_t)(r0 + p) * 2 * DB + ch);
                const float o0 = bf2f(uu.x) * (acc[0] * g4.x + bsv), o1 = bf2f(uu.x >> 16) * (acc[1] * g4.y + bsv), o2 = bf2f(uu.y) * (acc[2] * g4.z + bsv), o3 = bf2f(uu.y >> 16) * (acc[3] * g4.w + bsv);
                u32x2 w; w.x = f2bf(o0) | (f2bf(o1) << 16); w.y = f2bf(o2) | (f2bf(o3) << 16);
                *(GAS u32x2*)(ACT + (size_t)(r0 + p) * DB + ch) = w; }
        }
        __syncthreads();
    }
}

__device__ __forceinline__ void phase_qkv_post(Frame& F, const bf16* QKV, bf16* Q, bf16* KP, bf16* VP) {
    F.fresh();
    const int gw = F.bid * NWAVES + F.wave, NGW = F.G * NWAVES;
    const float* qkg = F.inp(I_AT_QKG);
    for (int row = gw; row < M; row += NGW) {
        const bool smp = row >= NPROMPT; const int sb = smp ? (row - NPROMPT) >> 10 : 0, t = smp ? (row - NPROMPT) & 1023 : 0;
        const float cs = smp ? F.rope[t * 32 + (F.lane & 31)] : 1.f, sn = smp ? F.rope[32768 + t * 32 + (F.lane & 31)] : 0.f;
        for (int grp = 0; grp < 32; ++grp) {
            const float v = bf2f(QKV[(size_t)row * 3072 + grp * 64 + F.lane]);
            const float ms = wave_sum(v * v) * (1.f / 64.f);
            float n = v * rsqrtf(ms + EPS) * qkg[(grp >> 4) * 64 + F.lane];
            const float keep = n;
            if (smp) { float pr; { auto r_ = __builtin_amdgcn_permlane32_swap(__builtin_bit_cast(unsigned, n), __builtin_bit_cast(unsigned, n), false, false); pr = __builtin_bit_cast(float, F.lane < 32 ? (unsigned)r_[1] : (unsigned)r_[0]); } n = F.lane < 32 ? n * cs - pr * sn : n * cs + pr * sn; }
            if (grp < 16) Q[(size_t)row * D + grp * 64 + F.lane] = (bf16)f2bf(n);
            else { const int c = (grp - 16) * 64 + F.lane;
                if (smp) F.KS[((size_t)sb * TKS + PAST + t) * D + c] = (bf16)f2bf(n);
                else { KP[(size_t)row * D + c] = (bf16)f2bf(keep); F.out[O_CK + (size_t)row * D + c] = keep; } }
        }
        for (int c = F.lane; c < D; c += 64) { const bf16 vb = QKV[(size_t)row * 3072 + 2048 + c];
            if (smp) F.VS[((size_t)sb * TKS + PAST + t) * D + c] = vb; else { VP[(size_t)row * D + c] = vb; F.out[O_CV + (size_t)row * D + c] = bf2f(vb); } }
    }
}
__device__ __forceinline__ void phase_attn_naive(Frame& F, int l, const bf16* Q, const bf16* KP, const bf16* VP, bf16* O) {
    F.fresh();
    const int gw = F.bid * NWAVES + F.wave, NGW = F.G * NWAVES;
    LAS float* s1 = (LAS float*)F.lds + F.wave * 3328; LAS float* s2 = s1 + 1536; LAS float* qs = s2 + 1536;
    const float* al = F.inp(I_AT_LAM);
    const float lam_init = 0.8f - 0.6f * expf(-0.3f * (float)l);
    const float lam = expf(wave_sum(al[F.lane] * al[64 + F.lane])) - expf(wave_sum(al[128 + F.lane] * al[192 + F.lane])) + lam_init;
    const float* sg = F.inp(I_AT_SUBG);
    for (int item = gw; item < M * 8; item += NGW) {
        const int row = item >> 3, h = item & 7;
        const bf16 *Kb, *Vb; int Tk;
        if (row < NPROMPT) { Kb = KP + (size_t)(row & ~255) * D; Vb = VP + (size_t)(row & ~255) * D; Tk = 256; }
        else { const int sb = (row - NPROMPT) >> 10; Kb = F.KS + (size_t)sb * TKS * D; Vb = F.VS + (size_t)sb * TKS * D; Tk = TKS; }
        qs[F.lane] = bf2f(Q[(size_t)row * D + h * 128 + F.lane]); qs[64 + F.lane] = bf2f(Q[(size_t)row * D + h * 128 + 64 + F.lane]);
        asm volatile("s_waitcnt lgkmcnt(0)" ::: "memory");
        float m1 = -1e30f, m2 = -1e30f;
        for (int k = F.lane; k < Tk; k += 64) { const bf16* kr = Kb + (size_t)k * D + h * 128; float d1 = 0.f, d2 = 0.f;
#pragma unroll 4
            for (int d = 0; d < 64; d += 2) { const unsigned a = *(const unsigned*)(kr + d), b = *(const unsigned*)(kr + 64 + d);
                d1 += qs[d] * bf2f(a) + qs[d + 1] * bf2f(a >> 16); d2 += qs[64 + d] * bf2f(b) + qs[64 + d + 1] * bf2f(b >> 16); }
            d1 *= 0.125f; d2 *= 0.125f; s1[k] = d1; s2[k] = d2; m1 = fmaxf(m1, d1); m2 = fmaxf(m2, d2); }
        m1 = wave_max(m1); m2 = wave_max(m2);
        float l1 = 0.f, l2 = 0.f;
        for (int k = F.lane; k < Tk; k += 64) { const float e1 = expf(s1[k] - m1), e2 = expf(s2[k] - m2); s1[k] = e1; s2[k] = e2; l1 += e1; l2 += e2; }
        l1 = wave_sum(l1); l2 = wave_sum(l2);
        const float i1 = 1.f / l1, i2 = lam / l2;
        for (int k = F.lane; k < Tk; k += 64) s1[k] = bf2f(f2bf(s1[k] * i1 - s2[k] * i2));
        asm volatile("s_waitcnt lgkmcnt(0)" ::: "memory");
        float o0 = 0.f, o1 = 0.f;
        for (int k = 0; k < Tk; ++k) { const unsigned vv = *(const unsigned*)(Vb + (size_t)k * D + h * 128 + 2 * F.lane); const float w = s1[k]; o0 += w * bf2f(vv); o1 += w * bf2f(vv >> 16); }
        const float ms = wave_sum(o0 * o0 + o1 * o1) * (1.f / 128.f), rs = rsqrtf(ms + EPS) * (1.f - lam_init);
        o0 = o0 * rs * sg[2 * F.lane]; o1 = o1 * rs * sg[2 * F.lane + 1];
        *(unsigned*)(O + (size_t)row * D + h * 128 + 2 * F.lane) = f2bf(o0) | (f2bf(o1) << 16);
        asm volatile("s_waitcnt lgkmcnt(0)" ::: "memory");
    }
}


constexpr int AT_KT = 128, AT_NMF = AT_KT / 16, AT_NCH = AT_KT / 32;
constexpr int AT_KS = 272, AT_VS = 288, AT_KBYTES = AT_KT * AT_KS, AT_VBYTES = AT_KT * AT_VS, AT_BUF = AT_KBYTES + AT_VBYTES;
__device__ __forceinline__ void attn_unit(Frame& F, int l, const bf16* Qrows  , const bf16* Kb, const bf16* Vb, int Tk, bf16* Orows, int h, float lam, float lam_init) {
    const int tid = F.tid, lane = F.lane, wave = F.wave, c = lane & 15, q4 = lane >> 4;
    LAS unsigned char* lds = F.lds;
    const float SC = 0.18033688f;
    bf16x8 Qf[2][2];
#pragma unroll
    for (int cp = 0; cp < 2; ++cp)
#pragma unroll
        for (int ks = 0; ks < 2; ++ks) Qf[cp][ks] = *(const GAS bf16x8*)(Qrows + (size_t)(16 * wave + c) * D + h * 128 + cp * 64 + 32 * ks + 8 * q4);
    const int nt = Tk / AT_KT;
    const int key0 = tid >> 4, cc0 = tid & 15;
    u32x4 kreg[AT_NCH], vreg[AT_NCH];
    float m1 = -1e30f, m2 = -1e30f, l1 = 0.f, l2 = 0.f;
#pragma unroll
    for (int i = 0; i < AT_NCH; ++i) kreg[i] = *(const GAS u32x4*)(Kb + (size_t)(key0 + 32 * i) * D + h * 128 + 8 * cc0);
#pragma unroll
    for (int i = 0; i < AT_NCH; ++i) *(LAS u32x4*)(lds + (key0 + 32 * i) * AT_KS + 16 * cc0) = kreg[i];
    __syncthreads();
    for (int t = 0; t < nt; ++t) {
        LAS const unsigned char* kt = lds + (t & 1) * AT_BUF;
        if (t + 1 < nt) {
#pragma unroll
            for (int i = 0; i < AT_NCH; ++i) kreg[i] = *(const GAS u32x4*)(Kb + (size_t)((t + 1) * AT_KT + key0 + 32 * i) * D + h * 128 + 8 * cc0); }
#pragma unroll
        for (int hf = 0; hf < AT_NMF / 4; ++hf) {
            f32x4 S[2][4];
#pragma unroll
            for (int cp = 0; cp < 2; ++cp)
#pragma unroll
                for (int mf = 0; mf < 4; ++mf) { S[cp][mf] = (f32x4){0.f, 0.f, 0.f, 0.f};
#pragma unroll
                    for (int ks = 0; ks < 2; ++ks) { const bf16x8 kf = *(LAS const bf16x8*)(kt + (64 * hf + 16 * mf + c) * AT_KS + cp * 128 + ks * 64 + 16 * q4);
                        S[cp][mf] = __builtin_amdgcn_mfma_f32_16x16x32_bf16(kf, Qf[cp][ks], S[cp][mf], 0, 0, 0); } }
            float x1 = -1e30f, x2 = -1e30f;
#pragma unroll
            for (int mf = 0; mf < 4; ++mf)
#pragma unroll
                for (int k = 0; k < 4; ++k) { x1 = fmaxf(x1, S[0][mf][k]); x2 = fmaxf(x2, S[1][mf][k]); }
            x1 = max_q4(x1); x2 = max_q4(x2);
            const float n1 = fmaxf(m1, x1), n2 = fmaxf(m2, x2);
            l1 *= __builtin_amdgcn_exp2f((m1 - n1) * SC); l2 *= __builtin_amdgcn_exp2f((m2 - n2) * SC); m1 = n1; m2 = n2;
            const float o1 = m1 * SC, o2 = m2 * SC;
#pragma unroll
            for (int mf = 0; mf < 4; ++mf)
#pragma unroll
                for (int k = 0; k < 4; ++k) { l1 += __builtin_amdgcn_exp2f(S[0][mf][k] * SC - o1); l2 += __builtin_amdgcn_exp2f(S[1][mf][k] * SC - o2); }
        }
        if (t + 1 < nt) {
#pragma unroll
            for (int i = 0; i < AT_NCH; ++i) *(LAS u32x4*)(lds + ((t + 1) & 1) * AT_BUF + (key0 + 32 * i) * AT_KS + 16 * cc0) = kreg[i]; }
        __syncthreads();
    }
    l1 = sum_q4(l1); l2 = sum_q4(l2);
    const float i1 = 1.f / l1, i2 = lam / l2, o1 = m1 * SC, o2 = m2 * SC;
    f32x4 Ot[8];
#pragma unroll
    for (int md = 0; md < 8; ++md) Ot[md] = (f32x4){0.f, 0.f, 0.f, 0.f};
#pragma unroll
    for (int i = 0; i < AT_NCH; ++i) { kreg[i] = *(const GAS u32x4*)(Kb + (size_t)(key0 + 32 * i) * D + h * 128 + 8 * cc0); vreg[i] = *(const GAS u32x4*)(Vb + (size_t)(key0 + 32 * i) * D + h * 128 + 8 * cc0); }
#pragma unroll
    for (int i = 0; i < AT_NCH; ++i) { *(LAS u32x4*)(lds + (key0 + 32 * i) * AT_KS + 16 * cc0) = kreg[i]; *(LAS u32x4*)(lds + AT_KBYTES + (key0 + 32 * i) * AT_VS + 16 * cc0) = vreg[i]; }
    __syncthreads();
    for (int t = 0; t < nt; ++t) {
        LAS const unsigned char* kt = lds + (t & 1) * AT_BUF; LAS const unsigned char* vt = kt + AT_KBYTES;
        if (t + 1 < nt) {
#pragma unroll
            for (int i = 0; i < AT_NCH; ++i) { kreg[i] = *(const GAS u32x4*)(Kb + (size_t)((t + 1) * AT_KT + key0 + 32 * i) * D + h * 128 + 8 * cc0);
                                               vreg[i] = *(const GAS u32x4*)(Vb + (size_t)((t + 1) * AT_KT + key0 + 32 * i) * D + h * 128 + 8 * cc0); } }
#pragma unroll
        for (int hf = 0; hf < AT_NMF / 4; ++hf) {
            f32x4 S[2][4];
#pragma unroll
            for (int cp = 0; cp < 2; ++cp)
#pragma unroll
                for (int mf = 0; mf < 4; ++mf) { S[cp][mf] = (f32x4){0.f, 0.f, 0.f, 0.f};
#pragma unroll
                    for (int ks = 0; ks < 2; ++ks) { const bf16x8 kf = *(LAS const bf16x8*)(kt + (64 * hf + 16 * mf + c) * AT_KS + cp * 128 + ks * 64 + 16 * q4);
                        S[cp][mf] = __builtin_amdgcn_mfma_f32_16x16x32_bf16(kf, Qf[cp][ks], S[cp][mf], 0, 0, 0); } }
            bf16x8 Wf[2];
#pragma unroll
            for (int kk = 0; kk < 2; ++kk) { float w[8];
#pragma unroll
                for (int jj = 0; jj < 8; ++jj) { const int mf = 2 * kk + (jj >> 2), k = jj & 3;
                    w[jj] = __builtin_amdgcn_exp2f(S[0][mf][k] * SC - o1) * i1 - __builtin_amdgcn_exp2f(S[1][mf][k] * SC - o2) * i2; }
                const unsigned p0 = pg8::cvt_pk_bf16(w[0], w[1]), p1 = pg8::cvt_pk_bf16(w[2], w[3]), p2 = pg8::cvt_pk_bf16(w[4], w[5]), p3 = pg8::cvt_pk_bf16(w[6], w[7]);
                Wf[kk] = __builtin_bit_cast(bf16x8, (u32x4){p0, p1, p2, p3}); }
#pragma unroll
            for (int md = 0; md < 8; ++md)
#pragma unroll
                for (int kk = 0; kk < 2; ++kk) { LAS const unsigned char* vp = vt + (64 * hf + 32 * kk + 4 * q4 + (c >> 2)) * AT_VS + (16 * md + 4 * (c & 3)) * 2;
                    const v4i16_t lo = __builtin_amdgcn_ds_read_tr16_b64_v4i16((LAS v4i16_t*)vp), hi = __builtin_amdgcn_ds_read_tr16_b64_v4i16((LAS v4i16_t*)(vp + 16 * AT_VS));
                    const bf16x8 vf = {lo[0], lo[1], lo[2], lo[3], hi[0], hi[1], hi[2], hi[3]};
                    Ot[md] = __builtin_amdgcn_mfma_f32_16x16x32_bf16(vf, Wf[kk], Ot[md], 0, 0, 0); }
        }
        if (t + 1 < nt) {
#pragma unroll
            for (int i = 0; i < AT_NCH; ++i) { *(LAS u32x4*)(lds + ((t + 1) & 1) * AT_BUF + (key0 + 32 * i) * AT_KS + 16 * cc0) = kreg[i];
                                               *(LAS u32x4*)(lds + ((t + 1) & 1) * AT_BUF + AT_KBYTES + (key0 + 32 * i) * AT_VS + 16 * cc0) = vreg[i]; } }
        __syncthreads();
    }
    float ss = 0.f;
#pragma unroll
    for (int md = 0; md < 8; ++md)
#pragma unroll
        for (int k = 0; k < 4; ++k) ss += Ot[md][k] * Ot[md][k];
    ss = sum_q4(ss);
    const float rs = rsqrtf(ss * (1.f / 128.f) + EPS) * (1.f - lam_init);
    const float* sg = F.inp(I_AT_SUBG);
#pragma unroll
    for (int md = 0; md < 8; ++md) { const int d0 = 16 * md + 4 * q4; const f32x4 g4 = *(const GAS f32x4*)(sg + d0);
        u32x2 w; w.x = pg8::cvt_pk_bf16(Ot[md][0] * rs * g4.x, Ot[md][1] * rs * g4.y); w.y = pg8::cvt_pk_bf16(Ot[md][2] * rs * g4.z, Ot[md][3] * rs * g4.w);
        *(GAS u32x2*)(Orows + (size_t)(16 * wave + c) * D + h * 128 + d0) = w; }
}
__device__ __forceinline__ void phase_attn(Frame& F, int l, const bf16* Q, const bf16* KP, const bf16* VP, bf16* O) {
    F.fresh();
    const float* al = F.inp(I_AT_LAM);
    const float lam_init = 0.8f - 0.6f * expf(-0.3f * (float)l);
    const float lam = expf(wave_sum(al[F.lane] * al[64 + F.lane])) - expf(wave_sum(al[128 + F.lane] * al[192 + F.lane])) + lam_init;
    for (int s = 0; ; ++s) {
        int u;
        if (F.G == 256) { if (F.bid < 128) { if (s > 0) break; u = F.bid; } else { if (s > 3) break; u = 128 + 4 * (F.bid - 128) + s; } }
        else { u = F.bid + s * F.G; if (u >= 640) break; }
        if (u < 128) { const int sb = u >> 6, h = (u >> 3) & 7, qt = u & 7; const size_t r0 = (size_t)NPROMPT + sb * 1024 + qt * 128;
            attn_unit(F, l, Q + r0 * D, F.KS + (size_t)sb * TKS * D, F.VS + (size_t)sb * TKS * D, TKS, O + r0 * D, h, lam, lam_init); }
        else { const int v = u - 128, b = v >> 4, h = (v >> 1) & 7, qt = v & 1; const size_t r0 = (size_t)b * 256 + qt * 128;
            attn_unit(F, l, Q + r0 * D, KP + (size_t)b * 256 * D, VP + (size_t)b * 256 * D, 256, O + r0 * D, h, lam, lam_init); }
    }
}

__device__ __forceinline__ void phase_ffn_convgate(Frame& F, int l, const bf16* Z, bf16* ACT) {
    F.fresh();
    const float* cw = F.inp(I_FF_CW) + (size_t)l * 3 * 2 * DFF; const float* cb = F.inp(I_FF_CB) + (size_t)l * 2 * DFF;
    const int gt = F.bid * NT + F.tid, GT = F.G * NT;
    for (int i = gt; i < M * DFF; i += GT) { const int row = i / DFF, j = i % DFF;
        int t, T; if (row < NPROMPT) { t = row & 255; T = 256; } else { t = (row - NPROMPT) & 1023; T = 1024; }
        float g = cb[j], u = cb[DFF + j];
#pragma unroll
        for (int k = 0; k < 3; ++k) { const int tt = t + k - 1; if (tt >= 0 && tt < T) { const bf16* zr = Z + (size_t)(row + k - 1) * 2 * DFF; g += cw[k * 2 * DFF + j] * bf2f(zr[j]); u += cw[k * 2 * DFF + DFF + j] * bf2f(zr[DFF + j]); } }
        ACT[i] = (bf16)f2bf(siluf_(g) * u); }
}

__global__ void __launch_bounds__(NT, 2) mk_fwd(Params prm) {
    extern __shared__ __attribute__((aligned(16))) unsigned char lds_raw[];
    Frame F;
    F.lds = (LAS unsigned char*)lds_raw; F.G = gridDim.x; F.out0 = prm.out; F.ws0 = prm.ws; F.wave0 = __builtin_amdgcn_readfirstlane(threadIdx.x >> 6);
    F.fresh();
    if (F.tid < N_IN) ((LAS unsigned long long*)(F.lds + PTR_OFF))[F.tid] = (unsigned long long)prm.in[F.tid];
    volatile LAS unsigned* MISC = (volatile LAS unsigned*)(F.lds + MISC_OFF);
    if (F.tid < 32) MISC[F.tid] = 0u;
    __syncthreads();
    (void)xcd_barrier_post((unsigned*)(prm.ws + WS_CTL) + CW_BAR, MISC + 8, F.tid == 0);
#define GRID_BAR() do { F.fresh(); XcdBarrier bar_; bar_.t0 = F.tid == 0; { unsigned* bp_ = (unsigned*)(prm.ws + WS_CTL) + CW_BAR; asm volatile("" : "+s"(bp_)); bar_.bar = bp_; } bar_.x = xb_xcc_id(); bar_.st = (volatile LAS unsigned*)(F.lds + MISC_OFF) + 8; xcd_barrier(bar_); } while (0)

#define GEMM_BF16(ACT, A_, Bt_, N_, K_, O_, ldc_, bias_, splitc_, splits_, rsq_, b2_, rsqv_, vt0_) do { pg8::Gemm g{A_, Bt_, M, N_, K_}; pg8::StaticOrder S; S.init(M, N_, F.G, F.bid); S.wave = F.wave; \
        pg8::EpiBf16<ACT> E{O_, ldc_, bias_, splitc_, splits_, rsq_, b2_, N_, rsqv_, vt0_, F.lds}; F.fresh(); E.prep(S, F.tid); pg8::gemm_phase<pg8::EpiBf16<ACT>, pg8::StaticOrder, true, true>(F.lds, g, S, E); } while (0)
#define GEMM_RESID(A_, Bt_, K_, sub_, fromin_) do { pg8::Gemm g{A_, Bt_, M, D, K_}; pg8::StaticOrder S; S.init(M, D, F.G, F.bid); S.wave = F.wave; \
        const int nl_ = (sub_) == 0 ? l : l + 1, ns_ = (sub_) == 0 ? 1 : 0; const bool last_ = nl_ >= DEPTH; \
        pg8::EpiResid E{F.out, F.inp(I_XP), F.inp(I_XS), F.mod + (size_t)l * 18 * D, (sub_) * 3 + 2, fromin_, last_ ? nullptr : F.H, F.inp(I_NORMG) + (size_t)((last_ ? 0 : nl_) * 2 + ns_) * D, \
                          F.mod + (size_t)(last_ ? 0 : nl_) * 18 * D, ns_ * 3 + 1, (sub_) == 0 ? F.rsq1 : F.rsq0, F.lds}; \
        F.fresh(); E.prep(S, F.tid); pg8::gemm_phase<pg8::EpiResid, pg8::StaticOrder, true, true>(F.lds, g, S, E); side_job(F, 2 * l + (sub_) + 1); } while (0)

    phase_prologue(F);
    GRID_BAR();
    phase_modulate0(F);
    GRID_BAR();
#pragma unroll 1
    for (int l = 0; l < DEPTH; ++l) {
        const int kind = l % 3, j = l / 3;
        F.fresh();
        if (kind == 0) {
            bf16 *GB = F.T2, *REC = F.T2 + (size_t)M * DRNN, *PF = F.T3, *PB = F.T3 + (size_t)NSAMPLE * DRNN, *HS = F.T3 + (size_t)6 * 1024 * 1024;
            float* AGG = (float*)(F.T3 + (size_t)2 * NSAMPLE * DRNN);
            GEMM_BF16(2, F.H, F.WT + WE_LRU_IN + (size_t)j * 2 * DRNN * D, 2 * DRNN, D, GB, DRNN, nullptr, DRNN, (size_t)M * DRNN, F.rsq0, F.bias2 + B2_LRU + (size_t)j * 3 * 2560, nullptr, 0);
            GRID_BAR();
            phase_lru_core(F, j, REC, GB, HS, PF, PB, AGG, (unsigned*)(F.ws + WS_CTL) + CW_LRU, F.WT + WE_WG + (size_t)j * 40 * 128 * 128);
            GRID_BAR();
            GEMM_RESID(HS, F.WT + WE_LRU_OUT + (size_t)j * D * DRNN, DRNN, 0, l == 0);
        } else if (kind == 1) {
            bf16 *UV = F.T1, *ACT = F.T2;
            GEMM_BF16(1, F.H, F.WT + WE_CM_IN, 2 * DB, D, UV, 2 * DB, F.inp(I_CM_BIN), 0, 0, F.rsq0, F.bias2 + B2_CM, F.rsqv, 8);
            GRID_BAR();
            phase_cmlp_spatial_mfma(F, UV, ACT, F.WT + WE_WSB);
            GRID_BAR();
            GEMM_RESID(ACT, F.WT + WE_CM_OUT, DB, 0, false);
        } else {
            bf16 *Q = F.T2, *KP = F.T2 + (size_t)M * D, *VP = KP + (size_t)NPROMPT * D, *O = F.T3;
            { pg8::Gemm g{F.H, F.WT + WE_QKV, M, 3 * D, D}; pg8::StaticOrder S; S.init(M, 3 * D, F.G, F.bid); S.wave = F.wave;
              pg8::EpiQkv E{F.ws, F.out, F.rsq0, F.bias2 + B2_QKV, F.lds, F.inp(I_AT_QKG), F.rope};
              F.fresh(); E.prep(S, F.tid); pg8::gemm_phase<pg8::EpiQkv, pg8::StaticOrder, true, true>(F.lds, g, S, E); }
            GRID_BAR();
            phase_attn(F, l, Q, KP, VP, O);
            GRID_BAR();
            GEMM_RESID(O, F.WT + WE_AT_OUT, D, 0, false);
        }
        GRID_BAR();
        { pg8::Gemm g{F.H, F.WT + WE_UP + (size_t)l * 2 * DFF * D, 42 * 256, 2 * DFF, D}; pg8::FfnOrder S; S.init(42 * 256, 2 * DFF, F.G, F.bid); S.wave = F.wave;
          pg8::EpiFfn E{F.T2, F.inp(I_FF_CW) + (size_t)l * 3 * 2 * DFF, F.inp(I_FF_CB) + (size_t)l * 2 * DFF, F.rsq1, F.bias2 + B2_UP + (size_t)l * 3 * 5632, F.lds};
          F.fresh(); E.prep(S, F.tid); pg8::gemm_phase<pg8::EpiFfn, pg8::FfnOrder, true, true>(F.lds, g, S, E); }
        GRID_BAR();
        GEMM_RESID(F.T2, F.WT + WE_DN + (size_t)l * D * DFF, DFF, 1, false);
        GRID_BAR();
    }
}

extern "C" void kernel_launch(void* const* d_in, const int* in_sizes, int n_in, void* d_out, int out_size, void* d_ws, size_t ws_size, hipStream_t stream) {
    static int grid = 0;
    if (grid == 0) {
        if (n_in != N_IN || ws_size < WS_END) { fprintf(stderr, "kernel_launch: unexpected n_in %d or ws_size %zu\n", n_in, ws_size); grid = -1; return; }
        int dev = 0, cus = 0, per_cu = 0;
        hipGetDevice(&dev); hipDeviceGetAttribute(&cus, hipDeviceAttributeMultiprocessorCount, dev);
        hipFuncSetAttribute((const void*)mk_fwd, hipFuncAttributeMaxDynamicSharedMemorySize, LDS_BYTES);
        hipOccupancyMaxActiveBlocksPerMultiprocessor(&per_cu, (const void*)mk_fwd, NT, LDS_BYTES);
        (void)hipGetLastError();
        if (per_cu < 1) { fprintf(stderr, "kernel_launch: occupancy query says %d blocks per CU\n", per_cu); per_cu = 1; }
        grid = cus;
    }
    if (grid < 0) return;
    hipMemsetAsync((char*)d_ws + WS_CTL, 0, CTL_ZERO_BYTES, stream);
    Params p{};
    for (int i = 0; i < N_IN; ++i) p.in[i] = (const float*)d_in[i];
    p.out = (float*)d_out; p.ws = (unsigned char*)d_ws;
    void* args[] = {&p};
    hipError_t e = hipLaunchCooperativeKernel((const void*)mk_fwd, dim3(grid), dim3(NT), args, LDS_BYTES, stream);
    if (e != hipSuccess) fprintf(stderr, "kernel_launch: cooperative launch failed: %s (grid %d)\n", hipGetErrorString(e), grid);
}
```

```cpp
#include <hip/hip_runtime.h>
#include <cstdio>
#include <cstdint>

#define GAS __attribute__((address_space(1)))
#define LAS __attribute__((address_space(3)))
typedef unsigned short bf16;
typedef float f32x4 __attribute__((ext_vector_type(4)));
typedef unsigned u32x2 __attribute__((ext_vector_type(2)));
typedef unsigned u32x4 __attribute__((ext_vector_type(4)));

constexpr int D = 1024, NPROMPT = 32 * 256, NSAMPLE = 2 * 1024, M = NPROMPT + NSAMPLE;
constexpr int DEPTH = 4, DRNN = 1280, DB = 2048, DFF = 2816, PAST = 512, TKS = PAST + 1024;
constexpr float EPS = 1e-6f;
constexpr int NWAVES = 8, NT = NWAVES * 64;

enum { I_XP = 0, I_XS, I_STATE, I_CK, I_CV, I_C, I_CCTX, I_WMOD, I_BMOD, I_NORMG, I_LRU_WIN, I_LRU_CW, I_LRU_CB, I_LRU_WG, I_LRU_BG, I_LRU_LAM, I_LRU_WOUT,
       I_CM_WIN, I_CM_BIN, I_CM_NG, I_CM_WS, I_CM_BS, I_CM_WOUT, I_AT_WQKV, I_AT_QKG, I_AT_LAM, I_AT_SUBG, I_AT_WOUT, I_FF_WUP, I_FF_CW, I_FF_CB, I_FF_WDN, N_IN };
constexpr size_t O_YP = 0, O_YS = (size_t)NPROMPT * D, O_STATE = (size_t)M * D, O_CK = O_STATE + 32 * 2 * 2 * DRNN, O_CV = O_CK + (size_t)NPROMPT * D;

constexpr size_t MiB = 1u << 20;
constexpr size_t WS_CTL = 0, CTL_ZERO_BYTES = 64 * 1024;
constexpr size_t WS_MOD = 1 * MiB;
constexpr size_t WS_RSTD = WS_MOD + 512 * 1024;
constexpr size_t WS_ROPE = WS_RSTD + 256 * 1024;
constexpr size_t WS_H = 2 * MiB;
constexpr size_t WS_T1 = 22 * MiB;
constexpr size_t WS_XB = 22 * MiB + 84 * MiB;
constexpr size_t WS_T2 = 132 * MiB;
constexpr size_t WS_T3 = 187 * MiB;
constexpr size_t WS_X = WS_T3 + 40 * MiB;
constexpr size_t B2_LRU = 0, B2_CM = B2_LRU + (size_t)2 * 3 * 2560, B2_QKV = B2_CM + (size_t)3 * 4096, B2_UP = B2_QKV + (size_t)3 * 3072, B2_END = B2_UP + (size_t)4 * 3 * 5632;
constexpr size_t WS_KS = 237 * MiB, WS_VS = 243 * MiB;
constexpr size_t WS_W = 249 * MiB;
constexpr size_t WE_LRU_IN = 0, WE_LRU_OUT = WE_LRU_IN + (size_t)2 * 2560 * 1024, WE_CM_IN = WE_LRU_OUT + (size_t)2 * 1024 * 1280, WE_CM_OUT = WE_CM_IN + (size_t)4096 * 1024,
                 WE_QKV = WE_CM_OUT + (size_t)1024 * 2048, WE_AT_OUT = WE_QKV + (size_t)3072 * 1024, WE_UP = WE_AT_OUT + (size_t)1024 * 1024, WE_DN = WE_UP + (size_t)4 * 5632 * 1024,
                 WE_WG = WE_DN + (size_t)4 * 1024 * 2816, WE_WSB = WE_WG + (size_t)80 * 128 * 128, WE_END = WE_WSB + (size_t)8 * 128 * 128;
constexpr size_t WS_END = WS_W + 106 * MiB;
static_assert(WE_END * 2 <= 106 * MiB, "weight copies fit");
constexpr int CW_BAR = 1024;
constexpr int CW_SJQ = 12288;
constexpr int CW_LRU = 8192;

constexpr int LDS_BYTES = 163840;
constexpr int MISC_OFF = LDS_BYTES - 256, PTR_OFF = LDS_BYTES - 1024;

__device__ __forceinline__ unsigned f2bf(float f) { unsigned u = __builtin_bit_cast(unsigned, f); return (u + 0x7fffu + ((u >> 16) & 1u)) >> 16; }
__device__ __forceinline__ float bf2f(unsigned b) { return __builtin_bit_cast(float, (b & 0xffffu) << 16); }
template <int CTRL> __device__ __forceinline__ float dppf(float v) { return __builtin_bit_cast(float, __builtin_amdgcn_update_dpp(0, __builtin_bit_cast(int, v), CTRL, 0xf, 0xf, false)); }
__device__ __forceinline__ float swz_xor16(float v) { return __builtin_bit_cast(float, __builtin_amdgcn_ds_swizzle(__builtin_bit_cast(int, v), 0x401F)); }
__device__ __forceinline__ float sum_x32(float v) { auto r = __builtin_amdgcn_permlane32_swap(__builtin_bit_cast(unsigned, v), __builtin_bit_cast(unsigned, v), false, false);
    return __builtin_bit_cast(float, (unsigned)r[0]) + __builtin_bit_cast(float, (unsigned)r[1]); }
__device__ __forceinline__ float max_x32(float v) { auto r = __builtin_amdgcn_permlane32_swap(__builtin_bit_cast(unsigned, v), __builtin_bit_cast(unsigned, v), false, false);
    return fmaxf(__builtin_bit_cast(float, (unsigned)r[0]), __builtin_bit_cast(float, (unsigned)r[1])); }
__device__ __forceinline__ float sum_q4(float v) { v += swz_xor16(v); return sum_x32(v); }
__device__ __forceinline__ float max_q4(float v) { v = fmaxf(v, swz_xor16(v)); return max_x32(v); }
__device__ __forceinline__ float wave_sum(float v) { v += dppf<0xB1>(v); v += dppf<0x4E>(v); v += dppf<0x141>(v); v += dppf<0x140>(v); return sum_q4(v); }
__device__ __forceinline__ float wave_max(float v) { v = fmaxf(v, dppf<0xB1>(v)); v = fmaxf(v, dppf<0x4E>(v)); v = fmaxf(v, dppf<0x141>(v)); v = fmaxf(v, dppf<0x140>(v)); return max_q4(v); }
__device__ __forceinline__ float bperm(float v, int src_lane) { return __builtin_bit_cast(float, __builtin_amdgcn_ds_bpermute(src_lane << 2, __builtin_bit_cast(int, v))); }
__device__ __forceinline__ float gelu_tanh(float x) {
    const float t = x * x * (-0.102943174f) + (-2.302208198f);
    return x * __builtin_amdgcn_rcpf(1.f + __builtin_amdgcn_exp2f(t * x)); }
__device__ __forceinline__ float sigmoidf_(float x) { return __builtin_amdgcn_rcpf(1.f + __builtin_amdgcn_exp2f(-1.44269504f * x)); }
__device__ __forceinline__ float siluf_(float x) { return x * __builtin_amdgcn_rcpf(1.f + __builtin_amdgcn_exp2f(-1.44269504f * x)); }
__device__ __forceinline__ float softplusf_(float x) { return fmaxf(x, 0.f) + 0.693147181f * __builtin_amdgcn_logf(1.f + __builtin_amdgcn_exp2f(-1.44269504f * fabsf(x))); }

#define XB_TMO      128
#define XB_XCNT(j)  (256  + 64 * (j))
#define XB_XSUB(j)  (1280 + 64 * (j))
#define XB_XGEN(j)  (2304 + 64 * (j))
#define XB_TOP      3328
#define XB_TOPGEN   3392
#define XCD_BAR_WORDS 3456
#define XB_SPIN_CAP (1u << 22)
__device__ __forceinline__ unsigned xb_ld(unsigned* p)              { return __hip_atomic_load(p, __ATOMIC_RELAXED, __HIP_MEMORY_SCOPE_AGENT); }
__device__ __forceinline__ unsigned xb_add(unsigned* p, unsigned v) { return __hip_atomic_fetch_add(p, v, __ATOMIC_RELAXED, __HIP_MEMORY_SCOPE_AGENT); }
__device__ __forceinline__ unsigned xb_xcc_id() { return (unsigned)__builtin_amdgcn_s_getreg((3 << 11) | 20) & 0xFu; }
#define XB_SPIN(cond, bar) do { unsigned _sp = 0; while (cond) { __builtin_amdgcn_s_sleep(1); \
    if ((++_sp & 255u) == 0u) { if (xb_ld(&(bar)[XB_TMO])) break; if (_sp > XB_SPIN_CAP) { atomicAdd(&(bar)[XB_TMO], 1u); break; } } } } while (0)
struct XcdBarrier { unsigned* bar; unsigned x; volatile LAS unsigned* st; bool t0; };
__device__ __forceinline__ XcdBarrier xcd_barrier_post(unsigned* bar, volatile LAS unsigned* st, bool t0) {
    XcdBarrier b; b.bar = bar; b.x = xb_xcc_id(); b.st = st; b.t0 = t0;
    if (t0) (void)xb_add(&bar[XB_XCNT(b.x)], 1u);
    return b;
}
__device__ __forceinline__ void xcd_barrier_complete(unsigned* bar, unsigned x, unsigned& nloc, unsigned& nx) {
    const unsigned G = gridDim.x * gridDim.y * gridDim.z;
    unsigned sum, cnt, mine, sp = 0u;
    for (;;) {
        sum = 0u; cnt = 0u; mine = 0u;
#pragma unroll
        for (unsigned j = 0; j < 16; ++j) { const unsigned c = xb_ld(&bar[XB_XCNT(j)]); sum += c; cnt += (c > 0u) ? 1u : 0u; mine = (j == x) ? c : mine; }
        if (sum == G) break;
        __builtin_amdgcn_s_sleep(1);
        if ((++sp & 255u) == 0u) { if (xb_ld(&bar[XB_TMO])) break; if (sp > XB_SPIN_CAP) { atomicAdd(&bar[XB_TMO], 1u); break; } }
    }
    nloc = mine > 0u ? mine : 1u; nx = cnt > 0u ? cnt : 1u;
}
__device__ __forceinline__ void xcd_barrier(const XcdBarrier& b) {
    asm volatile("s_waitcnt vmcnt(0)" ::: "memory");
    __syncthreads();
    if (b.t0) {
        unsigned* bar = b.bar;
        __builtin_amdgcn_s_waitcnt(0);
        unsigned nloc = b.st[0], nx = b.st[1];
        if (nloc == 0u) { xcd_barrier_complete(bar, b.x, nloc, nx); b.st[0] = nloc; b.st[1] = nx; }
        const unsigned old = xb_add(&bar[XB_XSUB(b.x)], 1u);
        const unsigned gen = old / nloc;
        if (old + 1u == (gen + 1u) * nloc) {
            __builtin_amdgcn_fence(__ATOMIC_RELEASE, "agent");
            asm volatile("s_waitcnt vmcnt(0)" ::: "memory");
            const unsigned og = xb_add(&bar[XB_TOP], 1u);
            const unsigned tg = og / nx;
            if (og + 1u == (tg + 1u) * nx) xb_add(&bar[XB_TOPGEN], 1u);
            else XB_SPIN(xb_ld(&bar[XB_TOPGEN]) == tg, bar);
            __builtin_amdgcn_fence(__ATOMIC_ACQUIRE, "agent");
            xb_add(&bar[XB_XGEN(b.x)], 1u);
            asm volatile("s_waitcnt vmcnt(0)" ::: "memory");
        } else {
            XB_SPIN(xb_ld(&bar[XB_XGEN(b.x)]) == gen, bar);
            __builtin_amdgcn_fence(__ATOMIC_ACQUIRE, "agent");
            asm volatile("s_waitcnt vmcnt(0)" ::: "memory");
        }
    }
    __syncthreads();
}

__device__ __forceinline__ void xcd_barrier_arrive(const XcdBarrier& b) {
    asm volatile("s_waitcnt vmcnt(0)" ::: "memory");
    __syncthreads();
    if (b.t0) {
        unsigned* bar = b.bar;
        __builtin_amdgcn_s_waitcnt(0);
        unsigned nloc = b.st[0], nx = b.st[1];
        if (nloc == 0u) { xcd_barrier_complete(bar, b.x, nloc, nx); b.st[0] = nloc; b.st[1] = nx; }
        const unsigned old = xb_add(&bar[XB_XSUB(b.x)], 1u);
        const unsigned gen = old / nloc;
        if (old + 1u == (gen + 1u) * nloc) {
            __builtin_amdgcn_fence(__ATOMIC_RELEASE, "agent");
            asm volatile("s_waitcnt vmcnt(0)" ::: "memory");
            const unsigned og = xb_add(&bar[XB_TOP], 1u);
            const unsigned tg = og / nx;
            if (og + 1u == (tg + 1u) * nx) xb_add(&bar[XB_TOPGEN], 1u);
            else XB_SPIN(xb_ld(&bar[XB_TOPGEN]) == tg, bar);
            __builtin_amdgcn_fence(__ATOMIC_ACQUIRE, "agent");
            xb_add(&bar[XB_XGEN(b.x)], 1u);
            asm volatile("s_waitcnt vmcnt(0)" ::: "memory");
            b.st[2] = 0xffffffffu;
        } else b.st[2] = gen;
    }
    __syncthreads();
}
__device__ __forceinline__ void xcd_barrier_wait(const XcdBarrier& b) {
    asm volatile("s_waitcnt vmcnt(0)" ::: "memory");
    __syncthreads();
    if (b.t0) { const unsigned gen = b.st[2];
        if (gen != 0xffffffffu) { unsigned* bar = b.bar;
            XB_SPIN(xb_ld(&bar[XB_XGEN(b.x)]) == gen, bar);
            __builtin_amdgcn_fence(__ATOMIC_ACQUIRE, "agent");
            asm volatile("s_waitcnt vmcnt(0)" ::: "memory"); } }
    __syncthreads();
}

namespace pg8 {
#define PG8_LAS __attribute__((address_space(3)))
typedef unsigned short bf16_t;
typedef short bf16x8 __attribute__((ext_vector_type(8)));
typedef float f32x4 __attribute__((ext_vector_type(4)));
typedef unsigned u32x4 __attribute__((ext_vector_type(4)));
constexpr int BM = 256, BK = 64, HALF = 128, HTB = HALF * BK * 2  , STAGE_BYTES = 8 * HTB, NXCD = 8, WGM = 8;

__host__ __device__ __forceinline__ int lds_byte(int r, int c) { const int st = (r >> 4) * 2 + (c >> 5), rr = r & 15, cc = c & 31, ob = rr * 64 + cc * 2; return st * 1024 + (ob ^ (((ob >> 9) & 1) << 5)); }
__host__ __device__ __forceinline__ void stage_rc(int b, int& R, int& C) { const int st = b / 1024, sb = b % 1024, swz = sb ^ (((sb >> 9) & 1) << 5); R = (st >> 1) * 16 + swz / 64; C = (st & 1) * 32 + (swz % 64) / 2; }
__host__ __device__ __forceinline__ int perm32(int rho) { const int n = rho >> 4, i = rho & 15; return 8 * (i >> 2) + 4 * n + (i & 3); }

struct Unit { int pm, pn; };
struct Gemm { const bf16_t* A; const bf16_t* Bt; int M, N, K; };

struct StaticOrder {
    int nM, nN, nwg, G, c, wave;
    __host__ __device__ __forceinline__ void init(int M, int N, int G_, int c_) { nM = M / BM; nN = N / BM; nwg = nM * nN; G = G_; c = c_; }
    __host__ __device__ __forceinline__ bool next(int i, Unit& u) const {
        const long L = (long)i * G + c; if (L >= nwg) return false;
        int wgid = (int)L; { const int q = nwg / NXCD, r = nwg % NXCD, xcd = wgid % NXCD, off = wgid / NXCD; wgid = (xcd < r ? xcd * (q + 1) : r * (q + 1) + (xcd - r) * q) + off; }
        const int nig = WGM * nN, gid = wgid / nig, fm = gid * WGM, gsz = (nM - fm) < WGM ? (nM - fm) : WGM;
        u.pm = fm + ((wgid % nig) % gsz); u.pn = (wgid % nig) / gsz; return true;
    }
    __device__ __forceinline__ int arow(int pm) const { return pm * BM; }
    __device__ __forceinline__ void a_ready(const Unit&) const {}
    __device__ __forceinline__ void done(const Unit&) const {}
};

template <class Epi, class Sched, bool ALIGN_EPI = false, bool SP2 = false>
__device__ __forceinline__ void gemm_phase(PG8_LAS unsigned char* lds, const Gemm g, const Sched& S, const Epi& E) {
    int z_ = 0; asm volatile("" : "+v"(z_));
    const int lane = __builtin_amdgcn_mbcnt_hi(~0u, __builtin_amdgcn_mbcnt_lo(~0u, z_)), wid = S.wave, tid = wid * 64 + lane, wr = wid >> 2, wc = wid & 3, fr = lane & 15, fq = lane >> 4;
    const int K = g.K, nt = K / BK;
    unsigned voffA[2], voffB[2];
#pragma unroll
    for (int i = 0; i < 2; ++i) { int R, C; stage_rc(tid * 16 + i * 8192, R, C); const int Rb = Epi::PERM ? ((R & ~31) + perm32(R & 31)) : R;
        const int Ra = Epi::PERMA ? ((R & ~63) + 4 * (R & 15) + ((R >> 4) & 3)) : R;
        voffA[i] = (unsigned)(Ra * K + C) * 2u; voffB[i] = (unsigned)(Rb * K + C) * 2u; }
    const size_t kstep = (size_t)(BK * 2);
    constexpr int MF = Epi::MF;
    const size_t hstep = (size_t)HALF * K * 2;
    const size_t hstepA = (size_t)(32 * MF) * K * 2;
    const size_t tstep = 2 * hstep;
    const unsigned ldsw = (unsigned)wid * 1024u;
    const int aoff = lds_byte(wr * 16 * MF + fr, fq * 8), boff = lds_byte(wc * 32 + fr, fq * 8);
#define PG8_SA(b, h) (((b) * 2 + (h)) * HTB)
#define PG8_SB(b, h) ((4 + (b) * 2 + (h)) * HTB)
#define PG8_STAGE(bufoff, gbase, voff) do { _Pragma("unroll") for (int _i = 0; _i < 2; ++_i) \
        __builtin_amdgcn_global_load_lds((const unsigned*)((const char*)(gbase) + (voff)[_i]), (PG8_LAS unsigned*)(lds + (bufoff) + ldsw + _i * 8192), 16, 0, 0); } while (0)
#define PG8_LDA(dst, b, h) do { _Pragma("unroll") for (int m = 0; m < MF; ++m) _Pragma("unroll") for (int k = 0; k < 2; ++k) dst[m][k] = *(const PG8_LAS bf16x8*)(lds + PG8_SA(b, h) + aoff + m * 2048 + k * 1024); } while (0)
#define PG8_LDB(dst, b, h) do { _Pragma("unroll") for (int n = 0; n < 2; ++n) _Pragma("unroll") for (int k = 0; k < 2; ++k) dst[n][k] = *(const PG8_LAS bf16x8*)(lds + PG8_SB(b, h) + boff + n * 2048 + k * 1024); } while (0)
#define PG8_MMA(ai, bj, At, Bt) do { __builtin_amdgcn_s_setprio(1); _Pragma("unroll") for (int m = 0; m < MF; ++m) _Pragma("unroll") for (int n = 0; n < 2; ++n) _Pragma("unroll") for (int k = 0; k < 2; ++k) \
        acc[ai][bj][m][n] = __builtin_amdgcn_mfma_f32_16x16x32_bf16(Bt[n][k], At[m][k], acc[ai][bj][m][n], 0, 0, 0); __builtin_amdgcn_s_setprio(0); } while (0)
#define PG8_WAIT_V(n) asm volatile("s_waitcnt vmcnt(" #n ")" ::: "memory")
    const bool afull = (MF == 4) || wid < 4;
#define PG8_STAGEA(bufoff, gbase) do { __builtin_amdgcn_global_load_lds((const unsigned*)((const char*)(gbase) + voffA[0]), (PG8_LAS unsigned*)(lds + (bufoff) + ldsw), 16, 0, 0); \
        if (afull) __builtin_amdgcn_global_load_lds((const unsigned*)((const char*)(gbase) + voffA[1]), (PG8_LAS unsigned*)(lds + (bufoff) + ldsw + 8192), 16, 0, 0); } while (0)
#define PG8_WAIT_VA(n, nr) do { if (afull) asm volatile("s_waitcnt vmcnt(" #n ")" ::: "memory"); else asm volatile("s_waitcnt vmcnt(" #nr ")" ::: "memory"); } while (0)
#define PG8_WAIT_L(n) asm volatile("s_waitcnt lgkmcnt(" #n ")" ::: "memory")
#define PG8_BAR __builtin_amdgcn_s_barrier()
#define PG8_SCHED __builtin_amdgcn_sched_barrier(0)
    Unit cur, nxt; int ui = 0;
    if (!S.next(0, cur)) return;
    f32x4 acc[2][2][MF][2];
#pragma unroll
    for (int a = 0; a < 2; ++a)
#pragma unroll
        for (int b = 0; b < 2; ++b)
#pragma unroll
            for (int m = 0; m < MF; ++m)
#pragma unroll
                for (int n = 0; n < 2; ++n) acc[a][b][m][n] = (f32x4){0.f, 0.f, 0.f, 0.f};
    bf16x8 At[MF][2], B0[2][2], B1[2][2];
    const char* cA = (const char*)g.A + (size_t)S.arow(cur.pm) * (size_t)K * 2; const char* cB = (const char*)g.Bt + (size_t)cur.pn * tstep;
    S.a_ready(cur);
    if constexpr (SP2) {
        PG8_STAGE(PG8_SB(0, 0), cB, voffB); PG8_STAGE(PG8_SB(0, 1), cB + hstep, voffB); PG8_STAGEA(PG8_SA(0, 0), cA); PG8_STAGEA(PG8_SA(0, 1), cA + hstepA);
        if (wr == 1) PG8_BAR;
        PG8_WAIT_VA(2, 1); PG8_BAR;
        PG8_STAGE(PG8_SB(1, 0), cB + kstep, voffB); PG8_STAGEA(PG8_SA(1, 0), cA + kstep); PG8_STAGE(PG8_SB(1, 1), cB + hstep + kstep, voffB);
        PG8_WAIT_VA(6, 5); PG8_BAR;
    } else {
        PG8_STAGE(PG8_SB(0, 0), cB, voffB); PG8_STAGE(PG8_SA(0, 0), cA, voffA); PG8_STAGE(PG8_SB(0, 1), cB + hstep, voffB); PG8_STAGE(PG8_SA(0, 1), cA + hstepA, voffA);
        if (wr == 1) PG8_BAR;
        PG8_WAIT_V(4); PG8_BAR;
        PG8_STAGE(PG8_SB(1, 0), cB + kstep, voffB); PG8_STAGE(PG8_SA(1, 0), cA + kstep, voffA); PG8_STAGE(PG8_SB(1, 1), cB + hstep + kstep, voffB);
        PG8_WAIT_V(6); PG8_BAR;
    }
    for (;;) {
        const bool has_next = S.next(ui + 1, nxt);
        const char* nA = has_next ? (const char*)g.A + (size_t)S.arow(nxt.pm) * (size_t)K * 2 : cA; const char* nB = has_next ? (const char*)g.Bt + (size_t)nxt.pn * tstep : cB;
        for (int t = 0; t < nt; t += 2) {
            const bool last = (t == nt - 2);
            const char* a1 = cA + (size_t)(t + 1) * kstep;
            const char* a2 = last ? nA : cA + (size_t)(t + 2) * kstep; const char* b2 = last ? nB : cB + (size_t)(t + 2) * kstep;
            const char* a3 = a2 + kstep; const char* b3 = b2 + kstep;
            if (last && has_next) S.a_ready(nxt);
            if constexpr (SP2) {
            const bool tail = last && !has_next;
            PG8_LDB(B0, 0, 0); PG8_LDB(B1, 0, 1); PG8_SCHED; PG8_LDA(At, 0, 0); PG8_STAGEA(PG8_SA(1, 1), a1 + hstepA);
            PG8_WAIT_VA(8, 6); PG8_WAIT_L(0); PG8_BAR; PG8_MMA(0, 0, At, B0); PG8_MMA(0, 1, At, B1); PG8_BAR; PG8_SCHED;
            PG8_LDA(At, 0, 1); if (!tail) { PG8_STAGE(PG8_SB(0, 0), b2, voffB); PG8_STAGE(PG8_SB(0, 1), b2 + hstep, voffB); PG8_STAGEA(PG8_SA(0, 0), a2); }
            if (tail) PG8_WAIT_VA(2, 1); else PG8_WAIT_VA(8, 6);
            PG8_WAIT_L(0); PG8_BAR; PG8_MMA(1, 0, At, B0); PG8_MMA(1, 1, At, B1); PG8_BAR; PG8_SCHED;
            PG8_LDB(B0, 1, 0); PG8_LDB(B1, 1, 1); PG8_SCHED; PG8_LDA(At, 1, 0); if (!tail) PG8_STAGEA(PG8_SA(0, 1), a2 + hstepA);
            if (tail) PG8_WAIT_V(0); else PG8_WAIT_VA(8, 6);
            PG8_WAIT_L(0); PG8_BAR; PG8_MMA(0, 0, At, B0); PG8_MMA(0, 1, At, B1); PG8_BAR; PG8_SCHED;
            PG8_LDA(At, 1, 1); if (!tail) { PG8_STAGE(PG8_SB(1, 0), b3, voffB); PG8_STAGE(PG8_SB(1, 1), b3 + hstep, voffB); PG8_STAGEA(PG8_SA(1, 0), a3); }
            if (tail) PG8_WAIT_V(0); else PG8_WAIT_VA(8, 6);
            PG8_WAIT_L(0); PG8_BAR; PG8_MMA(1, 0, At, B0); PG8_MMA(1, 1, At, B1); PG8_BAR; PG8_SCHED;
            } else {
            PG8_LDB(B0, 0, 0); PG8_SCHED; PG8_LDA(At, 0, 0); PG8_STAGE(PG8_SA(1, 1), a1 + hstepA, voffA);
            PG8_WAIT_L(8); PG8_BAR; PG8_WAIT_L(0); PG8_MMA(0, 0, At, B0); PG8_BAR; PG8_SCHED;
            PG8_LDB(B1, 0, 1); PG8_STAGE(PG8_SB(0, 0), b2, voffB);
            PG8_BAR; PG8_WAIT_L(0); PG8_MMA(0, 1, At, B1); PG8_BAR;
            PG8_LDA(At, 0, 1); PG8_STAGE(PG8_SA(0, 0), a2, voffA);
            PG8_BAR; PG8_WAIT_L(0); PG8_MMA(1, 0, At, B0); PG8_BAR; PG8_SCHED;
            PG8_STAGE(PG8_SB(0, 1), b2 + hstep, voffB);
            PG8_WAIT_V(6); PG8_BAR; PG8_MMA(1, 1, At, B1); PG8_BAR;
            PG8_LDB(B0, 1, 0); PG8_SCHED; PG8_LDA(At, 1, 0); PG8_STAGE(PG8_SA(0, 1), a2 + hstepA, voffA);
            PG8_WAIT_L(8); PG8_BAR; PG8_WAIT_L(0); PG8_MMA(0, 0, At, B0); PG8_BAR; PG8_SCHED;
            PG8_LDB(B1, 1, 1); PG8_STAGE(PG8_SB(1, 0), b3, voffB);
            PG8_BAR; PG8_WAIT_L(0); PG8_MMA(0, 1, At, B1); PG8_BAR;
            PG8_LDA(At, 1, 1); PG8_STAGE(PG8_SA(1, 0), a3, voffA);
            PG8_BAR; PG8_WAIT_L(0); PG8_MMA(1, 0, At, B0); PG8_BAR; PG8_SCHED;
            PG8_STAGE(PG8_SB(1, 1), b3 + hstep, voffB);
            PG8_WAIT_V(6); PG8_BAR; PG8_MMA(1, 1, At, B1); PG8_BAR;
            }
        }
        if constexpr (ALIGN_EPI) { if (wr == 0) PG8_BAR; }
        if constexpr (!Epi::AFTER_DRAIN) { int ze_ = 0; asm volatile("" : "+v"(ze_)); const int le_ = __builtin_amdgcn_mbcnt_hi(~0u, __builtin_amdgcn_mbcnt_lo(~0u, ze_)), fre = le_ & 15, fqe = le_ >> 4;
            if constexpr (Epi::DEFER) E(acc, cur, ui, wr, wc, fre, fqe, !has_next); else E(acc, cur, ui, wr, wc, fre, fqe); S.done(cur); }
        if (!has_next) break;
#pragma unroll
        for (int a = 0; a < 2; ++a)
#pragma unroll
            for (int b = 0; b < 2; ++b)
#pragma unroll
                for (int m = 0; m < MF; ++m)
#pragma unroll
                    for (int n = 0; n < 2; ++n) acc[a][b][m][n] = (f32x4){0.f, 0.f, 0.f, 0.f};
        cur = nxt; cA = nA; cB = nB; ++ui;
        if constexpr (ALIGN_EPI) { if (wr == 1) PG8_BAR; }
    }
    PG8_WAIT_V(0);
    if constexpr (!ALIGN_EPI) { if (wr == 0) PG8_BAR; }
    PG8_BAR;
    if constexpr (Epi::AFTER_DRAIN) { E.fused(acc, cur, wr, wc, fr, fq, lds, wid, lane); S.done(cur); }
#undef PG8_SA
#undef PG8_SB
#undef PG8_STAGE
#undef PG8_LDA
#undef PG8_LDB
#undef PG8_MMA
#undef PG8_WAIT_V
#undef PG8_WAIT_VA
#undef PG8_STAGEA
#undef PG8_WAIT_L
#undef PG8_BAR
#undef PG8_SCHED
}
}

namespace pg8 {
__device__ __forceinline__ unsigned cvt_pk_bf16(float lo, float hi) { unsigned r; asm volatile("v_cvt_pk_bf16_f32 %0, %1, %2" : "=v"(r) : "v"(lo), "v"(hi)); return r; }
__device__ __forceinline__ f32x4 gelu4(f32x4 v) { f32x4 o; o.x = gelu_tanh(v.x); o.y = gelu_tanh(v.y); o.z = gelu_tanh(v.z); o.w = gelu_tanh(v.w); return o; }
constexpr int ETAB_OFF = 131072 + 8192, ETAB_SLOT = 4608, ETAB_MAXU = 4, FFN_ZROW = ETAB_OFF + ETAB_MAXU * ETAB_SLOT;
__device__ __forceinline__ float row_rstd(const float* rsq, int row) {
    const GAS f32x4* p = (const GAS f32x4*)(rsq + (size_t)row * 16);
    const f32x4 a = p[0], b = p[1], c = p[2], d = p[3];
    const float s = ((a.x + a.y) + (a.z + a.w)) + ((b.x + b.y) + (b.z + b.w)) + ((c.x + c.y) + (c.z + c.w)) + ((d.x + d.y) + (d.z + d.w));
    return rsqrtf(s * (1.f / D) + EPS);
}
__device__ __forceinline__ void rstd_load(const float* rsq, int row, f32x4 (&q)[4]) { const GAS f32x4* p = (const GAS f32x4*)(rsq + (size_t)row * 16); q[0] = p[0]; q[1] = p[1]; q[2] = p[2]; q[3] = p[3]; }
__device__ __forceinline__ float rstd_finish(const f32x4 (&q)[4]) {
    const float s = ((q[0].x + q[0].y) + (q[0].z + q[0].w)) + ((q[1].x + q[1].y) + (q[1].z + q[1].w)) + ((q[2].x + q[2].y) + (q[2].z + q[2].w)) + ((q[3].x + q[3].y) + (q[3].z + q[3].w));
    return rsqrtf(s * (1.f / D) + EPS); }
__device__ __forceinline__ int tile_cidx(int trow) { return trow < NPROMPT ? 0 : 1 + ((trow - NPROMPT) >> 10); }
__device__ __forceinline__ PG8_LAS float* etab(PG8_LAS unsigned char* lds, int ui) { return (PG8_LAS float*)(lds + ETAB_OFF + ui * ETAB_SLOT); }

template <int ACT> struct EpiBf16 {
    static constexpr bool PERM = true, PERMA = false, AFTER_DRAIN = false, DEFER = false; static constexpr int MF = 4;
    bf16_t* O; int ldc; const float* bias; int split_cols; size_t split_stride; const float* rsq; const float* b2; int N; float* rsqv; int vt0; PG8_LAS unsigned char* lds;
    template <class Sched> __device__ __forceinline__ void prep(const Sched& S, int tid) const {
        Unit us[ETAB_MAXU]; bool ok[ETAB_MAXU];
#pragma unroll
        for (int i = 0; i < ETAB_MAXU; ++i) ok[i] = S.next(i, us[i]);
        if (tid < 256) { f32x4 q[ETAB_MAXU][4];
#pragma unroll
            for (int i = 0; i < ETAB_MAXU; ++i) if (ok[i]) rstd_load(rsq, S.arow(us[i].pm) + tid, q[i]);
#pragma unroll
            for (int i = 0; i < ETAB_MAXU; ++i) if (ok[i]) etab(lds, i)[tid] = rstd_finish(q[i]);
        } else { const int c = tid - 256; float v[ETAB_MAXU], vb[ETAB_MAXU];
#pragma unroll
            for (int i = 0; i < ETAB_MAXU; ++i) if (ok[i]) { const int col = us[i].pn * BM + c; v[i] = b2[(size_t)tile_cidx(S.arow(us[i].pm)) * N + col]; vb[i] = bias ? bias[col] : 0.f; }
#pragma unroll
            for (int i = 0; i < ETAB_MAXU; ++i) if (ok[i]) etab(lds, i)[256 + c] = v[i] + vb[i]; }
        __syncthreads();
    }
    __device__ __forceinline__ void operator()(f32x4 (&acc)[2][2][4][2], const Unit& u, int ui, int wr, int wc, int fr, int fq) const {
        asm volatile("" : "+v"(fr), "+v"(fq));
        PG8_LAS const float* tb = etab(lds, ui);
        const int lrow0 = wr * 64 + fr; int colt = u.pn * BM; bf16_t* base = O; int t = 0;
        if (split_cols) { t = colt / split_cols; base += (size_t)t * split_stride; colt -= t * split_cols; }
        const bool act = (ACT == 1) || (ACT == 2 && t == 0);
        const int col0 = colt + wc * 32 + 8 * fq, tc0 = wc * 32 + 8 * fq;
        const bool wantv = ACT == 1 && rsqv != nullptr && u.pn >= vt0;
        GAS unsigned char* ob = (GAS unsigned char*)base;
        float ss[8];
#pragma unroll
        for (int i = 0; i < 8; ++i) ss[i] = 0.f;
#pragma unroll
        for (int bj = 0; bj < 2; ++bj) { const f32x4 bv0 = *(PG8_LAS const f32x4*)(tb + 256 + tc0 + bj * HALF), bv1 = *(PG8_LAS const f32x4*)(tb + 256 + tc0 + bj * HALF + 4);
#pragma unroll
            for (int ai = 0; ai < 2; ++ai)
#pragma unroll
                for (int m = 0; m < 4; ++m) { const int lrow = lrow0 + ai * HALF + m * 16; const float rs = tb[lrow];
                    f32x4 v0 = acc[ai][bj][m][0] * rs + bv0, v1 = acc[ai][bj][m][1] * rs + bv1;
                    if (ACT != 0) { if (act) { v0 = gelu4(v0); v1 = gelu4(v1); } }
                    if (ACT == 1) ss[ai * 4 + m] += (v0[0] * v0[0] + v0[1] * v0[1]) + (v0[2] * v0[2] + v0[3] * v0[3]) + (v1[0] * v1[0] + v1[1] * v1[1]) + (v1[2] * v1[2] + v1[3] * v1[3]);
                    u32x4 w; w.x = cvt_pk_bf16(v0[0], v0[1]); w.y = cvt_pk_bf16(v0[2], v0[3]); w.z = cvt_pk_bf16(v1[0], v1[1]); w.w = cvt_pk_bf16(v1[2], v1[3]);
                    *(GAS u32x4*)(ob + ((unsigned)(u.pm * BM + lrow) * (unsigned)ldc + col0 + bj * HALF) * 2u) = w;
                    if (m & 1) __builtin_amdgcn_sched_barrier(0); } }
        if (wantv) {
#pragma unroll
            for (int i = 0; i < 8; ++i) { const float q = sum_q4(ss[i]);
                if (fq == 0) *(GAS float*)(rsqv + (size_t)(u.pm * BM + lrow0 + (i >> 2) * HALF + (i & 3) * 16) * 32 + (u.pn - vt0) * 4 + wc) = q; } }
    }
};
struct ResOrder : StaticOrder { __device__ __forceinline__ int arow(int pm) const { return pm * 192; } };
struct EpiResid {
    static constexpr bool PERM = true, PERMA = false, AFTER_DRAIN = false, DEFER = true; static constexpr int MF = 3;
    float* out; bf16_t* XB; const float* modl; int which; bool final_;
    bf16_t* H; const float* ng; const float* modn; int whichs; float* rsq_out; PG8_LAS unsigned char* lds;
    template <class Sched> __device__ __forceinline__ void prep(const Sched& S, int tid) const {
        Unit u;
        for (int i = 0; i < ETAB_MAXU && S.next(i, u); ++i) { PG8_LAS float* t = etab(lds, i);
            if (tid < 256) { const int r0 = u.pm * 192, r1 = r0 + 191 < M ? r0 + 191 : M - 1, c0 = tile_cidx(r0), c1 = tile_cidx(r1), col = u.pn * BM + tid;
                t[tid] = modl[(size_t)(c1 * 6 + which) * D + col]; t[256 + tid] = modl[(size_t)(c0 * 6 + which) * D + col];
                t[512 + tid] = H ? ng[col] * (1.f + modn[(size_t)(c0 * 6 + whichs) * D + col]) : 0.f; t[768 + tid] = H ? ng[col] * (1.f + modn[(size_t)(c1 * 6 + whichs) * D + col]) : 0.f; } }
        __syncthreads();
    }
    static constexpr int XLS = 528;
    __device__ __forceinline__ void flush(const Unit& u, int tid) const {
        const int trow = u.pm * 192; GAS unsigned char* xbp = (GAS unsigned char*)XB;
        u32x4 v[12];
#pragma unroll
        for (int i = 0; i < 12; ++i) { const int id = i * 512 + tid, row = id >> 5, c16 = id & 31; v[i] = *(PG8_LAS const u32x4*)(lds + row * XLS + c16 * 16); }
#pragma unroll
        for (int i = 0; i < 12; ++i) { const int id = i * 512 + tid, row = id >> 5, c16 = id & 31;
            if (trow + row < M) *(GAS u32x4*)(xbp + ((unsigned)(trow + row) * (unsigned)D + u.pn * BM + c16 * 8) * 2u) = v[i]; }
    }
    __device__ __forceinline__ void operator()(f32x4 (&acc)[2][2][3][2], const Unit& u, int ui, int wr, int wc, int fr, int fq, bool park) const {
        asm volatile("" : "+v"(fr), "+v"(fq));
        PG8_LAS const float* tb = etab(lds, ui);
        const int trow = u.pm * 192, tc0 = wc * 32 + 8 * fq, col0 = u.pn * BM + tc0, ci0 = tile_cidx(trow);
        GAS unsigned char* op = (GAS unsigned char*)out; GAS unsigned char* hb = (GAS unsigned char*)H; GAS unsigned char* xbp = (GAS unsigned char*)XB;
        u32x4 xr[2][2][3];
#pragma unroll
        for (int ai = 0; ai < 2; ++ai)
#pragma unroll
            for (int m = 0; m < 3; ++m) { const int r16 = trow + 96 * ai + 48 * wr + 16 * m; const unsigned row = (unsigned)(r16 + fr);
#pragma unroll
                for (int bj = 0; bj < 2; ++bj) xr[ai][bj][m] = r16 < M ? *(const GAS u32x4*)(xbp + (row * (unsigned)D + col0 + bj * HALF) * 2u) : (u32x4){0u, 0u, 0u, 0u}; }
#pragma unroll
        for (int ai = 0; ai < 2; ++ai) {
            float ss[3] = {0.f, 0.f, 0.f};
#pragma unroll
            for (int m = 0; m < 3; ++m) { const int r16 = trow + 96 * ai + 48 * wr + 16 * m; const unsigned row = (unsigned)(r16 + fr);
                const bool alt = tile_cidx(r16 < M ? r16 : M - 1) != ci0;
                PG8_LAS const float* gt = tb + (alt ? 0 : 256); PG8_LAS const float* st = tb + (alt ? 768 : 512);
                if (r16 < M) {
#pragma unroll
                    for (int bj = 0; bj < 2; ++bj) { const f32x4 gv0 = *(PG8_LAS const f32x4*)(gt + tc0 + bj * HALF), gv1 = *(PG8_LAS const f32x4*)(gt + tc0 + bj * HALF + 4);
                        const unsigned eo = row * (unsigned)D + col0 + bj * HALF; const u32x4 xw = xr[ai][bj][m];
                        const f32x4 xa = {__builtin_bit_cast(float, xw.x << 16), __builtin_bit_cast(float, xw.x & 0xffff0000u), __builtin_bit_cast(float, xw.y << 16), __builtin_bit_cast(float, xw.y & 0xffff0000u)},
                                    xb4 = {__builtin_bit_cast(float, xw.z << 16), __builtin_bit_cast(float, xw.z & 0xffff0000u), __builtin_bit_cast(float, xw.w << 16), __builtin_bit_cast(float, xw.w & 0xffff0000u)};
                        const f32x4 x0 = xa + gv0 * acc[ai][bj][m][0], x1 = xb4 + gv1 * acc[ai][bj][m][1];
                        if (final_) { *(GAS f32x4*)(op + eo * 4u) = x0; *(GAS f32x4*)(op + eo * 4u + 16) = x1; }
                        else { u32x4 w; w.x = cvt_pk_bf16(x0[0], x0[1]); w.y = cvt_pk_bf16(x0[2], x0[3]); w.z = cvt_pk_bf16(x1[0], x1[1]); w.w = cvt_pk_bf16(x1[2], x1[3]);
                            if (park) *(PG8_LAS u32x4*)(lds + (r16 - trow + fr) * XLS + (tc0 + bj * HALF) * 2) = w; else *(GAS u32x4*)(xbp + eo * 2u) = w; }
                        if (H) { const f32x4 gs0 = *(PG8_LAS const f32x4*)(st + tc0 + bj * HALF), gs1 = *(PG8_LAS const f32x4*)(st + tc0 + bj * HALF + 4);
                            ss[m] += (x0[0] * x0[0] + x0[1] * x0[1]) + (x0[2] * x0[2] + x0[3] * x0[3]) + (x1[0] * x1[0] + x1[1] * x1[1]) + (x1[2] * x1[2] + x1[3] * x1[3]);
                            const f32x4 a0 = x0 * gs0, a1 = x1 * gs1;
                            u32x4 w; w.x = cvt_pk_bf16(a0[0], a0[1]); w.y = cvt_pk_bf16(a0[2], a0[3]); w.z = cvt_pk_bf16(a1[0], a1[1]); w.w = cvt_pk_bf16(a1[2], a1[3]);
                            *(GAS u32x4*)(hb + eo * 2u) = w; } } } }
            if (H) {
#pragma unroll
                for (int m = 0; m < 3; ++m) { const int r16 = trow + 96 * ai + 48 * wr + 16 * m; const float q = sum_q4(ss[m]);
                    if (fq == 0 && r16 < M) *(GAS float*)(rsq_out + (size_t)(r16 + fr) * 16 + u.pn * 4 + wc) = q; } }
            asm volatile("" ::: "memory");
        }
    }
};

__device__ __forceinline__ void ffn_tile_geom(int pm, int& rs, int& vlo, int& vhi) {
    if (pm < 32) { rs = 256 * pm; vlo = 0; vhi = 255; }
    else { const int sq = (pm - 32) / 5, i = (pm - 32) % 5; rs = NPROMPT + 1024 * sq + (i < 4 ? 254 * i : 768); vlo = i == 0 ? 0 : (i < 4 ? 1 : 249); vhi = i < 4 ? 254 : 255; }
}
struct FfnOrder : StaticOrder {
    __device__ __forceinline__ int arow(int pm) const { int rs, a, b; ffn_tile_geom(pm, rs, a, b); return rs; }
};
template <int CTRL> __device__ __forceinline__ float dpp0(float v) { return __builtin_bit_cast(float, __builtin_amdgcn_update_dpp(0, __builtin_bit_cast(int, v), CTRL, 0xf, 0xf, true)); }
struct EpiFfn {
    static constexpr bool PERM = true, PERMA = true, AFTER_DRAIN = false, DEFER = false; static constexpr int MF = 4;
    bf16_t* ACT; const float* cw; const float* cb; const float* rsq; const float* b2; PG8_LAS unsigned char* lds;
    template <class Sched> __device__ __forceinline__ void prep(const Sched& S, int tid) const {
        Unit us[ETAB_MAXU]; bool ok[ETAB_MAXU];
#pragma unroll
        for (int i = 0; i < ETAB_MAXU; ++i) ok[i] = S.next(i, us[i]);
        if (tid < 256) { f32x4 q[ETAB_MAXU][4];
#pragma unroll
            for (int i = 0; i < ETAB_MAXU; ++i) if (ok[i]) rstd_load(rsq, S.arow(us[i].pm) + tid, q[i]);
#pragma unroll
            for (int i = 0; i < ETAB_MAXU; ++i) if (ok[i]) etab(lds, i)[tid] = rstd_finish(q[i]);
        } else { const int c = tid - 256; float vb2[ETAB_MAXU], vcb[ETAB_MAXU], vw[ETAB_MAXU][3];
#pragma unroll
            for (int i = 0; i < ETAB_MAXU; ++i) if (ok[i]) { const int ch = (c < 128 ? 0 : DFF) + us[i].pn * 128 + (c & 127);
                vb2[i] = b2[(size_t)tile_cidx(S.arow(us[i].pm)) * 2 * DFF + us[i].pn * 256 + c]; vcb[i] = cb[ch];
#pragma unroll
                for (int k = 0; k < 3; ++k) vw[i][k] = cw[(size_t)k * 2 * DFF + ch]; }
#pragma unroll
            for (int i = 0; i < ETAB_MAXU; ++i) if (ok[i]) { PG8_LAS float* t = etab(lds, i); t[256 + c] = vb2[i]; t[512 + c] = vcb[i];
                PG8_LAS unsigned short* tw = (PG8_LAS unsigned short*)(t + 768);
#pragma unroll
                for (int k = 0; k < 3; ++k) tw[k * 256 + c] = (unsigned short)f2bf(vw[i][k]); } }
        if (tid < 256) ((PG8_LAS float*)(lds + FFN_ZROW))[tid] = 0.f;
        __syncthreads();
    }
    __device__ __forceinline__ void operator()(f32x4 (&acc)[2][2][4][2], const Unit& u, int ui, int wr, int wc, int fr, int fq) const {
        asm volatile("" : "+v"(fr), "+v"(fq));
        PG8_LAS const float* tb = etab(lds, ui); PG8_LAS float* xb = (PG8_LAS float*)(lds + 131072);
        int rs, vlo, vhi; ffn_tile_geom(u.pm, rs, vlo, vhi);
        const int colw = wc * 32 + 8 * fq;
#pragma unroll
        for (int bj = 0; bj < 2; ++bj) { const f32x4 bz0 = *(PG8_LAS const f32x4*)(tb + 256 + bj * 128 + colw), bz1 = *(PG8_LAS const f32x4*)(tb + 256 + bj * 128 + colw + 4);
#pragma unroll
            for (int ai = 0; ai < 2; ++ai) { const f32x4 rsd4 = *(PG8_LAS const f32x4*)(tb + 128 * ai + 64 * wr + 4 * fr);
#pragma unroll
                for (int m = 0; m < 4; ++m) { const float rsd = rsd4[m];
                    acc[ai][bj][m][0] = acc[ai][bj][m][0] * rsd + bz0; acc[ai][bj][m][1] = acc[ai][bj][m][1] * rsd + bz1; } } }
#pragma unroll
        for (int ai = 0; ai < 2; ++ai) { const int b = 2 * ai + wr;
            if (fr == 0) {
#pragma unroll
                for (int bj = 0; bj < 2; ++bj)
#pragma unroll
                    for (int n = 0; n < 2; ++n) *(PG8_LAS f32x4*)(xb + (b * 2 + 0) * 256 + bj * 128 + colw + 4 * n) = acc[ai][bj][0][n]; }
            if (fr == 15) {
#pragma unroll
                for (int bj = 0; bj < 2; ++bj)
#pragma unroll
                    for (int n = 0; n < 2; ++n) *(PG8_LAS f32x4*)(xb + (b * 2 + 1) * 256 + bj * 128 + colw + 4 * n) = acc[ai][bj][3][n]; } }
        asm volatile("s_waitcnt lgkmcnt(0)" ::: "memory"); __builtin_amdgcn_s_barrier(); asm volatile("" ::: "memory");
        GAS unsigned char* actb = (GAS unsigned char*)ACT;
        const unsigned lane_off = (unsigned)((rs + 64 * wr + 4 * fr) * DFF + u.pn * 128 + colw) * 2u;
        PG8_LAS const unsigned short* tw = (PG8_LAS const unsigned short*)(tb + 768);
        PG8_LAS const float* zr = (PG8_LAS const float*)(lds + FFN_ZROW);
        u32x2 hold[2][4];
#pragma unroll
        for (int n = 0; n < 2; ++n) {
            f32x4 wg[3], wu[3];
#pragma unroll
            for (int k = 0; k < 3; ++k) { const u32x2 pg = *(PG8_LAS const u32x2*)(tw + k * 256 + colw + 4 * n), pu = *(PG8_LAS const u32x2*)(tw + k * 256 + 128 + colw + 4 * n);
                wg[k] = (f32x4){__builtin_bit_cast(float, pg.x << 16), __builtin_bit_cast(float, pg.x & 0xffff0000u), __builtin_bit_cast(float, pg.y << 16), __builtin_bit_cast(float, pg.y & 0xffff0000u)};
                wu[k] = (f32x4){__builtin_bit_cast(float, pu.x << 16), __builtin_bit_cast(float, pu.x & 0xffff0000u), __builtin_bit_cast(float, pu.y << 16), __builtin_bit_cast(float, pu.y & 0xffff0000u)}; }
            const f32x4 bgv = *(PG8_LAS const f32x4*)(tb + 512 + colw + 4 * n), buv = *(PG8_LAS const f32x4*)(tb + 512 + 128 + colw + 4 * n);
#pragma unroll
            for (int ai = 0; ai < 2; ++ai) { const int b = 2 * ai + wr;
                PG8_LAS const float* pzp = (b > 0 && fr == 0) ? xb + ((b - 1) * 2 + 1) * 256 : zr; PG8_LAS const float* nzp = (b < 3 && fr == 15) ? xb + ((b + 1) * 2 + 0) * 256 : zr;
#pragma unroll
                for (int bj = 0; bj < 2; ++bj) { const f32x4* w3 = bj == 0 ? wg : wu; const f32x4 o = bj == 0 ? bgv : buv;
                    const f32x4 pz = *(PG8_LAS const f32x4*)(pzp + bj * 128 + colw + 4 * n), nz = *(PG8_LAS const f32x4*)(nzp + bj * 128 + colw + 4 * n);
                    const f32x4 z0 = acc[ai][bj][0][n], z1 = acc[ai][bj][1][n], z2 = acc[ai][bj][2][n], z3 = acc[ai][bj][3][n];
                    f32x4 a0 = w3[1] * z0 + o; a0 = w3[2] * z1 + a0; a0 = w3[0] * pz + a0;
                    f32x4 a1 = w3[1] * z1 + o; a1 = w3[0] * z0 + a1; a1 = w3[2] * z2 + a1;
                    f32x4 a2 = w3[1] * z2 + o; a2 = w3[0] * z1 + a2; a2 = w3[2] * z3 + a2;
                    f32x4 a3 = w3[1] * z3 + o; a3 = w3[0] * z2 + a3; a3 = w3[2] * nz + a3;
#pragma unroll
                    for (int e = 0; e < 4; ++e) { float t0 = a0[e], t3 = a3[e];
                        asm("v_fmac_f32_dpp %0, %1, %2 row_shr:1 row_mask:0xf bank_mask:0xf bound_ctrl:1" : "+v"(t0) : "v"(z3[e]), "v"(w3[0][e]));
                        asm("v_fmac_f32_dpp %0, %1, %2 row_shl:1 row_mask:0xf bank_mask:0xf bound_ctrl:1" : "+v"(t3) : "v"(z0[e]), "v"(w3[2][e]));
                        a0[e] = t0; a3[e] = t3; }
                    acc[ai][bj][0][n] = a0; acc[ai][bj][1][n] = a1; acc[ai][bj][2][n] = a2; acc[ai][bj][3][n] = a3; }
#pragma unroll
                for (int m = 0; m < 4; ++m) { const f32x4 g = acc[ai][0][m][n], uu = acc[ai][1][m][n];
                    const int lr = 128 * ai + 64 * wr + 4 * fr + m;
                    if (lr >= vlo && lr <= vhi) { const f32x4 t = g * -1.44269504f; f32x4 ex;
#pragma unroll
                        for (int e = 0; e < 4; ++e) ex[e] = __builtin_amdgcn_exp2f(t[e]);
                        const f32x4 den = ex + 1.f, gu = g * uu; f32x4 r;
#pragma unroll
                        for (int e = 0; e < 4; ++e) r[e] = __builtin_amdgcn_rcpf(den[e]);
                        const f32x4 y = gu * r; u32x2 w; w.x = cvt_pk_bf16(y[0], y[1]); w.y = cvt_pk_bf16(y[2], y[3]);
                        if (n == 0) hold[ai][m] = w;
                        else *(GAS u32x4*)(actb + (lane_off + (unsigned)((128 * ai + m) * DFF) * 2u)) = (u32x4){hold[ai][m].x, hold[ai][m].y, w.x, w.y}; } } }
        }
    }
};

struct EpiQkv {
    static constexpr bool PERM = true, PERMA = false, AFTER_DRAIN = false, DEFER = false; static constexpr int MF = 4;
    unsigned char* ws; float* out; const float* rsq; const float* b2; PG8_LAS unsigned char* lds; const float* qkg; const float* rope;
    template <class Sched> __device__ __forceinline__ void prep(const Sched& S, int tid) const {
        Unit us[ETAB_MAXU]; bool ok[ETAB_MAXU];
#pragma unroll
        for (int i = 0; i < ETAB_MAXU; ++i) ok[i] = S.next(i, us[i]);
        if (tid < 256) { f32x4 q[ETAB_MAXU][4];
#pragma unroll
            for (int i = 0; i < ETAB_MAXU; ++i) if (ok[i]) rstd_load(rsq, us[i].pm * BM + tid, q[i]);
#pragma unroll
            for (int i = 0; i < ETAB_MAXU; ++i) if (ok[i]) etab(lds, i)[tid] = rstd_finish(q[i]);
        } else { const int c = tid - 256; float v[ETAB_MAXU];
#pragma unroll
            for (int i = 0; i < ETAB_MAXU; ++i) if (ok[i]) v[i] = b2[(size_t)tile_cidx(us[i].pm * BM) * 3 * D + us[i].pn * BM + c];
#pragma unroll
            for (int i = 0; i < ETAB_MAXU; ++i) if (ok[i]) etab(lds, i)[256 + c] = v[i]; }
        __syncthreads();
    }
    __device__ __forceinline__ void operator()(f32x4 (&acc)[2][2][4][2], const Unit& u, int ui, int wr, int wc, int fr, int fq) const {
        asm volatile("" : "+v"(fr), "+v"(fq));
        PG8_LAS const float* tb = etab(lds, ui);
        const int trow = u.pm * BM; const bool smp = trow >= NPROMPT; const int sb = smp ? (trow - NPROMPT) >> 10 : 0, tq0 = smp ? (trow - NPROMPT) & 1023 : 0;
        const int kind = u.pn >> 2, tc0 = wc * 32 + 8 * fq;
        if (kind < 2) {
            const int oc = (u.pn & 3) * 256 + wc * 64 + 8 * fq;
            f32x4 bz[2][2], gq[2][2];
#pragma unroll
            for (int bj = 0; bj < 2; ++bj)
#pragma unroll
                for (int n = 0; n < 2; ++n) { bz[bj][n] = *(PG8_LAS const f32x4*)(tb + 256 + tc0 + bj * HALF + 4 * n); gq[bj][n] = *(const GAS f32x4*)(qkg + kind * 64 + 32 * bj + 8 * fq + 4 * n); }
            const size_t doff = kind == 0 ? WS_T2 : (smp ? WS_KS : WS_T2 + (size_t)M * D * 2); GAS unsigned char* dst = (GAS unsigned char*)ws + doff;
#pragma unroll
            for (int ai = 0; ai < 2; ++ai) {
                f32x4 cs[4][2], sn[4][2];
#pragma unroll
                for (int m = 0; m < 4; ++m) { const int lrow = 128 * ai + 64 * wr + 16 * m + fr; const float rs = tb[lrow];
                    if (smp && (m & 1) == 0) {
#pragma unroll
                        for (int mm = m; mm < m + 2; ++mm)
#pragma unroll
                            for (int n = 0; n < 2; ++n) { const int t = tq0 + 128 * ai + 64 * wr + 16 * mm + fr; cs[mm][n] = *(const GAS f32x4*)(rope + t * 32 + 8 * fq + 4 * n); sn[mm][n] = *(const GAS f32x4*)(rope + 32768 + t * 32 + 8 * fq + 4 * n); } }
                    f32x4 v[2][2]; float ss = 0.f;
#pragma unroll
                    for (int bj = 0; bj < 2; ++bj)
#pragma unroll
                        for (int n = 0; n < 2; ++n) { v[bj][n] = acc[ai][bj][m][n] * rs + bz[bj][n]; ss += (v[bj][n][0] * v[bj][n][0] + v[bj][n][1] * v[bj][n][1]) + (v[bj][n][2] * v[bj][n][2] + v[bj][n][3] * v[bj][n][3]); }
                    ss = sum_q4(ss);
                    const float rn = rsqrtf(ss * (1.f / 64.f) + EPS);
#pragma unroll
                    for (int bj = 0; bj < 2; ++bj)
#pragma unroll
                        for (int n = 0; n < 2; ++n) v[bj][n] = v[bj][n] * rn * gq[bj][n];
                    const unsigned row = (unsigned)(trow + lrow);
                    if (!smp) {
                        if (kind == 1) {
#pragma unroll
                            for (int bj = 0; bj < 2; ++bj)
#pragma unroll
                                for (int n = 0; n < 2; ++n) *(GAS f32x4*)((GAS unsigned char*)out + O_CK * 4 + (row * (unsigned)D + oc + 32 * bj + 4 * n) * 4u) = v[bj][n]; }
                    } else {
#pragma unroll
                        for (int n = 0; n < 2; ++n) { const f32x4 x1 = v[0][n], x2 = v[1][n]; v[0][n] = x1 * cs[m][n] - x2 * sn[m][n]; v[1][n] = x2 * cs[m][n] + x1 * sn[m][n]; } }
                    const unsigned drow = (kind == 1 && smp) ? (unsigned)(sb * TKS + PAST + tq0 + lrow) : row;
#pragma unroll
                    for (int bj = 0; bj < 2; ++bj) { u32x4 w; w.x = cvt_pk_bf16(v[bj][0][0], v[bj][0][1]); w.y = cvt_pk_bf16(v[bj][0][2], v[bj][0][3]); w.z = cvt_pk_bf16(v[bj][1][0], v[bj][1][1]); w.w = cvt_pk_bf16(v[bj][1][2], v[bj][1][3]);
                        *(GAS u32x4*)(dst + (drow * (unsigned)D + oc + 32 * bj) * 2u) = w; }
                    if (m & 1) { asm volatile("" ::: "memory"); __builtin_amdgcn_sched_barrier(0); } } }
        } else {
            const int oc = (u.pn - 8) * 256 + wc * 32 + 8 * fq;
            const size_t doff = smp ? WS_VS : WS_T2 + (size_t)M * D * 2 + (size_t)NPROMPT * D * 2; GAS unsigned char* dst = (GAS unsigned char*)ws + doff;
#pragma unroll
            for (int bj = 0; bj < 2; ++bj) { const f32x4 bz0 = *(PG8_LAS const f32x4*)(tb + 256 + tc0 + bj * HALF), bz1 = *(PG8_LAS const f32x4*)(tb + 256 + tc0 + bj * HALF + 4);
#pragma unroll
                for (int ai = 0; ai < 2; ++ai)
#pragma unroll
                    for (int m = 0; m < 4; ++m) { const int lrow = 128 * ai + 64 * wr + 16 * m + fr; const float rs = tb[lrow];
                        const f32x4 v0 = acc[ai][bj][m][0] * rs + bz0, v1 = acc[ai][bj][m][1] * rs + bz1;
                        const unsigned row = (unsigned)(trow + lrow), drow = smp ? (unsigned)(sb * TKS + PAST + tq0 + lrow) : row;
                        u32x4 w; w.x = cvt_pk_bf16(v0[0], v0[1]); w.y = cvt_pk_bf16(v0[2], v0[3]); w.z = cvt_pk_bf16(v1[0], v1[1]); w.w = cvt_pk_bf16(v1[2], v1[3]);
                        *(GAS u32x4*)(dst + (drow * (unsigned)D + oc + 128 * bj) * 2u) = w;
                        if (!smp) { *(GAS f32x4*)((GAS unsigned char*)out + O_CV * 4 + (row * (unsigned)D + oc + 128 * bj) * 4u) = v0; *(GAS f32x4*)((GAS unsigned char*)out + O_CV * 4 + (row * (unsigned)D + oc + 128 * bj + 4) * 4u) = v1; } } }
        }
    }
};
}

struct Params { const float* in[N_IN]; float* out; unsigned char* ws; };
struct Frame {
    LAS unsigned char* lds; int tid, lane, wave, bid, G, wave0;
    float* out; unsigned char* ws; float* out0; unsigned char* ws0;
    __device__ __forceinline__ const float* inp(int i) const { const unsigned long long v = ((LAS const unsigned long long*)(lds + PTR_OFF))[i];
        const unsigned lo = __builtin_amdgcn_readfirstlane((unsigned)v), hi = __builtin_amdgcn_readfirstlane((unsigned)(v >> 32)); return (const float*)(const GAS float*)(((unsigned long long)hi << 32) | lo); }
    float* mod; float* rstd; float* rope; bf16 *H, *T1, *T2, *T3, *KS, *VS, *WT; float *rsq0, *rsq1, *rsqv, *bias2;
    __device__ __forceinline__ void fresh() {
        int z = 0; asm volatile("" : "+v"(z));
        lane = __builtin_amdgcn_mbcnt_hi(~0u, __builtin_amdgcn_mbcnt_lo(~0u, z)); int wv = wave0; asm volatile("" : "+s"(wv)); wave = wv; tid = wv * 64 + lane;
        int b = blockIdx.x; asm volatile("" : "+s"(b)); bid = b;
        unsigned char* w = ws0; asm volatile("" : "+s"(w)); w = (unsigned char*)(GAS unsigned char*)(unsigned long long)w; ws = w; float* o = out0; asm volatile("" : "+s"(o)); o = (float*)(GAS float*)(unsigned long long)o; out = o;
        mod = (float*)(w + WS_MOD); rstd = (float*)(w + WS_RSTD); rope = (float*)(w + WS_ROPE);
        H = (bf16*)(w + WS_H); T1 = (bf16*)(w + WS_T1); T2 = (bf16*)(w + WS_T2); T3 = (bf16*)(w + WS_T3); KS = (bf16*)(w + WS_KS); VS = (bf16*)(w + WS_VS); WT = (bf16*)(w + WS_W);
        rsq0 = (float*)(w + WS_X); rsq1 = (float*)(w + WS_X + MiB); rsqv = (float*)(w + WS_X + 2 * MiB); bias2 = (float*)(w + WS_X + 4 * MiB);
    }
};
__device__ __forceinline__ const float* xin_row(const Frame& F, int row) { return row < NPROMPT ? F.inp(I_XP) + (size_t)row * D : F.inp(I_XS) + (size_t)(row - NPROMPT) * D; }
__device__ __forceinline__ int cidx_of(int row) { return row < NPROMPT ? 0 : 1 + ((row - NPROMPT) >> 10); }
__device__ __forceinline__ const float* modp(const Frame& F, int l, int row, int which) { return F.mod + (size_t)((l * 3 + cidx_of(row)) * 6 + which) * D; }


template <int MODE  >
__device__ __forceinline__ void transpose_item(const float* W, int K, int N, bf16* WT, LAS float* scr, int item, int lane) {
    const int nblk = N / 32, kb = item / nblk, nb = item % nblk, k0 = 64 * kb, n0 = 32 * nb;
    int d0 = n0; if (MODE == 1) { const int isu = n0 >= DFF, jj = n0 - isu * DFF; d0 = (jj >> 7) * 256 + isu * 128 + (jj & 127); }
    if (MODE == 2 && n0 < 2 * D) { const int w = n0 & 255; d0 = (n0 & ~255) + ((w >> 5) & 1) * 128 + (w >> 6) * 32; }
    float wv[32];
    const GAS float* wp = (const GAS float*)W + (size_t)(k0 + (lane >> 5)) * N + n0 + (lane & 31);
#pragma unroll
    for (int i = 0; i < 32; ++i) wv[i] = wp[(size_t)(2 * i) * N];
#pragma unroll
    for (int i = 0; i < 32; ++i) scr[(2 * i + (lane >> 5)) * 33 + (lane & 31)] = wv[i];
    asm volatile("s_waitcnt lgkmcnt(0)" ::: "memory");
    const int c = lane & 7;
#pragma unroll
    for (int j = 0; j < 4; ++j) { const int n = (lane >> 3) + 8 * j; const LAS float* sp = scr + (8 * c) * 33 + n;
        u32x4 o; o.x = f2bf(sp[0 * 33]) | (f2bf(sp[1 * 33]) << 16); o.y = f2bf(sp[2 * 33]) | (f2bf(sp[3 * 33]) << 16); o.z = f2bf(sp[4 * 33]) | (f2bf(sp[5 * 33]) << 16); o.w = f2bf(sp[6 * 33]) | (f2bf(sp[7 * 33]) << 16);
        *(u32x4*)(WT + (size_t)(d0 + n) * K + k0 + 8 * c) = o; }
    asm volatile("s_waitcnt lgkmcnt(0)" ::: "memory");
}
template <int MODE = 0>
__device__ __forceinline__ bool transpose_group(int& r, const float* W, int nmat, int K, int N, bf16* WT, LAS float* scr, int lane) {
    const int per = (K / 64) * (N / 32), tot = nmat * per;
    if (r >= tot) { r -= tot; return false; }
    const int mi = r / per; transpose_item<MODE>(W + (size_t)mi * K * N, K, N, WT + (size_t)mi * K * N, scr, r % per, lane); return true;
}

template <int SLOT>
__device__ __forceinline__ void convert_slot(Frame& F, int gw, int NGW) {
    LAS float* scr = (LAS float*)(F.lds + F.wave * 16384);
    constexpr size_t UPE = (size_t)2 * DFF * D, DNE = (size_t)D * DFF;
    constexpr int I_UP1 = (D / 64) * (2 * DFF / 32), I_DN1 = (DFF / 64) * (D / 32), I_LIN = (D / 64) * (2 * DRNN / 32), I_LOUT = (DRNN / 64) * (D / 32), I_WG = 80 * 2 * 4,
                  I_CIN = (D / 64) * (2 * DB / 32), I_COUT = (DB / 64) * (D / 32), I_QKV = (D / 64) * (3 * D / 32), I_AOUT = (D / 64) * (D / 32);
    constexpr int NIT = SLOT == 9 ? I_UP1 : SLOT == 13 ? I_LOUT + I_WG : SLOT == 0 ? I_LIN : SLOT == 1 ? I_CIN + I_DN1 : SLOT == 2 ? I_COUT + I_UP1 : SLOT == 3 ? I_DN1 + I_QKV + I_AOUT : SLOT == 4 ? I_UP1 : SLOT == 5 ? I_DN1 + I_LIN
                      : SLOT == 6 ? I_LOUT + I_UP1 : I_DN1;
    for (int it = gw; it < NIT; it += NGW) { int r = it;
        if (SLOT == 0) {
            transpose_group(r, F.inp(I_LRU_WIN), 1, D, 2 * DRNN, F.WT + WE_LRU_IN, scr, F.lane);
        } else if (SLOT == 13) {
            if (transpose_group(r, F.inp(I_LRU_WOUT), 1, DRNN, D, F.WT + WE_LRU_OUT, scr, F.lane)) continue;
            transpose_group(r, F.inp(I_LRU_WG), 80, 128, 128, F.WT + WE_WG, scr, F.lane);
        } else if (SLOT == 9) {
            transpose_group<1>(r, F.inp(I_FF_WUP), 1, D, 2 * DFF, F.WT + WE_UP, scr, F.lane);
        } else if (SLOT == 1) {
            if (transpose_group(r, F.inp(I_CM_WIN), 1, D, 2 * DB, F.WT + WE_CM_IN, scr, F.lane)) continue;
            transpose_group(r, F.inp(I_FF_WDN), 1, DFF, D, F.WT + WE_DN, scr, F.lane);
        } else if (SLOT == 2) {
            if (transpose_group(r, F.inp(I_CM_WOUT), 1, DB, D, F.WT + WE_CM_OUT, scr, F.lane)) continue;
            transpose_group<1>(r, F.inp(I_FF_WUP) + UPE, 1, D, 2 * DFF, F.WT + WE_UP + UPE, scr, F.lane);
        } else if (SLOT == 3) {
            if (transpose_group(r, F.inp(I_FF_WDN) + DNE, 1, DFF, D, F.WT + WE_DN + DNE, scr, F.lane)) continue;
            if (transpose_group<2>(r, F.inp(I_AT_WQKV), 1, D, 3 * D, F.WT + WE_QKV, scr, F.lane)) continue;
            transpose_group(r, F.inp(I_AT_WOUT), 1, D, D, F.WT + WE_AT_OUT, scr, F.lane);
        } else if (SLOT == 4) {
            transpose_group<1>(r, F.inp(I_FF_WUP) + 2 * UPE, 1, D, 2 * DFF, F.WT + WE_UP + 2 * UPE, scr, F.lane);
        } else if (SLOT == 5) {
            if (transpose_group(r, F.inp(I_FF_WDN) + 2 * DNE, 1, DFF, D, F.WT + WE_DN + 2 * DNE, scr, F.lane)) continue;
            transpose_group(r, F.inp(I_LRU_WIN) + (size_t)D * 2 * DRNN, 1, D, 2 * DRNN, F.WT + WE_LRU_IN + (size_t)D * 2 * DRNN, scr, F.lane);
        } else if (SLOT == 6) {
            if (transpose_group(r, F.inp(I_LRU_WOUT) + (size_t)DRNN * D, 1, DRNN, D, F.WT + WE_LRU_OUT + (size_t)DRNN * D, scr, F.lane)) continue;
            transpose_group<1>(r, F.inp(I_FF_WUP) + 3 * UPE, 1, D, 2 * DFF, F.WT + WE_UP + 3 * UPE, scr, F.lane);
        } else {
            transpose_group(r, F.inp(I_FF_WDN) + 3 * DNE, 1, DFF, D, F.WT + WE_DN + 3 * DNE, scr, F.lane);
        }
    }
}
__device__ __forceinline__ void adaln_layer(Frame& F, int l, int wk, int nwk) {
    LAS float* sc = (LAS float*)(F.lds + 106496);
    const float* c = F.inp(I_C); const float* cctx = F.inp(I_CCTX);
    __syncthreads();
    for (int i = F.tid; i < 3 * D; i += NT) { const int ci = i >> 10, k = i & 1023; const float v = ci == 0 ? cctx[k] : c[(ci - 1) * D + k]; sc[i] = siluf_(v); }
    __syncthreads();
    LAS float* part = sc + 3 * D;
    const int kp = F.tid >> 6, cl = F.tid & 63;
    for (int item = wk; item < 6 * D / 64; item += nwk) {
        const int cc = item * 64 + cl;
        const float* w = F.inp(I_WMOD) + (size_t)l * D * 6 * D + cc;
        float s0 = 0.f, s1 = 0.f, s2 = 0.f;
#pragma unroll 1
        for (int kb = kp * 128; kb < kp * 128 + 128; kb += 64) { float wv[64];
#pragma unroll
            for (int i = 0; i < 64; ++i) wv[i] = ((const GAS float*)w)[(size_t)(kb + i) * 6 * D];
#pragma unroll
            for (int i = 0; i < 64; ++i) { s0 += sc[kb + i] * wv[i]; s1 += sc[D + kb + i] * wv[i]; s2 += sc[2 * D + kb + i] * wv[i]; } }
        part[(kp * 3 + 0) * 64 + cl] = s0; part[(kp * 3 + 1) * 64 + cl] = s1; part[(kp * 3 + 2) * 64 + cl] = s2;
        __syncthreads();
        if (F.tid < 192) { const int ci = F.tid >> 6; float s = F.inp(I_BMOD)[l * 6 * D + cc];
            for (int q = 0; q < 8; ++q) s += part[(q * 3 + ci) * 64 + cl];
            F.mod[(size_t)((l * 3 + ci) * 6) * D + cc] = s; }
        __syncthreads();
    }
}
__device__ __forceinline__ void bias2_gemm(Frame& F, const bf16* Wt, int N, int l, int sub, float* outp, int gw, int NGW, int n1 = 1 << 30) {
    float sh[3][16];
#pragma unroll
    for (int ci = 0; ci < 3; ++ci) { const GAS f32x4* sp = (const GAS f32x4*)(F.mod + (size_t)((l * 3 + ci) * 6 + sub * 3) * D + 16 * F.lane);
#pragma unroll
        for (int i = 0; i < 4; ++i) { const f32x4 v = sp[i]; sh[ci][4 * i] = v.x; sh[ci][4 * i + 1] = v.y; sh[ci][4 * i + 2] = v.z; sh[ci][4 * i + 3] = v.w; } }
    const int nend = n1 < N ? n1 : N;
    for (int n = gw; n < nend; n += NGW) { const GAS u32x4* wp = (const GAS u32x4*)(Wt + (size_t)n * D + 16 * F.lane); const u32x4 w0 = wp[0], w1 = wp[1];
        const unsigned ww[8] = {w0.x, w0.y, w0.z, w0.w, w1.x, w1.y, w1.z, w1.w};
        float d0 = 0.f, d1 = 0.f, d2 = 0.f;
#pragma unroll
        for (int i = 0; i < 8; ++i) { const float lo = bf2f(ww[i]), hi = bf2f(ww[i] >> 16); d0 += sh[0][2 * i] * lo + sh[0][2 * i + 1] * hi; d1 += sh[1][2 * i] * lo + sh[1][2 * i + 1] * hi; d2 += sh[2][2 * i] * lo + sh[2][2 * i + 1] * hi; }
        d0 = wave_sum(d0); d1 = wave_sum(d1); d2 = wave_sum(d2);
        if (F.lane == 0) { outp[n] = d0; outp[(size_t)N + n] = d1; outp[(size_t)2 * N + n] = d2; } }
}
__device__ __forceinline__ void bias2_item(Frame& F, int slot, int chunk) {
    const int n0 = chunk * 64 + F.wave, n1 = chunk * 64 + 64;
    if (slot == 1) bias2_gemm(F, F.WT + WE_UP, 2 * DFF, 0, 1, F.bias2 + B2_UP, n0, 8, n1);
    else if (slot == 2) bias2_gemm(F, F.WT + WE_CM_IN, 2 * DB, 1, 0, F.bias2 + B2_CM, n0, 8, n1);
    else if (slot == 3) bias2_gemm(F, F.WT + WE_UP + (size_t)1 * 2 * DFF * D, 2 * DFF, 1, 1, F.bias2 + B2_UP + (size_t)1 * 3 * 5632, n0, 8, n1);
    else if (slot == 4) bias2_gemm(F, F.WT + WE_QKV, 3 * D, 2, 0, F.bias2 + B2_QKV, n0, 8, n1);
    else if (slot == 5) bias2_gemm(F, F.WT + WE_UP + (size_t)2 * 2 * DFF * D, 2 * DFF, 2, 1, F.bias2 + B2_UP + (size_t)2 * 3 * 5632, n0, 8, n1);
    else if (slot == 6) bias2_gemm(F, F.WT + WE_LRU_IN + (size_t)2 * DRNN * D, 2 * DRNN, 3, 0, F.bias2 + B2_LRU + 3 * 2560, n0, 8, n1);
    else if (slot == 7) bias2_gemm(F, F.WT + WE_UP + (size_t)3 * 2 * DFF * D, 2 * DFF, 3, 1, F.bias2 + B2_UP + (size_t)3 * 3 * 5632, n0, 8, n1);
}
__device__ __forceinline__ void side_job(Frame& F, int slot, int part = 0) {
    F.fresh();
    if (slot < 0 || (slot > 7 && slot != 9 && slot != 13)) return;
    constexpr int I_UP1 = (D / 64) * (2 * DFF / 32), I_DN1 = (DFF / 64) * (D / 32), I_LIN = (D / 64) * (2 * DRNN / 32), I_LOUT = (DRNN / 64) * (D / 32),
                  I_CIN = (D / 64) * (2 * DB / 32), I_COUT = (DB / 64) * (D / 32), I_QKV = (D / 64) * (3 * D / 32), I_AOUT = (D / 64) * (D / 32);
    const int nb2 = part == 2 ? 0 : slot == 2 ? 2 * DB / 64 : slot == 4 ? 3 * D / 64 : slot == 6 ? 2 * DRNN / 64 : (slot == 1 || slot == 3 || slot == 5 || slot == 7) ? 2 * DFF / 64 : 0;
    const int nad = (slot == 0 ? part == 1 : part == 2) ? 0 : (slot == 0 || slot == 9 || slot == 2 || slot == 4) ? 6 * D / 64 : 0;
    constexpr int I_WG = 80 * 2 * 4;
    const int ncv = part == 1 ? 0 : (slot == 9 ? I_UP1 : slot == 13 ? I_LOUT + I_WG : slot == 0 ? I_LIN : slot == 1 ? I_CIN + I_DN1 : slot == 2 ? I_COUT + I_UP1 : slot == 3 ? I_DN1 + I_QKV + I_AOUT : slot == 4 ? I_UP1 : slot == 5 ? I_DN1 + I_LIN : slot == 6 ? I_LOUT + I_UP1 : I_DN1) / 8;
    const int total = nb2 + nad + ncv;
    unsigned* q = (unsigned*)(F.ws + WS_CTL) + CW_SJQ + 64 * slot + (part == 2 ? 32 : 0);
    volatile LAS unsigned* bc = (volatile LAS unsigned*)(F.lds + MISC_OFF) + 16;
    for (;;) {
        __syncthreads();
        if (F.tid == 0) bc[0] = __hip_atomic_fetch_add(q, 1u, __ATOMIC_RELAXED, __HIP_MEMORY_SCOPE_AGENT);
        __syncthreads();
        const int it = (int)bc[0];
        if (it >= total) break;
        if (it < nb2) bias2_item(F, slot, it);
        else if (it < nb2 + nad) adaln_layer(F, slot == 4 ? 3 : slot == 9 ? 1 : slot, it - nb2, 1 << 30);
        else { const int gw = (it - nb2 - nad) * 8 + F.wave;
            if (slot == 13) convert_slot<13>(F, gw, 1 << 30); else if (slot == 9) convert_slot<9>(F, gw, 1 << 30); else if (slot == 0) convert_slot<0>(F, gw, 1 << 30); else if (slot == 1) convert_slot<1>(F, gw, 1 << 30); else if (slot == 2) convert_slot<2>(F, gw, 1 << 30); else if (slot == 3) convert_slot<3>(F, gw, 1 << 30);
            else if (slot == 4) convert_slot<4>(F, gw, 1 << 30); else if (slot == 5) convert_slot<5>(F, gw, 1 << 30); else if (slot == 6) convert_slot<6>(F, gw, 1 << 30); else convert_slot<7>(F, gw, 1 << 30); }
    }
}
__device__ __forceinline__ void phase_prologue(Frame& F) {
    F.fresh();
    side_job(F, 0);
    F.fresh();
    const int gt = F.bid * NT + F.tid, GT = F.G * NT;
    for (int i = gt; i < 1024 * 32; i += GT) { const int t = i >> 5, j = i & 31; const float inv = powf(10000.f, -(float)(j & 15) / 16.f); const float pos = (float)(j < 16 ? (t >> 6) : (t & 63));
        const float ang = pos * inv; F.rope[i] = cosf(ang); F.rope[32768 + i] = sinf(ang); }
    for (int i = gt; i < 8 * 8 * 4 * 64; i += GT) { const int ln = i & 63, ks = (i >> 6) & 3, nf = (i >> 8) & 7, g = i >> 11, cq = ln >> 4, p = 16 * nf + (ln & 15);
        const float* wr = F.inp(I_CM_WS) + (size_t)(g * 128 + p) * 128 + 32 * ks + 4 * cq;
        u32x4 o; o.x = f2bf(wr[0]) | (f2bf(wr[1]) << 16); o.y = f2bf(wr[2]) | (f2bf(wr[3]) << 16); o.z = f2bf(wr[16]) | (f2bf(wr[17]) << 16); o.w = f2bf(wr[18]) | (f2bf(wr[19]) << 16);
        *(u32x4*)(F.WT + WE_WSB + (size_t)i * 8) = o; }
    for (int i8 = gt; i8 < 2 * PAST * D / 8; i8 += GT) { const int i = i8 * 8, b = i / (PAST * D), r = i % (PAST * D);
        const GAS f32x4* kp = (const GAS f32x4*)(F.inp(I_CK) + i); const GAS f32x4* vp = (const GAS f32x4*)(F.inp(I_CV) + i);
        const f32x4 k0 = kp[0], k1 = kp[1], v0 = vp[0], v1 = vp[1];
        u32x4 ko, vo; ko.x = f2bf(k0.x) | (f2bf(k0.y) << 16); ko.y = f2bf(k0.z) | (f2bf(k0.w) << 16); ko.z = f2bf(k1.x) | (f2bf(k1.y) << 16); ko.w = f2bf(k1.z) | (f2bf(k1.w) << 16);
        vo.x = f2bf(v0.x) | (f2bf(v0.y) << 16); vo.y = f2bf(v0.z) | (f2bf(v0.w) << 16); vo.z = f2bf(v1.x) | (f2bf(v1.y) << 16); vo.w = f2bf(v1.z) | (f2bf(v1.w) << 16);
        *(GAS u32x4*)(F.KS + (size_t)b * TKS * D + r) = ko; *(GAS u32x4*)(F.VS + (size_t)b * TKS * D + r) = vo; }
}

__device__ __forceinline__ void phase_modulate0(Frame& F) {
    F.fresh();
    const int gw = F.bid * NWAVES + F.wave, NGW = F.G * NWAVES;
    const float* g = F.inp(I_NORMG);
    for (int rb = gw; rb < M; rb += 5 * NGW) {
    f32x4 vv[5][4], cc[5][4], gg[4];
#pragma unroll
    for (int j = 0; j < 4; ++j) gg[j] = *(const GAS f32x4*)(g + 4 * F.lane + 256 * j);
#pragma unroll
    for (int k = 0; k < 5; ++k) { const int row = rb + k * NGW, rc = row < M ? row : M - 1; const float* xr = xin_row(F, rc); const float* scl = modp(F, 0, rc, 1);
#pragma unroll
        for (int j = 0; j < 4; ++j) { vv[k][j] = *(const GAS f32x4*)(xr + 4 * F.lane + 256 * j); cc[k][j] = *(const GAS f32x4*)(scl + 4 * F.lane + 256 * j); } }
#pragma unroll
    for (int k = 0; k < 5; ++k) { const int row = rb + k * NGW; if (row >= M) break;
        f32x4 (&v)[4] = vv[k]; float s = 0.f;
#pragma unroll
        for (int j = 0; j < 4; ++j) s += v[j].x * v[j].x + v[j].y * v[j].y + v[j].z * v[j].z + v[j].w * v[j].w;
        s = wave_sum(s);
        if (F.lane < 16) F.rsq0[(size_t)row * 16 + F.lane] = F.lane == 0 ? s : 0.f;
#pragma unroll
        for (int j = 0; j < 4; ++j) { const int c0 = 4 * F.lane + 256 * j;
            const f32x4 o = v[j] * gg[j] * (1.f + cc[k][j]); u32x2 w; w.x = f2bf(o.x) | (f2bf(o.y) << 16); w.y = f2bf(o.z) | (f2bf(o.w) << 16);
            *(GAS u32x2*)(F.H + (size_t)row * D + c0) = w;
            u32x2 xw; xw.x = f2bf(v[j].x) | (f2bf(v[j].y) << 16); xw.y = f2bf(v[j].z) | (f2bf(v[j].w) << 16);
            *(GAS u32x2*)((bf16*)(F.ws + WS_XB) + (size_t)row * D + c0) = xw; }
    }
    }
    bias2_gemm(F, F.WT + WE_LRU_IN, 2 * DRNN, 0, 0, F.bias2 + B2_LRU, gw, NGW);
}

template <class P>
__device__ __forceinline__ void gemm_naive(Frame& F, const P& p, int nbatch, int Mr, int N, int K) {
    F.fresh();
    LAS float* As = (LAS float*)F.lds;
    LAS float* Bs = As + 16 * 132;
    const int tid = F.tid, tx = tid & 31, ty = tid >> 5;
    const int tm = Mr / 128, tn = N / 128, per = tm * tn, total = per * nbatch;
    for (int t = F.bid; t < total; t += F.G) {
        const int b = t / per, r = t % per, pn = r / tm, pm = r % tm;
        const bf16* A; int lda; const float* W; int ldw; p.get(b, A, lda, W, ldw);
        float acc[8][4];
#pragma unroll
        for (int i = 0; i < 8; ++i)
#pragma unroll
            for (int j = 0; j < 4; ++j) acc[i][j] = 0.f;
        for (int k0 = 0; k0 < K; k0 += 16) {
            { const int row = tid >> 2, kq = (tid & 3) * 4;
              const u32x2 v = *(const u32x2*)(A + (size_t)(pm * 128 + row) * lda + k0 + kq);
              As[(kq + 0) * 132 + row] = bf2f(v.x); As[(kq + 1) * 132 + row] = bf2f(v.x >> 16); As[(kq + 2) * 132 + row] = bf2f(v.y); As[(kq + 3) * 132 + row] = bf2f(v.y >> 16); }
            { const int k = tid >> 5, n4 = (tid & 31) * 4;
              *(LAS f32x4*)(Bs + k * 128 + n4) = *(const f32x4*)(W + (size_t)(k0 + k) * ldw + pn * 128 + n4); }
            __syncthreads();
#pragma unroll 2
            for (int k = 0; k < 16; ++k) {
                const f32x4 a0 = *(const LAS f32x4*)(As + k * 132 + ty * 8), a1 = *(const LAS f32x4*)(As + k * 132 + ty * 8 + 4), bv = *(const LAS f32x4*)(Bs + k * 128 + tx * 4);
                const float a[8] = {a0.x, a0.y, a0.z, a0.w, a1.x, a1.y, a1.z, a1.w}; const float bb[4] = {bv.x, bv.y, bv.z, bv.w};
#pragma unroll
                for (int i = 0; i < 8; ++i)
#pragma unroll
                    for (int j = 0; j < 4; ++j) acc[i][j] += a[i] * bb[j];
            }
            __syncthreads();
        }
#pragma unroll
        for (int i = 0; i < 8; ++i)
#pragma unroll
            for (int j = 0; j < 4; ++j) p.epi(b, pm * 128 + ty * 8 + i, pn * 128 + tx * 4 + j, acc[i][j]);
    }
}

struct PStoreBf16 {
    const bf16* A; int lda; const float* W; int ldw; bf16* O; int ldo; const float* bias; int act; int split;
    __device__ __forceinline__ void get(int, const bf16*& a, int& la, const float*& w, int& lw) const { a = A; la = lda; w = W; lw = ldw; }
    __device__ __forceinline__ void epi(int, int row, int col, float v) const {
        if (bias) v += bias[col];
        if (act == 1 || (act == 2 && col < split)) v = gelu_tanh(v);
        O[(size_t)row * ldo + col] = (bf16)f2bf(v); }
};
struct PResid {
    const bf16* A; int lda; const float* W; int ldw; float* out; const float* xp; const float* xs; const float* modl; int which; bool from_input;
    __device__ __forceinline__ void get(int, const bf16*& a, int& la, const float*& w, int& lw) const { a = A; la = lda; w = W; lw = ldw; }
    __device__ __forceinline__ void epi(int, int row, int col, float v) const {
        const float base = from_input ? (row < NPROMPT ? xp[(size_t)row * D + col] : xs[(size_t)(row - NPROMPT) * D + col]) : out[(size_t)row * D + col];
        out[(size_t)row * D + col] = base + modl[(size_t)(cidx_of(row) * 6 + which) * D + col] * v; }
};
struct PLruIn {
    const bf16* A; const float* W; bf16* GBp; bf16* RECp;
    __device__ __forceinline__ void get(int, const bf16*& a, int& la, const float*& w, int& lw) const { a = A; la = D; w = W; lw = 2 * DRNN; }
    __device__ __forceinline__ void epi(int, int row, int col, float v) const {
        if (col < DRNN) GBp[(size_t)row * DRNN + col] = (bf16)f2bf(gelu_tanh(v)); else RECp[(size_t)row * DRNN + col - DRNN] = (bf16)f2bf(v); }
};
struct PGates {
    const bf16* XC; const float* WG; const float* BG; bf16* O;
    __device__ __forceinline__ void get(int b, const bf16*& a, int& la, const float*& w, int& lw) const { a = XC + (b % 10) * 128; la = DRNN; w = WG + (size_t)b * 128 * 128; lw = 128; }
    __device__ __forceinline__ void epi(int b, int row, int col, float v) const { const int dg = b / 10, n = b % 10;
        O[((size_t)dg * M + row) * DRNN + n * 128 + col] = (bf16)f2bf(sigmoidf_(v + BG[dg * DRNN + n * 128 + col])); }
};

__device__ __forceinline__ void phase_lru_conv(Frame& F, int j, const bf16* REC, bf16* XC) {
    F.fresh();
    const float* cw = F.inp(I_LRU_CW) + (size_t)j * 4 * DRNN; const float* cb = F.inp(I_LRU_CB) + (size_t)j * DRNN;
    const int gt = F.bid * NT + F.tid, GT = F.G * NT;
    for (int i = gt; i < M * DRNN; i += GT) { const int row = i / DRNN, ch = i % DRNN;
        int t, T; if (row < NPROMPT) { t = row & 255; T = 256; } else { t = (row - NPROMPT) & 1023; T = 1024; }
        float s = cb[ch];
#pragma unroll
        for (int k = 0; k < 4; ++k) { const int tt = t + k - 2; if (tt >= 0 && tt < T) s += cw[k * DRNN + ch] * bf2f(REC[(size_t)(row + k - 2) * DRNN + ch]); }
        XC[i] = (bf16)f2bf(s); }
}
__device__ __forceinline__ void phase_lru_scan(Frame& F, int j, const bf16* GATES, const bf16* XC, const bf16* GB, bf16* HS) {
    F.fresh();
    const int gt = F.bid * NT + F.tid, GT = F.G * NT;
    const int NL = (2 + 32) * DRNN;
    for (int line = gt; line < NL; line += GT) {
        const int s = line / DRNN, ch = line % DRNN;
        int base, T; float h0f = 0.f, h0b = 0.f;
        if (s < 2) { base = NPROMPT + s * 1024; T = 1024; h0f = F.inp(I_STATE)[((size_t)(s * 2 + j) * 2 + 0) * DRNN + ch]; h0b = F.inp(I_STATE)[((size_t)(s * 2 + j) * 2 + 1) * DRNN + ch]; }
        else { base = (s - 2) * 256; T = 256; }
        const float spf = softplusf_(-F.inp(I_LRU_LAM)[(size_t)(j * 2 + 0) * DRNN + ch]), spb = softplusf_(-F.inp(I_LRU_LAM)[(size_t)(j * 2 + 1) * DRNN + ch]);
        float h = h0f;
        for (int t = 0; t < T; ++t) { const size_t o = (size_t)(base + t) * DRNN + ch;
            const float r = bf2f(GATES[o]), ig = bf2f(GATES[(size_t)M * DRNN + o]), xc = bf2f(XC[o]);
            const float la = -8.f * r * spf, a = expf(la), bx = sqrtf(-expm1f(2.f * la)) * (ig * xc);
            h = a * h + bx; HS[o] = (bf16)f2bf(h); }
        const float ff = h;
        h = h0b;
        for (int t = T - 1; t >= 0; --t) { const size_t o = (size_t)(base + t) * DRNN + ch;
            const float r = bf2f(GATES[(size_t)2 * M * DRNN + o]), ig = bf2f(GATES[(size_t)3 * M * DRNN + o]), xc = bf2f(XC[o]);
            const float la = -8.f * r * spb, a = expf(la), bx = sqrtf(-expm1f(2.f * la)) * (ig * xc);
            h = a * h + bx; HS[o] = (bf16)f2bf(bf2f(GB[o]) * (bf2f(HS[o]) + h)); }
        if (s >= 2) { float* st = F.out + O_STATE + ((size_t)((s - 2) * 2 + j) * 2) * DRNN; st[ch] = ff; st[DRNN + ch] = h; }
    }
}


typedef short bf16x8 __attribute__((ext_vector_type(8)));
typedef short v4i16_t __attribute__((ext_vector_type(4)));
constexpr int LRU_XS = 272;
constexpr int LRU_XC_OFF = 0, LRU_GB_OFF = 256 * LRU_XS;
template <bool REV>
__device__ __forceinline__ float lru_dir(LAS const unsigned char* xct, LAS unsigned char* hft, const bf16* wgt  ,
                                         const bf16* gbp  , float br, float bi, float sp, float hc, int wave, int lane, bool wantp, bf16* Pdst, float& decay) {
    const int c = lane & 15, q = lane >> 4, qq = REV ? 3 - q : q;
    bf16x8 Br[4], Bi[4], Id;
#pragma unroll
    for (int ks = 0; ks < 4; ++ks) { Br[ks] = *(const GAS bf16x8*)(wgt + (size_t)(16 * wave + c) * 128 + 32 * ks + 8 * q);
                                     Bi[ks] = *(const GAS bf16x8*)(wgt + (size_t)10 * 128 * 128 + (size_t)(16 * wave + c) * 128 + 32 * ks + 8 * q); }
#pragma unroll
    for (int jj = 0; jj < 8; ++jj) Id[jj] = (8 * q + jj == 16 * (wave & 1) + c) ? (short)0x3F80 : (short)0;
    const int ksel = wave >> 1;
    const float nsp8 = -8.f * sp * 1.44269504f;
    const float brs = -1.44269504f * br, bis = -1.44269504f * bi;
    float Pc = 1.f;
    unsigned short gcur[16], gnxt[16];
#pragma unroll
    for (int i = 0; i < 16; ++i) { gcur[i] = 0; gnxt[i] = 0; }
    if (REV) {
#pragma unroll
        for (int i = 0; i < 16; ++i) gcur[i] = *(const GAS unsigned short*)(gbp + (size_t)(16 * (12 + (i >> 2)) + 4 * q + (i & 3)) * DRNN); }
    f32x4 r, ig, xc;
#define LRU_STAGE_A(MI, R_, I_, X_) do { LAS const unsigned char* rp_ = xct + (16 * (MI) + c) * LRU_XS + 16 * q; bf16x8 Af_[4]; \
        _Pragma("unroll") for (int ks = 0; ks < 4; ++ks) Af_[ks] = *(LAS const bf16x8*)(rp_ + 64 * ks); \
        const bf16x8 Ax_ = *(LAS const bf16x8*)(rp_ + 64 * ksel); \
        R_ = (f32x4){0.f, 0.f, 0.f, 0.f}; I_ = (f32x4){0.f, 0.f, 0.f, 0.f}; \
        _Pragma("unroll") for (int ks = 0; ks < 4; ++ks) { R_ = __builtin_amdgcn_mfma_f32_16x16x32_bf16(Af_[ks], Br[ks], R_, 0, 0, 0); I_ = __builtin_amdgcn_mfma_f32_16x16x32_bf16(Af_[ks], Bi[ks], I_, 0, 0, 0); } \
        X_ = __builtin_amdgcn_mfma_f32_16x16x32_bf16(Ax_, Id, (f32x4){0.f, 0.f, 0.f, 0.f}, 0, 0, 0); } while (0)
    LRU_STAGE_A(REV ? 15 : 0, r, ig, xc);
#pragma unroll 1
    for (int og = 0; og < 4; ++og) {
        if (REV && og < 3) {
#pragma unroll
            for (int i = 0; i < 16; ++i) gnxt[i] = *(const GAS unsigned short*)(gbp + (size_t)(16 * (4 * (2 - og) + (i >> 2)) + 4 * q + (i & 3)) * DRNN); }
#pragma unroll
        for (int ii = 0; ii < 4; ++ii) {
        const int it = 4 * og + ii, mi = REV ? 15 - it : it, mloc = REV ? 3 - ii : ii;
        f32x4 rn = r, ign = ig, xcn = xc;
        if (it < 15) { const int min_ = REV ? 14 - it : it + 1; LRU_STAGE_A(min_, rn, ign, xcn); }
        float av[4], bv[4];
        {
          const f32x4 tr = r * -1.44269504f + brs, ti = ig * -1.44269504f + bis; f32x4 er, ei, rg, iv, a4, sq;
#pragma unroll
          for (int k = 0; k < 4; ++k) { er[k] = __builtin_amdgcn_exp2f(tr[k]); ei[k] = __builtin_amdgcn_exp2f(ti[k]); }
          const f32x4 dr = er + 1.f, di = ei + 1.f;
#pragma unroll
          for (int k = 0; k < 4; ++k) { rg[k] = __builtin_amdgcn_rcpf(dr[k]); iv[k] = __builtin_amdgcn_rcpf(di[k]); }
          const f32x4 l2a = rg * nsp8;
#pragma unroll
          for (int k = 0; k < 4; ++k) a4[k] = __builtin_amdgcn_exp2f(l2a[k]);
          const f32x4 om = 1.f - a4 * a4;
#pragma unroll
          for (int k = 0; k < 4; ++k) sq[k] = __builtin_amdgcn_sqrtf(fmaxf(om[k], 0.f));
          const f32x4 b4 = sq * (iv * xc);
#pragma unroll
          for (int k = 0; k < 4; ++k) { av[k] = a4[k]; bv[k] = b4[k]; } }
        float pA[4], pB[4];
#pragma unroll
        for (int kk = 0; kk < 4; ++kk) { const int k = REV ? 3 - kk : kk;
            if (kk == 0) { pA[k] = av[k]; pB[k] = bv[k]; } else { const int kp = REV ? k + 1 : k - 1; pA[k] = pA[kp] * av[k]; pB[k] = pB[kp] * av[k] + bv[k]; } }
        const int kl = REV ? 0 : 3;
        float gA[4], gB[4];
#pragma unroll
        for (int g = 0; g < 4; ++g) { const int src = 16 * (REV ? 3 - g : g) + c; gA[g] = bperm(pA[kl], src); gB[g] = bperm(pB[kl], src); }
        float eA = 1.f, eB = 0.f, tA = 1.f, tB = 0.f;
#pragma unroll
        for (int g = 0; g < 4; ++g) { if (g == qq) { eA = tA; eB = tB; } tB = tB * gA[g] + gB[g]; tA = tA * gA[g]; }
        const float hin = eA * hc + eB;
        float hv[4];
#pragma unroll
        for (int k = 0; k < 4; ++k) { hv[k] = pA[k] * hin + pB[k];
            if (REV) { LAS const unsigned short* hp = (LAS const unsigned short*)(hft + (16 * mi + 4 * q + k) * LRU_XS + 2 * (16 * wave + c)); hv[k] = bf2f(gcur[4 * mloc + k]) * (bf2f(*hp) + hv[k]); } }
        { const unsigned w01 = pg8::cvt_pk_bf16(hv[0], hv[1]), w23 = pg8::cvt_pk_bf16(hv[2], hv[3]);
          LAS unsigned short* hp = (LAS unsigned short*)(hft + (16 * mi + 4 * q) * LRU_XS + 2 * (16 * wave + c));
          hp[0] = (unsigned short)w01; hp[LRU_XS / 2] = (unsigned short)(w01 >> 16); hp[LRU_XS] = (unsigned short)w23; hp[3 * LRU_XS / 2] = (unsigned short)(w23 >> 16); }
        if (wantp) { const float pe = eA * Pc; const unsigned p01 = pg8::cvt_pk_bf16(pA[0] * pe, pA[1] * pe), p23 = pg8::cvt_pk_bf16(pA[2] * pe, pA[3] * pe);
          bf16* pp = Pdst + (size_t)(16 * mi + 4 * q) * DRNN; pp[0] = (bf16)p01; pp[DRNN] = (bf16)(p01 >> 16); pp[2 * DRNN] = (bf16)p23; pp[3 * DRNN] = (bf16)(p23 >> 16); }
        hc = tA * hc + tB; Pc *= tA;
        r = rn; ig = ign; xc = xcn;
        }
        if (REV) {
#pragma unroll
            for (int i = 0; i < 16; ++i) gcur[i] = gnxt[i]; }
    }
#undef LRU_STAGE_A
    decay = Pc;
    return hc;
}
__device__ __forceinline__ void lru_unit(Frame& F, int j, int pm, int n, const bf16* REC, const bf16* GB, bf16* HS, bf16* PF, bf16* PB, float* AGG, unsigned* cnt, const bf16* WGT) {
    const int tid = F.tid, lane = F.lane, wave = F.wave, r0 = 256 * pm;
    const bool smp = pm >= 32; const int tix = smp ? (pm - 32) & 3 : 0, sq = smp ? (pm - 32) >> 2 : 0;
    const int t0 = smp ? 256 * tix : 0, T = smp ? 1024 : 256;
    LAS unsigned char* xct = F.lds + LRU_XC_OFF; LAS unsigned char* hft = F.lds + LRU_GB_OFF;
    { const float* cw = F.inp(I_LRU_CW) + (size_t)j * 4 * DRNN + n * 128 + 2 * lane; const float* cb = F.inp(I_LRU_CB) + (size_t)j * DRNN + n * 128 + 2 * lane;
      float w0[4], w1[4];
#pragma unroll
      for (int k = 0; k < 4; ++k) { w0[k] = cw[k * DRNN]; w1[k] = cw[k * DRNN + 1]; }
      const float b0 = cb[0], b1 = cb[1];
      unsigned v[35];
#pragma unroll
      for (int i = 0; i < 35; ++i) { const int tl = 32 * wave + i - 2, tt = t0 + tl;
          v[i] = (tt >= 0 && tt < T) ? *(const GAS unsigned*)(REC + (size_t)(r0 + tl) * DRNN + n * 128 + 2 * lane) : 0u; }
#pragma unroll
      for (int i = 0; i < 32; ++i) { float s0 = b0, s1 = b1;
#pragma unroll
          for (int k = 0; k < 4; ++k) { s0 += w0[k] * bf2f(v[i + k]); s1 += w1[k] * bf2f(v[i + k] >> 16); }
          *(LAS unsigned*)(xct + (32 * wave + i) * LRU_XS + 4 * lane) = f2bf(s0) | (f2bf(s1) << 16); } }
    __syncthreads();
    const int c = lane & 15, q = lane >> 4, ch = n * 128 + 16 * wave + c;
    const float* bg = F.inp(I_LRU_BG) + (size_t)j * 4 * DRNN; const float* lam = F.inp(I_LRU_LAM) + (size_t)j * 2 * DRNN;
    const bf16* gbp = GB + (size_t)r0 * DRNN + ch;
    bf16* pf = PF + (size_t)(smp ? r0 - NPROMPT : 0) * DRNN + ch; bf16* pb = PB + (size_t)(smp ? r0 - NPROMPT : 0) * DRNN + ch;
    { float h0 = 0.f; if (smp && tix == 0) h0 = F.inp(I_STATE)[((size_t)(sq * 2 + j) * 2 + 0) * DRNN + ch];
      float dec;
      const float hfin = lru_dir<false>(xct, hft, WGT + (size_t)(0 * 10 + n) * 128 * 128, gbp, bg[0 * DRNN + ch], bg[1 * DRNN + ch], softplusf_(-lam[ch]), h0, wave, lane, smp, pf, dec);
      if (q == 0) { if (smp) { float* ag = AGG + (size_t)(((sq * 4 + tix) * 2 + 0) * 2) * DRNN + ch; __hip_atomic_store(ag, hfin, __ATOMIC_RELAXED, __HIP_MEMORY_SCOPE_AGENT); __hip_atomic_store(ag + DRNN, dec, __ATOMIC_RELAXED, __HIP_MEMORY_SCOPE_AGENT); }
                    else F.out[O_STATE + ((size_t)(pm * 2 + j) * 2 + 0) * DRNN + ch] = hfin; } }
    { float h0 = 0.f; if (smp && tix == 3) h0 = F.inp(I_STATE)[((size_t)(sq * 2 + j) * 2 + 1) * DRNN + ch];
      float dec;
      const float hfin = lru_dir<true>(xct, hft, WGT + (size_t)(2 * 10 + n) * 128 * 128, gbp, bg[2 * DRNN + ch], bg[3 * DRNN + ch], softplusf_(-lam[DRNN + ch]), h0, wave, lane, smp, pb, dec);
      if (q == 0) { if (smp) { float* ag = AGG + (size_t)(((sq * 4 + tix) * 2 + 1) * 2) * DRNN + ch; __hip_atomic_store(ag, hfin, __ATOMIC_RELAXED, __HIP_MEMORY_SCOPE_AGENT); __hip_atomic_store(ag + DRNN, dec, __ATOMIC_RELAXED, __HIP_MEMORY_SCOPE_AGENT); }
                    else F.out[O_STATE + ((size_t)(pm * 2 + j) * 2 + 1) * DRNN + ch] = hfin; } }
    if (smp) {
        asm volatile("s_waitcnt vmcnt(0)" ::: "memory");
        __syncthreads();
        if (tid == 0) { unsigned* cp = cnt + 64 * ((j * 2 + sq) * 10 + n);
            __hip_atomic_fetch_add(cp, 1u, __ATOMIC_RELAXED, __HIP_MEMORY_SCOPE_AGENT);
            unsigned sp_ = 0; while (__hip_atomic_load(cp, __ATOMIC_RELAXED, __HIP_MEMORY_SCOPE_AGENT) < 4u) { __builtin_amdgcn_s_sleep(2); if (++sp_ > (1u << 20)) break; }
            __builtin_amdgcn_fence(__ATOMIC_ACQUIRE, "agent"); asm volatile("s_waitcnt vmcnt(0)" ::: "memory"); }
        __syncthreads();
        LAS float* cfb = (LAS float*)(F.lds + LRU_GB_OFF + 256 * LRU_XS);
        if (tid < 128) { const int chn = n * 128 + tid; float cf = 0.f, cbk = 0.f;
            for (int t = 0; t < tix; ++t) { const float* ag = AGG + (size_t)(((sq * 4 + t) * 2 + 0) * 2) * DRNN + chn;
                cf = __hip_atomic_load(ag + DRNN, __ATOMIC_RELAXED, __HIP_MEMORY_SCOPE_AGENT) * cf + __hip_atomic_load(ag, __ATOMIC_RELAXED, __HIP_MEMORY_SCOPE_AGENT); }
            for (int t = 3; t > tix; --t) { const float* ag = AGG + (size_t)(((sq * 4 + t) * 2 + 1) * 2) * DRNN + chn;
                cbk = __hip_atomic_load(ag + DRNN, __ATOMIC_RELAXED, __HIP_MEMORY_SCOPE_AGENT) * cbk + __hip_atomic_load(ag, __ATOMIC_RELAXED, __HIP_MEMORY_SCOPE_AGENT); }
            cfb[tid] = cf; cfb[128 + tid] = cbk; }
        __syncthreads();
#pragma unroll 2
        for (int i = 0; i < 8; ++i) { const int id = i * NT + tid, row = id >> 4, cc = id & 15;
            const size_t go = (size_t)(r0 + row) * DRNN + n * 128 + 8 * cc, po = (size_t)(r0 - NPROMPT + row) * DRNN + n * 128 + 8 * cc;
            const u32x4 g4 = *(const GAS u32x4*)(GB + go), f4 = *(const GAS u32x4*)(PF + po), b4 = *(const GAS u32x4*)(PB + po); u32x4 h4 = *(LAS const u32x4*)(hft + row * LRU_XS + 16 * cc);
            const unsigned gg[4] = {g4.x, g4.y, g4.z, g4.w}, ff[4] = {f4.x, f4.y, f4.z, f4.w}, bb[4] = {b4.x, b4.y, b4.z, b4.w}; unsigned hh[4] = {h4.x, h4.y, h4.z, h4.w};
#pragma unroll
            for (int e = 0; e < 4; ++e) { const int c0 = 8 * cc + 2 * e;
                const float lo = bf2f(hh[e]) + bf2f(gg[e]) * (bf2f(ff[e]) * cfb[c0] + bf2f(bb[e]) * cfb[128 + c0]), hi = bf2f(hh[e] >> 16) + bf2f(gg[e] >> 16) * (bf2f(ff[e] >> 16) * cfb[c0 + 1] + bf2f(bb[e] >> 16) * cfb[128 + c0 + 1]);
                hh[e] = pg8::cvt_pk_bf16(lo, hi); }
            *(LAS u32x4*)(hft + row * LRU_XS + 16 * cc) = (u32x4){hh[0], hh[1], hh[2], hh[3]}; }
    }
    __syncthreads();
#pragma unroll
    for (int i = 0; i < 8; ++i) { const int id = i * NT + tid, row = id >> 4, cc = id & 15;
        *(GAS u32x4*)(HS + (size_t)(r0 + row) * DRNN + n * 128 + 8 * cc) = *(LAS const u32x4*)(hft + row * LRU_XS + 16 * cc); }
    __syncthreads();
}
__device__ __forceinline__ void phase_lru_core(Frame& F, int j, const bf16* REC, const bf16* GB, bf16* HS, bf16* PF, bf16* PB, float* AGG, unsigned* cnt, const bf16* WGT) {
    F.fresh();
    for (int s_ = 0; ; ++s_) { int pm, n;
        if (F.G == 256) { if (F.bid >= 176) { if (s_ > 0) break; pm = 32 + (F.bid - 176) / 10; n = (F.bid - 176) % 10; }
                          else { if (s_ > 1 || (s_ == 1 && F.bid >= 144)) break; const int u = s_ ? 176 + F.bid : F.bid; pm = u / 10; n = u % 10; } }
        else { const int u = F.bid + s_ * F.G; if (u >= 400) break; pm = u < 80 ? 32 + u / 10 : (u - 80) / 10; n = u % 10; }
        lru_unit(F, j, pm, n, REC, GB, HS, PF, PB, AGG, cnt, WGT); }
}
__device__ __forceinline__ void phase_lru_fixup(Frame& F, const bf16* GB, bf16* HS, const bf16* PF, const bf16* PB, const float* AGG) {
    F.fresh();
    const int gt = F.bid * NT + F.tid, GT = F.G * NT;
    for (int i = gt; i < NSAMPLE * DRNN; i += GT) { const int rs = i / DRNN, ch = i % DRNN, sq = rs >> 10, tix = (rs >> 8) & 3;
        float cf = 0.f, cbk = 0.f;
        if (tix > 0) { for (int t = 0; t < tix; ++t) { const float At = bf2f(PF[(size_t)(sq * 1024 + t * 256 + 255) * DRNN + ch]); cf = At * cf + AGG[(size_t)((sq * 4 + t) * 2 + 0) * DRNN + ch]; } }
        if (tix < 3) { for (int t = 3; t > tix; --t) { const float At = bf2f(PB[(size_t)(sq * 1024 + t * 256) * DRNN + ch]); cbk = At * cbk + AGG[(size_t)((sq * 4 + t) * 2 + 1) * DRNN + ch]; } }
        const size_t o = (size_t)(NPROMPT + rs) * DRNN + ch;
        HS[o] = (bf16)f2bf(bf2f(HS[o]) + bf2f(GB[o]) * (bf2f(PF[(size_t)rs * DRNN + ch]) * cf + bf2f(PB[(size_t)rs * DRNN + ch]) * cbk)); }
}

__device__ __forceinline__ void phase_cmlp_rstd(Frame& F, const bf16* UV) {
    F.fresh();
    const int gw = F.bid * NWAVES + F.wave, NGW = F.G * NWAVES;
    for (int row = gw; row < M; row += NGW) { float s = 0.f;
        for (int c = F.lane; c < DB; c += 64) { const float v = bf2f(UV[(size_t)row * 2 * DB + DB + c]); s += v * v; }
        s = wave_sum(s); if (F.lane == 0) F.rstd[row] = rsqrtf(s * (1.f / DB) + EPS); }
}
__device__ __forceinline__ void phase_cmlp_spatial(Frame& F, const bf16* UV, bf16* ACT) {
    F.fresh();
    const float* ws = F.inp(I_CM_WS); const float* bs = F.inp(I_CM_BS); const float* ng = F.inp(I_CM_NG);
    const int gt = F.bid * NT + F.tid, GT = F.G * NT;
    for (int i = gt; i < M * DB; i += GT) { const int row = i / DB, ch = i % DB, g = ch >> 8, p = row & 127, r0 = row & ~127;
        float s = 0.f;
        for (int q = 0; q < 128; ++q) s += ws[(size_t)(g * 128 + p) * 128 + q] * F.rstd[r0 + q] * bf2f(UV[(size_t)(r0 + q) * 2 * DB + DB + ch]);
        const float sv = s * ng[ch] + bs[g * 128 + p];
        ACT[i] = (bf16)f2bf(bf2f(UV[(size_t)row * 2 * DB + ch]) * sv); }
}


constexpr int CM_VS = 544;
__device__ __forceinline__ void phase_cmlp_spatial_mfma(Frame& F, const bf16* UV, bf16* ACT, const bf16* WSB) {
    F.fresh();
    const int tid = F.tid, lane = F.lane, wave = F.wave, c = lane & 15, q4 = lane >> 4;
    LAS unsigned char* vt = F.lds;
    const float* ng = F.inp(I_CM_NG); const float* bs = F.inp(I_CM_BS);
    f32x4 pq[8]; u32x4 px[8];
#define CM_PREFETCH(u_) do { const int ch_ = (u_) >> 3, g_ = (u_) & 7, r_ = ch_ * 128; \
        if (tid < 128) { const GAS f32x4* p_ = (const GAS f32x4*)(F.rsqv + (size_t)(r_ + tid) * 32); _Pragma("unroll") for (int i = 0; i < 8; ++i) pq[i] = p_[i]; } \
        _Pragma("unroll") for (int i = 0; i < 8; ++i) { const int id = i * NT + tid, row = id >> 5, cc = id & 31; px[i] = *(const GAS u32x4*)(UV + (size_t)(r_ + row) * 2 * DB + DB + g_ * 256 + 8 * cc); } } while (0)
    if (F.bid < 640) CM_PREFETCH(F.bid);
    for (int u = F.bid; u < 640; u += F.G) {
        const int chunk = u >> 3, g = u & 7, r0 = chunk * 128;
        LAS float* rsl = (LAS float*)(vt + 128 * CM_VS);
        if (tid < 128) { float sm = 0.f;
#pragma unroll
            for (int i = 0; i < 8; ++i) { const f32x4 t4 = pq[i]; sm += (t4.x + t4.y) + (t4.z + t4.w); }
            rsl[tid] = rsqrtf(sm * (1.f / DB) + EPS); }
        __syncthreads();
#pragma unroll
        for (int i = 0; i < 8; ++i) { const int id = i * NT + tid, row = id >> 5, cc = id & 31;
            const u32x4 x = px[i]; const float rs = rsl[row];
            u32x4 y; y.x = f2bf(bf2f(x.x) * rs) | (f2bf(bf2f(x.x >> 16) * rs) << 16); y.y = f2bf(bf2f(x.y) * rs) | (f2bf(bf2f(x.y >> 16) * rs) << 16);
            y.z = f2bf(bf2f(x.z) * rs) | (f2bf(bf2f(x.z >> 16) * rs) << 16); y.w = f2bf(bf2f(x.w) * rs) | (f2bf(bf2f(x.w >> 16) * rs) << 16);
            *(LAS u32x4*)(vt + row * CM_VS + 16 * cc) = y; }
        __syncthreads();
        if (u + F.G < 640) CM_PREFETCH(u + F.G);
        bf16x8 vf[2][4];
#pragma unroll
        for (int mfc = 0; mfc < 2; ++mfc)
#pragma unroll
            for (int ks = 0; ks < 4; ++ks) { LAS const unsigned char* vp = vt + (32 * ks + 4 * q4 + (c >> 2)) * CM_VS + (32 * wave + 8 * (c & 3) + 4 * mfc) * 2;
                const v4i16_t lo = __builtin_amdgcn_ds_read_tr16_b64_v4i16((LAS v4i16_t*)vp), hi = __builtin_amdgcn_ds_read_tr16_b64_v4i16((LAS v4i16_t*)(vp + 16 * CM_VS));
                vf[mfc][ks] = (bf16x8){lo[0], lo[1], lo[2], lo[3], hi[0], hi[1], hi[2], hi[3]}; }
        f32x4 g4[2];
#pragma unroll
        for (int mfc = 0; mfc < 2; ++mfc) g4[mfc] = *(const GAS f32x4*)(ng + g * 256 + 32 * wave + 8 * q4 + 4 * mfc);
        bf16x8 Bf[2][4]; u32x2 uu[2][2]; float bsv[2];
#define CM_LOADNF(nf_, sl_) do { _Pragma("unroll") for (int ks = 0; ks < 4; ++ks) Bf[sl_][ks] = *(const GAS bf16x8*)(WSB + ((size_t)((g * 8 + (nf_)) * 4 + ks) * 64 + lane) * 8); \
            bsv[sl_] = bs[g * 128 + 16 * (nf_) + c]; \
            { const u32x4 u4_ = *(const GAS u32x4*)(UV + (size_t)(r0 + 16 * (nf_) + c) * 2 * DB + g * 256 + 32 * wave + 8 * q4); uu[sl_][0] = (u32x2){u4_.x, u4_.y}; uu[sl_][1] = (u32x2){u4_.z, u4_.w}; } } while (0)
        CM_LOADNF(0, 0);
#pragma unroll
        for (int nf = 0; nf < 8; ++nf) { const int sl = nf & 1;
            if (nf + 1 < 8) CM_LOADNF(nf + 1, sl ^ 1);
            const int p = 16 * nf + c; u32x2 wq[2];
#pragma unroll
            for (int mfc = 0; mfc < 2; ++mfc) { f32x4 acc = {0.f, 0.f, 0.f, 0.f};
#pragma unroll
                for (int ks = 0; ks < 4; ++ks) acc = __builtin_amdgcn_mfma_f32_16x16x32_bf16(vf[mfc][ks], Bf[sl][ks], acc, 0, 0, 0);
                const u32x2 u2 = uu[sl][mfc]; const float bv = bsv[sl];
                const float o0 = bf2f(u2.x) * (acc[0] * g4[mfc].x + bv), o1 = bf2f(u2.x >> 16) * (acc[1] * g4[mfc].y + bv), o2 = bf2f(u2.y) * (acc[2] * g4[mfc].z + bv), o3 = bf2f(u2.y >> 16) * (acc[3] * g4[mfc].w + bv);
                wq[mfc].x = f2bf(o0) | (f2bf(o1) << 16); wq[mfc].y = f2bf(o2) | (f2bf(o3) << 16); }
            *(GAS u32x4*)(ACT + (size_t)(r0 + p) * DB + g * 256 + 32 * wave + 8 * q4) = (u32x4){wq[0].x, wq[0].y, wq[1].x, wq[1].y};
        }
        __syncthreads();
    }
}

__device__ __forceinline__ void phase_qkv_post(Frame& F, const bf16* QKV, bf16* Q, bf16* KP, bf16* VP) {
    F.fresh();
    const int gw = F.bid * NWAVES + F.wave, NGW = F.G * NWAVES;
    const float* qkg = F.inp(I_AT_QKG);
    for (int row = gw; row < M; row += NGW) {
        const bool smp = row >= NPROMPT; const int sb = smp ? (row - NPROMPT) >> 10 : 0, t = smp ? (row - NPROMPT) & 1023 : 0;
        const float cs = smp ? F.rope[t * 32 + (F.lane & 31)] : 1.f, sn = smp ? F.rope[32768 + t * 32 + (F.lane & 31)] : 0.f;
        for (int grp = 0; grp < 32; ++grp) {
            const float v = bf2f(QKV[(size_t)row * 3072 + grp * 64 + F.lane]);
            const float ms = wave_sum(v * v) * (1.f / 64.f);
            float n = v * rsqrtf(ms + EPS) * qkg[(grp >> 4) * 64 + F.lane];
            const float keep = n;
            if (smp) { float pr; { auto r_ = __builtin_amdgcn_permlane32_swap(__builtin_bit_cast(unsigned, n), __builtin_bit_cast(unsigned, n), false, false); pr = __builtin_bit_cast(float, F.lane < 32 ? (unsigned)r_[1] : (unsigned)r_[0]); } n = F.lane < 32 ? n * cs - pr * sn : n * cs + pr * sn; }
            if (grp < 16) Q[(size_t)row * D + grp * 64 + F.lane] = (bf16)f2bf(n);
            else { const int c = (grp - 16) * 64 + F.lane;
                if (smp) F.KS[((size_t)sb * TKS + PAST + t) * D + c] = (bf16)f2bf(n);
                else { KP[(size_t)row * D + c] = (bf16)f2bf(keep); F.out[O_CK + (size_t)row * D + c] = keep; } }
        }
        for (int c = F.lane; c < D; c += 64) { const bf16 vb = QKV[(size_t)row * 3072 + 2048 + c];
            if (smp) F.VS[((size_t)sb * TKS + PAST + t) * D + c] = vb; else { VP[(size_t)row * D + c] = vb; F.out[O_CV + (size_t)row * D + c] = bf2f(vb); } }
    }
}
__device__ __forceinline__ void phase_attn_naive(Frame& F, int l, const bf16* Q, const bf16* KP, const bf16* VP, bf16* O) {
    F.fresh();
    const int gw = F.bid * NWAVES + F.wave, NGW = F.G * NWAVES;
    LAS float* s1 = (LAS float*)F.lds + F.wave * 3328; LAS float* s2 = s1 + 1536; LAS float* qs = s2 + 1536;
    const float* al = F.inp(I_AT_LAM);
    const float lam_init = 0.8f - 0.6f * expf(-0.3f * (float)l);
    const float lam = expf(wave_sum(al[F.lane] * al[64 + F.lane])) - expf(wave_sum(al[128 + F.lane] * al[192 + F.lane])) + lam_init;
    const float* sg = F.inp(I_AT_SUBG);
    for (int item = gw; item < M * 8; item += NGW) {
        const int row = item >> 3, h = item & 7;
        const bf16 *Kb, *Vb; int Tk;
        if (row < NPROMPT) { Kb = KP + (size_t)(row & ~255) * D; Vb = VP + (size_t)(row & ~255) * D; Tk = 256; }
        else { const int sb = (row - NPROMPT) >> 10; Kb = F.KS + (size_t)sb * TKS * D; Vb = F.VS + (size_t)sb * TKS * D; Tk = TKS; }
        qs[F.lane] = bf2f(Q[(size_t)row * D + h * 128 + F.lane]); qs[64 + F.lane] = bf2f(Q[(size_t)row * D + h * 128 + 64 + F.lane]);
        asm volatile("s_waitcnt lgkmcnt(0)" ::: "memory");
        float m1 = -1e30f, m2 = -1e30f;
        for (int k = F.lane; k < Tk; k += 64) { const bf16* kr = Kb + (size_t)k * D + h * 128; float d1 = 0.f, d2 = 0.f;
#pragma unroll 4
            for (int d = 0; d < 64; d += 2) { const unsigned a = *(const unsigned*)(kr + d), b = *(const unsigned*)(kr + 64 + d);
                d1 += qs[d] * bf2f(a) + qs[d + 1] * bf2f(a >> 16); d2 += qs[64 + d] * bf2f(b) + qs[64 + d + 1] * bf2f(b >> 16); }
            d1 *= 0.125f; d2 *= 0.125f; s1[k] = d1; s2[k] = d2; m1 = fmaxf(m1, d1); m2 = fmaxf(m2, d2); }
        m1 = wave_max(m1); m2 = wave_max(m2);
        float l1 = 0.f, l2 = 0.f;
        for (int k = F.lane; k < Tk; k += 64) { const float e1 = expf(s1[k] - m1), e2 = expf(s2[k] - m2); s1[k] = e1; s2[k] = e2; l1 += e1; l2 += e2; }
        l1 = wave_sum(l1); l2 = wave_sum(l2);
        const float i1 = 1.f / l1, i2 = lam / l2;
        for (int k = F.lane; k < Tk; k += 64) s1[k] = bf2f(f2bf(s1[k] * i1 - s2[k] * i2));
        asm volatile("s_waitcnt lgkmcnt(0)" ::: "memory");
        float o0 = 0.f, o1 = 0.f;
        for (int k = 0; k < Tk; ++k) { const unsigned vv = *(const unsigned*)(Vb + (size_t)k * D + h * 128 + 2 * F.lane); const float w = s1[k]; o0 += w * bf2f(vv); o1 += w * bf2f(vv >> 16); }
        const float ms = wave_sum(o0 * o0 + o1 * o1) * (1.f / 128.f), rs = rsqrtf(ms + EPS) * (1.f - lam_init);
        o0 = o0 * rs * sg[2 * F.lane]; o1 = o1 * rs * sg[2 * F.lane + 1];
        *(unsigned*)(O + (size_t)row * D + h * 128 + 2 * F.lane) = f2bf(o0) | (f2bf(o1) << 16);
        asm volatile("s_waitcnt lgkmcnt(0)" ::: "memory");
    }
}


constexpr int AT_KT = 128, AT_NMF = AT_KT / 16, AT_NCH = AT_KT / 32;
constexpr int AT_KS = 272, AT_VS = 288, AT_KBYTES = AT_KT * AT_KS, AT_VBYTES = AT_KT * AT_VS, AT_BUF = AT_KBYTES + AT_VBYTES;
__device__ __forceinline__ void attn_p1_tile(LAS const unsigned char* kt, const bf16x8 (&Qf)[2][2], int c, int q4, float& m1, float& m2, float& l1, float& l2) {
    const float SC = 0.18033688f;
#pragma unroll
    for (int hf = 0; hf < AT_NMF / 4; ++hf) {
        f32x4 S[2][4];
        { bf16x8 kf[2][4][2];
#pragma unroll
          for (int cp = 0; cp < 2; ++cp)
#pragma unroll
              for (int mf = 0; mf < 4; ++mf)
#pragma unroll
                  for (int ks = 0; ks < 2; ++ks) kf[cp][mf][ks] = *(LAS const bf16x8*)(kt + (64 * hf + 16 * mf + c) * AT_KS + cp * 128 + ks * 64 + 16 * q4);
          __builtin_amdgcn_sched_barrier(0);
#pragma unroll
          for (int cp = 0; cp < 2; ++cp)
#pragma unroll
              for (int mf = 0; mf < 4; ++mf) { S[cp][mf] = (f32x4){0.f, 0.f, 0.f, 0.f};
#pragma unroll
                  for (int ks = 0; ks < 2; ++ks) S[cp][mf] = __builtin_amdgcn_mfma_f32_16x16x32_bf16(kf[cp][mf][ks], Qf[cp][ks], S[cp][mf], 0, 0, 0); } }
        float x1 = -1e30f, x2 = -1e30f;
#pragma unroll
        for (int mf = 0; mf < 4; ++mf)
#pragma unroll
            for (int k = 0; k < 4; ++k) { x1 = fmaxf(x1, S[0][mf][k]); x2 = fmaxf(x2, S[1][mf][k]); }
        x1 = max_q4(x1); x2 = max_q4(x2);
        const float n1 = fmaxf(m1, x1), n2 = fmaxf(m2, x2);
        l1 *= __builtin_amdgcn_exp2f((m1 - n1) * SC); l2 *= __builtin_amdgcn_exp2f((m2 - n2) * SC); m1 = n1; m2 = n2;
        const float o1 = m1 * SC, o2 = m2 * SC;
#pragma unroll
        for (int mf = 0; mf < 4; ++mf)
#pragma unroll
            for (int k = 0; k < 4; ++k) { l1 += __builtin_amdgcn_exp2f(S[0][mf][k] * SC - o1); l2 += __builtin_amdgcn_exp2f(S[1][mf][k] * SC - o2); }
    }
}
__device__ __forceinline__ void attn_p2_tile(LAS const unsigned char* kt, LAS const unsigned char* vt, const bf16x8 (&Qf)[2][2], int c, int q4, float o1, float o2, float i1, float i2, f32x4 (&Ot)[8]) {
    const float SC = 0.18033688f;
#pragma unroll
    for (int hf = 0; hf < AT_NMF / 4; ++hf) {
        f32x4 S[2][4];
        { bf16x8 kf[2][4][2];
#pragma unroll
          for (int cp = 0; cp < 2; ++cp)
#pragma unroll
              for (int mf = 0; mf < 4; ++mf)
#pragma unroll
                  for (int ks = 0; ks < 2; ++ks) kf[cp][mf][ks] = *(LAS const bf16x8*)(kt + (64 * hf + 16 * mf + c) * AT_KS + cp * 128 + ks * 64 + 16 * q4);
          __builtin_amdgcn_sched_barrier(0);
#pragma unroll
          for (int cp = 0; cp < 2; ++cp)
#pragma unroll
              for (int mf = 0; mf < 4; ++mf) { S[cp][mf] = (f32x4){0.f, 0.f, 0.f, 0.f};
#pragma unroll
                  for (int ks = 0; ks < 2; ++ks) S[cp][mf] = __builtin_amdgcn_mfma_f32_16x16x32_bf16(kf[cp][mf][ks], Qf[cp][ks], S[cp][mf], 0, 0, 0); } }
        bf16x8 Wf[2];
#pragma unroll
        for (int kk = 0; kk < 2; ++kk) { float w[8];
#pragma unroll
            for (int jj = 0; jj < 8; ++jj) { const int mf = 2 * kk + (jj >> 2), k = jj & 3;
                w[jj] = __builtin_amdgcn_exp2f(S[0][mf][k] * SC - o1) * i1 - __builtin_amdgcn_exp2f(S[1][mf][k] * SC - o2) * i2; }
            const unsigned p0 = pg8::cvt_pk_bf16(w[0], w[1]), p1 = pg8::cvt_pk_bf16(w[2], w[3]), p2 = pg8::cvt_pk_bf16(w[4], w[5]), p3 = pg8::cvt_pk_bf16(w[6], w[7]);
            Wf[kk] = __builtin_bit_cast(bf16x8, (u32x4){p0, p1, p2, p3}); }
#pragma unroll
        for (int mh = 0; mh < 2; ++mh) {
            v4i16_t lo[4][2], hi[4][2];
#pragma unroll
            for (int mm = 0; mm < 4; ++mm)
#pragma unroll
                for (int kk = 0; kk < 2; ++kk) { LAS const unsigned char* vp = vt + (64 * hf + 32 * kk + 4 * q4 + (c >> 2)) * AT_VS + (16 * (4 * mh + mm) + 4 * (c & 3)) * 2;
                    lo[mm][kk] = __builtin_amdgcn_ds_read_tr16_b64_v4i16((LAS v4i16_t*)vp); hi[mm][kk] = __builtin_amdgcn_ds_read_tr16_b64_v4i16((LAS v4i16_t*)(vp + 16 * AT_VS)); }
            __builtin_amdgcn_sched_barrier(0);
#pragma unroll
            for (int mm = 0; mm < 4; ++mm)
#pragma unroll
                for (int kk = 0; kk < 2; ++kk) { const bf16x8 vf = {lo[mm][kk][0], lo[mm][kk][1], lo[mm][kk][2], lo[mm][kk][3], hi[mm][kk][0], hi[mm][kk][1], hi[mm][kk][2], hi[mm][kk][3]};
                    Ot[4 * mh + mm] = __builtin_amdgcn_mfma_f32_16x16x32_bf16(vf, Wf[kk], Ot[4 * mh + mm], 0, 0, 0); }
        }
    }
}
__device__ __forceinline__ void attn_store(LAS const float* sgl  , const f32x4 (&Ot)[8], bf16* Orows, int h, int wave, int c, int q4, float lam_init) {
    float ss = 0.f;
#pragma unroll
    for (int md = 0; md < 8; ++md)
#pragma unroll
        for (int k = 0; k < 4; ++k) ss += Ot[md][k] * Ot[md][k];
    ss = sum_q4(ss);
    const float rs = rsqrtf(ss * (1.f / 128.f) + EPS) * (1.f - lam_init);
#pragma unroll
    for (int md = 0; md < 8; ++md) { const int d0 = 16 * md + 4 * q4; const f32x4 g4 = *(LAS const f32x4*)(sgl + d0);
        u32x2 w; w.x = pg8::cvt_pk_bf16(Ot[md][0] * rs * g4[0], Ot[md][1] * rs * g4[1]); w.y = pg8::cvt_pk_bf16(Ot[md][2] * rs * g4[2], Ot[md][3] * rs * g4[3]);
        *(GAS u32x2*)(Orows + (size_t)(16 * wave + c) * D + h * 128 + d0) = w; }
}
__device__ __forceinline__ void attn_unit(Frame& F, LAS const float* sgv, const bf16* Qrows  , const bf16* Kb, const bf16* Vb, int Tk, bf16* Orows, int h, float lam, float lam_init) {
    const int tid = F.tid, lane = F.lane, wave = F.wave, c = lane & 15, q4 = lane >> 4;
    LAS unsigned char* lds = F.lds;
    const float SC = 0.18033688f, THR = 8.f;
    bf16x8 Qf[2][2];
#pragma unroll
    for (int cp = 0; cp < 2; ++cp)
#pragma unroll
        for (int ks = 0; ks < 2; ++ks) Qf[cp][ks] = *(const GAS bf16x8*)(Qrows + (size_t)(16 * wave + c) * D + h * 128 + cp * 64 + 32 * ks + 8 * q4);
    const int nt = Tk / AT_KT;
    const int key0 = tid >> 4, cc0 = tid & 15;
    const GAS unsigned char* kgb = (const GAS unsigned char*)Kb + (size_t)h * 256; const GAS unsigned char* vgb = (const GAS unsigned char*)Vb + (size_t)h * 256;
    const unsigned koff = (unsigned)(key0 * D + 8 * cc0) * 2u;
    u32x4 kreg[AT_NCH], vreg[AT_NCH];
    float om[2] = {-1e30f, -1e30f}, ls[2] = {0.f, 0.f};
    f32x4 Ot[2][8];
#pragma unroll
    for (int cp = 0; cp < 2; ++cp)
#pragma unroll
        for (int md = 0; md < 8; ++md) Ot[cp][md] = (f32x4){0.f, 0.f, 0.f, 0.f};
#pragma unroll
    for (int i = 0; i < AT_NCH; ++i) { kreg[i] = *(const GAS u32x4*)(kgb + (size_t)(32 * i) * D * 2 + koff); vreg[i] = *(const GAS u32x4*)(vgb + (size_t)(32 * i) * D * 2 + koff); }
#pragma unroll
    for (int i = 0; i < AT_NCH; ++i) { *(LAS u32x4*)(lds + (key0 + 32 * i) * AT_KS + 16 * cc0) = kreg[i]; *(LAS u32x4*)(lds + AT_KBYTES + (key0 + 32 * i) * AT_VS + 16 * cc0) = vreg[i]; }
    __syncthreads();
    for (int t = 0; t < nt; ++t) {
        LAS const unsigned char* kt = lds + (t & 1) * AT_BUF; LAS const unsigned char* vt = kt + AT_KBYTES;
#pragma unroll
        for (int hf = 0; hf < AT_NMF / 4; ++hf) {
            if (hf == AT_NMF / 4 - 1 && t + 1 < nt) {
#pragma unroll
                for (int i = 0; i < AT_NCH; ++i) { kreg[i] = *(const GAS u32x4*)(kgb + (size_t)((t + 1) * AT_KT + 32 * i) * D * 2 + koff);
                                                   vreg[i] = *(const GAS u32x4*)(vgb + (size_t)((t + 1) * AT_KT + 32 * i) * D * 2 + koff); } }
            bf16x8 Pf[2][2];
#pragma unroll
            for (int cp = 0; cp < 2; ++cp) {
                f32x4 S[4];
                { bf16x8 kf[4][2];
#pragma unroll
                  for (int mf = 0; mf < 4; ++mf)
#pragma unroll
                      for (int ks = 0; ks < 2; ++ks) kf[mf][ks] = *(LAS const bf16x8*)(kt + (64 * hf + 16 * mf + c) * AT_KS + cp * 128 + ks * 64 + 16 * q4);
#pragma unroll
                  for (int mf = 0; mf < 4; ++mf) { S[mf] = (f32x4){0.f, 0.f, 0.f, 0.f};
#pragma unroll
                      for (int ks = 0; ks < 2; ++ks) S[mf] = __builtin_amdgcn_mfma_f32_16x16x32_bf16(kf[mf][ks], Qf[cp][ks], S[mf], 0, 0, 0); } }
                float x = -1e30f;
#pragma unroll
                for (int mf = 0; mf < 4; ++mf)
#pragma unroll
                    for (int k = 0; k < 4; ++k) x = fmaxf(x, S[mf][k]);
                x = max_q4(x) * SC;
                if (!__all(x - om[cp] <= THR)) {
                    const float nm = fmaxf(om[cp], x), al = __builtin_amdgcn_exp2f(om[cp] - nm);
                    om[cp] = nm; ls[cp] *= al;
#pragma unroll
                    for (int md = 0; md < 8; ++md) Ot[cp][md] = Ot[cp][md] * al; }
                float p[16]; const float o = om[cp];
#pragma unroll
                for (int mf = 0; mf < 4; ++mf)
#pragma unroll
                    for (int k = 0; k < 4; ++k) { p[4 * mf + k] = __builtin_amdgcn_exp2f(S[mf][k] * SC - o); ls[cp] += p[4 * mf + k]; }
#pragma unroll
                for (int kk = 0; kk < 2; ++kk) { const unsigned p0 = pg8::cvt_pk_bf16(p[8 * kk + 0], p[8 * kk + 1]), p1 = pg8::cvt_pk_bf16(p[8 * kk + 2], p[8 * kk + 3]), p2 = pg8::cvt_pk_bf16(p[8 * kk + 4], p[8 * kk + 5]), p3 = pg8::cvt_pk_bf16(p[8 * kk + 6], p[8 * kk + 7]);
                    Pf[cp][kk] = __builtin_bit_cast(bf16x8, (u32x4){p0, p1, p2, p3}); }
            }
#pragma unroll
            for (int mh = 0; mh < 4; ++mh) {
                v4i16_t lo[2][2], hi[2][2];
#pragma unroll
                for (int mm = 0; mm < 2; ++mm)
#pragma unroll
                    for (int kk = 0; kk < 2; ++kk) { LAS const unsigned char* vp = vt + (64 * hf + 32 * kk + 4 * q4 + (c >> 2)) * AT_VS + (16 * (2 * mh + mm) + 4 * (c & 3)) * 2;
                        lo[mm][kk] = __builtin_amdgcn_ds_read_tr16_b64_v4i16((LAS v4i16_t*)vp); hi[mm][kk] = __builtin_amdgcn_ds_read_tr16_b64_v4i16((LAS v4i16_t*)(vp + 16 * AT_VS)); }
                __builtin_amdgcn_sched_barrier(0);
#pragma unroll
                for (int mm = 0; mm < 2; ++mm)
#pragma unroll
                    for (int kk = 0; kk < 2; ++kk) { const bf16x8 vf = {lo[mm][kk][0], lo[mm][kk][1], lo[mm][kk][2], lo[mm][kk][3], hi[mm][kk][0], hi[mm][kk][1], hi[mm][kk][2], hi[mm][kk][3]};
                        Ot[0][2 * mh + mm] = __builtin_amdgcn_mfma_f32_16x16x32_bf16(vf, Pf[0][kk], Ot[0][2 * mh + mm], 0, 0, 0);
                        Ot[1][2 * mh + mm] = __builtin_amdgcn_mfma_f32_16x16x32_bf16(vf, Pf[1][kk], Ot[1][2 * mh + mm], 0, 0, 0); }
            }
        }
        if (t + 1 < nt) {
#pragma unroll
            for (int i = 0; i < AT_NCH; ++i) { *(LAS u32x4*)(lds + ((t + 1) & 1) * AT_BUF + (key0 + 32 * i) * AT_KS + 16 * cc0) = kreg[i];
                                               *(LAS u32x4*)(lds + ((t + 1) & 1) * AT_BUF + AT_KBYTES + (key0 + 32 * i) * AT_VS + 16 * cc0) = vreg[i]; } }
        __syncthreads();
    }
    const float i1 = 1.f / sum_q4(ls[0]), i2 = lam / sum_q4(ls[1]);
    f32x4 Oc[8];
#pragma unroll
    for (int md = 0; md < 8; ++md) Oc[md] = Ot[0][md] * i1 - Ot[1][md] * i2;
    attn_store(sgv, Oc, Orows, h, wave, c, q4, lam_init);
}
__device__ __forceinline__ void attn_unit_resident(Frame& F, LAS const float* sgv, const bf16* Qrows, const bf16* Kb, const bf16* Vb, bf16* Orows, int h, float lam, float lam_init) {
    const int tid = F.tid, lane = F.lane, wave = F.wave, c = lane & 15, q4 = lane >> 4;
    LAS unsigned char* lds = F.lds;
    const float SC = 0.18033688f;
    const int key0 = tid >> 4, cc0 = tid & 15;
    const GAS unsigned char* kgb = (const GAS unsigned char*)Kb + (size_t)h * 256; const GAS unsigned char* vgb = (const GAS unsigned char*)Vb + (size_t)h * 256;
    const unsigned koff = (unsigned)(key0 * D + 8 * cc0) * 2u;
    bf16x8 Qf[2][2][2];
#pragma unroll
    for (int qi = 0; qi < 2; ++qi)
#pragma unroll
        for (int cp = 0; cp < 2; ++cp)
#pragma unroll
            for (int ks = 0; ks < 2; ++ks) Qf[qi][cp][ks] = *(const GAS bf16x8*)(Qrows + (size_t)(128 * qi + 16 * wave + c) * D + h * 128 + cp * 64 + 32 * ks + 8 * q4);
#pragma unroll
    for (int t = 0; t < 2; ++t) { u32x4 kreg[AT_NCH], vreg[AT_NCH];
#pragma unroll
        for (int i = 0; i < AT_NCH; ++i) { kreg[i] = *(const GAS u32x4*)(kgb + (size_t)(t * AT_KT + 32 * i) * D * 2 + koff); vreg[i] = *(const GAS u32x4*)(vgb + (size_t)(t * AT_KT + 32 * i) * D * 2 + koff); }
#pragma unroll
        for (int i = 0; i < AT_NCH; ++i) { *(LAS u32x4*)(lds + t * AT_BUF + (key0 + 32 * i) * AT_KS + 16 * cc0) = kreg[i]; *(LAS u32x4*)(lds + t * AT_BUF + AT_KBYTES + (key0 + 32 * i) * AT_VS + 16 * cc0) = vreg[i]; } }
    __syncthreads();
#pragma unroll
    for (int qi = 0; qi < 2; ++qi) {
        float m1 = -1e30f, m2 = -1e30f, l1 = 0.f, l2 = 0.f;
        const bf16x8 (&Qq)[2][2] = Qf[qi];
        attn_p1_tile(lds, Qq, c, q4, m1, m2, l1, l2); attn_p1_tile(lds + AT_BUF, Qq, c, q4, m1, m2, l1, l2);
        l1 = sum_q4(l1); l2 = sum_q4(l2);
        const float i1 = 1.f / l1, i2 = lam / l2, o1 = m1 * SC, o2 = m2 * SC;
        f32x4 Ot[8];
#pragma unroll
        for (int md = 0; md < 8; ++md) Ot[md] = (f32x4){0.f, 0.f, 0.f, 0.f};
        attn_p2_tile(lds, lds + AT_KBYTES, Qq, c, q4, o1, o2, i1, i2, Ot); attn_p2_tile(lds + AT_BUF, lds + AT_BUF + AT_KBYTES, Qq, c, q4, o1, o2, i1, i2, Ot);
        attn_store(sgv, Ot, Orows + (size_t)128 * qi * D, h, wave, c, q4, lam_init);
    }
    __syncthreads();
}
__device__ __forceinline__ void phase_attn(Frame& F, int l, const bf16* Q, const bf16* KP, const bf16* VP, bf16* O) {
    F.fresh();
    const float* al = F.inp(I_AT_LAM);
    const float lam_init = 0.8f - 0.6f * expf(-0.3f * (float)l);
    const float lam = expf(wave_sum(al[F.lane] * al[64 + F.lane])) - expf(wave_sum(al[128 + F.lane] * al[192 + F.lane])) + lam_init;
    LAS float* sgv = (LAS float*)(F.lds + 2 * AT_BUF);
    if (F.tid < 128) sgv[F.tid] = F.inp(I_AT_SUBG)[F.tid];
    __syncthreads();
    for (int s = 0; ; ++s) {
        int u;
        if (F.G == 256) { if (F.bid < 128) { if (s > 0) break; const int x = F.bid & 7, i = F.bid >> 3; u = (2 * x + (i >> 3)) * 8 + (i & 7); }
                          else { if (s > 1) break; u = 128 + 2 * (F.bid - 128) + s; } }
        else { u = F.bid + s * F.G; if (u >= 384) break; }
        if (u < 128) { const int sb = u >> 6, h = (u >> 3) & 7, qt = u & 7; const size_t r0 = (size_t)NPROMPT + sb * 1024 + qt * 128;
            attn_unit(F, sgv, Q + r0 * D, F.KS + (size_t)sb * TKS * D, F.VS + (size_t)sb * TKS * D, TKS, O + r0 * D, h, lam, lam_init); }
        else { const int v = u - 128, b = v >> 3, h = v & 7; const size_t r0 = (size_t)b * 256;
            attn_unit_resident(F, sgv, Q + r0 * D, KP + r0 * D, VP + r0 * D, O + r0 * D, h, lam, lam_init); }
    }
}

__device__ __forceinline__ void phase_ffn_convgate(Frame& F, int l, const bf16* Z, bf16* ACT) {
    F.fresh();
    const float* cw = F.inp(I_FF_CW) + (size_t)l * 3 * 2 * DFF; const float* cb = F.inp(I_FF_CB) + (size_t)l * 2 * DFF;
    const int gt = F.bid * NT + F.tid, GT = F.G * NT;
    for (int i = gt; i < M * DFF; i += GT) { const int row = i / DFF, j = i % DFF;
        int t, T; if (row < NPROMPT) { t = row & 255; T = 256; } else { t = (row - NPROMPT) & 1023; T = 1024; }
        float g = cb[j], u = cb[DFF + j];
#pragma unroll
        for (int k = 0; k < 3; ++k) { const int tt = t + k - 1; if (tt >= 0 && tt < T) { const bf16* zr = Z + (size_t)(row + k - 1) * 2 * DFF; g += cw[k * 2 * DFF + j] * bf2f(zr[j]); u += cw[k * 2 * DFF + DFF + j] * bf2f(zr[DFF + j]); } }
        ACT[i] = (bf16)f2bf(siluf_(g) * u); }
}

__global__ void __launch_bounds__(NT, 2) mk_fwd(Params prm) {
    extern __shared__ __attribute__((aligned(16))) unsigned char lds_raw[];
    Frame F;
    F.lds = (LAS unsigned char*)lds_raw; F.G = gridDim.x; F.out0 = prm.out; F.ws0 = prm.ws; F.wave0 = __builtin_amdgcn_readfirstlane(threadIdx.x >> 6);
    F.fresh();
    if (F.tid < N_IN) ((LAS unsigned long long*)(F.lds + PTR_OFF))[F.tid] = (unsigned long long)prm.in[F.tid];
    volatile LAS unsigned* MISC = (volatile LAS unsigned*)(F.lds + MISC_OFF);
    if (F.tid < 32) MISC[F.tid] = 0u;
    __syncthreads();
    (void)xcd_barrier_post((unsigned*)(prm.ws + WS_CTL) + CW_BAR, MISC + 8, F.tid == 0);
#define GRID_BAR_X(fn_) do { F.fresh(); XcdBarrier bar_; bar_.t0 = F.tid == 0; { unsigned* bp_ = (unsigned*)(prm.ws + WS_CTL) + CW_BAR; asm volatile("" : "+s"(bp_)); bar_.bar = bp_; } bar_.x = xb_xcc_id(); bar_.st = (volatile LAS unsigned*)(F.lds + MISC_OFF) + 8; fn_(bar_); } while (0)
#define GRID_ARRIVE() GRID_BAR_X(xcd_barrier_arrive)
#define GRID_WAIT() GRID_BAR_X(xcd_barrier_wait)
#define GRID_BAR() do { F.fresh(); XcdBarrier bar_; bar_.t0 = F.tid == 0; { unsigned* bp_ = (unsigned*)(prm.ws + WS_CTL) + CW_BAR; asm volatile("" : "+s"(bp_)); bar_.bar = bp_; } bar_.x = xb_xcc_id(); bar_.st = (volatile LAS unsigned*)(F.lds + MISC_OFF) + 8; xcd_barrier(bar_); } while (0)

#define GEMM_BF16(ACT, A_, Bt_, N_, K_, O_, ldc_, bias_, splitc_, splits_, rsq_, b2_, rsqv_, vt0_) do { pg8::Gemm g{A_, Bt_, M, N_, K_}; pg8::StaticOrder S; S.init(M, N_, F.G, F.bid); S.wave = F.wave; \
        pg8::EpiBf16<ACT> E{O_, ldc_, bias_, splitc_, splits_, rsq_, b2_, N_, rsqv_, vt0_, F.lds}; F.fresh(); E.prep(S, F.tid); pg8::gemm_phase<pg8::EpiBf16<ACT>, pg8::StaticOrder, true, true>(F.lds, g, S, E); } while (0)
#define GEMM_RESID(A_, Bt_, K_, sub_, fromin_) do { pg8::Gemm g{A_, Bt_, 54 * 192, D, K_}; pg8::ResOrder S; S.init(54 * 256, D, F.G, F.bid); S.wave = F.wave; \
        const int nl_ = (sub_) == 0 ? l : l + 1, ns_ = (sub_) == 0 ? 1 : 0; const bool last_ = nl_ >= DEPTH; \
        pg8::EpiResid E{F.out, (bf16*)(F.ws + WS_XB), F.mod + (size_t)l * 18 * D, (sub_) * 3 + 2, last_, last_ ? nullptr : F.H, F.inp(I_NORMG) + (size_t)((last_ ? 0 : nl_) * 2 + ns_) * D, \
                          F.mod + (size_t)(last_ ? 0 : nl_) * 18 * D, ns_ * 3 + 1, (sub_) == 0 ? F.rsq1 : F.rsq0, F.lds}; \
        GRID_ARRIVE(); F.fresh(); E.prep(S, F.tid); GRID_WAIT();            \
        pg8::gemm_phase<pg8::EpiResid, pg8::ResOrder, true, true>(F.lds, g, S, E); \
        if (F.bid >= 54 * 4 || F.G <= 54 * 4) side_job(F, 2 * l + (sub_) + 1, 1);     \
        if (!last_) { GRID_ARRIVE(); F.fresh(); pg8::ResOrder S2; S2.init(54 * 256, D, F.G, F.bid); const int n_ = S2.nwg > S2.c ? (S2.nwg - 1 - S2.c) / S2.G + 1 : 0; \
            if (n_ > 0) { pg8::Unit u_{0, 0}; (void)S2.next(n_ - 1, u_); pg8::EpiResid E2{}; E2.XB = (bf16*)(F.ws + WS_XB); E2.lds = F.lds; E2.flush(u_, F.tid); } } } while (0)

    phase_prologue(F);
    GRID_BAR();
    phase_modulate0(F);
    GRID_BAR();
#pragma unroll 1
    for (int l = 0; l < DEPTH; ++l) {
        const int kind = l % 3, j = l / 3;
        F.fresh();
        if (kind == 0) {
            bf16 *GB = F.T2, *REC = F.T2 + (size_t)M * DRNN, *PF = F.T3, *PB = F.T3 + (size_t)NSAMPLE * DRNN, *HS = F.T3 + (size_t)6 * 1024 * 1024;
            float* AGG = (float*)(F.T3 + (size_t)2 * NSAMPLE * DRNN);
            GEMM_BF16(2, F.H, F.WT + WE_LRU_IN + (size_t)j * 2 * DRNN * D, 2 * DRNN, D, GB, DRNN, nullptr, DRNN, (size_t)M * DRNN, F.rsq0, F.bias2 + B2_LRU + (size_t)j * 3 * 2560, nullptr, 0);
            if (l == 0 && (F.G != 256 || F.bid >= 400 - 256)) side_job(F, 13);
            GRID_BAR();
            phase_lru_core(F, j, REC, GB, HS, PF, PB, AGG, (unsigned*)(F.ws + WS_CTL) + CW_LRU, F.WT + WE_WG + (size_t)j * 40 * 128 * 128);
            if (l == 0) side_job(F, 9);
                        GEMM_RESID(HS, F.WT + WE_LRU_OUT + (size_t)j * D * DRNN, DRNN, 0, l == 0);
        } else if (kind == 1) {
            bf16 *UV = F.T1, *ACT = F.T2;
            GEMM_BF16(1, F.H, F.WT + WE_CM_IN, 2 * DB, D, UV, 2 * DB, F.inp(I_CM_BIN), 0, 0, F.rsq0, F.bias2 + B2_CM, F.rsqv, 8);
            GRID_BAR();
            phase_cmlp_spatial_mfma(F, UV, ACT, F.WT + WE_WSB);
                        GEMM_RESID(ACT, F.WT + WE_CM_OUT, DB, 0, false);
        } else {
            bf16 *Q = F.T2, *KP = F.T2 + (size_t)M * D, *VP = KP + (size_t)NPROMPT * D, *O = F.T3;
            { pg8::Gemm g{F.H, F.WT + WE_QKV, M, 3 * D, D}; pg8::StaticOrder S; S.init(M, 3 * D, F.G, F.bid); S.wave = F.wave;
              pg8::EpiQkv E{F.ws, F.out, F.rsq0, F.bias2 + B2_QKV, F.lds, F.inp(I_AT_QKG), F.rope};
              F.fresh(); E.prep(S, F.tid); pg8::gemm_phase<pg8::EpiQkv, pg8::StaticOrder, true, true>(F.lds, g, S, E); }
            GRID_BAR();
            phase_attn(F, l, Q, KP, VP, O);
                        GEMM_RESID(O, F.WT + WE_AT_OUT, D, 0, false);
        }
        if (F.G != 256 || F.bid >= 924 - 3 * 256) side_job(F, 2 * l + 1, 2);
        GRID_WAIT();
        { pg8::Gemm g{F.H, F.WT + WE_UP + (size_t)l * 2 * DFF * D, 42 * 256, 2 * DFF, D}; pg8::FfnOrder S; S.init(42 * 256, 2 * DFF, F.G, F.bid); S.wave = F.wave;
          pg8::EpiFfn E{F.T2, F.inp(I_FF_CW) + (size_t)l * 3 * 2 * DFF, F.inp(I_FF_CB) + (size_t)l * 2 * DFF, F.rsq1, F.bias2 + B2_UP + (size_t)l * 3 * 5632, F.lds};
          F.fresh(); E.prep(S, F.tid); pg8::gemm_phase<pg8::EpiFfn, pg8::FfnOrder, true, true>(F.lds, g, S, E); }
                GEMM_RESID(F.T2, F.WT + WE_DN + (size_t)l * D * DFF, DFF, 1, false);
        if (l + 1 < DEPTH) { const int crit_ = (l + 1) % 3 == 0 ? 400 - 256 : (l + 1) % 3 == 1 ? 640 - 2 * 256 : 480 - 256;
            if (F.G != 256 || F.bid >= crit_) side_job(F, 2 * l + 2, 2); GRID_WAIT(); }
    }
}

extern "C" void kernel_launch(void* const* d_in, const int* in_sizes, int n_in, void* d_out, int out_size, void* d_ws, size_t ws_size, hipStream_t stream) {
    static int grid = 0;
    if (grid == 0) {
        if (n_in != N_IN || ws_size < WS_END) { fprintf(stderr, "kernel_launch: unexpected n_in %d or ws_size %zu\n", n_in, ws_size); grid = -1; return; }
        int dev = 0, cus = 0, per_cu = 0;
        hipGetDevice(&dev); hipDeviceGetAttribute(&cus, hipDeviceAttributeMultiprocessorCount, dev);
        hipFuncSetAttribute((const void*)mk_fwd, hipFuncAttributeMaxDynamicSharedMemorySize, LDS_BYTES);
        hipOccupancyMaxActiveBlocksPerMultiprocessor(&per_cu, (const void*)mk_fwd, NT, LDS_BYTES);
        (void)hipGetLastError();
        if (per_cu < 1) { fprintf(stderr, "kernel_launch: occupancy query says %d blocks per CU\n", per_cu); per_cu = 1; }
        grid = cus;
    }
    if (grid < 0) return;
    hipMemsetAsync((char*)d_ws + WS_CTL, 0, CTL_ZERO_BYTES, stream);
    Params p{};
    for (int i = 0; i < N_IN; ++i) p.in[i] = (const float*)d_in[i];
    p.out = (float*)d_out; p.ws = (unsigned char*)d_ws;
    void* args[] = {&p};
    hipError_t e = hipLaunchCooperativeKernel((const void*)mk_fwd, dim3(grid), dim3(NT), args, LDS_BYTES, stream);
    if (e != hipSuccess) fprintf(stderr, "kernel_launch: cooperative launch failed: %s (grid %d)\n", hipGetErrorString(e), grid);
}
```

```cpp
#include <hip/hip_runtime.h>
#include <cstdio>
#include <cstdint>

#define GAS __attribute__((address_space(1)))
#define LAS __attribute__((address_space(3)))
typedef unsigned short bf16;
typedef float f32x4 __attribute__((ext_vector_type(4)));
typedef unsigned u32x2 __attribute__((ext_vector_type(2)));
typedef unsigned u32x4 __attribute__((ext_vector_type(4)));

constexpr int D = 1024, NPROMPT = 32 * 256, NSAMPLE = 2 * 1024, M = NPROMPT + NSAMPLE;
constexpr int DEPTH = 4, DRNN = 1280, DB = 2048, DFF = 2816, PAST = 512, TKS = PAST + 1024;
constexpr float EPS = 1e-6f;
constexpr int NWAVES = 8, NT = NWAVES * 64;

enum { I_XP = 0, I_XS, I_STATE, I_CK, I_CV, I_C, I_CCTX, I_WMOD, I_BMOD, I_NORMG, I_LRU_WIN, I_LRU_CW, I_LRU_CB, I_LRU_WG, I_LRU_BG, I_LRU_LAM, I_LRU_WOUT,
       I_CM_WIN, I_CM_BIN, I_CM_NG, I_CM_WS, I_CM_BS, I_CM_WOUT, I_AT_WQKV, I_AT_QKG, I_AT_LAM, I_AT_SUBG, I_AT_WOUT, I_FF_WUP, I_FF_CW, I_FF_CB, I_FF_WDN, N_IN };
constexpr size_t O_YP = 0, O_YS = (size_t)NPROMPT * D, O_STATE = (size_t)M * D, O_CK = O_STATE + 32 * 2 * 2 * DRNN, O_CV = O_CK + (size_t)NPROMPT * D;

constexpr size_t MiB = 1u << 20;
constexpr size_t WS_CTL = 0, CTL_ZERO_BYTES = 64 * 1024;
constexpr size_t WS_MOD = 1 * MiB;
constexpr size_t WS_RSTD = WS_MOD + 512 * 1024;
constexpr size_t WS_ROPE = WS_RSTD + 256 * 1024;
constexpr size_t WS_H = 2 * MiB;
constexpr size_t WS_T1 = 22 * MiB;
constexpr size_t WS_XB = 22 * MiB + 84 * MiB;
constexpr size_t WS_T2 = 132 * MiB;
constexpr size_t WS_T3 = 187 * MiB;
constexpr size_t WS_X = WS_T3 + 40 * MiB;
constexpr size_t B2_LRU = 0, B2_CM = B2_LRU + (size_t)2 * 3 * 2560, B2_QKV = B2_CM + (size_t)3 * 4096, B2_UP = B2_QKV + (size_t)3 * 3072, B2_END = B2_UP + (size_t)4 * 3 * 5632;
constexpr size_t WS_KS = 237 * MiB, WS_VS = 243 * MiB;
constexpr size_t WS_W = 249 * MiB;
constexpr size_t WE_LRU_IN = 0, WE_LRU_OUT = WE_LRU_IN + (size_t)2 * 2560 * 1024, WE_CM_IN = WE_LRU_OUT + (size_t)2 * 1024 * 1280, WE_CM_OUT = WE_CM_IN + (size_t)4096 * 1024,
                 WE_QKV = WE_CM_OUT + (size_t)1024 * 2048, WE_AT_OUT = WE_QKV + (size_t)3072 * 1024, WE_UP = WE_AT_OUT + (size_t)1024 * 1024, WE_DN = WE_UP + (size_t)4 * 5632 * 1024,
                 WE_WG = WE_DN + (size_t)4 * 1024 * 2816, WE_WSB = WE_WG + (size_t)80 * 128 * 128, WE_END = WE_WSB + (size_t)8 * 128 * 128;
constexpr size_t WS_END = WS_W + 106 * MiB;
static_assert(WE_END * 2 <= 106 * MiB, "weight copies fit");
constexpr int CW_BAR = 1024;
constexpr int CW_SJQ = 12288;
constexpr int CW_LRU = 8192;

constexpr int LDS_BYTES = 163840;
constexpr int MISC_OFF = LDS_BYTES - 256, PTR_OFF = LDS_BYTES - 1024;

__device__ __forceinline__ unsigned f2bf(float f) { unsigned u = __builtin_bit_cast(unsigned, f); return (u + 0x7fffu + ((u >> 16) & 1u)) >> 16; }
__device__ __forceinline__ float bf2f(unsigned b) { return __builtin_bit_cast(float, (b & 0xffffu) << 16); }
template <int CTRL> __device__ __forceinline__ float dppf(float v) { return __builtin_bit_cast(float, __builtin_amdgcn_update_dpp(0, __builtin_bit_cast(int, v), CTRL, 0xf, 0xf, false)); }
__device__ __forceinline__ float swz_xor16(float v) { return __builtin_bit_cast(float, __builtin_amdgcn_ds_swizzle(__builtin_bit_cast(int, v), 0x401F)); }
__device__ __forceinline__ float sum_x32(float v) { auto r = __builtin_amdgcn_permlane32_swap(__builtin_bit_cast(unsigned, v), __builtin_bit_cast(unsigned, v), false, false);
    return __builtin_bit_cast(float, (unsigned)r[0]) + __builtin_bit_cast(float, (unsigned)r[1]); }
__device__ __forceinline__ float max_x32(float v) { auto r = __builtin_amdgcn_permlane32_swap(__builtin_bit_cast(unsigned, v), __builtin_bit_cast(unsigned, v), false, false);
    return fmaxf(__builtin_bit_cast(float, (unsigned)r[0]), __builtin_bit_cast(float, (unsigned)r[1])); }
__device__ __forceinline__ float sum_q4(float v) { v += swz_xor16(v); return sum_x32(v); }
__device__ __forceinline__ float max_q4(float v) { v = fmaxf(v, swz_xor16(v)); return max_x32(v); }
__device__ __forceinline__ float wave_sum(float v) { v += dppf<0xB1>(v); v += dppf<0x4E>(v); v += dppf<0x141>(v); v += dppf<0x140>(v); return sum_q4(v); }
__device__ __forceinline__ float wave_max(float v) { v = fmaxf(v, dppf<0xB1>(v)); v = fmaxf(v, dppf<0x4E>(v)); v = fmaxf(v, dppf<0x141>(v)); v = fmaxf(v, dppf<0x140>(v)); return max_q4(v); }
__device__ __forceinline__ float bperm(float v, int src_lane) { return __builtin_bit_cast(float, __builtin_amdgcn_ds_bpermute(src_lane << 2, __builtin_bit_cast(int, v))); }
__device__ __forceinline__ float gelu_tanh(float x) {
    const float t = x * x * (-0.102943174f) + (-2.302208198f);
    return x * __builtin_amdgcn_rcpf(1.f + __builtin_amdgcn_exp2f(t * x)); }
__device__ __forceinline__ float sigmoidf_(float x) { return __builtin_amdgcn_rcpf(1.f + __builtin_amdgcn_exp2f(-1.44269504f * x)); }
__device__ __forceinline__ float siluf_(float x) { return x * __builtin_amdgcn_rcpf(1.f + __builtin_amdgcn_exp2f(-1.44269504f * x)); }
__device__ __forceinline__ float softplusf_(float x) { return fmaxf(x, 0.f) + 0.693147181f * __builtin_amdgcn_logf(1.f + __builtin_amdgcn_exp2f(-1.44269504f * fabsf(x))); }

#define XB_TMO      128
#define XB_XCNT(j)  (256  + 64 * (j))
#define XB_XSUB(j)  (1280 + 64 * (j))
#define XB_XGEN(j)  (2304 + 64 * (j))
#define XB_TOP      3328
#define XB_TOPGEN   3392
#define XCD_BAR_WORDS 3456
#define XB_SPIN_CAP (1u << 22)
__device__ __forceinline__ unsigned xb_ld(unsigned* p)              { return __hip_atomic_load(p, __ATOMIC_RELAXED, __HIP_MEMORY_SCOPE_AGENT); }
__device__ __forceinline__ unsigned xb_add(unsigned* p, unsigned v) { return __hip_atomic_fetch_add(p, v, __ATOMIC_RELAXED, __HIP_MEMORY_SCOPE_AGENT); }
__device__ __forceinline__ unsigned xb_xcc_id() { return (unsigned)__builtin_amdgcn_s_getreg((3 << 11) | 20) & 0xFu; }
#define XB_SPIN(cond, bar) do { unsigned _sp = 0; while (cond) { __builtin_amdgcn_s_sleep(1); \
    if ((++_sp & 255u) == 0u) { if (xb_ld(&(bar)[XB_TMO])) break; if (_sp > XB_SPIN_CAP) { atomicAdd(&(bar)[XB_TMO], 1u); break; } } } } while (0)
struct XcdBarrier { unsigned* bar; unsigned x; volatile LAS unsigned* st; bool t0; };
__device__ __forceinline__ XcdBarrier xcd_barrier_post(unsigned* bar, volatile LAS unsigned* st, bool t0) {
    XcdBarrier b; b.bar = bar; b.x = xb_xcc_id(); b.st = st; b.t0 = t0;
    if (t0) (void)xb_add(&bar[XB_XCNT(b.x)], 1u);
    return b;
}
__device__ __forceinline__ void xcd_barrier_complete(unsigned* bar, unsigned x, unsigned& nloc, unsigned& nx) {
    const unsigned G = gridDim.x * gridDim.y * gridDim.z;
    unsigned sum, cnt, mine, sp = 0u;
    for (;;) {
        sum = 0u; cnt = 0u; mine = 0u;
#pragma unroll
        for (unsigned j = 0; j < 16; ++j) { const unsigned c = xb_ld(&bar[XB_XCNT(j)]); sum += c; cnt += (c > 0u) ? 1u : 0u; mine = (j == x) ? c : mine; }
        if (sum == G) break;
        __builtin_amdgcn_s_sleep(1);
        if ((++sp & 255u) == 0u) { if (xb_ld(&bar[XB_TMO])) break; if (sp > XB_SPIN_CAP) { atomicAdd(&bar[XB_TMO], 1u); break; } }
    }
    nloc = mine > 0u ? mine : 1u; nx = cnt > 0u ? cnt : 1u;
}
__device__ __forceinline__ void xcd_barrier(const XcdBarrier& b) {
    asm volatile("s_waitcnt vmcnt(0)" ::: "memory");
    __syncthreads();
    if (b.t0) {
        unsigned* bar = b.bar;
        __builtin_amdgcn_s_waitcnt(0);
        unsigned nloc = b.st[0], nx = b.st[1];
        if (nloc == 0u) { xcd_barrier_complete(bar, b.x, nloc, nx); b.st[0] = nloc; b.st[1] = nx; }
        const unsigned old = xb_add(&bar[XB_XSUB(b.x)], 1u);
        const unsigned gen = old / nloc;
        if (old + 1u == (gen + 1u) * nloc) {
            __builtin_amdgcn_fence(__ATOMIC_RELEASE, "agent");
            asm volatile("s_waitcnt vmcnt(0)" ::: "memory");
            const unsigned og = xb_add(&bar[XB_TOP], 1u);
            const unsigned tg = og / nx;
            if (og + 1u == (tg + 1u) * nx) xb_add(&bar[XB_TOPGEN], 1u);
            else XB_SPIN(xb_ld(&bar[XB_TOPGEN]) == tg, bar);
            __builtin_amdgcn_fence(__ATOMIC_ACQUIRE, "agent");
            xb_add(&bar[XB_XGEN(b.x)], 1u);
            asm volatile("s_waitcnt vmcnt(0)" ::: "memory");
        } else {
            XB_SPIN(xb_ld(&bar[XB_XGEN(b.x)]) == gen, bar);
            __builtin_amdgcn_fence(__ATOMIC_ACQUIRE, "agent");
            asm volatile("s_waitcnt vmcnt(0)" ::: "memory");
        }
    }
    __syncthreads();
}

__device__ __forceinline__ void xcd_barrier_arrive(const XcdBarrier& b) {
    asm volatile("s_waitcnt vmcnt(0)" ::: "memory");
    __syncthreads();
    if (b.t0) {
        unsigned* bar = b.bar;
        __builtin_amdgcn_s_waitcnt(0);
        unsigned nloc = b.st[0], nx = b.st[1];
        if (nloc == 0u) { xcd_barrier_complete(bar, b.x, nloc, nx); b.st[0] = nloc; b.st[1] = nx; }
        const unsigned old = xb_add(&bar[XB_XSUB(b.x)], 1u);
        const unsigned gen = old / nloc;
        if (old + 1u == (gen + 1u) * nloc) {
            __builtin_amdgcn_fence(__ATOMIC_RELEASE, "agent");
            asm volatile("s_waitcnt vmcnt(0)" ::: "memory");
            const unsigned og = xb_add(&bar[XB_TOP], 1u);
            const unsigned tg = og / nx;
            if (og + 1u == (tg + 1u) * nx) xb_add(&bar[XB_TOPGEN], 1u);
            else XB_SPIN(xb_ld(&bar[XB_TOPGEN]) == tg, bar);
            __builtin_amdgcn_fence(__ATOMIC_ACQUIRE, "agent");
            xb_add(&bar[XB_XGEN(b.x)], 1u);
            asm volatile("s_waitcnt vmcnt(0)" ::: "memory");
            b.st[2] = 0xffffffffu;
        } else b.st[2] = gen;
    }
    __syncthreads();
}
__device__ __forceinline__ void xcd_barrier_wait(const XcdBarrier& b) {
    asm volatile("s_waitcnt vmcnt(0)" ::: "memory");
    __syncthreads();
    if (b.t0) { const unsigned gen = b.st[2];
        if (gen != 0xffffffffu) { unsigned* bar = b.bar;
            XB_SPIN(xb_ld(&bar[XB_XGEN(b.x)]) == gen, bar);
            __builtin_amdgcn_fence(__ATOMIC_ACQUIRE, "agent");
            asm volatile("s_waitcnt vmcnt(0)" ::: "memory"); } }
    __syncthreads();
}

namespace pg8 {
#define PG8_LAS __attribute__((address_space(3)))
typedef unsigned short bf16_t;
typedef short bf16x8 __attribute__((ext_vector_type(8)));
typedef float f32x4 __attribute__((ext_vector_type(4)));
typedef unsigned u32x4 __attribute__((ext_vector_type(4)));
constexpr int BM = 256, BK = 64, HALF = 128, HTB = HALF * BK * 2  , STAGE_BYTES = 8 * HTB, NXCD = 8, WGM = 8;

__host__ __device__ __forceinline__ int lds_byte(int r, int c) { const int st = (r >> 4) * 2 + (c >> 5), rr = r & 15, cc = c & 31, ob = rr * 64 + cc * 2; return st * 1024 + (ob ^ (((ob >> 9) & 1) << 5)); }
__host__ __device__ __forceinline__ void stage_rc(int b, int& R, int& C) { const int st = b / 1024, sb = b % 1024, swz = sb ^ (((sb >> 9) & 1) << 5); R = (st >> 1) * 16 + swz / 64; C = (st & 1) * 32 + (swz % 64) / 2; }
__host__ __device__ __forceinline__ int perm32(int rho) { const int n = rho >> 4, i = rho & 15; return 8 * (i >> 2) + 4 * n + (i & 3); }

struct Unit { int pm, pn; };
struct Gemm { const bf16_t* A; const bf16_t* Bt; int M, N, K; };

struct StaticOrder {
    int nM, nN, nwg, G, c, wave;
    __host__ __device__ __forceinline__ void init(int M, int N, int G_, int c_) { nM = M / BM; nN = N / BM; nwg = nM * nN; G = G_; c = c_; }
    __host__ __device__ __forceinline__ bool next(int i, Unit& u) const {
        const long L = (long)i * G + c; if (L >= nwg) return false;
        int wgid = (int)L; { const int q = nwg / NXCD, r = nwg % NXCD, xcd = wgid % NXCD, off = wgid / NXCD; wgid = (xcd < r ? xcd * (q + 1) : r * (q + 1) + (xcd - r) * q) + off; }
        const int nig = WGM * nN, gid = wgid / nig, fm = gid * WGM, gsz = (nM - fm) < WGM ? (nM - fm) : WGM;
        u.pm = fm + ((wgid % nig) % gsz); u.pn = (wgid % nig) / gsz; return true;
    }
    __device__ __forceinline__ int arow(int pm) const { return pm * BM; }
    __device__ __forceinline__ void a_ready(const Unit&) const {}
    __device__ __forceinline__ void done(const Unit&) const {}
};

template <class Epi, class Sched, bool ALIGN_EPI = false, bool SP2 = false>
__device__ __forceinline__ void gemm_phase(PG8_LAS unsigned char* lds, const Gemm g, const Sched& S, const Epi& E) {
    int z_ = 0; asm volatile("" : "+v"(z_));
    const int lane = __builtin_amdgcn_mbcnt_hi(~0u, __builtin_amdgcn_mbcnt_lo(~0u, z_)), wid = S.wave, tid = wid * 64 + lane, wr = wid >> 2, wc = wid & 3, fr = lane & 15, fq = lane >> 4;
    const int K = g.K, nt = K / BK;
    unsigned voffA[2], voffB[2];
#pragma unroll
    for (int i = 0; i < 2; ++i) { int R, C; stage_rc(tid * 16 + i * 8192, R, C); const int Rb = Epi::PERM ? ((R & ~31) + perm32(R & 31)) : R;
        const int Ra = Epi::PERMA ? ((R & ~63) + 4 * (R & 15) + ((R >> 4) & 3)) : R;
        voffA[i] = (unsigned)(Ra * K + C) * 2u; voffB[i] = (unsigned)(Rb * K + C) * 2u; }
    const size_t kstep = (size_t)(BK * 2);
    constexpr int MF = Epi::MF;
    const size_t hstep = (size_t)HALF * K * 2;
    const size_t hstepA = (size_t)(32 * MF) * K * 2;
    const size_t tstep = 2 * hstep;
    const unsigned ldsw = (unsigned)wid * 1024u;
    const int aoff = lds_byte(wr * 16 * MF + fr, fq * 8), boff = lds_byte(wc * 32 + fr, fq * 8);
#define PG8_SA(b, h) (((b) * 2 + (h)) * HTB)
#define PG8_SB(b, h) ((4 + (b) * 2 + (h)) * HTB)
#define PG8_STAGE(bufoff, gbase, voff) do { _Pragma("unroll") for (int _i = 0; _i < 2; ++_i) \
        __builtin_amdgcn_global_load_lds((const unsigned*)((const char*)(gbase) + (voff)[_i]), (PG8_LAS unsigned*)(lds + (bufoff) + ldsw + _i * 8192), 16, 0, 0); } while (0)
#define PG8_LDA(dst, b, h) do { _Pragma("unroll") for (int m = 0; m < MF; ++m) _Pragma("unroll") for (int k = 0; k < 2; ++k) dst[m][k] = *(const PG8_LAS bf16x8*)(lds + PG8_SA(b, h) + aoff + m * 2048 + k * 1024); } while (0)
#define PG8_LDB(dst, b, h) do { _Pragma("unroll") for (int n = 0; n < 2; ++n) _Pragma("unroll") for (int k = 0; k < 2; ++k) dst[n][k] = *(const PG8_LAS bf16x8*)(lds + PG8_SB(b, h) + boff + n * 2048 + k * 1024); } while (0)
#define PG8_MMA(ai, bj, At, Bt) do { __builtin_amdgcn_s_setprio(1); _Pragma("unroll") for (int m = 0; m < MF; ++m) _Pragma("unroll") for (int n = 0; n < 2; ++n) _Pragma("unroll") for (int k = 0; k < 2; ++k) \
        acc[ai][bj][m][n] = __builtin_amdgcn_mfma_f32_16x16x32_bf16(Bt[n][k], At[m][k], acc[ai][bj][m][n], 0, 0, 0); __builtin_amdgcn_s_setprio(0); } while (0)
#define PG8_WAIT_V(n) asm volatile("s_waitcnt vmcnt(" #n ")" ::: "memory")
    const bool afull = (MF == 4) || wid < 4;
#define PG8_STAGEA(bufoff, gbase) do { __builtin_amdgcn_global_load_lds((const unsigned*)((const char*)(gbase) + voffA[0]), (PG8_LAS unsigned*)(lds + (bufoff) + ldsw), 16, 0, 0); \
        if (afull) __builtin_amdgcn_global_load_lds((const unsigned*)((const char*)(gbase) + voffA[1]), (PG8_LAS unsigned*)(lds + (bufoff) + ldsw + 8192), 16, 0, 0); } while (0)
#define PG8_WAIT_VA(n, nr) do { if (afull) asm volatile("s_waitcnt vmcnt(" #n ")" ::: "memory"); else asm volatile("s_waitcnt vmcnt(" #nr ")" ::: "memory"); } while (0)
#define PG8_WAIT_L(n) asm volatile("s_waitcnt lgkmcnt(" #n ")" ::: "memory")
#define PG8_BAR __builtin_amdgcn_s_barrier()
#define PG8_SCHED __builtin_amdgcn_sched_barrier(0)
    Unit cur, nxt; int ui = 0;
    if (!S.next(0, cur)) return;
    f32x4 acc[2][2][MF][2];
#pragma unroll
    for (int a = 0; a < 2; ++a)
#pragma unroll
        for (int b = 0; b < 2; ++b)
#pragma unroll
            for (int m = 0; m < MF; ++m)
#pragma unroll
                for (int n = 0; n < 2; ++n) acc[a][b][m][n] = (f32x4){0.f, 0.f, 0.f, 0.f};
    bf16x8 At[MF][2], B0[2][2], B1[2][2];
    const char* cA = (const char*)g.A + (size_t)S.arow(cur.pm) * (size_t)K * 2; const char* cB = (const char*)g.Bt + (size_t)cur.pn * tstep;
    S.a_ready(cur);
    if constexpr (SP2) {
        PG8_STAGE(PG8_SB(0, 0), cB, voffB); PG8_STAGE(PG8_SB(0, 1), cB + hstep, voffB); PG8_STAGEA(PG8_SA(0, 0), cA); PG8_STAGEA(PG8_SA(0, 1), cA + hstepA);
        if (wr == 1) PG8_BAR;
        PG8_WAIT_VA(2, 1); PG8_BAR;
        PG8_STAGE(PG8_SB(1, 0), cB + kstep, voffB); PG8_STAGEA(PG8_SA(1, 0), cA + kstep); PG8_STAGE(PG8_SB(1, 1), cB + hstep + kstep, voffB);
        PG8_WAIT_VA(6, 5); PG8_BAR;
    } else {
        PG8_STAGE(PG8_SB(0, 0), cB, voffB); PG8_STAGE(PG8_SA(0, 0), cA, voffA); PG8_STAGE(PG8_SB(0, 1), cB + hstep, voffB); PG8_STAGE(PG8_SA(0, 1), cA + hstepA, voffA);
        if (wr == 1) PG8_BAR;
        PG8_WAIT_V(4); PG8_BAR;
        PG8_STAGE(PG8_SB(1, 0), cB + kstep, voffB); PG8_STAGE(PG8_SA(1, 0), cA + kstep, voffA); PG8_STAGE(PG8_SB(1, 1), cB + hstep + kstep, voffB);
        PG8_WAIT_V(6); PG8_BAR;
    }
    for (;;) {
        const bool has_next = S.next(ui + 1, nxt);
        const char* nA = has_next ? (const char*)g.A + (size_t)S.arow(nxt.pm) * (size_t)K * 2 : cA; const char* nB = has_next ? (const char*)g.Bt + (size_t)nxt.pn * tstep : cB;
        for (int t = 0; t < nt; t += 2) {
            const bool last = (t == nt - 2);
            const char* a1 = cA + (size_t)(t + 1) * kstep;
            const char* a2 = last ? nA : cA + (size_t)(t + 2) * kstep; const char* b2 = last ? nB : cB + (size_t)(t + 2) * kstep;
            const char* a3 = a2 + kstep; const char* b3 = b2 + kstep;
            if (last && has_next) S.a_ready(nxt);
            if constexpr (SP2) {
            const bool tail = last && !has_next;
            PG8_LDB(B0, 0, 0); PG8_LDB(B1, 0, 1); PG8_SCHED; PG8_LDA(At, 0, 0); PG8_STAGEA(PG8_SA(1, 1), a1 + hstepA);
            PG8_WAIT_VA(8, 6); PG8_WAIT_L(0); PG8_BAR; PG8_MMA(0, 0, At, B0); PG8_MMA(0, 1, At, B1); PG8_BAR; PG8_SCHED;
            PG8_LDA(At, 0, 1); if (!tail) { PG8_STAGE(PG8_SB(0, 0), b2, voffB); PG8_STAGE(PG8_SB(0, 1), b2 + hstep, voffB); PG8_STAGEA(PG8_SA(0, 0), a2); }
            if (tail) PG8_WAIT_VA(2, 1); else PG8_WAIT_VA(8, 6);
            PG8_WAIT_L(0); PG8_BAR; PG8_MMA(1, 0, At, B0); PG8_MMA(1, 1, At, B1); PG8_BAR; PG8_SCHED;
            PG8_LDB(B0, 1, 0); PG8_LDB(B1, 1, 1); PG8_SCHED; PG8_LDA(At, 1, 0); if (!tail) PG8_STAGEA(PG8_SA(0, 1), a2 + hstepA);
            if (tail) PG8_WAIT_V(0); else PG8_WAIT_VA(8, 6);
            PG8_WAIT_L(0); PG8_BAR; PG8_MMA(0, 0, At, B0); PG8_MMA(0, 1, At, B1); PG8_BAR; PG8_SCHED;
            PG8_LDA(At, 1, 1); if (!tail) { PG8_STAGE(PG8_SB(1, 0), b3, voffB); PG8_STAGE(PG8_SB(1, 1), b3 + hstep, voffB); PG8_STAGEA(PG8_SA(1, 0), a3); }
            if (tail) PG8_WAIT_V(0); else PG8_WAIT_VA(8, 6);
            PG8_WAIT_L(0); PG8_BAR; PG8_MMA(1, 0, At, B0); PG8_MMA(1, 1, At, B1); PG8_BAR; PG8_SCHED;
            } else {
            PG8_LDB(B0, 0, 0); PG8_SCHED; PG8_LDA(At, 0, 0); PG8_STAGE(PG8_SA(1, 1), a1 + hstepA, voffA);
            PG8_WAIT_L(8); PG8_BAR; PG8_WAIT_L(0); PG8_MMA(0, 0, At, B0); PG8_BAR; PG8_SCHED;
            PG8_LDB(B1, 0, 1); PG8_STAGE(PG8_SB(0, 0), b2, voffB);
            PG8_BAR; PG8_WAIT_L(0); PG8_MMA(0, 1, At, B1); PG8_BAR;
            PG8_LDA(At, 0, 1); PG8_STAGE(PG8_SA(0, 0), a2, voffA);
            PG8_BAR; PG8_WAIT_L(0); PG8_MMA(1, 0, At, B0); PG8_BAR; PG8_SCHED;
            PG8_STAGE(PG8_SB(0, 1), b2 + hstep, voffB);
            PG8_WAIT_V(6); PG8_BAR; PG8_MMA(1, 1, At, B1); PG8_BAR;
            PG8_LDB(B0, 1, 0); PG8_SCHED; PG8_LDA(At, 1, 0); PG8_STAGE(PG8_SA(0, 1), a2 + hstepA, voffA);
            PG8_WAIT_L(8); PG8_BAR; PG8_WAIT_L(0); PG8_MMA(0, 0, At, B0); PG8_BAR; PG8_SCHED;
            PG8_LDB(B1, 1, 1); PG8_STAGE(PG8_SB(1, 0), b3, voffB);
            PG8_BAR; PG8_WAIT_L(0); PG8_MMA(0, 1, At, B1); PG8_BAR;
            PG8_LDA(At, 1, 1); PG8_STAGE(PG8_SA(1, 0), a3, voffA);
            PG8_BAR; PG8_WAIT_L(0); PG8_MMA(1, 0, At, B0); PG8_BAR; PG8_SCHED;
            PG8_STAGE(PG8_SB(1, 1), b3 + hstep, voffB);
            PG8_WAIT_V(6); PG8_BAR; PG8_MMA(1, 1, At, B1); PG8_BAR;
            }
        }
        if constexpr (ALIGN_EPI) { if (wr == 0) PG8_BAR; }
        if constexpr (!Epi::AFTER_DRAIN) { int ze_ = 0; asm volatile("" : "+v"(ze_)); const int le_ = __builtin_amdgcn_mbcnt_hi(~0u, __builtin_amdgcn_mbcnt_lo(~0u, ze_)), fre = le_ & 15, fqe = le_ >> 4;
            if constexpr (Epi::DEFER) E(acc, cur, ui, wr, wc, fre, fqe, !has_next); else E(acc, cur, ui, wr, wc, fre, fqe); S.done(cur); }
        if (!has_next) break;
#pragma unroll
        for (int a = 0; a < 2; ++a)
#pragma unroll
            for (int b = 0; b < 2; ++b)
#pragma unroll
                for (int m = 0; m < MF; ++m)
#pragma unroll
                    for (int n = 0; n < 2; ++n) acc[a][b][m][n] = (f32x4){0.f, 0.f, 0.f, 0.f};
        cur = nxt; cA = nA; cB = nB; ++ui;
        if constexpr (ALIGN_EPI) { if (wr == 1) PG8_BAR; }
    }
    PG8_WAIT_V(0);
    if constexpr (!ALIGN_EPI) { if (wr == 0) PG8_BAR; }
    PG8_BAR;
    if constexpr (Epi::AFTER_DRAIN) { E.fused(acc, cur, wr, wc, fr, fq, lds, wid, lane); S.done(cur); }
#undef PG8_SA
#undef PG8_SB
#undef PG8_STAGE
#undef PG8_LDA
#undef PG8_LDB
#undef PG8_MMA
#undef PG8_WAIT_V
#undef PG8_WAIT_VA
#undef PG8_STAGEA
#undef PG8_WAIT_L
#undef PG8_BAR
#undef PG8_SCHED
}
}

namespace pg8 {
__device__ __forceinline__ unsigned cvt_pk_bf16(float lo, float hi) { unsigned r; asm volatile("v_cvt_pk_bf16_f32 %0, %1, %2" : "=v"(r) : "v"(lo), "v"(hi)); return r; }
__device__ __forceinline__ f32x4 gelu4(f32x4 v) { f32x4 o; o.x = gelu_tanh(v.x); o.y = gelu_tanh(v.y); o.z = gelu_tanh(v.z); o.w = gelu_tanh(v.w); return o; }
constexpr int ETAB_OFF = 131072 + 8192, ETAB_SLOT = 4608, ETAB_MAXU = 4, FFN_ZROW = ETAB_OFF + ETAB_MAXU * ETAB_SLOT;
__device__ __forceinline__ float row_rstd(const float* rsq, int row) {
    const GAS f32x4* p = (const GAS f32x4*)(rsq + (size_t)row * 16);
    const f32x4 a = p[0], b = p[1], c = p[2], d = p[3];
    const float s = ((a.x + a.y) + (a.z + a.w)) + ((b.x + b.y) + (b.z + b.w)) + ((c.x + c.y) + (c.z + c.w)) + ((d.x + d.y) + (d.z + d.w));
    return rsqrtf(s * (1.f / D) + EPS);
}
__device__ __forceinline__ void rstd_load(const float* rsq, int row, f32x4 (&q)[4]) { const GAS f32x4* p = (const GAS f32x4*)(rsq + (size_t)row * 16); q[0] = p[0]; q[1] = p[1]; q[2] = p[2]; q[3] = p[3]; }
__device__ __forceinline__ float rstd_finish(const f32x4 (&q)[4]) {
    const float s = ((q[0].x + q[0].y) + (q[0].z + q[0].w)) + ((q[1].x + q[1].y) + (q[1].z + q[1].w)) + ((q[2].x + q[2].y) + (q[2].z + q[2].w)) + ((q[3].x + q[3].y) + (q[3].z + q[3].w));
    return rsqrtf(s * (1.f / D) + EPS); }
__device__ __forceinline__ int tile_cidx(int trow) { return trow < NPROMPT ? 0 : 1 + ((trow - NPROMPT) >> 10); }
__device__ __forceinline__ PG8_LAS float* etab(PG8_LAS unsigned char* lds, int ui) { return (PG8_LAS float*)(lds + ETAB_OFF + ui * ETAB_SLOT); }

template <int ACT> struct EpiBf16 {
    static constexpr bool PERM = true, PERMA = false, AFTER_DRAIN = false, DEFER = false; static constexpr int MF = 4;
    bf16_t* O; int ldc; const float* bias; int split_cols; size_t split_stride; const float* rsq; const float* b2; int N; float* rsqv; int vt0; PG8_LAS unsigned char* lds;
    template <class Sched> __device__ __forceinline__ void prep(const Sched& S, int tid) const {
        Unit us[ETAB_MAXU]; bool ok[ETAB_MAXU];
#pragma unroll
        for (int i = 0; i < ETAB_MAXU; ++i) ok[i] = S.next(i, us[i]);
        if (tid < 256) { f32x4 q[ETAB_MAXU][4];
#pragma unroll
            for (int i = 0; i < ETAB_MAXU; ++i) if (ok[i]) rstd_load(rsq, S.arow(us[i].pm) + tid, q[i]);
#pragma unroll
            for (int i = 0; i < ETAB_MAXU; ++i) if (ok[i]) etab(lds, i)[tid] = rstd_finish(q[i]);
        } else { const int c = tid - 256; float v[ETAB_MAXU], vb[ETAB_MAXU];
#pragma unroll
            for (int i = 0; i < ETAB_MAXU; ++i) if (ok[i]) { const int col = us[i].pn * BM + c; v[i] = b2[(size_t)tile_cidx(S.arow(us[i].pm)) * N + col]; vb[i] = bias ? bias[col] : 0.f; }
#pragma unroll
            for (int i = 0; i < ETAB_MAXU; ++i) if (ok[i]) etab(lds, i)[256 + c] = v[i] + vb[i]; }
        __syncthreads();
    }
    __device__ __forceinline__ void operator()(f32x4 (&acc)[2][2][4][2], const Unit& u, int ui, int wr, int wc, int fr, int fq) const {
        asm volatile("" : "+v"(fr), "+v"(fq));
        PG8_LAS const float* tb = etab(lds, ui);
        const int lrow0 = wr * 64 + fr; int colt = u.pn * BM; bf16_t* base = O; int t = 0;
        if (split_cols) { t = colt / split_cols; base += (size_t)t * split_stride; colt -= t * split_cols; }
        const bool act = (ACT == 1) || (ACT == 2 && t == 0);
        const int col0 = colt + wc * 32 + 8 * fq, tc0 = wc * 32 + 8 * fq;
        const bool wantv = ACT == 1 && rsqv != nullptr && u.pn >= vt0;
        GAS unsigned char* ob = (GAS unsigned char*)base;
        float ss[8];
#pragma unroll
        for (int i = 0; i < 8; ++i) ss[i] = 0.f;
#pragma unroll
        for (int bj = 0; bj < 2; ++bj) { const f32x4 bv0 = *(PG8_LAS const f32x4*)(tb + 256 + tc0 + bj * HALF), bv1 = *(PG8_LAS const f32x4*)(tb + 256 + tc0 + bj * HALF + 4);
#pragma unroll
            for (int ai = 0; ai < 2; ++ai)
#pragma unroll
                for (int m = 0; m < 4; ++m) { const int lrow = lrow0 + ai * HALF + m * 16; const float rs = tb[lrow];
                    f32x4 v0 = acc[ai][bj][m][0] * rs + bv0, v1 = acc[ai][bj][m][1] * rs + bv1;
                    if (ACT != 0) { if (act) { v0 = gelu4(v0); v1 = gelu4(v1); } }
                    if (ACT == 1) ss[ai * 4 + m] += (v0[0] * v0[0] + v0[1] * v0[1]) + (v0[2] * v0[2] + v0[3] * v0[3]) + (v1[0] * v1[0] + v1[1] * v1[1]) + (v1[2] * v1[2] + v1[3] * v1[3]);
                    u32x4 w; w.x = cvt_pk_bf16(v0[0], v0[1]); w.y = cvt_pk_bf16(v0[2], v0[3]); w.z = cvt_pk_bf16(v1[0], v1[1]); w.w = cvt_pk_bf16(v1[2], v1[3]);
                    *(GAS u32x4*)(ob + ((unsigned)(u.pm * BM + lrow) * (unsigned)ldc + col0 + bj * HALF) * 2u) = w;
                    if (m & 1) __builtin_amdgcn_sched_barrier(0); } }
        if (wantv) {
#pragma unroll
            for (int i = 0; i < 8; ++i) { const float q = sum_q4(ss[i]);
                if (fq == 0) *(GAS float*)(rsqv + (size_t)(u.pm * BM + lrow0 + (i >> 2) * HALF + (i & 3) * 16) * 32 + (u.pn - vt0) * 4 + wc) = q; } }
    }
};
struct ResOrder : StaticOrder { __device__ __forceinline__ int arow(int pm) const { return pm * 192; } };
struct EpiResid {
    static constexpr bool PERM = true, PERMA = false, AFTER_DRAIN = false, DEFER = true; static constexpr int MF = 3;
    float* out; bf16_t* XB; const float* modl; int which; bool final_;
    bf16_t* H; const float* ng; const float* modn; int whichs; float* rsq_out; PG8_LAS unsigned char* lds;
    template <class Sched> __device__ __forceinline__ void prep(const Sched& S, int tid) const {
        Unit u;
        for (int i = 0; i < ETAB_MAXU && S.next(i, u); ++i) { PG8_LAS float* t = etab(lds, i);
            if (tid < 256) { const int r0 = u.pm * 192, r1 = r0 + 191 < M ? r0 + 191 : M - 1, c0 = tile_cidx(r0), c1 = tile_cidx(r1), col = u.pn * BM + tid;
                t[tid] = modl[(size_t)(c1 * 6 + which) * D + col]; t[256 + tid] = modl[(size_t)(c0 * 6 + which) * D + col];
                t[512 + tid] = H ? ng[col] * (1.f + modn[(size_t)(c0 * 6 + whichs) * D + col]) : 0.f; t[768 + tid] = H ? ng[col] * (1.f + modn[(size_t)(c1 * 6 + whichs) * D + col]) : 0.f; } }
        __syncthreads();
    }
    static constexpr int XLS = 528;
    __device__ __forceinline__ void flush(const Unit& u, int tid) const {
        const int trow = u.pm * 192; GAS unsigned char* xbp = (GAS unsigned char*)XB;
        u32x4 v[12];
#pragma unroll
        for (int i = 0; i < 12; ++i) { const int id = i * 512 + tid, row = id >> 5, c16 = id & 31; v[i] = *(PG8_LAS const u32x4*)(lds + row * XLS + c16 * 16); }
#pragma unroll
        for (int i = 0; i < 12; ++i) { const int id = i * 512 + tid, row = id >> 5, c16 = id & 31;
            if (trow + row < M) *(GAS u32x4*)(xbp + ((unsigned)(trow + row) * (unsigned)D + u.pn * BM + c16 * 8) * 2u) = v[i]; }
    }
    __device__ __forceinline__ void operator()(f32x4 (&acc)[2][2][3][2], const Unit& u, int ui, int wr, int wc, int fr, int fq, bool park) const {
        asm volatile("" : "+v"(fr), "+v"(fq));
        PG8_LAS const float* tb = etab(lds, ui);
        const int trow = u.pm * 192, tc0 = wc * 32 + 8 * fq, col0 = u.pn * BM + tc0, ci0 = tile_cidx(trow);
        GAS unsigned char* op = (GAS unsigned char*)out; GAS unsigned char* hb = (GAS unsigned char*)H; GAS unsigned char* xbp = (GAS unsigned char*)XB;
        u32x4 xr[2][2][3];
#pragma unroll
        for (int ai = 0; ai < 2; ++ai)
#pragma unroll
            for (int m = 0; m < 3; ++m) { const int r16 = trow + 96 * ai + 48 * wr + 16 * m; const unsigned row = (unsigned)(r16 + fr);
#pragma unroll
                for (int bj = 0; bj < 2; ++bj) xr[ai][bj][m] = r16 < M ? *(const GAS u32x4*)(xbp + (row * (unsigned)D + col0 + bj * HALF) * 2u) : (u32x4){0u, 0u, 0u, 0u}; }
#pragma unroll
        for (int ai = 0; ai < 2; ++ai) {
            float ss[3] = {0.f, 0.f, 0.f};
#pragma unroll
            for (int m = 0; m < 3; ++m) { const int r16 = trow + 96 * ai + 48 * wr + 16 * m; const unsigned row = (unsigned)(r16 + fr);
                const bool alt = tile_cidx(r16 < M ? r16 : M - 1) != ci0;
                PG8_LAS const float* gt = tb + (alt ? 0 : 256); PG8_LAS const float* st = tb + (alt ? 768 : 512);
                if (r16 < M) {
#pragma unroll
                    for (int bj = 0; bj < 2; ++bj) { const f32x4 gv0 = *(PG8_LAS const f32x4*)(gt + tc0 + bj * HALF), gv1 = *(PG8_LAS const f32x4*)(gt + tc0 + bj * HALF + 4);
                        const unsigned eo = row * (unsigned)D + col0 + bj * HALF; const u32x4 xw = xr[ai][bj][m];
                        const f32x4 xa = {__builtin_bit_cast(float, xw.x << 16), __builtin_bit_cast(float, xw.x & 0xffff0000u), __builtin_bit_cast(float, xw.y << 16), __builtin_bit_cast(float, xw.y & 0xffff0000u)},
                                    xb4 = {__builtin_bit_cast(float, xw.z << 16), __builtin_bit_cast(float, xw.z & 0xffff0000u), __builtin_bit_cast(float, xw.w << 16), __builtin_bit_cast(float, xw.w & 0xffff0000u)};
                        const f32x4 x0 = xa + gv0 * acc[ai][bj][m][0], x1 = xb4 + gv1 * acc[ai][bj][m][1];
                        if (final_) { *(GAS f32x4*)(op + eo * 4u) = x0; *(GAS f32x4*)(op + eo * 4u + 16) = x1; }
                        else { u32x4 w; w.x = cvt_pk_bf16(x0[0], x0[1]); w.y = cvt_pk_bf16(x0[2], x0[3]); w.z = cvt_pk_bf16(x1[0], x1[1]); w.w = cvt_pk_bf16(x1[2], x1[3]);
                            if (park) *(PG8_LAS u32x4*)(lds + (r16 - trow + fr) * XLS + (tc0 + bj * HALF) * 2) = w; else *(GAS u32x4*)(xbp + eo * 2u) = w; }
                        if (H) { const f32x4 gs0 = *(PG8_LAS const f32x4*)(st + tc0 + bj * HALF), gs1 = *(PG8_LAS const f32x4*)(st + tc0 + bj * HALF + 4);
                            ss[m] += (x0[0] * x0[0] + x0[1] * x0[1]) + (x0[2] * x0[2] + x0[3] * x0[3]) + (x1[0] * x1[0] + x1[1] * x1[1]) + (x1[2] * x1[2] + x1[3] * x1[3]);
                            const f32x4 a0 = x0 * gs0, a1 = x1 * gs1;
                            u32x4 w; w.x = cvt_pk_bf16(a0[0], a0[1]); w.y = cvt_pk_bf16(a0[2], a0[3]); w.z = cvt_pk_bf16(a1[0], a1[1]); w.w = cvt_pk_bf16(a1[2], a1[3]);
                            *(GAS u32x4*)(hb + eo * 2u) = w; } } } }
            if (H) {
#pragma unroll
                for (int m = 0; m < 3; ++m) { const int r16 = trow + 96 * ai + 48 * wr + 16 * m; const float q = sum_q4(ss[m]);
                    if (fq == 0 && r16 < M) *(GAS float*)(rsq_out + (size_t)(r16 + fr) * 16 + u.pn * 4 + wc) = q; } }
            asm volatile("" ::: "memory");
        }
    }
};

__device__ __forceinline__ void ffn_tile_geom(int pm, int& rs, int& vlo, int& vhi) {
    if (pm < 32) { rs = 256 * pm; vlo = 0; vhi = 255; }
    else { const int sq = (pm - 32) / 5, i = (pm - 32) % 5; rs = NPROMPT + 1024 * sq + (i < 4 ? 254 * i : 768); vlo = i == 0 ? 0 : (i < 4 ? 1 : 249); vhi = i < 4 ? 254 : 255; }
}
struct FfnOrder : StaticOrder {
    __device__ __forceinline__ int arow(int pm) const { int rs, a, b; ffn_tile_geom(pm, rs, a, b); return rs; }
};
template <int CTRL> __device__ __forceinline__ float dpp0(float v) { return __builtin_bit_cast(float, __builtin_amdgcn_update_dpp(0, __builtin_bit_cast(int, v), CTRL, 0xf, 0xf, true)); }
struct EpiFfn {
    static constexpr bool PERM = true, PERMA = true, AFTER_DRAIN = false, DEFER = false; static constexpr int MF = 4;
    bf16_t* ACT; const float* cw; const float* cb; const float* rsq; const float* b2; PG8_LAS unsigned char* lds;
    template <class Sched> __device__ __forceinline__ void prep(const Sched& S, int tid) const {
        Unit us[ETAB_MAXU]; bool ok[ETAB_MAXU];
#pragma unroll
        for (int i = 0; i < ETAB_MAXU; ++i) ok[i] = S.next(i, us[i]);
        if (tid < 256) { f32x4 q[ETAB_MAXU][4];
#pragma unroll
            for (int i = 0; i < ETAB_MAXU; ++i) if (ok[i]) rstd_load(rsq, S.arow(us[i].pm) + tid, q[i]);
#pragma unroll
            for (int i = 0; i < ETAB_MAXU; ++i) if (ok[i]) etab(lds, i)[tid] = rstd_finish(q[i]);
        } else { const int c = tid - 256; float vb2[ETAB_MAXU], vcb[ETAB_MAXU], vw[ETAB_MAXU][3];
#pragma unroll
            for (int i = 0; i < ETAB_MAXU; ++i) if (ok[i]) { const int ch = (c < 128 ? 0 : DFF) + us[i].pn * 128 + (c & 127);
                vb2[i] = b2[(size_t)tile_cidx(S.arow(us[i].pm)) * 2 * DFF + us[i].pn * 256 + c]; vcb[i] = cb[ch];
#pragma unroll
                for (int k = 0; k < 3; ++k) vw[i][k] = cw[(size_t)k * 2 * DFF + ch]; }
#pragma unroll
            for (int i = 0; i < ETAB_MAXU; ++i) if (ok[i]) { PG8_LAS float* t = etab(lds, i); t[256 + c] = vb2[i]; t[512 + c] = vcb[i];
                PG8_LAS unsigned short* tw = (PG8_LAS unsigned short*)(t + 768);
#pragma unroll
                for (int k = 0; k < 3; ++k) tw[k * 256 + c] = (unsigned short)f2bf(vw[i][k]); } }
        if (tid < 256) ((PG8_LAS float*)(lds + FFN_ZROW))[tid] = 0.f;
        __syncthreads();
    }
    __device__ __forceinline__ void operator()(f32x4 (&acc)[2][2][4][2], const Unit& u, int ui, int wr, int wc, int fr, int fq) const {
        asm volatile("" : "+v"(fr), "+v"(fq));
        PG8_LAS const float* tb = etab(lds, ui); PG8_LAS float* xb = (PG8_LAS float*)(lds + 131072);
        int rs, vlo, vhi; ffn_tile_geom(u.pm, rs, vlo, vhi);
        const int colw = wc * 32 + 8 * fq;
#pragma unroll
        for (int bj = 0; bj < 2; ++bj) { const f32x4 bz0 = *(PG8_LAS const f32x4*)(tb + 256 + bj * 128 + colw), bz1 = *(PG8_LAS const f32x4*)(tb + 256 + bj * 128 + colw + 4);
#pragma unroll
            for (int ai = 0; ai < 2; ++ai) { const f32x4 rsd4 = *(PG8_LAS const f32x4*)(tb + 128 * ai + 64 * wr + 4 * fr);
#pragma unroll
                for (int m = 0; m < 4; ++m) { const float rsd = rsd4[m];
                    acc[ai][bj][m][0] = acc[ai][bj][m][0] * rsd + bz0; acc[ai][bj][m][1] = acc[ai][bj][m][1] * rsd + bz1; } } }
#pragma unroll
        for (int ai = 0; ai < 2; ++ai) { const int b = 2 * ai + wr;
            if (fr == 0) {
#pragma unroll
                for (int bj = 0; bj < 2; ++bj)
#pragma unroll
                    for (int n = 0; n < 2; ++n) *(PG8_LAS f32x4*)(xb + (b * 2 + 0) * 256 + bj * 128 + colw + 4 * n) = acc[ai][bj][0][n]; }
            if (fr == 15) {
#pragma unroll
                for (int bj = 0; bj < 2; ++bj)
#pragma unroll
                    for (int n = 0; n < 2; ++n) *(PG8_LAS f32x4*)(xb + (b * 2 + 1) * 256 + bj * 128 + colw + 4 * n) = acc[ai][bj][3][n]; } }
        asm volatile("s_waitcnt lgkmcnt(0)" ::: "memory"); __builtin_amdgcn_s_barrier(); asm volatile("" ::: "memory");
        GAS unsigned char* actb = (GAS unsigned char*)ACT;
        const unsigned lane_off = (unsigned)((rs + 64 * wr + 4 * fr) * DFF + u.pn * 128 + colw) * 2u;
        PG8_LAS const unsigned short* tw = (PG8_LAS const unsigned short*)(tb + 768);
        PG8_LAS const float* zr = (PG8_LAS const float*)(lds + FFN_ZROW);
        u32x2 hold[2][4];
#pragma unroll
        for (int n = 0; n < 2; ++n) {
            f32x4 wg[3], wu[3];
#pragma unroll
            for (int k = 0; k < 3; ++k) { const u32x2 pg = *(PG8_LAS const u32x2*)(tw + k * 256 + colw + 4 * n), pu = *(PG8_LAS const u32x2*)(tw + k * 256 + 128 + colw + 4 * n);
                wg[k] = (f32x4){__builtin_bit_cast(float, pg.x << 16), __builtin_bit_cast(float, pg.x & 0xffff0000u), __builtin_bit_cast(float, pg.y << 16), __builtin_bit_cast(float, pg.y & 0xffff0000u)};
                wu[k] = (f32x4){__builtin_bit_cast(float, pu.x << 16), __builtin_bit_cast(float, pu.x & 0xffff0000u), __builtin_bit_cast(float, pu.y << 16), __builtin_bit_cast(float, pu.y & 0xffff0000u)}; }
            const f32x4 bgv = *(PG8_LAS const f32x4*)(tb + 512 + colw + 4 * n), buv = *(PG8_LAS const f32x4*)(tb + 512 + 128 + colw + 4 * n);
#pragma unroll
            for (int ai = 0; ai < 2; ++ai) { const int b = 2 * ai + wr;
                PG8_LAS const float* pzp = (b > 0 && fr == 0) ? xb + ((b - 1) * 2 + 1) * 256 : zr; PG8_LAS const float* nzp = (b < 3 && fr == 15) ? xb + ((b + 1) * 2 + 0) * 256 : zr;
#pragma unroll
                for (int bj = 0; bj < 2; ++bj) { const f32x4* w3 = bj == 0 ? wg : wu; const f32x4 o = bj == 0 ? bgv : buv;
                    const f32x4 pz = *(PG8_LAS const f32x4*)(pzp + bj * 128 + colw + 4 * n), nz = *(PG8_LAS const f32x4*)(nzp + bj * 128 + colw + 4 * n);
                    const f32x4 z0 = acc[ai][bj][0][n], z1 = acc[ai][bj][1][n], z2 = acc[ai][bj][2][n], z3 = acc[ai][bj][3][n];
                    f32x4 a0 = w3[1] * z0 + o; a0 = w3[2] * z1 + a0; a0 = w3[0] * pz + a0;
                    f32x4 a1 = w3[1] * z1 + o; a1 = w3[0] * z0 + a1; a1 = w3[2] * z2 + a1;
                    f32x4 a2 = w3[1] * z2 + o; a2 = w3[0] * z1 + a2; a2 = w3[2] * z3 + a2;
                    f32x4 a3 = w3[1] * z3 + o; a3 = w3[0] * z2 + a3; a3 = w3[2] * nz + a3;
#pragma unroll
                    for (int e = 0; e < 4; ++e) { float t0 = a0[e], t3 = a3[e];
                        asm("v_fmac_f32_dpp %0, %1, %2 row_shr:1 row_mask:0xf bank_mask:0xf bound_ctrl:1" : "+v"(t0) : "v"(z3[e]), "v"(w3[0][e]));
                        asm("v_fmac_f32_dpp %0, %1, %2 row_shl:1 row_mask:0xf bank_mask:0xf bound_ctrl:1" : "+v"(t3) : "v"(z0[e]), "v"(w3[2][e]));
                        a0[e] = t0; a3[e] = t3; }
                    acc[ai][bj][0][n] = a0; acc[ai][bj][1][n] = a1; acc[ai][bj][2][n] = a2; acc[ai][bj][3][n] = a3; }
#pragma unroll
                for (int m = 0; m < 4; ++m) { const f32x4 g = acc[ai][0][m][n], uu = acc[ai][1][m][n];
                    const int lr = 128 * ai + 64 * wr + 4 * fr + m;
                    if (lr >= vlo && lr <= vhi) { const f32x4 t = g * -1.44269504f; f32x4 ex;
#pragma unroll
                        for (int e = 0; e < 4; ++e) ex[e] = __builtin_amdgcn_exp2f(t[e]);
                        const f32x4 den = ex + 1.f, gu = g * uu; f32x4 r;
#pragma unroll
                        for (int e = 0; e < 4; ++e) r[e] = __builtin_amdgcn_rcpf(den[e]);
                        const f32x4 y = gu * r; u32x2 w; w.x = cvt_pk_bf16(y[0], y[1]); w.y = cvt_pk_bf16(y[2], y[3]);
                        if (n == 0) hold[ai][m] = w;
                        else *(GAS u32x4*)(actb + (lane_off + (unsigned)((128 * ai + m) * DFF) * 2u)) = (u32x4){hold[ai][m].x, hold[ai][m].y, w.x, w.y}; } } }
        }
    }
};

struct EpiQkv {
    static constexpr bool PERM = true, PERMA = false, AFTER_DRAIN = false, DEFER = false; static constexpr int MF = 4;
    unsigned char* ws; float* out; const float* rsq; const float* b2; PG8_LAS unsigned char* lds; const float* qkg; const float* rope;
    template <class Sched> __device__ __forceinline__ void prep(const Sched& S, int tid) const {
        Unit us[ETAB_MAXU]; bool ok[ETAB_MAXU];
#pragma unroll
        for (int i = 0; i < ETAB_MAXU; ++i) ok[i] = S.next(i, us[i]);
        if (tid < 256) { f32x4 q[ETAB_MAXU][4];
#pragma unroll
            for (int i = 0; i < ETAB_MAXU; ++i) if (ok[i]) rstd_load(rsq, us[i].pm * BM + tid, q[i]);
#pragma unroll
            for (int i = 0; i < ETAB_MAXU; ++i) if (ok[i]) etab(lds, i)[tid] = rstd_finish(q[i]);
        } else { const int c = tid - 256; float v[ETAB_MAXU];
#pragma unroll
            for (int i = 0; i < ETAB_MAXU; ++i) if (ok[i]) v[i] = b2[(size_t)tile_cidx(us[i].pm * BM) * 3 * D + us[i].pn * BM + c];
#pragma unroll
            for (int i = 0; i < ETAB_MAXU; ++i) if (ok[i]) etab(lds, i)[256 + c] = v[i]; }
        __syncthreads();
    }
    __device__ __forceinline__ void operator()(f32x4 (&acc)[2][2][4][2], const Unit& u, int ui, int wr, int wc, int fr, int fq) const {
        asm volatile("" : "+v"(fr), "+v"(fq));
        PG8_LAS const float* tb = etab(lds, ui);
        const int trow = u.pm * BM; const bool smp = trow >= NPROMPT; const int sb = smp ? (trow - NPROMPT) >> 10 : 0, tq0 = smp ? (trow - NPROMPT) & 1023 : 0;
        const int kind = u.pn >> 2, tc0 = wc * 32 + 8 * fq;
        if (kind < 2) {
            const int oc = (u.pn & 3) * 256 + wc * 64 + 8 * fq;
            f32x4 bz[2][2], gq[2][2];
#pragma unroll
            for (int bj = 0; bj < 2; ++bj)
#pragma unroll
                for (int n = 0; n < 2; ++n) { bz[bj][n] = *(PG8_LAS const f32x4*)(tb + 256 + tc0 + bj * HALF + 4 * n); gq[bj][n] = *(const GAS f32x4*)(qkg + kind * 64 + 32 * bj + 8 * fq + 4 * n); }
            const size_t doff = kind == 0 ? WS_T2 : (smp ? WS_KS : WS_T2 + (size_t)M * D * 2); GAS unsigned char* dst = (GAS unsigned char*)ws + doff;
#pragma unroll
            for (int ai = 0; ai < 2; ++ai) {
                f32x4 cs[4][2], sn[4][2];
#pragma unroll
                for (int m = 0; m < 4; ++m) { const int lrow = 128 * ai + 64 * wr + 16 * m + fr; const float rs = tb[lrow];
                    if (smp && (m & 1) == 0) {
#pragma unroll
                        for (int mm = m; mm < m + 2; ++mm)
#pragma unroll
                            for (int n = 0; n < 2; ++n) { const int t = tq0 + 128 * ai + 64 * wr + 16 * mm + fr; cs[mm][n] = *(const GAS f32x4*)(rope + t * 32 + 8 * fq + 4 * n); sn[mm][n] = *(const GAS f32x4*)(rope + 32768 + t * 32 + 8 * fq + 4 * n); } }
                    f32x4 v[2][2]; float ss = 0.f;
#pragma unroll
                    for (int bj = 0; bj < 2; ++bj)
#pragma unroll
                        for (int n = 0; n < 2; ++n) { v[bj][n] = acc[ai][bj][m][n] * rs + bz[bj][n]; ss += (v[bj][n][0] * v[bj][n][0] + v[bj][n][1] * v[bj][n][1]) + (v[bj][n][2] * v[bj][n][2] + v[bj][n][3] * v[bj][n][3]); }
                    ss = sum_q4(ss);
                    const float rn = rsqrtf(ss * (1.f / 64.f) + EPS);
#pragma unroll
                    for (int bj = 0; bj < 2; ++bj)
#pragma unroll
                        for (int n = 0; n < 2; ++n) v[bj][n] = v[bj][n] * rn * gq[bj][n];
                    const unsigned row = (unsigned)(trow + lrow);
                    if (!smp) {
                        if (kind == 1) {
#pragma unroll
                            for (int bj = 0; bj < 2; ++bj)
#pragma unroll
                                for (int n = 0; n < 2; ++n) *(GAS f32x4*)((GAS unsigned char*)out + O_CK * 4 + (row * (unsigned)D + oc + 32 * bj + 4 * n) * 4u) = v[bj][n]; }
                    } else {
#pragma unroll
                        for (int n = 0; n < 2; ++n) { const f32x4 x1 = v[0][n], x2 = v[1][n]; v[0][n] = x1 * cs[m][n] - x2 * sn[m][n]; v[1][n] = x2 * cs[m][n] + x1 * sn[m][n]; } }
                    const unsigned drow = (kind == 1 && smp) ? (unsigned)(sb * TKS + PAST + tq0 + lrow) : row;
#pragma unroll
                    for (int bj = 0; bj < 2; ++bj) { u32x4 w; w.x = cvt_pk_bf16(v[bj][0][0], v[bj][0][1]); w.y = cvt_pk_bf16(v[bj][0][2], v[bj][0][3]); w.z = cvt_pk_bf16(v[bj][1][0], v[bj][1][1]); w.w = cvt_pk_bf16(v[bj][1][2], v[bj][1][3]);
                        *(GAS u32x4*)(dst + (drow * (unsigned)D + oc + 32 * bj) * 2u) = w; }
                    if (m & 1) { asm volatile("" ::: "memory"); __builtin_amdgcn_sched_barrier(0); } } }
        } else {
            const int oc = (u.pn - 8) * 256 + wc * 32 + 8 * fq;
            const size_t doff = smp ? WS_VS : WS_T2 + (size_t)M * D * 2 + (size_t)NPROMPT * D * 2; GAS unsigned char* dst = (GAS unsigned char*)ws + doff;
#pragma unroll
            for (int bj = 0; bj < 2; ++bj) { const f32x4 bz0 = *(PG8_LAS const f32x4*)(tb + 256 + tc0 + bj * HALF), bz1 = *(PG8_LAS const f32x4*)(tb + 256 + tc0 + bj * HALF + 4);
#pragma unroll
                for (int ai = 0; ai < 2; ++ai)
#pragma unroll
                    for (int m = 0; m < 4; ++m) { const int lrow = 128 * ai + 64 * wr + 16 * m + fr; const float rs = tb[lrow];
                        const f32x4 v0 = acc[ai][bj][m][0] * rs + bz0, v1 = acc[ai][bj][m][1] * rs + bz1;
                        const unsigned row = (unsigned)(trow + lrow), drow = smp ? (unsigned)(sb * TKS + PAST + tq0 + lrow) : row;
                        u32x4 w; w.x = cvt_pk_bf16(v0[0], v0[1]); w.y = cvt_pk_bf16(v0[2], v0[3]); w.z = cvt_pk_bf16(v1[0], v1[1]); w.w = cvt_pk_bf16(v1[2], v1[3]);
                        *(GAS u32x4*)(dst + (drow * (unsigned)D + oc + 128 * bj) * 2u) = w;
                        if (!smp) { *(GAS f32x4*)((GAS unsigned char*)out + O_CV * 4 + (row * (unsigned)D + oc + 128 * bj) * 4u) = v0; *(GAS f32x4*)((GAS unsigned char*)out + O_CV * 4 + (row * (unsigned)D + oc + 128 * bj + 4) * 4u) = v1; } } }
        }
    }
};
}

struct Params { const float* in[N_IN]; float* out; unsigned char* ws; };
struct Frame {
    LAS unsigned char* lds; int tid, lane, wave, bid, G, wave0;
    float* out; unsigned char* ws; float* out0; unsigned char* ws0;
    __device__ __forceinline__ const float* inp(int i) const { const unsigned long long v = ((LAS const unsigned long long*)(lds + PTR_OFF))[i];
        const unsigned lo = __builtin_amdgcn_readfirstlane((unsigned)v), hi = __builtin_amdgcn_readfirstlane((unsigned)(v >> 32)); return (const float*)(const GAS float*)(((unsigned long long)hi << 32) | lo); }
    float* mod; float* rstd; float* rope; bf16 *H, *T1, *T2, *T3, *KS, *VS, *WT; float *rsq0, *rsq1, *rsqv, *bias2;
    __device__ __forceinline__ void fresh() {
        int z = 0; asm volatile("" : "+v"(z));
        lane = __builtin_amdgcn_mbcnt_hi(~0u, __builtin_amdgcn_mbcnt_lo(~0u, z)); int wv = wave0; asm volatile("" : "+s"(wv)); wave = wv; tid = wv * 64 + lane;
        int b = blockIdx.x; asm volatile("" : "+s"(b)); bid = b;
        unsigned char* w = ws0; asm volatile("" : "+s"(w)); w = (unsigned char*)(GAS unsigned char*)(unsigned long long)w; ws = w; float* o = out0; asm volatile("" : "+s"(o)); o = (float*)(GAS float*)(unsigned long long)o; out = o;
        mod = (float*)(w + WS_MOD); rstd = (float*)(w + WS_RSTD); rope = (float*)(w + WS_ROPE);
        H = (bf16*)(w + WS_H); T1 = (bf16*)(w + WS_T1); T2 = (bf16*)(w + WS_T2); T3 = (bf16*)(w + WS_T3); KS = (bf16*)(w + WS_KS); VS = (bf16*)(w + WS_VS); WT = (bf16*)(w + WS_W);
        rsq0 = (float*)(w + WS_X); rsq1 = (float*)(w + WS_X + MiB); rsqv = (float*)(w + WS_X + 2 * MiB); bias2 = (float*)(w + WS_X + 4 * MiB);
    }
};
__device__ __forceinline__ const float* xin_row(const Frame& F, int row) { return row < NPROMPT ? F.inp(I_XP) + (size_t)row * D : F.inp(I_XS) + (size_t)(row - NPROMPT) * D; }
__device__ __forceinline__ int cidx_of(int row) { return row < NPROMPT ? 0 : 1 + ((row - NPROMPT) >> 10); }
__device__ __forceinline__ const float* modp(const Frame& F, int l, int row, int which) { return F.mod + (size_t)((l * 3 + cidx_of(row)) * 6 + which) * D; }


template <int MODE  >
__device__ __forceinline__ void transpose_item(const float* W, int K, int N, bf16* WT, LAS float* scr, int item, int lane) {
    const int nblk = N / 32, kb = item / nblk, nb = item % nblk, k0 = 64 * kb, n0 = 32 * nb;
    int d0 = n0; if (MODE == 1) { const int isu = n0 >= DFF, jj = n0 - isu * DFF; d0 = (jj >> 7) * 256 + isu * 128 + (jj & 127); }
    if (MODE == 2 && n0 < 2 * D) { const int w = n0 & 255; d0 = (n0 & ~255) + ((w >> 5) & 1) * 128 + (w >> 6) * 32; }
    float wv[32];
    const GAS float* wp = (const GAS float*)W + (size_t)(k0 + (lane >> 5)) * N + n0 + (lane & 31);
#pragma unroll
    for (int i = 0; i < 32; ++i) wv[i] = wp[(size_t)(2 * i) * N];
#pragma unroll
    for (int i = 0; i < 32; ++i) scr[(2 * i + (lane >> 5)) * 33 + (lane & 31)] = wv[i];
    asm volatile("s_waitcnt lgkmcnt(0)" ::: "memory");
    const int c = lane & 7;
#pragma unroll
    for (int j = 0; j < 4; ++j) { const int n = (lane >> 3) + 8 * j; const LAS float* sp = scr + (8 * c) * 33 + n;
        u32x4 o; o.x = f2bf(sp[0 * 33]) | (f2bf(sp[1 * 33]) << 16); o.y = f2bf(sp[2 * 33]) | (f2bf(sp[3 * 33]) << 16); o.z = f2bf(sp[4 * 33]) | (f2bf(sp[5 * 33]) << 16); o.w = f2bf(sp[6 * 33]) | (f2bf(sp[7 * 33]) << 16);
        *(u32x4*)(WT + (size_t)(d0 + n) * K + k0 + 8 * c) = o; }
    asm volatile("s_waitcnt lgkmcnt(0)" ::: "memory");
}
template <int MODE = 0>
__device__ __forceinline__ bool transpose_group(int& r, const float* W, int nmat, int K, int N, bf16* WT, LAS float* scr, int lane) {
    const int per = (K / 64) * (N / 32), tot = nmat * per;
    if (r >= tot) { r -= tot; return false; }
    const int mi = r / per; transpose_item<MODE>(W + (size_t)mi * K * N, K, N, WT + (size_t)mi * K * N, scr, r % per, lane); return true;
}

template <int SLOT>
__device__ __forceinline__ void convert_slot(Frame& F, int gw, int NGW) {
    LAS float* scr = (LAS float*)(F.lds + F.wave * 16384);
    constexpr size_t UPE = (size_t)2 * DFF * D, DNE = (size_t)D * DFF;
    constexpr int I_UP1 = (D / 64) * (2 * DFF / 32), I_DN1 = (DFF / 64) * (D / 32), I_LIN = (D / 64) * (2 * DRNN / 32), I_LOUT = (DRNN / 64) * (D / 32), I_WG = 80 * 2 * 4,
                  I_CIN = (D / 64) * (2 * DB / 32), I_COUT = (DB / 64) * (D / 32), I_QKV = (D / 64) * (3 * D / 32), I_AOUT = (D / 64) * (D / 32);
    constexpr int NIT = SLOT == 9 ? I_UP1 : SLOT == 0 ? I_LIN + I_LOUT + I_WG : SLOT == 1 ? I_CIN + I_DN1 : SLOT == 2 ? I_COUT + I_UP1 : SLOT == 3 ? I_DN1 + I_QKV + I_AOUT : SLOT == 4 ? I_UP1 : SLOT == 5 ? I_DN1 + I_LIN
                      : SLOT == 6 ? I_LOUT + I_UP1 : I_DN1;
    for (int it = gw; it < NIT; it += NGW) { int r = it;
        if (SLOT == 0) {
            if (transpose_group(r, F.inp(I_LRU_WIN), 1, D, 2 * DRNN, F.WT + WE_LRU_IN, scr, F.lane)) continue;
            if (transpose_group(r, F.inp(I_LRU_WOUT), 1, DRNN, D, F.WT + WE_LRU_OUT, scr, F.lane)) continue;
            transpose_group(r, F.inp(I_LRU_WG), 80, 128, 128, F.WT + WE_WG, scr, F.lane);
        } else if (SLOT == 9) {
            transpose_group<1>(r, F.inp(I_FF_WUP), 1, D, 2 * DFF, F.WT + WE_UP, scr, F.lane);
        } else if (SLOT == 1) {
            if (transpose_group(r, F.inp(I_CM_WIN), 1, D, 2 * DB, F.WT + WE_CM_IN, scr, F.lane)) continue;
            transpose_group(r, F.inp(I_FF_WDN), 1, DFF, D, F.WT + WE_DN, scr, F.lane);
        } else if (SLOT == 2) {
            if (transpose_group(r, F.inp(I_CM_WOUT), 1, DB, D, F.WT + WE_CM_OUT, scr, F.lane)) continue;
            transpose_group<1>(r, F.inp(I_FF_WUP) + UPE, 1, D, 2 * DFF, F.WT + WE_UP + UPE, scr, F.lane);
        } else if (SLOT == 3) {
            if (transpose_group(r, F.inp(I_FF_WDN) + DNE, 1, DFF, D, F.WT + WE_DN + DNE, scr, F.lane)) continue;
            if (transpose_group<2>(r, F.inp(I_AT_WQKV), 1, D, 3 * D, F.WT + WE_QKV, scr, F.lane)) continue;
            transpose_group(r, F.inp(I_AT_WOUT), 1, D, D, F.WT + WE_AT_OUT, scr, F.lane);
        } else if (SLOT == 4) {
            transpose_group<1>(r, F.inp(I_FF_WUP) + 2 * UPE, 1, D, 2 * DFF, F.WT + WE_UP + 2 * UPE, scr, F.lane);
        } else if (SLOT == 5) {
            if (transpose_group(r, F.inp(I_FF_WDN) + 2 * DNE, 1, DFF, D, F.WT + WE_DN + 2 * DNE, scr, F.lane)) continue;
            transpose_group(r, F.inp(I_LRU_WIN) + (size_t)D * 2 * DRNN, 1, D, 2 * DRNN, F.WT + WE_LRU_IN + (size_t)D * 2 * DRNN, scr, F.lane);
        } else if (SLOT == 6) {
            if (transpose_group(r, F.inp(I_LRU_WOUT) + (size_t)DRNN * D, 1, DRNN, D, F.WT + WE_LRU_OUT + (size_t)DRNN * D, scr, F.lane)) continue;
            transpose_group<1>(r, F.inp(I_FF_WUP) + 3 * UPE, 1, D, 2 * DFF, F.WT + WE_UP + 3 * UPE, scr, F.lane);
        } else {
            transpose_group(r, F.inp(I_FF_WDN) + 3 * DNE, 1, DFF, D, F.WT + WE_DN + 3 * DNE, scr, F.lane);
        }
    }
}
__device__ __forceinline__ void adaln_layer(Frame& F, int l, int wk, int nwk) {
    LAS float* sc = (LAS float*)(F.lds + 106496);
    const float* c = F.inp(I_C); const float* cctx = F.inp(I_CCTX);
    __syncthreads();
    for (int i = F.tid; i < 3 * D; i += NT) { const int ci = i >> 10, k = i & 1023; const float v = ci == 0 ? cctx[k] : c[(ci - 1) * D + k]; sc[i] = siluf_(v); }
    __syncthreads();
    LAS float* part = sc + 3 * D;
    const int kp = F.tid >> 6, cl = F.tid & 63;
    for (int item = wk; item < 6 * D / 64; item += nwk) {
        const int cc = item * 64 + cl;
        const float* w = F.inp(I_WMOD) + (size_t)l * D * 6 * D + cc;
        float s0 = 0.f, s1 = 0.f, s2 = 0.f;
#pragma unroll 1
        for (int kb = kp * 128; kb < kp * 128 + 128; kb += 64) { float wv[64];
#pragma unroll
            for (int i = 0; i < 64; ++i) wv[i] = ((const GAS float*)w)[(size_t)(kb + i) * 6 * D];
#pragma unroll
            for (int i = 0; i < 64; ++i) { s0 += sc[kb + i] * wv[i]; s1 += sc[D + kb + i] * wv[i]; s2 += sc[2 * D + kb + i] * wv[i]; } }
        part[(kp * 3 + 0) * 64 + cl] = s0; part[(kp * 3 + 1) * 64 + cl] = s1; part[(kp * 3 + 2) * 64 + cl] = s2;
        __syncthreads();
        if (F.tid < 192) { const int ci = F.tid >> 6; float s = F.inp(I_BMOD)[l * 6 * D + cc];
            for (int q = 0; q < 8; ++q) s += part[(q * 3 + ci) * 64 + cl];
            F.mod[(size_t)((l * 3 + ci) * 6) * D + cc] = s; }
        __syncthreads();
    }
}
__device__ __forceinline__ void bias2_gemm(Frame& F, const bf16* Wt, int N, int l, int sub, float* outp, int gw, int NGW, int n1 = 1 << 30) {
    float sh[3][16];
#pragma unroll
    for (int ci = 0; ci < 3; ++ci) { const GAS f32x4* sp = (const GAS f32x4*)(F.mod + (size_t)((l * 3 + ci) * 6 + sub * 3) * D + 16 * F.lane);
#pragma unroll
        for (int i = 0; i < 4; ++i) { const f32x4 v = sp[i]; sh[ci][4 * i] = v.x; sh[ci][4 * i + 1] = v.y; sh[ci][4 * i + 2] = v.z; sh[ci][4 * i + 3] = v.w; } }
    const int nend = n1 < N ? n1 : N;
    for (int n = gw; n < nend; n += NGW) { const GAS u32x4* wp = (const GAS u32x4*)(Wt + (size_t)n * D + 16 * F.lane); const u32x4 w0 = wp[0], w1 = wp[1];
        const unsigned ww[8] = {w0.x, w0.y, w0.z, w0.w, w1.x, w1.y, w1.z, w1.w};
        float d0 = 0.f, d1 = 0.f, d2 = 0.f;
#pragma unroll
        for (int i = 0; i < 8; ++i) { const float lo = bf2f(ww[i]), hi = bf2f(ww[i] >> 16); d0 += sh[0][2 * i] * lo + sh[0][2 * i + 1] * hi; d1 += sh[1][2 * i] * lo + sh[1][2 * i + 1] * hi; d2 += sh[2][2 * i] * lo + sh[2][2 * i + 1] * hi; }
        d0 = wave_sum(d0); d1 = wave_sum(d1); d2 = wave_sum(d2);
        if (F.lane == 0) { outp[n] = d0; outp[(size_t)N + n] = d1; outp[(size_t)2 * N + n] = d2; } }
}
__device__ __forceinline__ void bias2_item(Frame& F, int slot, int chunk) {
    const int n0 = chunk * 64 + F.wave, n1 = chunk * 64 + 64;
    if (slot == 1) bias2_gemm(F, F.WT + WE_UP, 2 * DFF, 0, 1, F.bias2 + B2_UP, n0, 8, n1);
    else if (slot == 2) bias2_gemm(F, F.WT + WE_CM_IN, 2 * DB, 1, 0, F.bias2 + B2_CM, n0, 8, n1);
    else if (slot == 3) bias2_gemm(F, F.WT + WE_UP + (size_t)1 * 2 * DFF * D, 2 * DFF, 1, 1, F.bias2 + B2_UP + (size_t)1 * 3 * 5632, n0, 8, n1);
    else if (slot == 4) bias2_gemm(F, F.WT + WE_QKV, 3 * D, 2, 0, F.bias2 + B2_QKV, n0, 8, n1);
    else if (slot == 5) bias2_gemm(F, F.WT + WE_UP + (size_t)2 * 2 * DFF * D, 2 * DFF, 2, 1, F.bias2 + B2_UP + (size_t)2 * 3 * 5632, n0, 8, n1);
    else if (slot == 6) bias2_gemm(F, F.WT + WE_LRU_IN + (size_t)2 * DRNN * D, 2 * DRNN, 3, 0, F.bias2 + B2_LRU + 3 * 2560, n0, 8, n1);
    else if (slot == 7) bias2_gemm(F, F.WT + WE_UP + (size_t)3 * 2 * DFF * D, 2 * DFF, 3, 1, F.bias2 + B2_UP + (size_t)3 * 3 * 5632, n0, 8, n1);
}
__device__ __forceinline__ void side_job(Frame& F, int slot, int part = 0) {
    F.fresh();
    if (slot < 0 || (slot > 7 && slot != 9)) return;
    constexpr int I_UP1 = (D / 64) * (2 * DFF / 32), I_DN1 = (DFF / 64) * (D / 32), I_LIN = (D / 64) * (2 * DRNN / 32), I_LOUT = (DRNN / 64) * (D / 32),
                  I_CIN = (D / 64) * (2 * DB / 32), I_COUT = (DB / 64) * (D / 32), I_QKV = (D / 64) * (3 * D / 32), I_AOUT = (D / 64) * (D / 32);
    const int nb2 = part == 2 ? 0 : slot == 2 ? 2 * DB / 64 : slot == 4 ? 3 * D / 64 : slot == 6 ? 2 * DRNN / 64 : (slot == 1 || slot == 3 || slot == 5 || slot == 7) ? 2 * DFF / 64 : 0;
    const int nad = (slot == 0 ? part == 1 : part == 2) ? 0 : (slot == 0 || slot == 9 || slot == 2 || slot == 4) ? 6 * D / 64 : 0;
    constexpr int I_WG = 80 * 2 * 4;
    const int ncv = part == 1 ? 0 : (slot == 9 ? I_UP1 : slot == 0 ? I_LIN + I_LOUT + I_WG : slot == 1 ? I_CIN + I_DN1 : slot == 2 ? I_COUT + I_UP1 : slot == 3 ? I_DN1 + I_QKV + I_AOUT : slot == 4 ? I_UP1 : slot == 5 ? I_DN1 + I_LIN : slot == 6 ? I_LOUT + I_UP1 : I_DN1) / 8;
    const int total = nb2 + nad + ncv;
    unsigned* q = (unsigned*)(F.ws + WS_CTL) + CW_SJQ + 64 * slot + (part == 2 ? 32 : 0);
    volatile LAS unsigned* bc = (volatile LAS unsigned*)(F.lds + MISC_OFF) + 16;
    for (;;) {
        __syncthreads();
        if (F.tid == 0) bc[0] = __hip_atomic_fetch_add(q, 1u, __ATOMIC_RELAXED, __HIP_MEMORY_SCOPE_AGENT);
        __syncthreads();
        const int it = (int)bc[0];
        if (it >= total) break;
        if (it < nb2) bias2_item(F, slot, it);
        else if (it < nb2 + nad) adaln_layer(F, slot == 4 ? 3 : slot == 9 ? 1 : slot, it - nb2, 1 << 30);
        else { const int gw = (it - nb2 - nad) * 8 + F.wave;
            if (slot == 9) convert_slot<9>(F, gw, 1 << 30); else if (slot == 0) convert_slot<0>(F, gw, 1 << 30); else if (slot == 1) convert_slot<1>(F, gw, 1 << 30); else if (slot == 2) convert_slot<2>(F, gw, 1 << 30); else if (slot == 3) convert_slot<3>(F, gw, 1 << 30);
            else if (slot == 4) convert_slot<4>(F, gw, 1 << 30); else if (slot == 5) convert_slot<5>(F, gw, 1 << 30); else if (slot == 6) convert_slot<6>(F, gw, 1 << 30); else convert_slot<7>(F, gw, 1 << 30); }
    }
}
__device__ __forceinline__ void phase_prologue(Frame& F) {
    F.fresh();
    side_job(F, 0);
    F.fresh();
    const int gt = F.bid * NT + F.tid, GT = F.G * NT;
    for (int i = gt; i < 1024 * 32; i += GT) { const int t = i >> 5, j = i & 31; const float inv = powf(10000.f, -(float)(j & 15) / 16.f); const float pos = (float)(j < 16 ? (t >> 6) : (t & 63));
        const float ang = pos * inv; F.rope[i] = cosf(ang); F.rope[32768 + i] = sinf(ang); }
    for (int i = gt; i < 8 * 8 * 4 * 64; i += GT) { const int ln = i & 63, ks = (i >> 6) & 3, nf = (i >> 8) & 7, g = i >> 11, cq = ln >> 4, p = 16 * nf + (ln & 15);
        const float* wr = F.inp(I_CM_WS) + (size_t)(g * 128 + p) * 128 + 32 * ks + 4 * cq;
        u32x4 o; o.x = f2bf(wr[0]) | (f2bf(wr[1]) << 16); o.y = f2bf(wr[2]) | (f2bf(wr[3]) << 16); o.z = f2bf(wr[16]) | (f2bf(wr[17]) << 16); o.w = f2bf(wr[18]) | (f2bf(wr[19]) << 16);
        *(u32x4*)(F.WT + WE_WSB + (size_t)i * 8) = o; }
    for (int i8 = gt; i8 < 2 * PAST * D / 8; i8 += GT) { const int i = i8 * 8, b = i / (PAST * D), r = i % (PAST * D);
        const GAS f32x4* kp = (const GAS f32x4*)(F.inp(I_CK) + i); const GAS f32x4* vp = (const GAS f32x4*)(F.inp(I_CV) + i);
        const f32x4 k0 = kp[0], k1 = kp[1], v0 = vp[0], v1 = vp[1];
        u32x4 ko, vo; ko.x = f2bf(k0.x) | (f2bf(k0.y) << 16); ko.y = f2bf(k0.z) | (f2bf(k0.w) << 16); ko.z = f2bf(k1.x) | (f2bf(k1.y) << 16); ko.w = f2bf(k1.z) | (f2bf(k1.w) << 16);
        vo.x = f2bf(v0.x) | (f2bf(v0.y) << 16); vo.y = f2bf(v0.z) | (f2bf(v0.w) << 16); vo.z = f2bf(v1.x) | (f2bf(v1.y) << 16); vo.w = f2bf(v1.z) | (f2bf(v1.w) << 16);
        *(GAS u32x4*)(F.KS + (size_t)b * TKS * D + r) = ko; *(GAS u32x4*)(F.VS + (size_t)b * TKS * D + r) = vo; }
}

__device__ __forceinline__ void phase_modulate0(Frame& F) {
    F.fresh();
    const int gw = F.bid * NWAVES + F.wave, NGW = F.G * NWAVES;
    const float* g = F.inp(I_NORMG);
    for (int rb = gw; rb < M; rb += 5 * NGW) {
    f32x4 vv[5][4], cc[5][4], gg[4];
#pragma unroll
    for (int j = 0; j < 4; ++j) gg[j] = *(const GAS f32x4*)(g + 4 * F.lane + 256 * j);
#pragma unroll
    for (int k = 0; k < 5; ++k) { const int row = rb + k * NGW, rc = row < M ? row : M - 1; const float* xr = xin_row(F, rc); const float* scl = modp(F, 0, rc, 1);
#pragma unroll
        for (int j = 0; j < 4; ++j) { vv[k][j] = *(const GAS f32x4*)(xr + 4 * F.lane + 256 * j); cc[k][j] = *(const GAS f32x4*)(scl + 4 * F.lane + 256 * j); } }
#pragma unroll
    for (int k = 0; k < 5; ++k) { const int row = rb + k * NGW; if (row >= M) break;
        f32x4 (&v)[4] = vv[k]; float s = 0.f;
#pragma unroll
        for (int j = 0; j < 4; ++j) s += v[j].x * v[j].x + v[j].y * v[j].y + v[j].z * v[j].z + v[j].w * v[j].w;
        s = wave_sum(s);
        if (F.lane < 16) F.rsq0[(size_t)row * 16 + F.lane] = F.lane == 0 ? s : 0.f;
#pragma unroll
        for (int j = 0; j < 4; ++j) { const int c0 = 4 * F.lane + 256 * j;
            const f32x4 o = v[j] * gg[j] * (1.f + cc[k][j]); u32x2 w; w.x = f2bf(o.x) | (f2bf(o.y) << 16); w.y = f2bf(o.z) | (f2bf(o.w) << 16);
            *(GAS u32x2*)(F.H + (size_t)row * D + c0) = w;
            u32x2 xw; xw.x = f2bf(v[j].x) | (f2bf(v[j].y) << 16); xw.y = f2bf(v[j].z) | (f2bf(v[j].w) << 16);
            *(GAS u32x2*)((bf16*)(F.ws + WS_XB) + (size_t)row * D + c0) = xw; }
    }
    }
    bias2_gemm(F, F.WT + WE_LRU_IN, 2 * DRNN, 0, 0, F.bias2 + B2_LRU, gw, NGW);
}

template <class P>
__device__ __forceinline__ void gemm_naive(Frame& F, const P& p, int nbatch, int Mr, int N, int K) {
    F.fresh();
    LAS float* As = (LAS float*)F.lds;
    LAS float* Bs = As + 16 * 132;
    const int tid = F.tid, tx = tid & 31, ty = tid >> 5;
    const int tm = Mr / 128, tn = N / 128, per = tm * tn, total = per * nbatch;
    for (int t = F.bid; t < total; t += F.G) {
        const int b = t / per, r = t % per, pn = r / tm, pm = r % tm;
        const bf16* A; int lda; const float* W; int ldw; p.get(b, A, lda, W, ldw);
        float acc[8][4];
#pragma unroll
        for (int i = 0; i < 8; ++i)
#pragma unroll
            for (int j = 0; j < 4; ++j) acc[i][j] = 0.f;
        for (int k0 = 0; k0 < K; k0 += 16) {
            { const int row = tid >> 2, kq = (tid & 3) * 4;
              const u32x2 v = *(const u32x2*)(A + (size_t)(pm * 128 + row) * lda + k0 + kq);
              As[(kq + 0) * 132 + row] = bf2f(v.x); As[(kq + 1) * 132 + row] = bf2f(v.x >> 16); As[(kq + 2) * 132 + row] = bf2f(v.y); As[(kq + 3) * 132 + row] = bf2f(v.y >> 16); }
            { const int k = tid >> 5, n4 = (tid & 31) * 4;
              *(LAS f32x4*)(Bs + k * 128 + n4) = *(const f32x4*)(W + (size_t)(k0 + k) * ldw + pn * 128 + n4); }
            __syncthreads();
#pragma unroll 2
            for (int k = 0; k < 16; ++k) {
                const f32x4 a0 = *(const LAS f32x4*)(As + k * 132 + ty * 8), a1 = *(const LAS f32x4*)(As + k * 132 + ty * 8 + 4), bv = *(const LAS f32x4*)(Bs + k * 128 + tx * 4);
                const float a[8] = {a0.x, a0.y, a0.z, a0.w, a1.x, a1.y, a1.z, a1.w}; const float bb[4] = {bv.x, bv.y, bv.z, bv.w};
#pragma unroll
                for (int i = 0; i < 8; ++i)
#pragma unroll
                    for (int j = 0; j < 4; ++j) acc[i][j] += a[i] * bb[j];
            }
            __syncthreads();
        }
#pragma unroll
        for (int i = 0; i < 8; ++i)
#pragma unroll
            for (int j = 0; j < 4; ++j) p.epi(b, pm * 128 + ty * 8 + i, pn * 128 + tx * 4 + j, acc[i][j]);
    }
}

struct PStoreBf16 {
    const bf16* A; int lda; const float* W; int ldw; bf16* O; int ldo; const float* bias; int act; int split;
    __device__ __forceinline__ void get(int, const bf16*& a, int& la, const float*& w, int& lw) const { a = A; la = lda; w = W; lw = ldw; }
    __device__ __forceinline__ void epi(int, int row, int col, float v) const {
        if (bias) v += bias[col];
        if (act == 1 || (act == 2 && col < split)) v = gelu_tanh(v);
        O[(size_t)row * ldo + col] = (bf16)f2bf(v); }
};
struct PResid {
    const bf16* A; int lda; const float* W; int ldw; float* out; const float* xp; const float* xs; const float* modl; int which; bool from_input;
    __device__ __forceinline__ void get(int, const bf16*& a, int& la, const float*& w, int& lw) const { a = A; la = lda; w = W; lw = ldw; }
    __device__ __forceinline__ void epi(int, int row, int col, float v) const {
        const float base = from_input ? (row < NPROMPT ? xp[(size_t)row * D + col] : xs[(size_t)(row - NPROMPT) * D + col]) : out[(size_t)row * D + col];
        out[(size_t)row * D + col] = base + modl[(size_t)(cidx_of(row) * 6 + which) * D + col] * v; }
};
struct PLruIn {
    const bf16* A; const float* W; bf16* GBp; bf16* RECp;
    __device__ __forceinline__ void get(int, const bf16*& a, int& la, const float*& w, int& lw) const { a = A; la = D; w = W; lw = 2 * DRNN; }
    __device__ __forceinline__ void epi(int, int row, int col, float v) const {
        if (col < DRNN) GBp[(size_t)row * DRNN + col] = (bf16)f2bf(gelu_tanh(v)); else RECp[(size_t)row * DRNN + col - DRNN] = (bf16)f2bf(v); }
};
struct PGates {
    const bf16* XC; const float* WG; const float* BG; bf16* O;
    __device__ __forceinline__ void get(int b, const bf16*& a, int& la, const float*& w, int& lw) const { a = XC + (b % 10) * 128; la = DRNN; w = WG + (size_t)b * 128 * 128; lw = 128; }
    __device__ __forceinline__ void epi(int b, int row, int col, float v) const { const int dg = b / 10, n = b % 10;
        O[((size_t)dg * M + row) * DRNN + n * 128 + col] = (bf16)f2bf(sigmoidf_(v + BG[dg * DRNN + n * 128 + col])); }
};

__device__ __forceinline__ void phase_lru_conv(Frame& F, int j, const bf16* REC, bf16* XC) {
    F.fresh();
    const float* cw = F.inp(I_LRU_CW) + (size_t)j * 4 * DRNN; const float* cb = F.inp(I_LRU_CB) + (size_t)j * DRNN;
    const int gt = F.bid * NT + F.tid, GT = F.G * NT;
    for (int i = gt; i < M * DRNN; i += GT) { const int row = i / DRNN, ch = i % DRNN;
        int t, T; if (row < NPROMPT) { t = row & 255; T = 256; } else { t = (row - NPROMPT) & 1023; T = 1024; }
        float s = cb[ch];
#pragma unroll
        for (int k = 0; k < 4; ++k) { const int tt = t + k - 2; if (tt >= 0 && tt < T) s += cw[k * DRNN + ch] * bf2f(REC[(size_t)(row + k - 2) * DRNN + ch]); }
        XC[i] = (bf16)f2bf(s); }
}
__device__ __forceinline__ void phase_lru_scan(Frame& F, int j, const bf16* GATES, const bf16* XC, const bf16* GB, bf16* HS) {
    F.fresh();
    const int gt = F.bid * NT + F.tid, GT = F.G * NT;
    const int NL = (2 + 32) * DRNN;
    for (int line = gt; line < NL; line += GT) {
        const int s = line / DRNN, ch = line % DRNN;
        int base, T; float h0f = 0.f, h0b = 0.f;
        if (s < 2) { base = NPROMPT + s * 1024; T = 1024; h0f = F.inp(I_STATE)[((size_t)(s * 2 + j) * 2 + 0) * DRNN + ch]; h0b = F.inp(I_STATE)[((size_t)(s * 2 + j) * 2 + 1) * DRNN + ch]; }
        else { base = (s - 2) * 256; T = 256; }
        const float spf = softplusf_(-F.inp(I_LRU_LAM)[(size_t)(j * 2 + 0) * DRNN + ch]), spb = softplusf_(-F.inp(I_LRU_LAM)[(size_t)(j * 2 + 1) * DRNN + ch]);
        float h = h0f;
        for (int t = 0; t < T; ++t) { const size_t o = (size_t)(base + t) * DRNN + ch;
            const float r = bf2f(GATES[o]), ig = bf2f(GATES[(size_t)M * DRNN + o]), xc = bf2f(XC[o]);
            const float la = -8.f * r * spf, a = expf(la), bx = sqrtf(-expm1f(2.f * la)) * (ig * xc);
            h = a * h + bx; HS[o] = (bf16)f2bf(h); }
        const float ff = h;
        h = h0b;
        for (int t = T - 1; t >= 0; --t) { const size_t o = (size_t)(base + t) * DRNN + ch;
            const float r = bf2f(GATES[(size_t)2 * M * DRNN + o]), ig = bf2f(GATES[(size_t)3 * M * DRNN + o]), xc = bf2f(XC[o]);
            const float la = -8.f * r * spb, a = expf(la), bx = sqrtf(-expm1f(2.f * la)) * (ig * xc);
            h = a * h + bx; HS[o] = (bf16)f2bf(bf2f(GB[o]) * (bf2f(HS[o]) + h)); }
        if (s >= 2) { float* st = F.out + O_STATE + ((size_t)((s - 2) * 2 + j) * 2) * DRNN; st[ch] = ff; st[DRNN + ch] = h; }
    }
}


typedef short bf16x8 __attribute__((ext_vector_type(8)));
typedef short v4i16_t __attribute__((ext_vector_type(4)));
constexpr int LRU_XS = 272;
constexpr int LRU_XC_OFF = 0, LRU_GB_OFF = 256 * LRU_XS;
template <bool REV>
__device__ __forceinline__ float lru_dir(LAS const unsigned char* xct, LAS unsigned char* hft, const bf16* wgt  ,
                                         const bf16* gbp  , float br, float bi, float sp, float hc, int wave, int lane, bool wantp, bf16* Pdst, float& decay) {
    const int c = lane & 15, q = lane >> 4, qq = REV ? 3 - q : q;
    bf16x8 Br[4], Bi[4], Id;
#pragma unroll
    for (int ks = 0; ks < 4; ++ks) { Br[ks] = *(const GAS bf16x8*)(wgt + (size_t)(16 * wave + c) * 128 + 32 * ks + 8 * q);
                                     Bi[ks] = *(const GAS bf16x8*)(wgt + (size_t)10 * 128 * 128 + (size_t)(16 * wave + c) * 128 + 32 * ks + 8 * q); }
#pragma unroll
    for (int jj = 0; jj < 8; ++jj) Id[jj] = (8 * q + jj == 16 * (wave & 1) + c) ? (short)0x3F80 : (short)0;
    const int ksel = wave >> 1;
    const float nsp8 = -8.f * sp * 1.44269504f;
    const float brs = -1.44269504f * br, bis = -1.44269504f * bi;
    float Pc = 1.f;
    unsigned short gcur[16], gnxt[16];
#pragma unroll
    for (int i = 0; i < 16; ++i) { gcur[i] = 0; gnxt[i] = 0; }
    if (REV) {
#pragma unroll
        for (int i = 0; i < 16; ++i) gcur[i] = *(const GAS unsigned short*)(gbp + (size_t)(16 * (12 + (i >> 2)) + 4 * q + (i & 3)) * DRNN); }
    f32x4 r, ig, xc;
#define LRU_STAGE_A(MI, R_, I_, X_) do { LAS const unsigned char* rp_ = xct + (16 * (MI) + c) * LRU_XS + 16 * q; bf16x8 Af_[4]; \
        _Pragma("unroll") for (int ks = 0; ks < 4; ++ks) Af_[ks] = *(LAS const bf16x8*)(rp_ + 64 * ks); \
        const bf16x8 Ax_ = *(LAS const bf16x8*)(rp_ + 64 * ksel); \
        R_ = (f32x4){0.f, 0.f, 0.f, 0.f}; I_ = (f32x4){0.f, 0.f, 0.f, 0.f}; \
        _Pragma("unroll") for (int ks = 0; ks < 4; ++ks) { R_ = __builtin_amdgcn_mfma_f32_16x16x32_bf16(Af_[ks], Br[ks], R_, 0, 0, 0); I_ = __builtin_amdgcn_mfma_f32_16x16x32_bf16(Af_[ks], Bi[ks], I_, 0, 0, 0); } \
        X_ = __builtin_amdgcn_mfma_f32_16x16x32_bf16(Ax_, Id, (f32x4){0.f, 0.f, 0.f, 0.f}, 0, 0, 0); } while (0)
    LRU_STAGE_A(REV ? 15 : 0, r, ig, xc);
#pragma unroll 1
    for (int og = 0; og < 4; ++og) {
        if (REV && og < 3) {
#pragma unroll
            for (int i = 0; i < 16; ++i) gnxt[i] = *(const GAS unsigned short*)(gbp + (size_t)(16 * (4 * (2 - og) + (i >> 2)) + 4 * q + (i & 3)) * DRNN); }
#pragma unroll
        for (int ii = 0; ii < 4; ++ii) {
        const int it = 4 * og + ii, mi = REV ? 15 - it : it, mloc = REV ? 3 - ii : ii;
        f32x4 rn = r, ign = ig, xcn = xc;
        if (it < 15) { const int min_ = REV ? 14 - it : it + 1; LRU_STAGE_A(min_, rn, ign, xcn); }
        float av[4], bv[4];
        {
          const f32x4 tr = r * -1.44269504f + brs, ti = ig * -1.44269504f + bis; f32x4 er, ei, rg, iv, a4, sq;
#pragma unroll
          for (int k = 0; k < 4; ++k) { er[k] = __builtin_amdgcn_exp2f(tr[k]); ei[k] = __builtin_amdgcn_exp2f(ti[k]); }
          const f32x4 dr = er + 1.f, di = ei + 1.f;
#pragma unroll
          for (int k = 0; k < 4; ++k) { rg[k] = __builtin_amdgcn_rcpf(dr[k]); iv[k] = __builtin_amdgcn_rcpf(di[k]); }
          const f32x4 l2a = rg * nsp8;
#pragma unroll
          for (int k = 0; k < 4; ++k) a4[k] = __builtin_amdgcn_exp2f(l2a[k]);
          const f32x4 om = 1.f - a4 * a4;
#pragma unroll
          for (int k = 0; k < 4; ++k) sq[k] = __builtin_amdgcn_sqrtf(fmaxf(om[k], 0.f));
          const f32x4 b4 = sq * (iv * xc);
#pragma unroll
          for (int k = 0; k < 4; ++k) { av[k] = a4[k]; bv[k] = b4[k]; } }
        float pA[4], pB[4];
#pragma unroll
        for (int kk = 0; kk < 4; ++kk) { const int k = REV ? 3 - kk : kk;
            if (kk == 0) { pA[k] = av[k]; pB[k] = bv[k]; } else { const int kp = REV ? k + 1 : k - 1; pA[k] = pA[kp] * av[k]; pB[k] = pB[kp] * av[k] + bv[k]; } }
        const int kl = REV ? 0 : 3;
        float gA[4], gB[4];
#pragma unroll
        for (int g = 0; g < 4; ++g) { const int src = 16 * (REV ? 3 - g : g) + c; gA[g] = bperm(pA[kl], src); gB[g] = bperm(pB[kl], src); }
        float eA = 1.f, eB = 0.f, tA = 1.f, tB = 0.f;
#pragma unroll
        for (int g = 0; g < 4; ++g) { if (g == qq) { eA = tA; eB = tB; } tB = tB * gA[g] + gB[g]; tA = tA * gA[g]; }
        const float hin = eA * hc + eB;
        float hv[4];
#pragma unroll
        for (int k = 0; k < 4; ++k) { hv[k] = pA[k] * hin + pB[k];
            if (REV) { LAS const unsigned short* hp = (LAS const unsigned short*)(hft + (16 * mi + 4 * q + k) * LRU_XS + 2 * (16 * wave + c)); hv[k] = bf2f(gcur[4 * mloc + k]) * (bf2f(*hp) + hv[k]); } }
        { const unsigned w01 = pg8::cvt_pk_bf16(hv[0], hv[1]), w23 = pg8::cvt_pk_bf16(hv[2], hv[3]);
          LAS unsigned short* hp = (LAS unsigned short*)(hft + (16 * mi + 4 * q) * LRU_XS + 2 * (16 * wave + c));
          hp[0] = (unsigned short)w01; hp[LRU_XS / 2] = (unsigned short)(w01 >> 16); hp[LRU_XS] = (unsigned short)w23; hp[3 * LRU_XS / 2] = (unsigned short)(w23 >> 16); }
        if (wantp) { const float pe = eA * Pc; const unsigned p01 = pg8::cvt_pk_bf16(pA[0] * pe, pA[1] * pe), p23 = pg8::cvt_pk_bf16(pA[2] * pe, pA[3] * pe);
          bf16* pp = Pdst + (size_t)(16 * mi + 4 * q) * DRNN; pp[0] = (bf16)p01; pp[DRNN] = (bf16)(p01 >> 16); pp[2 * DRNN] = (bf16)p23; pp[3 * DRNN] = (bf16)(p23 >> 16); }
        hc = tA * hc + tB; Pc *= tA;
        r = rn; ig = ign; xc = xcn;
        }
        if (REV) {
#pragma unroll
            for (int i = 0; i < 16; ++i) gcur[i] = gnxt[i]; }
    }
#undef LRU_STAGE_A
    decay = Pc;
    return hc;
}
__device__ __forceinline__ void lru_unit(Frame& F, int j, int pm, int n, const bf16* REC, const bf16* GB, bf16* HS, bf16* PF, bf16* PB, float* AGG, unsigned* cnt, const bf16* WGT) {
    const int tid = F.tid, lane = F.lane, wave = F.wave, r0 = 256 * pm;
    const bool smp = pm >= 32; const int tix = smp ? (pm - 32) & 3 : 0, sq = smp ? (pm - 32) >> 2 : 0;
    const int t0 = smp ? 256 * tix : 0, T = smp ? 1024 : 256;
    LAS unsigned char* xct = F.lds + LRU_XC_OFF; LAS unsigned char* hft = F.lds + LRU_GB_OFF;
    { const float* cw = F.inp(I_LRU_CW) + (size_t)j * 4 * DRNN + n * 128 + 2 * lane; const float* cb = F.inp(I_LRU_CB) + (size_t)j * DRNN + n * 128 + 2 * lane;
      float w0[4], w1[4];
#pragma unroll
      for (int k = 0; k < 4; ++k) { w0[k] = cw[k * DRNN]; w1[k] = cw[k * DRNN + 1]; }
      const float b0 = cb[0], b1 = cb[1];
      unsigned v[35];
#pragma unroll
      for (int i = 0; i < 35; ++i) { const int tl = 32 * wave + i - 2, tt = t0 + tl;
          v[i] = (tt >= 0 && tt < T) ? *(const GAS unsigned*)(REC + (size_t)(r0 + tl) * DRNN + n * 128 + 2 * lane) : 0u; }
#pragma unroll
      for (int i = 0; i < 32; ++i) { float s0 = b0, s1 = b1;
#pragma unroll
          for (int k = 0; k < 4; ++k) { s0 += w0[k] * bf2f(v[i + k]); s1 += w1[k] * bf2f(v[i + k] >> 16); }
          *(LAS unsigned*)(xct + (32 * wave + i) * LRU_XS + 4 * lane) = f2bf(s0) | (f2bf(s1) << 16); } }
    __syncthreads();
    const int c = lane & 15, q = lane >> 4, ch = n * 128 + 16 * wave + c;
    const float* bg = F.inp(I_LRU_BG) + (size_t)j * 4 * DRNN; const float* lam = F.inp(I_LRU_LAM) + (size_t)j * 2 * DRNN;
    const bf16* gbp = GB + (size_t)r0 * DRNN + ch;
    bf16* pf = PF + (size_t)(smp ? r0 - NPROMPT : 0) * DRNN + ch; bf16* pb = PB + (size_t)(smp ? r0 - NPROMPT : 0) * DRNN + ch;
    { float h0 = 0.f; if (smp && tix == 0) h0 = F.inp(I_STATE)[((size_t)(sq * 2 + j) * 2 + 0) * DRNN + ch];
      float dec;
      const float hfin = lru_dir<false>(xct, hft, WGT + (size_t)(0 * 10 + n) * 128 * 128, gbp, bg[0 * DRNN + ch], bg[1 * DRNN + ch], softplusf_(-lam[ch]), h0, wave, lane, smp, pf, dec);
      if (q == 0) { if (smp) { float* ag = AGG + (size_t)(((sq * 4 + tix) * 2 + 0) * 2) * DRNN + ch; __hip_atomic_store(ag, hfin, __ATOMIC_RELAXED, __HIP_MEMORY_SCOPE_AGENT); __hip_atomic_store(ag + DRNN, dec, __ATOMIC_RELAXED, __HIP_MEMORY_SCOPE_AGENT); }
                    else F.out[O_STATE + ((size_t)(pm * 2 + j) * 2 + 0) * DRNN + ch] = hfin; } }
    { float h0 = 0.f; if (smp && tix == 3) h0 = F.inp(I_STATE)[((size_t)(sq * 2 + j) * 2 + 1) * DRNN + ch];
      float dec;
      const float hfin = lru_dir<true>(xct, hft, WGT + (size_t)(2 * 10 + n) * 128 * 128, gbp, bg[2 * DRNN + ch], bg[3 * DRNN + ch], softplusf_(-lam[DRNN + ch]), h0, wave, lane, smp, pb, dec);
      if (q == 0) { if (smp) { float* ag = AGG + (size_t)(((sq * 4 + tix) * 2 + 1) * 2) * DRNN + ch; __hip_atomic_store(ag, hfin, __ATOMIC_RELAXED, __HIP_MEMORY_SCOPE_AGENT); __hip_atomic_store(ag + DRNN, dec, __ATOMIC_RELAXED, __HIP_MEMORY_SCOPE_AGENT); }
                    else F.out[O_STATE + ((size_t)(pm * 2 + j) * 2 + 1) * DRNN + ch] = hfin; } }
    if (smp) {
        asm volatile("s_waitcnt vmcnt(0)" ::: "memory");
        __syncthreads();
        if (tid == 0) { unsigned* cp = cnt + 64 * ((j * 2 + sq) * 10 + n);
            __hip_atomic_fetch_add(cp, 1u, __ATOMIC_RELAXED, __HIP_MEMORY_SCOPE_AGENT);
            unsigned sp_ = 0; while (__hip_atomic_load(cp, __ATOMIC_RELAXED, __HIP_MEMORY_SCOPE_AGENT) < 4u) { __builtin_amdgcn_s_sleep(2); if (++sp_ > (1u << 20)) break; }
            __builtin_amdgcn_fence(__ATOMIC_ACQUIRE, "agent"); asm volatile("s_waitcnt vmcnt(0)" ::: "memory"); }
        __syncthreads();
        LAS float* cfb = (LAS float*)(F.lds + LRU_GB_OFF + 256 * LRU_XS);
        if (tid < 128) { const int chn = n * 128 + tid; float cf = 0.f, cbk = 0.f;
            for (int t = 0; t < tix; ++t) { const float* ag = AGG + (size_t)(((sq * 4 + t) * 2 + 0) * 2) * DRNN + chn;
                cf = __hip_atomic_load(ag + DRNN, __ATOMIC_RELAXED, __HIP_MEMORY_SCOPE_AGENT) * cf + __hip_atomic_load(ag, __ATOMIC_RELAXED, __HIP_MEMORY_SCOPE_AGENT); }
            for (int t = 3; t > tix; --t) { const float* ag = AGG + (size_t)(((sq * 4 + t) * 2 + 1) * 2) * DRNN + chn;
                cbk = __hip_atomic_load(ag + DRNN, __ATOMIC_RELAXED, __HIP_MEMORY_SCOPE_AGENT) * cbk + __hip_atomic_load(ag, __ATOMIC_RELAXED, __HIP_MEMORY_SCOPE_AGENT); }
            cfb[tid] = cf; cfb[128 + tid] = cbk; }
        __syncthreads();
#pragma unroll 2
        for (int i = 0; i < 8; ++i) { const int id = i * NT + tid, row = id >> 4, cc = id & 15;
            const size_t go = (size_t)(r0 + row) * DRNN + n * 128 + 8 * cc, po = (size_t)(r0 - NPROMPT + row) * DRNN + n * 128 + 8 * cc;
            const u32x4 g4 = *(const GAS u32x4*)(GB + go), f4 = *(const GAS u32x4*)(PF + po), b4 = *(const GAS u32x4*)(PB + po); u32x4 h4 = *(LAS const u32x4*)(hft + row * LRU_XS + 16 * cc);
            const unsigned gg[4] = {g4.x, g4.y, g4.z, g4.w}, ff[4] = {f4.x, f4.y, f4.z, f4.w}, bb[4] = {b4.x, b4.y, b4.z, b4.w}; unsigned hh[4] = {h4.x, h4.y, h4.z, h4.w};
#pragma unroll
            for (int e = 0; e < 4; ++e) { const int c0 = 8 * cc + 2 * e;
                const float lo = bf2f(hh[e]) + bf2f(gg[e]) * (bf2f(ff[e]) * cfb[c0] + bf2f(bb[e]) * cfb[128 + c0]), hi = bf2f(hh[e] >> 16) + bf2f(gg[e] >> 16) * (bf2f(ff[e] >> 16) * cfb[c0 + 1] + bf2f(bb[e] >> 16) * cfb[128 + c0 + 1]);
                hh[e] = pg8::cvt_pk_bf16(lo, hi); }
            *(LAS u32x4*)(hft + row * LRU_XS + 16 * cc) = (u32x4){hh[0], hh[1], hh[2], hh[3]}; }
    }
    __syncthreads();
#pragma unroll
    for (int i = 0; i < 8; ++i) { const int id = i * NT + tid, row = id >> 4, cc = id & 15;
        *(GAS u32x4*)(HS + (size_t)(r0 + row) * DRNN + n * 128 + 8 * cc) = *(LAS const u32x4*)(hft + row * LRU_XS + 16 * cc); }
    __syncthreads();
}
__device__ __forceinline__ void phase_lru_core(Frame& F, int j, const bf16* REC, const bf16* GB, bf16* HS, bf16* PF, bf16* PB, float* AGG, unsigned* cnt, const bf16* WGT) {
    F.fresh();
    for (int s_ = 0; ; ++s_) { int pm, n;
        if (F.G == 256) { if (F.bid >= 176) { if (s_ > 0) break; pm = 32 + (F.bid - 176) / 10; n = (F.bid - 176) % 10; }
                          else { if (s_ > 1 || (s_ == 1 && F.bid >= 144)) break; const int u = s_ ? 176 + F.bid : F.bid; pm = u / 10; n = u % 10; } }
        else { const int u = F.bid + s_ * F.G; if (u >= 400) break; pm = u < 80 ? 32 + u / 10 : (u - 80) / 10; n = u % 10; }
        lru_unit(F, j, pm, n, REC, GB, HS, PF, PB, AGG, cnt, WGT); }
}
__device__ __forceinline__ void phase_lru_fixup(Frame& F, const bf16* GB, bf16* HS, const bf16* PF, const bf16* PB, const float* AGG) {
    F.fresh();
    const int gt = F.bid * NT + F.tid, GT = F.G * NT;
    for (int i = gt; i < NSAMPLE * DRNN; i += GT) { const int rs = i / DRNN, ch = i % DRNN, sq = rs >> 10, tix = (rs >> 8) & 3;
        float cf = 0.f, cbk = 0.f;
        if (tix > 0) { for (int t = 0; t < tix; ++t) { const float At = bf2f(PF[(size_t)(sq * 1024 + t * 256 + 255) * DRNN + ch]); cf = At * cf + AGG[(size_t)((sq * 4 + t) * 2 + 0) * DRNN + ch]; } }
        if (tix < 3) { for (int t = 3; t > tix; --t) { const float At = bf2f(PB[(size_t)(sq * 1024 + t * 256) * DRNN + ch]); cbk = At * cbk + AGG[(size_t)((sq * 4 + t) * 2 + 1) * DRNN + ch]; } }
        const size_t o = (size_t)(NPROMPT + rs) * DRNN + ch;
        HS[o] = (bf16)f2bf(bf2f(HS[o]) + bf2f(GB[o]) * (bf2f(PF[(size_t)rs * DRNN + ch]) * cf + bf2f(PB[(size_t)rs * DRNN + ch]) * cbk)); }
}

__device__ __forceinline__ void phase_cmlp_rstd(Frame& F, const bf16* UV) {
    F.fresh();
    const int gw = F.bid * NWAVES + F.wave, NGW = F.G * NWAVES;
    for (int row = gw; row < M; row += NGW) { float s = 0.f;
        for (int c = F.lane; c < DB; c += 64) { const float v = bf2f(UV[(size_t)row * 2 * DB + DB + c]); s += v * v; }
        s = wave_sum(s); if (F.lane == 0) F.rstd[row] = rsqrtf(s * (1.f / DB) + EPS); }
}
__device__ __forceinline__ void phase_cmlp_spatial(Frame& F, const bf16* UV, bf16* ACT) {
    F.fresh();
    const float* ws = F.inp(I_CM_WS); const float* bs = F.inp(I_CM_BS); const float* ng = F.inp(I_CM_NG);
    const int gt = F.bid * NT + F.tid, GT = F.G * NT;
    for (int i = gt; i < M * DB; i += GT) { const int row = i / DB, ch = i % DB, g = ch >> 8, p = row & 127, r0 = row & ~127;
        float s = 0.f;
        for (int q = 0; q < 128; ++q) s += ws[(size_t)(g * 128 + p) * 128 + q] * F.rstd[r0 + q] * bf2f(UV[(size_t)(r0 + q) * 2 * DB + DB + ch]);
        const float sv = s * ng[ch] + bs[g * 128 + p];
        ACT[i] = (bf16)f2bf(bf2f(UV[(size_t)row * 2 * DB + ch]) * sv); }
}


constexpr int CM_VS = 544;
__device__ __forceinline__ void phase_cmlp_spatial_mfma(Frame& F, const bf16* UV, bf16* ACT, const bf16* WSB) {
    F.fresh();
    const int tid = F.tid, lane = F.lane, wave = F.wave, c = lane & 15, q4 = lane >> 4;
    LAS unsigned char* vt = F.lds;
    const float* ng = F.inp(I_CM_NG); const float* bs = F.inp(I_CM_BS);
    f32x4 pq[8]; u32x4 px[8];
#define CM_PREFETCH(u_) do { const int ch_ = (u_) >> 3, g_ = (u_) & 7, r_ = ch_ * 128; \
        if (tid < 128) { const GAS f32x4* p_ = (const GAS f32x4*)(F.rsqv + (size_t)(r_ + tid) * 32); _Pragma("unroll") for (int i = 0; i < 8; ++i) pq[i] = p_[i]; } \
        _Pragma("unroll") for (int i = 0; i < 8; ++i) { const int id = i * NT + tid, row = id >> 5, cc = id & 31; px[i] = *(const GAS u32x4*)(UV + (size_t)(r_ + row) * 2 * DB + DB + g_ * 256 + 8 * cc); } } while (0)
    if (F.bid < 640) CM_PREFETCH(F.bid);
    for (int u = F.bid; u < 640; u += F.G) {
        const int chunk = u >> 3, g = u & 7, r0 = chunk * 128;
        LAS float* rsl = (LAS float*)(vt + 128 * CM_VS);
        if (tid < 128) { float sm = 0.f;
#pragma unroll
            for (int i = 0; i < 8; ++i) { const f32x4 t4 = pq[i]; sm += (t4.x + t4.y) + (t4.z + t4.w); }
            rsl[tid] = rsqrtf(sm * (1.f / DB) + EPS); }
        __syncthreads();
#pragma unroll
        for (int i = 0; i < 8; ++i) { const int id = i * NT + tid, row = id >> 5, cc = id & 31;
            const u32x4 x = px[i]; const float rs = rsl[row];
            u32x4 y; y.x = f2bf(bf2f(x.x) * rs) | (f2bf(bf2f(x.x >> 16) * rs) << 16); y.y = f2bf(bf2f(x.y) * rs) | (f2bf(bf2f(x.y >> 16) * rs) << 16);
            y.z = f2bf(bf2f(x.z) * rs) | (f2bf(bf2f(x.z >> 16) * rs) << 16); y.w = f2bf(bf2f(x.w) * rs) | (f2bf(bf2f(x.w >> 16) * rs) << 16);
            *(LAS u32x4*)(vt + row * CM_VS + 16 * cc) = y; }
        __syncthreads();
        if (u + F.G < 640) CM_PREFETCH(u + F.G);
        bf16x8 vf[2][4];
#pragma unroll
        for (int mfc = 0; mfc < 2; ++mfc)
#pragma unroll
            for (int ks = 0; ks < 4; ++ks) { LAS const unsigned char* vp = vt + (32 * ks + 4 * q4 + (c >> 2)) * CM_VS + (32 * wave + 8 * (c & 3) + 4 * mfc) * 2;
                const v4i16_t lo = __builtin_amdgcn_ds_read_tr16_b64_v4i16((LAS v4i16_t*)vp), hi = __builtin_amdgcn_ds_read_tr16_b64_v4i16((LAS v4i16_t*)(vp + 16 * CM_VS));
                vf[mfc][ks] = (bf16x8){lo[0], lo[1], lo[2], lo[3], hi[0], hi[1], hi[2], hi[3]}; }
        f32x4 g4[2];
#pragma unroll
        for (int mfc = 0; mfc < 2; ++mfc) g4[mfc] = *(const GAS f32x4*)(ng + g * 256 + 32 * wave + 8 * q4 + 4 * mfc);
        bf16x8 Bf[2][4]; u32x2 uu[2][2]; float bsv[2];
#define CM_LOADNF(nf_, sl_) do { _Pragma("unroll") for (int ks = 0; ks < 4; ++ks) Bf[sl_][ks] = *(const GAS bf16x8*)(WSB + ((size_t)((g * 8 + (nf_)) * 4 + ks) * 64 + lane) * 8); \
            bsv[sl_] = bs[g * 128 + 16 * (nf_) + c]; \
            { const u32x4 u4_ = *(const GAS u32x4*)(UV + (size_t)(r0 + 16 * (nf_) + c) * 2 * DB + g * 256 + 32 * wave + 8 * q4); uu[sl_][0] = (u32x2){u4_.x, u4_.y}; uu[sl_][1] = (u32x2){u4_.z, u4_.w}; } } while (0)
        CM_LOADNF(0, 0);
#pragma unroll
        for (int nf = 0; nf < 8; ++nf) { const int sl = nf & 1;
            if (nf + 1 < 8) CM_LOADNF(nf + 1, sl ^ 1);
            const int p = 16 * nf + c; u32x2 wq[2];
#pragma unroll
            for (int mfc = 0; mfc < 2; ++mfc) { f32x4 acc = {0.f, 0.f, 0.f, 0.f};
#pragma unroll
                for (int ks = 0; ks < 4; ++ks) acc = __builtin_amdgcn_mfma_f32_16x16x32_bf16(vf[mfc][ks], Bf[sl][ks], acc, 0, 0, 0);
                const u32x2 u2 = uu[sl][mfc]; const float bv = bsv[sl];
                const float o0 = bf2f(u2.x) * (acc[0] * g4[mfc].x + bv), o1 = bf2f(u2.x >> 16) * (acc[1] * g4[mfc].y + bv), o2 = bf2f(u2.y) * (acc[2] * g4[mfc].z + bv), o3 = bf2f(u2.y >> 16) * (acc[3] * g4[mfc].w + bv);
                wq[mfc].x = f2bf(o0) | (f2bf(o1) << 16); wq[mfc].y = f2bf(o2) | (f2bf(o3) << 16); }
            *(GAS u32x4*)(ACT + (size_t)(r0 + p) * DB + g * 256 + 32 * wave + 8 * q4) = (u32x4){wq[0].x, wq[0].y, wq[1].x, wq[1].y};
        }
        __syncthreads();
    }
}

__device__ __forceinline__ void phase_qkv_post(Frame& F, const bf16* QKV, bf16* Q, bf16* KP, bf16* VP) {
    F.fresh();
    const int gw = F.bid * NWAVES + F.wave, NGW = F.G * NWAVES;
    const float* qkg = F.inp(I_AT_QKG);
    for (int row = gw; row < M; row += NGW) {
        const bool smp = row >= NPROMPT; const int sb = smp ? (row - NPROMPT) >> 10 : 0, t = smp ? (row - NPROMPT) & 1023 : 0;
        const float cs = smp ? F.rope[t * 32 + (F.lane & 31)] : 1.f, sn = smp ? F.rope[32768 + t * 32 + (F.lane & 31)] : 0.f;
        for (int grp = 0; grp < 32; ++grp) {
            const float v = bf2f(QKV[(size_t)row * 3072 + grp * 64 + F.lane]);
            const float ms = wave_sum(v * v) * (1.f / 64.f);
            float n = v * rsqrtf(ms + EPS) * qkg[(grp >> 4) * 64 + F.lane];
            const float keep = n;
            if (smp) { float pr; { auto r_ = __builtin_amdgcn_permlane32_swap(__builtin_bit_cast(unsigned, n), __builtin_bit_cast(unsigned, n), false, false); pr = __builtin_bit_cast(float, F.lane < 32 ? (unsigned)r_[1] : (unsigned)r_[0]); } n = F.lane < 32 ? n * cs - pr * sn : n * cs + pr * sn; }
            if (grp < 16) Q[(size_t)row * D + grp * 64 + F.lane] = (bf16)f2bf(n);
            else { const int c = (grp - 16) * 64 + F.lane;
                if (smp) F.KS[((size_t)sb * TKS + PAST + t) * D + c] = (bf16)f2bf(n);
                else { KP[(size_t)row * D + c] = (bf16)f2bf(keep); F.out[O_CK + (size_t)row * D + c] = keep; } }
        }
        for (int c = F.lane; c < D; c += 64) { const bf16 vb = QKV[(size_t)row * 3072 + 2048 + c];
            if (smp) F.VS[((size_t)sb * TKS + PAST + t) * D + c] = vb; else { VP[(size_t)row * D + c] = vb; F.out[O_CV + (size_t)row * D + c] = bf2f(vb); } }
    }
}
__device__ __forceinline__ void phase_attn_naive(Frame& F, int l, const bf16* Q, const bf16* KP, const bf16* VP, bf16* O) {
    F.fresh();
    const int gw = F.bid * NWAVES + F.wave, NGW = F.G * NWAVES;
    LAS float* s1 = (LAS float*)F.lds + F.wave * 3328; LAS float* s2 = s1 + 1536; LAS float* qs = s2 + 1536;
    const float* al = F.inp(I_AT_LAM);
    const float lam_init = 0.8f - 0.6f * expf(-0.3f * (float)l);
    const float lam = expf(wave_sum(al[F.lane] * al[64 + F.lane])) - expf(wave_sum(al[128 + F.lane] * al[192 + F.lane])) + lam_init;
    const float* sg = F.inp(I_AT_SUBG);
    for (int item = gw; item < M * 8; item += NGW) {
        const int row = item >> 3, h = item & 7;
        const bf16 *Kb, *Vb; int Tk;
        if (row < NPROMPT) { Kb = KP + (size_t)(row & ~255) * D; Vb = VP + (size_t)(row & ~255) * D; Tk = 256; }
        else { const int sb = (row - NPROMPT) >> 10; Kb = F.KS + (size_t)sb * TKS * D; Vb = F.VS + (size_t)sb * TKS * D; Tk = TKS; }
        qs[F.lane] = bf2f(Q[(size_t)row * D + h * 128 + F.lane]); qs[64 + F.lane] = bf2f(Q[(size_t)row * D + h * 128 + 64 + F.lane]);
        asm volatile("s_waitcnt lgkmcnt(0)" ::: "memory");
        float m1 = -1e30f, m2 = -1e30f;
        for (int k = F.lane; k < Tk; k += 64) { const bf16* kr = Kb + (size_t)k * D + h * 128; float d1 = 0.f, d2 = 0.f;
#pragma unroll 4
            for (int d = 0; d < 64; d += 2) { const unsigned a = *(const unsigned*)(kr + d), b = *(const unsigned*)(kr + 64 + d);
                d1 += qs[d] * bf2f(a) + qs[d + 1] * bf2f(a >> 16); d2 += qs[64 + d] * bf2f(b) + qs[64 + d + 1] * bf2f(b >> 16); }
            d1 *= 0.125f; d2 *= 0.125f; s1[k] = d1; s2[k] = d2; m1 = fmaxf(m1, d1); m2 = fmaxf(m2, d2); }
        m1 = wave_max(m1); m2 = wave_max(m2);
        float l1 = 0.f, l2 = 0.f;
        for (int k = F.lane; k < Tk; k += 64) { const float e1 = expf(s1[k] - m1), e2 = expf(s2[k] - m2); s1[k] = e1; s2[k] = e2; l1 += e1; l2 += e2; }
        l1 = wave_sum(l1); l2 = wave_sum(l2);
        const float i1 = 1.f / l1, i2 = lam / l2;
        for (int k = F.lane; k < Tk; k += 64) s1[k] = bf2f(f2bf(s1[k] * i1 - s2[k] * i2));
        asm volatile("s_waitcnt lgkmcnt(0)" ::: "memory");
        float o0 = 0.f, o1 = 0.f;
        for (int k = 0; k < Tk; ++k) { const unsigned vv = *(const unsigned*)(Vb + (size_t)k * D + h * 128 + 2 * F.lane); const float w = s1[k]; o0 += w * bf2f(vv); o1 += w * bf2f(vv >> 16); }
        const float ms = wave_sum(o0 * o0 + o1 * o1) * (1.f / 128.f), rs = rsqrtf(ms + EPS) * (1.f - lam_init);
        o0 = o0 * rs * sg[2 * F.lane]; o1 = o1 * rs * sg[2 * F.lane + 1];
        *(unsigned*)(O + (size_t)row * D + h * 128 + 2 * F.lane) = f2bf(o0) | (f2bf(o1) << 16);
        asm volatile("s_waitcnt lgkmcnt(0)" ::: "memory");
    }
}


constexpr int AT_KT = 128, AT_NMF = AT_KT / 16, AT_NCH = AT_KT / 32;
constexpr int AT_KS = 272, AT_VS = 288, AT_KBYTES = AT_KT * AT_KS, AT_VBYTES = AT_KT * AT_VS, AT_BUF = AT_KBYTES + AT_VBYTES;
__device__ __forceinline__ void attn_p1_tile(LAS const unsigned char* kt, const bf16x8 (&Qf)[2][2], int c, int q4, float& m1, float& m2, float& l1, float& l2) {
    const float SC = 0.18033688f;
#pragma unroll
    for (int hf = 0; hf < AT_NMF / 4; ++hf) {
        f32x4 S[2][4];
        { bf16x8 kf[2][4][2];
#pragma unroll
          for (int cp = 0; cp < 2; ++cp)
#pragma unroll
              for (int mf = 0; mf < 4; ++mf)
#pragma unroll
                  for (int ks = 0; ks < 2; ++ks) kf[cp][mf][ks] = *(LAS const bf16x8*)(kt + (64 * hf + 16 * mf + c) * AT_KS + cp * 128 + ks * 64 + 16 * q4);
          __builtin_amdgcn_sched_barrier(0);
#pragma unroll
          for (int cp = 0; cp < 2; ++cp)
#pragma unroll
              for (int mf = 0; mf < 4; ++mf) { S[cp][mf] = (f32x4){0.f, 0.f, 0.f, 0.f};
#pragma unroll
                  for (int ks = 0; ks < 2; ++ks) S[cp][mf] = __builtin_amdgcn_mfma_f32_16x16x32_bf16(kf[cp][mf][ks], Qf[cp][ks], S[cp][mf], 0, 0, 0); } }
        float x1 = -1e30f, x2 = -1e30f;
#pragma unroll
        for (int mf = 0; mf < 4; ++mf)
#pragma unroll
            for (int k = 0; k < 4; ++k) { x1 = fmaxf(x1, S[0][mf][k]); x2 = fmaxf(x2, S[1][mf][k]); }
        x1 = max_q4(x1); x2 = max_q4(x2);
        const float n1 = fmaxf(m1, x1), n2 = fmaxf(m2, x2);
        l1 *= __builtin_amdgcn_exp2f((m1 - n1) * SC); l2 *= __builtin_amdgcn_exp2f((m2 - n2) * SC); m1 = n1; m2 = n2;
        const float o1 = m1 * SC, o2 = m2 * SC;
#pragma unroll
        for (int mf = 0; mf < 4; ++mf)
#pragma unroll
            for (int k = 0; k < 4; ++k) { l1 += __builtin_amdgcn_exp2f(S[0][mf][k] * SC - o1); l2 += __builtin_amdgcn_exp2f(S[1][mf][k] * SC - o2); }
    }
}
__device__ __forceinline__ void attn_p2_tile(LAS const unsigned char* kt, LAS const unsigned char* vt, const bf16x8 (&Qf)[2][2], int c, int q4, float o1, float o2, float i1, float i2, f32x4 (&Ot)[8]) {
    const float SC = 0.18033688f;
#pragma unroll
    for (int hf = 0; hf < AT_NMF / 4; ++hf) {
        f32x4 S[2][4];
        { bf16x8 kf[2][4][2];
#pragma unroll
          for (int cp = 0; cp < 2; ++cp)
#pragma unroll
              for (int mf = 0; mf < 4; ++mf)
#pragma unroll
                  for (int ks = 0; ks < 2; ++ks) kf[cp][mf][ks] = *(LAS const bf16x8*)(kt + (64 * hf + 16 * mf + c) * AT_KS + cp * 128 + ks * 64 + 16 * q4);
          __builtin_amdgcn_sched_barrier(0);
#pragma unroll
          for (int cp = 0; cp < 2; ++cp)
#pragma unroll
              for (int mf = 0; mf < 4; ++mf) { S[cp][mf] = (f32x4){0.f, 0.f, 0.f, 0.f};
#pragma unroll
                  for (int ks = 0; ks < 2; ++ks) S[cp][mf] = __builtin_amdgcn_mfma_f32_16x16x32_bf16(kf[cp][mf][ks], Qf[cp][ks], S[cp][mf], 0, 0, 0); } }
        bf16x8 Wf[2];
#pragma unroll
        for (int kk = 0; kk < 2; ++kk) { float w[8];
#pragma unroll
            for (int jj = 0; jj < 8; ++jj) { const int mf = 2 * kk + (jj >> 2), k = jj & 3;
                w[jj] = __builtin_amdgcn_exp2f(S[0][mf][k] * SC - o1) * i1 - __builtin_amdgcn_exp2f(S[1][mf][k] * SC - o2) * i2; }
            const unsigned p0 = pg8::cvt_pk_bf16(w[0], w[1]), p1 = pg8::cvt_pk_bf16(w[2], w[3]), p2 = pg8::cvt_pk_bf16(w[4], w[5]), p3 = pg8::cvt_pk_bf16(w[6], w[7]);
            Wf[kk] = __builtin_bit_cast(bf16x8, (u32x4){p0, p1, p2, p3}); }
#pragma unroll
        for (int mh = 0; mh < 2; ++mh) {
            v4i16_t lo[4][2], hi[4][2];
#pragma unroll
            for (int mm = 0; mm < 4; ++mm)
#pragma unroll
                for (int kk = 0; kk < 2; ++kk) { LAS const unsigned char* vp = vt + (64 * hf + 32 * kk + 4 * q4 + (c >> 2)) * AT_VS + (16 * (4 * mh + mm) + 4 * (c & 3)) * 2;
                    lo[mm][kk] = __builtin_amdgcn_ds_read_tr16_b64_v4i16((LAS v4i16_t*)vp); hi[mm][kk] = __builtin_amdgcn_ds_read_tr16_b64_v4i16((LAS v4i16_t*)(vp + 16 * AT_VS)); }
            __builtin_amdgcn_sched_barrier(0);
#pragma unroll
            for (int mm = 0; mm < 4; ++mm)
#pragma unroll
                for (int kk = 0; kk < 2; ++kk) { const bf16x8 vf = {lo[mm][kk][0], lo[mm][kk][1], lo[mm][kk][2], lo[mm][kk][3], hi[mm][kk][0], hi[mm][kk][1], hi[mm][kk][2], hi[mm][kk][3]};
                    Ot[4 * mh + mm] = __builtin_amdgcn_mfma_f32_16x16x32_bf16(vf, Wf[kk], Ot[4 * mh + mm], 0, 0, 0); }
        }
    }
}
__device__ __forceinline__ void attn_store(LAS const float* sgl  , const f32x4 (&Ot)[8], bf16* Orows, int h, int wave, int c, int q4, float lam_init) {
    float ss = 0.f;
#pragma unroll
    for (int md = 0; md < 8; ++md)
#pragma unroll
        for (int k = 0; k < 4; ++k) ss += Ot[md][k] * Ot[md][k];
    ss = sum_q4(ss);
    const float rs = rsqrtf(ss * (1.f / 128.f) + EPS) * (1.f - lam_init);
#pragma unroll
    for (int md = 0; md < 8; ++md) { const int d0 = 16 * md + 4 * q4; const f32x4 g4 = *(LAS const f32x4*)(sgl + d0);
        u32x2 w; w.x = pg8::cvt_pk_bf16(Ot[md][0] * rs * g4[0], Ot[md][1] * rs * g4[1]); w.y = pg8::cvt_pk_bf16(Ot[md][2] * rs * g4[2], Ot[md][3] * rs * g4[3]);
        *(GAS u32x2*)(Orows + (size_t)(16 * wave + c) * D + h * 128 + d0) = w; }
}
__device__ __forceinline__ void attn_unit(Frame& F, LAS const float* sgv, const bf16* Qrows  , const bf16* Kb, const bf16* Vb, int Tk, bf16* Orows, int h, float lam, float lam_init) {
    const int tid = F.tid, lane = F.lane, wave = F.wave, c = lane & 15, q4 = lane >> 4;
    LAS unsigned char* lds = F.lds;
    const float SC = 0.18033688f, THR = 8.f;
    bf16x8 Qf[2][2];
#pragma unroll
    for (int cp = 0; cp < 2; ++cp)
#pragma unroll
        for (int ks = 0; ks < 2; ++ks) Qf[cp][ks] = *(const GAS bf16x8*)(Qrows + (size_t)(16 * wave + c) * D + h * 128 + cp * 64 + 32 * ks + 8 * q4);
    const int nt = Tk / AT_KT;
    const int key0 = tid >> 4, cc0 = tid & 15;
    const GAS unsigned char* kgb = (const GAS unsigned char*)Kb + (size_t)h * 256; const GAS unsigned char* vgb = (const GAS unsigned char*)Vb + (size_t)h * 256;
    const unsigned koff = (unsigned)(key0 * D + 8 * cc0) * 2u;
    u32x4 kreg[AT_NCH], vreg[AT_NCH];
    float om[2] = {-1e30f, -1e30f}, ls[2] = {0.f, 0.f};
    f32x4 Ot[2][8];
#pragma unroll
    for (int cp = 0; cp < 2; ++cp)
#pragma unroll
        for (int md = 0; md < 8; ++md) Ot[cp][md] = (f32x4){0.f, 0.f, 0.f, 0.f};
#pragma unroll
    for (int i = 0; i < AT_NCH; ++i) { kreg[i] = *(const GAS u32x4*)(kgb + (size_t)(32 * i) * D * 2 + koff); vreg[i] = *(const GAS u32x4*)(vgb + (size_t)(32 * i) * D * 2 + koff); }
#pragma unroll
    for (int i = 0; i < AT_NCH; ++i) { *(LAS u32x4*)(lds + (key0 + 32 * i) * AT_KS + 16 * cc0) = kreg[i]; *(LAS u32x4*)(lds + AT_KBYTES + (key0 + 32 * i) * AT_VS + 16 * cc0) = vreg[i]; }
    __syncthreads();
    for (int t = 0; t < nt; ++t) {
        LAS const unsigned char* kt = lds + (t & 1) * AT_BUF; LAS const unsigned char* vt = kt + AT_KBYTES;
#pragma unroll
        for (int hf = 0; hf < AT_NMF / 4; ++hf) {
            if (hf == AT_NMF / 4 - 1 && t + 1 < nt) {
#pragma unroll
                for (int i = 0; i < AT_NCH; ++i) { kreg[i] = *(const GAS u32x4*)(kgb + (size_t)((t + 1) * AT_KT + 32 * i) * D * 2 + koff);
                                                   vreg[i] = *(const GAS u32x4*)(vgb + (size_t)((t + 1) * AT_KT + 32 * i) * D * 2 + koff); } }
            bf16x8 Pf[2][2];
#pragma unroll
            for (int cp = 0; cp < 2; ++cp) {
                f32x4 S[4];
                { bf16x8 kf[4][2];
#pragma unroll
                  for (int mf = 0; mf < 4; ++mf)
#pragma unroll
                      for (int ks = 0; ks < 2; ++ks) kf[mf][ks] = *(LAS const bf16x8*)(kt + (64 * hf + 16 * mf + c) * AT_KS + cp * 128 + ks * 64 + 16 * q4);
#pragma unroll
                  for (int mf = 0; mf < 4; ++mf) { S[mf] = (f32x4){0.f, 0.f, 0.f, 0.f};
#pragma unroll
                      for (int ks = 0; ks < 2; ++ks) S[mf] = __builtin_amdgcn_mfma_f32_16x16x32_bf16(kf[mf][ks], Qf[cp][ks], S[mf], 0, 0, 0); } }
                float x = -1e30f;
#pragma unroll
                for (int mf = 0; mf < 4; ++mf)
#pragma unroll
                    for (int k = 0; k < 4; ++k) x = fmaxf(x, S[mf][k]);
                x = max_q4(x) * SC;
                if (!__all(x - om[cp] <= THR)) {
                    const float nm = fmaxf(om[cp], x), al = __builtin_amdgcn_exp2f(om[cp] - nm);
                    om[cp] = nm; ls[cp] *= al;
#pragma unroll
                    for (int md = 0; md < 8; ++md) Ot[cp][md] = Ot[cp][md] * al; }
                float p[16]; const float o = om[cp];
#pragma unroll
                for (int mf = 0; mf < 4; ++mf)
#pragma unroll
                    for (int k = 0; k < 4; ++k) { p[4 * mf + k] = __builtin_amdgcn_exp2f(S[mf][k] * SC - o); ls[cp] += p[4 * mf + k]; }
#pragma unroll
                for (int kk = 0; kk < 2; ++kk) { const unsigned p0 = pg8::cvt_pk_bf16(p[8 * kk + 0], p[8 * kk + 1]), p1 = pg8::cvt_pk_bf16(p[8 * kk + 2], p[8 * kk + 3]), p2 = pg8::cvt_pk_bf16(p[8 * kk + 4], p[8 * kk + 5]), p3 = pg8::cvt_pk_bf16(p[8 * kk + 6], p[8 * kk + 7]);
                    Pf[cp][kk] = __builtin_bit_cast(bf16x8, (u32x4){p0, p1, p2, p3}); }
            }
#pragma unroll
            for (int mh = 0; mh < 4; ++mh) {
                v4i16_t lo[2][2], hi[2][2];
#pragma unroll
                for (int mm = 0; mm < 2; ++mm)
#pragma unroll
                    for (int kk = 0; kk < 2; ++kk) { LAS const unsigned char* vp = vt + (64 * hf + 32 * kk + 4 * q4 + (c >> 2)) * AT_VS + (16 * (2 * mh + mm) + 4 * (c & 3)) * 2;
                        lo[mm][kk] = __builtin_amdgcn_ds_read_tr16_b64_v4i16((LAS v4i16_t*)vp); hi[mm][kk] = __builtin_amdgcn_ds_read_tr16_b64_v4i16((LAS v4i16_t*)(vp + 16 * AT_VS)); }
                __builtin_amdgcn_sched_barrier(0);
#pragma unroll
                for (int mm = 0; mm < 2; ++mm)
#pragma unroll
                    for (int kk = 0; kk < 2; ++kk) { const bf16x8 vf = {lo[mm][kk][0], lo[mm][kk][1], lo[mm][kk][2], lo[mm][kk][3], hi[mm][kk][0], hi[mm][kk][1], hi[mm][kk][2], hi[mm][kk][3]};
                        Ot[0][2 * mh + mm] = __builtin_amdgcn_mfma_f32_16x16x32_bf16(vf, Pf[0][kk], Ot[0][2 * mh + mm], 0, 0, 0);
                        Ot[1][2 * mh + mm] = __builtin_amdgcn_mfma_f32_16x16x32_bf16(vf, Pf[1][kk], Ot[1][2 * mh + mm], 0, 0, 0); }
            }
        }
        if (t + 1 < nt) {
#pragma unroll
            for (int i = 0; i < AT_NCH; ++i) { *(LAS u32x4*)(lds + ((t + 1) & 1) * AT_BUF + (key0 + 32 * i) * AT_KS + 16 * cc0) = kreg[i];
                                               *(LAS u32x4*)(lds + ((t + 1) & 1) * AT_BUF + AT_KBYTES + (key0 + 32 * i) * AT_VS + 16 * cc0) = vreg[i]; } }
        __syncthreads();
    }
    const float i1 = 1.f / sum_q4(ls[0]), i2 = lam / sum_q4(ls[1]);
    f32x4 Oc[8];
#pragma unroll
    for (int md = 0; md < 8; ++md) Oc[md] = Ot[0][md] * i1 - Ot[1][md] * i2;
    attn_store(sgv, Oc, Orows, h, wave, c, q4, lam_init);
}
__device__ __forceinline__ void attn_unit_resident(Frame& F, LAS const float* sgv, const bf16* Qrows, const bf16* Kb, const bf16* Vb, bf16* Orows, int h, float lam, float lam_init) {
    const int tid = F.tid, lane = F.lane, wave = F.wave, c = lane & 15, q4 = lane >> 4;
    LAS unsigned char* lds = F.lds;
    const float SC = 0.18033688f;
    const int key0 = tid >> 4, cc0 = tid & 15;
    const GAS unsigned char* kgb = (const GAS unsigned char*)Kb + (size_t)h * 256; const GAS unsigned char* vgb = (const GAS unsigned char*)Vb + (size_t)h * 256;
    const unsigned koff = (unsigned)(key0 * D + 8 * cc0) * 2u;
    bf16x8 Qf[2][2][2];
#pragma unroll
    for (int qi = 0; qi < 2; ++qi)
#pragma unroll
        for (int cp = 0; cp < 2; ++cp)
#pragma unroll
            for (int ks = 0; ks < 2; ++ks) Qf[qi][cp][ks] = *(const GAS bf16x8*)(Qrows + (size_t)(128 * qi + 16 * wave + c) * D + h * 128 + cp * 64 + 32 * ks + 8 * q4);
#pragma unroll
    for (int t = 0; t < 2; ++t) { u32x4 kreg[AT_NCH], vreg[AT_NCH];
#pragma unroll
        for (int i = 0; i < AT_NCH; ++i) { kreg[i] = *(const GAS u32x4*)(kgb + (size_t)(t * AT_KT + 32 * i) * D * 2 + koff); vreg[i] = *(const GAS u32x4*)(vgb + (size_t)(t * AT_KT + 32 * i) * D * 2 + koff); }
#pragma unroll
        for (int i = 0; i < AT_NCH; ++i) { *(LAS u32x4*)(lds + t * AT_BUF + (key0 + 32 * i) * AT_KS + 16 * cc0) = kreg[i]; *(LAS u32x4*)(lds + t * AT_BUF + AT_KBYTES + (key0 + 32 * i) * AT_VS + 16 * cc0) = vreg[i]; } }
    __syncthreads();
#pragma unroll
    for (int qi = 0; qi < 2; ++qi) {
        float m1 = -1e30f, m2 = -1e30f, l1 = 0.f, l2 = 0.f;
        const bf16x8 (&Qq)[2][2] = Qf[qi];
        attn_p1_tile(lds, Qq, c, q4, m1, m2, l1, l2); attn_p1_tile(lds + AT_BUF, Qq, c, q4, m1, m2, l1, l2);
        l1 = sum_q4(l1); l2 = sum_q4(l2);
        const float i1 = 1.f / l1, i2 = lam / l2, o1 = m1 * SC, o2 = m2 * SC;
        f32x4 Ot[8];
#pragma unroll
        for (int md = 0; md < 8; ++md) Ot[md] = (f32x4){0.f, 0.f, 0.f, 0.f};
        attn_p2_tile(lds, lds + AT_KBYTES, Qq, c, q4, o1, o2, i1, i2, Ot); attn_p2_tile(lds + AT_BUF, lds + AT_BUF + AT_KBYTES, Qq, c, q4, o1, o2, i1, i2, Ot);
        attn_store(sgv, Ot, Orows + (size_t)128 * qi * D, h, wave, c, q4, lam_init);
    }
    __syncthreads();
}
__device__ __forceinline__ void phase_attn(Frame& F, int l, const bf16* Q, const bf16* KP, const bf16* VP, bf16* O) {
    F.fresh();
    const float* al = F.inp(I_AT_LAM);
    const float lam_init = 0.8f - 0.6f * expf(-0.3f * (float)l);
    const float lam = expf(wave_sum(al[F.lane] * al[64 + F.lane])) - expf(wave_sum(al[128 + F.lane] * al[192 + F.lane])) + lam_init;
    LAS float* sgv = (LAS float*)(F.lds + 2 * AT_BUF);
    if (F.tid < 128) sgv[F.tid] = F.inp(I_AT_SUBG)[F.tid];
    __syncthreads();
    for (int s = 0; ; ++s) {
        int u;
        if (F.G == 256) { if (F.bid < 128) { if (s > 0) break; const int x = F.bid & 7, i = F.bid >> 3; u = (2 * x + (i >> 3)) * 8 + (i & 7); }
                          else { if (s > 1) break; u = 128 + 2 * (F.bid - 128) + s; } }
        else { u = F.bid + s * F.G; if (u >= 384) break; }
        if (u < 128) { const int sb = u >> 6, h = (u >> 3) & 7, qt = u & 7; const size_t r0 = (size_t)NPROMPT + sb * 1024 + qt * 128;
            attn_unit(F, sgv, Q + r0 * D, F.KS + (size_t)sb * TKS * D, F.VS + (size_t)sb * TKS * D, TKS, O + r0 * D, h, lam, lam_init); }
        else { const int v = u - 128, b = v >> 3, h = v & 7; const size_t r0 = (size_t)b * 256;
            attn_unit_resident(F, sgv, Q + r0 * D, KP + r0 * D, VP + r0 * D, O + r0 * D, h, lam, lam_init); }
    }
}

__device__ __forceinline__ void phase_ffn_convgate(Frame& F, int l, const bf16* Z, bf16* ACT) {
    F.fresh();
    const float* cw = F.inp(I_FF_CW) + (size_t)l * 3 * 2 * DFF; const float* cb = F.inp(I_FF_CB) + (size_t)l * 2 * DFF;
    const int gt = F.bid * NT + F.tid, GT = F.G * NT;
    for (int i = gt; i < M * DFF; i += GT) { const int row = i / DFF, j = i % DFF;
        int t, T; if (row < NPROMPT) { t = row & 255; T = 256; } else { t = (row - NPROMPT) & 1023; T = 1024; }
        float g = cb[j], u = cb[DFF + j];
#pragma unroll
        for (int k = 0; k < 3; ++k) { const int tt = t + k - 1; if (tt >= 0 && tt < T) { const bf16* zr = Z + (size_t)(row + k - 1) * 2 * DFF; g += cw[k * 2 * DFF + j] * bf2f(zr[j]); u += cw[k * 2 * DFF + DFF + j] * bf2f(zr[DFF + j]); } }
        ACT[i] = (bf16)f2bf(siluf_(g) * u); }
}

__global__ void __launch_bounds__(NT, 2) mk_fwd(Params prm) {
    extern __shared__ __attribute__((aligned(16))) unsigned char lds_raw[];
    Frame F;
    F.lds = (LAS unsigned char*)lds_raw; F.G = gridDim.x; F.out0 = prm.out; F.ws0 = prm.ws; F.wave0 = __builtin_amdgcn_readfirstlane(threadIdx.x >> 6);
    F.fresh();
    if (F.tid < N_IN) ((LAS unsigned long long*)(F.lds + PTR_OFF))[F.tid] = (unsigned long long)prm.in[F.tid];
    volatile LAS unsigned* MISC = (volatile LAS unsigned*)(F.lds + MISC_OFF);
    if (F.tid < 32) MISC[F.tid] = 0u;
    __syncthreads();
    (void)xcd_barrier_post((unsigned*)(prm.ws + WS_CTL) + CW_BAR, MISC + 8, F.tid == 0);
#define GRID_BAR_X(fn_) do { F.fresh(); XcdBarrier bar_; bar_.t0 = F.tid == 0; { unsigned* bp_ = (unsigned*)(prm.ws + WS_CTL) + CW_BAR; asm volatile("" : "+s"(bp_)); bar_.bar = bp_; } bar_.x = xb_xcc_id(); bar_.st = (volatile LAS unsigned*)(F.lds + MISC_OFF) + 8; fn_(bar_); } while (0)
#define GRID_ARRIVE() GRID_BAR_X(xcd_barrier_arrive)
#define GRID_WAIT() GRID_BAR_X(xcd_barrier_wait)
#define GRID_BAR() do { F.fresh(); XcdBarrier bar_; bar_.t0 = F.tid == 0; { unsigned* bp_ = (unsigned*)(prm.ws + WS_CTL) + CW_BAR; asm volatile("" : "+s"(bp_)); bar_.bar = bp_; } bar_.x = xb_xcc_id(); bar_.st = (volatile LAS unsigned*)(F.lds + MISC_OFF) + 8; xcd_barrier(bar_); } while (0)

#define GEMM_BF16(ACT, A_, Bt_, N_, K_, O_, ldc_, bias_, splitc_, splits_, rsq_, b2_, rsqv_, vt0_) do { pg8::Gemm g{A_, Bt_, M, N_, K_}; pg8::StaticOrder S; S.init(M, N_, F.G, F.bid); S.wave = F.wave; \
        pg8::EpiBf16<ACT> E{O_, ldc_, bias_, splitc_, splits_, rsq_, b2_, N_, rsqv_, vt0_, F.lds}; F.fresh(); E.prep(S, F.tid); pg8::gemm_phase<pg8::EpiBf16<ACT>, pg8::StaticOrder, true, true>(F.lds, g, S, E); } while (0)
#define GEMM_RESID(A_, Bt_, K_, sub_, fromin_) do { pg8::Gemm g{A_, Bt_, 54 * 192, D, K_}; pg8::ResOrder S; S.init(54 * 256, D, F.G, F.bid); S.wave = F.wave; \
        const int nl_ = (sub_) == 0 ? l : l + 1, ns_ = (sub_) == 0 ? 1 : 0; const bool last_ = nl_ >= DEPTH; \
        pg8::EpiResid E{F.out, (bf16*)(F.ws + WS_XB), F.mod + (size_t)l * 18 * D, (sub_) * 3 + 2, last_, last_ ? nullptr : F.H, F.inp(I_NORMG) + (size_t)((last_ ? 0 : nl_) * 2 + ns_) * D, \
                          F.mod + (size_t)(last_ ? 0 : nl_) * 18 * D, ns_ * 3 + 1, (sub_) == 0 ? F.rsq1 : F.rsq0, F.lds}; \
        GRID_ARRIVE(); F.fresh(); E.prep(S, F.tid); GRID_WAIT();            \
        pg8::gemm_phase<pg8::EpiResid, pg8::ResOrder, true, true>(F.lds, g, S, E); \
        if (F.bid >= 54 * 4 || F.G <= 54 * 4) side_job(F, 2 * l + (sub_) + 1, 1);     \
        if (!last_) { GRID_ARRIVE(); F.fresh(); pg8::ResOrder S2; S2.init(54 * 256, D, F.G, F.bid); const int n_ = S2.nwg > S2.c ? (S2.nwg - 1 - S2.c) / S2.G + 1 : 0; \
            if (n_ > 0) { pg8::Unit u_{0, 0}; (void)S2.next(n_ - 1, u_); pg8::EpiResid E2{}; E2.XB = (bf16*)(F.ws + WS_XB); E2.lds = F.lds; E2.flush(u_, F.tid); } } } while (0)

    phase_prologue(F);
    GRID_BAR();
    phase_modulate0(F);
    GRID_BAR();
#pragma unroll 1
    for (int l = 0; l < DEPTH; ++l) {
        const int kind = l % 3, j = l / 3;
        F.fresh();
        if (kind == 0) {
            bf16 *GB = F.T2, *REC = F.T2 + (size_t)M * DRNN, *PF = F.T3, *PB = F.T3 + (size_t)NSAMPLE * DRNN, *HS = F.T3 + (size_t)6 * 1024 * 1024;
            float* AGG = (float*)(F.T3 + (size_t)2 * NSAMPLE * DRNN);
            GEMM_BF16(2, F.H, F.WT + WE_LRU_IN + (size_t)j * 2 * DRNN * D, 2 * DRNN, D, GB, DRNN, nullptr, DRNN, (size_t)M * DRNN, F.rsq0, F.bias2 + B2_LRU + (size_t)j * 3 * 2560, nullptr, 0);
            GRID_BAR();
            phase_lru_core(F, j, REC, GB, HS, PF, PB, AGG, (unsigned*)(F.ws + WS_CTL) + CW_LRU, F.WT + WE_WG + (size_t)j * 40 * 128 * 128);
            if (l == 0 && (F.G != 256 || F.bid >= 400 - 256)) side_job(F, 9);
                        GEMM_RESID(HS, F.WT + WE_LRU_OUT + (size_t)j * D * DRNN, DRNN, 0, l == 0);
        } else if (kind == 1) {
            bf16 *UV = F.T1, *ACT = F.T2;
            GEMM_BF16(1, F.H, F.WT + WE_CM_IN, 2 * DB, D, UV, 2 * DB, F.inp(I_CM_BIN), 0, 0, F.rsq0, F.bias2 + B2_CM, F.rsqv, 8);
            GRID_BAR();
            phase_cmlp_spatial_mfma(F, UV, ACT, F.WT + WE_WSB);
                        GEMM_RESID(ACT, F.WT + WE_CM_OUT, DB, 0, false);
        } else {
            bf16 *Q = F.T2, *KP = F.T2 + (size_t)M * D, *VP = KP + (size_t)NPROMPT * D, *O = F.T3;
            { pg8::Gemm g{F.H, F.WT + WE_QKV, M, 3 * D, D}; pg8::StaticOrder S; S.init(M, 3 * D, F.G, F.bid); S.wave = F.wave;
              pg8::EpiQkv E{F.ws, F.out, F.rsq0, F.bias2 + B2_QKV, F.lds, F.inp(I_AT_QKG), F.rope};
              F.fresh(); E.prep(S, F.tid); pg8::gemm_phase<pg8::EpiQkv, pg8::StaticOrder, true, true>(F.lds, g, S, E); }
            GRID_BAR();
            phase_attn(F, l, Q, KP, VP, O);
                        GEMM_RESID(O, F.WT + WE_AT_OUT, D, 0, false);
        }
        if (F.G != 256 || F.bid >= 924 - 3 * 256) side_job(F, 2 * l + 1, 2);
        GRID_WAIT();
        { pg8::Gemm g{F.H, F.WT + WE_UP + (size_t)l * 2 * DFF * D, 42 * 256, 2 * DFF, D}; pg8::FfnOrder S; S.init(42 * 256, 2 * DFF, F.G, F.bid); S.wave = F.wave;
          pg8::EpiFfn E{F.T2, F.inp(I_FF_CW) + (size_t)l * 3 * 2 * DFF, F.inp(I_FF_CB) + (size_t)l * 2 * DFF, F.rsq1, F.bias2 + B2_UP + (size_t)l * 3 * 5632, F.lds};
          F.fresh(); E.prep(S, F.tid); pg8::gemm_phase<pg8::EpiFfn, pg8::FfnOrder, true, true>(F.lds, g, S, E); }
                GEMM_RESID(F.T2, F.WT + WE_DN + (size_t)l * D * DFF, DFF, 1, false);
        if (l + 1 < DEPTH) { const int crit_ = (l + 1) % 3 == 0 ? 400 - 256 : (l + 1) % 3 == 1 ? 640 - 2 * 256 : 480 - 256;
            if (F.G != 256 || F.bid >= crit_) side_job(F, 2 * l + 2, 2); GRID_WAIT(); }
    }
}

extern "C" void kernel_launch(void* const* d_in, const int* in_sizes, int n_in, void* d_out, int out_size, void* d_ws, size_t ws_size, hipStream_t stream) {
    static int grid = 0;
    if (grid == 0) {
        if (n_in != N_IN || ws_size < WS_END) { fprintf(stderr, "kernel_launch: unexpected n_in %d or ws_size %zu\n", n_in, ws_size); grid = -1; return; }
        int dev = 0, cus = 0, per_cu = 0;
        hipGetDevice(&dev); hipDeviceGetAttribute(&cus, hipDeviceAttributeMultiprocessorCount, dev);
        hipFuncSetAttribute((const void*)mk_fwd, hipFuncAttributeMaxDynamicSharedMemorySize, LDS_BYTES);
        hipOccupancyMaxActiveBlocksPerMultiprocessor(&per_cu, (const void*)mk_fwd, NT, LDS_BYTES);
        (void)hipGetLastError();
        if (per_cu < 1) { fprintf(stderr, "kernel_launch: occupancy query says %d blocks per CU\n", per_cu); per_cu = 1; }
        grid = cus;
    }
    if (grid < 0) return;
    hipMemsetAsync((char*)d_ws + WS_CTL, 0, CTL_ZERO_BYTES, stream);
    Params p{};
    for (int i = 0; i < N_IN; ++i) p.in[i] = (const float*)d_in[i];
    p.out = (float*)d_out; p.ws = (unsigned char*)d_ws;
    void* args[] = {&p};
    hipError_t e = hipLaunchCooperativeKernel((const void*)mk_fwd, dim3(grid), dim3(NT), args, LDS_BYTES, stream);
    if (e != hipSuccess) fprintf(stderr, "kernel_launch: cooperative launch failed: %s (grid %d)\n", hipGetErrorString(e), grid);
}
```
